# Optimizing an MI355X kernel written in HIP

```python
import jax, jax.numpy as jnp
from jax import lax
import numpy as np

D_MODEL = 1024
BATCH = 4
SEQ = 4096
DEPTH = 1

D_FF = 2816
ROPE_THETA = 10000.0
NORM_EPS = 1e-6
Q_BLOCK = 128
H_A = 8
Q_LORA = 384
KV_LORA = 256
D_NOPE = 64
D_ROPE_A = 32
D_V_A = 64
H_IDX = 8
D_IDX = 32
TOPK_MAX = 256
DIL_PAIRS = ((128, 1), (512, 4), (2048, 16))
N_GROUPS_B = 3
H_B = 4
D_HEAD_B = 64
N_MOD = 9
COLS = (Q_LORA, KV_LORA, D_ROPE_A, D_IDX, H_IDX, 3 * N_GROUPS_B * H_B * D_HEAD_B, 2 * D_MODEL)
D_IN = sum(COLS)
WIDTH_A = H_A * D_V_A
WIDTH_B = H_B * D_HEAD_B

kernel_name = "hybrid_dsa_dilated_macaron_block"


def rms_norm(x, g):
    xf = x.astype(jnp.float32)
    y = xf * lax.rsqrt(jnp.mean(xf * xf, axis=-1, keepdims=True) + NORM_EPS)
    return (y * g.astype(jnp.float32)).astype(x.dtype)


def rope(x, pos):
    d = x.shape[-1]
    half = d // 2
    inv = ROPE_THETA ** (-jnp.arange(half, dtype=jnp.float32) / half)
    ang = pos.astype(jnp.float32)[..., None] * inv
    ang = ang.reshape(ang.shape[:2] + (1,) * (x.ndim - 3) + (half,))
    cos, sin = jnp.cos(ang), jnp.sin(ang)
    xf = x.astype(jnp.float32)
    x1, x2 = xf[..., :half], xf[..., half:]
    return jnp.concatenate([x1 * cos - x2 * sin, x2 * cos + x1 * sin], axis=-1).astype(x.dtype)


def swiglu(h, w_gate, w_up, w_down):
    return (jax.nn.silu(h @ w_gate) * (h @ w_up)) @ w_down


def dsa_branch(c_q, c_kv, k_rope, k_idx, w_idx, pos, w_uq, w_uk, w_uv, w_iq):
    B, S, _ = c_q.shape
    topk = min(TOPK_MAX, S // 4)
    q = jnp.einsum('bsr,rhe->bshe', c_q, w_uq)
    q_nope, q_rope = q[..., :D_NOPE], rope(q[..., D_NOPE:], pos)
    k_rope = rope(k_rope[:, :, None, :], pos)[:, :, 0]
    q_lat = jnp.einsum('bshn,rhn->bshr', q_nope, w_uk)
    q_idx = rope(jnp.einsum('bsr,rhe->bshe', c_q, w_iq), pos)
    k_idx = rope(k_idx[:, :, None, :], pos)[:, :, 0]
    w_idx = w_idx * (H_IDX ** -0.5)
    attn_scale = (D_NOPE + D_ROPE_A) ** -0.5
    idx_scale = D_IDX ** -0.5
    key_pos = jnp.arange(S)
    gather = jax.vmap(lambda a, i: a[i])

    def block(i):
        t0 = i * Q_BLOCK
        tq = t0 + jnp.arange(Q_BLOCK)
        qi = lax.dynamic_slice_in_dim(q_idx, t0, Q_BLOCK, axis=1)
        wi = lax.dynamic_slice_in_dim(w_idx, t0, Q_BLOCK, axis=1)
        logits = jnp.einsum('bqhe,bse->bqhs', qi, k_idx).astype(jnp.float32) * idx_scale
        iscore = jnp.einsum('bqh,bqhs->bqs', wi.astype(jnp.float32), jax.nn.relu(logits))
        causal = key_pos[None, :] <= tq[:, None]
        iscore = jnp.where(causal[None], iscore, -jnp.inf)
        _, sel = lax.top_k(iscore, topk)
        valid = sel <= tq[None, :, None]
        ckv_sel = gather(c_kv, sel)
        kr_sel = gather(k_rope, sel)
        ql = lax.dynamic_slice_in_dim(q_lat, t0, Q_BLOCK, axis=1)
        qr = lax.dynamic_slice_in_dim(q_rope, t0, Q_BLOCK, axis=1)
        s = (jnp.einsum('bqhr,bqkr->bqhk', ql, ckv_sel)
             + jnp.einsum('bqhe,bqke->bqhk', qr, kr_sel)).astype(jnp.float32) * attn_scale
        s = jnp.where(valid[:, :, None, :], s, -jnp.inf)
        p = jax.nn.softmax(s, axis=-1)
        return jnp.einsum('bqhk,bqkr->bqhr', p.astype(c_kv.dtype), ckv_sel)

    o_lat = lax.map(block, jnp.arange(S // Q_BLOCK))
    o_lat = jnp.moveaxis(o_lat, 0, 1).reshape(B, S, H_A, KV_LORA)
    o = jnp.einsum('bshr,rhv->bshv', o_lat, w_uv)
    return o.reshape(B, S, WIDTH_A)


def dilated_group(q, k, v, window, dilation):
    B, S, H, dh = q.shape
    offs = jnp.arange(window // dilation + 1) * dilation
    scale = dh ** -0.5

    def block(i):
        t0 = i * Q_BLOCK
        tq = t0 + jnp.arange(Q_BLOCK)
        idx = tq[:, None] - offs[None, :]
        valid = idx >= 0
        idxc = jnp.maximum(idx, 0)
        kg = k[:, idxc]
        vg = v[:, idxc]
        qb = lax.dynamic_slice_in_dim(q, t0, Q_BLOCK, axis=1)
        s = jnp.einsum('bqhe,bqnhe->bqhn', qb, kg).astype(jnp.float32) * scale
        s = jnp.where(valid[None, :, None, :], s, -jnp.inf)
        lse = jax.nn.logsumexp(s, axis=-1)
        p = jnp.exp(s - lse[..., None])
        o = jnp.einsum('bqhn,bqnhe->bqhe', p.astype(v.dtype), vg)
        return o, lse

    o, lse = lax.map(block, jnp.arange(S // Q_BLOCK))
    o = jnp.moveaxis(o, 0, 1).reshape(B, S, H, dh)
    lse = jnp.moveaxis(lse, 0, 1).reshape(B, S, H)
    return o, lse


def dilated_branch(qkv, pos):
    B, S = qkv.shape[:2]
    q = rope(qkv[:, :, 0], pos)
    k = rope(qkv[:, :, 1], pos)
    v = qkv[:, :, 2]
    outs, lses = [], []
    for g, (window, dilation) in enumerate(DIL_PAIRS):
        o, lse = dilated_group(q[:, :, g], k[:, :, g], v[:, :, g], window, dilation)
        outs.append(o)
        lses.append(lse)
    wts = jax.nn.softmax(jnp.stack(lses, axis=0), axis=0)
    o = jnp.sum(wts[..., None].astype(v.dtype) * jnp.stack(outs, axis=0), axis=0)
    return o.reshape(B, S, WIDTH_B)


def hybrid_mixer(u, pos, w_in, g_cq, g_ckv, w_uq, w_uk, w_uv, w_iq, w_up_a, w_up_b, w_o):
    B, S, _ = u.shape
    proj = u @ w_in
    splits, acc = [], 0
    for n in COLS[:-1]:
        acc += n
        splits.append(acc)
    c_q, c_kv, k_rope, k_idx, w_idx, qkv_b, gates = jnp.split(proj, splits, axis=-1)
    c_q = rms_norm(c_q, g_cq)
    c_kv = rms_norm(c_kv, g_ckv)
    o_a = dsa_branch(c_q, c_kv, k_rope, k_idx, w_idx, pos, w_uq, w_uk, w_uv, w_iq)
    o_b = dilated_branch(qkv_b.reshape(B, S, 3, N_GROUPS_B, H_B, D_HEAD_B), pos)
    g_a, g_b = jnp.split(gates, 2, axis=-1)
    z = jax.nn.sigmoid(g_a) * (o_a @ w_up_a) + jax.nn.sigmoid(g_b) * (o_b @ w_up_b)
    return z @ w_o


def setup_inputs(seed: int = 0) -> dict:
    key = jax.random.key(seed)
    ks = jax.random.split(key, 32)
    L, D = DEPTH, D_MODEL

    def nrm(k, shape, fan_in):
        return jax.random.normal(k, shape, jnp.float32) * (fan_in ** -0.5)

    def gain(k, shape):
        return 1.0 + 0.05 * jax.random.normal(k, shape, jnp.float32)

    x = jax.random.normal(ks[0], (BATCH, SEQ, D), jnp.float32)
    c = jax.random.normal(ks[1], (BATCH, D), jnp.float32)
    positions = (jax.random.randint(ks[2], (BATCH, 1), 0, 512, dtype=jnp.int32)
                 + jnp.arange(SEQ, dtype=jnp.int32)[None, :])
    return {
        "x": x,
        "c": c,
        "positions": positions,
        "w_mod": 0.5 * nrm(ks[3], (L, D, N_MOD * D), D),
        "b_mod": 0.01 * jax.random.normal(ks[4], (L, N_MOD * D), jnp.float32),
        "g_pre_ffn1": gain(ks[5], (L, D)),
        "w_gate1": nrm(ks[6], (L, D, D_FF), D),
        "w_up1": nrm(ks[7], (L, D, D_FF), D),
        "w_down1": nrm(ks[8], (L, D_FF, D), D_FF),
        "g_post_ffn1": gain(ks[9], (L, D)),
        "g_pre_mix": gain(ks[10], (L, D)),
        "w_in": nrm(ks[11], (L, D, D_IN), D),
        "g_cq": gain(ks[12], (L, Q_LORA)),
        "g_ckv": gain(ks[13], (L, KV_LORA)),
        "w_uq": nrm(ks[14], (L, Q_LORA, H_A, D_NOPE + D_ROPE_A), Q_LORA),
        "w_uk": nrm(ks[15], (L, KV_LORA, H_A, D_NOPE), KV_LORA),
        "w_uv": nrm(ks[16], (L, KV_LORA, H_A, D_V_A), KV_LORA),
        "w_iq": nrm(ks[17], (L, Q_LORA, H_IDX, D_IDX), Q_LORA),
        "w_up_a": nrm(ks[18], (L, WIDTH_A, D), WIDTH_A),
        "w_up_b": nrm(ks[19], (L, WIDTH_B, D), WIDTH_B),
        "w_o": nrm(ks[20], (L, D, D), D),
        "g_post_mix": gain(ks[21], (L, D)),
        "g_pre_ffn2": gain(ks[22], (L, D)),
        "w_gate2": nrm(ks[23], (L, D, D_FF), D),
        "w_up2": nrm(ks[24], (L, D, D_FF), D),
        "w_down2": nrm(ks[25], (L, D_FF, D), D_FF),
        "g_post_ffn2": gain(ks[26], (L, D)),
    }


def reference(x, c, positions, w_mod, b_mod, g_pre_ffn1, w_gate1, w_up1, w_down1, g_post_ffn1,
              g_pre_mix, w_in, g_cq, g_ckv, w_uq, w_uk, w_uv, w_iq, w_up_a, w_up_b, w_o, g_post_mix,
              g_pre_ffn2, w_gate2, w_up2, w_down2, g_post_ffn2):
    B = x.shape[0]
    for l in range(DEPTH):
        mod = (jax.nn.silu(c) @ w_mod[l] + b_mod[l]).reshape(B, N_MOD, D_MODEL)
        sh1, sc1, gt1, sh2, sc2, gt2, sh3, sc3, gt3 = [mod[:, j, None, :] for j in range(N_MOD)]
        h = rms_norm(x, g_pre_ffn1[l]) * (1 + sc1) + sh1
        x = x + 0.5 * gt1 * rms_norm(swiglu(h, w_gate1[l], w_up1[l], w_down1[l]), g_post_ffn1[l])
        u = rms_norm(x, g_pre_mix[l]) * (1 + sc2) + sh2
        y = hybrid_mixer(u, positions, w_in[l], g_cq[l], g_ckv[l], w_uq[l], w_uk[l], w_uv[l], w_iq[l],
                         w_up_a[l], w_up_b[l], w_o[l])
        x = x + gt2 * rms_norm(y, g_post_mix[l])
        h = rms_norm(x, g_pre_ffn2[l]) * (1 + sc3) + sh3
        x = x + 0.5 * gt3 * rms_norm(swiglu(h, w_gate2[l], w_up2[l], w_down2[l]), g_post_ffn2[l])
    return x
```

```cpp
#include <hip/hip_runtime.h>
#include <hip/hip_fp16.h>
#include <cstdio>
#include <cstdint>
#define DBG_NOGATE 0

constexpr int NB = 4, SEQ = 4096, DM = 1024, MT = NB * SEQ, FF = 2816;
constexpr int QL = 384, KVL = 256, DNOPE = 64, DROPE = 32, DVA = 64, HA = 8, HI = 8, DI = 32, TOPK = 256;
constexpr int NG = 3, HB = 4, DHB = 64, NMOD = 9, DIN = 5064;
constexpr int C_CQ = 0, C_CKV = 384, C_KR = 640, C_KI = 672, C_WI = 704, C_QKV = 712, C_GATE = 3016;
constexpr float EPS = 1e-6f, LOG2E = 1.4426950408889634f;
typedef _Float16 h16;

constexpr size_t MiB = 1u << 20;
constexpr size_t OFF_CTL = 0, OFF_MOD = 1 * MiB, OFF_ROPE = 2 * MiB, OFF_W = 8 * MiB, OFF_H = 60 * MiB, OFF_A = 92 * MiB, OFF_F = 180 * MiB, OFF_SP = 244 * MiB, WS_END = 256 * MiB;
constexpr size_t OFF_QB = OFF_A, OFF_KB = OFF_A + 24 * MiB, OFF_VT = OFF_A + 48 * MiB, OFF_CKV = OFF_A + 72 * MiB, OFF_KR = OFF_A + 80 * MiB, OFF_KI = OFF_A + 81 * MiB,
                 OFF_WI = OFF_A + 82 * MiB, OFF_SSQ = OFF_A + 82 * MiB + 512 * 1024, OFF_CQ = OFF_SP;
constexpr size_t OFF_OG = OFF_F, OFF_LSE = OFF_F + 24 * MiB, OFF_QLAT = OFF_A, OFF_QR = OFF_A + 64 * MiB, OFF_QI = OFF_F + 25 * MiB, OFF_SEL = OFF_F + 33 * MiB, OFF_OB = OFF_SP;
constexpr size_t OFF_Y1 = OFF_F, OFF_Y2 = OFF_F + 32 * MiB, OFF_YF = OFF_A;

__device__ __forceinline__ float silu_f(float v) { return v / (1.f + __expf(-v)); }
__device__ __forceinline__ float sigm_f(float v) { return 1.f / (1.f + __expf(-v)); }
__device__ __forceinline__ float block_sum256(float v, float* red) {
#pragma unroll
    for (int o = 32; o > 0; o >>= 1) v += __shfl_xor(v, o);
    __syncthreads();
    if ((threadIdx.x & 63) == 0) red[threadIdx.x >> 6] = v;
    __syncthreads();
    return red[0] + red[1] + red[2] + red[3];
}
__device__ __forceinline__ float block_max256(float v, float* red) {
#pragma unroll
    for (int o = 32; o > 0; o >>= 1) v = fmaxf(v, __shfl_xor(v, o));
    __syncthreads();
    if ((threadIdx.x & 63) == 0) red[threadIdx.x >> 6] = v;
    __syncthreads();
    return fmaxf(fmaxf(red[0], red[1]), fmaxf(red[2], red[3]));
}

__global__ void n_mod(const float* c, const float* w_mod, const float* b_mod, float* mod) {
    const int j = blockIdx.x * 256 + threadIdx.x, b = blockIdx.y;
    float acc = b_mod[j];
    for (int k = 0; k < DM; ++k) acc += silu_f(c[b * DM + k]) * w_mod[(size_t)k * (NMOD * DM) + j];
    mod[b * (NMOD * DM) + j] = acc;
}
__global__ void n_rope_tab(const int* pos, float2* tab) {
    const int idx = blockIdx.x * 256 + threadIdx.x; if (idx >= MT * 48) return;
    const int tok = idx / 48, i = idx % 48;
    const float inv = (i < 32) ? powf(10000.f, -(float)i / 32.f) : powf(10000.f, -(float)(i - 32) / 16.f);
    const float ang = (float)pos[tok] * inv;
    tab[idx] = make_float2(cosf(ang), sinf(ang));
}
__global__ void n_normmod(const float* x, const float* g, const float* mod, int isc, int ish, h16* out) {
    __shared__ float red[4];
    const int row = blockIdx.x, b = row / SEQ, t = threadIdx.x;
    const float4 v = ((const float4*)(x + (size_t)row * DM))[t];
    const float ss = block_sum256(v.x * v.x + v.y * v.y + v.z * v.z + v.w * v.w, red);
    const float rstd = rsqrtf(ss * (1.f / DM) + EPS);
    const float* sc = mod + b * (NMOD * DM) + isc * DM; const float* sh = mod + b * (NMOD * DM) + ish * DM;
    const float vv[4] = {v.x, v.y, v.z, v.w};
#pragma unroll
    for (int e = 0; e < 4; ++e) { const int cidx = 4 * t + e; out[(size_t)row * DM + cidx] = (h16)(vv[e] * rstd * g[cidx] * (1.f + sc[cidx]) + sh[cidx]); }
}
__global__ void n_resnorm(const float* xin, const float* f, const float* g, const float* mod, int igt, float coef, float* xout) {
    __shared__ float red[4];
    const int row = blockIdx.x, b = row / SEQ, t = threadIdx.x;
    const float4 v = ((const float4*)(f + (size_t)row * DM))[t];
    const float ss = block_sum256(v.x * v.x + v.y * v.y + v.z * v.z + v.w * v.w, red);
    const float rstd = rsqrtf(ss * (1.f / DM) + EPS);
    const float* gt = mod + b * (NMOD * DM) + igt * DM;
    const float4 xi = ((const float4*)(xin + (size_t)row * DM))[t];
    const float vv[4] = {v.x, v.y, v.z, v.w}, xx[4] = {xi.x, xi.y, xi.z, xi.w};
    float o[4];
#pragma unroll
    for (int e = 0; e < 4; ++e) { const int cidx = 4 * t + e; o[e] = xx[e] + coef * gt[cidx] * vv[e] * rstd * g[cidx]; }
    ((float4*)(xout + (size_t)row * DM))[t] = make_float4(o[0], o[1], o[2], o[3]);
}
template <typename TA>
__global__ void __launch_bounds__(256) n_gemm(const TA* A, int lda, const float* B, int ldb, const float* bs, float* C, int ldc, int N, int K) {
    __shared__ float As[16][65], Bs[16][65];
    const int tx = threadIdx.x & 15, ty = threadIdx.x >> 4, m0 = blockIdx.y * 64, n0 = blockIdx.x * 64;
    float acc[4][4] = {};
    for (int k0 = 0; k0 < K; k0 += 16) {
        for (int i = threadIdx.x; i < 1024; i += 256) { const int r = i >> 4, kk = i & 15; As[kk][r] = (float)A[(size_t)(m0 + r) * lda + k0 + kk]; }
        for (int i = threadIdx.x; i < 1024; i += 256) { const int kk = i >> 6, cc = i & 63; const int n = n0 + cc; Bs[kk][cc] = (n < N) ? B[(size_t)(k0 + kk) * ldb + n] * (bs ? bs[k0 + kk] : 1.f) : 0.f; }
        __syncthreads();
#pragma unroll
        for (int kk = 0; kk < 16; ++kk) {
            float a[4], b[4];
#pragma unroll
            for (int i = 0; i < 4; ++i) { a[i] = As[kk][ty * 4 + i]; b[i] = Bs[kk][tx * 4 + i]; }
#pragma unroll
            for (int i = 0; i < 4; ++i)
#pragma unroll
                for (int j = 0; j < 4; ++j) acc[i][j] += a[i] * b[j];
        }
        __syncthreads();
    }
#pragma unroll
    for (int i = 0; i < 4; ++i)
#pragma unroll
        for (int j = 0; j < 4; ++j) { const int n = n0 + tx * 4 + j; if (n < N) C[(size_t)(m0 + ty * 4 + i) * ldc + n] = acc[i][j]; }
}
__global__ void __launch_bounds__(256) n_gemm_swiglu(const h16* A, const float* Wg, const float* Wu, h16* out) {
    __shared__ float As[16][65], Bg[16][65], Bu[16][65];
    const int tx = threadIdx.x & 15, ty = threadIdx.x >> 4, m0 = blockIdx.y * 64, n0 = blockIdx.x * 64;
    float ag[4][4] = {}, au[4][4] = {};
    for (int k0 = 0; k0 < DM; k0 += 16) {
        for (int i = threadIdx.x; i < 1024; i += 256) { const int r = i >> 4, kk = i & 15; As[kk][r] = (float)A[(size_t)(m0 + r) * DM + k0 + kk]; }
        for (int i = threadIdx.x; i < 1024; i += 256) { const int kk = i >> 6, cc = i & 63; Bg[kk][cc] = Wg[(size_t)(k0 + kk) * FF + n0 + cc]; Bu[kk][cc] = Wu[(size_t)(k0 + kk) * FF + n0 + cc]; }
        __syncthreads();
#pragma unroll
        for (int kk = 0; kk < 16; ++kk) {
            float a[4], g[4], u[4];
#pragma unroll
            for (int i = 0; i < 4; ++i) { a[i] = As[kk][ty * 4 + i]; g[i] = Bg[kk][tx * 4 + i]; u[i] = Bu[kk][tx * 4 + i]; }
#pragma unroll
            for (int i = 0; i < 4; ++i)
#pragma unroll
                for (int j = 0; j < 4; ++j) { ag[i][j] += a[i] * g[j]; au[i][j] += a[i] * u[j]; }
        }
        __syncthreads();
    }
#pragma unroll
    for (int i = 0; i < 4; ++i)
#pragma unroll
        for (int j = 0; j < 4; ++j) out[(size_t)(m0 + ty * 4 + i) * FF + n0 + tx * 4 + j] = (h16)(silu_f(ag[i][j]) * au[i][j]);
}
__global__ void n_post_cq(const float* tmp, h16* cq, float* ssq) {
    const int tok = blockIdx.x * 4 + (threadIdx.x >> 6), lane = threadIdx.x & 63;
    float s = 0.f;
    for (int i = lane; i < QL; i += 64) { const float v = tmp[(size_t)tok * QL + i]; s += v * v; cq[(size_t)tok * QL + i] = (h16)v; }
#pragma unroll
    for (int o = 32; o > 0; o >>= 1) s += __shfl_xor(s, o);
    if (lane < 8) ssq[tok * 8 + lane] = (lane == 0) ? s : 0.f;
}
__global__ void n_post_ckv(const float* tmp, const float* g, h16* ckv) {
    const int tok = blockIdx.x * 4 + (threadIdx.x >> 6), lane = threadIdx.x & 63;
    float v[4], s = 0.f;
#pragma unroll
    for (int e = 0; e < 4; ++e) { v[e] = tmp[(size_t)tok * KVL + lane + 64 * e]; s += v[e] * v[e]; }
#pragma unroll
    for (int o = 32; o > 0; o >>= 1) s += __shfl_xor(s, o);
    const float rstd = rsqrtf(s * (1.f / KVL) + EPS);
#pragma unroll
    for (int e = 0; e < 4; ++e) ckv[(size_t)tok * KVL + lane + 64 * e] = (h16)(v[e] * rstd * g[lane + 64 * e]);
}
__global__ void n_post_small(const float* tmp, const float2* tab, h16* kr, h16* ki, float* wi) {
    const int idx = blockIdx.x * 256 + threadIdx.x; if (idx >= MT * 40) return;
    const int tok = idx / 40, j = idx % 40; const float* r = tmp + (size_t)tok * 72;
    if (j < 32) { const int which = j >> 4, i = j & 15; const float2 cs = tab[tok * 48 + 32 + i]; const float x1 = r[which * 32 + i], x2 = r[which * 32 + 16 + i];
        h16* o = (which ? ki : kr) + (size_t)tok * 32; o[i] = (h16)(x1 * cs.x - x2 * cs.y); o[i + 16] = (h16)(x2 * cs.x + x1 * cs.y); }
    else wi[tok * 8 + (j - 32)] = r[64 + (j - 32)] * 0.35355339059327373f;
}
__global__ void n_post_qk(const float* tmp, const float2* tab, float scale, h16* out) {
    const int idx = blockIdx.x * 256 + threadIdx.x; if (idx >= MT * 384) return;
    const int tok = idx / 384, j = idx % 384, hd = j >> 5, i = j & 31;
    const float2 cs = tab[tok * 48 + i]; const float x1 = tmp[(size_t)tok * 768 + hd * 64 + i], x2 = tmp[(size_t)tok * 768 + hd * 64 + 32 + i];
    out[(size_t)tok * 768 + hd * 64 + i] = (h16)((x1 * cs.x - x2 * cs.y) * scale); out[(size_t)tok * 768 + hd * 64 + 32 + i] = (h16)((x2 * cs.x + x1 * cs.y) * scale);
}
__host__ __device__ __forceinline__ int dil_of(int g) { return g == 0 ? 1 : (g == 1 ? 4 : 16); }
__global__ void n_post_v(const float* tmp, h16* vb) {
    const int idx = blockIdx.x * 256 + threadIdx.x; if (idx >= MT * 768) return;
    vb[idx] = (h16)tmp[idx];
}
__global__ void __launch_bounds__(256) n_post_q(const float* tmp, const float* ssq, const float* w_uk, const float2* tab, h16* qlat, h16* qr, int h0) {
    __shared__ float q[384];
    const int tok = blockIdx.x, t = threadIdx.x;
    float s = 0.f; for (int i = 0; i < 8; ++i) s += ssq[tok * 8 + i];
    const float rstd = rsqrtf(s * (1.f / QL) + EPS), c2 = 0.10206207261596575f * LOG2E;
    for (int i = t; i < 384; i += 256) q[i] = tmp[(size_t)tok * 384 + i] * rstd;
    __syncthreads();
    if (t < 64) { const int hl = t >> 4, i = t & 15, hd = h0 + hl; const float2 cs = tab[tok * 48 + 32 + i]; const float x1 = q[hl * 96 + 64 + i], x2 = q[hl * 96 + 80 + i];
        qr[(size_t)tok * 256 + hd * 32 + i] = (h16)((x1 * cs.x - x2 * cs.y) * c2); qr[(size_t)tok * 256 + hd * 32 + 16 + i] = (h16)((x2 * cs.x + x1 * cs.y) * c2); }
    for (int hl = 0; hl < 4; ++hl) { const int hd = h0 + hl; float a = 0.f; const float* w = w_uk + (size_t)t * 512 + hd * 64;
        for (int n = 0; n < 64; ++n) a += q[hl * 96 + n] * w[n];
        qlat[(size_t)tok * 2048 + hd * 256 + t] = (h16)(a * c2); }
}
__global__ void n_post_qi(const float* tmp, const float* ssq, const float2* tab, h16* qi) {
    const int idx = blockIdx.x * 256 + threadIdx.x; if (idx >= MT * 128) return;
    const int tok = idx / 128, j = idx % 128, hd = j >> 4, i = j & 15;
    float s = 0.f; for (int e = 0; e < 8; ++e) s += ssq[tok * 8 + e];
    const float rstd = rsqrtf(s * (1.f / QL) + EPS);
    const float2 cs = tab[tok * 48 + 32 + i]; const float x1 = tmp[(size_t)tok * 256 + hd * 32 + i] * rstd, x2 = tmp[(size_t)tok * 256 + hd * 32 + 16 + i] * rstd;
    qi[(size_t)tok * 256 + hd * 32 + i] = (h16)(x1 * cs.x - x2 * cs.y); qi[(size_t)tok * 256 + hd * 32 + 16 + i] = (h16)(x2 * cs.x + x1 * cs.y);
}
__device__ __forceinline__ unsigned fkey(float f) { const unsigned u = __float_as_uint(f); return (u & 0x80000000u) ? ~u : (u | 0x80000000u); }
__global__ void __launch_bounds__(256) n_topk(const h16* qi, const h16* ki, const float* wi, unsigned short* sel) {
    __shared__ unsigned key[SEQ]; __shared__ float q[256]; __shared__ float w[8]; __shared__ unsigned cnt;
    const int tok = blockIdx.x, b = tok / SEQ, t = tok % SEQ, tid = threadIdx.x;
    unsigned short* so = sel + (size_t)tok * TOPK;
    if (t < TOPK) { so[tid] = (unsigned short)(tid <= t ? tid : 0); return; }
    q[tid] = (float)qi[(size_t)tok * 256 + tid]; if (tid < 8) w[tid] = wi[tok * 8 + tid];
    __syncthreads();
    const int n = t + 1;
#pragma unroll 1
    for (int s = tid; s < n; s += 256) {
        const h16* kp = ki + (size_t)(b * SEQ + s) * 32;
        float a[8];
#pragma unroll
        for (int hd = 0; hd < 8; ++hd) a[hd] = 0.f;
#pragma unroll 4
        for (int e = 0; e < 32; ++e) { const float kv = (float)kp[e];
#pragma unroll
            for (int hd = 0; hd < 8; ++hd) a[hd] += q[hd * 32 + e] * kv; }
        float sc = 0.f;
#pragma unroll
        for (int hd = 0; hd < 8; ++hd) sc += w[hd] * fmaxf(a[hd] * 0.17677669529663687f, 0.f);
        key[s] = fkey(sc);
    }
    __syncthreads();
    unsigned T = 0;
    for (int bit = 31; bit >= 0; --bit) {
        const unsigned cand = T | (1u << bit);
        if (tid == 0) cnt = 0; __syncthreads();
        unsigned c = 0; for (int s = tid; s < n; s += 256) c += (key[s] >= cand) ? 1u : 0u;
#pragma unroll
        for (int o = 32; o > 0; o >>= 1) c += __shfl_xor(c, o);
        if ((tid & 63) == 0) atomicAdd(&cnt, c);
        __syncthreads();
        if (cnt >= TOPK) T = cand;
        __syncthreads();
    }
    if (tid == 0) cnt = 0; __syncthreads();
    for (int s = tid; s < n; s += 256) if (key[s] > T) { const unsigned p = atomicAdd(&cnt, 1u); so[p] = (unsigned short)s; }
    __syncthreads();
    if (tid == 0) { unsigned p = cnt; for (int s = 0; s < n && p < TOPK; ++s) if (key[s] == T) so[p++] = (unsigned short)s; }
}
__global__ void __launch_bounds__(256) n_sparse(h16* qlat, const h16* qr, const h16* ckv, const h16* kr, const unsigned short* sel) {
    __shared__ float ql[8][256], qrr[8][32], p[8][256], red[4]; __shared__ int rows[256];
    const int tok = blockIdx.x, b = tok / SEQ, t = tok % SEQ, tid = threadIdx.x, cnt = (t + 1 < TOPK) ? t + 1 : TOPK;
    for (int i = tid; i < 2048; i += 256) ql[i >> 8][i & 255] = (float)qlat[(size_t)tok * 2048 + i];
    qrr[tid >> 5][tid & 31] = (float)qr[(size_t)tok * 256 + tid];
    const int row = b * SEQ + (tid < cnt ? (int)sel[(size_t)tok * TOPK + tid] : 0); rows[tid] = row;
    __syncthreads();
    float s[8];
#pragma unroll
    for (int hd = 0; hd < 8; ++hd) s[hd] = 0.f;
    if (tid < cnt) {
        const h16* kp = ckv + (size_t)row * 256;
        for (int r = 0; r < 256; ++r) { const float kvv = (float)kp[r];
#pragma unroll
            for (int hd = 0; hd < 8; ++hd) s[hd] += ql[hd][r] * kvv; }
        const h16* rp = kr + (size_t)row * 32;
        for (int e = 0; e < 32; ++e) { const float kvv = (float)rp[e];
#pragma unroll
            for (int hd = 0; hd < 8; ++hd) s[hd] += qrr[hd][e] * kvv; }
    } else {
#pragma unroll
        for (int hd = 0; hd < 8; ++hd) s[hd] = -INFINITY;
    }
    float linv[8];
#pragma unroll
    for (int hd = 0; hd < 8; ++hd) {
        const float m = block_max256(s[hd], red);
        const float e = (tid < cnt) ? exp2f(s[hd] - m) : 0.f;
        p[hd][tid] = e;
        linv[hd] = 1.f / block_sum256(e, red);
    }
    __syncthreads();
    float o[8];
#pragma unroll
    for (int hd = 0; hd < 8; ++hd) o[hd] = 0.f;
    for (int k = 0; k < cnt; ++k) { const float v = (float)ckv[(size_t)rows[k] * 256 + tid];
#pragma unroll
        for (int hd = 0; hd < 8; ++hd) o[hd] += p[hd][k] * v; }
#pragma unroll
    for (int hd = 0; hd < 8; ++hd) qlat[(size_t)tok * 2048 + hd * 256 + tid] = (h16)(o[hd] * linv[hd]);
}
__global__ void __launch_bounds__(128) n_dilated(const h16* qb, const h16* kb, const h16* vT, h16* og, float* lse2) {
    __shared__ float q[64], p[132], red[2]; __shared__ int kidx[132];
    const int tok = blockIdx.x, gh = blockIdx.y, g = gh >> 2, b = tok / SEQ, t = tok % SEQ, tid = threadIdx.x, dil = dil_of(g);
    if (tid < 64) q[tid] = (float)qb[(size_t)tok * 768 + gh * 64 + tid];
    __syncthreads();
    float sc[2]; float m = -INFINITY;
    for (int r = 0; r < 2; ++r) { const int k = tid + r * 128; sc[r] = -INFINITY;
        if (k < 129) { const int ti = t - k * dil; kidx[k] = ti;
            if (ti >= 0) { const h16* kp = kb + (size_t)(b * SEQ + ti) * 768 + gh * 64; float a = 0.f; for (int d = 0; d < 64; ++d) a += q[d] * (float)kp[d]; sc[r] = a; } }
        m = fmaxf(m, sc[r]); }
#pragma unroll
    for (int o = 32; o > 0; o >>= 1) m = fmaxf(m, __shfl_xor(m, o));
    if ((tid & 63) == 0) red[tid >> 6] = m; __syncthreads(); m = fmaxf(red[0], red[1]); __syncthreads();
    float l = 0.f;
    for (int r = 0; r < 2; ++r) { const int k = tid + r * 128; if (k < 129) { const float e = (sc[r] == -INFINITY) ? 0.f : exp2f(sc[r] - m); p[k] = e; l += e; } }
#pragma unroll
    for (int o = 32; o > 0; o >>= 1) l += __shfl_xor(l, o);
    if ((tid & 63) == 0) red[tid >> 6] = l; __syncthreads(); l = red[0] + red[1];
    if (tid < 64) { float a = 0.f; const h16* vp = vT + (size_t)(b * SEQ) * 768 + gh * 64 + tid;
        for (int k = 0; k < 129; ++k) { const int ti = kidx[k]; if (ti >= 0) a += p[k] * (float)vp[(size_t)ti * 768]; }
        og[(size_t)tok * 768 + gh * 64 + tid] = (h16)(a / l); }
    if (tid == 0) lse2[tok * 12 + gh] = m + log2f(l);
}
__global__ void n_combine(const h16* og, const float* lse2, h16* ob) {
    const int idx = blockIdx.x * 256 + threadIdx.x; if (idx >= MT * 256) return;
    const int tok = idx >> 8, c = idx & 255, hh = c >> 6;
    const float l0 = lse2[tok * 12 + hh], l1 = lse2[tok * 12 + 4 + hh], l2 = lse2[tok * 12 + 8 + hh], m = fmaxf(l0, fmaxf(l1, l2));
    const float w0 = exp2f(l0 - m), w1 = exp2f(l1 - m), w2 = exp2f(l2 - m), inv = 1.f / (w0 + w1 + w2);
    ob[idx] = (h16)((w0 * (float)og[(size_t)tok * 768 + c] + w1 * (float)og[(size_t)tok * 768 + 256 + c] + w2 * (float)og[(size_t)tok * 768 + 512 + c]) * inv);
}
__global__ void __launch_bounds__(256) n_oa(const h16* olat, const float* w_uv, h16* oa) {
    __shared__ float ol[2048];
    const int tok = blockIdx.x, tid = threadIdx.x;
    for (int i = tid; i < 2048; i += 256) ol[i] = (float)olat[(size_t)tok * 2048 + i];
    __syncthreads();
    for (int o = tid; o < 512; o += 256) { const int hd = o >> 6; float a = 0.f; for (int r = 0; r < 256; ++r) a += ol[hd * 256 + r] * w_uv[(size_t)r * 512 + o]; oa[(size_t)tok * 512 + o] = (h16)a; }
}
__global__ void n_gate(const float* tg, const float* ty, h16* z, int n0, int accum) {
    const size_t idx = (size_t)blockIdx.x * 256 + threadIdx.x; const size_t row = idx >> 8; const int col = (int)(idx & 255);
    h16* zp = z + row * DM + n0 + col;
    const float v = (accum == 2) ? ty[idx] : (sigm_f(tg[idx]) * ty[idx] + (accum ? (float)*zp : 0.f));
    *zp = (h16)v;
}
__global__ void n_f32_to_f16(const float* a, h16* o) { const size_t idx = (size_t)blockIdx.x * 256 + threadIdx.x; o[idx] = (h16)a[idx]; }


#define LAS __attribute__((address_space(3)))
#define GAS __attribute__((address_space(1)))
typedef _Float16 f16x8 __attribute__((ext_vector_type(8)));
typedef float f32x4 __attribute__((ext_vector_type(4)));
typedef float f32x2 __attribute__((ext_vector_type(2)));
typedef unsigned u32x4 __attribute__((ext_vector_type(4)));
typedef unsigned u32x2 __attribute__((ext_vector_type(2)));
typedef _Float16 h16x2 __attribute__((ext_vector_type(2)));
__device__ __forceinline__ unsigned pk_h2(float lo, float hi) { f32x2 v = {lo, hi}; h16x2 h = __builtin_convertvector(v, h16x2); return __builtin_bit_cast(unsigned, h); }

namespace pg8 {
constexpr int BM = 256, BK = 64, HALF = 128, HTB = HALF * BK * 2, STAGE_BYTES = 8 * HTB, NXCD = 8, WGM = 8;
__host__ __device__ __forceinline__ int lds_byte(int r, int c) { const int st = (r >> 4) * 2 + (c >> 5), rr = r & 15, cc = c & 31, ob = rr * 64 + cc * 2; return st * 1024 + (ob ^ (((ob >> 9) & 1) << 5)); }
__host__ __device__ __forceinline__ void stage_rc(int b, int& R, int& C) { const int st = b / 1024, sb = b % 1024, swz = sb ^ (((sb >> 9) & 1) << 5); R = (st >> 1) * 16 + swz / 64; C = (st & 1) * 32 + (swz % 64) / 2; }
__host__ __device__ __forceinline__ int perm32(int rho) { const int n = rho >> 4, i = rho & 15; return 8 * (i >> 2) + 4 * n + (i & 3); }
struct Unit { int pm, pn; };
struct Gemm { const h16* A; const h16* Bt; int M, N, K; };
struct StaticOrder {
    int nM, nN, nwg, G, c;
    __host__ __device__ void init(int M, int N, int G_, int c_) { nM = M / BM; nN = N / BM; nwg = nM * nN; G = G_; c = c_; }
    __host__ __device__ bool next(int i, Unit& u) const {
        const long L = (long)i * G + c; if (L >= nwg) return false;
        int wgid = (int)L; { const int q = nwg / NXCD, r = nwg % NXCD, xcd = wgid % NXCD, off = wgid / NXCD; wgid = (xcd < r ? xcd * (q + 1) : r * (q + 1) + (xcd - r) * q) + off; }
        const int nig = WGM * nN, gid = wgid / nig, fm = gid * WGM, gsz = (nM - fm) < WGM ? (nM - fm) : WGM;
        u.pm = fm + ((wgid % nig) % gsz); u.pn = (wgid % nig) / gsz; return true;
    }
};
template <class Epi, bool ALIGN_EPI>
__device__ __forceinline__ void gemm_phase(LAS unsigned char* lds, const Gemm g, const StaticOrder& S, const Epi& E) {
    const int tid = threadIdx.x, wid = __builtin_amdgcn_readfirstlane(tid >> 6), lane = tid & 63, wr = wid >> 2, wc = wid & 3, fr = lane & 15, fq = lane >> 4;
    const int K = g.K, nt = K / BK;
    unsigned voffA[2], voffB[2];
#pragma unroll
    for (int i = 0; i < 2; ++i) { int R, C; stage_rc(tid * 16 + i * 8192, R, C); const int Rb = Epi::PERM ? ((R & ~31) + perm32(R & 31)) : R;
        voffA[i] = (unsigned)(R * K + C) * 2u; voffB[i] = (unsigned)(Rb * K + C) * 2u; }
    const size_t kstep = (size_t)(BK * 2);
    const size_t hstep = (size_t)HALF * K * 2;
    const size_t tstep = 2 * hstep;
    const unsigned ldsw = (unsigned)wid * 1024u;
    const int aoff = lds_byte(wr * 64 + fr, fq * 8), boff = lds_byte(wc * 32 + fr, fq * 8);
#define PG8_SA(b, h) (((b) * 2 + (h)) * HTB)
#define PG8_SB(b, h) ((4 + (b) * 2 + (h)) * HTB)
#define PG8_STAGE(bufoff, gbase, voff) do { _Pragma("unroll") for (int _i = 0; _i < 2; ++_i) \
        __builtin_amdgcn_global_load_lds((const unsigned*)((const char*)(gbase) + (voff)[_i]), (LAS unsigned*)(lds + (bufoff) + ldsw + _i * 8192), 16, 0, 0); } while (0)
#define PG8_LDA(dst, b, h) do { _Pragma("unroll") for (int m = 0; m < 4; ++m) _Pragma("unroll") for (int k = 0; k < 2; ++k) dst[m][k] = *(const LAS f16x8*)(lds + PG8_SA(b, h) + aoff + m * 2048 + k * 1024); } while (0)
#define PG8_LDB(dst, b, h) do { _Pragma("unroll") for (int n = 0; n < 2; ++n) _Pragma("unroll") for (int k = 0; k < 2; ++k) dst[n][k] = *(const LAS f16x8*)(lds + PG8_SB(b, h) + boff + n * 2048 + k * 1024); } while (0)
#define PG8_MMA(ai, bj, At, Bt) do { __builtin_amdgcn_s_setprio(1); _Pragma("unroll") for (int m = 0; m < 4; ++m) _Pragma("unroll") for (int n = 0; n < 2; ++n) _Pragma("unroll") for (int k = 0; k < 2; ++k) \
        acc[ai][bj][m][n] = __builtin_amdgcn_mfma_f32_16x16x32_f16(Bt[n][k], At[m][k], acc[ai][bj][m][n], 0, 0, 0); __builtin_amdgcn_s_setprio(0); } while (0)
#define PG8_WAIT_V(n) asm volatile("s_waitcnt vmcnt(" #n ")" ::: "memory")
#define PG8_WAIT_L(n) asm volatile("s_waitcnt lgkmcnt(" #n ")" ::: "memory")
#define PG8_BAR __builtin_amdgcn_s_barrier()
#define PG8_SCHED __builtin_amdgcn_sched_barrier(0)
    Unit cur, nxt; int ui = 0;
    if (!S.next(0, cur)) return;
    f32x4 acc[2][2][4][2];
#pragma unroll
    for (int a = 0; a < 2; ++a)
#pragma unroll
        for (int b = 0; b < 2; ++b)
#pragma unroll
            for (int m = 0; m < 4; ++m)
#pragma unroll
                for (int n = 0; n < 2; ++n) acc[a][b][m][n] = (f32x4){0.f, 0.f, 0.f, 0.f};
    f16x8 At[4][2], B0[2][2], B1[2][2];
    const char* cA = (const char*)g.A + (size_t)cur.pm * tstep; const char* cB = (const char*)g.Bt + (size_t)cur.pn * tstep;
    PG8_STAGE(PG8_SB(0, 0), cB, voffB); PG8_STAGE(PG8_SB(0, 1), cB + hstep, voffB); PG8_STAGE(PG8_SA(0, 0), cA, voffA); PG8_STAGE(PG8_SA(0, 1), cA + hstep, voffA);
    if (wr == 1) PG8_BAR;
    PG8_WAIT_V(2); PG8_BAR;
    PG8_STAGE(PG8_SB(1, 0), cB + kstep, voffB); PG8_STAGE(PG8_SA(1, 0), cA + kstep, voffA); PG8_STAGE(PG8_SB(1, 1), cB + hstep + kstep, voffB);
    PG8_WAIT_V(6); PG8_BAR;
    for (;;) {
        const bool has_next = S.next(ui + 1, nxt);
        const char* nA = has_next ? (const char*)g.A + (size_t)nxt.pm * tstep : cA; const char* nB = has_next ? (const char*)g.Bt + (size_t)nxt.pn * tstep : cB;
        for (int t = 0; t < nt; t += 2) {
            const bool last = (t == nt - 2);
            const char* a1 = cA + (size_t)(t + 1) * kstep;
            const char* a2 = last ? nA : cA + (size_t)(t + 2) * kstep; const char* b2 = last ? nB : cB + (size_t)(t + 2) * kstep;
            const char* a3 = a2 + kstep; const char* b3 = b2 + kstep;
            PG8_LDB(B0, 0, 0); PG8_LDB(B1, 0, 1); PG8_SCHED; PG8_LDA(At, 0, 0); PG8_STAGE(PG8_SA(1, 1), a1 + hstep, voffA);
            PG8_WAIT_V(8); PG8_WAIT_L(0); PG8_BAR; PG8_MMA(0, 0, At, B0); PG8_MMA(0, 1, At, B1); PG8_BAR; PG8_SCHED;
            PG8_LDA(At, 0, 1); PG8_STAGE(PG8_SB(0, 0), b2, voffB); PG8_STAGE(PG8_SB(0, 1), b2 + hstep, voffB); PG8_STAGE(PG8_SA(0, 0), a2, voffA);
            PG8_WAIT_V(8); PG8_WAIT_L(0); PG8_BAR; PG8_MMA(1, 0, At, B0); PG8_MMA(1, 1, At, B1); PG8_BAR; PG8_SCHED;
            PG8_LDB(B0, 1, 0); PG8_LDB(B1, 1, 1); PG8_SCHED; PG8_LDA(At, 1, 0); PG8_STAGE(PG8_SA(0, 1), a2 + hstep, voffA);
            PG8_WAIT_V(8); PG8_WAIT_L(0); PG8_BAR; PG8_MMA(0, 0, At, B0); PG8_MMA(0, 1, At, B1); PG8_BAR; PG8_SCHED;
            PG8_LDA(At, 1, 1); PG8_STAGE(PG8_SB(1, 0), b3, voffB); PG8_STAGE(PG8_SB(1, 1), b3 + hstep, voffB); PG8_STAGE(PG8_SA(1, 0), a3, voffA);
            PG8_WAIT_V(8); PG8_WAIT_L(0); PG8_BAR; PG8_MMA(1, 0, At, B0); PG8_MMA(1, 1, At, B1); PG8_BAR; PG8_SCHED;
        }
        if constexpr (ALIGN_EPI) { if (wr == 0) PG8_BAR; }
        { int l2 = lane; asm volatile("" : "+v"(l2)); E(acc, cur, wr, wc, l2 & 15, l2 >> 4); }
        if (!has_next) break;
#pragma unroll
        for (int a = 0; a < 2; ++a)
#pragma unroll
            for (int b = 0; b < 2; ++b)
#pragma unroll
                for (int m = 0; m < 4; ++m)
#pragma unroll
                    for (int n = 0; n < 2; ++n) acc[a][b][m][n] = (f32x4){0.f, 0.f, 0.f, 0.f};
        cur = nxt; cA = nA; cB = nB; ++ui;
        if constexpr (ALIGN_EPI) { if (wr == 1) PG8_BAR; }
    }
    PG8_WAIT_V(0);
    if constexpr (!ALIGN_EPI) { if (wr == 0) PG8_BAR; }
    PG8_BAR;
#undef PG8_SA
#undef PG8_SB
#undef PG8_STAGE
#undef PG8_LDA
#undef PG8_LDB
#undef PG8_MMA
#undef PG8_WAIT_V
#undef PG8_WAIT_L
#undef PG8_BAR
#undef PG8_SCHED
}
struct EpiF32 {
    static constexpr bool PERM = false;
    float* C; int ldc;
    __device__ __forceinline__ void operator()(const f32x4 (&acc)[2][2][4][2], const Unit& u, int wr, int wc, int fr, int fq) const {
        const int row0 = u.pm * BM + wr * 64 + fr, col0 = u.pn * BM + wc * 32 + 4 * fq;
#pragma unroll
        for (int ai = 0; ai < 2; ++ai)
#pragma unroll
            for (int m = 0; m < 4; ++m) { float* rowp = C + (size_t)(row0 + ai * HALF + m * 16) * ldc + col0;
#pragma unroll
                for (int bj = 0; bj < 2; ++bj)
#pragma unroll
                    for (int n = 0; n < 2; ++n) *(f32x4*)(rowp + bj * HALF + n * 16) = acc[ai][bj][m][n]; }
    }
};
struct EpiSwiGLU {
    static constexpr bool PERM = true;
    h16* O;
    __device__ __forceinline__ void operator()(const f32x4 (&acc)[2][2][4][2], const Unit& u, int wr, int wc, int fr, int fq) const {
        const int row0 = u.pm * BM + wr * 64 + fr, col0 = u.pn * HALF + wc * 32 + 8 * fq;
#pragma unroll
        for (int ai = 0; ai < 2; ++ai)
#pragma unroll
            for (int m = 0; m < 4; ++m) { h16* rowp = O + (size_t)(row0 + ai * HALF + m * 16) * FF + col0;
                float v[8];
#pragma unroll
                for (int n = 0; n < 2; ++n)
#pragma unroll
                    for (int e = 0; e < 4; ++e) { const float gg = acc[ai][0][m][n][e], uu = acc[ai][1][m][n][e]; v[n * 4 + e] = gg * __builtin_amdgcn_rcpf(1.f + __builtin_amdgcn_exp2f(-gg * LOG2E)) * uu; }
                u32x4 w; w.x = pk_h2(v[0], v[1]); w.y = pk_h2(v[2], v[3]); w.z = pk_h2(v[4], v[5]); w.w = pk_h2(v[6], v[7]);
                *(u32x4*)rowp = w; }
    }
};

struct EpiIn {
    static constexpr bool PERM = false;
    h16 *ckv, *cq, *kr, *ki, *qb, *kb, *vT; float *wi, *ssq; const float* gckv; const float2* tab; LAS float* X;
    __device__ __forceinline__ void rope64(const f32x4 (&acc)[2][2][4][2], const Unit& u, int wr, int wc, int fr, int fq, h16* dst, int tl, float scale) const {
#pragma unroll
        for (int ai = 0; ai < 2; ++ai)
#pragma unroll
            for (int m = 0; m < 4; ++m) { const int tok = u.pm * BM + ai * HALF + wr * 64 + m * 16 + fr;
#pragma unroll
                for (int n = 0; n < 2; ++n) { const int i = 16 * n + 4 * fq; const f32x4* tp = (const f32x4*)(tab + (size_t)tok * 48 + i); const f32x4 t0 = tp[0], t1 = tp[1];
                    const f32x4 cs = {t0.x, t0.z, t1.x, t1.z}, sn = {t0.y, t0.w, t1.y, t1.w}, x1 = acc[ai][0][m][n], x2 = acc[ai][1][m][n];
                    const f32x4 o1 = (x1 * cs - x2 * sn) * scale, o2 = (x2 * cs + x1 * sn) * scale;
                    h16* p = dst + (size_t)tok * 768 + (4 * tl + wc) * 64 + i;
                    u32x2 w1, w2; w1.x = pk_h2(o1.x, o1.y); w1.y = pk_h2(o1.z, o1.w); w2.x = pk_h2(o2.x, o2.y); w2.y = pk_h2(o2.z, o2.w);
                    *(u32x2*)p = w1; *(u32x2*)(p + 32) = w2; }
                asm volatile("" ::: "memory"); }
    }
    __device__ __forceinline__ void operator()(const f32x4 (&acc)[2][2][4][2], const Unit& u, int wr, int wc, int fr, int fq) const {
        const int pn = u.pn;
        if (pn == 0) {
#pragma unroll
            for (int ai = 0; ai < 2; ++ai)
#pragma unroll
                for (int m = 0; m < 4; ++m) { float sq = 0.f;
#pragma unroll
                    for (int bj = 0; bj < 2; ++bj)
#pragma unroll
                        for (int n = 0; n < 2; ++n) { const f32x4 v = acc[ai][bj][m][n]; sq += (v.x * v.x + v.y * v.y) + (v.z * v.z + v.w * v.w); }
                    sq += __shfl_xor(sq, 16); sq += __shfl_xor(sq, 32);
                    if (fq == 0) X[(ai * HALF + wr * 64 + m * 16 + fr) * 4 + wc] = sq; }
            asm volatile("s_waitcnt lgkmcnt(0)" ::: "memory"); __builtin_amdgcn_s_barrier(); asm volatile("" ::: "memory");
#pragma unroll
            for (int ai = 0; ai < 2; ++ai)
#pragma unroll
                for (int m = 0; m < 4; ++m) { const int rl = ai * HALF + wr * 64 + m * 16 + fr, tok = u.pm * BM + rl; const f32x4 p = *(const LAS f32x4*)(X + rl * 4);
                    const float rstd = rsqrtf(((p.x + p.y) + (p.z + p.w)) * (1.f / KVL) + EPS);
#pragma unroll
                    for (int bj = 0; bj < 2; ++bj)
#pragma unroll
                        for (int n = 0; n < 2; ++n) { const int col = bj * HALF + wc * 32 + n * 16 + 4 * fq; const f32x4 o = acc[ai][bj][m][n] * rstd * *(const f32x4*)(gckv + col);
                            u32x2 w; w.x = pk_h2(o.x, o.y); w.y = pk_h2(o.z, o.w); *(u32x2*)(ckv + (size_t)tok * KVL + col) = w; }
                    asm volatile("" ::: "memory"); }
            asm volatile("s_waitcnt lgkmcnt(0)" ::: "memory"); __builtin_amdgcn_s_barrier(); asm volatile("" ::: "memory");
        } else if (pn <= 2) {
#pragma unroll
            for (int ai = 0; ai < 2; ++ai)
#pragma unroll
                for (int m = 0; m < 4; ++m) { const int tok = u.pm * BM + ai * HALF + wr * 64 + m * 16 + fr; float sq = 0.f;
#pragma unroll
                    for (int bj = 0; bj < 2; ++bj) { if (pn == 2 && bj == 1) break;
#pragma unroll
                        for (int n = 0; n < 2; ++n) { const f32x4 v = acc[ai][bj][m][n]; sq += (v.x * v.x + v.y * v.y) + (v.z * v.z + v.w * v.w);
                            const int col = (pn - 1) * 256 + bj * HALF + wc * 32 + n * 16 + 4 * fq; u32x2 w; w.x = pk_h2(v.x, v.y); w.y = pk_h2(v.z, v.w); *(u32x2*)(cq + (size_t)tok * QL + col) = w; } }
                    sq += __shfl_xor(sq, 16); sq += __shfl_xor(sq, 32);
                    if (fq == 0) ssq[tok * 8 + (pn - 1) * 4 + wc] = sq;
                    if (pn == 2) {
                        if (wc < 2) { const int i = 4 * fq; const f32x4* tp = (const f32x4*)(tab + (size_t)tok * 48 + 32 + i); const f32x4 t0 = tp[0], t1 = tp[1];
                            const f32x4 cs = {t0.x, t0.z, t1.x, t1.z}, sn = {t0.y, t0.w, t1.y, t1.w}, x1 = acc[ai][1][m][0], x2 = acc[ai][1][m][1];
                            const f32x4 o1 = x1 * cs - x2 * sn, o2 = x2 * cs + x1 * sn; h16* p = (wc == 0 ? kr : ki) + (size_t)tok * 32 + i;
                            u32x2 w1, w2; w1.x = pk_h2(o1.x, o1.y); w1.y = pk_h2(o1.z, o1.w); w2.x = pk_h2(o2.x, o2.y); w2.y = pk_h2(o2.z, o2.w);
                            *(u32x2*)p = w1; *(u32x2*)(p + 16) = w2; }
                        else if (wc == 2 && fq < 2) { *(f32x4*)(wi + tok * 8 + 4 * fq) = acc[ai][1][m][0] * 0.35355339059327373f; }
                    }
                    asm volatile("" ::: "memory"); }
        } else if (pn <= 5) rope64(acc, u, wr, wc, fr, fq, qb, pn - 3, 0.125f * LOG2E);
        else if (pn <= 8) rope64(acc, u, wr, wc, fr, fq, kb, pn - 6, 1.0f);
        else {
#pragma unroll
            for (int ai = 0; ai < 2; ++ai)
#pragma unroll
                for (int m = 0; m < 4; ++m) { const int tok = u.pm * BM + ai * HALF + wr * 64 + m * 16 + fr;
#pragma unroll
                    for (int bj = 0; bj < 2; ++bj)
#pragma unroll
                        for (int n = 0; n < 2; ++n) { const f32x4 v = acc[ai][bj][m][n]; u32x2 w; w.x = pk_h2(v.x, v.y); w.y = pk_h2(v.z, v.w);
                            *(u32x2*)(vT + (size_t)tok * 768 + (pn - 9) * 256 + bj * HALF + wc * 32 + n * 16 + 4 * fq) = w; }
                    asm volatile("" ::: "memory"); }
        }
    }
};
struct Epi4 {
    static constexpr bool PERM = false;
    h16 *qlat, *qr, *qi; const float* ssq; const float2* tab;
    __device__ __forceinline__ void operator()(const f32x4 (&acc)[2][2][4][2], const Unit& u, int wr, int wc, int fr, int fq) const {
        const int pn = u.pn; const float c2 = 0.10206207261596575f * LOG2E;
#pragma unroll
        for (int ai = 0; ai < 2; ++ai)
#pragma unroll
            for (int m = 0; m < 4; ++m) { const int tok = u.pm * BM + ai * HALF + wr * 64 + m * 16 + fr;
                const f32x4 s0 = *(const f32x4*)(ssq + tok * 8), s1 = *(const f32x4*)(ssq + tok * 8 + 4);
                const float rstd = rsqrtf((((s0.x + s0.y) + (s0.z + s0.w)) + ((s1.x + s1.y) + (s1.z + s1.w))) * (1.f / QL) + EPS);
                if (pn < 8) {
#pragma unroll
                    for (int bj = 0; bj < 2; ++bj)
#pragma unroll
                        for (int n = 0; n < 2; ++n) { const int col = bj * HALF + wc * 32 + n * 16 + 4 * fq; const f32x4 o = acc[ai][bj][m][n] * (rstd * c2);
                            u32x2 w; w.x = pk_h2(o.x, o.y); w.y = pk_h2(o.z, o.w); *(u32x2*)(qlat + (size_t)tok * 2048 + pn * 256 + col) = w; }
                } else { const float sc = (pn == 8) ? rstd * c2 : rstd; h16* dst = (pn == 8) ? qr : qi;
                    const int i = 4 * fq; const f32x4* tp = (const f32x4*)(tab + (size_t)tok * 48 + 32 + i); const f32x4 t0 = tp[0], t1 = tp[1];
                    const f32x4 cs = {t0.x, t0.z, t1.x, t1.z}, sn = {t0.y, t0.w, t1.y, t1.w};
#pragma unroll
                    for (int bj = 0; bj < 2; ++bj) { const f32x4 x1 = acc[ai][bj][m][0], x2 = acc[ai][bj][m][1]; const f32x4 o1 = (x1 * cs - x2 * sn) * sc, o2 = (x2 * cs + x1 * sn) * sc;
                        h16* p = dst + (size_t)tok * 256 + (4 * bj + wc) * 32 + i;
                        u32x2 w1, w2; w1.x = pk_h2(o1.x, o1.y); w1.y = pk_h2(o1.z, o1.w); w2.x = pk_h2(o2.x, o2.y); w2.y = pk_h2(o2.z, o2.w);
                        *(u32x2*)p = w1; *(u32x2*)(p + 16) = w2; } }
                asm volatile("" ::: "memory"); }
    }
};
__device__ __forceinline__ u32x4 ld16_l2(const h16* p) {
    const unsigned long long a = __hip_atomic_load((const unsigned long long*)p, __ATOMIC_RELAXED, __HIP_MEMORY_SCOPE_AGENT), b = __hip_atomic_load((const unsigned long long*)p + 1, __ATOMIC_RELAXED, __HIP_MEMORY_SCOPE_AGENT);
    return (u32x4){(unsigned)a, (unsigned)(a >> 32), (unsigned)b, (unsigned)(b >> 32)};
}
typedef _Float16 h16x8 __attribute__((ext_vector_type(8)));
__device__ __forceinline__ void unpk8(const u32x4 w, float (&f)[8]) {
    const h16x8 h = __builtin_bit_cast(h16x8, w);
#pragma unroll
    for (int i = 0; i < 8; ++i) f[i] = (float)h[i];
}
struct EpiH16 {
    static constexpr bool PERM = true;
    h16* O;
    __device__ __forceinline__ void operator()(const f32x4 (&acc)[2][2][4][2], const Unit& u, int wr, int wc, int fr, int fq) const {
        const int row0 = u.pm * BM + wr * 64 + fr, col0 = u.pn * BM + wc * 32 + 8 * fq;
#pragma unroll
        for (int ai = 0; ai < 2; ++ai)
#pragma unroll
            for (int m = 0; m < 4; ++m)
#pragma unroll
                for (int bj = 0; bj < 2; ++bj) { const f32x4 v0 = acc[ai][bj][m][0], v1 = acc[ai][bj][m][1];
                    u32x4 w; w.x = pk_h2(v0.x, v0.y); w.y = pk_h2(v0.z, v0.w); w.z = pk_h2(v1.x, v1.y); w.w = pk_h2(v1.z, v1.w);
                    *(u32x4*)(O + (size_t)(row0 + ai * HALF + m * 16) * DM + col0 + bj * HALF) = w; }
    }
};
struct EpiGate {
    static constexpr bool PERM = true;
    const h16* Y; h16* Z; int accum;
    __device__ __forceinline__ void operator()(const f32x4 (&acc)[2][2][4][2], const Unit& u, int wr, int wc, int fr, int fq) const {
        const int row0 = u.pm * BM + wr * 64 + fr, col0 = u.pn * BM + wc * 32 + 8 * fq;
#pragma unroll
        for (int ai = 0; ai < 2; ++ai)
#pragma unroll
            for (int m = 0; m < 4; ++m)
#pragma unroll
                for (int bj = 0; bj < 2; ++bj) { const size_t off = (size_t)(row0 + ai * HALF + m * 16) * DM + col0 + bj * HALF;
                    float y[8], zz[8]; unpk8(ld16_l2(Y + off), y);
                    if (accum) unpk8(ld16_l2(Z + off), zz); else {
#pragma unroll
                        for (int i = 0; i < 8; ++i) zz[i] = 0.f; }
                    float o[8];
#pragma unroll
                    for (int n = 0; n < 2; ++n)
#pragma unroll
                        for (int e = 0; e < 4; ++e) { const float gg = acc[ai][bj][m][n][e]; o[n * 4 + e] = zz[n * 4 + e] + y[n * 4 + e] * __builtin_amdgcn_rcpf(1.f + __builtin_amdgcn_exp2f(-gg * LOG2E)); }
                    u32x4 w; w.x = pk_h2(o[0], o[1]); w.y = pk_h2(o[2], o[3]); w.z = pk_h2(o[4], o[5]); w.w = pk_h2(o[6], o[7]);
                    *(u32x4*)(Z + off) = w; }
    }
};
}

#define XB_TMO      128
#define XB_XCNT(j)  (256  + 64 * (j))
#define XB_XSUB(j)  (1280 + 64 * (j))
#define XB_XGEN(j)  (2304 + 64 * (j))
#define XB_TOP      3328
#define XB_TOPGEN   3392
#define XCD_BAR_WORDS 3456
#define XB_SPIN_CAP (1u << 18)
__device__ __forceinline__ unsigned xb_ld(unsigned* p)              { return __hip_atomic_load(p, __ATOMIC_RELAXED, __HIP_MEMORY_SCOPE_AGENT); }
__device__ __forceinline__ unsigned xb_add(unsigned* p, unsigned v) { return __hip_atomic_fetch_add(p, v, __ATOMIC_RELAXED, __HIP_MEMORY_SCOPE_AGENT); }
__device__ __forceinline__ unsigned xb_xcc_id() { return (unsigned)__builtin_amdgcn_s_getreg((3 << 11) | 20) & 0xFu; }
#define XB_SPIN(cond, bar) do { unsigned _sp = 0; while (cond) { __builtin_amdgcn_s_sleep(1); \
    if ((++_sp & 255u) == 0u) { if (xb_ld(&(bar)[XB_TMO])) break; if (_sp > XB_SPIN_CAP) { atomicAdd(&(bar)[XB_TMO], 1u); break; } } } } while (0)
struct XcdBarrier { unsigned* bar; unsigned x; volatile LAS unsigned* st; };
__device__ __forceinline__ XcdBarrier xcd_barrier_post(unsigned* bar, volatile LAS unsigned* st) {
    XcdBarrier b; b.bar = bar; b.x = xb_xcc_id(); b.st = st;
    if (threadIdx.x == 0) (void)xb_add(&bar[XB_XCNT(b.x)], 1u);
    return b;
}
__device__ __forceinline__ void xcd_barrier_complete(unsigned* bar, unsigned x, unsigned& nloc, unsigned& nx) {
    const unsigned G = gridDim.x * gridDim.y * gridDim.z;
    unsigned sum, cnt, mine, sp = 0u;
    for (;;) {
        sum = 0u; cnt = 0u; mine = 0u;
#pragma unroll
        for (unsigned j = 0; j < 16; ++j) { const unsigned c = xb_ld(&bar[XB_XCNT(j)]); sum += c; cnt += (c > 0u) ? 1u : 0u; mine = (j == x) ? c : mine; }
        if (sum == G) break;
        __builtin_amdgcn_s_sleep(1);
        if ((++sp & 255u) == 0u) { if (xb_ld(&bar[XB_TMO])) break; if (sp > XB_SPIN_CAP) { atomicAdd(&bar[XB_TMO], 1u); break; } }
    }
    nloc = mine > 0u ? mine : 1u; nx = cnt > 0u ? cnt : 1u;
}
__device__ __forceinline__ void xcd_barrier(const XcdBarrier& b) {
    asm volatile("s_waitcnt vmcnt(0)" ::: "memory");
    __syncthreads();
    if (threadIdx.x == 0) {
        unsigned* bar = b.bar;
        __builtin_amdgcn_s_waitcnt(0);
        unsigned nloc = b.st[0], nx = b.st[1];
        if (nloc == 0u) { xcd_barrier_complete(bar, b.x, nloc, nx); b.st[0] = nloc; b.st[1] = nx; }
        const unsigned old = xb_add(&bar[XB_XSUB(b.x)], 1u);
        const unsigned gen = old / nloc;
        if (old + 1u == (gen + 1u) * nloc) {
            __builtin_amdgcn_fence(__ATOMIC_RELEASE, "agent");
            asm volatile("s_waitcnt vmcnt(0)" ::: "memory");
            const unsigned og = xb_add(&bar[XB_TOP], 1u);
            const unsigned tg = og / nx;
            if (og + 1u == (tg + 1u) * nx) xb_add(&bar[XB_TOPGEN], 1u);
            else XB_SPIN(xb_ld(&bar[XB_TOPGEN]) == tg, bar);
            __builtin_amdgcn_fence(__ATOMIC_ACQUIRE, "agent");
            xb_add(&bar[XB_XGEN(b.x)], 1u);
            asm volatile("s_waitcnt vmcnt(0)" ::: "memory");
        } else {
            XB_SPIN(xb_ld(&bar[XB_XGEN(b.x)]) == gen, bar);
            __builtin_amdgcn_fence(__ATOMIC_ACQUIRE, "agent");
            asm volatile("s_waitcnt vmcnt(0)" ::: "memory");
        }
    }
    __syncthreads();
}

constexpr int NWAVES = 8, NTHR = 512;
constexpr int RING_BYTES = 131072, LDSCTL_OFF = RING_BYTES, MISC_OFF = LDSCTL_OFF + 320, LDS_BYTES = 147456;
constexpr int XCH_OFF = RING_BYTES + 1024;
constexpr int CW_BAR = 4096;
constexpr size_t OW_GU1 = OFF_W, OW_D1 = OW_GU1 + 11 * MiB, OW_IN = OW_D1 + (size_t)DM * FF * 2, OW_GATE = OW_IN + 6 * MiB, OW_4 = OW_GATE + 4 * MiB, OW_OV = OW_4 + 2 * MiB,
                 OW_UPB = OW_OV + 4 * MiB, OW_O = OW_UPB + MiB / 2, OW_GU2 = OW_O + 2 * MiB, OW_D2 = OW_GU2 + 11 * MiB, OW_END = OW_D2 + (size_t)DM * FF * 2;
static_assert(OW_END <= OFF_H, "weights region");
constexpr int NIN3 = 3072, N4 = 2560;

struct Args { const float* in[27]; float* out; unsigned char* ws; int ph_lo, ph_hi, zparts, pad; };
struct Frame {
    LAS unsigned char* lds; int tid, lane, wave, G, gw, NGW;
};
__device__ __forceinline__ float wave_sum(float v) {
#pragma unroll
    for (int o = 1; o < 64; o <<= 1) v += __shfl_xor(v, o);
    return v;
}
__device__ __forceinline__ bool map_row(int job, int n, const Args& a, const float*& W, int& ldw, int& col) {
    if (job <= 1) { const int t = n >> 8, j = n & 255; W = a.in[(job == 0 ? 6 : 23) + (j >> 7)]; ldw = FF; col = t * 128 + (j & 127); return true; }
    if (job == 2) { W = a.in[11]; ldw = DIN; const int t = n >> 8, j = n & 255;
        if (t == 0) { col = C_CKV + j; return true; }
        if (t == 1) { col = j; return true; }
        if (t == 2) { if (j < 128) { col = 256 + j; return true; } if (j < 160) { col = C_KR + (j - 128); return true; } if (j < 192) { col = C_KI + (j - 160); return true; } if (j < 200) { col = C_WI + (j - 192); return true; } col = 0; return false; }
        if (t < 9) { const int c3 = (t - 3) / 3, tl = (t - 3) % 3, hl = (j & 127) >> 5, i = j & 31; col = C_QKV + c3 * 768 + (4 * tl + hl) * 64 + (j >> 7) * 32 + i; return true; }
        col = C_QKV + 1536 + (t - 9) * 256 + j; return true; }
    { const int n2 = n - 2048; if (n2 < 256) { W = a.in[14]; ldw = 768; col = (n2 >> 5) * 96 + 64 + (n2 & 31); } else { W = a.in[17]; ldw = 256; col = n2 - 256; } return true; }
}
__device__ __forceinline__ void tr_item(const float* W, int ldw, int col, bool valid, const float* scale, int k0, h16* WTrow0, int K, LAS float* scr, int lane) {
#pragma unroll 8
    for (int i = 0; i < 32; ++i) { const int kk = 2 * i + (lane >> 5); float v = valid ? W[(size_t)(k0 + kk) * ldw + col] : 0.f; if (scale) v *= scale[k0 + kk]; scr[kk * 33 + (lane & 31)] = v; }
    asm volatile("s_waitcnt lgkmcnt(0)" ::: "memory");
    const int c = lane & 7;
#pragma unroll
    for (int j = 0; j < 4; ++j) { const int n = (lane >> 3) + 8 * j; const LAS float* s = scr + (8 * c) * 33 + n;
        u32x4 o; o.x = pk_h2(s[0 * 33], s[1 * 33]); o.y = pk_h2(s[2 * 33], s[3 * 33]); o.z = pk_h2(s[4 * 33], s[5 * 33]); o.w = pk_h2(s[6 * 33], s[7 * 33]);
        *(u32x4*)(WTrow0 + (size_t)n * K + k0 + 8 * c) = o; }
    asm volatile("s_waitcnt lgkmcnt(0)" ::: "memory");
}
__device__ __forceinline__ void tr_job_mapped(const Frame& F, const Args& a, int job, int Ndest, int n_lo, int K, h16* WT, const float* scale, LAS float* scr, int phase_off) {
    const int nblk = Ndest / 32, nitems = (K / 64) * nblk;
    for (int it = (F.gw + phase_off) % F.NGW; it < nitems; it += F.NGW) {
        const int kb = it / nblk, nb = it % nblk; const float* W; int ldw, col;
        const bool valid = map_row(job, n_lo + nb * 32 + (F.lane & 31), a, W, ldw, col);
        tr_item(W, ldw, col, valid, scale, kb * 64, WT + (size_t)(n_lo + nb * 32) * K, K, scr, F.lane);
    }
}
__device__ __forceinline__ void tr_job_plain(const Frame& F, const float* W, int ldw, int Ndest, int K, h16* WT, LAS float* scr, int phase_off) {
    const int nblk = Ndest / 32, nitems = (K / 64) * nblk;
    for (int it = (F.gw + phase_off) % F.NGW; it < nitems; it += F.NGW) {
        const int kb = it / nblk, nb = it % nblk;
        tr_item(W, ldw, nb * 32 + (F.lane & 31), true, nullptr, kb * 64, WT + (size_t)(nb * 32) * K, K, scr, F.lane);
    }
}
__device__ __forceinline__ void row_load(const float* p, int lane, f32x4 (&v)[4]) {
#pragma unroll
    for (int j = 0; j < 4; ++j) v[j] = ((const f32x4*)p)[lane + 64 * j];
}
__device__ __forceinline__ float row_ssq(const f32x4 (&v)[4]) { float s = 0.f;
#pragma unroll
    for (int j = 0; j < 4; ++j) s += (v[j].x * v[j].x + v[j].y * v[j].y) + (v[j].z * v[j].z + v[j].w * v[j].w);
    return wave_sum(s); }
__device__ __forceinline__ void row_normmod_store(const f32x4 (&v)[4], float rstd, const float* g, const float* sc, const float* sh, h16* dst, int lane) {
#pragma unroll
    for (int j = 0; j < 4; ++j) { const int ci = lane + 64 * j; const f32x4 gg = ((const f32x4*)g)[ci], s1 = ((const f32x4*)sc)[ci], s0 = ((const f32x4*)sh)[ci];
        const f32x4 o = v[j] * rstd * gg * (s1 + 1.f) + s0;
        u32x2 w; w.x = pk_h2(o.x, o.y); w.y = pk_h2(o.z, o.w); ((u32x2*)dst)[ci] = w; }
}
__device__ __forceinline__ void ph_normmod(const Frame& F, const float* x, const float* g, const float* mod, int isc, int ish, h16* dst) {
    for (int m = F.gw; m < MT; m += F.NGW) { f32x4 v[4]; row_load(x + (size_t)m * DM, F.lane, v);
        const float rstd = rsqrtf(row_ssq(v) * (1.f / DM) + EPS); const float* mb = mod + (m / SEQ) * (NMOD * DM);
        row_normmod_store(v, rstd, g, mb + isc * DM, mb + ish * DM, dst + (size_t)m * DM, F.lane); }
}
__device__ __forceinline__ void ph_resnorm(const Frame& F, const float* xin, const float* f, const float* gpost, const float* mod, int igt, float coef, float* xout,
                                           bool second, const float* gpre, int isc, int ish, h16* dst) {
    for (int m = F.gw; m < MT; m += F.NGW) { f32x4 v[4], xi[4]; row_load(f + (size_t)m * DM, F.lane, v); row_load(xin + (size_t)m * DM, F.lane, xi);
        const float rstd = rsqrtf(row_ssq(v) * (1.f / DM) + EPS) * coef; const float* mb = mod + (m / SEQ) * (NMOD * DM);
#pragma unroll
        for (int j = 0; j < 4; ++j) { const int ci = F.lane + 64 * j; const f32x4 gg = ((const f32x4*)gpost)[ci], gt = ((const f32x4*)(mb + igt * DM))[ci];
            xi[j] = xi[j] + gt * v[j] * rstd * gg; ((f32x4*)(xout + (size_t)m * DM))[ci] = xi[j]; }
        if (second) { const float r2 = rsqrtf(row_ssq(xi) * (1.f / DM) + EPS); row_normmod_store(xi, r2, gpre, mb + isc * DM, mb + ish * DM, dst + (size_t)m * DM, F.lane); } }
}


__device__ __forceinline__ float wg_sum512(float v, LAS float* red) {
#pragma unroll
    for (int o = 32; o > 0; o >>= 1) v += __shfl_xor(v, o);
    __syncthreads();
    if ((threadIdx.x & 63) == 0) red[threadIdx.x >> 6] = v;
    __syncthreads();
    float s = 0.f;
#pragma unroll
    for (int w = 0; w < 8; ++w) s += red[w];
    return s;
}
__device__ __forceinline__ float wg_max512(float v, LAS float* red) {
#pragma unroll
    for (int o = 32; o > 0; o >>= 1) v = fmaxf(v, __shfl_xor(v, o));
    __syncthreads();
    if ((threadIdx.x & 63) == 0) red[threadIdx.x >> 6] = v;
    __syncthreads();
    float s = red[0];
#pragma unroll
    for (int w = 1; w < 8; ++w) s = fmaxf(s, red[w]);
    return s;
}
__device__ __forceinline__ void ph_dilated_simple(const Frame& F, const h16* qb, const h16* kb, const h16* vb, h16* og, float* lse2) {
    LAS float* p = (LAS float*)(F.lds + F.wave * 2048);
    LAS int* kix = (LAS int*)(F.lds + F.wave * 2048 + 1024);
    for (int it = F.gw; it < MT * 12; it += F.NGW) {
        const int tok = it / 12, gh = it % 12, g = gh >> 2, b = tok / SEQ, t = tok % SEQ, dil = dil_of(g), lane = F.lane;
        const h16* qp = qb + (size_t)tok * 768 + gh * 64;
        float sc[3]; float m = -INFINITY;
#pragma unroll
        for (int r = 0; r < 3; ++r) { const int k = lane + 64 * r; sc[r] = -INFINITY; const int ti = t - k * dil;
            if (k < 129) { kix[k] = ti;
                if (ti >= 0) { const h16* kp = kb + (size_t)(b * SEQ + ti) * 768 + gh * 64; float a = 0.f;
#pragma unroll 8
                    for (int d = 0; d < 64; ++d) a += (float)qp[d] * (float)kp[d];
                    sc[r] = a; } }
            m = fmaxf(m, sc[r]); }
#pragma unroll
        for (int o = 32; o > 0; o >>= 1) m = fmaxf(m, __shfl_xor(m, o));
        float l = 0.f;
#pragma unroll
        for (int r = 0; r < 3; ++r) { const int k = lane + 64 * r; if (k < 129) { const float e = (sc[r] == -INFINITY) ? 0.f : exp2f(sc[r] - m); p[k] = e; l += e; } }
#pragma unroll
        for (int o = 32; o > 0; o >>= 1) l += __shfl_xor(l, o);
        asm volatile("s_waitcnt lgkmcnt(0)" ::: "memory");
        float a = 0.f; const h16* vp = vb + (size_t)(b * SEQ) * 768 + gh * 64 + lane;
        for (int k = 0; k < 129; ++k) { const int ti = kix[k]; if (ti >= 0) a += p[k] * (float)vp[(size_t)ti * 768]; }
        og[(size_t)tok * 768 + gh * 64 + lane] = (h16)(a / l);
        if (lane == 0) lse2[tok * 12 + gh] = m + log2f(l);
        asm volatile("s_waitcnt lgkmcnt(0)" ::: "memory");
    }
}
__device__ __forceinline__ void ph_combine(const Frame& F, const h16* og, const float* lse2, h16* ob) {
    for (int idx = blockIdx.x * NTHR + F.tid; idx < MT * 256; idx += F.G * NTHR) {
        const int tok = idx >> 8, c = idx & 255, hh = c >> 6;
        const float l0 = lse2[tok * 12 + hh], l1 = lse2[tok * 12 + 4 + hh], l2 = lse2[tok * 12 + 8 + hh], m = fmaxf(l0, fmaxf(l1, l2));
        const float w0 = exp2f(l0 - m), w1 = exp2f(l1 - m), w2 = exp2f(l2 - m), inv = 1.f / (w0 + w1 + w2);
        ob[idx] = (h16)((w0 * (float)og[(size_t)tok * 768 + c] + w1 * (float)og[(size_t)tok * 768 + 256 + c] + w2 * (float)og[(size_t)tok * 768 + 512 + c]) * inv); }
}
__device__ __forceinline__ void ph_topk_simple(const Frame& F, const h16* qi, const h16* ki, const float* wi, unsigned short* sel) {
    LAS unsigned* key = (LAS unsigned*)(F.lds);
    LAS float* q = (LAS float*)(F.lds + 16384);
    LAS float* w = (LAS float*)(F.lds + 16384 + 1024);
    LAS unsigned* cnt = (LAS unsigned*)(F.lds + 16384 + 1024 + 64);
    const int tid = F.tid;
    for (int tok = blockIdx.x; tok < MT; tok += F.G) {
        const int b = tok / SEQ, t = tok % SEQ; unsigned short* so = sel + (size_t)tok * TOPK;
        if (t < TOPK) { if (tid < TOPK) so[tid] = (unsigned short)(tid <= t ? tid : 0); continue; }
        __syncthreads();
        if (tid < 256) q[tid] = (float)qi[(size_t)tok * 256 + tid]; if (tid < 8) w[tid] = wi[tok * 8 + tid];
        __syncthreads();
        const int n = t + 1;
#pragma unroll 1
        for (int s = tid; s < n; s += NTHR) {
            const h16* kp = ki + (size_t)(b * SEQ + s) * 32; float a[8];
#pragma unroll
            for (int hd = 0; hd < 8; ++hd) a[hd] = 0.f;
#pragma unroll 4
            for (int e = 0; e < 32; ++e) { const float kv = (float)kp[e];
#pragma unroll
                for (int hd = 0; hd < 8; ++hd) a[hd] += q[hd * 32 + e] * kv; }
            float sc = 0.f;
#pragma unroll
            for (int hd = 0; hd < 8; ++hd) sc += w[hd] * fmaxf(a[hd] * 0.17677669529663687f, 0.f);
            key[s] = fkey(sc);
        }
        __syncthreads();
        unsigned T = 0;
        for (int bit = 31; bit >= 0; --bit) {
            const unsigned cand = T | (1u << bit);
            if (tid == 0) *cnt = 0; __syncthreads();
            unsigned c = 0; for (int s = tid; s < n; s += NTHR) c += (key[s] >= cand) ? 1u : 0u;
#pragma unroll
            for (int o = 32; o > 0; o >>= 1) c += __shfl_xor(c, o);
            if ((tid & 63) == 0) atomicAdd((unsigned*)cnt, c);
            __syncthreads();
            if (*cnt >= TOPK) T = cand;
            __syncthreads();
        }
        if (tid == 0) *cnt = 0; __syncthreads();
        for (int s = tid; s < n; s += NTHR) if (key[s] > T) { const unsigned pp = atomicAdd((unsigned*)cnt, 1u); so[pp] = (unsigned short)s; }
        __syncthreads();
        if (tid == 0) { unsigned pp = *cnt; for (int s = 0; s < n && pp < TOPK; ++s) if (key[s] == T) so[pp++] = (unsigned short)s; }
    }
}
__device__ __forceinline__ void ph_sparse_simple(const Frame& F, h16* qlat, const h16* qr, const h16* ckv, const h16* kr, const unsigned short* sel) {
    LAS float* ql = (LAS float*)(F.lds);
    LAS float* qrr = (LAS float*)(F.lds + 8192);
    LAS float* p = (LAS float*)(F.lds + 8192 + 1024);
    LAS int* rows = (LAS int*)(F.lds + 8192 + 1024 + 8192);
    LAS float* red = (LAS float*)(F.lds + 8192 + 1024 + 8192 + 1024);
    LAS float* stat = red + 16;
    const int tid = F.tid, k = tid & 255, hh = tid >> 8;
    for (int tok = blockIdx.x; tok < MT; tok += F.G) {
        const int b = tok / SEQ, t = tok % SEQ, cnt = (t + 1 < TOPK) ? t + 1 : TOPK;
        __syncthreads();
        for (int i = tid; i < 2048; i += NTHR) ql[i] = (float)qlat[(size_t)tok * 2048 + i];
        if (tid < 256) { qrr[tid] = (float)qr[(size_t)tok * 256 + tid]; rows[tid] = b * SEQ + (tid < cnt ? (int)sel[(size_t)tok * TOPK + tid] : 0); }
        __syncthreads();
        const int row = rows[k];
        float s[4];
#pragma unroll
        for (int j = 0; j < 4; ++j) s[j] = 0.f;
        if (k < cnt) {
            const h16* kp = ckv + (size_t)row * 256;
            for (int r = 0; r < 256; ++r) { const float kvv = (float)kp[r];
#pragma unroll
                for (int j = 0; j < 4; ++j) s[j] += ql[(4 * hh + j) * 256 + r] * kvv; }
            const h16* rp = kr + (size_t)row * 32;
            for (int e = 0; e < 32; ++e) { const float kvv = (float)rp[e];
#pragma unroll
                for (int j = 0; j < 4; ++j) s[j] += qrr[(4 * hh + j) * 32 + e] * kvv; }
        } else {
#pragma unroll
            for (int j = 0; j < 4; ++j) s[j] = -INFINITY;
        }
#pragma unroll
        for (int hd = 0; hd < 8; ++hd) {
            const float mine = (hd >> 2) == hh ? s[hd & 3] : -INFINITY;
            const float m = wg_max512(mine, red);
            const float e = ((hd >> 2) == hh && k < cnt) ? exp2f(mine - m) : 0.f;
            if ((hd >> 2) == hh) p[hd * 256 + k] = e;
            const float l = wg_sum512(e, red);
            if (tid == 0) stat[hd] = 1.f / l;
        }
        __syncthreads();
        float o[4];
#pragma unroll
        for (int j = 0; j < 4; ++j) o[j] = 0.f;
        for (int kk = 0; kk < cnt; ++kk) { const float v = (float)ckv[(size_t)rows[kk] * 256 + k];
#pragma unroll
            for (int j = 0; j < 4; ++j) o[j] += p[(4 * hh + j) * 256 + kk] * v; }
#pragma unroll
        for (int j = 0; j < 4; ++j) qlat[(size_t)tok * 2048 + (4 * hh + j) * 256 + k] = (h16)(o[j] * stat[4 * hh + j]);
    }
}

__global__ void __launch_bounds__(NTHR, 2) mega_fwd(Args args) {
    extern __shared__ __attribute__((aligned(16))) unsigned char lds_raw[];
    Frame F; F.lds = (LAS unsigned char*)lds_raw; F.tid = threadIdx.x; F.lane = F.tid & 63; F.wave = __builtin_amdgcn_readfirstlane(F.tid >> 6);
    F.G = gridDim.x; F.gw = blockIdx.x * NWAVES + F.wave; F.NGW = F.G * NWAVES;
    volatile LAS unsigned* MISC = (volatile LAS unsigned*)(F.lds + MISC_OFF);
    unsigned char* ws = args.ws;
    for (int u = F.tid; u < (LDS_BYTES - LDSCTL_OFF) / 4; u += NTHR) ((LAS unsigned*)(F.lds + LDSCTL_OFF))[u] = 0u;
    __syncthreads();
    XcdBarrier bar = xcd_barrier_post((unsigned*)(ws + OFF_CTL) + CW_BAR, MISC + 8);
    const int lo = args.ph_lo, hi = args.ph_hi;
#ifndef PHMASK
#define PHMASK 0xFFFFu
#endif
#define IN(k) (((PHMASK >> (k)) & 1u) && lo <= (k) && (k) < hi)
#define SEAM(k) do { if (IN(k) && IN((k) + 1)) xcd_barrier(bar); } while (0)
    float* mod = (float*)(ws + OFF_MOD); float2* tab = (float2*)(ws + OFF_ROPE);
    h16* Hb = (h16*)(ws + OFF_H); h16* Ab = (h16*)(ws + OFF_A); float* Fb = (float*)(ws + OFF_F);

    if (IN(0)) {
        LAS float* scr = (LAS float*)(F.lds + F.wave * 16384);
        for (int ch = blockIdx.x; ch < (NMOD * DM) / 64; ch += F.G) {
            LAS float* sl = (LAS float*)(F.lds);
            LAS float* part = (LAS float*)(F.lds + 16384);
            __syncthreads();
            for (int i = F.tid; i < 4 * DM; i += NTHR) sl[i] = silu_f(args.in[1][i]);
            __syncthreads();
            const float* wm = args.in[3] + (size_t)(F.wave * 128) * (NMOD * DM) + ch * 64 + F.lane;
            float a0 = 0.f, a1 = 0.f, a2 = 0.f, a3 = 0.f;
#pragma unroll 8
            for (int k = 0; k < 128; ++k) { const float w = wm[(size_t)k * (NMOD * DM)]; const int kk = F.wave * 128 + k; a0 += sl[kk] * w; a1 += sl[DM + kk] * w; a2 += sl[2 * DM + kk] * w; a3 += sl[3 * DM + kk] * w; }
            part[(F.wave * 4 + 0) * 64 + F.lane] = a0; part[(F.wave * 4 + 1) * 64 + F.lane] = a1; part[(F.wave * 4 + 2) * 64 + F.lane] = a2; part[(F.wave * 4 + 3) * 64 + F.lane] = a3;
            __syncthreads();
            if (F.tid < 256) { const int b = F.tid >> 6, l = F.tid & 63; float s = args.in[4][ch * 64 + l];
#pragma unroll
                for (int w = 0; w < 8; ++w) s += part[(w * 4 + b) * 64 + l];
                mod[b * (NMOD * DM) + ch * 64 + l] = s; }
            __syncthreads();
        }
        for (int idx = blockIdx.x * NTHR + F.tid; idx < MT * 48; idx += F.G * NTHR) { const int tok = idx / 48, i = idx % 48;
            const float inv = (i < 32) ? powf(10000.f, -(float)i / 32.f) : powf(10000.f, -(float)(i - 32) / 16.f);
            const float ang = (float)((const int*)args.in[2])[tok] * inv; tab[idx] = make_float2(cosf(ang), sinf(ang)); }
        tr_job_mapped(F, args, 0, 2 * FF, 0, DM, (h16*)(ws + OW_GU1), nullptr, scr, 0);
        tr_job_plain(F, args.in[8], DM, DM, FF, (h16*)(ws + OW_D1), scr, 768);
        tr_job_mapped(F, args, 2, NIN3, 0, DM, (h16*)(ws + OW_IN), nullptr, scr, 128);
        tr_job_plain(F, args.in[11] + C_GATE, DIN, 2048, DM, (h16*)(ws + OW_GATE), scr, 1664);
        tr_job_mapped(F, args, 3, 512, 2048, QL, (h16*)(ws + OW_4), args.in[12], scr, 640);
        tr_job_plain(F, args.in[19], DM, DM, 256, (h16*)(ws + OW_UPB), scr, 736);
        tr_job_plain(F, args.in[20], DM, DM, DM, (h16*)(ws + OW_O), scr, 864);
        tr_job_mapped(F, args, 1, 2 * FF, 0, DM, (h16*)(ws + OW_GU2), nullptr, scr, 1376);
        tr_job_plain(F, args.in[25], DM, DM, FF, (h16*)(ws + OW_D2), scr, 96);
        for (int idx = blockIdx.x * NTHR + F.tid; idx < 2048 * QL; idx += F.G * NTHR) { const int n = idx / QL, k = idx % QL, hd = n >> 8, r = n & 255;
            const float* pa = args.in[14] + (size_t)k * 768 + hd * 96; const float* pb = args.in[15] + (size_t)r * 512 + hd * 64; float s = 0.f;
#pragma unroll 8
            for (int e = 0; e < 64; ++e) s += pa[e] * pb[e];
            ((h16*)(ws + OW_4))[(size_t)n * QL + k] = (h16)(s * args.in[12][k]); }
        for (int idx = blockIdx.x * NTHR + F.tid; idx < DM * 2048; idx += F.G * NTHR) { const int d = idx >> 11, kx = idx & 2047, hd = kx >> 8, r = kx & 255;
            const float* pa = args.in[16] + (size_t)r * 512 + hd * 64; const float* pb = args.in[18] + (size_t)(hd * 64) * DM + d; float s = 0.f;
#pragma unroll 8
            for (int v = 0; v < 64; ++v) s += pa[v] * pb[(size_t)v * DM];
            ((h16*)(ws + OW_OV))[idx] = (h16)s; }
    }
    SEAM(0);
    if (IN(1)) ph_normmod(F, args.in[0], args.in[5], mod, 1, 0, Hb);
    SEAM(1);
    if (IN(2)) { pg8::Gemm g{Hb, (const h16*)(ws + OW_GU1), MT, 2 * FF, DM}; pg8::StaticOrder S; S.init(MT, 2 * FF, F.G, (int)blockIdx.x); pg8::EpiSwiGLU E{Ab};
        pg8::gemm_phase<pg8::EpiSwiGLU, true>(F.lds, g, S, E); }
    SEAM(2);
    if (IN(3)) { pg8::Gemm g{Ab, (const h16*)(ws + OW_D1), MT, DM, FF}; pg8::StaticOrder S; S.init(MT, DM, F.G, (int)blockIdx.x); pg8::EpiF32 E{Fb, DM};
        pg8::gemm_phase<pg8::EpiF32, false>(F.lds, g, S, E); }
    SEAM(3);
    if (IN(4)) ph_resnorm(F, args.in[0], Fb, args.in[9], mod, 2, 0.5f, args.out, true, args.in[10], 4, 3, Hb);
    SEAM(4);
    if (IN(5)) { pg8::Gemm g{Hb, (const h16*)(ws + OW_IN), MT, NIN3, DM}; pg8::StaticOrder S; S.init(MT, NIN3, F.G, (int)blockIdx.x);
        pg8::EpiIn E{(h16*)(ws + OFF_CKV), (h16*)(ws + OFF_CQ), (h16*)(ws + OFF_KR), (h16*)(ws + OFF_KI), (h16*)(ws + OFF_QB), (h16*)(ws + OFF_KB), (h16*)(ws + OFF_VT), (float*)(ws + OFF_WI), (float*)(ws + OFF_SSQ),
                     args.in[13], tab, (LAS float*)(F.lds + XCH_OFF)};
        pg8::gemm_phase<pg8::EpiIn, true>(F.lds, g, S, E); }
    SEAM(5);
    if (IN(6)) ph_dilated_simple(F, (const h16*)(ws + OFF_QB), (const h16*)(ws + OFF_KB), (const h16*)(ws + OFF_VT), (h16*)(ws + OFF_OG), (float*)(ws + OFF_LSE));
    SEAM(6);
    if (IN(7)) { pg8::Gemm g{(const h16*)(ws + OFF_CQ), (const h16*)(ws + OW_4), MT, N4, QL}; pg8::StaticOrder S; S.init(MT, N4, F.G, (int)blockIdx.x);
        pg8::Epi4 E{(h16*)(ws + OFF_QLAT), (h16*)(ws + OFF_QR), (h16*)(ws + OFF_QI), (const float*)(ws + OFF_SSQ), tab};
        pg8::gemm_phase<pg8::Epi4, true>(F.lds, g, S, E); }
    SEAM(7);
    if (IN(8)) { ph_combine(F, (const h16*)(ws + OFF_OG), (const float*)(ws + OFF_LSE), (h16*)(ws + OFF_OB));
        ph_topk_simple(F, (const h16*)(ws + OFF_QI), (const h16*)(ws + OFF_KI), (const float*)(ws + OFF_WI), (unsigned short*)(ws + OFF_SEL)); }
    SEAM(8);
    if (IN(9)) ph_sparse_simple(F, (h16*)(ws + OFF_QLAT), (const h16*)(ws + OFF_QR), (const h16*)(ws + OFF_CKV), (const h16*)(ws + OFF_KR), (const unsigned short*)(ws + OFF_SEL));
    SEAM(9);
    if (IN(10)) { const int Z_PARTS = args.zparts; pg8::StaticOrder S; S.init(MT, DM, F.G, (int)blockIdx.x); h16* Y1 = (h16*)(ws + OFF_Y1); h16* Y2 = (h16*)(ws + OFF_Y2);
        if (Z_PARTS == 32) { pg8::Gemm g{Hb, (const h16*)(ws + OW_GATE) + (size_t)DM * DM, MT, DM, DM}; pg8::EpiH16 E{Y1}; pg8::gemm_phase<pg8::EpiH16, false>(F.lds, g, S, E); }
        else if (Z_PARTS == 8) { pg8::Gemm g{Hb, (const h16*)(ws + OW_GATE) + (size_t)DM * DM, MT, DM, DM}; pg8::EpiGate E{Y2, Y1, 0}; pg8::gemm_phase<pg8::EpiGate, false>(F.lds, g, S, E); }
        else if (Z_PARTS == 4) { pg8::Gemm g{(const h16*)(ws + OFF_OB), (const h16*)(ws + OW_UPB), MT, DM, 256}; pg8::EpiH16 E{Y1}; pg8::gemm_phase<pg8::EpiH16, false>(F.lds, g, S, E); }
        else {
        if (Z_PARTS & 1) {
        { pg8::Gemm g{(const h16*)(ws + OFF_QLAT), (const h16*)(ws + OW_OV), MT, DM, 2048}; pg8::EpiH16 E{Y1}; pg8::gemm_phase<pg8::EpiH16, false>(F.lds, g, S, E); }
        { pg8::Gemm g{Hb, (const h16*)(ws + OW_GATE), MT, DM, DM}; pg8::EpiGate E{Y1, Y1, 0}; pg8::gemm_phase<pg8::EpiGate, false>(F.lds, g, S, E); } }
        if (Z_PARTS & 2) {
        { pg8::Gemm g{(const h16*)(ws + OFF_OB), (const h16*)(ws + OW_UPB), MT, DM, 256}; pg8::EpiH16 E{Y2}; pg8::gemm_phase<pg8::EpiH16, false>(F.lds, g, S, E); }
        { pg8::Gemm g{Hb, (const h16*)(ws + OW_GATE) + (size_t)DM * DM, MT, DM, DM}; pg8::EpiGate E{Y2, Y1, (Z_PARTS & 1)}; pg8::gemm_phase<pg8::EpiGate, false>(F.lds, g, S, E); } } } }
    SEAM(10);
    if (IN(11)) { pg8::Gemm g{(const h16*)(ws + OFF_Y1), (const h16*)(ws + OW_O), MT, DM, DM}; pg8::StaticOrder S; S.init(MT, DM, F.G, (int)blockIdx.x); pg8::EpiF32 E{(float*)(ws + OFF_YF), DM};
        pg8::gemm_phase<pg8::EpiF32, false>(F.lds, g, S, E); }
    SEAM(11);
    if (IN(12)) ph_resnorm(F, args.out, (const float*)(ws + OFF_YF), args.in[21], mod, 5, 1.0f, args.out, true, args.in[22], 7, 6, Hb);
    SEAM(12);
    if (IN(13)) { pg8::Gemm g{Hb, (const h16*)(ws + OW_GU2), MT, 2 * FF, DM}; pg8::StaticOrder S; S.init(MT, 2 * FF, F.G, (int)blockIdx.x); pg8::EpiSwiGLU E{Ab};
        pg8::gemm_phase<pg8::EpiSwiGLU, true>(F.lds, g, S, E); }
    SEAM(13);
    if (IN(14)) { pg8::Gemm g{Ab, (const h16*)(ws + OW_D2), MT, DM, FF}; pg8::StaticOrder S; S.init(MT, DM, F.G, (int)blockIdx.x); pg8::EpiF32 E{Fb, DM};
        pg8::gemm_phase<pg8::EpiF32, false>(F.lds, g, S, E); }
    SEAM(14);
    if (IN(15)) ph_resnorm(F, args.out, Fb, args.in[26], mod, 8, 0.5f, args.out, false, nullptr, 0, 0, nullptr);
#undef IN
#undef SEAM
}


__global__ void n_stat_h16(const h16* p, size_t n, float* acc) {
    __shared__ float red[4];
    float a = 0.f, b = 0.f;
    for (size_t i = (size_t)blockIdx.x * 256 + threadIdx.x; i < n; i += (size_t)gridDim.x * 256) { const float v = (float)p[i]; const float w = (float)(((unsigned)(i * 2654435761u) >> 16) & 255u) * (1.f / 128.f) - 1.f; a += v * v; b += v * w; }
    a = block_sum256(a, red); b = block_sum256(b, red);
    if (threadIdx.x == 0) { atomicAdd(acc, a); atomicAdd(acc + 1, b); }
}
__global__ void n_tr(const float* W, int ldw, int N, int K, h16* WT) {
    const size_t idx = (size_t)blockIdx.x * 256 + threadIdx.x; if (idx >= (size_t)N * K) return;
    const int n = (int)(idx / K), k = (int)(idx % K); WT[idx] = (h16)W[(size_t)k * ldw + n];
}
__global__ void n_scale(float* out, const float* acc, float gain) {
    const size_t i = (size_t)blockIdx.x * 256 + threadIdx.x;
    const float d0 = fabsf(acc[0] - acc[2]) / fmaxf(fabsf(acc[2]), 1e-20f), d1 = fabsf(acc[1] - acc[3]) / fmaxf(sqrtf(fabsf(acc[2])), 1e-20f);
    const float d = fminf(fmaxf(d0, d1) * gain, 10.f);
    out[i] *= (1.f + d);
}
#ifndef FASTMASK
#define FASTMASK 0xFFFFu
#endif
extern "C" void kernel_launch(void* const* d_in, const int* in_sizes, int n_in, void* d_out, int out_size, void* d_ws, size_t ws_size, hipStream_t stream) {
    if (n_in != 27 || ws_size < WS_END || out_size != MT * DM) { fprintf(stderr, "kernel_launch: unexpected shapes (n_in %d ws %zu out %d)\n", n_in, ws_size, out_size); return; }
    static int grid = 0;
    if (grid == 0) {
        int dev = 0, cus = 0, per_cu = 0;
        if (hipGetDevice(&dev) != hipSuccess || hipDeviceGetAttribute(&cus, hipDeviceAttributeMultiprocessorCount, dev) != hipSuccess) { grid = -1; return; }
        if (hipFuncSetAttribute((const void*)mega_fwd, hipFuncAttributeMaxDynamicSharedMemorySize, LDS_BYTES) != hipSuccess) { fprintf(stderr, "kernel_launch: hipFuncSetAttribute failed\n"); grid = -1; return; }
        if (hipOccupancyMaxActiveBlocksPerMultiprocessor(&per_cu, (const void*)mega_fwd, NTHR, LDS_BYTES) != hipSuccess || per_cu < 1) { fprintf(stderr, "kernel_launch: occupancy query says %d blocks/CU\n", per_cu); grid = -1; return; }
        grid = cus;
    }
    if (grid < 0) return;
    const float* x = (const float*)d_in[0]; const float* c = (const float*)d_in[1]; const int* pos = (const int*)d_in[2];
    const float *w_mod = (const float*)d_in[3], *b_mod = (const float*)d_in[4], *g_pre1 = (const float*)d_in[5], *w_gate1 = (const float*)d_in[6], *w_up1 = (const float*)d_in[7], *w_down1 = (const float*)d_in[8],
                *g_post1 = (const float*)d_in[9], *g_premix = (const float*)d_in[10], *w_in = (const float*)d_in[11], *g_cq = (const float*)d_in[12], *g_ckv = (const float*)d_in[13], *w_uq = (const float*)d_in[14],
                *w_uk = (const float*)d_in[15], *w_uv = (const float*)d_in[16], *w_iq = (const float*)d_in[17], *w_up_a = (const float*)d_in[18], *w_up_b = (const float*)d_in[19], *w_o = (const float*)d_in[20],
                *g_postmix = (const float*)d_in[21], *g_pre2 = (const float*)d_in[22], *w_gate2 = (const float*)d_in[23], *w_up2 = (const float*)d_in[24], *w_down2 = (const float*)d_in[25], *g_post2 = (const float*)d_in[26];
    float* out = (float*)d_out; char* ws = (char*)d_ws;
    float* mod = (float*)(ws + OFF_MOD); float2* tab = (float2*)(ws + OFF_ROPE);
    h16* Hb = (h16*)(ws + OFF_H); h16* Ab = (h16*)(ws + OFF_A); float* Fb = (float*)(ws + OFF_F);
    h16 *qb = (h16*)(ws + OFF_QB), *kb = (h16*)(ws + OFF_KB), *vT = (h16*)(ws + OFF_VT), *ckv = (h16*)(ws + OFF_CKV), *kr = (h16*)(ws + OFF_KR), *ki = (h16*)(ws + OFF_KI), *cq = (h16*)(ws + OFF_CQ);
    float *wi = (float*)(ws + OFF_WI), *ssq = (float*)(ws + OFF_SSQ), *lse = (float*)(ws + OFF_LSE);
    h16 *og = (h16*)(ws + OFF_OG), *qlat = (h16*)(ws + OFF_QLAT), *qr = (h16*)(ws + OFF_QR), *qi = (h16*)(ws + OFF_QI), *ob = (h16*)(ws + OFF_OB);
    unsigned short* sel = (unsigned short*)(ws + OFF_SEL);
    float* Y = (float*)(ws + OFF_YF);
#define GEMM(TA, A, lda, B, ldb, bs, C, ldc, N, K) hipLaunchKernelGGL((n_gemm<TA>), dim3(((N) + 63) / 64, MT / 64), dim3(256), 0, stream, A, lda, B, ldb, bs, C, ldc, N, K)
    auto mega = [&](int lo, int hi, int zparts = 3) {
        hipMemsetAsync(ws + OFF_CTL, 0, 1 * MiB, stream);
        Args a{}; for (int i = 0; i < 27; ++i) a.in[i] = (const float*)d_in[i]; a.out = out; a.ws = (unsigned char*)d_ws; a.ph_lo = lo; a.ph_hi = hi; a.zparts = zparts;
        void* kargs[] = {&a};
        const hipError_t e = hipLaunchCooperativeKernel((const void*)mega_fwd, dim3(grid), dim3(NTHR), kargs, LDS_BYTES, stream);
        if (e != hipSuccess) fprintf(stderr, "kernel_launch: cooperative launch failed: %s (grid %d)\n", hipGetErrorString(e), grid);
    };
    auto naive = [&](int s, int Z_PARTS = 3) {
        switch (s) {
        case 0: hipLaunchKernelGGL(n_mod, dim3(NMOD * DM / 256, NB), dim3(256), 0, stream, c, w_mod, b_mod, mod);
                hipLaunchKernelGGL(n_rope_tab, dim3(MT * 48 / 256), dim3(256), 0, stream, pos, tab); break;
        case 1: hipLaunchKernelGGL(n_normmod, dim3(MT), dim3(256), 0, stream, x, g_pre1, mod, 1, 0, Hb); break;
        case 2: hipLaunchKernelGGL(n_gemm_swiglu, dim3(FF / 64, MT / 64), dim3(256), 0, stream, Hb, w_gate1, w_up1, Ab); break;
        case 3: GEMM(h16, Ab, FF, w_down1, DM, (const float*)nullptr, Fb, DM, DM, FF); break;
        case 4: hipLaunchKernelGGL(n_resnorm, dim3(MT), dim3(256), 0, stream, x, Fb, g_post1, mod, 2, 0.5f, out);
                hipLaunchKernelGGL(n_normmod, dim3(MT), dim3(256), 0, stream, out, g_premix, mod, 4, 3, Hb); break;
        case 5:
            GEMM(h16, Hb, DM, w_in + C_CQ, DIN, (const float*)nullptr, Fb, QL, QL, DM);
            hipLaunchKernelGGL(n_post_cq, dim3(MT / 4), dim3(256), 0, stream, Fb, cq, ssq);
            GEMM(h16, Hb, DM, w_in + C_CKV, DIN, (const float*)nullptr, Fb, KVL, KVL, DM);
            hipLaunchKernelGGL(n_post_ckv, dim3(MT / 4), dim3(256), 0, stream, Fb, g_ckv, ckv);
            GEMM(h16, Hb, DM, w_in + C_KR, DIN, (const float*)nullptr, Fb, 72, 72, DM);
            hipLaunchKernelGGL(n_post_small, dim3(MT * 40 / 256), dim3(256), 0, stream, Fb, tab, kr, ki, wi);
            GEMM(h16, Hb, DM, w_in + C_QKV, DIN, (const float*)nullptr, Fb, 768, 768, DM);
            hipLaunchKernelGGL(n_post_qk, dim3(MT * 384 / 256), dim3(256), 0, stream, Fb, tab, 0.125f * LOG2E, qb);
            GEMM(h16, Hb, DM, w_in + C_QKV + 768, DIN, (const float*)nullptr, Fb, 768, 768, DM);
            hipLaunchKernelGGL(n_post_qk, dim3(MT * 384 / 256), dim3(256), 0, stream, Fb, tab, 1.0f, kb);
            GEMM(h16, Hb, DM, w_in + C_QKV + 1536, DIN, (const float*)nullptr, Fb, 768, 768, DM);
            hipLaunchKernelGGL(n_post_v, dim3(MT * 768 / 256), dim3(256), 0, stream, Fb, vT); break;
        case 6: hipLaunchKernelGGL(n_dilated, dim3(MT, 12), dim3(128), 0, stream, qb, kb, vT, og, lse); break;
        case 7: { float* Tq = (float*)(ws + OFF_F + 33 * MiB);
            for (int hh = 0; hh < 2; ++hh) {
                GEMM(h16, cq, QL, w_uq + hh * 384, 768, g_cq, Tq, 384, 384, QL);
                hipLaunchKernelGGL(n_post_q, dim3(MT), dim3(256), 0, stream, Tq, ssq, w_uk, tab, qlat, qr, hh * 4); }
            GEMM(h16, cq, QL, w_iq, 256, g_cq, Tq, 256, 256, QL);
            hipLaunchKernelGGL(n_post_qi, dim3(MT * 128 / 256), dim3(256), 0, stream, Tq, ssq, tab, qi); } break;
        case 8: hipLaunchKernelGGL(n_topk, dim3(MT), dim3(256), 0, stream, qi, ki, wi, sel);
                hipLaunchKernelGGL(n_combine, dim3(MT), dim3(256), 0, stream, og, lse, ob); break;
        case 9: hipLaunchKernelGGL(n_sparse, dim3(MT), dim3(256), 0, stream, qlat, qr, ckv, kr, sel); break;
        case 10: { h16* oa = (h16*)(ws + OFF_Y2 + 16 * MiB);
            hipLaunchKernelGGL(n_oa, dim3(MT), dim3(256), 0, stream, qlat, w_uv, oa);
            h16* z = (h16*)(ws + OFF_Y1); float* Tg = (float*)(ws + OFF_A + 64 * MiB); float* Ty = (float*)(ws + OFF_F + 32 * MiB);
            for (int q = 0; q < 4; ++q) { const int n0 = q * 256;
                if (Z_PARTS == 4) { GEMM(h16, ob, 256, w_up_b + n0, DM, (const float*)nullptr, Ty, 256, 256, 256);
                    hipLaunchKernelGGL(n_gate, dim3(MT * 256 / 256), dim3(256), 0, stream, Ty, Ty, z, n0, 2); continue; }
                if (Z_PARTS & 1) {
                GEMM(h16, Hb, DM, w_in + C_GATE + n0, DIN, (const float*)nullptr, Tg, 256, 256, DM);
                GEMM(h16, oa, 512, w_up_a + n0, DM, (const float*)nullptr, Ty, 256, 256, 512);
                hipLaunchKernelGGL(n_gate, dim3(MT * 256 / 256), dim3(256), 0, stream, Tg, Ty, z, n0, 0); }
                if (Z_PARTS & 2) {
                GEMM(h16, Hb, DM, w_in + C_GATE + 1024 + n0, DIN, (const float*)nullptr, Tg, 256, 256, DM);
                GEMM(h16, ob, 256, w_up_b + n0, DM, (const float*)nullptr, Ty, 256, 256, 256);
                hipLaunchKernelGGL(n_gate, dim3(MT * 256 / 256), dim3(256), 0, stream, Tg, Ty, z, n0, (Z_PARTS & 1)); } } } break;
        case 11: GEMM(h16, (h16*)(ws + OFF_Y1), DM, w_o, DM, (const float*)nullptr, Y, DM, DM, DM); break;
        case 12: hipLaunchKernelGGL(n_resnorm, dim3(MT), dim3(256), 0, stream, out, Y, g_postmix, mod, 5, 1.0f, out);
                 hipLaunchKernelGGL(n_normmod, dim3(MT), dim3(256), 0, stream, out, g_pre2, mod, 7, 6, Hb); break;
        case 13: hipLaunchKernelGGL(n_gemm_swiglu, dim3(FF / 64, MT / 64), dim3(256), 0, stream, Hb, w_gate2, w_up2, Ab); break;
        case 14: GEMM(h16, Ab, FF, w_down2, DM, (const float*)nullptr, Fb, DM, DM, FF); break;
        case 15: hipLaunchKernelGGL(n_resnorm, dim3(MT), dim3(256), 0, stream, out, Fb, g_post2, mod, 8, 0.5f, out); break;
        }
    };
#ifdef DBG_W
    { float* dacc = (float*)(ws + OFF_MOD + 512 * 1024);
      hipMemsetAsync(dacc, 0, 16, stream);
      mega(0, 1);
      hipLaunchKernelGGL(n_stat_h16, dim3(2048), dim3(256), 0, stream, (const h16*)(ws + OW_GATE), (size_t)2048 * DM, dacc);
      hipLaunchKernelGGL(n_stat_h16, dim3(2048), dim3(256), 0, stream, (const h16*)(ws + OW_UPB), (size_t)DM * 256, dacc);
      hipLaunchKernelGGL(n_tr, dim3(2048 * DM / 256), dim3(256), 0, stream, w_in + C_GATE, DIN, 2048, DM, (h16*)(ws + OW_GATE));
      hipLaunchKernelGGL(n_tr, dim3(DM * 256 / 256), dim3(256), 0, stream, w_up_b, DM, DM, 256, (h16*)(ws + OW_UPB));
      hipLaunchKernelGGL(n_stat_h16, dim3(2048), dim3(256), 0, stream, (const h16*)(ws + OW_GATE), (size_t)2048 * DM, dacc + 2);
      hipLaunchKernelGGL(n_stat_h16, dim3(2048), dim3(256), 0, stream, (const h16*)(ws + OW_UPB), (size_t)DM * 256, dacc + 2);
      for (int s = 0; s < 16; ++s) naive(s);
      hipLaunchKernelGGL(n_scale, dim3(MT * DM / 256), dim3(256), 0, stream, out, dacc, 1.0f); }
#elif defined(DBG_STAGE)
    float* dacc = (float*)(ws + OFF_MOD + 512 * 1024);
    for (int s = 0; s < 16;) {
        if (s == DBG_STAGE) {
            hipMemsetAsync(dacc, 0, 16, stream);
            if (DBG_PARTS == 8) naive(s, 16);
            mega(s, s + 1, DBG_PARTS); hipLaunchKernelGGL(n_stat_h16, dim3(2048), dim3(256), 0, stream, (const h16*)(ws + DBG_OFF), (size_t)DBG_N, dacc);
            naive(s, DBG_PARTS == 8 ? 2 : DBG_PARTS);       hipLaunchKernelGGL(n_stat_h16, dim3(2048), dim3(256), 0, stream, (const h16*)(ws + DBG_OFF), (size_t)DBG_N, dacc + 2);
            if (DBG_PARTS != 3) naive(s);
            ++s; continue; }
        if ((FASTMASK >> s) & 1u) { int e = s; while (e < 16 && e != DBG_STAGE && ((FASTMASK >> e) & 1u)) ++e; mega(s, e); s = e; }
        else { naive(s); ++s; }
    }
    hipLaunchKernelGGL(n_scale, dim3(MT * DM / 256), dim3(256), 0, stream, out, dacc, DBG_GAIN);
#else
    for (int s = 0; s < 16;) {
        if ((FASTMASK >> s) & 1u) { int e = s; while (e < 16 && ((FASTMASK >> e) & 1u)) ++e; mega(s, e); s = e; }
        else { naive(s); ++s; }
    }
#endif
    (void)in_sizes;
}
```

```cpp
#include <hip/hip_runtime.h>
#include <hip/hip_fp16.h>
#include <cstdio>
#include <cstdint>
#define DBG_NOGATE 0

constexpr int NB = 4, SEQ = 4096, DM = 1024, MT = NB * SEQ, FF = 2816;
constexpr int QL = 384, KVL = 256, DNOPE = 64, DROPE = 32, DVA = 64, HA = 8, HI = 8, DI = 32, TOPK = 256;
constexpr int NG = 3, HB = 4, DHB = 64, NMOD = 9, DIN = 5064;
constexpr int C_CQ = 0, C_CKV = 384, C_KR = 640, C_KI = 672, C_WI = 704, C_QKV = 712, C_GATE = 3016;
constexpr float EPS = 1e-6f, LOG2E = 1.4426950408889634f;
typedef _Float16 h16;

constexpr size_t MiB = 1u << 20;
constexpr size_t OFF_CTL = 0, OFF_MOD = 1 * MiB, OFF_ROPE = 2 * MiB, OFF_W = 8 * MiB, OFF_H = 60 * MiB, OFF_A = 92 * MiB, OFF_F = 180 * MiB, OFF_SP = 244 * MiB, WS_END = 256 * MiB;
constexpr size_t OFF_QB = OFF_A, OFF_KB = OFF_A + 24 * MiB, OFF_VT = OFF_A + 48 * MiB, OFF_CKV = OFF_A + 72 * MiB, OFF_KR = OFF_A + 80 * MiB, OFF_KI = OFF_A + 81 * MiB,
                 OFF_WI = OFF_A + 82 * MiB, OFF_SSQ = OFF_A + 82 * MiB + 512 * 1024, OFF_CQ = OFF_SP;
constexpr size_t OFF_OG = OFF_F, OFF_LSE = OFF_F + 24 * MiB, OFF_QLAT = OFF_A, OFF_QR = OFF_A + 64 * MiB, OFF_QI = OFF_F + 25 * MiB, OFF_SEL = OFF_F + 33 * MiB, OFF_OB = OFF_SP;
constexpr size_t OFF_Y1 = OFF_F, OFF_Y2 = OFF_F + 32 * MiB, OFF_YF = OFF_A;

__device__ __forceinline__ float silu_f(float v) { return v / (1.f + __expf(-v)); }
__device__ __forceinline__ float sigm_f(float v) { return 1.f / (1.f + __expf(-v)); }
__device__ __forceinline__ float block_sum256(float v, float* red) {
#pragma unroll
    for (int o = 32; o > 0; o >>= 1) v += __shfl_xor(v, o);
    __syncthreads();
    if ((threadIdx.x & 63) == 0) red[threadIdx.x >> 6] = v;
    __syncthreads();
    return red[0] + red[1] + red[2] + red[3];
}
__device__ __forceinline__ float block_max256(float v, float* red) {
#pragma unroll
    for (int o = 32; o > 0; o >>= 1) v = fmaxf(v, __shfl_xor(v, o));
    __syncthreads();
    if ((threadIdx.x & 63) == 0) red[threadIdx.x >> 6] = v;
    __syncthreads();
    return fmaxf(fmaxf(red[0], red[1]), fmaxf(red[2], red[3]));
}

__global__ void n_mod(const float* c, const float* w_mod, const float* b_mod, float* mod) {
    const int j = blockIdx.x * 256 + threadIdx.x, b = blockIdx.y;
    float acc = b_mod[j];
    for (int k = 0; k < DM; ++k) acc += silu_f(c[b * DM + k]) * w_mod[(size_t)k * (NMOD * DM) + j];
    mod[b * (NMOD * DM) + j] = acc;
}
__global__ void n_rope_tab(const int* pos, float2* tab) {
    const int idx = blockIdx.x * 256 + threadIdx.x; if (idx >= MT * 48) return;
    const int tok = idx / 48, i = idx % 48;
    const float inv = (i < 32) ? powf(10000.f, -(float)i / 32.f) : powf(10000.f, -(float)(i - 32) / 16.f);
    const float ang = (float)pos[tok] * inv;
    tab[idx] = make_float2(cosf(ang), sinf(ang));
}
__global__ void n_normmod(const float* x, const float* g, const float* mod, int isc, int ish, h16* out) {
    __shared__ float red[4];
    const int row = blockIdx.x, b = row / SEQ, t = threadIdx.x;
    const float4 v = ((const float4*)(x + (size_t)row * DM))[t];
    const float ss = block_sum256(v.x * v.x + v.y * v.y + v.z * v.z + v.w * v.w, red);
    const float rstd = rsqrtf(ss * (1.f / DM) + EPS);
    const float* sc = mod + b * (NMOD * DM) + isc * DM; const float* sh = mod + b * (NMOD * DM) + ish * DM;
    const float vv[4] = {v.x, v.y, v.z, v.w};
#pragma unroll
    for (int e = 0; e < 4; ++e) { const int cidx = 4 * t + e; out[(size_t)row * DM + cidx] = (h16)(vv[e] * rstd * g[cidx] * (1.f + sc[cidx]) + sh[cidx]); }
}
__global__ void n_resnorm(const float* xin, const float* f, const float* g, const float* mod, int igt, float coef, float* xout) {
    __shared__ float red[4];
    const int row = blockIdx.x, b = row / SEQ, t = threadIdx.x;
    const float4 v = ((const float4*)(f + (size_t)row * DM))[t];
    const float ss = block_sum256(v.x * v.x + v.y * v.y + v.z * v.z + v.w * v.w, red);
    const float rstd = rsqrtf(ss * (1.f / DM) + EPS);
    const float* gt = mod + b * (NMOD * DM) + igt * DM;
    const float4 xi = ((const float4*)(xin + (size_t)row * DM))[t];
    const float vv[4] = {v.x, v.y, v.z, v.w}, xx[4] = {xi.x, xi.y, xi.z, xi.w};
    float o[4];
#pragma unroll
    for (int e = 0; e < 4; ++e) { const int cidx = 4 * t + e; o[e] = xx[e] + coef * gt[cidx] * vv[e] * rstd * g[cidx]; }
    ((float4*)(xout + (size_t)row * DM))[t] = make_float4(o[0], o[1], o[2], o[3]);
}
template <typename TA>
__global__ void __launch_bounds__(256) n_gemm(const TA* A, int lda, const float* B, int ldb, const float* bs, float* C, int ldc, int N, int K) {
    __shared__ float As[16][65], Bs[16][65];
    const int tx = threadIdx.x & 15, ty = threadIdx.x >> 4, m0 = blockIdx.y * 64, n0 = blockIdx.x * 64;
    float acc[4][4] = {};
    for (int k0 = 0; k0 < K; k0 += 16) {
        for (int i = threadIdx.x; i < 1024; i += 256) { const int r = i >> 4, kk = i & 15; As[kk][r] = (float)A[(size_t)(m0 + r) * lda + k0 + kk]; }
        for (int i = threadIdx.x; i < 1024; i += 256) { const int kk = i >> 6, cc = i & 63; const int n = n0 + cc; Bs[kk][cc] = (n < N) ? B[(size_t)(k0 + kk) * ldb + n] * (bs ? bs[k0 + kk] : 1.f) : 0.f; }
        __syncthreads();
#pragma unroll
        for (int kk = 0; kk < 16; ++kk) {
            float a[4], b[4];
#pragma unroll
            for (int i = 0; i < 4; ++i) { a[i] = As[kk][ty * 4 + i]; b[i] = Bs[kk][tx * 4 + i]; }
#pragma unroll
            for (int i = 0; i < 4; ++i)
#pragma unroll
                for (int j = 0; j < 4; ++j) acc[i][j] += a[i] * b[j];
        }
        __syncthreads();
    }
#pragma unroll
    for (int i = 0; i < 4; ++i)
#pragma unroll
        for (int j = 0; j < 4; ++j) { const int n = n0 + tx * 4 + j; if (n < N) C[(size_t)(m0 + ty * 4 + i) * ldc + n] = acc[i][j]; }
}
__global__ void __launch_bounds__(256) n_gemm_swiglu(const h16* A, const float* Wg, const float* Wu, h16* out) {
    __shared__ float As[16][65], Bg[16][65], Bu[16][65];
    const int tx = threadIdx.x & 15, ty = threadIdx.x >> 4, m0 = blockIdx.y * 64, n0 = blockIdx.x * 64;
    float ag[4][4] = {}, au[4][4] = {};
    for (int k0 = 0; k0 < DM; k0 += 16) {
        for (int i = threadIdx.x; i < 1024; i += 256) { const int r = i >> 4, kk = i & 15; As[kk][r] = (float)A[(size_t)(m0 + r) * DM + k0 + kk]; }
        for (int i = threadIdx.x; i < 1024; i += 256) { const int kk = i >> 6, cc = i & 63; Bg[kk][cc] = Wg[(size_t)(k0 + kk) * FF + n0 + cc]; Bu[kk][cc] = Wu[(size_t)(k0 + kk) * FF + n0 + cc]; }
        __syncthreads();
#pragma unroll
        for (int kk = 0; kk < 16; ++kk) {
            float a[4], g[4], u[4];
#pragma unroll
            for (int i = 0; i < 4; ++i) { a[i] = As[kk][ty * 4 + i]; g[i] = Bg[kk][tx * 4 + i]; u[i] = Bu[kk][tx * 4 + i]; }
#pragma unroll
            for (int i = 0; i < 4; ++i)
#pragma unroll
                for (int j = 0; j < 4; ++j) { ag[i][j] += a[i] * g[j]; au[i][j] += a[i] * u[j]; }
        }
        __syncthreads();
    }
#pragma unroll
    for (int i = 0; i < 4; ++i)
#pragma unroll
        for (int j = 0; j < 4; ++j) out[(size_t)(m0 + ty * 4 + i) * FF + n0 + tx * 4 + j] = (h16)(silu_f(ag[i][j]) * au[i][j]);
}
__global__ void n_post_cq(const float* tmp, h16* cq, float* ssq) {
    const int tok = blockIdx.x * 4 + (threadIdx.x >> 6), lane = threadIdx.x & 63;
    float s = 0.f;
    for (int i = lane; i < QL; i += 64) { const float v = tmp[(size_t)tok * QL + i]; s += v * v; cq[(size_t)tok * QL + i] = (h16)v; }
#pragma unroll
    for (int o = 32; o > 0; o >>= 1) s += __shfl_xor(s, o);
    if (lane < 8) ssq[tok * 8 + lane] = (lane == 0) ? s : 0.f;
}
__global__ void n_post_ckv(const float* tmp, const float* g, h16* ckv) {
    const int tok = blockIdx.x * 4 + (threadIdx.x >> 6), lane = threadIdx.x & 63;
    float v[4], s = 0.f;
#pragma unroll
    for (int e = 0; e < 4; ++e) { v[e] = tmp[(size_t)tok * KVL + lane + 64 * e]; s += v[e] * v[e]; }
#pragma unroll
    for (int o = 32; o > 0; o >>= 1) s += __shfl_xor(s, o);
    const float rstd = rsqrtf(s * (1.f / KVL) + EPS);
#pragma unroll
    for (int e = 0; e < 4; ++e) ckv[(size_t)tok * KVL + lane + 64 * e] = (h16)(v[e] * rstd * g[lane + 64 * e]);
}
__global__ void n_post_small(const float* tmp, const float2* tab, h16* kr, h16* ki, float* wi) {
    const int idx = blockIdx.x * 256 + threadIdx.x; if (idx >= MT * 40) return;
    const int tok = idx / 40, j = idx % 40; const float* r = tmp + (size_t)tok * 72;
    if (j < 32) { const int which = j >> 4, i = j & 15; const float2 cs = tab[tok * 48 + 32 + i]; const float x1 = r[which * 32 + i], x2 = r[which * 32 + 16 + i];
        h16* o = (which ? ki : kr) + (size_t)tok * 32; o[i] = (h16)(x1 * cs.x - x2 * cs.y); o[i + 16] = (h16)(x2 * cs.x + x1 * cs.y); }
    else wi[tok * 8 + (j - 32)] = r[64 + (j - 32)] * 0.35355339059327373f;
}
__global__ void n_post_qk(const float* tmp, const float2* tab, float scale, h16* out) {
    const int idx = blockIdx.x * 256 + threadIdx.x; if (idx >= MT * 384) return;
    const int tok = idx / 384, j = idx % 384, hd = j >> 5, i = j & 31;
    const float2 cs = tab[tok * 48 + i]; const float x1 = tmp[(size_t)tok * 768 + hd * 64 + i], x2 = tmp[(size_t)tok * 768 + hd * 64 + 32 + i];
    out[(size_t)tok * 768 + hd * 64 + i] = (h16)((x1 * cs.x - x2 * cs.y) * scale); out[(size_t)tok * 768 + hd * 64 + 32 + i] = (h16)((x2 * cs.x + x1 * cs.y) * scale);
}
__host__ __device__ __forceinline__ int dil_of(int g) { return g == 0 ? 1 : (g == 1 ? 4 : 16); }
__global__ void n_post_v(const float* tmp, h16* vb) {
    const int idx = blockIdx.x * 256 + threadIdx.x; if (idx >= MT * 768) return;
    vb[idx] = (h16)tmp[idx];
}
__global__ void __launch_bounds__(256) n_post_q(const float* tmp, const float* ssq, const float* w_uk, const float2* tab, h16* qlat, h16* qr, int h0) {
    __shared__ float q[384];
    const int tok = blockIdx.x, t = threadIdx.x;
    float s = 0.f; for (int i = 0; i < 8; ++i) s += ssq[tok * 8 + i];
    const float rstd = rsqrtf(s * (1.f / QL) + EPS), c2 = 0.10206207261596575f * LOG2E;
    for (int i = t; i < 384; i += 256) q[i] = tmp[(size_t)tok * 384 + i] * rstd;
    __syncthreads();
    if (t < 64) { const int hl = t >> 4, i = t & 15, hd = h0 + hl; const float2 cs = tab[tok * 48 + 32 + i]; const float x1 = q[hl * 96 + 64 + i], x2 = q[hl * 96 + 80 + i];
        qr[(size_t)tok * 256 + hd * 32 + i] = (h16)((x1 * cs.x - x2 * cs.y) * c2); qr[(size_t)tok * 256 + hd * 32 + 16 + i] = (h16)((x2 * cs.x + x1 * cs.y) * c2); }
    for (int hl = 0; hl < 4; ++hl) { const int hd = h0 + hl; float a = 0.f; const float* w = w_uk + (size_t)t * 512 + hd * 64;
        for (int n = 0; n < 64; ++n) a += q[hl * 96 + n] * w[n];
        qlat[(size_t)tok * 2048 + hd * 256 + t] = (h16)(a * c2); }
}
__global__ void n_post_qi(const float* tmp, const float* ssq, const float2* tab, h16* qi) {
    const int idx = blockIdx.x * 256 + threadIdx.x; if (idx >= MT * 128) return;
    const int tok = idx / 128, j = idx % 128, hd = j >> 4, i = j & 15;
    float s = 0.f; for (int e = 0; e < 8; ++e) s += ssq[tok * 8 + e];
    const float rstd = rsqrtf(s * (1.f / QL) + EPS);
    const float2 cs = tab[tok * 48 + 32 + i]; const float x1 = tmp[(size_t)tok * 256 + hd * 32 + i] * rstd, x2 = tmp[(size_t)tok * 256 + hd * 32 + 16 + i] * rstd;
    qi[(size_t)tok * 256 + hd * 32 + i] = (h16)(x1 * cs.x - x2 * cs.y); qi[(size_t)tok * 256 + hd * 32 + 16 + i] = (h16)(x2 * cs.x + x1 * cs.y);
}
__device__ __forceinline__ unsigned fkey(float f) { const unsigned u = __float_as_uint(f); return (u & 0x80000000u) ? ~u : (u | 0x80000000u); }
__global__ void __launch_bounds__(256) n_topk(const h16* qi, const h16* ki, const float* wi, unsigned short* sel) {
    __shared__ unsigned key[SEQ]; __shared__ float q[256]; __shared__ float w[8]; __shared__ unsigned cnt;
    const int tok = blockIdx.x, b = tok / SEQ, t = tok % SEQ, tid = threadIdx.x;
    unsigned short* so = sel + (size_t)tok * TOPK;
    if (t < TOPK) { so[tid] = (unsigned short)(tid <= t ? tid : 0); return; }
    q[tid] = (float)qi[(size_t)tok * 256 + tid]; if (tid < 8) w[tid] = wi[tok * 8 + tid];
    __syncthreads();
    const int n = t + 1;
#pragma unroll 1
    for (int s = tid; s < n; s += 256) {
        const h16* kp = ki + (size_t)(b * SEQ + s) * 32;
        float a[8];
#pragma unroll
        for (int hd = 0; hd < 8; ++hd) a[hd] = 0.f;
#pragma unroll 4
        for (int e = 0; e < 32; ++e) { const float kv = (float)kp[e];
#pragma unroll
            for (int hd = 0; hd < 8; ++hd) a[hd] += q[hd * 32 + e] * kv; }
        float sc = 0.f;
#pragma unroll
        for (int hd = 0; hd < 8; ++hd) sc += w[hd] * fmaxf(a[hd] * 0.17677669529663687f, 0.f);
        key[s] = fkey(sc);
    }
    __syncthreads();
    unsigned T = 0;
    for (int bit = 31; bit >= 0; --bit) {
        const unsigned cand = T | (1u << bit);
        if (tid == 0) cnt = 0; __syncthreads();
        unsigned c = 0; for (int s = tid; s < n; s += 256) c += (key[s] >= cand) ? 1u : 0u;
#pragma unroll
        for (int o = 32; o > 0; o >>= 1) c += __shfl_xor(c, o);
        if ((tid & 63) == 0) atomicAdd(&cnt, c);
        __syncthreads();
        if (cnt >= TOPK) T = cand;
        __syncthreads();
    }
    if (tid == 0) cnt = 0; __syncthreads();
    for (int s = tid; s < n; s += 256) if (key[s] > T) { const unsigned p = atomicAdd(&cnt, 1u); so[p] = (unsigned short)s; }
    __syncthreads();
    if (tid == 0) { unsigned p = cnt; for (int s = 0; s < n && p < TOPK; ++s) if (key[s] == T) so[p++] = (unsigned short)s; }
}
__global__ void __launch_bounds__(256) n_sparse(h16* qlat, const h16* qr, const h16* ckv, const h16* kr, const unsigned short* sel) {
    __shared__ float ql[8][256], qrr[8][32], p[8][256], red[4]; __shared__ int rows[256];
    const int tok = blockIdx.x, b = tok / SEQ, t = tok % SEQ, tid = threadIdx.x, cnt = (t + 1 < TOPK) ? t + 1 : TOPK;
    for (int i = tid; i < 2048; i += 256) ql[i >> 8][i & 255] = (float)qlat[(size_t)tok * 2048 + i];
    qrr[tid >> 5][tid & 31] = (float)qr[(size_t)tok * 256 + tid];
    const int row = b * SEQ + (tid < cnt ? (int)sel[(size_t)tok * TOPK + tid] : 0); rows[tid] = row;
    __syncthreads();
    float s[8];
#pragma unroll
    for (int hd = 0; hd < 8; ++hd) s[hd] = 0.f;
    if (tid < cnt) {
        const h16* kp = ckv + (size_t)row * 256;
        for (int r = 0; r < 256; ++r) { const float kvv = (float)kp[r];
#pragma unroll
            for (int hd = 0; hd < 8; ++hd) s[hd] += ql[hd][r] * kvv; }
        const h16* rp = kr + (size_t)row * 32;
        for (int e = 0; e < 32; ++e) { const float kvv = (float)rp[e];
#pragma unroll
            for (int hd = 0; hd < 8; ++hd) s[hd] += qrr[hd][e] * kvv; }
    } else {
#pragma unroll
        for (int hd = 0; hd < 8; ++hd) s[hd] = -INFINITY;
    }
    float linv[8];
#pragma unroll
    for (int hd = 0; hd < 8; ++hd) {
        const float m = block_max256(s[hd], red);
        const float e = (tid < cnt) ? exp2f(s[hd] - m) : 0.f;
        p[hd][tid] = e;
        linv[hd] = 1.f / block_sum256(e, red);
    }
    __syncthreads();
    float o[8];
#pragma unroll
    for (int hd = 0; hd < 8; ++hd) o[hd] = 0.f;
    for (int k = 0; k < cnt; ++k) { const float v = (float)ckv[(size_t)rows[k] * 256 + tid];
#pragma unroll
        for (int hd = 0; hd < 8; ++hd) o[hd] += p[hd][k] * v; }
#pragma unroll
    for (int hd = 0; hd < 8; ++hd) qlat[(size_t)tok * 2048 + hd * 256 + tid] = (h16)(o[hd] * linv[hd]);
}
__global__ void __launch_bounds__(128) n_dilated(const h16* qb, const h16* kb, const h16* vT, h16* og, float* lse2) {
    __shared__ float q[64], p[132], red[2]; __shared__ int kidx[132];
    const int tok = blockIdx.x, gh = blockIdx.y, g = gh >> 2, b = tok / SEQ, t = tok % SEQ, tid = threadIdx.x, dil = dil_of(g);
    if (tid < 64) q[tid] = (float)qb[(size_t)tok * 768 + gh * 64 + tid];
    __syncthreads();
    float sc[2]; float m = -INFINITY;
    for (int r = 0; r < 2; ++r) { const int k = tid + r * 128; sc[r] = -INFINITY;
        if (k < 129) { const int ti = t - k * dil; kidx[k] = ti;
            if (ti >= 0) { const h16* kp = kb + (size_t)(b * SEQ + ti) * 768 + gh * 64; float a = 0.f; for (int d = 0; d < 64; ++d) a += q[d] * (float)kp[d]; sc[r] = a; } }
        m = fmaxf(m, sc[r]); }
#pragma unroll
    for (int o = 32; o > 0; o >>= 1) m = fmaxf(m, __shfl_xor(m, o));
    if ((tid & 63) == 0) red[tid >> 6] = m; __syncthreads(); m = fmaxf(red[0], red[1]); __syncthreads();
    float l = 0.f;
    for (int r = 0; r < 2; ++r) { const int k = tid + r * 128; if (k < 129) { const float e = (sc[r] == -INFINITY) ? 0.f : exp2f(sc[r] - m); p[k] = e; l += e; } }
#pragma unroll
    for (int o = 32; o > 0; o >>= 1) l += __shfl_xor(l, o);
    if ((tid & 63) == 0) red[tid >> 6] = l; __syncthreads(); l = red[0] + red[1];
    if (tid < 64) { float a = 0.f; const h16* vp = vT + (size_t)(b * SEQ) * 768 + gh * 64 + tid;
        for (int k = 0; k < 129; ++k) { const int ti = kidx[k]; if (ti >= 0) a += p[k] * (float)vp[(size_t)ti * 768]; }
        og[(size_t)tok * 768 + gh * 64 + tid] = (h16)(a / l); }
    if (tid == 0) lse2[tok * 12 + gh] = m + log2f(l);
}
__global__ void n_combine(const h16* og, const float* lse2, h16* ob) {
    const int idx = blockIdx.x * 256 + threadIdx.x; if (idx >= MT * 256) return;
    const int tok = idx >> 8, c = idx & 255, hh = c >> 6;
    const float l0 = lse2[tok * 12 + hh], l1 = lse2[tok * 12 + 4 + hh], l2 = lse2[tok * 12 + 8 + hh], m = fmaxf(l0, fmaxf(l1, l2));
    const float w0 = exp2f(l0 - m), w1 = exp2f(l1 - m), w2 = exp2f(l2 - m), inv = 1.f / (w0 + w1 + w2);
    ob[idx] = (h16)((w0 * (float)og[(size_t)tok * 768 + c] + w1 * (float)og[(size_t)tok * 768 + 256 + c] + w2 * (float)og[(size_t)tok * 768 + 512 + c]) * inv);
}
__global__ void __launch_bounds__(256) n_oa(const h16* olat, const float* w_uv, h16* oa) {
    __shared__ float ol[2048];
    const int tok = blockIdx.x, tid = threadIdx.x;
    for (int i = tid; i < 2048; i += 256) ol[i] = (float)olat[(size_t)tok * 2048 + i];
    __syncthreads();
    for (int o = tid; o < 512; o += 256) { const int hd = o >> 6; float a = 0.f; for (int r = 0; r < 256; ++r) a += ol[hd * 256 + r] * w_uv[(size_t)r * 512 + o]; oa[(size_t)tok * 512 + o] = (h16)a; }
}
__global__ void n_gate(const float* tg, const float* ty, h16* z, int n0, int accum) {
    const size_t idx = (size_t)blockIdx.x * 256 + threadIdx.x; const size_t row = idx >> 8; const int col = (int)(idx & 255);
    h16* zp = z + row * DM + n0 + col;
    const float v = (accum == 2) ? ty[idx] : (sigm_f(tg[idx]) * ty[idx] + (accum ? (float)*zp : 0.f));
    *zp = (h16)v;
}
__global__ void n_f32_to_f16(const float* a, h16* o) { const size_t idx = (size_t)blockIdx.x * 256 + threadIdx.x; o[idx] = (h16)a[idx]; }


#define LAS __attribute__((address_space(3)))
#define GAS __attribute__((address_space(1)))
typedef _Float16 f16x8 __attribute__((ext_vector_type(8)));
typedef float f32x4 __attribute__((ext_vector_type(4)));
typedef float f32x2 __attribute__((ext_vector_type(2)));
typedef unsigned u32x4 __attribute__((ext_vector_type(4)));
typedef unsigned u32x2 __attribute__((ext_vector_type(2)));
typedef _Float16 h16x2 __attribute__((ext_vector_type(2)));
__device__ __forceinline__ unsigned pk_h2(float lo, float hi) { f32x2 v = {lo, hi}; h16x2 h = __builtin_convertvector(v, h16x2); return __builtin_bit_cast(unsigned, h); }

namespace pg8 {
constexpr int BM = 256, BK = 64, HALF = 128, HTB = HALF * BK * 2, STAGE_BYTES = 8 * HTB, NXCD = 8, WGM = 8;
__host__ __device__ __forceinline__ int lds_byte(int r, int c) { const int st = (r >> 4) * 2 + (c >> 5), rr = r & 15, cc = c & 31, ob = rr * 64 + cc * 2; return st * 1024 + (ob ^ (((ob >> 9) & 1) << 5)); }
__host__ __device__ __forceinline__ void stage_rc(int b, int& R, int& C) { const int st = b / 1024, sb = b % 1024, swz = sb ^ (((sb >> 9) & 1) << 5); R = (st >> 1) * 16 + swz / 64; C = (st & 1) * 32 + (swz % 64) / 2; }
__host__ __device__ __forceinline__ int perm32(int rho) { const int n = rho >> 4, i = rho & 15; return 8 * (i >> 2) + 4 * n + (i & 3); }
struct Unit { int pm, pn; };
struct Gemm { const h16* A; const h16* Bt; int M, N, K; };
struct StaticOrder {
    int nM, nN, nwg, G, c;
    __host__ __device__ void init(int M, int N, int G_, int c_) { nM = M / BM; nN = N / BM; nwg = nM * nN; G = G_; c = c_; }
    __host__ __device__ bool next(int i, Unit& u) const {
        const long L = (long)i * G + c; if (L >= nwg) return false;
        int wgid = (int)L; { const int q = nwg / NXCD, r = nwg % NXCD, xcd = wgid % NXCD, off = wgid / NXCD; wgid = (xcd < r ? xcd * (q + 1) : r * (q + 1) + (xcd - r) * q) + off; }
        const int nig = WGM * nN, gid = wgid / nig, fm = gid * WGM, gsz = (nM - fm) < WGM ? (nM - fm) : WGM;
        u.pm = fm + ((wgid % nig) % gsz); u.pn = (wgid % nig) / gsz; return true;
    }
};
template <class Epi, bool ALIGN_EPI>
__device__ __forceinline__ void gemm_phase(LAS unsigned char* lds, const Gemm g, const StaticOrder& S, const Epi& E) {
    const int tid = threadIdx.x, wid = __builtin_amdgcn_readfirstlane(tid >> 6), lane = tid & 63, wr = wid >> 2, wc = wid & 3, fr = lane & 15, fq = lane >> 4;
    const int K = g.K, nt = K / BK;
    unsigned voffA[2], voffB[2];
#pragma unroll
    for (int i = 0; i < 2; ++i) { int R, C; stage_rc(tid * 16 + i * 8192, R, C); const int Rb = Epi::PERM ? ((R & ~31) + perm32(R & 31)) : R;
        voffA[i] = (unsigned)(R * K + C) * 2u; voffB[i] = (unsigned)(Rb * K + C) * 2u; }
    const size_t kstep = (size_t)(BK * 2);
    const size_t hstep = (size_t)HALF * K * 2;
    const size_t tstep = 2 * hstep;
    const unsigned ldsw = (unsigned)wid * 1024u;
    const int aoff = lds_byte(wr * 64 + fr, fq * 8), boff = lds_byte(wc * 32 + fr, fq * 8);
#define PG8_SA(b, h) (((b) * 2 + (h)) * HTB)
#define PG8_SB(b, h) ((4 + (b) * 2 + (h)) * HTB)
#define PG8_STAGE(bufoff, gbase, voff) do { _Pragma("unroll") for (int _i = 0; _i < 2; ++_i) \
        __builtin_amdgcn_global_load_lds((const unsigned*)((const char*)(gbase) + (voff)[_i]), (LAS unsigned*)(lds + (bufoff) + ldsw + _i * 8192), 16, 0, 0); } while (0)
#define PG8_LDA(dst, b, h) do { _Pragma("unroll") for (int m = 0; m < 4; ++m) _Pragma("unroll") for (int k = 0; k < 2; ++k) dst[m][k] = *(const LAS f16x8*)(lds + PG8_SA(b, h) + aoff + m * 2048 + k * 1024); } while (0)
#define PG8_LDB(dst, b, h) do { _Pragma("unroll") for (int n = 0; n < 2; ++n) _Pragma("unroll") for (int k = 0; k < 2; ++k) dst[n][k] = *(const LAS f16x8*)(lds + PG8_SB(b, h) + boff + n * 2048 + k * 1024); } while (0)
#define PG8_MMA(ai, bj, At, Bt) do { __builtin_amdgcn_s_setprio(1); _Pragma("unroll") for (int m = 0; m < 4; ++m) _Pragma("unroll") for (int n = 0; n < 2; ++n) _Pragma("unroll") for (int k = 0; k < 2; ++k) \
        acc[ai][bj][m][n] = __builtin_amdgcn_mfma_f32_16x16x32_f16(Bt[n][k], At[m][k], acc[ai][bj][m][n], 0, 0, 0); __builtin_amdgcn_s_setprio(0); } while (0)
#define PG8_WAIT_V(n) asm volatile("s_waitcnt vmcnt(" #n ")" ::: "memory")
#define PG8_WAIT_L(n) asm volatile("s_waitcnt lgkmcnt(" #n ")" ::: "memory")
#define PG8_BAR __builtin_amdgcn_s_barrier()
#define PG8_SCHED __builtin_amdgcn_sched_barrier(0)
    Unit cur, nxt; int ui = 0;
    if (!S.next(0, cur)) return;
    f32x4 acc[2][2][4][2];
#pragma unroll
    for (int a = 0; a < 2; ++a)
#pragma unroll
        for (int b = 0; b < 2; ++b)
#pragma unroll
            for (int m = 0; m < 4; ++m)
#pragma unroll
                for (int n = 0; n < 2; ++n) acc[a][b][m][n] = (f32x4){0.f, 0.f, 0.f, 0.f};
    f16x8 At[4][2], B0[2][2], B1[2][2];
    const char* cA = (const char*)g.A + (size_t)cur.pm * tstep; const char* cB = (const char*)g.Bt + (size_t)cur.pn * tstep;
    PG8_STAGE(PG8_SB(0, 0), cB, voffB); PG8_STAGE(PG8_SB(0, 1), cB + hstep, voffB); PG8_STAGE(PG8_SA(0, 0), cA, voffA); PG8_STAGE(PG8_SA(0, 1), cA + hstep, voffA);
    if (wr == 1) PG8_BAR;
    PG8_WAIT_V(2); PG8_BAR;
    PG8_STAGE(PG8_SB(1, 0), cB + kstep, voffB); PG8_STAGE(PG8_SA(1, 0), cA + kstep, voffA); PG8_STAGE(PG8_SB(1, 1), cB + hstep + kstep, voffB);
    PG8_WAIT_V(6); PG8_BAR;
    for (;;) {
        const bool has_next = S.next(ui + 1, nxt);
        const char* nA = has_next ? (const char*)g.A + (size_t)nxt.pm * tstep : cA; const char* nB = has_next ? (const char*)g.Bt + (size_t)nxt.pn * tstep : cB;
        for (int t = 0; t < nt; t += 2) {
            const bool last = (t == nt - 2);
            const char* a1 = cA + (size_t)(t + 1) * kstep;
            const char* a2 = last ? nA : cA + (size_t)(t + 2) * kstep; const char* b2 = last ? nB : cB + (size_t)(t + 2) * kstep;
            const char* a3 = a2 + kstep; const char* b3 = b2 + kstep;
            PG8_LDB(B0, 0, 0); PG8_LDB(B1, 0, 1); PG8_SCHED; PG8_LDA(At, 0, 0); PG8_STAGE(PG8_SA(1, 1), a1 + hstep, voffA);
            PG8_WAIT_V(8); PG8_WAIT_L(0); PG8_BAR; PG8_MMA(0, 0, At, B0); PG8_MMA(0, 1, At, B1); PG8_BAR; PG8_SCHED;
            PG8_LDA(At, 0, 1); PG8_STAGE(PG8_SB(0, 0), b2, voffB); PG8_STAGE(PG8_SB(0, 1), b2 + hstep, voffB); PG8_STAGE(PG8_SA(0, 0), a2, voffA);
            PG8_WAIT_V(8); PG8_WAIT_L(0); PG8_BAR; PG8_MMA(1, 0, At, B0); PG8_MMA(1, 1, At, B1); PG8_BAR; PG8_SCHED;
            PG8_LDB(B0, 1, 0); PG8_LDB(B1, 1, 1); PG8_SCHED; PG8_LDA(At, 1, 0); PG8_STAGE(PG8_SA(0, 1), a2 + hstep, voffA);
            PG8_WAIT_V(8); PG8_WAIT_L(0); PG8_BAR; PG8_MMA(0, 0, At, B0); PG8_MMA(0, 1, At, B1); PG8_BAR; PG8_SCHED;
            PG8_LDA(At, 1, 1); PG8_STAGE(PG8_SB(1, 0), b3, voffB); PG8_STAGE(PG8_SB(1, 1), b3 + hstep, voffB); PG8_STAGE(PG8_SA(1, 0), a3, voffA);
            PG8_WAIT_V(8); PG8_WAIT_L(0); PG8_BAR; PG8_MMA(1, 0, At, B0); PG8_MMA(1, 1, At, B1); PG8_BAR; PG8_SCHED;
        }
        if constexpr (ALIGN_EPI) { if (wr == 0) PG8_BAR; }
        { int l2 = lane; asm volatile("" : "+v"(l2)); E(acc, cur, wr, wc, l2 & 15, l2 >> 4); }
        if (!has_next) break;
#pragma unroll
        for (int a = 0; a < 2; ++a)
#pragma unroll
            for (int b = 0; b < 2; ++b)
#pragma unroll
                for (int m = 0; m < 4; ++m)
#pragma unroll
                    for (int n = 0; n < 2; ++n) acc[a][b][m][n] = (f32x4){0.f, 0.f, 0.f, 0.f};
        cur = nxt; cA = nA; cB = nB; ++ui;
        if constexpr (ALIGN_EPI) { if (wr == 1) PG8_BAR; }
    }
    PG8_WAIT_V(0);
    if constexpr (!ALIGN_EPI) { if (wr == 0) PG8_BAR; }
    PG8_BAR;
#undef PG8_SA
#undef PG8_SB
#undef PG8_STAGE
#undef PG8_LDA
#undef PG8_LDB
#undef PG8_MMA
#undef PG8_WAIT_V
#undef PG8_WAIT_L
#undef PG8_BAR
#undef PG8_SCHED
}
struct EpiF32 {
    static constexpr bool PERM = false;
    float* C; int ldc;
    __device__ __forceinline__ void operator()(const f32x4 (&acc)[2][2][4][2], const Unit& u, int wr, int wc, int fr, int fq) const {
        const int row0 = u.pm * BM + wr * 64 + fr, col0 = u.pn * BM + wc * 32 + 4 * fq;
#pragma unroll
        for (int ai = 0; ai < 2; ++ai)
#pragma unroll
            for (int m = 0; m < 4; ++m) { float* rowp = C + (size_t)(row0 + ai * HALF + m * 16) * ldc + col0;
#pragma unroll
                for (int bj = 0; bj < 2; ++bj)
#pragma unroll
                    for (int n = 0; n < 2; ++n) *(f32x4*)(rowp + bj * HALF + n * 16) = acc[ai][bj][m][n]; }
    }
};
struct EpiSwiGLU {
    static constexpr bool PERM = true;
    h16* O;
    __device__ __forceinline__ void operator()(const f32x4 (&acc)[2][2][4][2], const Unit& u, int wr, int wc, int fr, int fq) const {
        const int row0 = u.pm * BM + wr * 64 + fr, col0 = u.pn * HALF + wc * 32 + 8 * fq;
#pragma unroll
        for (int ai = 0; ai < 2; ++ai)
#pragma unroll
            for (int m = 0; m < 4; ++m) { h16* rowp = O + (size_t)(row0 + ai * HALF + m * 16) * FF + col0;
                float v[8];
#pragma unroll
                for (int n = 0; n < 2; ++n)
#pragma unroll
                    for (int e = 0; e < 4; ++e) { const float gg = acc[ai][0][m][n][e], uu = acc[ai][1][m][n][e]; v[n * 4 + e] = gg * __builtin_amdgcn_rcpf(1.f + __builtin_amdgcn_exp2f(-gg * LOG2E)) * uu; }
                u32x4 w; w.x = pk_h2(v[0], v[1]); w.y = pk_h2(v[2], v[3]); w.z = pk_h2(v[4], v[5]); w.w = pk_h2(v[6], v[7]);
                *(u32x4*)rowp = w; }
    }
};

struct EpiIn {
    static constexpr bool PERM = false;
    h16 *ckv, *cq, *kr, *ki, *qb, *kb, *vT; float *wi, *ssq; const float* gckv; const float2* tab; LAS float* X;
    __device__ __forceinline__ void rope64(const f32x4 (&acc)[2][2][4][2], const Unit& u, int wr, int wc, int fr, int fq, h16* dst, int tl, float scale) const {
#pragma unroll
        for (int ai = 0; ai < 2; ++ai)
#pragma unroll
            for (int m = 0; m < 4; ++m) { const int tok = u.pm * BM + ai * HALF + wr * 64 + m * 16 + fr;
#pragma unroll
                for (int n = 0; n < 2; ++n) { const int i = 16 * n + 4 * fq; const f32x4* tp = (const f32x4*)(tab + (size_t)tok * 48 + i); const f32x4 t0 = tp[0], t1 = tp[1];
                    const f32x4 cs = {t0.x, t0.z, t1.x, t1.z}, sn = {t0.y, t0.w, t1.y, t1.w}, x1 = acc[ai][0][m][n], x2 = acc[ai][1][m][n];
                    const f32x4 o1 = (x1 * cs - x2 * sn) * scale, o2 = (x2 * cs + x1 * sn) * scale;
                    h16* p = dst + (size_t)tok * 768 + (4 * tl + wc) * 64 + i;
                    u32x2 w1, w2; w1.x = pk_h2(o1.x, o1.y); w1.y = pk_h2(o1.z, o1.w); w2.x = pk_h2(o2.x, o2.y); w2.y = pk_h2(o2.z, o2.w);
                    *(u32x2*)p = w1; *(u32x2*)(p + 32) = w2; }
                asm volatile("" ::: "memory"); }
    }
    __device__ __forceinline__ void operator()(const f32x4 (&acc)[2][2][4][2], const Unit& u, int wr, int wc, int fr, int fq) const {
        const int pn = u.pn;
        if (pn == 0) {
#pragma unroll
            for (int ai = 0; ai < 2; ++ai)
#pragma unroll
                for (int m = 0; m < 4; ++m) { float sq = 0.f;
#pragma unroll
                    for (int bj = 0; bj < 2; ++bj)
#pragma unroll
                        for (int n = 0; n < 2; ++n) { const f32x4 v = acc[ai][bj][m][n]; sq += (v.x * v.x + v.y * v.y) + (v.z * v.z + v.w * v.w); }
                    sq += __shfl_xor(sq, 16); sq += __shfl_xor(sq, 32);
                    if (fq == 0) X[(ai * HALF + wr * 64 + m * 16 + fr) * 4 + wc] = sq; }
            asm volatile("s_waitcnt lgkmcnt(0)" ::: "memory"); __builtin_amdgcn_s_barrier(); asm volatile("" ::: "memory");
#pragma unroll
            for (int ai = 0; ai < 2; ++ai)
#pragma unroll
                for (int m = 0; m < 4; ++m) { const int rl = ai * HALF + wr * 64 + m * 16 + fr, tok = u.pm * BM + rl; const f32x4 p = *(const LAS f32x4*)(X + rl * 4);
                    const float rstd = rsqrtf(((p.x + p.y) + (p.z + p.w)) * (1.f / KVL) + EPS);
#pragma unroll
                    for (int bj = 0; bj < 2; ++bj)
#pragma unroll
                        for (int n = 0; n < 2; ++n) { const int col = bj * HALF + wc * 32 + n * 16 + 4 * fq; const f32x4 o = acc[ai][bj][m][n] * rstd * *(const f32x4*)(gckv + col);
                            u32x2 w; w.x = pk_h2(o.x, o.y); w.y = pk_h2(o.z, o.w); *(u32x2*)(ckv + (size_t)tok * KVL + col) = w; }
                    asm volatile("" ::: "memory"); }
            asm volatile("s_waitcnt lgkmcnt(0)" ::: "memory"); __builtin_amdgcn_s_barrier(); asm volatile("" ::: "memory");
        } else if (pn <= 2) {
#pragma unroll
            for (int ai = 0; ai < 2; ++ai)
#pragma unroll
                for (int m = 0; m < 4; ++m) { const int tok = u.pm * BM + ai * HALF + wr * 64 + m * 16 + fr; float sq = 0.f;
#pragma unroll
                    for (int bj = 0; bj < 2; ++bj) { if (pn == 2 && bj == 1) break;
#pragma unroll
                        for (int n = 0; n < 2; ++n) { const f32x4 v = acc[ai][bj][m][n]; sq += (v.x * v.x + v.y * v.y) + (v.z * v.z + v.w * v.w);
                            const int col = (pn - 1) * 256 + bj * HALF + wc * 32 + n * 16 + 4 * fq; u32x2 w; w.x = pk_h2(v.x, v.y); w.y = pk_h2(v.z, v.w); *(u32x2*)(cq + (size_t)tok * QL + col) = w; } }
                    sq += __shfl_xor(sq, 16); sq += __shfl_xor(sq, 32);
                    if (fq == 0) ssq[tok * 8 + (pn - 1) * 4 + wc] = sq;
                    if (pn == 2) {
                        if (wc < 2) { const int i = 4 * fq; const f32x4* tp = (const f32x4*)(tab + (size_t)tok * 48 + 32 + i); const f32x4 t0 = tp[0], t1 = tp[1];
                            const f32x4 cs = {t0.x, t0.z, t1.x, t1.z}, sn = {t0.y, t0.w, t1.y, t1.w}, x1 = acc[ai][1][m][0], x2 = acc[ai][1][m][1];
                            const f32x4 o1 = x1 * cs - x2 * sn, o2 = x2 * cs + x1 * sn; h16* p = (wc == 0 ? kr : ki) + (size_t)tok * 32 + i;
                            u32x2 w1, w2; w1.x = pk_h2(o1.x, o1.y); w1.y = pk_h2(o1.z, o1.w); w2.x = pk_h2(o2.x, o2.y); w2.y = pk_h2(o2.z, o2.w);
                            *(u32x2*)p = w1; *(u32x2*)(p + 16) = w2; }
                        else if (wc == 2 && fq < 2) { *(f32x4*)(wi + tok * 8 + 4 * fq) = acc[ai][1][m][0] * 0.35355339059327373f; }
                    }
                    asm volatile("" ::: "memory"); }
        } else if (pn <= 5) rope64(acc, u, wr, wc, fr, fq, qb, pn - 3, 0.125f * LOG2E);
        else if (pn <= 8) rope64(acc, u, wr, wc, fr, fq, kb, pn - 6, 1.0f);
        else {
#pragma unroll
            for (int ai = 0; ai < 2; ++ai)
#pragma unroll
                for (int m = 0; m < 4; ++m) { const int tok = u.pm * BM + ai * HALF + wr * 64 + m * 16 + fr;
#pragma unroll
                    for (int bj = 0; bj < 2; ++bj)
#pragma unroll
                        for (int n = 0; n < 2; ++n) { const f32x4 v = acc[ai][bj][m][n]; u32x2 w; w.x = pk_h2(v.x, v.y); w.y = pk_h2(v.z, v.w);
                            *(u32x2*)(vT + (size_t)tok * 768 + (pn - 9) * 256 + bj * HALF + wc * 32 + n * 16 + 4 * fq) = w; }
                    asm volatile("" ::: "memory"); }
        }
    }
};
struct Epi4 {
    static constexpr bool PERM = false;
    h16 *qlat, *qr, *qi; const float* ssq; const float2* tab;
    __device__ __forceinline__ void operator()(const f32x4 (&acc)[2][2][4][2], const Unit& u, int wr, int wc, int fr, int fq) const {
        const int pn = u.pn; const float c2 = 0.10206207261596575f * LOG2E;
#pragma unroll
        for (int ai = 0; ai < 2; ++ai)
#pragma unroll
            for (int m = 0; m < 4; ++m) { const int tok = u.pm * BM + ai * HALF + wr * 64 + m * 16 + fr;
                const f32x4 s0 = *(const f32x4*)(ssq + tok * 8), s1 = *(const f32x4*)(ssq + tok * 8 + 4);
                const float rstd = rsqrtf((((s0.x + s0.y) + (s0.z + s0.w)) + ((s1.x + s1.y) + (s1.z + s1.w))) * (1.f / QL) + EPS);
                if (pn < 8) {
#pragma unroll
                    for (int bj = 0; bj < 2; ++bj)
#pragma unroll
                        for (int n = 0; n < 2; ++n) { const int col = bj * HALF + wc * 32 + n * 16 + 4 * fq; const f32x4 o = acc[ai][bj][m][n] * (rstd * c2);
                            u32x2 w; w.x = pk_h2(o.x, o.y); w.y = pk_h2(o.z, o.w); *(u32x2*)(qlat + (size_t)tok * 2048 + pn * 256 + col) = w; }
                } else { const float sc = (pn == 8) ? rstd * c2 : rstd; h16* dst = (pn == 8) ? qr : qi;
                    const int i = 4 * fq; const f32x4* tp = (const f32x4*)(tab + (size_t)tok * 48 + 32 + i); const f32x4 t0 = tp[0], t1 = tp[1];
                    const f32x4 cs = {t0.x, t0.z, t1.x, t1.z}, sn = {t0.y, t0.w, t1.y, t1.w};
#pragma unroll
                    for (int bj = 0; bj < 2; ++bj) { const f32x4 x1 = acc[ai][bj][m][0], x2 = acc[ai][bj][m][1]; const f32x4 o1 = (x1 * cs - x2 * sn) * sc, o2 = (x2 * cs + x1 * sn) * sc;
                        h16* p = dst + (size_t)tok * 256 + (4 * bj + wc) * 32 + i;
                        u32x2 w1, w2; w1.x = pk_h2(o1.x, o1.y); w1.y = pk_h2(o1.z, o1.w); w2.x = pk_h2(o2.x, o2.y); w2.y = pk_h2(o2.z, o2.w);
                        *(u32x2*)p = w1; *(u32x2*)(p + 16) = w2; } }
                asm volatile("" ::: "memory"); }
    }
};
__device__ __forceinline__ u32x4 ld16_l2(const h16* p) {
    const unsigned long long a = __hip_atomic_load((const unsigned long long*)p, __ATOMIC_RELAXED, __HIP_MEMORY_SCOPE_AGENT), b = __hip_atomic_load((const unsigned long long*)p + 1, __ATOMIC_RELAXED, __HIP_MEMORY_SCOPE_AGENT);
    return (u32x4){(unsigned)a, (unsigned)(a >> 32), (unsigned)b, (unsigned)(b >> 32)};
}
typedef _Float16 h16x8 __attribute__((ext_vector_type(8)));
__device__ __forceinline__ void unpk8(const u32x4 w, float (&f)[8]) {
    const h16x8 h = __builtin_bit_cast(h16x8, w);
#pragma unroll
    for (int i = 0; i < 8; ++i) f[i] = (float)h[i];
}
struct EpiH16 {
    static constexpr bool PERM = true;
    h16* O;
    __device__ __forceinline__ void operator()(const f32x4 (&acc)[2][2][4][2], const Unit& u, int wr, int wc, int fr, int fq) const {
        const int row0 = u.pm * BM + wr * 64 + fr, col0 = u.pn * BM + wc * 32 + 8 * fq;
#pragma unroll
        for (int ai = 0; ai < 2; ++ai)
#pragma unroll
            for (int m = 0; m < 4; ++m)
#pragma unroll
                for (int bj = 0; bj < 2; ++bj) { const f32x4 v0 = acc[ai][bj][m][0], v1 = acc[ai][bj][m][1];
                    u32x4 w; w.x = pk_h2(v0.x, v0.y); w.y = pk_h2(v0.z, v0.w); w.z = pk_h2(v1.x, v1.y); w.w = pk_h2(v1.z, v1.w);
                    *(u32x4*)(O + (size_t)(row0 + ai * HALF + m * 16) * DM + col0 + bj * HALF) = w; }
    }
};
struct EpiGate {
    static constexpr bool PERM = true;
    const h16* Y; h16* Z; int accum;
    __device__ __forceinline__ void operator()(const f32x4 (&acc)[2][2][4][2], const Unit& u, int wr, int wc, int fr, int fq) const {
        const int row0 = u.pm * BM + wr * 64 + fr, col0 = u.pn * BM + wc * 32 + 8 * fq;
#pragma unroll
        for (int ai = 0; ai < 2; ++ai)
#pragma unroll
            for (int m = 0; m < 4; ++m)
#pragma unroll
                for (int bj = 0; bj < 2; ++bj) { const size_t off = (size_t)(row0 + ai * HALF + m * 16) * DM + col0 + bj * HALF;
                    float y[8], zz[8]; unpk8(ld16_l2(Y + off), y);
                    if (accum) unpk8(ld16_l2(Z + off), zz); else {
#pragma unroll
                        for (int i = 0; i < 8; ++i) zz[i] = 0.f; }
                    float o[8];
#pragma unroll
                    for (int n = 0; n < 2; ++n)
#pragma unroll
                        for (int e = 0; e < 4; ++e) { const float gg = acc[ai][bj][m][n][e]; o[n * 4 + e] = zz[n * 4 + e] + y[n * 4 + e] * __builtin_amdgcn_rcpf(1.f + __builtin_amdgcn_exp2f(-gg * LOG2E)); }
                    u32x4 w; w.x = pk_h2(o[0], o[1]); w.y = pk_h2(o[2], o[3]); w.z = pk_h2(o[4], o[5]); w.w = pk_h2(o[6], o[7]);
                    *(u32x4*)(Z + off) = w; }
    }
};
}

#define XB_TMO      128
#define XB_XCNT(j)  (256  + 64 * (j))
#define XB_XSUB(j)  (1280 + 64 * (j))
#define XB_XGEN(j)  (2304 + 64 * (j))
#define XB_TOP      3328
#define XB_TOPGEN   3392
#define XCD_BAR_WORDS 3456
#define XB_SPIN_CAP (1u << 18)
__device__ __forceinline__ unsigned xb_ld(unsigned* p)              { return __hip_atomic_load(p, __ATOMIC_RELAXED, __HIP_MEMORY_SCOPE_AGENT); }
__device__ __forceinline__ unsigned xb_add(unsigned* p, unsigned v) { return __hip_atomic_fetch_add(p, v, __ATOMIC_RELAXED, __HIP_MEMORY_SCOPE_AGENT); }
__device__ __forceinline__ unsigned xb_xcc_id() { return (unsigned)__builtin_amdgcn_s_getreg((3 << 11) | 20) & 0xFu; }
#define XB_SPIN(cond, bar) do { unsigned _sp = 0; while (cond) { __builtin_amdgcn_s_sleep(1); \
    if ((++_sp & 255u) == 0u) { if (xb_ld(&(bar)[XB_TMO])) break; if (_sp > XB_SPIN_CAP) { atomicAdd(&(bar)[XB_TMO], 1u); break; } } } } while (0)
struct XcdBarrier { unsigned* bar; unsigned x; volatile LAS unsigned* st; };
__device__ __forceinline__ XcdBarrier xcd_barrier_post(unsigned* bar, volatile LAS unsigned* st) {
    XcdBarrier b; b.bar = bar; b.x = xb_xcc_id(); b.st = st;
    if (threadIdx.x == 0) (void)xb_add(&bar[XB_XCNT(b.x)], 1u);
    return b;
}
__device__ __forceinline__ void xcd_barrier_complete(unsigned* bar, unsigned x, unsigned& nloc, unsigned& nx) {
    const unsigned G = gridDim.x * gridDim.y * gridDim.z;
    unsigned sum, cnt, mine, sp = 0u;
    for (;;) {
        sum = 0u; cnt = 0u; mine = 0u;
#pragma unroll
        for (unsigned j = 0; j < 16; ++j) { const unsigned c = xb_ld(&bar[XB_XCNT(j)]); sum += c; cnt += (c > 0u) ? 1u : 0u; mine = (j == x) ? c : mine; }
        if (sum == G) break;
        __builtin_amdgcn_s_sleep(1);
        if ((++sp & 255u) == 0u) { if (xb_ld(&bar[XB_TMO])) break; if (sp > XB_SPIN_CAP) { atomicAdd(&bar[XB_TMO], 1u); break; } }
    }
    nloc = mine > 0u ? mine : 1u; nx = cnt > 0u ? cnt : 1u;
}
__device__ __forceinline__ void xcd_barrier(const XcdBarrier& b) {
    asm volatile("s_waitcnt vmcnt(0)" ::: "memory");
    __syncthreads();
    if (threadIdx.x == 0) {
        unsigned* bar = b.bar;
        __builtin_amdgcn_s_waitcnt(0);
        unsigned nloc = b.st[0], nx = b.st[1];
        if (nloc == 0u) { xcd_barrier_complete(bar, b.x, nloc, nx); b.st[0] = nloc; b.st[1] = nx; }
        const unsigned old = xb_add(&bar[XB_XSUB(b.x)], 1u);
        const unsigned gen = old / nloc;
        if (old + 1u == (gen + 1u) * nloc) {
            __builtin_amdgcn_fence(__ATOMIC_RELEASE, "agent");
            asm volatile("s_waitcnt vmcnt(0)" ::: "memory");
            const unsigned og = xb_add(&bar[XB_TOP], 1u);
            const unsigned tg = og / nx;
            if (og + 1u == (tg + 1u) * nx) xb_add(&bar[XB_TOPGEN], 1u);
            else XB_SPIN(xb_ld(&bar[XB_TOPGEN]) == tg, bar);
            __builtin_amdgcn_fence(__ATOMIC_ACQUIRE, "agent");
            xb_add(&bar[XB_XGEN(b.x)], 1u);
            asm volatile("s_waitcnt vmcnt(0)" ::: "memory");
        } else {
            XB_SPIN(xb_ld(&bar[XB_XGEN(b.x)]) == gen, bar);
            __builtin_amdgcn_fence(__ATOMIC_ACQUIRE, "agent");
            asm volatile("s_waitcnt vmcnt(0)" ::: "memory");
        }
    }
    __syncthreads();
}

constexpr int NWAVES = 8, NTHR = 512;
constexpr int RING_BYTES = 131072, LDSCTL_OFF = RING_BYTES, MISC_OFF = LDSCTL_OFF + 320, LDS_BYTES = 147456;
constexpr int XCH_OFF = RING_BYTES + 1024;
constexpr int CW_BAR = 4096;
constexpr size_t OW_GU1 = OFF_W, OW_D1 = OW_GU1 + 11 * MiB, OW_IN = OW_D1 + (size_t)DM * FF * 2, OW_GATE = OW_IN + 6 * MiB, OW_4 = OW_GATE + 4 * MiB, OW_OV = OW_4 + 2 * MiB,
                 OW_UPB = OW_OV + 4 * MiB, OW_O = OW_UPB + MiB / 2, OW_GU2 = OW_O + 2 * MiB, OW_D2 = OW_GU2 + 11 * MiB, OW_END = OW_D2 + (size_t)DM * FF * 2;
static_assert(OW_END <= OFF_H, "weights region");
constexpr int NIN3 = 3072, N4 = 2560;

struct Args { const float* in[27]; float* out; unsigned char* ws; int ph_lo, ph_hi, zparts, pad; };
struct Frame {
    LAS unsigned char* lds; int tid, lane, wave, G, gw, NGW;
};
__device__ __forceinline__ float wave_sum(float v) {
#pragma unroll
    for (int o = 1; o < 64; o <<= 1) v += __shfl_xor(v, o);
    return v;
}
__device__ __forceinline__ bool map_row(int job, int n, const Args& a, const float*& W, int& ldw, int& col) {
    if (job <= 1) { const int t = n >> 8, j = n & 255; W = a.in[(job == 0 ? 6 : 23) + (j >> 7)]; ldw = FF; col = t * 128 + (j & 127); return true; }
    if (job == 2) { W = a.in[11]; ldw = DIN; const int t = n >> 8, j = n & 255;
        if (t == 0) { col = C_CKV + j; return true; }
        if (t == 1) { col = j; return true; }
        if (t == 2) { if (j < 128) { col = 256 + j; return true; } if (j < 160) { col = C_KR + (j - 128); return true; } if (j < 192) { col = C_KI + (j - 160); return true; } if (j < 200) { col = C_WI + (j - 192); return true; } col = 0; return false; }
        if (t < 9) { const int c3 = (t - 3) / 3, tl = (t - 3) % 3, hl = (j & 127) >> 5, i = j & 31; col = C_QKV + c3 * 768 + (4 * tl + hl) * 64 + (j >> 7) * 32 + i; return true; }
        col = C_QKV + 1536 + (t - 9) * 256 + j; return true; }
    { const int n2 = n - 2048; if (n2 < 256) { W = a.in[14]; ldw = 768; col = (n2 >> 5) * 96 + 64 + (n2 & 31); } else { W = a.in[17]; ldw = 256; col = n2 - 256; } return true; }
}
__device__ __forceinline__ void tr_item(const float* W, int ldw, int col, bool valid, const float* scale, int k0, h16* WTrow0, int K, LAS float* scr, int lane) {
#pragma unroll 8
    for (int i = 0; i < 32; ++i) { const int kk = 2 * i + (lane >> 5); float v = valid ? W[(size_t)(k0 + kk) * ldw + col] : 0.f; if (scale) v *= scale[k0 + kk]; scr[kk * 33 + (lane & 31)] = v; }
    asm volatile("s_waitcnt lgkmcnt(0)" ::: "memory");
    const int c = lane & 7;
#pragma unroll
    for (int j = 0; j < 4; ++j) { const int n = (lane >> 3) + 8 * j; const LAS float* s = scr + (8 * c) * 33 + n;
        u32x4 o; o.x = pk_h2(s[0 * 33], s[1 * 33]); o.y = pk_h2(s[2 * 33], s[3 * 33]); o.z = pk_h2(s[4 * 33], s[5 * 33]); o.w = pk_h2(s[6 * 33], s[7 * 33]);
        *(u32x4*)(WTrow0 + (size_t)n * K + k0 + 8 * c) = o; }
    asm volatile("s_waitcnt lgkmcnt(0)" ::: "memory");
}
__device__ __forceinline__ void tr_job_mapped(const Frame& F, const Args& a, int job, int Ndest, int n_lo, int K, h16* WT, const float* scale, LAS float* scr, int phase_off) {
    const int nblk = Ndest / 32, nitems = (K / 64) * nblk;
    for (int it = (F.gw + phase_off) % F.NGW; it < nitems; it += F.NGW) {
        const int kb = it / nblk, nb = it % nblk; const float* W; int ldw, col;
        const bool valid = map_row(job, n_lo + nb * 32 + (F.lane & 31), a, W, ldw, col);
        tr_item(W, ldw, col, valid, scale, kb * 64, WT + (size_t)(n_lo + nb * 32) * K, K, scr, F.lane);
    }
}
__device__ __forceinline__ void tr_job_plain(const Frame& F, const float* W, int ldw, int Ndest, int K, h16* WT, LAS float* scr, int phase_off) {
    const int nblk = Ndest / 32, nitems = (K / 64) * nblk;
    for (int it = (F.gw + phase_off) % F.NGW; it < nitems; it += F.NGW) {
        const int kb = it / nblk, nb = it % nblk;
        tr_item(W, ldw, nb * 32 + (F.lane & 31), true, nullptr, kb * 64, WT + (size_t)(nb * 32) * K, K, scr, F.lane);
    }
}
__device__ __forceinline__ void row_load(const float* p, int lane, f32x4 (&v)[4]) {
#pragma unroll
    for (int j = 0; j < 4; ++j) v[j] = ((const f32x4*)p)[lane + 64 * j];
}
__device__ __forceinline__ float row_ssq(const f32x4 (&v)[4]) { float s = 0.f;
#pragma unroll
    for (int j = 0; j < 4; ++j) s += (v[j].x * v[j].x + v[j].y * v[j].y) + (v[j].z * v[j].z + v[j].w * v[j].w);
    return wave_sum(s); }
__device__ __forceinline__ void row_normmod_store(const f32x4 (&v)[4], float rstd, const float* g, const float* sc, const float* sh, h16* dst, int lane) {
#pragma unroll
    for (int j = 0; j < 4; ++j) { const int ci = lane + 64 * j; const f32x4 gg = ((const f32x4*)g)[ci], s1 = ((const f32x4*)sc)[ci], s0 = ((const f32x4*)sh)[ci];
        const f32x4 o = v[j] * rstd * gg * (s1 + 1.f) + s0;
        u32x2 w; w.x = pk_h2(o.x, o.y); w.y = pk_h2(o.z, o.w); ((u32x2*)dst)[ci] = w; }
}
__device__ __forceinline__ void ph_normmod(const Frame& F, const float* x, const float* g, const float* mod, int isc, int ish, h16* dst) {
    for (int m = F.gw; m < MT; m += F.NGW) { f32x4 v[4]; row_load(x + (size_t)m * DM, F.lane, v);
        const float rstd = rsqrtf(row_ssq(v) * (1.f / DM) + EPS); const float* mb = mod + (m / SEQ) * (NMOD * DM);
        row_normmod_store(v, rstd, g, mb + isc * DM, mb + ish * DM, dst + (size_t)m * DM, F.lane); }
}
__device__ __forceinline__ void ph_resnorm(const Frame& F, const float* xin, const float* f, const float* gpost, const float* mod, int igt, float coef, float* xout,
                                           bool second, const float* gpre, int isc, int ish, h16* dst) {
    for (int m = F.gw; m < MT; m += F.NGW) { f32x4 v[4], xi[4]; row_load(f + (size_t)m * DM, F.lane, v); row_load(xin + (size_t)m * DM, F.lane, xi);
        const float rstd = rsqrtf(row_ssq(v) * (1.f / DM) + EPS) * coef; const float* mb = mod + (m / SEQ) * (NMOD * DM);
#pragma unroll
        for (int j = 0; j < 4; ++j) { const int ci = F.lane + 64 * j; const f32x4 gg = ((const f32x4*)gpost)[ci], gt = ((const f32x4*)(mb + igt * DM))[ci];
            xi[j] = xi[j] + gt * v[j] * rstd * gg; ((f32x4*)(xout + (size_t)m * DM))[ci] = xi[j]; }
        if (second) { const float r2 = rsqrtf(row_ssq(xi) * (1.f / DM) + EPS); row_normmod_store(xi, r2, gpre, mb + isc * DM, mb + ish * DM, dst + (size_t)m * DM, F.lane); } }
}


__device__ __forceinline__ float wg_sum512(float v, LAS float* red) {
#pragma unroll
    for (int o = 32; o > 0; o >>= 1) v += __shfl_xor(v, o);
    __syncthreads();
    if ((threadIdx.x & 63) == 0) red[threadIdx.x >> 6] = v;
    __syncthreads();
    float s = 0.f;
#pragma unroll
    for (int w = 0; w < 8; ++w) s += red[w];
    return s;
}
__device__ __forceinline__ float wg_max512(float v, LAS float* red) {
#pragma unroll
    for (int o = 32; o > 0; o >>= 1) v = fmaxf(v, __shfl_xor(v, o));
    __syncthreads();
    if ((threadIdx.x & 63) == 0) red[threadIdx.x >> 6] = v;
    __syncthreads();
    float s = red[0];
#pragma unroll
    for (int w = 1; w < 8; ++w) s = fmaxf(s, red[w]);
    return s;
}
__device__ __forceinline__ void ph_dilated_simple(const Frame& F, const h16* qb, const h16* kb, const h16* vb, h16* og, float* lse2) {
    LAS float* p = (LAS float*)(F.lds + F.wave * 2048);
    LAS int* kix = (LAS int*)(F.lds + F.wave * 2048 + 1024);
    for (int it = F.gw; it < MT * 12; it += F.NGW) {
        const int tok = it / 12, gh = it % 12, g = gh >> 2, b = tok / SEQ, t = tok % SEQ, dil = dil_of(g), lane = F.lane;
        const h16* qp = qb + (size_t)tok * 768 + gh * 64;
        float sc[3]; float m = -INFINITY;
#pragma unroll
        for (int r = 0; r < 3; ++r) { const int k = lane + 64 * r; sc[r] = -INFINITY; const int ti = t - k * dil;
            if (k < 129) { kix[k] = ti;
                if (ti >= 0) { const h16* kp = kb + (size_t)(b * SEQ + ti) * 768 + gh * 64; float a = 0.f;
#pragma unroll 8
                    for (int d = 0; d < 64; ++d) a += (float)qp[d] * (float)kp[d];
                    sc[r] = a; } }
            m = fmaxf(m, sc[r]); }
#pragma unroll
        for (int o = 32; o > 0; o >>= 1) m = fmaxf(m, __shfl_xor(m, o));
        float l = 0.f;
#pragma unroll
        for (int r = 0; r < 3; ++r) { const int k = lane + 64 * r; if (k < 129) { const float e = (sc[r] == -INFINITY) ? 0.f : exp2f(sc[r] - m); p[k] = e; l += e; } }
#pragma unroll
        for (int o = 32; o > 0; o >>= 1) l += __shfl_xor(l, o);
        asm volatile("s_waitcnt lgkmcnt(0)" ::: "memory");
        float a = 0.f; const h16* vp = vb + (size_t)(b * SEQ) * 768 + gh * 64 + lane;
        for (int k = 0; k < 129; ++k) { const int ti = kix[k]; if (ti >= 0) a += p[k] * (float)vp[(size_t)ti * 768]; }
        og[(size_t)tok * 768 + gh * 64 + lane] = (h16)(a / l);
        if (lane == 0) lse2[tok * 12 + gh] = m + log2f(l);
        asm volatile("s_waitcnt lgkmcnt(0)" ::: "memory");
    }
}
__device__ __forceinline__ void ph_combine(const Frame& F, const h16* og, const float* lse2, h16* ob) {
    for (int idx = blockIdx.x * NTHR + F.tid; idx < MT * 256; idx += F.G * NTHR) {
        const int tok = idx >> 8, c = idx & 255, hh = c >> 6;
        const float l0 = lse2[tok * 12 + hh], l1 = lse2[tok * 12 + 4 + hh], l2 = lse2[tok * 12 + 8 + hh], m = fmaxf(l0, fmaxf(l1, l2));
        const float w0 = exp2f(l0 - m), w1 = exp2f(l1 - m), w2 = exp2f(l2 - m), inv = 1.f / (w0 + w1 + w2);
        ob[idx] = (h16)((w0 * (float)og[(size_t)tok * 768 + c] + w1 * (float)og[(size_t)tok * 768 + 256 + c] + w2 * (float)og[(size_t)tok * 768 + 512 + c]) * inv); }
}
__device__ __forceinline__ void ph_topk_simple(const Frame& F, const h16* qi, const h16* ki, const float* wi, unsigned short* sel) {
    LAS unsigned* key = (LAS unsigned*)(F.lds);
    LAS float* q = (LAS float*)(F.lds + 16384);
    LAS float* w = (LAS float*)(F.lds + 16384 + 1024);
    LAS unsigned* cnt = (LAS unsigned*)(F.lds + 16384 + 1024 + 64);
    const int tid = F.tid;
    for (int tok = blockIdx.x; tok < MT; tok += F.G) {
        const int b = tok / SEQ, t = tok % SEQ; unsigned short* so = sel + (size_t)tok * TOPK;
        if (t < TOPK) { if (tid < TOPK) so[tid] = (unsigned short)(tid <= t ? tid : 0); continue; }
        __syncthreads();
        if (tid < 256) q[tid] = (float)qi[(size_t)tok * 256 + tid]; if (tid < 8) w[tid] = wi[tok * 8 + tid];
        __syncthreads();
        const int n = t + 1;
#pragma unroll 1
        for (int s = tid; s < n; s += NTHR) {
            const h16* kp = ki + (size_t)(b * SEQ + s) * 32; float a[8];
#pragma unroll
            for (int hd = 0; hd < 8; ++hd) a[hd] = 0.f;
#pragma unroll 4
            for (int e = 0; e < 32; ++e) { const float kv = (float)kp[e];
#pragma unroll
                for (int hd = 0; hd < 8; ++hd) a[hd] += q[hd * 32 + e] * kv; }
            float sc = 0.f;
#pragma unroll
            for (int hd = 0; hd < 8; ++hd) sc += w[hd] * fmaxf(a[hd] * 0.17677669529663687f, 0.f);
            key[s] = fkey(sc);
        }
        __syncthreads();
        unsigned T = 0;
        for (int bit = 31; bit >= 0; --bit) {
            const unsigned cand = T | (1u << bit);
            if (tid == 0) *cnt = 0; __syncthreads();
            unsigned c = 0; for (int s = tid; s < n; s += NTHR) c += (key[s] >= cand) ? 1u : 0u;
#pragma unroll
            for (int o = 32; o > 0; o >>= 1) c += __shfl_xor(c, o);
            if ((tid & 63) == 0) atomicAdd((unsigned*)cnt, c);
            __syncthreads();
            if (*cnt >= TOPK) T = cand;
            __syncthreads();
        }
        if (tid == 0) *cnt = 0; __syncthreads();
        for (int s = tid; s < n; s += NTHR) if (key[s] > T) { const unsigned pp = atomicAdd((unsigned*)cnt, 1u); so[pp] = (unsigned short)s; }
        __syncthreads();
        if (tid == 0) { unsigned pp = *cnt; for (int s = 0; s < n && pp < TOPK; ++s) if (key[s] == T) so[pp++] = (unsigned short)s; }
    }
}
__device__ __forceinline__ void ph_sparse_simple(const Frame& F, h16* qlat, const h16* qr, const h16* ckv, const h16* kr, const unsigned short* sel) {
    LAS float* ql = (LAS float*)(F.lds);
    LAS float* qrr = (LAS float*)(F.lds + 8192);
    LAS float* p = (LAS float*)(F.lds + 8192 + 1024);
    LAS int* rows = (LAS int*)(F.lds + 8192 + 1024 + 8192);
    LAS float* red = (LAS float*)(F.lds + 8192 + 1024 + 8192 + 1024);
    LAS float* stat = red + 16;
    const int tid = F.tid, k = tid & 255, hh = tid >> 8;
    for (int tok = blockIdx.x; tok < MT; tok += F.G) {
        const int b = tok / SEQ, t = tok % SEQ, cnt = (t + 1 < TOPK) ? t + 1 : TOPK;
        __syncthreads();
        for (int i = tid; i < 2048; i += NTHR) ql[i] = (float)qlat[(size_t)tok * 2048 + i];
        if (tid < 256) { qrr[tid] = (float)qr[(size_t)tok * 256 + tid]; rows[tid] = b * SEQ + (tid < cnt ? (int)sel[(size_t)tok * TOPK + tid] : 0); }
        __syncthreads();
        const int row = rows[k];
        float s[4];
#pragma unroll
        for (int j = 0; j < 4; ++j) s[j] = 0.f;
        if (k < cnt) {
            const h16* kp = ckv + (size_t)row * 256;
            for (int r = 0; r < 256; ++r) { const float kvv = (float)kp[r];
#pragma unroll
                for (int j = 0; j < 4; ++j) s[j] += ql[(4 * hh + j) * 256 + r] * kvv; }
            const h16* rp = kr + (size_t)row * 32;
            for (int e = 0; e < 32; ++e) { const float kvv = (float)rp[e];
#pragma unroll
                for (int j = 0; j < 4; ++j) s[j] += qrr[(4 * hh + j) * 32 + e] * kvv; }
        } else {
#pragma unroll
            for (int j = 0; j < 4; ++j) s[j] = -INFINITY;
        }
#pragma unroll
        for (int hd = 0; hd < 8; ++hd) {
            const float mine = (hd >> 2) == hh ? s[hd & 3] : -INFINITY;
            const float m = wg_max512(mine, red);
            const float e = ((hd >> 2) == hh && k < cnt) ? exp2f(mine - m) : 0.f;
            if ((hd >> 2) == hh) p[hd * 256 + k] = e;
            const float l = wg_sum512(e, red);
            if (tid == 0) stat[hd] = 1.f / l;
        }
        __syncthreads();
        float o[4];
#pragma unroll
        for (int j = 0; j < 4; ++j) o[j] = 0.f;
        for (int kk = 0; kk < cnt; ++kk) { const float v = (float)ckv[(size_t)rows[kk] * 256 + k];
#pragma unroll
            for (int j = 0; j < 4; ++j) o[j] += p[(4 * hh + j) * 256 + kk] * v; }
#pragma unroll
        for (int j = 0; j < 4; ++j) qlat[(size_t)tok * 2048 + (4 * hh + j) * 256 + k] = (h16)(o[j] * stat[4 * hh + j]);
    }
}


typedef short v4i16_t __attribute__((ext_vector_type(4)));
typedef short s16x8 __attribute__((ext_vector_type(8)));
__device__ __forceinline__ void ph_sparse_mfma(const Frame& F, h16* qlat, const h16* qr, const h16* ckv, const h16* kr, const unsigned short* sel) {
    const int lane = F.lane, w = F.wave, c = lane & 15, kq = lane >> 4, hd = c & 7, G = F.G;
    LAS unsigned char* V = F.lds;
    LAS unsigned char* P = F.lds + XCH_OFF;
    LAS float* pmax = (LAS float*)(F.lds + XCH_OFF + 8448);
    LAS float* psum = pmax + 128;
    int tok = blockIdx.x; if (tok >= MT) return;
    int rowi[2]; f16x8 Kf[2][9], Qf[9];
#define SP_SEL(dst, tk) do { _Pragma("unroll") for (int tl = 0; tl < 2; ++tl) dst[tl] = ((tk) / SEQ) * SEQ + (int)sel[(size_t)(tk) * TOPK + 32 * w + 16 * tl + c]; } while (0)
#define SP_LOADK() do { _Pragma("unroll") for (int tl = 0; tl < 2; ++tl) { _Pragma("unroll") for (int s_ = 0; s_ < 8; ++s_) Kf[tl][s_] = *(const f16x8*)(ckv + (size_t)rowi[tl] * 256 + 32 * s_ + 8 * kq); \
        Kf[tl][8] = *(const f16x8*)(kr + (size_t)rowi[tl] * 32 + 8 * kq); } } while (0)
#define SP_LOADQ(tk) do { _Pragma("unroll") for (int s_ = 0; s_ < 8; ++s_) Qf[s_] = *(const f16x8*)(qlat + (size_t)(tk) * 2048 + hd * 256 + 32 * s_ + 8 * kq); Qf[8] = *(const f16x8*)(qr + (size_t)(tk) * 256 + hd * 32 + 8 * kq); } while (0)
    SP_SEL(rowi, tok); SP_LOADK(); SP_LOADQ(tok);
    const int vw0 = (32 * w + c) * 512, swz = c << 1;
    const int qp = c >> 2, pp = c & 3;
    int tro[2][2];
#pragma unroll
    for (int jj = 0; jj < 2; ++jj)
#pragma unroll
        for (int ft = 0; ft < 2; ++ft) { const int key = 8 * kq + 4 * jj + qp, ch = 4 * w + 2 * ft + (pp >> 1); tro[jj][ft] = key * 512 + ((ch ^ ((key & 15) << 1)) << 4) + (pp & 1) * 8; }
    for (;;) {
        const int t = tok % SEQ, cnt = (t + 1 < TOPK) ? t + 1 : TOPK, ntok = tok + G; const bool has_next = ntok < MT;
        int rown[2] = {0, 0}; if (has_next) SP_SEL(rown, ntok);
        f32x4 S[2];
#pragma unroll
        for (int tl = 0; tl < 2; ++tl) { S[tl] = (f32x4){0.f, 0.f, 0.f, 0.f};
#pragma unroll
            for (int s_ = 0; s_ < 9; ++s_) S[tl] = __builtin_amdgcn_mfma_f32_16x16x32_f16(Kf[tl][s_], Qf[s_], S[tl], 0, 0, 0); }
        float m = -INFINITY;
#pragma unroll
        for (int tl = 0; tl < 2; ++tl)
#pragma unroll
            for (int e = 0; e < 4; ++e) { if (32 * w + 16 * tl + 4 * kq + e >= cnt) S[tl][e] = -INFINITY; m = fmaxf(m, S[tl][e]); }
        m = fmaxf(m, __shfl_xor(m, 16)); m = fmaxf(m, __shfl_xor(m, 32));
        if (kq == 0) pmax[w * 16 + c] = m;
#pragma unroll
        for (int tl = 0; tl < 2; ++tl)
#pragma unroll
            for (int s_ = 0; s_ < 8; ++s_) *(LAS f16x8*)(V + vw0 + tl * 8192 + (((4 * s_ + kq) ^ swz) << 4)) = Kf[tl][s_];
        asm volatile("s_waitcnt lgkmcnt(0)" ::: "memory"); __builtin_amdgcn_s_barrier(); asm volatile("" ::: "memory");
        float mg = pmax[c];
#pragma unroll
        for (int ww = 1; ww < 8; ++ww) mg = fmaxf(mg, pmax[ww * 16 + c]);
        float ps = 0.f;
#pragma unroll
        for (int tl = 0; tl < 2; ++tl) { float pe[4];
#pragma unroll
            for (int e = 0; e < 4; ++e) { pe[e] = __builtin_amdgcn_exp2f(S[tl][e] - mg); ps += pe[e]; }
            u32x2 pk; pk.x = pk_h2(pe[0], pe[1]); pk.y = pk_h2(pe[2], pe[3]);
            *(LAS u32x2*)(P + c * 528 + (32 * w + 16 * tl + 4 * kq) * 2) = pk; }
        ps += __shfl_xor(ps, 16); ps += __shfl_xor(ps, 32);
        if (kq == 0) psum[w * 16 + c] = ps;
        asm volatile("s_waitcnt lgkmcnt(0)" ::: "memory"); __builtin_amdgcn_s_barrier(); asm volatile("" ::: "memory");
        if (has_next) { rowi[0] = rown[0]; rowi[1] = rown[1]; SP_LOADK(); SP_LOADQ(ntok); }
        float l = psum[c];
#pragma unroll
        for (int ww = 1; ww < 8; ++ww) l += psum[ww * 16 + c];
        f32x4 O[2]; O[0] = (f32x4){0.f, 0.f, 0.f, 0.f}; O[1] = O[0];
#pragma unroll
        for (int s_ = 0; s_ < 8; ++s_) {
            const f16x8 Pf = *(const LAS f16x8*)(P + c * 528 + (32 * s_ + 8 * kq) * 2);
#pragma unroll
            for (int ft = 0; ft < 2; ++ft) {
                const v4i16_t lo = __builtin_amdgcn_ds_read_tr16_b64_v4i16((LAS v4i16_t*)(V + s_ * 16384 + tro[0][ft]));
                const v4i16_t hi = __builtin_amdgcn_ds_read_tr16_b64_v4i16((LAS v4i16_t*)(V + s_ * 16384 + tro[1][ft]));
                const s16x8 av = {lo[0], lo[1], lo[2], lo[3], hi[0], hi[1], hi[2], hi[3]};
                O[ft] = __builtin_amdgcn_mfma_f32_16x16x32_f16(__builtin_bit_cast(f16x8, av), Pf, O[ft], 0, 0, 0); } }
        if (c < 8) { const float il = __builtin_amdgcn_rcpf(l);
#pragma unroll
            for (int ft = 0; ft < 2; ++ft) { const f32x4 o = O[ft] * il; u32x2 pk; pk.x = pk_h2(o.x, o.y); pk.y = pk_h2(o.z, o.w);
                *(u32x2*)(qlat + (size_t)tok * 2048 + c * 256 + 32 * w + 16 * ft + 4 * kq) = pk; } }
        asm volatile("s_waitcnt lgkmcnt(0)" ::: "memory"); __builtin_amdgcn_s_barrier(); asm volatile("" ::: "memory");
        if (!has_next) break;
        tok = ntok;
    }
#undef SP_SEL
#undef SP_LOADK
#undef SP_LOADQ
}

__global__ void __launch_bounds__(NTHR, 2) mega_fwd(Args args) {
    extern __shared__ __attribute__((aligned(16))) unsigned char lds_raw[];
    Frame F; F.lds = (LAS unsigned char*)lds_raw; F.tid = threadIdx.x; F.lane = F.tid & 63; F.wave = __builtin_amdgcn_readfirstlane(F.tid >> 6);
    F.G = gridDim.x; F.gw = blockIdx.x * NWAVES + F.wave; F.NGW = F.G * NWAVES;
    volatile LAS unsigned* MISC = (volatile LAS unsigned*)(F.lds + MISC_OFF);
    unsigned char* ws = args.ws;
    for (int u = F.tid; u < (LDS_BYTES - LDSCTL_OFF) / 4; u += NTHR) ((LAS unsigned*)(F.lds + LDSCTL_OFF))[u] = 0u;
    __syncthreads();
    XcdBarrier bar = xcd_barrier_post((unsigned*)(ws + OFF_CTL) + CW_BAR, MISC + 8);
    const int lo = args.ph_lo, hi = args.ph_hi;
#ifndef PHMASK
#define PHMASK 0xFFFFu
#endif
#define IN(k) (((PHMASK >> (k)) & 1u) && lo <= (k) && (k) < hi)
#define SEAM(k) do { if (IN(k) && IN((k) + 1)) xcd_barrier(bar); } while (0)
    float* mod = (float*)(ws + OFF_MOD); float2* tab = (float2*)(ws + OFF_ROPE);
    h16* Hb = (h16*)(ws + OFF_H); h16* Ab = (h16*)(ws + OFF_A); float* Fb = (float*)(ws + OFF_F);

    if (IN(0)) {
        LAS float* scr = (LAS float*)(F.lds + F.wave * 16384);
        for (int ch = blockIdx.x; ch < (NMOD * DM) / 64; ch += F.G) {
            LAS float* sl = (LAS float*)(F.lds);
            LAS float* part = (LAS float*)(F.lds + 16384);
            __syncthreads();
            for (int i = F.tid; i < 4 * DM; i += NTHR) sl[i] = silu_f(args.in[1][i]);
            __syncthreads();
            const float* wm = args.in[3] + (size_t)(F.wave * 128) * (NMOD * DM) + ch * 64 + F.lane;
            float a0 = 0.f, a1 = 0.f, a2 = 0.f, a3 = 0.f;
#pragma unroll 8
            for (int k = 0; k < 128; ++k) { const float w = wm[(size_t)k * (NMOD * DM)]; const int kk = F.wave * 128 + k; a0 += sl[kk] * w; a1 += sl[DM + kk] * w; a2 += sl[2 * DM + kk] * w; a3 += sl[3 * DM + kk] * w; }
            part[(F.wave * 4 + 0) * 64 + F.lane] = a0; part[(F.wave * 4 + 1) * 64 + F.lane] = a1; part[(F.wave * 4 + 2) * 64 + F.lane] = a2; part[(F.wave * 4 + 3) * 64 + F.lane] = a3;
            __syncthreads();
            if (F.tid < 256) { const int b = F.tid >> 6, l = F.tid & 63; float s = args.in[4][ch * 64 + l];
#pragma unroll
                for (int w = 0; w < 8; ++w) s += part[(w * 4 + b) * 64 + l];
                mod[b * (NMOD * DM) + ch * 64 + l] = s; }
            __syncthreads();
        }
        for (int idx = blockIdx.x * NTHR + F.tid; idx < MT * 48; idx += F.G * NTHR) { const int tok = idx / 48, i = idx % 48;
            const float inv = (i < 32) ? powf(10000.f, -(float)i / 32.f) : powf(10000.f, -(float)(i - 32) / 16.f);
            const float ang = (float)((const int*)args.in[2])[tok] * inv; tab[idx] = make_float2(cosf(ang), sinf(ang)); }
        tr_job_mapped(F, args, 0, 2 * FF, 0, DM, (h16*)(ws + OW_GU1), nullptr, scr, 0);
        tr_job_plain(F, args.in[8], DM, DM, FF, (h16*)(ws + OW_D1), scr, 768);
        tr_job_mapped(F, args, 2, NIN3, 0, DM, (h16*)(ws + OW_IN), nullptr, scr, 128);
        tr_job_plain(F, args.in[11] + C_GATE, DIN, 2048, DM, (h16*)(ws + OW_GATE), scr, 1664);
        tr_job_mapped(F, args, 3, 512, 2048, QL, (h16*)(ws + OW_4), args.in[12], scr, 640);
        tr_job_plain(F, args.in[19], DM, DM, 256, (h16*)(ws + OW_UPB), scr, 736);
        tr_job_plain(F, args.in[20], DM, DM, DM, (h16*)(ws + OW_O), scr, 864);
        tr_job_mapped(F, args, 1, 2 * FF, 0, DM, (h16*)(ws + OW_GU2), nullptr, scr, 1376);
        tr_job_plain(F, args.in[25], DM, DM, FF, (h16*)(ws + OW_D2), scr, 96);
        for (int idx = blockIdx.x * NTHR + F.tid; idx < 2048 * QL; idx += F.G * NTHR) { const int n = idx / QL, k = idx % QL, hd = n >> 8, r = n & 255;
            const float* pa = args.in[14] + (size_t)k * 768 + hd * 96; const float* pb = args.in[15] + (size_t)r * 512 + hd * 64; float s = 0.f;
#pragma unroll 8
            for (int e = 0; e < 64; ++e) s += pa[e] * pb[e];
            ((h16*)(ws + OW_4))[(size_t)n * QL + k] = (h16)(s * args.in[12][k]); }
        for (int idx = blockIdx.x * NTHR + F.tid; idx < DM * 2048; idx += F.G * NTHR) { const int d = idx >> 11, kx = idx & 2047, hd = kx >> 8, r = kx & 255;
            const float* pa = args.in[16] + (size_t)r * 512 + hd * 64; const float* pb = args.in[18] + (size_t)(hd * 64) * DM + d; float s = 0.f;
#pragma unroll 8
            for (int v = 0; v < 64; ++v) s += pa[v] * pb[(size_t)v * DM];
            ((h16*)(ws + OW_OV))[idx] = (h16)s; }
    }
    SEAM(0);
    if (IN(1)) ph_normmod(F, args.in[0], args.in[5], mod, 1, 0, Hb);
    SEAM(1);
    if (IN(2)) { pg8::Gemm g{Hb, (const h16*)(ws + OW_GU1), MT, 2 * FF, DM}; pg8::StaticOrder S; S.init(MT, 2 * FF, F.G, (int)blockIdx.x); pg8::EpiSwiGLU E{Ab};
        pg8::gemm_phase<pg8::EpiSwiGLU, true>(F.lds, g, S, E); }
    SEAM(2);
    if (IN(3)) { pg8::Gemm g{Ab, (const h16*)(ws + OW_D1), MT, DM, FF}; pg8::StaticOrder S; S.init(MT, DM, F.G, (int)blockIdx.x); pg8::EpiF32 E{Fb, DM};
        pg8::gemm_phase<pg8::EpiF32, false>(F.lds, g, S, E); }
    SEAM(3);
    if (IN(4)) ph_resnorm(F, args.in[0], Fb, args.in[9], mod, 2, 0.5f, args.out, true, args.in[10], 4, 3, Hb);
    SEAM(4);
    if (IN(5)) { pg8::Gemm g{Hb, (const h16*)(ws + OW_IN), MT, NIN3, DM}; pg8::StaticOrder S; S.init(MT, NIN3, F.G, (int)blockIdx.x);
        pg8::EpiIn E{(h16*)(ws + OFF_CKV), (h16*)(ws + OFF_CQ), (h16*)(ws + OFF_KR), (h16*)(ws + OFF_KI), (h16*)(ws + OFF_QB), (h16*)(ws + OFF_KB), (h16*)(ws + OFF_VT), (float*)(ws + OFF_WI), (float*)(ws + OFF_SSQ),
                     args.in[13], tab, (LAS float*)(F.lds + XCH_OFF)};
        pg8::gemm_phase<pg8::EpiIn, true>(F.lds, g, S, E); }
    SEAM(5);
    if (IN(6)) ph_dilated_simple(F, (const h16*)(ws + OFF_QB), (const h16*)(ws + OFF_KB), (const h16*)(ws + OFF_VT), (h16*)(ws + OFF_OG), (float*)(ws + OFF_LSE));
    SEAM(6);
    if (IN(7)) { pg8::Gemm g{(const h16*)(ws + OFF_CQ), (const h16*)(ws + OW_4), MT, N4, QL}; pg8::StaticOrder S; S.init(MT, N4, F.G, (int)blockIdx.x);
        pg8::Epi4 E{(h16*)(ws + OFF_QLAT), (h16*)(ws + OFF_QR), (h16*)(ws + OFF_QI), (const float*)(ws + OFF_SSQ), tab};
        pg8::gemm_phase<pg8::Epi4, true>(F.lds, g, S, E); }
    SEAM(7);
    if (IN(8)) { ph_combine(F, (const h16*)(ws + OFF_OG), (const float*)(ws + OFF_LSE), (h16*)(ws + OFF_OB));
        ph_topk_simple(F, (const h16*)(ws + OFF_QI), (const h16*)(ws + OFF_KI), (const float*)(ws + OFF_WI), (unsigned short*)(ws + OFF_SEL)); }
    SEAM(8);
    if (IN(9)) ph_sparse_mfma(F, (h16*)(ws + OFF_QLAT), (const h16*)(ws + OFF_QR), (const h16*)(ws + OFF_CKV), (const h16*)(ws + OFF_KR), (const unsigned short*)(ws + OFF_SEL));
    SEAM(9);
    if (IN(10)) { const int Z_PARTS = args.zparts; pg8::StaticOrder S; S.init(MT, DM, F.G, (int)blockIdx.x); h16* Y1 = (h16*)(ws + OFF_Y1); h16* Y2 = (h16*)(ws + OFF_Y2);
        if (Z_PARTS == 32) { pg8::Gemm g{Hb, (const h16*)(ws + OW_GATE) + (size_t)DM * DM, MT, DM, DM}; pg8::EpiH16 E{Y1}; pg8::gemm_phase<pg8::EpiH16, false>(F.lds, g, S, E); }
        else if (Z_PARTS == 8) { pg8::Gemm g{Hb, (const h16*)(ws + OW_GATE) + (size_t)DM * DM, MT, DM, DM}; pg8::EpiGate E{Y2, Y1, 0}; pg8::gemm_phase<pg8::EpiGate, false>(F.lds, g, S, E); }
        else if (Z_PARTS == 4) { pg8::Gemm g{(const h16*)(ws + OFF_OB), (const h16*)(ws + OW_UPB), MT, DM, 256}; pg8::EpiH16 E{Y1}; pg8::gemm_phase<pg8::EpiH16, false>(F.lds, g, S, E); }
        else {
        if (Z_PARTS & 1) {
        { pg8::Gemm g{(const h16*)(ws + OFF_QLAT), (const h16*)(ws + OW_OV), MT, DM, 2048}; pg8::EpiH16 E{Y1}; pg8::gemm_phase<pg8::EpiH16, false>(F.lds, g, S, E); }
        { pg8::Gemm g{Hb, (const h16*)(ws + OW_GATE), MT, DM, DM}; pg8::EpiGate E{Y1, Y1, 0}; pg8::gemm_phase<pg8::EpiGate, false>(F.lds, g, S, E); } }
        if (Z_PARTS & 2) {
        { pg8::Gemm g{(const h16*)(ws + OFF_OB), (const h16*)(ws + OW_UPB), MT, DM, 256}; pg8::EpiH16 E{Y2}; pg8::gemm_phase<pg8::EpiH16, false>(F.lds, g, S, E); }
        { pg8::Gemm g{Hb, (const h16*)(ws + OW_GATE) + (size_t)DM * DM, MT, DM, DM}; pg8::EpiGate E{Y2, Y1, (Z_PARTS & 1)}; pg8::gemm_phase<pg8::EpiGate, false>(F.lds, g, S, E); } } } }
    SEAM(10);
    if (IN(11)) { pg8::Gemm g{(const h16*)(ws + OFF_Y1), (const h16*)(ws + OW_O), MT, DM, DM}; pg8::StaticOrder S; S.init(MT, DM, F.G, (int)blockIdx.x); pg8::EpiF32 E{(float*)(ws + OFF_YF), DM};
        pg8::gemm_phase<pg8::EpiF32, false>(F.lds, g, S, E); }
    SEAM(11);
    if (IN(12)) ph_resnorm(F, args.out, (const float*)(ws + OFF_YF), args.in[21], mod, 5, 1.0f, args.out, true, args.in[22], 7, 6, Hb);
    SEAM(12);
    if (IN(13)) { pg8::Gemm g{Hb, (const h16*)(ws + OW_GU2), MT, 2 * FF, DM}; pg8::StaticOrder S; S.init(MT, 2 * FF, F.G, (int)blockIdx.x); pg8::EpiSwiGLU E{Ab};
        pg8::gemm_phase<pg8::EpiSwiGLU, true>(F.lds, g, S, E); }
    SEAM(13);
    if (IN(14)) { pg8::Gemm g{Ab, (const h16*)(ws + OW_D2), MT, DM, FF}; pg8::StaticOrder S; S.init(MT, DM, F.G, (int)blockIdx.x); pg8::EpiF32 E{Fb, DM};
        pg8::gemm_phase<pg8::EpiF32, false>(F.lds, g, S, E); }
    SEAM(14);
    if (IN(15)) ph_resnorm(F, args.out, Fb, args.in[26], mod, 8, 0.5f, args.out, false, nullptr, 0, 0, nullptr);
#undef IN
#undef SEAM
}


__global__ void n_stat_h16(const h16* p, size_t n, float* acc) {
    __shared__ float red[4];
    float a = 0.f, b = 0.f;
    for (size_t i = (size_t)blockIdx.x * 256 + threadIdx.x; i < n; i += (size_t)gridDim.x * 256) { const float v = (float)p[i]; const float w = (float)(((unsigned)(i * 2654435761u) >> 16) & 255u) * (1.f / 128.f) - 1.f; a += v * v; b += v * w; }
    a = block_sum256(a, red); b = block_sum256(b, red);
    if (threadIdx.x == 0) { atomicAdd(acc, a); atomicAdd(acc + 1, b); }
}
__global__ void n_tr(const float* W, int ldw, int N, int K, h16* WT) {
    const size_t idx = (size_t)blockIdx.x * 256 + threadIdx.x; if (idx >= (size_t)N * K) return;
    const int n = (int)(idx / K), k = (int)(idx % K); WT[idx] = (h16)W[(size_t)k * ldw + n];
}
__global__ void n_scale(float* out, const float* acc, float gain) {
    const size_t i = (size_t)blockIdx.x * 256 + threadIdx.x;
    const float d0 = fabsf(acc[0] - acc[2]) / fmaxf(fabsf(acc[2]), 1e-20f), d1 = fabsf(acc[1] - acc[3]) / fmaxf(sqrtf(fabsf(acc[2])), 1e-20f);
    const float d = fminf(fmaxf(d0, d1) * gain, 10.f);
    out[i] *= (1.f + d);
}
#ifndef FASTMASK
#define FASTMASK 0xFFFFu
#endif
extern "C" void kernel_launch(void* const* d_in, const int* in_sizes, int n_in, void* d_out, int out_size, void* d_ws, size_t ws_size, hipStream_t stream) {
    if (n_in != 27 || ws_size < WS_END || out_size != MT * DM) { fprintf(stderr, "kernel_launch: unexpected shapes (n_in %d ws %zu out %d)\n", n_in, ws_size, out_size); return; }
    static int grid = 0;
    if (grid == 0) {
        int dev = 0, cus = 0, per_cu = 0;
        if (hipGetDevice(&dev) != hipSuccess || hipDeviceGetAttribute(&cus, hipDeviceAttributeMultiprocessorCount, dev) != hipSuccess) { grid = -1; return; }
        if (hipFuncSetAttribute((const void*)mega_fwd, hipFuncAttributeMaxDynamicSharedMemorySize, LDS_BYTES) != hipSuccess) { fprintf(stderr, "kernel_launch: hipFuncSetAttribute failed\n"); grid = -1; return; }
        if (hipOccupancyMaxActiveBlocksPerMultiprocessor(&per_cu, (const void*)mega_fwd, NTHR, LDS_BYTES) != hipSuccess || per_cu < 1) { fprintf(stderr, "kernel_launch: occupancy query says %d blocks/CU\n", per_cu); grid = -1; return; }
        grid = cus;
    }
    if (grid < 0) return;
    const float* x = (const float*)d_in[0]; const float* c = (const float*)d_in[1]; const int* pos = (const int*)d_in[2];
    const float *w_mod = (const float*)d_in[3], *b_mod = (const float*)d_in[4], *g_pre1 = (const float*)d_in[5], *w_gate1 = (const float*)d_in[6], *w_up1 = (const float*)d_in[7], *w_down1 = (const float*)d_in[8],
                *g_post1 = (const float*)d_in[9], *g_premix = (const float*)d_in[10], *w_in = (const float*)d_in[11], *g_cq = (const float*)d_in[12], *g_ckv = (const float*)d_in[13], *w_uq = (const float*)d_in[14],
                *w_uk = (const float*)d_in[15], *w_uv = (const float*)d_in[16], *w_iq = (const float*)d_in[17], *w_up_a = (const float*)d_in[18], *w_up_b = (const float*)d_in[19], *w_o = (const float*)d_in[20],
                *g_postmix = (const float*)d_in[21], *g_pre2 = (const float*)d_in[22], *w_gate2 = (const float*)d_in[23], *w_up2 = (const float*)d_in[24], *w_down2 = (const float*)d_in[25], *g_post2 = (const float*)d_in[26];
    float* out = (float*)d_out; char* ws = (char*)d_ws;
    float* mod = (float*)(ws + OFF_MOD); float2* tab = (float2*)(ws + OFF_ROPE);
    h16* Hb = (h16*)(ws + OFF_H); h16* Ab = (h16*)(ws + OFF_A); float* Fb = (float*)(ws + OFF_F);
    h16 *qb = (h16*)(ws + OFF_QB), *kb = (h16*)(ws + OFF_KB), *vT = (h16*)(ws + OFF_VT), *ckv = (h16*)(ws + OFF_CKV), *kr = (h16*)(ws + OFF_KR), *ki = (h16*)(ws + OFF_KI), *cq = (h16*)(ws + OFF_CQ);
    float *wi = (float*)(ws + OFF_WI), *ssq = (float*)(ws + OFF_SSQ), *lse = (float*)(ws + OFF_LSE);
    h16 *og = (h16*)(ws + OFF_OG), *qlat = (h16*)(ws + OFF_QLAT), *qr = (h16*)(ws + OFF_QR), *qi = (h16*)(ws + OFF_QI), *ob = (h16*)(ws + OFF_OB);
    unsigned short* sel = (unsigned short*)(ws + OFF_SEL);
    float* Y = (float*)(ws + OFF_YF);
#define GEMM(TA, A, lda, B, ldb, bs, C, ldc, N, K) hipLaunchKernelGGL((n_gemm<TA>), dim3(((N) + 63) / 64, MT / 64), dim3(256), 0, stream, A, lda, B, ldb, bs, C, ldc, N, K)
    auto mega = [&](int lo, int hi, int zparts = 3) {
        hipMemsetAsync(ws + OFF_CTL, 0, 1 * MiB, stream);
        Args a{}; for (int i = 0; i < 27; ++i) a.in[i] = (const float*)d_in[i]; a.out = out; a.ws = (unsigned char*)d_ws; a.ph_lo = lo; a.ph_hi = hi; a.zparts = zparts;
        void* kargs[] = {&a};
        const hipError_t e = hipLaunchCooperativeKernel((const void*)mega_fwd, dim3(grid), dim3(NTHR), kargs, LDS_BYTES, stream);
        if (e != hipSuccess) fprintf(stderr, "kernel_launch: cooperative launch failed: %s (grid %d)\n", hipGetErrorString(e), grid);
    };
    auto naive = [&](int s, int Z_PARTS = 3) {
        switch (s) {
        case 0: hipLaunchKernelGGL(n_mod, dim3(NMOD * DM / 256, NB), dim3(256), 0, stream, c, w_mod, b_mod, mod);
                hipLaunchKernelGGL(n_rope_tab, dim3(MT * 48 / 256), dim3(256), 0, stream, pos, tab); break;
        case 1: hipLaunchKernelGGL(n_normmod, dim3(MT), dim3(256), 0, stream, x, g_pre1, mod, 1, 0, Hb); break;
        case 2: hipLaunchKernelGGL(n_gemm_swiglu, dim3(FF / 64, MT / 64), dim3(256), 0, stream, Hb, w_gate1, w_up1, Ab); break;
        case 3: GEMM(h16, Ab, FF, w_down1, DM, (const float*)nullptr, Fb, DM, DM, FF); break;
        case 4: hipLaunchKernelGGL(n_resnorm, dim3(MT), dim3(256), 0, stream, x, Fb, g_post1, mod, 2, 0.5f, out);
                hipLaunchKernelGGL(n_normmod, dim3(MT), dim3(256), 0, stream, out, g_premix, mod, 4, 3, Hb); break;
        case 5:
            GEMM(h16, Hb, DM, w_in + C_CQ, DIN, (const float*)nullptr, Fb, QL, QL, DM);
            hipLaunchKernelGGL(n_post_cq, dim3(MT / 4), dim3(256), 0, stream, Fb, cq, ssq);
            GEMM(h16, Hb, DM, w_in + C_CKV, DIN, (const float*)nullptr, Fb, KVL, KVL, DM);
            hipLaunchKernelGGL(n_post_ckv, dim3(MT / 4), dim3(256), 0, stream, Fb, g_ckv, ckv);
            GEMM(h16, Hb, DM, w_in + C_KR, DIN, (const float*)nullptr, Fb, 72, 72, DM);
            hipLaunchKernelGGL(n_post_small, dim3(MT * 40 / 256), dim3(256), 0, stream, Fb, tab, kr, ki, wi);
            GEMM(h16, Hb, DM, w_in + C_QKV, DIN, (const float*)nullptr, Fb, 768, 768, DM);
            hipLaunchKernelGGL(n_post_qk, dim3(MT * 384 / 256), dim3(256), 0, stream, Fb, tab, 0.125f * LOG2E, qb);
            GEMM(h16, Hb, DM, w_in + C_QKV + 768, DIN, (const float*)nullptr, Fb, 768, 768, DM);
            hipLaunchKernelGGL(n_post_qk, dim3(MT * 384 / 256), dim3(256), 0, stream, Fb, tab, 1.0f, kb);
            GEMM(h16, Hb, DM, w_in + C_QKV + 1536, DIN, (const float*)nullptr, Fb, 768, 768, DM);
            hipLaunchKernelGGL(n_post_v, dim3(MT * 768 / 256), dim3(256), 0, stream, Fb, vT); break;
        case 6: hipLaunchKernelGGL(n_dilated, dim3(MT, 12), dim3(128), 0, stream, qb, kb, vT, og, lse); break;
        case 7: { float* Tq = (float*)(ws + OFF_F + 33 * MiB);
            for (int hh = 0; hh < 2; ++hh) {
                GEMM(h16, cq, QL, w_uq + hh * 384, 768, g_cq, Tq, 384, 384, QL);
                hipLaunchKernelGGL(n_post_q, dim3(MT), dim3(256), 0, stream, Tq, ssq, w_uk, tab, qlat, qr, hh * 4); }
            GEMM(h16, cq, QL, w_iq, 256, g_cq, Tq, 256, 256, QL);
            hipLaunchKernelGGL(n_post_qi, dim3(MT * 128 / 256), dim3(256), 0, stream, Tq, ssq, tab, qi); } break;
        case 8: hipLaunchKernelGGL(n_topk, dim3(MT), dim3(256), 0, stream, qi, ki, wi, sel);
                hipLaunchKernelGGL(n_combine, dim3(MT), dim3(256), 0, stream, og, lse, ob); break;
        case 9: hipLaunchKernelGGL(n_sparse, dim3(MT), dim3(256), 0, stream, qlat, qr, ckv, kr, sel); break;
        case 10: { h16* oa = (h16*)(ws + OFF_Y2 + 16 * MiB);
            hipLaunchKernelGGL(n_oa, dim3(MT), dim3(256), 0, stream, qlat, w_uv, oa);
            h16* z = (h16*)(ws + OFF_Y1); float* Tg = (float*)(ws + OFF_A + 64 * MiB); float* Ty = (float*)(ws + OFF_F + 32 * MiB);
            for (int q = 0; q < 4; ++q) { const int n0 = q * 256;
                if (Z_PARTS == 4) { GEMM(h16, ob, 256, w_up_b + n0, DM, (const float*)nullptr, Ty, 256, 256, 256);
                    hipLaunchKernelGGL(n_gate, dim3(MT * 256 / 256), dim3(256), 0, stream, Ty, Ty, z, n0, 2); continue; }
                if (Z_PARTS & 1) {
                GEMM(h16, Hb, DM, w_in + C_GATE + n0, DIN, (const float*)nullptr, Tg, 256, 256, DM);
                GEMM(h16, oa, 512, w_up_a + n0, DM, (const float*)nullptr, Ty, 256, 256, 512);
                hipLaunchKernelGGL(n_gate, dim3(MT * 256 / 256), dim3(256), 0, stream, Tg, Ty, z, n0, 0); }
                if (Z_PARTS & 2) {
                GEMM(h16, Hb, DM, w_in + C_GATE + 1024 + n0, DIN, (const float*)nullptr, Tg, 256, 256, DM);
                GEMM(h16, ob, 256, w_up_b + n0, DM, (const float*)nullptr, Ty, 256, 256, 256);
                hipLaunchKernelGGL(n_gate, dim3(MT * 256 / 256), dim3(256), 0, stream, Tg, Ty, z, n0, (Z_PARTS & 1)); } } } break;
        case 11: GEMM(h16, (h16*)(ws + OFF_Y1), DM, w_o, DM, (const float*)nullptr, Y, DM, DM, DM); break;
        case 12: hipLaunchKernelGGL(n_resnorm, dim3(MT), dim3(256), 0, stream, out, Y, g_postmix, mod, 5, 1.0f, out);
                 hipLaunchKernelGGL(n_normmod, dim3(MT), dim3(256), 0, stream, out, g_pre2, mod, 7, 6, Hb); break;
        case 13: hipLaunchKernelGGL(n_gemm_swiglu, dim3(FF / 64, MT / 64), dim3(256), 0, stream, Hb, w_gate2, w_up2, Ab); break;
        case 14: GEMM(h16, Ab, FF, w_down2, DM, (const float*)nullptr, Fb, DM, DM, FF); break;
        case 15: hipLaunchKernelGGL(n_resnorm, dim3(MT), dim3(256), 0, stream, out, Fb, g_post2, mod, 8, 0.5f, out); break;
        }
    };
#ifdef DBG_W
    { float* dacc = (float*)(ws + OFF_MOD + 512 * 1024);
      hipMemsetAsync(dacc, 0, 16, stream);
      mega(0, 1);
      hipLaunchKernelGGL(n_stat_h16, dim3(2048), dim3(256), 0, stream, (const h16*)(ws + OW_GATE), (size_t)2048 * DM, dacc);
      hipLaunchKernelGGL(n_stat_h16, dim3(2048), dim3(256), 0, stream, (const h16*)(ws + OW_UPB), (size_t)DM * 256, dacc);
      hipLaunchKernelGGL(n_tr, dim3(2048 * DM / 256), dim3(256), 0, stream, w_in + C_GATE, DIN, 2048, DM, (h16*)(ws + OW_GATE));
      hipLaunchKernelGGL(n_tr, dim3(DM * 256 / 256), dim3(256), 0, stream, w_up_b, DM, DM, 256, (h16*)(ws + OW_UPB));
      hipLaunchKernelGGL(n_stat_h16, dim3(2048), dim3(256), 0, stream, (const h16*)(ws + OW_GATE), (size_t)2048 * DM, dacc + 2);
      hipLaunchKernelGGL(n_stat_h16, dim3(2048), dim3(256), 0, stream, (const h16*)(ws + OW_UPB), (size_t)DM * 256, dacc + 2);
      for (int s = 0; s < 16; ++s) naive(s);
      hipLaunchKernelGGL(n_scale, dim3(MT * DM / 256), dim3(256), 0, stream, out, dacc, 1.0f); }
#elif defined(DBG_STAGE)
    float* dacc = (float*)(ws + OFF_MOD + 512 * 1024);
    for (int s = 0; s < 16;) {
        if (s == DBG_STAGE) {
            hipMemsetAsync(dacc, 0, 16, stream);
            if (DBG_PARTS == 8) naive(s, 16);
            mega(s, s + 1, DBG_PARTS); hipLaunchKernelGGL(n_stat_h16, dim3(2048), dim3(256), 0, stream, (const h16*)(ws + DBG_OFF), (size_t)DBG_N, dacc);
            naive(s, DBG_PARTS == 8 ? 2 : DBG_PARTS);       hipLaunchKernelGGL(n_stat_h16, dim3(2048), dim3(256), 0, stream, (const h16*)(ws + DBG_OFF), (size_t)DBG_N, dacc + 2);
            if (DBG_PARTS != 3) naive(s);
            ++s; continue; }
        if ((FASTMASK >> s) & 1u) { int e = s; while (e < 16 && e != DBG_STAGE && ((FASTMASK >> e) & 1u)) ++e; mega(s, e); s = e; }
        else { naive(s); ++s; }
    }
    hipLaunchKernelGGL(n_scale, dim3(MT * DM / 256), dim3(256), 0, stream, out, dacc, DBG_GAIN);
#else
    for (int s = 0; s < 16;) {
        if ((FASTMASK >> s) & 1u) { int e = s; while (e < 16 && ((FASTMASK >> e) & 1u)) ++e; mega(s, e); s = e; }
        else { naive(s); ++s; }
    }
#endif
    (void)in_sizes;
}
```

```cpp
#include <hip/hip_runtime.h>
#include <hip/hip_fp16.h>
#include <cstdio>
#include <cstdint>
#define DBG_NOGATE 0

constexpr int NB = 4, SEQ = 4096, DM = 1024, MT = NB * SEQ, FF = 2816;
constexpr int QL = 384, KVL = 256, DNOPE = 64, DROPE = 32, DVA = 64, HA = 8, HI = 8, DI = 32, TOPK = 256;
constexpr int NG = 3, HB = 4, DHB = 64, NMOD = 9, DIN = 5064;
constexpr int C_CQ = 0, C_CKV = 384, C_KR = 640, C_KI = 672, C_WI = 704, C_QKV = 712, C_GATE = 3016;
constexpr float EPS = 1e-6f, LOG2E = 1.4426950408889634f;
typedef _Float16 h16;

constexpr size_t MiB = 1u << 20;
constexpr size_t OFF_CTL = 0, OFF_MOD = 1 * MiB, OFF_ROPE = 2 * MiB, OFF_W = 8 * MiB, OFF_H = 60 * MiB, OFF_A = 92 * MiB, OFF_F = 180 * MiB, OFF_SP = 244 * MiB, WS_END = 256 * MiB;
constexpr size_t OFF_QB = OFF_A, OFF_KB = OFF_A + 24 * MiB, OFF_VT = OFF_A + 48 * MiB, OFF_CKV = OFF_A + 72 * MiB, OFF_KR = OFF_A + 80 * MiB, OFF_KI = OFF_A + 81 * MiB,
                 OFF_WI = OFF_A + 82 * MiB, OFF_SSQ = OFF_A + 82 * MiB + 512 * 1024, OFF_CQ = OFF_SP;
constexpr size_t OFF_OG = OFF_F, OFF_LSE = OFF_F + 24 * MiB, OFF_QLAT = OFF_A, OFF_QR = OFF_A + 64 * MiB, OFF_QI = OFF_F + 25 * MiB, OFF_SEL = OFF_F + 33 * MiB, OFF_OB = OFF_SP;
constexpr size_t OFF_Y1 = OFF_F, OFF_Y2 = OFF_F + 32 * MiB, OFF_YF = OFF_A;

__device__ __forceinline__ float silu_f(float v) { return v / (1.f + __expf(-v)); }
__device__ __forceinline__ float sigm_f(float v) { return 1.f / (1.f + __expf(-v)); }
__device__ __forceinline__ float block_sum256(float v, float* red) {
#pragma unroll
    for (int o = 32; o > 0; o >>= 1) v += __shfl_xor(v, o);
    __syncthreads();
    if ((threadIdx.x & 63) == 0) red[threadIdx.x >> 6] = v;
    __syncthreads();
    return red[0] + red[1] + red[2] + red[3];
}
__device__ __forceinline__ float block_max256(float v, float* red) {
#pragma unroll
    for (int o = 32; o > 0; o >>= 1) v = fmaxf(v, __shfl_xor(v, o));
    __syncthreads();
    if ((threadIdx.x & 63) == 0) red[threadIdx.x >> 6] = v;
    __syncthreads();
    return fmaxf(fmaxf(red[0], red[1]), fmaxf(red[2], red[3]));
}

__global__ void n_mod(const float* c, const float* w_mod, const float* b_mod, float* mod) {
    const int j = blockIdx.x * 256 + threadIdx.x, b = blockIdx.y;
    float acc = b_mod[j];
    for (int k = 0; k < DM; ++k) acc += silu_f(c[b * DM + k]) * w_mod[(size_t)k * (NMOD * DM) + j];
    mod[b * (NMOD * DM) + j] = acc;
}
__global__ void n_rope_tab(const int* pos, float2* tab) {
    const int idx = blockIdx.x * 256 + threadIdx.x; if (idx >= MT * 48) return;
    const int tok = idx / 48, i = idx % 48;
    const float inv = (i < 32) ? powf(10000.f, -(float)i / 32.f) : powf(10000.f, -(float)(i - 32) / 16.f);
    const float ang = (float)pos[tok] * inv;
    tab[idx] = make_float2(cosf(ang), sinf(ang));
}
__global__ void n_normmod(const float* x, const float* g, const float* mod, int isc, int ish, h16* out) {
    __shared__ float red[4];
    const int row = blockIdx.x, b = row / SEQ, t = threadIdx.x;
    const float4 v = ((const float4*)(x + (size_t)row * DM))[t];
    const float ss = block_sum256(v.x * v.x + v.y * v.y + v.z * v.z + v.w * v.w, red);
    const float rstd = rsqrtf(ss * (1.f / DM) + EPS);
    const float* sc = mod + b * (NMOD * DM) + isc * DM; const float* sh = mod + b * (NMOD * DM) + ish * DM;
    const float vv[4] = {v.x, v.y, v.z, v.w};
#pragma unroll
    for (int e = 0; e < 4; ++e) { const int cidx = 4 * t + e; out[(size_t)row * DM + cidx] = (h16)(vv[e] * rstd * g[cidx] * (1.f + sc[cidx]) + sh[cidx]); }
}
__global__ void n_resnorm(const float* xin, const float* f, const float* g, const float* mod, int igt, float coef, float* xout) {
    __shared__ float red[4];
    const int row = blockIdx.x, b = row / SEQ, t = threadIdx.x;
    const float4 v = ((const float4*)(f + (size_t)row * DM))[t];
    const float ss = block_sum256(v.x * v.x + v.y * v.y + v.z * v.z + v.w * v.w, red);
    const float rstd = rsqrtf(ss * (1.f / DM) + EPS);
    const float* gt = mod + b * (NMOD * DM) + igt * DM;
    const float4 xi = ((const float4*)(xin + (size_t)row * DM))[t];
    const float vv[4] = {v.x, v.y, v.z, v.w}, xx[4] = {xi.x, xi.y, xi.z, xi.w};
    float o[4];
#pragma unroll
    for (int e = 0; e < 4; ++e) { const int cidx = 4 * t + e; o[e] = xx[e] + coef * gt[cidx] * vv[e] * rstd * g[cidx]; }
    ((float4*)(xout + (size_t)row * DM))[t] = make_float4(o[0], o[1], o[2], o[3]);
}
template <typename TA>
__global__ void __launch_bounds__(256) n_gemm(const TA* A, int lda, const float* B, int ldb, const float* bs, float* C, int ldc, int N, int K) {
    __shared__ float As[16][65], Bs[16][65];
    const int tx = threadIdx.x & 15, ty = threadIdx.x >> 4, m0 = blockIdx.y * 64, n0 = blockIdx.x * 64;
    float acc[4][4] = {};
    for (int k0 = 0; k0 < K; k0 += 16) {
        for (int i = threadIdx.x; i < 1024; i += 256) { const int r = i >> 4, kk = i & 15; As[kk][r] = (float)A[(size_t)(m0 + r) * lda + k0 + kk]; }
        for (int i = threadIdx.x; i < 1024; i += 256) { const int kk = i >> 6, cc = i & 63; const int n = n0 + cc; Bs[kk][cc] = (n < N) ? B[(size_t)(k0 + kk) * ldb + n] * (bs ? bs[k0 + kk] : 1.f) : 0.f; }
        __syncthreads();
#pragma unroll
        for (int kk = 0; kk < 16; ++kk) {
            float a[4], b[4];
#pragma unroll
            for (int i = 0; i < 4; ++i) { a[i] = As[kk][ty * 4 + i]; b[i] = Bs[kk][tx * 4 + i]; }
#pragma unroll
            for (int i = 0; i < 4; ++i)
#pragma unroll
                for (int j = 0; j < 4; ++j) acc[i][j] += a[i] * b[j];
        }
        __syncthreads();
    }
#pragma unroll
    for (int i = 0; i < 4; ++i)
#pragma unroll
        for (int j = 0; j < 4; ++j) { const int n = n0 + tx * 4 + j; if (n < N) C[(size_t)(m0 + ty * 4 + i) * ldc + n] = acc[i][j]; }
}
__global__ void __launch_bounds__(256) n_gemm_swiglu(const h16* A, const float* Wg, const float* Wu, h16* out) {
    __shared__ float As[16][65], Bg[16][65], Bu[16][65];
    const int tx = threadIdx.x & 15, ty = threadIdx.x >> 4, m0 = blockIdx.y * 64, n0 = blockIdx.x * 64;
    float ag[4][4] = {}, au[4][4] = {};
    for (int k0 = 0; k0 < DM; k0 += 16) {
        for (int i = threadIdx.x; i < 1024; i += 256) { const int r = i >> 4, kk = i & 15; As[kk][r] = (float)A[(size_t)(m0 + r) * DM + k0 + kk]; }
        for (int i = threadIdx.x; i < 1024; i += 256) { const int kk = i >> 6, cc = i & 63; Bg[kk][cc] = Wg[(size_t)(k0 + kk) * FF + n0 + cc]; Bu[kk][cc] = Wu[(size_t)(k0 + kk) * FF + n0 + cc]; }
        __syncthreads();
#pragma unroll
        for (int kk = 0; kk < 16; ++kk) {
            float a[4], g[4], u[4];
#pragma unroll
            for (int i = 0; i < 4; ++i) { a[i] = As[kk][ty * 4 + i]; g[i] = Bg[kk][tx * 4 + i]; u[i] = Bu[kk][tx * 4 + i]; }
#pragma unroll
            for (int i = 0; i < 4; ++i)
#pragma unroll
                for (int j = 0; j < 4; ++j) { ag[i][j] += a[i] * g[j]; au[i][j] += a[i] * u[j]; }
        }
        __syncthreads();
    }
#pragma unroll
    for (int i = 0; i < 4; ++i)
#pragma unroll
        for (int j = 0; j < 4; ++j) out[(size_t)(m0 + ty * 4 + i) * FF + n0 + tx * 4 + j] = (h16)(silu_f(ag[i][j]) * au[i][j]);
}
__global__ void n_post_cq(const float* tmp, h16* cq, float* ssq) {
    const int tok = blockIdx.x * 4 + (threadIdx.x >> 6), lane = threadIdx.x & 63;
    float s = 0.f;
    for (int i = lane; i < QL; i += 64) { const float v = tmp[(size_t)tok * QL + i]; s += v * v; cq[(size_t)tok * QL + i] = (h16)v; }
#pragma unroll
    for (int o = 32; o > 0; o >>= 1) s += __shfl_xor(s, o);
    if (lane < 8) ssq[tok * 8 + lane] = (lane == 0) ? s : 0.f;
}
__global__ void n_post_ckv(const float* tmp, const float* g, h16* ckv) {
    const int tok = blockIdx.x * 4 + (threadIdx.x >> 6), lane = threadIdx.x & 63;
    float v[4], s = 0.f;
#pragma unroll
    for (int e = 0; e < 4; ++e) { v[e] = tmp[(size_t)tok * KVL + lane + 64 * e]; s += v[e] * v[e]; }
#pragma unroll
    for (int o = 32; o > 0; o >>= 1) s += __shfl_xor(s, o);
    const float rstd = rsqrtf(s * (1.f / KVL) + EPS);
#pragma unroll
    for (int e = 0; e < 4; ++e) ckv[(size_t)tok * KVL + lane + 64 * e] = (h16)(v[e] * rstd * g[lane + 64 * e]);
}
__global__ void n_post_small(const float* tmp, const float2* tab, h16* kr, h16* ki, float* wi) {
    const int idx = blockIdx.x * 256 + threadIdx.x; if (idx >= MT * 40) return;
    const int tok = idx / 40, j = idx % 40; const float* r = tmp + (size_t)tok * 72;
    if (j < 32) { const int which = j >> 4, i = j & 15; const float2 cs = tab[tok * 48 + 32 + i]; const float x1 = r[which * 32 + i], x2 = r[which * 32 + 16 + i];
        h16* o = (which ? ki : kr) + (size_t)tok * 32; o[i] = (h16)(x1 * cs.x - x2 * cs.y); o[i + 16] = (h16)(x2 * cs.x + x1 * cs.y); }
    else wi[tok * 8 + (j - 32)] = r[64 + (j - 32)] * 0.35355339059327373f;
}
__global__ void n_post_qk(const float* tmp, const float2* tab, float scale, h16* out) {
    const int idx = blockIdx.x * 256 + threadIdx.x; if (idx >= MT * 384) return;
    const int tok = idx / 384, j = idx % 384, hd = j >> 5, i = j & 31;
    const float2 cs = tab[tok * 48 + i]; const float x1 = tmp[(size_t)tok * 768 + hd * 64 + i], x2 = tmp[(size_t)tok * 768 + hd * 64 + 32 + i];
    out[(size_t)tok * 768 + hd * 64 + i] = (h16)((x1 * cs.x - x2 * cs.y) * scale); out[(size_t)tok * 768 + hd * 64 + 32 + i] = (h16)((x2 * cs.x + x1 * cs.y) * scale);
}
__host__ __device__ __forceinline__ int dil_of(int g) { return g == 0 ? 1 : (g == 1 ? 4 : 16); }
__global__ void n_post_v(const float* tmp, h16* vb) {
    const int idx = blockIdx.x * 256 + threadIdx.x; if (idx >= MT * 768) return;
    vb[idx] = (h16)tmp[idx];
}
__global__ void __launch_bounds__(256) n_post_q(const float* tmp, const float* ssq, const float* w_uk, const float2* tab, h16* qlat, h16* qr, int h0) {
    __shared__ float q[384];
    const int tok = blockIdx.x, t = threadIdx.x;
    float s = 0.f; for (int i = 0; i < 8; ++i) s += ssq[tok * 8 + i];
    const float rstd = rsqrtf(s * (1.f / QL) + EPS), c2 = 0.10206207261596575f * LOG2E;
    for (int i = t; i < 384; i += 256) q[i] = tmp[(size_t)tok * 384 + i] * rstd;
    __syncthreads();
    if (t < 64) { const int hl = t >> 4, i = t & 15, hd = h0 + hl; const float2 cs = tab[tok * 48 + 32 + i]; const float x1 = q[hl * 96 + 64 + i], x2 = q[hl * 96 + 80 + i];
        qr[(size_t)tok * 256 + hd * 32 + i] = (h16)((x1 * cs.x - x2 * cs.y) * c2); qr[(size_t)tok * 256 + hd * 32 + 16 + i] = (h16)((x2 * cs.x + x1 * cs.y) * c2); }
    for (int hl = 0; hl < 4; ++hl) { const int hd = h0 + hl; float a = 0.f; const float* w = w_uk + (size_t)t * 512 + hd * 64;
        for (int n = 0; n < 64; ++n) a += q[hl * 96 + n] * w[n];
        qlat[(size_t)tok * 2048 + hd * 256 + t] = (h16)(a * c2); }
}
__global__ void n_post_qi(const float* tmp, const float* ssq, const float2* tab, h16* qi) {
    const int idx = blockIdx.x * 256 + threadIdx.x; if (idx >= MT * 128) return;
    const int tok = idx / 128, j = idx % 128, hd = j >> 4, i = j & 15;
    float s = 0.f; for (int e = 0; e < 8; ++e) s += ssq[tok * 8 + e];
    const float rstd = rsqrtf(s * (1.f / QL) + EPS);
    const float2 cs = tab[tok * 48 + 32 + i]; const float x1 = tmp[(size_t)tok * 256 + hd * 32 + i] * rstd, x2 = tmp[(size_t)tok * 256 + hd * 32 + 16 + i] * rstd;
    qi[(size_t)tok * 256 + hd * 32 + i] = (h16)(x1 * cs.x - x2 * cs.y); qi[(size_t)tok * 256 + hd * 32 + 16 + i] = (h16)(x2 * cs.x + x1 * cs.y);
}
__device__ __forceinline__ unsigned fkey(float f) { const unsigned u = __float_as_uint(f); return (u & 0x80000000u) ? ~u : (u | 0x80000000u); }
__global__ void __launch_bounds__(256) n_topk(const h16* qi, const h16* ki, const float* wi, unsigned short* sel) {
    __shared__ unsigned key[SEQ]; __shared__ float q[256]; __shared__ float w[8]; __shared__ unsigned cnt;
    const int tok = blockIdx.x, b = tok / SEQ, t = tok % SEQ, tid = threadIdx.x;
    unsigned short* so = sel + (size_t)tok * TOPK;
    if (t < TOPK) { so[tid] = (unsigned short)(tid <= t ? tid : 0); return; }
    q[tid] = (float)qi[(size_t)tok * 256 + tid]; if (tid < 8) w[tid] = wi[tok * 8 + tid];
    __syncthreads();
    const int n = t + 1;
#pragma unroll 1
    for (int s = tid; s < n; s += 256) {
        const h16* kp = ki + (size_t)(b * SEQ + s) * 32;
        float a[8];
#pragma unroll
        for (int hd = 0; hd < 8; ++hd) a[hd] = 0.f;
#pragma unroll 4
        for (int e = 0; e < 32; ++e) { const float kv = (float)kp[e];
#pragma unroll
            for (int hd = 0; hd < 8; ++hd) a[hd] += q[hd * 32 + e] * kv; }
        float sc = 0.f;
#pragma unroll
        for (int hd = 0; hd < 8; ++hd) sc += w[hd] * fmaxf(a[hd] * 0.17677669529663687f, 0.f);
        key[s] = fkey(sc);
    }
    __syncthreads();
    unsigned T = 0;
    for (int bit = 31; bit >= 0; --bit) {
        const unsigned cand = T | (1u << bit);
        if (tid == 0) cnt = 0; __syncthreads();
        unsigned c = 0; for (int s = tid; s < n; s += 256) c += (key[s] >= cand) ? 1u : 0u;
#pragma unroll
        for (int o = 32; o > 0; o >>= 1) c += __shfl_xor(c, o);
        if ((tid & 63) == 0) atomicAdd(&cnt, c);
        __syncthreads();
        if (cnt >= TOPK) T = cand;
        __syncthreads();
    }
    if (tid == 0) cnt = 0; __syncthreads();
    for (int s = tid; s < n; s += 256) if (key[s] > T) { const unsigned p = atomicAdd(&cnt, 1u); so[p] = (unsigned short)s; }
    __syncthreads();
    if (tid == 0) { unsigned p = cnt; for (int s = 0; s < n && p < TOPK; ++s) if (key[s] == T) so[p++] = (unsigned short)s; }
}
__global__ void __launch_bounds__(256) n_sparse(h16* qlat, const h16* qr, const h16* ckv, const h16* kr, const unsigned short* sel) {
    __shared__ float ql[8][256], qrr[8][32], p[8][256], red[4]; __shared__ int rows[256];
    const int tok = blockIdx.x, b = tok / SEQ, t = tok % SEQ, tid = threadIdx.x, cnt = (t + 1 < TOPK) ? t + 1 : TOPK;
    for (int i = tid; i < 2048; i += 256) ql[i >> 8][i & 255] = (float)qlat[(size_t)tok * 2048 + i];
    qrr[tid >> 5][tid & 31] = (float)qr[(size_t)tok * 256 + tid];
    const int row = b * SEQ + (tid < cnt ? (int)sel[(size_t)tok * TOPK + tid] : 0); rows[tid] = row;
    __syncthreads();
    float s[8];
#pragma unroll
    for (int hd = 0; hd < 8; ++hd) s[hd] = 0.f;
    if (tid < cnt) {
        const h16* kp = ckv + (size_t)row * 256;
        for (int r = 0; r < 256; ++r) { const float kvv = (float)kp[r];
#pragma unroll
            for (int hd = 0; hd < 8; ++hd) s[hd] += ql[hd][r] * kvv; }
        const h16* rp = kr + (size_t)row * 32;
        for (int e = 0; e < 32; ++e) { const float kvv = (float)rp[e];
#pragma unroll
            for (int hd = 0; hd < 8; ++hd) s[hd] += qrr[hd][e] * kvv; }
    } else {
#pragma unroll
        for (int hd = 0; hd < 8; ++hd) s[hd] = -INFINITY;
    }
    float linv[8];
#pragma unroll
    for (int hd = 0; hd < 8; ++hd) {
        const float m = block_max256(s[hd], red);
        const float e = (tid < cnt) ? exp2f(s[hd] - m) : 0.f;
        p[hd][tid] = e;
        linv[hd] = 1.f / block_sum256(e, red);
    }
    __syncthreads();
    float o[8];
#pragma unroll
    for (int hd = 0; hd < 8; ++hd) o[hd] = 0.f;
    for (int k = 0; k < cnt; ++k) { const float v = (float)ckv[(size_t)rows[k] * 256 + tid];
#pragma unroll
        for (int hd = 0; hd < 8; ++hd) o[hd] += p[hd][k] * v; }
#pragma unroll
    for (int hd = 0; hd < 8; ++hd) qlat[(size_t)tok * 2048 + hd * 256 + tid] = (h16)(o[hd] * linv[hd]);
}
__global__ void __launch_bounds__(128) n_dilated(const h16* qb, const h16* kb, const h16* vT, h16* og, float* lse2) {
    __shared__ float q[64], p[132], red[2]; __shared__ int kidx[132];
    const int tok = blockIdx.x, gh = blockIdx.y, g = gh >> 2, b = tok / SEQ, t = tok % SEQ, tid = threadIdx.x, dil = dil_of(g);
    if (tid < 64) q[tid] = (float)qb[(size_t)tok * 768 + gh * 64 + tid];
    __syncthreads();
    float sc[2]; float m = -INFINITY;
    for (int r = 0; r < 2; ++r) { const int k = tid + r * 128; sc[r] = -INFINITY;
        if (k < 129) { const int ti = t - k * dil; kidx[k] = ti;
            if (ti >= 0) { const h16* kp = kb + (size_t)(b * SEQ + ti) * 768 + gh * 64; float a = 0.f; for (int d = 0; d < 64; ++d) a += q[d] * (float)kp[d]; sc[r] = a; } }
        m = fmaxf(m, sc[r]); }
#pragma unroll
    for (int o = 32; o > 0; o >>= 1) m = fmaxf(m, __shfl_xor(m, o));
    if ((tid & 63) == 0) red[tid >> 6] = m; __syncthreads(); m = fmaxf(red[0], red[1]); __syncthreads();
    float l = 0.f;
    for (int r = 0; r < 2; ++r) { const int k = tid + r * 128; if (k < 129) { const float e = (sc[r] == -INFINITY) ? 0.f : exp2f(sc[r] - m); p[k] = e; l += e; } }
#pragma unroll
    for (int o = 32; o > 0; o >>= 1) l += __shfl_xor(l, o);
    if ((tid & 63) == 0) red[tid >> 6] = l; __syncthreads(); l = red[0] + red[1];
    if (tid < 64) { float a = 0.f; const h16* vp = vT + (size_t)(b * SEQ) * 768 + gh * 64 + tid;
        for (int k = 0; k < 129; ++k) { const int ti = kidx[k]; if (ti >= 0) a += p[k] * (float)vp[(size_t)ti * 768]; }
        og[(size_t)tok * 768 + gh * 64 + tid] = (h16)(a / l); }
    if (tid == 0) lse2[tok * 12 + gh] = m + log2f(l);
}
__global__ void n_combine(const h16* og, const float* lse2, h16* ob) {
    const int idx = blockIdx.x * 256 + threadIdx.x; if (idx >= MT * 256) return;
    const int tok = idx >> 8, c = idx & 255, hh = c >> 6;
    const float l0 = lse2[tok * 12 + hh], l1 = lse2[tok * 12 + 4 + hh], l2 = lse2[tok * 12 + 8 + hh], m = fmaxf(l0, fmaxf(l1, l2));
    const float w0 = exp2f(l0 - m), w1 = exp2f(l1 - m), w2 = exp2f(l2 - m), inv = 1.f / (w0 + w1 + w2);
    ob[idx] = (h16)((w0 * (float)og[(size_t)tok * 768 + c] + w1 * (float)og[(size_t)tok * 768 + 256 + c] + w2 * (float)og[(size_t)tok * 768 + 512 + c]) * inv);
}
__global__ void __launch_bounds__(256) n_oa(const h16* olat, const float* w_uv, h16* oa) {
    __shared__ float ol[2048];
    const int tok = blockIdx.x, tid = threadIdx.x;
    for (int i = tid; i < 2048; i += 256) ol[i] = (float)olat[(size_t)tok * 2048 + i];
    __syncthreads();
    for (int o = tid; o < 512; o += 256) { const int hd = o >> 6; float a = 0.f; for (int r = 0; r < 256; ++r) a += ol[hd * 256 + r] * w_uv[(size_t)r * 512 + o]; oa[(size_t)tok * 512 + o] = (h16)a; }
}
__global__ void n_gate(const float* tg, const float* ty, h16* z, int n0, int accum) {
    const size_t idx = (size_t)blockIdx.x * 256 + threadIdx.x; const size_t row = idx >> 8; const int col = (int)(idx & 255);
    h16* zp = z + row * DM + n0 + col;
    const float v = (accum == 2) ? ty[idx] : (sigm_f(tg[idx]) * ty[idx] + (accum ? (float)*zp : 0.f));
    *zp = (h16)v;
}
__global__ void n_f32_to_f16(const float* a, h16* o) { const size_t idx = (size_t)blockIdx.x * 256 + threadIdx.x; o[idx] = (h16)a[idx]; }


#define LAS __attribute__((address_space(3)))
#define GAS __attribute__((address_space(1)))
typedef _Float16 f16x8 __attribute__((ext_vector_type(8)));
typedef float f32x4 __attribute__((ext_vector_type(4)));
typedef float f32x2 __attribute__((ext_vector_type(2)));
typedef unsigned u32x4 __attribute__((ext_vector_type(4)));
typedef unsigned u32x2 __attribute__((ext_vector_type(2)));
typedef _Float16 h16x2 __attribute__((ext_vector_type(2)));
__device__ __forceinline__ unsigned pk_h2(float lo, float hi) { f32x2 v = {lo, hi}; h16x2 h = __builtin_convertvector(v, h16x2); return __builtin_bit_cast(unsigned, h); }

namespace pg8 {
constexpr int BM = 256, BK = 64, HALF = 128, HTB = HALF * BK * 2, STAGE_BYTES = 8 * HTB, NXCD = 8, WGM = 8;
__host__ __device__ __forceinline__ int lds_byte(int r, int c) { const int st = (r >> 4) * 2 + (c >> 5), rr = r & 15, cc = c & 31, ob = rr * 64 + cc * 2; return st * 1024 + (ob ^ (((ob >> 9) & 1) << 5)); }
__host__ __device__ __forceinline__ void stage_rc(int b, int& R, int& C) { const int st = b / 1024, sb = b % 1024, swz = sb ^ (((sb >> 9) & 1) << 5); R = (st >> 1) * 16 + swz / 64; C = (st & 1) * 32 + (swz % 64) / 2; }
__host__ __device__ __forceinline__ int perm32(int rho) { const int n = rho >> 4, i = rho & 15; return 8 * (i >> 2) + 4 * n + (i & 3); }
struct Unit { int pm, pn; };
struct Gemm { const h16* A; const h16* Bt; int M, N, K; };
struct StaticOrder {
    int nM, nN, nwg, G, c;
    __host__ __device__ void init(int M, int N, int G_, int c_) { nM = M / BM; nN = N / BM; nwg = nM * nN; G = G_; c = c_; }
    __host__ __device__ bool next(int i, Unit& u) const {
        const long L = (long)i * G + c; if (L >= nwg) return false;
        int wgid = (int)L; { const int q = nwg / NXCD, r = nwg % NXCD, xcd = wgid % NXCD, off = wgid / NXCD; wgid = (xcd < r ? xcd * (q + 1) : r * (q + 1) + (xcd - r) * q) + off; }
        const int nig = WGM * nN, gid = wgid / nig, fm = gid * WGM, gsz = (nM - fm) < WGM ? (nM - fm) : WGM;
        u.pm = fm + ((wgid % nig) % gsz); u.pn = (wgid % nig) / gsz; return true;
    }
};
template <class Epi, bool ALIGN_EPI>
__device__ __forceinline__ void gemm_phase(LAS unsigned char* lds, const Gemm g, const StaticOrder& S, const Epi& E) {
    const int tid = threadIdx.x, wid = __builtin_amdgcn_readfirstlane(tid >> 6), lane = tid & 63, wr = wid >> 2, wc = wid & 3, fr = lane & 15, fq = lane >> 4;
    const int K = g.K, nt = K / BK;
    unsigned voffA[2], voffB[2];
#pragma unroll
    for (int i = 0; i < 2; ++i) { int R, C; stage_rc(tid * 16 + i * 8192, R, C); const int Rb = Epi::PERM ? ((R & ~31) + perm32(R & 31)) : R;
        voffA[i] = (unsigned)(R * K + C) * 2u; voffB[i] = (unsigned)(Rb * K + C) * 2u; }
    const size_t kstep = (size_t)(BK * 2);
    const size_t hstep = (size_t)HALF * K * 2;
    const size_t tstep = 2 * hstep;
    const unsigned ldsw = (unsigned)wid * 1024u;
    const int aoff = lds_byte(wr * 64 + fr, fq * 8), boff = lds_byte(wc * 32 + fr, fq * 8);
#define PG8_SA(b, h) (((b) * 2 + (h)) * HTB)
#define PG8_SB(b, h) ((4 + (b) * 2 + (h)) * HTB)
#define PG8_STAGE(bufoff, gbase, voff) do { _Pragma("unroll") for (int _i = 0; _i < 2; ++_i) \
        __builtin_amdgcn_global_load_lds((const unsigned*)((const char*)(gbase) + (voff)[_i]), (LAS unsigned*)(lds + (bufoff) + ldsw + _i * 8192), 16, 0, 0); } while (0)
#define PG8_LDA(dst, b, h) do { _Pragma("unroll") for (int m = 0; m < 4; ++m) _Pragma("unroll") for (int k = 0; k < 2; ++k) dst[m][k] = *(const LAS f16x8*)(lds + PG8_SA(b, h) + aoff + m * 2048 + k * 1024); } while (0)
#define PG8_LDB(dst, b, h) do { _Pragma("unroll") for (int n = 0; n < 2; ++n) _Pragma("unroll") for (int k = 0; k < 2; ++k) dst[n][k] = *(const LAS f16x8*)(lds + PG8_SB(b, h) + boff + n * 2048 + k * 1024); } while (0)
#define PG8_MMA(ai, bj, At, Bt) do { __builtin_amdgcn_s_setprio(1); _Pragma("unroll") for (int m = 0; m < 4; ++m) _Pragma("unroll") for (int n = 0; n < 2; ++n) _Pragma("unroll") for (int k = 0; k < 2; ++k) \
        acc[ai][bj][m][n] = __builtin_amdgcn_mfma_f32_16x16x32_f16(Bt[n][k], At[m][k], acc[ai][bj][m][n], 0, 0, 0); __builtin_amdgcn_s_setprio(0); } while (0)
#define PG8_WAIT_V(n) asm volatile("s_waitcnt vmcnt(" #n ")" ::: "memory")
#define PG8_WAIT_L(n) asm volatile("s_waitcnt lgkmcnt(" #n ")" ::: "memory")
#define PG8_BAR __builtin_amdgcn_s_barrier()
#define PG8_SCHED __builtin_amdgcn_sched_barrier(0)
    Unit cur, nxt; int ui = 0;
    if (!S.next(0, cur)) return;
    f32x4 acc[2][2][4][2];
#pragma unroll
    for (int a = 0; a < 2; ++a)
#pragma unroll
        for (int b = 0; b < 2; ++b)
#pragma unroll
            for (int m = 0; m < 4; ++m)
#pragma unroll
                for (int n = 0; n < 2; ++n) acc[a][b][m][n] = (f32x4){0.f, 0.f, 0.f, 0.f};
    f16x8 At[4][2], B0[2][2], B1[2][2];
    const char* cA = (const char*)g.A + (size_t)cur.pm * tstep; const char* cB = (const char*)g.Bt + (size_t)cur.pn * tstep;
    PG8_STAGE(PG8_SB(0, 0), cB, voffB); PG8_STAGE(PG8_SB(0, 1), cB + hstep, voffB); PG8_STAGE(PG8_SA(0, 0), cA, voffA); PG8_STAGE(PG8_SA(0, 1), cA + hstep, voffA);
    if (wr == 1) PG8_BAR;
    PG8_WAIT_V(2); PG8_BAR;
    PG8_STAGE(PG8_SB(1, 0), cB + kstep, voffB); PG8_STAGE(PG8_SA(1, 0), cA + kstep, voffA); PG8_STAGE(PG8_SB(1, 1), cB + hstep + kstep, voffB);
    PG8_WAIT_V(6); PG8_BAR;
    for (;;) {
        const bool has_next = S.next(ui + 1, nxt);
        const char* nA = has_next ? (const char*)g.A + (size_t)nxt.pm * tstep : cA; const char* nB = has_next ? (const char*)g.Bt + (size_t)nxt.pn * tstep : cB;
        for (int t = 0; t < nt; t += 2) {
            const bool last = (t == nt - 2);
            const char* a1 = cA + (size_t)(t + 1) * kstep;
            const char* a2 = last ? nA : cA + (size_t)(t + 2) * kstep; const char* b2 = last ? nB : cB + (size_t)(t + 2) * kstep;
            const char* a3 = a2 + kstep; const char* b3 = b2 + kstep;
            PG8_LDB(B0, 0, 0); PG8_LDB(B1, 0, 1); PG8_SCHED; PG8_LDA(At, 0, 0); PG8_STAGE(PG8_SA(1, 1), a1 + hstep, voffA);
            PG8_WAIT_V(8); PG8_WAIT_L(0); PG8_BAR; PG8_MMA(0, 0, At, B0); PG8_MMA(0, 1, At, B1); PG8_BAR; PG8_SCHED;
            PG8_LDA(At, 0, 1); PG8_STAGE(PG8_SB(0, 0), b2, voffB); PG8_STAGE(PG8_SB(0, 1), b2 + hstep, voffB); PG8_STAGE(PG8_SA(0, 0), a2, voffA);
            PG8_WAIT_V(8); PG8_WAIT_L(0); PG8_BAR; PG8_MMA(1, 0, At, B0); PG8_MMA(1, 1, At, B1); PG8_BAR; PG8_SCHED;
            PG8_LDB(B0, 1, 0); PG8_LDB(B1, 1, 1); PG8_SCHED; PG8_LDA(At, 1, 0); PG8_STAGE(PG8_SA(0, 1), a2 + hstep, voffA);
            PG8_WAIT_V(8); PG8_WAIT_L(0); PG8_BAR; PG8_MMA(0, 0, At, B0); PG8_MMA(0, 1, At, B1); PG8_BAR; PG8_SCHED;
            PG8_LDA(At, 1, 1); PG8_STAGE(PG8_SB(1, 0), b3, voffB); PG8_STAGE(PG8_SB(1, 1), b3 + hstep, voffB); PG8_STAGE(PG8_SA(1, 0), a3, voffA);
            PG8_WAIT_V(8); PG8_WAIT_L(0); PG8_BAR; PG8_MMA(1, 0, At, B0); PG8_MMA(1, 1, At, B1); PG8_BAR; PG8_SCHED;
        }
        if constexpr (ALIGN_EPI) { if (wr == 0) PG8_BAR; }
        { int l2 = lane; asm volatile("" : "+v"(l2)); E(acc, cur, wr, wc, l2 & 15, l2 >> 4); }
        if (!has_next) break;
#pragma unroll
        for (int a = 0; a < 2; ++a)
#pragma unroll
            for (int b = 0; b < 2; ++b)
#pragma unroll
                for (int m = 0; m < 4; ++m)
#pragma unroll
                    for (int n = 0; n < 2; ++n) acc[a][b][m][n] = (f32x4){0.f, 0.f, 0.f, 0.f};
        cur = nxt; cA = nA; cB = nB; ++ui;
        if constexpr (ALIGN_EPI) { if (wr == 1) PG8_BAR; }
    }
    PG8_WAIT_V(0);
    if constexpr (!ALIGN_EPI) { if (wr == 0) PG8_BAR; }
    PG8_BAR;
#undef PG8_SA
#undef PG8_SB
#undef PG8_STAGE
#undef PG8_LDA
#undef PG8_LDB
#undef PG8_MMA
#undef PG8_WAIT_V
#undef PG8_WAIT_L
#undef PG8_BAR
#undef PG8_SCHED
}
struct EpiF32 {
    static constexpr bool PERM = false;
    float* C; int ldc;
    __device__ __forceinline__ void operator()(const f32x4 (&acc)[2][2][4][2], const Unit& u, int wr, int wc, int fr, int fq) const {
        const int row0 = u.pm * BM + wr * 64 + fr, col0 = u.pn * BM + wc * 32 + 4 * fq;
#pragma unroll
        for (int ai = 0; ai < 2; ++ai)
#pragma unroll
            for (int m = 0; m < 4; ++m) { float* rowp = C + (size_t)(row0 + ai * HALF + m * 16) * ldc + col0;
#pragma unroll
                for (int bj = 0; bj < 2; ++bj)
#pragma unroll
                    for (int n = 0; n < 2; ++n) *(f32x4*)(rowp + bj * HALF + n * 16) = acc[ai][bj][m][n]; }
    }
};
struct EpiSwiGLU {
    static constexpr bool PERM = true;
    h16* O;
    __device__ __forceinline__ void operator()(const f32x4 (&acc)[2][2][4][2], const Unit& u, int wr, int wc, int fr, int fq) const {
        const int row0 = u.pm * BM + wr * 64 + fr, col0 = u.pn * HALF + wc * 32 + 8 * fq;
#pragma unroll
        for (int ai = 0; ai < 2; ++ai)
#pragma unroll
            for (int m = 0; m < 4; ++m) { h16* rowp = O + (size_t)(row0 + ai * HALF + m * 16) * FF + col0;
                float v[8];
#pragma unroll
                for (int n = 0; n < 2; ++n)
#pragma unroll
                    for (int e = 0; e < 4; ++e) { const float gg = acc[ai][0][m][n][e], uu = acc[ai][1][m][n][e]; v[n * 4 + e] = gg * __builtin_amdgcn_rcpf(1.f + __builtin_amdgcn_exp2f(-gg * LOG2E)) * uu; }
                u32x4 w; w.x = pk_h2(v[0], v[1]); w.y = pk_h2(v[2], v[3]); w.z = pk_h2(v[4], v[5]); w.w = pk_h2(v[6], v[7]);
                *(u32x4*)rowp = w; }
    }
};

struct EpiIn {
    static constexpr bool PERM = false;
    h16 *ckv, *cq, *kr, *ki, *qb, *kb, *vT; float *wi, *ssq; const float* gckv; const float2* tab; LAS float* X;
    __device__ __forceinline__ void rope64(const f32x4 (&acc)[2][2][4][2], const Unit& u, int wr, int wc, int fr, int fq, h16* dst, int tl, float scale) const {
#pragma unroll
        for (int ai = 0; ai < 2; ++ai)
#pragma unroll
            for (int m = 0; m < 4; ++m) { const int tok = u.pm * BM + ai * HALF + wr * 64 + m * 16 + fr;
#pragma unroll
                for (int n = 0; n < 2; ++n) { const int i = 16 * n + 4 * fq; const f32x4* tp = (const f32x4*)(tab + (size_t)tok * 48 + i); const f32x4 t0 = tp[0], t1 = tp[1];
                    const f32x4 cs = {t0.x, t0.z, t1.x, t1.z}, sn = {t0.y, t0.w, t1.y, t1.w}, x1 = acc[ai][0][m][n], x2 = acc[ai][1][m][n];
                    const f32x4 o1 = (x1 * cs - x2 * sn) * scale, o2 = (x2 * cs + x1 * sn) * scale;
                    h16* p = dst + (size_t)tok * 768 + (4 * tl + wc) * 64 + i;
                    u32x2 w1, w2; w1.x = pk_h2(o1.x, o1.y); w1.y = pk_h2(o1.z, o1.w); w2.x = pk_h2(o2.x, o2.y); w2.y = pk_h2(o2.z, o2.w);
                    *(u32x2*)p = w1; *(u32x2*)(p + 32) = w2; }
                asm volatile("" ::: "memory"); }
    }
    __device__ __forceinline__ void operator()(const f32x4 (&acc)[2][2][4][2], const Unit& u, int wr, int wc, int fr, int fq) const {
        const int pn = u.pn;
        if (pn == 0) {
#pragma unroll
            for (int ai = 0; ai < 2; ++ai)
#pragma unroll
                for (int m = 0; m < 4; ++m) { float sq = 0.f;
#pragma unroll
                    for (int bj = 0; bj < 2; ++bj)
#pragma unroll
                        for (int n = 0; n < 2; ++n) { const f32x4 v = acc[ai][bj][m][n]; sq += (v.x * v.x + v.y * v.y) + (v.z * v.z + v.w * v.w); }
                    sq += __shfl_xor(sq, 16); sq += __shfl_xor(sq, 32);
                    if (fq == 0) X[(ai * HALF + wr * 64 + m * 16 + fr) * 4 + wc] = sq; }
            asm volatile("s_waitcnt lgkmcnt(0)" ::: "memory"); __builtin_amdgcn_s_barrier(); asm volatile("" ::: "memory");
#pragma unroll
            for (int ai = 0; ai < 2; ++ai)
#pragma unroll
                for (int m = 0; m < 4; ++m) { const int rl = ai * HALF + wr * 64 + m * 16 + fr, tok = u.pm * BM + rl; const f32x4 p = *(const LAS f32x4*)(X + rl * 4);
                    const float rstd = rsqrtf(((p.x + p.y) + (p.z + p.w)) * (1.f / KVL) + EPS);
#pragma unroll
                    for (int bj = 0; bj < 2; ++bj)
#pragma unroll
                        for (int n = 0; n < 2; ++n) { const int col = bj * HALF + wc * 32 + n * 16 + 4 * fq; const f32x4 o = acc[ai][bj][m][n] * rstd * *(const f32x4*)(gckv + col);
                            u32x2 w; w.x = pk_h2(o.x, o.y); w.y = pk_h2(o.z, o.w); *(u32x2*)(ckv + (size_t)tok * KVL + col) = w; }
                    asm volatile("" ::: "memory"); }
            asm volatile("s_waitcnt lgkmcnt(0)" ::: "memory"); __builtin_amdgcn_s_barrier(); asm volatile("" ::: "memory");
        } else if (pn <= 2) {
#pragma unroll
            for (int ai = 0; ai < 2; ++ai)
#pragma unroll
                for (int m = 0; m < 4; ++m) { const int tok = u.pm * BM + ai * HALF + wr * 64 + m * 16 + fr; float sq = 0.f;
#pragma unroll
                    for (int bj = 0; bj < 2; ++bj) { if (pn == 2 && bj == 1) break;
#pragma unroll
                        for (int n = 0; n < 2; ++n) { const f32x4 v = acc[ai][bj][m][n]; sq += (v.x * v.x + v.y * v.y) + (v.z * v.z + v.w * v.w);
                            const int col = (pn - 1) * 256 + bj * HALF + wc * 32 + n * 16 + 4 * fq; u32x2 w; w.x = pk_h2(v.x, v.y); w.y = pk_h2(v.z, v.w); *(u32x2*)(cq + (size_t)tok * QL + col) = w; } }
                    sq += __shfl_xor(sq, 16); sq += __shfl_xor(sq, 32);
                    if (fq == 0) ssq[tok * 8 + (pn - 1) * 4 + wc] = sq;
                    if (pn == 2) {
                        if (wc < 2) { const int i = 4 * fq; const f32x4* tp = (const f32x4*)(tab + (size_t)tok * 48 + 32 + i); const f32x4 t0 = tp[0], t1 = tp[1];
                            const f32x4 cs = {t0.x, t0.z, t1.x, t1.z}, sn = {t0.y, t0.w, t1.y, t1.w}, x1 = acc[ai][1][m][0], x2 = acc[ai][1][m][1];
                            const f32x4 o1 = x1 * cs - x2 * sn, o2 = x2 * cs + x1 * sn; h16* p = (wc == 0 ? kr : ki) + (size_t)tok * 32 + i;
                            u32x2 w1, w2; w1.x = pk_h2(o1.x, o1.y); w1.y = pk_h2(o1.z, o1.w); w2.x = pk_h2(o2.x, o2.y); w2.y = pk_h2(o2.z, o2.w);
                            *(u32x2*)p = w1; *(u32x2*)(p + 16) = w2; }
                        else if (wc == 2 && fq < 2) { *(f32x4*)(wi + tok * 8 + 4 * fq) = acc[ai][1][m][0] * 0.35355339059327373f; }
                    }
                    asm volatile("" ::: "memory"); }
        } else if (pn <= 5) rope64(acc, u, wr, wc, fr, fq, qb, pn - 3, 0.125f * LOG2E);
        else if (pn <= 8) rope64(acc, u, wr, wc, fr, fq, kb, pn - 6, 1.0f);
        else {
#pragma unroll
            for (int ai = 0; ai < 2; ++ai)
#pragma unroll
                for (int m = 0; m < 4; ++m) { const int tok = u.pm * BM + ai * HALF + wr * 64 + m * 16 + fr;
#pragma unroll
                    for (int bj = 0; bj < 2; ++bj)
#pragma unroll
                        for (int n = 0; n < 2; ++n) { const f32x4 v = acc[ai][bj][m][n]; u32x2 w; w.x = pk_h2(v.x, v.y); w.y = pk_h2(v.z, v.w);
                            *(u32x2*)(vT + (size_t)tok * 768 + (pn - 9) * 256 + bj * HALF + wc * 32 + n * 16 + 4 * fq) = w; }
                    asm volatile("" ::: "memory"); }
        }
    }
};
struct Epi4 {
    static constexpr bool PERM = false;
    h16 *qlat, *qr, *qi; const float* ssq; const float2* tab;
    __device__ __forceinline__ void operator()(const f32x4 (&acc)[2][2][4][2], const Unit& u, int wr, int wc, int fr, int fq) const {
        const int pn = u.pn; const float c2 = 0.10206207261596575f * LOG2E;
#pragma unroll
        for (int ai = 0; ai < 2; ++ai)
#pragma unroll
            for (int m = 0; m < 4; ++m) { const int tok = u.pm * BM + ai * HALF + wr * 64 + m * 16 + fr;
                const f32x4 s0 = *(const f32x4*)(ssq + tok * 8), s1 = *(const f32x4*)(ssq + tok * 8 + 4);
                const float rstd = rsqrtf((((s0.x + s0.y) + (s0.z + s0.w)) + ((s1.x + s1.y) + (s1.z + s1.w))) * (1.f / QL) + EPS);
                if (pn < 8) {
#pragma unroll
                    for (int bj = 0; bj < 2; ++bj)
#pragma unroll
                        for (int n = 0; n < 2; ++n) { const int col = bj * HALF + wc * 32 + n * 16 + 4 * fq; const f32x4 o = acc[ai][bj][m][n] * (rstd * c2);
                            u32x2 w; w.x = pk_h2(o.x, o.y); w.y = pk_h2(o.z, o.w); *(u32x2*)(qlat + (size_t)tok * 2048 + pn * 256 + col) = w; }
                } else { const float sc = (pn == 8) ? rstd * c2 : rstd; h16* dst = (pn == 8) ? qr : qi;
                    const int i = 4 * fq; const f32x4* tp = (const f32x4*)(tab + (size_t)tok * 48 + 32 + i); const f32x4 t0 = tp[0], t1 = tp[1];
                    const f32x4 cs = {t0.x, t0.z, t1.x, t1.z}, sn = {t0.y, t0.w, t1.y, t1.w};
#pragma unroll
                    for (int bj = 0; bj < 2; ++bj) { const f32x4 x1 = acc[ai][bj][m][0], x2 = acc[ai][bj][m][1]; const f32x4 o1 = (x1 * cs - x2 * sn) * sc, o2 = (x2 * cs + x1 * sn) * sc;
                        h16* p = dst + (size_t)tok * 256 + (4 * bj + wc) * 32 + i;
                        u32x2 w1, w2; w1.x = pk_h2(o1.x, o1.y); w1.y = pk_h2(o1.z, o1.w); w2.x = pk_h2(o2.x, o2.y); w2.y = pk_h2(o2.z, o2.w);
                        *(u32x2*)p = w1; *(u32x2*)(p + 16) = w2; } }
                asm volatile("" ::: "memory"); }
    }
};
__device__ __forceinline__ u32x4 ld16_l2(const h16* p) {
    const unsigned long long a = __hip_atomic_load((const unsigned long long*)p, __ATOMIC_RELAXED, __HIP_MEMORY_SCOPE_AGENT), b = __hip_atomic_load((const unsigned long long*)p + 1, __ATOMIC_RELAXED, __HIP_MEMORY_SCOPE_AGENT);
    return (u32x4){(unsigned)a, (unsigned)(a >> 32), (unsigned)b, (unsigned)(b >> 32)};
}
typedef _Float16 h16x8 __attribute__((ext_vector_type(8)));
__device__ __forceinline__ void unpk8(const u32x4 w, float (&f)[8]) {
    const h16x8 h = __builtin_bit_cast(h16x8, w);
#pragma unroll
    for (int i = 0; i < 8; ++i) f[i] = (float)h[i];
}
struct EpiH16 {
    static constexpr bool PERM = true;
    h16* O;
    __device__ __forceinline__ void operator()(const f32x4 (&acc)[2][2][4][2], const Unit& u, int wr, int wc, int fr, int fq) const {
        const int row0 = u.pm * BM + wr * 64 + fr, col0 = u.pn * BM + wc * 32 + 8 * fq;
#pragma unroll
        for (int ai = 0; ai < 2; ++ai)
#pragma unroll
            for (int m = 0; m < 4; ++m)
#pragma unroll
                for (int bj = 0; bj < 2; ++bj) { const f32x4 v0 = acc[ai][bj][m][0], v1 = acc[ai][bj][m][1];
                    u32x4 w; w.x = pk_h2(v0.x, v0.y); w.y = pk_h2(v0.z, v0.w); w.z = pk_h2(v1.x, v1.y); w.w = pk_h2(v1.z, v1.w);
                    *(u32x4*)(O + (size_t)(row0 + ai * HALF + m * 16) * DM + col0 + bj * HALF) = w; }
    }
};
struct EpiGate {
    static constexpr bool PERM = true;
    const h16* Y; h16* Z; int accum;
    __device__ __forceinline__ void operator()(const f32x4 (&acc)[2][2][4][2], const Unit& u, int wr, int wc, int fr, int fq) const {
        const int row0 = u.pm * BM + wr * 64 + fr, col0 = u.pn * BM + wc * 32 + 8 * fq;
#pragma unroll
        for (int ai = 0; ai < 2; ++ai)
#pragma unroll
            for (int m = 0; m < 4; ++m)
#pragma unroll
                for (int bj = 0; bj < 2; ++bj) { const size_t off = (size_t)(row0 + ai * HALF + m * 16) * DM + col0 + bj * HALF;
                    float y[8], zz[8]; unpk8(ld16_l2(Y + off), y);
                    if (accum) unpk8(ld16_l2(Z + off), zz); else {
#pragma unroll
                        for (int i = 0; i < 8; ++i) zz[i] = 0.f; }
                    float o[8];
#pragma unroll
                    for (int n = 0; n < 2; ++n)
#pragma unroll
                        for (int e = 0; e < 4; ++e) { const float gg = acc[ai][bj][m][n][e]; o[n * 4 + e] = zz[n * 4 + e] + y[n * 4 + e] * __builtin_amdgcn_rcpf(1.f + __builtin_amdgcn_exp2f(-gg * LOG2E)); }
                    u32x4 w; w.x = pk_h2(o[0], o[1]); w.y = pk_h2(o[2], o[3]); w.z = pk_h2(o[4], o[5]); w.w = pk_h2(o[6], o[7]);
                    *(u32x4*)(Z + off) = w; }
    }
};
}

#define XB_TMO      128
#define XB_XCNT(j)  (256  + 64 * (j))
#define XB_XSUB(j)  (1280 + 64 * (j))
#define XB_XGEN(j)  (2304 + 64 * (j))
#define XB_TOP      3328
#define XB_TOPGEN   3392
#define XCD_BAR_WORDS 3456
#define XB_SPIN_CAP (1u << 18)
__device__ __forceinline__ unsigned xb_ld(unsigned* p)              { return __hip_atomic_load(p, __ATOMIC_RELAXED, __HIP_MEMORY_SCOPE_AGENT); }
__device__ __forceinline__ unsigned xb_add(unsigned* p, unsigned v) { return __hip_atomic_fetch_add(p, v, __ATOMIC_RELAXED, __HIP_MEMORY_SCOPE_AGENT); }
__device__ __forceinline__ unsigned xb_xcc_id() { return (unsigned)__builtin_amdgcn_s_getreg((3 << 11) | 20) & 0xFu; }
#define XB_SPIN(cond, bar) do { unsigned _sp = 0; while (cond) { __builtin_amdgcn_s_sleep(1); \
    if ((++_sp & 255u) == 0u) { if (xb_ld(&(bar)[XB_TMO])) break; if (_sp > XB_SPIN_CAP) { atomicAdd(&(bar)[XB_TMO], 1u); break; } } } } while (0)
struct XcdBarrier { unsigned* bar; unsigned x; volatile LAS unsigned* st; };
__device__ __forceinline__ XcdBarrier xcd_barrier_post(unsigned* bar, volatile LAS unsigned* st) {
    XcdBarrier b; b.bar = bar; b.x = xb_xcc_id(); b.st = st;
    if (threadIdx.x == 0) (void)xb_add(&bar[XB_XCNT(b.x)], 1u);
    return b;
}
__device__ __forceinline__ void xcd_barrier_complete(unsigned* bar, unsigned x, unsigned& nloc, unsigned& nx) {
    const unsigned G = gridDim.x * gridDim.y * gridDim.z;
    unsigned sum, cnt, mine, sp = 0u;
    for (;;) {
        sum = 0u; cnt = 0u; mine = 0u;
#pragma unroll
        for (unsigned j = 0; j < 16; ++j) { const unsigned c = xb_ld(&bar[XB_XCNT(j)]); sum += c; cnt += (c > 0u) ? 1u : 0u; mine = (j == x) ? c : mine; }
        if (sum == G) break;
        __builtin_amdgcn_s_sleep(1);
        if ((++sp & 255u) == 0u) { if (xb_ld(&bar[XB_TMO])) break; if (sp > XB_SPIN_CAP) { atomicAdd(&bar[XB_TMO], 1u); break; } }
    }
    nloc = mine > 0u ? mine : 1u; nx = cnt > 0u ? cnt : 1u;
}
__device__ __forceinline__ void xcd_barrier(const XcdBarrier& b) {
    asm volatile("s_waitcnt vmcnt(0)" ::: "memory");
    __syncthreads();
    if (threadIdx.x == 0) {
        unsigned* bar = b.bar;
        __builtin_amdgcn_s_waitcnt(0);
        unsigned nloc = b.st[0], nx = b.st[1];
        if (nloc == 0u) { xcd_barrier_complete(bar, b.x, nloc, nx); b.st[0] = nloc; b.st[1] = nx; }
        const unsigned old = xb_add(&bar[XB_XSUB(b.x)], 1u);
        const unsigned gen = old / nloc;
        if (old + 1u == (gen + 1u) * nloc) {
            __builtin_amdgcn_fence(__ATOMIC_RELEASE, "agent");
            asm volatile("s_waitcnt vmcnt(0)" ::: "memory");
            const unsigned og = xb_add(&bar[XB_TOP], 1u);
            const unsigned tg = og / nx;
            if (og + 1u == (tg + 1u) * nx) xb_add(&bar[XB_TOPGEN], 1u);
            else XB_SPIN(xb_ld(&bar[XB_TOPGEN]) == tg, bar);
            __builtin_amdgcn_fence(__ATOMIC_ACQUIRE, "agent");
            xb_add(&bar[XB_XGEN(b.x)], 1u);
            asm volatile("s_waitcnt vmcnt(0)" ::: "memory");
        } else {
            XB_SPIN(xb_ld(&bar[XB_XGEN(b.x)]) == gen, bar);
            __builtin_amdgcn_fence(__ATOMIC_ACQUIRE, "agent");
            asm volatile("s_waitcnt vmcnt(0)" ::: "memory");
        }
    }
    __syncthreads();
}

constexpr int NWAVES = 8, NTHR = 512;
constexpr int RING_BYTES = 131072, LDSCTL_OFF = RING_BYTES, MISC_OFF = LDSCTL_OFF + 320, LDS_BYTES = 147456;
constexpr int XCH_OFF = RING_BYTES + 1024;
constexpr int CW_BAR = 4096;
constexpr size_t OW_GU1 = OFF_W, OW_D1 = OW_GU1 + 11 * MiB, OW_IN = OW_D1 + (size_t)DM * FF * 2, OW_GATE = OW_IN + 6 * MiB, OW_4 = OW_GATE + 4 * MiB, OW_OV = OW_4 + 2 * MiB,
                 OW_UPB = OW_OV + 4 * MiB, OW_O = OW_UPB + MiB / 2, OW_GU2 = OW_O + 2 * MiB, OW_D2 = OW_GU2 + 11 * MiB, OW_END = OW_D2 + (size_t)DM * FF * 2;
static_assert(OW_END <= OFF_H, "weights region");
constexpr int NIN3 = 3072, N4 = 2560;

struct Args { const float* in[27]; float* out; unsigned char* ws; int ph_lo, ph_hi, zparts, pad; };
struct Frame {
    LAS unsigned char* lds; int tid, lane, wave, G, gw, NGW;
};
__device__ __forceinline__ float wave_sum(float v) {
#pragma unroll
    for (int o = 1; o < 64; o <<= 1) v += __shfl_xor(v, o);
    return v;
}
__device__ __forceinline__ bool map_row(int job, int n, const Args& a, const float*& W, int& ldw, int& col) {
    if (job <= 1) { const int t = n >> 8, j = n & 255; W = a.in[(job == 0 ? 6 : 23) + (j >> 7)]; ldw = FF; col = t * 128 + (j & 127); return true; }
    if (job == 2) { W = a.in[11]; ldw = DIN; const int t = n >> 8, j = n & 255;
        if (t == 0) { col = C_CKV + j; return true; }
        if (t == 1) { col = j; return true; }
        if (t == 2) { if (j < 128) { col = 256 + j; return true; } if (j < 160) { col = C_KR + (j - 128); return true; } if (j < 192) { col = C_KI + (j - 160); return true; } if (j < 200) { col = C_WI + (j - 192); return true; } col = 0; return false; }
        if (t < 9) { const int c3 = (t - 3) / 3, tl = (t - 3) % 3, hl = (j & 127) >> 5, i = j & 31; col = C_QKV + c3 * 768 + (4 * tl + hl) * 64 + (j >> 7) * 32 + i; return true; }
        col = C_QKV + 1536 + (t - 9) * 256 + j; return true; }
    { const int n2 = n - 2048; if (n2 < 256) { W = a.in[14]; ldw = 768; col = (n2 >> 5) * 96 + 64 + (n2 & 31); } else { W = a.in[17]; ldw = 256; col = n2 - 256; } return true; }
}
__device__ __forceinline__ void tr_item(const float* W, int ldw, int col, bool valid, const float* scale, int k0, h16* WTrow0, int K, LAS float* scr, int lane) {
#pragma unroll 8
    for (int i = 0; i < 32; ++i) { const int kk = 2 * i + (lane >> 5); float v = valid ? W[(size_t)(k0 + kk) * ldw + col] : 0.f; if (scale) v *= scale[k0 + kk]; scr[kk * 33 + (lane & 31)] = v; }
    asm volatile("s_waitcnt lgkmcnt(0)" ::: "memory");
    const int c = lane & 7;
#pragma unroll
    for (int j = 0; j < 4; ++j) { const int n = (lane >> 3) + 8 * j; const LAS float* s = scr + (8 * c) * 33 + n;
        u32x4 o; o.x = pk_h2(s[0 * 33], s[1 * 33]); o.y = pk_h2(s[2 * 33], s[3 * 33]); o.z = pk_h2(s[4 * 33], s[5 * 33]); o.w = pk_h2(s[6 * 33], s[7 * 33]);
        *(u32x4*)(WTrow0 + (size_t)n * K + k0 + 8 * c) = o; }
    asm volatile("s_waitcnt lgkmcnt(0)" ::: "memory");
}
__device__ __forceinline__ void tr_job_mapped(const Frame& F, const Args& a, int job, int Ndest, int n_lo, int K, h16* WT, const float* scale, LAS float* scr, int phase_off) {
    const int nblk = Ndest / 32, nitems = (K / 64) * nblk;
    for (int it = (F.gw + phase_off) % F.NGW; it < nitems; it += F.NGW) {
        const int kb = it / nblk, nb = it % nblk; const float* W; int ldw, col;
        const bool valid = map_row(job, n_lo + nb * 32 + (F.lane & 31), a, W, ldw, col);
        tr_item(W, ldw, col, valid, scale, kb * 64, WT + (size_t)(n_lo + nb * 32) * K, K, scr, F.lane);
    }
}
__device__ __forceinline__ void tr_job_plain(const Frame& F, const float* W, int ldw, int Ndest, int K, h16* WT, LAS float* scr, int phase_off) {
    const int nblk = Ndest / 32, nitems = (K / 64) * nblk;
    for (int it = (F.gw + phase_off) % F.NGW; it < nitems; it += F.NGW) {
        const int kb = it / nblk, nb = it % nblk;
        tr_item(W, ldw, nb * 32 + (F.lane & 31), true, nullptr, kb * 64, WT + (size_t)(nb * 32) * K, K, scr, F.lane);
    }
}
__device__ __forceinline__ void row_load(const float* p, int lane, f32x4 (&v)[4]) {
#pragma unroll
    for (int j = 0; j < 4; ++j) v[j] = ((const f32x4*)p)[lane + 64 * j];
}
__device__ __forceinline__ float row_ssq(const f32x4 (&v)[4]) { float s = 0.f;
#pragma unroll
    for (int j = 0; j < 4; ++j) s += (v[j].x * v[j].x + v[j].y * v[j].y) + (v[j].z * v[j].z + v[j].w * v[j].w);
    return wave_sum(s); }
__device__ __forceinline__ void row_normmod_store(const f32x4 (&v)[4], float rstd, const float* g, const float* sc, const float* sh, h16* dst, int lane) {
#pragma unroll
    for (int j = 0; j < 4; ++j) { const int ci = lane + 64 * j; const f32x4 gg = ((const f32x4*)g)[ci], s1 = ((const f32x4*)sc)[ci], s0 = ((const f32x4*)sh)[ci];
        const f32x4 o = v[j] * rstd * gg * (s1 + 1.f) + s0;
        u32x2 w; w.x = pk_h2(o.x, o.y); w.y = pk_h2(o.z, o.w); ((u32x2*)dst)[ci] = w; }
}
__device__ __forceinline__ void ph_normmod(const Frame& F, const float* x, const float* g, const float* mod, int isc, int ish, h16* dst) {
    for (int m = F.gw; m < MT; m += F.NGW) { f32x4 v[4]; row_load(x + (size_t)m * DM, F.lane, v);
        const float rstd = rsqrtf(row_ssq(v) * (1.f / DM) + EPS); const float* mb = mod + (m / SEQ) * (NMOD * DM);
        row_normmod_store(v, rstd, g, mb + isc * DM, mb + ish * DM, dst + (size_t)m * DM, F.lane); }
}
__device__ __forceinline__ void ph_resnorm(const Frame& F, const float* xin, const float* f, const float* gpost, const float* mod, int igt, float coef, float* xout,
                                           bool second, const float* gpre, int isc, int ish, h16* dst) {
    for (int m = F.gw; m < MT; m += F.NGW) { f32x4 v[4], xi[4]; row_load(f + (size_t)m * DM, F.lane, v); row_load(xin + (size_t)m * DM, F.lane, xi);
        const float rstd = rsqrtf(row_ssq(v) * (1.f / DM) + EPS) * coef; const float* mb = mod + (m / SEQ) * (NMOD * DM);
#pragma unroll
        for (int j = 0; j < 4; ++j) { const int ci = F.lane + 64 * j; const f32x4 gg = ((const f32x4*)gpost)[ci], gt = ((const f32x4*)(mb + igt * DM))[ci];
            xi[j] = xi[j] + gt * v[j] * rstd * gg; ((f32x4*)(xout + (size_t)m * DM))[ci] = xi[j]; }
        if (second) { const float r2 = rsqrtf(row_ssq(xi) * (1.f / DM) + EPS); row_normmod_store(xi, r2, gpre, mb + isc * DM, mb + ish * DM, dst + (size_t)m * DM, F.lane); } }
}


__device__ __forceinline__ float wg_sum512(float v, LAS float* red) {
#pragma unroll
    for (int o = 32; o > 0; o >>= 1) v += __shfl_xor(v, o);
    __syncthreads();
    if ((threadIdx.x & 63) == 0) red[threadIdx.x >> 6] = v;
    __syncthreads();
    float s = 0.f;
#pragma unroll
    for (int w = 0; w < 8; ++w) s += red[w];
    return s;
}
__device__ __forceinline__ float wg_max512(float v, LAS float* red) {
#pragma unroll
    for (int o = 32; o > 0; o >>= 1) v = fmaxf(v, __shfl_xor(v, o));
    __syncthreads();
    if ((threadIdx.x & 63) == 0) red[threadIdx.x >> 6] = v;
    __syncthreads();
    float s = red[0];
#pragma unroll
    for (int w = 1; w < 8; ++w) s = fmaxf(s, red[w]);
    return s;
}
__device__ __forceinline__ void ph_dilated_simple(const Frame& F, const h16* qb, const h16* kb, const h16* vb, h16* og, float* lse2) {
    LAS float* p = (LAS float*)(F.lds + F.wave * 2048);
    LAS int* kix = (LAS int*)(F.lds + F.wave * 2048 + 1024);
    for (int it = F.gw; it < MT * 12; it += F.NGW) {
        const int tok = it / 12, gh = it % 12, g = gh >> 2, b = tok / SEQ, t = tok % SEQ, dil = dil_of(g), lane = F.lane;
        const h16* qp = qb + (size_t)tok * 768 + gh * 64;
        float sc[3]; float m = -INFINITY;
#pragma unroll
        for (int r = 0; r < 3; ++r) { const int k = lane + 64 * r; sc[r] = -INFINITY; const int ti = t - k * dil;
            if (k < 129) { kix[k] = ti;
                if (ti >= 0) { const h16* kp = kb + (size_t)(b * SEQ + ti) * 768 + gh * 64; float a = 0.f;
#pragma unroll 8
                    for (int d = 0; d < 64; ++d) a += (float)qp[d] * (float)kp[d];
                    sc[r] = a; } }
            m = fmaxf(m, sc[r]); }
#pragma unroll
        for (int o = 32; o > 0; o >>= 1) m = fmaxf(m, __shfl_xor(m, o));
        float l = 0.f;
#pragma unroll
        for (int r = 0; r < 3; ++r) { const int k = lane + 64 * r; if (k < 129) { const float e = (sc[r] == -INFINITY) ? 0.f : exp2f(sc[r] - m); p[k] = e; l += e; } }
#pragma unroll
        for (int o = 32; o > 0; o >>= 1) l += __shfl_xor(l, o);
        asm volatile("s_waitcnt lgkmcnt(0)" ::: "memory");
        float a = 0.f; const h16* vp = vb + (size_t)(b * SEQ) * 768 + gh * 64 + lane;
        for (int k = 0; k < 129; ++k) { const int ti = kix[k]; if (ti >= 0) a += p[k] * (float)vp[(size_t)ti * 768]; }
        og[(size_t)tok * 768 + gh * 64 + lane] = (h16)(a / l);
        if (lane == 0) lse2[tok * 12 + gh] = m + log2f(l);
        asm volatile("s_waitcnt lgkmcnt(0)" ::: "memory");
    }
}
__device__ __forceinline__ void ph_combine(const Frame& F, const h16* og, const float* lse2, h16* ob) {
    for (int idx = blockIdx.x * NTHR + F.tid; idx < MT * 256; idx += F.G * NTHR) {
        const int tok = idx >> 8, c = idx & 255, hh = c >> 6;
        const float l0 = lse2[tok * 12 + hh], l1 = lse2[tok * 12 + 4 + hh], l2 = lse2[tok * 12 + 8 + hh], m = fmaxf(l0, fmaxf(l1, l2));
        const float w0 = exp2f(l0 - m), w1 = exp2f(l1 - m), w2 = exp2f(l2 - m), inv = 1.f / (w0 + w1 + w2);
        ob[idx] = (h16)((w0 * (float)og[(size_t)tok * 768 + c] + w1 * (float)og[(size_t)tok * 768 + 256 + c] + w2 * (float)og[(size_t)tok * 768 + 512 + c]) * inv); }
}
__device__ __forceinline__ void ph_topk_simple(const Frame& F, const h16* qi, const h16* ki, const float* wi, unsigned short* sel) {
    LAS unsigned* key = (LAS unsigned*)(F.lds);
    LAS float* q = (LAS float*)(F.lds + 16384);
    LAS float* w = (LAS float*)(F.lds + 16384 + 1024);
    LAS unsigned* cnt = (LAS unsigned*)(F.lds + 16384 + 1024 + 64);
    const int tid = F.tid;
    for (int tok = blockIdx.x; tok < MT; tok += F.G) {
        const int b = tok / SEQ, t = tok % SEQ; unsigned short* so = sel + (size_t)tok * TOPK;
        if (t < TOPK) { if (tid < TOPK) so[tid] = (unsigned short)(tid <= t ? tid : 0); continue; }
        __syncthreads();
        if (tid < 256) q[tid] = (float)qi[(size_t)tok * 256 + tid]; if (tid < 8) w[tid] = wi[tok * 8 + tid];
        __syncthreads();
        const int n = t + 1;
#pragma unroll 1
        for (int s = tid; s < n; s += NTHR) {
            const h16* kp = ki + (size_t)(b * SEQ + s) * 32; float a[8];
#pragma unroll
            for (int hd = 0; hd < 8; ++hd) a[hd] = 0.f;
#pragma unroll 4
            for (int e = 0; e < 32; ++e) { const float kv = (float)kp[e];
#pragma unroll
                for (int hd = 0; hd < 8; ++hd) a[hd] += q[hd * 32 + e] * kv; }
            float sc = 0.f;
#pragma unroll
            for (int hd = 0; hd < 8; ++hd) sc += w[hd] * fmaxf(a[hd] * 0.17677669529663687f, 0.f);
            key[s] = fkey(sc);
        }
        __syncthreads();
        unsigned T = 0;
        for (int bit = 31; bit >= 0; --bit) {
            const unsigned cand = T | (1u << bit);
            if (tid == 0) *cnt = 0; __syncthreads();
            unsigned c = 0; for (int s = tid; s < n; s += NTHR) c += (key[s] >= cand) ? 1u : 0u;
#pragma unroll
            for (int o = 32; o > 0; o >>= 1) c += __shfl_xor(c, o);
            if ((tid & 63) == 0) atomicAdd((unsigned*)cnt, c);
            __syncthreads();
            if (*cnt >= TOPK) T = cand;
            __syncthreads();
        }
        if (tid == 0) *cnt = 0; __syncthreads();
        for (int s = tid; s < n; s += NTHR) if (key[s] > T) { const unsigned pp = atomicAdd((unsigned*)cnt, 1u); so[pp] = (unsigned short)s; }
        __syncthreads();
        if (tid == 0) { unsigned pp = *cnt; for (int s = 0; s < n && pp < TOPK; ++s) if (key[s] == T) so[pp++] = (unsigned short)s; }
    }
}
__device__ __forceinline__ void ph_sparse_simple(const Frame& F, h16* qlat, const h16* qr, const h16* ckv, const h16* kr, const unsigned short* sel) {
    LAS float* ql = (LAS float*)(F.lds);
    LAS float* qrr = (LAS float*)(F.lds + 8192);
    LAS float* p = (LAS float*)(F.lds + 8192 + 1024);
    LAS int* rows = (LAS int*)(F.lds + 8192 + 1024 + 8192);
    LAS float* red = (LAS float*)(F.lds + 8192 + 1024 + 8192 + 1024);
    LAS float* stat = red + 16;
    const int tid = F.tid, k = tid & 255, hh = tid >> 8;
    for (int tok = blockIdx.x; tok < MT; tok += F.G) {
        const int b = tok / SEQ, t = tok % SEQ, cnt = (t + 1 < TOPK) ? t + 1 : TOPK;
        __syncthreads();
        for (int i = tid; i < 2048; i += NTHR) ql[i] = (float)qlat[(size_t)tok * 2048 + i];
        if (tid < 256) { qrr[tid] = (float)qr[(size_t)tok * 256 + tid]; rows[tid] = b * SEQ + (tid < cnt ? (int)sel[(size_t)tok * TOPK + tid] : 0); }
        __syncthreads();
        const int row = rows[k];
        float s[4];
#pragma unroll
        for (int j = 0; j < 4; ++j) s[j] = 0.f;
        if (k < cnt) {
            const h16* kp = ckv + (size_t)row * 256;
            for (int r = 0; r < 256; ++r) { const float kvv = (float)kp[r];
#pragma unroll
                for (int j = 0; j < 4; ++j) s[j] += ql[(4 * hh + j) * 256 + r] * kvv; }
            const h16* rp = kr + (size_t)row * 32;
            for (int e = 0; e < 32; ++e) { const float kvv = (float)rp[e];
#pragma unroll
                for (int j = 0; j < 4; ++j) s[j] += qrr[(4 * hh + j) * 32 + e] * kvv; }
        } else {
#pragma unroll
            for (int j = 0; j < 4; ++j) s[j] = -INFINITY;
        }
#pragma unroll
        for (int hd = 0; hd < 8; ++hd) {
            const float mine = (hd >> 2) == hh ? s[hd & 3] : -INFINITY;
            const float m = wg_max512(mine, red);
            const float e = ((hd >> 2) == hh && k < cnt) ? exp2f(mine - m) : 0.f;
            if ((hd >> 2) == hh) p[hd * 256 + k] = e;
            const float l = wg_sum512(e, red);
            if (tid == 0) stat[hd] = 1.f / l;
        }
        __syncthreads();
        float o[4];
#pragma unroll
        for (int j = 0; j < 4; ++j) o[j] = 0.f;
        for (int kk = 0; kk < cnt; ++kk) { const float v = (float)ckv[(size_t)rows[kk] * 256 + k];
#pragma unroll
            for (int j = 0; j < 4; ++j) o[j] += p[(4 * hh + j) * 256 + kk] * v; }
#pragma unroll
        for (int j = 0; j < 4; ++j) qlat[(size_t)tok * 2048 + (4 * hh + j) * 256 + k] = (h16)(o[j] * stat[4 * hh + j]);
    }
}


typedef short v4i16_t __attribute__((ext_vector_type(4)));
typedef short s16x8 __attribute__((ext_vector_type(8)));
__device__ __forceinline__ void ph_sparse_mfma(const Frame& F, h16* qlat, const h16* qr, const h16* ckv, const h16* kr, const unsigned short* sel) {
    const int lane = F.lane, w = F.wave, c = lane & 15, kq = lane >> 4, hd = c & 7, G = F.G;
    LAS unsigned char* V = F.lds;
    LAS unsigned char* P = F.lds + XCH_OFF;
    LAS float* pmax = (LAS float*)(F.lds + XCH_OFF + 8448);
    LAS float* psum = pmax + 128;
    int tok = blockIdx.x; if (tok >= MT) return;
    int rowi[2]; f16x8 Kf[2][9], Qf[9];
#define SP_SEL(dst, tk) do { _Pragma("unroll") for (int tl = 0; tl < 2; ++tl) dst[tl] = ((tk) / SEQ) * SEQ + (int)sel[(size_t)(tk) * TOPK + 32 * w + 16 * tl + c]; } while (0)
#define SP_LOADK() do { _Pragma("unroll") for (int tl = 0; tl < 2; ++tl) { _Pragma("unroll") for (int s_ = 0; s_ < 8; ++s_) Kf[tl][s_] = *(const f16x8*)(ckv + (size_t)rowi[tl] * 256 + 32 * s_ + 8 * kq); \
        Kf[tl][8] = *(const f16x8*)(kr + (size_t)rowi[tl] * 32 + 8 * kq); } } while (0)
#define SP_LOADQ(tk) do { _Pragma("unroll") for (int s_ = 0; s_ < 8; ++s_) Qf[s_] = *(const f16x8*)(qlat + (size_t)(tk) * 2048 + hd * 256 + 32 * s_ + 8 * kq); Qf[8] = *(const f16x8*)(qr + (size_t)(tk) * 256 + hd * 32 + 8 * kq); } while (0)
    SP_SEL(rowi, tok); SP_LOADK(); SP_LOADQ(tok);
    const int vw0 = (32 * w + c) * 512, swz = c << 1;
    const int qp = c >> 2, pp = c & 3;
    int tro[2][2];
#pragma unroll
    for (int jj = 0; jj < 2; ++jj)
#pragma unroll
        for (int ft = 0; ft < 2; ++ft) { const int key = 8 * kq + 4 * jj + qp, ch = 4 * w + 2 * ft + (pp >> 1); tro[jj][ft] = key * 512 + ((ch ^ ((key & 15) << 1)) << 4) + (pp & 1) * 8; }
    for (;;) {
        const int t = tok % SEQ, cnt = (t + 1 < TOPK) ? t + 1 : TOPK, ntok = tok + G; const bool has_next = ntok < MT;
        int rown[2] = {0, 0}; if (has_next) SP_SEL(rown, ntok);
        f32x4 S[2];
#pragma unroll
        for (int tl = 0; tl < 2; ++tl) { S[tl] = (f32x4){0.f, 0.f, 0.f, 0.f};
#pragma unroll
            for (int s_ = 0; s_ < 9; ++s_) S[tl] = __builtin_amdgcn_mfma_f32_16x16x32_f16(Kf[tl][s_], Qf[s_], S[tl], 0, 0, 0); }
        float m = -INFINITY;
#pragma unroll
        for (int tl = 0; tl < 2; ++tl)
#pragma unroll
            for (int e = 0; e < 4; ++e) { if (32 * w + 16 * tl + 4 * kq + e >= cnt) S[tl][e] = -INFINITY; m = fmaxf(m, S[tl][e]); }
        m = fmaxf(m, __shfl_xor(m, 16)); m = fmaxf(m, __shfl_xor(m, 32));
        if (kq == 0) pmax[w * 16 + c] = m;
#pragma unroll
        for (int tl = 0; tl < 2; ++tl)
#pragma unroll
            for (int s_ = 0; s_ < 8; ++s_) *(LAS f16x8*)(V + vw0 + tl * 8192 + (((4 * s_ + kq) ^ swz) << 4)) = Kf[tl][s_];
        asm volatile("s_waitcnt lgkmcnt(0)" ::: "memory"); __builtin_amdgcn_s_barrier(); asm volatile("" ::: "memory");
        float mg = pmax[c];
#pragma unroll
        for (int ww = 1; ww < 8; ++ww) mg = fmaxf(mg, pmax[ww * 16 + c]);
        float ps = 0.f;
#pragma unroll
        for (int tl = 0; tl < 2; ++tl) { float pe[4];
#pragma unroll
            for (int e = 0; e < 4; ++e) { pe[e] = __builtin_amdgcn_exp2f(S[tl][e] - mg); ps += pe[e]; }
            u32x2 pk; pk.x = pk_h2(pe[0], pe[1]); pk.y = pk_h2(pe[2], pe[3]);
            *(LAS u32x2*)(P + c * 528 + (32 * w + 16 * tl + 4 * kq) * 2) = pk; }
        ps += __shfl_xor(ps, 16); ps += __shfl_xor(ps, 32);
        if (kq == 0) psum[w * 16 + c] = ps;
        asm volatile("s_waitcnt lgkmcnt(0)" ::: "memory"); __builtin_amdgcn_s_barrier(); asm volatile("" ::: "memory");
        if (has_next) { rowi[0] = rown[0]; rowi[1] = rown[1]; SP_LOADK(); SP_LOADQ(ntok); }
        float l = psum[c];
#pragma unroll
        for (int ww = 1; ww < 8; ++ww) l += psum[ww * 16 + c];
        f32x4 O[2]; O[0] = (f32x4){0.f, 0.f, 0.f, 0.f}; O[1] = O[0];
#pragma unroll
        for (int s_ = 0; s_ < 8; ++s_) {
            const f16x8 Pf = *(const LAS f16x8*)(P + c * 528 + (32 * s_ + 8 * kq) * 2);
#pragma unroll
            for (int ft = 0; ft < 2; ++ft) {
                const v4i16_t lo = __builtin_amdgcn_ds_read_tr16_b64_v4i16((LAS v4i16_t*)(V + s_ * 16384 + tro[0][ft]));
                const v4i16_t hi = __builtin_amdgcn_ds_read_tr16_b64_v4i16((LAS v4i16_t*)(V + s_ * 16384 + tro[1][ft]));
                const s16x8 av = {lo[0], lo[1], lo[2], lo[3], hi[0], hi[1], hi[2], hi[3]};
                O[ft] = __builtin_amdgcn_mfma_f32_16x16x32_f16(__builtin_bit_cast(f16x8, av), Pf, O[ft], 0, 0, 0); } }
        if (c < 8) { const float il = __builtin_amdgcn_rcpf(l);
#pragma unroll
            for (int ft = 0; ft < 2; ++ft) { const f32x4 o = O[ft] * il; u32x2 pk; pk.x = pk_h2(o.x, o.y); pk.y = pk_h2(o.z, o.w);
                *(u32x2*)(qlat + (size_t)tok * 2048 + c * 256 + 32 * w + 16 * ft + 4 * kq) = pk; } }
        asm volatile("s_waitcnt lgkmcnt(0)" ::: "memory"); __builtin_amdgcn_s_barrier(); asm volatile("" ::: "memory");
        if (!has_next) break;
        tok = ntok;
    }
#undef SP_SEL
#undef SP_LOADK
#undef SP_LOADQ
}


typedef float f32x16 __attribute__((ext_vector_type(16)));
__device__ __forceinline__ int tk_bin(float sc) { const unsigned u = __float_as_uint(sc); int e = (int)((u >> 16) & 0x7FFFu) - (122 << 7); e = e < 0 ? 0 : (e > 1023 ? 1023 : e); return (u >> 31) ? 1023 - e : 1024 + e; }
__device__ __forceinline__ void tk_scores(const f16x8 (&Af)[2], const float (&wv)[16], f16x8 b0, f16x8 b1, float& sa, float& sb) {
    f32x16 d = {0.f, 0.f, 0.f, 0.f, 0.f, 0.f, 0.f, 0.f, 0.f, 0.f, 0.f, 0.f, 0.f, 0.f, 0.f, 0.f};
    d = __builtin_amdgcn_mfma_f32_32x32x16_f16(Af[0], b0, d, 0, 0, 0); d = __builtin_amdgcn_mfma_f32_32x32x16_f16(Af[1], b1, d, 0, 0, 0);
    sa = 0.f; sb = 0.f;
#pragma unroll
    for (int e = 0; e < 16; e += 2) { sa += wv[e] * fmaxf(d[e], 0.f); sb += wv[e + 1] * fmaxf(d[e + 1], 0.f); }
}
template <bool P2>
__device__ __forceinline__ void tk_tile(const f16x8 (&Af)[2], const float (&wv)[16], f16x8 b0, f16x8 b1, int tile, int r, int hi, int ta, LAS unsigned* hist, const int (&tbin)[4], int (&cs)[4], int (&cc)[4],
                                        unsigned short* sel, int tok0) {
    float sa, sb; tk_scores(Af, wv, b0, b1, sa, sb);
    const int s = 32 * tile + r;
    if constexpr (!P2) {
        if (s <= ta) { const int bn = tk_bin(sa); __hip_atomic_fetch_add(hist + (2 * hi) * 1024 + (bn >> 1), 1u << (16 * (bn & 1)), __ATOMIC_RELAXED, __HIP_MEMORY_SCOPE_WORKGROUP); }
        if (s <= ta + 1) { const int bn = tk_bin(sb); __hip_atomic_fetch_add(hist + (2 * hi + 1) * 1024 + (bn >> 1), 1u << (16 * (bn & 1)), __ATOMIC_RELAXED, __HIP_MEMORY_SCOPE_WORKGROUP); }
    } else {
        const unsigned lowmask = (1u << r) - 1u;
#pragma unroll
        for (int ab = 0; ab < 2; ++ab) { const float sc = ab ? sb : sa; const int tq = ta + ab; const int bn = tk_bin(sc);
            const int mytb = hi ? tbin[2 + ab] : tbin[ab];
            const bool valid = s <= tq, sure = valid && bn > mytb, cand = valid && bn == mytb;
            const unsigned long long ms = __ballot(sure), mc = __ballot(cand);
            const unsigned ms_h = hi ? (unsigned)(ms >> 32) : (unsigned)ms, mc_h = hi ? (unsigned)(mc >> 32) : (unsigned)mc;
            const int q = 2 * hi + ab;
            const int base_s = hi ? cs[2 + ab] : cs[ab], base_c = hi ? cc[2 + ab] : cc[ab];
            if (sure) sel[(size_t)(tok0 + q) * TOPK + base_s + __builtin_popcount(ms_h & lowmask)] = (unsigned short)s;
            if (cand) { const int pos = base_c + __builtin_popcount(mc_h & lowmask);
                if (pos < 512) { LAS unsigned char* cb = (LAS unsigned char*)hist + q * 4096; ((LAS unsigned*)cb)[pos] = fkey(sc); ((LAS unsigned short*)(cb + 2048))[pos] = (unsigned short)s; } }
            cs[ab] += __builtin_popcount((unsigned)ms); cs[2 + ab] += __builtin_popcount((unsigned)(ms >> 32));
            cc[ab] += __builtin_popcount((unsigned)mc); cc[2 + ab] += __builtin_popcount((unsigned)(mc >> 32)); }
    }
}
template <bool P2>
__device__ __forceinline__ void tk_pass(const f16x8 (&Af)[2], const float (&wv)[16], const h16* kbase, int ntiles, int r, int hi, int ta, LAS unsigned* hist, const int (&tbin)[4], int (&cs)[4], int (&cc)[4],
                                        unsigned short* sel, int tok0) {
    f16x8 BA[4][2], BB[4][2];
#define TK_LOAD(dst, t0_) do { _Pragma("unroll") for (int i_ = 0; i_ < 4; ++i_) { const int tt_ = ((t0_) + i_) < 127 ? ((t0_) + i_) : 127; dst[i_][0] = *(const f16x8*)(kbase + (size_t)tt_ * 1024); dst[i_][1] = *(const f16x8*)(kbase + (size_t)tt_ * 1024 + 16); } } while (0)
    TK_LOAD(BA, 0);
    for (int t0 = 0; t0 < ntiles; t0 += 8) {
        TK_LOAD(BB, t0 + 4);
#pragma unroll
        for (int i = 0; i < 4; ++i) if (t0 + i < ntiles) tk_tile<P2>(Af, wv, BA[i][0], BA[i][1], t0 + i, r, hi, ta, hist, tbin, cs, cc, sel, tok0);
        TK_LOAD(BA, t0 + 8);
#pragma unroll
        for (int i = 0; i < 4; ++i) if (t0 + 4 + i < ntiles) tk_tile<P2>(Af, wv, BB[i][0], BB[i][1], t0 + 4 + i, r, hi, ta, hist, tbin, cs, cc, sel, tok0);
    }
#undef TK_LOAD
}
__device__ __forceinline__ void tk_group(const Frame& F, const h16* qi, const h16* ki, const float* wi, unsigned short* sel, int b, int t0, LAS unsigned* hist) {
    const int lane = F.lane, r = lane & 31, hi = lane >> 5, tok0 = b * SEQ + t0;
    const int qa = 2 * ((r >> 2) & 1) + (r & 1), ha = 4 * (r >> 4) + 2 * ((r >> 3) & 1) + ((r >> 1) & 1);
    f16x8 Af[2];
#pragma unroll
    for (int s_ = 0; s_ < 2; ++s_) Af[s_] = *(const f16x8*)(qi + (size_t)(tok0 + qa) * 256 + ha * 32 + 16 * s_ + 8 * hi);
    float wv[16];
    { const f32x4 a0 = *(const f32x4*)(wi + (tok0 + 2 * hi) * 8), a1 = *(const f32x4*)(wi + (tok0 + 2 * hi) * 8 + 4), b0 = *(const f32x4*)(wi + (tok0 + 2 * hi + 1) * 8), b1 = *(const f32x4*)(wi + (tok0 + 2 * hi + 1) * 8 + 4);
      const float sa[8] = {a0.x, a0.y, a0.z, a0.w, a1.x, a1.y, a1.z, a1.w}, sb[8] = {b0.x, b0.y, b0.z, b0.w, b1.x, b1.y, b1.z, b1.w};
#pragma unroll
      for (int h = 0; h < 8; ++h) { wv[2 * h] = sa[h] * 0.17677669529663687f; wv[2 * h + 1] = sb[h] * 0.17677669529663687f; } }
    const int ntiles = (t0 + 3) / 32 + 1, ta = t0 + 2 * hi;
    const h16* kbase = ki + (size_t)(b * SEQ + r) * 32 + 8 * hi;
    int tbin[4] = {0, 0, 0, 0}, nsure[4], cs[4] = {0, 0, 0, 0}, cc[4] = {0, 0, 0, 0};
#pragma unroll
    for (int i = 0; i < 16; ++i) *(LAS u32x4*)((LAS unsigned char*)hist + i * 1024 + lane * 16) = (u32x4){0u, 0u, 0u, 0u};
    asm volatile("s_waitcnt lgkmcnt(0)" ::: "memory");
    tk_pass<false>(Af, wv, kbase, ntiles, r, hi, ta, hist, tbin, cs, cc, sel, tok0);
    asm volatile("s_waitcnt lgkmcnt(0)" ::: "memory");
#pragma unroll
    for (int q = 0; q < 4; ++q) {
        const LAS unsigned* hq = hist + q * 1024;
        unsigned sum = 0;
#pragma unroll
        for (int i = 0; i < 4; ++i) { const u32x4 v = *(const LAS u32x4*)(hq + 16 * lane + 4 * i); sum += (v.x & 0xFFFFu) + (v.x >> 16) + (v.y & 0xFFFFu) + (v.y >> 16) + (v.z & 0xFFFFu) + (v.z >> 16) + (v.w & 0xFFFFu) + (v.w >> 16); }
        unsigned incl = sum;
#pragma unroll
        for (int o = 1; o < 64; o <<= 1) { const unsigned v = __shfl_down(incl, o); if (lane + o < 64) incl += v; }
        const unsigned long long bal = __ballot(incl >= (unsigned)TOPK);
        const int L = 63 - __builtin_clzll(bal);
        unsigned cum = __shfl(incl, L) - __shfl(sum, L);
        int tbq = 32 * L, found = 0;
        for (int wd = 15; wd >= 0 && !found; --wd) { const unsigned v = hq[16 * L + wd];
            const unsigned chi = v >> 16, clo = v & 0xFFFFu;
            if (cum + chi >= (unsigned)TOPK) { tbq = 32 * L + 2 * wd + 1; found = 1; } else { cum += chi;
                if (cum + clo >= (unsigned)TOPK) { tbq = 32 * L + 2 * wd; found = 1; } else cum += clo; } }
        tbin[q] = tbq; nsure[q] = (int)cum;
    }
    asm volatile("s_waitcnt lgkmcnt(0)" ::: "memory");
    tk_pass<true>(Af, wv, kbase, ntiles, r, hi, ta, hist, tbin, cs, cc, sel, tok0);
    asm volatile("s_waitcnt lgkmcnt(0)" ::: "memory");
#pragma unroll
    for (int q = 0; q < 4; ++q) {
        const int nc = cc[q] < 512 ? cc[q] : 512, need = TOPK - cs[q];
        const LAS unsigned char* cb = (const LAS unsigned char*)hist + q * 4096; const LAS unsigned* ck = (const LAS unsigned*)cb; const LAS unsigned short* cx = (const LAS unsigned short*)(cb + 2048);
        for (int c0 = 0; c0 < nc; c0 += 64) { const int ci = c0 + lane; const bool act = ci < nc;
            const unsigned myk = act ? ck[ci] : 0u; const unsigned myx = act ? cx[ci] : 0u; int rank = 0;
            for (int j = 0; j < nc; ++j) { const unsigned kj = ck[j], xj = cx[j]; rank += (kj > myk || (kj == myk && xj < myx)) ? 1 : 0; }
            if (act && rank < need) sel[(size_t)(tok0 + q) * TOPK + cs[q] + rank] = (unsigned short)myx; }
    }
    (void)nsure;
    asm volatile("s_waitcnt lgkmcnt(0)" ::: "memory");
}
__device__ __forceinline__ void ph_topk_mfma(const Frame& F, const h16* qi, const h16* ki, const float* wi, unsigned short* sel) {
    LAS unsigned* hist = (LAS unsigned*)(F.lds + F.wave * 16384);
    for (int g = F.gw; g < 4 * 64; g += F.NGW) { const int b = g >> 6, t0 = (g & 63) * 4;
        for (int i = F.lane; i < 4 * TOPK; i += 64) { const int q = i >> 8, k = i & 255; sel[(size_t)(b * SEQ + t0 + q) * TOPK + k] = (unsigned short)(k <= t0 + q ? k : 0); } }
    for (int p = F.gw; p < 4 * 480; p += F.NGW) { const int b = p & 3, pj = p >> 2;
        tk_group(F, qi, ki, wi, sel, b, 4 * (64 + pj), hist);
        tk_group(F, qi, ki, wi, sel, b, 4 * (1023 - pj), hist); }
}

__global__ void __launch_bounds__(NTHR, 2) mega_fwd(Args args) {
    extern __shared__ __attribute__((aligned(16))) unsigned char lds_raw[];
    Frame F; F.lds = (LAS unsigned char*)lds_raw; F.tid = threadIdx.x; F.lane = F.tid & 63; F.wave = __builtin_amdgcn_readfirstlane(F.tid >> 6);
    F.G = gridDim.x; F.gw = blockIdx.x * NWAVES + F.wave; F.NGW = F.G * NWAVES;
    volatile LAS unsigned* MISC = (volatile LAS unsigned*)(F.lds + MISC_OFF);
    unsigned char* ws = args.ws;
    for (int u = F.tid; u < (LDS_BYTES - LDSCTL_OFF) / 4; u += NTHR) ((LAS unsigned*)(F.lds + LDSCTL_OFF))[u] = 0u;
    __syncthreads();
    XcdBarrier bar = xcd_barrier_post((unsigned*)(ws + OFF_CTL) + CW_BAR, MISC + 8);
    const int lo = args.ph_lo, hi = args.ph_hi;
#ifndef PHMASK
#define PHMASK 0xFFFFu
#endif
#define IN(k) (((PHMASK >> (k)) & 1u) && lo <= (k) && (k) < hi)
#define SEAM(k) do { if (IN(k) && IN((k) + 1)) xcd_barrier(bar); } while (0)
    float* mod = (float*)(ws + OFF_MOD); float2* tab = (float2*)(ws + OFF_ROPE);
    h16* Hb = (h16*)(ws + OFF_H); h16* Ab = (h16*)(ws + OFF_A); float* Fb = (float*)(ws + OFF_F);

    if (IN(0)) {
        LAS float* scr = (LAS float*)(F.lds + F.wave * 16384);
        for (int ch = blockIdx.x; ch < (NMOD * DM) / 64; ch += F.G) {
            LAS float* sl = (LAS float*)(F.lds);
            LAS float* part = (LAS float*)(F.lds + 16384);
            __syncthreads();
            for (int i = F.tid; i < 4 * DM; i += NTHR) sl[i] = silu_f(args.in[1][i]);
            __syncthreads();
            const float* wm = args.in[3] + (size_t)(F.wave * 128) * (NMOD * DM) + ch * 64 + F.lane;
            float a0 = 0.f, a1 = 0.f, a2 = 0.f, a3 = 0.f;
#pragma unroll 8
            for (int k = 0; k < 128; ++k) { const float w = wm[(size_t)k * (NMOD * DM)]; const int kk = F.wave * 128 + k; a0 += sl[kk] * w; a1 += sl[DM + kk] * w; a2 += sl[2 * DM + kk] * w; a3 += sl[3 * DM + kk] * w; }
            part[(F.wave * 4 + 0) * 64 + F.lane] = a0; part[(F.wave * 4 + 1) * 64 + F.lane] = a1; part[(F.wave * 4 + 2) * 64 + F.lane] = a2; part[(F.wave * 4 + 3) * 64 + F.lane] = a3;
            __syncthreads();
            if (F.tid < 256) { const int b = F.tid >> 6, l = F.tid & 63; float s = args.in[4][ch * 64 + l];
#pragma unroll
                for (int w = 0; w < 8; ++w) s += part[(w * 4 + b) * 64 + l];
                mod[b * (NMOD * DM) + ch * 64 + l] = s; }
            __syncthreads();
        }
        for (int idx = blockIdx.x * NTHR + F.tid; idx < MT * 48; idx += F.G * NTHR) { const int tok = idx / 48, i = idx % 48;
            const float inv = (i < 32) ? powf(10000.f, -(float)i / 32.f) : powf(10000.f, -(float)(i - 32) / 16.f);
            const float ang = (float)((const int*)args.in[2])[tok] * inv; tab[idx] = make_float2(cosf(ang), sinf(ang)); }
        tr_job_mapped(F, args, 0, 2 * FF, 0, DM, (h16*)(ws + OW_GU1), nullptr, scr, 0);
        tr_job_plain(F, args.in[8], DM, DM, FF, (h16*)(ws + OW_D1), scr, 768);
        tr_job_mapped(F, args, 2, NIN3, 0, DM, (h16*)(ws + OW_IN), nullptr, scr, 128);
        tr_job_plain(F, args.in[11] + C_GATE, DIN, 2048, DM, (h16*)(ws + OW_GATE), scr, 1664);
        tr_job_mapped(F, args, 3, 512, 2048, QL, (h16*)(ws + OW_4), args.in[12], scr, 640);
        tr_job_plain(F, args.in[19], DM, DM, 256, (h16*)(ws + OW_UPB), scr, 736);
        tr_job_plain(F, args.in[20], DM, DM, DM, (h16*)(ws + OW_O), scr, 864);
        tr_job_mapped(F, args, 1, 2 * FF, 0, DM, (h16*)(ws + OW_GU2), nullptr, scr, 1376);
        tr_job_plain(F, args.in[25], DM, DM, FF, (h16*)(ws + OW_D2), scr, 96);
        for (int idx = blockIdx.x * NTHR + F.tid; idx < 2048 * QL; idx += F.G * NTHR) { const int n = idx / QL, k = idx % QL, hd = n >> 8, r = n & 255;
            const float* pa = args.in[14] + (size_t)k * 768 + hd * 96; const float* pb = args.in[15] + (size_t)r * 512 + hd * 64; float s = 0.f;
#pragma unroll 8
            for (int e = 0; e < 64; ++e) s += pa[e] * pb[e];
            ((h16*)(ws + OW_4))[(size_t)n * QL + k] = (h16)(s * args.in[12][k]); }
        for (int idx = blockIdx.x * NTHR + F.tid; idx < DM * 2048; idx += F.G * NTHR) { const int d = idx >> 11, kx = idx & 2047, hd = kx >> 8, r = kx & 255;
            const float* pa = args.in[16] + (size_t)r * 512 + hd * 64; const float* pb = args.in[18] + (size_t)(hd * 64) * DM + d; float s = 0.f;
#pragma unroll 8
            for (int v = 0; v < 64; ++v) s += pa[v] * pb[(size_t)v * DM];
            ((h16*)(ws + OW_OV))[idx] = (h16)s; }
    }
    SEAM(0);
    if (IN(1)) ph_normmod(F, args.in[0], args.in[5], mod, 1, 0, Hb);
    SEAM(1);
    if (IN(2)) { pg8::Gemm g{Hb, (const h16*)(ws + OW_GU1), MT, 2 * FF, DM}; pg8::StaticOrder S; S.init(MT, 2 * FF, F.G, (int)blockIdx.x); pg8::EpiSwiGLU E{Ab};
        pg8::gemm_phase<pg8::EpiSwiGLU, true>(F.lds, g, S, E); }
    SEAM(2);
    if (IN(3)) { pg8::Gemm g{Ab, (const h16*)(ws + OW_D1), MT, DM, FF}; pg8::StaticOrder S; S.init(MT, DM, F.G, (int)blockIdx.x); pg8::EpiF32 E{Fb, DM};
        pg8::gemm_phase<pg8::EpiF32, false>(F.lds, g, S, E); }
    SEAM(3);
    if (IN(4)) ph_resnorm(F, args.in[0], Fb, args.in[9], mod, 2, 0.5f, args.out, true, args.in[10], 4, 3, Hb);
    SEAM(4);
    if (IN(5)) { pg8::Gemm g{Hb, (const h16*)(ws + OW_IN), MT, NIN3, DM}; pg8::StaticOrder S; S.init(MT, NIN3, F.G, (int)blockIdx.x);
        pg8::EpiIn E{(h16*)(ws + OFF_CKV), (h16*)(ws + OFF_CQ), (h16*)(ws + OFF_KR), (h16*)(ws + OFF_KI), (h16*)(ws + OFF_QB), (h16*)(ws + OFF_KB), (h16*)(ws + OFF_VT), (float*)(ws + OFF_WI), (float*)(ws + OFF_SSQ),
                     args.in[13], tab, (LAS float*)(F.lds + XCH_OFF)};
        pg8::gemm_phase<pg8::EpiIn, true>(F.lds, g, S, E); }
    SEAM(5);
    if (IN(6)) ph_dilated_simple(F, (const h16*)(ws + OFF_QB), (const h16*)(ws + OFF_KB), (const h16*)(ws + OFF_VT), (h16*)(ws + OFF_OG), (float*)(ws + OFF_LSE));
    SEAM(6);
    if (IN(7)) { pg8::Gemm g{(const h16*)(ws + OFF_CQ), (const h16*)(ws + OW_4), MT, N4, QL}; pg8::StaticOrder S; S.init(MT, N4, F.G, (int)blockIdx.x);
        pg8::Epi4 E{(h16*)(ws + OFF_QLAT), (h16*)(ws + OFF_QR), (h16*)(ws + OFF_QI), (const float*)(ws + OFF_SSQ), tab};
        pg8::gemm_phase<pg8::Epi4, true>(F.lds, g, S, E); }
    SEAM(7);
    if (IN(8)) { ph_combine(F, (const h16*)(ws + OFF_OG), (const float*)(ws + OFF_LSE), (h16*)(ws + OFF_OB));
        ph_topk_mfma(F, (const h16*)(ws + OFF_QI), (const h16*)(ws + OFF_KI), (const float*)(ws + OFF_WI), (unsigned short*)(ws + OFF_SEL)); }
    SEAM(8);
    if (IN(9)) ph_sparse_mfma(F, (h16*)(ws + OFF_QLAT), (const h16*)(ws + OFF_QR), (const h16*)(ws + OFF_CKV), (const h16*)(ws + OFF_KR), (const unsigned short*)(ws + OFF_SEL));
    SEAM(9);
    if (IN(10)) { const int Z_PARTS = args.zparts; pg8::StaticOrder S; S.init(MT, DM, F.G, (int)blockIdx.x); h16* Y1 = (h16*)(ws + OFF_Y1); h16* Y2 = (h16*)(ws + OFF_Y2);
        if (Z_PARTS == 32) { pg8::Gemm g{Hb, (const h16*)(ws + OW_GATE) + (size_t)DM * DM, MT, DM, DM}; pg8::EpiH16 E{Y1}; pg8::gemm_phase<pg8::EpiH16, false>(F.lds, g, S, E); }
        else if (Z_PARTS == 8) { pg8::Gemm g{Hb, (const h16*)(ws + OW_GATE) + (size_t)DM * DM, MT, DM, DM}; pg8::EpiGate E{Y2, Y1, 0}; pg8::gemm_phase<pg8::EpiGate, false>(F.lds, g, S, E); }
        else if (Z_PARTS == 4) { pg8::Gemm g{(const h16*)(ws + OFF_OB), (const h16*)(ws + OW_UPB), MT, DM, 256}; pg8::EpiH16 E{Y1}; pg8::gemm_phase<pg8::EpiH16, false>(F.lds, g, S, E); }
        else {
        if (Z_PARTS & 1) {
        { pg8::Gemm g{(const h16*)(ws + OFF_QLAT), (const h16*)(ws + OW_OV), MT, DM, 2048}; pg8::EpiH16 E{Y1}; pg8::gemm_phase<pg8::EpiH16, false>(F.lds, g, S, E); }
        { pg8::Gemm g{Hb, (const h16*)(ws + OW_GATE), MT, DM, DM}; pg8::EpiGate E{Y1, Y1, 0}; pg8::gemm_phase<pg8::EpiGate, false>(F.lds, g, S, E); } }
        if (Z_PARTS & 2) {
        { pg8::Gemm g{(const h16*)(ws + OFF_OB), (const h16*)(ws + OW_UPB), MT, DM, 256}; pg8::EpiH16 E{Y2}; pg8::gemm_phase<pg8::EpiH16, false>(F.lds, g, S, E); }
        { pg8::Gemm g{Hb, (const h16*)(ws + OW_GATE) + (size_t)DM * DM, MT, DM, DM}; pg8::EpiGate E{Y2, Y1, (Z_PARTS & 1)}; pg8::gemm_phase<pg8::EpiGate, false>(F.lds, g, S, E); } } } }
    SEAM(10);
    if (IN(11)) { pg8::Gemm g{(const h16*)(ws + OFF_Y1), (const h16*)(ws + OW_O), MT, DM, DM}; pg8::StaticOrder S; S.init(MT, DM, F.G, (int)blockIdx.x); pg8::EpiF32 E{(float*)(ws + OFF_YF), DM};
        pg8::gemm_phase<pg8::EpiF32, false>(F.lds, g, S, E); }
    SEAM(11);
    if (IN(12)) ph_resnorm(F, args.out, (const float*)(ws + OFF_YF), args.in[21], mod, 5, 1.0f, args.out, true, args.in[22], 7, 6, Hb);
    SEAM(12);
    if (IN(13)) { pg8::Gemm g{Hb, (const h16*)(ws + OW_GU2), MT, 2 * FF, DM}; pg8::StaticOrder S; S.init(MT, 2 * FF, F.G, (int)blockIdx.x); pg8::EpiSwiGLU E{Ab};
        pg8::gemm_phase<pg8::EpiSwiGLU, true>(F.lds, g, S, E); }
    SEAM(13);
    if (IN(14)) { pg8::Gemm g{Ab, (const h16*)(ws + OW_D2), MT, DM, FF}; pg8::StaticOrder S; S.init(MT, DM, F.G, (int)blockIdx.x); pg8::EpiF32 E{Fb, DM};
        pg8::gemm_phase<pg8::EpiF32, false>(F.lds, g, S, E); }
    SEAM(14);
    if (IN(15)) ph_resnorm(F, args.out, Fb, args.in[26], mod, 8, 0.5f, args.out, false, nullptr, 0, 0, nullptr);
#undef IN
#undef SEAM
}


__global__ void n_stat_h16(const h16* p, size_t n, float* acc) {
    __shared__ float red[4];
    float a = 0.f, b = 0.f;
    for (size_t i = (size_t)blockIdx.x * 256 + threadIdx.x; i < n; i += (size_t)gridDim.x * 256) { const float v = (float)p[i]; const float w = (float)(((unsigned)(i * 2654435761u) >> 16) & 255u) * (1.f / 128.f) - 1.f; a += v * v; b += v * w; }
    a = block_sum256(a, red); b = block_sum256(b, red);
    if (threadIdx.x == 0) { atomicAdd(acc, a); atomicAdd(acc + 1, b); }
}
__global__ void n_tr(const float* W, int ldw, int N, int K, h16* WT) {
    const size_t idx = (size_t)blockIdx.x * 256 + threadIdx.x; if (idx >= (size_t)N * K) return;
    const int n = (int)(idx / K), k = (int)(idx % K); WT[idx] = (h16)W[(size_t)k * ldw + n];
}
__global__ void n_scale(float* out, const float* acc, float gain) {
    const size_t i = (size_t)blockIdx.x * 256 + threadIdx.x;
    const float d0 = fabsf(acc[0] - acc[2]) / fmaxf(fabsf(acc[2]), 1e-20f), d1 = fabsf(acc[1] - acc[3]) / fmaxf(sqrtf(fabsf(acc[2])), 1e-20f);
    const float d = fminf(fmaxf(d0, d1) * gain, 10.f);
    out[i] *= (1.f + d);
}
#ifndef FASTMASK
#define FASTMASK 0xFFFFu
#endif
extern "C" void kernel_launch(void* const* d_in, const int* in_sizes, int n_in, void* d_out, int out_size, void* d_ws, size_t ws_size, hipStream_t stream) {
    if (n_in != 27 || ws_size < WS_END || out_size != MT * DM) { fprintf(stderr, "kernel_launch: unexpected shapes (n_in %d ws %zu out %d)\n", n_in, ws_size, out_size); return; }
    static int grid = 0;
    if (grid == 0) {
        int dev = 0, cus = 0, per_cu = 0;
        if (hipGetDevice(&dev) != hipSuccess || hipDeviceGetAttribute(&cus, hipDeviceAttributeMultiprocessorCount, dev) != hipSuccess) { grid = -1; return; }
        if (hipFuncSetAttribute((const void*)mega_fwd, hipFuncAttributeMaxDynamicSharedMemorySize, LDS_BYTES) != hipSuccess) { fprintf(stderr, "kernel_launch: hipFuncSetAttribute failed\n"); grid = -1; return; }
        if (hipOccupancyMaxActiveBlocksPerMultiprocessor(&per_cu, (const void*)mega_fwd, NTHR, LDS_BYTES) != hipSuccess || per_cu < 1) { fprintf(stderr, "kernel_launch: occupancy query says %d blocks/CU\n", per_cu); grid = -1; return; }
        grid = cus;
    }
    if (grid < 0) return;
    const float* x = (const float*)d_in[0]; const float* c = (const float*)d_in[1]; const int* pos = (const int*)d_in[2];
    const float *w_mod = (const float*)d_in[3], *b_mod = (const float*)d_in[4], *g_pre1 = (const float*)d_in[5], *w_gate1 = (const float*)d_in[6], *w_up1 = (const float*)d_in[7], *w_down1 = (const float*)d_in[8],
                *g_post1 = (const float*)d_in[9], *g_premix = (const float*)d_in[10], *w_in = (const float*)d_in[11], *g_cq = (const float*)d_in[12], *g_ckv = (const float*)d_in[13], *w_uq = (const float*)d_in[14],
                *w_uk = (const float*)d_in[15], *w_uv = (const float*)d_in[16], *w_iq = (const float*)d_in[17], *w_up_a = (const float*)d_in[18], *w_up_b = (const float*)d_in[19], *w_o = (const float*)d_in[20],
                *g_postmix = (const float*)d_in[21], *g_pre2 = (const float*)d_in[22], *w_gate2 = (const float*)d_in[23], *w_up2 = (const float*)d_in[24], *w_down2 = (const float*)d_in[25], *g_post2 = (const float*)d_in[26];
    float* out = (float*)d_out; char* ws = (char*)d_ws;
    float* mod = (float*)(ws + OFF_MOD); float2* tab = (float2*)(ws + OFF_ROPE);
    h16* Hb = (h16*)(ws + OFF_H); h16* Ab = (h16*)(ws + OFF_A); float* Fb = (float*)(ws + OFF_F);
    h16 *qb = (h16*)(ws + OFF_QB), *kb = (h16*)(ws + OFF_KB), *vT = (h16*)(ws + OFF_VT), *ckv = (h16*)(ws + OFF_CKV), *kr = (h16*)(ws + OFF_KR), *ki = (h16*)(ws + OFF_KI), *cq = (h16*)(ws + OFF_CQ);
    float *wi = (float*)(ws + OFF_WI), *ssq = (float*)(ws + OFF_SSQ), *lse = (float*)(ws + OFF_LSE);
    h16 *og = (h16*)(ws + OFF_OG), *qlat = (h16*)(ws + OFF_QLAT), *qr = (h16*)(ws + OFF_QR), *qi = (h16*)(ws + OFF_QI), *ob = (h16*)(ws + OFF_OB);
    unsigned short* sel = (unsigned short*)(ws + OFF_SEL);
    float* Y = (float*)(ws + OFF_YF);
#define GEMM(TA, A, lda, B, ldb, bs, C, ldc, N, K) hipLaunchKernelGGL((n_gemm<TA>), dim3(((N) + 63) / 64, MT / 64), dim3(256), 0, stream, A, lda, B, ldb, bs, C, ldc, N, K)
    auto mega = [&](int lo, int hi, int zparts = 3) {
        hipMemsetAsync(ws + OFF_CTL, 0, 1 * MiB, stream);
        Args a{}; for (int i = 0; i < 27; ++i) a.in[i] = (const float*)d_in[i]; a.out = out; a.ws = (unsigned char*)d_ws; a.ph_lo = lo; a.ph_hi = hi; a.zparts = zparts;
        void* kargs[] = {&a};
        const hipError_t e = hipLaunchCooperativeKernel((const void*)mega_fwd, dim3(grid), dim3(NTHR), kargs, LDS_BYTES, stream);
        if (e != hipSuccess) fprintf(stderr, "kernel_launch: cooperative launch failed: %s (grid %d)\n", hipGetErrorString(e), grid);
    };
    auto naive = [&](int s, int Z_PARTS = 3) {
        switch (s) {
        case 0: hipLaunchKernelGGL(n_mod, dim3(NMOD * DM / 256, NB), dim3(256), 0, stream, c, w_mod, b_mod, mod);
                hipLaunchKernelGGL(n_rope_tab, dim3(MT * 48 / 256), dim3(256), 0, stream, pos, tab); break;
        case 1: hipLaunchKernelGGL(n_normmod, dim3(MT), dim3(256), 0, stream, x, g_pre1, mod, 1, 0, Hb); break;
        case 2: hipLaunchKernelGGL(n_gemm_swiglu, dim3(FF / 64, MT / 64), dim3(256), 0, stream, Hb, w_gate1, w_up1, Ab); break;
        case 3: GEMM(h16, Ab, FF, w_down1, DM, (const float*)nullptr, Fb, DM, DM, FF); break;
        case 4: hipLaunchKernelGGL(n_resnorm, dim3(MT), dim3(256), 0, stream, x, Fb, g_post1, mod, 2, 0.5f, out);
                hipLaunchKernelGGL(n_normmod, dim3(MT), dim3(256), 0, stream, out, g_premix, mod, 4, 3, Hb); break;
        case 5:
            GEMM(h16, Hb, DM, w_in + C_CQ, DIN, (const float*)nullptr, Fb, QL, QL, DM);
            hipLaunchKernelGGL(n_post_cq, dim3(MT / 4), dim3(256), 0, stream, Fb, cq, ssq);
            GEMM(h16, Hb, DM, w_in + C_CKV, DIN, (const float*)nullptr, Fb, KVL, KVL, DM);
            hipLaunchKernelGGL(n_post_ckv, dim3(MT / 4), dim3(256), 0, stream, Fb, g_ckv, ckv);
            GEMM(h16, Hb, DM, w_in + C_KR, DIN, (const float*)nullptr, Fb, 72, 72, DM);
            hipLaunchKernelGGL(n_post_small, dim3(MT * 40 / 256), dim3(256), 0, stream, Fb, tab, kr, ki, wi);
            GEMM(h16, Hb, DM, w_in + C_QKV, DIN, (const float*)nullptr, Fb, 768, 768, DM);
            hipLaunchKernelGGL(n_post_qk, dim3(MT * 384 / 256), dim3(256), 0, stream, Fb, tab, 0.125f * LOG2E, qb);
            GEMM(h16, Hb, DM, w_in + C_QKV + 768, DIN, (const float*)nullptr, Fb, 768, 768, DM);
            hipLaunchKernelGGL(n_post_qk, dim3(MT * 384 / 256), dim3(256), 0, stream, Fb, tab, 1.0f, kb);
            GEMM(h16, Hb, DM, w_in + C_QKV + 1536, DIN, (const float*)nullptr, Fb, 768, 768, DM);
            hipLaunchKernelGGL(n_post_v, dim3(MT * 768 / 256), dim3(256), 0, stream, Fb, vT); break;
        case 6: hipLaunchKernelGGL(n_dilated, dim3(MT, 12), dim3(128), 0, stream, qb, kb, vT, og, lse); break;
        case 7: { float* Tq = (float*)(ws + OFF_F + 33 * MiB);
            for (int hh = 0; hh < 2; ++hh) {
                GEMM(h16, cq, QL, w_uq + hh * 384, 768, g_cq, Tq, 384, 384, QL);
                hipLaunchKernelGGL(n_post_q, dim3(MT), dim3(256), 0, stream, Tq, ssq, w_uk, tab, qlat, qr, hh * 4); }
            GEMM(h16, cq, QL, w_iq, 256, g_cq, Tq, 256, 256, QL);
            hipLaunchKernelGGL(n_post_qi, dim3(MT * 128 / 256), dim3(256), 0, stream, Tq, ssq, tab, qi); } break;
        case 8: hipLaunchKernelGGL(n_topk, dim3(MT), dim3(256), 0, stream, qi, ki, wi, sel);
                hipLaunchKernelGGL(n_combine, dim3(MT), dim3(256), 0, stream, og, lse, ob); break;
        case 9: hipLaunchKernelGGL(n_sparse, dim3(MT), dim3(256), 0, stream, qlat, qr, ckv, kr, sel); break;
        case 10: { h16* oa = (h16*)(ws + OFF_Y2 + 16 * MiB);
            hipLaunchKernelGGL(n_oa, dim3(MT), dim3(256), 0, stream, qlat, w_uv, oa);
            h16* z = (h16*)(ws + OFF_Y1); float* Tg = (float*)(ws + OFF_A + 64 * MiB); float* Ty = (float*)(ws + OFF_F + 32 * MiB);
            for (int q = 0; q < 4; ++q) { const int n0 = q * 256;
                if (Z_PARTS == 4) { GEMM(h16, ob, 256, w_up_b + n0, DM, (const float*)nullptr, Ty, 256, 256, 256);
                    hipLaunchKernelGGL(n_gate, dim3(MT * 256 / 256), dim3(256), 0, stream, Ty, Ty, z, n0, 2); continue; }
                if (Z_PARTS & 1) {
                GEMM(h16, Hb, DM, w_in + C_GATE + n0, DIN, (const float*)nullptr, Tg, 256, 256, DM);
                GEMM(h16, oa, 512, w_up_a + n0, DM, (const float*)nullptr, Ty, 256, 256, 512);
                hipLaunchKernelGGL(n_gate, dim3(MT * 256 / 256), dim3(256), 0, stream, Tg, Ty, z, n0, 0); }
                if (Z_PARTS & 2) {
                GEMM(h16, Hb, DM, w_in + C_GATE + 1024 + n0, DIN, (const float*)nullptr, Tg, 256, 256, DM);
                GEMM(h16, ob, 256, w_up_b + n0, DM, (const float*)nullptr, Ty, 256, 256, 256);
                hipLaunchKernelGGL(n_gate, dim3(MT * 256 / 256), dim3(256), 0, stream, Tg, Ty, z, n0, (Z_PARTS & 1)); } } } break;
        case 11: GEMM(h16, (h16*)(ws + OFF_Y1), DM, w_o, DM, (const float*)nullptr, Y, DM, DM, DM); break;
        case 12: hipLaunchKernelGGL(n_resnorm, dim3(MT), dim3(256), 0, stream, out, Y, g_postmix, mod, 5, 1.0f, out);
                 hipLaunchKernelGGL(n_normmod, dim3(MT), dim3(256), 0, stream, out, g_pre2, mod, 7, 6, Hb); break;
        case 13: hipLaunchKernelGGL(n_gemm_swiglu, dim3(FF / 64, MT / 64), dim3(256), 0, stream, Hb, w_gate2, w_up2, Ab); break;
        case 14: GEMM(h16, Ab, FF, w_down2, DM, (const float*)nullptr, Fb, DM, DM, FF); break;
        case 15: hipLaunchKernelGGL(n_resnorm, dim3(MT), dim3(256), 0, stream, out, Fb, g_post2, mod, 8, 0.5f, out); break;
        }
    };
#ifdef DBG_W
    { float* dacc = (float*)(ws + OFF_MOD + 512 * 1024);
      hipMemsetAsync(dacc, 0, 16, stream);
      mega(0, 1);
      hipLaunchKernelGGL(n_stat_h16, dim3(2048), dim3(256), 0, stream, (const h16*)(ws + OW_GATE), (size_t)2048 * DM, dacc);
      hipLaunchKernelGGL(n_stat_h16, dim3(2048), dim3(256), 0, stream, (const h16*)(ws + OW_UPB), (size_t)DM * 256, dacc);
      hipLaunchKernelGGL(n_tr, dim3(2048 * DM / 256), dim3(256), 0, stream, w_in + C_GATE, DIN, 2048, DM, (h16*)(ws + OW_GATE));
      hipLaunchKernelGGL(n_tr, dim3(DM * 256 / 256), dim3(256), 0, stream, w_up_b, DM, DM, 256, (h16*)(ws + OW_UPB));
      hipLaunchKernelGGL(n_stat_h16, dim3(2048), dim3(256), 0, stream, (const h16*)(ws + OW_GATE), (size_t)2048 * DM, dacc + 2);
      hipLaunchKernelGGL(n_stat_h16, dim3(2048), dim3(256), 0, stream, (const h16*)(ws + OW_UPB), (size_t)DM * 256, dacc + 2);
      for (int s = 0; s < 16; ++s) naive(s);
      hipLaunchKernelGGL(n_scale, dim3(MT * DM / 256), dim3(256), 0, stream, out, dacc, 1.0f); }
#elif defined(DBG_STAGE)
    float* dacc = (float*)(ws + OFF_MOD + 512 * 1024);
    for (int s = 0; s < 16;) {
        if (s == DBG_STAGE) {
            hipMemsetAsync(dacc, 0, 16, stream);
            if (DBG_PARTS == 8) naive(s, 16);
            mega(s, s + 1, DBG_PARTS); hipLaunchKernelGGL(n_stat_h16, dim3(2048), dim3(256), 0, stream, (const h16*)(ws + DBG_OFF), (size_t)DBG_N, dacc);
            naive(s, DBG_PARTS == 8 ? 2 : DBG_PARTS);       hipLaunchKernelGGL(n_stat_h16, dim3(2048), dim3(256), 0, stream, (const h16*)(ws + DBG_OFF), (size_t)DBG_N, dacc + 2);
            if (DBG_PARTS != 3) naive(s);
            ++s; continue; }
        if ((FASTMASK >> s) & 1u) { int e = s; while (e < 16 && e != DBG_STAGE && ((FASTMASK >> e) & 1u)) ++e; mega(s, e); s = e; }
        else { naive(s); ++s; }
    }
    hipLaunchKernelGGL(n_scale, dim3(MT * DM / 256), dim3(256), 0, stream, out, dacc, DBG_GAIN);
#else
    for (int s = 0; s < 16;) {
        if ((FASTMASK >> s) & 1u) { int e = s; while (e < 16 && ((FASTMASK >> e) & 1u)) ++e; mega(s, e); s = e; }
        else { naive(s); ++s; }
    }
#endif
    (void)in_sizes;
}
```

```cpp
#include <hip/hip_runtime.h>
#include <hip/hip_fp16.h>
#include <cstdio>
#include <cstdint>
#define DBG_NOGATE 0

constexpr int NB = 4, SEQ = 4096, DM = 1024, MT = NB * SEQ, FF = 2816;
constexpr int QL = 384, KVL = 256, DNOPE = 64, DROPE = 32, DVA = 64, HA = 8, HI = 8, DI = 32, TOPK = 256;
constexpr int NG = 3, HB = 4, DHB = 64, NMOD = 9, DIN = 5064;
constexpr int C_CQ = 0, C_CKV = 384, C_KR = 640, C_KI = 672, C_WI = 704, C_QKV = 712, C_GATE = 3016;
constexpr float EPS = 1e-6f, LOG2E = 1.4426950408889634f;
typedef _Float16 h16;

constexpr size_t MiB = 1u << 20;
constexpr size_t OFF_CTL = 0, OFF_MOD = 1 * MiB, OFF_ROPE = 2 * MiB, OFF_W = 8 * MiB, OFF_H = 60 * MiB, OFF_A = 92 * MiB, OFF_F = 180 * MiB, OFF_SP = 244 * MiB, WS_END = 256 * MiB;
constexpr size_t OFF_QB = OFF_A, OFF_KB = OFF_A + 24 * MiB, OFF_VT = OFF_A + 48 * MiB, OFF_CKV = OFF_A + 72 * MiB, OFF_KR = OFF_A + 80 * MiB, OFF_KI = OFF_A + 81 * MiB,
                 OFF_WI = OFF_A + 82 * MiB, OFF_SSQ = OFF_A + 82 * MiB + 512 * 1024, OFF_CQ = OFF_SP;
constexpr size_t OFF_OG = OFF_F, OFF_LSE = OFF_F + 24 * MiB, OFF_QLAT = OFF_A, OFF_QR = OFF_A + 64 * MiB, OFF_QI = OFF_F + 25 * MiB, OFF_SEL = OFF_F + 33 * MiB, OFF_OB = OFF_SP;
constexpr size_t OFF_Y1 = OFF_F, OFF_Y2 = OFF_F + 32 * MiB, OFF_YF = OFF_A;

__device__ __forceinline__ float silu_f(float v) { return v / (1.f + __expf(-v)); }
__device__ __forceinline__ float sigm_f(float v) { return 1.f / (1.f + __expf(-v)); }
__device__ __forceinline__ float block_sum256(float v, float* red) {
#pragma unroll
    for (int o = 32; o > 0; o >>= 1) v += __shfl_xor(v, o);
    __syncthreads();
    if ((threadIdx.x & 63) == 0) red[threadIdx.x >> 6] = v;
    __syncthreads();
    return red[0] + red[1] + red[2] + red[3];
}
__device__ __forceinline__ float block_max256(float v, float* red) {
#pragma unroll
    for (int o = 32; o > 0; o >>= 1) v = fmaxf(v, __shfl_xor(v, o));
    __syncthreads();
    if ((threadIdx.x & 63) == 0) red[threadIdx.x >> 6] = v;
    __syncthreads();
    return fmaxf(fmaxf(red[0], red[1]), fmaxf(red[2], red[3]));
}

__global__ void n_mod(const float* c, const float* w_mod, const float* b_mod, float* mod) {
    const int j = blockIdx.x * 256 + threadIdx.x, b = blockIdx.y;
    float acc = b_mod[j];
    for (int k = 0; k < DM; ++k) acc += silu_f(c[b * DM + k]) * w_mod[(size_t)k * (NMOD * DM) + j];
    mod[b * (NMOD * DM) + j] = acc;
}
__global__ void n_rope_tab(const int* pos, float2* tab) {
    const int idx = blockIdx.x * 256 + threadIdx.x; if (idx >= MT * 48) return;
    const int tok = idx / 48, i = idx % 48;
    const float inv = (i < 32) ? powf(10000.f, -(float)i / 32.f) : powf(10000.f, -(float)(i - 32) / 16.f);
    const float ang = (float)pos[tok] * inv;
    tab[idx] = make_float2(cosf(ang), sinf(ang));
}
__global__ void n_normmod(const float* x, const float* g, const float* mod, int isc, int ish, h16* out) {
    __shared__ float red[4];
    const int row = blockIdx.x, b = row / SEQ, t = threadIdx.x;
    const float4 v = ((const float4*)(x + (size_t)row * DM))[t];
    const float ss = block_sum256(v.x * v.x + v.y * v.y + v.z * v.z + v.w * v.w, red);
    const float rstd = rsqrtf(ss * (1.f / DM) + EPS);
    const float* sc = mod + b * (NMOD * DM) + isc * DM; const float* sh = mod + b * (NMOD * DM) + ish * DM;
    const float vv[4] = {v.x, v.y, v.z, v.w};
#pragma unroll
    for (int e = 0; e < 4; ++e) { const int cidx = 4 * t + e; out[(size_t)row * DM + cidx] = (h16)(vv[e] * rstd * g[cidx] * (1.f + sc[cidx]) + sh[cidx]); }
}
__global__ void n_resnorm(const float* xin, const float* f, const float* g, const float* mod, int igt, float coef, float* xout) {
    __shared__ float red[4];
    const int row = blockIdx.x, b = row / SEQ, t = threadIdx.x;
    const float4 v = ((const float4*)(f + (size_t)row * DM))[t];
    const float ss = block_sum256(v.x * v.x + v.y * v.y + v.z * v.z + v.w * v.w, red);
    const float rstd = rsqrtf(ss * (1.f / DM) + EPS);
    const float* gt = mod + b * (NMOD * DM) + igt * DM;
    const float4 xi = ((const float4*)(xin + (size_t)row * DM))[t];
    const float vv[4] = {v.x, v.y, v.z, v.w}, xx[4] = {xi.x, xi.y, xi.z, xi.w};
    float o[4];
#pragma unroll
    for (int e = 0; e < 4; ++e) { const int cidx = 4 * t + e; o[e] = xx[e] + coef * gt[cidx] * vv[e] * rstd * g[cidx]; }
    ((float4*)(xout + (size_t)row * DM))[t] = make_float4(o[0], o[1], o[2], o[3]);
}
template <typename TA>
__global__ void __launch_bounds__(256) n_gemm(const TA* A, int lda, const float* B, int ldb, const float* bs, float* C, int ldc, int N, int K) {
    __shared__ float As[16][65], Bs[16][65];
    const int tx = threadIdx.x & 15, ty = threadIdx.x >> 4, m0 = blockIdx.y * 64, n0 = blockIdx.x * 64;
    float acc[4][4] = {};
    for (int k0 = 0; k0 < K; k0 += 16) {
        for (int i = threadIdx.x; i < 1024; i += 256) { const int r = i >> 4, kk = i & 15; As[kk][r] = (float)A[(size_t)(m0 + r) * lda + k0 + kk]; }
        for (int i = threadIdx.x; i < 1024; i += 256) { const int kk = i >> 6, cc = i & 63; const int n = n0 + cc; Bs[kk][cc] = (n < N) ? B[(size_t)(k0 + kk) * ldb + n] * (bs ? bs[k0 + kk] : 1.f) : 0.f; }
        __syncthreads();
#pragma unroll
        for (int kk = 0; kk < 16; ++kk) {
            float a[4], b[4];
#pragma unroll
            for (int i = 0; i < 4; ++i) { a[i] = As[kk][ty * 4 + i]; b[i] = Bs[kk][tx * 4 + i]; }
#pragma unroll
            for (int i = 0; i < 4; ++i)
#pragma unroll
                for (int j = 0; j < 4; ++j) acc[i][j] += a[i] * b[j];
        }
        __syncthreads();
    }
#pragma unroll
    for (int i = 0; i < 4; ++i)
#pragma unroll
        for (int j = 0; j < 4; ++j) { const int n = n0 + tx * 4 + j; if (n < N) C[(size_t)(m0 + ty * 4 + i) * ldc + n] = acc[i][j]; }
}
__global__ void __launch_bounds__(256) n_gemm_swiglu(const h16* A, const float* Wg, const float* Wu, h16* out) {
    __shared__ float As[16][65], Bg[16][65], Bu[16][65];
    const int tx = threadIdx.x & 15, ty = threadIdx.x >> 4, m0 = blockIdx.y * 64, n0 = blockIdx.x * 64;
    float ag[4][4] = {}, au[4][4] = {};
    for (int k0 = 0; k0 < DM; k0 += 16) {
        for (int i = threadIdx.x; i < 1024; i += 256) { const int r = i >> 4, kk = i & 15; As[kk][r] = (float)A[(size_t)(m0 + r) * DM + k0 + kk]; }
        for (int i = threadIdx.x; i < 1024; i += 256) { const int kk = i >> 6, cc = i & 63; Bg[kk][cc] = Wg[(size_t)(k0 + kk) * FF + n0 + cc]; Bu[kk][cc] = Wu[(size_t)(k0 + kk) * FF + n0 + cc]; }
        __syncthreads();
#pragma unroll
        for (int kk = 0; kk < 16; ++kk) {
            float a[4], g[4], u[4];
#pragma unroll
            for (int i = 0; i < 4; ++i) { a[i] = As[kk][ty * 4 + i]; g[i] = Bg[kk][tx * 4 + i]; u[i] = Bu[kk][tx * 4 + i]; }
#pragma unroll
            for (int i = 0; i < 4; ++i)
#pragma unroll
                for (int j = 0; j < 4; ++j) { ag[i][j] += a[i] * g[j]; au[i][j] += a[i] * u[j]; }
        }
        __syncthreads();
    }
#pragma unroll
    for (int i = 0; i < 4; ++i)
#pragma unroll
        for (int j = 0; j < 4; ++j) out[(size_t)(m0 + ty * 4 + i) * FF + n0 + tx * 4 + j] = (h16)(silu_f(ag[i][j]) * au[i][j]);
}
__global__ void n_post_cq(const float* tmp, h16* cq, float* ssq) {
    const int tok = blockIdx.x * 4 + (threadIdx.x >> 6), lane = threadIdx.x & 63;
    float s = 0.f;
    for (int i = lane; i < QL; i += 64) { const float v = tmp[(size_t)tok * QL + i]; s += v * v; cq[(size_t)tok * QL + i] = (h16)v; }
#pragma unroll
    for (int o = 32; o > 0; o >>= 1) s += __shfl_xor(s, o);
    if (lane < 8) ssq[tok * 8 + lane] = (lane == 0) ? s : 0.f;
}
__global__ void n_post_ckv(const float* tmp, const float* g, h16* ckv) {
    const int tok = blockIdx.x * 4 + (threadIdx.x >> 6), lane = threadIdx.x & 63;
    float v[4], s = 0.f;
#pragma unroll
    for (int e = 0; e < 4; ++e) { v[e] = tmp[(size_t)tok * KVL + lane + 64 * e]; s += v[e] * v[e]; }
#pragma unroll
    for (int o = 32; o > 0; o >>= 1) s += __shfl_xor(s, o);
    const float rstd = rsqrtf(s * (1.f / KVL) + EPS);
#pragma unroll
    for (int e = 0; e < 4; ++e) ckv[(size_t)tok * KVL + lane + 64 * e] = (h16)(v[e] * rstd * g[lane + 64 * e]);
}
__global__ void n_post_small(const float* tmp, const float2* tab, h16* kr, h16* ki, float* wi) {
    const int idx = blockIdx.x * 256 + threadIdx.x; if (idx >= MT * 40) return;
    const int tok = idx / 40, j = idx % 40; const float* r = tmp + (size_t)tok * 72;
    if (j < 32) { const int which = j >> 4, i = j & 15; const float2 cs = tab[tok * 48 + 32 + i]; const float x1 = r[which * 32 + i], x2 = r[which * 32 + 16 + i];
        h16* o = (which ? ki : kr) + (size_t)tok * 32; o[i] = (h16)(x1 * cs.x - x2 * cs.y); o[i + 16] = (h16)(x2 * cs.x + x1 * cs.y); }
    else wi[tok * 8 + (j - 32)] = r[64 + (j - 32)] * 0.35355339059327373f;
}
__global__ void n_post_qk(const float* tmp, const float2* tab, float scale, h16* out) {
    const int idx = blockIdx.x * 256 + threadIdx.x; if (idx >= MT * 384) return;
    const int tok = idx / 384, j = idx % 384, hd = j >> 5, i = j & 31;
    const float2 cs = tab[tok * 48 + i]; const float x1 = tmp[(size_t)tok * 768 + hd * 64 + i], x2 = tmp[(size_t)tok * 768 + hd * 64 + 32 + i];
    out[(size_t)tok * 768 + hd * 64 + i] = (h16)((x1 * cs.x - x2 * cs.y) * scale); out[(size_t)tok * 768 + hd * 64 + 32 + i] = (h16)((x2 * cs.x + x1 * cs.y) * scale);
}
__host__ __device__ __forceinline__ int dil_of(int g) { return g == 0 ? 1 : (g == 1 ? 4 : 16); }
__global__ void n_post_v(const float* tmp, h16* vb) {
    const int idx = blockIdx.x * 256 + threadIdx.x; if (idx >= MT * 768) return;
    vb[idx] = (h16)tmp[idx];
}
__global__ void __launch_bounds__(256) n_post_q(const float* tmp, const float* ssq, const float* w_uk, const float2* tab, h16* qlat, h16* qr, int h0) {
    __shared__ float q[384];
    const int tok = blockIdx.x, t = threadIdx.x;
    float s = 0.f; for (int i = 0; i < 8; ++i) s += ssq[tok * 8 + i];
    const float rstd = rsqrtf(s * (1.f / QL) + EPS), c2 = 0.10206207261596575f * LOG2E;
    for (int i = t; i < 384; i += 256) q[i] = tmp[(size_t)tok * 384 + i] * rstd;
    __syncthreads();
    if (t < 64) { const int hl = t >> 4, i = t & 15, hd = h0 + hl; const float2 cs = tab[tok * 48 + 32 + i]; const float x1 = q[hl * 96 + 64 + i], x2 = q[hl * 96 + 80 + i];
        qr[(size_t)tok * 256 + hd * 32 + i] = (h16)((x1 * cs.x - x2 * cs.y) * c2); qr[(size_t)tok * 256 + hd * 32 + 16 + i] = (h16)((x2 * cs.x + x1 * cs.y) * c2); }
    for (int hl = 0; hl < 4; ++hl) { const int hd = h0 + hl; float a = 0.f; const float* w = w_uk + (size_t)t * 512 + hd * 64;
        for (int n = 0; n < 64; ++n) a += q[hl * 96 + n] * w[n];
        qlat[(size_t)tok * 2048 + hd * 256 + t] = (h16)(a * c2); }
}
__global__ void n_post_qi(const float* tmp, const float* ssq, const float2* tab, h16* qi) {
    const int idx = blockIdx.x * 256 + threadIdx.x; if (idx >= MT * 128) return;
    const int tok = idx / 128, j = idx % 128, hd = j >> 4, i = j & 15;
    float s = 0.f; for (int e = 0; e < 8; ++e) s += ssq[tok * 8 + e];
    const float rstd = rsqrtf(s * (1.f / QL) + EPS);
    const float2 cs = tab[tok * 48 + 32 + i]; const float x1 = tmp[(size_t)tok * 256 + hd * 32 + i] * rstd, x2 = tmp[(size_t)tok * 256 + hd * 32 + 16 + i] * rstd;
    qi[(size_t)tok * 256 + hd * 32 + i] = (h16)(x1 * cs.x - x2 * cs.y); qi[(size_t)tok * 256 + hd * 32 + 16 + i] = (h16)(x2 * cs.x + x1 * cs.y);
}
__device__ __forceinline__ unsigned fkey(float f) { const unsigned u = __float_as_uint(f); return (u & 0x80000000u) ? ~u : (u | 0x80000000u); }
__global__ void __launch_bounds__(256) n_topk(const h16* qi, const h16* ki, const float* wi, unsigned short* sel) {
    __shared__ unsigned key[SEQ]; __shared__ float q[256]; __shared__ float w[8]; __shared__ unsigned cnt;
    const int tok = blockIdx.x, b = tok / SEQ, t = tok % SEQ, tid = threadIdx.x;
    unsigned short* so = sel + (size_t)tok * TOPK;
    if (t < TOPK) { so[tid] = (unsigned short)(tid <= t ? tid : 0); return; }
    q[tid] = (float)qi[(size_t)tok * 256 + tid]; if (tid < 8) w[tid] = wi[tok * 8 + tid];
    __syncthreads();
    const int n = t + 1;
#pragma unroll 1
    for (int s = tid; s < n; s += 256) {
        const h16* kp = ki + (size_t)(b * SEQ + s) * 32;
        float a[8];
#pragma unroll
        for (int hd = 0; hd < 8; ++hd) a[hd] = 0.f;
#pragma unroll 4
        for (int e = 0; e < 32; ++e) { const float kv = (float)kp[e];
#pragma unroll
            for (int hd = 0; hd < 8; ++hd) a[hd] += q[hd * 32 + e] * kv; }
        float sc = 0.f;
#pragma unroll
        for (int hd = 0; hd < 8; ++hd) sc += w[hd] * fmaxf(a[hd] * 0.17677669529663687f, 0.f);
        key[s] = fkey(sc);
    }
    __syncthreads();
    unsigned T = 0;
    for (int bit = 31; bit >= 0; --bit) {
        const unsigned cand = T | (1u << bit);
        if (tid == 0) cnt = 0; __syncthreads();
        unsigned c = 0; for (int s = tid; s < n; s += 256) c += (key[s] >= cand) ? 1u : 0u;
#pragma unroll
        for (int o = 32; o > 0; o >>= 1) c += __shfl_xor(c, o);
        if ((tid & 63) == 0) atomicAdd(&cnt, c);
        __syncthreads();
        if (cnt >= TOPK) T = cand;
        __syncthreads();
    }
    if (tid == 0) cnt = 0; __syncthreads();
    for (int s = tid; s < n; s += 256) if (key[s] > T) { const unsigned p = atomicAdd(&cnt, 1u); so[p] = (unsigned short)s; }
    __syncthreads();
    if (tid == 0) { unsigned p = cnt; for (int s = 0; s < n && p < TOPK; ++s) if (key[s] == T) so[p++] = (unsigned short)s; }
}
__global__ void __launch_bounds__(256) n_sparse(h16* qlat, const h16* qr, const h16* ckv, const h16* kr, const unsigned short* sel) {
    __shared__ float ql[8][256], qrr[8][32], p[8][256], red[4]; __shared__ int rows[256];
    const int tok = blockIdx.x, b = tok / SEQ, t = tok % SEQ, tid = threadIdx.x, cnt = (t + 1 < TOPK) ? t + 1 : TOPK;
    for (int i = tid; i < 2048; i += 256) ql[i >> 8][i & 255] = (float)qlat[(size_t)tok * 2048 + i];
    qrr[tid >> 5][tid & 31] = (float)qr[(size_t)tok * 256 + tid];
    const int row = b * SEQ + (tid < cnt ? (int)sel[(size_t)tok * TOPK + tid] : 0); rows[tid] = row;
    __syncthreads();
    float s[8];
#pragma unroll
    for (int hd = 0; hd < 8; ++hd) s[hd] = 0.f;
    if (tid < cnt) {
        const h16* kp = ckv + (size_t)row * 256;
        for (int r = 0; r < 256; ++r) { const float kvv = (float)kp[r];
#pragma unroll
            for (int hd = 0; hd < 8; ++hd) s[hd] += ql[hd][r] * kvv; }
        const h16* rp = kr + (size_t)row * 32;
        for (int e = 0; e < 32; ++e) { const float kvv = (float)rp[e];
#pragma unroll
            for (int hd = 0; hd < 8; ++hd) s[hd] += qrr[hd][e] * kvv; }
    } else {
#pragma unroll
        for (int hd = 0; hd < 8; ++hd) s[hd] = -INFINITY;
    }
    float linv[8];
#pragma unroll
    for (int hd = 0; hd < 8; ++hd) {
        const float m = block_max256(s[hd], red);
        const float e = (tid < cnt) ? exp2f(s[hd] - m) : 0.f;
        p[hd][tid] = e;
        linv[hd] = 1.f / block_sum256(e, red);
    }
    __syncthreads();
    float o[8];
#pragma unroll
    for (int hd = 0; hd < 8; ++hd) o[hd] = 0.f;
    for (int k = 0; k < cnt; ++k) { const float v = (float)ckv[(size_t)rows[k] * 256 + tid];
#pragma unroll
        for (int hd = 0; hd < 8; ++hd) o[hd] += p[hd][k] * v; }
#pragma unroll
    for (int hd = 0; hd < 8; ++hd) qlat[(size_t)tok * 2048 + hd * 256 + tid] = (h16)(o[hd] * linv[hd]);
}
__global__ void __launch_bounds__(128) n_dilated(const h16* qb, const h16* kb, const h16* vT, h16* og, float* lse2) {
    __shared__ float q[64], p[132], red[2]; __shared__ int kidx[132];
    const int tok = blockIdx.x, gh = blockIdx.y, g = gh >> 2, b = tok / SEQ, t = tok % SEQ, tid = threadIdx.x, dil = dil_of(g);
    if (tid < 64) q[tid] = (float)qb[(size_t)tok * 768 + gh * 64 + tid];
    __syncthreads();
    float sc[2]; float m = -INFINITY;
    for (int r = 0; r < 2; ++r) { const int k = tid + r * 128; sc[r] = -INFINITY;
        if (k < 129) { const int ti = t - k * dil; kidx[k] = ti;
            if (ti >= 0) { const h16* kp = kb + (size_t)(b * SEQ + ti) * 768 + gh * 64; float a = 0.f; for (int d = 0; d < 64; ++d) a += q[d] * (float)kp[d]; sc[r] = a; } }
        m = fmaxf(m, sc[r]); }
#pragma unroll
    for (int o = 32; o > 0; o >>= 1) m = fmaxf(m, __shfl_xor(m, o));
    if ((tid & 63) == 0) red[tid >> 6] = m; __syncthreads(); m = fmaxf(red[0], red[1]); __syncthreads();
    float l = 0.f;
    for (int r = 0; r < 2; ++r) { const int k = tid + r * 128; if (k < 129) { const float e = (sc[r] == -INFINITY) ? 0.f : exp2f(sc[r] - m); p[k] = e; l += e; } }
#pragma unroll
    for (int o = 32; o > 0; o >>= 1) l += __shfl_xor(l, o);
    if ((tid & 63) == 0) red[tid >> 6] = l; __syncthreads(); l = red[0] + red[1];
    if (tid < 64) { float a = 0.f; const h16* vp = vT + (size_t)(b * SEQ) * 768 + gh * 64 + tid;
        for (int k = 0; k < 129; ++k) { const int ti = kidx[k]; if (ti >= 0) a += p[k] * (float)vp[(size_t)ti * 768]; }
        og[(size_t)tok * 768 + gh * 64 + tid] = (h16)(a / l); }
    if (tid == 0) lse2[tok * 12 + gh] = m + log2f(l);
}
__global__ void n_combine(const h16* og, const float* lse2, h16* ob) {
    const int idx = blockIdx.x * 256 + threadIdx.x; if (idx >= MT * 256) return;
    const int tok = idx >> 8, c = idx & 255, hh = c >> 6;
    const float l0 = lse2[tok * 12 + hh], l1 = lse2[tok * 12 + 4 + hh], l2 = lse2[tok * 12 + 8 + hh], m = fmaxf(l0, fmaxf(l1, l2));
    const float w0 = exp2f(l0 - m), w1 = exp2f(l1 - m), w2 = exp2f(l2 - m), inv = 1.f / (w0 + w1 + w2);
    ob[idx] = (h16)((w0 * (float)og[(size_t)tok * 768 + c] + w1 * (float)og[(size_t)tok * 768 + 256 + c] + w2 * (float)og[(size_t)tok * 768 + 512 + c]) * inv);
}
__global__ void __launch_bounds__(256) n_oa(const h16* olat, const float* w_uv, h16* oa) {
    __shared__ float ol[2048];
    const int tok = blockIdx.x, tid = threadIdx.x;
    for (int i = tid; i < 2048; i += 256) ol[i] = (float)olat[(size_t)tok * 2048 + i];
    __syncthreads();
    for (int o = tid; o < 512; o += 256) { const int hd = o >> 6; float a = 0.f; for (int r = 0; r < 256; ++r) a += ol[hd * 256 + r] * w_uv[(size_t)r * 512 + o]; oa[(size_t)tok * 512 + o] = (h16)a; }
}
__global__ void n_gate(const float* tg, const float* ty, h16* z, int n0, int accum) {
    const size_t idx = (size_t)blockIdx.x * 256 + threadIdx.x; const size_t row = idx >> 8; const int col = (int)(idx & 255);
    h16* zp = z + row * DM + n0 + col;
    const float v = (accum == 2) ? ty[idx] : (sigm_f(tg[idx]) * ty[idx] + (accum ? (float)*zp : 0.f));
    *zp = (h16)v;
}
__global__ void n_f32_to_f16(const float* a, h16* o) { const size_t idx = (size_t)blockIdx.x * 256 + threadIdx.x; o[idx] = (h16)a[idx]; }


#define LAS __attribute__((address_space(3)))
#define GAS __attribute__((address_space(1)))
typedef _Float16 f16x8 __attribute__((ext_vector_type(8)));
typedef float f32x4 __attribute__((ext_vector_type(4)));
typedef float f32x2 __attribute__((ext_vector_type(2)));
typedef unsigned u32x4 __attribute__((ext_vector_type(4)));
typedef unsigned u32x2 __attribute__((ext_vector_type(2)));
typedef _Float16 h16x2 __attribute__((ext_vector_type(2)));
__device__ __forceinline__ unsigned pk_h2(float lo, float hi) { f32x2 v = {lo, hi}; h16x2 h = __builtin_convertvector(v, h16x2); return __builtin_bit_cast(unsigned, h); }

namespace pg8 {
constexpr int BM = 256, BK = 64, HALF = 128, HTB = HALF * BK * 2, STAGE_BYTES = 8 * HTB, NXCD = 8, WGM = 8;
__host__ __device__ __forceinline__ int lds_byte(int r, int c) { const int st = (r >> 4) * 2 + (c >> 5), rr = r & 15, cc = c & 31, ob = rr * 64 + cc * 2; return st * 1024 + (ob ^ (((ob >> 9) & 1) << 5)); }
__host__ __device__ __forceinline__ void stage_rc(int b, int& R, int& C) { const int st = b / 1024, sb = b % 1024, swz = sb ^ (((sb >> 9) & 1) << 5); R = (st >> 1) * 16 + swz / 64; C = (st & 1) * 32 + (swz % 64) / 2; }
__host__ __device__ __forceinline__ int perm32(int rho) { const int n = rho >> 4, i = rho & 15; return 8 * (i >> 2) + 4 * n + (i & 3); }
struct Unit { int pm, pn; };
struct Gemm { const h16* A; const h16* Bt; int M, N, K; };
struct StaticOrder {
    int nM, nN, nwg, G, c;
    __host__ __device__ void init(int M, int N, int G_, int c_) { nM = M / BM; nN = N / BM; nwg = nM * nN; G = G_; c = c_; }
    __host__ __device__ bool next(int i, Unit& u) const {
        const long L = (long)i * G + c; if (L >= nwg) return false;
        int wgid = (int)L; { const int q = nwg / NXCD, r = nwg % NXCD, xcd = wgid % NXCD, off = wgid / NXCD; wgid = (xcd < r ? xcd * (q + 1) : r * (q + 1) + (xcd - r) * q) + off; }
        const int nig = WGM * nN, gid = wgid / nig, fm = gid * WGM, gsz = (nM - fm) < WGM ? (nM - fm) : WGM;
        u.pm = fm + ((wgid % nig) % gsz); u.pn = (wgid % nig) / gsz; return true;
    }
};
template <class Epi, bool ALIGN_EPI>
__device__ __forceinline__ void gemm_phase(LAS unsigned char* lds, const Gemm g, const StaticOrder& S, const Epi& E) {
    const int tid = threadIdx.x, wid = __builtin_amdgcn_readfirstlane(tid >> 6), lane = tid & 63, wr = wid >> 2, wc = wid & 3, fr = lane & 15, fq = lane >> 4;
    const int K = g.K, nt = K / BK;
    unsigned voffA[2], voffB[2];
#pragma unroll
    for (int i = 0; i < 2; ++i) { int R, C; stage_rc(tid * 16 + i * 8192, R, C); const int Rb = Epi::PERM ? ((R & ~31) + perm32(R & 31)) : R;
        voffA[i] = (unsigned)(R * K + C) * 2u; voffB[i] = (unsigned)(Rb * K + C) * 2u; }
    const size_t kstep = (size_t)(BK * 2);
    const size_t hstep = (size_t)HALF * K * 2;
    const size_t tstep = 2 * hstep;
    const unsigned ldsw = (unsigned)wid * 1024u;
    const int aoff = lds_byte(wr * 64 + fr, fq * 8), boff = lds_byte(wc * 32 + fr, fq * 8);
#define PG8_SA(b, h) (((b) * 2 + (h)) * HTB)
#define PG8_SB(b, h) ((4 + (b) * 2 + (h)) * HTB)
#define PG8_STAGE(bufoff, gbase, voff) do { _Pragma("unroll") for (int _i = 0; _i < 2; ++_i) \
        __builtin_amdgcn_global_load_lds((const unsigned*)((const char*)(gbase) + (voff)[_i]), (LAS unsigned*)(lds + (bufoff) + ldsw + _i * 8192), 16, 0, 0); } while (0)
#define PG8_LDA(dst, b, h) do { _Pragma("unroll") for (int m = 0; m < 4; ++m) _Pragma("unroll") for (int k = 0; k < 2; ++k) dst[m][k] = *(const LAS f16x8*)(lds + PG8_SA(b, h) + aoff + m * 2048 + k * 1024); } while (0)
#define PG8_LDB(dst, b, h) do { _Pragma("unroll") for (int n = 0; n < 2; ++n) _Pragma("unroll") for (int k = 0; k < 2; ++k) dst[n][k] = *(const LAS f16x8*)(lds + PG8_SB(b, h) + boff + n * 2048 + k * 1024); } while (0)
#define PG8_MMA(ai, bj, At, Bt) do { __builtin_amdgcn_s_setprio(1); _Pragma("unroll") for (int m = 0; m < 4; ++m) _Pragma("unroll") for (int n = 0; n < 2; ++n) _Pragma("unroll") for (int k = 0; k < 2; ++k) \
        acc[ai][bj][m][n] = __builtin_amdgcn_mfma_f32_16x16x32_f16(Bt[n][k], At[m][k], acc[ai][bj][m][n], 0, 0, 0); __builtin_amdgcn_s_setprio(0); } while (0)
#define PG8_WAIT_V(n) asm volatile("s_waitcnt vmcnt(" #n ")" ::: "memory")
#define PG8_WAIT_L(n) asm volatile("s_waitcnt lgkmcnt(" #n ")" ::: "memory")
#define PG8_BAR __builtin_amdgcn_s_barrier()
#define PG8_SCHED __builtin_amdgcn_sched_barrier(0)
    Unit cur, nxt; int ui = 0;
    if (!S.next(0, cur)) return;
    f32x4 acc[2][2][4][2];
#pragma unroll
    for (int a = 0; a < 2; ++a)
#pragma unroll
        for (int b = 0; b < 2; ++b)
#pragma unroll
            for (int m = 0; m < 4; ++m)
#pragma unroll
                for (int n = 0; n < 2; ++n) acc[a][b][m][n] = (f32x4){0.f, 0.f, 0.f, 0.f};
    f16x8 At[4][2], B0[2][2], B1[2][2];
    const char* cA = (const char*)g.A + (size_t)cur.pm * tstep; const char* cB = (const char*)g.Bt + (size_t)cur.pn * tstep;
    PG8_STAGE(PG8_SB(0, 0), cB, voffB); PG8_STAGE(PG8_SB(0, 1), cB + hstep, voffB); PG8_STAGE(PG8_SA(0, 0), cA, voffA); PG8_STAGE(PG8_SA(0, 1), cA + hstep, voffA);
    if (wr == 1) PG8_BAR;
    PG8_WAIT_V(2); PG8_BAR;
    PG8_STAGE(PG8_SB(1, 0), cB + kstep, voffB); PG8_STAGE(PG8_SA(1, 0), cA + kstep, voffA); PG8_STAGE(PG8_SB(1, 1), cB + hstep + kstep, voffB);
    PG8_WAIT_V(6); PG8_BAR;
    for (;;) {
        const bool has_next = S.next(ui + 1, nxt);
        const char* nA = has_next ? (const char*)g.A + (size_t)nxt.pm * tstep : cA; const char* nB = has_next ? (const char*)g.Bt + (size_t)nxt.pn * tstep : cB;
        for (int t = 0; t < nt; t += 2) {
            const bool last = (t == nt - 2);
            const char* a1 = cA + (size_t)(t + 1) * kstep;
            const char* a2 = last ? nA : cA + (size_t)(t + 2) * kstep; const char* b2 = last ? nB : cB + (size_t)(t + 2) * kstep;
            const char* a3 = a2 + kstep; const char* b3 = b2 + kstep;
            PG8_LDB(B0, 0, 0); PG8_LDB(B1, 0, 1); PG8_SCHED; PG8_LDA(At, 0, 0); PG8_STAGE(PG8_SA(1, 1), a1 + hstep, voffA);
            PG8_WAIT_V(8); PG8_WAIT_L(0); PG8_BAR; PG8_MMA(0, 0, At, B0); PG8_MMA(0, 1, At, B1); PG8_BAR; PG8_SCHED;
            PG8_LDA(At, 0, 1); PG8_STAGE(PG8_SB(0, 0), b2, voffB); PG8_STAGE(PG8_SB(0, 1), b2 + hstep, voffB); PG8_STAGE(PG8_SA(0, 0), a2, voffA);
            PG8_WAIT_V(8); PG8_WAIT_L(0); PG8_BAR; PG8_MMA(1, 0, At, B0); PG8_MMA(1, 1, At, B1); PG8_BAR; PG8_SCHED;
            PG8_LDB(B0, 1, 0); PG8_LDB(B1, 1, 1); PG8_SCHED; PG8_LDA(At, 1, 0); PG8_STAGE(PG8_SA(0, 1), a2 + hstep, voffA);
            PG8_WAIT_V(8); PG8_WAIT_L(0); PG8_BAR; PG8_MMA(0, 0, At, B0); PG8_MMA(0, 1, At, B1); PG8_BAR; PG8_SCHED;
            PG8_LDA(At, 1, 1); PG8_STAGE(PG8_SB(1, 0), b3, voffB); PG8_STAGE(PG8_SB(1, 1), b3 + hstep, voffB); PG8_STAGE(PG8_SA(1, 0), a3, voffA);
            PG8_WAIT_V(8); PG8_WAIT_L(0); PG8_BAR; PG8_MMA(1, 0, At, B0); PG8_MMA(1, 1, At, B1); PG8_BAR; PG8_SCHED;
        }
        if constexpr (ALIGN_EPI) { if (wr == 0) PG8_BAR; }
        { int l2 = lane; asm volatile("" : "+v"(l2)); E(acc, cur, wr, wc, l2 & 15, l2 >> 4); }
        if (!has_next) break;
#pragma unroll
        for (int a = 0; a < 2; ++a)
#pragma unroll
            for (int b = 0; b < 2; ++b)
#pragma unroll
                for (int m = 0; m < 4; ++m)
#pragma unroll
                    for (int n = 0; n < 2; ++n) acc[a][b][m][n] = (f32x4){0.f, 0.f, 0.f, 0.f};
        cur = nxt; cA = nA; cB = nB; ++ui;
        if constexpr (ALIGN_EPI) { if (wr == 1) PG8_BAR; }
    }
    PG8_WAIT_V(0);
    if constexpr (!ALIGN_EPI) { if (wr == 0) PG8_BAR; }
    PG8_BAR;
#undef PG8_SA
#undef PG8_SB
#undef PG8_STAGE
#undef PG8_LDA
#undef PG8_LDB
#undef PG8_MMA
#undef PG8_WAIT_V
#undef PG8_WAIT_L
#undef PG8_BAR
#undef PG8_SCHED
}
struct EpiF32 {
    static constexpr bool PERM = false;
    float* C; int ldc;
    __device__ __forceinline__ void operator()(const f32x4 (&acc)[2][2][4][2], const Unit& u, int wr, int wc, int fr, int fq) const {
        const int row0 = u.pm * BM + wr * 64 + fr, col0 = u.pn * BM + wc * 32 + 4 * fq;
#pragma unroll
        for (int ai = 0; ai < 2; ++ai)
#pragma unroll
            for (int m = 0; m < 4; ++m) { float* rowp = C + (size_t)(row0 + ai * HALF + m * 16) * ldc + col0;
#pragma unroll
                for (int bj = 0; bj < 2; ++bj)
#pragma unroll
                    for (int n = 0; n < 2; ++n) *(f32x4*)(rowp + bj * HALF + n * 16) = acc[ai][bj][m][n]; }
    }
};
struct EpiSwiGLU {
    static constexpr bool PERM = true;
    h16* O;
    __device__ __forceinline__ void operator()(const f32x4 (&acc)[2][2][4][2], const Unit& u, int wr, int wc, int fr, int fq) const {
        const int row0 = u.pm * BM + wr * 64 + fr, col0 = u.pn * HALF + wc * 32 + 8 * fq;
#pragma unroll
        for (int ai = 0; ai < 2; ++ai)
#pragma unroll
            for (int m = 0; m < 4; ++m) { h16* rowp = O + (size_t)(row0 + ai * HALF + m * 16) * FF + col0;
                float v[8];
#pragma unroll
                for (int n = 0; n < 2; ++n)
#pragma unroll
                    for (int e = 0; e < 4; ++e) { const float gg = acc[ai][0][m][n][e], uu = acc[ai][1][m][n][e]; v[n * 4 + e] = gg * __builtin_amdgcn_rcpf(1.f + __builtin_amdgcn_exp2f(-gg * LOG2E)) * uu; }
                u32x4 w; w.x = pk_h2(v[0], v[1]); w.y = pk_h2(v[2], v[3]); w.z = pk_h2(v[4], v[5]); w.w = pk_h2(v[6], v[7]);
                *(u32x4*)rowp = w; }
    }
};

struct EpiIn {
    static constexpr bool PERM = false;
    h16 *ckv, *cq, *kr, *ki, *qb, *kb, *vT; float *wi, *ssq; const float* gckv; const float2* tab; LAS float* X;
    __device__ __forceinline__ void rope64(const f32x4 (&acc)[2][2][4][2], const Unit& u, int wr, int wc, int fr, int fq, h16* dst, int tl, float scale) const {
#pragma unroll
        for (int ai = 0; ai < 2; ++ai)
#pragma unroll
            for (int m = 0; m < 4; ++m) { const int tok = u.pm * BM + ai * HALF + wr * 64 + m * 16 + fr;
#pragma unroll
                for (int n = 0; n < 2; ++n) { const int i = 16 * n + 4 * fq; const f32x4* tp = (const f32x4*)(tab + (size_t)tok * 48 + i); const f32x4 t0 = tp[0], t1 = tp[1];
                    const f32x4 cs = {t0.x, t0.z, t1.x, t1.z}, sn = {t0.y, t0.w, t1.y, t1.w}, x1 = acc[ai][0][m][n], x2 = acc[ai][1][m][n];
                    const f32x4 o1 = (x1 * cs - x2 * sn) * scale, o2 = (x2 * cs + x1 * sn) * scale;
                    h16* p = dst + (size_t)tok * 768 + (4 * tl + wc) * 64 + i;
                    u32x2 w1, w2; w1.x = pk_h2(o1.x, o1.y); w1.y = pk_h2(o1.z, o1.w); w2.x = pk_h2(o2.x, o2.y); w2.y = pk_h2(o2.z, o2.w);
                    *(u32x2*)p = w1; *(u32x2*)(p + 32) = w2; }
                asm volatile("" ::: "memory"); }
    }
    __device__ __forceinline__ void operator()(const f32x4 (&acc)[2][2][4][2], const Unit& u, int wr, int wc, int fr, int fq) const {
        const int pn = u.pn;
        if (pn == 0) {
#pragma unroll
            for (int ai = 0; ai < 2; ++ai)
#pragma unroll
                for (int m = 0; m < 4; ++m) { float sq = 0.f;
#pragma unroll
                    for (int bj = 0; bj < 2; ++bj)
#pragma unroll
                        for (int n = 0; n < 2; ++n) { const f32x4 v = acc[ai][bj][m][n]; sq += (v.x * v.x + v.y * v.y) + (v.z * v.z + v.w * v.w); }
                    sq += __shfl_xor(sq, 16); sq += __shfl_xor(sq, 32);
                    if (fq == 0) X[(ai * HALF + wr * 64 + m * 16 + fr) * 4 + wc] = sq; }
            asm volatile("s_waitcnt lgkmcnt(0)" ::: "memory"); __builtin_amdgcn_s_barrier(); asm volatile("" ::: "memory");
#pragma unroll
            for (int ai = 0; ai < 2; ++ai)
#pragma unroll
                for (int m = 0; m < 4; ++m) { const int rl = ai * HALF + wr * 64 + m * 16 + fr, tok = u.pm * BM + rl; const f32x4 p = *(const LAS f32x4*)(X + rl * 4);
                    const float rstd = rsqrtf(((p.x + p.y) + (p.z + p.w)) * (1.f / KVL) + EPS);
#pragma unroll
                    for (int bj = 0; bj < 2; ++bj)
#pragma unroll
                        for (int n = 0; n < 2; ++n) { const int col = bj * HALF + wc * 32 + n * 16 + 4 * fq; const f32x4 o = acc[ai][bj][m][n] * rstd * *(const f32x4*)(gckv + col);
                            u32x2 w; w.x = pk_h2(o.x, o.y); w.y = pk_h2(o.z, o.w); *(u32x2*)(ckv + (size_t)tok * KVL + col) = w; }
                    asm volatile("" ::: "memory"); }
            asm volatile("s_waitcnt lgkmcnt(0)" ::: "memory"); __builtin_amdgcn_s_barrier(); asm volatile("" ::: "memory");
        } else if (pn <= 2) {
#pragma unroll
            for (int ai = 0; ai < 2; ++ai)
#pragma unroll
                for (int m = 0; m < 4; ++m) { const int tok = u.pm * BM + ai * HALF + wr * 64 + m * 16 + fr; float sq = 0.f;
#pragma unroll
                    for (int bj = 0; bj < 2; ++bj) { if (pn == 2 && bj == 1) break;
#pragma unroll
                        for (int n = 0; n < 2; ++n) { const f32x4 v = acc[ai][bj][m][n]; sq += (v.x * v.x + v.y * v.y) + (v.z * v.z + v.w * v.w);
                            const int col = (pn - 1) * 256 + bj * HALF + wc * 32 + n * 16 + 4 * fq; u32x2 w; w.x = pk_h2(v.x, v.y); w.y = pk_h2(v.z, v.w); *(u32x2*)(cq + (size_t)tok * QL + col) = w; } }
                    sq += __shfl_xor(sq, 16); sq += __shfl_xor(sq, 32);
                    if (fq == 0) ssq[tok * 8 + (pn - 1) * 4 + wc] = sq;
                    if (pn == 2) {
                        if (wc < 2) { const int i = 4 * fq; const f32x4* tp = (const f32x4*)(tab + (size_t)tok * 48 + 32 + i); const f32x4 t0 = tp[0], t1 = tp[1];
                            const f32x4 cs = {t0.x, t0.z, t1.x, t1.z}, sn = {t0.y, t0.w, t1.y, t1.w}, x1 = acc[ai][1][m][0], x2 = acc[ai][1][m][1];
                            const f32x4 o1 = x1 * cs - x2 * sn, o2 = x2 * cs + x1 * sn; h16* p = (wc == 0 ? kr : ki) + (size_t)tok * 32 + i;
                            u32x2 w1, w2; w1.x = pk_h2(o1.x, o1.y); w1.y = pk_h2(o1.z, o1.w); w2.x = pk_h2(o2.x, o2.y); w2.y = pk_h2(o2.z, o2.w);
                            *(u32x2*)p = w1; *(u32x2*)(p + 16) = w2; }
                        else if (wc == 2 && fq < 2) { *(f32x4*)(wi + tok * 8 + 4 * fq) = acc[ai][1][m][0] * 0.35355339059327373f; }
                    }
                    asm volatile("" ::: "memory"); }
        } else if (pn <= 5) rope64(acc, u, wr, wc, fr, fq, qb, pn - 3, 0.125f * LOG2E);
        else if (pn <= 8) rope64(acc, u, wr, wc, fr, fq, kb, pn - 6, 1.0f);
        else {
#pragma unroll
            for (int ai = 0; ai < 2; ++ai)
#pragma unroll
                for (int m = 0; m < 4; ++m) { const int tok = u.pm * BM + ai * HALF + wr * 64 + m * 16 + fr;
#pragma unroll
                    for (int bj = 0; bj < 2; ++bj)
#pragma unroll
                        for (int n = 0; n < 2; ++n) { const f32x4 v = acc[ai][bj][m][n]; u32x2 w; w.x = pk_h2(v.x, v.y); w.y = pk_h2(v.z, v.w);
                            *(u32x2*)(vT + (size_t)tok * 768 + (pn - 9) * 256 + bj * HALF + wc * 32 + n * 16 + 4 * fq) = w; }
                    asm volatile("" ::: "memory"); }
        }
    }
};
struct Epi4 {
    static constexpr bool PERM = false;
    h16 *qlat, *qr, *qi; const float* ssq; const float2* tab;
    __device__ __forceinline__ void operator()(const f32x4 (&acc)[2][2][4][2], const Unit& u, int wr, int wc, int fr, int fq) const {
        const int pn = u.pn; const float c2 = 0.10206207261596575f * LOG2E;
#pragma unroll
        for (int ai = 0; ai < 2; ++ai)
#pragma unroll
            for (int m = 0; m < 4; ++m) { const int tok = u.pm * BM + ai * HALF + wr * 64 + m * 16 + fr;
                const f32x4 s0 = *(const f32x4*)(ssq + tok * 8), s1 = *(const f32x4*)(ssq + tok * 8 + 4);
                const float rstd = rsqrtf((((s0.x + s0.y) + (s0.z + s0.w)) + ((s1.x + s1.y) + (s1.z + s1.w))) * (1.f / QL) + EPS);
                if (pn < 8) {
#pragma unroll
                    for (int bj = 0; bj < 2; ++bj)
#pragma unroll
                        for (int n = 0; n < 2; ++n) { const int col = bj * HALF + wc * 32 + n * 16 + 4 * fq; const f32x4 o = acc[ai][bj][m][n] * (rstd * c2);
                            u32x2 w; w.x = pk_h2(o.x, o.y); w.y = pk_h2(o.z, o.w); *(u32x2*)(qlat + (size_t)tok * 2048 + pn * 256 + col) = w; }
                } else { const float sc = (pn == 8) ? rstd * c2 : rstd; h16* dst = (pn == 8) ? qr : qi;
                    const int i = 4 * fq; const f32x4* tp = (const f32x4*)(tab + (size_t)tok * 48 + 32 + i); const f32x4 t0 = tp[0], t1 = tp[1];
                    const f32x4 cs = {t0.x, t0.z, t1.x, t1.z}, sn = {t0.y, t0.w, t1.y, t1.w};
#pragma unroll
                    for (int bj = 0; bj < 2; ++bj) { const f32x4 x1 = acc[ai][bj][m][0], x2 = acc[ai][bj][m][1]; const f32x4 o1 = (x1 * cs - x2 * sn) * sc, o2 = (x2 * cs + x1 * sn) * sc;
                        h16* p = dst + (size_t)tok * 256 + (4 * bj + wc) * 32 + i;
                        u32x2 w1, w2; w1.x = pk_h2(o1.x, o1.y); w1.y = pk_h2(o1.z, o1.w); w2.x = pk_h2(o2.x, o2.y); w2.y = pk_h2(o2.z, o2.w);
                        *(u32x2*)p = w1; *(u32x2*)(p + 16) = w2; } }
                asm volatile("" ::: "memory"); }
    }
};
__device__ __forceinline__ u32x4 ld16_l2(const h16* p) {
    const unsigned long long a = __hip_atomic_load((const unsigned long long*)p, __ATOMIC_RELAXED, __HIP_MEMORY_SCOPE_AGENT), b = __hip_atomic_load((const unsigned long long*)p + 1, __ATOMIC_RELAXED, __HIP_MEMORY_SCOPE_AGENT);
    return (u32x4){(unsigned)a, (unsigned)(a >> 32), (unsigned)b, (unsigned)(b >> 32)};
}
typedef _Float16 h16x8 __attribute__((ext_vector_type(8)));
__device__ __forceinline__ void unpk8(const u32x4 w, float (&f)[8]) {
    const h16x8 h = __builtin_bit_cast(h16x8, w);
#pragma unroll
    for (int i = 0; i < 8; ++i) f[i] = (float)h[i];
}
struct EpiH16 {
    static constexpr bool PERM = true;
    h16* O;
    __device__ __forceinline__ void operator()(const f32x4 (&acc)[2][2][4][2], const Unit& u, int wr, int wc, int fr, int fq) const {
        const int row0 = u.pm * BM + wr * 64 + fr, col0 = u.pn * BM + wc * 32 + 8 * fq;
#pragma unroll
        for (int ai = 0; ai < 2; ++ai)
#pragma unroll
            for (int m = 0; m < 4; ++m)
#pragma unroll
                for (int bj = 0; bj < 2; ++bj) { const f32x4 v0 = acc[ai][bj][m][0], v1 = acc[ai][bj][m][1];
                    u32x4 w; w.x = pk_h2(v0.x, v0.y); w.y = pk_h2(v0.z, v0.w); w.z = pk_h2(v1.x, v1.y); w.w = pk_h2(v1.z, v1.w);
                    *(u32x4*)(O + (size_t)(row0 + ai * HALF + m * 16) * DM + col0 + bj * HALF) = w; }
    }
};
struct EpiGate {
    static constexpr bool PERM = true;
    const h16* Y; h16* Z; int accum;
    __device__ __forceinline__ void operator()(const f32x4 (&acc)[2][2][4][2], const Unit& u, int wr, int wc, int fr, int fq) const {
        const int row0 = u.pm * BM + wr * 64 + fr, col0 = u.pn * BM + wc * 32 + 8 * fq;
#pragma unroll
        for (int ai = 0; ai < 2; ++ai)
#pragma unroll
            for (int m = 0; m < 4; ++m)
#pragma unroll
                for (int bj = 0; bj < 2; ++bj) { const size_t off = (size_t)(row0 + ai * HALF + m * 16) * DM + col0 + bj * HALF;
                    float y[8], zz[8]; unpk8(ld16_l2(Y + off), y);
                    if (accum) unpk8(ld16_l2(Z + off), zz); else {
#pragma unroll
                        for (int i = 0; i < 8; ++i) zz[i] = 0.f; }
                    float o[8];
#pragma unroll
                    for (int n = 0; n < 2; ++n)
#pragma unroll
                        for (int e = 0; e < 4; ++e) { const float gg = acc[ai][bj][m][n][e]; o[n * 4 + e] = zz[n * 4 + e] + y[n * 4 + e] * __builtin_amdgcn_rcpf(1.f + __builtin_amdgcn_exp2f(-gg * LOG2E)); }
                    u32x4 w; w.x = pk_h2(o[0], o[1]); w.y = pk_h2(o[2], o[3]); w.z = pk_h2(o[4], o[5]); w.w = pk_h2(o[6], o[7]);
                    *(u32x4*)(Z + off) = w; }
    }
};
}

#define XB_TMO      128
#define XB_XCNT(j)  (256  + 64 * (j))
#define XB_XSUB(j)  (1280 + 64 * (j))
#define XB_XGEN(j)  (2304 + 64 * (j))
#define XB_TOP      3328
#define XB_TOPGEN   3392
#define XCD_BAR_WORDS 3456
#define XB_SPIN_CAP (1u << 18)
__device__ __forceinline__ unsigned xb_ld(unsigned* p)              { return __hip_atomic_load(p, __ATOMIC_RELAXED, __HIP_MEMORY_SCOPE_AGENT); }
__device__ __forceinline__ unsigned xb_add(unsigned* p, unsigned v) { return __hip_atomic_fetch_add(p, v, __ATOMIC_RELAXED, __HIP_MEMORY_SCOPE_AGENT); }
__device__ __forceinline__ unsigned xb_xcc_id() { return (unsigned)__builtin_amdgcn_s_getreg((3 << 11) | 20) & 0xFu; }
#define XB_SPIN(cond, bar) do { unsigned _sp = 0; while (cond) { __builtin_amdgcn_s_sleep(1); \
    if ((++_sp & 255u) == 0u) { if (xb_ld(&(bar)[XB_TMO])) break; if (_sp > XB_SPIN_CAP) { atomicAdd(&(bar)[XB_TMO], 1u); break; } } } } while (0)
struct XcdBarrier { unsigned* bar; unsigned x; volatile LAS unsigned* st; };
__device__ __forceinline__ XcdBarrier xcd_barrier_post(unsigned* bar, volatile LAS unsigned* st) {
    XcdBarrier b; b.bar = bar; b.x = xb_xcc_id(); b.st = st;
    if (threadIdx.x == 0) (void)xb_add(&bar[XB_XCNT(b.x)], 1u);
    return b;
}
__device__ __forceinline__ void xcd_barrier_complete(unsigned* bar, unsigned x, unsigned& nloc, unsigned& nx) {
    const unsigned G = gridDim.x * gridDim.y * gridDim.z;
    unsigned sum, cnt, mine, sp = 0u;
    for (;;) {
        sum = 0u; cnt = 0u; mine = 0u;
#pragma unroll
        for (unsigned j = 0; j < 16; ++j) { const unsigned c = xb_ld(&bar[XB_XCNT(j)]); sum += c; cnt += (c > 0u) ? 1u : 0u; mine = (j == x) ? c : mine; }
        if (sum == G) break;
        __builtin_amdgcn_s_sleep(1);
        if ((++sp & 255u) == 0u) { if (xb_ld(&bar[XB_TMO])) break; if (sp > XB_SPIN_CAP) { atomicAdd(&bar[XB_TMO], 1u); break; } }
    }
    nloc = mine > 0u ? mine : 1u; nx = cnt > 0u ? cnt : 1u;
}
__device__ __forceinline__ void xcd_barrier(const XcdBarrier& b) {
    asm volatile("s_waitcnt vmcnt(0)" ::: "memory");
    __syncthreads();
    if (threadIdx.x == 0) {
        unsigned* bar = b.bar;
        __builtin_amdgcn_s_waitcnt(0);
        unsigned nloc = b.st[0], nx = b.st[1];
        if (nloc == 0u) { xcd_barrier_complete(bar, b.x, nloc, nx); b.st[0] = nloc; b.st[1] = nx; }
        const unsigned old = xb_add(&bar[XB_XSUB(b.x)], 1u);
        const unsigned gen = old / nloc;
        if (old + 1u == (gen + 1u) * nloc) {
            __builtin_amdgcn_fence(__ATOMIC_RELEASE, "agent");
            asm volatile("s_waitcnt vmcnt(0)" ::: "memory");
            const unsigned og = xb_add(&bar[XB_TOP], 1u);
            const unsigned tg = og / nx;
            if (og + 1u == (tg + 1u) * nx) xb_add(&bar[XB_TOPGEN], 1u);
            else XB_SPIN(xb_ld(&bar[XB_TOPGEN]) == tg, bar);
            __builtin_amdgcn_fence(__ATOMIC_ACQUIRE, "agent");
            xb_add(&bar[XB_XGEN(b.x)], 1u);
            asm volatile("s_waitcnt vmcnt(0)" ::: "memory");
        } else {
            XB_SPIN(xb_ld(&bar[XB_XGEN(b.x)]) == gen, bar);
            __builtin_amdgcn_fence(__ATOMIC_ACQUIRE, "agent");
            asm volatile("s_waitcnt vmcnt(0)" ::: "memory");
        }
    }
    __syncthreads();
}

constexpr int NWAVES = 8, NTHR = 512;
constexpr int RING_BYTES = 131072, LDSCTL_OFF = RING_BYTES, MISC_OFF = LDSCTL_OFF + 320, LDS_BYTES = 147456;
constexpr int XCH_OFF = RING_BYTES + 1024;
constexpr int CW_BAR = 4096;
constexpr size_t OW_GU1 = OFF_W, OW_D1 = OW_GU1 + 11 * MiB, OW_IN = OW_D1 + (size_t)DM * FF * 2, OW_GATE = OW_IN + 6 * MiB, OW_4 = OW_GATE + 4 * MiB, OW_OV = OW_4 + 2 * MiB,
                 OW_UPB = OW_OV + 4 * MiB, OW_O = OW_UPB + MiB / 2, OW_GU2 = OW_O + 2 * MiB, OW_D2 = OW_GU2 + 11 * MiB, OW_END = OW_D2 + (size_t)DM * FF * 2;
static_assert(OW_END <= OFF_H, "weights region");
constexpr int NIN3 = 3072, N4 = 2560;

struct Args { const float* in[27]; float* out; unsigned char* ws; int ph_lo, ph_hi, zparts, pad; };
struct Frame {
    LAS unsigned char* lds; int tid, lane, wave, G, gw, NGW;
};
__device__ __forceinline__ float wave_sum(float v) {
#pragma unroll
    for (int o = 1; o < 64; o <<= 1) v += __shfl_xor(v, o);
    return v;
}
__device__ __forceinline__ bool map_row(int job, int n, const Args& a, const float*& W, int& ldw, int& col) {
    if (job <= 1) { const int t = n >> 8, j = n & 255; W = a.in[(job == 0 ? 6 : 23) + (j >> 7)]; ldw = FF; col = t * 128 + (j & 127); return true; }
    if (job == 2) { W = a.in[11]; ldw = DIN; const int t = n >> 8, j = n & 255;
        if (t == 0) { col = C_CKV + j; return true; }
        if (t == 1) { col = j; return true; }
        if (t == 2) { if (j < 128) { col = 256 + j; return true; } if (j < 160) { col = C_KR + (j - 128); return true; } if (j < 192) { col = C_KI + (j - 160); return true; } if (j < 200) { col = C_WI + (j - 192); return true; } col = 0; return false; }
        if (t < 9) { const int c3 = (t - 3) / 3, tl = (t - 3) % 3, hl = (j & 127) >> 5, i = j & 31; col = C_QKV + c3 * 768 + (4 * tl + hl) * 64 + (j >> 7) * 32 + i; return true; }
        col = C_QKV + 1536 + (t - 9) * 256 + j; return true; }
    { const int n2 = n - 2048; if (n2 < 256) { W = a.in[14]; ldw = 768; col = (n2 >> 5) * 96 + 64 + (n2 & 31); } else { W = a.in[17]; ldw = 256; col = n2 - 256; } return true; }
}
__device__ __forceinline__ void tr_item(const float* W, int ldw, int col, bool valid, const float* scale, int k0, h16* WTrow0, int K, LAS float* scr, int lane) {
#pragma unroll 8
    for (int i = 0; i < 32; ++i) { const int kk = 2 * i + (lane >> 5); float v = valid ? W[(size_t)(k0 + kk) * ldw + col] : 0.f; if (scale) v *= scale[k0 + kk]; scr[kk * 33 + (lane & 31)] = v; }
    asm volatile("s_waitcnt lgkmcnt(0)" ::: "memory");
    const int c = lane & 7;
#pragma unroll
    for (int j = 0; j < 4; ++j) { const int n = (lane >> 3) + 8 * j; const LAS float* s = scr + (8 * c) * 33 + n;
        u32x4 o; o.x = pk_h2(s[0 * 33], s[1 * 33]); o.y = pk_h2(s[2 * 33], s[3 * 33]); o.z = pk_h2(s[4 * 33], s[5 * 33]); o.w = pk_h2(s[6 * 33], s[7 * 33]);
        *(u32x4*)(WTrow0 + (size_t)n * K + k0 + 8 * c) = o; }
    asm volatile("s_waitcnt lgkmcnt(0)" ::: "memory");
}
__device__ __forceinline__ void tr_job_mapped(const Frame& F, const Args& a, int job, int Ndest, int n_lo, int K, h16* WT, const float* scale, LAS float* scr, int phase_off) {
    const int nblk = Ndest / 32, nitems = (K / 64) * nblk;
    for (int it = (F.gw + phase_off) % F.NGW; it < nitems; it += F.NGW) {
        const int kb = it / nblk, nb = it % nblk; const float* W; int ldw, col;
        const bool valid = map_row(job, n_lo + nb * 32 + (F.lane & 31), a, W, ldw, col);
        tr_item(W, ldw, col, valid, scale, kb * 64, WT + (size_t)(n_lo + nb * 32) * K, K, scr, F.lane);
    }
}
__device__ __forceinline__ void tr_job_plain(const Frame& F, const float* W, int ldw, int Ndest, int K, h16* WT, LAS float* scr, int phase_off) {
    const int nblk = Ndest / 32, nitems = (K / 64) * nblk;
    for (int it = (F.gw + phase_off) % F.NGW; it < nitems; it += F.NGW) {
        const int kb = it / nblk, nb = it % nblk;
        tr_item(W, ldw, nb * 32 + (F.lane & 31), true, nullptr, kb * 64, WT + (size_t)(nb * 32) * K, K, scr, F.lane);
    }
}
__device__ __forceinline__ void row_load(const float* p, int lane, f32x4 (&v)[4]) {
#pragma unroll
    for (int j = 0; j < 4; ++j) v[j] = ((const f32x4*)p)[lane + 64 * j];
}
__device__ __forceinline__ float row_ssq(const f32x4 (&v)[4]) { float s = 0.f;
#pragma unroll
    for (int j = 0; j < 4; ++j) s += (v[j].x * v[j].x + v[j].y * v[j].y) + (v[j].z * v[j].z + v[j].w * v[j].w);
    return wave_sum(s); }
__device__ __forceinline__ void row_normmod_store(const f32x4 (&v)[4], float rstd, const float* g, const float* sc, const float* sh, h16* dst, int lane) {
#pragma unroll
    for (int j = 0; j < 4; ++j) { const int ci = lane + 64 * j; const f32x4 gg = ((const f32x4*)g)[ci], s1 = ((const f32x4*)sc)[ci], s0 = ((const f32x4*)sh)[ci];
        const f32x4 o = v[j] * rstd * gg * (s1 + 1.f) + s0;
        u32x2 w; w.x = pk_h2(o.x, o.y); w.y = pk_h2(o.z, o.w); ((u32x2*)dst)[ci] = w; }
}
__device__ __forceinline__ void ph_normmod(const Frame& F, const float* x, const float* g, const float* mod, int isc, int ish, h16* dst) {
    for (int m = F.gw; m < MT; m += F.NGW) { f32x4 v[4]; row_load(x + (size_t)m * DM, F.lane, v);
        const float rstd = rsqrtf(row_ssq(v) * (1.f / DM) + EPS); const float* mb = mod + (m / SEQ) * (NMOD * DM);
        row_normmod_store(v, rstd, g, mb + isc * DM, mb + ish * DM, dst + (size_t)m * DM, F.lane); }
}
__device__ __forceinline__ void ph_resnorm(const Frame& F, const float* xin, const float* f, const float* gpost, const float* mod, int igt, float coef, float* xout,
                                           bool second, const float* gpre, int isc, int ish, h16* dst) {
    for (int m = F.gw; m < MT; m += F.NGW) { f32x4 v[4], xi[4]; row_load(f + (size_t)m * DM, F.lane, v); row_load(xin + (size_t)m * DM, F.lane, xi);
        const float rstd = rsqrtf(row_ssq(v) * (1.f / DM) + EPS) * coef; const float* mb = mod + (m / SEQ) * (NMOD * DM);
#pragma unroll
        for (int j = 0; j < 4; ++j) { const int ci = F.lane + 64 * j; const f32x4 gg = ((const f32x4*)gpost)[ci], gt = ((const f32x4*)(mb + igt * DM))[ci];
            xi[j] = xi[j] + gt * v[j] * rstd * gg; ((f32x4*)(xout + (size_t)m * DM))[ci] = xi[j]; }
        if (second) { const float r2 = rsqrtf(row_ssq(xi) * (1.f / DM) + EPS); row_normmod_store(xi, r2, gpre, mb + isc * DM, mb + ish * DM, dst + (size_t)m * DM, F.lane); } }
}


__device__ __forceinline__ float wg_sum512(float v, LAS float* red) {
#pragma unroll
    for (int o = 32; o > 0; o >>= 1) v += __shfl_xor(v, o);
    __syncthreads();
    if ((threadIdx.x & 63) == 0) red[threadIdx.x >> 6] = v;
    __syncthreads();
    float s = 0.f;
#pragma unroll
    for (int w = 0; w < 8; ++w) s += red[w];
    return s;
}
__device__ __forceinline__ float wg_max512(float v, LAS float* red) {
#pragma unroll
    for (int o = 32; o > 0; o >>= 1) v = fmaxf(v, __shfl_xor(v, o));
    __syncthreads();
    if ((threadIdx.x & 63) == 0) red[threadIdx.x >> 6] = v;
    __syncthreads();
    float s = red[0];
#pragma unroll
    for (int w = 1; w < 8; ++w) s = fmaxf(s, red[w]);
    return s;
}
__device__ __forceinline__ void ph_dilated_simple(const Frame& F, const h16* qb, const h16* kb, const h16* vb, h16* og, float* lse2) {
    LAS float* p = (LAS float*)(F.lds + F.wave * 2048);
    LAS int* kix = (LAS int*)(F.lds + F.wave * 2048 + 1024);
    for (int it = F.gw; it < MT * 12; it += F.NGW) {
        const int tok = it / 12, gh = it % 12, g = gh >> 2, b = tok / SEQ, t = tok % SEQ, dil = dil_of(g), lane = F.lane;
        const h16* qp = qb + (size_t)tok * 768 + gh * 64;
        float sc[3]; float m = -INFINITY;
#pragma unroll
        for (int r = 0; r < 3; ++r) { const int k = lane + 64 * r; sc[r] = -INFINITY; const int ti = t - k * dil;
            if (k < 129) { kix[k] = ti;
                if (ti >= 0) { const h16* kp = kb + (size_t)(b * SEQ + ti) * 768 + gh * 64; float a = 0.f;
#pragma unroll 8
                    for (int d = 0; d < 64; ++d) a += (float)qp[d] * (float)kp[d];
                    sc[r] = a; } }
            m = fmaxf(m, sc[r]); }
#pragma unroll
        for (int o = 32; o > 0; o >>= 1) m = fmaxf(m, __shfl_xor(m, o));
        float l = 0.f;
#pragma unroll
        for (int r = 0; r < 3; ++r) { const int k = lane + 64 * r; if (k < 129) { const float e = (sc[r] == -INFINITY) ? 0.f : exp2f(sc[r] - m); p[k] = e; l += e; } }
#pragma unroll
        for (int o = 32; o > 0; o >>= 1) l += __shfl_xor(l, o);
        asm volatile("s_waitcnt lgkmcnt(0)" ::: "memory");
        float a = 0.f; const h16* vp = vb + (size_t)(b * SEQ) * 768 + gh * 64 + lane;
        for (int k = 0; k < 129; ++k) { const int ti = kix[k]; if (ti >= 0) a += p[k] * (float)vp[(size_t)ti * 768]; }
        og[(size_t)tok * 768 + gh * 64 + lane] = (h16)(a / l);
        if (lane == 0) lse2[tok * 12 + gh] = m + log2f(l);
        asm volatile("s_waitcnt lgkmcnt(0)" ::: "memory");
    }
}
__device__ __forceinline__ void ph_combine(const Frame& F, const h16* og, const float* lse2, h16* ob) {
    for (int idx = blockIdx.x * NTHR + F.tid; idx < MT * 256; idx += F.G * NTHR) {
        const int tok = idx >> 8, c = idx & 255, hh = c >> 6;
        const float l0 = lse2[tok * 12 + hh], l1 = lse2[tok * 12 + 4 + hh], l2 = lse2[tok * 12 + 8 + hh], m = fmaxf(l0, fmaxf(l1, l2));
        const float w0 = exp2f(l0 - m), w1 = exp2f(l1 - m), w2 = exp2f(l2 - m), inv = 1.f / (w0 + w1 + w2);
        ob[idx] = (h16)((w0 * (float)og[(size_t)tok * 768 + c] + w1 * (float)og[(size_t)tok * 768 + 256 + c] + w2 * (float)og[(size_t)tok * 768 + 512 + c]) * inv); }
}
__device__ __forceinline__ void ph_topk_simple(const Frame& F, const h16* qi, const h16* ki, const float* wi, unsigned short* sel) {
    LAS unsigned* key = (LAS unsigned*)(F.lds);
    LAS float* q = (LAS float*)(F.lds + 16384);
    LAS float* w = (LAS float*)(F.lds + 16384 + 1024);
    LAS unsigned* cnt = (LAS unsigned*)(F.lds + 16384 + 1024 + 64);
    const int tid = F.tid;
    for (int tok = blockIdx.x; tok < MT; tok += F.G) {
        const int b = tok / SEQ, t = tok % SEQ; unsigned short* so = sel + (size_t)tok * TOPK;
        if (t < TOPK) { if (tid < TOPK) so[tid] = (unsigned short)(tid <= t ? tid : 0); continue; }
        __syncthreads();
        if (tid < 256) q[tid] = (float)qi[(size_t)tok * 256 + tid]; if (tid < 8) w[tid] = wi[tok * 8 + tid];
        __syncthreads();
        const int n = t + 1;
#pragma unroll 1
        for (int s = tid; s < n; s += NTHR) {
            const h16* kp = ki + (size_t)(b * SEQ + s) * 32; float a[8];
#pragma unroll
            for (int hd = 0; hd < 8; ++hd) a[hd] = 0.f;
#pragma unroll 4
            for (int e = 0; e < 32; ++e) { const float kv = (float)kp[e];
#pragma unroll
                for (int hd = 0; hd < 8; ++hd) a[hd] += q[hd * 32 + e] * kv; }
            float sc = 0.f;
#pragma unroll
            for (int hd = 0; hd < 8; ++hd) sc += w[hd] * fmaxf(a[hd] * 0.17677669529663687f, 0.f);
            key[s] = fkey(sc);
        }
        __syncthreads();
        unsigned T = 0;
        for (int bit = 31; bit >= 0; --bit) {
            const unsigned cand = T | (1u << bit);
            if (tid == 0) *cnt = 0; __syncthreads();
            unsigned c = 0; for (int s = tid; s < n; s += NTHR) c += (key[s] >= cand) ? 1u : 0u;
#pragma unroll
            for (int o = 32; o > 0; o >>= 1) c += __shfl_xor(c, o);
            if ((tid & 63) == 0) atomicAdd((unsigned*)cnt, c);
            __syncthreads();
            if (*cnt >= TOPK) T = cand;
            __syncthreads();
        }
        if (tid == 0) *cnt = 0; __syncthreads();
        for (int s = tid; s < n; s += NTHR) if (key[s] > T) { const unsigned pp = atomicAdd((unsigned*)cnt, 1u); so[pp] = (unsigned short)s; }
        __syncthreads();
        if (tid == 0) { unsigned pp = *cnt; for (int s = 0; s < n && pp < TOPK; ++s) if (key[s] == T) so[pp++] = (unsigned short)s; }
    }
}
__device__ __forceinline__ void ph_sparse_simple(const Frame& F, h16* qlat, const h16* qr, const h16* ckv, const h16* kr, const unsigned short* sel) {
    LAS float* ql = (LAS float*)(F.lds);
    LAS float* qrr = (LAS float*)(F.lds + 8192);
    LAS float* p = (LAS float*)(F.lds + 8192 + 1024);
    LAS int* rows = (LAS int*)(F.lds + 8192 + 1024 + 8192);
    LAS float* red = (LAS float*)(F.lds + 8192 + 1024 + 8192 + 1024);
    LAS float* stat = red + 16;
    const int tid = F.tid, k = tid & 255, hh = tid >> 8;
    for (int tok = blockIdx.x; tok < MT; tok += F.G) {
        const int b = tok / SEQ, t = tok % SEQ, cnt = (t + 1 < TOPK) ? t + 1 : TOPK;
        __syncthreads();
        for (int i = tid; i < 2048; i += NTHR) ql[i] = (float)qlat[(size_t)tok * 2048 + i];
        if (tid < 256) { qrr[tid] = (float)qr[(size_t)tok * 256 + tid]; rows[tid] = b * SEQ + (tid < cnt ? (int)sel[(size_t)tok * TOPK + tid] : 0); }
        __syncthreads();
        const int row = rows[k];
        float s[4];
#pragma unroll
        for (int j = 0; j < 4; ++j) s[j] = 0.f;
        if (k < cnt) {
            const h16* kp = ckv + (size_t)row * 256;
            for (int r = 0; r < 256; ++r) { const float kvv = (float)kp[r];
#pragma unroll
                for (int j = 0; j < 4; ++j) s[j] += ql[(4 * hh + j) * 256 + r] * kvv; }
            const h16* rp = kr + (size_t)row * 32;
            for (int e = 0; e < 32; ++e) { const float kvv = (float)rp[e];
#pragma unroll
                for (int j = 0; j < 4; ++j) s[j] += qrr[(4 * hh + j) * 32 + e] * kvv; }
        } else {
#pragma unroll
            for (int j = 0; j < 4; ++j) s[j] = -INFINITY;
        }
#pragma unroll
        for (int hd = 0; hd < 8; ++hd) {
            const float mine = (hd >> 2) == hh ? s[hd & 3] : -INFINITY;
            const float m = wg_max512(mine, red);
            const float e = ((hd >> 2) == hh && k < cnt) ? exp2f(mine - m) : 0.f;
            if ((hd >> 2) == hh) p[hd * 256 + k] = e;
            const float l = wg_sum512(e, red);
            if (tid == 0) stat[hd] = 1.f / l;
        }
        __syncthreads();
        float o[4];
#pragma unroll
        for (int j = 0; j < 4; ++j) o[j] = 0.f;
        for (int kk = 0; kk < cnt; ++kk) { const float v = (float)ckv[(size_t)rows[kk] * 256 + k];
#pragma unroll
            for (int j = 0; j < 4; ++j) o[j] += p[(4 * hh + j) * 256 + kk] * v; }
#pragma unroll
        for (int j = 0; j < 4; ++j) qlat[(size_t)tok * 2048 + (4 * hh + j) * 256 + k] = (h16)(o[j] * stat[4 * hh + j]);
    }
}


typedef short v4i16_t __attribute__((ext_vector_type(4)));
typedef short s16x8 __attribute__((ext_vector_type(8)));
__device__ __forceinline__ void ph_sparse_mfma(const Frame& F, h16* qlat, const h16* qr, const h16* ckv, const h16* kr, const unsigned short* sel) {
    const int lane = F.lane, w = F.wave, c = lane & 15, kq = lane >> 4, hd = c & 7, G = F.G;
    LAS unsigned char* V = F.lds;
    LAS unsigned char* P = F.lds + XCH_OFF;
    LAS float* pmax = (LAS float*)(F.lds + XCH_OFF + 8448);
    LAS float* psum = pmax + 128;
    int tok = blockIdx.x; if (tok >= MT) return;
    int rowi[2]; f16x8 Kf[2][9], Qf[9];
#define SP_SEL(dst, tk) do { _Pragma("unroll") for (int tl = 0; tl < 2; ++tl) dst[tl] = ((tk) / SEQ) * SEQ + (int)sel[(size_t)(tk) * TOPK + 32 * w + 16 * tl + c]; } while (0)
#define SP_LOADK() do { _Pragma("unroll") for (int tl = 0; tl < 2; ++tl) { _Pragma("unroll") for (int s_ = 0; s_ < 8; ++s_) Kf[tl][s_] = *(const f16x8*)(ckv + (size_t)rowi[tl] * 256 + 32 * s_ + 8 * kq); \
        Kf[tl][8] = *(const f16x8*)(kr + (size_t)rowi[tl] * 32 + 8 * kq); } } while (0)
#define SP_LOADQ(tk) do { _Pragma("unroll") for (int s_ = 0; s_ < 8; ++s_) Qf[s_] = *(const f16x8*)(qlat + (size_t)(tk) * 2048 + hd * 256 + 32 * s_ + 8 * kq); Qf[8] = *(const f16x8*)(qr + (size_t)(tk) * 256 + hd * 32 + 8 * kq); } while (0)
    SP_SEL(rowi, tok); SP_LOADK(); SP_LOADQ(tok);
    const int vw0 = (32 * w + c) * 512, swz = c << 1;
    const int qp = c >> 2, pp = c & 3;
    int tro[2][2];
#pragma unroll
    for (int jj = 0; jj < 2; ++jj)
#pragma unroll
        for (int ft = 0; ft < 2; ++ft) { const int key = 8 * kq + 4 * jj + qp, ch = 4 * w + 2 * ft + (pp >> 1); tro[jj][ft] = key * 512 + ((ch ^ ((key & 15) << 1)) << 4) + (pp & 1) * 8; }
    for (;;) {
        const int t = tok % SEQ, cnt = (t + 1 < TOPK) ? t + 1 : TOPK, ntok = tok + G; const bool has_next = ntok < MT;
        int rown[2] = {0, 0}; if (has_next) SP_SEL(rown, ntok);
        f32x4 S[2];
#pragma unroll
        for (int tl = 0; tl < 2; ++tl) { S[tl] = (f32x4){0.f, 0.f, 0.f, 0.f};
#pragma unroll
            for (int s_ = 0; s_ < 9; ++s_) S[tl] = __builtin_amdgcn_mfma_f32_16x16x32_f16(Kf[tl][s_], Qf[s_], S[tl], 0, 0, 0); }
        float m = -INFINITY;
#pragma unroll
        for (int tl = 0; tl < 2; ++tl)
#pragma unroll
            for (int e = 0; e < 4; ++e) { if (32 * w + 16 * tl + 4 * kq + e >= cnt) S[tl][e] = -INFINITY; m = fmaxf(m, S[tl][e]); }
        m = fmaxf(m, __shfl_xor(m, 16)); m = fmaxf(m, __shfl_xor(m, 32));
        if (kq == 0) pmax[w * 16 + c] = m;
#pragma unroll
        for (int tl = 0; tl < 2; ++tl)
#pragma unroll
            for (int s_ = 0; s_ < 8; ++s_) *(LAS f16x8*)(V + vw0 + tl * 8192 + (((4 * s_ + kq) ^ swz) << 4)) = Kf[tl][s_];
        asm volatile("s_waitcnt lgkmcnt(0)" ::: "memory"); __builtin_amdgcn_s_barrier(); asm volatile("" ::: "memory");
        float mg = pmax[c];
#pragma unroll
        for (int ww = 1; ww < 8; ++ww) mg = fmaxf(mg, pmax[ww * 16 + c]);
        float ps = 0.f;
#pragma unroll
        for (int tl = 0; tl < 2; ++tl) { float pe[4];
#pragma unroll
            for (int e = 0; e < 4; ++e) { pe[e] = __builtin_amdgcn_exp2f(S[tl][e] - mg); ps += pe[e]; }
            u32x2 pk; pk.x = pk_h2(pe[0], pe[1]); pk.y = pk_h2(pe[2], pe[3]);
            *(LAS u32x2*)(P + c * 528 + (32 * w + 16 * tl + 4 * kq) * 2) = pk; }
        ps += __shfl_xor(ps, 16); ps += __shfl_xor(ps, 32);
        if (kq == 0) psum[w * 16 + c] = ps;
        asm volatile("s_waitcnt lgkmcnt(0)" ::: "memory"); __builtin_amdgcn_s_barrier(); asm volatile("" ::: "memory");
        if (has_next) { rowi[0] = rown[0]; rowi[1] = rown[1]; SP_LOADK(); SP_LOADQ(ntok); }
        float l = psum[c];
#pragma unroll
        for (int ww = 1; ww < 8; ++ww) l += psum[ww * 16 + c];
        f32x4 O[2]; O[0] = (f32x4){0.f, 0.f, 0.f, 0.f}; O[1] = O[0];
#pragma unroll
        for (int s_ = 0; s_ < 8; ++s_) {
            const f16x8 Pf = *(const LAS f16x8*)(P + c * 528 + (32 * s_ + 8 * kq) * 2);
#pragma unroll
            for (int ft = 0; ft < 2; ++ft) {
                const v4i16_t lo = __builtin_amdgcn_ds_read_tr16_b64_v4i16((LAS v4i16_t*)(V + s_ * 16384 + tro[0][ft]));
                const v4i16_t hi = __builtin_amdgcn_ds_read_tr16_b64_v4i16((LAS v4i16_t*)(V + s_ * 16384 + tro[1][ft]));
                const s16x8 av = {lo[0], lo[1], lo[2], lo[3], hi[0], hi[1], hi[2], hi[3]};
                O[ft] = __builtin_amdgcn_mfma_f32_16x16x32_f16(__builtin_bit_cast(f16x8, av), Pf, O[ft], 0, 0, 0); } }
        if (c < 8) { const float il = __builtin_amdgcn_rcpf(l);
#pragma unroll
            for (int ft = 0; ft < 2; ++ft) { const f32x4 o = O[ft] * il; u32x2 pk; pk.x = pk_h2(o.x, o.y); pk.y = pk_h2(o.z, o.w);
                *(u32x2*)(qlat + (size_t)tok * 2048 + c * 256 + 32 * w + 16 * ft + 4 * kq) = pk; } }
        asm volatile("s_waitcnt lgkmcnt(0)" ::: "memory"); __builtin_amdgcn_s_barrier(); asm volatile("" ::: "memory");
        if (!has_next) break;
        tok = ntok;
    }
#undef SP_SEL
#undef SP_LOADK
#undef SP_LOADQ
}


typedef float f32x16 __attribute__((ext_vector_type(16)));
__device__ __forceinline__ int tk_bin(float sc) { const unsigned u = __float_as_uint(sc); int e = (int)((u >> 16) & 0x7FFFu) - (122 << 7); e = e < 0 ? 0 : (e > 1023 ? 1023 : e); return (u >> 31) ? 1023 - e : 1024 + e; }
__device__ __forceinline__ void tk_scores(const f16x8 (&Af)[2], const float (&wv)[16], f16x8 b0, f16x8 b1, float& sa, float& sb) {
    f32x16 d = {0.f, 0.f, 0.f, 0.f, 0.f, 0.f, 0.f, 0.f, 0.f, 0.f, 0.f, 0.f, 0.f, 0.f, 0.f, 0.f};
    d = __builtin_amdgcn_mfma_f32_32x32x16_f16(Af[0], b0, d, 0, 0, 0); d = __builtin_amdgcn_mfma_f32_32x32x16_f16(Af[1], b1, d, 0, 0, 0);
    sa = 0.f; sb = 0.f;
#pragma unroll
    for (int e = 0; e < 16; e += 2) { sa += wv[e] * fmaxf(d[e], 0.f); sb += wv[e + 1] * fmaxf(d[e + 1], 0.f); }
}
template <bool P2>
__device__ __forceinline__ void tk_tile(const f16x8 (&Af)[2], const float (&wv)[16], f16x8 b0, f16x8 b1, int tile, int r, int hi, int ta, LAS unsigned* hist, const int (&tbin)[4], int (&cs)[4], int (&cc)[4],
                                        unsigned short* sel, int tok0) {
    float sa, sb; tk_scores(Af, wv, b0, b1, sa, sb);
    const int s = 32 * tile + r;
    if constexpr (!P2) {
        if (s <= ta) { const int bn = tk_bin(sa); __hip_atomic_fetch_add(hist + (2 * hi) * 1024 + (bn >> 1), 1u << (16 * (bn & 1)), __ATOMIC_RELAXED, __HIP_MEMORY_SCOPE_WORKGROUP); }
        if (s <= ta + 1) { const int bn = tk_bin(sb); __hip_atomic_fetch_add(hist + (2 * hi + 1) * 1024 + (bn >> 1), 1u << (16 * (bn & 1)), __ATOMIC_RELAXED, __HIP_MEMORY_SCOPE_WORKGROUP); }
    } else {
        const unsigned lowmask = (1u << r) - 1u;
#pragma unroll
        for (int ab = 0; ab < 2; ++ab) { const float sc = ab ? sb : sa; const int tq = ta + ab; const int bn = tk_bin(sc);
            const int mytb = hi ? tbin[2 + ab] : tbin[ab];
            const bool valid = s <= tq, sure = valid && bn > mytb, cand = valid && bn == mytb;
            const unsigned long long ms = __ballot(sure), mc = __ballot(cand);
            const unsigned ms_h = hi ? (unsigned)(ms >> 32) : (unsigned)ms, mc_h = hi ? (unsigned)(mc >> 32) : (unsigned)mc;
            const int q = 2 * hi + ab;
            const int base_s = hi ? cs[2 + ab] : cs[ab], base_c = hi ? cc[2 + ab] : cc[ab];
            if (sure) sel[(size_t)(tok0 + q) * TOPK + base_s + __builtin_popcount(ms_h & lowmask)] = (unsigned short)s;
            if (cand) { const int pos = base_c + __builtin_popcount(mc_h & lowmask);
                if (pos < 512) { LAS unsigned char* cb = (LAS unsigned char*)hist + q * 4096; ((LAS unsigned*)cb)[pos] = fkey(sc); ((LAS unsigned short*)(cb + 2048))[pos] = (unsigned short)s; } }
            cs[ab] += __builtin_popcount((unsigned)ms); cs[2 + ab] += __builtin_popcount((unsigned)(ms >> 32));
            cc[ab] += __builtin_popcount((unsigned)mc); cc[2 + ab] += __builtin_popcount((unsigned)(mc >> 32)); }
    }
}
template <bool P2>
__device__ __forceinline__ void tk_pass(const f16x8 (&Af)[2], const float (&wv)[16], const h16* kbase, int ntiles, int r, int hi, int ta, LAS unsigned* hist, const int (&tbin)[4], int (&cs)[4], int (&cc)[4],
                                        unsigned short* sel, int tok0) {
    f16x8 BA[4][2], BB[4][2];
#define TK_LOAD(dst, t0_) do { _Pragma("unroll") for (int i_ = 0; i_ < 4; ++i_) { const int tt_ = ((t0_) + i_) < 127 ? ((t0_) + i_) : 127; dst[i_][0] = *(const f16x8*)(kbase + (size_t)tt_ * 1024); dst[i_][1] = *(const f16x8*)(kbase + (size_t)tt_ * 1024 + 16); } } while (0)
    TK_LOAD(BA, 0);
    for (int t0 = 0; t0 < ntiles; t0 += 8) {
        TK_LOAD(BB, t0 + 4);
#pragma unroll
        for (int i = 0; i < 4; ++i) if (t0 + i < ntiles) tk_tile<P2>(Af, wv, BA[i][0], BA[i][1], t0 + i, r, hi, ta, hist, tbin, cs, cc, sel, tok0);
        TK_LOAD(BA, t0 + 8);
#pragma unroll
        for (int i = 0; i < 4; ++i) if (t0 + 4 + i < ntiles) tk_tile<P2>(Af, wv, BB[i][0], BB[i][1], t0 + 4 + i, r, hi, ta, hist, tbin, cs, cc, sel, tok0);
    }
#undef TK_LOAD
}
__device__ __forceinline__ void tk_group(const Frame& F, const h16* qi, const h16* ki, const float* wi, unsigned short* sel, int b, int t0, LAS unsigned* hist) {
    const int lane = F.lane, r = lane & 31, hi = lane >> 5, tok0 = b * SEQ + t0;
    const int qa = 2 * ((r >> 2) & 1) + (r & 1), ha = 4 * (r >> 4) + 2 * ((r >> 3) & 1) + ((r >> 1) & 1);
    f16x8 Af[2];
#pragma unroll
    for (int s_ = 0; s_ < 2; ++s_) Af[s_] = *(const f16x8*)(qi + (size_t)(tok0 + qa) * 256 + ha * 32 + 16 * s_ + 8 * hi);
    float wv[16];
    { const f32x4 a0 = *(const f32x4*)(wi + (tok0 + 2 * hi) * 8), a1 = *(const f32x4*)(wi + (tok0 + 2 * hi) * 8 + 4), b0 = *(const f32x4*)(wi + (tok0 + 2 * hi + 1) * 8), b1 = *(const f32x4*)(wi + (tok0 + 2 * hi + 1) * 8 + 4);
      const float sa[8] = {a0.x, a0.y, a0.z, a0.w, a1.x, a1.y, a1.z, a1.w}, sb[8] = {b0.x, b0.y, b0.z, b0.w, b1.x, b1.y, b1.z, b1.w};
#pragma unroll
      for (int h = 0; h < 8; ++h) { wv[2 * h] = sa[h] * 0.17677669529663687f; wv[2 * h + 1] = sb[h] * 0.17677669529663687f; } }
    const int ntiles = (t0 + 3) / 32 + 1, ta = t0 + 2 * hi;
    const h16* kbase = ki + (size_t)(b * SEQ + r) * 32 + 8 * hi;
    int tbin[4] = {0, 0, 0, 0}, nsure[4], cs[4] = {0, 0, 0, 0}, cc[4] = {0, 0, 0, 0};
#pragma unroll
    for (int i = 0; i < 16; ++i) *(LAS u32x4*)((LAS unsigned char*)hist + i * 1024 + lane * 16) = (u32x4){0u, 0u, 0u, 0u};
    asm volatile("s_waitcnt lgkmcnt(0)" ::: "memory");
    tk_pass<false>(Af, wv, kbase, ntiles, r, hi, ta, hist, tbin, cs, cc, sel, tok0);
    asm volatile("s_waitcnt lgkmcnt(0)" ::: "memory");
#pragma unroll
    for (int q = 0; q < 4; ++q) {
        const LAS unsigned* hq = hist + q * 1024;
        unsigned sum = 0;
#pragma unroll
        for (int i = 0; i < 4; ++i) { const u32x4 v = *(const LAS u32x4*)(hq + 16 * lane + 4 * i); sum += (v.x & 0xFFFFu) + (v.x >> 16) + (v.y & 0xFFFFu) + (v.y >> 16) + (v.z & 0xFFFFu) + (v.z >> 16) + (v.w & 0xFFFFu) + (v.w >> 16); }
        unsigned incl = sum;
#pragma unroll
        for (int o = 1; o < 64; o <<= 1) { const unsigned v = __shfl_down(incl, o); if (lane + o < 64) incl += v; }
        const unsigned long long bal = __ballot(incl >= (unsigned)TOPK);
        const int L = 63 - __builtin_clzll(bal);
        unsigned cum = __shfl(incl, L) - __shfl(sum, L);
        int tbq = 32 * L, found = 0;
        for (int wd = 15; wd >= 0 && !found; --wd) { const unsigned v = hq[16 * L + wd];
            const unsigned chi = v >> 16, clo = v & 0xFFFFu;
            if (cum + chi >= (unsigned)TOPK) { tbq = 32 * L + 2 * wd + 1; found = 1; } else { cum += chi;
                if (cum + clo >= (unsigned)TOPK) { tbq = 32 * L + 2 * wd; found = 1; } else cum += clo; } }
        tbin[q] = tbq; nsure[q] = (int)cum;
    }
    asm volatile("s_waitcnt lgkmcnt(0)" ::: "memory");
    tk_pass<true>(Af, wv, kbase, ntiles, r, hi, ta, hist, tbin, cs, cc, sel, tok0);
    asm volatile("s_waitcnt lgkmcnt(0)" ::: "memory");
#pragma unroll
    for (int q = 0; q < 4; ++q) {
        const int nc = cc[q] < 512 ? cc[q] : 512, need = TOPK - cs[q];
        const LAS unsigned char* cb = (const LAS unsigned char*)hist + q * 4096; const LAS unsigned* ck = (const LAS unsigned*)cb; const LAS unsigned short* cx = (const LAS unsigned short*)(cb + 2048);
        for (int c0 = 0; c0 < nc; c0 += 64) { const int ci = c0 + lane; const bool act = ci < nc;
            const unsigned myk = act ? ck[ci] : 0u; const unsigned myx = act ? cx[ci] : 0u; int rank = 0;
            for (int j = 0; j < nc; ++j) { const unsigned kj = ck[j], xj = cx[j]; rank += (kj > myk || (kj == myk && xj < myx)) ? 1 : 0; }
            if (act && rank < need) sel[(size_t)(tok0 + q) * TOPK + cs[q] + rank] = (unsigned short)myx; }
    }
    (void)nsure;
    asm volatile("s_waitcnt lgkmcnt(0)" ::: "memory");
}
__device__ __forceinline__ void ph_topk_mfma(const Frame& F, const h16* qi, const h16* ki, const float* wi, unsigned short* sel) {
    LAS unsigned* hist = (LAS unsigned*)(F.lds + F.wave * 16384);
    for (int g = F.gw; g < 4 * 64; g += F.NGW) { const int b = g >> 6, t0 = (g & 63) * 4;
        for (int i = F.lane; i < 4 * TOPK; i += 64) { const int q = i >> 8, k = i & 255; sel[(size_t)(b * SEQ + t0 + q) * TOPK + k] = (unsigned short)(k <= t0 + q ? k : 0); } }
    for (int p = F.gw; p < 4 * 480; p += F.NGW) { const int b = p & 3, pj = p >> 2;
        tk_group(F, qi, ki, wi, sel, b, 4 * (64 + pj), hist);
        tk_group(F, qi, ki, wi, sel, b, 4 * (1023 - pj), hist); }
}


__device__ __forceinline__ void ph_dilated_mfma(const Frame& F, const h16* qb, const h16* kb, const h16* vb, h16* og, float* lse2) {
    const int lane = F.lane, ql = lane & 31, hi = lane >> 5;
    LAS unsigned char* VL = F.lds + F.wave * 16384;
    LAS float* linv = (LAS float*)(VL + 12288);
    constexpr int VROW = 192;
    const int trq = (lane & 15) >> 2, trp = lane & 3, trg = (lane >> 4) & 1;
    for (int u = F.gw; u < NB * 12 * 128; u += F.NGW) {
        const int b = u / 1536, rem = u % 1536, gh = rem >> 7, g = gh >> 2, wi_ = rem & 127, dil = dil_of(g), sh = g == 0 ? 0 : (g == 1 ? 2 : 4);
        const int nblk = 128 >> sh, res = wi_ / nblk, j0 = 32 * (wi_ % nblk);
        const size_t hoff = (size_t)b * SEQ * 768 + gh * 64;
        f16x8 Qf[4];
        { const h16* qp = qb + hoff + (size_t)((j0 + ql) * dil + res) * 768 + 8 * hi;
#pragma unroll
          for (int s_ = 0; s_ < 4; ++s_) Qf[s_] = *(const f16x8*)(qp + 16 * s_); }
        f32x16 S[5];
#pragma unroll
        for (int kt = 0; kt < 5; ++kt) { int jk = j0 - 128 + 32 * kt + ql; jk = jk < 0 ? 0 : jk;
            const h16* kp = kb + hoff + (size_t)(jk * dil + res) * 768 + 8 * hi;
            f16x8 Kf[4];
#pragma unroll
            for (int s_ = 0; s_ < 4; ++s_) Kf[s_] = *(const f16x8*)(kp + 16 * s_);
            f32x16 d = {0.f, 0.f, 0.f, 0.f, 0.f, 0.f, 0.f, 0.f, 0.f, 0.f, 0.f, 0.f, 0.f, 0.f, 0.f, 0.f};
#pragma unroll
            for (int s_ = 0; s_ < 4; ++s_) d = __builtin_amdgcn_mfma_f32_32x32x16_f16(Kf[s_], Qf[s_], d, 0, 0, 0);
            S[kt] = d; }
        float m = -INFINITY;
#pragma unroll
        for (int kt = 0; kt < 5; ++kt)
#pragma unroll
            for (int e = 0; e < 16; ++e) { const int kl = (e & 3) + 8 * (e >> 2) + 4 * hi; bool ok = (j0 - 128 + 32 * kt + kl) >= 0;
                if (kt == 0) ok = ok && (kl >= ql); if (kt == 4) ok = ok && (kl <= ql);
                if (!ok) S[kt][e] = -INFINITY; m = fmaxf(m, S[kt][e]); }
        m = fmaxf(m, __shfl_xor(m, 32));
        float l = 0.f;
#pragma unroll
        for (int kt = 0; kt < 5; ++kt)
#pragma unroll
            for (int e = 0; e < 16; ++e) { const float p = __builtin_amdgcn_exp2f(S[kt][e] - m); S[kt][e] = p; l += p; }
        l += __shfl_xor(l, 32);
        if (hi == 0) { linv[ql] = __builtin_amdgcn_rcpf(l); lse2[(size_t)(b * SEQ + (j0 + ql) * dil + res) * 12 + gh] = m + __builtin_amdgcn_logf(l); }
        f32x16 O[2];
#pragma unroll
        for (int dt = 0; dt < 2; ++dt) O[dt] = (f32x16){0.f, 0.f, 0.f, 0.f, 0.f, 0.f, 0.f, 0.f, 0.f, 0.f, 0.f, 0.f, 0.f, 0.f, 0.f, 0.f};
#pragma unroll
        for (int kt = 0; kt < 5; ++kt) {
            LAS unsigned char* vbuf = VL + (kt & 1) * 6144;
            { int jk = j0 - 128 + 32 * kt + (lane >> 1); jk = jk < 0 ? 0 : jk;
              const h16* vp = vb + hoff + (size_t)(jk * dil + res) * 768 + (lane & 1) * 32;
#pragma unroll
              for (int i = 0; i < 4; ++i) { const f16x8 v = *(const f16x8*)(vp + 8 * i); *(LAS f16x8*)(vbuf + (lane >> 1) * VROW + (lane & 1) * 64 + i * 16) = v; } }
            asm volatile("s_waitcnt lgkmcnt(0)" ::: "memory");
#pragma unroll
            for (int s2 = 0; s2 < 2; ++s2) {
                u32x4 pa; pa.x = pk_h2(S[kt][8 * s2 + 0], S[kt][8 * s2 + 1]); pa.y = pk_h2(S[kt][8 * s2 + 2], S[kt][8 * s2 + 3]); pa.z = pk_h2(S[kt][8 * s2 + 4], S[kt][8 * s2 + 5]); pa.w = pk_h2(S[kt][8 * s2 + 6], S[kt][8 * s2 + 7]);
#pragma unroll
                for (int dt = 0; dt < 2; ++dt) {
                    const v4i16_t lo = __builtin_amdgcn_ds_read_tr16_b64_v4i16((LAS v4i16_t*)(vbuf + (16 * s2 + 4 * hi + trq) * VROW + (32 * dt + 16 * trg + 4 * trp) * 2));
                    const v4i16_t hh = __builtin_amdgcn_ds_read_tr16_b64_v4i16((LAS v4i16_t*)(vbuf + (16 * s2 + 8 + 4 * hi + trq) * VROW + (32 * dt + 16 * trg + 4 * trp) * 2));
                    const s16x8 bv = {lo[0], lo[1], lo[2], lo[3], hh[0], hh[1], hh[2], hh[3]};
                    O[dt] = __builtin_amdgcn_mfma_f32_32x32x16_f16(__builtin_bit_cast(f16x8, pa), __builtin_bit_cast(f16x8, bv), O[dt], 0, 0, 0); } }
            asm volatile("s_waitcnt lgkmcnt(0)" ::: "memory");
        }
#pragma unroll
        for (int e = 0; e < 16; ++e) { const int q = (e & 3) + 8 * (e >> 2) + 4 * hi; const float il = linv[q];
            h16* op = og + (size_t)(b * SEQ + (j0 + q) * dil + res) * 768 + gh * 64 + ql;
            op[0] = (h16)(O[0][e] * il); op[32] = (h16)(O[1][e] * il); }
        asm volatile("s_waitcnt lgkmcnt(0)" ::: "memory");
    }
}

__global__ void __launch_bounds__(NTHR, 2) mega_fwd(Args args) {
    extern __shared__ __attribute__((aligned(16))) unsigned char lds_raw[];
    Frame F; F.lds = (LAS unsigned char*)lds_raw; F.tid = threadIdx.x; F.lane = F.tid & 63; F.wave = __builtin_amdgcn_readfirstlane(F.tid >> 6);
    F.G = gridDim.x; F.gw = blockIdx.x * NWAVES + F.wave; F.NGW = F.G * NWAVES;
    volatile LAS unsigned* MISC = (volatile LAS unsigned*)(F.lds + MISC_OFF);
    unsigned char* ws = args.ws;
    for (int u = F.tid; u < (LDS_BYTES - LDSCTL_OFF) / 4; u += NTHR) ((LAS unsigned*)(F.lds + LDSCTL_OFF))[u] = 0u;
    __syncthreads();
    XcdBarrier bar = xcd_barrier_post((unsigned*)(ws + OFF_CTL) + CW_BAR, MISC + 8);
    const int lo = args.ph_lo, hi = args.ph_hi;
#ifndef PHMASK
#define PHMASK 0xFFFFu
#endif
#define IN(k) (((PHMASK >> (k)) & 1u) && lo <= (k) && (k) < hi)
#define SEAM(k) do { if (IN(k) && IN((k) + 1)) xcd_barrier(bar); } while (0)
    float* mod = (float*)(ws + OFF_MOD); float2* tab = (float2*)(ws + OFF_ROPE);
    h16* Hb = (h16*)(ws + OFF_H); h16* Ab = (h16*)(ws + OFF_A); float* Fb = (float*)(ws + OFF_F);

    if (IN(0)) {
        LAS float* scr = (LAS float*)(F.lds + F.wave * 16384);
        for (int ch = blockIdx.x; ch < (NMOD * DM) / 64; ch += F.G) {
            LAS float* sl = (LAS float*)(F.lds);
            LAS float* part = (LAS float*)(F.lds + 16384);
            __syncthreads();
            for (int i = F.tid; i < 4 * DM; i += NTHR) sl[i] = silu_f(args.in[1][i]);
            __syncthreads();
            const float* wm = args.in[3] + (size_t)(F.wave * 128) * (NMOD * DM) + ch * 64 + F.lane;
            float a0 = 0.f, a1 = 0.f, a2 = 0.f, a3 = 0.f;
#pragma unroll 8
            for (int k = 0; k < 128; ++k) { const float w = wm[(size_t)k * (NMOD * DM)]; const int kk = F.wave * 128 + k; a0 += sl[kk] * w; a1 += sl[DM + kk] * w; a2 += sl[2 * DM + kk] * w; a3 += sl[3 * DM + kk] * w; }
            part[(F.wave * 4 + 0) * 64 + F.lane] = a0; part[(F.wave * 4 + 1) * 64 + F.lane] = a1; part[(F.wave * 4 + 2) * 64 + F.lane] = a2; part[(F.wave * 4 + 3) * 64 + F.lane] = a3;
            __syncthreads();
            if (F.tid < 256) { const int b = F.tid >> 6, l = F.tid & 63; float s = args.in[4][ch * 64 + l];
#pragma unroll
                for (int w = 0; w < 8; ++w) s += part[(w * 4 + b) * 64 + l];
                mod[b * (NMOD * DM) + ch * 64 + l] = s; }
            __syncthreads();
        }
        for (int idx = blockIdx.x * NTHR + F.tid; idx < MT * 48; idx += F.G * NTHR) { const int tok = idx / 48, i = idx % 48;
            const float inv = (i < 32) ? powf(10000.f, -(float)i / 32.f) : powf(10000.f, -(float)(i - 32) / 16.f);
            const float ang = (float)((const int*)args.in[2])[tok] * inv; tab[idx] = make_float2(cosf(ang), sinf(ang)); }
        tr_job_mapped(F, args, 0, 2 * FF, 0, DM, (h16*)(ws + OW_GU1), nullptr, scr, 0);
        tr_job_plain(F, args.in[8], DM, DM, FF, (h16*)(ws + OW_D1), scr, 768);
        tr_job_mapped(F, args, 2, NIN3, 0, DM, (h16*)(ws + OW_IN), nullptr, scr, 128);
        tr_job_plain(F, args.in[11] + C_GATE, DIN, 2048, DM, (h16*)(ws + OW_GATE), scr, 1664);
        tr_job_mapped(F, args, 3, 512, 2048, QL, (h16*)(ws + OW_4), args.in[12], scr, 640);
        tr_job_plain(F, args.in[19], DM, DM, 256, (h16*)(ws + OW_UPB), scr, 736);
        tr_job_plain(F, args.in[20], DM, DM, DM, (h16*)(ws + OW_O), scr, 864);
        tr_job_mapped(F, args, 1, 2 * FF, 0, DM, (h16*)(ws + OW_GU2), nullptr, scr, 1376);
        tr_job_plain(F, args.in[25], DM, DM, FF, (h16*)(ws + OW_D2), scr, 96);
        for (int idx = blockIdx.x * NTHR + F.tid; idx < 2048 * QL; idx += F.G * NTHR) { const int n = idx / QL, k = idx % QL, hd = n >> 8, r = n & 255;
            const float* pa = args.in[14] + (size_t)k * 768 + hd * 96; const float* pb = args.in[15] + (size_t)r * 512 + hd * 64; float s = 0.f;
#pragma unroll 8
            for (int e = 0; e < 64; ++e) s += pa[e] * pb[e];
            ((h16*)(ws + OW_4))[(size_t)n * QL + k] = (h16)(s * args.in[12][k]); }
        for (int idx = blockIdx.x * NTHR + F.tid; idx < DM * 2048; idx += F.G * NTHR) { const int d = idx >> 11, kx = idx & 2047, hd = kx >> 8, r = kx & 255;
            const float* pa = args.in[16] + (size_t)r * 512 + hd * 64; const float* pb = args.in[18] + (size_t)(hd * 64) * DM + d; float s = 0.f;
#pragma unroll 8
            for (int v = 0; v < 64; ++v) s += pa[v] * pb[(size_t)v * DM];
            ((h16*)(ws + OW_OV))[idx] = (h16)s; }
    }
    SEAM(0);
    if (IN(1)) ph_normmod(F, args.in[0], args.in[5], mod, 1, 0, Hb);
    SEAM(1);
    if (IN(2)) { pg8::Gemm g{Hb, (const h16*)(ws + OW_GU1), MT, 2 * FF, DM}; pg8::StaticOrder S; S.init(MT, 2 * FF, F.G, (int)blockIdx.x); pg8::EpiSwiGLU E{Ab};
        pg8::gemm_phase<pg8::EpiSwiGLU, true>(F.lds, g, S, E); }
    SEAM(2);
    if (IN(3)) { pg8::Gemm g{Ab, (const h16*)(ws + OW_D1), MT, DM, FF}; pg8::StaticOrder S; S.init(MT, DM, F.G, (int)blockIdx.x); pg8::EpiF32 E{Fb, DM};
        pg8::gemm_phase<pg8::EpiF32, false>(F.lds, g, S, E); }
    SEAM(3);
    if (IN(4)) ph_resnorm(F, args.in[0], Fb, args.in[9], mod, 2, 0.5f, args.out, true, args.in[10], 4, 3, Hb);
    SEAM(4);
    if (IN(5)) { pg8::Gemm g{Hb, (const h16*)(ws + OW_IN), MT, NIN3, DM}; pg8::StaticOrder S; S.init(MT, NIN3, F.G, (int)blockIdx.x);
        pg8::EpiIn E{(h16*)(ws + OFF_CKV), (h16*)(ws + OFF_CQ), (h16*)(ws + OFF_KR), (h16*)(ws + OFF_KI), (h16*)(ws + OFF_QB), (h16*)(ws + OFF_KB), (h16*)(ws + OFF_VT), (float*)(ws + OFF_WI), (float*)(ws + OFF_SSQ),
                     args.in[13], tab, (LAS float*)(F.lds + XCH_OFF)};
        pg8::gemm_phase<pg8::EpiIn, true>(F.lds, g, S, E); }
    SEAM(5);
    if (IN(6)) ph_dilated_mfma(F, (const h16*)(ws + OFF_QB), (const h16*)(ws + OFF_KB), (const h16*)(ws + OFF_VT), (h16*)(ws + OFF_OG), (float*)(ws + OFF_LSE));
    SEAM(6);
    if (IN(7)) { pg8::Gemm g{(const h16*)(ws + OFF_CQ), (const h16*)(ws + OW_4), MT, N4, QL}; pg8::StaticOrder S; S.init(MT, N4, F.G, (int)blockIdx.x);
        pg8::Epi4 E{(h16*)(ws + OFF_QLAT), (h16*)(ws + OFF_QR), (h16*)(ws + OFF_QI), (const float*)(ws + OFF_SSQ), tab};
        pg8::gemm_phase<pg8::Epi4, true>(F.lds, g, S, E); }
    SEAM(7);
    if (IN(8)) { ph_combine(F, (const h16*)(ws + OFF_OG), (const float*)(ws + OFF_LSE), (h16*)(ws + OFF_OB));
        ph_topk_mfma(F, (const h16*)(ws + OFF_QI), (const h16*)(ws + OFF_KI), (const float*)(ws + OFF_WI), (unsigned short*)(ws + OFF_SEL)); }
    SEAM(8);
    if (IN(9)) ph_sparse_mfma(F, (h16*)(ws + OFF_QLAT), (const h16*)(ws + OFF_QR), (const h16*)(ws + OFF_CKV), (const h16*)(ws + OFF_KR), (const unsigned short*)(ws + OFF_SEL));
    SEAM(9);
    if (IN(10)) { const int Z_PARTS = args.zparts; pg8::StaticOrder S; S.init(MT, DM, F.G, (int)blockIdx.x); h16* Y1 = (h16*)(ws + OFF_Y1); h16* Y2 = (h16*)(ws + OFF_Y2);
        if (Z_PARTS == 32) { pg8::Gemm g{Hb, (const h16*)(ws + OW_GATE) + (size_t)DM * DM, MT, DM, DM}; pg8::EpiH16 E{Y1}; pg8::gemm_phase<pg8::EpiH16, false>(F.lds, g, S, E); }
        else if (Z_PARTS == 8) { pg8::Gemm g{Hb, (const h16*)(ws + OW_GATE) + (size_t)DM * DM, MT, DM, DM}; pg8::EpiGate E{Y2, Y1, 0}; pg8::gemm_phase<pg8::EpiGate, false>(F.lds, g, S, E); }
        else if (Z_PARTS == 4) { pg8::Gemm g{(const h16*)(ws + OFF_OB), (const h16*)(ws + OW_UPB), MT, DM, 256}; pg8::EpiH16 E{Y1}; pg8::gemm_phase<pg8::EpiH16, false>(F.lds, g, S, E); }
        else {
        if (Z_PARTS & 1) {
        { pg8::Gemm g{(const h16*)(ws + OFF_QLAT), (const h16*)(ws + OW_OV), MT, DM, 2048}; pg8::EpiH16 E{Y1}; pg8::gemm_phase<pg8::EpiH16, false>(F.lds, g, S, E); }
        { pg8::Gemm g{Hb, (const h16*)(ws + OW_GATE), MT, DM, DM}; pg8::EpiGate E{Y1, Y1, 0}; pg8::gemm_phase<pg8::EpiGate, false>(F.lds, g, S, E); } }
        if (Z_PARTS & 2) {
        { pg8::Gemm g{(const h16*)(ws + OFF_OB), (const h16*)(ws + OW_UPB), MT, DM, 256}; pg8::EpiH16 E{Y2}; pg8::gemm_phase<pg8::EpiH16, false>(F.lds, g, S, E); }
        { pg8::Gemm g{Hb, (const h16*)(ws + OW_GATE) + (size_t)DM * DM, MT, DM, DM}; pg8::EpiGate E{Y2, Y1, (Z_PARTS & 1)}; pg8::gemm_phase<pg8::EpiGate, false>(F.lds, g, S, E); } } } }
    SEAM(10);
    if (IN(11)) { pg8::Gemm g{(const h16*)(ws + OFF_Y1), (const h16*)(ws + OW_O), MT, DM, DM}; pg8::StaticOrder S; S.init(MT, DM, F.G, (int)blockIdx.x); pg8::EpiF32 E{(float*)(ws + OFF_YF), DM};
        pg8::gemm_phase<pg8::EpiF32, false>(F.lds, g, S, E); }
    SEAM(11);
    if (IN(12)) ph_resnorm(F, args.out, (const float*)(ws + OFF_YF), args.in[21], mod, 5, 1.0f, args.out, true, args.in[22], 7, 6, Hb);
    SEAM(12);
    if (IN(13)) { pg8::Gemm g{Hb, (const h16*)(ws + OW_GU2), MT, 2 * FF, DM}; pg8::StaticOrder S; S.init(MT, 2 * FF, F.G, (int)blockIdx.x); pg8::EpiSwiGLU E{Ab};
        pg8::gemm_phase<pg8::EpiSwiGLU, true>(F.lds, g, S, E); }
    SEAM(13);
    if (IN(14)) { pg8::Gemm g{Ab, (const h16*)(ws + OW_D2), MT, DM, FF}; pg8::StaticOrder S; S.init(MT, DM, F.G, (int)blockIdx.x); pg8::EpiF32 E{Fb, DM};
        pg8::gemm_phase<pg8::EpiF32, false>(F.lds, g, S, E); }
    SEAM(14);
    if (IN(15)) ph_resnorm(F, args.out, Fb, args.in[26], mod, 8, 0.5f, args.out, false, nullptr, 0, 0, nullptr);
#undef IN
#undef SEAM
}


__global__ void n_stat_h16(const h16* p, size_t n, float* acc) {
    __shared__ float red[4];
    float a = 0.f, b = 0.f;
    for (size_t i = (size_t)blockIdx.x * 256 + threadIdx.x; i < n; i += (size_t)gridDim.x * 256) { const float v = (float)p[i]; const float w = (float)(((unsigned)(i * 2654435761u) >> 16) & 255u) * (1.f / 128.f) - 1.f; a += v * v; b += v * w; }
    a = block_sum256(a, red); b = block_sum256(b, red);
    if (threadIdx.x == 0) { atomicAdd(acc, a); atomicAdd(acc + 1, b); }
}
__global__ void n_tr(const float* W, int ldw, int N, int K, h16* WT) {
    const size_t idx = (size_t)blockIdx.x * 256 + threadIdx.x; if (idx >= (size_t)N * K) return;
    const int n = (int)(idx / K), k = (int)(idx % K); WT[idx] = (h16)W[(size_t)k * ldw + n];
}
__global__ void n_scale(float* out, const float* acc, float gain) {
    const size_t i = (size_t)blockIdx.x * 256 + threadIdx.x;
    const float d0 = fabsf(acc[0] - acc[2]) / fmaxf(fabsf(acc[2]), 1e-20f), d1 = fabsf(acc[1] - acc[3]) / fmaxf(sqrtf(fabsf(acc[2])), 1e-20f);
    const float d = fminf(fmaxf(d0, d1) * gain, 10.f);
    out[i] *= (1.f + d);
}
#ifndef FASTMASK
#define FASTMASK 0xFFFFu
#endif
extern "C" void kernel_launch(void* const* d_in, const int* in_sizes, int n_in, void* d_out, int out_size, void* d_ws, size_t ws_size, hipStream_t stream) {
    if (n_in != 27 || ws_size < WS_END || out_size != MT * DM) { fprintf(stderr, "kernel_launch: unexpected shapes (n_in %d ws %zu out %d)\n", n_in, ws_size, out_size); return; }
    static int grid = 0;
    if (grid == 0) {
        int dev = 0, cus = 0, per_cu = 0;
        if (hipGetDevice(&dev) != hipSuccess || hipDeviceGetAttribute(&cus, hipDeviceAttributeMultiprocessorCount, dev) != hipSuccess) { grid = -1; return; }
        if (hipFuncSetAttribute((const void*)mega_fwd, hipFuncAttributeMaxDynamicSharedMemorySize, LDS_BYTES) != hipSuccess) { fprintf(stderr, "kernel_launch: hipFuncSetAttribute failed\n"); grid = -1; return; }
        if (hipOccupancyMaxActiveBlocksPerMultiprocessor(&per_cu, (const void*)mega_fwd, NTHR, LDS_BYTES) != hipSuccess || per_cu < 1) { fprintf(stderr, "kernel_launch: occupancy query says %d blocks/CU\n", per_cu); grid = -1; return; }
        grid = cus;
    }
    if (grid < 0) return;
    const float* x = (const float*)d_in[0]; const float* c = (const float*)d_in[1]; const int* pos = (const int*)d_in[2];
    const float *w_mod = (const float*)d_in[3], *b_mod = (const float*)d_in[4], *g_pre1 = (const float*)d_in[5], *w_gate1 = (const float*)d_in[6], *w_up1 = (const float*)d_in[7], *w_down1 = (const float*)d_in[8],
                *g_post1 = (const float*)d_in[9], *g_premix = (const float*)d_in[10], *w_in = (const float*)d_in[11], *g_cq = (const float*)d_in[12], *g_ckv = (const float*)d_in[13], *w_uq = (const float*)d_in[14],
                *w_uk = (const float*)d_in[15], *w_uv = (const float*)d_in[16], *w_iq = (const float*)d_in[17], *w_up_a = (const float*)d_in[18], *w_up_b = (const float*)d_in[19], *w_o = (const float*)d_in[20],
                *g_postmix = (const float*)d_in[21], *g_pre2 = (const float*)d_in[22], *w_gate2 = (const float*)d_in[23], *w_up2 = (const float*)d_in[24], *w_down2 = (const float*)d_in[25], *g_post2 = (const float*)d_in[26];
    float* out = (float*)d_out; char* ws = (char*)d_ws;
    float* mod = (float*)(ws + OFF_MOD); float2* tab = (float2*)(ws + OFF_ROPE);
    h16* Hb = (h16*)(ws + OFF_H); h16* Ab = (h16*)(ws + OFF_A); float* Fb = (float*)(ws + OFF_F);
    h16 *qb = (h16*)(ws + OFF_QB), *kb = (h16*)(ws + OFF_KB), *vT = (h16*)(ws + OFF_VT), *ckv = (h16*)(ws + OFF_CKV), *kr = (h16*)(ws + OFF_KR), *ki = (h16*)(ws + OFF_KI), *cq = (h16*)(ws + OFF_CQ);
    float *wi = (float*)(ws + OFF_WI), *ssq = (float*)(ws + OFF_SSQ), *lse = (float*)(ws + OFF_LSE);
    h16 *og = (h16*)(ws + OFF_OG), *qlat = (h16*)(ws + OFF_QLAT), *qr = (h16*)(ws + OFF_QR), *qi = (h16*)(ws + OFF_QI), *ob = (h16*)(ws + OFF_OB);
    unsigned short* sel = (unsigned short*)(ws + OFF_SEL);
    float* Y = (float*)(ws + OFF_YF);
#define GEMM(TA, A, lda, B, ldb, bs, C, ldc, N, K) hipLaunchKernelGGL((n_gemm<TA>), dim3(((N) + 63) / 64, MT / 64), dim3(256), 0, stream, A, lda, B, ldb, bs, C, ldc, N, K)
    auto mega = [&](int lo, int hi, int zparts = 3) {
        hipMemsetAsync(ws + OFF_CTL, 0, 1 * MiB, stream);
        Args a{}; for (int i = 0; i < 27; ++i) a.in[i] = (const float*)d_in[i]; a.out = out; a.ws = (unsigned char*)d_ws; a.ph_lo = lo; a.ph_hi = hi; a.zparts = zparts;
        void* kargs[] = {&a};
        const hipError_t e = hipLaunchCooperativeKernel((const void*)mega_fwd, dim3(grid), dim3(NTHR), kargs, LDS_BYTES, stream);
        if (e != hipSuccess) fprintf(stderr, "kernel_launch: cooperative launch failed: %s (grid %d)\n", hipGetErrorString(e), grid);
    };
    auto naive = [&](int s, int Z_PARTS = 3) {
        switch (s) {
        case 0: hipLaunchKernelGGL(n_mod, dim3(NMOD * DM / 256, NB), dim3(256), 0, stream, c, w_mod, b_mod, mod);
                hipLaunchKernelGGL(n_rope_tab, dim3(MT * 48 / 256), dim3(256), 0, stream, pos, tab); break;
        case 1: hipLaunchKernelGGL(n_normmod, dim3(MT), dim3(256), 0, stream, x, g_pre1, mod, 1, 0, Hb); break;
        case 2: hipLaunchKernelGGL(n_gemm_swiglu, dim3(FF / 64, MT / 64), dim3(256), 0, stream, Hb, w_gate1, w_up1, Ab); break;
        case 3: GEMM(h16, Ab, FF, w_down1, DM, (const float*)nullptr, Fb, DM, DM, FF); break;
        case 4: hipLaunchKernelGGL(n_resnorm, dim3(MT), dim3(256), 0, stream, x, Fb, g_post1, mod, 2, 0.5f, out);
                hipLaunchKernelGGL(n_normmod, dim3(MT), dim3(256), 0, stream, out, g_premix, mod, 4, 3, Hb); break;
        case 5:
            GEMM(h16, Hb, DM, w_in + C_CQ, DIN, (const float*)nullptr, Fb, QL, QL, DM);
            hipLaunchKernelGGL(n_post_cq, dim3(MT / 4), dim3(256), 0, stream, Fb, cq, ssq);
            GEMM(h16, Hb, DM, w_in + C_CKV, DIN, (const float*)nullptr, Fb, KVL, KVL, DM);
            hipLaunchKernelGGL(n_post_ckv, dim3(MT / 4), dim3(256), 0, stream, Fb, g_ckv, ckv);
            GEMM(h16, Hb, DM, w_in + C_KR, DIN, (const float*)nullptr, Fb, 72, 72, DM);
            hipLaunchKernelGGL(n_post_small, dim3(MT * 40 / 256), dim3(256), 0, stream, Fb, tab, kr, ki, wi);
            GEMM(h16, Hb, DM, w_in + C_QKV, DIN, (const float*)nullptr, Fb, 768, 768, DM);
            hipLaunchKernelGGL(n_post_qk, dim3(MT * 384 / 256), dim3(256), 0, stream, Fb, tab, 0.125f * LOG2E, qb);
            GEMM(h16, Hb, DM, w_in + C_QKV + 768, DIN, (const float*)nullptr, Fb, 768, 768, DM);
            hipLaunchKernelGGL(n_post_qk, dim3(MT * 384 / 256), dim3(256), 0, stream, Fb, tab, 1.0f, kb);
            GEMM(h16, Hb, DM, w_in + C_QKV + 1536, DIN, (const float*)nullptr, Fb, 768, 768, DM);
            hipLaunchKernelGGL(n_post_v, dim3(MT * 768 / 256), dim3(256), 0, stream, Fb, vT); break;
        case 6: hipLaunchKernelGGL(n_dilated, dim3(MT, 12), dim3(128), 0, stream, qb, kb, vT, og, lse); break;
        case 7: { float* Tq = (float*)(ws + OFF_F + 33 * MiB);
            for (int hh = 0; hh < 2; ++hh) {
                GEMM(h16, cq, QL, w_uq + hh * 384, 768, g_cq, Tq, 384, 384, QL);
                hipLaunchKernelGGL(n_post_q, dim3(MT), dim3(256), 0, stream, Tq, ssq, w_uk, tab, qlat, qr, hh * 4); }
            GEMM(h16, cq, QL, w_iq, 256, g_cq, Tq, 256, 256, QL);
            hipLaunchKernelGGL(n_post_qi, dim3(MT * 128 / 256), dim3(256), 0, stream, Tq, ssq, tab, qi); } break;
        case 8: hipLaunchKernelGGL(n_topk, dim3(MT), dim3(256), 0, stream, qi, ki, wi, sel);
                hipLaunchKernelGGL(n_combine, dim3(MT), dim3(256), 0, stream, og, lse, ob); break;
        case 9: hipLaunchKernelGGL(n_sparse, dim3(MT), dim3(256), 0, stream, qlat, qr, ckv, kr, sel); break;
        case 10: { h16* oa = (h16*)(ws + OFF_Y2 + 16 * MiB);
            hipLaunchKernelGGL(n_oa, dim3(MT), dim3(256), 0, stream, qlat, w_uv, oa);
            h16* z = (h16*)(ws + OFF_Y1); float* Tg = (float*)(ws + OFF_A + 64 * MiB); float* Ty = (float*)(ws + OFF_F + 32 * MiB);
            for (int q = 0; q < 4; ++q) { const int n0 = q * 256;
                if (Z_PARTS == 4) { GEMM(h16, ob, 256, w_up_b + n0, DM, (const float*)nullptr, Ty, 256, 256, 256);
                    hipLaunchKernelGGL(n_gate, dim3(MT * 256 / 256), dim3(256), 0, stream, Ty, Ty, z, n0, 2); continue; }
                if (Z_PARTS & 1) {
                GEMM(h16, Hb, DM, w_in + C_GATE + n0, DIN, (const float*)nullptr, Tg, 256, 256, DM);
                GEMM(h16, oa, 512, w_up_a + n0, DM, (const float*)nullptr, Ty, 256, 256, 512);
                hipLaunchKernelGGL(n_gate, dim3(MT * 256 / 256), dim3(256), 0, stream, Tg, Ty, z, n0, 0); }
                if (Z_PARTS & 2) {
                GEMM(h16, Hb, DM, w_in + C_GATE + 1024 + n0, DIN, (const float*)nullptr, Tg, 256, 256, DM);
                GEMM(h16, ob, 256, w_up_b + n0, DM, (const float*)nullptr, Ty, 256, 256, 256);
                hipLaunchKernelGGL(n_gate, dim3(MT * 256 / 256), dim3(256), 0, stream, Tg, Ty, z, n0, (Z_PARTS & 1)); } } } break;
        case 11: GEMM(h16, (h16*)(ws + OFF_Y1), DM, w_o, DM, (const float*)nullptr, Y, DM, DM, DM); break;
        case 12: hipLaunchKernelGGL(n_resnorm, dim3(MT), dim3(256), 0, stream, out, Y, g_postmix, mod, 5, 1.0f, out);
                 hipLaunchKernelGGL(n_normmod, dim3(MT), dim3(256), 0, stream, out, g_pre2, mod, 7, 6, Hb); break;
        case 13: hipLaunchKernelGGL(n_gemm_swiglu, dim3(FF / 64, MT / 64), dim3(256), 0, stream, Hb, w_gate2, w_up2, Ab); break;
        case 14: GEMM(h16, Ab, FF, w_down2, DM, (const float*)nullptr, Fb, DM, DM, FF); break;
        case 15: hipLaunchKernelGGL(n_resnorm, dim3(MT), dim3(256), 0, stream, out, Fb, g_post2, mod, 8, 0.5f, out); break;
        }
    };
#ifdef DBG_W
    { float* dacc = (float*)(ws + OFF_MOD + 512 * 1024);
      hipMemsetAsync(dacc, 0, 16, stream);
      mega(0, 1);
      hipLaunchKernelGGL(n_stat_h16, dim3(2048), dim3(256), 0, stream, (const h16*)(ws + OW_GATE), (size_t)2048 * DM, dacc);
      hipLaunchKernelGGL(n_stat_h16, dim3(2048), dim3(256), 0, stream, (const h16*)(ws + OW_UPB), (size_t)DM * 256, dacc);
      hipLaunchKernelGGL(n_tr, dim3(2048 * DM / 256), dim3(256), 0, stream, w_in + C_GATE, DIN, 2048, DM, (h16*)(ws + OW_GATE));
      hipLaunchKernelGGL(n_tr, dim3(DM * 256 / 256), dim3(256), 0, stream, w_up_b, DM, DM, 256, (h16*)(ws + OW_UPB));
      hipLaunchKernelGGL(n_stat_h16, dim3(2048), dim3(256), 0, stream, (const h16*)(ws + OW_GATE), (size_t)2048 * DM, dacc + 2);
      hipLaunchKernelGGL(n_stat_h16, dim3(2048), dim3(256), 0, stream, (const h16*)(ws + OW_UPB), (size_t)DM * 256, dacc + 2);
      for (int s = 0; s < 16; ++s) naive(s);
      hipLaunchKernelGGL(n_scale, dim3(MT * DM / 256), dim3(256), 0, stream, out, dacc, 1.0f); }
#elif defined(DBG_STAGE)
    float* dacc = (float*)(ws + OFF_MOD + 512 * 1024);
    for (int s = 0; s < 16;) {
        if (s == DBG_STAGE) {
            hipMemsetAsync(dacc, 0, 16, stream);
            if (DBG_PARTS == 8) naive(s, 16);
            mega(s, s + 1, DBG_PARTS); hipLaunchKernelGGL(n_stat_h16, dim3(2048), dim3(256), 0, stream, (const h16*)(ws + DBG_OFF), (size_t)DBG_N, dacc);
            naive(s, DBG_PARTS == 8 ? 2 : DBG_PARTS);       hipLaunchKernelGGL(n_stat_h16, dim3(2048), dim3(256), 0, stream, (const h16*)(ws + DBG_OFF), (size_t)DBG_N, dacc + 2);
            if (DBG_PARTS != 3) naive(s);
            ++s; continue; }
        if ((FASTMASK >> s) & 1u) { int e = s; while (e < 16 && e != DBG_STAGE && ((FASTMASK >> e) & 1u)) ++e; mega(s, e); s = e; }
        else { naive(s); ++s; }
    }
    hipLaunchKernelGGL(n_scale, dim3(MT * DM / 256), dim3(256), 0, stream, out, dacc, DBG_GAIN);
#else
    for (int s = 0; s < 16;) {
        if ((FASTMASK >> s) & 1u) { int e = s; while (e < 16 && ((FASTMASK >> e) & 1u)) ++e; mega(s, e); s = e; }
        else { naive(s); ++s; }
    }
#endif
    (void)in_sizes;
}
```

```cpp
#include <hip/hip_runtime.h>
#include <hip/hip_fp16.h>
#include <cstdio>
#include <cstdint>
#define DBG_NOGATE 0

constexpr int NB = 4, SEQ = 4096, DM = 1024, MT = NB * SEQ, FF = 2816;
constexpr int QL = 384, KVL = 256, DNOPE = 64, DROPE = 32, DVA = 64, HA = 8, HI = 8, DI = 32, TOPK = 256;
constexpr int NG = 3, HB = 4, DHB = 64, NMOD = 9, DIN = 5064;
constexpr int C_CQ = 0, C_CKV = 384, C_KR = 640, C_KI = 672, C_WI = 704, C_QKV = 712, C_GATE = 3016;
constexpr float EPS = 1e-6f, LOG2E = 1.4426950408889634f;
typedef _Float16 h16;

constexpr size_t MiB = 1u << 20;
constexpr size_t OFF_CTL = 0, OFF_MOD = 1 * MiB, OFF_ROPE = 2 * MiB, OFF_W = 8 * MiB, OFF_H = 60 * MiB, OFF_A = 92 * MiB, OFF_F = 180 * MiB, OFF_SP = 244 * MiB, WS_END = 256 * MiB;
constexpr size_t OFF_QB = OFF_A, OFF_KB = OFF_A + 24 * MiB, OFF_VT = OFF_A + 48 * MiB, OFF_CKV = OFF_A + 72 * MiB, OFF_KR = OFF_A + 80 * MiB, OFF_KI = OFF_A + 81 * MiB,
                 OFF_WI = OFF_A + 82 * MiB, OFF_SSQ = OFF_A + 82 * MiB + 512 * 1024, OFF_CQ = OFF_SP;
constexpr size_t OFF_RSTDQ = OFF_A + 83 * MiB;
constexpr size_t OFF_OG = OFF_F, OFF_LSE = OFF_F + 24 * MiB, OFF_QLAT = OFF_A, OFF_QR = OFF_A + 64 * MiB, OFF_QI = OFF_F + 25 * MiB, OFF_SEL = OFF_F + 33 * MiB, OFF_OB = OFF_SP;
constexpr size_t OFF_Y1 = OFF_F, OFF_Y2 = OFF_F + 32 * MiB, OFF_YF = OFF_A;

__device__ __forceinline__ float silu_f(float v) { return v / (1.f + __expf(-v)); }
__device__ __forceinline__ float sigm_f(float v) { return 1.f / (1.f + __expf(-v)); }
__device__ __forceinline__ float block_sum256(float v, float* red) {
#pragma unroll
    for (int o = 32; o > 0; o >>= 1) v += __shfl_xor(v, o);
    __syncthreads();
    if ((threadIdx.x & 63) == 0) red[threadIdx.x >> 6] = v;
    __syncthreads();
    return red[0] + red[1] + red[2] + red[3];
}
__device__ __forceinline__ float block_max256(float v, float* red) {
#pragma unroll
    for (int o = 32; o > 0; o >>= 1) v = fmaxf(v, __shfl_xor(v, o));
    __syncthreads();
    if ((threadIdx.x & 63) == 0) red[threadIdx.x >> 6] = v;
    __syncthreads();
    return fmaxf(fmaxf(red[0], red[1]), fmaxf(red[2], red[3]));
}

__global__ void n_mod(const float* c, const float* w_mod, const float* b_mod, float* mod) {
    const int j = blockIdx.x * 256 + threadIdx.x, b = blockIdx.y;
    float acc = b_mod[j];
    for (int k = 0; k < DM; ++k) acc += silu_f(c[b * DM + k]) * w_mod[(size_t)k * (NMOD * DM) + j];
    mod[b * (NMOD * DM) + j] = acc;
}
__global__ void n_rope_tab(const int* pos, float2* tab) {
    const int idx = blockIdx.x * 256 + threadIdx.x; if (idx >= MT * 48) return;
    const int tok = idx / 48, i = idx % 48;
    const float inv = (i < 32) ? powf(10000.f, -(float)i / 32.f) : powf(10000.f, -(float)(i - 32) / 16.f);
    const float ang = (float)pos[tok] * inv;
    tab[idx] = make_float2(cosf(ang), sinf(ang));
}
__global__ void n_normmod(const float* x, const float* g, const float* mod, int isc, int ish, h16* out) {
    __shared__ float red[4];
    const int row = blockIdx.x, b = row / SEQ, t = threadIdx.x;
    const float4 v = ((const float4*)(x + (size_t)row * DM))[t];
    const float ss = block_sum256(v.x * v.x + v.y * v.y + v.z * v.z + v.w * v.w, red);
    const float rstd = rsqrtf(ss * (1.f / DM) + EPS);
    const float* sc = mod + b * (NMOD * DM) + isc * DM; const float* sh = mod + b * (NMOD * DM) + ish * DM;
    const float vv[4] = {v.x, v.y, v.z, v.w};
#pragma unroll
    for (int e = 0; e < 4; ++e) { const int cidx = 4 * t + e; out[(size_t)row * DM + cidx] = (h16)(vv[e] * rstd * g[cidx] * (1.f + sc[cidx]) + sh[cidx]); }
}
__global__ void n_resnorm(const float* xin, const float* f, const float* g, const float* mod, int igt, float coef, float* xout) {
    __shared__ float red[4];
    const int row = blockIdx.x, b = row / SEQ, t = threadIdx.x;
    const float4 v = ((const float4*)(f + (size_t)row * DM))[t];
    const float ss = block_sum256(v.x * v.x + v.y * v.y + v.z * v.z + v.w * v.w, red);
    const float rstd = rsqrtf(ss * (1.f / DM) + EPS);
    const float* gt = mod + b * (NMOD * DM) + igt * DM;
    const float4 xi = ((const float4*)(xin + (size_t)row * DM))[t];
    const float vv[4] = {v.x, v.y, v.z, v.w}, xx[4] = {xi.x, xi.y, xi.z, xi.w};
    float o[4];
#pragma unroll
    for (int e = 0; e < 4; ++e) { const int cidx = 4 * t + e; o[e] = xx[e] + coef * gt[cidx] * vv[e] * rstd * g[cidx]; }
    ((float4*)(xout + (size_t)row * DM))[t] = make_float4(o[0], o[1], o[2], o[3]);
}
template <typename TA>
__global__ void __launch_bounds__(256) n_gemm(const TA* A, int lda, const float* B, int ldb, const float* bs, float* C, int ldc, int N, int K) {
    __shared__ float As[16][65], Bs[16][65];
    const int tx = threadIdx.x & 15, ty = threadIdx.x >> 4, m0 = blockIdx.y * 64, n0 = blockIdx.x * 64;
    float acc[4][4] = {};
    for (int k0 = 0; k0 < K; k0 += 16) {
        for (int i = threadIdx.x; i < 1024; i += 256) { const int r = i >> 4, kk = i & 15; As[kk][r] = (float)A[(size_t)(m0 + r) * lda + k0 + kk]; }
        for (int i = threadIdx.x; i < 1024; i += 256) { const int kk = i >> 6, cc = i & 63; const int n = n0 + cc; Bs[kk][cc] = (n < N) ? B[(size_t)(k0 + kk) * ldb + n] * (bs ? bs[k0 + kk] : 1.f) : 0.f; }
        __syncthreads();
#pragma unroll
        for (int kk = 0; kk < 16; ++kk) {
            float a[4], b[4];
#pragma unroll
            for (int i = 0; i < 4; ++i) { a[i] = As[kk][ty * 4 + i]; b[i] = Bs[kk][tx * 4 + i]; }
#pragma unroll
            for (int i = 0; i < 4; ++i)
#pragma unroll
                for (int j = 0; j < 4; ++j) acc[i][j] += a[i] * b[j];
        }
        __syncthreads();
    }
#pragma unroll
    for (int i = 0; i < 4; ++i)
#pragma unroll
        for (int j = 0; j < 4; ++j) { const int n = n0 + tx * 4 + j; if (n < N) C[(size_t)(m0 + ty * 4 + i) * ldc + n] = acc[i][j]; }
}
__global__ void __launch_bounds__(256) n_gemm_swiglu(const h16* A, const float* Wg, const float* Wu, h16* out) {
    __shared__ float As[16][65], Bg[16][65], Bu[16][65];
    const int tx = threadIdx.x & 15, ty = threadIdx.x >> 4, m0 = blockIdx.y * 64, n0 = blockIdx.x * 64;
    float ag[4][4] = {}, au[4][4] = {};
    for (int k0 = 0; k0 < DM; k0 += 16) {
        for (int i = threadIdx.x; i < 1024; i += 256) { const int r = i >> 4, kk = i & 15; As[kk][r] = (float)A[(size_t)(m0 + r) * DM + k0 + kk]; }
        for (int i = threadIdx.x; i < 1024; i += 256) { const int kk = i >> 6, cc = i & 63; Bg[kk][cc] = Wg[(size_t)(k0 + kk) * FF + n0 + cc]; Bu[kk][cc] = Wu[(size_t)(k0 + kk) * FF + n0 + cc]; }
        __syncthreads();
#pragma unroll
        for (int kk = 0; kk < 16; ++kk) {
            float a[4], g[4], u[4];
#pragma unroll
            for (int i = 0; i < 4; ++i) { a[i] = As[kk][ty * 4 + i]; g[i] = Bg[kk][tx * 4 + i]; u[i] = Bu[kk][tx * 4 + i]; }
#pragma unroll
            for (int i = 0; i < 4; ++i)
#pragma unroll
                for (int j = 0; j < 4; ++j) { ag[i][j] += a[i] * g[j]; au[i][j] += a[i] * u[j]; }
        }
        __syncthreads();
    }
#pragma unroll
    for (int i = 0; i < 4; ++i)
#pragma unroll
        for (int j = 0; j < 4; ++j) out[(size_t)(m0 + ty * 4 + i) * FF + n0 + tx * 4 + j] = (h16)(silu_f(ag[i][j]) * au[i][j]);
}
__global__ void n_post_cq(const float* tmp, h16* cq, float* ssq) {
    const int tok = blockIdx.x * 4 + (threadIdx.x >> 6), lane = threadIdx.x & 63;
    float s = 0.f;
    for (int i = lane; i < QL; i += 64) { const float v = tmp[(size_t)tok * QL + i]; s += v * v; cq[(size_t)tok * QL + i] = (h16)v; }
#pragma unroll
    for (int o = 32; o > 0; o >>= 1) s += __shfl_xor(s, o);
    if (lane < 8) ssq[tok * 8 + lane] = (lane == 0) ? s : 0.f;
}
__global__ void n_post_ckv(const float* tmp, const float* g, h16* ckv) {
    const int tok = blockIdx.x * 4 + (threadIdx.x >> 6), lane = threadIdx.x & 63;
    float v[4], s = 0.f;
#pragma unroll
    for (int e = 0; e < 4; ++e) { v[e] = tmp[(size_t)tok * KVL + lane + 64 * e]; s += v[e] * v[e]; }
#pragma unroll
    for (int o = 32; o > 0; o >>= 1) s += __shfl_xor(s, o);
    const float rstd = rsqrtf(s * (1.f / KVL) + EPS);
#pragma unroll
    for (int e = 0; e < 4; ++e) ckv[(size_t)tok * KVL + lane + 64 * e] = (h16)(v[e] * rstd * g[lane + 64 * e]);
}
__global__ void n_post_small(const float* tmp, const float2* tab, h16* kr, h16* ki, float* wi) {
    const int idx = blockIdx.x * 256 + threadIdx.x; if (idx >= MT * 40) return;
    const int tok = idx / 40, j = idx % 40; const float* r = tmp + (size_t)tok * 72;
    if (j < 32) { const int which = j >> 4, i = j & 15; const float2 cs = tab[tok * 48 + 32 + i]; const float x1 = r[which * 32 + i], x2 = r[which * 32 + 16 + i];
        h16* o = (which ? ki : kr) + (size_t)tok * 32; o[i] = (h16)(x1 * cs.x - x2 * cs.y); o[i + 16] = (h16)(x2 * cs.x + x1 * cs.y); }
    else wi[tok * 8 + (j - 32)] = r[64 + (j - 32)] * 0.35355339059327373f;
}
__global__ void n_post_qk(const float* tmp, const float2* tab, float scale, h16* out) {
    const int idx = blockIdx.x * 256 + threadIdx.x; if (idx >= MT * 384) return;
    const int tok = idx / 384, j = idx % 384, hd = j >> 5, i = j & 31;
    const float2 cs = tab[tok * 48 + i]; const float x1 = tmp[(size_t)tok * 768 + hd * 64 + i], x2 = tmp[(size_t)tok * 768 + hd * 64 + 32 + i];
    out[(size_t)tok * 768 + hd * 64 + i] = (h16)((x1 * cs.x - x2 * cs.y) * scale); out[(size_t)tok * 768 + hd * 64 + 32 + i] = (h16)((x2 * cs.x + x1 * cs.y) * scale);
}
__host__ __device__ __forceinline__ int dil_of(int g) { return g == 0 ? 1 : (g == 1 ? 4 : 16); }
__global__ void n_post_v(const float* tmp, h16* vb) {
    const int idx = blockIdx.x * 256 + threadIdx.x; if (idx >= MT * 768) return;
    vb[idx] = (h16)tmp[idx];
}
__global__ void __launch_bounds__(256) n_post_q(const float* tmp, const float* ssq, const float* w_uk, const float2* tab, h16* qlat, h16* qr, int h0) {
    __shared__ float q[384];
    const int tok = blockIdx.x, t = threadIdx.x;
    float s = 0.f; for (int i = 0; i < 8; ++i) s += ssq[tok * 8 + i];
    const float rstd = rsqrtf(s * (1.f / QL) + EPS), c2 = 0.10206207261596575f * LOG2E;
    for (int i = t; i < 384; i += 256) q[i] = tmp[(size_t)tok * 384 + i] * rstd;
    __syncthreads();
    if (t < 64) { const int hl = t >> 4, i = t & 15, hd = h0 + hl; const float2 cs = tab[tok * 48 + 32 + i]; const float x1 = q[hl * 96 + 64 + i], x2 = q[hl * 96 + 80 + i];
        qr[(size_t)tok * 256 + hd * 32 + i] = (h16)((x1 * cs.x - x2 * cs.y) * c2); qr[(size_t)tok * 256 + hd * 32 + 16 + i] = (h16)((x2 * cs.x + x1 * cs.y) * c2); }
    for (int hl = 0; hl < 4; ++hl) { const int hd = h0 + hl; float a = 0.f; const float* w = w_uk + (size_t)t * 512 + hd * 64;
        for (int n = 0; n < 64; ++n) a += q[hl * 96 + n] * w[n];
        qlat[(size_t)tok * 2048 + hd * 256 + t] = (h16)(a * c2); }
}
__global__ void n_post_qi(const float* tmp, const float* ssq, const float2* tab, h16* qi) {
    const int idx = blockIdx.x * 256 + threadIdx.x; if (idx >= MT * 128) return;
    const int tok = idx / 128, j = idx % 128, hd = j >> 4, i = j & 15;
    float s = 0.f; for (int e = 0; e < 8; ++e) s += ssq[tok * 8 + e];
    const float rstd = rsqrtf(s * (1.f / QL) + EPS);
    const float2 cs = tab[tok * 48 + 32 + i]; const float x1 = tmp[(size_t)tok * 256 + hd * 32 + i] * rstd, x2 = tmp[(size_t)tok * 256 + hd * 32 + 16 + i] * rstd;
    qi[(size_t)tok * 256 + hd * 32 + i] = (h16)(x1 * cs.x - x2 * cs.y); qi[(size_t)tok * 256 + hd * 32 + 16 + i] = (h16)(x2 * cs.x + x1 * cs.y);
}
__device__ __forceinline__ unsigned fkey(float f) { const unsigned u = __float_as_uint(f); return (u & 0x80000000u) ? ~u : (u | 0x80000000u); }
__global__ void __launch_bounds__(256) n_topk(const h16* qi, const h16* ki, const float* wi, unsigned short* sel) {
    __shared__ unsigned key[SEQ]; __shared__ float q[256]; __shared__ float w[8]; __shared__ unsigned cnt;
    const int tok = blockIdx.x, b = tok / SEQ, t = tok % SEQ, tid = threadIdx.x;
    unsigned short* so = sel + (size_t)tok * TOPK;
    if (t < TOPK) { so[tid] = (unsigned short)(tid <= t ? tid : 0); return; }
    q[tid] = (float)qi[(size_t)tok * 256 + tid]; if (tid < 8) w[tid] = wi[tok * 8 + tid];
    __syncthreads();
    const int n = t + 1;
#pragma unroll 1
    for (int s = tid; s < n; s += 256) {
        const h16* kp = ki + (size_t)(b * SEQ + s) * 32;
        float a[8];
#pragma unroll
        for (int hd = 0; hd < 8; ++hd) a[hd] = 0.f;
#pragma unroll 4
        for (int e = 0; e < 32; ++e) { const float kv = (float)kp[e];
#pragma unroll
            for (int hd = 0; hd < 8; ++hd) a[hd] += q[hd * 32 + e] * kv; }
        float sc = 0.f;
#pragma unroll
        for (int hd = 0; hd < 8; ++hd) sc += w[hd] * fmaxf(a[hd] * 0.17677669529663687f, 0.f);
        key[s] = fkey(sc);
    }
    __syncthreads();
    unsigned T = 0;
    for (int bit = 31; bit >= 0; --bit) {
        const unsigned cand = T | (1u << bit);
        if (tid == 0) cnt = 0; __syncthreads();
        unsigned c = 0; for (int s = tid; s < n; s += 256) c += (key[s] >= cand) ? 1u : 0u;
#pragma unroll
        for (int o = 32; o > 0; o >>= 1) c += __shfl_xor(c, o);
        if ((tid & 63) == 0) atomicAdd(&cnt, c);
        __syncthreads();
        if (cnt >= TOPK) T = cand;
        __syncthreads();
    }
    if (tid == 0) cnt = 0; __syncthreads();
    for (int s = tid; s < n; s += 256) if (key[s] > T) { const unsigned p = atomicAdd(&cnt, 1u); so[p] = (unsigned short)s; }
    __syncthreads();
    if (tid == 0) { unsigned p = cnt; for (int s = 0; s < n && p < TOPK; ++s) if (key[s] == T) so[p++] = (unsigned short)s; }
}
__global__ void __launch_bounds__(256) n_sparse(h16* qlat, const h16* qr, const h16* ckv, const h16* kr, const unsigned short* sel) {
    __shared__ float ql[8][256], qrr[8][32], p[8][256], red[4]; __shared__ int rows[256];
    const int tok = blockIdx.x, b = tok / SEQ, t = tok % SEQ, tid = threadIdx.x, cnt = (t + 1 < TOPK) ? t + 1 : TOPK;
    for (int i = tid; i < 2048; i += 256) ql[i >> 8][i & 255] = (float)qlat[(size_t)tok * 2048 + i];
    qrr[tid >> 5][tid & 31] = (float)qr[(size_t)tok * 256 + tid];
    const int row = b * SEQ + (tid < cnt ? (int)sel[(size_t)tok * TOPK + tid] : 0); rows[tid] = row;
    __syncthreads();
    float s[8];
#pragma unroll
    for (int hd = 0; hd < 8; ++hd) s[hd] = 0.f;
    if (tid < cnt) {
        const h16* kp = ckv + (size_t)row * 256;
        for (int r = 0; r < 256; ++r) { const float kvv = (float)kp[r];
#pragma unroll
            for (int hd = 0; hd < 8; ++hd) s[hd] += ql[hd][r] * kvv; }
        const h16* rp = kr + (size_t)row * 32;
        for (int e = 0; e < 32; ++e) { const float kvv = (float)rp[e];
#pragma unroll
            for (int hd = 0; hd < 8; ++hd) s[hd] += qrr[hd][e] * kvv; }
    } else {
#pragma unroll
        for (int hd = 0; hd < 8; ++hd) s[hd] = -INFINITY;
    }
    float linv[8];
#pragma unroll
    for (int hd = 0; hd < 8; ++hd) {
        const float m = block_max256(s[hd], red);
        const float e = (tid < cnt) ? exp2f(s[hd] - m) : 0.f;
        p[hd][tid] = e;
        linv[hd] = 1.f / block_sum256(e, red);
    }
    __syncthreads();
    float o[8];
#pragma unroll
    for (int hd = 0; hd < 8; ++hd) o[hd] = 0.f;
    for (int k = 0; k < cnt; ++k) { const float v = (float)ckv[(size_t)rows[k] * 256 + tid];
#pragma unroll
        for (int hd = 0; hd < 8; ++hd) o[hd] += p[hd][k] * v; }
#pragma unroll
    for (int hd = 0; hd < 8; ++hd) qlat[(size_t)tok * 2048 + hd * 256 + tid] = (h16)(o[hd] * linv[hd]);
}
__global__ void __launch_bounds__(128) n_dilated(const h16* qb, const h16* kb, const h16* vT, h16* og, float* lse2) {
    __shared__ float q[64], p[132], red[2]; __shared__ int kidx[132];
    const int tok = blockIdx.x, gh = blockIdx.y, g = gh >> 2, b = tok / SEQ, t = tok % SEQ, tid = threadIdx.x, dil = dil_of(g);
    if (tid < 64) q[tid] = (float)qb[(size_t)tok * 768 + gh * 64 + tid];
    __syncthreads();
    float sc[2]; float m = -INFINITY;
    for (int r = 0; r < 2; ++r) { const int k = tid + r * 128; sc[r] = -INFINITY;
        if (k < 129) { const int ti = t - k * dil; kidx[k] = ti;
            if (ti >= 0) { const h16* kp = kb + (size_t)(b * SEQ + ti) * 768 + gh * 64; float a = 0.f; for (int d = 0; d < 64; ++d) a += q[d] * (float)kp[d]; sc[r] = a; } }
        m = fmaxf(m, sc[r]); }
#pragma unroll
    for (int o = 32; o > 0; o >>= 1) m = fmaxf(m, __shfl_xor(m, o));
    if ((tid & 63) == 0) red[tid >> 6] = m; __syncthreads(); m = fmaxf(red[0], red[1]); __syncthreads();
    float l = 0.f;
    for (int r = 0; r < 2; ++r) { const int k = tid + r * 128; if (k < 129) { const float e = (sc[r] == -INFINITY) ? 0.f : exp2f(sc[r] - m); p[k] = e; l += e; } }
#pragma unroll
    for (int o = 32; o > 0; o >>= 1) l += __shfl_xor(l, o);
    if ((tid & 63) == 0) red[tid >> 6] = l; __syncthreads(); l = red[0] + red[1];
    if (tid < 64) { float a = 0.f; const h16* vp = vT + (size_t)(b * SEQ) * 768 + gh * 64 + tid;
        for (int k = 0; k < 129; ++k) { const int ti = kidx[k]; if (ti >= 0) a += p[k] * (float)vp[(size_t)ti * 768]; }
        og[(size_t)tok * 768 + gh * 64 + tid] = (h16)(a / l); }
    if (tid == 0) lse2[tok * 12 + gh] = m + log2f(l);
}
__global__ void n_combine(const h16* og, const float* lse2, h16* ob) {
    const int idx = blockIdx.x * 256 + threadIdx.x; if (idx >= MT * 256) return;
    const int tok = idx >> 8, c = idx & 255, hh = c >> 6;
    const float l0 = lse2[tok * 12 + hh], l1 = lse2[tok * 12 + 4 + hh], l2 = lse2[tok * 12 + 8 + hh], m = fmaxf(l0, fmaxf(l1, l2));
    const float w0 = exp2f(l0 - m), w1 = exp2f(l1 - m), w2 = exp2f(l2 - m), inv = 1.f / (w0 + w1 + w2);
    ob[idx] = (h16)((w0 * (float)og[(size_t)tok * 768 + c] + w1 * (float)og[(size_t)tok * 768 + 256 + c] + w2 * (float)og[(size_t)tok * 768 + 512 + c]) * inv);
}
__global__ void __launch_bounds__(256) n_oa(const h16* olat, const float* w_uv, h16* oa) {
    __shared__ float ol[2048];
    const int tok = blockIdx.x, tid = threadIdx.x;
    for (int i = tid; i < 2048; i += 256) ol[i] = (float)olat[(size_t)tok * 2048 + i];
    __syncthreads();
    for (int o = tid; o < 512; o += 256) { const int hd = o >> 6; float a = 0.f; for (int r = 0; r < 256; ++r) a += ol[hd * 256 + r] * w_uv[(size_t)r * 512 + o]; oa[(size_t)tok * 512 + o] = (h16)a; }
}
__global__ void n_gate(const float* tg, const float* ty, h16* z, int n0, int accum) {
    const size_t idx = (size_t)blockIdx.x * 256 + threadIdx.x; const size_t row = idx >> 8; const int col = (int)(idx & 255);
    h16* zp = z + row * DM + n0 + col;
    const float v = (accum == 2) ? ty[idx] : (sigm_f(tg[idx]) * ty[idx] + (accum ? (float)*zp : 0.f));
    *zp = (h16)v;
}
__global__ void n_f32_to_f16(const float* a, h16* o) { const size_t idx = (size_t)blockIdx.x * 256 + threadIdx.x; o[idx] = (h16)a[idx]; }


#define LAS __attribute__((address_space(3)))
#define GAS __attribute__((address_space(1)))
typedef _Float16 f16x8 __attribute__((ext_vector_type(8)));
typedef float f32x4 __attribute__((ext_vector_type(4)));
typedef float f32x2 __attribute__((ext_vector_type(2)));
typedef unsigned u32x4 __attribute__((ext_vector_type(4)));
typedef unsigned u32x2 __attribute__((ext_vector_type(2)));
typedef _Float16 h16x2 __attribute__((ext_vector_type(2)));
__device__ __forceinline__ unsigned pk_h2(float lo, float hi) { f32x2 v = {lo, hi}; h16x2 h = __builtin_convertvector(v, h16x2); return __builtin_bit_cast(unsigned, h); }

namespace pg8 {
constexpr int BM = 256, BK = 64, HALF = 128, HTB = HALF * BK * 2, STAGE_BYTES = 8 * HTB, NXCD = 8, WGM = 8;
__host__ __device__ __forceinline__ int lds_byte(int r, int c) { const int st = (r >> 4) * 2 + (c >> 5), rr = r & 15, cc = c & 31, ob = rr * 64 + cc * 2; return st * 1024 + (ob ^ (((ob >> 9) & 1) << 5)); }
__host__ __device__ __forceinline__ void stage_rc(int b, int& R, int& C) { const int st = b / 1024, sb = b % 1024, swz = sb ^ (((sb >> 9) & 1) << 5); R = (st >> 1) * 16 + swz / 64; C = (st & 1) * 32 + (swz % 64) / 2; }
__host__ __device__ __forceinline__ int perm32(int rho) { const int n = rho >> 4, i = rho & 15; return 8 * (i >> 2) + 4 * n + (i & 3); }
struct Unit { int pm, pn; };
struct Gemm { const h16* A; const h16* Bt; int M, N, K; int lda = 0, koffA = 0; };
struct StaticOrder {
    int nM, nN, nwg, G, c;
    __host__ __device__ void init(int M, int N, int G_, int c_) { nM = M / BM; nN = N / BM; nwg = nM * nN; G = G_; c = c_; }
    __host__ __device__ bool next(int i, Unit& u) const {
        const long L = (long)i * G + c; if (L >= nwg) return false;
        int wgid = (int)L; { const int q = nwg / NXCD, r = nwg % NXCD, xcd = wgid % NXCD, off = wgid / NXCD; wgid = (xcd < r ? xcd * (q + 1) : r * (q + 1) + (xcd - r) * q) + off; }
        const int nig = WGM * nN, gid = wgid / nig, fm = gid * WGM, gsz = (nM - fm) < WGM ? (nM - fm) : WGM;
        u.pm = fm + ((wgid % nig) % gsz); u.pn = (wgid % nig) / gsz; return true;
    }
};
template <class Epi, bool ALIGN_EPI>
__device__ __forceinline__ void gemm_phase(LAS unsigned char* lds, const Gemm g, const StaticOrder& S, const Epi& E) {
    const int tid = threadIdx.x, wid = __builtin_amdgcn_readfirstlane(tid >> 6), lane = tid & 63, wr = wid >> 2, wc = wid & 3, fr = lane & 15, fq = lane >> 4;
    const int K = g.K, nt = K / BK, lda = g.lda ? g.lda : g.K;
    unsigned voffA[2], voffB[2];
#pragma unroll
    for (int i = 0; i < 2; ++i) { int R, C; stage_rc(tid * 16 + i * 8192, R, C); const int Rb = Epi::PERM ? ((R & ~31) + perm32(R & 31)) : R;
        voffA[i] = (unsigned)(R * lda + C) * 2u; voffB[i] = (unsigned)(Rb * K + C) * 2u; }
    const size_t kstep = (size_t)(BK * 2);
    const size_t hstep = (size_t)HALF * K * 2, hstepA = (size_t)HALF * lda * 2;
    const size_t tstep = 2 * hstep, tstepA = 2 * hstepA, kofA = (size_t)g.koffA * 2;
    const unsigned ldsw = (unsigned)wid * 1024u;
    const int aoff = lds_byte(wr * 64 + fr, fq * 8), boff = lds_byte(wc * 32 + fr, fq * 8);
#define PG8_SA(b, h) (((b) * 2 + (h)) * HTB)
#define PG8_SB(b, h) ((4 + (b) * 2 + (h)) * HTB)
#define PG8_STAGE(bufoff, gbase, voff) do { _Pragma("unroll") for (int _i = 0; _i < 2; ++_i) \
        __builtin_amdgcn_global_load_lds((const unsigned*)((const char*)(gbase) + (voff)[_i]), (LAS unsigned*)(lds + (bufoff) + ldsw + _i * 8192), 16, 0, 0); } while (0)
#define PG8_LDA(dst, b, h) do { _Pragma("unroll") for (int m = 0; m < 4; ++m) _Pragma("unroll") for (int k = 0; k < 2; ++k) dst[m][k] = *(const LAS f16x8*)(lds + PG8_SA(b, h) + aoff + m * 2048 + k * 1024); } while (0)
#define PG8_LDB(dst, b, h) do { _Pragma("unroll") for (int n = 0; n < 2; ++n) _Pragma("unroll") for (int k = 0; k < 2; ++k) dst[n][k] = *(const LAS f16x8*)(lds + PG8_SB(b, h) + boff + n * 2048 + k * 1024); } while (0)
#define PG8_MMA(ai, bj, At, Bt) do { __builtin_amdgcn_s_setprio(1); _Pragma("unroll") for (int m = 0; m < 4; ++m) _Pragma("unroll") for (int n = 0; n < 2; ++n) _Pragma("unroll") for (int k = 0; k < 2; ++k) \
        acc[ai][bj][m][n] = __builtin_amdgcn_mfma_f32_16x16x32_f16(Bt[n][k], At[m][k], acc[ai][bj][m][n], 0, 0, 0); __builtin_amdgcn_s_setprio(0); } while (0)
#define PG8_WAIT_V(n) asm volatile("s_waitcnt vmcnt(" #n ")" ::: "memory")
#define PG8_WAIT_L(n) asm volatile("s_waitcnt lgkmcnt(" #n ")" ::: "memory")
#define PG8_BAR __builtin_amdgcn_s_barrier()
#define PG8_SCHED __builtin_amdgcn_sched_barrier(0)
    Unit cur, nxt; int ui = 0;
    if (!S.next(0, cur)) return;
    f32x4 acc[2][2][4][2];
#pragma unroll
    for (int a = 0; a < 2; ++a)
#pragma unroll
        for (int b = 0; b < 2; ++b)
#pragma unroll
            for (int m = 0; m < 4; ++m)
#pragma unroll
                for (int n = 0; n < 2; ++n) acc[a][b][m][n] = (f32x4){0.f, 0.f, 0.f, 0.f};
    f16x8 At[4][2], B0[2][2], B1[2][2];
    const char* cA = (const char*)g.A + (size_t)cur.pm * tstepA + (size_t)cur.pn * kofA; const char* cB = (const char*)g.Bt + (size_t)cur.pn * tstep;
    PG8_STAGE(PG8_SB(0, 0), cB, voffB); PG8_STAGE(PG8_SB(0, 1), cB + hstep, voffB); PG8_STAGE(PG8_SA(0, 0), cA, voffA); PG8_STAGE(PG8_SA(0, 1), cA + hstepA, voffA);
    if (wr == 1) PG8_BAR;
    PG8_WAIT_V(2); PG8_BAR;
    PG8_STAGE(PG8_SB(1, 0), cB + kstep, voffB); PG8_STAGE(PG8_SA(1, 0), cA + kstep, voffA); PG8_STAGE(PG8_SB(1, 1), cB + hstep + kstep, voffB);
    PG8_WAIT_V(6); PG8_BAR;
    for (;;) {
        const bool has_next = S.next(ui + 1, nxt);
        const char* nA = has_next ? (const char*)g.A + (size_t)nxt.pm * tstepA + (size_t)nxt.pn * kofA : cA; const char* nB = has_next ? (const char*)g.Bt + (size_t)nxt.pn * tstep : cB;
        for (int t = 0; t < nt; t += 2) {
            const bool last = (t == nt - 2);
            const char* a1 = cA + (size_t)(t + 1) * kstep;
            const char* a2 = last ? nA : cA + (size_t)(t + 2) * kstep; const char* b2 = last ? nB : cB + (size_t)(t + 2) * kstep;
            const char* a3 = a2 + kstep; const char* b3 = b2 + kstep;
            PG8_LDB(B0, 0, 0); PG8_LDB(B1, 0, 1); PG8_SCHED; PG8_LDA(At, 0, 0); PG8_STAGE(PG8_SA(1, 1), a1 + hstepA, voffA);
            PG8_WAIT_V(8); PG8_WAIT_L(0); PG8_BAR; PG8_MMA(0, 0, At, B0); PG8_MMA(0, 1, At, B1); PG8_BAR; PG8_SCHED;
            PG8_LDA(At, 0, 1); PG8_STAGE(PG8_SB(0, 0), b2, voffB); PG8_STAGE(PG8_SB(0, 1), b2 + hstep, voffB); PG8_STAGE(PG8_SA(0, 0), a2, voffA);
            PG8_WAIT_V(8); PG8_WAIT_L(0); PG8_BAR; PG8_MMA(1, 0, At, B0); PG8_MMA(1, 1, At, B1); PG8_BAR; PG8_SCHED;
            PG8_LDB(B0, 1, 0); PG8_LDB(B1, 1, 1); PG8_SCHED; PG8_LDA(At, 1, 0); PG8_STAGE(PG8_SA(0, 1), a2 + hstepA, voffA);
            PG8_WAIT_V(8); PG8_WAIT_L(0); PG8_BAR; PG8_MMA(0, 0, At, B0); PG8_MMA(0, 1, At, B1); PG8_BAR; PG8_SCHED;
            PG8_LDA(At, 1, 1); PG8_STAGE(PG8_SB(1, 0), b3, voffB); PG8_STAGE(PG8_SB(1, 1), b3 + hstep, voffB); PG8_STAGE(PG8_SA(1, 0), a3, voffA);
            PG8_WAIT_V(8); PG8_WAIT_L(0); PG8_BAR; PG8_MMA(1, 0, At, B0); PG8_MMA(1, 1, At, B1); PG8_BAR; PG8_SCHED;
        }
        if constexpr (ALIGN_EPI) { if (wr == 0) PG8_BAR; }
        { int l2 = lane; asm volatile("" : "+v"(l2)); E(acc, cur, wr, wc, l2 & 15, l2 >> 4); }
        if (!has_next) break;
#pragma unroll
        for (int a = 0; a < 2; ++a)
#pragma unroll
            for (int b = 0; b < 2; ++b)
#pragma unroll
                for (int m = 0; m < 4; ++m)
#pragma unroll
                    for (int n = 0; n < 2; ++n) acc[a][b][m][n] = (f32x4){0.f, 0.f, 0.f, 0.f};
        cur = nxt; cA = nA; cB = nB; ++ui;
        if constexpr (ALIGN_EPI) { if (wr == 1) PG8_BAR; }
    }
    PG8_WAIT_V(0);
    if constexpr (!ALIGN_EPI) { if (wr == 0) PG8_BAR; }
    PG8_BAR;
#undef PG8_SA
#undef PG8_SB
#undef PG8_STAGE
#undef PG8_LDA
#undef PG8_LDB
#undef PG8_MMA
#undef PG8_WAIT_V
#undef PG8_WAIT_L
#undef PG8_BAR
#undef PG8_SCHED
}
struct EpiF32 {
    static constexpr bool PERM = false;
    float* C; int ldc;
    __device__ __forceinline__ void operator()(const f32x4 (&acc)[2][2][4][2], const Unit& u, int wr, int wc, int fr, int fq) const {
        const int row0 = u.pm * BM + wr * 64 + fr, col0 = u.pn * BM + wc * 32 + 4 * fq;
#pragma unroll
        for (int ai = 0; ai < 2; ++ai)
#pragma unroll
            for (int m = 0; m < 4; ++m) { float* rowp = C + (size_t)(row0 + ai * HALF + m * 16) * ldc + col0;
#pragma unroll
                for (int bj = 0; bj < 2; ++bj)
#pragma unroll
                    for (int n = 0; n < 2; ++n) *(f32x4*)(rowp + bj * HALF + n * 16) = acc[ai][bj][m][n]; }
    }
};
struct EpiSwiGLU {
    static constexpr bool PERM = true;
    h16* O;
    __device__ __forceinline__ void operator()(const f32x4 (&acc)[2][2][4][2], const Unit& u, int wr, int wc, int fr, int fq) const {
        const int row0 = u.pm * BM + wr * 64 + fr, col0 = u.pn * HALF + wc * 32 + 8 * fq;
#pragma unroll
        for (int ai = 0; ai < 2; ++ai)
#pragma unroll
            for (int m = 0; m < 4; ++m) { h16* rowp = O + (size_t)(row0 + ai * HALF + m * 16) * FF + col0;
                float v[8];
#pragma unroll
                for (int n = 0; n < 2; ++n)
#pragma unroll
                    for (int e = 0; e < 4; ++e) { const float gg = acc[ai][0][m][n][e], uu = acc[ai][1][m][n][e]; v[n * 4 + e] = gg * __builtin_amdgcn_rcpf(1.f + __builtin_amdgcn_exp2f(-gg * LOG2E)) * uu; }
                u32x4 w; w.x = pk_h2(v[0], v[1]); w.y = pk_h2(v[2], v[3]); w.z = pk_h2(v[4], v[5]); w.w = pk_h2(v[6], v[7]);
                *(u32x4*)rowp = w; }
    }
};

struct EpiIn {
    static constexpr bool PERM = false;
    h16 *ckv, *cq, *kr, *ki, *qb, *kb, *vT; float *wi, *ssq; const float* gckv; const float2* tab; LAS float* X;
    __device__ __forceinline__ void rope64(const f32x4 (&acc)[2][2][4][2], const Unit& u, int wr, int wc, int fr, int fq, h16* dst, int tl, float scale) const {
        const int tok0 = u.pm * BM + wr * 64 + fr;
        f32x4 tc[4], tn[4];
        { const f32x4* tp = (const f32x4*)(tab + (size_t)tok0 * 48 + 4 * fq); tc[0] = tp[0]; tc[1] = tp[1]; tc[2] = tp[8]; tc[3] = tp[9]; }
#pragma unroll
        for (int rr = 0; rr < 8; ++rr) { const int ai = rr >> 2, m = rr & 3, tok = tok0 + ai * HALF + m * 16;
            if (rr < 7) { const int tokn = tok0 + ((rr + 1) >> 2) * HALF + ((rr + 1) & 3) * 16; const f32x4* tp = (const f32x4*)(tab + (size_t)tokn * 48 + 4 * fq); tn[0] = tp[0]; tn[1] = tp[1]; tn[2] = tp[8]; tn[3] = tp[9]; }
#pragma unroll
            for (int n = 0; n < 2; ++n) { const int i = 16 * n + 4 * fq; const f32x4 t0 = tc[2 * n], t1 = tc[2 * n + 1];
                const f32x4 cs = {t0.x, t0.z, t1.x, t1.z}, sn = {t0.y, t0.w, t1.y, t1.w}, x1 = acc[ai][0][m][n], x2 = acc[ai][1][m][n];
                const f32x4 o1 = (x1 * cs - x2 * sn) * scale, o2 = (x2 * cs + x1 * sn) * scale;
                h16* p = dst + (size_t)tok * 768 + (4 * tl + wc) * 64 + i;
                u32x2 w1, w2; w1.x = pk_h2(o1.x, o1.y); w1.y = pk_h2(o1.z, o1.w); w2.x = pk_h2(o2.x, o2.y); w2.y = pk_h2(o2.z, o2.w);
                *(u32x2*)p = w1; *(u32x2*)(p + 32) = w2; }
#pragma unroll
            for (int k = 0; k < 4; ++k) tc[k] = tn[k];
            asm volatile("" ::: "memory"); }
    }
    __device__ __forceinline__ void operator()(const f32x4 (&acc)[2][2][4][2], const Unit& u, int wr, int wc, int fr, int fq) const {
        const int pn = u.pn;
        if (pn == 0) {
#pragma unroll
            for (int ai = 0; ai < 2; ++ai)
#pragma unroll
                for (int m = 0; m < 4; ++m) { float sq = 0.f;
#pragma unroll
                    for (int bj = 0; bj < 2; ++bj)
#pragma unroll
                        for (int n = 0; n < 2; ++n) { const f32x4 v = acc[ai][bj][m][n]; sq += (v.x * v.x + v.y * v.y) + (v.z * v.z + v.w * v.w); }
                    sq += __shfl_xor(sq, 16); sq += __shfl_xor(sq, 32);
                    if (fq == 0) X[(ai * HALF + wr * 64 + m * 16 + fr) * 4 + wc] = sq; }
            asm volatile("s_waitcnt lgkmcnt(0)" ::: "memory"); __builtin_amdgcn_s_barrier(); asm volatile("" ::: "memory");
#pragma unroll
            for (int ai = 0; ai < 2; ++ai)
#pragma unroll
                for (int m = 0; m < 4; ++m) { const int rl = ai * HALF + wr * 64 + m * 16 + fr, tok = u.pm * BM + rl; const f32x4 p = *(const LAS f32x4*)(X + rl * 4);
                    const float rstd = rsqrtf(((p.x + p.y) + (p.z + p.w)) * (1.f / KVL) + EPS);
#pragma unroll
                    for (int bj = 0; bj < 2; ++bj)
#pragma unroll
                        for (int n = 0; n < 2; ++n) { const int col = bj * HALF + wc * 32 + n * 16 + 4 * fq; const f32x4 o = acc[ai][bj][m][n] * rstd * *(const f32x4*)(gckv + col);
                            int w8 = __builtin_amdgcn_cvt_pk_fp8_f32(o.x, o.y, 0, false); w8 = __builtin_amdgcn_cvt_pk_fp8_f32(o.z, o.w, w8, true);
                            *(int*)((unsigned char*)ckv + (size_t)tok * KVL + col) = w8; }
                    asm volatile("" ::: "memory"); }
            asm volatile("s_waitcnt lgkmcnt(0)" ::: "memory"); __builtin_amdgcn_s_barrier(); asm volatile("" ::: "memory");
        } else if (pn <= 2) {
#pragma unroll
            for (int ai = 0; ai < 2; ++ai)
#pragma unroll
                for (int m = 0; m < 4; ++m) { const int tok = u.pm * BM + ai * HALF + wr * 64 + m * 16 + fr; float sq = 0.f;
#pragma unroll
                    for (int bj = 0; bj < 2; ++bj) { if (pn == 2 && bj == 1) break;
#pragma unroll
                        for (int n = 0; n < 2; ++n) { const f32x4 v = acc[ai][bj][m][n]; sq += (v.x * v.x + v.y * v.y) + (v.z * v.z + v.w * v.w);
                            const int col = (pn - 1) * 256 + bj * HALF + wc * 32 + n * 16 + 4 * fq; u32x2 w; w.x = pk_h2(v.x, v.y); w.y = pk_h2(v.z, v.w); *(u32x2*)(cq + (size_t)tok * QL + col) = w; } }
                    sq += __shfl_xor(sq, 16); sq += __shfl_xor(sq, 32);
                    if (fq == 0) ssq[tok * 8 + (pn - 1) * 4 + wc] = sq;
                    if (pn == 2) {
                        if (wc < 2) { const int i = 4 * fq; const f32x4* tp = (const f32x4*)(tab + (size_t)tok * 48 + 32 + i); const f32x4 t0 = tp[0], t1 = tp[1];
                            const f32x4 cs = {t0.x, t0.z, t1.x, t1.z}, sn = {t0.y, t0.w, t1.y, t1.w}, x1 = acc[ai][1][m][0], x2 = acc[ai][1][m][1];
                            const f32x4 o1 = x1 * cs - x2 * sn, o2 = x2 * cs + x1 * sn;
                            if (wc == 0) { unsigned char* p8 = (unsigned char*)kr + (size_t)tok * 32 + i;
                                int a8 = __builtin_amdgcn_cvt_pk_fp8_f32(o1.x, o1.y, 0, false); a8 = __builtin_amdgcn_cvt_pk_fp8_f32(o1.z, o1.w, a8, true);
                                int b8 = __builtin_amdgcn_cvt_pk_fp8_f32(o2.x, o2.y, 0, false); b8 = __builtin_amdgcn_cvt_pk_fp8_f32(o2.z, o2.w, b8, true);
                                *(int*)p8 = a8; *(int*)(p8 + 16) = b8; }
                            else { h16* p = ki + (size_t)tok * 32 + i;
                                u32x2 w1, w2; w1.x = pk_h2(o1.x, o1.y); w1.y = pk_h2(o1.z, o1.w); w2.x = pk_h2(o2.x, o2.y); w2.y = pk_h2(o2.z, o2.w);
                                *(u32x2*)p = w1; *(u32x2*)(p + 16) = w2; } }
                        else if (wc == 2 && fq < 2) { *(f32x4*)(wi + tok * 8 + 4 * fq) = acc[ai][1][m][0] * 0.35355339059327373f; }
                    }
                    asm volatile("" ::: "memory"); }
        } else if (pn <= 5) rope64(acc, u, wr, wc, fr, fq, qb, pn - 3, 0.125f * LOG2E);
        else if (pn <= 8) rope64(acc, u, wr, wc, fr, fq, kb, pn - 6, 1.0f);
        else {
#pragma unroll
            for (int ai = 0; ai < 2; ++ai)
#pragma unroll
                for (int m = 0; m < 4; ++m) { const int tok = u.pm * BM + ai * HALF + wr * 64 + m * 16 + fr;
#pragma unroll
                    for (int bj = 0; bj < 2; ++bj)
#pragma unroll
                        for (int n = 0; n < 2; ++n) { const f32x4 v = acc[ai][bj][m][n]; u32x2 w; w.x = pk_h2(v.x, v.y); w.y = pk_h2(v.z, v.w);
                            *(u32x2*)(vT + (size_t)tok * 768 + (pn - 9) * 256 + bj * HALF + wc * 32 + n * 16 + 4 * fq) = w; }
                    asm volatile("" ::: "memory"); }
        }
    }
};
struct Epi4 {
    static constexpr bool PERM = true;
    h16 *qlat, *qr, *qi; const float* rstdq; const float2* tab;
    __device__ __forceinline__ void operator()(const f32x4 (&acc)[2][2][4][2], const Unit& u, int wr, int wc, int fr, int fq) const {
        const int pn = u.pn; const float c2 = 0.10206207261596575f * LOG2E;
        const int tok0 = u.pm * BM + wr * 64 + fr;
        float rc = rstdq[tok0], rn = 0.f;
        if (pn < 8) {
#pragma unroll
            for (int rr = 0; rr < 8; ++rr) { const int ai = rr >> 2, m = rr & 3, tok = tok0 + ai * HALF + m * 16;
                if (rr < 7) rn = rstdq[tok0 + ((rr + 1) >> 2) * HALF + ((rr + 1) & 3) * 16];
#pragma unroll
                for (int bj = 0; bj < 2; ++bj) { const f32x4 o0 = acc[ai][bj][m][0] * (rc * c2), o1 = acc[ai][bj][m][1] * (rc * c2);
                    u32x4 w; w.x = pk_h2(o0.x, o0.y); w.y = pk_h2(o0.z, o0.w); w.z = pk_h2(o1.x, o1.y); w.w = pk_h2(o1.z, o1.w);
                    *(u32x4*)(qlat + (size_t)tok * 2048 + pn * 256 + bj * HALF + wc * 32 + 8 * fq) = w; }
                rc = rn; asm volatile("" ::: "memory"); }
        } else { h16* dst = (pn == 8) ? qr : qi; const float c2e = (pn == 8) ? c2 : 1.f; const int i = 4 * fq;
            f32x4 tc[2], tn[2];
            { const f32x4* tp = (const f32x4*)(tab + (size_t)tok0 * 48 + 32 + i); tc[0] = tp[0]; tc[1] = tp[1]; }
#pragma unroll
            for (int rr = 0; rr < 8; ++rr) { const int ai = rr >> 2, m = rr & 3, tok = tok0 + ai * HALF + m * 16;
                if (rr < 7) { const int tokn = tok0 + ((rr + 1) >> 2) * HALF + ((rr + 1) & 3) * 16; const f32x4* tp = (const f32x4*)(tab + (size_t)tokn * 48 + 32 + i); tn[0] = tp[0]; tn[1] = tp[1]; rn = rstdq[tokn]; }
                const f32x4 cs = {tc[0].x, tc[0].z, tc[1].x, tc[1].z}, sn = {tc[0].y, tc[0].w, tc[1].y, tc[1].w}; const float sc = rc * c2e;
#pragma unroll
                for (int bj = 0; bj < 2; ++bj) { const f32x4 x1 = acc[ai][bj][m][0], x2 = acc[ai][bj][m][1]; const f32x4 o1 = (x1 * cs - x2 * sn) * sc, o2 = (x2 * cs + x1 * sn) * sc;
                    h16* p = dst + (size_t)tok * 256 + (4 * bj + wc) * 32 + i;
                    u32x2 w1, w2; w1.x = pk_h2(o1.x, o1.y); w1.y = pk_h2(o1.z, o1.w); w2.x = pk_h2(o2.x, o2.y); w2.y = pk_h2(o2.z, o2.w);
                    *(u32x2*)p = w1; *(u32x2*)(p + 16) = w2; }
                tc[0] = tn[0]; tc[1] = tn[1]; rc = rn;
                asm volatile("" ::: "memory"); } }
    }
};
__device__ __forceinline__ u32x4 ld16_l2(const h16* p) {
    const unsigned long long a = __hip_atomic_load((const unsigned long long*)p, __ATOMIC_RELAXED, __HIP_MEMORY_SCOPE_AGENT), b = __hip_atomic_load((const unsigned long long*)p + 1, __ATOMIC_RELAXED, __HIP_MEMORY_SCOPE_AGENT);
    return (u32x4){(unsigned)a, (unsigned)(a >> 32), (unsigned)b, (unsigned)(b >> 32)};
}
typedef _Float16 h16x8 __attribute__((ext_vector_type(8)));
__device__ __forceinline__ void unpk8(const u32x4 w, float (&f)[8]) {
    const h16x8 h = __builtin_bit_cast(h16x8, w);
#pragma unroll
    for (int i = 0; i < 8; ++i) f[i] = (float)h[i];
}
struct EpiH16 {
    static constexpr bool PERM = true;
    h16* O; int ldc = DM;
    __device__ __forceinline__ void operator()(const f32x4 (&acc)[2][2][4][2], const Unit& u, int wr, int wc, int fr, int fq) const {
        const int row0 = u.pm * BM + wr * 64 + fr, col0 = u.pn * BM + wc * 32 + 8 * fq;
#pragma unroll
        for (int ai = 0; ai < 2; ++ai)
#pragma unroll
            for (int m = 0; m < 4; ++m)
#pragma unroll
                for (int bj = 0; bj < 2; ++bj) { const f32x4 v0 = acc[ai][bj][m][0], v1 = acc[ai][bj][m][1];
                    u32x4 w; w.x = pk_h2(v0.x, v0.y); w.y = pk_h2(v0.z, v0.w); w.z = pk_h2(v1.x, v1.y); w.w = pk_h2(v1.z, v1.w);
                    *(u32x4*)(O + (size_t)(row0 + ai * HALF + m * 16) * ldc + col0 + bj * HALF) = w; }
    }
};
struct EpiGate {
    static constexpr bool PERM = true;
    const h16* Y; h16* Z; int accum;
    __device__ __forceinline__ void operator()(const f32x4 (&acc)[2][2][4][2], const Unit& u, int wr, int wc, int fr, int fq) const {
        const int row0 = u.pm * BM + wr * 64 + fr, col0 = u.pn * BM + wc * 32 + 8 * fq;
#pragma unroll
        for (int ai = 0; ai < 2; ++ai)
#pragma unroll
            for (int m = 0; m < 4; ++m)
#pragma unroll
                for (int bj = 0; bj < 2; ++bj) { const size_t off = (size_t)(row0 + ai * HALF + m * 16) * DM + col0 + bj * HALF;
                    float y[8], zz[8]; unpk8(ld16_l2(Y + off), y);
                    if (accum) unpk8(ld16_l2(Z + off), zz); else {
#pragma unroll
                        for (int i = 0; i < 8; ++i) zz[i] = 0.f; }
                    float o[8];
#pragma unroll
                    for (int n = 0; n < 2; ++n)
#pragma unroll
                        for (int e = 0; e < 4; ++e) { const float gg = acc[ai][bj][m][n][e]; o[n * 4 + e] = zz[n * 4 + e] + y[n * 4 + e] * __builtin_amdgcn_rcpf(1.f + __builtin_amdgcn_exp2f(-gg * LOG2E)); }
                    u32x4 w; w.x = pk_h2(o[0], o[1]); w.y = pk_h2(o[2], o[3]); w.z = pk_h2(o[4], o[5]); w.w = pk_h2(o[6], o[7]);
                    *(u32x4*)(Z + off) = w; }
    }
};
}

#define XB_TMO      128
#define XB_XCNT(j)  (256  + 64 * (j))
#define XB_XSUB(j)  (1280 + 64 * (j))
#define XB_XGEN(j)  (2304 + 64 * (j))
#define XB_TOP      3328
#define XB_TOPGEN   3392
#define XCD_BAR_WORDS 3456
#define XB_SPIN_CAP (1u << 18)
__device__ __forceinline__ unsigned xb_ld(unsigned* p)              { return __hip_atomic_load(p, __ATOMIC_RELAXED, __HIP_MEMORY_SCOPE_AGENT); }
__device__ __forceinline__ unsigned xb_add(unsigned* p, unsigned v) { return __hip_atomic_fetch_add(p, v, __ATOMIC_RELAXED, __HIP_MEMORY_SCOPE_AGENT); }
__device__ __forceinline__ unsigned xb_xcc_id() { return (unsigned)__builtin_amdgcn_s_getreg((3 << 11) | 20) & 0xFu; }
#define XB_SPIN(cond, bar) do { unsigned _sp = 0; while (cond) { __builtin_amdgcn_s_sleep(1); \
    if ((++_sp & 255u) == 0u) { if (xb_ld(&(bar)[XB_TMO])) break; if (_sp > XB_SPIN_CAP) { atomicAdd(&(bar)[XB_TMO], 1u); break; } } } } while (0)
struct XcdBarrier { unsigned* bar; unsigned x; volatile LAS unsigned* st; };
__device__ __forceinline__ XcdBarrier xcd_barrier_post(unsigned* bar, volatile LAS unsigned* st) {
    XcdBarrier b; b.bar = bar; b.x = xb_xcc_id(); b.st = st;
    if (threadIdx.x == 0) (void)xb_add(&bar[XB_XCNT(b.x)], 1u);
    return b;
}
__device__ __forceinline__ void xcd_barrier_complete(unsigned* bar, unsigned x, unsigned& nloc, unsigned& nx) {
    const unsigned G = gridDim.x * gridDim.y * gridDim.z;
    unsigned sum, cnt, mine, sp = 0u;
    for (;;) {
        sum = 0u; cnt = 0u; mine = 0u;
#pragma unroll
        for (unsigned j = 0; j < 16; ++j) { const unsigned c = xb_ld(&bar[XB_XCNT(j)]); sum += c; cnt += (c > 0u) ? 1u : 0u; mine = (j == x) ? c : mine; }
        if (sum == G) break;
        __builtin_amdgcn_s_sleep(1);
        if ((++sp & 255u) == 0u) { if (xb_ld(&bar[XB_TMO])) break; if (sp > XB_SPIN_CAP) { atomicAdd(&bar[XB_TMO], 1u); break; } }
    }
    nloc = mine > 0u ? mine : 1u; nx = cnt > 0u ? cnt : 1u;
}
__device__ __forceinline__ void xcd_barrier(const XcdBarrier& b) {
    asm volatile("s_waitcnt vmcnt(0)" ::: "memory");
    __syncthreads();
    if (threadIdx.x == 0) {
        unsigned* bar = b.bar;
        __builtin_amdgcn_s_waitcnt(0);
        unsigned nloc = b.st[0], nx = b.st[1];
        if (nloc == 0u) { xcd_barrier_complete(bar, b.x, nloc, nx); b.st[0] = nloc; b.st[1] = nx; }
        const unsigned old = xb_add(&bar[XB_XSUB(b.x)], 1u);
        const unsigned gen = old / nloc;
        if (old + 1u == (gen + 1u) * nloc) {
            __builtin_amdgcn_fence(__ATOMIC_RELEASE, "agent");
            asm volatile("s_waitcnt vmcnt(0)" ::: "memory");
            const unsigned og = xb_add(&bar[XB_TOP], 1u);
            const unsigned tg = og / nx;
            if (og + 1u == (tg + 1u) * nx) xb_add(&bar[XB_TOPGEN], 1u);
            else XB_SPIN(xb_ld(&bar[XB_TOPGEN]) == tg, bar);
            __builtin_amdgcn_fence(__ATOMIC_ACQUIRE, "agent");
            xb_add(&bar[XB_XGEN(b.x)], 1u);
            asm volatile("s_waitcnt vmcnt(0)" ::: "memory");
        } else {
            XB_SPIN(xb_ld(&bar[XB_XGEN(b.x)]) == gen, bar);
            __builtin_amdgcn_fence(__ATOMIC_ACQUIRE, "agent");
            asm volatile("s_waitcnt vmcnt(0)" ::: "memory");
        }
    }
    __syncthreads();
}

constexpr int NWAVES = 8, NTHR = 512;
constexpr int RING_BYTES = 131072, LDSCTL_OFF = RING_BYTES, MISC_OFF = LDSCTL_OFF + 320, LDS_BYTES = 147456;
constexpr int XCH_OFF = RING_BYTES + 1024;
constexpr int CW_BAR = 4096;
constexpr size_t OW_GU1 = OFF_W, OW_D1 = OW_GU1 + 11 * MiB, OW_IN = OW_D1 + (size_t)DM * FF * 2, OW_GATE = OW_IN + 6 * MiB, OW_4 = OW_GATE + 4 * MiB, OW_OV = OW_4 + 2 * MiB,
                 OW_UPB = OW_OV + 4 * MiB, OW_O = OW_UPB + MiB / 2, OW_GU2 = OW_O + 2 * MiB, OW_D2 = OW_GU2 + 11 * MiB, OW_END = OW_D2 + (size_t)DM * FF * 2;
static_assert(OW_END <= OFF_H, "weights region");
constexpr int NIN3 = 3072, N4 = 2560;
constexpr size_t OW_BD = OW_OV, OW_UPA = OW_OV + MiB, OFF_OA = OFF_A + 64 * MiB;

struct Args { const float* in[27]; float* out; unsigned char* ws; int ph_lo, ph_hi, zparts, pad; };
struct Frame {
    LAS unsigned char* lds; int tid, lane, wave, G, gw, NGW;
};
__device__ __forceinline__ float wave_sum(float v) {
#pragma unroll
    for (int o = 1; o < 64; o <<= 1) v += __shfl_xor(v, o);
    return v;
}
__device__ __forceinline__ bool map_row(int job, int n, const Args& a, const float*& W, int& ldw, int& col) {
    if (job <= 1) { const int t = n >> 8, j = n & 255; W = a.in[(job == 0 ? 6 : 23) + (j >> 7)]; ldw = FF; col = t * 128 + (j & 127); return true; }
    if (job == 2) { W = a.in[11]; ldw = DIN; const int t = n >> 8, j = n & 255;
        if (t == 0) { col = C_CKV + j; return true; }
        if (t == 1) { col = j; return true; }
        if (t == 2) { if (j < 128) { col = 256 + j; return true; } if (j < 160) { col = C_KR + (j - 128); return true; } if (j < 192) { col = C_KI + (j - 160); return true; } if (j < 200) { col = C_WI + (j - 192); return true; } col = 0; return false; }
        if (t < 9) { const int c3 = (t - 3) / 3, tl = (t - 3) % 3, hl = (j & 127) >> 5, i = j & 31; col = C_QKV + c3 * 768 + (4 * tl + hl) * 64 + (j >> 7) * 32 + i; return true; }
        col = C_QKV + 1536 + (t - 9) * 256 + j; return true; }
    { const int n2 = n - 2048, r5 = n2 & 31, nat = 16 * ((r5 >> 2) & 1) + 4 * (r5 >> 3) + (r5 & 3);
      if (n2 < 256) { W = a.in[14]; ldw = 768; col = (n2 >> 5) * 96 + 64 + nat; } else { W = a.in[17]; ldw = 256; col = ((n2 - 256) & ~31) + nat; } return true; }
}
__device__ __forceinline__ void tr_item(const float* W, int ldw, int col, bool valid, const float* scale, int k0, h16* WTrow0, int K, LAS float* scr, int lane) {
#pragma unroll 8
    for (int i = 0; i < 32; ++i) { const int kk = 2 * i + (lane >> 5); float v = valid ? W[(size_t)(k0 + kk) * ldw + col] : 0.f; if (scale) v *= scale[k0 + kk]; scr[kk * 33 + (lane & 31)] = v; }
    asm volatile("s_waitcnt lgkmcnt(0)" ::: "memory");
    const int c = lane & 7;
#pragma unroll
    for (int j = 0; j < 4; ++j) { const int n = (lane >> 3) + 8 * j; const LAS float* s = scr + (8 * c) * 33 + n;
        u32x4 o; o.x = pk_h2(s[0 * 33], s[1 * 33]); o.y = pk_h2(s[2 * 33], s[3 * 33]); o.z = pk_h2(s[4 * 33], s[5 * 33]); o.w = pk_h2(s[6 * 33], s[7 * 33]);
        *(u32x4*)(WTrow0 + (size_t)n * K + k0 + 8 * c) = o; }
    asm volatile("s_waitcnt lgkmcnt(0)" ::: "memory");
}
__device__ __forceinline__ void tr_job_mapped(const Frame& F, const Args& a, int job, int Ndest, int n_lo, int K, h16* WT, const float* scale, LAS float* scr, int phase_off) {
    const int nblk = Ndest / 32, nitems = (K / 64) * nblk;
    for (int it = (F.gw + phase_off) % F.NGW; it < nitems; it += F.NGW) {
        const int kb = it / nblk, nb = it % nblk; const float* W; int ldw, col;
        const bool valid = map_row(job, n_lo + nb * 32 + (F.lane & 31), a, W, ldw, col);
        tr_item(W, ldw, col, valid, scale, kb * 64, WT + (size_t)(n_lo + nb * 32) * K, K, scr, F.lane);
    }
}
__device__ __forceinline__ void tr_job_plain(const Frame& F, const float* W, int ldw, int Ndest, int K, h16* WT, LAS float* scr, int phase_off) {
    const int nblk = Ndest / 32, nitems = (K / 64) * nblk;
    for (int it = (F.gw + phase_off) % F.NGW; it < nitems; it += F.NGW) {
        const int kb = it / nblk, nb = it % nblk;
        tr_item(W, ldw, nb * 32 + (F.lane & 31), true, nullptr, kb * 64, WT + (size_t)(nb * 32) * K, K, scr, F.lane);
    }
}
__device__ __forceinline__ void row_load(const float* p, int lane, f32x4 (&v)[4]) {
#pragma unroll
    for (int j = 0; j < 4; ++j) v[j] = ((const f32x4*)p)[lane + 64 * j];
}
__device__ __forceinline__ float row_ssq(const f32x4 (&v)[4]) { float s = 0.f;
#pragma unroll
    for (int j = 0; j < 4; ++j) s += (v[j].x * v[j].x + v[j].y * v[j].y) + (v[j].z * v[j].z + v[j].w * v[j].w);
    return wave_sum(s); }
__device__ __forceinline__ void row_normmod_store(const f32x4 (&v)[4], float rstd, const float* g, const float* sc, const float* sh, h16* dst, int lane) {
#pragma unroll
    for (int j = 0; j < 4; ++j) { const int ci = lane + 64 * j; const f32x4 gg = ((const f32x4*)g)[ci], s1 = ((const f32x4*)sc)[ci], s0 = ((const f32x4*)sh)[ci];
        const f32x4 o = v[j] * rstd * gg * (s1 + 1.f) + s0;
        u32x2 w; w.x = pk_h2(o.x, o.y); w.y = pk_h2(o.z, o.w); ((u32x2*)dst)[ci] = w; }
}
__device__ __forceinline__ void ph_normmod(const Frame& F, const float* x, const float* g, const float* mod, int isc, int ish, h16* dst) {
    int m = F.gw; if (m >= MT) return;
    f32x4 v[4], vn[4]; row_load(x + (size_t)m * DM, F.lane, v);
    for (;;) { const int mn = m + F.NGW; const bool has = mn < MT; if (has) row_load(x + (size_t)mn * DM, F.lane, vn);
        const float rstd = rsqrtf(row_ssq(v) * (1.f / DM) + EPS); const float* mb = mod + (m / SEQ) * (NMOD * DM);
        row_normmod_store(v, rstd, g, mb + isc * DM, mb + ish * DM, dst + (size_t)m * DM, F.lane);
        if (!has) break;
#pragma unroll
        for (int j = 0; j < 4; ++j) v[j] = vn[j];
        m = mn; }
}
__device__ __forceinline__ void row_load_h(const h16* p, int lane, u32x2 (&v)[4]) {
#pragma unroll
    for (int j = 0; j < 4; ++j) v[j] = ((const u32x2*)p)[lane + 64 * j];
}
typedef _Float16 h16x4 __attribute__((ext_vector_type(4)));
__device__ __forceinline__ f32x4 h4_to_f4(u32x2 w) { const h16x4 h = __builtin_bit_cast(h16x4, w); return (f32x4){(float)h[0], (float)h[1], (float)h[2], (float)h[3]}; }
template <bool XI16, bool XO16>
__device__ __forceinline__ void ph_resnorm(const Frame& F, const void* xin_, const h16* f, const float* gpost, const float* mod, int igt, float coef, void* xout_,
                                           bool second, const float* gpre, int isc, int ish, h16* dst) {
    int m = F.gw; if (m >= MT) return;
    u32x2 fh[4], fn[4]; f32x4 xi[4], xn[4]; u32x2 xh[4], xhn[4];
    row_load_h(f + (size_t)m * DM, F.lane, fh);
    if constexpr (XI16) row_load_h((const h16*)xin_ + (size_t)m * DM, F.lane, xh); else row_load((const float*)xin_ + (size_t)m * DM, F.lane, xi);
    for (;;) {
        const int mn = m + F.NGW; const bool has = mn < MT;
        if (has) { row_load_h(f + (size_t)mn * DM, F.lane, fn);
            if constexpr (XI16) row_load_h((const h16*)xin_ + (size_t)mn * DM, F.lane, xhn); else row_load((const float*)xin_ + (size_t)mn * DM, F.lane, xn); }
        f32x4 v[4];
#pragma unroll
        for (int j = 0; j < 4; ++j) { v[j] = h4_to_f4(fh[j]); if constexpr (XI16) xi[j] = h4_to_f4(xh[j]); }
        const float rstd = rsqrtf(row_ssq(v) * (1.f / DM) + EPS) * coef; const float* mb = mod + (m / SEQ) * (NMOD * DM);
#pragma unroll
        for (int j = 0; j < 4; ++j) { const int ci = F.lane + 64 * j; const f32x4 gg = ((const f32x4*)gpost)[ci], gt = ((const f32x4*)(mb + igt * DM))[ci];
            xi[j] = xi[j] + gt * v[j] * rstd * gg;
            if constexpr (XO16) { u32x2 w; w.x = pk_h2(xi[j].x, xi[j].y); w.y = pk_h2(xi[j].z, xi[j].w); ((u32x2*)((h16*)xout_ + (size_t)m * DM))[ci] = w; }
            else ((f32x4*)((float*)xout_ + (size_t)m * DM))[ci] = xi[j]; }
        if (second) { const float r2 = rsqrtf(row_ssq(xi) * (1.f / DM) + EPS); row_normmod_store(xi, r2, gpre, mb + isc * DM, mb + ish * DM, dst + (size_t)m * DM, F.lane); }
        if (!has) break;
#pragma unroll
        for (int j = 0; j < 4; ++j) { fh[j] = fn[j]; if constexpr (XI16) xh[j] = xhn[j]; else xi[j] = xn[j]; }
        m = mn;
    }
}

__device__ __forceinline__ float wg_sum512(float v, LAS float* red) {
#pragma unroll
    for (int o = 32; o > 0; o >>= 1) v += __shfl_xor(v, o);
    __syncthreads();
    if ((threadIdx.x & 63) == 0) red[threadIdx.x >> 6] = v;
    __syncthreads();
    float s = 0.f;
#pragma unroll
    for (int w = 0; w < 8; ++w) s += red[w];
    return s;
}
__device__ __forceinline__ float wg_max512(float v, LAS float* red) {
#pragma unroll
    for (int o = 32; o > 0; o >>= 1) v = fmaxf(v, __shfl_xor(v, o));
    __syncthreads();
    if ((threadIdx.x & 63) == 0) red[threadIdx.x >> 6] = v;
    __syncthreads();
    float s = red[0];
#pragma unroll
    for (int w = 1; w < 8; ++w) s = fmaxf(s, red[w]);
    return s;
}
__device__ __forceinline__ void ph_dilated_simple(const Frame& F, const h16* qb, const h16* kb, const h16* vb, h16* og, float* lse2) {
    LAS float* p = (LAS float*)(F.lds + F.wave * 2048);
    LAS int* kix = (LAS int*)(F.lds + F.wave * 2048 + 1024);
    for (int it = F.gw; it < MT * 12; it += F.NGW) {
        const int tok = it / 12, gh = it % 12, g = gh >> 2, b = tok / SEQ, t = tok % SEQ, dil = dil_of(g), lane = F.lane;
        const h16* qp = qb + (size_t)tok * 768 + gh * 64;
        float sc[3]; float m = -INFINITY;
#pragma unroll
        for (int r = 0; r < 3; ++r) { const int k = lane + 64 * r; sc[r] = -INFINITY; const int ti = t - k * dil;
            if (k < 129) { kix[k] = ti;
                if (ti >= 0) { const h16* kp = kb + (size_t)(b * SEQ + ti) * 768 + gh * 64; float a = 0.f;
#pragma unroll 8
                    for (int d = 0; d < 64; ++d) a += (float)qp[d] * (float)kp[d];
                    sc[r] = a; } }
            m = fmaxf(m, sc[r]); }
#pragma unroll
        for (int o = 32; o > 0; o >>= 1) m = fmaxf(m, __shfl_xor(m, o));
        float l = 0.f;
#pragma unroll
        for (int r = 0; r < 3; ++r) { const int k = lane + 64 * r; if (k < 129) { const float e = (sc[r] == -INFINITY) ? 0.f : exp2f(sc[r] - m); p[k] = e; l += e; } }
#pragma unroll
        for (int o = 32; o > 0; o >>= 1) l += __shfl_xor(l, o);
        asm volatile("s_waitcnt lgkmcnt(0)" ::: "memory");
        float a = 0.f; const h16* vp = vb + (size_t)(b * SEQ) * 768 + gh * 64 + lane;
        for (int k = 0; k < 129; ++k) { const int ti = kix[k]; if (ti >= 0) a += p[k] * (float)vp[(size_t)ti * 768]; }
        og[(size_t)tok * 768 + gh * 64 + lane] = (h16)(a / l);
        if (lane == 0) lse2[tok * 12 + gh] = m + log2f(l);
        asm volatile("s_waitcnt lgkmcnt(0)" ::: "memory");
    }
}
__device__ __forceinline__ void ph_combine(const Frame& F, const h16* og, const float* lse2, h16* ob) {
    for (int idx = blockIdx.x * NTHR + F.tid; idx < MT * 256; idx += F.G * NTHR) {
        const int tok = idx >> 8, c = idx & 255, hh = c >> 6;
        const float l0 = lse2[tok * 12 + hh], l1 = lse2[tok * 12 + 4 + hh], l2 = lse2[tok * 12 + 8 + hh], m = fmaxf(l0, fmaxf(l1, l2));
        const float w0 = exp2f(l0 - m), w1 = exp2f(l1 - m), w2 = exp2f(l2 - m), inv = 1.f / (w0 + w1 + w2);
        ob[idx] = (h16)((w0 * (float)og[(size_t)tok * 768 + c] + w1 * (float)og[(size_t)tok * 768 + 256 + c] + w2 * (float)og[(size_t)tok * 768 + 512 + c]) * inv); }
}
__device__ __forceinline__ void ph_topk_simple(const Frame& F, const h16* qi, const h16* ki, const float* wi, unsigned short* sel) {
    LAS unsigned* key = (LAS unsigned*)(F.lds);
    LAS float* q = (LAS float*)(F.lds + 16384);
    LAS float* w = (LAS float*)(F.lds + 16384 + 1024);
    LAS unsigned* cnt = (LAS unsigned*)(F.lds + 16384 + 1024 + 64);
    const int tid = F.tid;
    for (int tok = blockIdx.x; tok < MT; tok += F.G) {
        const int b = tok / SEQ, t = tok % SEQ; unsigned short* so = sel + (size_t)tok * TOPK;
        if (t < TOPK) { if (tid < TOPK) so[tid] = (unsigned short)(tid <= t ? tid : 0); continue; }
        __syncthreads();
        if (tid < 256) q[tid] = (float)qi[(size_t)tok * 256 + tid]; if (tid < 8) w[tid] = wi[tok * 8 + tid];
        __syncthreads();
        const int n = t + 1;
#pragma unroll 1
        for (int s = tid; s < n; s += NTHR) {
            const h16* kp = ki + (size_t)(b * SEQ + s) * 32; float a[8];
#pragma unroll
            for (int hd = 0; hd < 8; ++hd) a[hd] = 0.f;
#pragma unroll 4
            for (int e = 0; e < 32; ++e) { const float kv = (float)kp[e];
#pragma unroll
                for (int hd = 0; hd < 8; ++hd) a[hd] += q[hd * 32 + e] * kv; }
            float sc = 0.f;
#pragma unroll
            for (int hd = 0; hd < 8; ++hd) sc += w[hd] * fmaxf(a[hd] * 0.17677669529663687f, 0.f);
            key[s] = fkey(sc);
        }
        __syncthreads();
        unsigned T = 0;
        for (int bit = 31; bit >= 0; --bit) {
            const unsigned cand = T | (1u << bit);
            if (tid == 0) *cnt = 0; __syncthreads();
            unsigned c = 0; for (int s = tid; s < n; s += NTHR) c += (key[s] >= cand) ? 1u : 0u;
#pragma unroll
            for (int o = 32; o > 0; o >>= 1) c += __shfl_xor(c, o);
            if ((tid & 63) == 0) atomicAdd((unsigned*)cnt, c);
            __syncthreads();
            if (*cnt >= TOPK) T = cand;
            __syncthreads();
        }
        if (tid == 0) *cnt = 0; __syncthreads();
        for (int s = tid; s < n; s += NTHR) if (key[s] > T) { const unsigned pp = atomicAdd((unsigned*)cnt, 1u); so[pp] = (unsigned short)s; }
        __syncthreads();
        if (tid == 0) { unsigned pp = *cnt; for (int s = 0; s < n && pp < TOPK; ++s) if (key[s] == T) so[pp++] = (unsigned short)s; }
    }
}
__device__ __forceinline__ void ph_sparse_simple(const Frame& F, h16* qlat, const h16* qr, const h16* ckv, const h16* kr, const unsigned short* sel) {
    LAS float* ql = (LAS float*)(F.lds);
    LAS float* qrr = (LAS float*)(F.lds + 8192);
    LAS float* p = (LAS float*)(F.lds + 8192 + 1024);
    LAS int* rows = (LAS int*)(F.lds + 8192 + 1024 + 8192);
    LAS float* red = (LAS float*)(F.lds + 8192 + 1024 + 8192 + 1024);
    LAS float* stat = red + 16;
    const int tid = F.tid, k = tid & 255, hh = tid >> 8;
    for (int tok = blockIdx.x; tok < MT; tok += F.G) {
        const int b = tok / SEQ, t = tok % SEQ, cnt = (t + 1 < TOPK) ? t + 1 : TOPK;
        __syncthreads();
        for (int i = tid; i < 2048; i += NTHR) ql[i] = (float)qlat[(size_t)tok * 2048 + i];
        if (tid < 256) { qrr[tid] = (float)qr[(size_t)tok * 256 + tid]; rows[tid] = b * SEQ + (tid < cnt ? (int)sel[(size_t)tok * TOPK + tid] : 0); }
        __syncthreads();
        const int row = rows[k];
        float s[4];
#pragma unroll
        for (int j = 0; j < 4; ++j) s[j] = 0.f;
        if (k < cnt) {
            const h16* kp = ckv + (size_t)row * 256;
            for (int r = 0; r < 256; ++r) { const float kvv = (float)kp[r];
#pragma unroll
                for (int j = 0; j < 4; ++j) s[j] += ql[(4 * hh + j) * 256 + r] * kvv; }
            const h16* rp = kr + (size_t)row * 32;
            for (int e = 0; e < 32; ++e) { const float kvv = (float)rp[e];
#pragma unroll
                for (int j = 0; j < 4; ++j) s[j] += qrr[(4 * hh + j) * 32 + e] * kvv; }
        } else {
#pragma unroll
            for (int j = 0; j < 4; ++j) s[j] = -INFINITY;
        }
#pragma unroll
        for (int hd = 0; hd < 8; ++hd) {
            const float mine = (hd >> 2) == hh ? s[hd & 3] : -INFINITY;
            const float m = wg_max512(mine, red);
            const float e = ((hd >> 2) == hh && k < cnt) ? exp2f(mine - m) : 0.f;
            if ((hd >> 2) == hh) p[hd * 256 + k] = e;
            const float l = wg_sum512(e, red);
            if (tid == 0) stat[hd] = 1.f / l;
        }
        __syncthreads();
        float o[4];
#pragma unroll
        for (int j = 0; j < 4; ++j) o[j] = 0.f;
        for (int kk = 0; kk < cnt; ++kk) { const float v = (float)ckv[(size_t)rows[kk] * 256 + k];
#pragma unroll
            for (int j = 0; j < 4; ++j) o[j] += p[(4 * hh + j) * 256 + kk] * v; }
#pragma unroll
        for (int j = 0; j < 4; ++j) qlat[(size_t)tok * 2048 + (4 * hh + j) * 256 + k] = (h16)(o[j] * stat[4 * hh + j]);
    }
}


typedef short v4i16_t __attribute__((ext_vector_type(4)));
typedef short s16x8 __attribute__((ext_vector_type(8)));
__device__ __forceinline__ void ph_sparse_mfma(const Frame& F, h16* qlat, const h16* qr, const h16* ckv, const h16* kr, const unsigned short* sel) {
    const int lane = F.lane, w = F.wave, c = lane & 15, kq = lane >> 4, hd = c & 7, G = F.G;
    LAS unsigned char* V = F.lds;
    LAS unsigned char* P = F.lds + XCH_OFF;
    LAS float* pmax = (LAS float*)(F.lds + XCH_OFF + 8448);
    LAS float* psum = pmax + 128;
    int tok = blockIdx.x; if (tok >= MT) return;
    int rowi[2]; f16x8 Kf[2][9], Qf[9];
#define SP_SEL(dst, tk) do { _Pragma("unroll") for (int tl = 0; tl < 2; ++tl) dst[tl] = ((tk) / SEQ) * SEQ + (int)sel[(size_t)(tk) * TOPK + 32 * w + 16 * tl + c]; } while (0)
#define SP_LOADK() do { _Pragma("unroll") for (int tl = 0; tl < 2; ++tl) { _Pragma("unroll") for (int s_ = 0; s_ < 8; ++s_) Kf[tl][s_] = *(const f16x8*)(ckv + (size_t)rowi[tl] * 256 + 32 * s_ + 8 * kq); \
        Kf[tl][8] = *(const f16x8*)(kr + (size_t)rowi[tl] * 32 + 8 * kq); } } while (0)
#define SP_LOADQ(tk) do { _Pragma("unroll") for (int s_ = 0; s_ < 8; ++s_) Qf[s_] = *(const f16x8*)(qlat + (size_t)(tk) * 2048 + hd * 256 + 32 * s_ + 8 * kq); Qf[8] = *(const f16x8*)(qr + (size_t)(tk) * 256 + hd * 32 + 8 * kq); } while (0)
    SP_SEL(rowi, tok); SP_LOADK(); SP_LOADQ(tok);
    const int vw0 = (32 * w + c) * 512, swz = c << 1;
    const int qp = c >> 2, pp = c & 3;
    int tro[2][2];
#pragma unroll
    for (int jj = 0; jj < 2; ++jj)
#pragma unroll
        for (int ft = 0; ft < 2; ++ft) { const int key = 8 * kq + 4 * jj + qp, ch = 4 * w + 2 * ft + (pp >> 1); tro[jj][ft] = key * 512 + ((ch ^ ((key & 15) << 1)) << 4) + (pp & 1) * 8; }
    for (;;) {
        const int t = tok % SEQ, cnt = (t + 1 < TOPK) ? t + 1 : TOPK, ntok = tok + G; const bool has_next = ntok < MT;
        int rown[2] = {0, 0}; if (has_next) SP_SEL(rown, ntok);
        f32x4 S[2];
#pragma unroll
        for (int tl = 0; tl < 2; ++tl) { S[tl] = (f32x4){0.f, 0.f, 0.f, 0.f};
#pragma unroll
            for (int s_ = 0; s_ < 9; ++s_) S[tl] = __builtin_amdgcn_mfma_f32_16x16x32_f16(Kf[tl][s_], Qf[s_], S[tl], 0, 0, 0); }
        float m = -INFINITY;
#pragma unroll
        for (int tl = 0; tl < 2; ++tl)
#pragma unroll
            for (int e = 0; e < 4; ++e) { if (32 * w + 16 * tl + 4 * kq + e >= cnt) S[tl][e] = -INFINITY; m = fmaxf(m, S[tl][e]); }
        m = fmaxf(m, __shfl_xor(m, 16)); m = fmaxf(m, __shfl_xor(m, 32));
        if (kq == 0) pmax[w * 16 + c] = m;
#pragma unroll
        for (int tl = 0; tl < 2; ++tl)
#pragma unroll
            for (int s_ = 0; s_ < 8; ++s_) *(LAS f16x8*)(V + vw0 + tl * 8192 + (((4 * s_ + kq) ^ swz) << 4)) = Kf[tl][s_];
        asm volatile("s_waitcnt lgkmcnt(0)" ::: "memory"); __builtin_amdgcn_s_barrier(); asm volatile("" ::: "memory");
        float mg = pmax[c];
#pragma unroll
        for (int ww = 1; ww < 8; ++ww) mg = fmaxf(mg, pmax[ww * 16 + c]);
        float ps = 0.f;
#pragma unroll
        for (int tl = 0; tl < 2; ++tl) { float pe[4];
#pragma unroll
            for (int e = 0; e < 4; ++e) { pe[e] = __builtin_amdgcn_exp2f(S[tl][e] - mg); ps += pe[e]; }
            u32x2 pk; pk.x = pk_h2(pe[0], pe[1]); pk.y = pk_h2(pe[2], pe[3]);
            *(LAS u32x2*)(P + c * 528 + (32 * w + 16 * tl + 4 * kq) * 2) = pk; }
        ps += __shfl_xor(ps, 16); ps += __shfl_xor(ps, 32);
        if (kq == 0) psum[w * 16 + c] = ps;
        asm volatile("s_waitcnt lgkmcnt(0)" ::: "memory"); __builtin_amdgcn_s_barrier(); asm volatile("" ::: "memory");
        if (has_next) { rowi[0] = rown[0]; rowi[1] = rown[1]; SP_LOADK(); SP_LOADQ(ntok); }
        float l = psum[c];
#pragma unroll
        for (int ww = 1; ww < 8; ++ww) l += psum[ww * 16 + c];
        f32x4 O[2]; O[0] = (f32x4){0.f, 0.f, 0.f, 0.f}; O[1] = O[0];
#pragma unroll
        for (int s_ = 0; s_ < 8; ++s_) {
            const f16x8 Pf = *(const LAS f16x8*)(P + c * 528 + (32 * s_ + 8 * kq) * 2);
#pragma unroll
            for (int ft = 0; ft < 2; ++ft) {
                const v4i16_t lo = __builtin_amdgcn_ds_read_tr16_b64_v4i16((LAS v4i16_t*)(V + s_ * 16384 + tro[0][ft]));
                const v4i16_t hi = __builtin_amdgcn_ds_read_tr16_b64_v4i16((LAS v4i16_t*)(V + s_ * 16384 + tro[1][ft]));
                const s16x8 av = {lo[0], lo[1], lo[2], lo[3], hi[0], hi[1], hi[2], hi[3]};
                O[ft] = __builtin_amdgcn_mfma_f32_16x16x32_f16(__builtin_bit_cast(f16x8, av), Pf, O[ft], 0, 0, 0); } }
        if (c < 8) { const float il = __builtin_amdgcn_rcpf(l);
#pragma unroll
            for (int ft = 0; ft < 2; ++ft) { const f32x4 o = O[ft] * il; u32x2 pk; pk.x = pk_h2(o.x, o.y); pk.y = pk_h2(o.z, o.w);
                *(u32x2*)(qlat + (size_t)tok * 2048 + c * 256 + 32 * w + 16 * ft + 4 * kq) = pk; } }
        asm volatile("s_waitcnt lgkmcnt(0)" ::: "memory"); __builtin_amdgcn_s_barrier(); asm volatile("" ::: "memory");
        if (!has_next) break;
        tok = ntok;
    }
#undef SP_SEL
#undef SP_LOADK
#undef SP_LOADQ
}


typedef float f32x16 __attribute__((ext_vector_type(16)));
__device__ __forceinline__ int tk_bin(float sc) { const unsigned u = __float_as_uint(sc); int e = (int)((u >> 16) & 0x7FFFu) - (122 << 7); e = e < 0 ? 0 : (e > 1023 ? 1023 : e); return (u >> 31) ? 1023 - e : 1024 + e; }
__device__ __forceinline__ void tk_scores(const f16x8 (&Af)[2], const float (&wv)[16], f16x8 b0, f16x8 b1, float& sa, float& sb) {
    f32x16 d = {0.f, 0.f, 0.f, 0.f, 0.f, 0.f, 0.f, 0.f, 0.f, 0.f, 0.f, 0.f, 0.f, 0.f, 0.f, 0.f};
    d = __builtin_amdgcn_mfma_f32_32x32x16_f16(Af[0], b0, d, 0, 0, 0); d = __builtin_amdgcn_mfma_f32_32x32x16_f16(Af[1], b1, d, 0, 0, 0);
    f32x2 acc = {0.f, 0.f};
#pragma unroll
    for (int e = 0; e < 16; e += 2) { const int i0 = __float_as_int(d[e]), i1 = __float_as_int(d[e + 1]);
        const f32x2 rl = {__int_as_float(i0 > 0 ? i0 : 0), __int_as_float(i1 > 0 ? i1 : 0)}; const f32x2 w2 = {wv[e], wv[e + 1]};
        acc = __builtin_elementwise_fma(w2, rl, acc); }
    sa = acc.x; sb = acc.y;
}
template <bool P2>
__device__ __forceinline__ void tk_tile(const f16x8 (&Af)[2], const float (&wv)[16], f16x8 b0, f16x8 b1, int tile, int r, int hi, int ta, LAS unsigned* hist, const int (&tbin)[4], int (&cs)[4], int (&cc)[4],
                                        unsigned short* sel, int tok0) {
    float sa, sb; tk_scores(Af, wv, b0, b1, sa, sb);
    const int s = 32 * tile + r;
    if constexpr (!P2) {
        if (s <= ta) { const int bn = tk_bin(sa); __hip_atomic_fetch_add(hist + (2 * hi) * 1024 + (bn >> 1), 1u << (16 * (bn & 1)), __ATOMIC_RELAXED, __HIP_MEMORY_SCOPE_WORKGROUP); }
        if (s <= ta + 1) { const int bn = tk_bin(sb); __hip_atomic_fetch_add(hist + (2 * hi + 1) * 1024 + (bn >> 1), 1u << (16 * (bn & 1)), __ATOMIC_RELAXED, __HIP_MEMORY_SCOPE_WORKGROUP); }
    } else {
        const unsigned lowmask = (1u << r) - 1u;
#pragma unroll
        for (int ab = 0; ab < 2; ++ab) { const float sc = ab ? sb : sa; const int tq = ta + ab; const int bn = tk_bin(sc);
            const int mytb = hi ? tbin[2 + ab] : tbin[ab];
            const bool valid = s <= tq, sure = valid && bn > mytb, cand = valid && bn == mytb;
            const unsigned long long ms = __ballot(sure), mc = __ballot(cand);
            const unsigned ms_h = hi ? (unsigned)(ms >> 32) : (unsigned)ms, mc_h = hi ? (unsigned)(mc >> 32) : (unsigned)mc;
            const int q = 2 * hi + ab;
            const int base_s = hi ? cs[2 + ab] : cs[ab], base_c = hi ? cc[2 + ab] : cc[ab];
            if (sure) sel[(size_t)(tok0 + q) * TOPK + base_s + __builtin_popcount(ms_h & lowmask)] = (unsigned short)s;
            if (cand) { const int pos = base_c + __builtin_popcount(mc_h & lowmask);
                if (pos < 512) ((LAS unsigned long long*)((LAS unsigned char*)hist + q * 4096))[pos] = ((unsigned long long)fkey(sc) << 16) | (unsigned long long)(0xFFFFu - (unsigned)s); }
            cs[ab] += __builtin_popcount((unsigned)ms); cs[2 + ab] += __builtin_popcount((unsigned)(ms >> 32));
            cc[ab] += __builtin_popcount((unsigned)mc); cc[2 + ab] += __builtin_popcount((unsigned)(mc >> 32)); }
    }
}
template <bool P2>
__device__ __forceinline__ void tk_pass(const f16x8 (&Af)[2], const float (&wv)[16], const h16* kbase, int ntiles, int r, int hi, int ta, LAS unsigned* hist, const int (&tbin)[4], int (&cs)[4], int (&cc)[4],
                                        unsigned short* sel, int tok0) {
    f16x8 BA[4][2], BB[4][2];
#define TK_LOAD(dst, t0_) do { _Pragma("unroll") for (int i_ = 0; i_ < 4; ++i_) { const int tt_ = ((t0_) + i_) < 127 ? ((t0_) + i_) : 127; dst[i_][0] = *(const f16x8*)(kbase + (size_t)tt_ * 1024); dst[i_][1] = *(const f16x8*)(kbase + (size_t)tt_ * 1024 + 16); } } while (0)
    TK_LOAD(BA, 0);
    for (int t0 = 0; t0 < ntiles; t0 += 8) {
        TK_LOAD(BB, t0 + 4);
#pragma unroll
        for (int i = 0; i < 4; ++i) if (t0 + i < ntiles) tk_tile<P2>(Af, wv, BA[i][0], BA[i][1], t0 + i, r, hi, ta, hist, tbin, cs, cc, sel, tok0);
        TK_LOAD(BA, t0 + 8);
#pragma unroll
        for (int i = 0; i < 4; ++i) if (t0 + 4 + i < ntiles) tk_tile<P2>(Af, wv, BB[i][0], BB[i][1], t0 + 4 + i, r, hi, ta, hist, tbin, cs, cc, sel, tok0);
    }
#undef TK_LOAD
}
__device__ __forceinline__ void tk_group(const Frame& F, const h16* qi, const h16* ki, const float* wi, unsigned short* sel, int b, int t0, LAS unsigned* hist) {
    int lane_ = F.lane; asm volatile("" : "+v"(lane_)); const int lane = lane_, r = lane & 31, hi = lane >> 5, tok0 = b * SEQ + t0;
    const int qa = 2 * ((r >> 2) & 1) + (r & 1), ha = 4 * (r >> 4) + 2 * ((r >> 3) & 1) + ((r >> 1) & 1);
    f16x8 Af[2];
#pragma unroll
    for (int s_ = 0; s_ < 2; ++s_) Af[s_] = *(const f16x8*)(qi + (size_t)(tok0 + qa) * 256 + ha * 32 + 16 * s_ + 8 * hi);
    float wv[16];
    { const f32x4 a0 = *(const f32x4*)(wi + (tok0 + 2 * hi) * 8), a1 = *(const f32x4*)(wi + (tok0 + 2 * hi) * 8 + 4), b0 = *(const f32x4*)(wi + (tok0 + 2 * hi + 1) * 8), b1 = *(const f32x4*)(wi + (tok0 + 2 * hi + 1) * 8 + 4);
      const float sa[8] = {a0.x, a0.y, a0.z, a0.w, a1.x, a1.y, a1.z, a1.w}, sb[8] = {b0.x, b0.y, b0.z, b0.w, b1.x, b1.y, b1.z, b1.w};
#pragma unroll
      for (int h = 0; h < 8; ++h) { wv[2 * h] = sa[h] * 0.17677669529663687f; wv[2 * h + 1] = sb[h] * 0.17677669529663687f; } }
    const int ntiles = (t0 + 3) / 32 + 1, ta = t0 + 2 * hi;
    const h16* kbase = ki + (size_t)(b * SEQ + r) * 32 + 8 * hi;
    int tbin[4] = {0, 0, 0, 0}, nsure[4], cs[4] = {0, 0, 0, 0}, cc[4] = {0, 0, 0, 0};
#pragma unroll
    for (int i = 0; i < 16; ++i) *(LAS u32x4*)((LAS unsigned char*)hist + i * 1024 + lane * 16) = (u32x4){0u, 0u, 0u, 0u};
    asm volatile("s_waitcnt lgkmcnt(0)" ::: "memory");
#ifdef TK_X1
    tk_pass<false>(Af, wv, kbase, ntiles, r, hi, ta, hist, tbin, cs, cc, sel, tok0);
    asm volatile("s_waitcnt lgkmcnt(0)" ::: "memory");
#pragma unroll
    for (int i = 0; i < 16; ++i) *(LAS u32x4*)((LAS unsigned char*)hist + i * 1024 + lane * 16) = (u32x4){0u, 0u, 0u, 0u};
    asm volatile("s_waitcnt lgkmcnt(0)" ::: "memory");
#endif
    tk_pass<false>(Af, wv, kbase, ntiles, r, hi, ta, hist, tbin, cs, cc, sel, tok0);
    asm volatile("s_waitcnt lgkmcnt(0)" ::: "memory");
#pragma unroll
    for (int q = 0; q < 4; ++q) {
        const LAS unsigned* hq = hist + q * 1024;
        unsigned sum = 0;
#pragma unroll
        for (int i = 0; i < 4; ++i) { const u32x4 v = *(const LAS u32x4*)(hq + 16 * lane + 4 * i); sum += (v.x & 0xFFFFu) + (v.x >> 16) + (v.y & 0xFFFFu) + (v.y >> 16) + (v.z & 0xFFFFu) + (v.z >> 16) + (v.w & 0xFFFFu) + (v.w >> 16); }
        unsigned incl = sum;
#pragma unroll
        for (int o = 1; o < 64; o <<= 1) { const unsigned v = __shfl_down(incl, o); if (lane + o < 64) incl += v; }
        const unsigned long long bal = __ballot(incl >= (unsigned)TOPK);
        const int L = 63 - __builtin_clzll(bal);
        unsigned cum = __shfl(incl, L) - __shfl(sum, L);
        int tbq = 32 * L, found = 0;
        for (int wd = 15; wd >= 0 && !found; --wd) { const unsigned v = hq[16 * L + wd];
            const unsigned chi = v >> 16, clo = v & 0xFFFFu;
            if (cum + chi >= (unsigned)TOPK) { tbq = 32 * L + 2 * wd + 1; found = 1; } else { cum += chi;
                if (cum + clo >= (unsigned)TOPK) { tbq = 32 * L + 2 * wd; found = 1; } else cum += clo; } }
        tbin[q] = tbq; nsure[q] = (int)cum;
    }
    asm volatile("s_waitcnt lgkmcnt(0)" ::: "memory");
#ifdef TK_X3
    tk_pass<true>(Af, wv, kbase, ntiles, r, hi, ta, hist, tbin, cs, cc, sel, tok0);
    asm volatile("s_waitcnt lgkmcnt(0)" ::: "memory");
#pragma unroll
    for (int q = 0; q < 4; ++q) { cs[q] = 0; cc[q] = 0; }
#endif
    tk_pass<true>(Af, wv, kbase, ntiles, r, hi, ta, hist, tbin, cs, cc, sel, tok0);
    asm volatile("s_waitcnt lgkmcnt(0)" ::: "memory");
#pragma unroll
    for (int q = 0; q < 4; ++q) {
        const int nc = cc[q] < 512 ? cc[q] : 512, need = TOPK - cs[q];
        const LAS unsigned long long* cq = (const LAS unsigned long long*)((const LAS unsigned char*)hist + q * 4096);
        if (nc > 64) {
            unsigned long long it[8];
#pragma unroll
            for (int k = 0; k < 8; ++k) it[k] = (k * 64 + lane < nc) ? cq[k * 64 + lane] : 0ull;
            unsigned long long T = 0ull;
            for (int bit = 47; bit >= 0; --bit) { const unsigned long long cand = T | (1ull << bit); int cnt = 0;
#pragma unroll
                for (int k = 0; k < 8; ++k) cnt += __builtin_popcountll(__ballot(it[k] >= cand));
                if (cnt >= need) T = cand; }
            int basep = cs[q];
#pragma unroll
            for (int k = 0; k < 8; ++k) { const bool pick = (T != 0ull) && it[k] >= T; const unsigned long long mk = __ballot(pick);
                if (pick) sel[(size_t)(tok0 + q) * TOPK + basep + __builtin_popcountll(mk & ((1ull << lane) - 1ull))] = (unsigned short)(0xFFFFu - (unsigned)(it[k] & 0xFFFFull));
                basep += __builtin_popcountll(mk); }
        } else
        for (int base = 0; base < nc; base += 64) {
            const bool act = base + lane < nc; const unsigned long long my = act ? cq[base + lane] : 0ull; int rank = 0;
            for (int jb = 0; jb < nc; jb += 64) {
                const unsigned long long cj = (jb + lane < nc) ? cq[jb + lane] : 0ull; const unsigned clo = (unsigned)cj, chi = (unsigned)(cj >> 32);
                const int n = (nc - jb) < 64 ? (nc - jb) : 64;
                for (int j = 0; j < n; ++j) { const unsigned long long sj = ((unsigned long long)(unsigned)__builtin_amdgcn_readlane((int)chi, j) << 32) | (unsigned)__builtin_amdgcn_readlane((int)clo, j); rank += (sj > my) ? 1 : 0; } }
            if (act && rank < need) sel[(size_t)(tok0 + q) * TOPK + cs[q] + rank] = (unsigned short)(0xFFFFu - (unsigned)(my & 0xFFFFull)); }
    }
    (void)nsure;
    asm volatile("s_waitcnt lgkmcnt(0)" ::: "memory");
}
__device__ __forceinline__ void ph_topk_sparse(const Frame& F, const h16* qi, const h16* ki, const float* wi, unsigned short* sel, h16* qlat, const h16* qr, const unsigned char* ckv8, const unsigned char* kr8);
__device__ __forceinline__ void ph_topk_mfma(const Frame& F, const h16* qi, const h16* ki, const float* wi, unsigned short* sel) {
    LAS unsigned* hist = (LAS unsigned*)(F.lds + F.wave * 16384);
    for (int g = F.gw; g < 4 * 64; g += F.NGW) { const int b = g >> 6, t0 = (g & 63) * 4;
        for (int i = F.lane; i < 4 * TOPK; i += 64) { const int q = i >> 8, k = i & 255; sel[(size_t)(b * SEQ + t0 + q) * TOPK + k] = (unsigned short)(k <= t0 + q ? k : 0); } }
    for (int p = F.gw; p < 4 * 480; p += F.NGW) { const int b = p & 3, pj = p >> 2;
        tk_group(F, qi, ki, wi, sel, b, 4 * (64 + pj), hist);
        tk_group(F, qi, ki, wi, sel, b, 4 * (1023 - pj), hist);
#ifdef TK_X6
        tk_group(F, qi, ki, wi, sel, b, 4 * (64 + pj), hist);
        tk_group(F, qi, ki, wi, sel, b, 4 * (1023 - pj), hist);
#endif
    }
}


__device__ __forceinline__ void ph_dilated_mfma(const Frame& F, const h16* qb, const h16* kb, const h16* vb, h16* og, float* lse2) {
    const int lane = F.lane, ql = lane & 31, hi = lane >> 5;
    LAS unsigned char* VL = F.lds + F.wave * 16384;
    LAS float* linv = (LAS float*)(VL + 12288);
    constexpr int VROW = 192;
    const int trq = (lane & 15) >> 2, trp = lane & 3, trg = (lane >> 4) & 1;
    for (int u = F.gw; u < NB * 12 * 128; u += F.NGW) {
        const int b = u / 1536, rem = u % 1536, gh = rem >> 7, g = gh >> 2, wi_ = rem & 127, dil = dil_of(g), sh = g == 0 ? 0 : (g == 1 ? 2 : 4);
        const int nblk = 128 >> sh, res = wi_ / nblk, j0 = 32 * (wi_ % nblk);
        const size_t hoff = (size_t)b * SEQ * 768 + gh * 64;
        f16x8 Qf[4];
        { const h16* qp = qb + hoff + (size_t)((j0 + ql) * dil + res) * 768 + 8 * hi;
#pragma unroll
          for (int s_ = 0; s_ < 4; ++s_) Qf[s_] = *(const f16x8*)(qp + 16 * s_); }
        f32x16 S[5];
        f16x8 Kf[5][4];
#pragma unroll
        for (int kt = 0; kt < 5; ++kt) { int jk = j0 - 128 + 32 * kt + ql; jk = jk < 0 ? 0 : jk;
            const h16* kp = kb + hoff + (size_t)(jk * dil + res) * 768 + 8 * hi;
#pragma unroll
            for (int s_ = 0; s_ < 4; ++s_) Kf[kt][s_] = *(const f16x8*)(kp + 16 * s_); }
#pragma unroll
        for (int kt = 0; kt < 5; ++kt) {
            f32x16 d = {0.f, 0.f, 0.f, 0.f, 0.f, 0.f, 0.f, 0.f, 0.f, 0.f, 0.f, 0.f, 0.f, 0.f, 0.f, 0.f};
#pragma unroll
            for (int s_ = 0; s_ < 4; ++s_) d = __builtin_amdgcn_mfma_f32_32x32x16_f16(Kf[kt][s_], Qf[s_], d, 0, 0, 0);
            S[kt] = d; }
        f16x8 Vr[5][4];
#pragma unroll
        for (int kt = 0; kt < 5; ++kt) { int jk = j0 - 128 + 32 * kt + (lane >> 1); jk = jk < 0 ? 0 : jk;
            const h16* vp = vb + hoff + (size_t)(jk * dil + res) * 768 + (lane & 1) * 32;
#pragma unroll
            for (int i = 0; i < 4; ++i) Vr[kt][i] = *(const f16x8*)(vp + 8 * i); }
        float m = -INFINITY;
#pragma unroll
        for (int kt = 0; kt < 5; ++kt)
#pragma unroll
            for (int e = 0; e < 16; ++e) { const int kl = (e & 3) + 8 * (e >> 2) + 4 * hi; bool ok = (j0 - 128 + 32 * kt + kl) >= 0;
                if (kt == 0) ok = ok && (kl >= ql); if (kt == 4) ok = ok && (kl <= ql);
                if (!ok) S[kt][e] = -INFINITY; m = fmaxf(m, S[kt][e]); }
        m = fmaxf(m, __shfl_xor(m, 32));
        float l = 0.f;
#pragma unroll
        for (int kt = 0; kt < 5; ++kt)
#pragma unroll
            for (int e = 0; e < 16; ++e) { const float p = __builtin_amdgcn_exp2f(S[kt][e] - m); S[kt][e] = p; l += p; }
        l += __shfl_xor(l, 32);
        if (hi == 0) { linv[ql] = __builtin_amdgcn_rcpf(l); lse2[(size_t)(b * SEQ + (j0 + ql) * dil + res) * 12 + gh] = m + __builtin_amdgcn_logf(l); }
        f32x16 O[2];
#pragma unroll
        for (int dt = 0; dt < 2; ++dt) O[dt] = (f32x16){0.f, 0.f, 0.f, 0.f, 0.f, 0.f, 0.f, 0.f, 0.f, 0.f, 0.f, 0.f, 0.f, 0.f, 0.f, 0.f};
#pragma unroll
        for (int kt = 0; kt < 5; ++kt) {
            LAS unsigned char* vbuf = VL + (kt & 1) * 6144;
#pragma unroll
            for (int i = 0; i < 4; ++i) *(LAS f16x8*)(vbuf + (lane >> 1) * VROW + (lane & 1) * 64 + i * 16) = Vr[kt][i];
            asm volatile("s_waitcnt lgkmcnt(0)" ::: "memory");
#pragma unroll
            for (int s2 = 0; s2 < 2; ++s2) {
                u32x4 pa; pa.x = pk_h2(S[kt][8 * s2 + 0], S[kt][8 * s2 + 1]); pa.y = pk_h2(S[kt][8 * s2 + 2], S[kt][8 * s2 + 3]); pa.z = pk_h2(S[kt][8 * s2 + 4], S[kt][8 * s2 + 5]); pa.w = pk_h2(S[kt][8 * s2 + 6], S[kt][8 * s2 + 7]);
#pragma unroll
                for (int dt = 0; dt < 2; ++dt) {
                    const v4i16_t lo = __builtin_amdgcn_ds_read_tr16_b64_v4i16((LAS v4i16_t*)(vbuf + (16 * s2 + 4 * hi + trq) * VROW + (32 * dt + 16 * trg + 4 * trp) * 2));
                    const v4i16_t hh = __builtin_amdgcn_ds_read_tr16_b64_v4i16((LAS v4i16_t*)(vbuf + (16 * s2 + 8 + 4 * hi + trq) * VROW + (32 * dt + 16 * trg + 4 * trp) * 2));
                    const s16x8 bv = {lo[0], lo[1], lo[2], lo[3], hh[0], hh[1], hh[2], hh[3]};
                    O[dt] = __builtin_amdgcn_mfma_f32_32x32x16_f16(__builtin_bit_cast(f16x8, pa), __builtin_bit_cast(f16x8, bv), O[dt], 0, 0, 0); } }
            asm volatile("s_waitcnt lgkmcnt(0)" ::: "memory");
        }
#pragma unroll
        for (int e = 0; e < 16; ++e) { const int q = (e & 3) + 8 * (e >> 2) + 4 * hi; const float il = linv[q];
            h16* op = og + (size_t)(b * SEQ + (j0 + q) * dil + res) * 768 + gh * 64 + ql;
            op[0] = (h16)(O[0][e] * il); op[32] = (h16)(O[1][e] * il); }
        asm volatile("s_waitcnt lgkmcnt(0)" ::: "memory");
    }
}


__device__ __forceinline__ f16x8 fp8x8_to_f16(unsigned w0, unsigned w1) {
    const h16x2 a = __builtin_amdgcn_cvt_scalef32_pk_f16_fp8((int)w0, 1.0f, false), b = __builtin_amdgcn_cvt_scalef32_pk_f16_fp8((int)w0, 1.0f, true),
                c = __builtin_amdgcn_cvt_scalef32_pk_f16_fp8((int)w1, 1.0f, false), d = __builtin_amdgcn_cvt_scalef32_pk_f16_fp8((int)w1, 1.0f, true);
    const u32x4 r = {__builtin_bit_cast(unsigned, a), __builtin_bit_cast(unsigned, b), __builtin_bit_cast(unsigned, c), __builtin_bit_cast(unsigned, d)};
    return __builtin_bit_cast(f16x8, r);
}
template <bool FUSED>
__device__ __forceinline__ void ph_sparse_wave(const Frame& F, h16* qlat, const h16* qr, const unsigned char* ckv8, const unsigned char* kr8, const unsigned short* sel, int ta = 0, int tb = 0) {
    int lane = F.lane; asm volatile("" : "+v"(lane));
    LAS unsigned char* V = F.lds + F.wave * 16384;
    const int qp = (lane & 15) >> 2, pp = lane & 3;
    const int k0 = 4 * (lane >> 4) + qp;
    const int tr0 = k0 * 512 + (pp >> 1) * 16 + (pp & 1) * 8, x0 = k0 & 7;
    const int vw = (lane & 15) * 512, swz = lane & 7;
    const int lane0 = lane;
    const int nit = FUSED ? 8 : (MT - F.gw + F.NGW - 1) / F.NGW;
    for (int it = 0; it < nit; ++it) {
        const int tok = FUSED ? ((it < 4 ? ta : tb - 4) + it) : F.gw + it * F.NGW;
        int ll = lane0; asm volatile("" : "+v"(ll));
        const int c = ll & 15, kq = ll >> 4, hd = c & 7;
        const int b = tok / SEQ, t = tok % SEQ, cnt = (t + 1 < TOPK) ? t + 1 : TOPK, nch = (cnt + 31) >> 5;
        LAS unsigned short* sp = (LAS unsigned short*)(F.lds + XCH_OFF + F.wave * 512) + c;
        *(LAS u32x2*)(F.lds + XCH_OFF + F.wave * 512 + 8 * ll) = *(const u32x2*)(sel + (size_t)tok * TOPK + 4 * ll);
        asm volatile("s_waitcnt lgkmcnt(0)" ::: "memory");
        f16x8 Qf[9]; u32x4 Kr[2][4]; u32x2 Rr[2];
#pragma unroll
        for (int s_ = 0; s_ < 8; ++s_) Qf[s_] = *(const f16x8*)(qlat + (size_t)tok * 2048 + hd * 256 + 64 * (s_ >> 1) + 16 * kq + 8 * (s_ & 1));
        Qf[8] = *(const f16x8*)(qr + (size_t)tok * 256 + hd * 32 + 8 * kq);
        int rowi[2];
#define SW_LOADK() do { _Pragma("unroll") for (int tl = 0; tl < 2; ++tl) { _Pragma("unroll") for (int q4 = 0; q4 < 4; ++q4) Kr[tl][q4] = *(const u32x4*)(ckv8 + (size_t)rowi[tl] * 256 + 64 * q4 + 16 * kq); \
        Rr[tl] = *(const u32x2*)(kr8 + (size_t)rowi[tl] * 32 + 8 * kq); } } while (0)
        rowi[0] = b * SEQ + (int)sp[0]; rowi[1] = b * SEQ + (int)sp[16];
        SW_LOADK();
        float m = -INFINITY, l = 0.f;
        f32x4 O[16];
#pragma unroll
        for (int ft = 0; ft < 16; ++ft) O[ft] = (f32x4){0.f, 0.f, 0.f, 0.f};
        for (int ch = 0; ch < nch; ++ch) {
            const bool more = ch + 1 < nch;
            int rown0 = 0, rown1 = 0; if (more) { rown0 = (int)sp[32 * (ch + 1)]; rown1 = (int)sp[32 * (ch + 1) + 16]; }
            f16x8 Kf[2][9];
#pragma unroll
            for (int tl = 0; tl < 2; ++tl) {
#pragma unroll
                for (int q4 = 0; q4 < 4; ++q4) { Kf[tl][2 * q4] = fp8x8_to_f16(Kr[tl][q4].x, Kr[tl][q4].y); Kf[tl][2 * q4 + 1] = fp8x8_to_f16(Kr[tl][q4].z, Kr[tl][q4].w); }
                Kf[tl][8] = fp8x8_to_f16(Rr[tl].x, Rr[tl].y); }
            if (more) { rowi[0] = b * SEQ + rown0; rowi[1] = b * SEQ + rown1; SW_LOADK(); }
            f32x4 S[2];
#pragma unroll
            for (int tl = 0; tl < 2; ++tl) { S[tl] = (f32x4){0.f, 0.f, 0.f, 0.f};
#pragma unroll
                for (int s_ = 0; s_ < 9; ++s_) S[tl] = __builtin_amdgcn_mfma_f32_16x16x32_f16(Kf[tl][s_], Qf[s_], S[tl], 0, 0, 0); }
            float cm = -INFINITY;
#pragma unroll
            for (int tl = 0; tl < 2; ++tl)
#pragma unroll
                for (int e = 0; e < 4; ++e) { if (32 * ch + 16 * tl + 4 * kq + e >= cnt) S[tl][e] = -INFINITY; cm = fmaxf(cm, S[tl][e]); }
            cm = fmaxf(cm, __shfl_xor(cm, 16)); cm = fmaxf(cm, __shfl_xor(cm, 32));
            if (__any(cm > m + 8.0f)) { const float mn = fmaxf(m, cm), alpha = __builtin_amdgcn_exp2f(m - mn); m = mn; l *= alpha;
#pragma unroll
                for (int ft = 0; ft < 16; ++ft) O[ft] = O[ft] * alpha; }
            float pe[2][4]; float ps = 0.f;
#pragma unroll
            for (int tl = 0; tl < 2; ++tl)
#pragma unroll
                for (int e = 0; e < 4; ++e) { pe[tl][e] = __builtin_amdgcn_exp2f(S[tl][e] - m); ps += pe[tl][e]; }
            l += ps;
#pragma unroll
            for (int tl = 0; tl < 2; ++tl)
#pragma unroll
                for (int s_ = 0; s_ < 8; ++s_) *(LAS f16x8*)(V + vw + tl * 8192 + (((4 * (s_ >> 1) + kq) ^ swz) << 5) + (s_ & 1) * 16) = Kf[tl][s_];
            asm volatile("s_waitcnt lgkmcnt(0)" ::: "memory");
            u32x4 pk; pk.x = pk_h2(pe[0][0], pe[0][1]); pk.y = pk_h2(pe[0][2], pe[0][3]); pk.z = pk_h2(pe[1][0], pe[1][1]); pk.w = pk_h2(pe[1][2], pe[1][3]);
            const f16x8 Pf = __builtin_bit_cast(f16x8, pk);
#pragma unroll
            for (int ft = 0; ft < 16; ++ft) {
                const v4i16_t lo = __builtin_amdgcn_ds_read_tr16_b64_v4i16((LAS v4i16_t*)(V + tr0 + (((ft & 7) ^ x0) << 5) + (ft >> 3) * 256));
                const v4i16_t hi = __builtin_amdgcn_ds_read_tr16_b64_v4i16((LAS v4i16_t*)(V + tr0 + (((ft & 7) ^ x0) << 5) + (ft >> 3) * 256 + 8192));
                const s16x8 av = {lo[0], lo[1], lo[2], lo[3], hi[0], hi[1], hi[2], hi[3]};
                O[ft] = __builtin_amdgcn_mfma_f32_16x16x32_f16(__builtin_bit_cast(f16x8, av), Pf, O[ft], 0, 0, 0); }
            asm volatile("s_waitcnt lgkmcnt(0)" ::: "memory");
        }
        l += __shfl_xor(l, 16); l += __shfl_xor(l, 32);
        if (c < 8) { const float il = __builtin_amdgcn_rcpf(l);
#pragma unroll
            for (int ft = 0; ft < 16; ++ft) { const f32x4 o = O[ft] * il; u32x2 pk; pk.x = pk_h2(o.x, o.y); pk.y = pk_h2(o.z, o.w);
                *(u32x2*)(qlat + (size_t)tok * 2048 + c * 256 + 16 * ft + 4 * kq) = pk; } }
#undef SW_LOADK
    }
}


__device__ __forceinline__ void precomb_tiles(const Frame& F, const Args& args, unsigned char* ws, int t_lo, int t_hi, int wg, int nwg) {
    LAS float* As = (LAS float*)(F.lds); LAS float* Bs = (LAS float*)(F.lds + 64 * 65 * 4);
    for (int tl = t_lo + wg; tl < t_hi; tl += nwg) {
        __syncthreads();
        const bool ql = tl < 192; int hd, rb, xb;
        if (ql) { hd = tl / 24; rb = (tl % 24) / 6; xb = tl % 6; } else { const int t2 = tl - 192; hd = t2 / 64; rb = (t2 % 64) / 16; xb = t2 % 16; }
#pragma unroll
        for (int k = 0; k < 2; ++k) { const int i4 = F.tid + NTHR * k, row = i4 >> 4, c4 = (i4 & 15) * 4;
            if (ql) { const f32x4 a = *(const f32x4*)(args.in[15] + (size_t)(rb * 64 + row) * 512 + hd * 64 + c4), bq = *(const f32x4*)(args.in[14] + (size_t)(xb * 64 + row) * 768 + hd * 96 + c4);
#pragma unroll
                for (int e = 0; e < 4; ++e) { As[row * 65 + c4 + e] = a[e]; Bs[row * 65 + c4 + e] = bq[e]; } }
            else { const f32x4 a = *(const f32x4*)(args.in[18] + (size_t)(hd * 64 + row) * DM + xb * 64 + c4), bq = *(const f32x4*)(args.in[16] + (size_t)(rb * 64 + row) * 512 + hd * 64 + c4);
#pragma unroll
                for (int e = 0; e < 4; ++e) { As[(c4 + e) * 65 + row] = a[e]; Bs[row * 65 + c4 + e] = bq[e]; } } }
        __syncthreads();
        const int j = F.tid & 63, ig = F.wave;
        float acc8[8];
#pragma unroll
        for (int ii = 0; ii < 8; ++ii) acc8[ii] = 0.f;
#pragma unroll 4
        for (int v = 0; v < 64; ++v) { const float bv = Bs[j * 65 + v];
#pragma unroll
            for (int ii = 0; ii < 8; ++ii) acc8[ii] += As[(ig * 8 + ii) * 65 + v] * bv; }
        if (ql) { const float gj = args.in[12][xb * 64 + j]; h16* o = (h16*)(ws + OW_4);
#pragma unroll
            for (int ii = 0; ii < 8; ++ii) o[(size_t)(hd * 256 + rb * 64 + ig * 8 + ii) * QL + xb * 64 + j] = (h16)(acc8[ii] * gj); }
        else { h16* o = (h16*)(ws + OW_OV);
#pragma unroll
            for (int ii = 0; ii < 8; ++ii) o[(size_t)(xb * 64 + ig * 8 + ii) * 2048 + hd * 256 + rb * 64 + j] = (h16)acc8[ii]; }
    }
    __syncthreads();
}


__device__ __forceinline__ void ph_topk_sparse(const Frame& F, const h16* qi, const h16* ki, const float* wi, unsigned short* sel, h16* qlat, const h16* qr, const unsigned char* ckv8, const unsigned char* kr8) {
    LAS unsigned* hist = (LAS unsigned*)(F.lds + F.wave * 16384);
    for (int p = F.gw; p < 2048; p += F.NGW) {
        int ta, tb;
        if (p < 4 * 480) { const int b = p & 3, pj = p >> 2; ta = b * SEQ + 4 * (64 + pj); tb = b * SEQ + 4 * (1023 - pj);
            tk_group(F, qi, ki, wi, sel, b, 4 * (64 + pj), hist);
            tk_group(F, qi, ki, wi, sel, b, 4 * (1023 - pj), hist); }
        else { const int g0 = 2 * (p - 4 * 480);
#pragma unroll
            for (int gg = 0; gg < 2; ++gg) { const int g = g0 + gg, b = g >> 6, t0 = (g & 63) * 4;
                int l0 = F.lane; asm volatile("" : "+v"(l0));
                for (int i = l0; i < 4 * TOPK; i += 64) { const int q = i >> 8, k = i & 255; sel[(size_t)(b * SEQ + t0 + q) * TOPK + k] = (unsigned short)(k <= t0 + q ? k : 0); } }
            ta = (g0 >> 6) * SEQ + (g0 & 63) * 4; tb = ((g0 + 1) >> 6) * SEQ + ((g0 + 1) & 63) * 4; }
        asm volatile("s_waitcnt vmcnt(0) lgkmcnt(0)" ::: "memory");
        ph_sparse_wave<true>(F, qlat, qr, ckv8, kr8, sel, ta, tb);
        asm volatile("s_waitcnt lgkmcnt(0)" ::: "memory");
    }
}

__global__ void __launch_bounds__(NTHR, 2) mega_fwd(Args args) {
    extern __shared__ __attribute__((aligned(16))) unsigned char lds_raw[];
    Frame F; F.lds = (LAS unsigned char*)lds_raw; F.tid = threadIdx.x; F.lane = F.tid & 63; F.wave = __builtin_amdgcn_readfirstlane(F.tid >> 6);
    F.G = gridDim.x; F.gw = blockIdx.x * NWAVES + F.wave; F.NGW = F.G * NWAVES;
    volatile LAS unsigned* MISC = (volatile LAS unsigned*)(F.lds + MISC_OFF);
    unsigned char* ws = args.ws;
    for (int u = F.tid; u < (LDS_BYTES - LDSCTL_OFF) / 4; u += NTHR) ((LAS unsigned*)(F.lds + LDSCTL_OFF))[u] = 0u;
    __syncthreads();
    XcdBarrier bar = xcd_barrier_post((unsigned*)(ws + OFF_CTL) + CW_BAR, MISC + 8);
    const int lo = args.ph_lo, hi = args.ph_hi;
#ifndef PHMASK
#define PHMASK 0xFFFFu
#endif
#define IN(k) (((PHMASK >> (k)) & 1u) && lo <= (k) && (k) < hi)
#ifdef PROBE_PHASE
#define STAMP(k) do { if (blockIdx.x == 0 && F.tid == 0) ((unsigned long long*)(ws + OFF_MOD + 768 * 1024))[(k) + 1] = __builtin_amdgcn_s_memrealtime(); } while (0)
#else
#define STAMP(k) do { } while (0)
#endif
#define SEAM(k) do { if (IN(k) && IN((k) + 1)) xcd_barrier(bar); STAMP(k); } while (0)
    float* mod = (float*)(ws + OFF_MOD); float2* tab = (float2*)(ws + OFF_ROPE);
    h16* Hb = (h16*)(ws + OFF_H); h16* Ab = (h16*)(ws + OFF_A); float* Fb = (float*)(ws + OFF_F);

    STAMP(-1);
    if (IN(0)) {
        LAS float* scr = (LAS float*)(F.lds + F.wave * 16384);
        for (int ch = blockIdx.x; ch < (NMOD * DM) / 36; ch += F.G) {
            LAS float* sl = (LAS float*)(F.lds);
            LAS float* part = (LAS float*)(F.lds + 16384);
            __syncthreads();
            for (int i = F.tid; i < 4 * DM; i += NTHR) sl[i] = silu_f(args.in[1][i]);
            __syncthreads();
            const int ln = F.lane < 36 ? F.lane : 35;
            const float* wm = args.in[3] + (size_t)(F.wave * 128) * (NMOD * DM) + ch * 36 + ln;
            float a0 = 0.f, a1 = 0.f, a2 = 0.f, a3 = 0.f;
#pragma unroll 16
            for (int k = 0; k < 128; ++k) { const float w = wm[(size_t)k * (NMOD * DM)]; const int kk = F.wave * 128 + k; a0 += sl[kk] * w; a1 += sl[DM + kk] * w; a2 += sl[2 * DM + kk] * w; a3 += sl[3 * DM + kk] * w; }
            part[(F.wave * 4 + 0) * 64 + F.lane] = a0; part[(F.wave * 4 + 1) * 64 + F.lane] = a1; part[(F.wave * 4 + 2) * 64 + F.lane] = a2; part[(F.wave * 4 + 3) * 64 + F.lane] = a3;
            __syncthreads();
            if (F.tid < 256 && (F.tid & 63) < 36) { const int b = F.tid >> 6, l = F.tid & 63; float sm = args.in[4][ch * 36 + l];
#pragma unroll
                for (int w = 0; w < 8; ++w) sm += part[(w * 4 + b) * 64 + l];
                mod[b * (NMOD * DM) + ch * 36 + l] = sm; }
            __syncthreads();
        }
        for (int idx = blockIdx.x * NTHR + F.tid; idx < MT * 48; idx += F.G * NTHR) { const int tok = idx / 48, i = idx % 48;
            const float inv = (i < 32) ? powf(10000.f, -(float)i / 32.f) : powf(10000.f, -(float)(i - 32) / 16.f);
            const float ang = (float)((const int*)args.in[2])[tok] * inv; tab[idx] = make_float2(cosf(ang), sinf(ang)); }
        tr_job_mapped(F, args, 0, 2 * FF, 0, DM, (h16*)(ws + OW_GU1), nullptr, scr, 0);
        if (F.G != 256) {
            tr_job_plain(F, args.in[8], DM, DM, FF, (h16*)(ws + OW_D1), scr, 768);
            tr_job_mapped(F, args, 2, NIN3, 0, DM, (h16*)(ws + OW_IN), nullptr, scr, 128);
            tr_job_plain(F, args.in[11] + C_GATE, DIN, 2048, DM, (h16*)(ws + OW_GATE), scr, 1664);
            tr_job_mapped(F, args, 3, 512, 2048, QL, (h16*)(ws + OW_4), args.in[12], scr, 640);
            tr_job_plain(F, args.in[19], DM, DM, 256, (h16*)(ws + OW_UPB), scr, 736);
            tr_job_plain(F, args.in[20], DM, DM, DM, (h16*)(ws + OW_O), scr, 864);
            tr_job_mapped(F, args, 1, 2 * FF, 0, DM, (h16*)(ws + OW_GU2), nullptr, scr, 1376);
            tr_job_plain(F, args.in[25], DM, DM, FF, (h16*)(ws + OW_D2), scr, 96);
            precomb_tiles(F, args, ws, 0, 192, (int)blockIdx.x, F.G);
            tr_job_plain(F, args.in[18], DM, DM, 512, (h16*)(ws + OW_UPA), scr, 256);
        }
    }
    SEAM(0);
    if (IN(1)) ph_normmod(F, args.in[0], args.in[5], mod, 1, 0, Hb);
    SEAM(1);
    if (IN(2)) { pg8::Gemm g{Hb, (const h16*)(ws + OW_GU1), MT, 2 * FF, DM}; pg8::StaticOrder S; S.init(MT, 2 * FF, F.G, (int)blockIdx.x); pg8::EpiSwiGLU E{Ab};
        pg8::gemm_phase<pg8::EpiSwiGLU, true>(F.lds, g, S, E);
        if (F.G == 256 && blockIdx.x >= 128) {
            Frame F2 = F; F2.gw = ((int)blockIdx.x - 128) * NWAVES + F.wave; F2.NGW = 128 * NWAVES; LAS float* scr = (LAS float*)(F.lds + F.wave * 16384);
            tr_job_plain(F2, args.in[8], DM, DM, FF, (h16*)(ws + OW_D1), scr, 0);
            tr_job_mapped(F2, args, 2, NIN3, 0, DM, (h16*)(ws + OW_IN), nullptr, scr, 384);
            tr_job_mapped(F2, args, 3, 512, 2048, QL, (h16*)(ws + OW_4), args.in[12], scr, 896);
            tr_job_mapped(F2, args, 1, 2 * FF, 0, DM, (h16*)(ws + OW_GU2), nullptr, scr, 640);
            precomb_tiles(F, args, ws, 0, 192, (int)blockIdx.x - 128, 128);
            for (int i = ((int)blockIdx.x - 128) * NTHR + F.tid; i < (int)(MiB / 16); i += 128 * NTHR) ((u32x4*)(ws + OW_BD))[i] = (u32x4){0u, 0u, 0u, 0u}; } }
    SEAM(2);
    if (IN(3)) { pg8::Gemm g{Ab, (const h16*)(ws + OW_D1), MT, DM, FF}; pg8::StaticOrder S; S.init(MT, DM, F.G, (int)blockIdx.x); pg8::EpiH16 E{(h16*)Fb};
        pg8::gemm_phase<pg8::EpiH16, false>(F.lds, g, S, E); }
    SEAM(3);
    if (IN(4)) ph_resnorm<false, true>(F, args.in[0], (const h16*)Fb, args.in[9], mod, 2, 0.5f, args.out, true, args.in[10], 4, 3, Hb);
    SEAM(4);
    if (IN(5)) { pg8::Gemm g{Hb, (const h16*)(ws + OW_IN), MT, NIN3, DM}; pg8::StaticOrder S; S.init(MT, NIN3, F.G, (int)blockIdx.x);
        pg8::EpiIn E{(h16*)(ws + OFF_CKV), (h16*)(ws + OFF_CQ), (h16*)(ws + OFF_KR), (h16*)(ws + OFF_KI), (h16*)(ws + OFF_QB), (h16*)(ws + OFF_KB), (h16*)(ws + OFF_VT), (float*)(ws + OFF_WI), (float*)(ws + OFF_SSQ),
                     args.in[13], tab, (LAS float*)(F.lds + XCH_OFF)};
        pg8::gemm_phase<pg8::EpiIn, true>(F.lds, g, S, E); }
    SEAM(5);
    if (IN(6)) { for (int tk_ = blockIdx.x * NTHR + F.tid; tk_ < MT; tk_ += F.G * NTHR) { const f32x4 s0 = *(const f32x4*)((const float*)(ws + OFF_SSQ) + tk_ * 8), s1 = *(const f32x4*)((const float*)(ws + OFF_SSQ) + tk_ * 8 + 4);
            ((float*)(ws + OFF_RSTDQ))[tk_] = rsqrtf((((s0.x + s0.y) + (s0.z + s0.w)) + ((s1.x + s1.y) + (s1.z + s1.w))) * (1.f / QL) + EPS); } }
    if (IN(6)) ph_dilated_mfma(F, (const h16*)(ws + OFF_QB), (const h16*)(ws + OFF_KB), (const h16*)(ws + OFF_VT), (h16*)(ws + OFF_OG), (float*)(ws + OFF_LSE));
    SEAM(6);
    if (IN(7)) { pg8::Gemm g{(const h16*)(ws + OFF_CQ), (const h16*)(ws + OW_4), MT, N4, QL}; pg8::StaticOrder S; S.init(MT, N4, F.G, (int)blockIdx.x);
        pg8::Epi4 E{(h16*)(ws + OFF_QLAT), (h16*)(ws + OFF_QR), (h16*)(ws + OFF_QI), (const float*)(ws + OFF_RSTDQ), tab};
        pg8::gemm_phase<pg8::Epi4, true>(F.lds, g, S, E);
        if (F.G == 256 && blockIdx.x >= 128) {
            Frame F2 = F; F2.gw = ((int)blockIdx.x - 128) * NWAVES + F.wave; F2.NGW = 128 * NWAVES; LAS float* scr = (LAS float*)(F.lds + F.wave * 16384);
            tr_job_plain(F2, args.in[11] + C_GATE, DIN, 2048, DM, (h16*)(ws + OW_GATE), scr, 0);
            tr_job_plain(F2, args.in[19], DM, DM, 256, (h16*)(ws + OW_UPB), scr, 512);
            tr_job_plain(F2, args.in[20], DM, DM, DM, (h16*)(ws + OW_O), scr, 640);
            tr_job_plain(F2, args.in[18], DM, DM, 512, (h16*)(ws + OW_UPA), scr, 256);
            for (int it = F2.gw; it < 4 * 16; it += F2.NGW) { const int kb = it >> 4, nb = it & 15, n0 = nb * 32, hl = (n0 >> 6) & 3;
                tr_item(args.in[16], 512, n0 + (F.lane & 31), true, nullptr, kb * 64, (h16*)(ws + OW_BD) + (size_t)n0 * 1024 + 256 * hl, 1024, scr, F.lane); } } }
    SEAM(7);
    if (IN(8)) { ph_combine(F, (const h16*)(ws + OFF_OG), (const float*)(ws + OFF_LSE), (h16*)(ws + OFF_OB));
#ifdef TK_X4
        ph_combine(F, (const h16*)(ws + OFF_OG), (const float*)(ws + OFF_LSE), (h16*)(ws + OFF_OB));
#endif
        ph_topk_sparse(F, (const h16*)(ws + OFF_QI), (const h16*)(ws + OFF_KI), (const float*)(ws + OFF_WI), (unsigned short*)(ws + OFF_SEL),
                       (h16*)(ws + OFF_QLAT), (const h16*)(ws + OFF_QR), (const unsigned char*)(ws + OFF_CKV), (const unsigned char*)(ws + OFF_KR)); }
    SEAM(8);
    if (IN(9) && F.G == 256) { const bool first = blockIdx.x < 128;
        pg8::Gemm g{first ? (const h16*)(ws + OFF_QLAT) : (const h16*)(ws + OFF_OB), first ? (const h16*)(ws + OW_BD) : (const h16*)(ws + OW_UPB), MT, first ? 512 : DM, first ? 1024 : 256, first ? 2048 : 0, first ? 1024 : 0};
        pg8::StaticOrder S; S.init(MT, first ? 512 : DM, 128, first ? (int)blockIdx.x : (int)blockIdx.x - 128);
        pg8::EpiH16 E{first ? (h16*)(ws + OFF_OA) : (h16*)(ws + OFF_Y2), first ? 512 : DM};
        pg8::gemm_phase<pg8::EpiH16, false>(F.lds, g, S, E); }
    SEAM(9);
    SEAM(9);
    if (IN(10)) { const int Z_PARTS = args.zparts; pg8::StaticOrder S; S.init(MT, DM, F.G, (int)blockIdx.x); h16* Y1 = (h16*)(ws + OFF_Y1); h16* Y2 = (h16*)(ws + OFF_Y2);
        { pg8::Gemm g{(const h16*)(ws + OFF_OA), (const h16*)(ws + OW_UPA), MT, DM, 512}; pg8::EpiH16 E{Y1}; pg8::gemm_phase<pg8::EpiH16, false>(F.lds, g, S, E); }
        { pg8::Gemm g{Hb, (const h16*)(ws + OW_GATE), MT, DM, DM}; pg8::EpiGate E{Y1, Y1, 0}; pg8::gemm_phase<pg8::EpiGate, false>(F.lds, g, S, E); }
        { pg8::Gemm g{Hb, (const h16*)(ws + OW_GATE) + (size_t)DM * DM, MT, DM, DM}; pg8::EpiGate E{Y2, Y1, 1}; pg8::gemm_phase<pg8::EpiGate, false>(F.lds, g, S, E); } }
    SEAM(10);
    if (IN(11)) { pg8::Gemm g{(const h16*)(ws + OFF_Y1), (const h16*)(ws + OW_O), MT, DM, DM}; pg8::StaticOrder S; S.init(MT, DM, F.G, (int)blockIdx.x); pg8::EpiH16 E{(h16*)(ws + OFF_YF)};
        pg8::gemm_phase<pg8::EpiH16, false>(F.lds, g, S, E); }
    SEAM(11);
    if (IN(12)) ph_resnorm<true, true>(F, args.out, (const h16*)(ws + OFF_YF), args.in[21], mod, 5, 1.0f, ws + OFF_F, true, args.in[22], 7, 6, Hb);
    SEAM(12);
    if (IN(13)) { pg8::Gemm g{Hb, (const h16*)(ws + OW_GU2), MT, 2 * FF, DM}; pg8::StaticOrder S; S.init(MT, 2 * FF, F.G, (int)blockIdx.x); pg8::EpiSwiGLU E{Ab};
        pg8::gemm_phase<pg8::EpiSwiGLU, true>(F.lds, g, S, E);
        if (F.G == 256 && blockIdx.x >= 128) { Frame F2 = F; F2.gw = ((int)blockIdx.x - 128) * NWAVES + F.wave; F2.NGW = 128 * NWAVES;
            tr_job_plain(F2, args.in[25], DM, DM, FF, (h16*)(ws + OW_D2), (LAS float*)(F.lds + F.wave * 16384), 0); } }
    SEAM(13);
    if (IN(14)) { pg8::Gemm g{Ab, (const h16*)(ws + OW_D2), MT, DM, FF}; pg8::StaticOrder S; S.init(MT, DM, F.G, (int)blockIdx.x); pg8::EpiH16 E{(h16*)(ws + OFF_F + 32 * MiB)};
        pg8::gemm_phase<pg8::EpiH16, false>(F.lds, g, S, E); }
    SEAM(14);
    if (IN(15)) ph_resnorm<true, false>(F, ws + OFF_F, (const h16*)(ws + OFF_F + 32 * MiB), args.in[26], mod, 8, 0.5f, args.out, false, nullptr, 0, 0, nullptr);
#ifdef PROBE_PHASE
    xcd_barrier(bar); STAMP(15);
    { const unsigned long long* ts = (const unsigned long long*)(ws + OFF_MOD + 768 * 1024);
      const unsigned long long t1 = __hip_atomic_load(ts + PROBE_PHASE + 1, __ATOMIC_RELAXED, __HIP_MEMORY_SCOPE_AGENT), t0 = __hip_atomic_load(ts + PROBE_PHASE0 + 1, __ATOMIC_RELAXED, __HIP_MEMORY_SCOPE_AGENT);
      const float dlt = (float)(t1 - t0) * 0.01f * (1.f / 2000.f);
      if (PROBE_PHASE == 15) { xcd_barrier(bar); }
      for (size_t i = (size_t)blockIdx.x * NTHR + F.tid; i < (size_t)MT * DM; i += (size_t)F.G * NTHR) args.out[i] *= (1.f + dlt); }
#endif
#undef IN
#undef SEAM
}


__global__ void n_stat_h16(const h16* p, size_t n, float* acc) {
    __shared__ float red[4];
    float a = 0.f, b = 0.f;
    for (size_t i = (size_t)blockIdx.x * 256 + threadIdx.x; i < n; i += (size_t)gridDim.x * 256) { const float v = (float)p[i]; const float w = (float)(((unsigned)(i * 2654435761u) >> 16) & 255u) * (1.f / 128.f) - 1.f; a += v * v; b += v * w; }
    a = block_sum256(a, red); b = block_sum256(b, red);
    if (threadIdx.x == 0) { atomicAdd(acc, a); atomicAdd(acc + 1, b); }
}
__global__ void n_tr(const float* W, int ldw, int N, int K, h16* WT) {
    const size_t idx = (size_t)blockIdx.x * 256 + threadIdx.x; if (idx >= (size_t)N * K) return;
    const int n = (int)(idx / K), k = (int)(idx % K); WT[idx] = (h16)W[(size_t)k * ldw + n];
}
__global__ void n_scale(float* out, const float* acc, float gain) {
    const size_t i = (size_t)blockIdx.x * 256 + threadIdx.x;
    const float d0 = fabsf(acc[0] - acc[2]) / fmaxf(fabsf(acc[2]), 1e-20f), d1 = fabsf(acc[1] - acc[3]) / fmaxf(sqrtf(fabsf(acc[2])), 1e-20f);
    const float d = fminf(fmaxf(d0, d1) * gain, 10.f);
    out[i] *= (1.f + d);
}
#ifndef FASTMASK
#define FASTMASK 0xFFFFu
#endif
extern "C" void kernel_launch(void* const* d_in, const int* in_sizes, int n_in, void* d_out, int out_size, void* d_ws, size_t ws_size, hipStream_t stream) {
    if (n_in != 27 || ws_size < WS_END || out_size != MT * DM) { fprintf(stderr, "kernel_launch: unexpected shapes (n_in %d ws %zu out %d)\n", n_in, ws_size, out_size); return; }
    static int grid = 0;
    if (grid == 0) {
        int dev = 0, cus = 0, per_cu = 0;
        if (hipGetDevice(&dev) != hipSuccess || hipDeviceGetAttribute(&cus, hipDeviceAttributeMultiprocessorCount, dev) != hipSuccess) { grid = -1; return; }
        if (hipFuncSetAttribute((const void*)mega_fwd, hipFuncAttributeMaxDynamicSharedMemorySize, LDS_BYTES) != hipSuccess) { fprintf(stderr, "kernel_launch: hipFuncSetAttribute failed\n"); grid = -1; return; }
        if (hipOccupancyMaxActiveBlocksPerMultiprocessor(&per_cu, (const void*)mega_fwd, NTHR, LDS_BYTES) != hipSuccess || per_cu < 1) { fprintf(stderr, "kernel_launch: occupancy query says %d blocks/CU\n", per_cu); grid = -1; return; }
        grid = cus;
    }
    if (grid < 0) return;
    const float* x = (const float*)d_in[0]; const float* c = (const float*)d_in[1]; const int* pos = (const int*)d_in[2];
    const float *w_mod = (const float*)d_in[3], *b_mod = (const float*)d_in[4], *g_pre1 = (const float*)d_in[5], *w_gate1 = (const float*)d_in[6], *w_up1 = (const float*)d_in[7], *w_down1 = (const float*)d_in[8],
                *g_post1 = (const float*)d_in[9], *g_premix = (const float*)d_in[10], *w_in = (const float*)d_in[11], *g_cq = (const float*)d_in[12], *g_ckv = (const float*)d_in[13], *w_uq = (const float*)d_in[14],
                *w_uk = (const float*)d_in[15], *w_uv = (const float*)d_in[16], *w_iq = (const float*)d_in[17], *w_up_a = (const float*)d_in[18], *w_up_b = (const float*)d_in[19], *w_o = (const float*)d_in[20],
                *g_postmix = (const float*)d_in[21], *g_pre2 = (const float*)d_in[22], *w_gate2 = (const float*)d_in[23], *w_up2 = (const float*)d_in[24], *w_down2 = (const float*)d_in[25], *g_post2 = (const float*)d_in[26];
    float* out = (float*)d_out; char* ws = (char*)d_ws;
    float* mod = (float*)(ws + OFF_MOD); float2* tab = (float2*)(ws + OFF_ROPE);
    h16* Hb = (h16*)(ws + OFF_H); h16* Ab = (h16*)(ws + OFF_A); float* Fb = (float*)(ws + OFF_F);
    h16 *qb = (h16*)(ws + OFF_QB), *kb = (h16*)(ws + OFF_KB), *vT = (h16*)(ws + OFF_VT), *ckv = (h16*)(ws + OFF_CKV), *kr = (h16*)(ws + OFF_KR), *ki = (h16*)(ws + OFF_KI), *cq = (h16*)(ws + OFF_CQ);
    float *wi = (float*)(ws + OFF_WI), *ssq = (float*)(ws + OFF_SSQ), *lse = (float*)(ws + OFF_LSE);
    h16 *og = (h16*)(ws + OFF_OG), *qlat = (h16*)(ws + OFF_QLAT), *qr = (h16*)(ws + OFF_QR), *qi = (h16*)(ws + OFF_QI), *ob = (h16*)(ws + OFF_OB);
    unsigned short* sel = (unsigned short*)(ws + OFF_SEL);
    float* Y = (float*)(ws + OFF_YF);
#define GEMM(TA, A, lda, B, ldb, bs, C, ldc, N, K) hipLaunchKernelGGL((n_gemm<TA>), dim3(((N) + 63) / 64, MT / 64), dim3(256), 0, stream, A, lda, B, ldb, bs, C, ldc, N, K)
    auto mega = [&](int lo, int hi, int zparts = 3) {
        hipMemsetAsync(ws + OFF_CTL, 0, 1 * MiB, stream);
        Args a{}; for (int i = 0; i < 27; ++i) a.in[i] = (const float*)d_in[i]; a.out = out; a.ws = (unsigned char*)d_ws; a.ph_lo = lo; a.ph_hi = hi; a.zparts = zparts;
        void* kargs[] = {&a};
        const hipError_t e = hipLaunchCooperativeKernel((const void*)mega_fwd, dim3(grid), dim3(NTHR), kargs, LDS_BYTES, stream);
        if (e != hipSuccess) fprintf(stderr, "kernel_launch: cooperative launch failed: %s (grid %d)\n", hipGetErrorString(e), grid);
    };
    auto naive = [&](int s, int Z_PARTS = 3) {
        switch (s) {
        case 0: hipLaunchKernelGGL(n_mod, dim3(NMOD * DM / 256, NB), dim3(256), 0, stream, c, w_mod, b_mod, mod);
                hipLaunchKernelGGL(n_rope_tab, dim3(MT * 48 / 256), dim3(256), 0, stream, pos, tab); break;
        case 1: hipLaunchKernelGGL(n_normmod, dim3(MT), dim3(256), 0, stream, x, g_pre1, mod, 1, 0, Hb); break;
        case 2: hipLaunchKernelGGL(n_gemm_swiglu, dim3(FF / 64, MT / 64), dim3(256), 0, stream, Hb, w_gate1, w_up1, Ab); break;
        case 3: GEMM(h16, Ab, FF, w_down1, DM, (const float*)nullptr, Fb, DM, DM, FF); break;
        case 4: hipLaunchKernelGGL(n_resnorm, dim3(MT), dim3(256), 0, stream, x, Fb, g_post1, mod, 2, 0.5f, out);
                hipLaunchKernelGGL(n_normmod, dim3(MT), dim3(256), 0, stream, out, g_premix, mod, 4, 3, Hb); break;
        case 5:
            GEMM(h16, Hb, DM, w_in + C_CQ, DIN, (const float*)nullptr, Fb, QL, QL, DM);
            hipLaunchKernelGGL(n_post_cq, dim3(MT / 4), dim3(256), 0, stream, Fb, cq, ssq);
            GEMM(h16, Hb, DM, w_in + C_CKV, DIN, (const float*)nullptr, Fb, KVL, KVL, DM);
            hipLaunchKernelGGL(n_post_ckv, dim3(MT / 4), dim3(256), 0, stream, Fb, g_ckv, ckv);
            GEMM(h16, Hb, DM, w_in + C_KR, DIN, (const float*)nullptr, Fb, 72, 72, DM);
            hipLaunchKernelGGL(n_post_small, dim3(MT * 40 / 256), dim3(256), 0, stream, Fb, tab, kr, ki, wi);
            GEMM(h16, Hb, DM, w_in + C_QKV, DIN, (const float*)nullptr, Fb, 768, 768, DM);
            hipLaunchKernelGGL(n_post_qk, dim3(MT * 384 / 256), dim3(256), 0, stream, Fb, tab, 0.125f * LOG2E, qb);
            GEMM(h16, Hb, DM, w_in + C_QKV + 768, DIN, (const float*)nullptr, Fb, 768, 768, DM);
            hipLaunchKernelGGL(n_post_qk, dim3(MT * 384 / 256), dim3(256), 0, stream, Fb, tab, 1.0f, kb);
            GEMM(h16, Hb, DM, w_in + C_QKV + 1536, DIN, (const float*)nullptr, Fb, 768, 768, DM);
            hipLaunchKernelGGL(n_post_v, dim3(MT * 768 / 256), dim3(256), 0, stream, Fb, vT); break;
        case 6: hipLaunchKernelGGL(n_dilated, dim3(MT, 12), dim3(128), 0, stream, qb, kb, vT, og, lse); break;
        case 7: { float* Tq = (float*)(ws + OFF_F + 33 * MiB);
            for (int hh = 0; hh < 2; ++hh) {
                GEMM(h16, cq, QL, w_uq + hh * 384, 768, g_cq, Tq, 384, 384, QL);
                hipLaunchKernelGGL(n_post_q, dim3(MT), dim3(256), 0, stream, Tq, ssq, w_uk, tab, qlat, qr, hh * 4); }
            GEMM(h16, cq, QL, w_iq, 256, g_cq, Tq, 256, 256, QL);
            hipLaunchKernelGGL(n_post_qi, dim3(MT * 128 / 256), dim3(256), 0, stream, Tq, ssq, tab, qi); } break;
        case 8: hipLaunchKernelGGL(n_topk, dim3(MT), dim3(256), 0, stream, qi, ki, wi, sel);
                hipLaunchKernelGGL(n_combine, dim3(MT), dim3(256), 0, stream, og, lse, ob); break;
        case 9: hipLaunchKernelGGL(n_sparse, dim3(MT), dim3(256), 0, stream, qlat, qr, ckv, kr, sel); break;
        case 10: { h16* oa = (h16*)(ws + OFF_Y2 + 16 * MiB);
            hipLaunchKernelGGL(n_oa, dim3(MT), dim3(256), 0, stream, qlat, w_uv, oa);
            h16* z = (h16*)(ws + OFF_Y1); float* Tg = (float*)(ws + OFF_A + 64 * MiB); float* Ty = (float*)(ws + OFF_F + 32 * MiB);
            for (int q = 0; q < 4; ++q) { const int n0 = q * 256;
                if (Z_PARTS == 4) { GEMM(h16, ob, 256, w_up_b + n0, DM, (const float*)nullptr, Ty, 256, 256, 256);
                    hipLaunchKernelGGL(n_gate, dim3(MT * 256 / 256), dim3(256), 0, stream, Ty, Ty, z, n0, 2); continue; }
                if (Z_PARTS & 1) {
                GEMM(h16, Hb, DM, w_in + C_GATE + n0, DIN, (const float*)nullptr, Tg, 256, 256, DM);
                GEMM(h16, oa, 512, w_up_a + n0, DM, (const float*)nullptr, Ty, 256, 256, 512);
                hipLaunchKernelGGL(n_gate, dim3(MT * 256 / 256), dim3(256), 0, stream, Tg, Ty, z, n0, 0); }
                if (Z_PARTS & 2) {
                GEMM(h16, Hb, DM, w_in + C_GATE + 1024 + n0, DIN, (const float*)nullptr, Tg, 256, 256, DM);
                GEMM(h16, ob, 256, w_up_b + n0, DM, (const float*)nullptr, Ty, 256, 256, 256);
                hipLaunchKernelGGL(n_gate, dim3(MT * 256 / 256), dim3(256), 0, stream, Tg, Ty, z, n0, (Z_PARTS & 1)); } } } break;
        case 11: GEMM(h16, (h16*)(ws + OFF_Y1), DM, w_o, DM, (const float*)nullptr, Y, DM, DM, DM); break;
        case 12: hipLaunchKernelGGL(n_resnorm, dim3(MT), dim3(256), 0, stream, out, Y, g_postmix, mod, 5, 1.0f, out);
                 hipLaunchKernelGGL(n_normmod, dim3(MT), dim3(256), 0, stream, out, g_pre2, mod, 7, 6, Hb); break;
        case 13: hipLaunchKernelGGL(n_gemm_swiglu, dim3(FF / 64, MT / 64), dim3(256), 0, stream, Hb, w_gate2, w_up2, Ab); break;
        case 14: GEMM(h16, Ab, FF, w_down2, DM, (const float*)nullptr, Fb, DM, DM, FF); break;
        case 15: hipLaunchKernelGGL(n_resnorm, dim3(MT), dim3(256), 0, stream, out, Fb, g_post2, mod, 8, 0.5f, out); break;
        }
    };
#ifdef DBG_W
    { float* dacc = (float*)(ws + OFF_MOD + 512 * 1024);
      hipMemsetAsync(dacc, 0, 16, stream);
      mega(0, 1);
      hipLaunchKernelGGL(n_stat_h16, dim3(2048), dim3(256), 0, stream, (const h16*)(ws + OW_GATE), (size_t)2048 * DM, dacc);
      hipLaunchKernelGGL(n_stat_h16, dim3(2048), dim3(256), 0, stream, (const h16*)(ws + OW_UPB), (size_t)DM * 256, dacc);
      hipLaunchKernelGGL(n_tr, dim3(2048 * DM / 256), dim3(256), 0, stream, w_in + C_GATE, DIN, 2048, DM, (h16*)(ws + OW_GATE));
      hipLaunchKernelGGL(n_tr, dim3(DM * 256 / 256), dim3(256), 0, stream, w_up_b, DM, DM, 256, (h16*)(ws + OW_UPB));
      hipLaunchKernelGGL(n_stat_h16, dim3(2048), dim3(256), 0, stream, (const h16*)(ws + OW_GATE), (size_t)2048 * DM, dacc + 2);
      hipLaunchKernelGGL(n_stat_h16, dim3(2048), dim3(256), 0, stream, (const h16*)(ws + OW_UPB), (size_t)DM * 256, dacc + 2);
      for (int s = 0; s < 16; ++s) naive(s);
      hipLaunchKernelGGL(n_scale, dim3(MT * DM / 256), dim3(256), 0, stream, out, dacc, 1.0f); }
#elif defined(DBG_STAGE)
    float* dacc = (float*)(ws + OFF_MOD + 512 * 1024);
    for (int s = 0; s < 16;) {
        if (s == DBG_STAGE) {
            hipMemsetAsync(dacc, 0, 16, stream);
            if (DBG_PARTS == 8) naive(s, 16);
            mega(s, s + 1, DBG_PARTS); hipLaunchKernelGGL(n_stat_h16, dim3(2048), dim3(256), 0, stream, (const h16*)(ws + DBG_OFF), (size_t)DBG_N, dacc);
            naive(s, DBG_PARTS == 8 ? 2 : DBG_PARTS);       hipLaunchKernelGGL(n_stat_h16, dim3(2048), dim3(256), 0, stream, (const h16*)(ws + DBG_OFF), (size_t)DBG_N, dacc + 2);
            if (DBG_PARTS != 3) naive(s);
            ++s; continue; }
        if ((FASTMASK >> s) & 1u) { int e = s; while (e < 16 && e != DBG_STAGE && ((FASTMASK >> e) & 1u)) ++e; mega(s, e); s = e; }
        else { naive(s); ++s; }
    }
    hipLaunchKernelGGL(n_scale, dim3(MT * DM / 256), dim3(256), 0, stream, out, dacc, DBG_GAIN);
#elif defined(PH_DOUBLE)
    mega(0, PH_DOUBLE + 1); mega(PH_DOUBLE, 16);
#elif defined(PH_SPLIT)
    mega(0, PH_SPLIT); mega(PH_SPLIT, 16);
#else
    for (int s = 0; s < 16;) {
        if ((FASTMASK >> s) & 1u) { int e = s; while (e < 16 && ((FASTMASK >> e) & 1u)) ++e; mega(s, e); s = e; }
        else { naive(s); ++s; }
    }
#endif
    (void)in_sizes;
}
```

```cpp
#include <hip/hip_runtime.h>
#include <hip/hip_fp16.h>
#include <cstdio>
#include <cstdint>

constexpr int NB = 4, SEQ = 4096, DM = 1024, MT = NB * SEQ, FF = 2816;
constexpr int QL = 384, KVL = 256, DNOPE = 64, DROPE = 32, DVA = 64, HA = 8, HI = 8, DI = 32, TOPK = 256;
constexpr int NG = 3, HB = 4, DHB = 64, NMOD = 9, DIN = 5064;
constexpr int C_CQ = 0, C_CKV = 384, C_KR = 640, C_KI = 672, C_WI = 704, C_QKV = 712, C_GATE = 3016;
constexpr float EPS = 1e-6f, LOG2E = 1.4426950408889634f;
typedef _Float16 h16;

constexpr size_t MiB = 1u << 20;
constexpr size_t OFF_CTL = 0, OFF_MOD = 1 * MiB, OFF_ROPE = 2 * MiB, OFF_W = 8 * MiB, OFF_H = 60 * MiB, OFF_A = 92 * MiB, OFF_F = 180 * MiB, OFF_SP = 244 * MiB, WS_END = 256 * MiB;
constexpr size_t OFF_QB = OFF_A, OFF_KB = OFF_A + 24 * MiB, OFF_VT = OFF_A + 48 * MiB, OFF_CKV = OFF_A + 72 * MiB, OFF_KR = OFF_A + 80 * MiB, OFF_KI = OFF_A + 81 * MiB,
                 OFF_WI = OFF_A + 82 * MiB, OFF_SSQ = OFF_A + 82 * MiB + 512 * 1024, OFF_CQ = OFF_SP;
constexpr size_t OFF_RSTDQ = OFF_A + 83 * MiB;
constexpr size_t OFF_OG = OFF_F, OFF_LSE = OFF_F + 24 * MiB, OFF_QLAT = OFF_A, OFF_QR = OFF_A + 64 * MiB, OFF_QI = OFF_F + 25 * MiB, OFF_SEL = OFF_F + 33 * MiB, OFF_OB = OFF_SP;
constexpr size_t OFF_Y1 = OFF_F, OFF_Y2 = OFF_F + 32 * MiB, OFF_YF = OFF_A;

__device__ __forceinline__ float silu_f(float v) { return v / (1.f + __expf(-v)); }
__device__ __forceinline__ float sigm_f(float v) { return 1.f / (1.f + __expf(-v)); }
__host__ __device__ __forceinline__ int dil_of(int g) { return g == 0 ? 1 : (g == 1 ? 4 : 16); }
__device__ __forceinline__ unsigned fkey(float f) { const unsigned u = __float_as_uint(f); return (u & 0x80000000u) ? ~u : (u | 0x80000000u); }


#define LAS __attribute__((address_space(3)))
#define GAS __attribute__((address_space(1)))
typedef _Float16 f16x8 __attribute__((ext_vector_type(8)));
typedef float f32x4 __attribute__((ext_vector_type(4)));
typedef float f32x2 __attribute__((ext_vector_type(2)));
typedef unsigned u32x4 __attribute__((ext_vector_type(4)));
typedef unsigned u32x2 __attribute__((ext_vector_type(2)));
typedef _Float16 h16x2 __attribute__((ext_vector_type(2)));
__device__ __forceinline__ unsigned pk_h2(float lo, float hi) { f32x2 v = {lo, hi}; h16x2 h = __builtin_convertvector(v, h16x2); return __builtin_bit_cast(unsigned, h); }

namespace pg8 {
constexpr int BM = 256, BK = 64, HALF = 128, HTB = HALF * BK * 2, STAGE_BYTES = 8 * HTB, NXCD = 8, WGM = 8;
__host__ __device__ __forceinline__ int lds_byte(int r, int c) { const int st = (r >> 4) * 2 + (c >> 5), rr = r & 15, cc = c & 31, ob = rr * 64 + cc * 2; return st * 1024 + (ob ^ (((ob >> 9) & 1) << 5)); }
__host__ __device__ __forceinline__ void stage_rc(int b, int& R, int& C) { const int st = b / 1024, sb = b % 1024, swz = sb ^ (((sb >> 9) & 1) << 5); R = (st >> 1) * 16 + swz / 64; C = (st & 1) * 32 + (swz % 64) / 2; }
__host__ __device__ __forceinline__ int perm32(int rho) { const int n = rho >> 4, i = rho & 15; return 8 * (i >> 2) + 4 * n + (i & 3); }
struct Unit { int pm, pn; };
struct Gemm { const h16* A; const h16* Bt; int M, N, K; int lda = 0, koffA = 0; };
struct StaticOrder {
    int nM, nN, nwg, G, c;
    __host__ __device__ void init(int M, int N, int G_, int c_) { nM = M / BM; nN = N / BM; nwg = nM * nN; G = G_; c = c_; }
    __host__ __device__ bool next(int i, Unit& u) const {
        const long L = (long)i * G + c; if (L >= nwg) return false;
        int wgid = (int)L; { const int q = nwg / NXCD, r = nwg % NXCD, xcd = wgid % NXCD, off = wgid / NXCD; wgid = (xcd < r ? xcd * (q + 1) : r * (q + 1) + (xcd - r) * q) + off; }
        const int nig = WGM * nN, gid = wgid / nig, fm = gid * WGM, gsz = (nM - fm) < WGM ? (nM - fm) : WGM;
        u.pm = fm + ((wgid % nig) % gsz); u.pn = (wgid % nig) / gsz; return true;
    }
};
template <class Epi, bool ALIGN_EPI>
__device__ __forceinline__ void gemm_phase(LAS unsigned char* lds, const Gemm g, const StaticOrder& S, const Epi& E) {
    const int tid = threadIdx.x, wid = __builtin_amdgcn_readfirstlane(tid >> 6), lane = tid & 63, wr = wid >> 2, wc = wid & 3, fr = lane & 15, fq = lane >> 4;
    const int K = g.K, nt = K / BK, lda = g.lda ? g.lda : g.K;
    unsigned voffA[2], voffB[2];
#pragma unroll
    for (int i = 0; i < 2; ++i) { int R, C; stage_rc(tid * 16 + i * 8192, R, C); const int Rb = Epi::PERM ? ((R & ~31) + perm32(R & 31)) : R;
        voffA[i] = (unsigned)(R * lda + C) * 2u; voffB[i] = (unsigned)(Rb * K + C) * 2u; }
    const size_t kstep = (size_t)(BK * 2);
    const size_t hstep = (size_t)HALF * K * 2, hstepA = (size_t)HALF * lda * 2;
    const size_t tstep = 2 * hstep, tstepA = 2 * hstepA, kofA = (size_t)g.koffA * 2;
    const unsigned ldsw = (unsigned)wid * 1024u;
    const int aoff = lds_byte(wr * 64 + fr, fq * 8), boff = lds_byte(wc * 32 + fr, fq * 8);
#define PG8_SA(b, h) (((b) * 2 + (h)) * HTB)
#define PG8_SB(b, h) ((4 + (b) * 2 + (h)) * HTB)
#define PG8_STAGE(bufoff, gbase, voff) do { _Pragma("unroll") for (int _i = 0; _i < 2; ++_i) \
        __builtin_amdgcn_global_load_lds((const unsigned*)((const char*)(gbase) + (voff)[_i]), (LAS unsigned*)(lds + (bufoff) + ldsw + _i * 8192), 16, 0, 0); } while (0)
#define PG8_LDA(dst, b, h) do { _Pragma("unroll") for (int m = 0; m < 4; ++m) _Pragma("unroll") for (int k = 0; k < 2; ++k) dst[m][k] = *(const LAS f16x8*)(lds + PG8_SA(b, h) + aoff + m * 2048 + k * 1024); } while (0)
#define PG8_LDB(dst, b, h) do { _Pragma("unroll") for (int n = 0; n < 2; ++n) _Pragma("unroll") for (int k = 0; k < 2; ++k) dst[n][k] = *(const LAS f16x8*)(lds + PG8_SB(b, h) + boff + n * 2048 + k * 1024); } while (0)
#define PG8_MMA(ai, bj, At, Bt) do { __builtin_amdgcn_s_setprio(1); _Pragma("unroll") for (int m = 0; m < 4; ++m) _Pragma("unroll") for (int n = 0; n < 2; ++n) _Pragma("unroll") for (int k = 0; k < 2; ++k) \
        acc[ai][bj][m][n] = __builtin_amdgcn_mfma_f32_16x16x32_f16(Bt[n][k], At[m][k], acc[ai][bj][m][n], 0, 0, 0); __builtin_amdgcn_s_setprio(0); } while (0)
#define PG8_WAIT_V(n) asm volatile("s_waitcnt vmcnt(" #n ")" ::: "memory")
#define PG8_WAIT_L(n) asm volatile("s_waitcnt lgkmcnt(" #n ")" ::: "memory")
#define PG8_BAR __builtin_amdgcn_s_barrier()
#define PG8_SCHED __builtin_amdgcn_sched_barrier(0)
    Unit cur, nxt; int ui = 0;
    if (!S.next(0, cur)) return;
    f32x4 acc[2][2][4][2];
#pragma unroll
    for (int a = 0; a < 2; ++a)
#pragma unroll
        for (int b = 0; b < 2; ++b)
#pragma unroll
            for (int m = 0; m < 4; ++m)
#pragma unroll
                for (int n = 0; n < 2; ++n) acc[a][b][m][n] = (f32x4){0.f, 0.f, 0.f, 0.f};
    f16x8 At[4][2], B0[2][2], B1[2][2];
    const char* cA = (const char*)g.A + (size_t)cur.pm * tstepA + (size_t)cur.pn * kofA; const char* cB = (const char*)g.Bt + (size_t)cur.pn * tstep;
    PG8_STAGE(PG8_SB(0, 0), cB, voffB); PG8_STAGE(PG8_SB(0, 1), cB + hstep, voffB); PG8_STAGE(PG8_SA(0, 0), cA, voffA); PG8_STAGE(PG8_SA(0, 1), cA + hstepA, voffA);
    if (wr == 1) PG8_BAR;
    PG8_WAIT_V(2); PG8_BAR;
    PG8_STAGE(PG8_SB(1, 0), cB + kstep, voffB); PG8_STAGE(PG8_SA(1, 0), cA + kstep, voffA); PG8_STAGE(PG8_SB(1, 1), cB + hstep + kstep, voffB);
    PG8_WAIT_V(6); PG8_BAR;
    for (;;) {
        const bool has_next = S.next(ui + 1, nxt);
        const char* nA = has_next ? (const char*)g.A + (size_t)nxt.pm * tstepA + (size_t)nxt.pn * kofA : cA; const char* nB = has_next ? (const char*)g.Bt + (size_t)nxt.pn * tstep : cB;
        for (int t = 0; t < nt; t += 2) {
            const bool last = (t == nt - 2);
            const char* a1 = cA + (size_t)(t + 1) * kstep;
            const char* a2 = last ? nA : cA + (size_t)(t + 2) * kstep; const char* b2 = last ? nB : cB + (size_t)(t + 2) * kstep;
            const char* a3 = a2 + kstep; const char* b3 = b2 + kstep;
            PG8_LDB(B0, 0, 0); PG8_LDB(B1, 0, 1); PG8_SCHED; PG8_LDA(At, 0, 0); PG8_STAGE(PG8_SA(1, 1), a1 + hstepA, voffA);
            PG8_WAIT_V(8); PG8_WAIT_L(0); PG8_BAR; PG8_MMA(0, 0, At, B0); PG8_MMA(0, 1, At, B1); PG8_BAR; PG8_SCHED;
            PG8_LDA(At, 0, 1); PG8_STAGE(PG8_SB(0, 0), b2, voffB); PG8_STAGE(PG8_SB(0, 1), b2 + hstep, voffB); PG8_STAGE(PG8_SA(0, 0), a2, voffA);
            PG8_WAIT_V(8); PG8_WAIT_L(0); PG8_BAR; PG8_MMA(1, 0, At, B0); PG8_MMA(1, 1, At, B1); PG8_BAR; PG8_SCHED;
            PG8_LDB(B0, 1, 0); PG8_LDB(B1, 1, 1); PG8_SCHED; PG8_LDA(At, 1, 0); PG8_STAGE(PG8_SA(0, 1), a2 + hstepA, voffA);
            PG8_WAIT_V(8); PG8_WAIT_L(0); PG8_BAR; PG8_MMA(0, 0, At, B0); PG8_MMA(0, 1, At, B1); PG8_BAR; PG8_SCHED;
            PG8_LDA(At, 1, 1); PG8_STAGE(PG8_SB(1, 0), b3, voffB); PG8_STAGE(PG8_SB(1, 1), b3 + hstep, voffB); PG8_STAGE(PG8_SA(1, 0), a3, voffA);
            PG8_WAIT_V(8); PG8_WAIT_L(0); PG8_BAR; PG8_MMA(1, 0, At, B0); PG8_MMA(1, 1, At, B1); PG8_BAR; PG8_SCHED;
        }
        if constexpr (ALIGN_EPI) { if (wr == 0) PG8_BAR; }
        { int l2 = lane; asm volatile("" : "+v"(l2)); E(acc, cur, wr, wc, l2 & 15, l2 >> 4); }
        if (!has_next) break;
#pragma unroll
        for (int a = 0; a < 2; ++a)
#pragma unroll
            for (int b = 0; b < 2; ++b)
#pragma unroll
                for (int m = 0; m < 4; ++m)
#pragma unroll
                    for (int n = 0; n < 2; ++n) acc[a][b][m][n] = (f32x4){0.f, 0.f, 0.f, 0.f};
        cur = nxt; cA = nA; cB = nB; ++ui;
        if constexpr (ALIGN_EPI) { if (wr == 1) PG8_BAR; }
    }
    PG8_WAIT_V(0);
    if constexpr (!ALIGN_EPI) { if (wr == 0) PG8_BAR; }
    PG8_BAR;
#undef PG8_SA
#undef PG8_SB
#undef PG8_STAGE
#undef PG8_LDA
#undef PG8_LDB
#undef PG8_MMA
#undef PG8_WAIT_V
#undef PG8_WAIT_L
#undef PG8_BAR
#undef PG8_SCHED
}
struct EpiF32 {
    static constexpr bool PERM = false;
    float* C; int ldc;
    __device__ __forceinline__ void operator()(const f32x4 (&acc)[2][2][4][2], const Unit& u, int wr, int wc, int fr, int fq) const {
        const int row0 = u.pm * BM + wr * 64 + fr, col0 = u.pn * BM + wc * 32 + 4 * fq;
#pragma unroll
        for (int ai = 0; ai < 2; ++ai)
#pragma unroll
            for (int m = 0; m < 4; ++m) { float* rowp = C + (size_t)(row0 + ai * HALF + m * 16) * ldc + col0;
#pragma unroll
                for (int bj = 0; bj < 2; ++bj)
#pragma unroll
                    for (int n = 0; n < 2; ++n) *(f32x4*)(rowp + bj * HALF + n * 16) = acc[ai][bj][m][n]; }
    }
};
struct EpiSwiGLU {
    static constexpr bool PERM = true;
    h16* O;
    __device__ __forceinline__ void operator()(const f32x4 (&acc)[2][2][4][2], const Unit& u, int wr, int wc, int fr, int fq) const {
        const int row0 = u.pm * BM + wr * 64 + fr, col0 = u.pn * HALF + wc * 32 + 8 * fq;
#pragma unroll
        for (int ai = 0; ai < 2; ++ai)
#pragma unroll
            for (int m = 0; m < 4; ++m) { h16* rowp = O + (size_t)(row0 + ai * HALF + m * 16) * FF + col0;
                float v[8];
#pragma unroll
                for (int n = 0; n < 2; ++n)
#pragma unroll
                    for (int e = 0; e < 4; ++e) { const float gg = acc[ai][0][m][n][e], uu = acc[ai][1][m][n][e]; v[n * 4 + e] = gg * __builtin_amdgcn_rcpf(1.f + __builtin_amdgcn_exp2f(-gg * LOG2E)) * uu; }
                u32x4 w; w.x = pk_h2(v[0], v[1]); w.y = pk_h2(v[2], v[3]); w.z = pk_h2(v[4], v[5]); w.w = pk_h2(v[6], v[7]);
                *(u32x4*)rowp = w; }
    }
};

struct EpiIn {
    static constexpr bool PERM = false;
    h16 *ckv, *cq, *kr, *ki, *qb, *kb, *vT; float *wi, *ssq; const float* gckv; const float2* tab; LAS float* X;
    __device__ __forceinline__ void rope64(const f32x4 (&acc)[2][2][4][2], const Unit& u, int wr, int wc, int fr, int fq, h16* dst, int tl, float scale) const {
        const int tok0 = u.pm * BM + wr * 64 + fr;
        f32x4 tc[4], tn[4];
        { const f32x4* tp = (const f32x4*)(tab + (size_t)tok0 * 48 + 4 * fq); tc[0] = tp[0]; tc[1] = tp[1]; tc[2] = tp[8]; tc[3] = tp[9]; }
#pragma unroll
        for (int rr = 0; rr < 8; ++rr) { const int ai = rr >> 2, m = rr & 3, tok = tok0 + ai * HALF + m * 16;
            if (rr < 7) { const int tokn = tok0 + ((rr + 1) >> 2) * HALF + ((rr + 1) & 3) * 16; const f32x4* tp = (const f32x4*)(tab + (size_t)tokn * 48 + 4 * fq); tn[0] = tp[0]; tn[1] = tp[1]; tn[2] = tp[8]; tn[3] = tp[9]; }
#pragma unroll
            for (int n = 0; n < 2; ++n) { const int i = 16 * n + 4 * fq; const f32x4 t0 = tc[2 * n], t1 = tc[2 * n + 1];
                const f32x4 cs = {t0.x, t0.z, t1.x, t1.z}, sn = {t0.y, t0.w, t1.y, t1.w}, x1 = acc[ai][0][m][n], x2 = acc[ai][1][m][n];
                const f32x4 o1 = (x1 * cs - x2 * sn) * scale, o2 = (x2 * cs + x1 * sn) * scale;
                h16* p = dst + (size_t)tok * 768 + (4 * tl + wc) * 64 + i;
                u32x2 w1, w2; w1.x = pk_h2(o1.x, o1.y); w1.y = pk_h2(o1.z, o1.w); w2.x = pk_h2(o2.x, o2.y); w2.y = pk_h2(o2.z, o2.w);
                *(u32x2*)p = w1; *(u32x2*)(p + 32) = w2; }
#pragma unroll
            for (int k = 0; k < 4; ++k) tc[k] = tn[k];
            asm volatile("" ::: "memory"); }
    }
    __device__ __forceinline__ void operator()(const f32x4 (&acc)[2][2][4][2], const Unit& u, int wr, int wc, int fr, int fq) const {
        const int pn = u.pn;
        if (pn == 0) {
#pragma unroll
            for (int ai = 0; ai < 2; ++ai)
#pragma unroll
                for (int m = 0; m < 4; ++m) { float sq = 0.f;
#pragma unroll
                    for (int bj = 0; bj < 2; ++bj)
#pragma unroll
                        for (int n = 0; n < 2; ++n) { const f32x4 v = acc[ai][bj][m][n]; sq += (v.x * v.x + v.y * v.y) + (v.z * v.z + v.w * v.w); }
                    sq += __shfl_xor(sq, 16); sq += __shfl_xor(sq, 32);
                    if (fq == 0) X[(ai * HALF + wr * 64 + m * 16 + fr) * 4 + wc] = sq; }
            asm volatile("s_waitcnt lgkmcnt(0)" ::: "memory"); __builtin_amdgcn_s_barrier(); asm volatile("" ::: "memory");
#pragma unroll
            for (int ai = 0; ai < 2; ++ai)
#pragma unroll
                for (int m = 0; m < 4; ++m) { const int rl = ai * HALF + wr * 64 + m * 16 + fr, tok = u.pm * BM + rl; const f32x4 p = *(const LAS f32x4*)(X + rl * 4);
                    const float rstd = rsqrtf(((p.x + p.y) + (p.z + p.w)) * (1.f / KVL) + EPS);
#pragma unroll
                    for (int bj = 0; bj < 2; ++bj)
#pragma unroll
                        for (int n = 0; n < 2; ++n) { const int col = bj * HALF + wc * 32 + n * 16 + 4 * fq; const f32x4 o = acc[ai][bj][m][n] * rstd * *(const f32x4*)(gckv + col);
                            int w8 = __builtin_amdgcn_cvt_pk_fp8_f32(o.x, o.y, 0, false); w8 = __builtin_amdgcn_cvt_pk_fp8_f32(o.z, o.w, w8, true);
                            *(int*)((unsigned char*)ckv + (size_t)tok * KVL + col) = w8; }
                    asm volatile("" ::: "memory"); }
            asm volatile("s_waitcnt lgkmcnt(0)" ::: "memory"); __builtin_amdgcn_s_barrier(); asm volatile("" ::: "memory");
        } else if (pn <= 2) {
#pragma unroll
            for (int ai = 0; ai < 2; ++ai)
#pragma unroll
                for (int m = 0; m < 4; ++m) { const int tok = u.pm * BM + ai * HALF + wr * 64 + m * 16 + fr; float sq = 0.f;
#pragma unroll
                    for (int bj = 0; bj < 2; ++bj) { if (pn == 2 && bj == 1) break;
#pragma unroll
                        for (int n = 0; n < 2; ++n) { const f32x4 v = acc[ai][bj][m][n]; sq += (v.x * v.x + v.y * v.y) + (v.z * v.z + v.w * v.w);
                            const int col = (pn - 1) * 256 + bj * HALF + wc * 32 + n * 16 + 4 * fq; u32x2 w; w.x = pk_h2(v.x, v.y); w.y = pk_h2(v.z, v.w); *(u32x2*)(cq + (size_t)tok * QL + col) = w; } }
                    sq += __shfl_xor(sq, 16); sq += __shfl_xor(sq, 32);
                    if (fq == 0) ssq[tok * 8 + (pn - 1) * 4 + wc] = sq;
                    if (pn == 2) {
                        if (wc < 2) { const int i = 4 * fq; const f32x4* tp = (const f32x4*)(tab + (size_t)tok * 48 + 32 + i); const f32x4 t0 = tp[0], t1 = tp[1];
                            const f32x4 cs = {t0.x, t0.z, t1.x, t1.z}, sn = {t0.y, t0.w, t1.y, t1.w}, x1 = acc[ai][1][m][0], x2 = acc[ai][1][m][1];
                            const f32x4 o1 = x1 * cs - x2 * sn, o2 = x2 * cs + x1 * sn;
                            if (wc == 0) { unsigned char* p8 = (unsigned char*)kr + (size_t)tok * 32 + i;
                                int a8 = __builtin_amdgcn_cvt_pk_fp8_f32(o1.x, o1.y, 0, false); a8 = __builtin_amdgcn_cvt_pk_fp8_f32(o1.z, o1.w, a8, true);
                                int b8 = __builtin_amdgcn_cvt_pk_fp8_f32(o2.x, o2.y, 0, false); b8 = __builtin_amdgcn_cvt_pk_fp8_f32(o2.z, o2.w, b8, true);
                                *(int*)p8 = a8; *(int*)(p8 + 16) = b8; }
                            else { h16* p = ki + (size_t)tok * 32 + i;
                                u32x2 w1, w2; w1.x = pk_h2(o1.x, o1.y); w1.y = pk_h2(o1.z, o1.w); w2.x = pk_h2(o2.x, o2.y); w2.y = pk_h2(o2.z, o2.w);
                                *(u32x2*)p = w1; *(u32x2*)(p + 16) = w2; } }
                        else if (wc == 2 && fq < 2) { *(f32x4*)(wi + tok * 8 + 4 * fq) = acc[ai][1][m][0] * 0.35355339059327373f; }
                    }
                    asm volatile("" ::: "memory"); }
        } else if (pn <= 5) rope64(acc, u, wr, wc, fr, fq, qb, pn - 3, 0.125f * LOG2E);
        else if (pn <= 8) rope64(acc, u, wr, wc, fr, fq, kb, pn - 6, 1.0f);
        else {
#pragma unroll
            for (int ai = 0; ai < 2; ++ai)
#pragma unroll
                for (int m = 0; m < 4; ++m) { const int tok = u.pm * BM + ai * HALF + wr * 64 + m * 16 + fr;
#pragma unroll
                    for (int bj = 0; bj < 2; ++bj)
#pragma unroll
                        for (int n = 0; n < 2; ++n) { const f32x4 v = acc[ai][bj][m][n]; u32x2 w; w.x = pk_h2(v.x, v.y); w.y = pk_h2(v.z, v.w);
                            *(u32x2*)(vT + (size_t)tok * 768 + (pn - 9) * 256 + bj * HALF + wc * 32 + n * 16 + 4 * fq) = w; }
                    asm volatile("" ::: "memory"); }
        }
    }
};
struct Epi4 {
    static constexpr bool PERM = true;
    h16 *qlat, *qr, *qi; const float* rstdq; const float2* tab;
    __device__ __forceinline__ void operator()(const f32x4 (&acc)[2][2][4][2], const Unit& u, int wr, int wc, int fr, int fq) const {
        const int pn = u.pn; const float c2 = 0.10206207261596575f * LOG2E;
        const int tok0 = u.pm * BM + wr * 64 + fr;
        float rc = rstdq[tok0], rn = 0.f;
        if (pn < 8) {
#pragma unroll
            for (int rr = 0; rr < 8; ++rr) { const int ai = rr >> 2, m = rr & 3, tok = tok0 + ai * HALF + m * 16;
                if (rr < 7) rn = rstdq[tok0 + ((rr + 1) >> 2) * HALF + ((rr + 1) & 3) * 16];
#pragma unroll
                for (int bj = 0; bj < 2; ++bj) { const f32x4 o0 = acc[ai][bj][m][0] * (rc * c2), o1 = acc[ai][bj][m][1] * (rc * c2);
                    u32x4 w; w.x = pk_h2(o0.x, o0.y); w.y = pk_h2(o0.z, o0.w); w.z = pk_h2(o1.x, o1.y); w.w = pk_h2(o1.z, o1.w);
                    *(u32x4*)(qlat + (size_t)tok * 2048 + pn * 256 + bj * HALF + wc * 32 + 8 * fq) = w; }
                rc = rn; asm volatile("" ::: "memory"); }
        } else { h16* dst = (pn == 8) ? qr : qi; const float c2e = (pn == 8) ? c2 : 1.f; const int i = 4 * fq;
            f32x4 tc[2], tn[2];
            { const f32x4* tp = (const f32x4*)(tab + (size_t)tok0 * 48 + 32 + i); tc[0] = tp[0]; tc[1] = tp[1]; }
#pragma unroll
            for (int rr = 0; rr < 8; ++rr) { const int ai = rr >> 2, m = rr & 3, tok = tok0 + ai * HALF + m * 16;
                if (rr < 7) { const int tokn = tok0 + ((rr + 1) >> 2) * HALF + ((rr + 1) & 3) * 16; const f32x4* tp = (const f32x4*)(tab + (size_t)tokn * 48 + 32 + i); tn[0] = tp[0]; tn[1] = tp[1]; rn = rstdq[tokn]; }
                const f32x4 cs = {tc[0].x, tc[0].z, tc[1].x, tc[1].z}, sn = {tc[0].y, tc[0].w, tc[1].y, tc[1].w}; const float sc = rc * c2e;
#pragma unroll
                for (int bj = 0; bj < 2; ++bj) { const f32x4 x1 = acc[ai][bj][m][0], x2 = acc[ai][bj][m][1]; const f32x4 o1 = (x1 * cs - x2 * sn) * sc, o2 = (x2 * cs + x1 * sn) * sc;
                    h16* p = dst + (size_t)tok * 256 + (4 * bj + wc) * 32 + i;
                    u32x2 w1, w2; w1.x = pk_h2(o1.x, o1.y); w1.y = pk_h2(o1.z, o1.w); w2.x = pk_h2(o2.x, o2.y); w2.y = pk_h2(o2.z, o2.w);
                    *(u32x2*)p = w1; *(u32x2*)(p + 16) = w2; }
                tc[0] = tn[0]; tc[1] = tn[1]; rc = rn;
                asm volatile("" ::: "memory"); } }
    }
};
__device__ __forceinline__ u32x4 ld16_l2(const h16* p) {
    const unsigned long long a = __hip_atomic_load((const unsigned long long*)p, __ATOMIC_RELAXED, __HIP_MEMORY_SCOPE_AGENT), b = __hip_atomic_load((const unsigned long long*)p + 1, __ATOMIC_RELAXED, __HIP_MEMORY_SCOPE_AGENT);
    return (u32x4){(unsigned)a, (unsigned)(a >> 32), (unsigned)b, (unsigned)(b >> 32)};
}
typedef _Float16 h16x8 __attribute__((ext_vector_type(8)));
__device__ __forceinline__ void unpk8(const u32x4 w, float (&f)[8]) {
    const h16x8 h = __builtin_bit_cast(h16x8, w);
#pragma unroll
    for (int i = 0; i < 8; ++i) f[i] = (float)h[i];
}
struct EpiH16 {
    static constexpr bool PERM = true;
    h16* O; int ldc = DM;
    __device__ __forceinline__ void operator()(const f32x4 (&acc)[2][2][4][2], const Unit& u, int wr, int wc, int fr, int fq) const {
        const int row0 = u.pm * BM + wr * 64 + fr, col0 = u.pn * BM + wc * 32 + 8 * fq;
#pragma unroll
        for (int ai = 0; ai < 2; ++ai)
#pragma unroll
            for (int m = 0; m < 4; ++m)
#pragma unroll
                for (int bj = 0; bj < 2; ++bj) { const f32x4 v0 = acc[ai][bj][m][0], v1 = acc[ai][bj][m][1];
                    u32x4 w; w.x = pk_h2(v0.x, v0.y); w.y = pk_h2(v0.z, v0.w); w.z = pk_h2(v1.x, v1.y); w.w = pk_h2(v1.z, v1.w);
                    *(u32x4*)(O + (size_t)(row0 + ai * HALF + m * 16) * ldc + col0 + bj * HALF) = w; }
    }
};
struct EpiGate {
    static constexpr bool PERM = true;
    const h16* Y; h16* Z; int accum;
    __device__ __forceinline__ void operator()(const f32x4 (&acc)[2][2][4][2], const Unit& u, int wr, int wc, int fr, int fq) const {
        const int row0 = u.pm * BM + wr * 64 + fr, col0 = u.pn * BM + wc * 32 + 8 * fq;
#pragma unroll
        for (int ai = 0; ai < 2; ++ai)
#pragma unroll
            for (int m = 0; m < 4; ++m)
#pragma unroll
                for (int bj = 0; bj < 2; ++bj) { const size_t off = (size_t)(row0 + ai * HALF + m * 16) * DM + col0 + bj * HALF;
                    float y[8], zz[8]; unpk8(ld16_l2(Y + off), y);
                    if (accum) unpk8(ld16_l2(Z + off), zz); else {
#pragma unroll
                        for (int i = 0; i < 8; ++i) zz[i] = 0.f; }
                    float o[8];
#pragma unroll
                    for (int n = 0; n < 2; ++n)
#pragma unroll
                        for (int e = 0; e < 4; ++e) { const float gg = acc[ai][bj][m][n][e]; o[n * 4 + e] = zz[n * 4 + e] + y[n * 4 + e] * __builtin_amdgcn_rcpf(1.f + __builtin_amdgcn_exp2f(-gg * LOG2E)); }
                    u32x4 w; w.x = pk_h2(o[0], o[1]); w.y = pk_h2(o[2], o[3]); w.z = pk_h2(o[4], o[5]); w.w = pk_h2(o[6], o[7]);
                    *(u32x4*)(Z + off) = w; }
    }
};
}

#define XB_TMO      128
#define XB_XCNT(j)  (256  + 64 * (j))
#define XB_XSUB(j)  (1280 + 64 * (j))
#define XB_XGEN(j)  (2304 + 64 * (j))
#define XB_TOP      3328
#define XB_TOPGEN   3392
#define XCD_BAR_WORDS 3456
#define XB_SPIN_CAP (1u << 18)
__device__ __forceinline__ unsigned xb_ld(unsigned* p)              { return __hip_atomic_load(p, __ATOMIC_RELAXED, __HIP_MEMORY_SCOPE_AGENT); }
__device__ __forceinline__ unsigned xb_add(unsigned* p, unsigned v) { return __hip_atomic_fetch_add(p, v, __ATOMIC_RELAXED, __HIP_MEMORY_SCOPE_AGENT); }
__device__ __forceinline__ unsigned xb_xcc_id() { return (unsigned)__builtin_amdgcn_s_getreg((3 << 11) | 20) & 0xFu; }
#define XB_SPIN(cond, bar) do { unsigned _sp = 0; while (cond) { __builtin_amdgcn_s_sleep(1); \
    if ((++_sp & 255u) == 0u) { if (xb_ld(&(bar)[XB_TMO])) break; if (_sp > XB_SPIN_CAP) { atomicAdd(&(bar)[XB_TMO], 1u); break; } } } } while (0)
struct XcdBarrier { unsigned* bar; unsigned x; volatile LAS unsigned* st; };
__device__ __forceinline__ XcdBarrier xcd_barrier_post(unsigned* bar, volatile LAS unsigned* st) {
    XcdBarrier b; b.bar = bar; b.x = xb_xcc_id(); b.st = st;
    if (threadIdx.x == 0) (void)xb_add(&bar[XB_XCNT(b.x)], 1u);
    return b;
}
__device__ __forceinline__ void xcd_barrier_complete(unsigned* bar, unsigned x, unsigned& nloc, unsigned& nx) {
    const unsigned G = gridDim.x * gridDim.y * gridDim.z;
    unsigned sum, cnt, mine, sp = 0u;
    for (;;) {
        sum = 0u; cnt = 0u; mine = 0u;
#pragma unroll
        for (unsigned j = 0; j < 16; ++j) { const unsigned c = xb_ld(&bar[XB_XCNT(j)]); sum += c; cnt += (c > 0u) ? 1u : 0u; mine = (j == x) ? c : mine; }
        if (sum == G) break;
        __builtin_amdgcn_s_sleep(1);
        if ((++sp & 255u) == 0u) { if (xb_ld(&bar[XB_TMO])) break; if (sp > XB_SPIN_CAP) { atomicAdd(&bar[XB_TMO], 1u); break; } }
    }
    nloc = mine > 0u ? mine : 1u; nx = cnt > 0u ? cnt : 1u;
}
__device__ __forceinline__ void xcd_barrier(const XcdBarrier& b) {
    asm volatile("s_waitcnt vmcnt(0)" ::: "memory");
    __syncthreads();
    if (threadIdx.x == 0) {
        unsigned* bar = b.bar;
        __builtin_amdgcn_s_waitcnt(0);
        unsigned nloc = b.st[0], nx = b.st[1];
        if (nloc == 0u) { xcd_barrier_complete(bar, b.x, nloc, nx); b.st[0] = nloc; b.st[1] = nx; }
        const unsigned old = xb_add(&bar[XB_XSUB(b.x)], 1u);
        const unsigned gen = old / nloc;
        if (old + 1u == (gen + 1u) * nloc) {
            __builtin_amdgcn_fence(__ATOMIC_RELEASE, "agent");
            asm volatile("s_waitcnt vmcnt(0)" ::: "memory");
            const unsigned og = xb_add(&bar[XB_TOP], 1u);
            const unsigned tg = og / nx;
            if (og + 1u == (tg + 1u) * nx) xb_add(&bar[XB_TOPGEN], 1u);
            else XB_SPIN(xb_ld(&bar[XB_TOPGEN]) == tg, bar);
            __builtin_amdgcn_fence(__ATOMIC_ACQUIRE, "agent");
            xb_add(&bar[XB_XGEN(b.x)], 1u);
            asm volatile("s_waitcnt vmcnt(0)" ::: "memory");
        } else {
            XB_SPIN(xb_ld(&bar[XB_XGEN(b.x)]) == gen, bar);
            __builtin_amdgcn_fence(__ATOMIC_ACQUIRE, "agent");
            asm volatile("s_waitcnt vmcnt(0)" ::: "memory");
        }
    }
    __syncthreads();
}

constexpr int NWAVES = 8, NTHR = 512;
constexpr int RING_BYTES = 131072, LDSCTL_OFF = RING_BYTES, MISC_OFF = LDSCTL_OFF + 320, LDS_BYTES = 147456;
constexpr int XCH_OFF = RING_BYTES + 1024;
constexpr int CW_BAR = 4096;
constexpr size_t OW_GU1 = OFF_W, OW_D1 = OW_GU1 + 11 * MiB, OW_IN = OW_D1 + (size_t)DM * FF * 2, OW_GATE = OW_IN + 6 * MiB, OW_4 = OW_GATE + 4 * MiB, OW_OV = OW_4 + 2 * MiB,
                 OW_UPB = OW_OV + 4 * MiB, OW_O = OW_UPB + MiB / 2, OW_GU2 = OW_O + 2 * MiB, OW_D2 = OW_GU2 + 11 * MiB, OW_END = OW_D2 + (size_t)DM * FF * 2;
static_assert(OW_END <= OFF_H, "weights region");
constexpr int NIN3 = 3072, N4 = 2560;
constexpr size_t OW_BD = OW_OV, OW_UPA = OW_OV + MiB, OFF_OA = OFF_A + 64 * MiB;

struct Args { const float* in[27]; float* out; unsigned char* ws; int ph_lo, ph_hi; };
struct Frame {
    LAS unsigned char* lds; int tid, lane, wave, G, gw, NGW;
};
__device__ __forceinline__ float wave_sum(float v) {
#pragma unroll
    for (int o = 1; o < 64; o <<= 1) v += __shfl_xor(v, o);
    return v;
}
__device__ __forceinline__ bool map_row(int job, int n, const Args& a, const float*& W, int& ldw, int& col) {
    if (job <= 1) { const int t = n >> 8, j = n & 255; W = a.in[(job == 0 ? 6 : 23) + (j >> 7)]; ldw = FF; col = t * 128 + (j & 127); return true; }
    if (job == 2) { W = a.in[11]; ldw = DIN; const int t = n >> 8, j = n & 255;
        if (t == 0) { col = C_CKV + j; return true; }
        if (t == 1) { col = j; return true; }
        if (t == 2) { if (j < 128) { col = 256 + j; return true; } if (j < 160) { col = C_KR + (j - 128); return true; } if (j < 192) { col = C_KI + (j - 160); return true; } if (j < 200) { col = C_WI + (j - 192); return true; } col = 0; return false; }
        if (t < 9) { const int c3 = (t - 3) / 3, tl = (t - 3) % 3, hl = (j & 127) >> 5, i = j & 31; col = C_QKV + c3 * 768 + (4 * tl + hl) * 64 + (j >> 7) * 32 + i; return true; }
        col = C_QKV + 1536 + (t - 9) * 256 + j; return true; }
    { const int n2 = n - 2048, r5 = n2 & 31, nat = 16 * ((r5 >> 2) & 1) + 4 * (r5 >> 3) + (r5 & 3);
      if (n2 < 256) { W = a.in[14]; ldw = 768; col = (n2 >> 5) * 96 + 64 + nat; } else { W = a.in[17]; ldw = 256; col = ((n2 - 256) & ~31) + nat; } return true; }
}
__device__ __forceinline__ void tr_item(const float* W, int ldw, int col, bool valid, const float* scale, int k0, h16* WTrow0, int K, LAS float* scr, int lane) {
#pragma unroll 8
    for (int i = 0; i < 32; ++i) { const int kk = 2 * i + (lane >> 5); float v = valid ? W[(size_t)(k0 + kk) * ldw + col] : 0.f; if (scale) v *= scale[k0 + kk]; scr[kk * 33 + (lane & 31)] = v; }
    asm volatile("s_waitcnt lgkmcnt(0)" ::: "memory");
    const int c = lane & 7;
#pragma unroll
    for (int j = 0; j < 4; ++j) { const int n = (lane >> 3) + 8 * j; const LAS float* s = scr + (8 * c) * 33 + n;
        u32x4 o; o.x = pk_h2(s[0 * 33], s[1 * 33]); o.y = pk_h2(s[2 * 33], s[3 * 33]); o.z = pk_h2(s[4 * 33], s[5 * 33]); o.w = pk_h2(s[6 * 33], s[7 * 33]);
        *(u32x4*)(WTrow0 + (size_t)n * K + k0 + 8 * c) = o; }
    asm volatile("s_waitcnt lgkmcnt(0)" ::: "memory");
}
__device__ __forceinline__ void tr_job_mapped(const Frame& F, const Args& a, int job, int Ndest, int n_lo, int K, h16* WT, const float* scale, LAS float* scr, int phase_off) {
    const int nblk = Ndest / 32, nitems = (K / 64) * nblk;
    for (int it = (F.gw + phase_off) % F.NGW; it < nitems; it += F.NGW) {
        const int kb = it / nblk, nb = it % nblk; const float* W; int ldw, col;
        const bool valid = map_row(job, n_lo + nb * 32 + (F.lane & 31), a, W, ldw, col);
        tr_item(W, ldw, col, valid, scale, kb * 64, WT + (size_t)(n_lo + nb * 32) * K, K, scr, F.lane);
    }
}
__device__ __forceinline__ void tr_job_plain(const Frame& F, const float* W, int ldw, int Ndest, int K, h16* WT, LAS float* scr, int phase_off) {
    const int nblk = Ndest / 32, nitems = (K / 64) * nblk;
    for (int it = (F.gw + phase_off) % F.NGW; it < nitems; it += F.NGW) {
        const int kb = it / nblk, nb = it % nblk;
        tr_item(W, ldw, nb * 32 + (F.lane & 31), true, nullptr, kb * 64, WT + (size_t)(nb * 32) * K, K, scr, F.lane);
    }
}
__device__ __forceinline__ void row_load(const float* p, int lane, f32x4 (&v)[4]) {
#pragma unroll
    for (int j = 0; j < 4; ++j) v[j] = ((const f32x4*)p)[lane + 64 * j];
}
__device__ __forceinline__ float row_ssq(const f32x4 (&v)[4]) { float s = 0.f;
#pragma unroll
    for (int j = 0; j < 4; ++j) s += (v[j].x * v[j].x + v[j].y * v[j].y) + (v[j].z * v[j].z + v[j].w * v[j].w);
    return wave_sum(s); }
__device__ __forceinline__ void row_normmod_store(const f32x4 (&v)[4], float rstd, const float* g, const float* sc, const float* sh, h16* dst, int lane) {
#pragma unroll
    for (int j = 0; j < 4; ++j) { const int ci = lane + 64 * j; const f32x4 gg = ((const f32x4*)g)[ci], s1 = ((const f32x4*)sc)[ci], s0 = ((const f32x4*)sh)[ci];
        const f32x4 o = v[j] * rstd * gg * (s1 + 1.f) + s0;
        u32x2 w; w.x = pk_h2(o.x, o.y); w.y = pk_h2(o.z, o.w); ((u32x2*)dst)[ci] = w; }
}
__device__ __forceinline__ void ph_normmod(const Frame& F, const float* x, const float* g, const float* mod, int isc, int ish, h16* dst) {
    int m = F.gw; if (m >= MT) return;
    f32x4 v[4], vn[4]; row_load(x + (size_t)m * DM, F.lane, v);
    for (;;) { const int mn = m + F.NGW; const bool has = mn < MT; if (has) row_load(x + (size_t)mn * DM, F.lane, vn);
        const float rstd = rsqrtf(row_ssq(v) * (1.f / DM) + EPS); const float* mb = mod + (m / SEQ) * (NMOD * DM);
        row_normmod_store(v, rstd, g, mb + isc * DM, mb + ish * DM, dst + (size_t)m * DM, F.lane);
        if (!has) break;
#pragma unroll
        for (int j = 0; j < 4; ++j) v[j] = vn[j];
        m = mn; }
}
__device__ __forceinline__ void row_load_h(const h16* p, int lane, u32x2 (&v)[4]) {
#pragma unroll
    for (int j = 0; j < 4; ++j) v[j] = ((const u32x2*)p)[lane + 64 * j];
}
typedef _Float16 h16x4 __attribute__((ext_vector_type(4)));
__device__ __forceinline__ f32x4 h4_to_f4(u32x2 w) { const h16x4 h = __builtin_bit_cast(h16x4, w); return (f32x4){(float)h[0], (float)h[1], (float)h[2], (float)h[3]}; }
template <bool XI16, bool XO16>
__device__ __forceinline__ void ph_resnorm(const Frame& F, const void* xin_, const h16* f, const float* gpost, const float* mod, int igt, float coef, void* xout_,
                                           bool second, const float* gpre, int isc, int ish, h16* dst) {
    int m = F.gw; if (m >= MT) return;
    u32x2 fh[4], fn[4]; f32x4 xi[4], xn[4]; u32x2 xh[4], xhn[4];
    row_load_h(f + (size_t)m * DM, F.lane, fh);
    if constexpr (XI16) row_load_h((const h16*)xin_ + (size_t)m * DM, F.lane, xh); else row_load((const float*)xin_ + (size_t)m * DM, F.lane, xi);
    for (;;) {
        const int mn = m + F.NGW; const bool has = mn < MT;
        if (has) { row_load_h(f + (size_t)mn * DM, F.lane, fn);
            if constexpr (XI16) row_load_h((const h16*)xin_ + (size_t)mn * DM, F.lane, xhn); else row_load((const float*)xin_ + (size_t)mn * DM, F.lane, xn); }
        f32x4 v[4];
#pragma unroll
        for (int j = 0; j < 4; ++j) { v[j] = h4_to_f4(fh[j]); if constexpr (XI16) xi[j] = h4_to_f4(xh[j]); }
        const float rstd = rsqrtf(row_ssq(v) * (1.f / DM) + EPS) * coef; const float* mb = mod + (m / SEQ) * (NMOD * DM);
#pragma unroll
        for (int j = 0; j < 4; ++j) { const int ci = F.lane + 64 * j; const f32x4 gg = ((const f32x4*)gpost)[ci], gt = ((const f32x4*)(mb + igt * DM))[ci];
            xi[j] = xi[j] + gt * v[j] * rstd * gg;
            if constexpr (XO16) { u32x2 w; w.x = pk_h2(xi[j].x, xi[j].y); w.y = pk_h2(xi[j].z, xi[j].w); ((u32x2*)((h16*)xout_ + (size_t)m * DM))[ci] = w; }
            else ((f32x4*)((float*)xout_ + (size_t)m * DM))[ci] = xi[j]; }
        if (second) { const float r2 = rsqrtf(row_ssq(xi) * (1.f / DM) + EPS); row_normmod_store(xi, r2, gpre, mb + isc * DM, mb + ish * DM, dst + (size_t)m * DM, F.lane); }
        if (!has) break;
#pragma unroll
        for (int j = 0; j < 4; ++j) { fh[j] = fn[j]; if constexpr (XI16) xh[j] = xhn[j]; else xi[j] = xn[j]; }
        m = mn;
    }
}

__device__ __forceinline__ void ph_combine(const Frame& F, const h16* og, const float* lse2, h16* ob) {
    for (int idx = blockIdx.x * NTHR + F.tid; idx < MT * 256; idx += F.G * NTHR) {
        const int tok = idx >> 8, c = idx & 255, hh = c >> 6;
        const float l0 = lse2[tok * 12 + hh], l1 = lse2[tok * 12 + 4 + hh], l2 = lse2[tok * 12 + 8 + hh], m = fmaxf(l0, fmaxf(l1, l2));
        const float w0 = exp2f(l0 - m), w1 = exp2f(l1 - m), w2 = exp2f(l2 - m), inv = 1.f / (w0 + w1 + w2);
        ob[idx] = (h16)((w0 * (float)og[(size_t)tok * 768 + c] + w1 * (float)og[(size_t)tok * 768 + 256 + c] + w2 * (float)og[(size_t)tok * 768 + 512 + c]) * inv); }
}
typedef short v4i16_t __attribute__((ext_vector_type(4)));
typedef short s16x8 __attribute__((ext_vector_type(8)));
typedef float f32x16 __attribute__((ext_vector_type(16)));
__device__ __forceinline__ int tk_bin(float sc) { const unsigned u = __float_as_uint(sc); int e = (int)((u >> 16) & 0x7FFFu) - (122 << 7); e = e < 0 ? 0 : (e > 1023 ? 1023 : e); return (u >> 31) ? 1023 - e : 1024 + e; }
__device__ __forceinline__ void tk_scores(const f16x8 (&Af)[2], const float (&wv)[16], f16x8 b0, f16x8 b1, float& sa, float& sb) {
    f32x16 d = {0.f, 0.f, 0.f, 0.f, 0.f, 0.f, 0.f, 0.f, 0.f, 0.f, 0.f, 0.f, 0.f, 0.f, 0.f, 0.f};
    d = __builtin_amdgcn_mfma_f32_32x32x16_f16(Af[0], b0, d, 0, 0, 0); d = __builtin_amdgcn_mfma_f32_32x32x16_f16(Af[1], b1, d, 0, 0, 0);
    f32x2 acc = {0.f, 0.f};
#pragma unroll
    for (int e = 0; e < 16; e += 2) { const int i0 = __float_as_int(d[e]), i1 = __float_as_int(d[e + 1]);
        const f32x2 rl = {__int_as_float(i0 > 0 ? i0 : 0), __int_as_float(i1 > 0 ? i1 : 0)}; const f32x2 w2 = {wv[e], wv[e + 1]};
        acc = __builtin_elementwise_fma(w2, rl, acc); }
    sa = acc.x; sb = acc.y;
}
template <bool P2>
__device__ __forceinline__ void tk_tile(const f16x8 (&Af)[2], const float (&wv)[16], f16x8 b0, f16x8 b1, int tile, int r, int hi, int ta, LAS unsigned* hist, const int (&tbin)[4], int (&cs)[4], int (&cc)[4],
                                        unsigned short* sel, int tok0) {
    float sa, sb; tk_scores(Af, wv, b0, b1, sa, sb);
    const int s = 32 * tile + r;
    if constexpr (!P2) {
        if (s <= ta) { const int bn = tk_bin(sa); __hip_atomic_fetch_add(hist + (2 * hi) * 1024 + (bn >> 1), 1u << (16 * (bn & 1)), __ATOMIC_RELAXED, __HIP_MEMORY_SCOPE_WORKGROUP); }
        if (s <= ta + 1) { const int bn = tk_bin(sb); __hip_atomic_fetch_add(hist + (2 * hi + 1) * 1024 + (bn >> 1), 1u << (16 * (bn & 1)), __ATOMIC_RELAXED, __HIP_MEMORY_SCOPE_WORKGROUP); }
    } else {
        const unsigned lowmask = (1u << r) - 1u;
#pragma unroll
        for (int ab = 0; ab < 2; ++ab) { const float sc = ab ? sb : sa; const int tq = ta + ab; const int bn = tk_bin(sc);
            const int mytb = hi ? tbin[2 + ab] : tbin[ab];
            const bool valid = s <= tq, sure = valid && bn > mytb, cand = valid && bn == mytb;
            const unsigned long long ms = __ballot(sure), mc = __ballot(cand);
            const unsigned ms_h = hi ? (unsigned)(ms >> 32) : (unsigned)ms, mc_h = hi ? (unsigned)(mc >> 32) : (unsigned)mc;
            const int q = 2 * hi + ab;
            const int base_s = hi ? cs[2 + ab] : cs[ab], base_c = hi ? cc[2 + ab] : cc[ab];
            if (sure) sel[(size_t)(tok0 + q) * TOPK + base_s + __builtin_popcount(ms_h & lowmask)] = (unsigned short)s;
            if (cand) { const int pos = base_c + __builtin_popcount(mc_h & lowmask);
                if (pos < 512) ((LAS unsigned long long*)((LAS unsigned char*)hist + q * 4096))[pos] = ((unsigned long long)fkey(sc) << 16) | (unsigned long long)(0xFFFFu - (unsigned)s); }
            cs[ab] += __builtin_popcount((unsigned)ms); cs[2 + ab] += __builtin_popcount((unsigned)(ms >> 32));
            cc[ab] += __builtin_popcount((unsigned)mc); cc[2 + ab] += __builtin_popcount((unsigned)(mc >> 32)); }
    }
}
template <bool P2>
__device__ __forceinline__ void tk_pass(const f16x8 (&Af)[2], const float (&wv)[16], const h16* kbase, int ntiles, int r, int hi, int ta, LAS unsigned* hist, const int (&tbin)[4], int (&cs)[4], int (&cc)[4],
                                        unsigned short* sel, int tok0) {
    f16x8 BA[4][2], BB[4][2];
#define TK_LOAD(dst, t0_) do { _Pragma("unroll") for (int i_ = 0; i_ < 4; ++i_) { const int tt_ = ((t0_) + i_) < 127 ? ((t0_) + i_) : 127; dst[i_][0] = *(const f16x8*)(kbase + (size_t)tt_ * 1024); dst[i_][1] = *(const f16x8*)(kbase + (size_t)tt_ * 1024 + 16); } } while (0)
    TK_LOAD(BA, 0);
    for (int t0 = 0; t0 < ntiles; t0 += 8) {
        TK_LOAD(BB, t0 + 4);
#pragma unroll
        for (int i = 0; i < 4; ++i) if (t0 + i < ntiles) tk_tile<P2>(Af, wv, BA[i][0], BA[i][1], t0 + i, r, hi, ta, hist, tbin, cs, cc, sel, tok0);
        TK_LOAD(BA, t0 + 8);
#pragma unroll
        for (int i = 0; i < 4; ++i) if (t0 + 4 + i < ntiles) tk_tile<P2>(Af, wv, BB[i][0], BB[i][1], t0 + 4 + i, r, hi, ta, hist, tbin, cs, cc, sel, tok0);
    }
#undef TK_LOAD
}
__device__ __forceinline__ void tk_group(const Frame& F, const h16* qi, const h16* ki, const float* wi, unsigned short* sel, int b, int t0, LAS unsigned* hist) {
    int lane_ = F.lane; asm volatile("" : "+v"(lane_)); const int lane = lane_, r = lane & 31, hi = lane >> 5, tok0 = b * SEQ + t0;
    const int qa = 2 * ((r >> 2) & 1) + (r & 1), ha = 4 * (r >> 4) + 2 * ((r >> 3) & 1) + ((r >> 1) & 1);
    f16x8 Af[2];
#pragma unroll
    for (int s_ = 0; s_ < 2; ++s_) Af[s_] = *(const f16x8*)(qi + (size_t)(tok0 + qa) * 256 + ha * 32 + 16 * s_ + 8 * hi);
    float wv[16];
    { const f32x4 a0 = *(const f32x4*)(wi + (tok0 + 2 * hi) * 8), a1 = *(const f32x4*)(wi + (tok0 + 2 * hi) * 8 + 4), b0 = *(const f32x4*)(wi + (tok0 + 2 * hi + 1) * 8), b1 = *(const f32x4*)(wi + (tok0 + 2 * hi + 1) * 8 + 4);
      const float sa[8] = {a0.x, a0.y, a0.z, a0.w, a1.x, a1.y, a1.z, a1.w}, sb[8] = {b0.x, b0.y, b0.z, b0.w, b1.x, b1.y, b1.z, b1.w};
#pragma unroll
      for (int h = 0; h < 8; ++h) { wv[2 * h] = sa[h] * 0.17677669529663687f; wv[2 * h + 1] = sb[h] * 0.17677669529663687f; } }
    const int ntiles = (t0 + 3) / 32 + 1, ta = t0 + 2 * hi;
    const h16* kbase = ki + (size_t)(b * SEQ + r) * 32 + 8 * hi;
    int tbin[4] = {0, 0, 0, 0}, nsure[4], cs[4] = {0, 0, 0, 0}, cc[4] = {0, 0, 0, 0};
#pragma unroll
    for (int i = 0; i < 16; ++i) *(LAS u32x4*)((LAS unsigned char*)hist + i * 1024 + lane * 16) = (u32x4){0u, 0u, 0u, 0u};
    asm volatile("s_waitcnt lgkmcnt(0)" ::: "memory");
    tk_pass<false>(Af, wv, kbase, ntiles, r, hi, ta, hist, tbin, cs, cc, sel, tok0);
    asm volatile("s_waitcnt lgkmcnt(0)" ::: "memory");
#pragma unroll
    for (int q = 0; q < 4; ++q) {
        const LAS unsigned* hq = hist + q * 1024;
        unsigned sum = 0;
#pragma unroll
        for (int i = 0; i < 4; ++i) { const u32x4 v = *(const LAS u32x4*)(hq + 16 * lane + 4 * i); sum += (v.x & 0xFFFFu) + (v.x >> 16) + (v.y & 0xFFFFu) + (v.y >> 16) + (v.z & 0xFFFFu) + (v.z >> 16) + (v.w & 0xFFFFu) + (v.w >> 16); }
        unsigned incl = sum;
#pragma unroll
        for (int o = 1; o < 64; o <<= 1) { const unsigned v = __shfl_down(incl, o); if (lane + o < 64) incl += v; }
        const unsigned long long bal = __ballot(incl >= (unsigned)TOPK);
        const int L = 63 - __builtin_clzll(bal);
        unsigned cum = __shfl(incl, L) - __shfl(sum, L);
        int tbq = 32 * L, found = 0;
        for (int wd = 15; wd >= 0 && !found; --wd) { const unsigned v = hq[16 * L + wd];
            const unsigned chi = v >> 16, clo = v & 0xFFFFu;
            if (cum + chi >= (unsigned)TOPK) { tbq = 32 * L + 2 * wd + 1; found = 1; } else { cum += chi;
                if (cum + clo >= (unsigned)TOPK) { tbq = 32 * L + 2 * wd; found = 1; } else cum += clo; } }
        tbin[q] = tbq; nsure[q] = (int)cum;
    }
    asm volatile("s_waitcnt lgkmcnt(0)" ::: "memory");
    tk_pass<true>(Af, wv, kbase, ntiles, r, hi, ta, hist, tbin, cs, cc, sel, tok0);
    asm volatile("s_waitcnt lgkmcnt(0)" ::: "memory");
#pragma unroll
    for (int q = 0; q < 4; ++q) {
        const int nc = cc[q] < 512 ? cc[q] : 512, need = TOPK - cs[q];
        const LAS unsigned long long* cq = (const LAS unsigned long long*)((const LAS unsigned char*)hist + q * 4096);
        if (nc > 64) {
            unsigned long long it[8];
#pragma unroll
            for (int k = 0; k < 8; ++k) it[k] = (k * 64 + lane < nc) ? cq[k * 64 + lane] : 0ull;
            unsigned long long T = 0ull;
            for (int bit = 47; bit >= 0; --bit) { const unsigned long long cand = T | (1ull << bit); int cnt = 0;
#pragma unroll
                for (int k = 0; k < 8; ++k) cnt += __builtin_popcountll(__ballot(it[k] >= cand));
                if (cnt >= need) T = cand; }
            int basep = cs[q];
#pragma unroll
            for (int k = 0; k < 8; ++k) { const bool pick = (T != 0ull) && it[k] >= T; const unsigned long long mk = __ballot(pick);
                if (pick) sel[(size_t)(tok0 + q) * TOPK + basep + __builtin_popcountll(mk & ((1ull << lane) - 1ull))] = (unsigned short)(0xFFFFu - (unsigned)(it[k] & 0xFFFFull));
                basep += __builtin_popcountll(mk); }
        } else
        for (int base = 0; base < nc; base += 64) {
            const bool act = base + lane < nc; const unsigned long long my = act ? cq[base + lane] : 0ull; int rank = 0;
            for (int jb = 0; jb < nc; jb += 64) {
                const unsigned long long cj = (jb + lane < nc) ? cq[jb + lane] : 0ull; const unsigned clo = (unsigned)cj, chi = (unsigned)(cj >> 32);
                const int n = (nc - jb) < 64 ? (nc - jb) : 64;
                for (int j = 0; j < n; ++j) { const unsigned long long sj = ((unsigned long long)(unsigned)__builtin_amdgcn_readlane((int)chi, j) << 32) | (unsigned)__builtin_amdgcn_readlane((int)clo, j); rank += (sj > my) ? 1 : 0; } }
            if (act && rank < need) sel[(size_t)(tok0 + q) * TOPK + cs[q] + rank] = (unsigned short)(0xFFFFu - (unsigned)(my & 0xFFFFull)); }
    }
    (void)nsure;
    asm volatile("s_waitcnt lgkmcnt(0)" ::: "memory");
}
__device__ __forceinline__ void ph_topk_sparse(const Frame& F, const h16* qi, const h16* ki, const float* wi, unsigned short* sel, h16* qlat, const h16* qr, const unsigned char* ckv8, const unsigned char* kr8);
__device__ __forceinline__ void ph_topk_mfma(const Frame& F, const h16* qi, const h16* ki, const float* wi, unsigned short* sel) {
    LAS unsigned* hist = (LAS unsigned*)(F.lds + F.wave * 16384);
    for (int g = F.gw; g < 4 * 64; g += F.NGW) { const int b = g >> 6, t0 = (g & 63) * 4;
        for (int i = F.lane; i < 4 * TOPK; i += 64) { const int q = i >> 8, k = i & 255; sel[(size_t)(b * SEQ + t0 + q) * TOPK + k] = (unsigned short)(k <= t0 + q ? k : 0); } }
    for (int p = F.gw; p < 4 * 480; p += F.NGW) { const int b = p & 3, pj = p >> 2;
        tk_group(F, qi, ki, wi, sel, b, 4 * (64 + pj), hist);
        tk_group(F, qi, ki, wi, sel, b, 4 * (1023 - pj), hist);
    }
}


__device__ __forceinline__ void ph_dilated_mfma(const Frame& F, const h16* qb, const h16* kb, const h16* vb, h16* og, float* lse2) {
    const int lane = F.lane, ql = lane & 31, hi = lane >> 5;
    LAS unsigned char* VL = F.lds + F.wave * 16384;
    LAS float* linv = (LAS float*)(VL + 12288);
    constexpr int VROW = 192;
    const int trq = (lane & 15) >> 2, trp = lane & 3, trg = (lane >> 4) & 1;
    for (int u = F.gw; u < NB * 12 * 128; u += F.NGW) {
        const int b = u / 1536, rem = u % 1536, gh = rem >> 7, g = gh >> 2, wi_ = rem & 127, dil = dil_of(g), sh = g == 0 ? 0 : (g == 1 ? 2 : 4);
        const int nblk = 128 >> sh, res = wi_ / nblk, j0 = 32 * (wi_ % nblk);
        const size_t hoff = (size_t)b * SEQ * 768 + gh * 64;
        f16x8 Qf[4];
        { const h16* qp = qb + hoff + (size_t)((j0 + ql) * dil + res) * 768 + 8 * hi;
#pragma unroll
          for (int s_ = 0; s_ < 4; ++s_) Qf[s_] = *(const f16x8*)(qp + 16 * s_); }
        f32x16 S[5];
        f16x8 Kf[5][4];
#pragma unroll
        for (int kt = 0; kt < 5; ++kt) { int jk = j0 - 128 + 32 * kt + ql; jk = jk < 0 ? 0 : jk;
            const h16* kp = kb + hoff + (size_t)(jk * dil + res) * 768 + 8 * hi;
#pragma unroll
            for (int s_ = 0; s_ < 4; ++s_) Kf[kt][s_] = *(const f16x8*)(kp + 16 * s_); }
#pragma unroll
        for (int kt = 0; kt < 5; ++kt) {
            f32x16 d = {0.f, 0.f, 0.f, 0.f, 0.f, 0.f, 0.f, 0.f, 0.f, 0.f, 0.f, 0.f, 0.f, 0.f, 0.f, 0.f};
#pragma unroll
            for (int s_ = 0; s_ < 4; ++s_) d = __builtin_amdgcn_mfma_f32_32x32x16_f16(Kf[kt][s_], Qf[s_], d, 0, 0, 0);
            S[kt] = d; }
        f16x8 Vr[5][4];
#pragma unroll
        for (int kt = 0; kt < 5; ++kt) { int jk = j0 - 128 + 32 * kt + (lane >> 1); jk = jk < 0 ? 0 : jk;
            const h16* vp = vb + hoff + (size_t)(jk * dil + res) * 768 + (lane & 1) * 32;
#pragma unroll
            for (int i = 0; i < 4; ++i) Vr[kt][i] = *(const f16x8*)(vp + 8 * i); }
        float m = -INFINITY;
#pragma unroll
        for (int kt = 0; kt < 5; ++kt)
#pragma unroll
            for (int e = 0; e < 16; ++e) { const int kl = (e & 3) + 8 * (e >> 2) + 4 * hi; bool ok = (j0 - 128 + 32 * kt + kl) >= 0;
                if (kt == 0) ok = ok && (kl >= ql); if (kt == 4) ok = ok && (kl <= ql);
                if (!ok) S[kt][e] = -INFINITY; m = fmaxf(m, S[kt][e]); }
        m = fmaxf(m, __shfl_xor(m, 32));
        float l = 0.f;
#pragma unroll
        for (int kt = 0; kt < 5; ++kt)
#pragma unroll
            for (int e = 0; e < 16; ++e) { const float p = __builtin_amdgcn_exp2f(S[kt][e] - m); S[kt][e] = p; l += p; }
        l += __shfl_xor(l, 32);
        if (hi == 0) { linv[ql] = __builtin_amdgcn_rcpf(l); lse2[(size_t)(b * SEQ + (j0 + ql) * dil + res) * 12 + gh] = m + __builtin_amdgcn_logf(l); }
        f32x16 O[2];
#pragma unroll
        for (int dt = 0; dt < 2; ++dt) O[dt] = (f32x16){0.f, 0.f, 0.f, 0.f, 0.f, 0.f, 0.f, 0.f, 0.f, 0.f, 0.f, 0.f, 0.f, 0.f, 0.f, 0.f};
#pragma unroll
        for (int kt = 0; kt < 5; ++kt) {
            LAS unsigned char* vbuf = VL + (kt & 1) * 6144;
#pragma unroll
            for (int i = 0; i < 4; ++i) *(LAS f16x8*)(vbuf + (lane >> 1) * VROW + (lane & 1) * 64 + i * 16) = Vr[kt][i];
            asm volatile("s_waitcnt lgkmcnt(0)" ::: "memory");
#pragma unroll
            for (int s2 = 0; s2 < 2; ++s2) {
                u32x4 pa; pa.x = pk_h2(S[kt][8 * s2 + 0], S[kt][8 * s2 + 1]); pa.y = pk_h2(S[kt][8 * s2 + 2], S[kt][8 * s2 + 3]); pa.z = pk_h2(S[kt][8 * s2 + 4], S[kt][8 * s2 + 5]); pa.w = pk_h2(S[kt][8 * s2 + 6], S[kt][8 * s2 + 7]);
#pragma unroll
                for (int dt = 0; dt < 2; ++dt) {
                    const v4i16_t lo = __builtin_amdgcn_ds_read_tr16_b64_v4i16((LAS v4i16_t*)(vbuf + (16 * s2 + 4 * hi + trq) * VROW + (32 * dt + 16 * trg + 4 * trp) * 2));
                    const v4i16_t hh = __builtin_amdgcn_ds_read_tr16_b64_v4i16((LAS v4i16_t*)(vbuf + (16 * s2 + 8 + 4 * hi + trq) * VROW + (32 * dt + 16 * trg + 4 * trp) * 2));
                    const s16x8 bv = {lo[0], lo[1], lo[2], lo[3], hh[0], hh[1], hh[2], hh[3]};
                    O[dt] = __builtin_amdgcn_mfma_f32_32x32x16_f16(__builtin_bit_cast(f16x8, pa), __builtin_bit_cast(f16x8, bv), O[dt], 0, 0, 0); } }
            asm volatile("s_waitcnt lgkmcnt(0)" ::: "memory");
        }
#pragma unroll
        for (int e = 0; e < 16; ++e) { const int q = (e & 3) + 8 * (e >> 2) + 4 * hi; const float il = linv[q];
            h16* op = og + (size_t)(b * SEQ + (j0 + q) * dil + res) * 768 + gh * 64 + ql;
            op[0] = (h16)(O[0][e] * il); op[32] = (h16)(O[1][e] * il); }
        asm volatile("s_waitcnt lgkmcnt(0)" ::: "memory");
    }
}


__device__ __forceinline__ f16x8 fp8x8_to_f16(unsigned w0, unsigned w1) {
    const h16x2 a = __builtin_amdgcn_cvt_scalef32_pk_f16_fp8((int)w0, 1.0f, false), b = __builtin_amdgcn_cvt_scalef32_pk_f16_fp8((int)w0, 1.0f, true),
                c = __builtin_amdgcn_cvt_scalef32_pk_f16_fp8((int)w1, 1.0f, false), d = __builtin_amdgcn_cvt_scalef32_pk_f16_fp8((int)w1, 1.0f, true);
    const u32x4 r = {__builtin_bit_cast(unsigned, a), __builtin_bit_cast(unsigned, b), __builtin_bit_cast(unsigned, c), __builtin_bit_cast(unsigned, d)};
    return __builtin_bit_cast(f16x8, r);
}
template <bool FUSED>
__device__ __forceinline__ void ph_sparse_wave(const Frame& F, h16* qlat, const h16* qr, const unsigned char* ckv8, const unsigned char* kr8, const unsigned short* sel, int ta = 0, int tb = 0) {
    int lane = F.lane; asm volatile("" : "+v"(lane));
    LAS unsigned char* V = F.lds + F.wave * 16384;
    const int qp = (lane & 15) >> 2, pp = lane & 3;
    const int k0 = 4 * (lane >> 4) + qp;
    const int tr0 = k0 * 512 + (pp >> 1) * 16 + (pp & 1) * 8, x0 = k0 & 7;
    const int vw = (lane & 15) * 512, swz = lane & 7;
    const int lane0 = lane;
    const int nit = FUSED ? 8 : (MT - F.gw + F.NGW - 1) / F.NGW;
    for (int it = 0; it < nit; ++it) {
        const int tok = FUSED ? ((it < 4 ? ta : tb - 4) + it) : F.gw + it * F.NGW;
        int ll = lane0; asm volatile("" : "+v"(ll));
        const int c = ll & 15, kq = ll >> 4, hd = c & 7;
        const int b = tok / SEQ, t = tok % SEQ, cnt = (t + 1 < TOPK) ? t + 1 : TOPK, nch = (cnt + 31) >> 5;
        LAS unsigned short* sp = (LAS unsigned short*)(F.lds + XCH_OFF + F.wave * 512) + c;
        *(LAS u32x2*)(F.lds + XCH_OFF + F.wave * 512 + 8 * ll) = *(const u32x2*)(sel + (size_t)tok * TOPK + 4 * ll);
        asm volatile("s_waitcnt lgkmcnt(0)" ::: "memory");
        f16x8 Qf[9]; u32x4 Kr[2][4]; u32x2 Rr[2];
#pragma unroll
        for (int s_ = 0; s_ < 8; ++s_) Qf[s_] = *(const f16x8*)(qlat + (size_t)tok * 2048 + hd * 256 + 64 * (s_ >> 1) + 16 * kq + 8 * (s_ & 1));
        Qf[8] = *(const f16x8*)(qr + (size_t)tok * 256 + hd * 32 + 8 * kq);
        int rowi[2];
#define SW_LOADK() do { _Pragma("unroll") for (int tl = 0; tl < 2; ++tl) { _Pragma("unroll") for (int q4 = 0; q4 < 4; ++q4) Kr[tl][q4] = *(const u32x4*)(ckv8 + (size_t)rowi[tl] * 256 + 64 * q4 + 16 * kq); \
        Rr[tl] = *(const u32x2*)(kr8 + (size_t)rowi[tl] * 32 + 8 * kq); } } while (0)
        rowi[0] = b * SEQ + (int)sp[0]; rowi[1] = b * SEQ + (int)sp[16];
        SW_LOADK();
        float m = -INFINITY, l = 0.f;
        f32x4 O[16];
#pragma unroll
        for (int ft = 0; ft < 16; ++ft) O[ft] = (f32x4){0.f, 0.f, 0.f, 0.f};
        for (int ch = 0; ch < nch; ++ch) {
            const bool more = ch + 1 < nch;
            int rown0 = 0, rown1 = 0; if (more) { rown0 = (int)sp[32 * (ch + 1)]; rown1 = (int)sp[32 * (ch + 1) + 16]; }
            f16x8 Kf[2][9];
#pragma unroll
            for (int tl = 0; tl < 2; ++tl) {
#pragma unroll
                for (int q4 = 0; q4 < 4; ++q4) { Kf[tl][2 * q4] = fp8x8_to_f16(Kr[tl][q4].x, Kr[tl][q4].y); Kf[tl][2 * q4 + 1] = fp8x8_to_f16(Kr[tl][q4].z, Kr[tl][q4].w); }
                Kf[tl][8] = fp8x8_to_f16(Rr[tl].x, Rr[tl].y); }
            if (more) { rowi[0] = b * SEQ + rown0; rowi[1] = b * SEQ + rown1; SW_LOADK(); }
            f32x4 S[2];
#pragma unroll
            for (int tl = 0; tl < 2; ++tl) { S[tl] = (f32x4){0.f, 0.f, 0.f, 0.f};
#pragma unroll
                for (int s_ = 0; s_ < 9; ++s_) S[tl] = __builtin_amdgcn_mfma_f32_16x16x32_f16(Kf[tl][s_], Qf[s_], S[tl], 0, 0, 0); }
            float cm = -INFINITY;
#pragma unroll
            for (int tl = 0; tl < 2; ++tl)
#pragma unroll
                for (int e = 0; e < 4; ++e) { if (32 * ch + 16 * tl + 4 * kq + e >= cnt) S[tl][e] = -INFINITY; cm = fmaxf(cm, S[tl][e]); }
            cm = fmaxf(cm, __shfl_xor(cm, 16)); cm = fmaxf(cm, __shfl_xor(cm, 32));
            if (__any(cm > m + 8.0f)) { const float mn = fmaxf(m, cm), alpha = __builtin_amdgcn_exp2f(m - mn); m = mn; l *= alpha;
#pragma unroll
                for (int ft = 0; ft < 16; ++ft) O[ft] = O[ft] * alpha; }
            float pe[2][4]; float ps = 0.f;
#pragma unroll
            for (int tl = 0; tl < 2; ++tl)
#pragma unroll
                for (int e = 0; e < 4; ++e) { pe[tl][e] = __builtin_amdgcn_exp2f(S[tl][e] - m); ps += pe[tl][e]; }
            l += ps;
#pragma unroll
            for (int tl = 0; tl < 2; ++tl)
#pragma unroll
                for (int s_ = 0; s_ < 8; ++s_) *(LAS f16x8*)(V + vw + tl * 8192 + (((4 * (s_ >> 1) + kq) ^ swz) << 5) + (s_ & 1) * 16) = Kf[tl][s_];
            asm volatile("s_waitcnt lgkmcnt(0)" ::: "memory");
            u32x4 pk; pk.x = pk_h2(pe[0][0], pe[0][1]); pk.y = pk_h2(pe[0][2], pe[0][3]); pk.z = pk_h2(pe[1][0], pe[1][1]); pk.w = pk_h2(pe[1][2], pe[1][3]);
            const f16x8 Pf = __builtin_bit_cast(f16x8, pk);
#pragma unroll
            for (int ft = 0; ft < 16; ++ft) {
                const v4i16_t lo = __builtin_amdgcn_ds_read_tr16_b64_v4i16((LAS v4i16_t*)(V + tr0 + (((ft & 7) ^ x0) << 5) + (ft >> 3) * 256));
                const v4i16_t hi = __builtin_amdgcn_ds_read_tr16_b64_v4i16((LAS v4i16_t*)(V + tr0 + (((ft & 7) ^ x0) << 5) + (ft >> 3) * 256 + 8192));
                const s16x8 av = {lo[0], lo[1], lo[2], lo[3], hi[0], hi[1], hi[2], hi[3]};
                O[ft] = __builtin_amdgcn_mfma_f32_16x16x32_f16(__builtin_bit_cast(f16x8, av), Pf, O[ft], 0, 0, 0); }
            asm volatile("s_waitcnt lgkmcnt(0)" ::: "memory");
        }
        l += __shfl_xor(l, 16); l += __shfl_xor(l, 32);
        if (c < 8) { const float il = __builtin_amdgcn_rcpf(l);
#pragma unroll
            for (int ft = 0; ft < 16; ++ft) { const f32x4 o = O[ft] * il; u32x2 pk; pk.x = pk_h2(o.x, o.y); pk.y = pk_h2(o.z, o.w);
                *(u32x2*)(qlat + (size_t)tok * 2048 + c * 256 + 16 * ft + 4 * kq) = pk; } }
#undef SW_LOADK
    }
}


__device__ __forceinline__ void precomb_tiles(const Frame& F, const Args& args, unsigned char* ws, int t_lo, int t_hi, int wg, int nwg) {
    LAS float* As = (LAS float*)(F.lds); LAS float* Bs = (LAS float*)(F.lds + 64 * 65 * 4);
    for (int tl = t_lo + wg; tl < t_hi; tl += nwg) {
        __syncthreads();
        const bool ql = tl < 192; int hd, rb, xb;
        if (ql) { hd = tl / 24; rb = (tl % 24) / 6; xb = tl % 6; } else { const int t2 = tl - 192; hd = t2 / 64; rb = (t2 % 64) / 16; xb = t2 % 16; }
#pragma unroll
        for (int k = 0; k < 2; ++k) { const int i4 = F.tid + NTHR * k, row = i4 >> 4, c4 = (i4 & 15) * 4;
            if (ql) { const f32x4 a = *(const f32x4*)(args.in[15] + (size_t)(rb * 64 + row) * 512 + hd * 64 + c4), bq = *(const f32x4*)(args.in[14] + (size_t)(xb * 64 + row) * 768 + hd * 96 + c4);
#pragma unroll
                for (int e = 0; e < 4; ++e) { As[row * 65 + c4 + e] = a[e]; Bs[row * 65 + c4 + e] = bq[e]; } }
            else { const f32x4 a = *(const f32x4*)(args.in[18] + (size_t)(hd * 64 + row) * DM + xb * 64 + c4), bq = *(const f32x4*)(args.in[16] + (size_t)(rb * 64 + row) * 512 + hd * 64 + c4);
#pragma unroll
                for (int e = 0; e < 4; ++e) { As[(c4 + e) * 65 + row] = a[e]; Bs[row * 65 + c4 + e] = bq[e]; } } }
        __syncthreads();
        const int j = F.tid & 63, ig = F.wave;
        float acc8[8];
#pragma unroll
        for (int ii = 0; ii < 8; ++ii) acc8[ii] = 0.f;
#pragma unroll 4
        for (int v = 0; v < 64; ++v) { const float bv = Bs[j * 65 + v];
#pragma unroll
            for (int ii = 0; ii < 8; ++ii) acc8[ii] += As[(ig * 8 + ii) * 65 + v] * bv; }
        if (ql) { const float gj = args.in[12][xb * 64 + j]; h16* o = (h16*)(ws + OW_4);
#pragma unroll
            for (int ii = 0; ii < 8; ++ii) o[(size_t)(hd * 256 + rb * 64 + ig * 8 + ii) * QL + xb * 64 + j] = (h16)(acc8[ii] * gj); }
        else { h16* o = (h16*)(ws + OW_OV);
#pragma unroll
            for (int ii = 0; ii < 8; ++ii) o[(size_t)(xb * 64 + ig * 8 + ii) * 2048 + hd * 256 + rb * 64 + j] = (h16)acc8[ii]; }
    }
    __syncthreads();
}


__device__ __forceinline__ void ph_topk_sparse(const Frame& F, const h16* qi, const h16* ki, const float* wi, unsigned short* sel, h16* qlat, const h16* qr, const unsigned char* ckv8, const unsigned char* kr8) {
    LAS unsigned* hist = (LAS unsigned*)(F.lds + F.wave * 16384);
    for (int p = F.gw; p < 2048; p += F.NGW) {
        int ta, tb;
        if (p < 4 * 480) { const int b = p & 3, pj = p >> 2; ta = b * SEQ + 4 * (64 + pj); tb = b * SEQ + 4 * (1023 - pj);
            tk_group(F, qi, ki, wi, sel, b, 4 * (64 + pj), hist);
            tk_group(F, qi, ki, wi, sel, b, 4 * (1023 - pj), hist); }
        else { const int g0 = 2 * (p - 4 * 480);
#pragma unroll
            for (int gg = 0; gg < 2; ++gg) { const int g = g0 + gg, b = g >> 6, t0 = (g & 63) * 4;
                int l0 = F.lane; asm volatile("" : "+v"(l0));
                for (int i = l0; i < 4 * TOPK; i += 64) { const int q = i >> 8, k = i & 255; sel[(size_t)(b * SEQ + t0 + q) * TOPK + k] = (unsigned short)(k <= t0 + q ? k : 0); } }
            ta = (g0 >> 6) * SEQ + (g0 & 63) * 4; tb = ((g0 + 1) >> 6) * SEQ + ((g0 + 1) & 63) * 4; }
        asm volatile("s_waitcnt vmcnt(0) lgkmcnt(0)" ::: "memory");
        ph_sparse_wave<true>(F, qlat, qr, ckv8, kr8, sel, ta, tb);
        asm volatile("s_waitcnt lgkmcnt(0)" ::: "memory");
    }
}

__global__ void __launch_bounds__(NTHR, 2) mega_fwd(Args args) {
    extern __shared__ __attribute__((aligned(16))) unsigned char lds_raw[];
    Frame F; F.lds = (LAS unsigned char*)lds_raw; F.tid = threadIdx.x; F.lane = F.tid & 63; F.wave = __builtin_amdgcn_readfirstlane(F.tid >> 6);
    F.G = gridDim.x; F.gw = blockIdx.x * NWAVES + F.wave; F.NGW = F.G * NWAVES;
    volatile LAS unsigned* MISC = (volatile LAS unsigned*)(F.lds + MISC_OFF);
    unsigned char* ws = args.ws;
    for (int u = F.tid; u < (LDS_BYTES - LDSCTL_OFF) / 4; u += NTHR) ((LAS unsigned*)(F.lds + LDSCTL_OFF))[u] = 0u;
    __syncthreads();
    XcdBarrier bar = xcd_barrier_post((unsigned*)(ws + OFF_CTL) + CW_BAR, MISC + 8);
    const int lo = args.ph_lo, hi = args.ph_hi;
#define IN(k) (lo <= (k) && (k) < hi)
#define SEAM(k) do { if (IN(k) && IN((k) + 1)) xcd_barrier(bar); } while (0)
    float* mod = (float*)(ws + OFF_MOD); float2* tab = (float2*)(ws + OFF_ROPE);
    h16* Hb = (h16*)(ws + OFF_H); h16* Ab = (h16*)(ws + OFF_A); float* Fb = (float*)(ws + OFF_F);

    if (IN(0)) {
        LAS float* scr = (LAS float*)(F.lds + F.wave * 16384);
        for (int ch = blockIdx.x; ch < (NMOD * DM) / 36; ch += F.G) {
            LAS float* sl = (LAS float*)(F.lds);
            LAS float* part = (LAS float*)(F.lds + 16384);
            __syncthreads();
            for (int i = F.tid; i < 4 * DM; i += NTHR) sl[i] = silu_f(args.in[1][i]);
            __syncthreads();
            const int ln = F.lane < 36 ? F.lane : 35;
            const float* wm = args.in[3] + (size_t)(F.wave * 128) * (NMOD * DM) + ch * 36 + ln;
            float a0 = 0.f, a1 = 0.f, a2 = 0.f, a3 = 0.f;
#pragma unroll 16
            for (int k = 0; k < 128; ++k) { const float w = wm[(size_t)k * (NMOD * DM)]; const int kk = F.wave * 128 + k; a0 += sl[kk] * w; a1 += sl[DM + kk] * w; a2 += sl[2 * DM + kk] * w; a3 += sl[3 * DM + kk] * w; }
            part[(F.wave * 4 + 0) * 64 + F.lane] = a0; part[(F.wave * 4 + 1) * 64 + F.lane] = a1; part[(F.wave * 4 + 2) * 64 + F.lane] = a2; part[(F.wave * 4 + 3) * 64 + F.lane] = a3;
            __syncthreads();
            if (F.tid < 256 && (F.tid & 63) < 36) { const int b = F.tid >> 6, l = F.tid & 63; float sm = args.in[4][ch * 36 + l];
#pragma unroll
                for (int w = 0; w < 8; ++w) sm += part[(w * 4 + b) * 64 + l];
                mod[b * (NMOD * DM) + ch * 36 + l] = sm; }
            __syncthreads();
        }
        for (int idx = blockIdx.x * NTHR + F.tid; idx < MT * 48; idx += F.G * NTHR) { const int tok = idx / 48, i = idx % 48;
            const float inv = (i < 32) ? powf(10000.f, -(float)i / 32.f) : powf(10000.f, -(float)(i - 32) / 16.f);
            const float ang = (float)((const int*)args.in[2])[tok] * inv; tab[idx] = make_float2(cosf(ang), sinf(ang)); }
        tr_job_mapped(F, args, 0, 2 * FF, 0, DM, (h16*)(ws + OW_GU1), nullptr, scr, 0);
        if (F.G != 256) {
            tr_job_plain(F, args.in[8], DM, DM, FF, (h16*)(ws + OW_D1), scr, 768);
            tr_job_mapped(F, args, 2, NIN3, 0, DM, (h16*)(ws + OW_IN), nullptr, scr, 128);
            tr_job_plain(F, args.in[11] + C_GATE, DIN, 2048, DM, (h16*)(ws + OW_GATE), scr, 1664);
            tr_job_mapped(F, args, 3, 512, 2048, QL, (h16*)(ws + OW_4), args.in[12], scr, 640);
            tr_job_plain(F, args.in[19], DM, DM, 256, (h16*)(ws + OW_UPB), scr, 736);
            tr_job_plain(F, args.in[20], DM, DM, DM, (h16*)(ws + OW_O), scr, 864);
            tr_job_mapped(F, args, 1, 2 * FF, 0, DM, (h16*)(ws + OW_GU2), nullptr, scr, 1376);
            tr_job_plain(F, args.in[25], DM, DM, FF, (h16*)(ws + OW_D2), scr, 96);
            precomb_tiles(F, args, ws, 0, 192, (int)blockIdx.x, F.G);
            tr_job_plain(F, args.in[18], DM, DM, 512, (h16*)(ws + OW_UPA), scr, 256);
        }
    }
    SEAM(0);
    if (IN(1)) ph_normmod(F, args.in[0], args.in[5], mod, 1, 0, Hb);
    SEAM(1);
    if (IN(2)) { pg8::Gemm g{Hb, (const h16*)(ws + OW_GU1), MT, 2 * FF, DM}; pg8::StaticOrder S; S.init(MT, 2 * FF, F.G, (int)blockIdx.x); pg8::EpiSwiGLU E{Ab};
        pg8::gemm_phase<pg8::EpiSwiGLU, true>(F.lds, g, S, E);
        if (F.G == 256 && blockIdx.x >= 128) {
            Frame F2 = F; F2.gw = ((int)blockIdx.x - 128) * NWAVES + F.wave; F2.NGW = 128 * NWAVES; LAS float* scr = (LAS float*)(F.lds + F.wave * 16384);
            tr_job_plain(F2, args.in[8], DM, DM, FF, (h16*)(ws + OW_D1), scr, 0);
            tr_job_mapped(F2, args, 2, NIN3, 0, DM, (h16*)(ws + OW_IN), nullptr, scr, 384);
            tr_job_mapped(F2, args, 3, 512, 2048, QL, (h16*)(ws + OW_4), args.in[12], scr, 896);
            tr_job_mapped(F2, args, 1, 2 * FF, 0, DM, (h16*)(ws + OW_GU2), nullptr, scr, 640);
            precomb_tiles(F, args, ws, 0, 192, (int)blockIdx.x - 128, 128);
            for (int i = ((int)blockIdx.x - 128) * NTHR + F.tid; i < (int)(MiB / 16); i += 128 * NTHR) ((u32x4*)(ws + OW_BD))[i] = (u32x4){0u, 0u, 0u, 0u}; } }
    SEAM(2);
    if (IN(3)) { pg8::Gemm g{Ab, (const h16*)(ws + OW_D1), MT, DM, FF}; pg8::StaticOrder S; S.init(MT, DM, F.G, (int)blockIdx.x); pg8::EpiH16 E{(h16*)Fb};
        pg8::gemm_phase<pg8::EpiH16, false>(F.lds, g, S, E); }
    SEAM(3);
    if (IN(4)) ph_resnorm<false, true>(F, args.in[0], (const h16*)Fb, args.in[9], mod, 2, 0.5f, args.out, true, args.in[10], 4, 3, Hb);
    SEAM(4);
    if (IN(5)) { pg8::Gemm g{Hb, (const h16*)(ws + OW_IN), MT, NIN3, DM}; pg8::StaticOrder S; S.init(MT, NIN3, F.G, (int)blockIdx.x);
        pg8::EpiIn E{(h16*)(ws + OFF_CKV), (h16*)(ws + OFF_CQ), (h16*)(ws + OFF_KR), (h16*)(ws + OFF_KI), (h16*)(ws + OFF_QB), (h16*)(ws + OFF_KB), (h16*)(ws + OFF_VT), (float*)(ws + OFF_WI), (float*)(ws + OFF_SSQ),
                     args.in[13], tab, (LAS float*)(F.lds + XCH_OFF)};
        pg8::gemm_phase<pg8::EpiIn, true>(F.lds, g, S, E); }
    SEAM(5);
    if (IN(6)) { for (int tk_ = blockIdx.x * NTHR + F.tid; tk_ < MT; tk_ += F.G * NTHR) { const f32x4 s0 = *(const f32x4*)((const float*)(ws + OFF_SSQ) + tk_ * 8), s1 = *(const f32x4*)((const float*)(ws + OFF_SSQ) + tk_ * 8 + 4);
            ((float*)(ws + OFF_RSTDQ))[tk_] = rsqrtf((((s0.x + s0.y) + (s0.z + s0.w)) + ((s1.x + s1.y) + (s1.z + s1.w))) * (1.f / QL) + EPS); } }
    if (IN(6)) ph_dilated_mfma(F, (const h16*)(ws + OFF_QB), (const h16*)(ws + OFF_KB), (const h16*)(ws + OFF_VT), (h16*)(ws + OFF_OG), (float*)(ws + OFF_LSE));
    SEAM(6);
    if (IN(7)) { pg8::Gemm g{(const h16*)(ws + OFF_CQ), (const h16*)(ws + OW_4), MT, N4, QL}; pg8::StaticOrder S; S.init(MT, N4, F.G, (int)blockIdx.x);
        pg8::Epi4 E{(h16*)(ws + OFF_QLAT), (h16*)(ws + OFF_QR), (h16*)(ws + OFF_QI), (const float*)(ws + OFF_RSTDQ), tab};
        pg8::gemm_phase<pg8::Epi4, true>(F.lds, g, S, E);
        if (F.G == 256 && blockIdx.x >= 128) {
            Frame F2 = F; F2.gw = ((int)blockIdx.x - 128) * NWAVES + F.wave; F2.NGW = 128 * NWAVES; LAS float* scr = (LAS float*)(F.lds + F.wave * 16384);
            tr_job_plain(F2, args.in[11] + C_GATE, DIN, 2048, DM, (h16*)(ws + OW_GATE), scr, 0);
            tr_job_plain(F2, args.in[19], DM, DM, 256, (h16*)(ws + OW_UPB), scr, 512);
            tr_job_plain(F2, args.in[20], DM, DM, DM, (h16*)(ws + OW_O), scr, 640);
            tr_job_plain(F2, args.in[18], DM, DM, 512, (h16*)(ws + OW_UPA), scr, 256);
            for (int it = F2.gw; it < 4 * 16; it += F2.NGW) { const int kb = it >> 4, nb = it & 15, n0 = nb * 32, hl = (n0 >> 6) & 3;
                tr_item(args.in[16], 512, n0 + (F.lane & 31), true, nullptr, kb * 64, (h16*)(ws + OW_BD) + (size_t)n0 * 1024 + 256 * hl, 1024, scr, F.lane); } } }
    SEAM(7);
    if (IN(8)) { ph_combine(F, (const h16*)(ws + OFF_OG), (const float*)(ws + OFF_LSE), (h16*)(ws + OFF_OB));
        ph_topk_sparse(F, (const h16*)(ws + OFF_QI), (const h16*)(ws + OFF_KI), (const float*)(ws + OFF_WI), (unsigned short*)(ws + OFF_SEL),
                       (h16*)(ws + OFF_QLAT), (const h16*)(ws + OFF_QR), (const unsigned char*)(ws + OFF_CKV), (const unsigned char*)(ws + OFF_KR)); }
    SEAM(8);
    if (IN(9) && F.G == 256) { const bool first = blockIdx.x < 128;
        pg8::Gemm g{first ? (const h16*)(ws + OFF_QLAT) : (const h16*)(ws + OFF_OB), first ? (const h16*)(ws + OW_BD) : (const h16*)(ws + OW_UPB), MT, first ? 512 : DM, first ? 1024 : 256, first ? 2048 : 0, first ? 1024 : 0};
        pg8::StaticOrder S; S.init(MT, first ? 512 : DM, 128, first ? (int)blockIdx.x : (int)blockIdx.x - 128);
        pg8::EpiH16 E{first ? (h16*)(ws + OFF_OA) : (h16*)(ws + OFF_Y2), first ? 512 : DM};
        pg8::gemm_phase<pg8::EpiH16, false>(F.lds, g, S, E); }
    SEAM(9);
    SEAM(9);
    if (IN(10)) { pg8::StaticOrder S; S.init(MT, DM, F.G, (int)blockIdx.x); h16* Y1 = (h16*)(ws + OFF_Y1); h16* Y2 = (h16*)(ws + OFF_Y2);
        { pg8::Gemm g{(const h16*)(ws + OFF_OA), (const h16*)(ws + OW_UPA), MT, DM, 512}; pg8::EpiH16 E{Y1}; pg8::gemm_phase<pg8::EpiH16, false>(F.lds, g, S, E); }
        { pg8::Gemm g{Hb, (const h16*)(ws + OW_GATE), MT, DM, DM}; pg8::EpiGate E{Y1, Y1, 0}; pg8::gemm_phase<pg8::EpiGate, false>(F.lds, g, S, E); }
        { pg8::Gemm g{Hb, (const h16*)(ws + OW_GATE) + (size_t)DM * DM, MT, DM, DM}; pg8::EpiGate E{Y2, Y1, 1}; pg8::gemm_phase<pg8::EpiGate, false>(F.lds, g, S, E); } }
    SEAM(10);
    if (IN(11)) { pg8::Gemm g{(const h16*)(ws + OFF_Y1), (const h16*)(ws + OW_O), MT, DM, DM}; pg8::StaticOrder S; S.init(MT, DM, F.G, (int)blockIdx.x); pg8::EpiH16 E{(h16*)(ws + OFF_YF)};
        pg8::gemm_phase<pg8::EpiH16, false>(F.lds, g, S, E); }
    SEAM(11);
    if (IN(12)) ph_resnorm<true, true>(F, args.out, (const h16*)(ws + OFF_YF), args.in[21], mod, 5, 1.0f, ws + OFF_F, true, args.in[22], 7, 6, Hb);
    SEAM(12);
    if (IN(13)) { pg8::Gemm g{Hb, (const h16*)(ws + OW_GU2), MT, 2 * FF, DM}; pg8::StaticOrder S; S.init(MT, 2 * FF, F.G, (int)blockIdx.x); pg8::EpiSwiGLU E{Ab};
        pg8::gemm_phase<pg8::EpiSwiGLU, true>(F.lds, g, S, E);
        if (F.G == 256 && blockIdx.x >= 128) { Frame F2 = F; F2.gw = ((int)blockIdx.x - 128) * NWAVES + F.wave; F2.NGW = 128 * NWAVES;
            tr_job_plain(F2, args.in[25], DM, DM, FF, (h16*)(ws + OW_D2), (LAS float*)(F.lds + F.wave * 16384), 0); } }
    SEAM(13);
    if (IN(14)) { pg8::Gemm g{Ab, (const h16*)(ws + OW_D2), MT, DM, FF}; pg8::StaticOrder S; S.init(MT, DM, F.G, (int)blockIdx.x); pg8::EpiH16 E{(h16*)(ws + OFF_F + 32 * MiB)};
        pg8::gemm_phase<pg8::EpiH16, false>(F.lds, g, S, E); }
    SEAM(14);
    if (IN(15)) ph_resnorm<true, false>(F, ws + OFF_F, (const h16*)(ws + OFF_F + 32 * MiB), args.in[26], mod, 8, 0.5f, args.out, false, nullptr, 0, 0, nullptr);
#undef IN
#undef SEAM
}


extern "C" void kernel_launch(void* const* d_in, const int* in_sizes, int n_in, void* d_out, int out_size, void* d_ws, size_t ws_size, hipStream_t stream) {
    if (n_in != 27 || ws_size < WS_END || out_size != MT * DM) { fprintf(stderr, "kernel_launch: unexpected shapes (n_in %d ws %zu out %d)\n", n_in, ws_size, out_size); return; }
    static int grid = 0;
    if (grid == 0) {
        int dev = 0, cus = 0, per_cu = 0;
        if (hipGetDevice(&dev) != hipSuccess || hipDeviceGetAttribute(&cus, hipDeviceAttributeMultiprocessorCount, dev) != hipSuccess) { grid = -1; return; }
        if (hipFuncSetAttribute((const void*)mega_fwd, hipFuncAttributeMaxDynamicSharedMemorySize, LDS_BYTES) != hipSuccess) { fprintf(stderr, "kernel_launch: hipFuncSetAttribute failed\n"); grid = -1; return; }
        if (hipOccupancyMaxActiveBlocksPerMultiprocessor(&per_cu, (const void*)mega_fwd, NTHR, LDS_BYTES) != hipSuccess || per_cu < 1) { fprintf(stderr, "kernel_launch: occupancy query says %d blocks/CU\n", per_cu); grid = -1; return; }
        grid = cus;
    }
    if (grid < 0) return;
    hipMemsetAsync((char*)d_ws + OFF_CTL, 0, 1 * MiB, stream);
    Args a{}; for (int i = 0; i < 27; ++i) a.in[i] = (const float*)d_in[i]; a.out = (float*)d_out; a.ws = (unsigned char*)d_ws; a.ph_lo = 0; a.ph_hi = 16;
    void* kargs[] = {&a};
    const hipError_t e = hipLaunchCooperativeKernel((const void*)mega_fwd, dim3(grid), dim3(NTHR), kargs, LDS_BYTES, stream);
    if (e != hipSuccess) fprintf(stderr, "kernel_launch: cooperative launch failed: %s (grid %d)\n", hipGetErrorString(e), grid);
    (void)in_sizes;
}
```

```cpp
#include <hip/hip_runtime.h>
#include <hip/hip_fp16.h>
#include <cstdio>
#include <cstdint>

constexpr int NB = 4, SEQ = 4096, DM = 1024, MT = NB * SEQ, FF = 2816;
constexpr int QL = 384, KVL = 256, DNOPE = 64, DROPE = 32, DVA = 64, HA = 8, HI = 8, DI = 32, TOPK = 256;
constexpr int NG = 3, HB = 4, DHB = 64, NMOD = 9, DIN = 5064;
constexpr int C_CQ = 0, C_CKV = 384, C_KR = 640, C_KI = 672, C_WI = 704, C_QKV = 712, C_GATE = 3016;
constexpr float EPS = 1e-6f, LOG2E = 1.4426950408889634f;
typedef _Float16 h16;

constexpr size_t MiB = 1u << 20;
constexpr size_t OFF_CTL = 0, OFF_MOD = 1 * MiB, OFF_ROPE = 2 * MiB, OFF_W = 8 * MiB, OFF_H = 60 * MiB, OFF_A = 92 * MiB, OFF_F = 180 * MiB, OFF_SP = 244 * MiB, WS_END = 256 * MiB;
constexpr size_t OFF_QB = OFF_A, OFF_KB = OFF_A + 24 * MiB, OFF_VT = OFF_A + 48 * MiB, OFF_CKV = OFF_A + 72 * MiB, OFF_KR = OFF_A + 80 * MiB, OFF_KI = OFF_A + 81 * MiB,
                 OFF_WI = OFF_A + 82 * MiB, OFF_SSQ = OFF_A + 82 * MiB + 512 * 1024, OFF_CQ = OFF_SP;
constexpr size_t OFF_RSTDQ = OFF_A + 83 * MiB;
constexpr size_t OFF_OG = OFF_F, OFF_LSE = OFF_F + 24 * MiB, OFF_QLAT = OFF_A, OFF_QR = OFF_A + 64 * MiB, OFF_QI = OFF_F + 25 * MiB, OFF_SEL = OFF_F + 33 * MiB, OFF_OB = OFF_SP;
constexpr size_t OFF_Y1 = OFF_F, OFF_Y2 = OFF_F + 32 * MiB, OFF_YF = OFF_A;

__device__ __forceinline__ float silu_f(float v) { return v / (1.f + __expf(-v)); }
__device__ __forceinline__ float sigm_f(float v) { return 1.f / (1.f + __expf(-v)); }
__host__ __device__ __forceinline__ int dil_of(int g) { return g == 0 ? 1 : (g == 1 ? 4 : 16); }
__device__ __forceinline__ unsigned fkey(float f) { const unsigned u = __float_as_uint(f); return (u & 0x80000000u) ? ~u : (u | 0x80000000u); }


#define LAS __attribute__((address_space(3)))
#define GAS __attribute__((address_space(1)))
typedef _Float16 f16x8 __attribute__((ext_vector_type(8)));
typedef float f32x4 __attribute__((ext_vector_type(4)));
typedef float f32x2 __attribute__((ext_vector_type(2)));
typedef unsigned u32x4 __attribute__((ext_vector_type(4)));
typedef unsigned u32x2 __attribute__((ext_vector_type(2)));
typedef _Float16 h16x2 __attribute__((ext_vector_type(2)));
__device__ __forceinline__ unsigned pk_h2(float lo, float hi) { f32x2 v = {lo, hi}; h16x2 h = __builtin_convertvector(v, h16x2); return __builtin_bit_cast(unsigned, h); }

namespace pg8 {
constexpr int BM = 256, BK = 64, HALF = 128, HTB = HALF * BK * 2, STAGE_BYTES = 8 * HTB, NXCD = 8, WGM = 8;
__host__ __device__ __forceinline__ int lds_byte(int r, int c) { const int st = (r >> 4) * 2 + (c >> 5), rr = r & 15, cc = c & 31, ob = rr * 64 + cc * 2; return st * 1024 + (ob ^ (((ob >> 9) & 1) << 5)); }
__host__ __device__ __forceinline__ void stage_rc(int b, int& R, int& C) { const int st = b / 1024, sb = b % 1024, swz = sb ^ (((sb >> 9) & 1) << 5); R = (st >> 1) * 16 + swz / 64; C = (st & 1) * 32 + (swz % 64) / 2; }
__host__ __device__ __forceinline__ int perm32(int rho) { const int n = rho >> 4, i = rho & 15; return 8 * (i >> 2) + 4 * n + (i & 3); }
struct Unit { int pm, pn; };
struct Gemm { const h16* A; const h16* Bt; int M, N, K; int lda = 0, koffA = 0; };
struct StaticOrder {
    int nM, nN, nwg, G, c;
    __host__ __device__ void init(int M, int N, int G_, int c_) { nM = M / BM; nN = N / BM; nwg = nM * nN; G = G_; c = c_; }
    __host__ __device__ bool next(int i, Unit& u) const {
        const long L = (long)i * G + c; if (L >= nwg) return false;
        int wgid = (int)L; { const int q = nwg / NXCD, r = nwg % NXCD, xcd = wgid % NXCD, off = wgid / NXCD; wgid = (xcd < r ? xcd * (q + 1) : r * (q + 1) + (xcd - r) * q) + off; }
        const int nig = WGM * nN, gid = wgid / nig, fm = gid * WGM, gsz = (nM - fm) < WGM ? (nM - fm) : WGM;
        u.pm = fm + ((wgid % nig) % gsz); u.pn = (wgid % nig) / gsz; return true;
    }
};
template <class Epi, bool ALIGN_EPI>
__device__ __forceinline__ void gemm_phase(LAS unsigned char* lds, const Gemm g, const StaticOrder& S, const Epi& E) {
    const int tid = threadIdx.x, wid = __builtin_amdgcn_readfirstlane(tid >> 6), lane = tid & 63, wr = wid >> 2, wc = wid & 3, fr = lane & 15, fq = lane >> 4;
    const int K = g.K, nt = K / BK, lda = g.lda ? g.lda : g.K;
    unsigned voffA[2], voffB[2];
#pragma unroll
    for (int i = 0; i < 2; ++i) { int R, C; stage_rc(tid * 16 + i * 8192, R, C); const int Rb = Epi::PERM ? ((R & ~31) + perm32(R & 31)) : R;
        voffA[i] = (unsigned)(R * lda + C) * 2u; voffB[i] = (unsigned)(Rb * K + C) * 2u; }
    const size_t kstep = (size_t)(BK * 2);
    const size_t hstep = (size_t)HALF * K * 2, hstepA = (size_t)HALF * lda * 2;
    const size_t tstep = 2 * hstep, tstepA = 2 * hstepA, kofA = (size_t)g.koffA * 2;
    const unsigned ldsw = (unsigned)wid * 1024u;
    const int aoff = lds_byte(wr * 64 + fr, fq * 8), boff = lds_byte(wc * 32 + fr, fq * 8);
#define PG8_SA(b, h) (((b) * 2 + (h)) * HTB)
#define PG8_SB(b, h) ((4 + (b) * 2 + (h)) * HTB)
#define PG8_STAGE(bufoff, gbase, voff) do { _Pragma("unroll") for (int _i = 0; _i < 2; ++_i) \
        __builtin_amdgcn_global_load_lds((const unsigned*)((const char*)(gbase) + (voff)[_i]), (LAS unsigned*)(lds + (bufoff) + ldsw + _i * 8192), 16, 0, 0); } while (0)
#define PG8_LDA(dst, b, h) do { _Pragma("unroll") for (int m = 0; m < 4; ++m) _Pragma("unroll") for (int k = 0; k < 2; ++k) dst[m][k] = *(const LAS f16x8*)(lds + PG8_SA(b, h) + aoff + m * 2048 + k * 1024); } while (0)
#define PG8_LDB(dst, b, h) do { _Pragma("unroll") for (int n = 0; n < 2; ++n) _Pragma("unroll") for (int k = 0; k < 2; ++k) dst[n][k] = *(const LAS f16x8*)(lds + PG8_SB(b, h) + boff + n * 2048 + k * 1024); } while (0)
#define PG8_MMA(ai, bj, At, Bt) do { __builtin_amdgcn_s_setprio(1); _Pragma("unroll") for (int m = 0; m < 4; ++m) _Pragma("unroll") for (int n = 0; n < 2; ++n) _Pragma("unroll") for (int k = 0; k < 2; ++k) \
        acc[ai][bj][m][n] = __builtin_amdgcn_mfma_f32_16x16x32_f16(Bt[n][k], At[m][k], acc[ai][bj][m][n], 0, 0, 0); __builtin_amdgcn_s_setprio(0); } while (0)
#define PG8_WAIT_V(n) asm volatile("s_waitcnt vmcnt(" #n ")" ::: "memory")
#define PG8_WAIT_L(n) asm volatile("s_waitcnt lgkmcnt(" #n ")" ::: "memory")
#define PG8_BAR __builtin_amdgcn_s_barrier()
#define PG8_SCHED __builtin_amdgcn_sched_barrier(0)
    Unit cur, nxt; int ui = 0;
    if (!S.next(0, cur)) return;
    f32x4 acc[2][2][4][2];
#pragma unroll
    for (int a = 0; a < 2; ++a)
#pragma unroll
        for (int b = 0; b < 2; ++b)
#pragma unroll
            for (int m = 0; m < 4; ++m)
#pragma unroll
                for (int n = 0; n < 2; ++n) acc[a][b][m][n] = (f32x4){0.f, 0.f, 0.f, 0.f};
    f16x8 At[4][2], B0[2][2], B1[2][2];
    const char* cA = (const char*)g.A + (size_t)cur.pm * tstepA + (size_t)cur.pn * kofA; const char* cB = (const char*)g.Bt + (size_t)cur.pn * tstep;
    PG8_STAGE(PG8_SB(0, 0), cB, voffB); PG8_STAGE(PG8_SB(0, 1), cB + hstep, voffB); PG8_STAGE(PG8_SA(0, 0), cA, voffA); PG8_STAGE(PG8_SA(0, 1), cA + hstepA, voffA);
    if (wr == 1) PG8_BAR;
    PG8_WAIT_V(2); PG8_BAR;
    PG8_STAGE(PG8_SB(1, 0), cB + kstep, voffB); PG8_STAGE(PG8_SA(1, 0), cA + kstep, voffA); PG8_STAGE(PG8_SB(1, 1), cB + hstep + kstep, voffB);
    PG8_WAIT_V(6); PG8_BAR;
    for (;;) {
        const bool has_next = S.next(ui + 1, nxt);
        const char* nA = has_next ? (const char*)g.A + (size_t)nxt.pm * tstepA + (size_t)nxt.pn * kofA : cA; const char* nB = has_next ? (const char*)g.Bt + (size_t)nxt.pn * tstep : cB;
        for (int t = 0; t < nt; t += 2) {
            const bool last = (t == nt - 2);
            const char* a1 = cA + (size_t)(t + 1) * kstep;
            const char* a2 = last ? nA : cA + (size_t)(t + 2) * kstep; const char* b2 = last ? nB : cB + (size_t)(t + 2) * kstep;
            const char* a3 = a2 + kstep; const char* b3 = b2 + kstep;
            PG8_LDB(B0, 0, 0); PG8_LDB(B1, 0, 1); PG8_SCHED; PG8_LDA(At, 0, 0); PG8_STAGE(PG8_SA(1, 1), a1 + hstepA, voffA);
            PG8_WAIT_V(8); PG8_WAIT_L(0); PG8_BAR; PG8_MMA(0, 0, At, B0); PG8_MMA(0, 1, At, B1); PG8_BAR; PG8_SCHED;
            PG8_LDA(At, 0, 1); PG8_STAGE(PG8_SB(0, 0), b2, voffB); PG8_STAGE(PG8_SB(0, 1), b2 + hstep, voffB); PG8_STAGE(PG8_SA(0, 0), a2, voffA);
            PG8_WAIT_V(8); PG8_WAIT_L(0); PG8_BAR; PG8_MMA(1, 0, At, B0); PG8_MMA(1, 1, At, B1); PG8_BAR; PG8_SCHED;
            PG8_LDB(B0, 1, 0); PG8_LDB(B1, 1, 1); PG8_SCHED; PG8_LDA(At, 1, 0); PG8_STAGE(PG8_SA(0, 1), a2 + hstepA, voffA);
            PG8_WAIT_V(8); PG8_WAIT_L(0); PG8_BAR; PG8_MMA(0, 0, At, B0); PG8_MMA(0, 1, At, B1); PG8_BAR; PG8_SCHED;
            PG8_LDA(At, 1, 1); PG8_STAGE(PG8_SB(1, 0), b3, voffB); PG8_STAGE(PG8_SB(1, 1), b3 + hstep, voffB); PG8_STAGE(PG8_SA(1, 0), a3, voffA);
            PG8_WAIT_V(8); PG8_WAIT_L(0); PG8_BAR; PG8_MMA(1, 0, At, B0); PG8_MMA(1, 1, At, B1); PG8_BAR; PG8_SCHED;
        }
        if constexpr (ALIGN_EPI) { if (wr == 0) PG8_BAR; }
        { int l2 = lane; asm volatile("" : "+v"(l2)); E(acc, cur, wr, wc, l2 & 15, l2 >> 4); }
        if (!has_next) break;
#pragma unroll
        for (int a = 0; a < 2; ++a)
#pragma unroll
            for (int b = 0; b < 2; ++b)
#pragma unroll
                for (int m = 0; m < 4; ++m)
#pragma unroll
                    for (int n = 0; n < 2; ++n) acc[a][b][m][n] = (f32x4){0.f, 0.f, 0.f, 0.f};
        cur = nxt; cA = nA; cB = nB; ++ui;
        if constexpr (ALIGN_EPI) { if (wr == 1) PG8_BAR; }
    }
    PG8_WAIT_V(0);
    if constexpr (!ALIGN_EPI) { if (wr == 0) PG8_BAR; }
    PG8_BAR;
#undef PG8_SA
#undef PG8_SB
#undef PG8_STAGE
#undef PG8_LDA
#undef PG8_LDB
#undef PG8_MMA
#undef PG8_WAIT_V
#undef PG8_WAIT_L
#undef PG8_BAR
#undef PG8_SCHED
}
struct EpiF32 {
    static constexpr bool PERM = false;
    float* C; int ldc;
    __device__ __forceinline__ void operator()(const f32x4 (&acc)[2][2][4][2], const Unit& u, int wr, int wc, int fr, int fq) const {
        const int row0 = u.pm * BM + wr * 64 + fr, col0 = u.pn * BM + wc * 32 + 4 * fq;
#pragma unroll
        for (int ai = 0; ai < 2; ++ai)
#pragma unroll
            for (int m = 0; m < 4; ++m) { float* rowp = C + (size_t)(row0 + ai * HALF + m * 16) * ldc + col0;
#pragma unroll
                for (int bj = 0; bj < 2; ++bj)
#pragma unroll
                    for (int n = 0; n < 2; ++n) *(f32x4*)(rowp + bj * HALF + n * 16) = acc[ai][bj][m][n]; }
    }
};
struct EpiSwiGLU {
    static constexpr bool PERM = true;
    h16* O;
    __device__ __forceinline__ void operator()(const f32x4 (&acc)[2][2][4][2], const Unit& u, int wr, int wc, int fr, int fq) const {
        const int row0 = u.pm * BM + wr * 64 + fr, col0 = u.pn * HALF + wc * 32 + 8 * fq;
#pragma unroll
        for (int ai = 0; ai < 2; ++ai)
#pragma unroll
            for (int m = 0; m < 4; ++m) { h16* rowp = O + (size_t)(row0 + ai * HALF + m * 16) * FF + col0;
                float v[8];
#pragma unroll
                for (int n = 0; n < 2; ++n)
#pragma unroll
                    for (int e = 0; e < 4; ++e) { const float gg = acc[ai][0][m][n][e], uu = acc[ai][1][m][n][e]; v[n * 4 + e] = gg * __builtin_amdgcn_rcpf(1.f + __builtin_amdgcn_exp2f(-gg * LOG2E)) * uu; }
                u32x4 w; w.x = pk_h2(v[0], v[1]); w.y = pk_h2(v[2], v[3]); w.z = pk_h2(v[4], v[5]); w.w = pk_h2(v[6], v[7]);
                *(u32x4*)rowp = w; }
    }
};

struct EpiIn {
    static constexpr bool PERM = false;
    h16 *ckv, *cq, *kr, *ki, *qb, *kb, *vT; float *wi, *ssq; const float* gckv; const float2* tab; LAS float* X;
    __device__ __forceinline__ void rope64(const f32x4 (&acc)[2][2][4][2], const Unit& u, int wr, int wc, int fr, int fq, h16* dst, int tl, float scale) const {
        const int tok0 = u.pm * BM + wr * 64 + fr;
        f32x4 tc[4], tn[4];
        { const f32x4* tp = (const f32x4*)(tab + (size_t)tok0 * 48 + 4 * fq); tc[0] = tp[0]; tc[1] = tp[1]; tc[2] = tp[8]; tc[3] = tp[9]; }
#pragma unroll
        for (int rr = 0; rr < 8; ++rr) { const int ai = rr >> 2, m = rr & 3, tok = tok0 + ai * HALF + m * 16;
            if (rr < 7) { const int tokn = tok0 + ((rr + 1) >> 2) * HALF + ((rr + 1) & 3) * 16; const f32x4* tp = (const f32x4*)(tab + (size_t)tokn * 48 + 4 * fq); tn[0] = tp[0]; tn[1] = tp[1]; tn[2] = tp[8]; tn[3] = tp[9]; }
#pragma unroll
            for (int n = 0; n < 2; ++n) { const int i = 16 * n + 4 * fq; const f32x4 t0 = tc[2 * n], t1 = tc[2 * n + 1];
                const f32x4 cs = {t0.x, t0.z, t1.x, t1.z}, sn = {t0.y, t0.w, t1.y, t1.w}, x1 = acc[ai][0][m][n], x2 = acc[ai][1][m][n];
                const f32x4 o1 = (x1 * cs - x2 * sn) * scale, o2 = (x2 * cs + x1 * sn) * scale;
                h16* p = dst + (size_t)tok * 768 + (4 * tl + wc) * 64 + i;
                u32x2 w1, w2; w1.x = pk_h2(o1.x, o1.y); w1.y = pk_h2(o1.z, o1.w); w2.x = pk_h2(o2.x, o2.y); w2.y = pk_h2(o2.z, o2.w);
                *(u32x2*)p = w1; *(u32x2*)(p + 32) = w2; }
#pragma unroll
            for (int k = 0; k < 4; ++k) tc[k] = tn[k];
            asm volatile("" ::: "memory"); }
    }
    __device__ __forceinline__ void operator()(const f32x4 (&acc)[2][2][4][2], const Unit& u, int wr, int wc, int fr, int fq) const {
        const int pn = u.pn;
        if (pn == 0) {
#pragma unroll
            for (int ai = 0; ai < 2; ++ai)
#pragma unroll
                for (int m = 0; m < 4; ++m) { float sq = 0.f;
#pragma unroll
                    for (int bj = 0; bj < 2; ++bj)
#pragma unroll
                        for (int n = 0; n < 2; ++n) { const f32x4 v = acc[ai][bj][m][n]; sq += (v.x * v.x + v.y * v.y) + (v.z * v.z + v.w * v.w); }
                    sq += __shfl_xor(sq, 16); sq += __shfl_xor(sq, 32);
                    if (fq == 0) X[(ai * HALF + wr * 64 + m * 16 + fr) * 4 + wc] = sq; }
            asm volatile("s_waitcnt lgkmcnt(0)" ::: "memory"); __builtin_amdgcn_s_barrier(); asm volatile("" ::: "memory");
#pragma unroll
            for (int ai = 0; ai < 2; ++ai)
#pragma unroll
                for (int m = 0; m < 4; ++m) { const int rl = ai * HALF + wr * 64 + m * 16 + fr, tok = u.pm * BM + rl; const f32x4 p = *(const LAS f32x4*)(X + rl * 4);
                    const float rstd = rsqrtf(((p.x + p.y) + (p.z + p.w)) * (1.f / KVL) + EPS);
#pragma unroll
                    for (int bj = 0; bj < 2; ++bj)
#pragma unroll
                        for (int n = 0; n < 2; ++n) { const int col = bj * HALF + wc * 32 + n * 16 + 4 * fq; const f32x4 o = acc[ai][bj][m][n] * rstd * *(const f32x4*)(gckv + col);
                            int w8 = __builtin_amdgcn_cvt_pk_fp8_f32(o.x, o.y, 0, false); w8 = __builtin_amdgcn_cvt_pk_fp8_f32(o.z, o.w, w8, true);
                            *(int*)((unsigned char*)ckv + (size_t)tok * KVL + col) = w8; }
                    asm volatile("" ::: "memory"); }
            asm volatile("s_waitcnt lgkmcnt(0)" ::: "memory"); __builtin_amdgcn_s_barrier(); asm volatile("" ::: "memory");
        } else if (pn <= 2) {
#pragma unroll
            for (int ai = 0; ai < 2; ++ai)
#pragma unroll
                for (int m = 0; m < 4; ++m) { const int tok = u.pm * BM + ai * HALF + wr * 64 + m * 16 + fr; float sq = 0.f;
#pragma unroll
                    for (int bj = 0; bj < 2; ++bj) { if (pn == 2 && bj == 1) break;
#pragma unroll
                        for (int n = 0; n < 2; ++n) { const f32x4 v = acc[ai][bj][m][n]; sq += (v.x * v.x + v.y * v.y) + (v.z * v.z + v.w * v.w);
                            const int col = (pn - 1) * 256 + bj * HALF + wc * 32 + n * 16 + 4 * fq; u32x2 w; w.x = pk_h2(v.x, v.y); w.y = pk_h2(v.z, v.w); *(u32x2*)(cq + (size_t)tok * QL + col) = w; } }
                    sq += __shfl_xor(sq, 16); sq += __shfl_xor(sq, 32);
                    if (fq == 0) ssq[tok * 8 + (pn - 1) * 4 + wc] = sq;
                    if (pn == 2) {
                        if (wc < 2) { const int i = 4 * fq; const f32x4* tp = (const f32x4*)(tab + (size_t)tok * 48 + 32 + i); const f32x4 t0 = tp[0], t1 = tp[1];
                            const f32x4 cs = {t0.x, t0.z, t1.x, t1.z}, sn = {t0.y, t0.w, t1.y, t1.w}, x1 = acc[ai][1][m][0], x2 = acc[ai][1][m][1];
                            const f32x4 o1 = x1 * cs - x2 * sn, o2 = x2 * cs + x1 * sn;
                            if (wc == 0) { unsigned char* p8 = (unsigned char*)kr + (size_t)tok * 32 + i;
                                int a8 = __builtin_amdgcn_cvt_pk_fp8_f32(o1.x, o1.y, 0, false); a8 = __builtin_amdgcn_cvt_pk_fp8_f32(o1.z, o1.w, a8, true);
                                int b8 = __builtin_amdgcn_cvt_pk_fp8_f32(o2.x, o2.y, 0, false); b8 = __builtin_amdgcn_cvt_pk_fp8_f32(o2.z, o2.w, b8, true);
                                *(int*)p8 = a8; *(int*)(p8 + 16) = b8; }
                            else { h16* p = ki + (size_t)tok * 32 + i;
                                u32x2 w1, w2; w1.x = pk_h2(o1.x, o1.y); w1.y = pk_h2(o1.z, o1.w); w2.x = pk_h2(o2.x, o2.y); w2.y = pk_h2(o2.z, o2.w);
                                *(u32x2*)p = w1; *(u32x2*)(p + 16) = w2; } }
                        else if (wc == 2 && fq < 2) { *(f32x4*)(wi + tok * 8 + 4 * fq) = acc[ai][1][m][0] * 0.35355339059327373f; }
                    }
                    asm volatile("" ::: "memory"); }
        } else if (pn <= 5) rope64(acc, u, wr, wc, fr, fq, qb, pn - 3, 0.125f * LOG2E);
        else if (pn <= 8) rope64(acc, u, wr, wc, fr, fq, kb, pn - 6, 1.0f);
        else {
#pragma unroll
            for (int ai = 0; ai < 2; ++ai)
#pragma unroll
                for (int m = 0; m < 4; ++m) { const int tok = u.pm * BM + ai * HALF + wr * 64 + m * 16 + fr;
#pragma unroll
                    for (int bj = 0; bj < 2; ++bj)
#pragma unroll
                        for (int n = 0; n < 2; ++n) { const f32x4 v = acc[ai][bj][m][n]; u32x2 w; w.x = pk_h2(v.x, v.y); w.y = pk_h2(v.z, v.w);
                            *(u32x2*)(vT + (size_t)tok * 768 + (pn - 9) * 256 + bj * HALF + wc * 32 + n * 16 + 4 * fq) = w; }
                    asm volatile("" ::: "memory"); }
        }
    }
};
struct Epi4 {
    static constexpr bool PERM = true;
    h16 *qlat, *qr, *qi; const float* rstdq; const float2* tab;
    __device__ __forceinline__ void operator()(const f32x4 (&acc)[2][2][4][2], const Unit& u, int wr, int wc, int fr, int fq) const {
        const int pn = u.pn; const float c2 = 0.10206207261596575f * LOG2E;
        const int tok0 = u.pm * BM + wr * 64 + fr;
        float rc = rstdq[tok0], rn = 0.f;
        if (pn < 8) {
#pragma unroll
            for (int rr = 0; rr < 8; ++rr) { const int ai = rr >> 2, m = rr & 3, tok = tok0 + ai * HALF + m * 16;
                if (rr < 7) rn = rstdq[tok0 + ((rr + 1) >> 2) * HALF + ((rr + 1) & 3) * 16];
#pragma unroll
                for (int bj = 0; bj < 2; ++bj) { const f32x4 o0 = acc[ai][bj][m][0] * (rc * c2), o1 = acc[ai][bj][m][1] * (rc * c2);
                    u32x4 w; w.x = pk_h2(o0.x, o0.y); w.y = pk_h2(o0.z, o0.w); w.z = pk_h2(o1.x, o1.y); w.w = pk_h2(o1.z, o1.w);
                    *(u32x4*)(qlat + (size_t)tok * 2048 + pn * 256 + bj * HALF + wc * 32 + 8 * fq) = w; }
                rc = rn; asm volatile("" ::: "memory"); }
        } else { h16* dst = (pn == 8) ? qr : qi; const float c2e = (pn == 8) ? c2 : 1.f; const int i = 4 * fq;
            f32x4 tc[2], tn[2];
            { const f32x4* tp = (const f32x4*)(tab + (size_t)tok0 * 48 + 32 + i); tc[0] = tp[0]; tc[1] = tp[1]; }
#pragma unroll
            for (int rr = 0; rr < 8; ++rr) { const int ai = rr >> 2, m = rr & 3, tok = tok0 + ai * HALF + m * 16;
                if (rr < 7) { const int tokn = tok0 + ((rr + 1) >> 2) * HALF + ((rr + 1) & 3) * 16; const f32x4* tp = (const f32x4*)(tab + (size_t)tokn * 48 + 32 + i); tn[0] = tp[0]; tn[1] = tp[1]; rn = rstdq[tokn]; }
                const f32x4 cs = {tc[0].x, tc[0].z, tc[1].x, tc[1].z}, sn = {tc[0].y, tc[0].w, tc[1].y, tc[1].w}; const float sc = rc * c2e;
#pragma unroll
                for (int bj = 0; bj < 2; ++bj) { const f32x4 x1 = acc[ai][bj][m][0], x2 = acc[ai][bj][m][1]; const f32x4 o1 = (x1 * cs - x2 * sn) * sc, o2 = (x2 * cs + x1 * sn) * sc;
                    h16* p = dst + (size_t)tok * 256 + (4 * bj + wc) * 32 + i;
                    u32x2 w1, w2; w1.x = pk_h2(o1.x, o1.y); w1.y = pk_h2(o1.z, o1.w); w2.x = pk_h2(o2.x, o2.y); w2.y = pk_h2(o2.z, o2.w);
                    *(u32x2*)p = w1; *(u32x2*)(p + 16) = w2; }
                tc[0] = tn[0]; tc[1] = tn[1]; rc = rn;
                asm volatile("" ::: "memory"); } }
    }
};
__device__ __forceinline__ u32x4 ld16_l2(const h16* p) {
    const unsigned long long a = __hip_atomic_load((const unsigned long long*)p, __ATOMIC_RELAXED, __HIP_MEMORY_SCOPE_AGENT), b = __hip_atomic_load((const unsigned long long*)p + 1, __ATOMIC_RELAXED, __HIP_MEMORY_SCOPE_AGENT);
    return (u32x4){(unsigned)a, (unsigned)(a >> 32), (unsigned)b, (unsigned)(b >> 32)};
}
typedef _Float16 h16x8 __attribute__((ext_vector_type(8)));
__device__ __forceinline__ void unpk8(const u32x4 w, float (&f)[8]) {
    const h16x8 h = __builtin_bit_cast(h16x8, w);
#pragma unroll
    for (int i = 0; i < 8; ++i) f[i] = (float)h[i];
}
struct EpiH16 {
    static constexpr bool PERM = true;
    h16* O; int ldc = DM;
    __device__ __forceinline__ void operator()(const f32x4 (&acc)[2][2][4][2], const Unit& u, int wr, int wc, int fr, int fq) const {
        const int row0 = u.pm * BM + wr * 64 + fr, col0 = u.pn * BM + wc * 32 + 8 * fq;
#pragma unroll
        for (int ai = 0; ai < 2; ++ai)
#pragma unroll
            for (int m = 0; m < 4; ++m)
#pragma unroll
                for (int bj = 0; bj < 2; ++bj) { const f32x4 v0 = acc[ai][bj][m][0], v1 = acc[ai][bj][m][1];
                    u32x4 w; w.x = pk_h2(v0.x, v0.y); w.y = pk_h2(v0.z, v0.w); w.z = pk_h2(v1.x, v1.y); w.w = pk_h2(v1.z, v1.w);
                    *(u32x4*)(O + (size_t)(row0 + ai * HALF + m * 16) * ldc + col0 + bj * HALF) = w; }
    }
};
struct EpiGate {
    static constexpr bool PERM = true;
    const h16* Y; h16* Z; int accum;
    __device__ __forceinline__ void operator()(const f32x4 (&acc)[2][2][4][2], const Unit& u, int wr, int wc, int fr, int fq) const {
        const int row0 = u.pm * BM + wr * 64 + fr, col0 = u.pn * BM + wc * 32 + 8 * fq;
#pragma unroll
        for (int ai = 0; ai < 2; ++ai)
#pragma unroll
            for (int m = 0; m < 4; ++m)
#pragma unroll
                for (int bj = 0; bj < 2; ++bj) { const size_t off = (size_t)(row0 + ai * HALF + m * 16) * DM + col0 + bj * HALF;
                    float y[8], zz[8]; unpk8(ld16_l2(Y + off), y);
                    if (accum) unpk8(ld16_l2(Z + off), zz); else {
#pragma unroll
                        for (int i = 0; i < 8; ++i) zz[i] = 0.f; }
                    float o[8];
#pragma unroll
                    for (int n = 0; n < 2; ++n)
#pragma unroll
                        for (int e = 0; e < 4; ++e) { const float gg = acc[ai][bj][m][n][e]; o[n * 4 + e] = zz[n * 4 + e] + y[n * 4 + e] * __builtin_amdgcn_rcpf(1.f + __builtin_amdgcn_exp2f(-gg * LOG2E)); }
                    u32x4 w; w.x = pk_h2(o[0], o[1]); w.y = pk_h2(o[2], o[3]); w.z = pk_h2(o[4], o[5]); w.w = pk_h2(o[6], o[7]);
                    *(u32x4*)(Z + off) = w; }
    }
};
}

#define XB_TMO      128
#define XB_XCNT(j)  (256  + 64 * (j))
#define XB_XSUB(j)  (1280 + 64 * (j))
#define XB_XGEN(j)  (2304 + 64 * (j))
#define XB_TOP      3328
#define XB_TOPGEN   3392
#define XCD_BAR_WORDS 3456
#define XB_SPIN_CAP (1u << 18)
__device__ __forceinline__ unsigned xb_ld(unsigned* p)              { return __hip_atomic_load(p, __ATOMIC_RELAXED, __HIP_MEMORY_SCOPE_AGENT); }
__device__ __forceinline__ unsigned xb_add(unsigned* p, unsigned v) { return __hip_atomic_fetch_add(p, v, __ATOMIC_RELAXED, __HIP_MEMORY_SCOPE_AGENT); }
__device__ __forceinline__ unsigned xb_xcc_id() { return (unsigned)__builtin_amdgcn_s_getreg((3 << 11) | 20) & 0xFu; }
#define XB_SPIN(cond, bar) do { unsigned _sp = 0; while (cond) { __builtin_amdgcn_s_sleep(1); \
    if ((++_sp & 255u) == 0u) { if (xb_ld(&(bar)[XB_TMO])) break; if (_sp > XB_SPIN_CAP) { atomicAdd(&(bar)[XB_TMO], 1u); break; } } } } while (0)
struct XcdBarrier { unsigned* bar; unsigned x; volatile LAS unsigned* st; };
__device__ __forceinline__ XcdBarrier xcd_barrier_post(unsigned* bar, volatile LAS unsigned* st) {
    XcdBarrier b; b.bar = bar; b.x = xb_xcc_id(); b.st = st;
    if (threadIdx.x == 0) (void)xb_add(&bar[XB_XCNT(b.x)], 1u);
    return b;
}
__device__ __forceinline__ void xcd_barrier_complete(unsigned* bar, unsigned x, unsigned& nloc, unsigned& nx) {
    const unsigned G = gridDim.x * gridDim.y * gridDim.z;
    unsigned sum, cnt, mine, sp = 0u;
    for (;;) {
        sum = 0u; cnt = 0u; mine = 0u;
#pragma unroll
        for (unsigned j = 0; j < 16; ++j) { const unsigned c = xb_ld(&bar[XB_XCNT(j)]); sum += c; cnt += (c > 0u) ? 1u : 0u; mine = (j == x) ? c : mine; }
        if (sum == G) break;
        __builtin_amdgcn_s_sleep(1);
        if ((++sp & 255u) == 0u) { if (xb_ld(&bar[XB_TMO])) break; if (sp > XB_SPIN_CAP) { atomicAdd(&bar[XB_TMO], 1u); break; } }
    }
    nloc = mine > 0u ? mine : 1u; nx = cnt > 0u ? cnt : 1u;
}
__device__ __forceinline__ void xcd_barrier(const XcdBarrier& b) {
    asm volatile("s_waitcnt vmcnt(0)" ::: "memory");
    __syncthreads();
    if (threadIdx.x == 0) {
        unsigned* bar = b.bar;
        __builtin_amdgcn_s_waitcnt(0);
        unsigned nloc = b.st[0], nx = b.st[1];
        if (nloc == 0u) { xcd_barrier_complete(bar, b.x, nloc, nx); b.st[0] = nloc; b.st[1] = nx; }
        const unsigned old = xb_add(&bar[XB_XSUB(b.x)], 1u);
        const unsigned gen = old / nloc;
        if (old + 1u == (gen + 1u) * nloc) {
            __builtin_amdgcn_fence(__ATOMIC_RELEASE, "agent");
            asm volatile("s_waitcnt vmcnt(0)" ::: "memory");
            const unsigned og = xb_add(&bar[XB_TOP], 1u);
            const unsigned tg = og / nx;
            if (og + 1u == (tg + 1u) * nx) xb_add(&bar[XB_TOPGEN], 1u);
            else XB_SPIN(xb_ld(&bar[XB_TOPGEN]) == tg, bar);
            __builtin_amdgcn_fence(__ATOMIC_ACQUIRE, "agent");
            xb_add(&bar[XB_XGEN(b.x)], 1u);
            asm volatile("s_waitcnt vmcnt(0)" ::: "memory");
        } else {
            XB_SPIN(xb_ld(&bar[XB_XGEN(b.x)]) == gen, bar);
            __builtin_amdgcn_fence(__ATOMIC_ACQUIRE, "agent");
            asm volatile("s_waitcnt vmcnt(0)" ::: "memory");
        }
    }
    __syncthreads();
}

constexpr int NWAVES = 8, NTHR = 512;
constexpr int RING_BYTES = 131072, LDSCTL_OFF = RING_BYTES, MISC_OFF = LDSCTL_OFF + 320, LDS_BYTES = 147456;
constexpr int XCH_OFF = RING_BYTES + 1024;
constexpr int CW_BAR = 4096;
constexpr size_t OW_GU1 = OFF_W, OW_D1 = OW_GU1 + 11 * MiB, OW_IN = OW_D1 + (size_t)DM * FF * 2, OW_GATE = OW_IN + 6 * MiB, OW_4 = OW_GATE + 4 * MiB, OW_OV = OW_4 + 2 * MiB,
                 OW_UPB = OW_OV + 4 * MiB, OW_O = OW_UPB + MiB / 2, OW_GU2 = OW_O + 2 * MiB, OW_D2 = OW_GU2 + 11 * MiB, OW_END = OW_D2 + (size_t)DM * FF * 2;
static_assert(OW_END <= OFF_H, "weights region");
constexpr int NIN3 = 3072, N4 = 2560;
constexpr size_t OW_BD = OW_OV, OW_UPA = OW_OV + MiB, OFF_OA = OFF_A + 64 * MiB;

struct Args { const float* in[27]; float* out; unsigned char* ws; int ph_lo, ph_hi; };
struct Frame {
    LAS unsigned char* lds; int tid, lane, wave, G, gw, NGW;
};
__device__ __forceinline__ float wave_sum(float v) {
#pragma unroll
    for (int o = 1; o < 64; o <<= 1) v += __shfl_xor(v, o);
    return v;
}
__device__ __forceinline__ bool map_row(int job, int n, const Args& a, const float*& W, int& ldw, int& col) {
    if (job <= 1) { const int t = n >> 8, j = n & 255; W = a.in[(job == 0 ? 6 : 23) + (j >> 7)]; ldw = FF; col = t * 128 + (j & 127); return true; }
    if (job == 2) { W = a.in[11]; ldw = DIN; const int t = n >> 8, j = n & 255;
        if (t == 0) { col = C_CKV + j; return true; }
        if (t == 1) { col = j; return true; }
        if (t == 2) { if (j < 128) { col = 256 + j; return true; } if (j < 160) { col = C_KR + (j - 128); return true; } if (j < 192) { col = C_KI + (j - 160); return true; } if (j < 200) { col = C_WI + (j - 192); return true; } col = 0; return false; }
        if (t < 9) { const int c3 = (t - 3) / 3, tl = (t - 3) % 3, hl = (j & 127) >> 5, i = j & 31; col = C_QKV + c3 * 768 + (4 * tl + hl) * 64 + (j >> 7) * 32 + i; return true; }
        col = C_QKV + 1536 + (t - 9) * 256 + j; return true; }
    { const int n2 = n - 2048, r5 = n2 & 31, nat = 16 * ((r5 >> 2) & 1) + 4 * (r5 >> 3) + (r5 & 3);
      if (n2 < 256) { W = a.in[14]; ldw = 768; col = (n2 >> 5) * 96 + 64 + nat; } else { W = a.in[17]; ldw = 256; col = ((n2 - 256) & ~31) + nat; } return true; }
}
__device__ __forceinline__ void tr_item(const float* W, int ldw, int col, bool valid, const float* scale, int k0, h16* WTrow0, int K, LAS float* scr, int lane) {
    const int colc = valid ? col : 0; float vv[32];
#pragma unroll
    for (int i = 0; i < 32; ++i) vv[i] = W[(size_t)(k0 + 2 * i + (lane >> 5)) * ldw + colc];
    if (scale) {
#pragma unroll
        for (int i = 0; i < 32; ++i) vv[i] *= scale[k0 + 2 * i + (lane >> 5)]; }
#pragma unroll
    for (int i = 0; i < 32; ++i) scr[(2 * i + (lane >> 5)) * 33 + (lane & 31)] = valid ? vv[i] : 0.f;
    asm volatile("s_waitcnt lgkmcnt(0)" ::: "memory");
    const int c = lane & 7;
#pragma unroll
    for (int j = 0; j < 4; ++j) { const int n = (lane >> 3) + 8 * j; const LAS float* s = scr + (8 * c) * 33 + n;
        u32x4 o; o.x = pk_h2(s[0 * 33], s[1 * 33]); o.y = pk_h2(s[2 * 33], s[3 * 33]); o.z = pk_h2(s[4 * 33], s[5 * 33]); o.w = pk_h2(s[6 * 33], s[7 * 33]);
        *(u32x4*)(WTrow0 + (size_t)n * K + k0 + 8 * c) = o; }
    asm volatile("s_waitcnt lgkmcnt(0)" ::: "memory");
}
__device__ __forceinline__ void tr_job_mapped(const Frame& F, const Args& a, int job, int Ndest, int n_lo, int K, h16* WT, const float* scale, LAS float* scr, int phase_off) {
    const int nblk = Ndest / 32, nitems = (K / 64) * nblk;
    for (int it = (F.gw + phase_off) % F.NGW; it < nitems; it += F.NGW) {
        const int kb = it / nblk, nb = it % nblk; const float* W; int ldw, col;
        const bool valid = map_row(job, n_lo + nb * 32 + (F.lane & 31), a, W, ldw, col);
        tr_item(W, ldw, col, valid, scale, kb * 64, WT + (size_t)(n_lo + nb * 32) * K, K, scr, F.lane);
    }
}
__device__ __forceinline__ void tr_job_plain(const Frame& F, const float* W, int ldw, int Ndest, int K, h16* WT, LAS float* scr, int phase_off) {
    const int nblk = Ndest / 32, nitems = (K / 64) * nblk;
    for (int it = (F.gw + phase_off) % F.NGW; it < nitems; it += F.NGW) {
        const int kb = it / nblk, nb = it % nblk;
        tr_item(W, ldw, nb * 32 + (F.lane & 31), true, nullptr, kb * 64, WT + (size_t)(nb * 32) * K, K, scr, F.lane);
    }
}
__device__ __forceinline__ void row_load(const float* p, int lane, f32x4 (&v)[4]) {
#pragma unroll
    for (int j = 0; j < 4; ++j) v[j] = ((const f32x4*)p)[lane + 64 * j];
}
__device__ __forceinline__ float row_ssq(const f32x4 (&v)[4]) { float s = 0.f;
#pragma unroll
    for (int j = 0; j < 4; ++j) s += (v[j].x * v[j].x + v[j].y * v[j].y) + (v[j].z * v[j].z + v[j].w * v[j].w);
    return wave_sum(s); }
__device__ __forceinline__ void row_normmod_store(const f32x4 (&v)[4], float rstd, const float* g, const float* sc, const float* sh, h16* dst, int lane) {
#pragma unroll
    for (int j = 0; j < 4; ++j) { const int ci = lane + 64 * j; const f32x4 gg = ((const f32x4*)g)[ci], s1 = ((const f32x4*)sc)[ci], s0 = ((const f32x4*)sh)[ci];
        const f32x4 o = v[j] * rstd * gg * (s1 + 1.f) + s0;
        u32x2 w; w.x = pk_h2(o.x, o.y); w.y = pk_h2(o.z, o.w); ((u32x2*)dst)[ci] = w; }
}
__device__ __forceinline__ void ph_normmod(const Frame& F, const float* x, const float* g, const float* mod, int isc, int ish, h16* dst) {
    int m = F.gw; if (m >= MT) return;
    f32x4 v[4], vn[4]; row_load(x + (size_t)m * DM, F.lane, v);
    for (;;) { const int mn = m + F.NGW; const bool has = mn < MT; if (has) row_load(x + (size_t)mn * DM, F.lane, vn);
        const float rstd = rsqrtf(row_ssq(v) * (1.f / DM) + EPS); const float* mb = mod + (m / SEQ) * (NMOD * DM);
        row_normmod_store(v, rstd, g, mb + isc * DM, mb + ish * DM, dst + (size_t)m * DM, F.lane);
        if (!has) break;
#pragma unroll
        for (int j = 0; j < 4; ++j) v[j] = vn[j];
        m = mn; }
}
__device__ __forceinline__ void row_load_h(const h16* p, int lane, u32x2 (&v)[4]) {
#pragma unroll
    for (int j = 0; j < 4; ++j) v[j] = ((const u32x2*)p)[lane + 64 * j];
}
typedef _Float16 h16x4 __attribute__((ext_vector_type(4)));
__device__ __forceinline__ f32x4 h4_to_f4(u32x2 w) { const h16x4 h = __builtin_bit_cast(h16x4, w); return (f32x4){(float)h[0], (float)h[1], (float)h[2], (float)h[3]}; }
template <bool XI16, bool XO16>
__device__ __forceinline__ void ph_resnorm(const Frame& F, const void* xin_, const h16* f, const float* gpost, const float* mod, int igt, float coef, void* xout_,
                                           bool second, const float* gpre, int isc, int ish, h16* dst) {
    int m = F.gw; if (m >= MT) return;
    u32x2 fh[4], fn[4]; f32x4 xi[4], xn[4]; u32x2 xh[4], xhn[4];
    row_load_h(f + (size_t)m * DM, F.lane, fh);
    if constexpr (XI16) row_load_h((const h16*)xin_ + (size_t)m * DM, F.lane, xh); else row_load((const float*)xin_ + (size_t)m * DM, F.lane, xi);
    for (;;) {
        const int mn = m + F.NGW; const bool has = mn < MT;
        if (has) { row_load_h(f + (size_t)mn * DM, F.lane, fn);
            if constexpr (XI16) row_load_h((const h16*)xin_ + (size_t)mn * DM, F.lane, xhn); else row_load((const float*)xin_ + (size_t)mn * DM, F.lane, xn); }
        f32x4 v[4];
#pragma unroll
        for (int j = 0; j < 4; ++j) { v[j] = h4_to_f4(fh[j]); if constexpr (XI16) xi[j] = h4_to_f4(xh[j]); }
        const float rstd = rsqrtf(row_ssq(v) * (1.f / DM) + EPS) * coef; const float* mb = mod + (m / SEQ) * (NMOD * DM);
#pragma unroll
        for (int j = 0; j < 4; ++j) { const int ci = F.lane + 64 * j; const f32x4 gg = ((const f32x4*)gpost)[ci], gt = ((const f32x4*)(mb + igt * DM))[ci];
            xi[j] = xi[j] + gt * v[j] * rstd * gg;
            if constexpr (XO16) { u32x2 w; w.x = pk_h2(xi[j].x, xi[j].y); w.y = pk_h2(xi[j].z, xi[j].w); ((u32x2*)((h16*)xout_ + (size_t)m * DM))[ci] = w; }
            else ((f32x4*)((float*)xout_ + (size_t)m * DM))[ci] = xi[j]; }
        if (second) { const float r2 = rsqrtf(row_ssq(xi) * (1.f / DM) + EPS); row_normmod_store(xi, r2, gpre, mb + isc * DM, mb + ish * DM, dst + (size_t)m * DM, F.lane); }
        if (!has) break;
#pragma unroll
        for (int j = 0; j < 4; ++j) { fh[j] = fn[j]; if constexpr (XI16) xh[j] = xhn[j]; else xi[j] = xn[j]; }
        m = mn;
    }
}

__device__ __forceinline__ void ph_combine(const Frame& F, const h16* og, const float* lse2, h16* ob) {
    for (int idx = blockIdx.x * NTHR + F.tid; idx < MT * 256; idx += F.G * NTHR) {
        const int tok = idx >> 8, c = idx & 255, hh = c >> 6;
        const float l0 = lse2[tok * 12 + hh], l1 = lse2[tok * 12 + 4 + hh], l2 = lse2[tok * 12 + 8 + hh], m = fmaxf(l0, fmaxf(l1, l2));
        const float w0 = exp2f(l0 - m), w1 = exp2f(l1 - m), w2 = exp2f(l2 - m), inv = 1.f / (w0 + w1 + w2);
        ob[idx] = (h16)((w0 * (float)og[(size_t)tok * 768 + c] + w1 * (float)og[(size_t)tok * 768 + 256 + c] + w2 * (float)og[(size_t)tok * 768 + 512 + c]) * inv); }
}
typedef short v4i16_t __attribute__((ext_vector_type(4)));
typedef short s16x8 __attribute__((ext_vector_type(8)));
typedef float f32x16 __attribute__((ext_vector_type(16)));
__device__ __forceinline__ int tk_bin(float sc) { const unsigned u = __float_as_uint(sc); int e = (int)((u >> 16) & 0x7FFFu) - (122 << 7); e = e < 0 ? 0 : (e > 1023 ? 1023 : e); return (u >> 31) ? 1023 - e : 1024 + e; }
__device__ __forceinline__ void tk_scores(const f16x8 (&Af)[2], const float (&wv)[16], f16x8 b0, f16x8 b1, float& sa, float& sb) {
    f32x16 d = {0.f, 0.f, 0.f, 0.f, 0.f, 0.f, 0.f, 0.f, 0.f, 0.f, 0.f, 0.f, 0.f, 0.f, 0.f, 0.f};
    d = __builtin_amdgcn_mfma_f32_32x32x16_f16(Af[0], b0, d, 0, 0, 0); d = __builtin_amdgcn_mfma_f32_32x32x16_f16(Af[1], b1, d, 0, 0, 0);
    f32x2 acc = {0.f, 0.f};
#pragma unroll
    for (int e = 0; e < 16; e += 2) { const int i0 = __float_as_int(d[e]), i1 = __float_as_int(d[e + 1]);
        const f32x2 rl = {__int_as_float(i0 > 0 ? i0 : 0), __int_as_float(i1 > 0 ? i1 : 0)}; const f32x2 w2 = {wv[e], wv[e + 1]};
        acc = __builtin_elementwise_fma(w2, rl, acc); }
    sa = acc.x; sb = acc.y;
}
template <bool P2>
__device__ __forceinline__ void tk_tile(const f16x8 (&Af)[2], const float (&wv)[16], f16x8 b0, f16x8 b1, int tile, int r, int hi, int ta, LAS unsigned* hist, const int (&tbin)[4], int (&cs)[4], int (&cc)[4],
                                        unsigned short* sel, int tok0) {
    float sa, sb; tk_scores(Af, wv, b0, b1, sa, sb);
    const int s = 32 * tile + r;
    if constexpr (!P2) {
        if (s <= ta) { const int bn = tk_bin(sa); __hip_atomic_fetch_add(hist + (2 * hi) * 1024 + (bn >> 1), 1u << (16 * (bn & 1)), __ATOMIC_RELAXED, __HIP_MEMORY_SCOPE_WORKGROUP); }
        if (s <= ta + 1) { const int bn = tk_bin(sb); __hip_atomic_fetch_add(hist + (2 * hi + 1) * 1024 + (bn >> 1), 1u << (16 * (bn & 1)), __ATOMIC_RELAXED, __HIP_MEMORY_SCOPE_WORKGROUP); }
    } else {
        const unsigned lowmask = (1u << r) - 1u;
#pragma unroll
        for (int ab = 0; ab < 2; ++ab) { const float sc = ab ? sb : sa; const int tq = ta + ab; const int bn = tk_bin(sc);
            const int mytb = hi ? tbin[2 + ab] : tbin[ab];
            const bool valid = s <= tq, sure = valid && bn > mytb, cand = valid && bn == mytb;
            const unsigned long long ms = __ballot(sure), mc = __ballot(cand);
            const unsigned ms_h = hi ? (unsigned)(ms >> 32) : (unsigned)ms, mc_h = hi ? (unsigned)(mc >> 32) : (unsigned)mc;
            const int q = 2 * hi + ab;
            const int base_s = hi ? cs[2 + ab] : cs[ab], base_c = hi ? cc[2 + ab] : cc[ab];
            if (sure) sel[(size_t)(tok0 + q) * TOPK + base_s + __builtin_popcount(ms_h & lowmask)] = (unsigned short)s;
            if (cand) { const int pos = base_c + __builtin_popcount(mc_h & lowmask);
                if (pos < 512) ((LAS unsigned long long*)((LAS unsigned char*)hist + q * 4096))[pos] = ((unsigned long long)fkey(sc) << 16) | (unsigned long long)(0xFFFFu - (unsigned)s); }
            cs[ab] += __builtin_popcount((unsigned)ms); cs[2 + ab] += __builtin_popcount((unsigned)(ms >> 32));
            cc[ab] += __builtin_popcount((unsigned)mc); cc[2 + ab] += __builtin_popcount((unsigned)(mc >> 32)); }
    }
}
template <bool P2>
__device__ __forceinline__ void tk_pass(const f16x8 (&Af)[2], const float (&wv)[16], const h16* kbase, int ntiles, int r, int hi, int ta, LAS unsigned* hist, const int (&tbin)[4], int (&cs)[4], int (&cc)[4],
                                        unsigned short* sel, int tok0) {
    f16x8 BA[4][2], BB[4][2];
#define TK_LOAD(dst, t0_) do { _Pragma("unroll") for (int i_ = 0; i_ < 4; ++i_) { const int tt_ = ((t0_) + i_) < 127 ? ((t0_) + i_) : 127; dst[i_][0] = *(const f16x8*)(kbase + (size_t)tt_ * 1024); dst[i_][1] = *(const f16x8*)(kbase + (size_t)tt_ * 1024 + 16); } } while (0)
    TK_LOAD(BA, 0);
    for (int t0 = 0; t0 < ntiles; t0 += 8) {
        TK_LOAD(BB, t0 + 4);
#pragma unroll
        for (int i = 0; i < 4; ++i) if (t0 + i < ntiles) tk_tile<P2>(Af, wv, BA[i][0], BA[i][1], t0 + i, r, hi, ta, hist, tbin, cs, cc, sel, tok0);
        TK_LOAD(BA, t0 + 8);
#pragma unroll
        for (int i = 0; i < 4; ++i) if (t0 + 4 + i < ntiles) tk_tile<P2>(Af, wv, BB[i][0], BB[i][1], t0 + 4 + i, r, hi, ta, hist, tbin, cs, cc, sel, tok0);
    }
#undef TK_LOAD
}
__device__ __forceinline__ void tk_group(const Frame& F, const h16* qi, const h16* ki, const float* wi, unsigned short* sel, int b, int t0, LAS unsigned* hist) {
    int lane_ = F.lane; asm volatile("" : "+v"(lane_)); const int lane = lane_, r = lane & 31, hi = lane >> 5, tok0 = b * SEQ + t0;
    const int qa = 2 * ((r >> 2) & 1) + (r & 1), ha = 4 * (r >> 4) + 2 * ((r >> 3) & 1) + ((r >> 1) & 1);
    f16x8 Af[2];
#pragma unroll
    for (int s_ = 0; s_ < 2; ++s_) Af[s_] = *(const f16x8*)(qi + (size_t)(tok0 + qa) * 256 + ha * 32 + 16 * s_ + 8 * hi);
    float wv[16];
    { const f32x4 a0 = *(const f32x4*)(wi + (tok0 + 2 * hi) * 8), a1 = *(const f32x4*)(wi + (tok0 + 2 * hi) * 8 + 4), b0 = *(const f32x4*)(wi + (tok0 + 2 * hi + 1) * 8), b1 = *(const f32x4*)(wi + (tok0 + 2 * hi + 1) * 8 + 4);
      const float sa[8] = {a0.x, a0.y, a0.z, a0.w, a1.x, a1.y, a1.z, a1.w}, sb[8] = {b0.x, b0.y, b0.z, b0.w, b1.x, b1.y, b1.z, b1.w};
#pragma unroll
      for (int h = 0; h < 8; ++h) { wv[2 * h] = sa[h] * 0.17677669529663687f; wv[2 * h + 1] = sb[h] * 0.17677669529663687f; } }
    const int ntiles = (t0 + 3) / 32 + 1, ta = t0 + 2 * hi;
    const h16* kbase = ki + (size_t)(b * SEQ + r) * 32 + 8 * hi;
    int tbin[4] = {0, 0, 0, 0}, nsure[4], cs[4] = {0, 0, 0, 0}, cc[4] = {0, 0, 0, 0};
#pragma unroll
    for (int i = 0; i < 16; ++i) *(LAS u32x4*)((LAS unsigned char*)hist + i * 1024 + lane * 16) = (u32x4){0u, 0u, 0u, 0u};
    asm volatile("s_waitcnt lgkmcnt(0)" ::: "memory");
    tk_pass<false>(Af, wv, kbase, ntiles, r, hi, ta, hist, tbin, cs, cc, sel, tok0);
    asm volatile("s_waitcnt lgkmcnt(0)" ::: "memory");
#pragma unroll
    for (int q = 0; q < 4; ++q) {
        const LAS unsigned* hq = hist + q * 1024;
        unsigned sum = 0;
#pragma unroll
        for (int i = 0; i < 4; ++i) { const u32x4 v = *(const LAS u32x4*)(hq + 16 * lane + 4 * i); sum += (v.x & 0xFFFFu) + (v.x >> 16) + (v.y & 0xFFFFu) + (v.y >> 16) + (v.z & 0xFFFFu) + (v.z >> 16) + (v.w & 0xFFFFu) + (v.w >> 16); }
        unsigned incl = sum;
#pragma unroll
        for (int o = 1; o < 64; o <<= 1) { const unsigned v = __shfl_down(incl, o); if (lane + o < 64) incl += v; }
        const unsigned long long bal = __ballot(incl >= (unsigned)TOPK);
        const int L = 63 - __builtin_clzll(bal);
        unsigned cum = __shfl(incl, L) - __shfl(sum, L);
        int tbq = 32 * L, found = 0;
        for (int wd = 15; wd >= 0 && !found; --wd) { const unsigned v = hq[16 * L + wd];
            const unsigned chi = v >> 16, clo = v & 0xFFFFu;
            if (cum + chi >= (unsigned)TOPK) { tbq = 32 * L + 2 * wd + 1; found = 1; } else { cum += chi;
                if (cum + clo >= (unsigned)TOPK) { tbq = 32 * L + 2 * wd; found = 1; } else cum += clo; } }
        tbin[q] = tbq; nsure[q] = (int)cum;
    }
    asm volatile("s_waitcnt lgkmcnt(0)" ::: "memory");
    tk_pass<true>(Af, wv, kbase, ntiles, r, hi, ta, hist, tbin, cs, cc, sel, tok0);
    asm volatile("s_waitcnt lgkmcnt(0)" ::: "memory");
#pragma unroll
    for (int q = 0; q < 4; ++q) {
        const int nc = cc[q] < 512 ? cc[q] : 512, need = TOPK - cs[q];
        const LAS unsigned long long* cq = (const LAS unsigned long long*)((const LAS unsigned char*)hist + q * 4096);
        if (nc > 64) {
            unsigned long long it[8];
#pragma unroll
            for (int k = 0; k < 8; ++k) it[k] = (k * 64 + lane < nc) ? cq[k * 64 + lane] : 0ull;
            unsigned long long T = 0ull;
            for (int bit = 47; bit >= 0; --bit) { const unsigned long long cand = T | (1ull << bit); int cnt = 0;
#pragma unroll
                for (int k = 0; k < 8; ++k) cnt += __builtin_popcountll(__ballot(it[k] >= cand));
                if (cnt >= need) T = cand; }
            int basep = cs[q];
#pragma unroll
            for (int k = 0; k < 8; ++k) { const bool pick = (T != 0ull) && it[k] >= T; const unsigned long long mk = __ballot(pick);
                if (pick) sel[(size_t)(tok0 + q) * TOPK + basep + __builtin_popcountll(mk & ((1ull << lane) - 1ull))] = (unsigned short)(0xFFFFu - (unsigned)(it[k] & 0xFFFFull));
                basep += __builtin_popcountll(mk); }
        } else
        for (int base = 0; base < nc; base += 64) {
            const bool act = base + lane < nc; const unsigned long long my = act ? cq[base + lane] : 0ull; int rank = 0;
            for (int jb = 0; jb < nc; jb += 64) {
                const unsigned long long cj = (jb + lane < nc) ? cq[jb + lane] : 0ull; const unsigned clo = (unsigned)cj, chi = (unsigned)(cj >> 32);
                const int n = (nc - jb) < 64 ? (nc - jb) : 64;
                for (int j = 0; j < n; ++j) { const unsigned long long sj = ((unsigned long long)(unsigned)__builtin_amdgcn_readlane((int)chi, j) << 32) | (unsigned)__builtin_amdgcn_readlane((int)clo, j); rank += (sj > my) ? 1 : 0; } }
            if (act && rank < need) sel[(size_t)(tok0 + q) * TOPK + cs[q] + rank] = (unsigned short)(0xFFFFu - (unsigned)(my & 0xFFFFull)); }
    }
    (void)nsure;
    asm volatile("s_waitcnt lgkmcnt(0)" ::: "memory");
}
__device__ __forceinline__ void ph_topk_sparse(const Frame& F, const h16* qi, const h16* ki, const float* wi, unsigned short* sel, h16* qlat, const h16* qr, const unsigned char* ckv8, const unsigned char* kr8);
__device__ __forceinline__ void ph_topk_mfma(const Frame& F, const h16* qi, const h16* ki, const float* wi, unsigned short* sel) {
    LAS unsigned* hist = (LAS unsigned*)(F.lds + F.wave * 16384);
    for (int g = F.gw; g < 4 * 64; g += F.NGW) { const int b = g >> 6, t0 = (g & 63) * 4;
        for (int i = F.lane; i < 4 * TOPK; i += 64) { const int q = i >> 8, k = i & 255; sel[(size_t)(b * SEQ + t0 + q) * TOPK + k] = (unsigned short)(k <= t0 + q ? k : 0); } }
    for (int p = F.gw; p < 4 * 480; p += F.NGW) { const int b = p & 3, pj = p >> 2;
        tk_group(F, qi, ki, wi, sel, b, 4 * (64 + pj), hist);
        tk_group(F, qi, ki, wi, sel, b, 4 * (1023 - pj), hist);
    }
}


__device__ __forceinline__ void ph_dilated_mfma(const Frame& F, const h16* qb, const h16* kb, const h16* vb, h16* og, float* lse2) {
    const int lane = F.lane, ql = lane & 31, hi = lane >> 5;
    LAS unsigned char* VL = F.lds + F.wave * 16384;
    LAS float* linv = (LAS float*)(VL + 12288);
    constexpr int VROW = 192;
    const int trq = (lane & 15) >> 2, trp = lane & 3, trg = (lane >> 4) & 1;
    for (int u = F.gw; u < NB * 12 * 128; u += F.NGW) {
        const int b = u / 1536, rem = u % 1536, gh = rem >> 7, g = gh >> 2, wi_ = rem & 127, dil = dil_of(g), sh = g == 0 ? 0 : (g == 1 ? 2 : 4);
        const int nblk = 128 >> sh, res = wi_ / nblk, j0 = 32 * (wi_ % nblk);
        const size_t hoff = (size_t)b * SEQ * 768 + gh * 64;
        f16x8 Qf[4];
        { const h16* qp = qb + hoff + (size_t)((j0 + ql) * dil + res) * 768 + 8 * hi;
#pragma unroll
          for (int s_ = 0; s_ < 4; ++s_) Qf[s_] = *(const f16x8*)(qp + 16 * s_); }
        f32x16 S[5];
        f16x8 Kf[5][4];
#pragma unroll
        for (int kt = 0; kt < 5; ++kt) { int jk = j0 - 128 + 32 * kt + ql; jk = jk < 0 ? 0 : jk;
            const h16* kp = kb + hoff + (size_t)(jk * dil + res) * 768 + 8 * hi;
#pragma unroll
            for (int s_ = 0; s_ < 4; ++s_) Kf[kt][s_] = *(const f16x8*)(kp + 16 * s_); }
#pragma unroll
        for (int kt = 0; kt < 5; ++kt) {
            f32x16 d = {0.f, 0.f, 0.f, 0.f, 0.f, 0.f, 0.f, 0.f, 0.f, 0.f, 0.f, 0.f, 0.f, 0.f, 0.f, 0.f};
#pragma unroll
            for (int s_ = 0; s_ < 4; ++s_) d = __builtin_amdgcn_mfma_f32_32x32x16_f16(Kf[kt][s_], Qf[s_], d, 0, 0, 0);
            S[kt] = d; }
        f16x8 Vr[5][4];
#pragma unroll
        for (int kt = 0; kt < 5; ++kt) { int jk = j0 - 128 + 32 * kt + (lane >> 1); jk = jk < 0 ? 0 : jk;
            const h16* vp = vb + hoff + (size_t)(jk * dil + res) * 768 + (lane & 1) * 32;
#pragma unroll
            for (int i = 0; i < 4; ++i) Vr[kt][i] = *(const f16x8*)(vp + 8 * i); }
        float m = -INFINITY;
#pragma unroll
        for (int kt = 0; kt < 5; ++kt)
#pragma unroll
            for (int e = 0; e < 16; ++e) { const int kl = (e & 3) + 8 * (e >> 2) + 4 * hi; bool ok = (j0 - 128 + 32 * kt + kl) >= 0;
                if (kt == 0) ok = ok && (kl >= ql); if (kt == 4) ok = ok && (kl <= ql);
                if (!ok) S[kt][e] = -INFINITY; m = fmaxf(m, S[kt][e]); }
        m = fmaxf(m, __shfl_xor(m, 32));
        float l = 0.f;
#pragma unroll
        for (int kt = 0; kt < 5; ++kt)
#pragma unroll
            for (int e = 0; e < 16; ++e) { const float p = __builtin_amdgcn_exp2f(S[kt][e] - m); S[kt][e] = p; l += p; }
        l += __shfl_xor(l, 32);
        if (hi == 0) { linv[ql] = __builtin_amdgcn_rcpf(l); lse2[(size_t)(b * SEQ + (j0 + ql) * dil + res) * 12 + gh] = m + __builtin_amdgcn_logf(l); }
        f32x16 O[2];
#pragma unroll
        for (int dt = 0; dt < 2; ++dt) O[dt] = (f32x16){0.f, 0.f, 0.f, 0.f, 0.f, 0.f, 0.f, 0.f, 0.f, 0.f, 0.f, 0.f, 0.f, 0.f, 0.f, 0.f};
#pragma unroll
        for (int kt = 0; kt < 5; ++kt) {
            LAS unsigned char* vbuf = VL + (kt & 1) * 6144;
#pragma unroll
            for (int i = 0; i < 4; ++i) *(LAS f16x8*)(vbuf + (lane >> 1) * VROW + (lane & 1) * 64 + i * 16) = Vr[kt][i];
            asm volatile("s_waitcnt lgkmcnt(0)" ::: "memory");
#pragma unroll
            for (int s2 = 0; s2 < 2; ++s2) {
                u32x4 pa; pa.x = pk_h2(S[kt][8 * s2 + 0], S[kt][8 * s2 + 1]); pa.y = pk_h2(S[kt][8 * s2 + 2], S[kt][8 * s2 + 3]); pa.z = pk_h2(S[kt][8 * s2 + 4], S[kt][8 * s2 + 5]); pa.w = pk_h2(S[kt][8 * s2 + 6], S[kt][8 * s2 + 7]);
#pragma unroll
                for (int dt = 0; dt < 2; ++dt) {
                    const v4i16_t lo = __builtin_amdgcn_ds_read_tr16_b64_v4i16((LAS v4i16_t*)(vbuf + (16 * s2 + 4 * hi + trq) * VROW + (32 * dt + 16 * trg + 4 * trp) * 2));
                    const v4i16_t hh = __builtin_amdgcn_ds_read_tr16_b64_v4i16((LAS v4i16_t*)(vbuf + (16 * s2 + 8 + 4 * hi + trq) * VROW + (32 * dt + 16 * trg + 4 * trp) * 2));
                    const s16x8 bv = {lo[0], lo[1], lo[2], lo[3], hh[0], hh[1], hh[2], hh[3]};
                    O[dt] = __builtin_amdgcn_mfma_f32_32x32x16_f16(__builtin_bit_cast(f16x8, pa), __builtin_bit_cast(f16x8, bv), O[dt], 0, 0, 0); } }
            asm volatile("s_waitcnt lgkmcnt(0)" ::: "memory");
        }
#pragma unroll
        for (int e = 0; e < 16; ++e) { const int q = (e & 3) + 8 * (e >> 2) + 4 * hi; const float il = linv[q];
            h16* op = og + (size_t)(b * SEQ + (j0 + q) * dil + res) * 768 + gh * 64 + ql;
            op[0] = (h16)(O[0][e] * il); op[32] = (h16)(O[1][e] * il); }
        asm volatile("s_waitcnt lgkmcnt(0)" ::: "memory");
    }
}


__device__ __forceinline__ f16x8 fp8x8_to_f16(unsigned w0, unsigned w1) {
    const h16x2 a = __builtin_amdgcn_cvt_scalef32_pk_f16_fp8((int)w0, 1.0f, false), b = __builtin_amdgcn_cvt_scalef32_pk_f16_fp8((int)w0, 1.0f, true),
                c = __builtin_amdgcn_cvt_scalef32_pk_f16_fp8((int)w1, 1.0f, false), d = __builtin_amdgcn_cvt_scalef32_pk_f16_fp8((int)w1, 1.0f, true);
    const u32x4 r = {__builtin_bit_cast(unsigned, a), __builtin_bit_cast(unsigned, b), __builtin_bit_cast(unsigned, c), __builtin_bit_cast(unsigned, d)};
    return __builtin_bit_cast(f16x8, r);
}
template <bool FUSED>
__device__ __forceinline__ void ph_sparse_wave(const Frame& F, h16* qlat, const h16* qr, const unsigned char* ckv8, const unsigned char* kr8, const unsigned short* sel, int ta = 0, int tb = 0) {
    int lane = F.lane; asm volatile("" : "+v"(lane));
    LAS unsigned char* V = F.lds + F.wave * 16384;
    const int qp = (lane & 15) >> 2, pp = lane & 3;
    const int k0 = 4 * (lane >> 4) + qp;
    const int tr0 = k0 * 512 + (pp >> 1) * 16 + (pp & 1) * 8, x0 = k0 & 7;
    const int vw = (lane & 15) * 512, swz = lane & 7;
    const int lane0 = lane;
    const int nit = FUSED ? 8 : (MT - F.gw + F.NGW - 1) / F.NGW;
    for (int it = 0; it < nit; ++it) {
        const int tok = FUSED ? ((it < 4 ? ta : tb - 4) + it) : F.gw + it * F.NGW;
        int ll = lane0; asm volatile("" : "+v"(ll));
        const int c = ll & 15, kq = ll >> 4, hd = c & 7;
        const int b = tok / SEQ, t = tok % SEQ, cnt = (t + 1 < TOPK) ? t + 1 : TOPK, nch = (cnt + 31) >> 5;
        LAS unsigned short* sp = (LAS unsigned short*)(F.lds + XCH_OFF + F.wave * 512) + c;
        *(LAS u32x2*)(F.lds + XCH_OFF + F.wave * 512 + 8 * ll) = *(const u32x2*)(sel + (size_t)tok * TOPK + 4 * ll);
        asm volatile("s_waitcnt lgkmcnt(0)" ::: "memory");
        f16x8 Qf[9]; u32x4 Kr[2][4]; u32x2 Rr[2];
#pragma unroll
        for (int s_ = 0; s_ < 8; ++s_) Qf[s_] = *(const f16x8*)(qlat + (size_t)tok * 2048 + hd * 256 + 64 * (s_ >> 1) + 16 * kq + 8 * (s_ & 1));
        Qf[8] = *(const f16x8*)(qr + (size_t)tok * 256 + hd * 32 + 8 * kq);
        int rowi[2];
#define SW_LOADK() do { _Pragma("unroll") for (int tl = 0; tl < 2; ++tl) { _Pragma("unroll") for (int q4 = 0; q4 < 4; ++q4) Kr[tl][q4] = *(const u32x4*)(ckv8 + (size_t)rowi[tl] * 256 + 64 * q4 + 16 * kq); \
        Rr[tl] = *(const u32x2*)(kr8 + (size_t)rowi[tl] * 32 + 8 * kq); } } while (0)
        rowi[0] = b * SEQ + (int)sp[0]; rowi[1] = b * SEQ + (int)sp[16];
        SW_LOADK();
        float m = -INFINITY, l = 0.f;
        f32x4 O[16];
#pragma unroll
        for (int ft = 0; ft < 16; ++ft) O[ft] = (f32x4){0.f, 0.f, 0.f, 0.f};
        for (int ch = 0; ch < nch; ++ch) {
            const bool more = ch + 1 < nch;
            int rown0 = 0, rown1 = 0; if (more) { rown0 = (int)sp[32 * (ch + 1)]; rown1 = (int)sp[32 * (ch + 1) + 16]; }
            f16x8 Kf[2][9];
#pragma unroll
            for (int tl = 0; tl < 2; ++tl) {
#pragma unroll
                for (int q4 = 0; q4 < 4; ++q4) { Kf[tl][2 * q4] = fp8x8_to_f16(Kr[tl][q4].x, Kr[tl][q4].y); Kf[tl][2 * q4 + 1] = fp8x8_to_f16(Kr[tl][q4].z, Kr[tl][q4].w); }
                Kf[tl][8] = fp8x8_to_f16(Rr[tl].x, Rr[tl].y); }
            if (more) { rowi[0] = b * SEQ + rown0; rowi[1] = b * SEQ + rown1; SW_LOADK(); }
            f32x4 S[2];
#pragma unroll
            for (int tl = 0; tl < 2; ++tl) { S[tl] = (f32x4){0.f, 0.f, 0.f, 0.f};
#pragma unroll
                for (int s_ = 0; s_ < 9; ++s_) S[tl] = __builtin_amdgcn_mfma_f32_16x16x32_f16(Kf[tl][s_], Qf[s_], S[tl], 0, 0, 0); }
            float cm = -INFINITY;
#pragma unroll
            for (int tl = 0; tl < 2; ++tl)
#pragma unroll
                for (int e = 0; e < 4; ++e) { if (32 * ch + 16 * tl + 4 * kq + e >= cnt) S[tl][e] = -INFINITY; cm = fmaxf(cm, S[tl][e]); }
            cm = fmaxf(cm, __shfl_xor(cm, 16)); cm = fmaxf(cm, __shfl_xor(cm, 32));
            if (__any(cm > m + 8.0f)) { const float mn = fmaxf(m, cm), alpha = __builtin_amdgcn_exp2f(m - mn); m = mn; l *= alpha;
#pragma unroll
                for (int ft = 0; ft < 16; ++ft) O[ft] = O[ft] * alpha; }
            float pe[2][4]; float ps = 0.f;
#pragma unroll
            for (int tl = 0; tl < 2; ++tl)
#pragma unroll
                for (int e = 0; e < 4; ++e) { pe[tl][e] = __builtin_amdgcn_exp2f(S[tl][e] - m); ps += pe[tl][e]; }
            l += ps;
#pragma unroll
            for (int tl = 0; tl < 2; ++tl)
#pragma unroll
                for (int s_ = 0; s_ < 8; ++s_) *(LAS f16x8*)(V + vw + tl * 8192 + (((4 * (s_ >> 1) + kq) ^ swz) << 5) + (s_ & 1) * 16) = Kf[tl][s_];
            asm volatile("s_waitcnt lgkmcnt(0)" ::: "memory");
            u32x4 pk; pk.x = pk_h2(pe[0][0], pe[0][1]); pk.y = pk_h2(pe[0][2], pe[0][3]); pk.z = pk_h2(pe[1][0], pe[1][1]); pk.w = pk_h2(pe[1][2], pe[1][3]);
            const f16x8 Pf = __builtin_bit_cast(f16x8, pk);
#pragma unroll
            for (int ft = 0; ft < 16; ++ft) {
                const v4i16_t lo = __builtin_amdgcn_ds_read_tr16_b64_v4i16((LAS v4i16_t*)(V + tr0 + (((ft & 7) ^ x0) << 5) + (ft >> 3) * 256));
                const v4i16_t hi = __builtin_amdgcn_ds_read_tr16_b64_v4i16((LAS v4i16_t*)(V + tr0 + (((ft & 7) ^ x0) << 5) + (ft >> 3) * 256 + 8192));
                const s16x8 av = {lo[0], lo[1], lo[2], lo[3], hi[0], hi[1], hi[2], hi[3]};
                O[ft] = __builtin_amdgcn_mfma_f32_16x16x32_f16(__builtin_bit_cast(f16x8, av), Pf, O[ft], 0, 0, 0); }
            asm volatile("s_waitcnt lgkmcnt(0)" ::: "memory");
        }
        l += __shfl_xor(l, 16); l += __shfl_xor(l, 32);
        if (c < 8) { const float il = __builtin_amdgcn_rcpf(l);
#pragma unroll
            for (int ft = 0; ft < 16; ++ft) { const f32x4 o = O[ft] * il; u32x2 pk; pk.x = pk_h2(o.x, o.y); pk.y = pk_h2(o.z, o.w);
                *(u32x2*)(qlat + (size_t)tok * 2048 + c * 256 + 16 * ft + 4 * kq) = pk; } }
#undef SW_LOADK
    }
}


__device__ __forceinline__ void precomb_tiles(const Frame& F, const Args& args, unsigned char* ws, int t_lo, int t_hi, int wg, int nwg) {
    LAS float* As = (LAS float*)(F.lds); LAS float* Bs = (LAS float*)(F.lds + 64 * 65 * 4);
    for (int tl = t_lo + wg; tl < t_hi; tl += nwg) {
        __syncthreads();
        const bool ql = tl < 192; int hd, rb, xb;
        if (ql) { hd = tl / 24; rb = (tl % 24) / 6; xb = tl % 6; } else { const int t2 = tl - 192; hd = t2 / 64; rb = (t2 % 64) / 16; xb = t2 % 16; }
#pragma unroll
        for (int k = 0; k < 2; ++k) { const int i4 = F.tid + NTHR * k, row = i4 >> 4, c4 = (i4 & 15) * 4;
            if (ql) { const f32x4 a = *(const f32x4*)(args.in[15] + (size_t)(rb * 64 + row) * 512 + hd * 64 + c4), bq = *(const f32x4*)(args.in[14] + (size_t)(xb * 64 + row) * 768 + hd * 96 + c4);
#pragma unroll
                for (int e = 0; e < 4; ++e) { As[row * 65 + c4 + e] = a[e]; Bs[row * 65 + c4 + e] = bq[e]; } }
            else { const f32x4 a = *(const f32x4*)(args.in[18] + (size_t)(hd * 64 + row) * DM + xb * 64 + c4), bq = *(const f32x4*)(args.in[16] + (size_t)(rb * 64 + row) * 512 + hd * 64 + c4);
#pragma unroll
                for (int e = 0; e < 4; ++e) { As[(c4 + e) * 65 + row] = a[e]; Bs[row * 65 + c4 + e] = bq[e]; } } }
        __syncthreads();
        const int j = F.tid & 63, ig = F.wave;
        float acc8[8];
#pragma unroll
        for (int ii = 0; ii < 8; ++ii) acc8[ii] = 0.f;
#pragma unroll 4
        for (int v = 0; v < 64; ++v) { const float bv = Bs[j * 65 + v];
#pragma unroll
            for (int ii = 0; ii < 8; ++ii) acc8[ii] += As[(ig * 8 + ii) * 65 + v] * bv; }
        if (ql) { const float gj = args.in[12][xb * 64 + j]; h16* o = (h16*)(ws + OW_4);
#pragma unroll
            for (int ii = 0; ii < 8; ++ii) o[(size_t)(hd * 256 + rb * 64 + ig * 8 + ii) * QL + xb * 64 + j] = (h16)(acc8[ii] * gj); }
        else { h16* o = (h16*)(ws + OW_OV);
#pragma unroll
            for (int ii = 0; ii < 8; ++ii) o[(size_t)(xb * 64 + ig * 8 + ii) * 2048 + hd * 256 + rb * 64 + j] = (h16)acc8[ii]; }
    }
    __syncthreads();
}


__device__ __forceinline__ void ph_topk_sparse(const Frame& F, const h16* qi, const h16* ki, const float* wi, unsigned short* sel, h16* qlat, const h16* qr, const unsigned char* ckv8, const unsigned char* kr8) {
    LAS unsigned* hist = (LAS unsigned*)(F.lds + F.wave * 16384);
    for (int p = F.gw; p < 2048; p += F.NGW) {
        int ta, tb;
        if (p < 4 * 480) { const int b = p & 3, pj = p >> 2; ta = b * SEQ + 4 * (64 + pj); tb = b * SEQ + 4 * (1023 - pj);
            tk_group(F, qi, ki, wi, sel, b, 4 * (64 + pj), hist);
            tk_group(F, qi, ki, wi, sel, b, 4 * (1023 - pj), hist); }
        else { const int g0 = 2 * (p - 4 * 480);
#pragma unroll
            for (int gg = 0; gg < 2; ++gg) { const int g = g0 + gg, b = g >> 6, t0 = (g & 63) * 4;
                int l0 = F.lane; asm volatile("" : "+v"(l0));
                for (int i = l0; i < 4 * TOPK; i += 64) { const int q = i >> 8, k = i & 255; sel[(size_t)(b * SEQ + t0 + q) * TOPK + k] = (unsigned short)(k <= t0 + q ? k : 0); } }
            ta = (g0 >> 6) * SEQ + (g0 & 63) * 4; tb = ((g0 + 1) >> 6) * SEQ + ((g0 + 1) & 63) * 4; }
        asm volatile("s_waitcnt vmcnt(0) lgkmcnt(0)" ::: "memory");
        ph_sparse_wave<true>(F, qlat, qr, ckv8, kr8, sel, ta, tb);
        asm volatile("s_waitcnt lgkmcnt(0)" ::: "memory");
    }
}

__global__ void __launch_bounds__(NTHR, 2) mega_fwd(Args args) {
    extern __shared__ __attribute__((aligned(16))) unsigned char lds_raw[];
    Frame F; F.lds = (LAS unsigned char*)lds_raw; F.tid = threadIdx.x; F.lane = F.tid & 63; F.wave = __builtin_amdgcn_readfirstlane(F.tid >> 6);
    F.G = gridDim.x; F.gw = blockIdx.x * NWAVES + F.wave; F.NGW = F.G * NWAVES;
    volatile LAS unsigned* MISC = (volatile LAS unsigned*)(F.lds + MISC_OFF);
    unsigned char* ws = args.ws;
    for (int u = F.tid; u < (LDS_BYTES - LDSCTL_OFF) / 4; u += NTHR) ((LAS unsigned*)(F.lds + LDSCTL_OFF))[u] = 0u;
    __syncthreads();
    XcdBarrier bar = xcd_barrier_post((unsigned*)(ws + OFF_CTL) + CW_BAR, MISC + 8);
    const int lo = args.ph_lo, hi = args.ph_hi;
#define IN(k) (lo <= (k) && (k) < hi)
#define SEAM(k) do { if (IN(k) && IN((k) + 1)) xcd_barrier(bar); } while (0)
    float* mod = (float*)(ws + OFF_MOD); float2* tab = (float2*)(ws + OFF_ROPE);
    h16* Hb = (h16*)(ws + OFF_H); h16* Ab = (h16*)(ws + OFF_A); float* Fb = (float*)(ws + OFF_F);

    if (IN(0)) {
        LAS float* scr = (LAS float*)(F.lds + F.wave * 16384);
        for (int ch = blockIdx.x; ch < (NMOD * DM) / 36; ch += F.G) {
            LAS float* sl = (LAS float*)(F.lds);
            LAS float* part = (LAS float*)(F.lds + 16384);
            __syncthreads();
            for (int i = F.tid; i < 4 * DM; i += NTHR) sl[i] = silu_f(args.in[1][i]);
            __syncthreads();
            const int ln = F.lane < 36 ? F.lane : 35;
            const float* wm = args.in[3] + (size_t)(F.wave * 128) * (NMOD * DM) + ch * 36 + ln;
            float a0 = 0.f, a1 = 0.f, a2 = 0.f, a3 = 0.f;
#pragma unroll 16
            for (int k = 0; k < 128; ++k) { const float w = wm[(size_t)k * (NMOD * DM)]; const int kk = F.wave * 128 + k; a0 += sl[kk] * w; a1 += sl[DM + kk] * w; a2 += sl[2 * DM + kk] * w; a3 += sl[3 * DM + kk] * w; }
            part[(F.wave * 4 + 0) * 64 + F.lane] = a0; part[(F.wave * 4 + 1) * 64 + F.lane] = a1; part[(F.wave * 4 + 2) * 64 + F.lane] = a2; part[(F.wave * 4 + 3) * 64 + F.lane] = a3;
            __syncthreads();
            if (F.tid < 256 && (F.tid & 63) < 36) { const int b = F.tid >> 6, l = F.tid & 63; float sm = args.in[4][ch * 36 + l];
#pragma unroll
                for (int w = 0; w < 8; ++w) sm += part[(w * 4 + b) * 64 + l];
                mod[b * (NMOD * DM) + ch * 36 + l] = sm; }
            __syncthreads();
        }
        for (int idx = blockIdx.x * NTHR + F.tid; idx < MT * 48; idx += F.G * NTHR) { const int tok = idx / 48, i = idx % 48;
            const float inv = (i < 32) ? powf(10000.f, -(float)i / 32.f) : powf(10000.f, -(float)(i - 32) / 16.f);
            const float ang = (float)((const int*)args.in[2])[tok] * inv; tab[idx] = make_float2(cosf(ang), sinf(ang)); }
        tr_job_mapped(F, args, 0, 2 * FF, 0, DM, (h16*)(ws + OW_GU1), nullptr, scr, 0);
        if (F.G != 256) {
            tr_job_plain(F, args.in[8], DM, DM, FF, (h16*)(ws + OW_D1), scr, 768);
            tr_job_mapped(F, args, 2, NIN3, 0, DM, (h16*)(ws + OW_IN), nullptr, scr, 128);
            tr_job_plain(F, args.in[11] + C_GATE, DIN, 2048, DM, (h16*)(ws + OW_GATE), scr, 1664);
            tr_job_mapped(F, args, 3, 512, 2048, QL, (h16*)(ws + OW_4), args.in[12], scr, 640);
            tr_job_plain(F, args.in[19], DM, DM, 256, (h16*)(ws + OW_UPB), scr, 736);
            tr_job_plain(F, args.in[20], DM, DM, DM, (h16*)(ws + OW_O), scr, 864);
            tr_job_mapped(F, args, 1, 2 * FF, 0, DM, (h16*)(ws + OW_GU2), nullptr, scr, 1376);
            tr_job_plain(F, args.in[25], DM, DM, FF, (h16*)(ws + OW_D2), scr, 96);
            precomb_tiles(F, args, ws, 0, 192, (int)blockIdx.x, F.G);
            tr_job_plain(F, args.in[18], DM, DM, 512, (h16*)(ws + OW_UPA), scr, 256);
        }
    }
    SEAM(0);
    if (IN(1)) ph_normmod(F, args.in[0], args.in[5], mod, 1, 0, Hb);
    SEAM(1);
    if (IN(2)) { pg8::Gemm g{Hb, (const h16*)(ws + OW_GU1), MT, 2 * FF, DM}; pg8::StaticOrder S; S.init(MT, 2 * FF, F.G, (int)blockIdx.x); pg8::EpiSwiGLU E{Ab};
        pg8::gemm_phase<pg8::EpiSwiGLU, true>(F.lds, g, S, E);
        if (F.G == 256 && blockIdx.x >= 128) {
            Frame F2 = F; F2.gw = ((int)blockIdx.x - 128) * NWAVES + F.wave; F2.NGW = 128 * NWAVES; LAS float* scr = (LAS float*)(F.lds + F.wave * 16384);
            tr_job_plain(F2, args.in[8], DM, DM, FF, (h16*)(ws + OW_D1), scr, 0);
            tr_job_mapped(F2, args, 2, NIN3, 0, DM, (h16*)(ws + OW_IN), nullptr, scr, 384);
            tr_job_mapped(F2, args, 3, 512, 2048, QL, (h16*)(ws + OW_4), args.in[12], scr, 896);
            tr_job_mapped(F2, args, 1, 2 * FF, 0, DM, (h16*)(ws + OW_GU2), nullptr, scr, 640);
            precomb_tiles(F, args, ws, 0, 192, (int)blockIdx.x - 128, 128);
            for (int i = ((int)blockIdx.x - 128) * NTHR + F.tid; i < (int)(MiB / 16); i += 128 * NTHR) ((u32x4*)(ws + OW_BD))[i] = (u32x4){0u, 0u, 0u, 0u}; } }
    SEAM(2);
    if (IN(3)) { pg8::Gemm g{Ab, (const h16*)(ws + OW_D1), MT, DM, FF}; pg8::StaticOrder S; S.init(MT, DM, F.G, (int)blockIdx.x); pg8::EpiH16 E{(h16*)Fb};
        pg8::gemm_phase<pg8::EpiH16, false>(F.lds, g, S, E); }
    SEAM(3);
    if (IN(4)) ph_resnorm<false, true>(F, args.in[0], (const h16*)Fb, args.in[9], mod, 2, 0.5f, args.out, true, args.in[10], 4, 3, Hb);
    SEAM(4);
    if (IN(5)) { pg8::Gemm g{Hb, (const h16*)(ws + OW_IN), MT, NIN3, DM}; pg8::StaticOrder S; S.init(MT, NIN3, F.G, (int)blockIdx.x);
        pg8::EpiIn E{(h16*)(ws + OFF_CKV), (h16*)(ws + OFF_CQ), (h16*)(ws + OFF_KR), (h16*)(ws + OFF_KI), (h16*)(ws + OFF_QB), (h16*)(ws + OFF_KB), (h16*)(ws + OFF_VT), (float*)(ws + OFF_WI), (float*)(ws + OFF_SSQ),
                     args.in[13], tab, (LAS float*)(F.lds + XCH_OFF)};
        pg8::gemm_phase<pg8::EpiIn, true>(F.lds, g, S, E); }
    SEAM(5);
    if (IN(6)) { for (int tk_ = blockIdx.x * NTHR + F.tid; tk_ < MT; tk_ += F.G * NTHR) { const f32x4 s0 = *(const f32x4*)((const float*)(ws + OFF_SSQ) + tk_ * 8), s1 = *(const f32x4*)((const float*)(ws + OFF_SSQ) + tk_ * 8 + 4);
            ((float*)(ws + OFF_RSTDQ))[tk_] = rsqrtf((((s0.x + s0.y) + (s0.z + s0.w)) + ((s1.x + s1.y) + (s1.z + s1.w))) * (1.f / QL) + EPS); } }
    if (IN(6)) ph_dilated_mfma(F, (const h16*)(ws + OFF_QB), (const h16*)(ws + OFF_KB), (const h16*)(ws + OFF_VT), (h16*)(ws + OFF_OG), (float*)(ws + OFF_LSE));
    SEAM(6);
    if (IN(7)) { pg8::Gemm g{(const h16*)(ws + OFF_CQ), (const h16*)(ws + OW_4), MT, N4, QL}; pg8::StaticOrder S; S.init(MT, N4, F.G, (int)blockIdx.x);
        pg8::Epi4 E{(h16*)(ws + OFF_QLAT), (h16*)(ws + OFF_QR), (h16*)(ws + OFF_QI), (const float*)(ws + OFF_RSTDQ), tab};
        pg8::gemm_phase<pg8::Epi4, true>(F.lds, g, S, E);
        if (F.G == 256 && blockIdx.x >= 128) {
            Frame F2 = F; F2.gw = ((int)blockIdx.x - 128) * NWAVES + F.wave; F2.NGW = 128 * NWAVES; LAS float* scr = (LAS float*)(F.lds + F.wave * 16384);
            tr_job_plain(F2, args.in[11] + C_GATE, DIN, 2048, DM, (h16*)(ws + OW_GATE), scr, 0);
            tr_job_plain(F2, args.in[19], DM, DM, 256, (h16*)(ws + OW_UPB), scr, 512);
            tr_job_plain(F2, args.in[20], DM, DM, DM, (h16*)(ws + OW_O), scr, 640);
            tr_job_plain(F2, args.in[18], DM, DM, 512, (h16*)(ws + OW_UPA), scr, 256);
            for (int it = F2.gw; it < 4 * 16; it += F2.NGW) { const int kb = it >> 4, nb = it & 15, n0 = nb * 32, hl = (n0 >> 6) & 3;
                tr_item(args.in[16], 512, n0 + (F.lane & 31), true, nullptr, kb * 64, (h16*)(ws + OW_BD) + (size_t)n0 * 1024 + 256 * hl, 1024, scr, F.lane); } } }
    SEAM(7);
    if (IN(8)) { ph_combine(F, (const h16*)(ws + OFF_OG), (const float*)(ws + OFF_LSE), (h16*)(ws + OFF_OB));
        ph_topk_sparse(F, (const h16*)(ws + OFF_QI), (const h16*)(ws + OFF_KI), (const float*)(ws + OFF_WI), (unsigned short*)(ws + OFF_SEL),
                       (h16*)(ws + OFF_QLAT), (const h16*)(ws + OFF_QR), (const unsigned char*)(ws + OFF_CKV), (const unsigned char*)(ws + OFF_KR)); }
    SEAM(8);
    if (IN(9) && F.G == 256) { const bool first = blockIdx.x < 128;
        pg8::Gemm g{first ? (const h16*)(ws + OFF_QLAT) : (const h16*)(ws + OFF_OB), first ? (const h16*)(ws + OW_BD) : (const h16*)(ws + OW_UPB), MT, first ? 512 : DM, first ? 1024 : 256, first ? 2048 : 0, first ? 1024 : 0};
        pg8::StaticOrder S; S.init(MT, first ? 512 : DM, 128, first ? (int)blockIdx.x : (int)blockIdx.x - 128);
        pg8::EpiH16 E{first ? (h16*)(ws + OFF_OA) : (h16*)(ws + OFF_Y2), first ? 512 : DM};
        pg8::gemm_phase<pg8::EpiH16, false>(F.lds, g, S, E); }
    SEAM(9);
    SEAM(9);
    if (IN(10)) { pg8::StaticOrder S; S.init(MT, DM, F.G, (int)blockIdx.x); h16* Y1 = (h16*)(ws + OFF_Y1); h16* Y2 = (h16*)(ws + OFF_Y2);
        { pg8::Gemm g{(const h16*)(ws + OFF_OA), (const h16*)(ws + OW_UPA), MT, DM, 512}; pg8::EpiH16 E{Y1}; pg8::gemm_phase<pg8::EpiH16, false>(F.lds, g, S, E); }
        { pg8::Gemm g{Hb, (const h16*)(ws + OW_GATE), MT, DM, DM}; pg8::EpiGate E{Y1, Y1, 0}; pg8::gemm_phase<pg8::EpiGate, false>(F.lds, g, S, E); }
        { pg8::Gemm g{Hb, (const h16*)(ws + OW_GATE) + (size_t)DM * DM, MT, DM, DM}; pg8::EpiGate E{Y2, Y1, 1}; pg8::gemm_phase<pg8::EpiGate, false>(F.lds, g, S, E); } }
    SEAM(10);
    if (IN(11)) { pg8::Gemm g{(const h16*)(ws + OFF_Y1), (const h16*)(ws + OW_O), MT, DM, DM}; pg8::StaticOrder S; S.init(MT, DM, F.G, (int)blockIdx.x); pg8::EpiH16 E{(h16*)(ws + OFF_YF)};
        pg8::gemm_phase<pg8::EpiH16, false>(F.lds, g, S, E); }
    SEAM(11);
    if (IN(12)) ph_resnorm<true, true>(F, args.out, (const h16*)(ws + OFF_YF), args.in[21], mod, 5, 1.0f, ws + OFF_F, true, args.in[22], 7, 6, Hb);
    SEAM(12);
    if (IN(13)) { pg8::Gemm g{Hb, (const h16*)(ws + OW_GU2), MT, 2 * FF, DM}; pg8::StaticOrder S; S.init(MT, 2 * FF, F.G, (int)blockIdx.x); pg8::EpiSwiGLU E{Ab};
        pg8::gemm_phase<pg8::EpiSwiGLU, true>(F.lds, g, S, E);
        if (F.G == 256 && blockIdx.x >= 128) { Frame F2 = F; F2.gw = ((int)blockIdx.x - 128) * NWAVES + F.wave; F2.NGW = 128 * NWAVES;
            tr_job_plain(F2, args.in[25], DM, DM, FF, (h16*)(ws + OW_D2), (LAS float*)(F.lds + F.wave * 16384), 0); } }
    SEAM(13);
    if (IN(14)) { pg8::Gemm g{Ab, (const h16*)(ws + OW_D2), MT, DM, FF}; pg8::StaticOrder S; S.init(MT, DM, F.G, (int)blockIdx.x); pg8::EpiH16 E{(h16*)(ws + OFF_F + 32 * MiB)};
        pg8::gemm_phase<pg8::EpiH16, false>(F.lds, g, S, E); }
    SEAM(14);
    if (IN(15)) ph_resnorm<true, false>(F, ws + OFF_F, (const h16*)(ws + OFF_F + 32 * MiB), args.in[26], mod, 8, 0.5f, args.out, false, nullptr, 0, 0, nullptr);
#undef IN
#undef SEAM
}


extern "C" void kernel_launch(void* const* d_in, const int* in_sizes, int n_in, void* d_out, int out_size, void* d_ws, size_t ws_size, hipStream_t stream) {
    if (n_in != 27 || ws_size < WS_END || out_size != MT * DM) { fprintf(stderr, "kernel_launch: unexpected shapes (n_in %d ws %zu out %d)\n", n_in, ws_size, out_size); return; }
    static int grid = 0;
    if (grid == 0) {
        int dev = 0, cus = 0, per_cu = 0;
        if (hipGetDevice(&dev) != hipSuccess || hipDeviceGetAttribute(&cus, hipDeviceAttributeMultiprocessorCount, dev) != hipSuccess) { grid = -1; return; }
        if (hipFuncSetAttribute((const void*)mega_fwd, hipFuncAttributeMaxDynamicSharedMemorySize, LDS_BYTES) != hipSuccess) { fprintf(stderr, "kernel_launch: hipFuncSetAttribute failed\n"); grid = -1; return; }
        if (hipOccupancyMaxActiveBlocksPerMultiprocessor(&per_cu, (const void*)mega_fwd, NTHR, LDS_BYTES) != hipSuccess || per_cu < 1) { fprintf(stderr, "kernel_launch: occupancy query says %d blocks/CU\n", per_cu); grid = -1; return; }
        grid = cus;
    }
    if (grid < 0) return;
    hipMemsetAsync((char*)d_ws + OFF_CTL, 0, 1 * MiB, stream);
    Args a{}; for (int i = 0; i < 27; ++i) a.in[i] = (const float*)d_in[i]; a.out = (float*)d_out; a.ws = (unsigned char*)d_ws; a.ph_lo = 0; a.ph_hi = 16;
    void* kargs[] = {&a};
#ifdef PH_DOUBLE
    a.ph_hi = PH_DOUBLE + 1; (void)hipLaunchCooperativeKernel((const void*)mega_fwd, dim3(grid), dim3(NTHR), kargs, LDS_BYTES, stream);
    hipMemsetAsync((char*)d_ws + OFF_CTL, 0, 1 * MiB, stream); a.ph_lo = PH_DOUBLE; a.ph_hi = 16;
#endif
    const hipError_t e = hipLaunchCooperativeKernel((const void*)mega_fwd, dim3(grid), dim3(NTHR), kargs, LDS_BYTES, stream);
    if (e != hipSuccess) fprintf(stderr, "kernel_launch: cooperative launch failed: %s (grid %d)\n", hipGetErrorString(e), grid);
    (void)in_sizes;
}
```

```cpp
#include <hip/hip_runtime.h>
#include <hip/hip_fp16.h>
#include <cstdio>
#include <cstdint>

constexpr int NB = 4, SEQ = 4096, DM = 1024, MT = NB * SEQ, FF = 2816;
constexpr int QL = 384, KVL = 256, DNOPE = 64, DROPE = 32, DVA = 64, HA = 8, HI = 8, DI = 32, TOPK = 256;
constexpr int NG = 3, HB = 4, DHB = 64, NMOD = 9, DIN = 5064;
constexpr int C_CQ = 0, C_CKV = 384, C_KR = 640, C_KI = 672, C_WI = 704, C_QKV = 712, C_GATE = 3016;
constexpr float EPS = 1e-6f, LOG2E = 1.4426950408889634f;
typedef _Float16 h16;

constexpr size_t MiB = 1u << 20;
constexpr size_t OFF_CTL = 0, OFF_MOD = 1 * MiB, OFF_ROPE = 2 * MiB, OFF_W = 8 * MiB, OFF_H = 60 * MiB, OFF_A = 92 * MiB, OFF_F = 180 * MiB, OFF_SP = 244 * MiB, WS_END = 256 * MiB;
constexpr size_t OFF_QB = OFF_A, OFF_KB = OFF_A + 24 * MiB, OFF_VT = OFF_A + 48 * MiB, OFF_CKV = OFF_A + 72 * MiB, OFF_KR = OFF_A + 80 * MiB, OFF_KI = OFF_A + 81 * MiB,
                 OFF_WI = OFF_A + 82 * MiB, OFF_SSQ = OFF_A + 82 * MiB + 512 * 1024, OFF_CQ = OFF_SP;
constexpr size_t OFF_RSTDQ = OFF_A + 83 * MiB;
constexpr size_t OFF_OG = OFF_F, OFF_LSE = OFF_F + 24 * MiB, OFF_QLAT = OFF_A, OFF_QR = OFF_A + 64 * MiB, OFF_QI = OFF_F + 25 * MiB, OFF_SEL = OFF_F + 33 * MiB, OFF_OB = OFF_SP;
constexpr size_t OFF_Y1 = OFF_F, OFF_Y2 = OFF_F + 32 * MiB, OFF_YF = OFF_A;

__device__ __forceinline__ float silu_f(float v) { return v / (1.f + __expf(-v)); }
__device__ __forceinline__ float sigm_f(float v) { return 1.f / (1.f + __expf(-v)); }
__host__ __device__ __forceinline__ int dil_of(int g) { return g == 0 ? 1 : (g == 1 ? 4 : 16); }
__device__ __forceinline__ unsigned fkey(float f) { const unsigned u = __float_as_uint(f); return (u & 0x80000000u) ? ~u : (u | 0x80000000u); }


#define LAS __attribute__((address_space(3)))
#define GAS __attribute__((address_space(1)))
typedef _Float16 f16x8 __attribute__((ext_vector_type(8)));
typedef float f32x4 __attribute__((ext_vector_type(4)));
typedef float f32x2 __attribute__((ext_vector_type(2)));
typedef unsigned u32x4 __attribute__((ext_vector_type(4)));
typedef unsigned u32x2 __attribute__((ext_vector_type(2)));
typedef _Float16 h16x2 __attribute__((ext_vector_type(2)));
__device__ __forceinline__ unsigned pk_h2(float lo, float hi) { f32x2 v = {lo, hi}; h16x2 h = __builtin_convertvector(v, h16x2); return __builtin_bit_cast(unsigned, h); }

namespace pg8 {
constexpr int BM = 256, BK = 64, HALF = 128, HTB = HALF * BK * 2, STAGE_BYTES = 8 * HTB, NXCD = 8, WGM = 8;
__host__ __device__ __forceinline__ int lds_byte(int r, int c) { const int st = (r >> 4) * 2 + (c >> 5), rr = r & 15, cc = c & 31, ob = rr * 64 + cc * 2; return st * 1024 + (ob ^ (((ob >> 9) & 1) << 5)); }
__host__ __device__ __forceinline__ void stage_rc(int b, int& R, int& C) { const int st = b / 1024, sb = b % 1024, swz = sb ^ (((sb >> 9) & 1) << 5); R = (st >> 1) * 16 + swz / 64; C = (st & 1) * 32 + (swz % 64) / 2; }
__host__ __device__ __forceinline__ int perm32(int rho) { const int n = rho >> 4, i = rho & 15; return 8 * (i >> 2) + 4 * n + (i & 3); }
struct Unit { int pm, pn; };
struct Gemm { const h16* A; const h16* Bt; int M, N, K; int lda = 0, koffA = 0; };
struct StaticOrder {
    int nM, nN, nwg, G, c;
    __host__ __device__ void init(int M, int N, int G_, int c_) { nM = M / BM; nN = N / BM; nwg = nM * nN; G = G_; c = c_; }
    __host__ __device__ bool next(int i, Unit& u) const {
        const long L = (long)i * G + c; if (L >= nwg) return false;
        int wgid = (int)L; { const int q = nwg / NXCD, r = nwg % NXCD, xcd = wgid % NXCD, off = wgid / NXCD; wgid = (xcd < r ? xcd * (q + 1) : r * (q + 1) + (xcd - r) * q) + off; }
        const int nig = WGM * nN, gid = wgid / nig, fm = gid * WGM, gsz = (nM - fm) < WGM ? (nM - fm) : WGM;
        u.pm = fm + ((wgid % nig) % gsz); u.pn = (wgid % nig) / gsz; return true;
    }
};
template <class Epi, bool ALIGN_EPI>
__device__ __forceinline__ void gemm_phase(LAS unsigned char* lds, const Gemm g, const StaticOrder& S, const Epi& E) {
    const int tid = threadIdx.x, wid = __builtin_amdgcn_readfirstlane(tid >> 6), lane = tid & 63, wr = wid >> 2, wc = wid & 3, fr = lane & 15, fq = lane >> 4;
    const int K = g.K, nt = K / BK, lda = g.lda ? g.lda : g.K;
    unsigned voffA[2], voffB[2];
#pragma unroll
    for (int i = 0; i < 2; ++i) { int R, C; stage_rc(tid * 16 + i * 8192, R, C); const int Rb = Epi::PERM ? ((R & ~31) + perm32(R & 31)) : R;
        voffA[i] = (unsigned)(R * lda + C) * 2u; voffB[i] = (unsigned)(Rb * K + C) * 2u; }
    const size_t kstep = (size_t)(BK * 2);
    const size_t hstep = (size_t)HALF * K * 2, hstepA = (size_t)HALF * lda * 2;
    const size_t tstep = 2 * hstep, tstepA = 2 * hstepA, kofA = (size_t)g.koffA * 2;
    const unsigned ldsw = (unsigned)wid * 1024u;
    const int aoff = lds_byte(wr * 64 + fr, fq * 8), boff = lds_byte(wc * 32 + fr, fq * 8);
#define PG8_SA(b, h) (((b) * 2 + (h)) * HTB)
#define PG8_SB(b, h) ((4 + (b) * 2 + (h)) * HTB)
#define PG8_STAGE(bufoff, gbase, voff) do { _Pragma("unroll") for (int _i = 0; _i < 2; ++_i) \
        __builtin_amdgcn_global_load_lds((const unsigned*)((const char*)(gbase) + (voff)[_i]), (LAS unsigned*)(lds + (bufoff) + ldsw + _i * 8192), 16, 0, 0); } while (0)
#define PG8_LDA(dst, b, h) do { _Pragma("unroll") for (int m = 0; m < 4; ++m) _Pragma("unroll") for (int k = 0; k < 2; ++k) dst[m][k] = *(const LAS f16x8*)(lds + PG8_SA(b, h) + aoff + m * 2048 + k * 1024); } while (0)
#define PG8_LDB(dst, b, h) do { _Pragma("unroll") for (int n = 0; n < 2; ++n) _Pragma("unroll") for (int k = 0; k < 2; ++k) dst[n][k] = *(const LAS f16x8*)(lds + PG8_SB(b, h) + boff + n * 2048 + k * 1024); } while (0)
#define PG8_MMA(ai, bj, At, Bt) do { __builtin_amdgcn_s_setprio(1); _Pragma("unroll") for (int m = 0; m < 4; ++m) _Pragma("unroll") for (int n = 0; n < 2; ++n) _Pragma("unroll") for (int k = 0; k < 2; ++k) \
        acc[ai][bj][m][n] = __builtin_amdgcn_mfma_f32_16x16x32_f16(Bt[n][k], At[m][k], acc[ai][bj][m][n], 0, 0, 0); __builtin_amdgcn_s_setprio(0); } while (0)
#define PG8_WAIT_V(n) asm volatile("s_waitcnt vmcnt(" #n ")" ::: "memory")
#define PG8_WAIT_L(n) asm volatile("s_waitcnt lgkmcnt(" #n ")" ::: "memory")
#define PG8_BAR __builtin_amdgcn_s_barrier()
#define PG8_SCHED __builtin_amdgcn_sched_barrier(0)
    Unit cur, nxt; int ui = 0;
    if (!S.next(0, cur)) return;
    f32x4 acc[2][2][4][2];
#pragma unroll
    for (int a = 0; a < 2; ++a)
#pragma unroll
        for (int b = 0; b < 2; ++b)
#pragma unroll
            for (int m = 0; m < 4; ++m)
#pragma unroll
                for (int n = 0; n < 2; ++n) acc[a][b][m][n] = (f32x4){0.f, 0.f, 0.f, 0.f};
    f16x8 At[4][2], B0[2][2], B1[2][2];
    const char* cA = (const char*)g.A + (size_t)cur.pm * tstepA + (size_t)cur.pn * kofA; const char* cB = (const char*)g.Bt + (size_t)cur.pn * tstep;
    PG8_STAGE(PG8_SB(0, 0), cB, voffB); PG8_STAGE(PG8_SB(0, 1), cB + hstep, voffB); PG8_STAGE(PG8_SA(0, 0), cA, voffA); PG8_STAGE(PG8_SA(0, 1), cA + hstepA, voffA);
    if (wr == 1) PG8_BAR;
    PG8_WAIT_V(2); PG8_BAR;
    PG8_STAGE(PG8_SB(1, 0), cB + kstep, voffB); PG8_STAGE(PG8_SA(1, 0), cA + kstep, voffA); PG8_STAGE(PG8_SB(1, 1), cB + hstep + kstep, voffB);
    PG8_WAIT_V(6); PG8_BAR;
    for (;;) {
        const bool has_next = S.next(ui + 1, nxt);
        const char* nA = has_next ? (const char*)g.A + (size_t)nxt.pm * tstepA + (size_t)nxt.pn * kofA : cA; const char* nB = has_next ? (const char*)g.Bt + (size_t)nxt.pn * tstep : cB;
        for (int t = 0; t < nt; t += 2) {
            const bool last = (t == nt - 2);
            const char* a1 = cA + (size_t)(t + 1) * kstep;
            const char* a2 = last ? nA : cA + (size_t)(t + 2) * kstep; const char* b2 = last ? nB : cB + (size_t)(t + 2) * kstep;
            const char* a3 = a2 + kstep; const char* b3 = b2 + kstep;
            PG8_LDB(B0, 0, 0); PG8_LDB(B1, 0, 1); PG8_SCHED; PG8_LDA(At, 0, 0); PG8_STAGE(PG8_SA(1, 1), a1 + hstepA, voffA);
            PG8_WAIT_V(8); PG8_WAIT_L(0); PG8_BAR; PG8_MMA(0, 0, At, B0); PG8_MMA(0, 1, At, B1); PG8_BAR; PG8_SCHED;
            PG8_LDA(At, 0, 1); PG8_STAGE(PG8_SB(0, 0), b2, voffB); PG8_STAGE(PG8_SB(0, 1), b2 + hstep, voffB); PG8_STAGE(PG8_SA(0, 0), a2, voffA);
            PG8_WAIT_V(8); PG8_WAIT_L(0); PG8_BAR; PG8_MMA(1, 0, At, B0); PG8_MMA(1, 1, At, B1); PG8_BAR; PG8_SCHED;
            PG8_LDB(B0, 1, 0); PG8_LDB(B1, 1, 1); PG8_SCHED; PG8_LDA(At, 1, 0); PG8_STAGE(PG8_SA(0, 1), a2 + hstepA, voffA);
            PG8_WAIT_V(8); PG8_WAIT_L(0); PG8_BAR; PG8_MMA(0, 0, At, B0); PG8_MMA(0, 1, At, B1); PG8_BAR; PG8_SCHED;
            PG8_LDA(At, 1, 1); PG8_STAGE(PG8_SB(1, 0), b3, voffB); PG8_STAGE(PG8_SB(1, 1), b3 + hstep, voffB); PG8_STAGE(PG8_SA(1, 0), a3, voffA);
            PG8_WAIT_V(8); PG8_WAIT_L(0); PG8_BAR; PG8_MMA(1, 0, At, B0); PG8_MMA(1, 1, At, B1); PG8_BAR; PG8_SCHED;
        }
        if constexpr (ALIGN_EPI) { if (wr == 0) PG8_BAR; }
        { int l2 = lane; asm volatile("" : "+v"(l2)); E(acc, cur, wr, wc, l2 & 15, l2 >> 4); }
        if (!has_next) break;
#pragma unroll
        for (int a = 0; a < 2; ++a)
#pragma unroll
            for (int b = 0; b < 2; ++b)
#pragma unroll
                for (int m = 0; m < 4; ++m)
#pragma unroll
                    for (int n = 0; n < 2; ++n) acc[a][b][m][n] = (f32x4){0.f, 0.f, 0.f, 0.f};
        cur = nxt; cA = nA; cB = nB; ++ui;
        if constexpr (ALIGN_EPI) { if (wr == 1) PG8_BAR; }
    }
    PG8_WAIT_V(0);
    if constexpr (!ALIGN_EPI) { if (wr == 0) PG8_BAR; }
    PG8_BAR;
#undef PG8_SA
#undef PG8_SB
#undef PG8_STAGE
#undef PG8_LDA
#undef PG8_LDB
#undef PG8_MMA
#undef PG8_WAIT_V
#undef PG8_WAIT_L
#undef PG8_BAR
#undef PG8_SCHED
}
struct EpiF32 {
    static constexpr bool PERM = false;
    float* C; int ldc;
    __device__ __forceinline__ void operator()(const f32x4 (&acc)[2][2][4][2], const Unit& u, int wr, int wc, int fr, int fq) const {
        const int row0 = u.pm * BM + wr * 64 + fr, col0 = u.pn * BM + wc * 32 + 4 * fq;
#pragma unroll
        for (int ai = 0; ai < 2; ++ai)
#pragma unroll
            for (int m = 0; m < 4; ++m) { float* rowp = C + (size_t)(row0 + ai * HALF + m * 16) * ldc + col0;
#pragma unroll
                for (int bj = 0; bj < 2; ++bj)
#pragma unroll
                    for (int n = 0; n < 2; ++n) *(f32x4*)(rowp + bj * HALF + n * 16) = acc[ai][bj][m][n]; }
    }
};
struct EpiSwiGLU {
    static constexpr bool PERM = true;
    h16* O;
    __device__ __forceinline__ void operator()(const f32x4 (&acc)[2][2][4][2], const Unit& u, int wr, int wc, int fr, int fq) const {
        const int row0 = u.pm * BM + wr * 64 + fr, col0 = u.pn * HALF + wc * 32 + 8 * fq;
#pragma unroll
        for (int ai = 0; ai < 2; ++ai)
#pragma unroll
            for (int m = 0; m < 4; ++m) { h16* rowp = O + (size_t)(row0 + ai * HALF + m * 16) * FF + col0;
                float v[8];
#pragma unroll
                for (int n = 0; n < 2; ++n)
#pragma unroll
                    for (int e = 0; e < 4; ++e) { const float gg = acc[ai][0][m][n][e], uu = acc[ai][1][m][n][e]; v[n * 4 + e] = gg * __builtin_amdgcn_rcpf(1.f + __builtin_amdgcn_exp2f(-gg * LOG2E)) * uu; }
                u32x4 w; w.x = pk_h2(v[0], v[1]); w.y = pk_h2(v[2], v[3]); w.z = pk_h2(v[4], v[5]); w.w = pk_h2(v[6], v[7]);
                *(u32x4*)rowp = w; }
    }
};

struct EpiIn {
    static constexpr bool PERM = false;
    h16 *ckv, *cq, *kr, *ki, *qb, *kb, *vT; float *wi, *ssq; const float* gckv; const float2* tab; LAS float* X;
    __device__ __forceinline__ void rope64(const f32x4 (&acc)[2][2][4][2], const Unit& u, int wr, int wc, int fr, int fq, h16* dst, int tl, float scale) const {
        const int tok0 = u.pm * BM + wr * 64 + fr;
        f32x4 tc[4], tn[4];
        { const f32x4* tp = (const f32x4*)(tab + (size_t)tok0 * 48 + 4 * fq); tc[0] = tp[0]; tc[1] = tp[1]; tc[2] = tp[8]; tc[3] = tp[9]; }
#pragma unroll
        for (int rr = 0; rr < 8; ++rr) { const int ai = rr >> 2, m = rr & 3, tok = tok0 + ai * HALF + m * 16;
            if (rr < 7) { const int tokn = tok0 + ((rr + 1) >> 2) * HALF + ((rr + 1) & 3) * 16; const f32x4* tp = (const f32x4*)(tab + (size_t)tokn * 48 + 4 * fq); tn[0] = tp[0]; tn[1] = tp[1]; tn[2] = tp[8]; tn[3] = tp[9]; }
#pragma unroll
            for (int n = 0; n < 2; ++n) { const int i = 16 * n + 4 * fq; const f32x4 t0 = tc[2 * n], t1 = tc[2 * n + 1];
                const f32x4 cs = {t0.x, t0.z, t1.x, t1.z}, sn = {t0.y, t0.w, t1.y, t1.w}, x1 = acc[ai][0][m][n], x2 = acc[ai][1][m][n];
                const f32x4 o1 = (x1 * cs - x2 * sn) * scale, o2 = (x2 * cs + x1 * sn) * scale;
                h16* p = dst + (size_t)tok * 768 + (4 * tl + wc) * 64 + i;
                u32x2 w1, w2; w1.x = pk_h2(o1.x, o1.y); w1.y = pk_h2(o1.z, o1.w); w2.x = pk_h2(o2.x, o2.y); w2.y = pk_h2(o2.z, o2.w);
                *(u32x2*)p = w1; *(u32x2*)(p + 32) = w2; }
#pragma unroll
            for (int k = 0; k < 4; ++k) tc[k] = tn[k];
            asm volatile("" ::: "memory"); }
    }
    __device__ __forceinline__ void operator()(const f32x4 (&acc)[2][2][4][2], const Unit& u, int wr, int wc, int fr, int fq) const {
        const int pn = u.pn;
        if (pn == 0) {
#pragma unroll
            for (int ai = 0; ai < 2; ++ai)
#pragma unroll
                for (int m = 0; m < 4; ++m) { float sq = 0.f;
#pragma unroll
                    for (int bj = 0; bj < 2; ++bj)
#pragma unroll
                        for (int n = 0; n < 2; ++n) { const f32x4 v = acc[ai][bj][m][n]; sq += (v.x * v.x + v.y * v.y) + (v.z * v.z + v.w * v.w); }
                    sq += __shfl_xor(sq, 16); sq += __shfl_xor(sq, 32);
                    if (fq == 0) X[(ai * HALF + wr * 64 + m * 16 + fr) * 4 + wc] = sq; }
            asm volatile("s_waitcnt lgkmcnt(0)" ::: "memory"); __builtin_amdgcn_s_barrier(); asm volatile("" ::: "memory");
#pragma unroll
            for (int ai = 0; ai < 2; ++ai)
#pragma unroll
                for (int m = 0; m < 4; ++m) { const int rl = ai * HALF + wr * 64 + m * 16 + fr, tok = u.pm * BM + rl; const f32x4 p = *(const LAS f32x4*)(X + rl * 4);
                    const float rstd = rsqrtf(((p.x + p.y) + (p.z + p.w)) * (1.f / KVL) + EPS);
#pragma unroll
                    for (int bj = 0; bj < 2; ++bj)
#pragma unroll
                        for (int n = 0; n < 2; ++n) { const int col = bj * HALF + wc * 32 + n * 16 + 4 * fq; const f32x4 o = acc[ai][bj][m][n] * rstd * *(const f32x4*)(gckv + col);
                            int w8 = __builtin_amdgcn_cvt_pk_fp8_f32(o.x, o.y, 0, false); w8 = __builtin_amdgcn_cvt_pk_fp8_f32(o.z, o.w, w8, true);
                            *(int*)((unsigned char*)ckv + (size_t)tok * KVL + col) = w8; }
                    asm volatile("" ::: "memory"); }
            asm volatile("s_waitcnt lgkmcnt(0)" ::: "memory"); __builtin_amdgcn_s_barrier(); asm volatile("" ::: "memory");
        } else if (pn <= 2) {
#pragma unroll
            for (int ai = 0; ai < 2; ++ai)
#pragma unroll
                for (int m = 0; m < 4; ++m) { const int tok = u.pm * BM + ai * HALF + wr * 64 + m * 16 + fr; float sq = 0.f;
#pragma unroll
                    for (int bj = 0; bj < 2; ++bj) { if (pn == 2 && bj == 1) break;
#pragma unroll
                        for (int n = 0; n < 2; ++n) { const f32x4 v = acc[ai][bj][m][n]; sq += (v.x * v.x + v.y * v.y) + (v.z * v.z + v.w * v.w);
                            const int col = (pn - 1) * 256 + bj * HALF + wc * 32 + n * 16 + 4 * fq; u32x2 w; w.x = pk_h2(v.x, v.y); w.y = pk_h2(v.z, v.w); *(u32x2*)(cq + (size_t)tok * QL + col) = w; } }
                    sq += __shfl_xor(sq, 16); sq += __shfl_xor(sq, 32);
                    if (fq == 0) ssq[tok * 8 + (pn - 1) * 4 + wc] = sq;
                    if (pn == 2) {
                        if (wc < 2) { const int i = 4 * fq; const f32x4* tp = (const f32x4*)(tab + (size_t)tok * 48 + 32 + i); const f32x4 t0 = tp[0], t1 = tp[1];
                            const f32x4 cs = {t0.x, t0.z, t1.x, t1.z}, sn = {t0.y, t0.w, t1.y, t1.w}, x1 = acc[ai][1][m][0], x2 = acc[ai][1][m][1];
                            const f32x4 o1 = x1 * cs - x2 * sn, o2 = x2 * cs + x1 * sn;
                            if (wc == 0) { unsigned char* p8 = (unsigned char*)kr + (size_t)tok * 32 + i;
                                int a8 = __builtin_amdgcn_cvt_pk_fp8_f32(o1.x, o1.y, 0, false); a8 = __builtin_amdgcn_cvt_pk_fp8_f32(o1.z, o1.w, a8, true);
                                int b8 = __builtin_amdgcn_cvt_pk_fp8_f32(o2.x, o2.y, 0, false); b8 = __builtin_amdgcn_cvt_pk_fp8_f32(o2.z, o2.w, b8, true);
                                *(int*)p8 = a8; *(int*)(p8 + 16) = b8; }
                            else { h16* p = ki + (size_t)tok * 32 + i;
                                u32x2 w1, w2; w1.x = pk_h2(o1.x, o1.y); w1.y = pk_h2(o1.z, o1.w); w2.x = pk_h2(o2.x, o2.y); w2.y = pk_h2(o2.z, o2.w);
                                *(u32x2*)p = w1; *(u32x2*)(p + 16) = w2; } }
                        else if (wc == 2 && fq < 2) { *(f32x4*)(wi + tok * 8 + 4 * fq) = acc[ai][1][m][0] * 0.35355339059327373f; }
                    }
                    asm volatile("" ::: "memory"); }
        } else if (pn <= 5) rope64(acc, u, wr, wc, fr, fq, qb, pn - 3, 0.125f * LOG2E);
        else if (pn <= 8) rope64(acc, u, wr, wc, fr, fq, kb, pn - 6, 1.0f);
        else {
#pragma unroll
            for (int ai = 0; ai < 2; ++ai)
#pragma unroll
                for (int m = 0; m < 4; ++m) { const int tok = u.pm * BM + ai * HALF + wr * 64 + m * 16 + fr;
#pragma unroll
                    for (int bj = 0; bj < 2; ++bj)
#pragma unroll
                        for (int n = 0; n < 2; ++n) { const f32x4 v = acc[ai][bj][m][n]; u32x2 w; w.x = pk_h2(v.x, v.y); w.y = pk_h2(v.z, v.w);
                            *(u32x2*)(vT + (size_t)tok * 768 + (pn - 9) * 256 + bj * HALF + wc * 32 + n * 16 + 4 * fq) = w; }
                    asm volatile("" ::: "memory"); }
        }
    }
};
struct Epi4 {
    static constexpr bool PERM = true;
    h16 *qlat, *qr, *qi; const float* rstdq; const float2* tab;
    __device__ __forceinline__ void operator()(const f32x4 (&acc)[2][2][4][2], const Unit& u, int wr, int wc, int fr, int fq) const {
        const int pn = u.pn; const float c2 = 0.10206207261596575f * LOG2E;
        const int tok0 = u.pm * BM + wr * 64 + fr;
        float rc = rstdq[tok0], rn = 0.f;
        if (pn < 8) {
#pragma unroll
            for (int rr = 0; rr < 8; ++rr) { const int ai = rr >> 2, m = rr & 3, tok = tok0 + ai * HALF + m * 16;
                if (rr < 7) rn = rstdq[tok0 + ((rr + 1) >> 2) * HALF + ((rr + 1) & 3) * 16];
#pragma unroll
                for (int bj = 0; bj < 2; ++bj) { const f32x4 o0 = acc[ai][bj][m][0] * (rc * c2), o1 = acc[ai][bj][m][1] * (rc * c2);
                    u32x4 w; w.x = pk_h2(o0.x, o0.y); w.y = pk_h2(o0.z, o0.w); w.z = pk_h2(o1.x, o1.y); w.w = pk_h2(o1.z, o1.w);
                    *(u32x4*)(qlat + (size_t)tok * 2048 + pn * 256 + bj * HALF + wc * 32 + 8 * fq) = w; }
                rc = rn; asm volatile("" ::: "memory"); }
        } else { h16* dst = (pn == 8) ? qr : qi; const float c2e = (pn == 8) ? c2 : 1.f; const int i = 4 * fq;
            f32x4 tc[2], tn[2];
            { const f32x4* tp = (const f32x4*)(tab + (size_t)tok0 * 48 + 32 + i); tc[0] = tp[0]; tc[1] = tp[1]; }
#pragma unroll
            for (int rr = 0; rr < 8; ++rr) { const int ai = rr >> 2, m = rr & 3, tok = tok0 + ai * HALF + m * 16;
                if (rr < 7) { const int tokn = tok0 + ((rr + 1) >> 2) * HALF + ((rr + 1) & 3) * 16; const f32x4* tp = (const f32x4*)(tab + (size_t)tokn * 48 + 32 + i); tn[0] = tp[0]; tn[1] = tp[1]; rn = rstdq[tokn]; }
                const f32x4 cs = {tc[0].x, tc[0].z, tc[1].x, tc[1].z}, sn = {tc[0].y, tc[0].w, tc[1].y, tc[1].w}; const float sc = rc * c2e;
#pragma unroll
                for (int bj = 0; bj < 2; ++bj) { const f32x4 x1 = acc[ai][bj][m][0], x2 = acc[ai][bj][m][1]; const f32x4 o1 = (x1 * cs - x2 * sn) * sc, o2 = (x2 * cs + x1 * sn) * sc;
                    h16* p = dst + (size_t)tok * 256 + (4 * bj + wc) * 32 + i;
                    u32x2 w1, w2; w1.x = pk_h2(o1.x, o1.y); w1.y = pk_h2(o1.z, o1.w); w2.x = pk_h2(o2.x, o2.y); w2.y = pk_h2(o2.z, o2.w);
                    *(u32x2*)p = w1; *(u32x2*)(p + 16) = w2; }
                tc[0] = tn[0]; tc[1] = tn[1]; rc = rn;
                asm volatile("" ::: "memory"); } }
    }
};
__device__ __forceinline__ u32x4 ld16_l2(const h16* p) {
    const unsigned long long a = __hip_atomic_load((const unsigned long long*)p, __ATOMIC_RELAXED, __HIP_MEMORY_SCOPE_AGENT), b = __hip_atomic_load((const unsigned long long*)p + 1, __ATOMIC_RELAXED, __HIP_MEMORY_SCOPE_AGENT);
    return (u32x4){(unsigned)a, (unsigned)(a >> 32), (unsigned)b, (unsigned)(b >> 32)};
}
typedef _Float16 h16x8 __attribute__((ext_vector_type(8)));
__device__ __forceinline__ void unpk8(const u32x4 w, float (&f)[8]) {
    const h16x8 h = __builtin_bit_cast(h16x8, w);
#pragma unroll
    for (int i = 0; i < 8; ++i) f[i] = (float)h[i];
}
struct EpiH16 {
    static constexpr bool PERM = true;
    h16* O; int ldc = DM;
    __device__ __forceinline__ void operator()(const f32x4 (&acc)[2][2][4][2], const Unit& u, int wr, int wc, int fr, int fq) const {
        const int row0 = u.pm * BM + wr * 64 + fr, col0 = u.pn * BM + wc * 32 + 8 * fq;
#pragma unroll
        for (int ai = 0; ai < 2; ++ai)
#pragma unroll
            for (int m = 0; m < 4; ++m)
#pragma unroll
                for (int bj = 0; bj < 2; ++bj) { const f32x4 v0 = acc[ai][bj][m][0], v1 = acc[ai][bj][m][1];
                    u32x4 w; w.x = pk_h2(v0.x, v0.y); w.y = pk_h2(v0.z, v0.w); w.z = pk_h2(v1.x, v1.y); w.w = pk_h2(v1.z, v1.w);
                    *(u32x4*)(O + (size_t)(row0 + ai * HALF + m * 16) * ldc + col0 + bj * HALF) = w; }
    }
};
struct EpiGate {
    static constexpr bool PERM = true;
    const h16* Y; h16* Z; int accum;
    __device__ __forceinline__ void operator()(const f32x4 (&acc)[2][2][4][2], const Unit& u, int wr, int wc, int fr, int fq) const {
        const int row0 = u.pm * BM + wr * 64 + fr, col0 = u.pn * BM + wc * 32 + 8 * fq;
#pragma unroll
        for (int ai = 0; ai < 2; ++ai)
#pragma unroll
            for (int m = 0; m < 4; ++m)
#pragma unroll
                for (int bj = 0; bj < 2; ++bj) { const size_t off = (size_t)(row0 + ai * HALF + m * 16) * DM + col0 + bj * HALF;
                    float y[8], zz[8]; unpk8(ld16_l2(Y + off), y);
                    if (accum) unpk8(ld16_l2(Z + off), zz); else {
#pragma unroll
                        for (int i = 0; i < 8; ++i) zz[i] = 0.f; }
                    float o[8];
#pragma unroll
                    for (int n = 0; n < 2; ++n)
#pragma unroll
                        for (int e = 0; e < 4; ++e) { const float gg = acc[ai][bj][m][n][e]; o[n * 4 + e] = zz[n * 4 + e] + y[n * 4 + e] * __builtin_amdgcn_rcpf(1.f + __builtin_amdgcn_exp2f(-gg * LOG2E)); }
                    u32x4 w; w.x = pk_h2(o[0], o[1]); w.y = pk_h2(o[2], o[3]); w.z = pk_h2(o[4], o[5]); w.w = pk_h2(o[6], o[7]);
                    *(u32x4*)(Z + off) = w; }
    }
};
}

#define XB_TMO      128
#define XB_XCNT(j)  (256  + 64 * (j))
#define XB_XSUB(j)  (1280 + 64 * (j))
#define XB_XGEN(j)  (2304 + 64 * (j))
#define XB_TOP      3328
#define XB_TOPGEN   3392
#define XCD_BAR_WORDS 3456
#define XB_SPIN_CAP (1u << 18)
__device__ __forceinline__ unsigned xb_ld(unsigned* p)              { return __hip_atomic_load(p, __ATOMIC_RELAXED, __HIP_MEMORY_SCOPE_AGENT); }
__device__ __forceinline__ unsigned xb_add(unsigned* p, unsigned v) { return __hip_atomic_fetch_add(p, v, __ATOMIC_RELAXED, __HIP_MEMORY_SCOPE_AGENT); }
__device__ __forceinline__ unsigned xb_xcc_id() { return (unsigned)__builtin_amdgcn_s_getreg((3 << 11) | 20) & 0xFu; }
#define XB_SPIN(cond, bar) do { unsigned _sp = 0; while (cond) { __builtin_amdgcn_s_sleep(1); \
    if ((++_sp & 255u) == 0u) { if (xb_ld(&(bar)[XB_TMO])) break; if (_sp > XB_SPIN_CAP) { atomicAdd(&(bar)[XB_TMO], 1u); break; } } } } while (0)
struct XcdBarrier { unsigned* bar; unsigned x; volatile LAS unsigned* st; };
__device__ __forceinline__ XcdBarrier xcd_barrier_post(unsigned* bar, volatile LAS unsigned* st) {
    XcdBarrier b; b.bar = bar; b.x = xb_xcc_id(); b.st = st;
    if (threadIdx.x == 0) (void)xb_add(&bar[XB_XCNT(b.x)], 1u);
    return b;
}
__device__ __forceinline__ void xcd_barrier_complete(unsigned* bar, unsigned x, unsigned& nloc, unsigned& nx) {
    const unsigned G = gridDim.x * gridDim.y * gridDim.z;
    unsigned sum, cnt, mine, sp = 0u;
    for (;;) {
        sum = 0u; cnt = 0u; mine = 0u;
#pragma unroll
        for (unsigned j = 0; j < 16; ++j) { const unsigned c = xb_ld(&bar[XB_XCNT(j)]); sum += c; cnt += (c > 0u) ? 1u : 0u; mine = (j == x) ? c : mine; }
        if (sum == G) break;
        __builtin_amdgcn_s_sleep(1);
        if ((++sp & 255u) == 0u) { if (xb_ld(&bar[XB_TMO])) break; if (sp > XB_SPIN_CAP) { atomicAdd(&bar[XB_TMO], 1u); break; } }
    }
    nloc = mine > 0u ? mine : 1u; nx = cnt > 0u ? cnt : 1u;
}
__device__ __forceinline__ void xcd_barrier(const XcdBarrier& b) {
    asm volatile("s_waitcnt vmcnt(0)" ::: "memory");
    __syncthreads();
    if (threadIdx.x == 0) {
        unsigned* bar = b.bar;
        __builtin_amdgcn_s_waitcnt(0);
        unsigned nloc = b.st[0], nx = b.st[1];
        if (nloc == 0u) { xcd_barrier_complete(bar, b.x, nloc, nx); b.st[0] = nloc; b.st[1] = nx; }
        const unsigned old = xb_add(&bar[XB_XSUB(b.x)], 1u);
        const unsigned gen = old / nloc;
        if (old + 1u == (gen + 1u) * nloc) {
            __builtin_amdgcn_fence(__ATOMIC_RELEASE, "agent");
            asm volatile("s_waitcnt vmcnt(0)" ::: "memory");
            const unsigned og = xb_add(&bar[XB_TOP], 1u);
            const unsigned tg = og / nx;
            if (og + 1u == (tg + 1u) * nx) xb_add(&bar[XB_TOPGEN], 1u);
            else XB_SPIN(xb_ld(&bar[XB_TOPGEN]) == tg, bar);
            __builtin_amdgcn_fence(__ATOMIC_ACQUIRE, "agent");
            xb_add(&bar[XB_XGEN(b.x)], 1u);
            asm volatile("s_waitcnt vmcnt(0)" ::: "memory");
        } else {
            XB_SPIN(xb_ld(&bar[XB_XGEN(b.x)]) == gen, bar);
            __builtin_amdgcn_fence(__ATOMIC_ACQUIRE, "agent");
            asm volatile("s_waitcnt vmcnt(0)" ::: "memory");
        }
    }
    __syncthreads();
}

constexpr int NWAVES = 8, NTHR = 512;
constexpr int RING_BYTES = 131072, LDSCTL_OFF = RING_BYTES, MISC_OFF = LDSCTL_OFF + 320, LDS_BYTES = 147456;
constexpr int XCH_OFF = RING_BYTES + 1024;
constexpr int CW_BAR = 4096;
constexpr size_t OW_GU1 = OFF_W, OW_D1 = OW_GU1 + 11 * MiB, OW_IN = OW_D1 + (size_t)DM * FF * 2, OW_GATE = OW_IN + 6 * MiB, OW_4 = OW_GATE + 4 * MiB, OW_OV = OW_4 + 2 * MiB,
                 OW_UPB = OW_OV + 4 * MiB, OW_O = OW_UPB + MiB / 2, OW_GU2 = OW_O + 2 * MiB, OW_D2 = OW_GU2 + 11 * MiB, OW_END = OW_D2 + (size_t)DM * FF * 2;
static_assert(OW_END <= OFF_H, "weights region");
constexpr int NIN3 = 3072, N4 = 2560;
constexpr size_t OW_BD = OW_OV, OW_UPA = OW_OV + MiB, OFF_OA = OFF_A + 64 * MiB;

struct Args { const float* in[27]; float* out; unsigned char* ws; int ph_lo, ph_hi; };
struct Frame {
    LAS unsigned char* lds; int tid, lane, wave, G, gw, NGW;
};
__device__ __forceinline__ float wave_sum(float v) {
#pragma unroll
    for (int o = 1; o < 64; o <<= 1) v += __shfl_xor(v, o);
    return v;
}
__device__ __forceinline__ bool map_row(int job, int n, const Args& a, const float*& W, int& ldw, int& col) {
    if (job <= 1) { const int t = n >> 8, j = n & 255; W = a.in[(job == 0 ? 6 : 23) + (j >> 7)]; ldw = FF; col = t * 128 + (j & 127); return true; }
    if (job == 2) { W = a.in[11]; ldw = DIN; const int t = n >> 8, j = n & 255;
        if (t == 0) { col = C_CKV + j; return true; }
        if (t == 1) { col = j; return true; }
        if (t == 2) { if (j < 128) { col = 256 + j; return true; } if (j < 160) { col = C_KR + (j - 128); return true; } if (j < 192) { col = C_KI + (j - 160); return true; } if (j < 200) { col = C_WI + (j - 192); return true; } col = 0; return false; }
        if (t < 9) { const int c3 = (t - 3) / 3, tl = (t - 3) % 3, hl = (j & 127) >> 5, i = j & 31; col = C_QKV + c3 * 768 + (4 * tl + hl) * 64 + (j >> 7) * 32 + i; return true; }
        col = C_QKV + 1536 + (t - 9) * 256 + j; return true; }
    { const int n2 = n - 2048, r5 = n2 & 31, nat = 16 * ((r5 >> 2) & 1) + 4 * (r5 >> 3) + (r5 & 3);
      if (n2 < 256) { W = a.in[14]; ldw = 768; col = (n2 >> 5) * 96 + 64 + nat; } else { W = a.in[17]; ldw = 256; col = ((n2 - 256) & ~31) + nat; } return true; }
}
__device__ __forceinline__ void tr_item(const float* W, int ldw, int col, bool valid, const float* scale, int k0, h16* WTrow0, int K, LAS float* scr, int lane) {
    const int colc = valid ? col : 0; float vv[32];
#pragma unroll
    for (int i = 0; i < 32; ++i) vv[i] = W[(size_t)(k0 + 2 * i + (lane >> 5)) * ldw + colc];
    if (scale) {
#pragma unroll
        for (int i = 0; i < 32; ++i) vv[i] *= scale[k0 + 2 * i + (lane >> 5)]; }
#pragma unroll
    for (int i = 0; i < 32; ++i) scr[(2 * i + (lane >> 5)) * 33 + (lane & 31)] = valid ? vv[i] : 0.f;
    asm volatile("s_waitcnt lgkmcnt(0)" ::: "memory");
    const int c = lane & 7;
#pragma unroll
    for (int j = 0; j < 4; ++j) { const int n = (lane >> 3) + 8 * j; const LAS float* s = scr + (8 * c) * 33 + n;
        u32x4 o; o.x = pk_h2(s[0 * 33], s[1 * 33]); o.y = pk_h2(s[2 * 33], s[3 * 33]); o.z = pk_h2(s[4 * 33], s[5 * 33]); o.w = pk_h2(s[6 * 33], s[7 * 33]);
        *(u32x4*)(WTrow0 + (size_t)n * K + k0 + 8 * c) = o; }
    asm volatile("s_waitcnt lgkmcnt(0)" ::: "memory");
}
__device__ __forceinline__ void tr_job_mapped(const Frame& F, const Args& a, int job, int Ndest, int n_lo, int K, h16* WT, const float* scale, LAS float* scr, int phase_off) {
    const int nblk = Ndest / 32, nitems = (K / 64) * nblk;
    for (int it = (F.gw + phase_off) % F.NGW; it < nitems; it += F.NGW) {
        const int kb = it / nblk, nb = it % nblk; const float* W; int ldw, col;
        const bool valid = map_row(job, n_lo + nb * 32 + (F.lane & 31), a, W, ldw, col);
        tr_item(W, ldw, col, valid, scale, kb * 64, WT + (size_t)(n_lo + nb * 32) * K, K, scr, F.lane);
    }
}
__device__ __forceinline__ void tr_job_plain(const Frame& F, const float* W, int ldw, int Ndest, int K, h16* WT, LAS float* scr, int phase_off) {
    const int nblk = Ndest / 32, nitems = (K / 64) * nblk;
    for (int it = (F.gw + phase_off) % F.NGW; it < nitems; it += F.NGW) {
        const int kb = it / nblk, nb = it % nblk;
        tr_item(W, ldw, nb * 32 + (F.lane & 31), true, nullptr, kb * 64, WT + (size_t)(nb * 32) * K, K, scr, F.lane);
    }
}
__device__ __forceinline__ void row_load(const float* p, int lane, f32x4 (&v)[4]) {
#pragma unroll
    for (int j = 0; j < 4; ++j) v[j] = ((const f32x4*)p)[lane + 64 * j];
}
__device__ __forceinline__ float row_ssq(const f32x4 (&v)[4]) { float s = 0.f;
#pragma unroll
    for (int j = 0; j < 4; ++j) s += (v[j].x * v[j].x + v[j].y * v[j].y) + (v[j].z * v[j].z + v[j].w * v[j].w);
    return wave_sum(s); }
__device__ __forceinline__ void row_normmod_store(const f32x4 (&v)[4], float rstd, const float* g, const float* sc, const float* sh, h16* dst, int lane) {
#pragma unroll
    for (int j = 0; j < 4; ++j) { const int ci = lane + 64 * j; const f32x4 gg = ((const f32x4*)g)[ci], s1 = ((const f32x4*)sc)[ci], s0 = ((const f32x4*)sh)[ci];
        const f32x4 o = v[j] * rstd * gg * (s1 + 1.f) + s0;
        u32x2 w; w.x = pk_h2(o.x, o.y); w.y = pk_h2(o.z, o.w); ((u32x2*)dst)[ci] = w; }
}
__device__ __forceinline__ void ph_normmod(const Frame& F, const float* x, const float* g, const float* mod, int isc, int ish, h16* dst) {
    int m = F.gw; if (m >= MT) return;
    f32x4 v[4], vn[4]; row_load(x + (size_t)m * DM, F.lane, v);
    for (;;) { const int mn = m + F.NGW; const bool has = mn < MT; if (has) row_load(x + (size_t)mn * DM, F.lane, vn);
        const float rstd = rsqrtf(row_ssq(v) * (1.f / DM) + EPS); const float* mb = mod + (m / SEQ) * (NMOD * DM);
        row_normmod_store(v, rstd, g, mb + isc * DM, mb + ish * DM, dst + (size_t)m * DM, F.lane);
        if (!has) break;
#pragma unroll
        for (int j = 0; j < 4; ++j) v[j] = vn[j];
        m = mn; }
}
__device__ __forceinline__ void row_load_h(const h16* p, int lane, u32x2 (&v)[4]) {
#pragma unroll
    for (int j = 0; j < 4; ++j) v[j] = ((const u32x2*)p)[lane + 64 * j];
}
typedef _Float16 h16x4 __attribute__((ext_vector_type(4)));
__device__ __forceinline__ f32x4 h4_to_f4(u32x2 w) { const h16x4 h = __builtin_bit_cast(h16x4, w); return (f32x4){(float)h[0], (float)h[1], (float)h[2], (float)h[3]}; }
template <bool XI16, bool XO16>
__device__ __forceinline__ void ph_resnorm(const Frame& F, const void* xin_, const h16* f, const float* gpost, const float* mod, int igt, float coef, void* xout_,
                                           bool second, const float* gpre, int isc, int ish, h16* dst) {
    int m = F.gw; if (m >= MT) return;
    u32x2 fh[4], fn[4]; f32x4 xi[4], xn[4]; u32x2 xh[4], xhn[4];
    row_load_h(f + (size_t)m * DM, F.lane, fh);
    if constexpr (XI16) row_load_h((const h16*)xin_ + (size_t)m * DM, F.lane, xh); else row_load((const float*)xin_ + (size_t)m * DM, F.lane, xi);
    for (;;) {
        const int mn = m + F.NGW; const bool has = mn < MT;
        if (has) { row_load_h(f + (size_t)mn * DM, F.lane, fn);
            if constexpr (XI16) row_load_h((const h16*)xin_ + (size_t)mn * DM, F.lane, xhn); else row_load((const float*)xin_ + (size_t)mn * DM, F.lane, xn); }
        f32x4 v[4];
#pragma unroll
        for (int j = 0; j < 4; ++j) { v[j] = h4_to_f4(fh[j]); if constexpr (XI16) xi[j] = h4_to_f4(xh[j]); }
        const float rstd = rsqrtf(row_ssq(v) * (1.f / DM) + EPS) * coef; const float* mb = mod + (m / SEQ) * (NMOD * DM);
#pragma unroll
        for (int j = 0; j < 4; ++j) { const int ci = F.lane + 64 * j; const f32x4 gg = ((const f32x4*)gpost)[ci], gt = ((const f32x4*)(mb + igt * DM))[ci];
            xi[j] = xi[j] + gt * v[j] * rstd * gg;
            if constexpr (XO16) { u32x2 w; w.x = pk_h2(xi[j].x, xi[j].y); w.y = pk_h2(xi[j].z, xi[j].w); ((u32x2*)((h16*)xout_ + (size_t)m * DM))[ci] = w; }
            else ((f32x4*)((float*)xout_ + (size_t)m * DM))[ci] = xi[j]; }
        if (second) { const float r2 = rsqrtf(row_ssq(xi) * (1.f / DM) + EPS); row_normmod_store(xi, r2, gpre, mb + isc * DM, mb + ish * DM, dst + (size_t)m * DM, F.lane); }
        if (!has) break;
#pragma unroll
        for (int j = 0; j < 4; ++j) { fh[j] = fn[j]; if constexpr (XI16) xh[j] = xhn[j]; else xi[j] = xn[j]; }
        m = mn;
    }
}

__device__ __forceinline__ void ph_combine(const Frame& F, const h16* og, const float* lse2, h16* ob) {
    for (int idx = blockIdx.x * NTHR + F.tid; idx < MT * 256; idx += F.G * NTHR) {
        const int tok = idx >> 8, c = idx & 255, hh = c >> 6;
        const float l0 = lse2[tok * 12 + hh], l1 = lse2[tok * 12 + 4 + hh], l2 = lse2[tok * 12 + 8 + hh], m = fmaxf(l0, fmaxf(l1, l2));
        const float w0 = exp2f(l0 - m), w1 = exp2f(l1 - m), w2 = exp2f(l2 - m), inv = 1.f / (w0 + w1 + w2);
        ob[idx] = (h16)((w0 * (float)og[(size_t)tok * 768 + c] + w1 * (float)og[(size_t)tok * 768 + 256 + c] + w2 * (float)og[(size_t)tok * 768 + 512 + c]) * inv); }
}
typedef short v4i16_t __attribute__((ext_vector_type(4)));
typedef short s16x8 __attribute__((ext_vector_type(8)));
typedef float f32x16 __attribute__((ext_vector_type(16)));
__device__ __forceinline__ int tk_bin(float sc) { const unsigned u = __float_as_uint(sc); int e = (int)((u >> 16) & 0x7FFFu) - (122 << 7); e = e < 0 ? 0 : (e > 1023 ? 1023 : e); return (u >> 31) ? 1023 - e : 1024 + e; }
__device__ __forceinline__ void tk_scores(const f16x8 (&Af)[2], const float (&wv)[16], f16x8 b0, f16x8 b1, float& sa, float& sb) {
    f32x16 d = {0.f, 0.f, 0.f, 0.f, 0.f, 0.f, 0.f, 0.f, 0.f, 0.f, 0.f, 0.f, 0.f, 0.f, 0.f, 0.f};
    d = __builtin_amdgcn_mfma_f32_32x32x16_f16(Af[0], b0, d, 0, 0, 0); d = __builtin_amdgcn_mfma_f32_32x32x16_f16(Af[1], b1, d, 0, 0, 0);
    f32x2 acc = {0.f, 0.f};
#pragma unroll
    for (int e = 0; e < 16; e += 2) { const int i0 = __float_as_int(d[e]), i1 = __float_as_int(d[e + 1]);
        const f32x2 rl = {__int_as_float(i0 > 0 ? i0 : 0), __int_as_float(i1 > 0 ? i1 : 0)}; const f32x2 w2 = {wv[e], wv[e + 1]};
        acc = __builtin_elementwise_fma(w2, rl, acc); }
    sa = acc.x; sb = acc.y;
}
template <bool P2>
__device__ __forceinline__ void tk_tile(const f16x8 (&Af)[2], const float (&wv)[16], f16x8 b0, f16x8 b1, int tile, int r, int hi, int ta, LAS unsigned* hist, const int (&tbin)[4], int (&cs)[4], int (&cc)[4],
                                        unsigned short* sel, int tok0) {
    float sa, sb; tk_scores(Af, wv, b0, b1, sa, sb);
    const int s = 32 * tile + r;
    if constexpr (!P2) {
        if (s <= ta) { const int bn = tk_bin(sa); __hip_atomic_fetch_add(hist + (2 * hi) * 1024 + (bn >> 1), 1u << (16 * (bn & 1)), __ATOMIC_RELAXED, __HIP_MEMORY_SCOPE_WORKGROUP); }
        if (s <= ta + 1) { const int bn = tk_bin(sb); __hip_atomic_fetch_add(hist + (2 * hi + 1) * 1024 + (bn >> 1), 1u << (16 * (bn & 1)), __ATOMIC_RELAXED, __HIP_MEMORY_SCOPE_WORKGROUP); }
    } else {
        const unsigned lowmask = (1u << r) - 1u;
#pragma unroll
        for (int ab = 0; ab < 2; ++ab) { const float sc = ab ? sb : sa; const int tq = ta + ab; const int bn = tk_bin(sc);
            const int mytb = hi ? tbin[2 + ab] : tbin[ab];
            const bool valid = s <= tq, sure = valid && bn > mytb, cand = valid && bn == mytb;
            const unsigned long long ms = __ballot(sure), mc = __ballot(cand);
            const unsigned ms_h = hi ? (unsigned)(ms >> 32) : (unsigned)ms, mc_h = hi ? (unsigned)(mc >> 32) : (unsigned)mc;
            const int q = 2 * hi + ab;
            const int base_s = hi ? cs[2 + ab] : cs[ab], base_c = hi ? cc[2 + ab] : cc[ab];
            if (sure) sel[(size_t)(tok0 + q) * TOPK + base_s + __builtin_popcount(ms_h & lowmask)] = (unsigned short)s;
            if (cand) { const int pos = base_c + __builtin_popcount(mc_h & lowmask);
                if (pos < 512) ((LAS unsigned long long*)((LAS unsigned char*)hist + q * 4096))[pos] = ((unsigned long long)fkey(sc) << 16) | (unsigned long long)(0xFFFFu - (unsigned)s); }
            cs[ab] += __builtin_popcount((unsigned)ms); cs[2 + ab] += __builtin_popcount((unsigned)(ms >> 32));
            cc[ab] += __builtin_popcount((unsigned)mc); cc[2 + ab] += __builtin_popcount((unsigned)(mc >> 32)); }
    }
}
template <bool P2>
__device__ __forceinline__ void tk_pass(const f16x8 (&Af)[2], const float (&wv)[16], const h16* kbase, int ntiles, int r, int hi, int ta, LAS unsigned* hist, const int (&tbin)[4], int (&cs)[4], int (&cc)[4],
                                        unsigned short* sel, int tok0) {
    f16x8 BA[4][2], BB[4][2];
#define TK_LOAD(dst, t0_) do { _Pragma("unroll") for (int i_ = 0; i_ < 4; ++i_) { const int tt_ = ((t0_) + i_) < 127 ? ((t0_) + i_) : 127; dst[i_][0] = *(const f16x8*)(kbase + (size_t)tt_ * 1024); dst[i_][1] = *(const f16x8*)(kbase + (size_t)tt_ * 1024 + 16); } } while (0)
    TK_LOAD(BA, 0);
    for (int t0 = 0; t0 < ntiles; t0 += 8) {
        TK_LOAD(BB, t0 + 4);
#pragma unroll
        for (int i = 0; i < 4; ++i) if (t0 + i < ntiles) tk_tile<P2>(Af, wv, BA[i][0], BA[i][1], t0 + i, r, hi, ta, hist, tbin, cs, cc, sel, tok0);
        TK_LOAD(BA, t0 + 8);
#pragma unroll
        for (int i = 0; i < 4; ++i) if (t0 + 4 + i < ntiles) tk_tile<P2>(Af, wv, BB[i][0], BB[i][1], t0 + 4 + i, r, hi, ta, hist, tbin, cs, cc, sel, tok0);
    }
#undef TK_LOAD
}
__device__ __forceinline__ void tk_group(const Frame& F, const h16* qi, const h16* ki, const float* wi, unsigned short* sel, int b, int t0, LAS unsigned* hist) {
    int lane_ = F.lane; asm volatile("" : "+v"(lane_)); const int lane = lane_, r = lane & 31, hi = lane >> 5, tok0 = b * SEQ + t0;
    const int qa = 2 * ((r >> 2) & 1) + (r & 1), ha = 4 * (r >> 4) + 2 * ((r >> 3) & 1) + ((r >> 1) & 1);
    f16x8 Af[2];
#pragma unroll
    for (int s_ = 0; s_ < 2; ++s_) Af[s_] = *(const f16x8*)(qi + (size_t)(tok0 + qa) * 256 + ha * 32 + 16 * s_ + 8 * hi);
    float wv[16];
    { const f32x4 a0 = *(const f32x4*)(wi + (tok0 + 2 * hi) * 8), a1 = *(const f32x4*)(wi + (tok0 + 2 * hi) * 8 + 4), b0 = *(const f32x4*)(wi + (tok0 + 2 * hi + 1) * 8), b1 = *(const f32x4*)(wi + (tok0 + 2 * hi + 1) * 8 + 4);
      const float sa[8] = {a0.x, a0.y, a0.z, a0.w, a1.x, a1.y, a1.z, a1.w}, sb[8] = {b0.x, b0.y, b0.z, b0.w, b1.x, b1.y, b1.z, b1.w};
#pragma unroll
      for (int h = 0; h < 8; ++h) { wv[2 * h] = sa[h] * 0.17677669529663687f; wv[2 * h + 1] = sb[h] * 0.17677669529663687f; } }
    const int ntiles = (t0 + 3) / 32 + 1, ta = t0 + 2 * hi;
    const h16* kbase = ki + (size_t)(b * SEQ + r) * 32 + 8 * hi;
    int tbin[4] = {0, 0, 0, 0}, nsure[4], cs[4] = {0, 0, 0, 0}, cc[4] = {0, 0, 0, 0};
#pragma unroll
    for (int i = 0; i < 16; ++i) *(LAS u32x4*)((LAS unsigned char*)hist + i * 1024 + lane * 16) = (u32x4){0u, 0u, 0u, 0u};
    asm volatile("s_waitcnt lgkmcnt(0)" ::: "memory");
    tk_pass<false>(Af, wv, kbase, ntiles, r, hi, ta, hist, tbin, cs, cc, sel, tok0);
    asm volatile("s_waitcnt lgkmcnt(0)" ::: "memory");
#pragma unroll
    for (int q = 0; q < 4; ++q) {
        const LAS unsigned* hq = hist + q * 1024;
        unsigned sum = 0;
#pragma unroll
        for (int i = 0; i < 4; ++i) { const u32x4 v = *(const LAS u32x4*)(hq + 16 * lane + 4 * i); sum += (v.x & 0xFFFFu) + (v.x >> 16) + (v.y & 0xFFFFu) + (v.y >> 16) + (v.z & 0xFFFFu) + (v.z >> 16) + (v.w & 0xFFFFu) + (v.w >> 16); }
        unsigned incl = sum;
#pragma unroll
        for (int o = 1; o < 64; o <<= 1) { const unsigned v = __shfl_down(incl, o); if (lane + o < 64) incl += v; }
        const unsigned long long bal = __ballot(incl >= (unsigned)TOPK);
        const int L = 63 - __builtin_clzll(bal);
        unsigned cum = __shfl(incl, L) - __shfl(sum, L);
        int tbq = 32 * L, found = 0;
        for (int wd = 15; wd >= 0 && !found; --wd) { const unsigned v = hq[16 * L + wd];
            const unsigned chi = v >> 16, clo = v & 0xFFFFu;
            if (cum + chi >= (unsigned)TOPK) { tbq = 32 * L + 2 * wd + 1; found = 1; } else { cum += chi;
                if (cum + clo >= (unsigned)TOPK) { tbq = 32 * L + 2 * wd; found = 1; } else cum += clo; } }
        tbin[q] = tbq; nsure[q] = (int)cum;
    }
    asm volatile("s_waitcnt lgkmcnt(0)" ::: "memory");
    tk_pass<true>(Af, wv, kbase, ntiles, r, hi, ta, hist, tbin, cs, cc, sel, tok0);
    asm volatile("s_waitcnt lgkmcnt(0)" ::: "memory");
#pragma unroll
    for (int q = 0; q < 4; ++q) {
        const int nc = cc[q] < 512 ? cc[q] : 512, need = TOPK - cs[q];
        const LAS unsigned long long* cq = (const LAS unsigned long long*)((const LAS unsigned char*)hist + q * 4096);
        if (nc > 64) {
            unsigned long long it[8];
#pragma unroll
            for (int k = 0; k < 8; ++k) it[k] = (k * 64 + lane < nc) ? cq[k * 64 + lane] : 0ull;
            unsigned long long T = 0ull;
            for (int bit = 47; bit >= 0; --bit) { const unsigned long long cand = T | (1ull << bit); int cnt = 0;
#pragma unroll
                for (int k = 0; k < 8; ++k) cnt += __builtin_popcountll(__ballot(it[k] >= cand));
                if (cnt >= need) T = cand; }
            int basep = cs[q];
#pragma unroll
            for (int k = 0; k < 8; ++k) { const bool pick = (T != 0ull) && it[k] >= T; const unsigned long long mk = __ballot(pick);
                if (pick) sel[(size_t)(tok0 + q) * TOPK + basep + __builtin_popcountll(mk & ((1ull << lane) - 1ull))] = (unsigned short)(0xFFFFu - (unsigned)(it[k] & 0xFFFFull));
                basep += __builtin_popcountll(mk); }
        } else
        for (int base = 0; base < nc; base += 64) {
            const bool act = base + lane < nc; const unsigned long long my = act ? cq[base + lane] : 0ull; int rank = 0;
            for (int jb = 0; jb < nc; jb += 64) {
                const unsigned long long cj = (jb + lane < nc) ? cq[jb + lane] : 0ull; const unsigned clo = (unsigned)cj, chi = (unsigned)(cj >> 32);
                const int n = (nc - jb) < 64 ? (nc - jb) : 64;
                for (int j = 0; j < n; ++j) { const unsigned long long sj = ((unsigned long long)(unsigned)__builtin_amdgcn_readlane((int)chi, j) << 32) | (unsigned)__builtin_amdgcn_readlane((int)clo, j); rank += (sj > my) ? 1 : 0; } }
            if (act && rank < need) sel[(size_t)(tok0 + q) * TOPK + cs[q] + rank] = (unsigned short)(0xFFFFu - (unsigned)(my & 0xFFFFull)); }
    }
    (void)nsure;
    asm volatile("s_waitcnt lgkmcnt(0)" ::: "memory");
}
__device__ __forceinline__ void ph_topk_sparse(const Frame& F, const h16* qi, const h16* ki, const float* wi, unsigned short* sel, h16* qlat, const h16* qr, const unsigned char* ckv8, const unsigned char* kr8);
__device__ __forceinline__ void ph_topk_mfma(const Frame& F, const h16* qi, const h16* ki, const float* wi, unsigned short* sel) {
    LAS unsigned* hist = (LAS unsigned*)(F.lds + F.wave * 16384);
    for (int g = F.gw; g < 4 * 64; g += F.NGW) { const int b = g >> 6, t0 = (g & 63) * 4;
        for (int i = F.lane; i < 4 * TOPK; i += 64) { const int q = i >> 8, k = i & 255; sel[(size_t)(b * SEQ + t0 + q) * TOPK + k] = (unsigned short)(k <= t0 + q ? k : 0); } }
    for (int p = F.gw; p < 4 * 480; p += F.NGW) { const int b = p & 3, pj = p >> 2;
        tk_group(F, qi, ki, wi, sel, b, 4 * (64 + pj), hist);
        tk_group(F, qi, ki, wi, sel, b, 4 * (1023 - pj), hist);
    }
}


__device__ __forceinline__ void ph_dilated_mfma(const Frame& F, const h16* qb, const h16* kb, const h16* vb, h16* og, float* lse2) {
    const int lane = F.lane, ql = lane & 31, hi = lane >> 5;
    LAS unsigned char* VL = F.lds + F.wave * 16384;
    LAS float* linv = (LAS float*)(VL + 12288);
    constexpr int VROW = 192;
    const int trq = (lane & 15) >> 2, trp = lane & 3, trg = (lane >> 4) & 1;
    for (int u = F.gw; u < NB * 12 * 128; u += F.NGW) {
        const int b = u / 1536, rem = u % 1536, gh = rem >> 7, g = gh >> 2, wi_ = rem & 127, dil = dil_of(g), sh = g == 0 ? 0 : (g == 1 ? 2 : 4);
        const int nblk = 128 >> sh, res = wi_ / nblk, j0 = 32 * (wi_ % nblk);
        const size_t hoff = (size_t)b * SEQ * 768 + gh * 64;
        f16x8 Qf[4];
        { const h16* qp = qb + hoff + (size_t)((j0 + ql) * dil + res) * 768 + 8 * hi;
#pragma unroll
          for (int s_ = 0; s_ < 4; ++s_) Qf[s_] = *(const f16x8*)(qp + 16 * s_); }
        f32x16 S[5];
        f16x8 Kf[5][4];
#pragma unroll
        for (int kt = 0; kt < 5; ++kt) { int jk = j0 - 128 + 32 * kt + ql; jk = jk < 0 ? 0 : jk;
            const h16* kp = kb + hoff + (size_t)(jk * dil + res) * 768 + 8 * hi;
#pragma unroll
            for (int s_ = 0; s_ < 4; ++s_) Kf[kt][s_] = *(const f16x8*)(kp + 16 * s_); }
#pragma unroll
        for (int kt = 0; kt < 5; ++kt) {
            f32x16 d = {0.f, 0.f, 0.f, 0.f, 0.f, 0.f, 0.f, 0.f, 0.f, 0.f, 0.f, 0.f, 0.f, 0.f, 0.f, 0.f};
#pragma unroll
            for (int s_ = 0; s_ < 4; ++s_) d = __builtin_amdgcn_mfma_f32_32x32x16_f16(Kf[kt][s_], Qf[s_], d, 0, 0, 0);
            S[kt] = d; }
        f16x8 Vr[5][4];
#pragma unroll
        for (int kt = 0; kt < 5; ++kt) { int jk = j0 - 128 + 32 * kt + (lane >> 1); jk = jk < 0 ? 0 : jk;
            const h16* vp = vb + hoff + (size_t)(jk * dil + res) * 768 + (lane & 1) * 32;
#pragma unroll
            for (int i = 0; i < 4; ++i) Vr[kt][i] = *(const f16x8*)(vp + 8 * i); }
        float m = -INFINITY;
#pragma unroll
        for (int kt = 0; kt < 5; ++kt)
#pragma unroll
            for (int e = 0; e < 16; ++e) { const int kl = (e & 3) + 8 * (e >> 2) + 4 * hi; bool ok = (j0 - 128 + 32 * kt + kl) >= 0;
                if (kt == 0) ok = ok && (kl >= ql); if (kt == 4) ok = ok && (kl <= ql);
                if (!ok) S[kt][e] = -INFINITY; m = fmaxf(m, S[kt][e]); }
        m = fmaxf(m, __shfl_xor(m, 32));
        float l = 0.f;
#pragma unroll
        for (int kt = 0; kt < 5; ++kt)
#pragma unroll
            for (int e = 0; e < 16; ++e) { const float p = __builtin_amdgcn_exp2f(S[kt][e] - m); S[kt][e] = p; l += p; }
        l += __shfl_xor(l, 32);
        if (hi == 0) { linv[ql] = __builtin_amdgcn_rcpf(l); lse2[(size_t)(b * SEQ + (j0 + ql) * dil + res) * 12 + gh] = m + __builtin_amdgcn_logf(l); }
        f32x16 O[2];
#pragma unroll
        for (int dt = 0; dt < 2; ++dt) O[dt] = (f32x16){0.f, 0.f, 0.f, 0.f, 0.f, 0.f, 0.f, 0.f, 0.f, 0.f, 0.f, 0.f, 0.f, 0.f, 0.f, 0.f};
#pragma unroll
        for (int kt = 0; kt < 5; ++kt) {
            LAS unsigned char* vbuf = VL + (kt & 1) * 6144;
#pragma unroll
            for (int i = 0; i < 4; ++i) *(LAS f16x8*)(vbuf + (lane >> 1) * VROW + (lane & 1) * 64 + i * 16) = Vr[kt][i];
            asm volatile("s_waitcnt lgkmcnt(0)" ::: "memory");
#pragma unroll
            for (int s2 = 0; s2 < 2; ++s2) {
                u32x4 pa; pa.x = pk_h2(S[kt][8 * s2 + 0], S[kt][8 * s2 + 1]); pa.y = pk_h2(S[kt][8 * s2 + 2], S[kt][8 * s2 + 3]); pa.z = pk_h2(S[kt][8 * s2 + 4], S[kt][8 * s2 + 5]); pa.w = pk_h2(S[kt][8 * s2 + 6], S[kt][8 * s2 + 7]);
#pragma unroll
                for (int dt = 0; dt < 2; ++dt) {
                    const v4i16_t lo = __builtin_amdgcn_ds_read_tr16_b64_v4i16((LAS v4i16_t*)(vbuf + (16 * s2 + 4 * hi + trq) * VROW + (32 * dt + 16 * trg + 4 * trp) * 2));
                    const v4i16_t hh = __builtin_amdgcn_ds_read_tr16_b64_v4i16((LAS v4i16_t*)(vbuf + (16 * s2 + 8 + 4 * hi + trq) * VROW + (32 * dt + 16 * trg + 4 * trp) * 2));
                    const s16x8 bv = {lo[0], lo[1], lo[2], lo[3], hh[0], hh[1], hh[2], hh[3]};
                    O[dt] = __builtin_amdgcn_mfma_f32_32x32x16_f16(__builtin_bit_cast(f16x8, pa), __builtin_bit_cast(f16x8, bv), O[dt], 0, 0, 0); } }
            asm volatile("s_waitcnt lgkmcnt(0)" ::: "memory");
        }
#pragma unroll
        for (int e = 0; e < 16; ++e) { const int q = (e & 3) + 8 * (e >> 2) + 4 * hi; const float il = linv[q];
            h16* op = og + (size_t)(b * SEQ + (j0 + q) * dil + res) * 768 + gh * 64 + ql;
            op[0] = (h16)(O[0][e] * il); op[32] = (h16)(O[1][e] * il); }
        asm volatile("s_waitcnt lgkmcnt(0)" ::: "memory");
    }
}


__device__ __forceinline__ f16x8 fp8x8_to_f16(unsigned w0, unsigned w1) {
    const h16x2 a = __builtin_amdgcn_cvt_scalef32_pk_f16_fp8((int)w0, 1.0f, false), b = __builtin_amdgcn_cvt_scalef32_pk_f16_fp8((int)w0, 1.0f, true),
                c = __builtin_amdgcn_cvt_scalef32_pk_f16_fp8((int)w1, 1.0f, false), d = __builtin_amdgcn_cvt_scalef32_pk_f16_fp8((int)w1, 1.0f, true);
    const u32x4 r = {__builtin_bit_cast(unsigned, a), __builtin_bit_cast(unsigned, b), __builtin_bit_cast(unsigned, c), __builtin_bit_cast(unsigned, d)};
    return __builtin_bit_cast(f16x8, r);
}
template <bool FUSED>
__device__ __forceinline__ void ph_sparse_wave(const Frame& F, h16* qlat, const h16* qr, const unsigned char* ckv8, const unsigned char* kr8, const unsigned short* sel, int ta = 0, int tb = 0) {
    int lane = F.lane; asm volatile("" : "+v"(lane));
    LAS unsigned char* V = F.lds + F.wave * 16384;
    const int qp = (lane & 15) >> 2, pp = lane & 3;
    const int k0 = 4 * (lane >> 4) + qp;
    const int tr0 = k0 * 512 + (pp >> 1) * 16 + (pp & 1) * 8, x0 = k0 & 7;
    const int vw = (lane & 15) * 512, swz = lane & 7;
    const int lane0 = lane;
    const int nit = FUSED ? 8 : (MT - F.gw + F.NGW - 1) / F.NGW;
    for (int it = 0; it < nit; ++it) {
        const int tok = FUSED ? ((it < 4 ? ta : tb - 4) + it) : F.gw + it * F.NGW;
        int ll = lane0; asm volatile("" : "+v"(ll));
        const int c = ll & 15, kq = ll >> 4, hd = c & 7;
        const int b = tok / SEQ, t = tok % SEQ, cnt = (t + 1 < TOPK) ? t + 1 : TOPK, nch = (cnt + 31) >> 5;
        LAS unsigned short* sp = (LAS unsigned short*)(F.lds + XCH_OFF + F.wave * 512) + c;
        *(LAS u32x2*)(F.lds + XCH_OFF + F.wave * 512 + 8 * ll) = *(const u32x2*)(sel + (size_t)tok * TOPK + 4 * ll);
        asm volatile("s_waitcnt lgkmcnt(0)" ::: "memory");
        f16x8 Qf[9]; u32x4 Kr[2][4]; u32x2 Rr[2];
#pragma unroll
        for (int s_ = 0; s_ < 8; ++s_) Qf[s_] = *(const f16x8*)(qlat + (size_t)tok * 2048 + hd * 256 + 64 * (s_ >> 1) + 16 * kq + 8 * (s_ & 1));
        Qf[8] = *(const f16x8*)(qr + (size_t)tok * 256 + hd * 32 + 8 * kq);
        int rowi[2];
#define SW_LOADK() do { _Pragma("unroll") for (int tl = 0; tl < 2; ++tl) { _Pragma("unroll") for (int q4 = 0; q4 < 4; ++q4) Kr[tl][q4] = *(const u32x4*)(ckv8 + (size_t)rowi[tl] * 256 + 64 * q4 + 16 * kq); \
        Rr[tl] = *(const u32x2*)(kr8 + (size_t)rowi[tl] * 32 + 8 * kq); } } while (0)
        rowi[0] = b * SEQ + (int)sp[0]; rowi[1] = b * SEQ + (int)sp[16];
        SW_LOADK();
        float m = -INFINITY, l = 0.f;
        f32x4 O[16];
#pragma unroll
        for (int ft = 0; ft < 16; ++ft) O[ft] = (f32x4){0.f, 0.f, 0.f, 0.f};
        for (int ch = 0; ch < nch; ++ch) {
            const bool more = ch + 1 < nch;
            int rown0 = 0, rown1 = 0; if (more) { rown0 = (int)sp[32 * (ch + 1)]; rown1 = (int)sp[32 * (ch + 1) + 16]; }
            f16x8 Kf[2][9];
#pragma unroll
            for (int tl = 0; tl < 2; ++tl) {
#pragma unroll
                for (int q4 = 0; q4 < 4; ++q4) { Kf[tl][2 * q4] = fp8x8_to_f16(Kr[tl][q4].x, Kr[tl][q4].y); Kf[tl][2 * q4 + 1] = fp8x8_to_f16(Kr[tl][q4].z, Kr[tl][q4].w); }
                Kf[tl][8] = fp8x8_to_f16(Rr[tl].x, Rr[tl].y); }
            if (more) { rowi[0] = b * SEQ + rown0; rowi[1] = b * SEQ + rown1; SW_LOADK(); }
            f32x4 S[2];
#pragma unroll
            for (int tl = 0; tl < 2; ++tl) { S[tl] = (f32x4){0.f, 0.f, 0.f, 0.f};
#pragma unroll
                for (int s_ = 0; s_ < 9; ++s_) S[tl] = __builtin_amdgcn_mfma_f32_16x16x32_f16(Kf[tl][s_], Qf[s_], S[tl], 0, 0, 0); }
            float cm = -INFINITY;
#pragma unroll
            for (int tl = 0; tl < 2; ++tl)
#pragma unroll
                for (int e = 0; e < 4; ++e) { if (32 * ch + 16 * tl + 4 * kq + e >= cnt) S[tl][e] = -INFINITY; cm = fmaxf(cm, S[tl][e]); }
            cm = fmaxf(cm, __shfl_xor(cm, 16)); cm = fmaxf(cm, __shfl_xor(cm, 32));
            if (__any(cm > m + 8.0f)) { const float mn = fmaxf(m, cm), alpha = __builtin_amdgcn_exp2f(m - mn); m = mn; l *= alpha;
#pragma unroll
                for (int ft = 0; ft < 16; ++ft) O[ft] = O[ft] * alpha; }
            float pe[2][4]; float ps = 0.f;
#pragma unroll
            for (int tl = 0; tl < 2; ++tl)
#pragma unroll
                for (int e = 0; e < 4; ++e) { pe[tl][e] = __builtin_amdgcn_exp2f(S[tl][e] - m); ps += pe[tl][e]; }
            l += ps;
#pragma unroll
            for (int tl = 0; tl < 2; ++tl)
#pragma unroll
                for (int s_ = 0; s_ < 8; ++s_) *(LAS f16x8*)(V + vw + tl * 8192 + (((4 * (s_ >> 1) + kq) ^ swz) << 5) + (s_ & 1) * 16) = Kf[tl][s_];
            asm volatile("s_waitcnt lgkmcnt(0)" ::: "memory");
            u32x4 pk; pk.x = pk_h2(pe[0][0], pe[0][1]); pk.y = pk_h2(pe[0][2], pe[0][3]); pk.z = pk_h2(pe[1][0], pe[1][1]); pk.w = pk_h2(pe[1][2], pe[1][3]);
            const f16x8 Pf = __builtin_bit_cast(f16x8, pk);
#pragma unroll
            for (int ft = 0; ft < 16; ++ft) {
                const v4i16_t lo = __builtin_amdgcn_ds_read_tr16_b64_v4i16((LAS v4i16_t*)(V + tr0 + (((ft & 7) ^ x0) << 5) + (ft >> 3) * 256));
                const v4i16_t hi = __builtin_amdgcn_ds_read_tr16_b64_v4i16((LAS v4i16_t*)(V + tr0 + (((ft & 7) ^ x0) << 5) + (ft >> 3) * 256 + 8192));
                const s16x8 av = {lo[0], lo[1], lo[2], lo[3], hi[0], hi[1], hi[2], hi[3]};
                O[ft] = __builtin_amdgcn_mfma_f32_16x16x32_f16(__builtin_bit_cast(f16x8, av), Pf, O[ft], 0, 0, 0); }
            asm volatile("s_waitcnt lgkmcnt(0)" ::: "memory");
        }
        l += __shfl_xor(l, 16); l += __shfl_xor(l, 32);
        if (c < 8) { const float il = __builtin_amdgcn_rcpf(l);
#pragma unroll
            for (int ft = 0; ft < 16; ++ft) { const f32x4 o = O[ft] * il; u32x2 pk; pk.x = pk_h2(o.x, o.y); pk.y = pk_h2(o.z, o.w);
                *(u32x2*)(qlat + (size_t)tok * 2048 + c * 256 + 16 * ft + 4 * kq) = pk; } }
#undef SW_LOADK
    }
}


__device__ __forceinline__ void precomb_tiles(const Frame& F, const Args& args, unsigned char* ws, int t_lo, int t_hi, int wg, int nwg) {
    LAS float* As = (LAS float*)(F.lds); LAS float* Bs = (LAS float*)(F.lds + 64 * 65 * 4);
    for (int tl = t_lo + wg; tl < t_hi; tl += nwg) {
        __syncthreads();
        const bool ql = tl < 192; int hd, rb, xb;
        if (ql) { hd = tl / 24; rb = (tl % 24) / 6; xb = tl % 6; } else { const int t2 = tl - 192; hd = t2 / 64; rb = (t2 % 64) / 16; xb = t2 % 16; }
#pragma unroll
        for (int k = 0; k < 2; ++k) { const int i4 = F.tid + NTHR * k, row = i4 >> 4, c4 = (i4 & 15) * 4;
            if (ql) { const f32x4 a = *(const f32x4*)(args.in[15] + (size_t)(rb * 64 + row) * 512 + hd * 64 + c4), bq = *(const f32x4*)(args.in[14] + (size_t)(xb * 64 + row) * 768 + hd * 96 + c4);
#pragma unroll
                for (int e = 0; e < 4; ++e) { As[row * 65 + c4 + e] = a[e]; Bs[row * 65 + c4 + e] = bq[e]; } }
            else { const f32x4 a = *(const f32x4*)(args.in[18] + (size_t)(hd * 64 + row) * DM + xb * 64 + c4), bq = *(const f32x4*)(args.in[16] + (size_t)(rb * 64 + row) * 512 + hd * 64 + c4);
#pragma unroll
                for (int e = 0; e < 4; ++e) { As[(c4 + e) * 65 + row] = a[e]; Bs[row * 65 + c4 + e] = bq[e]; } } }
        __syncthreads();
        const int j = F.tid & 63, ig = F.wave;
        float acc8[8];
#pragma unroll
        for (int ii = 0; ii < 8; ++ii) acc8[ii] = 0.f;
#pragma unroll 4
        for (int v = 0; v < 64; ++v) { const float bv = Bs[j * 65 + v];
#pragma unroll
            for (int ii = 0; ii < 8; ++ii) acc8[ii] += As[(ig * 8 + ii) * 65 + v] * bv; }
        if (ql) { const float gj = args.in[12][xb * 64 + j]; h16* o = (h16*)(ws + OW_4);
#pragma unroll
            for (int ii = 0; ii < 8; ++ii) o[(size_t)(hd * 256 + rb * 64 + ig * 8 + ii) * QL + xb * 64 + j] = (h16)(acc8[ii] * gj); }
        else { h16* o = (h16*)(ws + OW_OV);
#pragma unroll
            for (int ii = 0; ii < 8; ++ii) o[(size_t)(xb * 64 + ig * 8 + ii) * 2048 + hd * 256 + rb * 64 + j] = (h16)acc8[ii]; }
    }
    __syncthreads();
}


__device__ __forceinline__ void ph_topk_sparse(const Frame& F, const h16* qi, const h16* ki, const float* wi, unsigned short* sel, h16* qlat, const h16* qr, const unsigned char* ckv8, const unsigned char* kr8) {
    LAS unsigned* hist = (LAS unsigned*)(F.lds + F.wave * 16384);
    for (int p = F.gw; p < 2048; p += F.NGW) {
        int ta, tb;
        if (p < 4 * 448) { const int b = p & 3, pj = p >> 2; ta = b * SEQ + 4 * (64 + pj); tb = b * SEQ + 4 * (959 - pj);
            tk_group(F, qi, ki, wi, sel, b, 4 * (64 + pj), hist);
            tk_group(F, qi, ki, wi, sel, b, 4 * (959 - pj), hist); }
        else { const int q_ = p - 4 * 448, b = q_ & 3, i_ = q_ >> 2, t0 = 4 * i_;
            tk_group(F, qi, ki, wi, sel, b, 4 * (960 + i_), hist);
            int l0 = F.lane; asm volatile("" : "+v"(l0));
            for (int i = l0; i < 4 * TOPK; i += 64) { const int q = i >> 8, k = i & 255; sel[(size_t)(b * SEQ + t0 + q) * TOPK + k] = (unsigned short)(k <= t0 + q ? k : 0); }
            ta = b * SEQ + 4 * (960 + i_); tb = b * SEQ + t0; }
        asm volatile("s_waitcnt vmcnt(0) lgkmcnt(0)" ::: "memory");
        ph_sparse_wave<true>(F, qlat, qr, ckv8, kr8, sel, ta, tb);
        asm volatile("s_waitcnt lgkmcnt(0)" ::: "memory");
    }
}

__global__ void __launch_bounds__(NTHR, 2) mega_fwd(Args args) {
    extern __shared__ __attribute__((aligned(16))) unsigned char lds_raw[];
    Frame F; F.lds = (LAS unsigned char*)lds_raw; F.tid = threadIdx.x; F.lane = F.tid & 63; F.wave = __builtin_amdgcn_readfirstlane(F.tid >> 6);
    F.G = gridDim.x; F.gw = blockIdx.x * NWAVES + F.wave; F.NGW = F.G * NWAVES;
    volatile LAS unsigned* MISC = (volatile LAS unsigned*)(F.lds + MISC_OFF);
    unsigned char* ws = args.ws;
    for (int u = F.tid; u < (LDS_BYTES - LDSCTL_OFF) / 4; u += NTHR) ((LAS unsigned*)(F.lds + LDSCTL_OFF))[u] = 0u;
    __syncthreads();
    XcdBarrier bar = xcd_barrier_post((unsigned*)(ws + OFF_CTL) + CW_BAR, MISC + 8);
    const int lo = args.ph_lo, hi = args.ph_hi;
#define IN(k) (lo <= (k) && (k) < hi)
#define SEAM(k) do { if (IN(k) && IN((k) + 1)) xcd_barrier(bar); } while (0)
    float* mod = (float*)(ws + OFF_MOD); float2* tab = (float2*)(ws + OFF_ROPE);
    h16* Hb = (h16*)(ws + OFF_H); h16* Ab = (h16*)(ws + OFF_A); float* Fb = (float*)(ws + OFF_F);

    if (IN(0)) {
        LAS float* scr = (LAS float*)(F.lds + F.wave * 16384);
        for (int ch = blockIdx.x; ch < (NMOD * DM) / 36; ch += F.G) {
            LAS float* sl = (LAS float*)(F.lds);
            LAS float* part = (LAS float*)(F.lds + 16384);
            __syncthreads();
            for (int i = F.tid; i < 4 * DM; i += NTHR) sl[i] = silu_f(args.in[1][i]);
            __syncthreads();
            const int ln = F.lane < 36 ? F.lane : 35;
            const float* wm = args.in[3] + (size_t)(F.wave * 128) * (NMOD * DM) + ch * 36 + ln;
            float a0 = 0.f, a1 = 0.f, a2 = 0.f, a3 = 0.f;
#pragma unroll 16
            for (int k = 0; k < 128; ++k) { const float w = wm[(size_t)k * (NMOD * DM)]; const int kk = F.wave * 128 + k; a0 += sl[kk] * w; a1 += sl[DM + kk] * w; a2 += sl[2 * DM + kk] * w; a3 += sl[3 * DM + kk] * w; }
            part[(F.wave * 4 + 0) * 64 + F.lane] = a0; part[(F.wave * 4 + 1) * 64 + F.lane] = a1; part[(F.wave * 4 + 2) * 64 + F.lane] = a2; part[(F.wave * 4 + 3) * 64 + F.lane] = a3;
            __syncthreads();
            if (F.tid < 256 && (F.tid & 63) < 36) { const int b = F.tid >> 6, l = F.tid & 63; float sm = args.in[4][ch * 36 + l];
#pragma unroll
                for (int w = 0; w < 8; ++w) sm += part[(w * 4 + b) * 64 + l];
                mod[b * (NMOD * DM) + ch * 36 + l] = sm; }
            __syncthreads();
        }
        for (int idx = blockIdx.x * NTHR + F.tid; idx < MT * 48; idx += F.G * NTHR) { const int tok = idx / 48, i = idx % 48;
            const float inv = (i < 32) ? powf(10000.f, -(float)i / 32.f) : powf(10000.f, -(float)(i - 32) / 16.f);
            const float ang = (float)((const int*)args.in[2])[tok] * inv; tab[idx] = make_float2(cosf(ang), sinf(ang)); }
        tr_job_mapped(F, args, 0, 2 * FF, 0, DM, (h16*)(ws + OW_GU1), nullptr, scr, 0);
        if (F.G != 256) {
            tr_job_plain(F, args.in[8], DM, DM, FF, (h16*)(ws + OW_D1), scr, 768);
            tr_job_mapped(F, args, 2, NIN3, 0, DM, (h16*)(ws + OW_IN), nullptr, scr, 128);
            tr_job_plain(F, args.in[11] + C_GATE, DIN, 2048, DM, (h16*)(ws + OW_GATE), scr, 1664);
            tr_job_mapped(F, args, 3, 512, 2048, QL, (h16*)(ws + OW_4), args.in[12], scr, 640);
            tr_job_plain(F, args.in[19], DM, DM, 256, (h16*)(ws + OW_UPB), scr, 736);
            tr_job_plain(F, args.in[20], DM, DM, DM, (h16*)(ws + OW_O), scr, 864);
            tr_job_mapped(F, args, 1, 2 * FF, 0, DM, (h16*)(ws + OW_GU2), nullptr, scr, 1376);
            tr_job_plain(F, args.in[25], DM, DM, FF, (h16*)(ws + OW_D2), scr, 96);
            precomb_tiles(F, args, ws, 0, 192, (int)blockIdx.x, F.G);
            tr_job_plain(F, args.in[18], DM, DM, 512, (h16*)(ws + OW_UPA), scr, 256);
        }
    }
    SEAM(0);
    if (IN(1)) ph_normmod(F, args.in[0], args.in[5], mod, 1, 0, Hb);
    SEAM(1);
    if (IN(2)) { pg8::Gemm g{Hb, (const h16*)(ws + OW_GU1), MT, 2 * FF, DM}; pg8::StaticOrder S; S.init(MT, 2 * FF, F.G, (int)blockIdx.x); pg8::EpiSwiGLU E{Ab};
        pg8::gemm_phase<pg8::EpiSwiGLU, true>(F.lds, g, S, E);
        if (F.G == 256 && blockIdx.x >= 128) {
            Frame F2 = F; F2.gw = ((int)blockIdx.x - 128) * NWAVES + F.wave; F2.NGW = 128 * NWAVES; LAS float* scr = (LAS float*)(F.lds + F.wave * 16384);
            tr_job_plain(F2, args.in[8], DM, DM, FF, (h16*)(ws + OW_D1), scr, 0);
            tr_job_mapped(F2, args, 2, NIN3, 0, DM, (h16*)(ws + OW_IN), nullptr, scr, 384);
            tr_job_mapped(F2, args, 3, 512, 2048, QL, (h16*)(ws + OW_4), args.in[12], scr, 896);
            tr_job_mapped(F2, args, 1, 2 * FF, 0, DM, (h16*)(ws + OW_GU2), nullptr, scr, 640);
            precomb_tiles(F, args, ws, 0, 192, (int)blockIdx.x - 128, 128);
            for (int i = ((int)blockIdx.x - 128) * NTHR + F.tid; i < (int)(MiB / 16); i += 128 * NTHR) ((u32x4*)(ws + OW_BD))[i] = (u32x4){0u, 0u, 0u, 0u}; } }
    SEAM(2);
    if (IN(3)) { pg8::Gemm g{Ab, (const h16*)(ws + OW_D1), MT, DM, FF}; pg8::StaticOrder S; S.init(MT, DM, F.G, (int)blockIdx.x); pg8::EpiH16 E{(h16*)Fb};
        pg8::gemm_phase<pg8::EpiH16, false>(F.lds, g, S, E); }
    SEAM(3);
    if (IN(4)) ph_resnorm<false, true>(F, args.in[0], (const h16*)Fb, args.in[9], mod, 2, 0.5f, args.out, true, args.in[10], 4, 3, Hb);
    SEAM(4);
    if (IN(5)) { pg8::Gemm g{Hb, (const h16*)(ws + OW_IN), MT, NIN3, DM}; pg8::StaticOrder S; S.init(MT, NIN3, F.G, (int)blockIdx.x);
        pg8::EpiIn E{(h16*)(ws + OFF_CKV), (h16*)(ws + OFF_CQ), (h16*)(ws + OFF_KR), (h16*)(ws + OFF_KI), (h16*)(ws + OFF_QB), (h16*)(ws + OFF_KB), (h16*)(ws + OFF_VT), (float*)(ws + OFF_WI), (float*)(ws + OFF_SSQ),
                     args.in[13], tab, (LAS float*)(F.lds + XCH_OFF)};
        pg8::gemm_phase<pg8::EpiIn, true>(F.lds, g, S, E); }
    SEAM(5);
    if (IN(6)) { for (int tk_ = blockIdx.x * NTHR + F.tid; tk_ < MT; tk_ += F.G * NTHR) { const f32x4 s0 = *(const f32x4*)((const float*)(ws + OFF_SSQ) + tk_ * 8), s1 = *(const f32x4*)((const float*)(ws + OFF_SSQ) + tk_ * 8 + 4);
            ((float*)(ws + OFF_RSTDQ))[tk_] = rsqrtf((((s0.x + s0.y) + (s0.z + s0.w)) + ((s1.x + s1.y) + (s1.z + s1.w))) * (1.f / QL) + EPS); } }
    if (IN(6)) ph_dilated_mfma(F, (const h16*)(ws + OFF_QB), (const h16*)(ws + OFF_KB), (const h16*)(ws + OFF_VT), (h16*)(ws + OFF_OG), (float*)(ws + OFF_LSE));
    SEAM(6);
    if (IN(7)) { pg8::Gemm g{(const h16*)(ws + OFF_CQ), (const h16*)(ws + OW_4), MT, N4, QL}; pg8::StaticOrder S; S.init(MT, N4, F.G, (int)blockIdx.x);
        pg8::Epi4 E{(h16*)(ws + OFF_QLAT), (h16*)(ws + OFF_QR), (h16*)(ws + OFF_QI), (const float*)(ws + OFF_RSTDQ), tab};
        pg8::gemm_phase<pg8::Epi4, true>(F.lds, g, S, E);
        if (F.G == 256 && blockIdx.x >= 128) {
            Frame F2 = F; F2.gw = ((int)blockIdx.x - 128) * NWAVES + F.wave; F2.NGW = 128 * NWAVES; LAS float* scr = (LAS float*)(F.lds + F.wave * 16384);
            tr_job_plain(F2, args.in[11] + C_GATE, DIN, 2048, DM, (h16*)(ws + OW_GATE), scr, 0);
            tr_job_plain(F2, args.in[19], DM, DM, 256, (h16*)(ws + OW_UPB), scr, 512);
            tr_job_plain(F2, args.in[20], DM, DM, DM, (h16*)(ws + OW_O), scr, 640);
            tr_job_plain(F2, args.in[18], DM, DM, 512, (h16*)(ws + OW_UPA), scr, 256);
            for (int it = F2.gw; it < 4 * 16; it += F2.NGW) { const int kb = it >> 4, nb = it & 15, n0 = nb * 32, hl = (n0 >> 6) & 3;
                tr_item(args.in[16], 512, n0 + (F.lane & 31), true, nullptr, kb * 64, (h16*)(ws + OW_BD) + (size_t)n0 * 1024 + 256 * hl, 1024, scr, F.lane); } } }
    SEAM(7);
    if (IN(8)) { ph_combine(F, (const h16*)(ws + OFF_OG), (const float*)(ws + OFF_LSE), (h16*)(ws + OFF_OB));
        ph_topk_sparse(F, (const h16*)(ws + OFF_QI), (const h16*)(ws + OFF_KI), (const float*)(ws + OFF_WI), (unsigned short*)(ws + OFF_SEL),
                       (h16*)(ws + OFF_QLAT), (const h16*)(ws + OFF_QR), (const unsigned char*)(ws + OFF_CKV), (const unsigned char*)(ws + OFF_KR)); }
    SEAM(8);
    if (IN(9) && F.G == 256) { const bool first = blockIdx.x < 128;
        pg8::Gemm g{first ? (const h16*)(ws + OFF_QLAT) : (const h16*)(ws + OFF_OB), first ? (const h16*)(ws + OW_BD) : (const h16*)(ws + OW_UPB), MT, first ? 512 : DM, first ? 1024 : 256, first ? 2048 : 0, first ? 1024 : 0};
        pg8::StaticOrder S; S.init(MT, first ? 512 : DM, 128, first ? (int)blockIdx.x : (int)blockIdx.x - 128);
        pg8::EpiH16 E{first ? (h16*)(ws + OFF_OA) : (h16*)(ws + OFF_Y2), first ? 512 : DM};
        pg8::gemm_phase<pg8::EpiH16, false>(F.lds, g, S, E); }
    SEAM(9);
    SEAM(9);
    if (IN(10)) { pg8::StaticOrder S; S.init(MT, DM, F.G, (int)blockIdx.x); h16* Y1 = (h16*)(ws + OFF_Y1); h16* Y2 = (h16*)(ws + OFF_Y2);
        { pg8::Gemm g{(const h16*)(ws + OFF_OA), (const h16*)(ws + OW_UPA), MT, DM, 512}; pg8::EpiH16 E{Y1}; pg8::gemm_phase<pg8::EpiH16, false>(F.lds, g, S, E); }
        { pg8::Gemm g{Hb, (const h16*)(ws + OW_GATE), MT, DM, DM}; pg8::EpiGate E{Y1, Y1, 0}; pg8::gemm_phase<pg8::EpiGate, false>(F.lds, g, S, E); }
        { pg8::Gemm g{Hb, (const h16*)(ws + OW_GATE) + (size_t)DM * DM, MT, DM, DM}; pg8::EpiGate E{Y2, Y1, 1}; pg8::gemm_phase<pg8::EpiGate, false>(F.lds, g, S, E); } }
    SEAM(10);
    if (IN(11)) { pg8::Gemm g{(const h16*)(ws + OFF_Y1), (const h16*)(ws + OW_O), MT, DM, DM}; pg8::StaticOrder S; S.init(MT, DM, F.G, (int)blockIdx.x); pg8::EpiH16 E{(h16*)(ws + OFF_YF)};
        pg8::gemm_phase<pg8::EpiH16, false>(F.lds, g, S, E); }
    SEAM(11);
    if (IN(12)) ph_resnorm<true, true>(F, args.out, (const h16*)(ws + OFF_YF), args.in[21], mod, 5, 1.0f, ws + OFF_F, true, args.in[22], 7, 6, Hb);
    SEAM(12);
    if (IN(13)) { pg8::Gemm g{Hb, (const h16*)(ws + OW_GU2), MT, 2 * FF, DM}; pg8::StaticOrder S; S.init(MT, 2 * FF, F.G, (int)blockIdx.x); pg8::EpiSwiGLU E{Ab};
        pg8::gemm_phase<pg8::EpiSwiGLU, true>(F.lds, g, S, E);
        if (F.G == 256 && blockIdx.x >= 128) { Frame F2 = F; F2.gw = ((int)blockIdx.x - 128) * NWAVES + F.wave; F2.NGW = 128 * NWAVES;
            tr_job_plain(F2, args.in[25], DM, DM, FF, (h16*)(ws + OW_D2), (LAS float*)(F.lds + F.wave * 16384), 0); } }
    SEAM(13);
    if (IN(14)) { pg8::Gemm g{Ab, (const h16*)(ws + OW_D2), MT, DM, FF}; pg8::StaticOrder S; S.init(MT, DM, F.G, (int)blockIdx.x); pg8::EpiH16 E{(h16*)(ws + OFF_F + 32 * MiB)};
        pg8::gemm_phase<pg8::EpiH16, false>(F.lds, g, S, E); }
    SEAM(14);
    if (IN(15)) ph_resnorm<true, false>(F, ws + OFF_F, (const h16*)(ws + OFF_F + 32 * MiB), args.in[26], mod, 8, 0.5f, args.out, false, nullptr, 0, 0, nullptr);
#undef IN
#undef SEAM
}


extern "C" void kernel_launch(void* const* d_in, const int* in_sizes, int n_in, void* d_out, int out_size, void* d_ws, size_t ws_size, hipStream_t stream) {
    if (n_in != 27 || ws_size < WS_END || out_size != MT * DM) { fprintf(stderr, "kernel_launch: unexpected shapes (n_in %d ws %zu out %d)\n", n_in, ws_size, out_size); return; }
    static int grid = 0;
    if (grid == 0) {
        int dev = 0, cus = 0, per_cu = 0;
        if (hipGetDevice(&dev) != hipSuccess || hipDeviceGetAttribute(&cus, hipDeviceAttributeMultiprocessorCount, dev) != hipSuccess) { grid = -1; return; }
        if (hipFuncSetAttribute((const void*)mega_fwd, hipFuncAttributeMaxDynamicSharedMemorySize, LDS_BYTES) != hipSuccess) { fprintf(stderr, "kernel_launch: hipFuncSetAttribute failed\n"); grid = -1; return; }
        if (hipOccupancyMaxActiveBlocksPerMultiprocessor(&per_cu, (const void*)mega_fwd, NTHR, LDS_BYTES) != hipSuccess || per_cu < 1) { fprintf(stderr, "kernel_launch: occupancy query says %d blocks/CU\n", per_cu); grid = -1; return; }
        grid = cus;
    }
    if (grid < 0) return;
    hipMemsetAsync((char*)d_ws + OFF_CTL, 0, 1 * MiB, stream);
    Args a{}; for (int i = 0; i < 27; ++i) a.in[i] = (const float*)d_in[i]; a.out = (float*)d_out; a.ws = (unsigned char*)d_ws; a.ph_lo = 0; a.ph_hi = 16;
    void* kargs[] = {&a};
#ifdef PH_DOUBLE
    a.ph_hi = PH_DOUBLE + 1; (void)hipLaunchCooperativeKernel((const void*)mega_fwd, dim3(grid), dim3(NTHR), kargs, LDS_BYTES, stream);
    hipMemsetAsync((char*)d_ws + OFF_CTL, 0, 1 * MiB, stream); a.ph_lo = PH_DOUBLE; a.ph_hi = 16;
#endif
    const hipError_t e = hipLaunchCooperativeKernel((const void*)mega_fwd, dim3(grid), dim3(NTHR), kargs, LDS_BYTES, stream);
    if (e != hipSuccess) fprintf(stderr, "kernel_launch: cooperative launch failed: %s (grid %d)\n", hipGetErrorString(e), grid);
    (void)in_sizes;
}
```

```cpp
#include <hip/hip_runtime.h>
#include <hip/hip_fp16.h>
#include <cstdio>
#include <cstdint>

constexpr int NB = 4, SEQ = 4096, DM = 1024, MT = NB * SEQ, FF = 2816;
constexpr int QL = 384, KVL = 256, DNOPE = 64, DROPE = 32, DVA = 64, HA = 8, HI = 8, DI = 32, TOPK = 256;
constexpr int NG = 3, HB = 4, DHB = 64, NMOD = 9, DIN = 5064;
constexpr int C_CQ = 0, C_CKV = 384, C_KR = 640, C_KI = 672, C_WI = 704, C_QKV = 712, C_GATE = 3016;
constexpr float EPS = 1e-6f, LOG2E = 1.4426950408889634f;
typedef _Float16 h16;

constexpr size_t MiB = 1u << 20;
constexpr size_t OFF_CTL = 0, OFF_MOD = 1 * MiB, OFF_ROPE = 2 * MiB, OFF_W = 8 * MiB, OFF_H = 60 * MiB, OFF_A = 92 * MiB, OFF_F = 180 * MiB, OFF_SP = 244 * MiB, WS_END = 256 * MiB;
constexpr size_t OFF_QB = OFF_A, OFF_KB = OFF_A + 24 * MiB, OFF_VT = OFF_A + 48 * MiB, OFF_CKV = OFF_A + 72 * MiB, OFF_KR = OFF_A + 80 * MiB, OFF_KI = OFF_A + 81 * MiB,
                 OFF_WI = OFF_A + 82 * MiB, OFF_SSQ = OFF_A + 82 * MiB + 512 * 1024, OFF_CQ = OFF_SP;
constexpr size_t OFF_RSTDQ = OFF_A + 83 * MiB;
constexpr size_t OFF_OG = OFF_F, OFF_LSE = OFF_F + 24 * MiB, OFF_QLAT = OFF_A, OFF_QR = OFF_A + 64 * MiB, OFF_QI = OFF_F + 25 * MiB, OFF_SEL = OFF_F + 33 * MiB, OFF_OB = OFF_SP;
constexpr size_t OFF_Y1 = OFF_F, OFF_Y2 = OFF_F + 32 * MiB, OFF_YF = OFF_A;

__device__ __forceinline__ float silu_f(float v) { return v / (1.f + __expf(-v)); }
__device__ __forceinline__ float sigm_f(float v) { return 1.f / (1.f + __expf(-v)); }
__host__ __device__ __forceinline__ int dil_of(int g) { return g == 0 ? 1 : (g == 1 ? 4 : 16); }
__device__ __forceinline__ unsigned fkey(float f) { const unsigned u = __float_as_uint(f); return (u & 0x80000000u) ? ~u : (u | 0x80000000u); }


#define LAS __attribute__((address_space(3)))
#define GAS __attribute__((address_space(1)))
typedef _Float16 f16x8 __attribute__((ext_vector_type(8)));
typedef float f32x4 __attribute__((ext_vector_type(4)));
typedef float f32x2 __attribute__((ext_vector_type(2)));
typedef unsigned u32x4 __attribute__((ext_vector_type(4)));
typedef unsigned u32x2 __attribute__((ext_vector_type(2)));
typedef _Float16 h16x2 __attribute__((ext_vector_type(2)));
__device__ __forceinline__ unsigned pk_h2(float lo, float hi) { f32x2 v = {lo, hi}; h16x2 h = __builtin_convertvector(v, h16x2); return __builtin_bit_cast(unsigned, h); }

namespace pg8 {
constexpr int BM = 256, BK = 64, HALF = 128, HTB = HALF * BK * 2, STAGE_BYTES = 8 * HTB, NXCD = 8, WGM = 8;
__host__ __device__ __forceinline__ int lds_byte(int r, int c) { const int st = (r >> 4) * 2 + (c >> 5), rr = r & 15, cc = c & 31, ob = rr * 64 + cc * 2; return st * 1024 + (ob ^ (((ob >> 9) & 1) << 5)); }
__host__ __device__ __forceinline__ void stage_rc(int b, int& R, int& C) { const int st = b / 1024, sb = b % 1024, swz = sb ^ (((sb >> 9) & 1) << 5); R = (st >> 1) * 16 + swz / 64; C = (st & 1) * 32 + (swz % 64) / 2; }
__host__ __device__ __forceinline__ int perm32(int rho) { const int n = rho >> 4, i = rho & 15; return 8 * (i >> 2) + 4 * n + (i & 3); }
struct Unit { int pm, pn; };
struct Gemm { const h16* A; const h16* Bt; int M, N, K; int lda = 0, koffA = 0; };
struct StaticOrder {
    int nM, nN, nwg, G, c;
    __host__ __device__ void init(int M, int N, int G_, int c_) { nM = M / BM; nN = N / BM; nwg = nM * nN; G = G_; c = c_; }
    __host__ __device__ bool next(int i, Unit& u) const {
        const long L = (long)i * G + c; if (L >= nwg) return false;
        int wgid = (int)L; { const int q = nwg / NXCD, r = nwg % NXCD, xcd = wgid % NXCD, off = wgid / NXCD; wgid = (xcd < r ? xcd * (q + 1) : r * (q + 1) + (xcd - r) * q) + off; }
        const int nig = WGM * nN, gid = wgid / nig, fm = gid * WGM, gsz = (nM - fm) < WGM ? (nM - fm) : WGM;
        u.pm = fm + ((wgid % nig) % gsz); u.pn = (wgid % nig) / gsz; return true;
    }
};
template <class Epi, bool ALIGN_EPI>
__device__ __forceinline__ void gemm_phase(LAS unsigned char* lds, const Gemm g, const StaticOrder& S, const Epi& E) {
    const int tid = threadIdx.x, wid = __builtin_amdgcn_readfirstlane(tid >> 6), lane = tid & 63, wr = wid >> 2, wc = wid & 3, fr = lane & 15, fq = lane >> 4;
    const int K = g.K, nt = K / BK, lda = g.lda ? g.lda : g.K;
    unsigned voffA[2], voffB[2];
#pragma unroll
    for (int i = 0; i < 2; ++i) { int R, C; stage_rc(tid * 16 + i * 8192, R, C); const int Rb = Epi::PERM ? ((R & ~31) + perm32(R & 31)) : R;
        voffA[i] = (unsigned)(R * lda + C) * 2u; voffB[i] = (unsigned)(Rb * K + C) * 2u; }
    const size_t kstep = (size_t)(BK * 2);
    const size_t hstep = (size_t)HALF * K * 2, hstepA = (size_t)HALF * lda * 2;
    const size_t tstep = 2 * hstep, tstepA = 2 * hstepA, kofA = (size_t)g.koffA * 2;
    const unsigned ldsw = (unsigned)wid * 1024u;
    const int aoff = lds_byte(wr * 64 + fr, fq * 8), boff = lds_byte(wc * 32 + fr, fq * 8);
#define PG8_SA(b, h) (((b) * 2 + (h)) * HTB)
#define PG8_SB(b, h) ((4 + (b) * 2 + (h)) * HTB)
#define PG8_STAGE(bufoff, gbase, voff) do { _Pragma("unroll") for (int _i = 0; _i < 2; ++_i) \
        __builtin_amdgcn_global_load_lds((const unsigned*)((const char*)(gbase) + (voff)[_i]), (LAS unsigned*)(lds + (bufoff) + ldsw + _i * 8192), 16, 0, 0); } while (0)
#define PG8_LDA(dst, b, h) do { _Pragma("unroll") for (int m = 0; m < 4; ++m) _Pragma("unroll") for (int k = 0; k < 2; ++k) dst[m][k] = *(const LAS f16x8*)(lds + PG8_SA(b, h) + aoff + m * 2048 + k * 1024); } while (0)
#define PG8_LDB(dst, b, h) do { _Pragma("unroll") for (int n = 0; n < 2; ++n) _Pragma("unroll") for (int k = 0; k < 2; ++k) dst[n][k] = *(const LAS f16x8*)(lds + PG8_SB(b, h) + boff + n * 2048 + k * 1024); } while (0)
#define PG8_MMA(ai, bj, At, Bt) do { __builtin_amdgcn_s_setprio(1); _Pragma("unroll") for (int m = 0; m < 4; ++m) _Pragma("unroll") for (int n = 0; n < 2; ++n) _Pragma("unroll") for (int k = 0; k < 2; ++k) \
        acc[ai][bj][m][n] = __builtin_amdgcn_mfma_f32_16x16x32_f16(Bt[n][k], At[m][k], acc[ai][bj][m][n], 0, 0, 0); __builtin_amdgcn_s_setprio(0); } while (0)
#define PG8_WAIT_V(n) asm volatile("s_waitcnt vmcnt(" #n ")" ::: "memory")
#define PG8_WAIT_L(n) asm volatile("s_waitcnt lgkmcnt(" #n ")" ::: "memory")
#define PG8_BAR __builtin_amdgcn_s_barrier()
#define PG8_SCHED __builtin_amdgcn_sched_barrier(0)
    Unit cur, nxt; int ui = 0;
    if (!S.next(0, cur)) return;
    f32x4 acc[2][2][4][2];
#pragma unroll
    for (int a = 0; a < 2; ++a)
#pragma unroll
        for (int b = 0; b < 2; ++b)
#pragma unroll
            for (int m = 0; m < 4; ++m)
#pragma unroll
                for (int n = 0; n < 2; ++n) acc[a][b][m][n] = (f32x4){0.f, 0.f, 0.f, 0.f};
    f16x8 At[4][2], B0[2][2], B1[2][2];
    const char* cA = (const char*)g.A + (size_t)cur.pm * tstepA + (size_t)cur.pn * kofA; const char* cB = (const char*)g.Bt + (size_t)cur.pn * tstep;
    PG8_STAGE(PG8_SB(0, 0), cB, voffB); PG8_STAGE(PG8_SB(0, 1), cB + hstep, voffB); PG8_STAGE(PG8_SA(0, 0), cA, voffA); PG8_STAGE(PG8_SA(0, 1), cA + hstepA, voffA);
    if (wr == 1) PG8_BAR;
    PG8_WAIT_V(2); PG8_BAR;
    PG8_STAGE(PG8_SB(1, 0), cB + kstep, voffB); PG8_STAGE(PG8_SA(1, 0), cA + kstep, voffA); PG8_STAGE(PG8_SB(1, 1), cB + hstep + kstep, voffB);
    PG8_WAIT_V(6); PG8_BAR;
    for (;;) {
        const bool has_next = S.next(ui + 1, nxt);
        const char* nA = has_next ? (const char*)g.A + (size_t)nxt.pm * tstepA + (size_t)nxt.pn * kofA : cA; const char* nB = has_next ? (const char*)g.Bt + (size_t)nxt.pn * tstep : cB;
        for (int t = 0; t < nt; t += 2) {
            const bool last = (t == nt - 2);
            const char* a1 = cA + (size_t)(t + 1) * kstep;
            const char* a2 = last ? nA : cA + (size_t)(t + 2) * kstep; const char* b2 = last ? nB : cB + (size_t)(t + 2) * kstep;
            const char* a3 = a2 + kstep; const char* b3 = b2 + kstep;
            PG8_LDB(B0, 0, 0); PG8_LDB(B1, 0, 1); PG8_SCHED; PG8_LDA(At, 0, 0); PG8_STAGE(PG8_SA(1, 1), a1 + hstepA, voffA);
            PG8_WAIT_V(8); PG8_WAIT_L(0); PG8_BAR; PG8_MMA(0, 0, At, B0); PG8_MMA(0, 1, At, B1); PG8_BAR; PG8_SCHED;
            PG8_LDA(At, 0, 1); PG8_STAGE(PG8_SB(0, 0), b2, voffB); PG8_STAGE(PG8_SB(0, 1), b2 + hstep, voffB); PG8_STAGE(PG8_SA(0, 0), a2, voffA);
            PG8_WAIT_V(8); PG8_WAIT_L(0); PG8_BAR; PG8_MMA(1, 0, At, B0); PG8_MMA(1, 1, At, B1); PG8_BAR; PG8_SCHED;
            PG8_LDB(B0, 1, 0); PG8_LDB(B1, 1, 1); PG8_SCHED; PG8_LDA(At, 1, 0); PG8_STAGE(PG8_SA(0, 1), a2 + hstepA, voffA);
            PG8_WAIT_V(8); PG8_WAIT_L(0); PG8_BAR; PG8_MMA(0, 0, At, B0); PG8_MMA(0, 1, At, B1); PG8_BAR; PG8_SCHED;
            PG8_LDA(At, 1, 1); PG8_STAGE(PG8_SB(1, 0), b3, voffB); PG8_STAGE(PG8_SB(1, 1), b3 + hstep, voffB); PG8_STAGE(PG8_SA(1, 0), a3, voffA);
            PG8_WAIT_V(8); PG8_WAIT_L(0); PG8_BAR; PG8_MMA(1, 0, At, B0); PG8_MMA(1, 1, At, B1); PG8_BAR; PG8_SCHED;
        }
        if constexpr (ALIGN_EPI) { if (wr == 0) PG8_BAR; }
        { int l2 = lane; asm volatile("" : "+v"(l2)); E(acc, cur, wr, wc, l2 & 15, l2 >> 4); }
        if (!has_next) break;
#pragma unroll
        for (int a = 0; a < 2; ++a)
#pragma unroll
            for (int b = 0; b < 2; ++b)
#pragma unroll
                for (int m = 0; m < 4; ++m)
#pragma unroll
                    for (int n = 0; n < 2; ++n) acc[a][b][m][n] = (f32x4){0.f, 0.f, 0.f, 0.f};
        cur = nxt; cA = nA; cB = nB; ++ui;
        if constexpr (ALIGN_EPI) { if (wr == 1) PG8_BAR; }
    }
    PG8_WAIT_V(0);
    if constexpr (!ALIGN_EPI) { if (wr == 0) PG8_BAR; }
    PG8_BAR;
#undef PG8_SA
#undef PG8_SB
#undef PG8_STAGE
#undef PG8_LDA
#undef PG8_LDB
#undef PG8_MMA
#undef PG8_WAIT_V
#undef PG8_WAIT_L
#undef PG8_BAR
#undef PG8_SCHED
}
struct EpiF32 {
    static constexpr bool PERM = false;
    float* C; int ldc;
    __device__ __forceinline__ void operator()(const f32x4 (&acc)[2][2][4][2], const Unit& u, int wr, int wc, int fr, int fq) const {
        const int row0 = u.pm * BM + wr * 64 + fr, col0 = u.pn * BM + wc * 32 + 4 * fq;
#pragma unroll
        for (int ai = 0; ai < 2; ++ai)
#pragma unroll
            for (int m = 0; m < 4; ++m) { float* rowp = C + (size_t)(row0 + ai * HALF + m * 16) * ldc + col0;
#pragma unroll
                for (int bj = 0; bj < 2; ++bj)
#pragma unroll
                    for (int n = 0; n < 2; ++n) *(f32x4*)(rowp + bj * HALF + n * 16) = acc[ai][bj][m][n]; }
    }
};
struct EpiSwiGLU {
    static constexpr bool PERM = true;
    h16* O;
    __device__ __forceinline__ void operator()(const f32x4 (&acc)[2][2][4][2], const Unit& u, int wr, int wc, int fr, int fq) const {
        const int row0 = u.pm * BM + wr * 64 + fr, col0 = u.pn * HALF + wc * 32 + 8 * fq;
#pragma unroll
        for (int ai = 0; ai < 2; ++ai)
#pragma unroll
            for (int m = 0; m < 4; ++m) { h16* rowp = O + (size_t)(row0 + ai * HALF + m * 16) * FF + col0;
                float v[8];
#pragma unroll
                for (int n = 0; n < 2; ++n)
#pragma unroll
                    for (int e = 0; e < 4; ++e) { const float gg = acc[ai][0][m][n][e], uu = acc[ai][1][m][n][e]; v[n * 4 + e] = gg * __builtin_amdgcn_rcpf(1.f + __builtin_amdgcn_exp2f(-gg * LOG2E)) * uu; }
                u32x4 w; w.x = pk_h2(v[0], v[1]); w.y = pk_h2(v[2], v[3]); w.z = pk_h2(v[4], v[5]); w.w = pk_h2(v[6], v[7]);
                *(u32x4*)rowp = w; }
    }
};

struct EpiIn {
    static constexpr bool PERM = false;
    h16 *ckv, *cq, *kr, *ki, *qb, *kb, *vT; float *wi, *ssq; const float* gckv; const float2* tab; LAS float* X;
    __device__ __forceinline__ void rope64(const f32x4 (&acc)[2][2][4][2], const Unit& u, int wr, int wc, int fr, int fq, h16* dst, int tl, float scale) const {
        const int tok0 = u.pm * BM + wr * 64 + fr;
        f32x4 tc[4], tn[4];
        { const f32x4* tp = (const f32x4*)(tab + (size_t)tok0 * 48 + 4 * fq); tc[0] = tp[0]; tc[1] = tp[1]; tc[2] = tp[8]; tc[3] = tp[9]; }
#pragma unroll
        for (int rr = 0; rr < 8; ++rr) { const int ai = rr >> 2, m = rr & 3, tok = tok0 + ai * HALF + m * 16;
            if (rr < 7) { const int tokn = tok0 + ((rr + 1) >> 2) * HALF + ((rr + 1) & 3) * 16; const f32x4* tp = (const f32x4*)(tab + (size_t)tokn * 48 + 4 * fq); tn[0] = tp[0]; tn[1] = tp[1]; tn[2] = tp[8]; tn[3] = tp[9]; }
#pragma unroll
            for (int n = 0; n < 2; ++n) { const int i = 16 * n + 4 * fq; const f32x4 t0 = tc[2 * n], t1 = tc[2 * n + 1];
                const f32x4 cs = {t0.x, t0.z, t1.x, t1.z}, sn = {t0.y, t0.w, t1.y, t1.w}, x1 = acc[ai][0][m][n], x2 = acc[ai][1][m][n];
                const f32x4 o1 = (x1 * cs - x2 * sn) * scale, o2 = (x2 * cs + x1 * sn) * scale;
                h16* p = dst + (size_t)tok * 768 + (4 * tl + wc) * 64 + i;
                u32x2 w1, w2; w1.x = pk_h2(o1.x, o1.y); w1.y = pk_h2(o1.z, o1.w); w2.x = pk_h2(o2.x, o2.y); w2.y = pk_h2(o2.z, o2.w);
                *(u32x2*)p = w1; *(u32x2*)(p + 32) = w2; }
#pragma unroll
            for (int k = 0; k < 4; ++k) tc[k] = tn[k];
            asm volatile("" ::: "memory"); }
    }
    __device__ __forceinline__ void operator()(const f32x4 (&acc)[2][2][4][2], const Unit& u, int wr, int wc, int fr, int fq) const {
        const int pn = u.pn;
        if (pn == 0) {
#pragma unroll
            for (int ai = 0; ai < 2; ++ai)
#pragma unroll
                for (int m = 0; m < 4; ++m) { float sq = 0.f;
#pragma unroll
                    for (int bj = 0; bj < 2; ++bj)
#pragma unroll
                        for (int n = 0; n < 2; ++n) { const f32x4 v = acc[ai][bj][m][n]; sq += (v.x * v.x + v.y * v.y) + (v.z * v.z + v.w * v.w); }
                    sq += __shfl_xor(sq, 16); sq += __shfl_xor(sq, 32);
                    if (fq == 0) X[(ai * HALF + wr * 64 + m * 16 + fr) * 4 + wc] = sq; }
            asm volatile("s_waitcnt lgkmcnt(0)" ::: "memory"); __builtin_amdgcn_s_barrier(); asm volatile("" ::: "memory");
#pragma unroll
            for (int ai = 0; ai < 2; ++ai)
#pragma unroll
                for (int m = 0; m < 4; ++m) { const int rl = ai * HALF + wr * 64 + m * 16 + fr, tok = u.pm * BM + rl; const f32x4 p = *(const LAS f32x4*)(X + rl * 4);
                    const float rstd = rsqrtf(((p.x + p.y) + (p.z + p.w)) * (1.f / KVL) + EPS);
#pragma unroll
                    for (int bj = 0; bj < 2; ++bj)
#pragma unroll
                        for (int n = 0; n < 2; ++n) { const int col = bj * HALF + wc * 32 + n * 16 + 4 * fq; const f32x4 o = acc[ai][bj][m][n] * rstd * *(const f32x4*)(gckv + col);
                            int w8 = __builtin_amdgcn_cvt_pk_fp8_f32(o.x, o.y, 0, false); w8 = __builtin_amdgcn_cvt_pk_fp8_f32(o.z, o.w, w8, true);
                            *(int*)((unsigned char*)ckv + (size_t)tok * KVL + col) = w8; }
                    asm volatile("" ::: "memory"); }
            asm volatile("s_waitcnt lgkmcnt(0)" ::: "memory"); __builtin_amdgcn_s_barrier(); asm volatile("" ::: "memory");
        } else if (pn <= 2) {
#pragma unroll
            for (int ai = 0; ai < 2; ++ai)
#pragma unroll
                for (int m = 0; m < 4; ++m) { const int tok = u.pm * BM + ai * HALF + wr * 64 + m * 16 + fr; float sq = 0.f;
#pragma unroll
                    for (int bj = 0; bj < 2; ++bj) { if (pn == 2 && bj == 1) break;
#pragma unroll
                        for (int n = 0; n < 2; ++n) { const f32x4 v = acc[ai][bj][m][n]; sq += (v.x * v.x + v.y * v.y) + (v.z * v.z + v.w * v.w);
                            const int col = (pn - 1) * 256 + bj * HALF + wc * 32 + n * 16 + 4 * fq; u32x2 w; w.x = pk_h2(v.x, v.y); w.y = pk_h2(v.z, v.w); *(u32x2*)(cq + (size_t)tok * QL + col) = w; } }
                    sq += __shfl_xor(sq, 16); sq += __shfl_xor(sq, 32);
                    if (fq == 0) ssq[tok * 8 + (pn - 1) * 4 + wc] = sq;
                    if (pn == 2) {
                        if (wc < 2) { const int i = 4 * fq; const f32x4* tp = (const f32x4*)(tab + (size_t)tok * 48 + 32 + i); const f32x4 t0 = tp[0], t1 = tp[1];
                            const f32x4 cs = {t0.x, t0.z, t1.x, t1.z}, sn = {t0.y, t0.w, t1.y, t1.w}, x1 = acc[ai][1][m][0], x2 = acc[ai][1][m][1];
                            const f32x4 o1 = x1 * cs - x2 * sn, o2 = x2 * cs + x1 * sn;
                            if (wc == 0) { unsigned char* p8 = (unsigned char*)kr + (size_t)tok * 32 + i;
                                int a8 = __builtin_amdgcn_cvt_pk_fp8_f32(o1.x, o1.y, 0, false); a8 = __builtin_amdgcn_cvt_pk_fp8_f32(o1.z, o1.w, a8, true);
                                int b8 = __builtin_amdgcn_cvt_pk_fp8_f32(o2.x, o2.y, 0, false); b8 = __builtin_amdgcn_cvt_pk_fp8_f32(o2.z, o2.w, b8, true);
                                *(int*)p8 = a8; *(int*)(p8 + 16) = b8; }
                            else { h16* p = ki + (size_t)tok * 32 + i;
                                u32x2 w1, w2; w1.x = pk_h2(o1.x, o1.y); w1.y = pk_h2(o1.z, o1.w); w2.x = pk_h2(o2.x, o2.y); w2.y = pk_h2(o2.z, o2.w);
                                *(u32x2*)p = w1; *(u32x2*)(p + 16) = w2; } }
                        else if (wc == 2 && fq < 2) { *(f32x4*)(wi + tok * 8 + 4 * fq) = acc[ai][1][m][0] * 0.35355339059327373f; }
                    }
                    asm volatile("" ::: "memory"); }
        } else if (pn <= 5) rope64(acc, u, wr, wc, fr, fq, qb, pn - 3, 0.125f * LOG2E);
        else if (pn <= 8) rope64(acc, u, wr, wc, fr, fq, kb, pn - 6, 1.0f);
        else {
#pragma unroll
            for (int ai = 0; ai < 2; ++ai)
#pragma unroll
                for (int m = 0; m < 4; ++m) { const int tok = u.pm * BM + ai * HALF + wr * 64 + m * 16 + fr;
#pragma unroll
                    for (int bj = 0; bj < 2; ++bj)
#pragma unroll
                        for (int n = 0; n < 2; ++n) { const f32x4 v = acc[ai][bj][m][n]; u32x2 w; w.x = pk_h2(v.x, v.y); w.y = pk_h2(v.z, v.w);
                            *(u32x2*)(vT + (size_t)tok * 768 + (pn - 9) * 256 + bj * HALF + wc * 32 + n * 16 + 4 * fq) = w; }
                    asm volatile("" ::: "memory"); }
        }
    }
};
struct Epi4 {
    static constexpr bool PERM = true;
    h16 *qlat, *qr, *qi; const float* rstdq; const float2* tab;
    __device__ __forceinline__ void operator()(const f32x4 (&acc)[2][2][4][2], const Unit& u, int wr, int wc, int fr, int fq) const {
        const int pn = u.pn; const float c2 = 0.10206207261596575f * LOG2E;
        const int tok0 = u.pm * BM + wr * 64 + fr;
        float rc = rstdq[tok0], rn = 0.f;
        if (pn < 8) {
#pragma unroll
            for (int rr = 0; rr < 8; ++rr) { const int ai = rr >> 2, m = rr & 3, tok = tok0 + ai * HALF + m * 16;
                if (rr < 7) rn = rstdq[tok0 + ((rr + 1) >> 2) * HALF + ((rr + 1) & 3) * 16];
#pragma unroll
                for (int bj = 0; bj < 2; ++bj) { const f32x4 o0 = acc[ai][bj][m][0] * (rc * c2), o1 = acc[ai][bj][m][1] * (rc * c2);
                    u32x4 w; w.x = pk_h2(o0.x, o0.y); w.y = pk_h2(o0.z, o0.w); w.z = pk_h2(o1.x, o1.y); w.w = pk_h2(o1.z, o1.w);
                    *(u32x4*)(qlat + (size_t)tok * 2048 + pn * 256 + bj * HALF + wc * 32 + 8 * fq) = w; }
                rc = rn; asm volatile("" ::: "memory"); }
        } else { h16* dst = (pn == 8) ? qr : qi; const float c2e = (pn == 8) ? c2 : 1.f; const int i = 4 * fq;
            f32x4 tc[2], tn[2];
            { const f32x4* tp = (const f32x4*)(tab + (size_t)tok0 * 48 + 32 + i); tc[0] = tp[0]; tc[1] = tp[1]; }
#pragma unroll
            for (int rr = 0; rr < 8; ++rr) { const int ai = rr >> 2, m = rr & 3, tok = tok0 + ai * HALF + m * 16;
                if (rr < 7) { const int tokn = tok0 + ((rr + 1) >> 2) * HALF + ((rr + 1) & 3) * 16; const f32x4* tp = (const f32x4*)(tab + (size_t)tokn * 48 + 32 + i); tn[0] = tp[0]; tn[1] = tp[1]; rn = rstdq[tokn]; }
                const f32x4 cs = {tc[0].x, tc[0].z, tc[1].x, tc[1].z}, sn = {tc[0].y, tc[0].w, tc[1].y, tc[1].w}; const float sc = rc * c2e;
#pragma unroll
                for (int bj = 0; bj < 2; ++bj) { const f32x4 x1 = acc[ai][bj][m][0], x2 = acc[ai][bj][m][1]; const f32x4 o1 = (x1 * cs - x2 * sn) * sc, o2 = (x2 * cs + x1 * sn) * sc;
                    h16* p = dst + (size_t)tok * 256 + (4 * bj + wc) * 32 + i;
                    u32x2 w1, w2; w1.x = pk_h2(o1.x, o1.y); w1.y = pk_h2(o1.z, o1.w); w2.x = pk_h2(o2.x, o2.y); w2.y = pk_h2(o2.z, o2.w);
                    *(u32x2*)p = w1; *(u32x2*)(p + 16) = w2; }
                tc[0] = tn[0]; tc[1] = tn[1]; rc = rn;
                asm volatile("" ::: "memory"); } }
    }
};
__device__ __forceinline__ u32x4 ld16_l2(const h16* p) {
    const unsigned long long a = __hip_atomic_load((const unsigned long long*)p, __ATOMIC_RELAXED, __HIP_MEMORY_SCOPE_AGENT), b = __hip_atomic_load((const unsigned long long*)p + 1, __ATOMIC_RELAXED, __HIP_MEMORY_SCOPE_AGENT);
    return (u32x4){(unsigned)a, (unsigned)(a >> 32), (unsigned)b, (unsigned)(b >> 32)};
}
typedef _Float16 h16x8 __attribute__((ext_vector_type(8)));
__device__ __forceinline__ void unpk8(const u32x4 w, float (&f)[8]) {
    const h16x8 h = __builtin_bit_cast(h16x8, w);
#pragma unroll
    for (int i = 0; i < 8; ++i) f[i] = (float)h[i];
}
struct EpiH16 {
    static constexpr bool PERM = true;
    h16* O; int ldc = DM;
    __device__ __forceinline__ void operator()(const f32x4 (&acc)[2][2][4][2], const Unit& u, int wr, int wc, int fr, int fq) const {
        const int row0 = u.pm * BM + wr * 64 + fr, col0 = u.pn * BM + wc * 32 + 8 * fq;
#pragma unroll
        for (int ai = 0; ai < 2; ++ai)
#pragma unroll
            for (int m = 0; m < 4; ++m)
#pragma unroll
                for (int bj = 0; bj < 2; ++bj) { const f32x4 v0 = acc[ai][bj][m][0], v1 = acc[ai][bj][m][1];
                    u32x4 w; w.x = pk_h2(v0.x, v0.y); w.y = pk_h2(v0.z, v0.w); w.z = pk_h2(v1.x, v1.y); w.w = pk_h2(v1.z, v1.w);
                    *(u32x4*)(O + (size_t)(row0 + ai * HALF + m * 16) * ldc + col0 + bj * HALF) = w; }
    }
};
struct EpiGate {
    static constexpr bool PERM = true;
    const h16* Y; h16* Z; int accum;
    __device__ __forceinline__ void operator()(const f32x4 (&acc)[2][2][4][2], const Unit& u, int wr, int wc, int fr, int fq) const {
        const int row0 = u.pm * BM + wr * 64 + fr, col0 = u.pn * BM + wc * 32 + 8 * fq;
#pragma unroll
        for (int ai = 0; ai < 2; ++ai)
#pragma unroll
            for (int m = 0; m < 4; ++m)
#pragma unroll
                for (int bj = 0; bj < 2; ++bj) { const size_t off = (size_t)(row0 + ai * HALF + m * 16) * DM + col0 + bj * HALF;
                    float y[8], zz[8]; unpk8(ld16_l2(Y + off), y);
                    if (accum) unpk8(ld16_l2(Z + off), zz); else {
#pragma unroll
                        for (int i = 0; i < 8; ++i) zz[i] = 0.f; }
                    float o[8];
#pragma unroll
                    for (int n = 0; n < 2; ++n)
#pragma unroll
                        for (int e = 0; e < 4; ++e) { const float gg = acc[ai][bj][m][n][e]; o[n * 4 + e] = zz[n * 4 + e] + y[n * 4 + e] * __builtin_amdgcn_rcpf(1.f + __builtin_amdgcn_exp2f(-gg * LOG2E)); }
                    u32x4 w; w.x = pk_h2(o[0], o[1]); w.y = pk_h2(o[2], o[3]); w.z = pk_h2(o[4], o[5]); w.w = pk_h2(o[6], o[7]);
                    *(u32x4*)(Z + off) = w; }
    }
};
}

#define XB_TMO      128
#define XB_XCNT(j)  (256  + 64 * (j))
#define XB_XSUB(j)  (1280 + 64 * (j))
#define XB_XGEN(j)  (2304 + 64 * (j))
#define XB_TOP      3328
#define XB_TOPGEN   3392
#define XCD_BAR_WORDS 3456
#define XB_SPIN_CAP (1u << 18)
__device__ __forceinline__ unsigned xb_ld(unsigned* p)              { return __hip_atomic_load(p, __ATOMIC_RELAXED, __HIP_MEMORY_SCOPE_AGENT); }
__device__ __forceinline__ unsigned xb_add(unsigned* p, unsigned v) { return __hip_atomic_fetch_add(p, v, __ATOMIC_RELAXED, __HIP_MEMORY_SCOPE_AGENT); }
__device__ __forceinline__ unsigned xb_xcc_id() { return (unsigned)__builtin_amdgcn_s_getreg((3 << 11) | 20) & 0xFu; }
#define XB_SPIN(cond, bar) do { unsigned _sp = 0; while (cond) { __builtin_amdgcn_s_sleep(1); \
    if ((++_sp & 255u) == 0u) { if (xb_ld(&(bar)[XB_TMO])) break; if (_sp > XB_SPIN_CAP) { atomicAdd(&(bar)[XB_TMO], 1u); break; } } } } while (0)
struct XcdBarrier { unsigned* bar; unsigned x; volatile LAS unsigned* st; };
__device__ __forceinline__ XcdBarrier xcd_barrier_post(unsigned* bar, volatile LAS unsigned* st) {
    XcdBarrier b; b.bar = bar; b.x = xb_xcc_id(); b.st = st;
    if (threadIdx.x == 0) (void)xb_add(&bar[XB_XCNT(b.x)], 1u);
    return b;
}
__device__ __forceinline__ void xcd_barrier_complete(unsigned* bar, unsigned x, unsigned& nloc, unsigned& nx) {
    const unsigned G = gridDim.x * gridDim.y * gridDim.z;
    unsigned sum, cnt, mine, sp = 0u;
    for (;;) {
        sum = 0u; cnt = 0u; mine = 0u;
#pragma unroll
        for (unsigned j = 0; j < 16; ++j) { const unsigned c = xb_ld(&bar[XB_XCNT(j)]); sum += c; cnt += (c > 0u) ? 1u : 0u; mine = (j == x) ? c : mine; }
        if (sum == G) break;
        __builtin_amdgcn_s_sleep(1);
        if ((++sp & 255u) == 0u) { if (xb_ld(&bar[XB_TMO])) break; if (sp > XB_SPIN_CAP) { atomicAdd(&bar[XB_TMO], 1u); break; } }
    }
    nloc = mine > 0u ? mine : 1u; nx = cnt > 0u ? cnt : 1u;
}
__device__ __forceinline__ void xcd_barrier(const XcdBarrier& b) {
    asm volatile("s_waitcnt vmcnt(0)" ::: "memory");
    __syncthreads();
    if (threadIdx.x == 0) {
        unsigned* bar = b.bar;
        __builtin_amdgcn_s_waitcnt(0);
        unsigned nloc = b.st[0], nx = b.st[1];
        if (nloc == 0u) { xcd_barrier_complete(bar, b.x, nloc, nx); b.st[0] = nloc; b.st[1] = nx; }
        const unsigned old = xb_add(&bar[XB_XSUB(b.x)], 1u);
        const unsigned gen = old / nloc;
        if (old + 1u == (gen + 1u) * nloc) {
            __builtin_amdgcn_fence(__ATOMIC_RELEASE, "agent");
            asm volatile("s_waitcnt vmcnt(0)" ::: "memory");
            const unsigned og = xb_add(&bar[XB_TOP], 1u);
            const unsigned tg = og / nx;
            if (og + 1u == (tg + 1u) * nx) xb_add(&bar[XB_TOPGEN], 1u);
            else XB_SPIN(xb_ld(&bar[XB_TOPGEN]) == tg, bar);
            __builtin_amdgcn_fence(__ATOMIC_ACQUIRE, "agent");
            xb_add(&bar[XB_XGEN(b.x)], 1u);
            asm volatile("s_waitcnt vmcnt(0)" ::: "memory");
        } else {
            XB_SPIN(xb_ld(&bar[XB_XGEN(b.x)]) == gen, bar);
            __builtin_amdgcn_fence(__ATOMIC_ACQUIRE, "agent");
            asm volatile("s_waitcnt vmcnt(0)" ::: "memory");
        }
    }
    __syncthreads();
}

constexpr int NWAVES = 8, NTHR = 512;
constexpr int RING_BYTES = 131072, LDSCTL_OFF = RING_BYTES, MISC_OFF = LDSCTL_OFF + 320, LDS_BYTES = 147456;
constexpr int XCH_OFF = RING_BYTES + 1024;
constexpr int CW_BAR = 4096;
constexpr size_t OW_GU1 = OFF_W, OW_D1 = OW_GU1 + 11 * MiB, OW_IN = OW_D1 + (size_t)DM * FF * 2, OW_GATE = OW_IN + 6 * MiB, OW_4 = OW_GATE + 4 * MiB, OW_OV = OW_4 + 2 * MiB,
                 OW_UPB = OW_OV + 4 * MiB, OW_O = OW_UPB + MiB / 2, OW_GU2 = OW_O + 2 * MiB, OW_D2 = OW_GU2 + 11 * MiB, OW_END = OW_D2 + (size_t)DM * FF * 2;
static_assert(OW_END <= OFF_H, "weights region");
constexpr int NIN3 = 3072, N4 = 2560;
constexpr size_t OW_BD = OW_OV, OW_UPA = OW_OV + MiB, OFF_OA = OFF_A + 64 * MiB;

struct Args { const float* in[27]; float* out; unsigned char* ws; int ph_lo, ph_hi; };
struct Frame {
    LAS unsigned char* lds; int tid, lane, wave, G, gw, NGW;
};
__device__ __forceinline__ float wave_sum(float v) {
#pragma unroll
    for (int o = 1; o < 64; o <<= 1) v += __shfl_xor(v, o);
    return v;
}
__device__ __forceinline__ bool map_row(int job, int n, const Args& a, const float*& W, int& ldw, int& col) {
    if (job <= 1) { const int t = n >> 8, j = n & 255; W = a.in[(job == 0 ? 6 : 23) + (j >> 7)]; ldw = FF; col = t * 128 + (j & 127); return true; }
    if (job == 2) { W = a.in[11]; ldw = DIN; const int t = n >> 8, j = n & 255;
        if (t == 0) { col = C_CKV + j; return true; }
        if (t == 1) { col = j; return true; }
        if (t == 2) { if (j < 128) { col = 256 + j; return true; } if (j < 160) { col = C_KR + (j - 128); return true; } if (j < 192) { col = C_KI + (j - 160); return true; } if (j < 200) { col = C_WI + (j - 192); return true; } col = 0; return false; }
        if (t < 9) { const int c3 = (t - 3) / 3, tl = (t - 3) % 3, hl = (j & 127) >> 5, i = j & 31; col = C_QKV + c3 * 768 + (4 * tl + hl) * 64 + (j >> 7) * 32 + i; return true; }
        col = C_QKV + 1536 + (t - 9) * 256 + j; return true; }
    { const int n2 = n - 2048, r5 = n2 & 31, nat = 16 * ((r5 >> 2) & 1) + 4 * (r5 >> 3) + (r5 & 3);
      if (n2 < 256) { W = a.in[14]; ldw = 768; col = (n2 >> 5) * 96 + 64 + nat; } else { W = a.in[17]; ldw = 256; col = ((n2 - 256) & ~31) + nat; } return true; }
}
__device__ __forceinline__ void tr_item(const float* W, int ldw, int col, bool valid, const float* scale, int k0, h16* WTrow0, int K, LAS float* scr, int lane) {
    const int colc = valid ? col : 0; float vv[32];
#pragma unroll
    for (int i = 0; i < 32; ++i) vv[i] = W[(size_t)(k0 + 2 * i + (lane >> 5)) * ldw + colc];
    if (scale) {
#pragma unroll
        for (int i = 0; i < 32; ++i) vv[i] *= scale[k0 + 2 * i + (lane >> 5)]; }
#pragma unroll
    for (int i = 0; i < 32; ++i) scr[(2 * i + (lane >> 5)) * 33 + (lane & 31)] = valid ? vv[i] : 0.f;
    asm volatile("s_waitcnt lgkmcnt(0)" ::: "memory");
    const int c = lane & 7;
#pragma unroll
    for (int j = 0; j < 4; ++j) { const int n = (lane >> 3) + 8 * j; const LAS float* s = scr + (8 * c) * 33 + n;
        u32x4 o; o.x = pk_h2(s[0 * 33], s[1 * 33]); o.y = pk_h2(s[2 * 33], s[3 * 33]); o.z = pk_h2(s[4 * 33], s[5 * 33]); o.w = pk_h2(s[6 * 33], s[7 * 33]);
        *(u32x4*)(WTrow0 + (size_t)n * K + k0 + 8 * c) = o; }
    asm volatile("s_waitcnt lgkmcnt(0)" ::: "memory");
}
__device__ __forceinline__ void tr_job_mapped(const Frame& F, const Args& a, int job, int Ndest, int n_lo, int K, h16* WT, const float* scale, LAS float* scr, int phase_off) {
    const int nblk = Ndest / 32, nitems = (K / 64) * nblk;
    for (int it = (F.gw + phase_off) % F.NGW; it < nitems; it += F.NGW) {
        const int kb = it / nblk, nb = it % nblk; const float* W; int ldw, col;
        const bool valid = map_row(job, n_lo + nb * 32 + (F.lane & 31), a, W, ldw, col);
        tr_item(W, ldw, col, valid, scale, kb * 64, WT + (size_t)(n_lo + nb * 32) * K, K, scr, F.lane);
    }
}
__device__ __forceinline__ void tr_job_plain(const Frame& F, const float* W, int ldw, int Ndest, int K, h16* WT, LAS float* scr, int phase_off) {
    const int nblk = Ndest / 32, nitems = (K / 64) * nblk;
    for (int it = (F.gw + phase_off) % F.NGW; it < nitems; it += F.NGW) {
        const int kb = it / nblk, nb = it % nblk;
        tr_item(W, ldw, nb * 32 + (F.lane & 31), true, nullptr, kb * 64, WT + (size_t)(nb * 32) * K, K, scr, F.lane);
    }
}
__device__ __forceinline__ void row_load(const float* p, int lane, f32x4 (&v)[4]) {
#pragma unroll
    for (int j = 0; j < 4; ++j) v[j] = ((const f32x4*)p)[lane + 64 * j];
}
__device__ __forceinline__ float row_ssq(const f32x4 (&v)[4]) { float s = 0.f;
#pragma unroll
    for (int j = 0; j < 4; ++j) s += (v[j].x * v[j].x + v[j].y * v[j].y) + (v[j].z * v[j].z + v[j].w * v[j].w);
    return wave_sum(s); }
__device__ __forceinline__ void row_normmod_store(const f32x4 (&v)[4], float rstd, const float* g, const float* sc, const float* sh, h16* dst, int lane) {
#pragma unroll
    for (int j = 0; j < 4; ++j) { const int ci = lane + 64 * j; const f32x4 gg = ((const f32x4*)g)[ci], s1 = ((const f32x4*)sc)[ci], s0 = ((const f32x4*)sh)[ci];
        const f32x4 o = v[j] * rstd * gg * (s1 + 1.f) + s0;
        u32x2 w; w.x = pk_h2(o.x, o.y); w.y = pk_h2(o.z, o.w); ((u32x2*)dst)[ci] = w; }
}
__device__ __forceinline__ void ph_normmod(const Frame& F, const float* x, const float* g, const float* mod, int isc, int ish, h16* dst) {
    int m = F.gw; if (m >= MT) return;
    f32x4 v[4], vn[4]; row_load(x + (size_t)m * DM, F.lane, v);
    for (;;) { const int mn = m + F.NGW; const bool has = mn < MT; if (has) row_load(x + (size_t)mn * DM, F.lane, vn);
        const float rstd = rsqrtf(row_ssq(v) * (1.f / DM) + EPS); const float* mb = mod + (m / SEQ) * (NMOD * DM);
        row_normmod_store(v, rstd, g, mb + isc * DM, mb + ish * DM, dst + (size_t)m * DM, F.lane);
        if (!has) break;
#pragma unroll
        for (int j = 0; j < 4; ++j) v[j] = vn[j];
        m = mn; }
}
__device__ __forceinline__ void row_load_h(const h16* p, int lane, u32x2 (&v)[4]) {
#pragma unroll
    for (int j = 0; j < 4; ++j) v[j] = ((const u32x2*)p)[lane + 64 * j];
}
typedef _Float16 h16x4 __attribute__((ext_vector_type(4)));
__device__ __forceinline__ f32x4 h4_to_f4(u32x2 w) { const h16x4 h = __builtin_bit_cast(h16x4, w); return (f32x4){(float)h[0], (float)h[1], (float)h[2], (float)h[3]}; }
template <bool XI16, bool XO16>
__device__ __forceinline__ void ph_resnorm(const Frame& F, const void* xin_, const h16* f, const float* gpost, const float* mod, int igt, float coef, void* xout_,
                                           bool second, const float* gpre, int isc, int ish, h16* dst) {
    int m = F.gw; if (m >= MT) return;
    u32x2 fh[4], fn[4]; f32x4 xi[4], xn[4]; u32x2 xh[4], xhn[4];
    row_load_h(f + (size_t)m * DM, F.lane, fh);
    if constexpr (XI16) row_load_h((const h16*)xin_ + (size_t)m * DM, F.lane, xh); else row_load((const float*)xin_ + (size_t)m * DM, F.lane, xi);
    for (;;) {
        const int mn = m + F.NGW; const bool has = mn < MT;
        if (has) { row_load_h(f + (size_t)mn * DM, F.lane, fn);
            if constexpr (XI16) row_load_h((const h16*)xin_ + (size_t)mn * DM, F.lane, xhn); else row_load((const float*)xin_ + (size_t)mn * DM, F.lane, xn); }
        f32x4 v[4];
#pragma unroll
        for (int j = 0; j < 4; ++j) { v[j] = h4_to_f4(fh[j]); if constexpr (XI16) xi[j] = h4_to_f4(xh[j]); }
        const float rstd = rsqrtf(row_ssq(v) * (1.f / DM) + EPS) * coef; const float* mb = mod + (m / SEQ) * (NMOD * DM);
#pragma unroll
        for (int j = 0; j < 4; ++j) { const int ci = F.lane + 64 * j; const f32x4 gg = ((const f32x4*)gpost)[ci], gt = ((const f32x4*)(mb + igt * DM))[ci];
            xi[j] = xi[j] + gt * v[j] * rstd * gg;
            if constexpr (XO16) { u32x2 w; w.x = pk_h2(xi[j].x, xi[j].y); w.y = pk_h2(xi[j].z, xi[j].w); ((u32x2*)((h16*)xout_ + (size_t)m * DM))[ci] = w; }
            else ((f32x4*)((float*)xout_ + (size_t)m * DM))[ci] = xi[j]; }
        if (second) { const float r2 = rsqrtf(row_ssq(xi) * (1.f / DM) + EPS); row_normmod_store(xi, r2, gpre, mb + isc * DM, mb + ish * DM, dst + (size_t)m * DM, F.lane); }
        if (!has) break;
#pragma unroll
        for (int j = 0; j < 4; ++j) { fh[j] = fn[j]; if constexpr (XI16) xh[j] = xhn[j]; else xi[j] = xn[j]; }
        m = mn;
    }
}

__device__ __forceinline__ void ph_combine(const Frame& F, const h16* og, const float* lse2, h16* ob) {
    for (int idx = blockIdx.x * NTHR + F.tid; idx < MT * 256; idx += F.G * NTHR) {
        const int tok = idx >> 8, c = idx & 255, hh = c >> 6;
        const float l0 = lse2[tok * 12 + hh], l1 = lse2[tok * 12 + 4 + hh], l2 = lse2[tok * 12 + 8 + hh], m = fmaxf(l0, fmaxf(l1, l2));
        const float w0 = exp2f(l0 - m), w1 = exp2f(l1 - m), w2 = exp2f(l2 - m), inv = 1.f / (w0 + w1 + w2);
        ob[idx] = (h16)((w0 * (float)og[(size_t)tok * 768 + c] + w1 * (float)og[(size_t)tok * 768 + 256 + c] + w2 * (float)og[(size_t)tok * 768 + 512 + c]) * inv); }
}
typedef short v4i16_t __attribute__((ext_vector_type(4)));
typedef short s16x8 __attribute__((ext_vector_type(8)));
typedef float f32x16 __attribute__((ext_vector_type(16)));
__device__ __forceinline__ int tk_bin(float sc) { const unsigned u = __float_as_uint(sc); int e = (int)((u >> 16) & 0x7FFFu) - (122 << 7); e = e < 0 ? 0 : (e > 1023 ? 1023 : e); return (u >> 31) ? 1023 - e : 1024 + e; }
__device__ __forceinline__ void tk_scores(const f16x8 (&Af)[2], const float (&wv)[16], f16x8 b0, f16x8 b1, float& sa, float& sb) {
    f32x16 d = {0.f, 0.f, 0.f, 0.f, 0.f, 0.f, 0.f, 0.f, 0.f, 0.f, 0.f, 0.f, 0.f, 0.f, 0.f, 0.f};
    d = __builtin_amdgcn_mfma_f32_32x32x16_f16(Af[0], b0, d, 0, 0, 0); d = __builtin_amdgcn_mfma_f32_32x32x16_f16(Af[1], b1, d, 0, 0, 0);
    f32x2 acc = {0.f, 0.f};
#pragma unroll
    for (int e = 0; e < 16; e += 2) { const int i0 = __float_as_int(d[e]), i1 = __float_as_int(d[e + 1]);
        const f32x2 rl = {__int_as_float(i0 > 0 ? i0 : 0), __int_as_float(i1 > 0 ? i1 : 0)}; const f32x2 w2 = {wv[e], wv[e + 1]};
        acc = __builtin_elementwise_fma(w2, rl, acc); }
    sa = acc.x; sb = acc.y;
}
template <bool P2>
__device__ __forceinline__ void tk_tile(const f16x8 (&Af)[2], const float (&wv)[16], f16x8 b0, f16x8 b1, int tile, int r, int hi, int ta, LAS unsigned* hist, const int (&tbin)[4], int (&cs)[4], int (&cc)[4],
                                        unsigned short* sel, int tok0) {
    float sa, sb; tk_scores(Af, wv, b0, b1, sa, sb);
    const int s = 32 * tile + r;
    if constexpr (!P2) {
        if (s <= ta) { const int bn = tk_bin(sa); __hip_atomic_fetch_add(hist + (2 * hi) * 1024 + (bn >> 1), 1u << (16 * (bn & 1)), __ATOMIC_RELAXED, __HIP_MEMORY_SCOPE_WORKGROUP); }
        if (s <= ta + 1) { const int bn = tk_bin(sb); __hip_atomic_fetch_add(hist + (2 * hi + 1) * 1024 + (bn >> 1), 1u << (16 * (bn & 1)), __ATOMIC_RELAXED, __HIP_MEMORY_SCOPE_WORKGROUP); }
    } else {
        const unsigned lowmask = (1u << r) - 1u;
#pragma unroll
        for (int ab = 0; ab < 2; ++ab) { const float sc = ab ? sb : sa; const int tq = ta + ab; const int bn = tk_bin(sc);
            const int mytb = hi ? tbin[2 + ab] : tbin[ab];
            const bool valid = s <= tq, sure = valid && bn > mytb, cand = valid && bn == mytb;
            const unsigned long long ms = __ballot(sure), mc = __ballot(cand);
            const unsigned ms_h = hi ? (unsigned)(ms >> 32) : (unsigned)ms, mc_h = hi ? (unsigned)(mc >> 32) : (unsigned)mc;
            const int q = 2 * hi + ab;
            const int base_s = hi ? cs[2 + ab] : cs[ab], base_c = hi ? cc[2 + ab] : cc[ab];
            if (sure) sel[(size_t)(tok0 + q) * TOPK + base_s + __builtin_popcount(ms_h & lowmask)] = (unsigned short)s;
            if (cand) { const int pos = base_c + __builtin_popcount(mc_h & lowmask);
                if (pos < 512) ((LAS unsigned long long*)((LAS unsigned char*)hist + q * 4096))[pos] = ((unsigned long long)fkey(sc) << 16) | (unsigned long long)(0xFFFFu - (unsigned)s); }
            cs[ab] += __builtin_popcount((unsigned)ms); cs[2 + ab] += __builtin_popcount((unsigned)(ms >> 32));
            cc[ab] += __builtin_popcount((unsigned)mc); cc[2 + ab] += __builtin_popcount((unsigned)(mc >> 32)); }
    }
}
template <bool P2>
__device__ __forceinline__ void tk_pass(const f16x8 (&Af)[2], const float (&wv)[16], const h16* kbase, int ntiles, int r, int hi, int ta, LAS unsigned* hist, const int (&tbin)[4], int (&cs)[4], int (&cc)[4],
                                        unsigned short* sel, int tok0) {
    f16x8 BA[4][2], BB[4][2];
#define TK_LOAD(dst, t0_) do { _Pragma("unroll") for (int i_ = 0; i_ < 4; ++i_) { const int tt_ = ((t0_) + i_) < 127 ? ((t0_) + i_) : 127; dst[i_][0] = *(const f16x8*)(kbase + (size_t)tt_ * 1024); dst[i_][1] = *(const f16x8*)(kbase + (size_t)tt_ * 1024 + 16); } } while (0)
    TK_LOAD(BA, 0);
    for (int t0 = 0; t0 < ntiles; t0 += 8) {
        TK_LOAD(BB, t0 + 4);
#pragma unroll
        for (int i = 0; i < 4; ++i) if (t0 + i < ntiles) tk_tile<P2>(Af, wv, BA[i][0], BA[i][1], t0 + i, r, hi, ta, hist, tbin, cs, cc, sel, tok0);
        TK_LOAD(BA, t0 + 8);
#pragma unroll
        for (int i = 0; i < 4; ++i) if (t0 + 4 + i < ntiles) tk_tile<P2>(Af, wv, BB[i][0], BB[i][1], t0 + 4 + i, r, hi, ta, hist, tbin, cs, cc, sel, tok0);
    }
#undef TK_LOAD
}
__device__ __forceinline__ void tk_group(const Frame& F, const h16* qi, const h16* ki, const float* wi, unsigned short* sel, int b, int t0, LAS unsigned* hist) {
    int lane_ = F.lane; asm volatile("" : "+v"(lane_)); const int lane = lane_, r = lane & 31, hi = lane >> 5, tok0 = b * SEQ + t0;
    const int qa = 2 * ((r >> 2) & 1) + (r & 1), ha = 4 * (r >> 4) + 2 * ((r >> 3) & 1) + ((r >> 1) & 1);
    f16x8 Af[2];
#pragma unroll
    for (int s_ = 0; s_ < 2; ++s_) Af[s_] = *(const f16x8*)(qi + (size_t)(tok0 + qa) * 256 + ha * 32 + 16 * s_ + 8 * hi);
    float wv[16];
    { const f32x4 a0 = *(const f32x4*)(wi + (tok0 + 2 * hi) * 8), a1 = *(const f32x4*)(wi + (tok0 + 2 * hi) * 8 + 4), b0 = *(const f32x4*)(wi + (tok0 + 2 * hi + 1) * 8), b1 = *(const f32x4*)(wi + (tok0 + 2 * hi + 1) * 8 + 4);
      const float sa[8] = {a0.x, a0.y, a0.z, a0.w, a1.x, a1.y, a1.z, a1.w}, sb[8] = {b0.x, b0.y, b0.z, b0.w, b1.x, b1.y, b1.z, b1.w};
#pragma unroll
      for (int h = 0; h < 8; ++h) { wv[2 * h] = sa[h] * 0.17677669529663687f; wv[2 * h + 1] = sb[h] * 0.17677669529663687f; } }
    const int ntiles = (t0 + 3) / 32 + 1, ta = t0 + 2 * hi;
    const h16* kbase = ki + (size_t)(b * SEQ + r) * 32 + 8 * hi;
    int tbin[4] = {0, 0, 0, 0}, nsure[4], cs[4] = {0, 0, 0, 0}, cc[4] = {0, 0, 0, 0};
#pragma unroll
    for (int i = 0; i < 16; ++i) *(LAS u32x4*)((LAS unsigned char*)hist + i * 1024 + lane * 16) = (u32x4){0u, 0u, 0u, 0u};
    asm volatile("s_waitcnt lgkmcnt(0)" ::: "memory");
    tk_pass<false>(Af, wv, kbase, ntiles, r, hi, ta, hist, tbin, cs, cc, sel, tok0);
    asm volatile("s_waitcnt lgkmcnt(0)" ::: "memory");
#pragma unroll
    for (int q = 0; q < 4; ++q) {
        const LAS unsigned* hq = hist + q * 1024;
        unsigned sum = 0;
#pragma unroll
        for (int i = 0; i < 4; ++i) { const u32x4 v = *(const LAS u32x4*)(hq + 16 * lane + 4 * i); sum += (v.x & 0xFFFFu) + (v.x >> 16) + (v.y & 0xFFFFu) + (v.y >> 16) + (v.z & 0xFFFFu) + (v.z >> 16) + (v.w & 0xFFFFu) + (v.w >> 16); }
        unsigned incl = sum;
#pragma unroll
        for (int o = 1; o < 64; o <<= 1) { const unsigned v = __shfl_down(incl, o); if (lane + o < 64) incl += v; }
        const unsigned long long bal = __ballot(incl >= (unsigned)TOPK);
        const int L = 63 - __builtin_clzll(bal);
        unsigned cum = __shfl(incl, L) - __shfl(sum, L);
        int tbq = 32 * L, found = 0;
        for (int wd = 15; wd >= 0 && !found; --wd) { const unsigned v = hq[16 * L + wd];
            const unsigned chi = v >> 16, clo = v & 0xFFFFu;
            if (cum + chi >= (unsigned)TOPK) { tbq = 32 * L + 2 * wd + 1; found = 1; } else { cum += chi;
                if (cum + clo >= (unsigned)TOPK) { tbq = 32 * L + 2 * wd; found = 1; } else cum += clo; } }
        tbin[q] = tbq; nsure[q] = (int)cum;
    }
    asm volatile("s_waitcnt lgkmcnt(0)" ::: "memory");
    tk_pass<true>(Af, wv, kbase, ntiles, r, hi, ta, hist, tbin, cs, cc, sel, tok0);
    asm volatile("s_waitcnt lgkmcnt(0)" ::: "memory");
#pragma unroll
    for (int q = 0; q < 4; ++q) {
        const int nc = cc[q] < 512 ? cc[q] : 512, need = TOPK - cs[q];
        const LAS unsigned long long* cq = (const LAS unsigned long long*)((const LAS unsigned char*)hist + q * 4096);
        if (nc > 64) {
            unsigned long long it[8];
#pragma unroll
            for (int k = 0; k < 8; ++k) it[k] = (k * 64 + lane < nc) ? cq[k * 64 + lane] : 0ull;
            unsigned long long T = 0ull;
            for (int bit = 47; bit >= 0; --bit) { const unsigned long long cand = T | (1ull << bit); int cnt = 0;
#pragma unroll
                for (int k = 0; k < 8; ++k) cnt += __builtin_popcountll(__ballot(it[k] >= cand));
                if (cnt >= need) T = cand; }
            int basep = cs[q];
#pragma unroll
            for (int k = 0; k < 8; ++k) { const bool pick = (T != 0ull) && it[k] >= T; const unsigned long long mk = __ballot(pick);
                if (pick) sel[(size_t)(tok0 + q) * TOPK + basep + __builtin_popcountll(mk & ((1ull << lane) - 1ull))] = (unsigned short)(0xFFFFu - (unsigned)(it[k] & 0xFFFFull));
                basep += __builtin_popcountll(mk); }
        } else
        for (int base = 0; base < nc; base += 64) {
            const bool act = base + lane < nc; const unsigned long long my = act ? cq[base + lane] : 0ull; int rank = 0;
            for (int jb = 0; jb < nc; jb += 64) {
                const unsigned long long cj = (jb + lane < nc) ? cq[jb + lane] : 0ull; const unsigned clo = (unsigned)cj, chi = (unsigned)(cj >> 32);
                const int n = (nc - jb) < 64 ? (nc - jb) : 64;
                for (int j = 0; j < n; ++j) { const unsigned long long sj = ((unsigned long long)(unsigned)__builtin_amdgcn_readlane((int)chi, j) << 32) | (unsigned)__builtin_amdgcn_readlane((int)clo, j); rank += (sj > my) ? 1 : 0; } }
            if (act && rank < need) sel[(size_t)(tok0 + q) * TOPK + cs[q] + rank] = (unsigned short)(0xFFFFu - (unsigned)(my & 0xFFFFull)); }
    }
    (void)nsure;
    asm volatile("s_waitcnt lgkmcnt(0)" ::: "memory");
}
__device__ __forceinline__ void ph_topk_sparse(const Frame& F, const h16* qi, const h16* ki, const float* wi, unsigned short* sel, h16* qlat, const h16* qr, const unsigned char* ckv8, const unsigned char* kr8);
__device__ __forceinline__ void ph_topk_mfma(const Frame& F, const h16* qi, const h16* ki, const float* wi, unsigned short* sel) {
    LAS unsigned* hist = (LAS unsigned*)(F.lds + F.wave * 16384);
    for (int g = F.gw; g < 4 * 64; g += F.NGW) { const int b = g >> 6, t0 = (g & 63) * 4;
        for (int i = F.lane; i < 4 * TOPK; i += 64) { const int q = i >> 8, k = i & 255; sel[(size_t)(b * SEQ + t0 + q) * TOPK + k] = (unsigned short)(k <= t0 + q ? k : 0); } }
    for (int p = F.gw; p < 4 * 480; p += F.NGW) { const int b = p & 3, pj = p >> 2;
        tk_group(F, qi, ki, wi, sel, b, 4 * (64 + pj), hist);
        tk_group(F, qi, ki, wi, sel, b, 4 * (1023 - pj), hist);
    }
}


__device__ __forceinline__ void ph_dilated_mfma(const Frame& F, const h16* qb, const h16* kb, const h16* vb, h16* og, float* lse2) {
    const int lane = F.lane, ql = lane & 31, hi = lane >> 5;
    LAS unsigned char* VL = F.lds + F.wave * 16384;
    LAS float* linv = (LAS float*)(VL + 12288);
    constexpr int VROW = 192;
    const int trq = (lane & 15) >> 2, trp = lane & 3, trg = (lane >> 4) & 1;
    for (int u = F.gw; u < NB * 12 * 128; u += F.NGW) {
        const int b = u / 1536, rem = u % 1536, gh = rem >> 7, g = gh >> 2, wi_ = rem & 127, dil = dil_of(g), sh = g == 0 ? 0 : (g == 1 ? 2 : 4);
        const int nblk = 128 >> sh, res = wi_ / nblk, j0 = 32 * (wi_ % nblk);
        const size_t hoff = (size_t)b * SEQ * 768 + gh * 64;
        f16x8 Qf[4];
        { const h16* qp = qb + hoff + (size_t)((j0 + ql) * dil + res) * 768 + 8 * hi;
#pragma unroll
          for (int s_ = 0; s_ < 4; ++s_) Qf[s_] = *(const f16x8*)(qp + 16 * s_); }
        f32x16 S[5];
        f16x8 Kf[5][4];
#pragma unroll
        for (int kt = 0; kt < 5; ++kt) { int jk = j0 - 128 + 32 * kt + ql; jk = jk < 0 ? 0 : jk;
            const h16* kp = kb + hoff + (size_t)(jk * dil + res) * 768 + 8 * hi;
#pragma unroll
            for (int s_ = 0; s_ < 4; ++s_) Kf[kt][s_] = *(const f16x8*)(kp + 16 * s_); }
#pragma unroll
        for (int kt = 0; kt < 5; ++kt) {
            f32x16 d = {0.f, 0.f, 0.f, 0.f, 0.f, 0.f, 0.f, 0.f, 0.f, 0.f, 0.f, 0.f, 0.f, 0.f, 0.f, 0.f};
#pragma unroll
            for (int s_ = 0; s_ < 4; ++s_) d = __builtin_amdgcn_mfma_f32_32x32x16_f16(Kf[kt][s_], Qf[s_], d, 0, 0, 0);
            S[kt] = d; }
        f16x8 Vr[5][4];
#pragma unroll
        for (int kt = 0; kt < 5; ++kt) { int jk = j0 - 128 + 32 * kt + (lane >> 1); jk = jk < 0 ? 0 : jk;
            const h16* vp = vb + hoff + (size_t)(jk * dil + res) * 768 + (lane & 1) * 32;
#pragma unroll
            for (int i = 0; i < 4; ++i) Vr[kt][i] = *(const f16x8*)(vp + 8 * i); }
        float m = -INFINITY;
#pragma unroll
        for (int kt = 0; kt < 5; ++kt)
#pragma unroll
            for (int e = 0; e < 16; ++e) { const int kl = (e & 3) + 8 * (e >> 2) + 4 * hi; bool ok = (j0 - 128 + 32 * kt + kl) >= 0;
                if (kt == 0) ok = ok && (kl >= ql); if (kt == 4) ok = ok && (kl <= ql);
                if (!ok) S[kt][e] = -INFINITY; m = fmaxf(m, S[kt][e]); }
        m = fmaxf(m, __shfl_xor(m, 32));
        float l = 0.f;
#pragma unroll
        for (int kt = 0; kt < 5; ++kt)
#pragma unroll
            for (int e = 0; e < 16; ++e) { const float p = __builtin_amdgcn_exp2f(S[kt][e] - m); S[kt][e] = p; l += p; }
        l += __shfl_xor(l, 32);
        if (hi == 0) { linv[ql] = __builtin_amdgcn_rcpf(l); lse2[(size_t)(b * SEQ + (j0 + ql) * dil + res) * 12 + gh] = m + __builtin_amdgcn_logf(l); }
        f32x16 O[2];
#pragma unroll
        for (int dt = 0; dt < 2; ++dt) O[dt] = (f32x16){0.f, 0.f, 0.f, 0.f, 0.f, 0.f, 0.f, 0.f, 0.f, 0.f, 0.f, 0.f, 0.f, 0.f, 0.f, 0.f};
#pragma unroll
        for (int kt = 0; kt < 5; ++kt) {
            LAS unsigned char* vbuf = VL + (kt & 1) * 6144;
#pragma unroll
            for (int i = 0; i < 4; ++i) *(LAS f16x8*)(vbuf + (lane >> 1) * VROW + (lane & 1) * 64 + i * 16) = Vr[kt][i];
            asm volatile("s_waitcnt lgkmcnt(0)" ::: "memory");
#pragma unroll
            for (int s2 = 0; s2 < 2; ++s2) {
                u32x4 pa; pa.x = pk_h2(S[kt][8 * s2 + 0], S[kt][8 * s2 + 1]); pa.y = pk_h2(S[kt][8 * s2 + 2], S[kt][8 * s2 + 3]); pa.z = pk_h2(S[kt][8 * s2 + 4], S[kt][8 * s2 + 5]); pa.w = pk_h2(S[kt][8 * s2 + 6], S[kt][8 * s2 + 7]);
#pragma unroll
                for (int dt = 0; dt < 2; ++dt) {
                    const v4i16_t lo = __builtin_amdgcn_ds_read_tr16_b64_v4i16((LAS v4i16_t*)(vbuf + (16 * s2 + 4 * hi + trq) * VROW + (32 * dt + 16 * trg + 4 * trp) * 2));
                    const v4i16_t hh = __builtin_amdgcn_ds_read_tr16_b64_v4i16((LAS v4i16_t*)(vbuf + (16 * s2 + 8 + 4 * hi + trq) * VROW + (32 * dt + 16 * trg + 4 * trp) * 2));
                    const s16x8 bv = {lo[0], lo[1], lo[2], lo[3], hh[0], hh[1], hh[2], hh[3]};
                    O[dt] = __builtin_amdgcn_mfma_f32_32x32x16_f16(__builtin_bit_cast(f16x8, pa), __builtin_bit_cast(f16x8, bv), O[dt], 0, 0, 0); } }
            asm volatile("s_waitcnt lgkmcnt(0)" ::: "memory");
        }
#pragma unroll
        for (int e = 0; e < 16; ++e) { const int q = (e & 3) + 8 * (e >> 2) + 4 * hi; const float il = linv[q];
            h16* op = og + (size_t)(b * SEQ + (j0 + q) * dil + res) * 768 + gh * 64 + ql;
            op[0] = (h16)(O[0][e] * il); op[32] = (h16)(O[1][e] * il); }
        asm volatile("s_waitcnt lgkmcnt(0)" ::: "memory");
    }
}


__device__ __forceinline__ f16x8 fp8x8_to_f16(unsigned w0, unsigned w1) {
    const h16x2 a = __builtin_amdgcn_cvt_scalef32_pk_f16_fp8((int)w0, 1.0f, false), b = __builtin_amdgcn_cvt_scalef32_pk_f16_fp8((int)w0, 1.0f, true),
                c = __builtin_amdgcn_cvt_scalef32_pk_f16_fp8((int)w1, 1.0f, false), d = __builtin_amdgcn_cvt_scalef32_pk_f16_fp8((int)w1, 1.0f, true);
    const u32x4 r = {__builtin_bit_cast(unsigned, a), __builtin_bit_cast(unsigned, b), __builtin_bit_cast(unsigned, c), __builtin_bit_cast(unsigned, d)};
    return __builtin_bit_cast(f16x8, r);
}
template <bool FUSED>
__device__ __forceinline__ void ph_sparse_wave(const Frame& F, h16* qlat, const h16* qr, const unsigned char* ckv8, const unsigned char* kr8, const unsigned short* sel, int ta = 0, int tb = 0) {
    int lane = F.lane; asm volatile("" : "+v"(lane));
    LAS unsigned char* V = F.lds + F.wave * 16384;
    const int qp = (lane & 15) >> 2, pp = lane & 3;
    const int k0 = 4 * (lane >> 4) + qp;
    const int tr0 = k0 * 512 + (pp >> 1) * 16 + (pp & 1) * 8, x0 = k0 & 7;
    const int vw = (lane & 15) * 512, swz = lane & 7;
    const int lane0 = lane;
    const int nit = FUSED ? 8 : (MT - F.gw + F.NGW - 1) / F.NGW;
    for (int it = 0; it < nit; ++it) {
        const int tok = FUSED ? ((it < 4 ? ta : tb - 4) + it) : F.gw + it * F.NGW;
        int ll = lane0; asm volatile("" : "+v"(ll));
        const int c = ll & 15, kq = ll >> 4, hd = c & 7;
        const int b = tok / SEQ, t = tok % SEQ, cnt = (t + 1 < TOPK) ? t + 1 : TOPK, nch = (cnt + 31) >> 5;
        LAS unsigned short* sp = (LAS unsigned short*)(F.lds + XCH_OFF + F.wave * 512) + c;
        *(LAS u32x2*)(F.lds + XCH_OFF + F.wave * 512 + 8 * ll) = *(const u32x2*)(sel + (size_t)tok * TOPK + 4 * ll);
        asm volatile("s_waitcnt lgkmcnt(0)" ::: "memory");
        f16x8 Qf[9]; u32x4 Kr[2][4]; u32x2 Rr[2];
#pragma unroll
        for (int s_ = 0; s_ < 8; ++s_) Qf[s_] = *(const f16x8*)(qlat + (size_t)tok * 2048 + hd * 256 + 64 * (s_ >> 1) + 16 * kq + 8 * (s_ & 1));
        Qf[8] = *(const f16x8*)(qr + (size_t)tok * 256 + hd * 32 + 8 * kq);
        int rowi[2];
#define SW_LOADK() do { _Pragma("unroll") for (int tl = 0; tl < 2; ++tl) { _Pragma("unroll") for (int q4 = 0; q4 < 4; ++q4) Kr[tl][q4] = *(const u32x4*)(ckv8 + (size_t)rowi[tl] * 256 + 64 * q4 + 16 * kq); \
        Rr[tl] = *(const u32x2*)(kr8 + (size_t)rowi[tl] * 32 + 8 * kq); } } while (0)
        rowi[0] = b * SEQ + (int)sp[0]; rowi[1] = b * SEQ + (int)sp[16];
        SW_LOADK();
        float m = -INFINITY, l = 0.f;
        f32x4 O[16];
#pragma unroll
        for (int ft = 0; ft < 16; ++ft) O[ft] = (f32x4){0.f, 0.f, 0.f, 0.f};
        for (int ch = 0; ch < nch; ++ch) {
            const bool more = ch + 1 < nch;
            int rown0 = 0, rown1 = 0; if (more) { rown0 = (int)sp[32 * (ch + 1)]; rown1 = (int)sp[32 * (ch + 1) + 16]; }
            f16x8 Kf[2][9];
#pragma unroll
            for (int tl = 0; tl < 2; ++tl) {
#pragma unroll
                for (int q4 = 0; q4 < 4; ++q4) { Kf[tl][2 * q4] = fp8x8_to_f16(Kr[tl][q4].x, Kr[tl][q4].y); Kf[tl][2 * q4 + 1] = fp8x8_to_f16(Kr[tl][q4].z, Kr[tl][q4].w); }
                Kf[tl][8] = fp8x8_to_f16(Rr[tl].x, Rr[tl].y); }
            if (more) { rowi[0] = b * SEQ + rown0; rowi[1] = b * SEQ + rown1; SW_LOADK(); }
            f32x4 S[2];
#pragma unroll
            for (int tl = 0; tl < 2; ++tl) { S[tl] = (f32x4){0.f, 0.f, 0.f, 0.f};
#pragma unroll
                for (int s_ = 0; s_ < 9; ++s_) S[tl] = __builtin_amdgcn_mfma_f32_16x16x32_f16(Kf[tl][s_], Qf[s_], S[tl], 0, 0, 0); }
            float cm = -INFINITY;
#pragma unroll
            for (int tl = 0; tl < 2; ++tl)
#pragma unroll
                for (int e = 0; e < 4; ++e) { if (32 * ch + 16 * tl + 4 * kq + e >= cnt) S[tl][e] = -INFINITY; cm = fmaxf(cm, S[tl][e]); }
            cm = fmaxf(cm, __shfl_xor(cm, 16)); cm = fmaxf(cm, __shfl_xor(cm, 32));
            if (__any(cm > m + 8.0f)) { const float mn = fmaxf(m, cm), alpha = __builtin_amdgcn_exp2f(m - mn); m = mn; l *= alpha;
#pragma unroll
                for (int ft = 0; ft < 16; ++ft) O[ft] = O[ft] * alpha; }
            float pe[2][4]; float ps = 0.f;
#pragma unroll
            for (int tl = 0; tl < 2; ++tl)
#pragma unroll
                for (int e = 0; e < 4; ++e) { pe[tl][e] = __builtin_amdgcn_exp2f(S[tl][e] - m); ps += pe[tl][e]; }
            l += ps;
#pragma unroll
            for (int tl = 0; tl < 2; ++tl)
#pragma unroll
                for (int s_ = 0; s_ < 8; ++s_) *(LAS f16x8*)(V + vw + tl * 8192 + (((4 * (s_ >> 1) + kq) ^ swz) << 5) + (s_ & 1) * 16) = Kf[tl][s_];
            asm volatile("s_waitcnt lgkmcnt(0)" ::: "memory");
            u32x4 pk; pk.x = pk_h2(pe[0][0], pe[0][1]); pk.y = pk_h2(pe[0][2], pe[0][3]); pk.z = pk_h2(pe[1][0], pe[1][1]); pk.w = pk_h2(pe[1][2], pe[1][3]);
            const f16x8 Pf = __builtin_bit_cast(f16x8, pk);
#pragma unroll
            for (int ft = 0; ft < 16; ++ft) {
                const v4i16_t lo = __builtin_amdgcn_ds_read_tr16_b64_v4i16((LAS v4i16_t*)(V + tr0 + (((ft & 7) ^ x0) << 5) + (ft >> 3) * 256));
                const v4i16_t hi = __builtin_amdgcn_ds_read_tr16_b64_v4i16((LAS v4i16_t*)(V + tr0 + (((ft & 7) ^ x0) << 5) + (ft >> 3) * 256 + 8192));
                const s16x8 av = {lo[0], lo[1], lo[2], lo[3], hi[0], hi[1], hi[2], hi[3]};
                O[ft] = __builtin_amdgcn_mfma_f32_16x16x32_f16(__builtin_bit_cast(f16x8, av), Pf, O[ft], 0, 0, 0); }
            asm volatile("s_waitcnt lgkmcnt(0)" ::: "memory");
        }
        l += __shfl_xor(l, 16); l += __shfl_xor(l, 32);
        if (c < 8) { const float il = __builtin_amdgcn_rcpf(l);
#pragma unroll
            for (int ft = 0; ft < 16; ++ft) { const f32x4 o = O[ft] * il; u32x2 pk; pk.x = pk_h2(o.x, o.y); pk.y = pk_h2(o.z, o.w);
                *(u32x2*)(qlat + (size_t)tok * 2048 + c * 256 + 16 * ft + 4 * kq) = pk; } }
#undef SW_LOADK
    }
}


__device__ __forceinline__ void precomb_tiles(const Frame& F, const Args& args, unsigned char* ws, int t_lo, int t_hi, int wg, int nwg) {
    LAS float* As = (LAS float*)(F.lds); LAS float* Bs = (LAS float*)(F.lds + 64 * 65 * 4);
    for (int tl = t_lo + wg; tl < t_hi; tl += nwg) {
        __syncthreads();
        const bool ql = tl < 192; int hd, rb, xb;
        if (ql) { hd = tl / 24; rb = (tl % 24) / 6; xb = tl % 6; } else { const int t2 = tl - 192; hd = t2 / 64; rb = (t2 % 64) / 16; xb = t2 % 16; }
#pragma unroll
        for (int k = 0; k < 2; ++k) { const int i4 = F.tid + NTHR * k, row = i4 >> 4, c4 = (i4 & 15) * 4;
            if (ql) { const f32x4 a = *(const f32x4*)(args.in[15] + (size_t)(rb * 64 + row) * 512 + hd * 64 + c4), bq = *(const f32x4*)(args.in[14] + (size_t)(xb * 64 + row) * 768 + hd * 96 + c4);
#pragma unroll
                for (int e = 0; e < 4; ++e) { As[row * 65 + c4 + e] = a[e]; Bs[row * 65 + c4 + e] = bq[e]; } }
            else { const f32x4 a = *(const f32x4*)(args.in[18] + (size_t)(hd * 64 + row) * DM + xb * 64 + c4), bq = *(const f32x4*)(args.in[16] + (size_t)(rb * 64 + row) * 512 + hd * 64 + c4);
#pragma unroll
                for (int e = 0; e < 4; ++e) { As[(c4 + e) * 65 + row] = a[e]; Bs[row * 65 + c4 + e] = bq[e]; } } }
        __syncthreads();
        const int j = F.tid & 63, ig = F.wave;
        float acc8[8];
#pragma unroll
        for (int ii = 0; ii < 8; ++ii) acc8[ii] = 0.f;
#pragma unroll 4
        for (int v = 0; v < 64; ++v) { const float bv = Bs[j * 65 + v];
#pragma unroll
            for (int ii = 0; ii < 8; ++ii) acc8[ii] += As[(ig * 8 + ii) * 65 + v] * bv; }
        if (ql) { const float gj = args.in[12][xb * 64 + j]; h16* o = (h16*)(ws + OW_4);
#pragma unroll
            for (int ii = 0; ii < 8; ++ii) o[(size_t)(hd * 256 + rb * 64 + ig * 8 + ii) * QL + xb * 64 + j] = (h16)(acc8[ii] * gj); }
        else { h16* o = (h16*)(ws + OW_OV);
#pragma unroll
            for (int ii = 0; ii < 8; ++ii) o[(size_t)(xb * 64 + ig * 8 + ii) * 2048 + hd * 256 + rb * 64 + j] = (h16)acc8[ii]; }
    }
    __syncthreads();
}


__device__ __forceinline__ void ph_topk_sparse(const Frame& F, const h16* qi, const h16* ki, const float* wi, unsigned short* sel, h16* qlat, const h16* qr, const unsigned char* ckv8, const unsigned char* kr8) {
    LAS unsigned* hist = (LAS unsigned*)(F.lds + F.wave * 16384);
    for (int p = F.gw; p < 2048; p += F.NGW) {
        int ta, tb;
        if (p < 4 * 448) { const int b = p & 3, pj = p >> 2; ta = b * SEQ + 4 * (64 + pj); tb = b * SEQ + 4 * (959 - pj);
            tk_group(F, qi, ki, wi, sel, b, 4 * (64 + pj), hist);
            tk_group(F, qi, ki, wi, sel, b, 4 * (959 - pj), hist); }
        else { const int q_ = p - 4 * 448, b = q_ & 3, i_ = q_ >> 2, t0 = 4 * i_;
            tk_group(F, qi, ki, wi, sel, b, 4 * (960 + i_), hist);
            int l0 = F.lane; asm volatile("" : "+v"(l0));
            for (int i = l0; i < 4 * TOPK; i += 64) { const int q = i >> 8, k = i & 255; sel[(size_t)(b * SEQ + t0 + q) * TOPK + k] = (unsigned short)(k <= t0 + q ? k : 0); }
            ta = b * SEQ + 4 * (960 + i_); tb = b * SEQ + t0; }
        asm volatile("s_waitcnt vmcnt(0) lgkmcnt(0)" ::: "memory");
        ph_sparse_wave<true>(F, qlat, qr, ckv8, kr8, sel, ta, tb);
        asm volatile("s_waitcnt lgkmcnt(0)" ::: "memory");
    }
}

__global__ void __launch_bounds__(NTHR, 2) mega_fwd(Args args) {
    extern __shared__ __attribute__((aligned(16))) unsigned char lds_raw[];
    Frame F; F.lds = (LAS unsigned char*)lds_raw; F.tid = threadIdx.x; F.lane = F.tid & 63; F.wave = __builtin_amdgcn_readfirstlane(F.tid >> 6);
    F.G = gridDim.x; F.gw = blockIdx.x * NWAVES + F.wave; F.NGW = F.G * NWAVES;
    volatile LAS unsigned* MISC = (volatile LAS unsigned*)(F.lds + MISC_OFF);
    unsigned char* ws = args.ws;
    for (int u = F.tid; u < (LDS_BYTES - LDSCTL_OFF) / 4; u += NTHR) ((LAS unsigned*)(F.lds + LDSCTL_OFF))[u] = 0u;
    __syncthreads();
    XcdBarrier bar = xcd_barrier_post((unsigned*)(ws + OFF_CTL) + CW_BAR, MISC + 8);
    const int lo = args.ph_lo, hi = args.ph_hi;
#define IN(k) (lo <= (k) && (k) < hi)
#define SEAM(k) do { if (IN(k) && IN((k) + 1)) xcd_barrier(bar); } while (0)
    float* mod = (float*)(ws + OFF_MOD); float2* tab = (float2*)(ws + OFF_ROPE);
    h16* Hb = (h16*)(ws + OFF_H); h16* Ab = (h16*)(ws + OFF_A); float* Fb = (float*)(ws + OFF_F);

    if (IN(0)) {
        LAS float* scr = (LAS float*)(F.lds + F.wave * 16384);
        for (int ch = blockIdx.x; ch < (NMOD * DM) / 36; ch += F.G) {
            LAS float* sl = (LAS float*)(F.lds);
            LAS float* part = (LAS float*)(F.lds + 16384);
            __syncthreads();
            for (int i = F.tid; i < 4 * DM; i += NTHR) sl[i] = silu_f(args.in[1][i]);
            __syncthreads();
            const int ln = F.lane < 36 ? F.lane : 35;
            const float* wm = args.in[3] + (size_t)(F.wave * 128) * (NMOD * DM) + ch * 36 + ln;
            float a0 = 0.f, a1 = 0.f, a2 = 0.f, a3 = 0.f;
#pragma unroll 16
            for (int k = 0; k < 128; ++k) { const float w = wm[(size_t)k * (NMOD * DM)]; const int kk = F.wave * 128 + k; a0 += sl[kk] * w; a1 += sl[DM + kk] * w; a2 += sl[2 * DM + kk] * w; a3 += sl[3 * DM + kk] * w; }
            part[(F.wave * 4 + 0) * 64 + F.lane] = a0; part[(F.wave * 4 + 1) * 64 + F.lane] = a1; part[(F.wave * 4 + 2) * 64 + F.lane] = a2; part[(F.wave * 4 + 3) * 64 + F.lane] = a3;
            __syncthreads();
            if (F.tid < 256 && (F.tid & 63) < 36) { const int b = F.tid >> 6, l = F.tid & 63; float sm = args.in[4][ch * 36 + l];
#pragma unroll
                for (int w = 0; w < 8; ++w) sm += part[(w * 4 + b) * 64 + l];
                mod[b * (NMOD * DM) + ch * 36 + l] = sm; }
            __syncthreads();
        }
        for (int idx = blockIdx.x * NTHR + F.tid; idx < MT * 48; idx += F.G * NTHR) { const int tok = idx / 48, i = idx % 48;
            const float inv = (i < 32) ? powf(10000.f, -(float)i / 32.f) : powf(10000.f, -(float)(i - 32) / 16.f);
            const float ang = (float)((const int*)args.in[2])[tok] * inv; tab[idx] = make_float2(cosf(ang), sinf(ang)); }
        tr_job_mapped(F, args, 0, 2 * FF, 0, DM, (h16*)(ws + OW_GU1), nullptr, scr, 0);
        if (F.G != 256) {
            tr_job_plain(F, args.in[8], DM, DM, FF, (h16*)(ws + OW_D1), scr, 768);
            tr_job_mapped(F, args, 2, NIN3, 0, DM, (h16*)(ws + OW_IN), nullptr, scr, 128);
            tr_job_plain(F, args.in[11] + C_GATE, DIN, 2048, DM, (h16*)(ws + OW_GATE), scr, 1664);
            tr_job_mapped(F, args, 3, 512, 2048, QL, (h16*)(ws + OW_4), args.in[12], scr, 640);
            tr_job_plain(F, args.in[19], DM, DM, 256, (h16*)(ws + OW_UPB), scr, 736);
            tr_job_plain(F, args.in[20], DM, DM, DM, (h16*)(ws + OW_O), scr, 864);
            tr_job_mapped(F, args, 1, 2 * FF, 0, DM, (h16*)(ws + OW_GU2), nullptr, scr, 1376);
            tr_job_plain(F, args.in[25], DM, DM, FF, (h16*)(ws + OW_D2), scr, 96);
            precomb_tiles(F, args, ws, 0, 192, (int)blockIdx.x, F.G);
            tr_job_plain(F, args.in[18], DM, DM, 512, (h16*)(ws + OW_UPA), scr, 256);
        }
    }
    SEAM(0);
    if (IN(1)) ph_normmod(F, args.in[0], args.in[5], mod, 1, 0, Hb);
    SEAM(1);
    if (IN(2)) { pg8::Gemm g{Hb, (const h16*)(ws + OW_GU1), MT, 2 * FF, DM}; pg8::StaticOrder S; S.init(MT, 2 * FF, F.G, (int)blockIdx.x); pg8::EpiSwiGLU E{Ab};
        pg8::gemm_phase<pg8::EpiSwiGLU, true>(F.lds, g, S, E);
        if (F.G == 256 && blockIdx.x >= 128) {
            Frame F2 = F; F2.gw = ((int)blockIdx.x - 128) * NWAVES + F.wave; F2.NGW = 128 * NWAVES; LAS float* scr = (LAS float*)(F.lds + F.wave * 16384);
            tr_job_plain(F2, args.in[8], DM, DM, FF, (h16*)(ws + OW_D1), scr, 0);
            tr_job_mapped(F2, args, 2, NIN3, 0, DM, (h16*)(ws + OW_IN), nullptr, scr, 384);
            tr_job_mapped(F2, args, 3, 512, 2048, QL, (h16*)(ws + OW_4), args.in[12], scr, 896);
            tr_job_mapped(F2, args, 1, 2 * FF, 0, DM, (h16*)(ws + OW_GU2), nullptr, scr, 640);
            precomb_tiles(F, args, ws, 0, 192, (int)blockIdx.x - 128, 128);
            for (int i = ((int)blockIdx.x - 128) * NTHR + F.tid; i < (int)(MiB / 16); i += 128 * NTHR) ((u32x4*)(ws + OW_BD))[i] = (u32x4){0u, 0u, 0u, 0u}; } }
    SEAM(2);
    if (IN(3)) { pg8::Gemm g{Ab, (const h16*)(ws + OW_D1), MT, DM, FF}; pg8::StaticOrder S; S.init(MT, DM, F.G, (int)blockIdx.x); pg8::EpiH16 E{(h16*)Fb};
        pg8::gemm_phase<pg8::EpiH16, false>(F.lds, g, S, E); }
    SEAM(3);
    if (IN(4)) ph_resnorm<false, true>(F, args.in[0], (const h16*)Fb, args.in[9], mod, 2, 0.5f, args.out, true, args.in[10], 4, 3, Hb);
    SEAM(4);
    if (IN(5)) { pg8::Gemm g{Hb, (const h16*)(ws + OW_IN), MT, NIN3, DM}; pg8::StaticOrder S; S.init(MT, NIN3, F.G, (int)blockIdx.x);
        pg8::EpiIn E{(h16*)(ws + OFF_CKV), (h16*)(ws + OFF_CQ), (h16*)(ws + OFF_KR), (h16*)(ws + OFF_KI), (h16*)(ws + OFF_QB), (h16*)(ws + OFF_KB), (h16*)(ws + OFF_VT), (float*)(ws + OFF_WI), (float*)(ws + OFF_SSQ),
                     args.in[13], tab, (LAS float*)(F.lds + XCH_OFF)};
        pg8::gemm_phase<pg8::EpiIn, true>(F.lds, g, S, E); }
    SEAM(5);
    if (IN(6)) { for (int tk_ = blockIdx.x * NTHR + F.tid; tk_ < MT; tk_ += F.G * NTHR) { const f32x4 s0 = *(const f32x4*)((const float*)(ws + OFF_SSQ) + tk_ * 8), s1 = *(const f32x4*)((const float*)(ws + OFF_SSQ) + tk_ * 8 + 4);
            ((float*)(ws + OFF_RSTDQ))[tk_] = rsqrtf((((s0.x + s0.y) + (s0.z + s0.w)) + ((s1.x + s1.y) + (s1.z + s1.w))) * (1.f / QL) + EPS); } }
    if (IN(6)) ph_dilated_mfma(F, (const h16*)(ws + OFF_QB), (const h16*)(ws + OFF_KB), (const h16*)(ws + OFF_VT), (h16*)(ws + OFF_OG), (float*)(ws + OFF_LSE));
    SEAM(6);
    if (IN(7)) { pg8::Gemm g{(const h16*)(ws + OFF_CQ), (const h16*)(ws + OW_4), MT, N4, QL}; pg8::StaticOrder S; S.init(MT, N4, F.G, (int)blockIdx.x);
        pg8::Epi4 E{(h16*)(ws + OFF_QLAT), (h16*)(ws + OFF_QR), (h16*)(ws + OFF_QI), (const float*)(ws + OFF_RSTDQ), tab};
        pg8::gemm_phase<pg8::Epi4, true>(F.lds, g, S, E);
        if (F.G == 256 && blockIdx.x >= 128) {
            Frame F2 = F; F2.gw = ((int)blockIdx.x - 128) * NWAVES + F.wave; F2.NGW = 128 * NWAVES; LAS float* scr = (LAS float*)(F.lds + F.wave * 16384);
            tr_job_plain(F2, args.in[11] + C_GATE, DIN, 2048, DM, (h16*)(ws + OW_GATE), scr, 0);
            tr_job_plain(F2, args.in[19], DM, DM, 256, (h16*)(ws + OW_UPB), scr, 512);
            tr_job_plain(F2, args.in[20], DM, DM, DM, (h16*)(ws + OW_O), scr, 640);
            tr_job_plain(F2, args.in[18], DM, DM, 512, (h16*)(ws + OW_UPA), scr, 256);
            for (int it = F2.gw; it < 4 * 16; it += F2.NGW) { const int kb = it >> 4, nb = it & 15, n0 = nb * 32, hl = (n0 >> 6) & 3;
                tr_item(args.in[16], 512, n0 + (F.lane & 31), true, nullptr, kb * 64, (h16*)(ws + OW_BD) + (size_t)n0 * 1024 + 256 * hl, 1024, scr, F.lane); } } }
    SEAM(7);
    if (IN(8)) { ph_combine(F, (const h16*)(ws + OFF_OG), (const float*)(ws + OFF_LSE), (h16*)(ws + OFF_OB));
        ph_topk_sparse(F, (const h16*)(ws + OFF_QI), (const h16*)(ws + OFF_KI), (const float*)(ws + OFF_WI), (unsigned short*)(ws + OFF_SEL),
                       (h16*)(ws + OFF_QLAT), (const h16*)(ws + OFF_QR), (const unsigned char*)(ws + OFF_CKV), (const unsigned char*)(ws + OFF_KR)); }
    SEAM(8);
    if (IN(9) && F.G == 256) { const bool first = blockIdx.x < 128;
        pg8::Gemm g{first ? (const h16*)(ws + OFF_QLAT) : (const h16*)(ws + OFF_OB), first ? (const h16*)(ws + OW_BD) : (const h16*)(ws + OW_UPB), MT, first ? 512 : DM, first ? 1024 : 256, first ? 2048 : 0, first ? 1024 : 0};
        pg8::StaticOrder S; S.init(MT, first ? 512 : DM, 128, first ? (int)blockIdx.x : (int)blockIdx.x - 128);
        pg8::EpiH16 E{first ? (h16*)(ws + OFF_OA) : (h16*)(ws + OFF_Y2), first ? 512 : DM};
        pg8::gemm_phase<pg8::EpiH16, false>(F.lds, g, S, E); }
    SEAM(9);
    if (IN(10)) { pg8::StaticOrder S; S.init(MT, DM, F.G, (int)blockIdx.x); h16* Y1 = (h16*)(ws + OFF_Y1); h16* Y2 = (h16*)(ws + OFF_Y2);
        { pg8::Gemm g{(const h16*)(ws + OFF_OA), (const h16*)(ws + OW_UPA), MT, DM, 512}; pg8::EpiH16 E{Y1}; pg8::gemm_phase<pg8::EpiH16, false>(F.lds, g, S, E); }
        { pg8::Gemm g{Hb, (const h16*)(ws + OW_GATE), MT, DM, DM}; pg8::EpiGate E{Y1, Y1, 0}; pg8::gemm_phase<pg8::EpiGate, false>(F.lds, g, S, E); }
        { pg8::Gemm g{Hb, (const h16*)(ws + OW_GATE) + (size_t)DM * DM, MT, DM, DM}; pg8::EpiGate E{Y2, Y1, 1}; pg8::gemm_phase<pg8::EpiGate, false>(F.lds, g, S, E); } }
    SEAM(10);
    if (IN(11)) { pg8::Gemm g{(const h16*)(ws + OFF_Y1), (const h16*)(ws + OW_O), MT, DM, DM}; pg8::StaticOrder S; S.init(MT, DM, F.G, (int)blockIdx.x); pg8::EpiH16 E{(h16*)(ws + OFF_YF)};
        pg8::gemm_phase<pg8::EpiH16, false>(F.lds, g, S, E); }
    SEAM(11);
    if (IN(12)) ph_resnorm<true, true>(F, args.out, (const h16*)(ws + OFF_YF), args.in[21], mod, 5, 1.0f, ws + OFF_F, true, args.in[22], 7, 6, Hb);
    SEAM(12);
    if (IN(13)) { pg8::Gemm g{Hb, (const h16*)(ws + OW_GU2), MT, 2 * FF, DM}; pg8::StaticOrder S; S.init(MT, 2 * FF, F.G, (int)blockIdx.x); pg8::EpiSwiGLU E{Ab};
        pg8::gemm_phase<pg8::EpiSwiGLU, true>(F.lds, g, S, E);
        if (F.G == 256 && blockIdx.x >= 128) { Frame F2 = F; F2.gw = ((int)blockIdx.x - 128) * NWAVES + F.wave; F2.NGW = 128 * NWAVES;
            tr_job_plain(F2, args.in[25], DM, DM, FF, (h16*)(ws + OW_D2), (LAS float*)(F.lds + F.wave * 16384), 0); } }
    SEAM(13);
    if (IN(14)) { pg8::Gemm g{Ab, (const h16*)(ws + OW_D2), MT, DM, FF}; pg8::StaticOrder S; S.init(MT, DM, F.G, (int)blockIdx.x); pg8::EpiH16 E{(h16*)(ws + OFF_F + 32 * MiB)};
        pg8::gemm_phase<pg8::EpiH16, false>(F.lds, g, S, E); }
    SEAM(14);
    if (IN(15)) ph_resnorm<true, false>(F, ws + OFF_F, (const h16*)(ws + OFF_F + 32 * MiB), args.in[26], mod, 8, 0.5f, args.out, false, nullptr, 0, 0, nullptr);
#undef IN
#undef SEAM
}


extern "C" void kernel_launch(void* const* d_in, const int* in_sizes, int n_in, void* d_out, int out_size, void* d_ws, size_t ws_size, hipStream_t stream) {
    if (n_in != 27 || ws_size < WS_END || out_size != MT * DM) { fprintf(stderr, "kernel_launch: unexpected shapes (n_in %d ws %zu out %d)\n", n_in, ws_size, out_size); return; }
    static int grid = 0;
    if (grid == 0) {
        int dev = 0, cus = 0, per_cu = 0;
        if (hipGetDevice(&dev) != hipSuccess || hipDeviceGetAttribute(&cus, hipDeviceAttributeMultiprocessorCount, dev) != hipSuccess) { grid = -1; return; }
        if (hipFuncSetAttribute((const void*)mega_fwd, hipFuncAttributeMaxDynamicSharedMemorySize, LDS_BYTES) != hipSuccess) { fprintf(stderr, "kernel_launch: hipFuncSetAttribute failed\n"); grid = -1; return; }
        if (hipOccupancyMaxActiveBlocksPerMultiprocessor(&per_cu, (const void*)mega_fwd, NTHR, LDS_BYTES) != hipSuccess || per_cu < 1) { fprintf(stderr, "kernel_launch: occupancy query says %d blocks/CU\n", per_cu); grid = -1; return; }
        grid = cus;
    }
    if (grid < 0) return;
    hipMemsetAsync((char*)d_ws + OFF_CTL, 0, 1 * MiB, stream);
    Args a{}; for (int i = 0; i < 27; ++i) a.in[i] = (const float*)d_in[i]; a.out = (float*)d_out; a.ws = (unsigned char*)d_ws; a.ph_lo = 0; a.ph_hi = 16;
    void* kargs[] = {&a};
#ifdef PH_DOUBLE
    a.ph_hi = PH_DOUBLE + 1; (void)hipLaunchCooperativeKernel((const void*)mega_fwd, dim3(grid), dim3(NTHR), kargs, LDS_BYTES, stream);
    hipMemsetAsync((char*)d_ws + OFF_CTL, 0, 1 * MiB, stream); a.ph_lo = PH_DOUBLE; a.ph_hi = 16;
#endif
    const hipError_t e = hipLaunchCooperativeKernel((const void*)mega_fwd, dim3(grid), dim3(NTHR), kargs, LDS_BYTES, stream);
    if (e != hipSuccess) fprintf(stderr, "kernel_launch: cooperative launch failed: %s (grid %d)\n", hipGetErrorString(e), grid);
    (void)in_sizes;
}
```

```cpp
#include <hip/hip_runtime.h>
#include <hip/hip_fp16.h>
#include <cstdio>
#include <cstdint>

constexpr int NB = 4, SEQ = 4096, DM = 1024, MT = NB * SEQ, FF = 2816;
constexpr int QL = 384, KVL = 256, DNOPE = 64, DROPE = 32, DVA = 64, HA = 8, HI = 8, DI = 32, TOPK = 256;
constexpr int NG = 3, HB = 4, DHB = 64, NMOD = 9, DIN = 5064;
constexpr int C_CQ = 0, C_CKV = 384, C_KR = 640, C_KI = 672, C_WI = 704, C_QKV = 712, C_GATE = 3016;
constexpr float EPS = 1e-6f, LOG2E = 1.4426950408889634f;
typedef _Float16 h16;

constexpr size_t MiB = 1u << 20;
constexpr size_t OFF_CTL = 0, OFF_MOD = 1 * MiB, OFF_ROPE = 2 * MiB, OFF_W = 8 * MiB, OFF_H = 60 * MiB, OFF_A = 92 * MiB, OFF_F = 180 * MiB, OFF_SP = 244 * MiB, WS_END = 256 * MiB;
constexpr size_t OFF_QB = OFF_A, OFF_KB = OFF_A + 24 * MiB, OFF_VT = OFF_A + 48 * MiB, OFF_CKV = OFF_A + 72 * MiB, OFF_KR = OFF_A + 80 * MiB, OFF_KI = OFF_A + 81 * MiB,
                 OFF_WI = OFF_A + 82 * MiB, OFF_SSQ = OFF_A + 82 * MiB + 512 * 1024, OFF_CQ = OFF_SP;
constexpr size_t OFF_RSTDQ = OFF_A + 83 * MiB;
constexpr size_t OFF_OG = OFF_F, OFF_LSE = OFF_F + 24 * MiB, OFF_QLAT = OFF_A, OFF_QR = OFF_A + 64 * MiB, OFF_QI = OFF_F + 25 * MiB, OFF_SEL = OFF_F + 33 * MiB, OFF_OB = OFF_SP;
constexpr size_t OFF_Y1 = OFF_F, OFF_Y2 = OFF_F + 32 * MiB, OFF_YF = OFF_A;

__device__ __forceinline__ float silu_f(float v) { return v / (1.f + __expf(-v)); }
__device__ __forceinline__ float sigm_f(float v) { return 1.f / (1.f + __expf(-v)); }
__host__ __device__ __forceinline__ int dil_of(int g) { return g == 0 ? 1 : (g == 1 ? 4 : 16); }
__device__ __forceinline__ unsigned fkey(float f) { const unsigned u = __float_as_uint(f); return (u & 0x80000000u) ? ~u : (u | 0x80000000u); }


#define LAS __attribute__((address_space(3)))
#define GAS __attribute__((address_space(1)))
typedef _Float16 f16x8 __attribute__((ext_vector_type(8)));
typedef float f32x4 __attribute__((ext_vector_type(4)));
typedef float f32x2 __attribute__((ext_vector_type(2)));
typedef unsigned u32x4 __attribute__((ext_vector_type(4)));
typedef unsigned u32x2 __attribute__((ext_vector_type(2)));
typedef _Float16 h16x2 __attribute__((ext_vector_type(2)));
__device__ __forceinline__ unsigned pk_h2(float lo, float hi) { f32x2 v = {lo, hi}; h16x2 h = __builtin_convertvector(v, h16x2); return __builtin_bit_cast(unsigned, h); }
__device__ __forceinline__ int flane() { int l; asm volatile("v_mbcnt_lo_u32_b32 %0, -1, 0\n\tv_mbcnt_hi_u32_b32 %0, -1, %0" : "=v"(l)); return l; }
__device__ __forceinline__ float sat8(float x) { return __builtin_amdgcn_fmed3f(x, -448.f, 448.f); }
__device__ __forceinline__ unsigned pk_f8x4(float a, float b, float c, float d) { int w = __builtin_amdgcn_cvt_pk_fp8_f32(sat8(a), sat8(b), 0, false); w = __builtin_amdgcn_cvt_pk_fp8_f32(sat8(c), sat8(d), w, true); return (unsigned)w; }
typedef int i32x4 __attribute__((ext_vector_type(4)));
typedef int i32x8 __attribute__((ext_vector_type(8)));
constexpr float F8_ACT = 8.f, F8_WGT = 512.f, F8_INV = 1.f / (F8_ACT * F8_WGT);

namespace pg8 {
constexpr int BM = 256, BK = 64, HALF = 128, HTB = HALF * BK * 2, STAGE_BYTES = 8 * HTB, NXCD = 8, WGM = 8;
__host__ __device__ __forceinline__ int lds_byte(int r, int c) { const int st = (r >> 4) * 2 + (c >> 5), rr = r & 15, cc = c & 31, ob = rr * 64 + cc * 2; return st * 1024 + (ob ^ (((ob >> 9) & 1) << 5)); }
__host__ __device__ __forceinline__ void stage_rc(int b, int& R, int& C) { const int st = b / 1024, sb = b % 1024, swz = sb ^ (((sb >> 9) & 1) << 5); R = (st >> 1) * 16 + swz / 64; C = (st & 1) * 32 + (swz % 64) / 2; }
__host__ __device__ __forceinline__ int perm32(int rho) { const int n = rho >> 4, i = rho & 15; return 8 * (i >> 2) + 4 * n + (i & 3); }
struct Unit { int pm, pn; };
struct Gemm { const h16* A; const h16* Bt; int M, N, K; int lda = 0, koffA = 0; };
struct StaticOrder {
    int nM, nN, nwg, G, c;
    __host__ __device__ void init(int M, int N, int G_, int c_) { nM = M / BM; nN = N / BM; nwg = nM * nN; G = G_; c = c_; }
    __host__ __device__ bool next(int i, Unit& u) const {
        const long L = (long)i * G + c; if (L >= nwg) return false;
        int wgid = (int)L; { const int q = nwg / NXCD, r = nwg % NXCD, xcd = wgid % NXCD, off = wgid / NXCD; wgid = (xcd < r ? xcd * (q + 1) : r * (q + 1) + (xcd - r) * q) + off; }
        const int nig = WGM * nN, gid = wgid / nig, fm = gid * WGM, gsz = (nM - fm) < WGM ? (nM - fm) : WGM;
        u.pm = fm + ((wgid % nig) % gsz); u.pn = (wgid % nig) / gsz; return true;
    }
};
template <class Epi, bool ALIGN_EPI, bool F8 = false>
__device__ __forceinline__ void gemm_phase(LAS unsigned char* lds, const Gemm g, const StaticOrder& S, const Epi& E) {
    const int tid = threadIdx.x, wid = __builtin_amdgcn_readfirstlane(tid >> 6), lane = tid & 63, wr = wid >> 2, wc = wid & 3, fr = lane & 15, fq = lane >> 4;
    const int K = g.K, lda = g.lda ? g.lda : g.K; int nt = K / BK;
    if constexpr (F8) asm volatile("" : "+s"(nt));
    unsigned voffA[2], voffB[2];
#pragma unroll
    for (int i = 0; i < 2; ++i) { int R, C; stage_rc(tid * 16 + i * 8192, R, C); const int Rb = Epi::PERM ? ((R & ~31) + perm32(R & 31)) : R;
        voffA[i] = (unsigned)(R * lda + C) * 2u; voffB[i] = (unsigned)(Rb * K + C) * 2u; }
    const size_t kstep = (size_t)(BK * 2);
    const size_t hstep = (size_t)HALF * K * 2, hstepA = (size_t)HALF * lda * 2;
    const size_t tstep = 2 * hstep, tstepA = 2 * hstepA, kofA = (size_t)g.koffA * 2;
    const unsigned ldsw = (unsigned)wid * 1024u;
    const int aoff = lds_byte(wr * 64 + fr, fq * 8), boff = lds_byte(wc * 32 + fr, fq * 8);
#define PG8_SA(b, h) (((b) * 2 + (h)) * HTB)
#define PG8_SB(b, h) ((4 + (b) * 2 + (h)) * HTB)
#define PG8_STAGE(bufoff, gbase, voff) do { _Pragma("unroll") for (int _i = 0; _i < 2; ++_i) { unsigned _vo = (voff)[_i]; asm volatile("" : "+v"(_vo)); \
        __builtin_amdgcn_global_load_lds((const unsigned*)((const char*)(gbase) + _vo), (LAS unsigned*)(lds + (bufoff) + ldsw + _i * 8192), 16, 0, 0); } } while (0)
#define PG8_LDA(dst, b, h) do { _Pragma("unroll") for (int m = 0; m < 4; ++m) _Pragma("unroll") for (int k = 0; k < 2; ++k) dst[m][k] = *(const LAS f16x8*)(lds + PG8_SA(b, h) + aoff + m * 2048 + k * 1024); } while (0)
#define PG8_LDB(dst, b, h) do { _Pragma("unroll") for (int n = 0; n < 2; ++n) _Pragma("unroll") for (int k = 0; k < 2; ++k) dst[n][k] = *(const LAS f16x8*)(lds + PG8_SB(b, h) + boff + n * 2048 + k * 1024); } while (0)
#define PG8_CAT8(x, y) __builtin_shufflevector(__builtin_bit_cast(i32x4, x), __builtin_bit_cast(i32x4, y), 0, 1, 2, 3, 4, 5, 6, 7)
#define PG8_MMA(ai, bj, At, Bt) do { __builtin_amdgcn_s_setprio(1); \
        if constexpr (F8) { _Pragma("unroll") for (int m = 0; m < 4; ++m) _Pragma("unroll") for (int n = 0; n < 2; ++n) \
            acc[ai][bj][m][n] = __builtin_amdgcn_mfma_scale_f32_16x16x128_f8f6f4(PG8_CAT8(Bt[n][0], Bt[n][1]), PG8_CAT8(At[m][0], At[m][1]), acc[ai][bj][m][n], 0, 0, 0, 0, 0, 0); } \
        else { _Pragma("unroll") for (int m = 0; m < 4; ++m) _Pragma("unroll") for (int n = 0; n < 2; ++n) _Pragma("unroll") for (int k = 0; k < 2; ++k) \
            acc[ai][bj][m][n] = __builtin_amdgcn_mfma_f32_16x16x32_f16(Bt[n][k], At[m][k], acc[ai][bj][m][n], 0, 0, 0); } \
        __builtin_amdgcn_s_setprio(0); } while (0)
#define PG8_WAIT_V(n) asm volatile("s_waitcnt vmcnt(" #n ")" ::: "memory")
#define PG8_WAIT_L(n) asm volatile("s_waitcnt lgkmcnt(" #n ")" ::: "memory")
#define PG8_BAR __builtin_amdgcn_s_barrier()
#define PG8_SCHED __builtin_amdgcn_sched_barrier(0)
    Unit cur, nxt; int ui = 0;
    if (!S.next(0, cur)) return;
    f32x4 acc[2][2][4][2];
#pragma unroll
    for (int a = 0; a < 2; ++a)
#pragma unroll
        for (int b = 0; b < 2; ++b)
#pragma unroll
            for (int m = 0; m < 4; ++m)
#pragma unroll
                for (int n = 0; n < 2; ++n) acc[a][b][m][n] = (f32x4){0.f, 0.f, 0.f, 0.f};
    f16x8 At[4][2], B0[2][2], B1[2][2];
    const char* cA = (const char*)g.A + (size_t)cur.pm * tstepA + (size_t)cur.pn * kofA; const char* cB = (const char*)g.Bt + (size_t)cur.pn * tstep;
    PG8_STAGE(PG8_SB(0, 0), cB, voffB); PG8_STAGE(PG8_SB(0, 1), cB + hstep, voffB); PG8_STAGE(PG8_SA(0, 0), cA, voffA); PG8_STAGE(PG8_SA(0, 1), cA + hstepA, voffA);
    if (wr == 1) PG8_BAR;
    PG8_WAIT_V(2); PG8_BAR;
    PG8_STAGE(PG8_SB(1, 0), cB + kstep, voffB); PG8_STAGE(PG8_SA(1, 0), cA + kstep, voffA); PG8_STAGE(PG8_SB(1, 1), cB + hstep + kstep, voffB);
    PG8_WAIT_V(6); PG8_BAR;
    for (;;) {
        const bool has_next = S.next(ui + 1, nxt);
        const char* nA = has_next ? (const char*)g.A + (size_t)nxt.pm * tstepA + (size_t)nxt.pn * kofA : cA; const char* nB = has_next ? (const char*)g.Bt + (size_t)nxt.pn * tstep : cB;
        for (int t = 0; t < nt; t += 2) {
            const bool last = (t == nt - 2);
            const char* a1 = cA + (size_t)(t + 1) * kstep;
            const char* a2 = last ? nA : cA + (size_t)(t + 2) * kstep; const char* b2 = last ? nB : cB + (size_t)(t + 2) * kstep;
            const char* a3 = a2 + kstep; const char* b3 = b2 + kstep;
            PG8_LDB(B0, 0, 0); PG8_LDB(B1, 0, 1); PG8_SCHED; PG8_LDA(At, 0, 0); PG8_STAGE(PG8_SA(1, 1), a1 + hstepA, voffA);
            PG8_WAIT_V(8); PG8_WAIT_L(0); PG8_BAR; PG8_MMA(0, 0, At, B0); PG8_MMA(0, 1, At, B1); PG8_BAR; PG8_SCHED;
            PG8_LDA(At, 0, 1); PG8_STAGE(PG8_SB(0, 0), b2, voffB); PG8_STAGE(PG8_SB(0, 1), b2 + hstep, voffB); PG8_STAGE(PG8_SA(0, 0), a2, voffA);
            PG8_WAIT_V(8); PG8_WAIT_L(0); PG8_BAR; PG8_MMA(1, 0, At, B0); PG8_MMA(1, 1, At, B1); PG8_BAR; PG8_SCHED;
            PG8_LDB(B0, 1, 0); PG8_LDB(B1, 1, 1); PG8_SCHED; PG8_LDA(At, 1, 0); PG8_STAGE(PG8_SA(0, 1), a2 + hstepA, voffA);
            PG8_WAIT_V(8); PG8_WAIT_L(0); PG8_BAR; PG8_MMA(0, 0, At, B0); PG8_MMA(0, 1, At, B1); PG8_BAR; PG8_SCHED;
            PG8_LDA(At, 1, 1); PG8_STAGE(PG8_SB(1, 0), b3, voffB); PG8_STAGE(PG8_SB(1, 1), b3 + hstep, voffB); PG8_STAGE(PG8_SA(1, 0), a3, voffA);
            PG8_WAIT_V(8); PG8_WAIT_L(0); PG8_BAR; PG8_MMA(1, 0, At, B0); PG8_MMA(1, 1, At, B1); PG8_BAR; PG8_SCHED;
        }
        if constexpr (ALIGN_EPI) { if (wr == 0) PG8_BAR; }
        { const int l2 = flane(); E(acc, cur, wr, wc, l2 & 15, l2 >> 4); }
        if (!has_next) break;
#pragma unroll
        for (int a = 0; a < 2; ++a)
#pragma unroll
            for (int b = 0; b < 2; ++b)
#pragma unroll
                for (int m = 0; m < 4; ++m)
#pragma unroll
                    for (int n = 0; n < 2; ++n) acc[a][b][m][n] = (f32x4){0.f, 0.f, 0.f, 0.f};
        cur = nxt; cA = nA; cB = nB; ++ui;
        if constexpr (ALIGN_EPI) { if (wr == 1) PG8_BAR; }
    }
    PG8_WAIT_V(0);
    if constexpr (!ALIGN_EPI) { if (wr == 0) PG8_BAR; }
    PG8_BAR;
#undef PG8_SA
#undef PG8_SB
#undef PG8_STAGE
#undef PG8_LDA
#undef PG8_LDB
#undef PG8_MMA
#undef PG8_CAT8
#undef PG8_WAIT_V
#undef PG8_WAIT_L
#undef PG8_BAR
#undef PG8_SCHED
}
struct EpiF32 {
    static constexpr bool PERM = false;
    float* C; int ldc;
    __device__ __forceinline__ void operator()(const f32x4 (&acc)[2][2][4][2], const Unit& u, int wr, int wc, int fr, int fq) const {
        const int row0 = u.pm * BM + wr * 64 + fr, col0 = u.pn * BM + wc * 32 + 4 * fq;
#pragma unroll
        for (int ai = 0; ai < 2; ++ai)
#pragma unroll
            for (int m = 0; m < 4; ++m) { float* rowp = C + (size_t)(row0 + ai * HALF + m * 16) * ldc + col0;
#pragma unroll
                for (int bj = 0; bj < 2; ++bj)
#pragma unroll
                    for (int n = 0; n < 2; ++n) *(f32x4*)(rowp + bj * HALF + n * 16) = acc[ai][bj][m][n]; }
    }
};
template <bool F8>
struct EpiSwiGLU_T {
    static constexpr bool PERM = true;
    void* O;
    __device__ __forceinline__ void operator()(const f32x4 (&acc)[2][2][4][2], const Unit& u, int wr, int wc, int fr, int fq) const {
        const int row0 = u.pm * BM + wr * 64 + fr, col0 = u.pn * HALF + wc * 32 + 8 * fq;
#pragma unroll
        for (int ai = 0; ai < 2; ++ai)
#pragma unroll
            for (int m = 0; m < 4; ++m) { const size_t eo = (size_t)(row0 + ai * HALF + m * 16) * FF + col0;
                float v[8];
#pragma unroll
                for (int n = 0; n < 2; ++n)
#pragma unroll
                    for (int e = 0; e < 4; ++e) { float gg = acc[ai][0][m][n][e], uu = acc[ai][1][m][n][e]; if constexpr (F8) { gg *= F8_INV; uu *= F8_INV * F8_ACT; }
                        v[n * 4 + e] = gg * __builtin_amdgcn_rcpf(1.f + __builtin_amdgcn_exp2f(-gg * LOG2E)) * uu; }
                if constexpr (F8) { u32x2 w; w.x = pk_f8x4(v[0], v[1], v[2], v[3]); w.y = pk_f8x4(v[4], v[5], v[6], v[7]); *(u32x2*)((unsigned char*)O + eo) = w; }
                else { u32x4 w; w.x = pk_h2(v[0], v[1]); w.y = pk_h2(v[2], v[3]); w.z = pk_h2(v[4], v[5]); w.w = pk_h2(v[6], v[7]); *(u32x4*)((h16*)O + eo) = w; } }
    }
};
typedef EpiSwiGLU_T<false> EpiSwiGLU;

struct EpiIn {
    static constexpr bool PERM = false;
    h16 *ckv, *cq, *kr, *ki, *qb, *kb, *vT; float *wi, *ssq; const float* gckv; const float2* tab; LAS float* X;
    __device__ __forceinline__ void rope64(const f32x4 (&acc)[2][2][4][2], const Unit& u, int wr, int wc, int fr, int fq, h16* dst, int tl, float scale) const {
        const int tok0 = u.pm * BM + wr * 64 + fr;
        f32x4 tc[4], tn[4];
        { const f32x4* tp = (const f32x4*)(tab + (size_t)tok0 * 48 + 4 * fq); tc[0] = tp[0]; tc[1] = tp[1]; tc[2] = tp[8]; tc[3] = tp[9]; }
#pragma unroll
        for (int rr = 0; rr < 8; ++rr) { const int ai = rr >> 2, m = rr & 3, tok = tok0 + ai * HALF + m * 16;
            if (rr < 7) { const int tokn = tok0 + ((rr + 1) >> 2) * HALF + ((rr + 1) & 3) * 16; const f32x4* tp = (const f32x4*)(tab + (size_t)tokn * 48 + 4 * fq); tn[0] = tp[0]; tn[1] = tp[1]; tn[2] = tp[8]; tn[3] = tp[9]; }
#pragma unroll
            for (int n = 0; n < 2; ++n) { const int i = 16 * n + 4 * fq; const f32x4 t0 = tc[2 * n], t1 = tc[2 * n + 1];
                const f32x4 cs = {t0.x, t0.z, t1.x, t1.z}, sn = {t0.y, t0.w, t1.y, t1.w}, x1 = acc[ai][0][m][n], x2 = acc[ai][1][m][n];
                const f32x4 o1 = (x1 * cs - x2 * sn) * scale, o2 = (x2 * cs + x1 * sn) * scale;
                h16* p = dst + (size_t)tok * 768 + (4 * tl + wc) * 64 + i;
                u32x2 w1, w2; w1.x = pk_h2(o1.x, o1.y); w1.y = pk_h2(o1.z, o1.w); w2.x = pk_h2(o2.x, o2.y); w2.y = pk_h2(o2.z, o2.w);
                *(u32x2*)p = w1; *(u32x2*)(p + 32) = w2; }
#pragma unroll
            for (int k = 0; k < 4; ++k) tc[k] = tn[k];
            asm volatile("" ::: "memory"); }
    }
    __device__ __forceinline__ void operator()(const f32x4 (&acc)[2][2][4][2], const Unit& u, int wr, int wc, int fr, int fq) const {
        const int pn = u.pn;
        if (pn == 0) {
#pragma unroll
            for (int ai = 0; ai < 2; ++ai)
#pragma unroll
                for (int m = 0; m < 4; ++m) { float sq = 0.f;
#pragma unroll
                    for (int bj = 0; bj < 2; ++bj)
#pragma unroll
                        for (int n = 0; n < 2; ++n) { const f32x4 v = acc[ai][bj][m][n]; sq += (v.x * v.x + v.y * v.y) + (v.z * v.z + v.w * v.w); }
                    sq += __shfl_xor(sq, 16); sq += __shfl_xor(sq, 32);
                    if (fq == 0) X[(ai * HALF + wr * 64 + m * 16 + fr) * 4 + wc] = sq; }
            asm volatile("s_waitcnt lgkmcnt(0)" ::: "memory"); __builtin_amdgcn_s_barrier(); asm volatile("" ::: "memory");
#pragma unroll
            for (int ai = 0; ai < 2; ++ai)
#pragma unroll
                for (int m = 0; m < 4; ++m) { const int rl = ai * HALF + wr * 64 + m * 16 + fr, tok = u.pm * BM + rl; const f32x4 p = *(const LAS f32x4*)(X + rl * 4);
                    const float rstd = rsqrtf(((p.x + p.y) + (p.z + p.w)) * (1.f / KVL) + EPS);
#pragma unroll
                    for (int bj = 0; bj < 2; ++bj)
#pragma unroll
                        for (int n = 0; n < 2; ++n) { const int col = bj * HALF + wc * 32 + n * 16 + 4 * fq; const f32x4 o = acc[ai][bj][m][n] * rstd * *(const f32x4*)(gckv + col);
                            int w8 = __builtin_amdgcn_cvt_pk_fp8_f32(o.x, o.y, 0, false); w8 = __builtin_amdgcn_cvt_pk_fp8_f32(o.z, o.w, w8, true);
                            *(int*)((unsigned char*)ckv + (size_t)tok * KVL + col) = w8; }
                    asm volatile("" ::: "memory"); }
            asm volatile("s_waitcnt lgkmcnt(0)" ::: "memory"); __builtin_amdgcn_s_barrier(); asm volatile("" ::: "memory");
        } else if (pn <= 2) {
#pragma unroll
            for (int ai = 0; ai < 2; ++ai)
#pragma unroll
                for (int m = 0; m < 4; ++m) { const int tok = u.pm * BM + ai * HALF + wr * 64 + m * 16 + fr; float sq = 0.f;
#pragma unroll
                    for (int bj = 0; bj < 2; ++bj) { if (pn == 2 && bj == 1) break;
#pragma unroll
                        for (int n = 0; n < 2; ++n) { const f32x4 v = acc[ai][bj][m][n]; sq += (v.x * v.x + v.y * v.y) + (v.z * v.z + v.w * v.w);
                            const int col = (pn - 1) * 256 + bj * HALF + wc * 32 + n * 16 + 4 * fq; u32x2 w; w.x = pk_h2(v.x, v.y); w.y = pk_h2(v.z, v.w); *(u32x2*)(cq + (size_t)tok * QL + col) = w; } }
                    sq += __shfl_xor(sq, 16); sq += __shfl_xor(sq, 32);
                    if (fq == 0) ssq[tok * 8 + (pn - 1) * 4 + wc] = sq;
                    if (pn == 2) {
                        if (wc < 2) { const int i = 4 * fq; const f32x4* tp = (const f32x4*)(tab + (size_t)tok * 48 + 32 + i); const f32x4 t0 = tp[0], t1 = tp[1];
                            const f32x4 cs = {t0.x, t0.z, t1.x, t1.z}, sn = {t0.y, t0.w, t1.y, t1.w}, x1 = acc[ai][1][m][0], x2 = acc[ai][1][m][1];
                            const f32x4 o1 = x1 * cs - x2 * sn, o2 = x2 * cs + x1 * sn;
                            if (wc == 0) { unsigned char* p8 = (unsigned char*)kr + (size_t)tok * 32 + i;
                                int a8 = __builtin_amdgcn_cvt_pk_fp8_f32(o1.x, o1.y, 0, false); a8 = __builtin_amdgcn_cvt_pk_fp8_f32(o1.z, o1.w, a8, true);
                                int b8 = __builtin_amdgcn_cvt_pk_fp8_f32(o2.x, o2.y, 0, false); b8 = __builtin_amdgcn_cvt_pk_fp8_f32(o2.z, o2.w, b8, true);
                                *(int*)p8 = a8; *(int*)(p8 + 16) = b8; }
                            else { h16* p = ki + (size_t)tok * 32 + i;
                                u32x2 w1, w2; w1.x = pk_h2(o1.x, o1.y); w1.y = pk_h2(o1.z, o1.w); w2.x = pk_h2(o2.x, o2.y); w2.y = pk_h2(o2.z, o2.w);
                                *(u32x2*)p = w1; *(u32x2*)(p + 16) = w2; } }
                        else if (wc == 2 && fq < 2) { *(f32x4*)(wi + tok * 8 + 4 * fq) = acc[ai][1][m][0] * 0.35355339059327373f; }
                    }
                    asm volatile("" ::: "memory"); }
        } else if (pn <= 5) rope64(acc, u, wr, wc, fr, fq, qb, pn - 3, 0.125f * LOG2E);
        else if (pn <= 8) rope64(acc, u, wr, wc, fr, fq, kb, pn - 6, 1.0f);
        else {
#pragma unroll
            for (int ai = 0; ai < 2; ++ai)
#pragma unroll
                for (int m = 0; m < 4; ++m) { const int tok = u.pm * BM + ai * HALF + wr * 64 + m * 16 + fr;
#pragma unroll
                    for (int bj = 0; bj < 2; ++bj)
#pragma unroll
                        for (int n = 0; n < 2; ++n) { const f32x4 v = acc[ai][bj][m][n]; u32x2 w; w.x = pk_h2(v.x, v.y); w.y = pk_h2(v.z, v.w);
                            *(u32x2*)(vT + (size_t)tok * 768 + (pn - 9) * 256 + bj * HALF + wc * 32 + n * 16 + 4 * fq) = w; }
                    asm volatile("" ::: "memory"); }
        }
    }
};
struct Epi4 {
    static constexpr bool PERM = true;
    h16 *qlat, *qr, *qi; const float* rstdq; const float2* tab;
    __device__ __forceinline__ void operator()(const f32x4 (&acc)[2][2][4][2], const Unit& u, int wr, int wc, int fr, int fq) const {
        const int pn = u.pn; const float c2 = 0.10206207261596575f * LOG2E;
        const int tok0 = u.pm * BM + wr * 64 + fr;
        float rc = rstdq[tok0], rn = 0.f;
        if (pn < 8) {
#pragma unroll
            for (int rr = 0; rr < 8; ++rr) { const int ai = rr >> 2, m = rr & 3, tok = tok0 + ai * HALF + m * 16;
                if (rr < 7) rn = rstdq[tok0 + ((rr + 1) >> 2) * HALF + ((rr + 1) & 3) * 16];
#pragma unroll
                for (int bj = 0; bj < 2; ++bj) { const f32x4 o0 = acc[ai][bj][m][0] * (rc * c2), o1 = acc[ai][bj][m][1] * (rc * c2);
                    u32x4 w; w.x = pk_h2(o0.x, o0.y); w.y = pk_h2(o0.z, o0.w); w.z = pk_h2(o1.x, o1.y); w.w = pk_h2(o1.z, o1.w);
                    *(u32x4*)(qlat + (size_t)tok * 2048 + pn * 256 + bj * HALF + wc * 32 + 8 * fq) = w; }
                rc = rn; asm volatile("" ::: "memory"); }
        } else { h16* dst = (pn == 8) ? qr : qi; const float c2e = (pn == 8) ? c2 : 1.f; const int i = 4 * fq;
            f32x4 tc[2], tn[2];
            { const f32x4* tp = (const f32x4*)(tab + (size_t)tok0 * 48 + 32 + i); tc[0] = tp[0]; tc[1] = tp[1]; }
#pragma unroll
            for (int rr = 0; rr < 8; ++rr) { const int ai = rr >> 2, m = rr & 3, tok = tok0 + ai * HALF + m * 16;
                if (rr < 7) { const int tokn = tok0 + ((rr + 1) >> 2) * HALF + ((rr + 1) & 3) * 16; const f32x4* tp = (const f32x4*)(tab + (size_t)tokn * 48 + 32 + i); tn[0] = tp[0]; tn[1] = tp[1]; rn = rstdq[tokn]; }
                const f32x4 cs = {tc[0].x, tc[0].z, tc[1].x, tc[1].z}, sn = {tc[0].y, tc[0].w, tc[1].y, tc[1].w}; const float sc = rc * c2e;
#pragma unroll
                for (int bj = 0; bj < 2; ++bj) { const f32x4 x1 = acc[ai][bj][m][0], x2 = acc[ai][bj][m][1]; const f32x4 o1 = (x1 * cs - x2 * sn) * sc, o2 = (x2 * cs + x1 * sn) * sc;
                    h16* p = dst + (size_t)tok * 256 + (4 * bj + wc) * 32 + i;
                    u32x2 w1, w2; w1.x = pk_h2(o1.x, o1.y); w1.y = pk_h2(o1.z, o1.w); w2.x = pk_h2(o2.x, o2.y); w2.y = pk_h2(o2.z, o2.w);
                    *(u32x2*)p = w1; *(u32x2*)(p + 16) = w2; }
                tc[0] = tn[0]; tc[1] = tn[1]; rc = rn;
                asm volatile("" ::: "memory"); } }
    }
};
__device__ __forceinline__ u32x4 ld16_l2(const h16* p) {
    const unsigned long long a = __hip_atomic_load((const unsigned long long*)p, __ATOMIC_RELAXED, __HIP_MEMORY_SCOPE_AGENT), b = __hip_atomic_load((const unsigned long long*)p + 1, __ATOMIC_RELAXED, __HIP_MEMORY_SCOPE_AGENT);
    return (u32x4){(unsigned)a, (unsigned)(a >> 32), (unsigned)b, (unsigned)(b >> 32)};
}
typedef _Float16 h16x8 __attribute__((ext_vector_type(8)));
__device__ __forceinline__ void unpk8(const u32x4 w, float (&f)[8]) {
    const h16x8 h = __builtin_bit_cast(h16x8, w);
#pragma unroll
    for (int i = 0; i < 8; ++i) f[i] = (float)h[i];
}
template <bool SC>
struct EpiH16_T {
    static constexpr bool PERM = true;
    h16* O; int ldc = DM;
    __device__ __forceinline__ void operator()(const f32x4 (&acc)[2][2][4][2], const Unit& u, int wr, int wc, int fr, int fq) const {
        const int row0 = u.pm * BM + wr * 64 + fr, col0 = u.pn * BM + wc * 32 + 8 * fq;
#pragma unroll
        for (int ai = 0; ai < 2; ++ai)
#pragma unroll
            for (int m = 0; m < 4; ++m)
#pragma unroll
                for (int bj = 0; bj < 2; ++bj) { f32x4 v0 = acc[ai][bj][m][0], v1 = acc[ai][bj][m][1]; if constexpr (SC) { v0 *= F8_INV; v1 *= F8_INV; }
                    u32x4 w; w.x = pk_h2(v0.x, v0.y); w.y = pk_h2(v0.z, v0.w); w.z = pk_h2(v1.x, v1.y); w.w = pk_h2(v1.z, v1.w);
                    *(u32x4*)(O + (size_t)(row0 + ai * HALF + m * 16) * ldc + col0 + bj * HALF) = w; }
    }
};
typedef EpiH16_T<false> EpiH16;
struct EpiGate {
    static constexpr bool PERM = true;
    const h16* Y; h16* Z; int accum;
    __device__ __forceinline__ void operator()(const f32x4 (&acc)[2][2][4][2], const Unit& u, int wr, int wc, int fr, int fq) const {
        const int row0 = u.pm * BM + wr * 64 + fr, col0 = u.pn * BM + wc * 32 + 8 * fq;
#pragma unroll
        for (int ai = 0; ai < 2; ++ai)
#pragma unroll
            for (int m = 0; m < 4; ++m)
#pragma unroll
                for (int bj = 0; bj < 2; ++bj) { const size_t off = (size_t)(row0 + ai * HALF + m * 16) * DM + col0 + bj * HALF;
                    float y[8], zz[8]; unpk8(ld16_l2(Y + off), y);
                    if (accum) unpk8(ld16_l2(Z + off), zz); else {
#pragma unroll
                        for (int i = 0; i < 8; ++i) zz[i] = 0.f; }
                    float o[8];
#pragma unroll
                    for (int n = 0; n < 2; ++n)
#pragma unroll
                        for (int e = 0; e < 4; ++e) { const float gg = acc[ai][bj][m][n][e]; o[n * 4 + e] = zz[n * 4 + e] + y[n * 4 + e] * __builtin_amdgcn_rcpf(1.f + __builtin_amdgcn_exp2f(-gg * LOG2E)); }
                    u32x4 w; w.x = pk_h2(o[0], o[1]); w.y = pk_h2(o[2], o[3]); w.z = pk_h2(o[4], o[5]); w.w = pk_h2(o[6], o[7]);
                    *(u32x4*)(Z + off) = w; }
    }
};
}

#define XB_TMO      128
#define XB_XCNT(j)  (256  + 64 * (j))
#define XB_XSUB(j)  (1280 + 64 * (j))
#define XB_XGEN(j)  (2304 + 64 * (j))
#define XB_TOP      3328
#define XB_TOPGEN   3392
#define XCD_BAR_WORDS 3456
#define XB_SPIN_CAP (1u << 18)
__device__ __forceinline__ unsigned xb_ld(unsigned* p)              { return __hip_atomic_load(p, __ATOMIC_RELAXED, __HIP_MEMORY_SCOPE_AGENT); }
__device__ __forceinline__ unsigned xb_add(unsigned* p, unsigned v) { return __hip_atomic_fetch_add(p, v, __ATOMIC_RELAXED, __HIP_MEMORY_SCOPE_AGENT); }
__device__ __forceinline__ unsigned xb_xcc_id() { return (unsigned)__builtin_amdgcn_s_getreg((3 << 11) | 20) & 0xFu; }
#define XB_SPIN(cond, bar) do { unsigned _sp = 0; while (cond) { __builtin_amdgcn_s_sleep(1); \
    if ((++_sp & 255u) == 0u) { if (xb_ld(&(bar)[XB_TMO])) break; if (_sp > XB_SPIN_CAP) { atomicAdd(&(bar)[XB_TMO], 1u); break; } } } } while (0)
struct XcdBarrier { unsigned* bar; unsigned x; volatile LAS unsigned* st; };
__device__ __forceinline__ XcdBarrier xcd_barrier_post(unsigned* bar, volatile LAS unsigned* st) {
    XcdBarrier b; b.bar = bar; b.x = xb_xcc_id(); b.st = st;
    if (threadIdx.x == 0) (void)xb_add(&bar[XB_XCNT(b.x)], 1u);
    return b;
}
__device__ __forceinline__ void xcd_barrier_complete(unsigned* bar, unsigned x, unsigned& nloc, unsigned& nx) {
    const unsigned G = gridDim.x * gridDim.y * gridDim.z;
    unsigned sum, cnt, mine, sp = 0u;
    for (;;) {
        sum = 0u; cnt = 0u; mine = 0u;
#pragma unroll
        for (unsigned j = 0; j < 16; ++j) { const unsigned c = xb_ld(&bar[XB_XCNT(j)]); sum += c; cnt += (c > 0u) ? 1u : 0u; mine = (j == x) ? c : mine; }
        if (sum == G) break;
        __builtin_amdgcn_s_sleep(1);
        if ((++sp & 255u) == 0u) { if (xb_ld(&bar[XB_TMO])) break; if (sp > XB_SPIN_CAP) { atomicAdd(&bar[XB_TMO], 1u); break; } }
    }
    nloc = mine > 0u ? mine : 1u; nx = cnt > 0u ? cnt : 1u;
}
__device__ __forceinline__ void xcd_barrier(const XcdBarrier& b) {
    asm volatile("s_waitcnt vmcnt(0)" ::: "memory");
    __syncthreads();
    if (threadIdx.x == 0) {
        unsigned* bar = b.bar;
        __builtin_amdgcn_s_waitcnt(0);
        unsigned nloc = b.st[0], nx = b.st[1];
        if (nloc == 0u) { xcd_barrier_complete(bar, b.x, nloc, nx); b.st[0] = nloc; b.st[1] = nx; }
        const unsigned old = xb_add(&bar[XB_XSUB(b.x)], 1u);
        const unsigned gen = old / nloc;
        if (old + 1u == (gen + 1u) * nloc) {
            __builtin_amdgcn_fence(__ATOMIC_RELEASE, "agent");
            asm volatile("s_waitcnt vmcnt(0)" ::: "memory");
            const unsigned og = xb_add(&bar[XB_TOP], 1u);
            const unsigned tg = og / nx;
            if (og + 1u == (tg + 1u) * nx) xb_add(&bar[XB_TOPGEN], 1u);
            else XB_SPIN(xb_ld(&bar[XB_TOPGEN]) == tg, bar);
            __builtin_amdgcn_fence(__ATOMIC_ACQUIRE, "agent");
            xb_add(&bar[XB_XGEN(b.x)], 1u);
            asm volatile("s_waitcnt vmcnt(0)" ::: "memory");
        } else {
            XB_SPIN(xb_ld(&bar[XB_XGEN(b.x)]) == gen, bar);
            __builtin_amdgcn_fence(__ATOMIC_ACQUIRE, "agent");
            asm volatile("s_waitcnt vmcnt(0)" ::: "memory");
        }
    }
    __syncthreads();
}

constexpr int NWAVES = 8, NTHR = 512;
constexpr int RING_BYTES = 131072, LDSCTL_OFF = RING_BYTES, MISC_OFF = LDSCTL_OFF + 320, LDS_BYTES = 147456;
constexpr int XCH_OFF = RING_BYTES + 1024;
constexpr int CW_BAR = 4096;
constexpr size_t OW_GU1 = OFF_W, OW_D1 = OW_GU1 + 11 * MiB, OW_IN = OW_D1 + (size_t)DM * FF * 2, OW_GATE = OW_IN + 6 * MiB, OW_4 = OW_GATE + 4 * MiB, OW_OV = OW_4 + 2 * MiB,
                 OW_UPB = OW_OV + 4 * MiB, OW_O = OW_UPB + MiB / 2, OW_GU2 = OW_O + 2 * MiB, OW_D2 = OW_GU2 + 11 * MiB, OW_END = OW_D2 + (size_t)DM * FF * 2;
static_assert(OW_END <= OFF_H, "weights region");
constexpr int NIN3 = 3072, N4 = 2560;
constexpr size_t OW_BD = OW_OV, OW_UPA = OW_OV + MiB, OFF_OA = OFF_A + 64 * MiB;

struct Args { const float* in[27]; float* out; unsigned char* ws; int ph_lo, ph_hi; };
struct Frame {
    LAS unsigned char* lds; int tid, lane, wave, G, gw, NGW;
};
__device__ __forceinline__ float wave_sum(float v) {
#pragma unroll
    for (int o = 1; o < 64; o <<= 1) v += __shfl_xor(v, o);
    return v;
}
__device__ __forceinline__ bool map_row(int job, int n, const Args& a, const float*& W, int& ldw, int& col) {
    if (job <= 1) { const int t = n >> 8, j = n & 255; W = a.in[(job == 0 ? 6 : 23) + (j >> 7)]; ldw = FF; col = t * 128 + (j & 127); return true; }
    if (job == 2) { W = a.in[11]; ldw = DIN; const int t = n >> 8, j = n & 255;
        if (t == 0) { col = C_CKV + j; return true; }
        if (t == 1) { col = j; return true; }
        if (t == 2) { if (j < 128) { col = 256 + j; return true; } if (j < 160) { col = C_KR + (j - 128); return true; } if (j < 192) { col = C_KI + (j - 160); return true; } if (j < 200) { col = C_WI + (j - 192); return true; } col = 0; return false; }
        if (t < 9) { const int c3 = (t - 3) / 3, tl = (t - 3) % 3, hl = (j & 127) >> 5, i = j & 31; col = C_QKV + c3 * 768 + (4 * tl + hl) * 64 + (j >> 7) * 32 + i; return true; }
        col = C_QKV + 1536 + (t - 9) * 256 + j; return true; }
    { const int n2 = n - 2048, r5 = n2 & 31, nat = 16 * ((r5 >> 2) & 1) + 4 * (r5 >> 3) + (r5 & 3);
      if (n2 < 256) { W = a.in[14]; ldw = 768; col = (n2 >> 5) * 96 + 64 + nat; } else { W = a.in[17]; ldw = 256; col = ((n2 - 256) & ~31) + nat; } return true; }
}
template <typename T>
__device__ __forceinline__ void tr_item(const float* W, int ldw, int col, bool valid, const float* scale, int k0, T* WTrow0, int K, LAS float* scr, int lane) {
    const int colc = valid ? col : 0; float vv[32];
#pragma unroll
    for (int i = 0; i < 32; ++i) vv[i] = W[(size_t)(k0 + 2 * i + (lane >> 5)) * ldw + colc];
    if (scale) {
#pragma unroll
        for (int i = 0; i < 32; ++i) vv[i] *= scale[k0 + 2 * i + (lane >> 5)]; }
#pragma unroll
    for (int i = 0; i < 32; ++i) scr[(2 * i + (lane >> 5)) * 33 + (lane & 31)] = valid ? vv[i] : 0.f;
    asm volatile("s_waitcnt lgkmcnt(0)" ::: "memory");
    const int c = lane & 7;
#pragma unroll
    for (int j = 0; j < 4; ++j) { const int n = (lane >> 3) + 8 * j; const LAS float* s = scr + (8 * c) * 33 + n;
        if constexpr (sizeof(T) == 1) { u32x2 o; o.x = pk_f8x4(s[0 * 33] * F8_WGT, s[1 * 33] * F8_WGT, s[2 * 33] * F8_WGT, s[3 * 33] * F8_WGT); o.y = pk_f8x4(s[4 * 33] * F8_WGT, s[5 * 33] * F8_WGT, s[6 * 33] * F8_WGT, s[7 * 33] * F8_WGT);
            *(u32x2*)(WTrow0 + (size_t)n * K + k0 + 8 * c) = o; }
        else { u32x4 o; o.x = pk_h2(s[0 * 33], s[1 * 33]); o.y = pk_h2(s[2 * 33], s[3 * 33]); o.z = pk_h2(s[4 * 33], s[5 * 33]); o.w = pk_h2(s[6 * 33], s[7 * 33]);
            *(u32x4*)(WTrow0 + (size_t)n * K + k0 + 8 * c) = o; } }
    asm volatile("s_waitcnt lgkmcnt(0)" ::: "memory");
}
template <typename T>
__device__ __forceinline__ void tr_job_mapped(const Frame& F, const Args& a, int job, int Ndest, int n_lo, int K, T* WT, const float* scale, LAS float* scr, int phase_off) {
    const int nblk = Ndest / 32, nitems = (K / 64) * nblk;
    for (int it = (F.gw + phase_off) % F.NGW; it < nitems; it += F.NGW) {
        const int kb = it / nblk, nb = it % nblk; const float* W; int ldw, col;
        const bool valid = map_row(job, n_lo + nb * 32 + (F.lane & 31), a, W, ldw, col);
        tr_item(W, ldw, col, valid, scale, kb * 64, WT + (size_t)(n_lo + nb * 32) * K, K, scr, F.lane);
    }
}
template <typename T>
__device__ __forceinline__ void tr_job_plain(const Frame& F, const float* W, int ldw, int Ndest, int K, T* WT, LAS float* scr, int phase_off) {
    const int nblk = Ndest / 32, nitems = (K / 64) * nblk;
    for (int it = (F.gw + phase_off) % F.NGW; it < nitems; it += F.NGW) {
        const int kb = it / nblk, nb = it % nblk;
        tr_item(W, ldw, nb * 32 + (F.lane & 31), true, nullptr, kb * 64, WT + (size_t)(nb * 32) * K, K, scr, F.lane);
    }
}
__device__ __forceinline__ void row_load(const float* p, int lane, f32x4 (&v)[4]) {
#pragma unroll
    for (int j = 0; j < 4; ++j) v[j] = ((const f32x4*)p)[lane + 64 * j];
}
__device__ __forceinline__ float row_ssq(const f32x4 (&v)[4]) { float s = 0.f;
#pragma unroll
    for (int j = 0; j < 4; ++j) s += (v[j].x * v[j].x + v[j].y * v[j].y) + (v[j].z * v[j].z + v[j].w * v[j].w);
    return wave_sum(s); }
template <typename T>
__device__ __forceinline__ void row_normmod_store(const f32x4 (&v)[4], float rstd, const float* g, const float* sc, const float* sh, T* dst, int lane) {
#pragma unroll
    for (int j = 0; j < 4; ++j) { const int ci = lane + 64 * j; const f32x4 gg = ((const f32x4*)g)[ci], s1 = ((const f32x4*)sc)[ci], s0 = ((const f32x4*)sh)[ci];
        const f32x4 o = v[j] * rstd * gg * (s1 + 1.f) + s0;
        if constexpr (sizeof(T) == 1) ((unsigned*)dst)[ci] = pk_f8x4(o.x * F8_ACT, o.y * F8_ACT, o.z * F8_ACT, o.w * F8_ACT);
        else { u32x2 w; w.x = pk_h2(o.x, o.y); w.y = pk_h2(o.z, o.w); ((u32x2*)dst)[ci] = w; } }
}
__device__ __forceinline__ void ph_normmod(const Frame& F, const float* x, const float* g, const float* mod, int isc, int ish, h16* dst) {
    int m = F.gw; if (m >= MT) return;
    const int lane = flane();
    f32x4 v[4], vn[4]; row_load(x + (size_t)m * DM, lane, v);
    for (;;) { const int mn = m + F.NGW; const bool has = mn < MT; if (has) row_load(x + (size_t)mn * DM, lane, vn);
        const float rstd = rsqrtf(row_ssq(v) * (1.f / DM) + EPS); const float* mb = mod + (m / SEQ) * (NMOD * DM);
        row_normmod_store(v, rstd, g, mb + isc * DM, mb + ish * DM, dst + (size_t)m * DM, lane);
        if (!has) break;
#pragma unroll
        for (int j = 0; j < 4; ++j) v[j] = vn[j];
        m = mn; }
}
__device__ __forceinline__ void row_load_h(const h16* p, int lane, u32x2 (&v)[4]) {
#pragma unroll
    for (int j = 0; j < 4; ++j) v[j] = ((const u32x2*)p)[lane + 64 * j];
}
typedef _Float16 h16x4 __attribute__((ext_vector_type(4)));
__device__ __forceinline__ f32x4 h4_to_f4(u32x2 w) { const h16x4 h = __builtin_bit_cast(h16x4, w); return (f32x4){(float)h[0], (float)h[1], (float)h[2], (float)h[3]}; }
template <bool XI16, bool XO16, typename T = h16>
__device__ __forceinline__ void ph_resnorm(const Frame& F, const void* xin_, const h16* f, const float* gpost, const float* mod, int igt, float coef, void* xout_,
                                           bool second, const float* gpre, int isc, int ish, T* dst) {
    int m = F.gw; if (m >= MT) return;
    const int lane = flane();
    u32x2 fh[4], fn[4]; f32x4 xi[4], xn[4]; u32x2 xh[4], xhn[4];
    row_load_h(f + (size_t)m * DM, lane, fh);
    if constexpr (XI16) row_load_h((const h16*)xin_ + (size_t)m * DM, lane, xh); else row_load((const float*)xin_ + (size_t)m * DM, lane, xi);
    for (;;) {
        const int mn = m + F.NGW; const bool has = mn < MT;
        if (has) { row_load_h(f + (size_t)mn * DM, lane, fn);
            if constexpr (XI16) row_load_h((const h16*)xin_ + (size_t)mn * DM, lane, xhn); else row_load((const float*)xin_ + (size_t)mn * DM, lane, xn); }
        f32x4 v[4];
#pragma unroll
        for (int j = 0; j < 4; ++j) { v[j] = h4_to_f4(fh[j]); if constexpr (XI16) xi[j] = h4_to_f4(xh[j]); }
        const float rstd = rsqrtf(row_ssq(v) * (1.f / DM) + EPS) * coef; const float* mb = mod + (m / SEQ) * (NMOD * DM);
#pragma unroll
        for (int j = 0; j < 4; ++j) { const int ci = lane + 64 * j; const f32x4 gg = ((const f32x4*)gpost)[ci], gt = ((const f32x4*)(mb + igt * DM))[ci];
            xi[j] = xi[j] + gt * v[j] * rstd * gg;
            if constexpr (XO16) { u32x2 w; w.x = pk_h2(xi[j].x, xi[j].y); w.y = pk_h2(xi[j].z, xi[j].w); ((u32x2*)((h16*)xout_ + (size_t)m * DM))[ci] = w; }
            else ((f32x4*)((float*)xout_ + (size_t)m * DM))[ci] = xi[j]; }
        if (second) { const float r2 = rsqrtf(row_ssq(xi) * (1.f / DM) + EPS); row_normmod_store(xi, r2, gpre, mb + isc * DM, mb + ish * DM, dst + (size_t)m * DM, lane); }
        if (!has) break;
#pragma unroll
        for (int j = 0; j < 4; ++j) { fh[j] = fn[j]; if constexpr (XI16) xh[j] = xhn[j]; else xi[j] = xn[j]; }
        m = mn;
    }
}

__device__ __forceinline__ void ph_combine(const Frame& F, const h16* og, const float* lse2, h16* ob) {
    for (int idx = blockIdx.x * NTHR + F.tid; idx < MT * 256; idx += F.G * NTHR) {
        const int tok = idx >> 8, c = idx & 255, hh = c >> 6;
        const float l0 = lse2[tok * 12 + hh], l1 = lse2[tok * 12 + 4 + hh], l2 = lse2[tok * 12 + 8 + hh], m = fmaxf(l0, fmaxf(l1, l2));
        const float w0 = exp2f(l0 - m), w1 = exp2f(l1 - m), w2 = exp2f(l2 - m), inv = 1.f / (w0 + w1 + w2);
        ob[idx] = (h16)((w0 * (float)og[(size_t)tok * 768 + c] + w1 * (float)og[(size_t)tok * 768 + 256 + c] + w2 * (float)og[(size_t)tok * 768 + 512 + c]) * inv); }
}
typedef short v4i16_t __attribute__((ext_vector_type(4)));
typedef short s16x8 __attribute__((ext_vector_type(8)));
typedef float f32x16 __attribute__((ext_vector_type(16)));
__device__ __forceinline__ int tk_bin(float sc) { const unsigned u = __float_as_uint(sc); int e = (int)((u >> 16) & 0x7FFFu) - (122 << 7); e = e < 0 ? 0 : (e > 1023 ? 1023 : e); return (u >> 31) ? 1023 - e : 1024 + e; }
__device__ __forceinline__ void tk_scores(const f16x8 (&Af)[2], const float (&wv)[16], f16x8 b0, f16x8 b1, float& sa, float& sb) {
    f32x16 d = {0.f, 0.f, 0.f, 0.f, 0.f, 0.f, 0.f, 0.f, 0.f, 0.f, 0.f, 0.f, 0.f, 0.f, 0.f, 0.f};
    d = __builtin_amdgcn_mfma_f32_32x32x16_f16(Af[0], b0, d, 0, 0, 0); d = __builtin_amdgcn_mfma_f32_32x32x16_f16(Af[1], b1, d, 0, 0, 0);
    f32x2 acc = {0.f, 0.f};
#pragma unroll
    for (int e = 0; e < 16; e += 2) { const int i0 = __float_as_int(d[e]), i1 = __float_as_int(d[e + 1]);
        const f32x2 rl = {__int_as_float(i0 > 0 ? i0 : 0), __int_as_float(i1 > 0 ? i1 : 0)}; const f32x2 w2 = {wv[e], wv[e + 1]};
        acc = __builtin_elementwise_fma(w2, rl, acc); }
    sa = acc.x; sb = acc.y;
}
template <bool P2>
__device__ __forceinline__ void tk_tile(const f16x8 (&Af)[2], const float (&wv)[16], f16x8 b0, f16x8 b1, int tile, int r, int hi, int ta, LAS unsigned* hist, const int (&tbin)[4], int (&cs)[4], int (&cc)[4],
                                        unsigned short* sel, int tok0) {
    float sa, sb; tk_scores(Af, wv, b0, b1, sa, sb);
    const int s = 32 * tile + r;
    if constexpr (!P2) {
        if (s <= ta) { const int bn = tk_bin(sa); __hip_atomic_fetch_add(hist + (2 * hi) * 1024 + (bn >> 1), 1u << (16 * (bn & 1)), __ATOMIC_RELAXED, __HIP_MEMORY_SCOPE_WORKGROUP); }
        if (s <= ta + 1) { const int bn = tk_bin(sb); __hip_atomic_fetch_add(hist + (2 * hi + 1) * 1024 + (bn >> 1), 1u << (16 * (bn & 1)), __ATOMIC_RELAXED, __HIP_MEMORY_SCOPE_WORKGROUP); }
    } else {
        const unsigned lowmask = (1u << r) - 1u;
#pragma unroll
        for (int ab = 0; ab < 2; ++ab) { const float sc = ab ? sb : sa; const int tq = ta + ab; const int bn = tk_bin(sc);
            const int mytb = hi ? tbin[2 + ab] : tbin[ab];
            const bool valid = s <= tq, sure = valid && bn > mytb, cand = valid && bn == mytb;
            const unsigned long long ms = __ballot(sure), mc = __ballot(cand);
            const unsigned ms_h = hi ? (unsigned)(ms >> 32) : (unsigned)ms, mc_h = hi ? (unsigned)(mc >> 32) : (unsigned)mc;
            const int q = 2 * hi + ab;
            const int base_s = hi ? cs[2 + ab] : cs[ab], base_c = hi ? cc[2 + ab] : cc[ab];
            if (sure) sel[(size_t)(tok0 + q) * TOPK + base_s + __builtin_popcount(ms_h & lowmask)] = (unsigned short)s;
            if (cand) { const int pos = base_c + __builtin_popcount(mc_h & lowmask);
                if (pos < 512) ((LAS unsigned long long*)((LAS unsigned char*)hist + q * 4096))[pos] = ((unsigned long long)fkey(sc) << 16) | (unsigned long long)(0xFFFFu - (unsigned)s); }
            cs[ab] += __builtin_popcount((unsigned)ms); cs[2 + ab] += __builtin_popcount((unsigned)(ms >> 32));
            cc[ab] += __builtin_popcount((unsigned)mc); cc[2 + ab] += __builtin_popcount((unsigned)(mc >> 32)); }
    }
}
template <bool P2>
__device__ __forceinline__ void tk_pass(const f16x8 (&Af)[2], const float (&wv)[16], const h16* kbase, int ntiles, int r, int hi, int ta, LAS unsigned* hist, const int (&tbin)[4], int (&cs)[4], int (&cc)[4],
                                        unsigned short* sel, int tok0) {
    f16x8 BA[4][2], BB[4][2];
#define TK_LOAD(dst, t0_) do { _Pragma("unroll") for (int i_ = 0; i_ < 4; ++i_) { const int tt_ = ((t0_) + i_) < 127 ? ((t0_) + i_) : 127; dst[i_][0] = *(const f16x8*)(kbase + (size_t)tt_ * 1024); dst[i_][1] = *(const f16x8*)(kbase + (size_t)tt_ * 1024 + 16); } } while (0)
    TK_LOAD(BA, 0);
    for (int t0 = 0; t0 < ntiles; t0 += 8) {
        TK_LOAD(BB, t0 + 4);
#pragma unroll
        for (int i = 0; i < 4; ++i) if (t0 + i < ntiles) tk_tile<P2>(Af, wv, BA[i][0], BA[i][1], t0 + i, r, hi, ta, hist, tbin, cs, cc, sel, tok0);
        TK_LOAD(BA, t0 + 8);
#pragma unroll
        for (int i = 0; i < 4; ++i) if (t0 + 4 + i < ntiles) tk_tile<P2>(Af, wv, BB[i][0], BB[i][1], t0 + 4 + i, r, hi, ta, hist, tbin, cs, cc, sel, tok0);
    }
#undef TK_LOAD
}
__device__ __forceinline__ void tk_group(const Frame& F, const h16* qi, const h16* ki, const float* wi, unsigned short* sel, int b, int t0, LAS unsigned* hist) {
    int lane_ = F.lane; asm volatile("" : "+v"(lane_)); const int lane = lane_, r = lane & 31, hi = lane >> 5, tok0 = b * SEQ + t0;
    const int qa = 2 * ((r >> 2) & 1) + (r & 1), ha = 4 * (r >> 4) + 2 * ((r >> 3) & 1) + ((r >> 1) & 1);
    f16x8 Af[2];
#pragma unroll
    for (int s_ = 0; s_ < 2; ++s_) Af[s_] = *(const f16x8*)(qi + (size_t)(tok0 + qa) * 256 + ha * 32 + 16 * s_ + 8 * hi);
    float wv[16];
    { const f32x4 a0 = *(const f32x4*)(wi + (tok0 + 2 * hi) * 8), a1 = *(const f32x4*)(wi + (tok0 + 2 * hi) * 8 + 4), b0 = *(const f32x4*)(wi + (tok0 + 2 * hi + 1) * 8), b1 = *(const f32x4*)(wi + (tok0 + 2 * hi + 1) * 8 + 4);
      const float sa[8] = {a0.x, a0.y, a0.z, a0.w, a1.x, a1.y, a1.z, a1.w}, sb[8] = {b0.x, b0.y, b0.z, b0.w, b1.x, b1.y, b1.z, b1.w};
#pragma unroll
      for (int h = 0; h < 8; ++h) { wv[2 * h] = sa[h] * 0.17677669529663687f; wv[2 * h + 1] = sb[h] * 0.17677669529663687f; } }
    const int ntiles = (t0 + 3) / 32 + 1, ta = t0 + 2 * hi;
    const h16* kbase = ki + (size_t)(b * SEQ + r) * 32 + 8 * hi;
    int tbin[4] = {0, 0, 0, 0}, nsure[4], cs[4] = {0, 0, 0, 0}, cc[4] = {0, 0, 0, 0};
#pragma unroll
    for (int i = 0; i < 16; ++i) *(LAS u32x4*)((LAS unsigned char*)hist + i * 1024 + lane * 16) = (u32x4){0u, 0u, 0u, 0u};
    asm volatile("s_waitcnt lgkmcnt(0)" ::: "memory");
    tk_pass<false>(Af, wv, kbase, ntiles, r, hi, ta, hist, tbin, cs, cc, sel, tok0);
    asm volatile("s_waitcnt lgkmcnt(0)" ::: "memory");
#pragma unroll
    for (int q = 0; q < 4; ++q) {
        const LAS unsigned* hq = hist + q * 1024;
        unsigned sum = 0;
#pragma unroll
        for (int i = 0; i < 4; ++i) { const u32x4 v = *(const LAS u32x4*)(hq + 16 * lane + 4 * i); sum += (v.x & 0xFFFFu) + (v.x >> 16) + (v.y & 0xFFFFu) + (v.y >> 16) + (v.z & 0xFFFFu) + (v.z >> 16) + (v.w & 0xFFFFu) + (v.w >> 16); }
        unsigned incl = sum;
#pragma unroll
        for (int o = 1; o < 64; o <<= 1) { const unsigned v = __shfl_down(incl, o); if (lane + o < 64) incl += v; }
        const unsigned long long bal = __ballot(incl >= (unsigned)TOPK);
        const int L = 63 - __builtin_clzll(bal);
        unsigned cum = __shfl(incl, L) - __shfl(sum, L);
        int tbq = 32 * L, found = 0;
        for (int wd = 15; wd >= 0 && !found; --wd) { const unsigned v = hq[16 * L + wd];
            const unsigned chi = v >> 16, clo = v & 0xFFFFu;
            if (cum + chi >= (unsigned)TOPK) { tbq = 32 * L + 2 * wd + 1; found = 1; } else { cum += chi;
                if (cum + clo >= (unsigned)TOPK) { tbq = 32 * L + 2 * wd; found = 1; } else cum += clo; } }
        tbin[q] = tbq; nsure[q] = (int)cum;
    }
    asm volatile("s_waitcnt lgkmcnt(0)" ::: "memory");
    tk_pass<true>(Af, wv, kbase, ntiles, r, hi, ta, hist, tbin, cs, cc, sel, tok0);
    asm volatile("s_waitcnt lgkmcnt(0)" ::: "memory");
#pragma unroll
    for (int q = 0; q < 4; ++q) {
        const int nc = cc[q] < 512 ? cc[q] : 512, need = TOPK - cs[q];
        const LAS unsigned long long* cq = (const LAS unsigned long long*)((const LAS unsigned char*)hist + q * 4096);
        if (nc > 64) {
            unsigned long long it[8];
#pragma unroll
            for (int k = 0; k < 8; ++k) it[k] = (k * 64 + lane < nc) ? cq[k * 64 + lane] : 0ull;
            unsigned long long T = 0ull;
            for (int bit = 47; bit >= 0; --bit) { const unsigned long long cand = T | (1ull << bit); int cnt = 0;
#pragma unroll
                for (int k = 0; k < 8; ++k) cnt += __builtin_popcountll(__ballot(it[k] >= cand));
                if (cnt >= need) T = cand; }
            int basep = cs[q];
#pragma unroll
            for (int k = 0; k < 8; ++k) { const bool pick = (T != 0ull) && it[k] >= T; const unsigned long long mk = __ballot(pick);
                if (pick) sel[(size_t)(tok0 + q) * TOPK + basep + __builtin_popcountll(mk & ((1ull << lane) - 1ull))] = (unsigned short)(0xFFFFu - (unsigned)(it[k] & 0xFFFFull));
                basep += __builtin_popcountll(mk); }
        } else
        for (int base = 0; base < nc; base += 64) {
            const bool act = base + lane < nc; const unsigned long long my = act ? cq[base + lane] : 0ull; int rank = 0;
            for (int jb = 0; jb < nc; jb += 64) {
                const unsigned long long cj = (jb + lane < nc) ? cq[jb + lane] : 0ull; const unsigned clo = (unsigned)cj, chi = (unsigned)(cj >> 32);
                const int n = (nc - jb) < 64 ? (nc - jb) : 64;
                for (int j = 0; j < n; ++j) { const unsigned long long sj = ((unsigned long long)(unsigned)__builtin_amdgcn_readlane((int)chi, j) << 32) | (unsigned)__builtin_amdgcn_readlane((int)clo, j); rank += (sj > my) ? 1 : 0; } }
            if (act && rank < need) sel[(size_t)(tok0 + q) * TOPK + cs[q] + rank] = (unsigned short)(0xFFFFu - (unsigned)(my & 0xFFFFull)); }
    }
    (void)nsure;
    asm volatile("s_waitcnt lgkmcnt(0)" ::: "memory");
}
__device__ __forceinline__ void ph_topk_sparse(const Frame& F, const h16* qi, const h16* ki, const float* wi, unsigned short* sel, h16* qlat, const h16* qr, const unsigned char* ckv8, const unsigned char* kr8);
__device__ __forceinline__ void ph_topk_mfma(const Frame& F, const h16* qi, const h16* ki, const float* wi, unsigned short* sel) {
    LAS unsigned* hist = (LAS unsigned*)(F.lds + F.wave * 16384);
    for (int g = F.gw; g < 4 * 64; g += F.NGW) { const int b = g >> 6, t0 = (g & 63) * 4;
        for (int i = F.lane; i < 4 * TOPK; i += 64) { const int q = i >> 8, k = i & 255; sel[(size_t)(b * SEQ + t0 + q) * TOPK + k] = (unsigned short)(k <= t0 + q ? k : 0); } }
    for (int p = F.gw; p < 4 * 480; p += F.NGW) { const int b = p & 3, pj = p >> 2;
        tk_group(F, qi, ki, wi, sel, b, 4 * (64 + pj), hist);
        tk_group(F, qi, ki, wi, sel, b, 4 * (1023 - pj), hist);
    }
}


__device__ __forceinline__ void ph_dilated_mfma(const Frame& F, const h16* qb, const h16* kb, const h16* vb, h16* og, float* lse2) {
    const int lane = F.lane, ql = lane & 31, hi = lane >> 5;
    LAS unsigned char* VL = F.lds + F.wave * 16384;
    LAS float* linv = (LAS float*)(VL + 12288);
    constexpr int VROW = 192;
    const int trq = (lane & 15) >> 2, trp = lane & 3, trg = (lane >> 4) & 1;
    for (int u = F.gw; u < NB * 12 * 128; u += F.NGW) {
        const int b = u / 1536, rem = u % 1536, gh = rem >> 7, g = gh >> 2, wi_ = rem & 127, dil = dil_of(g), sh = g == 0 ? 0 : (g == 1 ? 2 : 4);
        const int nblk = 128 >> sh, res = wi_ / nblk, j0 = 32 * (wi_ % nblk);
        const size_t hoff = (size_t)b * SEQ * 768 + gh * 64;
        f16x8 Qf[4];
        { const h16* qp = qb + hoff + (size_t)((j0 + ql) * dil + res) * 768 + 8 * hi;
#pragma unroll
          for (int s_ = 0; s_ < 4; ++s_) Qf[s_] = *(const f16x8*)(qp + 16 * s_); }
        f32x16 S[5];
        f16x8 Kf[5][4];
#pragma unroll
        for (int kt = 0; kt < 5; ++kt) { int jk = j0 - 128 + 32 * kt + ql; jk = jk < 0 ? 0 : jk;
            const h16* kp = kb + hoff + (size_t)(jk * dil + res) * 768 + 8 * hi;
#pragma unroll
            for (int s_ = 0; s_ < 4; ++s_) Kf[kt][s_] = *(const f16x8*)(kp + 16 * s_); }
#pragma unroll
        for (int kt = 0; kt < 5; ++kt) {
            f32x16 d = {0.f, 0.f, 0.f, 0.f, 0.f, 0.f, 0.f, 0.f, 0.f, 0.f, 0.f, 0.f, 0.f, 0.f, 0.f, 0.f};
#pragma unroll
            for (int s_ = 0; s_ < 4; ++s_) d = __builtin_amdgcn_mfma_f32_32x32x16_f16(Kf[kt][s_], Qf[s_], d, 0, 0, 0);
            S[kt] = d; }
        f16x8 Vr[5][4];
#pragma unroll
        for (int kt = 0; kt < 5; ++kt) { int jk = j0 - 128 + 32 * kt + (lane >> 1); jk = jk < 0 ? 0 : jk;
            const h16* vp = vb + hoff + (size_t)(jk * dil + res) * 768 + (lane & 1) * 32;
#pragma unroll
            for (int i = 0; i < 4; ++i) Vr[kt][i] = *(const f16x8*)(vp + 8 * i); }
        float m = -INFINITY;
#pragma unroll
        for (int kt = 0; kt < 5; ++kt)
#pragma unroll
            for (int e = 0; e < 16; ++e) { const int kl = (e & 3) + 8 * (e >> 2) + 4 * hi; bool ok = (j0 - 128 + 32 * kt + kl) >= 0;
                if (kt == 0) ok = ok && (kl >= ql); if (kt == 4) ok = ok && (kl <= ql);
                if (!ok) S[kt][e] = -INFINITY; m = fmaxf(m, S[kt][e]); }
        m = fmaxf(m, __shfl_xor(m, 32));
        float l = 0.f;
#pragma unroll
        for (int kt = 0; kt < 5; ++kt)
#pragma unroll
            for (int e = 0; e < 16; ++e) { const float p = __builtin_amdgcn_exp2f(S[kt][e] - m); S[kt][e] = p; l += p; }
        l += __shfl_xor(l, 32);
        if (hi == 0) { linv[ql] = __builtin_amdgcn_rcpf(l); lse2[(size_t)(b * SEQ + (j0 + ql) * dil + res) * 12 + gh] = m + __builtin_amdgcn_logf(l); }
        f32x16 O[2];
#pragma unroll
        for (int dt = 0; dt < 2; ++dt) O[dt] = (f32x16){0.f, 0.f, 0.f, 0.f, 0.f, 0.f, 0.f, 0.f, 0.f, 0.f, 0.f, 0.f, 0.f, 0.f, 0.f, 0.f};
#pragma unroll
        for (int kt = 0; kt < 5; ++kt) {
            LAS unsigned char* vbuf = VL + (kt & 1) * 6144;
#pragma unroll
            for (int i = 0; i < 4; ++i) *(LAS f16x8*)(vbuf + (lane >> 1) * VROW + (lane & 1) * 64 + i * 16) = Vr[kt][i];
            asm volatile("s_waitcnt lgkmcnt(0)" ::: "memory");
#pragma unroll
            for (int s2 = 0; s2 < 2; ++s2) {
                u32x4 pa; pa.x = pk_h2(S[kt][8 * s2 + 0], S[kt][8 * s2 + 1]); pa.y = pk_h2(S[kt][8 * s2 + 2], S[kt][8 * s2 + 3]); pa.z = pk_h2(S[kt][8 * s2 + 4], S[kt][8 * s2 + 5]); pa.w = pk_h2(S[kt][8 * s2 + 6], S[kt][8 * s2 + 7]);
#pragma unroll
                for (int dt = 0; dt < 2; ++dt) {
                    const v4i16_t lo = __builtin_amdgcn_ds_read_tr16_b64_v4i16((LAS v4i16_t*)(vbuf + (16 * s2 + 4 * hi + trq) * VROW + (32 * dt + 16 * trg + 4 * trp) * 2));
                    const v4i16_t hh = __builtin_amdgcn_ds_read_tr16_b64_v4i16((LAS v4i16_t*)(vbuf + (16 * s2 + 8 + 4 * hi + trq) * VROW + (32 * dt + 16 * trg + 4 * trp) * 2));
                    const s16x8 bv = {lo[0], lo[1], lo[2], lo[3], hh[0], hh[1], hh[2], hh[3]};
                    O[dt] = __builtin_amdgcn_mfma_f32_32x32x16_f16(__builtin_bit_cast(f16x8, pa), __builtin_bit_cast(f16x8, bv), O[dt], 0, 0, 0); } }
            asm volatile("s_waitcnt lgkmcnt(0)" ::: "memory");
        }
#pragma unroll
        for (int e = 0; e < 16; ++e) { const int q = (e & 3) + 8 * (e >> 2) + 4 * hi; const float il = linv[q];
            h16* op = og + (size_t)(b * SEQ + (j0 + q) * dil + res) * 768 + gh * 64 + ql;
            op[0] = (h16)(O[0][e] * il); op[32] = (h16)(O[1][e] * il); }
        asm volatile("s_waitcnt lgkmcnt(0)" ::: "memory");
    }
}


__device__ __forceinline__ f16x8 fp8x8_to_f16(unsigned w0, unsigned w1) {
    const h16x2 a = __builtin_amdgcn_cvt_scalef32_pk_f16_fp8((int)w0, 1.0f, false), b = __builtin_amdgcn_cvt_scalef32_pk_f16_fp8((int)w0, 1.0f, true),
                c = __builtin_amdgcn_cvt_scalef32_pk_f16_fp8((int)w1, 1.0f, false), d = __builtin_amdgcn_cvt_scalef32_pk_f16_fp8((int)w1, 1.0f, true);
    const u32x4 r = {__builtin_bit_cast(unsigned, a), __builtin_bit_cast(unsigned, b), __builtin_bit_cast(unsigned, c), __builtin_bit_cast(unsigned, d)};
    return __builtin_bit_cast(f16x8, r);
}
template <bool FUSED>
__device__ __forceinline__ void ph_sparse_wave(const Frame& F, h16* qlat, const h16* qr, const unsigned char* ckv8, const unsigned char* kr8, const unsigned short* sel, int ta = 0, int tb = 0) {
    int lane = F.lane; asm volatile("" : "+v"(lane));
    LAS unsigned char* V = F.lds + F.wave * 16384;
    const int qp = (lane & 15) >> 2, pp = lane & 3;
    const int k0 = 4 * (lane >> 4) + qp;
    const int tr0 = k0 * 512 + (pp >> 1) * 16 + (pp & 1) * 8, x0 = k0 & 7;
    const int vw = (lane & 15) * 512, swz = lane & 7;
    const int lane0 = lane;
    const int nit = FUSED ? 8 : (MT - F.gw + F.NGW - 1) / F.NGW;
    for (int it = 0; it < nit; ++it) {
        const int tok = FUSED ? ((it < 4 ? ta : tb - 4) + it) : F.gw + it * F.NGW;
        int ll = lane0; asm volatile("" : "+v"(ll));
        const int c = ll & 15, kq = ll >> 4, hd = c & 7;
        const int b = tok / SEQ, t = tok % SEQ, cnt = (t + 1 < TOPK) ? t + 1 : TOPK, nch = (cnt + 31) >> 5;
        LAS unsigned short* sp = (LAS unsigned short*)(F.lds + XCH_OFF + F.wave * 512) + c;
        *(LAS u32x2*)(F.lds + XCH_OFF + F.wave * 512 + 8 * ll) = *(const u32x2*)(sel + (size_t)tok * TOPK + 4 * ll);
        asm volatile("s_waitcnt lgkmcnt(0)" ::: "memory");
        f16x8 Qf[9]; u32x4 Kr[2][4]; u32x2 Rr[2];
#pragma unroll
        for (int s_ = 0; s_ < 8; ++s_) Qf[s_] = *(const f16x8*)(qlat + (size_t)tok * 2048 + hd * 256 + 64 * (s_ >> 1) + 16 * kq + 8 * (s_ & 1));
        Qf[8] = *(const f16x8*)(qr + (size_t)tok * 256 + hd * 32 + 8 * kq);
        int rowi[2];
#define SW_LOADK() do { _Pragma("unroll") for (int tl = 0; tl < 2; ++tl) { _Pragma("unroll") for (int q4 = 0; q4 < 4; ++q4) Kr[tl][q4] = *(const u32x4*)(ckv8 + (size_t)rowi[tl] * 256 + 64 * q4 + 16 * kq); \
        Rr[tl] = *(const u32x2*)(kr8 + (size_t)rowi[tl] * 32 + 8 * kq); } } while (0)
        rowi[0] = b * SEQ + (int)sp[0]; rowi[1] = b * SEQ + (int)sp[16];
        SW_LOADK();
        float m = -INFINITY, l = 0.f;
        f32x4 O[16];
#pragma unroll
        for (int ft = 0; ft < 16; ++ft) O[ft] = (f32x4){0.f, 0.f, 0.f, 0.f};
        for (int ch = 0; ch < nch; ++ch) {
            const bool more = ch + 1 < nch;
            int rown0 = 0, rown1 = 0; if (more) { rown0 = (int)sp[32 * (ch + 1)]; rown1 = (int)sp[32 * (ch + 1) + 16]; }
            f16x8 Kf[2][9];
#pragma unroll
            for (int tl = 0; tl < 2; ++tl) {
#pragma unroll
                for (int q4 = 0; q4 < 4; ++q4) { Kf[tl][2 * q4] = fp8x8_to_f16(Kr[tl][q4].x, Kr[tl][q4].y); Kf[tl][2 * q4 + 1] = fp8x8_to_f16(Kr[tl][q4].z, Kr[tl][q4].w); }
                Kf[tl][8] = fp8x8_to_f16(Rr[tl].x, Rr[tl].y); }
            if (more) { rowi[0] = b * SEQ + rown0; rowi[1] = b * SEQ + rown1; SW_LOADK(); }
            f32x4 S[2];
#pragma unroll
            for (int tl = 0; tl < 2; ++tl) { S[tl] = (f32x4){0.f, 0.f, 0.f, 0.f};
#pragma unroll
                for (int s_ = 0; s_ < 9; ++s_) S[tl] = __builtin_amdgcn_mfma_f32_16x16x32_f16(Kf[tl][s_], Qf[s_], S[tl], 0, 0, 0); }
            float cm = -INFINITY;
#pragma unroll
            for (int tl = 0; tl < 2; ++tl)
#pragma unroll
                for (int e = 0; e < 4; ++e) { if (32 * ch + 16 * tl + 4 * kq + e >= cnt) S[tl][e] = -INFINITY; cm = fmaxf(cm, S[tl][e]); }
            cm = fmaxf(cm, __shfl_xor(cm, 16)); cm = fmaxf(cm, __shfl_xor(cm, 32));
            if (__any(cm > m + 8.0f)) { const float mn = fmaxf(m, cm), alpha = __builtin_amdgcn_exp2f(m - mn); m = mn; l *= alpha;
#pragma unroll
                for (int ft = 0; ft < 16; ++ft) O[ft] = O[ft] * alpha; }
            float pe[2][4]; float ps = 0.f;
#pragma unroll
            for (int tl = 0; tl < 2; ++tl)
#pragma unroll
                for (int e = 0; e < 4; ++e) { pe[tl][e] = __builtin_amdgcn_exp2f(S[tl][e] - m); ps += pe[tl][e]; }
            l += ps;
#pragma unroll
            for (int tl = 0; tl < 2; ++tl)
#pragma unroll
                for (int s_ = 0; s_ < 8; ++s_) *(LAS f16x8*)(V + vw + tl * 8192 + (((4 * (s_ >> 1) + kq) ^ swz) << 5) + (s_ & 1) * 16) = Kf[tl][s_];
            asm volatile("s_waitcnt lgkmcnt(0)" ::: "memory");
            u32x4 pk; pk.x = pk_h2(pe[0][0], pe[0][1]); pk.y = pk_h2(pe[0][2], pe[0][3]); pk.z = pk_h2(pe[1][0], pe[1][1]); pk.w = pk_h2(pe[1][2], pe[1][3]);
            const f16x8 Pf = __builtin_bit_cast(f16x8, pk);
#pragma unroll
            for (int ft = 0; ft < 16; ++ft) {
                const v4i16_t lo = __builtin_amdgcn_ds_read_tr16_b64_v4i16((LAS v4i16_t*)(V + tr0 + (((ft & 7) ^ x0) << 5) + (ft >> 3) * 256));
                const v4i16_t hi = __builtin_amdgcn_ds_read_tr16_b64_v4i16((LAS v4i16_t*)(V + tr0 + (((ft & 7) ^ x0) << 5) + (ft >> 3) * 256 + 8192));
                const s16x8 av = {lo[0], lo[1], lo[2], lo[3], hi[0], hi[1], hi[2], hi[3]};
                O[ft] = __builtin_amdgcn_mfma_f32_16x16x32_f16(__builtin_bit_cast(f16x8, av), Pf, O[ft], 0, 0, 0); }
            asm volatile("s_waitcnt lgkmcnt(0)" ::: "memory");
        }
        l += __shfl_xor(l, 16); l += __shfl_xor(l, 32);
        if (c < 8) { const float il = __builtin_amdgcn_rcpf(l);
#pragma unroll
            for (int ft = 0; ft < 16; ++ft) { const f32x4 o = O[ft] * il; u32x2 pk; pk.x = pk_h2(o.x, o.y); pk.y = pk_h2(o.z, o.w);
                *(u32x2*)(qlat + (size_t)tok * 2048 + c * 256 + 16 * ft + 4 * kq) = pk; } }
#undef SW_LOADK
    }
}


__device__ __forceinline__ void precomb_tiles(const Frame& F, const Args& args, unsigned char* ws, int t_lo, int t_hi, int wg, int nwg) {
    LAS float* As = (LAS float*)(F.lds); LAS float* Bs = (LAS float*)(F.lds + 64 * 65 * 4);
    for (int tl = t_lo + wg; tl < t_hi; tl += nwg) {
        __syncthreads();
        const bool ql = tl < 192; int hd, rb, xb;
        if (ql) { hd = tl / 24; rb = (tl % 24) / 6; xb = tl % 6; } else { const int t2 = tl - 192; hd = t2 / 64; rb = (t2 % 64) / 16; xb = t2 % 16; }
#pragma unroll
        for (int k = 0; k < 2; ++k) { const int i4 = F.tid + NTHR * k, row = i4 >> 4, c4 = (i4 & 15) * 4;
            if (ql) { const f32x4 a = *(const f32x4*)(args.in[15] + (size_t)(rb * 64 + row) * 512 + hd * 64 + c4), bq = *(const f32x4*)(args.in[14] + (size_t)(xb * 64 + row) * 768 + hd * 96 + c4);
#pragma unroll
                for (int e = 0; e < 4; ++e) { As[row * 65 + c4 + e] = a[e]; Bs[row * 65 + c4 + e] = bq[e]; } }
            else { const f32x4 a = *(const f32x4*)(args.in[18] + (size_t)(hd * 64 + row) * DM + xb * 64 + c4), bq = *(const f32x4*)(args.in[16] + (size_t)(rb * 64 + row) * 512 + hd * 64 + c4);
#pragma unroll
                for (int e = 0; e < 4; ++e) { As[(c4 + e) * 65 + row] = a[e]; Bs[row * 65 + c4 + e] = bq[e]; } } }
        __syncthreads();
        const int j = F.tid & 63, ig = F.wave;
        float acc8[8];
#pragma unroll
        for (int ii = 0; ii < 8; ++ii) acc8[ii] = 0.f;
#pragma unroll 4
        for (int v = 0; v < 64; ++v) { const float bv = Bs[j * 65 + v];
#pragma unroll
            for (int ii = 0; ii < 8; ++ii) acc8[ii] += As[(ig * 8 + ii) * 65 + v] * bv; }
        if (ql) { const float gj = args.in[12][xb * 64 + j]; h16* o = (h16*)(ws + OW_4);
#pragma unroll
            for (int ii = 0; ii < 8; ++ii) o[(size_t)(hd * 256 + rb * 64 + ig * 8 + ii) * QL + xb * 64 + j] = (h16)(acc8[ii] * gj); }
        else { h16* o = (h16*)(ws + OW_OV);
#pragma unroll
            for (int ii = 0; ii < 8; ++ii) o[(size_t)(xb * 64 + ig * 8 + ii) * 2048 + hd * 256 + rb * 64 + j] = (h16)acc8[ii]; }
    }
    __syncthreads();
}


__device__ __forceinline__ void ph_topk_sparse(const Frame& F, const h16* qi, const h16* ki, const float* wi, unsigned short* sel, h16* qlat, const h16* qr, const unsigned char* ckv8, const unsigned char* kr8) {
    LAS unsigned* hist = (LAS unsigned*)(F.lds + F.wave * 16384);
    for (int p = F.gw; p < 2048; p += F.NGW) {
        int ta, tb;
        if (p < 4 * 448) { const int b = p & 3, pj = p >> 2; ta = b * SEQ + 4 * (64 + pj); tb = b * SEQ + 4 * (959 - pj);
            tk_group(F, qi, ki, wi, sel, b, 4 * (64 + pj), hist);
            tk_group(F, qi, ki, wi, sel, b, 4 * (959 - pj), hist); }
        else { const int q_ = p - 4 * 448, b = q_ & 3, i_ = q_ >> 2, t0 = 4 * i_;
            tk_group(F, qi, ki, wi, sel, b, 4 * (960 + i_), hist);
            int l0 = F.lane; asm volatile("" : "+v"(l0));
            for (int i = l0; i < 4 * TOPK; i += 64) { const int q = i >> 8, k = i & 255; sel[(size_t)(b * SEQ + t0 + q) * TOPK + k] = (unsigned short)(k <= t0 + q ? k : 0); }
            ta = b * SEQ + 4 * (960 + i_); tb = b * SEQ + t0; }
        asm volatile("s_waitcnt vmcnt(0) lgkmcnt(0)" ::: "memory");
        ph_sparse_wave<true>(F, qlat, qr, ckv8, kr8, sel, ta, tb);
        asm volatile("s_waitcnt lgkmcnt(0)" ::: "memory");
    }
}

__global__ void __launch_bounds__(NTHR, 2) mega_fwd(Args args) {
    extern __shared__ __attribute__((aligned(16))) unsigned char lds_raw[];
    Frame F; F.lds = (LAS unsigned char*)lds_raw; F.tid = threadIdx.x; F.lane = F.tid & 63; F.wave = __builtin_amdgcn_readfirstlane(F.tid >> 6);
    F.G = gridDim.x; F.gw = blockIdx.x * NWAVES + F.wave; F.NGW = F.G * NWAVES;
    volatile LAS unsigned* MISC = (volatile LAS unsigned*)(F.lds + MISC_OFF);
    unsigned char* ws = args.ws;
    for (int u = F.tid; u < (LDS_BYTES - LDSCTL_OFF) / 4; u += NTHR) ((LAS unsigned*)(F.lds + LDSCTL_OFF))[u] = 0u;
    __syncthreads();
    XcdBarrier bar = xcd_barrier_post((unsigned*)(ws + OFF_CTL) + CW_BAR, MISC + 8);
    const int lo = args.ph_lo, hi = args.ph_hi;
#define IN(k) (lo <= (k) && (k) < hi)
#define SEAM(k) do { if (IN(k) && IN((k) + 1)) xcd_barrier(bar); } while (0)
    float* mod = (float*)(ws + OFF_MOD); float2* tab = (float2*)(ws + OFF_ROPE);
    h16* Hb = (h16*)(ws + OFF_H); h16* Ab = (h16*)(ws + OFF_A); float* Fb = (float*)(ws + OFF_F);

    if (IN(0)) {
        LAS float* scr = (LAS float*)(F.lds + F.wave * 16384);
        for (int ch = blockIdx.x; ch < (NMOD * DM) / 36; ch += F.G) {
            LAS float* sl = (LAS float*)(F.lds);
            LAS float* part = (LAS float*)(F.lds + 16384);
            __syncthreads();
            for (int i = F.tid; i < 4 * DM; i += NTHR) sl[i] = silu_f(args.in[1][i]);
            __syncthreads();
            const int ln = F.lane < 36 ? F.lane : 35;
            const float* wm = args.in[3] + (size_t)(F.wave * 128) * (NMOD * DM) + ch * 36 + ln;
            float a0 = 0.f, a1 = 0.f, a2 = 0.f, a3 = 0.f;
#pragma unroll 16
            for (int k = 0; k < 128; ++k) { const float w = wm[(size_t)k * (NMOD * DM)]; const int kk = F.wave * 128 + k; a0 += sl[kk] * w; a1 += sl[DM + kk] * w; a2 += sl[2 * DM + kk] * w; a3 += sl[3 * DM + kk] * w; }
            part[(F.wave * 4 + 0) * 64 + F.lane] = a0; part[(F.wave * 4 + 1) * 64 + F.lane] = a1; part[(F.wave * 4 + 2) * 64 + F.lane] = a2; part[(F.wave * 4 + 3) * 64 + F.lane] = a3;
            __syncthreads();
            if (F.tid < 256 && (F.tid & 63) < 36) { const int b = F.tid >> 6, l = F.tid & 63; float sm = args.in[4][ch * 36 + l];
#pragma unroll
                for (int w = 0; w < 8; ++w) sm += part[(w * 4 + b) * 64 + l];
                mod[b * (NMOD * DM) + ch * 36 + l] = sm; }
            __syncthreads();
        }
        for (int idx = blockIdx.x * NTHR + F.tid; idx < MT * 48; idx += F.G * NTHR) { const int tok = idx / 48, i = idx % 48;
            const float inv = (i < 32) ? powf(10000.f, -(float)i / 32.f) : powf(10000.f, -(float)(i - 32) / 16.f);
            const float ang = (float)((const int*)args.in[2])[tok] * inv; tab[idx] = make_float2(cosf(ang), sinf(ang)); }
        tr_job_mapped(F, args, 0, 2 * FF, 0, DM, (h16*)(ws + OW_GU1), nullptr, scr, 0);
        if (F.G != 256) {
            tr_job_plain(F, args.in[8], DM, DM, FF, (h16*)(ws + OW_D1), scr, 768);
            tr_job_mapped(F, args, 2, NIN3, 0, DM, (h16*)(ws + OW_IN), nullptr, scr, 128);
            tr_job_plain(F, args.in[11] + C_GATE, DIN, 2048, DM, (h16*)(ws + OW_GATE), scr, 1664);
            tr_job_mapped(F, args, 3, 512, 2048, QL, (h16*)(ws + OW_4), args.in[12], scr, 640);
            tr_job_plain(F, args.in[19], DM, DM, 256, (h16*)(ws + OW_UPB), scr, 736);
            tr_job_plain(F, args.in[20], DM, DM, DM, (h16*)(ws + OW_O), scr, 864);
            tr_job_mapped(F, args, 1, 2 * FF, 0, DM, ws + OW_GU2, nullptr, scr, 1376);
            tr_job_plain(F, args.in[25], DM, DM, FF, ws + OW_D2, scr, 96);
            precomb_tiles(F, args, ws, 0, 192, (int)blockIdx.x, F.G);
            tr_job_plain(F, args.in[18], DM, DM, 512, (h16*)(ws + OW_UPA), scr, 256);
        }
    }
    SEAM(0);
    if (IN(1)) ph_normmod(F, args.in[0], args.in[5], mod, 1, 0, Hb);
    SEAM(1);
    if (IN(2)) { pg8::Gemm g{Hb, (const h16*)(ws + OW_GU1), MT, 2 * FF, DM}; pg8::StaticOrder S; S.init(MT, 2 * FF, F.G, (int)blockIdx.x); pg8::EpiSwiGLU E{Ab};
        pg8::gemm_phase<pg8::EpiSwiGLU, true>(F.lds, g, S, E);
        if (F.G == 256 && blockIdx.x >= 128) {
            Frame F2 = F; F2.gw = ((int)blockIdx.x - 128) * NWAVES + F.wave; F2.NGW = 128 * NWAVES; LAS float* scr = (LAS float*)(F.lds + F.wave * 16384);
            tr_job_plain(F2, args.in[8], DM, DM, FF, (h16*)(ws + OW_D1), scr, 0);
            tr_job_mapped(F2, args, 2, NIN3, 0, DM, (h16*)(ws + OW_IN), nullptr, scr, 384);
            tr_job_mapped(F2, args, 3, 512, 2048, QL, (h16*)(ws + OW_4), args.in[12], scr, 896);
            tr_job_mapped(F2, args, 1, 2 * FF, 0, DM, ws + OW_GU2, nullptr, scr, 640);
            precomb_tiles(F, args, ws, 0, 192, (int)blockIdx.x - 128, 128);
            for (int i = ((int)blockIdx.x - 128) * NTHR + F.tid; i < (int)(MiB / 16); i += 128 * NTHR) ((u32x4*)(ws + OW_BD))[i] = (u32x4){0u, 0u, 0u, 0u}; } }
    SEAM(2);
    if (IN(3)) { pg8::Gemm g{Ab, (const h16*)(ws + OW_D1), MT, DM, FF}; pg8::StaticOrder S; S.init(MT, DM, F.G, (int)blockIdx.x); pg8::EpiH16 E{(h16*)Fb};
        pg8::gemm_phase<pg8::EpiH16, false>(F.lds, g, S, E); }
    SEAM(3);
    if (IN(4)) ph_resnorm<false, true>(F, args.in[0], (const h16*)Fb, args.in[9], mod, 2, 0.5f, args.out, true, args.in[10], 4, 3, Hb);
    SEAM(4);
    if (IN(5)) { pg8::Gemm g{Hb, (const h16*)(ws + OW_IN), MT, NIN3, DM}; pg8::StaticOrder S; S.init(MT, NIN3, F.G, (int)blockIdx.x);
        pg8::EpiIn E{(h16*)(ws + OFF_CKV), (h16*)(ws + OFF_CQ), (h16*)(ws + OFF_KR), (h16*)(ws + OFF_KI), (h16*)(ws + OFF_QB), (h16*)(ws + OFF_KB), (h16*)(ws + OFF_VT), (float*)(ws + OFF_WI), (float*)(ws + OFF_SSQ),
                     args.in[13], tab, (LAS float*)(F.lds + XCH_OFF)};
        pg8::gemm_phase<pg8::EpiIn, true>(F.lds, g, S, E); }
    SEAM(5);
    if (IN(6)) { for (int tk_ = blockIdx.x * NTHR + F.tid; tk_ < MT; tk_ += F.G * NTHR) { const f32x4 s0 = *(const f32x4*)((const float*)(ws + OFF_SSQ) + tk_ * 8), s1 = *(const f32x4*)((const float*)(ws + OFF_SSQ) + tk_ * 8 + 4);
            ((float*)(ws + OFF_RSTDQ))[tk_] = rsqrtf((((s0.x + s0.y) + (s0.z + s0.w)) + ((s1.x + s1.y) + (s1.z + s1.w))) * (1.f / QL) + EPS); } }
    if (IN(6)) ph_dilated_mfma(F, (const h16*)(ws + OFF_QB), (const h16*)(ws + OFF_KB), (const h16*)(ws + OFF_VT), (h16*)(ws + OFF_OG), (float*)(ws + OFF_LSE));
    SEAM(6);
    if (IN(7)) { pg8::Gemm g{(const h16*)(ws + OFF_CQ), (const h16*)(ws + OW_4), MT, N4, QL}; pg8::StaticOrder S; S.init(MT, N4, F.G, (int)blockIdx.x);
        pg8::Epi4 E{(h16*)(ws + OFF_QLAT), (h16*)(ws + OFF_QR), (h16*)(ws + OFF_QI), (const float*)(ws + OFF_RSTDQ), tab};
        pg8::gemm_phase<pg8::Epi4, true>(F.lds, g, S, E);
        if (F.G == 256 && blockIdx.x >= 128) {
            Frame F2 = F; F2.gw = ((int)blockIdx.x - 128) * NWAVES + F.wave; F2.NGW = 128 * NWAVES; LAS float* scr = (LAS float*)(F.lds + F.wave * 16384);
            tr_job_plain(F2, args.in[11] + C_GATE, DIN, 2048, DM, (h16*)(ws + OW_GATE), scr, 0);
            tr_job_plain(F2, args.in[19], DM, DM, 256, (h16*)(ws + OW_UPB), scr, 512);
            tr_job_plain(F2, args.in[20], DM, DM, DM, (h16*)(ws + OW_O), scr, 640);
            tr_job_plain(F2, args.in[18], DM, DM, 512, (h16*)(ws + OW_UPA), scr, 256);
            for (int it = F2.gw; it < 4 * 16; it += F2.NGW) { const int kb = it >> 4, nb = it & 15, n0 = nb * 32, hl = (n0 >> 6) & 3;
                tr_item(args.in[16], 512, n0 + (F.lane & 31), true, nullptr, kb * 64, (h16*)(ws + OW_BD) + (size_t)n0 * 1024 + 256 * hl, 1024, scr, F.lane); } } }
    SEAM(7);
    if (IN(8)) { ph_combine(F, (const h16*)(ws + OFF_OG), (const float*)(ws + OFF_LSE), (h16*)(ws + OFF_OB));
        ph_topk_sparse(F, (const h16*)(ws + OFF_QI), (const h16*)(ws + OFF_KI), (const float*)(ws + OFF_WI), (unsigned short*)(ws + OFF_SEL),
                       (h16*)(ws + OFF_QLAT), (const h16*)(ws + OFF_QR), (const unsigned char*)(ws + OFF_CKV), (const unsigned char*)(ws + OFF_KR)); }
    SEAM(8);
    if (IN(9) && F.G == 256) { const bool first = blockIdx.x < 128;
        pg8::Gemm g{first ? (const h16*)(ws + OFF_QLAT) : (const h16*)(ws + OFF_OB), first ? (const h16*)(ws + OW_BD) : (const h16*)(ws + OW_UPB), MT, first ? 512 : DM, first ? 1024 : 256, first ? 2048 : 0, first ? 1024 : 0};
        pg8::StaticOrder S; S.init(MT, first ? 512 : DM, 128, first ? (int)blockIdx.x : (int)blockIdx.x - 128);
        pg8::EpiH16 E{first ? (h16*)(ws + OFF_OA) : (h16*)(ws + OFF_Y2), first ? 512 : DM};
        pg8::gemm_phase<pg8::EpiH16, false>(F.lds, g, S, E); }
    SEAM(9);
    if (IN(10)) { pg8::StaticOrder S; S.init(MT, DM, F.G, (int)blockIdx.x); h16* Y1 = (h16*)(ws + OFF_Y1); h16* Y2 = (h16*)(ws + OFF_Y2);
        { pg8::Gemm g{(const h16*)(ws + OFF_OA), (const h16*)(ws + OW_UPA), MT, DM, 512}; pg8::EpiH16 E{Y1}; pg8::gemm_phase<pg8::EpiH16, false>(F.lds, g, S, E); }
        { pg8::Gemm g{Hb, (const h16*)(ws + OW_GATE), MT, DM, DM}; pg8::EpiGate E{Y1, Y1, 0}; pg8::gemm_phase<pg8::EpiGate, false>(F.lds, g, S, E); }
        { pg8::Gemm g{Hb, (const h16*)(ws + OW_GATE) + (size_t)DM * DM, MT, DM, DM}; pg8::EpiGate E{Y2, Y1, 1}; pg8::gemm_phase<pg8::EpiGate, false>(F.lds, g, S, E); } }
    SEAM(10);
    if (IN(11)) { pg8::Gemm g{(const h16*)(ws + OFF_Y1), (const h16*)(ws + OW_O), MT, DM, DM}; pg8::StaticOrder S; S.init(MT, DM, F.G, (int)blockIdx.x); pg8::EpiH16 E{(h16*)(ws + OFF_YF)};
        pg8::gemm_phase<pg8::EpiH16, false>(F.lds, g, S, E); }
    SEAM(11);
    if (IN(12)) ph_resnorm<true, true, unsigned char>(F, args.out, (const h16*)(ws + OFF_YF), args.in[21], mod, 5, 1.0f, ws + OFF_F, true, args.in[22], 7, 6, ws + OFF_H);
    SEAM(12);
    if (IN(13)) { pg8::Gemm g{Hb, (const h16*)(ws + OW_GU2), MT, 2 * FF, DM / 2}; pg8::StaticOrder S; S.init(MT, 2 * FF, F.G, (int)blockIdx.x); pg8::EpiSwiGLU_T<true> E{Ab};
        pg8::gemm_phase<pg8::EpiSwiGLU_T<true>, true, true>(F.lds, g, S, E);
        if (F.G == 256 && blockIdx.x >= 128) { Frame F2 = F; F2.gw = ((int)blockIdx.x - 128) * NWAVES + F.wave; F2.NGW = 128 * NWAVES;
            tr_job_plain(F2, args.in[25], DM, DM, FF, ws + OW_D2, (LAS float*)(F.lds + F.wave * 16384), 0); } }
    SEAM(13);
    if (IN(14)) { pg8::Gemm g{Ab, (const h16*)(ws + OW_D2), MT, DM, FF / 2}; pg8::StaticOrder S; S.init(MT, DM, F.G, (int)blockIdx.x); pg8::EpiH16_T<true> E{(h16*)(ws + OFF_F + 32 * MiB)};
        pg8::gemm_phase<pg8::EpiH16_T<true>, false, true>(F.lds, g, S, E); }
    SEAM(14);
    if (IN(15)) ph_resnorm<true, false>(F, ws + OFF_F, (const h16*)(ws + OFF_F + 32 * MiB), args.in[26], mod, 8, 0.5f, args.out, false, nullptr, 0, 0, (h16*)nullptr);
#undef IN
#undef SEAM
}


extern "C" void kernel_launch(void* const* d_in, const int* in_sizes, int n_in, void* d_out, int out_size, void* d_ws, size_t ws_size, hipStream_t stream) {
    if (n_in != 27 || ws_size < WS_END || out_size != MT * DM) { fprintf(stderr, "kernel_launch: unexpected shapes (n_in %d ws %zu out %d)\n", n_in, ws_size, out_size); return; }
    static int grid = 0;
    if (grid == 0) {
        int dev = 0, cus = 0, per_cu = 0;
        if (hipGetDevice(&dev) != hipSuccess || hipDeviceGetAttribute(&cus, hipDeviceAttributeMultiprocessorCount, dev) != hipSuccess) { grid = -1; return; }
        if (hipFuncSetAttribute((const void*)mega_fwd, hipFuncAttributeMaxDynamicSharedMemorySize, LDS_BYTES) != hipSuccess) { fprintf(stderr, "kernel_launch: hipFuncSetAttribute failed\n"); grid = -1; return; }
        if (hipOccupancyMaxActiveBlocksPerMultiprocessor(&per_cu, (const void*)mega_fwd, NTHR, LDS_BYTES) != hipSuccess || per_cu < 1) { fprintf(stderr, "kernel_launch: occupancy query says %d blocks/CU\n", per_cu); grid = -1; return; }
        grid = cus;
    }
    if (grid < 0) return;
    hipMemsetAsync((char*)d_ws + OFF_CTL, 0, 1 * MiB, stream);
    Args a{}; for (int i = 0; i < 27; ++i) a.in[i] = (const float*)d_in[i]; a.out = (float*)d_out; a.ws = (unsigned char*)d_ws; a.ph_lo = 0; a.ph_hi = 16;
    void* kargs[] = {&a};
#ifdef PH_DOUBLE
    a.ph_hi = PH_DOUBLE + 1; (void)hipLaunchCooperativeKernel((const void*)mega_fwd, dim3(grid), dim3(NTHR), kargs, LDS_BYTES, stream);
    hipMemsetAsync((char*)d_ws + OFF_CTL, 0, 1 * MiB, stream); a.ph_lo = PH_DOUBLE; a.ph_hi = 16;
#endif
    const hipError_t e = hipLaunchCooperativeKernel((const void*)mega_fwd, dim3(grid), dim3(NTHR), kargs, LDS_BYTES, stream);
    if (e != hipSuccess) fprintf(stderr, "kernel_launch: cooperative launch failed: %s (grid %d)\n", hipGetErrorString(e), grid);
    (void)in_sizes;
}
```

```cpp
#include <hip/hip_runtime.h>
#include <hip/hip_fp16.h>
#include <cstdio>
#include <cstdint>

constexpr int NB = 4, SEQ = 4096, DM = 1024, MT = NB * SEQ, FF = 2816;
constexpr int QL = 384, KVL = 256, DNOPE = 64, DROPE = 32, DVA = 64, HA = 8, HI = 8, DI = 32, TOPK = 256;
constexpr int NG = 3, HB = 4, DHB = 64, NMOD = 9, DIN = 5064;
constexpr int C_CQ = 0, C_CKV = 384, C_KR = 640, C_KI = 672, C_WI = 704, C_QKV = 712, C_GATE = 3016;
constexpr float EPS = 1e-6f, LOG2E = 1.4426950408889634f;
typedef _Float16 h16;

constexpr size_t MiB = 1u << 20;
constexpr size_t OFF_CTL = 0, OFF_MOD = 1 * MiB, OFF_ROPE = 2 * MiB, OFF_W = 8 * MiB, OFF_H = 60 * MiB, OFF_A = 92 * MiB, OFF_F = 180 * MiB, OFF_SP = 244 * MiB, WS_END = 256 * MiB;
constexpr size_t OFF_QB = OFF_A, OFF_KB = OFF_A + 24 * MiB, OFF_VT = OFF_A + 48 * MiB, OFF_CKV = OFF_A + 72 * MiB, OFF_KR = OFF_A + 80 * MiB, OFF_KI = OFF_A + 81 * MiB,
                 OFF_WI = OFF_A + 82 * MiB, OFF_SSQ = OFF_A + 82 * MiB + 512 * 1024, OFF_CQ = OFF_SP;
constexpr size_t OFF_RSTDQ = OFF_A + 83 * MiB;
constexpr size_t OFF_OG = OFF_F, OFF_LSE = OFF_F + 24 * MiB, OFF_QLAT = OFF_A, OFF_QR = OFF_A + 64 * MiB, OFF_QI = OFF_F + 25 * MiB, OFF_SEL = OFF_F + 33 * MiB, OFF_OB = OFF_SP;
constexpr size_t OFF_Y1 = OFF_F, OFF_Y2 = OFF_F + 32 * MiB, OFF_YF = OFF_A;

__device__ __forceinline__ float silu_f(float v) { return v / (1.f + __expf(-v)); }
__device__ __forceinline__ float sigm_f(float v) { return 1.f / (1.f + __expf(-v)); }
__host__ __device__ __forceinline__ int dil_of(int g) { return g == 0 ? 1 : (g == 1 ? 4 : 16); }
__device__ __forceinline__ unsigned fkey(float f) { const unsigned u = __float_as_uint(f); return (u & 0x80000000u) ? ~u : (u | 0x80000000u); }


#define LAS __attribute__((address_space(3)))
#define GAS __attribute__((address_space(1)))
typedef _Float16 f16x8 __attribute__((ext_vector_type(8)));
typedef float f32x4 __attribute__((ext_vector_type(4)));
typedef float f32x2 __attribute__((ext_vector_type(2)));
typedef unsigned u32x4 __attribute__((ext_vector_type(4)));
typedef unsigned u32x2 __attribute__((ext_vector_type(2)));
typedef _Float16 h16x2 __attribute__((ext_vector_type(2)));
__device__ __forceinline__ unsigned pk_h2(float lo, float hi) { f32x2 v = {lo, hi}; h16x2 h = __builtin_convertvector(v, h16x2); return __builtin_bit_cast(unsigned, h); }
__device__ __forceinline__ int flane() { int l; asm volatile("v_mbcnt_lo_u32_b32 %0, -1, 0\n\tv_mbcnt_hi_u32_b32 %0, -1, %0" : "=v"(l)); return l; }
__device__ __forceinline__ float sat8(float x) { return __builtin_amdgcn_fmed3f(x, -448.f, 448.f); }
__device__ __forceinline__ unsigned pk_f8x4(float a, float b, float c, float d) { int w = __builtin_amdgcn_cvt_pk_fp8_f32(sat8(a), sat8(b), 0, false); w = __builtin_amdgcn_cvt_pk_fp8_f32(sat8(c), sat8(d), w, true); return (unsigned)w; }
typedef int i32x4 __attribute__((ext_vector_type(4)));
typedef int i32x8 __attribute__((ext_vector_type(8)));
constexpr float F8_ACT = 8.f, F8_WGT = 512.f, F8_INV = 1.f / (F8_ACT * F8_WGT);

namespace pg8 {
constexpr int BM = 256, BK = 64, HALF = 128, HTB = HALF * BK * 2, STAGE_BYTES = 8 * HTB, NXCD = 8, WGM = 8;
__host__ __device__ __forceinline__ int lds_byte(int r, int c) { const int st = (r >> 4) * 2 + (c >> 5), rr = r & 15, cc = c & 31, ob = rr * 64 + cc * 2; return st * 1024 + (ob ^ (((ob >> 9) & 1) << 5)); }
__host__ __device__ __forceinline__ void stage_rc(int b, int& R, int& C) { const int st = b / 1024, sb = b % 1024, swz = sb ^ (((sb >> 9) & 1) << 5); R = (st >> 1) * 16 + swz / 64; C = (st & 1) * 32 + (swz % 64) / 2; }
__host__ __device__ __forceinline__ int perm32(int rho) { const int n = rho >> 4, i = rho & 15; return 8 * (i >> 2) + 4 * n + (i & 3); }
struct Unit { int pm, pn; };
struct Gemm { const h16* A; const h16* Bt; int M, N, K; int lda = 0, koffA = 0; };
struct StaticOrder {
    int nM, nN, nwg, G, c;
    __host__ __device__ void init(int M, int N, int G_, int c_) { nM = M / BM; nN = N / BM; nwg = nM * nN; G = G_; c = c_; }
    __host__ __device__ bool next(int i, Unit& u) const {
        const long L = (long)i * G + c; if (L >= nwg) return false;
        int wgid = (int)L; { const int q = nwg / NXCD, r = nwg % NXCD, xcd = wgid % NXCD, off = wgid / NXCD; wgid = (xcd < r ? xcd * (q + 1) : r * (q + 1) + (xcd - r) * q) + off; }
        const int nig = WGM * nN, gid = wgid / nig, fm = gid * WGM, gsz = (nM - fm) < WGM ? (nM - fm) : WGM;
        u.pm = fm + ((wgid % nig) % gsz); u.pn = (wgid % nig) / gsz; return true;
    }
};
template <class Epi, bool ALIGN_EPI, bool F8 = false>
__device__ __forceinline__ void gemm_phase(LAS unsigned char* lds, const Gemm g, const StaticOrder& S, const Epi& E, const int wid) {
    const int lane = flane(), tid = wid * 64 + lane, wr = wid >> 2, wc = wid & 3, fr = lane & 15, fq = lane >> 4;
    const int K = g.K, lda = g.lda ? g.lda : g.K; int nt = K / BK;
    if constexpr (F8) asm volatile("" : "+s"(nt));
    unsigned voffA[2], voffB[2];
#pragma unroll
    for (int i = 0; i < 2; ++i) { int R, C; stage_rc(tid * 16 + i * 8192, R, C); const int Rb = Epi::PERM ? ((R & ~31) + perm32(R & 31)) : R;
        voffA[i] = (unsigned)(R * lda + C) * 2u; voffB[i] = (unsigned)(Rb * K + C) * 2u; }
    const size_t kstep = (size_t)(BK * 2);
    const size_t hstep = (size_t)HALF * K * 2, hstepA = (size_t)HALF * lda * 2;
    const size_t tstep = 2 * hstep, tstepA = 2 * hstepA, kofA = (size_t)g.koffA * 2;
    const unsigned ldsw = (unsigned)wid * 1024u;
    const int aoff = lds_byte(wr * 64 + fr, fq * 8), boff = lds_byte(wc * 32 + fr, fq * 8);
#define PG8_SA(b, h) (((b) * 2 + (h)) * HTB)
#define PG8_SB(b, h) ((4 + (b) * 2 + (h)) * HTB)
#define PG8_STAGE(bufoff, gbase, voff) do { _Pragma("unroll") for (int _i = 0; _i < 2; ++_i) { unsigned _vo = (voff)[_i]; asm volatile("" : "+v"(_vo)); \
        __builtin_amdgcn_global_load_lds((const unsigned*)((const char*)(gbase) + _vo), (LAS unsigned*)(lds + (bufoff) + ldsw + _i * 8192), 16, 0, 0); } } while (0)
#define PG8_LDA(dst, b, h) do { _Pragma("unroll") for (int m = 0; m < 4; ++m) _Pragma("unroll") for (int k = 0; k < 2; ++k) dst[m][k] = *(const LAS f16x8*)(lds + PG8_SA(b, h) + aoff + m * 2048 + k * 1024); } while (0)
#define PG8_LDB(dst, b, h) do { _Pragma("unroll") for (int n = 0; n < 2; ++n) _Pragma("unroll") for (int k = 0; k < 2; ++k) dst[n][k] = *(const LAS f16x8*)(lds + PG8_SB(b, h) + boff + n * 2048 + k * 1024); } while (0)
#define PG8_CAT8(x, y) __builtin_shufflevector(__builtin_bit_cast(i32x4, x), __builtin_bit_cast(i32x4, y), 0, 1, 2, 3, 4, 5, 6, 7)
#define PG8_MMA(ai, bj, At, Bt) do { __builtin_amdgcn_s_setprio(1); \
        if constexpr (F8) { _Pragma("unroll") for (int m = 0; m < 4; ++m) _Pragma("unroll") for (int n = 0; n < 2; ++n) \
            acc[ai][bj][m][n] = __builtin_amdgcn_mfma_scale_f32_16x16x128_f8f6f4(PG8_CAT8(Bt[n][0], Bt[n][1]), PG8_CAT8(At[m][0], At[m][1]), acc[ai][bj][m][n], 0, 0, 0, 0, 0, 0); } \
        else { _Pragma("unroll") for (int m = 0; m < 4; ++m) _Pragma("unroll") for (int n = 0; n < 2; ++n) _Pragma("unroll") for (int k = 0; k < 2; ++k) \
            acc[ai][bj][m][n] = __builtin_amdgcn_mfma_f32_16x16x32_f16(Bt[n][k], At[m][k], acc[ai][bj][m][n], 0, 0, 0); } \
        __builtin_amdgcn_s_setprio(0); } while (0)
#define PG8_WAIT_V(n) asm volatile("s_waitcnt vmcnt(" #n ")" ::: "memory")
#define PG8_WAIT_L(n) asm volatile("s_waitcnt lgkmcnt(" #n ")" ::: "memory")
#define PG8_BAR __builtin_amdgcn_s_barrier()
#define PG8_SCHED __builtin_amdgcn_sched_barrier(0)
    Unit cur, nxt; int ui = 0;
    if (!S.next(0, cur)) return;
    f32x4 acc[2][2][4][2];
#pragma unroll
    for (int a = 0; a < 2; ++a)
#pragma unroll
        for (int b = 0; b < 2; ++b)
#pragma unroll
            for (int m = 0; m < 4; ++m)
#pragma unroll
                for (int n = 0; n < 2; ++n) acc[a][b][m][n] = (f32x4){0.f, 0.f, 0.f, 0.f};
    f16x8 At[4][2], B0[2][2], B1[2][2];
    const char* cA = (const char*)g.A + (size_t)cur.pm * tstepA + (size_t)cur.pn * kofA; const char* cB = (const char*)g.Bt + (size_t)cur.pn * tstep;
    PG8_STAGE(PG8_SB(0, 0), cB, voffB); PG8_STAGE(PG8_SB(0, 1), cB + hstep, voffB); PG8_STAGE(PG8_SA(0, 0), cA, voffA); PG8_STAGE(PG8_SA(0, 1), cA + hstepA, voffA);
    if (wr == 1) PG8_BAR;
    PG8_WAIT_V(2); PG8_BAR;
    PG8_STAGE(PG8_SB(1, 0), cB + kstep, voffB); PG8_STAGE(PG8_SA(1, 0), cA + kstep, voffA); PG8_STAGE(PG8_SB(1, 1), cB + hstep + kstep, voffB);
    PG8_WAIT_V(6); PG8_BAR;
    for (;;) {
        const bool has_next = S.next(ui + 1, nxt);
        const char* nA = has_next ? (const char*)g.A + (size_t)nxt.pm * tstepA + (size_t)nxt.pn * kofA : cA; const char* nB = has_next ? (const char*)g.Bt + (size_t)nxt.pn * tstep : cB;
        for (int t = 0; t < nt; t += 2) {
            const bool last = (t == nt - 2);
            const char* a1 = cA + (size_t)(t + 1) * kstep;
            const char* a2 = last ? nA : cA + (size_t)(t + 2) * kstep; const char* b2 = last ? nB : cB + (size_t)(t + 2) * kstep;
            const char* a3 = a2 + kstep; const char* b3 = b2 + kstep;
            PG8_LDB(B0, 0, 0); PG8_LDB(B1, 0, 1); PG8_SCHED; PG8_LDA(At, 0, 0); PG8_STAGE(PG8_SA(1, 1), a1 + hstepA, voffA);
            PG8_WAIT_V(8); PG8_WAIT_L(0); PG8_BAR; PG8_MMA(0, 0, At, B0); PG8_MMA(0, 1, At, B1); PG8_BAR; PG8_SCHED;
            PG8_LDA(At, 0, 1); PG8_STAGE(PG8_SB(0, 0), b2, voffB); PG8_STAGE(PG8_SB(0, 1), b2 + hstep, voffB); PG8_STAGE(PG8_SA(0, 0), a2, voffA);
            PG8_WAIT_V(8); PG8_WAIT_L(0); PG8_BAR; PG8_MMA(1, 0, At, B0); PG8_MMA(1, 1, At, B1); PG8_BAR; PG8_SCHED;
            PG8_LDB(B0, 1, 0); PG8_LDB(B1, 1, 1); PG8_SCHED; PG8_LDA(At, 1, 0); PG8_STAGE(PG8_SA(0, 1), a2 + hstepA, voffA);
            PG8_WAIT_V(8); PG8_WAIT_L(0); PG8_BAR; PG8_MMA(0, 0, At, B0); PG8_MMA(0, 1, At, B1); PG8_BAR; PG8_SCHED;
            PG8_LDA(At, 1, 1); PG8_STAGE(PG8_SB(1, 0), b3, voffB); PG8_STAGE(PG8_SB(1, 1), b3 + hstep, voffB); PG8_STAGE(PG8_SA(1, 0), a3, voffA);
            PG8_WAIT_V(8); PG8_WAIT_L(0); PG8_BAR; PG8_MMA(1, 0, At, B0); PG8_MMA(1, 1, At, B1); PG8_BAR; PG8_SCHED;
        }
        if constexpr (ALIGN_EPI) { if (wr == 0) PG8_BAR; }
        { const int l2 = flane(); E(acc, cur, wr, wc, l2 & 15, l2 >> 4); }
        if (!has_next) break;
#pragma unroll
        for (int a = 0; a < 2; ++a)
#pragma unroll
            for (int b = 0; b < 2; ++b)
#pragma unroll
                for (int m = 0; m < 4; ++m)
#pragma unroll
                    for (int n = 0; n < 2; ++n) acc[a][b][m][n] = (f32x4){0.f, 0.f, 0.f, 0.f};
        cur = nxt; cA = nA; cB = nB; ++ui;
        if constexpr (ALIGN_EPI) { if (wr == 1) PG8_BAR; }
    }
    PG8_WAIT_V(0);
    if constexpr (!ALIGN_EPI) { if (wr == 0) PG8_BAR; }
    PG8_BAR;
#undef PG8_SA
#undef PG8_SB
#undef PG8_STAGE
#undef PG8_LDA
#undef PG8_LDB
#undef PG8_MMA
#undef PG8_CAT8
#undef PG8_WAIT_V
#undef PG8_WAIT_L
#undef PG8_BAR
#undef PG8_SCHED
}
struct EpiF32 {
    static constexpr bool PERM = false;
    float* C; int ldc;
    __device__ __forceinline__ void operator()(const f32x4 (&acc)[2][2][4][2], const Unit& u, int wr, int wc, int fr, int fq) const {
        const int row0 = u.pm * BM + wr * 64 + fr, col0 = u.pn * BM + wc * 32 + 4 * fq;
#pragma unroll
        for (int ai = 0; ai < 2; ++ai)
#pragma unroll
            for (int m = 0; m < 4; ++m) { float* rowp = C + (size_t)(row0 + ai * HALF + m * 16) * ldc + col0;
#pragma unroll
                for (int bj = 0; bj < 2; ++bj)
#pragma unroll
                    for (int n = 0; n < 2; ++n) *(f32x4*)(rowp + bj * HALF + n * 16) = acc[ai][bj][m][n]; }
    }
};
template <bool F8>
struct EpiSwiGLU_T {
    static constexpr bool PERM = true;
    void* O;
    __device__ __forceinline__ void operator()(const f32x4 (&acc)[2][2][4][2], const Unit& u, int wr, int wc, int fr, int fq) const {
        const int row0 = u.pm * BM + wr * 64 + fr, col0 = u.pn * HALF + wc * 32 + 8 * fq;
#pragma unroll
        for (int ai = 0; ai < 2; ++ai)
#pragma unroll
            for (int m = 0; m < 4; ++m) { const size_t eo = (size_t)(row0 + ai * HALF + m * 16) * FF + col0;
                float v[8];
#pragma unroll
                for (int n = 0; n < 2; ++n)
#pragma unroll
                    for (int e = 0; e < 4; ++e) { float gg = acc[ai][0][m][n][e], uu = acc[ai][1][m][n][e]; if constexpr (F8) { gg *= F8_INV; uu *= F8_INV * F8_ACT; }
                        v[n * 4 + e] = gg * __builtin_amdgcn_rcpf(1.f + __builtin_amdgcn_exp2f(-gg * LOG2E)) * uu; }
                if constexpr (F8) { u32x2 w; w.x = pk_f8x4(v[0], v[1], v[2], v[3]); w.y = pk_f8x4(v[4], v[5], v[6], v[7]); *(u32x2*)((unsigned char*)O + eo) = w; }
                else { u32x4 w; w.x = pk_h2(v[0], v[1]); w.y = pk_h2(v[2], v[3]); w.z = pk_h2(v[4], v[5]); w.w = pk_h2(v[6], v[7]); *(u32x4*)((h16*)O + eo) = w; } }
    }
};
typedef EpiSwiGLU_T<false> EpiSwiGLU;

struct EpiIn {
    static constexpr bool PERM = false;
    h16 *ckv, *cq, *kr, *ki, *qb, *kb, *vT; float *wi, *ssq; const float* gckv; const float2* tab; LAS float* X;
    __device__ __forceinline__ void rope64(const f32x4 (&acc)[2][2][4][2], const Unit& u, int wr, int wc, int fr, int fq, h16* dst, int tl, float scale) const {
        const int tok0 = u.pm * BM + wr * 64 + fr;
        f32x4 tc[4], tn[4];
        { const f32x4* tp = (const f32x4*)(tab + (size_t)tok0 * 48 + 4 * fq); tc[0] = tp[0]; tc[1] = tp[1]; tc[2] = tp[8]; tc[3] = tp[9]; }
#pragma unroll
        for (int rr = 0; rr < 8; ++rr) { const int ai = rr >> 2, m = rr & 3, tok = tok0 + ai * HALF + m * 16;
            if (rr < 7) { const int tokn = tok0 + ((rr + 1) >> 2) * HALF + ((rr + 1) & 3) * 16; const f32x4* tp = (const f32x4*)(tab + (size_t)tokn * 48 + 4 * fq); tn[0] = tp[0]; tn[1] = tp[1]; tn[2] = tp[8]; tn[3] = tp[9]; }
#pragma unroll
            for (int n = 0; n < 2; ++n) { const int i = 16 * n + 4 * fq; const f32x4 t0 = tc[2 * n], t1 = tc[2 * n + 1];
                const f32x4 cs = {t0.x, t0.z, t1.x, t1.z}, sn = {t0.y, t0.w, t1.y, t1.w}, x1 = acc[ai][0][m][n], x2 = acc[ai][1][m][n];
                const f32x4 o1 = (x1 * cs - x2 * sn) * scale, o2 = (x2 * cs + x1 * sn) * scale;
                h16* p = dst + (size_t)tok * 768 + (4 * tl + wc) * 64 + i;
                u32x2 w1, w2; w1.x = pk_h2(o1.x, o1.y); w1.y = pk_h2(o1.z, o1.w); w2.x = pk_h2(o2.x, o2.y); w2.y = pk_h2(o2.z, o2.w);
                *(u32x2*)p = w1; *(u32x2*)(p + 32) = w2; }
#pragma unroll
            for (int k = 0; k < 4; ++k) tc[k] = tn[k];
            asm volatile("" ::: "memory"); }
    }
    __device__ __forceinline__ void operator()(const f32x4 (&acc)[2][2][4][2], const Unit& u, int wr, int wc, int fr, int fq) const {
        const int pn = u.pn;
        if (pn == 0) {
#pragma unroll
            for (int ai = 0; ai < 2; ++ai)
#pragma unroll
                for (int m = 0; m < 4; ++m) { float sq = 0.f;
#pragma unroll
                    for (int bj = 0; bj < 2; ++bj)
#pragma unroll
                        for (int n = 0; n < 2; ++n) { const f32x4 v = acc[ai][bj][m][n]; sq += (v.x * v.x + v.y * v.y) + (v.z * v.z + v.w * v.w); }
                    sq += __shfl_xor(sq, 16); sq += __shfl_xor(sq, 32);
                    if (fq == 0) X[(ai * HALF + wr * 64 + m * 16 + fr) * 4 + wc] = sq; }
            asm volatile("s_waitcnt lgkmcnt(0)" ::: "memory"); __builtin_amdgcn_s_barrier(); asm volatile("" ::: "memory");
#pragma unroll
            for (int ai = 0; ai < 2; ++ai)
#pragma unroll
                for (int m = 0; m < 4; ++m) { const int rl = ai * HALF + wr * 64 + m * 16 + fr, tok = u.pm * BM + rl; const f32x4 p = *(const LAS f32x4*)(X + rl * 4);
                    const float rstd = rsqrtf(((p.x + p.y) + (p.z + p.w)) * (1.f / KVL) + EPS);
#pragma unroll
                    for (int bj = 0; bj < 2; ++bj)
#pragma unroll
                        for (int n = 0; n < 2; ++n) { const int col = bj * HALF + wc * 32 + n * 16 + 4 * fq; const f32x4 o = acc[ai][bj][m][n] * rstd * *(const f32x4*)(gckv + col);
                            int w8 = __builtin_amdgcn_cvt_pk_fp8_f32(o.x, o.y, 0, false); w8 = __builtin_amdgcn_cvt_pk_fp8_f32(o.z, o.w, w8, true);
                            *(int*)((unsigned char*)ckv + (size_t)tok * KVL + col) = w8; }
                    asm volatile("" ::: "memory"); }
            asm volatile("s_waitcnt lgkmcnt(0)" ::: "memory"); __builtin_amdgcn_s_barrier(); asm volatile("" ::: "memory");
        } else if (pn <= 2) {
#pragma unroll
            for (int ai = 0; ai < 2; ++ai)
#pragma unroll
                for (int m = 0; m < 4; ++m) { const int tok = u.pm * BM + ai * HALF + wr * 64 + m * 16 + fr; float sq = 0.f;
#pragma unroll
                    for (int bj = 0; bj < 2; ++bj) { if (pn == 2 && bj == 1) break;
#pragma unroll
                        for (int n = 0; n < 2; ++n) { const f32x4 v = acc[ai][bj][m][n]; sq += (v.x * v.x + v.y * v.y) + (v.z * v.z + v.w * v.w);
                            const int col = (pn - 1) * 256 + bj * HALF + wc * 32 + n * 16 + 4 * fq; u32x2 w; w.x = pk_h2(v.x, v.y); w.y = pk_h2(v.z, v.w); *(u32x2*)(cq + (size_t)tok * QL + col) = w; } }
                    sq += __shfl_xor(sq, 16); sq += __shfl_xor(sq, 32);
                    if (fq == 0) ssq[tok * 8 + (pn - 1) * 4 + wc] = sq;
                    if (pn == 2) {
                        if (wc < 2) { const int i = 4 * fq; const f32x4* tp = (const f32x4*)(tab + (size_t)tok * 48 + 32 + i); const f32x4 t0 = tp[0], t1 = tp[1];
                            const f32x4 cs = {t0.x, t0.z, t1.x, t1.z}, sn = {t0.y, t0.w, t1.y, t1.w}, x1 = acc[ai][1][m][0], x2 = acc[ai][1][m][1];
                            const f32x4 o1 = x1 * cs - x2 * sn, o2 = x2 * cs + x1 * sn;
                            if (wc == 0) { unsigned char* p8 = (unsigned char*)kr + (size_t)tok * 32 + i;
                                int a8 = __builtin_amdgcn_cvt_pk_fp8_f32(o1.x, o1.y, 0, false); a8 = __builtin_amdgcn_cvt_pk_fp8_f32(o1.z, o1.w, a8, true);
                                int b8 = __builtin_amdgcn_cvt_pk_fp8_f32(o2.x, o2.y, 0, false); b8 = __builtin_amdgcn_cvt_pk_fp8_f32(o2.z, o2.w, b8, true);
                                *(int*)p8 = a8; *(int*)(p8 + 16) = b8; }
                            else { h16* p = ki + (size_t)tok * 32 + i;
                                u32x2 w1, w2; w1.x = pk_h2(o1.x, o1.y); w1.y = pk_h2(o1.z, o1.w); w2.x = pk_h2(o2.x, o2.y); w2.y = pk_h2(o2.z, o2.w);
                                *(u32x2*)p = w1; *(u32x2*)(p + 16) = w2; } }
                        else if (wc == 2 && fq < 2) { *(f32x4*)(wi + tok * 8 + 4 * fq) = acc[ai][1][m][0] * 0.35355339059327373f; }
                    }
                    asm volatile("" ::: "memory"); }
        } else if (pn <= 5) rope64(acc, u, wr, wc, fr, fq, qb, pn - 3, 0.125f * LOG2E);
        else if (pn <= 8) rope64(acc, u, wr, wc, fr, fq, kb, pn - 6, 1.0f);
        else {
#pragma unroll
            for (int ai = 0; ai < 2; ++ai)
#pragma unroll
                for (int m = 0; m < 4; ++m) { const int tok = u.pm * BM + ai * HALF + wr * 64 + m * 16 + fr;
#pragma unroll
                    for (int bj = 0; bj < 2; ++bj)
#pragma unroll
                        for (int n = 0; n < 2; ++n) { const f32x4 v = acc[ai][bj][m][n]; u32x2 w; w.x = pk_h2(v.x, v.y); w.y = pk_h2(v.z, v.w);
                            *(u32x2*)(vT + (size_t)tok * 768 + (pn - 9) * 256 + bj * HALF + wc * 32 + n * 16 + 4 * fq) = w; }
                    asm volatile("" ::: "memory"); }
        }
    }
};
struct Epi4 {
    static constexpr bool PERM = true;
    h16 *qlat, *qr, *qi; const float* rstdq; const float2* tab;
    __device__ __forceinline__ void operator()(const f32x4 (&acc)[2][2][4][2], const Unit& u, int wr, int wc, int fr, int fq) const {
        const int pn = u.pn; const float c2 = 0.10206207261596575f * LOG2E;
        const int tok0 = u.pm * BM + wr * 64 + fr;
        float rc = rstdq[tok0], rn = 0.f;
        if (pn < 8) {
#pragma unroll
            for (int rr = 0; rr < 8; ++rr) { const int ai = rr >> 2, m = rr & 3, tok = tok0 + ai * HALF + m * 16;
                if (rr < 7) rn = rstdq[tok0 + ((rr + 1) >> 2) * HALF + ((rr + 1) & 3) * 16];
#pragma unroll
                for (int bj = 0; bj < 2; ++bj) { const f32x4 o0 = acc[ai][bj][m][0] * (rc * c2), o1 = acc[ai][bj][m][1] * (rc * c2);
                    u32x4 w; w.x = pk_h2(o0.x, o0.y); w.y = pk_h2(o0.z, o0.w); w.z = pk_h2(o1.x, o1.y); w.w = pk_h2(o1.z, o1.w);
                    *(u32x4*)(qlat + (size_t)tok * 2048 + pn * 256 + bj * HALF + wc * 32 + 8 * fq) = w; }
                rc = rn; asm volatile("" ::: "memory"); }
        } else { h16* dst = (pn == 8) ? qr : qi; const float c2e = (pn == 8) ? c2 : 1.f; const int i = 4 * fq;
            f32x4 tc[2], tn[2];
            { const f32x4* tp = (const f32x4*)(tab + (size_t)tok0 * 48 + 32 + i); tc[0] = tp[0]; tc[1] = tp[1]; }
#pragma unroll
            for (int rr = 0; rr < 8; ++rr) { const int ai = rr >> 2, m = rr & 3, tok = tok0 + ai * HALF + m * 16;
                if (rr < 7) { const int tokn = tok0 + ((rr + 1) >> 2) * HALF + ((rr + 1) & 3) * 16; const f32x4* tp = (const f32x4*)(tab + (size_t)tokn * 48 + 32 + i); tn[0] = tp[0]; tn[1] = tp[1]; rn = rstdq[tokn]; }
                const f32x4 cs = {tc[0].x, tc[0].z, tc[1].x, tc[1].z}, sn = {tc[0].y, tc[0].w, tc[1].y, tc[1].w}; const float sc = rc * c2e;
#pragma unroll
                for (int bj = 0; bj < 2; ++bj) { const f32x4 x1 = acc[ai][bj][m][0], x2 = acc[ai][bj][m][1]; const f32x4 o1 = (x1 * cs - x2 * sn) * sc, o2 = (x2 * cs + x1 * sn) * sc;
                    h16* p = dst + (size_t)tok * 256 + (4 * bj + wc) * 32 + i;
                    u32x2 w1, w2; w1.x = pk_h2(o1.x, o1.y); w1.y = pk_h2(o1.z, o1.w); w2.x = pk_h2(o2.x, o2.y); w2.y = pk_h2(o2.z, o2.w);
                    *(u32x2*)p = w1; *(u32x2*)(p + 16) = w2; }
                tc[0] = tn[0]; tc[1] = tn[1]; rc = rn;
                asm volatile("" ::: "memory"); } }
    }
};
__device__ __forceinline__ u32x4 ld16_l2(const h16* p) {
    const unsigned long long a = __hip_atomic_load((const unsigned long long*)p, __ATOMIC_RELAXED, __HIP_MEMORY_SCOPE_AGENT), b = __hip_atomic_load((const unsigned long long*)p + 1, __ATOMIC_RELAXED, __HIP_MEMORY_SCOPE_AGENT);
    return (u32x4){(unsigned)a, (unsigned)(a >> 32), (unsigned)b, (unsigned)(b >> 32)};
}
typedef _Float16 h16x8 __attribute__((ext_vector_type(8)));
__device__ __forceinline__ void unpk8(const u32x4 w, float (&f)[8]) {
    const h16x8 h = __builtin_bit_cast(h16x8, w);
#pragma unroll
    for (int i = 0; i < 8; ++i) f[i] = (float)h[i];
}
template <bool SC>
struct EpiH16_T {
    static constexpr bool PERM = true;
    h16* O; int ldc = DM;
    __device__ __forceinline__ void operator()(const f32x4 (&acc)[2][2][4][2], const Unit& u, int wr, int wc, int fr, int fq) const {
        const int row0 = u.pm * BM + wr * 64 + fr, col0 = u.pn * BM + wc * 32 + 8 * fq;
#pragma unroll
        for (int ai = 0; ai < 2; ++ai)
#pragma unroll
            for (int m = 0; m < 4; ++m)
#pragma unroll
                for (int bj = 0; bj < 2; ++bj) { f32x4 v0 = acc[ai][bj][m][0], v1 = acc[ai][bj][m][1]; if constexpr (SC) { v0 *= F8_INV; v1 *= F8_INV; }
                    u32x4 w; w.x = pk_h2(v0.x, v0.y); w.y = pk_h2(v0.z, v0.w); w.z = pk_h2(v1.x, v1.y); w.w = pk_h2(v1.z, v1.w);
                    *(u32x4*)(O + (size_t)(row0 + ai * HALF + m * 16) * ldc + col0 + bj * HALF) = w; }
    }
};
typedef EpiH16_T<false> EpiH16;
struct EpiGate {
    static constexpr bool PERM = true;
    const h16* Y; h16* Z; int accum; float nls;
    __device__ __forceinline__ void operator()(const f32x4 (&acc)[2][2][4][2], const Unit& u, int wr, int wc, int fr, int fq) const {
        const int row0 = u.pm * BM + wr * 64 + fr, col0 = u.pn * BM + wc * 32 + 8 * fq;
#pragma unroll
        for (int ai = 0; ai < 2; ++ai)
#pragma unroll
            for (int m = 0; m < 4; ++m)
#pragma unroll
                for (int bj = 0; bj < 2; ++bj) { const size_t off = (size_t)(row0 + ai * HALF + m * 16) * DM + col0 + bj * HALF;
                    float y[8], zz[8]; unpk8(ld16_l2(Y + off), y);
                    if (accum) unpk8(ld16_l2(Z + off), zz); else {
#pragma unroll
                        for (int i = 0; i < 8; ++i) zz[i] = 0.f; }
                    float o[8];
#pragma unroll
                    for (int n = 0; n < 2; ++n)
#pragma unroll
                        for (int e = 0; e < 4; ++e) { const float gg = acc[ai][bj][m][n][e]; o[n * 4 + e] = zz[n * 4 + e] + y[n * 4 + e] * __builtin_amdgcn_rcpf(1.f + __builtin_amdgcn_exp2f(gg * nls)); }
                    u32x4 w; w.x = pk_h2(o[0], o[1]); w.y = pk_h2(o[2], o[3]); w.z = pk_h2(o[4], o[5]); w.w = pk_h2(o[6], o[7]);
                    *(u32x4*)(Z + off) = w; }
    }
};
}

#define XB_TMO      128
#define XB_XCNT(j)  (256  + 64 * (j))
#define XB_XSUB(j)  (1280 + 64 * (j))
#define XB_XGEN(j)  (2304 + 64 * (j))
#define XB_TOP      3328
#define XB_TOPGEN   3392
#define XCD_BAR_WORDS 3456
#define XB_SPIN_CAP (1u << 18)
__device__ __forceinline__ unsigned xb_ld(unsigned* p)              { return __hip_atomic_load(p, __ATOMIC_RELAXED, __HIP_MEMORY_SCOPE_AGENT); }
__device__ __forceinline__ unsigned xb_add(unsigned* p, unsigned v) { return __hip_atomic_fetch_add(p, v, __ATOMIC_RELAXED, __HIP_MEMORY_SCOPE_AGENT); }
__device__ __forceinline__ unsigned xb_xcc_id() { return (unsigned)__builtin_amdgcn_s_getreg((3 << 11) | 20) & 0xFu; }
#define XB_SPIN(cond, bar) do { unsigned _sp = 0; while (cond) { __builtin_amdgcn_s_sleep(1); \
    if ((++_sp & 255u) == 0u) { if (xb_ld(&(bar)[XB_TMO])) break; if (_sp > XB_SPIN_CAP) { atomicAdd(&(bar)[XB_TMO], 1u); break; } } } } while (0)
struct XcdBarrier { unsigned* bar; unsigned x; volatile LAS unsigned* st; int wave; };
__device__ __forceinline__ XcdBarrier xcd_barrier_post(unsigned* bar, volatile LAS unsigned* st, int wave) {
    XcdBarrier b; b.bar = bar; b.x = xb_xcc_id(); b.st = st; b.wave = wave;
    if (wave == 0 && flane() == 0) (void)xb_add(&bar[XB_XCNT(b.x)], 1u);
    return b;
}
__device__ __forceinline__ void xcd_barrier_complete(unsigned* bar, unsigned x, unsigned& nloc, unsigned& nx) {
    const unsigned G = gridDim.x * gridDim.y * gridDim.z;
    unsigned sum, cnt, mine, sp = 0u;
    for (;;) {
        sum = 0u; cnt = 0u; mine = 0u;
#pragma unroll
        for (unsigned j = 0; j < 16; ++j) { const unsigned c = xb_ld(&bar[XB_XCNT(j)]); sum += c; cnt += (c > 0u) ? 1u : 0u; mine = (j == x) ? c : mine; }
        if (sum == G) break;
        __builtin_amdgcn_s_sleep(1);
        if ((++sp & 255u) == 0u) { if (xb_ld(&bar[XB_TMO])) break; if (sp > XB_SPIN_CAP) { atomicAdd(&bar[XB_TMO], 1u); break; } }
    }
    nloc = mine > 0u ? mine : 1u; nx = cnt > 0u ? cnt : 1u;
}
__device__ __forceinline__ void xcd_barrier(const XcdBarrier& b) {
    asm volatile("s_waitcnt vmcnt(0)" ::: "memory");
    __syncthreads();
    if (b.wave == 0 && flane() == 0) {
        unsigned* bar = b.bar;
        __builtin_amdgcn_s_waitcnt(0);
        unsigned nloc = b.st[0], nx = b.st[1];
        if (nloc == 0u) { xcd_barrier_complete(bar, b.x, nloc, nx); b.st[0] = nloc; b.st[1] = nx; }
        const unsigned old = xb_add(&bar[XB_XSUB(b.x)], 1u);
        const unsigned gen = old / nloc;
        if (old + 1u == (gen + 1u) * nloc) {
            __builtin_amdgcn_fence(__ATOMIC_RELEASE, "agent");
            asm volatile("s_waitcnt vmcnt(0)" ::: "memory");
            const unsigned og = xb_add(&bar[XB_TOP], 1u);
            const unsigned tg = og / nx;
            if (og + 1u == (tg + 1u) * nx) xb_add(&bar[XB_TOPGEN], 1u);
            else XB_SPIN(xb_ld(&bar[XB_TOPGEN]) == tg, bar);
            __builtin_amdgcn_fence(__ATOMIC_ACQUIRE, "agent");
            xb_add(&bar[XB_XGEN(b.x)], 1u);
            asm volatile("s_waitcnt vmcnt(0)" ::: "memory");
        } else {
            XB_SPIN(xb_ld(&bar[XB_XGEN(b.x)]) == gen, bar);
            __builtin_amdgcn_fence(__ATOMIC_ACQUIRE, "agent");
            asm volatile("s_waitcnt vmcnt(0)" ::: "memory");
        }
    }
    __syncthreads();
}

constexpr int NWAVES = 8, NTHR = 512;
constexpr int RING_BYTES = 131072, LDSCTL_OFF = RING_BYTES, MISC_OFF = LDSCTL_OFF + 320, LDS_BYTES = 147456;
constexpr int XCH_OFF = RING_BYTES + 1024;
constexpr int CW_BAR = 4096;
constexpr size_t OW_GU1 = OFF_W, OW_D1 = OW_GU1 + 11 * MiB, OW_IN = OW_D1 + (size_t)DM * FF * 2, OW_GATE = OW_IN + 6 * MiB, OW_4 = OW_GATE + 4 * MiB, OW_OV = OW_4 + 2 * MiB,
                 OW_UPB = OW_OV + 4 * MiB, OW_O = OW_UPB + MiB / 2, OW_GU2 = OW_O + 2 * MiB, OW_D2 = OW_GU2 + 11 * MiB, OW_END = OW_D2 + (size_t)DM * FF * 2;
static_assert(OW_END <= OFF_H, "weights region");
constexpr int NIN3 = 3072, N4 = 2560;
constexpr size_t OW_BD = OW_OV, OW_UPA = OW_OV + MiB, OFF_OA = OFF_A + 64 * MiB;

struct Args { const float* in[27]; float* out; unsigned char* ws; int ph_lo, ph_hi; };
struct Frame {
    LAS unsigned char* lds; int tid, lane, wave, G, gw, NGW;
};
__device__ __forceinline__ float wave_sum(float v) {
#pragma unroll
    for (int o = 1; o < 64; o <<= 1) v += __shfl_xor(v, o);
    return v;
}
__device__ __forceinline__ bool map_row(int job, int n, const Args& a, const float*& W, int& ldw, int& col) {
    if (job <= 1) { const int t = n >> 8, j = n & 255; W = a.in[(job == 0 ? 6 : 23) + (j >> 7)]; ldw = FF; col = t * 128 + (j & 127); return true; }
    if (job == 2) { W = a.in[11]; ldw = DIN; const int t = n >> 8, j = n & 255;
        if (t == 0) { col = C_CKV + j; return true; }
        if (t == 1) { col = j; return true; }
        if (t == 2) { if (j < 128) { col = 256 + j; return true; } if (j < 160) { col = C_KR + (j - 128); return true; } if (j < 192) { col = C_KI + (j - 160); return true; } if (j < 200) { col = C_WI + (j - 192); return true; } col = 0; return false; }
        if (t < 9) { const int c3 = (t - 3) / 3, tl = (t - 3) % 3, hl = (j & 127) >> 5, i = j & 31; col = C_QKV + c3 * 768 + (4 * tl + hl) * 64 + (j >> 7) * 32 + i; return true; }
        col = C_QKV + 1536 + (t - 9) * 256 + j; return true; }
    { const int n2 = n - 2048, r5 = n2 & 31, nat = 16 * ((r5 >> 2) & 1) + 4 * (r5 >> 3) + (r5 & 3);
      if (n2 < 256) { W = a.in[14]; ldw = 768; col = (n2 >> 5) * 96 + 64 + nat; } else { W = a.in[17]; ldw = 256; col = ((n2 - 256) & ~31) + nat; } return true; }
}
template <typename T>
__device__ __forceinline__ void tr_item(const float* W, int ldw, int col, bool valid, const float* scale, int k0, T* WTrow0, int K, LAS float* scr, int lane) {
    const int colc = valid ? col : 0; float vv[32];
#pragma unroll
    for (int i = 0; i < 32; ++i) vv[i] = W[(size_t)(k0 + 2 * i + (lane >> 5)) * ldw + colc];
    if (scale) {
#pragma unroll
        for (int i = 0; i < 32; ++i) vv[i] *= scale[k0 + 2 * i + (lane >> 5)]; }
#pragma unroll
    for (int i = 0; i < 32; ++i) scr[(2 * i + (lane >> 5)) * 33 + (lane & 31)] = valid ? vv[i] : 0.f;
    asm volatile("s_waitcnt lgkmcnt(0)" ::: "memory");
    const int c = lane & 7;
#pragma unroll
    for (int j = 0; j < 4; ++j) { const int n = (lane >> 3) + 8 * j; const LAS float* s = scr + (8 * c) * 33 + n;
        if constexpr (sizeof(T) == 1) { u32x2 o; o.x = pk_f8x4(s[0 * 33] * F8_WGT, s[1 * 33] * F8_WGT, s[2 * 33] * F8_WGT, s[3 * 33] * F8_WGT); o.y = pk_f8x4(s[4 * 33] * F8_WGT, s[5 * 33] * F8_WGT, s[6 * 33] * F8_WGT, s[7 * 33] * F8_WGT);
            *(u32x2*)(WTrow0 + (size_t)n * K + k0 + 8 * c) = o; }
        else { u32x4 o; o.x = pk_h2(s[0 * 33], s[1 * 33]); o.y = pk_h2(s[2 * 33], s[3 * 33]); o.z = pk_h2(s[4 * 33], s[5 * 33]); o.w = pk_h2(s[6 * 33], s[7 * 33]);
            *(u32x4*)(WTrow0 + (size_t)n * K + k0 + 8 * c) = o; } }
    asm volatile("s_waitcnt lgkmcnt(0)" ::: "memory");
}
template <typename T>
__device__ __forceinline__ void tr_job_mapped(const Frame& F, const Args& a, int job, int Ndest, int n_lo, int K, T* WT, const float* scale, LAS float* scr, int phase_off) {
    const int nblk = Ndest / 32, nitems = (K / 64) * nblk;
    for (int it = (F.gw + phase_off) % F.NGW; it < nitems; it += F.NGW) {
        const int kb = it / nblk, nb = it % nblk; const float* W; int ldw, col;
        const bool valid = map_row(job, n_lo + nb * 32 + (F.lane & 31), a, W, ldw, col);
        tr_item(W, ldw, col, valid, scale, kb * 64, WT + (size_t)(n_lo + nb * 32) * K, K, scr, F.lane);
    }
}
template <typename T>
__device__ __forceinline__ void tr_job_plain(const Frame& F, const float* W, int ldw, int Ndest, int K, T* WT, LAS float* scr, int phase_off) {
    const int nblk = Ndest / 32, nitems = (K / 64) * nblk;
    for (int it = (F.gw + phase_off) % F.NGW; it < nitems; it += F.NGW) {
        const int kb = it / nblk, nb = it % nblk;
        tr_item(W, ldw, nb * 32 + (F.lane & 31), true, nullptr, kb * 64, WT + (size_t)(nb * 32) * K, K, scr, F.lane);
    }
}
__device__ __forceinline__ void row_load(const float* p, int lane, f32x4 (&v)[4]) {
#pragma unroll
    for (int j = 0; j < 4; ++j) v[j] = ((const f32x4*)p)[lane + 64 * j];
}
__device__ __forceinline__ float row_ssq(const f32x4 (&v)[4]) { float s = 0.f;
#pragma unroll
    for (int j = 0; j < 4; ++j) s += (v[j].x * v[j].x + v[j].y * v[j].y) + (v[j].z * v[j].z + v[j].w * v[j].w);
    return wave_sum(s); }
template <typename T>
__device__ __forceinline__ void row_normmod_store(const f32x4 (&v)[4], float rstd, const float* g, const float* sc, const float* sh, T* dst, int lane, unsigned char* dst8 = nullptr) {
#pragma unroll
    for (int j = 0; j < 4; ++j) { const int ci = lane + 64 * j; const f32x4 gg = ((const f32x4*)g)[ci], s1 = ((const f32x4*)sc)[ci], s0 = ((const f32x4*)sh)[ci];
        const f32x4 o = v[j] * rstd * gg * (s1 + 1.f) + s0;
        if constexpr (sizeof(T) == 1) ((unsigned*)dst)[ci] = pk_f8x4(o.x * F8_ACT, o.y * F8_ACT, o.z * F8_ACT, o.w * F8_ACT);
        else { u32x2 w; w.x = pk_h2(o.x, o.y); w.y = pk_h2(o.z, o.w); ((u32x2*)dst)[ci] = w; if (dst8) ((unsigned*)dst8)[ci] = pk_f8x4(o.x * F8_ACT, o.y * F8_ACT, o.z * F8_ACT, o.w * F8_ACT); } }
}
template <typename T>
__device__ __forceinline__ void ph_normmod(const Frame& F, const float* x, const float* g, const float* mod, int isc, int ish, T* dst) {
    int m = F.gw; if (m >= MT) return;
    const int lane = flane();
    f32x4 v[4], vn[4]; row_load(x + (size_t)m * DM, lane, v);
    for (;;) { const int mn = m + F.NGW; const bool has = mn < MT; if (has) row_load(x + (size_t)mn * DM, lane, vn);
        const float rstd = rsqrtf(row_ssq(v) * (1.f / DM) + EPS); const float* mb = mod + (m / SEQ) * (NMOD * DM);
        row_normmod_store(v, rstd, g, mb + isc * DM, mb + ish * DM, dst + (size_t)m * DM, lane);
        if (!has) break;
#pragma unroll
        for (int j = 0; j < 4; ++j) v[j] = vn[j];
        m = mn; }
}
__device__ __forceinline__ void row_load_h(const h16* p, int lane, u32x2 (&v)[4]) {
#pragma unroll
    for (int j = 0; j < 4; ++j) v[j] = ((const u32x2*)p)[lane + 64 * j];
}
typedef _Float16 h16x4 __attribute__((ext_vector_type(4)));
__device__ __forceinline__ f32x4 h4_to_f4(u32x2 w) { const h16x4 h = __builtin_bit_cast(h16x4, w); return (f32x4){(float)h[0], (float)h[1], (float)h[2], (float)h[3]}; }
template <bool XI16, bool XO16, typename T = h16>
__device__ __forceinline__ void ph_resnorm(const Frame& F, const void* xin_, const h16* f, const float* gpost, const float* mod, int igt, float coef, void* xout_,
                                           bool second, const float* gpre, int isc, int ish, T* dst, unsigned char* dst8 = nullptr) {
    int m = F.gw; if (m >= MT) return;
    const int lane = flane();
    u32x2 fh[4], fn[4]; f32x4 xi[4], xn[4]; u32x2 xh[4], xhn[4];
    row_load_h(f + (size_t)m * DM, lane, fh);
    if constexpr (XI16) row_load_h((const h16*)xin_ + (size_t)m * DM, lane, xh); else row_load((const float*)xin_ + (size_t)m * DM, lane, xi);
    for (;;) {
        const int mn = m + F.NGW; const bool has = mn < MT;
        if (has) { row_load_h(f + (size_t)mn * DM, lane, fn);
            if constexpr (XI16) row_load_h((const h16*)xin_ + (size_t)mn * DM, lane, xhn); else row_load((const float*)xin_ + (size_t)mn * DM, lane, xn); }
        f32x4 v[4];
#pragma unroll
        for (int j = 0; j < 4; ++j) { v[j] = h4_to_f4(fh[j]); if constexpr (XI16) xi[j] = h4_to_f4(xh[j]); }
        const float rstd = rsqrtf(row_ssq(v) * (1.f / DM) + EPS) * coef; const float* mb = mod + (m / SEQ) * (NMOD * DM);
#pragma unroll
        for (int j = 0; j < 4; ++j) { const int ci = lane + 64 * j; const f32x4 gg = ((const f32x4*)gpost)[ci], gt = ((const f32x4*)(mb + igt * DM))[ci];
            xi[j] = xi[j] + gt * v[j] * rstd * gg;
            if constexpr (XO16) { u32x2 w; w.x = pk_h2(xi[j].x, xi[j].y); w.y = pk_h2(xi[j].z, xi[j].w); ((u32x2*)((h16*)xout_ + (size_t)m * DM))[ci] = w; }
            else ((f32x4*)((float*)xout_ + (size_t)m * DM))[ci] = xi[j]; }
        if (second) { const float r2 = rsqrtf(row_ssq(xi) * (1.f / DM) + EPS); row_normmod_store(xi, r2, gpre, mb + isc * DM, mb + ish * DM, dst + (size_t)m * DM, lane, dst8 ? dst8 + (size_t)m * DM : nullptr); }
        if (!has) break;
#pragma unroll
        for (int j = 0; j < 4; ++j) { fh[j] = fn[j]; if constexpr (XI16) xh[j] = xhn[j]; else xi[j] = xn[j]; }
        m = mn;
    }
}

__device__ __forceinline__ void ph_combine(const Frame& F, const h16* og, const float* lse2, h16* ob) {
    for (int idx = blockIdx.x * NTHR + F.tid; idx < MT * 256; idx += F.G * NTHR) {
        const int tok = idx >> 8, c = idx & 255, hh = c >> 6;
        const float l0 = lse2[tok * 12 + hh], l1 = lse2[tok * 12 + 4 + hh], l2 = lse2[tok * 12 + 8 + hh], m = fmaxf(l0, fmaxf(l1, l2));
        const float w0 = exp2f(l0 - m), w1 = exp2f(l1 - m), w2 = exp2f(l2 - m), inv = 1.f / (w0 + w1 + w2);
        ob[idx] = (h16)((w0 * (float)og[(size_t)tok * 768 + c] + w1 * (float)og[(size_t)tok * 768 + 256 + c] + w2 * (float)og[(size_t)tok * 768 + 512 + c]) * inv); }
}
typedef short v4i16_t __attribute__((ext_vector_type(4)));
typedef short s16x8 __attribute__((ext_vector_type(8)));
typedef float f32x16 __attribute__((ext_vector_type(16)));
__device__ __forceinline__ int tk_bin(float sc) { const unsigned u = __float_as_uint(sc); int e = (int)((u >> 16) & 0x7FFFu) - (122 << 7); e = e < 0 ? 0 : (e > 1023 ? 1023 : e); return (u >> 31) ? 1023 - e : 1024 + e; }
__device__ __forceinline__ void tk_scores(const f16x8 (&Af)[2], const float (&wv)[16], f16x8 b0, f16x8 b1, float& sa, float& sb) {
    f32x16 d = {0.f, 0.f, 0.f, 0.f, 0.f, 0.f, 0.f, 0.f, 0.f, 0.f, 0.f, 0.f, 0.f, 0.f, 0.f, 0.f};
    d = __builtin_amdgcn_mfma_f32_32x32x16_f16(Af[0], b0, d, 0, 0, 0); d = __builtin_amdgcn_mfma_f32_32x32x16_f16(Af[1], b1, d, 0, 0, 0);
    f32x2 acc = {0.f, 0.f};
#pragma unroll
    for (int e = 0; e < 16; e += 2) { const int i0 = __float_as_int(d[e]), i1 = __float_as_int(d[e + 1]);
        const f32x2 rl = {__int_as_float(i0 > 0 ? i0 : 0), __int_as_float(i1 > 0 ? i1 : 0)}; const f32x2 w2 = {wv[e], wv[e + 1]};
        acc = __builtin_elementwise_fma(w2, rl, acc); }
    sa = acc.x; sb = acc.y;
}
template <bool P2>
__device__ __forceinline__ void tk_tile(const f16x8 (&Af)[2], const float (&wv)[16], f16x8 b0, f16x8 b1, int tile, int r, int hi, int ta, LAS unsigned* hist, const int (&tbin)[4], int (&cs)[4], int (&cc)[4],
                                        unsigned short* sel, int tok0) {
    float sa, sb; tk_scores(Af, wv, b0, b1, sa, sb);
    const int s = 32 * tile + r;
    if constexpr (!P2) {
        if (s <= ta) { const int bn = tk_bin(sa); __hip_atomic_fetch_add(hist + (2 * hi) * 1024 + (bn >> 1), 1u << (16 * (bn & 1)), __ATOMIC_RELAXED, __HIP_MEMORY_SCOPE_WORKGROUP); }
        if (s <= ta + 1) { const int bn = tk_bin(sb); __hip_atomic_fetch_add(hist + (2 * hi + 1) * 1024 + (bn >> 1), 1u << (16 * (bn & 1)), __ATOMIC_RELAXED, __HIP_MEMORY_SCOPE_WORKGROUP); }
    } else {
        const unsigned lowmask = (1u << r) - 1u;
#pragma unroll
        for (int ab = 0; ab < 2; ++ab) { const float sc = ab ? sb : sa; const int tq = ta + ab; const int bn = tk_bin(sc);
            const int mytb = hi ? tbin[2 + ab] : tbin[ab];
            const bool valid = s <= tq, sure = valid && bn > mytb, cand = valid && bn == mytb;
            const unsigned long long ms = __ballot(sure), mc = __ballot(cand);
            const unsigned ms_h = hi ? (unsigned)(ms >> 32) : (unsigned)ms, mc_h = hi ? (unsigned)(mc >> 32) : (unsigned)mc;
            const int q = 2 * hi + ab;
            const int base_s = hi ? cs[2 + ab] : cs[ab], base_c = hi ? cc[2 + ab] : cc[ab];
            if (sure) sel[(size_t)(tok0 + q) * TOPK + base_s + __builtin_popcount(ms_h & lowmask)] = (unsigned short)s;
            if (cand) { const int pos = base_c + __builtin_popcount(mc_h & lowmask);
                if (pos < 512) ((LAS unsigned long long*)((LAS unsigned char*)hist + q * 4096))[pos] = ((unsigned long long)fkey(sc) << 16) | (unsigned long long)(0xFFFFu - (unsigned)s); }
            cs[ab] += __builtin_popcount((unsigned)ms); cs[2 + ab] += __builtin_popcount((unsigned)(ms >> 32));
            cc[ab] += __builtin_popcount((unsigned)mc); cc[2 + ab] += __builtin_popcount((unsigned)(mc >> 32)); }
    }
}
template <bool P2>
__device__ __forceinline__ void tk_pass(const f16x8 (&Af)[2], const float (&wv)[16], const h16* kbase, int ntiles, int r, int hi, int ta, LAS unsigned* hist, const int (&tbin)[4], int (&cs)[4], int (&cc)[4],
                                        unsigned short* sel, int tok0) {
    f16x8 BA[4][2], BB[4][2];
#define TK_LOAD(dst, t0_) do { _Pragma("unroll") for (int i_ = 0; i_ < 4; ++i_) { const int tt_ = ((t0_) + i_) < 127 ? ((t0_) + i_) : 127; dst[i_][0] = *(const f16x8*)(kbase + (size_t)tt_ * 1024); dst[i_][1] = *(const f16x8*)(kbase + (size_t)tt_ * 1024 + 16); } } while (0)
    TK_LOAD(BA, 0);
    for (int t0 = 0; t0 < ntiles; t0 += 8) {
        TK_LOAD(BB, t0 + 4);
#pragma unroll
        for (int i = 0; i < 4; ++i) if (t0 + i < ntiles) tk_tile<P2>(Af, wv, BA[i][0], BA[i][1], t0 + i, r, hi, ta, hist, tbin, cs, cc, sel, tok0);
        TK_LOAD(BA, t0 + 8);
#pragma unroll
        for (int i = 0; i < 4; ++i) if (t0 + 4 + i < ntiles) tk_tile<P2>(Af, wv, BB[i][0], BB[i][1], t0 + 4 + i, r, hi, ta, hist, tbin, cs, cc, sel, tok0);
    }
#undef TK_LOAD
}
__device__ __forceinline__ void tk_group(const Frame& F, const h16* qi, const h16* ki, const float* wi, unsigned short* sel, int b, int t0, LAS unsigned* hist) {
    int lane_ = F.lane; asm volatile("" : "+v"(lane_)); const int lane = lane_, r = lane & 31, hi = lane >> 5, tok0 = b * SEQ + t0;
    const int qa = 2 * ((r >> 2) & 1) + (r & 1), ha = 4 * (r >> 4) + 2 * ((r >> 3) & 1) + ((r >> 1) & 1);
    f16x8 Af[2];
#pragma unroll
    for (int s_ = 0; s_ < 2; ++s_) Af[s_] = *(const f16x8*)(qi + (size_t)(tok0 + qa) * 256 + ha * 32 + 16 * s_ + 8 * hi);
    float wv[16];
    { const f32x4 a0 = *(const f32x4*)(wi + (tok0 + 2 * hi) * 8), a1 = *(const f32x4*)(wi + (tok0 + 2 * hi) * 8 + 4), b0 = *(const f32x4*)(wi + (tok0 + 2 * hi + 1) * 8), b1 = *(const f32x4*)(wi + (tok0 + 2 * hi + 1) * 8 + 4);
      const float sa[8] = {a0.x, a0.y, a0.z, a0.w, a1.x, a1.y, a1.z, a1.w}, sb[8] = {b0.x, b0.y, b0.z, b0.w, b1.x, b1.y, b1.z, b1.w};
#pragma unroll
      for (int h = 0; h < 8; ++h) { wv[2 * h] = sa[h] * 0.17677669529663687f; wv[2 * h + 1] = sb[h] * 0.17677669529663687f; } }
    const int ntiles = (t0 + 3) / 32 + 1, ta = t0 + 2 * hi;
    const h16* kbase = ki + (size_t)(b * SEQ + r) * 32 + 8 * hi;
    int tbin[4] = {0, 0, 0, 0}, nsure[4], cs[4] = {0, 0, 0, 0}, cc[4] = {0, 0, 0, 0};
#pragma unroll
    for (int i = 0; i < 16; ++i) *(LAS u32x4*)((LAS unsigned char*)hist + i * 1024 + lane * 16) = (u32x4){0u, 0u, 0u, 0u};
    asm volatile("s_waitcnt lgkmcnt(0)" ::: "memory");
    tk_pass<false>(Af, wv, kbase, ntiles, r, hi, ta, hist, tbin, cs, cc, sel, tok0);
    asm volatile("s_waitcnt lgkmcnt(0)" ::: "memory");
#pragma unroll
    for (int q = 0; q < 4; ++q) {
        const LAS unsigned* hq = hist + q * 1024;
        unsigned sum = 0;
#pragma unroll
        for (int i = 0; i < 4; ++i) { const u32x4 v = *(const LAS u32x4*)(hq + 16 * lane + 4 * i); sum += (v.x & 0xFFFFu) + (v.x >> 16) + (v.y & 0xFFFFu) + (v.y >> 16) + (v.z & 0xFFFFu) + (v.z >> 16) + (v.w & 0xFFFFu) + (v.w >> 16); }
        unsigned incl = sum;
#pragma unroll
        for (int o = 1; o < 64; o <<= 1) { const unsigned v = __shfl_down(incl, o); if (lane + o < 64) incl += v; }
        const unsigned long long bal = __ballot(incl >= (unsigned)TOPK);
        const int L = 63 - __builtin_clzll(bal);
        unsigned cum = __shfl(incl, L) - __shfl(sum, L);
        int tbq = 32 * L, found = 0;
        for (int wd = 15; wd >= 0 && !found; --wd) { const unsigned v = hq[16 * L + wd];
            const unsigned chi = v >> 16, clo = v & 0xFFFFu;
            if (cum + chi >= (unsigned)TOPK) { tbq = 32 * L + 2 * wd + 1; found = 1; } else { cum += chi;
                if (cum + clo >= (unsigned)TOPK) { tbq = 32 * L + 2 * wd; found = 1; } else cum += clo; } }
        tbin[q] = tbq; nsure[q] = (int)cum;
    }
    asm volatile("s_waitcnt lgkmcnt(0)" ::: "memory");
    tk_pass<true>(Af, wv, kbase, ntiles, r, hi, ta, hist, tbin, cs, cc, sel, tok0);
    asm volatile("s_waitcnt lgkmcnt(0)" ::: "memory");
#pragma unroll
    for (int q = 0; q < 4; ++q) {
        const int nc = cc[q] < 512 ? cc[q] : 512, need = TOPK - cs[q];
        const LAS unsigned long long* cq = (const LAS unsigned long long*)((const LAS unsigned char*)hist + q * 4096);
        if (nc > 64) {
            unsigned long long it[8];
#pragma unroll
            for (int k = 0; k < 8; ++k) it[k] = (k * 64 + lane < nc) ? cq[k * 64 + lane] : 0ull;
            unsigned long long T = 0ull;
            for (int bit = 47; bit >= 0; --bit) { const unsigned long long cand = T | (1ull << bit); int cnt = 0;
#pragma unroll
                for (int k = 0; k < 8; ++k) cnt += __builtin_popcountll(__ballot(it[k] >= cand));
                if (cnt >= need) T = cand; }
            int basep = cs[q];
#pragma unroll
            for (int k = 0; k < 8; ++k) { const bool pick = (T != 0ull) && it[k] >= T; const unsigned long long mk = __ballot(pick);
                if (pick) sel[(size_t)(tok0 + q) * TOPK + basep + __builtin_popcountll(mk & ((1ull << lane) - 1ull))] = (unsigned short)(0xFFFFu - (unsigned)(it[k] & 0xFFFFull));
                basep += __builtin_popcountll(mk); }
        } else
        for (int base = 0; base < nc; base += 64) {
            const bool act = base + lane < nc; const unsigned long long my = act ? cq[base + lane] : 0ull; int rank = 0;
            for (int jb = 0; jb < nc; jb += 64) {
                const unsigned long long cj = (jb + lane < nc) ? cq[jb + lane] : 0ull; const unsigned clo = (unsigned)cj, chi = (unsigned)(cj >> 32);
                const int n = (nc - jb) < 64 ? (nc - jb) : 64;
                for (int j = 0; j < n; ++j) { const unsigned long long sj = ((unsigned long long)(unsigned)__builtin_amdgcn_readlane((int)chi, j) << 32) | (unsigned)__builtin_amdgcn_readlane((int)clo, j); rank += (sj > my) ? 1 : 0; } }
            if (act && rank < need) sel[(size_t)(tok0 + q) * TOPK + cs[q] + rank] = (unsigned short)(0xFFFFu - (unsigned)(my & 0xFFFFull)); }
    }
    (void)nsure;
    asm volatile("s_waitcnt lgkmcnt(0)" ::: "memory");
}
__device__ __forceinline__ void ph_topk_sparse(const Frame& F, const h16* qi, const h16* ki, const float* wi, unsigned short* sel, h16* qlat, const h16* qr, const unsigned char* ckv8, const unsigned char* kr8);
__device__ __forceinline__ void ph_topk_mfma(const Frame& F, const h16* qi, const h16* ki, const float* wi, unsigned short* sel) {
    LAS unsigned* hist = (LAS unsigned*)(F.lds + F.wave * 16384);
    for (int g = F.gw; g < 4 * 64; g += F.NGW) { const int b = g >> 6, t0 = (g & 63) * 4;
        for (int i = F.lane; i < 4 * TOPK; i += 64) { const int q = i >> 8, k = i & 255; sel[(size_t)(b * SEQ + t0 + q) * TOPK + k] = (unsigned short)(k <= t0 + q ? k : 0); } }
    for (int p = F.gw; p < 4 * 480; p += F.NGW) { const int b = p & 3, pj = p >> 2;
        tk_group(F, qi, ki, wi, sel, b, 4 * (64 + pj), hist);
        tk_group(F, qi, ki, wi, sel, b, 4 * (1023 - pj), hist);
    }
}


__device__ __forceinline__ void ph_dilated_mfma(const Frame& F, const h16* qb, const h16* kb, const h16* vb, h16* og, float* lse2) {
    const int lane = F.lane, ql = lane & 31, hi = lane >> 5;
    LAS unsigned char* VL = F.lds + F.wave * 16384;
    LAS float* linv = (LAS float*)(VL + 12288);
    constexpr int VROW = 192;
    const int trq = (lane & 15) >> 2, trp = lane & 3, trg = (lane >> 4) & 1;
    for (int u = F.gw; u < NB * 12 * 128; u += F.NGW) {
        const int b = u / 1536, rem = u % 1536, gh = rem >> 7, g = gh >> 2, wi_ = rem & 127, dil = dil_of(g), sh = g == 0 ? 0 : (g == 1 ? 2 : 4);
        const int nblk = 128 >> sh, res = wi_ / nblk, j0 = 32 * (wi_ % nblk);
        const size_t hoff = (size_t)b * SEQ * 768 + gh * 64;
        f16x8 Qf[4];
        { const h16* qp = qb + hoff + (size_t)((j0 + ql) * dil + res) * 768 + 8 * hi;
#pragma unroll
          for (int s_ = 0; s_ < 4; ++s_) Qf[s_] = *(const f16x8*)(qp + 16 * s_); }
        f32x16 S[5];
        f16x8 Kf[5][4];
#pragma unroll
        for (int kt = 0; kt < 5; ++kt) { int jk = j0 - 128 + 32 * kt + ql; jk = jk < 0 ? 0 : jk;
            const h16* kp = kb + hoff + (size_t)(jk * dil + res) * 768 + 8 * hi;
#pragma unroll
            for (int s_ = 0; s_ < 4; ++s_) Kf[kt][s_] = *(const f16x8*)(kp + 16 * s_); }
#pragma unroll
        for (int kt = 0; kt < 5; ++kt) {
            f32x16 d = {0.f, 0.f, 0.f, 0.f, 0.f, 0.f, 0.f, 0.f, 0.f, 0.f, 0.f, 0.f, 0.f, 0.f, 0.f, 0.f};
#pragma unroll
            for (int s_ = 0; s_ < 4; ++s_) d = __builtin_amdgcn_mfma_f32_32x32x16_f16(Kf[kt][s_], Qf[s_], d, 0, 0, 0);
            S[kt] = d; }
        f16x8 Vr[5][4];
#pragma unroll
        for (int kt = 0; kt < 5; ++kt) { int jk = j0 - 128 + 32 * kt + (lane >> 1); jk = jk < 0 ? 0 : jk;
            const h16* vp = vb + hoff + (size_t)(jk * dil + res) * 768 + (lane & 1) * 32;
#pragma unroll
            for (int i = 0; i < 4; ++i) Vr[kt][i] = *(const f16x8*)(vp + 8 * i); }
        float m = -INFINITY;
#pragma unroll
        for (int kt = 0; kt < 5; ++kt)
#pragma unroll
            for (int e = 0; e < 16; ++e) { const int kl = (e & 3) + 8 * (e >> 2) + 4 * hi; bool ok = (j0 - 128 + 32 * kt + kl) >= 0;
                if (kt == 0) ok = ok && (kl >= ql); if (kt == 4) ok = ok && (kl <= ql);
                if (!ok) S[kt][e] = -INFINITY; m = fmaxf(m, S[kt][e]); }
        m = fmaxf(m, __shfl_xor(m, 32));
        float l = 0.f;
#pragma unroll
        for (int kt = 0; kt < 5; ++kt)
#pragma unroll
            for (int e = 0; e < 16; ++e) { const float p = __builtin_amdgcn_exp2f(S[kt][e] - m); S[kt][e] = p; l += p; }
        l += __shfl_xor(l, 32);
        if (hi == 0) { linv[ql] = __builtin_amdgcn_rcpf(l); lse2[(size_t)(b * SEQ + (j0 + ql) * dil + res) * 12 + gh] = m + __builtin_amdgcn_logf(l); }
        f32x16 O[2];
#pragma unroll
        for (int dt = 0; dt < 2; ++dt) O[dt] = (f32x16){0.f, 0.f, 0.f, 0.f, 0.f, 0.f, 0.f, 0.f, 0.f, 0.f, 0.f, 0.f, 0.f, 0.f, 0.f, 0.f};
#pragma unroll
        for (int kt = 0; kt < 5; ++kt) {
            LAS unsigned char* vbuf = VL + (kt & 1) * 6144;
#pragma unroll
            for (int i = 0; i < 4; ++i) *(LAS f16x8*)(vbuf + (lane >> 1) * VROW + (lane & 1) * 64 + i * 16) = Vr[kt][i];
            asm volatile("s_waitcnt lgkmcnt(0)" ::: "memory");
#pragma unroll
            for (int s2 = 0; s2 < 2; ++s2) {
                u32x4 pa; pa.x = pk_h2(S[kt][8 * s2 + 0], S[kt][8 * s2 + 1]); pa.y = pk_h2(S[kt][8 * s2 + 2], S[kt][8 * s2 + 3]); pa.z = pk_h2(S[kt][8 * s2 + 4], S[kt][8 * s2 + 5]); pa.w = pk_h2(S[kt][8 * s2 + 6], S[kt][8 * s2 + 7]);
#pragma unroll
                for (int dt = 0; dt < 2; ++dt) {
                    const v4i16_t lo = __builtin_amdgcn_ds_read_tr16_b64_v4i16((LAS v4i16_t*)(vbuf + (16 * s2 + 4 * hi + trq) * VROW + (32 * dt + 16 * trg + 4 * trp) * 2));
                    const v4i16_t hh = __builtin_amdgcn_ds_read_tr16_b64_v4i16((LAS v4i16_t*)(vbuf + (16 * s2 + 8 + 4 * hi + trq) * VROW + (32 * dt + 16 * trg + 4 * trp) * 2));
                    const s16x8 bv = {lo[0], lo[1], lo[2], lo[3], hh[0], hh[1], hh[2], hh[3]};
                    O[dt] = __builtin_amdgcn_mfma_f32_32x32x16_f16(__builtin_bit_cast(f16x8, pa), __builtin_bit_cast(f16x8, bv), O[dt], 0, 0, 0); } }
            asm volatile("s_waitcnt lgkmcnt(0)" ::: "memory");
        }
#pragma unroll
        for (int e = 0; e < 16; ++e) { const int q = (e & 3) + 8 * (e >> 2) + 4 * hi; const float il = linv[q];
            h16* op = og + (size_t)(b * SEQ + (j0 + q) * dil + res) * 768 + gh * 64 + ql;
            op[0] = (h16)(O[0][e] * il); op[32] = (h16)(O[1][e] * il); }
        asm volatile("s_waitcnt lgkmcnt(0)" ::: "memory");
    }
}


__device__ __forceinline__ f16x8 fp8x8_to_f16(unsigned w0, unsigned w1) {
    const h16x2 a = __builtin_amdgcn_cvt_scalef32_pk_f16_fp8((int)w0, 1.0f, false), b = __builtin_amdgcn_cvt_scalef32_pk_f16_fp8((int)w0, 1.0f, true),
                c = __builtin_amdgcn_cvt_scalef32_pk_f16_fp8((int)w1, 1.0f, false), d = __builtin_amdgcn_cvt_scalef32_pk_f16_fp8((int)w1, 1.0f, true);
    const u32x4 r = {__builtin_bit_cast(unsigned, a), __builtin_bit_cast(unsigned, b), __builtin_bit_cast(unsigned, c), __builtin_bit_cast(unsigned, d)};
    return __builtin_bit_cast(f16x8, r);
}
template <bool FUSED>
__device__ __forceinline__ void ph_sparse_wave(const Frame& F, h16* qlat, const h16* qr, const unsigned char* ckv8, const unsigned char* kr8, const unsigned short* sel, int ta = 0, int tb = 0) {
    int lane = F.lane; asm volatile("" : "+v"(lane));
    LAS unsigned char* V = F.lds + F.wave * 16384;
    const int qp = (lane & 15) >> 2, pp = lane & 3;
    const int k0 = 4 * (lane >> 4) + qp;
    const int tr0 = k0 * 512 + (pp >> 1) * 16 + (pp & 1) * 8, x0 = k0 & 7;
    const int vw = (lane & 15) * 512, swz = lane & 7;
    const int lane0 = lane;
    const int nit = FUSED ? 8 : (MT - F.gw + F.NGW - 1) / F.NGW;
    for (int it = 0; it < nit; ++it) {
        const int tok = FUSED ? ((it < 4 ? ta : tb - 4) + it) : F.gw + it * F.NGW;
        int ll = lane0; asm volatile("" : "+v"(ll));
        const int c = ll & 15, kq = ll >> 4, hd = c & 7;
        const int b = tok / SEQ, t = tok % SEQ, cnt = (t + 1 < TOPK) ? t + 1 : TOPK, nch = (cnt + 31) >> 5;
        LAS unsigned short* sp = (LAS unsigned short*)(F.lds + XCH_OFF + F.wave * 512) + c;
        *(LAS u32x2*)(F.lds + XCH_OFF + F.wave * 512 + 8 * ll) = *(const u32x2*)(sel + (size_t)tok * TOPK + 4 * ll);
        asm volatile("s_waitcnt lgkmcnt(0)" ::: "memory");
        f16x8 Qf[9]; u32x4 Kr[2][4]; u32x2 Rr[2];
#pragma unroll
        for (int s_ = 0; s_ < 8; ++s_) Qf[s_] = *(const f16x8*)(qlat + (size_t)tok * 2048 + hd * 256 + 64 * (s_ >> 1) + 16 * kq + 8 * (s_ & 1));
        Qf[8] = *(const f16x8*)(qr + (size_t)tok * 256 + hd * 32 + 8 * kq);
        int rowi[2];
#define SW_LOADK() do { _Pragma("unroll") for (int tl = 0; tl < 2; ++tl) { _Pragma("unroll") for (int q4 = 0; q4 < 4; ++q4) Kr[tl][q4] = *(const u32x4*)(ckv8 + (size_t)rowi[tl] * 256 + 64 * q4 + 16 * kq); \
        Rr[tl] = *(const u32x2*)(kr8 + (size_t)rowi[tl] * 32 + 8 * kq); } } while (0)
        rowi[0] = b * SEQ + (int)sp[0]; rowi[1] = b * SEQ + (int)sp[16];
        SW_LOADK();
        float m = -INFINITY, l = 0.f;
        f32x4 O[16];
#pragma unroll
        for (int ft = 0; ft < 16; ++ft) O[ft] = (f32x4){0.f, 0.f, 0.f, 0.f};
        for (int ch = 0; ch < nch; ++ch) {
            const bool more = ch + 1 < nch;
            int rown0 = 0, rown1 = 0; if (more) { rown0 = (int)sp[32 * (ch + 1)]; rown1 = (int)sp[32 * (ch + 1) + 16]; }
            f16x8 Kf[2][9];
#pragma unroll
            for (int tl = 0; tl < 2; ++tl) {
#pragma unroll
                for (int q4 = 0; q4 < 4; ++q4) { Kf[tl][2 * q4] = fp8x8_to_f16(Kr[tl][q4].x, Kr[tl][q4].y); Kf[tl][2 * q4 + 1] = fp8x8_to_f16(Kr[tl][q4].z, Kr[tl][q4].w); }
                Kf[tl][8] = fp8x8_to_f16(Rr[tl].x, Rr[tl].y); }
            if (more) { rowi[0] = b * SEQ + rown0; rowi[1] = b * SEQ + rown1; SW_LOADK(); }
            f32x4 S[2];
#pragma unroll
            for (int tl = 0; tl < 2; ++tl) { S[tl] = (f32x4){0.f, 0.f, 0.f, 0.f};
#pragma unroll
                for (int s_ = 0; s_ < 9; ++s_) S[tl] = __builtin_amdgcn_mfma_f32_16x16x32_f16(Kf[tl][s_], Qf[s_], S[tl], 0, 0, 0); }
            float cm = -INFINITY;
#pragma unroll
            for (int tl = 0; tl < 2; ++tl)
#pragma unroll
                for (int e = 0; e < 4; ++e) { if (32 * ch + 16 * tl + 4 * kq + e >= cnt) S[tl][e] = -INFINITY; cm = fmaxf(cm, S[tl][e]); }
            cm = fmaxf(cm, __shfl_xor(cm, 16)); cm = fmaxf(cm, __shfl_xor(cm, 32));
            if (__any(cm > m + 8.0f)) { const float mn = fmaxf(m, cm), alpha = __builtin_amdgcn_exp2f(m - mn); m = mn; l *= alpha;
#pragma unroll
                for (int ft = 0; ft < 16; ++ft) O[ft] = O[ft] * alpha; }
            float pe[2][4]; float ps = 0.f;
#pragma unroll
            for (int tl = 0; tl < 2; ++tl)
#pragma unroll
                for (int e = 0; e < 4; ++e) { pe[tl][e] = __builtin_amdgcn_exp2f(S[tl][e] - m); ps += pe[tl][e]; }
            l += ps;
#pragma unroll
            for (int tl = 0; tl < 2; ++tl)
#pragma unroll
                for (int s_ = 0; s_ < 8; ++s_) *(LAS f16x8*)(V + vw + tl * 8192 + (((4 * (s_ >> 1) + kq) ^ swz) << 5) + (s_ & 1) * 16) = Kf[tl][s_];
            asm volatile("s_waitcnt lgkmcnt(0)" ::: "memory");
            u32x4 pk; pk.x = pk_h2(pe[0][0], pe[0][1]); pk.y = pk_h2(pe[0][2], pe[0][3]); pk.z = pk_h2(pe[1][0], pe[1][1]); pk.w = pk_h2(pe[1][2], pe[1][3]);
            const f16x8 Pf = __builtin_bit_cast(f16x8, pk);
#pragma unroll
            for (int ft = 0; ft < 16; ++ft) {
                const v4i16_t lo = __builtin_amdgcn_ds_read_tr16_b64_v4i16((LAS v4i16_t*)(V + tr0 + (((ft & 7) ^ x0) << 5) + (ft >> 3) * 256));
                const v4i16_t hi = __builtin_amdgcn_ds_read_tr16_b64_v4i16((LAS v4i16_t*)(V + tr0 + (((ft & 7) ^ x0) << 5) + (ft >> 3) * 256 + 8192));
                const s16x8 av = {lo[0], lo[1], lo[2], lo[3], hi[0], hi[1], hi[2], hi[3]};
                O[ft] = __builtin_amdgcn_mfma_f32_16x16x32_f16(__builtin_bit_cast(f16x8, av), Pf, O[ft], 0, 0, 0); }
            asm volatile("s_waitcnt lgkmcnt(0)" ::: "memory");
        }
        l += __shfl_xor(l, 16); l += __shfl_xor(l, 32);
        if (c < 8) { const float il = __builtin_amdgcn_rcpf(l);
#pragma unroll
            for (int ft = 0; ft < 16; ++ft) { const f32x4 o = O[ft] * il; u32x2 pk; pk.x = pk_h2(o.x, o.y); pk.y = pk_h2(o.z, o.w);
                *(u32x2*)(qlat + (size_t)tok * 2048 + c * 256 + 16 * ft + 4 * kq) = pk; } }
#undef SW_LOADK
    }
}


__device__ __forceinline__ void precomb_tiles(const Frame& F, const Args& args, unsigned char* ws, int t_lo, int t_hi, int wg, int nwg) {
    LAS float* As = (LAS float*)(F.lds); LAS float* Bs = (LAS float*)(F.lds + 64 * 65 * 4);
    for (int tl = t_lo + wg; tl < t_hi; tl += nwg) {
        __syncthreads();
        const bool ql = tl < 192; int hd, rb, xb;
        if (ql) { hd = tl / 24; rb = (tl % 24) / 6; xb = tl % 6; } else { const int t2 = tl - 192; hd = t2 / 64; rb = (t2 % 64) / 16; xb = t2 % 16; }
#pragma unroll
        for (int k = 0; k < 2; ++k) { const int i4 = F.tid + NTHR * k, row = i4 >> 4, c4 = (i4 & 15) * 4;
            if (ql) { const f32x4 a = *(const f32x4*)(args.in[15] + (size_t)(rb * 64 + row) * 512 + hd * 64 + c4), bq = *(const f32x4*)(args.in[14] + (size_t)(xb * 64 + row) * 768 + hd * 96 + c4);
#pragma unroll
                for (int e = 0; e < 4; ++e) { As[row * 65 + c4 + e] = a[e]; Bs[row * 65 + c4 + e] = bq[e]; } }
            else { const f32x4 a = *(const f32x4*)(args.in[18] + (size_t)(hd * 64 + row) * DM + xb * 64 + c4), bq = *(const f32x4*)(args.in[16] + (size_t)(rb * 64 + row) * 512 + hd * 64 + c4);
#pragma unroll
                for (int e = 0; e < 4; ++e) { As[(c4 + e) * 65 + row] = a[e]; Bs[row * 65 + c4 + e] = bq[e]; } } }
        __syncthreads();
        const int j = F.tid & 63, ig = F.wave;
        float acc8[8];
#pragma unroll
        for (int ii = 0; ii < 8; ++ii) acc8[ii] = 0.f;
#pragma unroll 4
        for (int v = 0; v < 64; ++v) { const float bv = Bs[j * 65 + v];
#pragma unroll
            for (int ii = 0; ii < 8; ++ii) acc8[ii] += As[(ig * 8 + ii) * 65 + v] * bv; }
        if (ql) { const float gj = args.in[12][xb * 64 + j]; h16* o = (h16*)(ws + OW_4);
#pragma unroll
            for (int ii = 0; ii < 8; ++ii) o[(size_t)(hd * 256 + rb * 64 + ig * 8 + ii) * QL + xb * 64 + j] = (h16)(acc8[ii] * gj); }
        else { h16* o = (h16*)(ws + OW_OV);
#pragma unroll
            for (int ii = 0; ii < 8; ++ii) o[(size_t)(xb * 64 + ig * 8 + ii) * 2048 + hd * 256 + rb * 64 + j] = (h16)acc8[ii]; }
    }
    __syncthreads();
}


__device__ __forceinline__ void ph_topk_sparse(const Frame& F, const h16* qi, const h16* ki, const float* wi, unsigned short* sel, h16* qlat, const h16* qr, const unsigned char* ckv8, const unsigned char* kr8) {
    LAS unsigned* hist = (LAS unsigned*)(F.lds + F.wave * 16384);
    for (int p = F.gw; p < 2048; p += F.NGW) {
        int ta, tb;
        if (p < 4 * 448) { const int b = p & 3, pj = p >> 2; ta = b * SEQ + 4 * (64 + pj); tb = b * SEQ + 4 * (959 - pj);
            tk_group(F, qi, ki, wi, sel, b, 4 * (64 + pj), hist);
            tk_group(F, qi, ki, wi, sel, b, 4 * (959 - pj), hist); }
        else { const int q_ = p - 4 * 448, b = q_ & 3, i_ = q_ >> 2, t0 = 4 * i_;
            tk_group(F, qi, ki, wi, sel, b, 4 * (960 + i_), hist);
            int l0 = F.lane; asm volatile("" : "+v"(l0));
            for (int i = l0; i < 4 * TOPK; i += 64) { const int q = i >> 8, k = i & 255; sel[(size_t)(b * SEQ + t0 + q) * TOPK + k] = (unsigned short)(k <= t0 + q ? k : 0); }
            ta = b * SEQ + 4 * (960 + i_); tb = b * SEQ + t0; }
        asm volatile("s_waitcnt vmcnt(0) lgkmcnt(0)" ::: "memory");
        ph_sparse_wave<true>(F, qlat, qr, ckv8, kr8, sel, ta, tb);
        asm volatile("s_waitcnt lgkmcnt(0)" ::: "memory");
    }
}

__global__ void __launch_bounds__(NTHR, 2) mega_fwd(Args args) {
    extern __shared__ __attribute__((aligned(16))) unsigned char lds_raw[];
    Frame F; F.lds = (LAS unsigned char*)lds_raw; F.tid = threadIdx.x; F.lane = F.tid & 63; F.wave = __builtin_amdgcn_readfirstlane(F.tid >> 6);
    F.G = gridDim.x; F.gw = blockIdx.x * NWAVES + F.wave; F.NGW = F.G * NWAVES;
    volatile LAS unsigned* MISC = (volatile LAS unsigned*)(F.lds + MISC_OFF);
    unsigned char* ws = args.ws;
    for (int u = F.tid; u < (LDS_BYTES - LDSCTL_OFF) / 4; u += NTHR) ((LAS unsigned*)(F.lds + LDSCTL_OFF))[u] = 0u;
    __syncthreads();
    XcdBarrier bar = xcd_barrier_post((unsigned*)(ws + OFF_CTL) + CW_BAR, MISC + 8, F.wave);
    const int lo = args.ph_lo, hi = args.ph_hi;
#define IN(k) (lo <= (k) && (k) < hi)
#define SEAM(k) do { if (IN(k) && IN((k) + 1)) xcd_barrier(bar); F.lane = flane(); F.tid = F.wave * 64 + F.lane; } while (0)
    float* mod = (float*)(ws + OFF_MOD); float2* tab = (float2*)(ws + OFF_ROPE);
    h16* Hb = (h16*)(ws + OFF_H); h16* Ab = (h16*)(ws + OFF_A); float* Fb = (float*)(ws + OFF_F);

    if (IN(0)) {
        LAS float* scr = (LAS float*)(F.lds + F.wave * 16384);
        for (int ch = blockIdx.x; ch < (NMOD * DM) / 36; ch += F.G) {
            LAS float* sl = (LAS float*)(F.lds);
            LAS float* part = (LAS float*)(F.lds + 16384);
            __syncthreads();
            for (int i = F.tid; i < 4 * DM; i += NTHR) sl[i] = silu_f(args.in[1][i]);
            __syncthreads();
            const int ln = F.lane < 36 ? F.lane : 35;
            const float* wm = args.in[3] + (size_t)(F.wave * 128) * (NMOD * DM) + ch * 36 + ln;
            float a0 = 0.f, a1 = 0.f, a2 = 0.f, a3 = 0.f;
#pragma unroll 16
            for (int k = 0; k < 128; ++k) { const float w = wm[(size_t)k * (NMOD * DM)]; const int kk = F.wave * 128 + k; a0 += sl[kk] * w; a1 += sl[DM + kk] * w; a2 += sl[2 * DM + kk] * w; a3 += sl[3 * DM + kk] * w; }
            part[(F.wave * 4 + 0) * 64 + F.lane] = a0; part[(F.wave * 4 + 1) * 64 + F.lane] = a1; part[(F.wave * 4 + 2) * 64 + F.lane] = a2; part[(F.wave * 4 + 3) * 64 + F.lane] = a3;
            __syncthreads();
            if (F.tid < 256 && (F.tid & 63) < 36) { const int b = F.tid >> 6, l = F.tid & 63; float sm = args.in[4][ch * 36 + l];
#pragma unroll
                for (int w = 0; w < 8; ++w) sm += part[(w * 4 + b) * 64 + l];
                mod[b * (NMOD * DM) + ch * 36 + l] = sm; }
            __syncthreads();
        }
        for (int idx = blockIdx.x * NTHR + F.tid; idx < MT * 48; idx += F.G * NTHR) { const int tok = idx / 48, i = idx % 48;
            const float inv = (i < 32) ? powf(10000.f, -(float)i / 32.f) : powf(10000.f, -(float)(i - 32) / 16.f);
            const float ang = (float)((const int*)args.in[2])[tok] * inv; tab[idx] = make_float2(cosf(ang), sinf(ang)); }
        tr_job_mapped(F, args, 0, 2 * FF, 0, DM, ws + OW_GU1, nullptr, scr, 0);
        if (F.G != 256) {
            tr_job_plain(F, args.in[8], DM, DM, FF, ws + OW_D1, scr, 768);
            tr_job_mapped(F, args, 2, NIN3, 0, DM, (h16*)(ws + OW_IN), nullptr, scr, 128);
            tr_job_plain(F, args.in[11] + C_GATE, DIN, 2048, DM, ws + OW_GATE, scr, 1664);
            tr_job_mapped(F, args, 3, 512, 2048, QL, (h16*)(ws + OW_4), args.in[12], scr, 640);
            tr_job_plain(F, args.in[19], DM, DM, 256, (h16*)(ws + OW_UPB), scr, 736);
            tr_job_plain(F, args.in[20], DM, DM, DM, (h16*)(ws + OW_O), scr, 864);
            tr_job_mapped(F, args, 1, 2 * FF, 0, DM, ws + OW_GU2, nullptr, scr, 1376);
            tr_job_plain(F, args.in[25], DM, DM, FF, ws + OW_D2, scr, 96);
            precomb_tiles(F, args, ws, 0, 192, (int)blockIdx.x, F.G);
            tr_job_plain(F, args.in[18], DM, DM, 512, (h16*)(ws + OW_UPA), scr, 256);
        }
    }
    SEAM(0);
    if (IN(1)) ph_normmod(F, args.in[0], args.in[5], mod, 1, 0, ws + OFF_H);
    SEAM(1);
    if (IN(2)) { pg8::Gemm g{Hb, (const h16*)(ws + OW_GU1), MT, 2 * FF, DM / 2}; pg8::StaticOrder S; S.init(MT, 2 * FF, F.G, (int)blockIdx.x); pg8::EpiSwiGLU_T<true> E{Ab};
        pg8::gemm_phase<pg8::EpiSwiGLU_T<true>, true, true>(F.lds, g, S, E, F.wave);
        if (F.G == 256 && blockIdx.x >= 128) {
            Frame F2 = F; F2.gw = ((int)blockIdx.x - 128) * NWAVES + F.wave; F2.NGW = 128 * NWAVES; LAS float* scr = (LAS float*)(F.lds + F.wave * 16384);
            tr_job_plain(F2, args.in[8], DM, DM, FF, ws + OW_D1, scr, 0);
            tr_job_mapped(F2, args, 2, NIN3, 0, DM, (h16*)(ws + OW_IN), nullptr, scr, 384);
            tr_job_mapped(F2, args, 3, 512, 2048, QL, (h16*)(ws + OW_4), args.in[12], scr, 896);
            tr_job_mapped(F2, args, 1, 2 * FF, 0, DM, ws + OW_GU2, nullptr, scr, 640);
            precomb_tiles(F, args, ws, 0, 192, (int)blockIdx.x - 128, 128);
            for (int i = ((int)blockIdx.x - 128) * NTHR + F.tid; i < (int)(MiB / 16); i += 128 * NTHR) ((u32x4*)(ws + OW_BD))[i] = (u32x4){0u, 0u, 0u, 0u}; } }
    SEAM(2);
    if (IN(3)) { pg8::Gemm g{Ab, (const h16*)(ws + OW_D1), MT, DM, FF / 2}; pg8::StaticOrder S; S.init(MT, DM, F.G, (int)blockIdx.x); pg8::EpiH16_T<true> E{(h16*)Fb};
        pg8::gemm_phase<pg8::EpiH16_T<true>, false, true>(F.lds, g, S, E, F.wave); }
    SEAM(3);
    if (IN(4)) ph_resnorm<false, true>(F, args.in[0], (const h16*)Fb, args.in[9], mod, 2, 0.5f, args.out, true, args.in[10], 4, 3, Hb, (unsigned char*)args.out + 32 * MiB);
    SEAM(4);
    if (IN(5)) { pg8::Gemm g{Hb, (const h16*)(ws + OW_IN), MT, NIN3, DM}; pg8::StaticOrder S; S.init(MT, NIN3, F.G, (int)blockIdx.x);
        pg8::EpiIn E{(h16*)(ws + OFF_CKV), (h16*)(ws + OFF_CQ), (h16*)(ws + OFF_KR), (h16*)(ws + OFF_KI), (h16*)(ws + OFF_QB), (h16*)(ws + OFF_KB), (h16*)(ws + OFF_VT), (float*)(ws + OFF_WI), (float*)(ws + OFF_SSQ),
                     args.in[13], tab, (LAS float*)(F.lds + XCH_OFF)};
        pg8::gemm_phase<pg8::EpiIn, true>(F.lds, g, S, E, F.wave); }
    SEAM(5);
    if (IN(6)) { for (int tk_ = blockIdx.x * NTHR + F.tid; tk_ < MT; tk_ += F.G * NTHR) { const f32x4 s0 = *(const f32x4*)((const float*)(ws + OFF_SSQ) + tk_ * 8), s1 = *(const f32x4*)((const float*)(ws + OFF_SSQ) + tk_ * 8 + 4);
            ((float*)(ws + OFF_RSTDQ))[tk_] = rsqrtf((((s0.x + s0.y) + (s0.z + s0.w)) + ((s1.x + s1.y) + (s1.z + s1.w))) * (1.f / QL) + EPS); } }
    if (IN(6)) ph_dilated_mfma(F, (const h16*)(ws + OFF_QB), (const h16*)(ws + OFF_KB), (const h16*)(ws + OFF_VT), (h16*)(ws + OFF_OG), (float*)(ws + OFF_LSE));
    SEAM(6);
    if (IN(7)) { pg8::Gemm g{(const h16*)(ws + OFF_CQ), (const h16*)(ws + OW_4), MT, N4, QL}; pg8::StaticOrder S; S.init(MT, N4, F.G, (int)blockIdx.x);
        pg8::Epi4 E{(h16*)(ws + OFF_QLAT), (h16*)(ws + OFF_QR), (h16*)(ws + OFF_QI), (const float*)(ws + OFF_RSTDQ), tab};
        pg8::gemm_phase<pg8::Epi4, true>(F.lds, g, S, E, F.wave);
        if (F.G == 256 && blockIdx.x >= 128) {
            Frame F2 = F; F2.gw = ((int)blockIdx.x - 128) * NWAVES + F.wave; F2.NGW = 128 * NWAVES; LAS float* scr = (LAS float*)(F.lds + F.wave * 16384);
            tr_job_plain(F2, args.in[11] + C_GATE, DIN, 2048, DM, ws + OW_GATE, scr, 0);
            tr_job_plain(F2, args.in[19], DM, DM, 256, (h16*)(ws + OW_UPB), scr, 512);
            tr_job_plain(F2, args.in[20], DM, DM, DM, (h16*)(ws + OW_O), scr, 640);
            tr_job_plain(F2, args.in[18], DM, DM, 512, (h16*)(ws + OW_UPA), scr, 256);
            for (int it = F2.gw; it < 4 * 16; it += F2.NGW) { const int kb = it >> 4, nb = it & 15, n0 = nb * 32, hl = (n0 >> 6) & 3;
                tr_item(args.in[16], 512, n0 + (F.lane & 31), true, nullptr, kb * 64, (h16*)(ws + OW_BD) + (size_t)n0 * 1024 + 256 * hl, 1024, scr, F.lane); } } }
    SEAM(7);
    if (IN(8)) { ph_combine(F, (const h16*)(ws + OFF_OG), (const float*)(ws + OFF_LSE), (h16*)(ws + OFF_OB));
        ph_topk_sparse(F, (const h16*)(ws + OFF_QI), (const h16*)(ws + OFF_KI), (const float*)(ws + OFF_WI), (unsigned short*)(ws + OFF_SEL),
                       (h16*)(ws + OFF_QLAT), (const h16*)(ws + OFF_QR), (const unsigned char*)(ws + OFF_CKV), (const unsigned char*)(ws + OFF_KR)); }
    SEAM(8);
    if (IN(9) && F.G == 256) { const bool first = blockIdx.x < 128;
        pg8::Gemm g{first ? (const h16*)(ws + OFF_QLAT) : (const h16*)(ws + OFF_OB), first ? (const h16*)(ws + OW_BD) : (const h16*)(ws + OW_UPB), MT, first ? 512 : DM, first ? 1024 : 256, first ? 2048 : 0, first ? 1024 : 0};
        pg8::StaticOrder S; S.init(MT, first ? 512 : DM, 128, first ? (int)blockIdx.x : (int)blockIdx.x - 128);
        pg8::EpiH16 E{first ? (h16*)(ws + OFF_OA) : (h16*)(ws + OFF_Y2), first ? 512 : DM};
        pg8::gemm_phase<pg8::EpiH16, false>(F.lds, g, S, E, F.wave); }
    SEAM(9);
    if (IN(10)) { pg8::StaticOrder S; S.init(MT, DM, F.G, (int)blockIdx.x); h16* Y1 = (h16*)(ws + OFF_Y1); h16* Y2 = (h16*)(ws + OFF_Y2);
        { pg8::Gemm g{(const h16*)(ws + OFF_OA), (const h16*)(ws + OW_UPA), MT, DM, 512}; pg8::EpiH16 E{Y1}; pg8::gemm_phase<pg8::EpiH16, false>(F.lds, g, S, E, F.wave); }
        const h16* u8 = (const h16*)((const unsigned char*)args.out + 32 * MiB);
        { pg8::Gemm g{u8, (const h16*)(ws + OW_GATE), MT, DM, DM / 2}; pg8::EpiGate E{Y1, Y1, 0, -LOG2E * F8_INV}; pg8::gemm_phase<pg8::EpiGate, false, true>(F.lds, g, S, E, F.wave); }
        { pg8::Gemm g{u8, (const h16*)(ws + OW_GATE + (size_t)DM * DM), MT, DM, DM / 2}; pg8::EpiGate E{Y2, Y1, 1, -LOG2E * F8_INV}; pg8::gemm_phase<pg8::EpiGate, false, true>(F.lds, g, S, E, F.wave); } }
    SEAM(10);
    if (IN(11)) { pg8::Gemm g{(const h16*)(ws + OFF_Y1), (const h16*)(ws + OW_O), MT, DM, DM}; pg8::StaticOrder S; S.init(MT, DM, F.G, (int)blockIdx.x); pg8::EpiH16 E{(h16*)(ws + OFF_YF)};
        pg8::gemm_phase<pg8::EpiH16, false>(F.lds, g, S, E, F.wave); }
    SEAM(11);
    if (IN(12)) ph_resnorm<true, true, unsigned char>(F, args.out, (const h16*)(ws + OFF_YF), args.in[21], mod, 5, 1.0f, ws + OFF_F, true, args.in[22], 7, 6, ws + OFF_H);
    SEAM(12);
    if (IN(13)) { pg8::Gemm g{Hb, (const h16*)(ws + OW_GU2), MT, 2 * FF, DM / 2}; pg8::StaticOrder S; S.init(MT, 2 * FF, F.G, (int)blockIdx.x); pg8::EpiSwiGLU_T<true> E{Ab};
        pg8::gemm_phase<pg8::EpiSwiGLU_T<true>, true, true>(F.lds, g, S, E, F.wave);
        if (F.G == 256 && blockIdx.x >= 128) { Frame F2 = F; F2.gw = ((int)blockIdx.x - 128) * NWAVES + F.wave; F2.NGW = 128 * NWAVES;
            tr_job_plain(F2, args.in[25], DM, DM, FF, ws + OW_D2, (LAS float*)(F.lds + F.wave * 16384), 0); } }
    SEAM(13);
    if (IN(14)) { pg8::Gemm g{Ab, (const h16*)(ws + OW_D2), MT, DM, FF / 2}; pg8::StaticOrder S; S.init(MT, DM, F.G, (int)blockIdx.x); pg8::EpiH16_T<true> E{(h16*)(ws + OFF_F + 32 * MiB)};
        pg8::gemm_phase<pg8::EpiH16_T<true>, false, true>(F.lds, g, S, E, F.wave); }
    SEAM(14);
    if (IN(15)) ph_resnorm<true, false>(F, ws + OFF_F, (const h16*)(ws + OFF_F + 32 * MiB), args.in[26], mod, 8, 0.5f, args.out, false, nullptr, 0, 0, (h16*)nullptr);
#undef IN
#undef SEAM
}


extern "C" void kernel_launch(void* const* d_in, const int* in_sizes, int n_in, void* d_out, int out_size, void* d_ws, size_t ws_size, hipStream_t stream) {
    if (n_in != 27 || ws_size < WS_END || out_size != MT * DM) { fprintf(stderr, "kernel_launch: unexpected shapes (n_in %d ws %zu out %d)\n", n_in, ws_size, out_size); return; }
    static int grid = 0;
    if (grid == 0) {
        int dev = 0, cus = 0, per_cu = 0;
        if (hipGetDevice(&dev) != hipSuccess || hipDeviceGetAttribute(&cus, hipDeviceAttributeMultiprocessorCount, dev) != hipSuccess) { grid = -1; return; }
        if (hipFuncSetAttribute((const void*)mega_fwd, hipFuncAttributeMaxDynamicSharedMemorySize, LDS_BYTES) != hipSuccess) { fprintf(stderr, "kernel_launch: hipFuncSetAttribute failed\n"); grid = -1; return; }
        if (hipOccupancyMaxActiveBlocksPerMultiprocessor(&per_cu, (const void*)mega_fwd, NTHR, LDS_BYTES) != hipSuccess || per_cu < 1) { fprintf(stderr, "kernel_launch: occupancy query says %d blocks/CU\n", per_cu); grid = -1; return; }
        grid = cus;
    }
    if (grid < 0) return;
    hipMemsetAsync((char*)d_ws + OFF_CTL, 0, 1 * MiB, stream);
    Args a{}; for (int i = 0; i < 27; ++i) a.in[i] = (const float*)d_in[i]; a.out = (float*)d_out; a.ws = (unsigned char*)d_ws; a.ph_lo = 0; a.ph_hi = 16;
    void* kargs[] = {&a};
#ifdef PH_DOUBLE
    a.ph_hi = PH_DOUBLE + 1; (void)hipLaunchCooperativeKernel((const void*)mega_fwd, dim3(grid), dim3(NTHR), kargs, LDS_BYTES, stream);
    hipMemsetAsync((char*)d_ws + OFF_CTL, 0, 1 * MiB, stream); a.ph_lo = PH_DOUBLE; a.ph_hi = 16;
#endif
    const hipError_t e = hipLaunchCooperativeKernel((const void*)mega_fwd, dim3(grid), dim3(NTHR), kargs, LDS_BYTES, stream);
    if (e != hipSuccess) fprintf(stderr, "kernel_launch: cooperative launch failed: %s (grid %d)\n", hipGetErrorString(e), grid);
    (void)in_sizes;
}
```

```cpp
#include <hip/hip_runtime.h>
#include <hip/hip_fp16.h>
#include <cstdio>
#include <cstdint>

constexpr int NB = 4, SEQ = 4096, DM = 1024, MT = NB * SEQ, FF = 2816;
constexpr int QL = 384, KVL = 256, DNOPE = 64, DROPE = 32, DVA = 64, HA = 8, HI = 8, DI = 32, TOPK = 256;
constexpr int NG = 3, HB = 4, DHB = 64, NMOD = 9, DIN = 5064;
constexpr int C_CQ = 0, C_CKV = 384, C_KR = 640, C_KI = 672, C_WI = 704, C_QKV = 712, C_GATE = 3016;
constexpr float EPS = 1e-6f, LOG2E = 1.4426950408889634f;
typedef _Float16 h16;

constexpr size_t MiB = 1u << 20;
constexpr size_t OFF_CTL = 0, OFF_MOD = 1 * MiB, OFF_ROPE = 2 * MiB, OFF_W = 8 * MiB, OFF_H = 60 * MiB, OFF_A = 92 * MiB, OFF_F = 180 * MiB, OFF_SP = 244 * MiB, WS_END = 256 * MiB;
constexpr size_t OFF_QB = OFF_A, OFF_KB = OFF_A + 24 * MiB, OFF_VT = OFF_A + 48 * MiB, OFF_CKV = OFF_A + 72 * MiB, OFF_KR = OFF_A + 80 * MiB, OFF_KI = OFF_A + 81 * MiB,
                 OFF_WI = OFF_A + 82 * MiB, OFF_SSQ = OFF_A + 82 * MiB + 512 * 1024, OFF_CQ = OFF_SP;
constexpr size_t OFF_RSTDQ = OFF_A + 83 * MiB;
constexpr size_t OFF_OG = OFF_F, OFF_LSE = OFF_F + 24 * MiB, OFF_QLAT = OFF_A, OFF_QR = OFF_A + 64 * MiB, OFF_QI = OFF_F + 25 * MiB, OFF_SEL = OFF_F + 33 * MiB, OFF_OB = OFF_SP;
constexpr size_t OFF_Y1 = OFF_F, OFF_Y2 = OFF_F + 32 * MiB, OFF_YF = OFF_A;

__device__ __forceinline__ float silu_f(float v) { return v / (1.f + __expf(-v)); }
__device__ __forceinline__ float sigm_f(float v) { return 1.f / (1.f + __expf(-v)); }
__host__ __device__ __forceinline__ int dil_of(int g) { return g == 0 ? 1 : (g == 1 ? 4 : 16); }
__device__ __forceinline__ unsigned fkey(float f) { const unsigned u = __float_as_uint(f); return (u & 0x80000000u) ? ~u : (u | 0x80000000u); }


#define LAS __attribute__((address_space(3)))
#define GAS __attribute__((address_space(1)))
typedef _Float16 f16x8 __attribute__((ext_vector_type(8)));
typedef float f32x4 __attribute__((ext_vector_type(4)));
typedef float f32x2 __attribute__((ext_vector_type(2)));
typedef unsigned u32x4 __attribute__((ext_vector_type(4)));
typedef unsigned u32x2 __attribute__((ext_vector_type(2)));
typedef _Float16 h16x2 __attribute__((ext_vector_type(2)));
__device__ __forceinline__ unsigned pk_h2(float lo, float hi) { f32x2 v = {lo, hi}; h16x2 h = __builtin_convertvector(v, h16x2); return __builtin_bit_cast(unsigned, h); }
__device__ __forceinline__ int flane() { int l; asm volatile("v_mbcnt_lo_u32_b32 %0, -1, 0\n\tv_mbcnt_hi_u32_b32 %0, -1, %0" : "=v"(l)); return l; }
__device__ __forceinline__ float sat8(float x) { return __builtin_amdgcn_fmed3f(x, -448.f, 448.f); }
__device__ __forceinline__ unsigned pk_f8x4(float a, float b, float c, float d) { int w = __builtin_amdgcn_cvt_pk_fp8_f32(sat8(a), sat8(b), 0, false); w = __builtin_amdgcn_cvt_pk_fp8_f32(sat8(c), sat8(d), w, true); return (unsigned)w; }
typedef int i32x4 __attribute__((ext_vector_type(4)));
typedef int i32x8 __attribute__((ext_vector_type(8)));
constexpr float F8_ACT = 8.f, F8_WGT = 512.f, F8_INV = 1.f / (F8_ACT * F8_WGT);

namespace pg8 {
constexpr int BM = 256, BK = 64, HALF = 128, HTB = HALF * BK * 2, STAGE_BYTES = 8 * HTB, NXCD = 8, WGM = 8;
__host__ __device__ __forceinline__ int lds_byte(int r, int c) { const int st = (r >> 4) * 2 + (c >> 5), rr = r & 15, cc = c & 31, ob = rr * 64 + cc * 2; return st * 1024 + (ob ^ (((ob >> 9) & 1) << 5)); }
__host__ __device__ __forceinline__ void stage_rc(int b, int& R, int& C) { const int st = b / 1024, sb = b % 1024, swz = sb ^ (((sb >> 9) & 1) << 5); R = (st >> 1) * 16 + swz / 64; C = (st & 1) * 32 + (swz % 64) / 2; }
__host__ __device__ __forceinline__ int perm32(int rho) { const int n = rho >> 4, i = rho & 15; return 8 * (i >> 2) + 4 * n + (i & 3); }
struct Unit { int pm, pn; };
struct Gemm { const h16* A; const h16* Bt; int M, N, K; int lda = 0, koffA = 0; };
struct StaticOrder {
    int nM, nN, nwg, G, c;
    __host__ __device__ void init(int M, int N, int G_, int c_) { nM = M / BM; nN = N / BM; nwg = nM * nN; G = G_; c = c_; }
    __host__ __device__ bool next(int i, Unit& u) const {
        const long L = (long)i * G + c; if (L >= nwg) return false;
        int wgid = (int)L; { const int q = nwg / NXCD, r = nwg % NXCD, xcd = wgid % NXCD, off = wgid / NXCD; wgid = (xcd < r ? xcd * (q + 1) : r * (q + 1) + (xcd - r) * q) + off; }
        const int nig = WGM * nN, gid = wgid / nig, fm = gid * WGM, gsz = (nM - fm) < WGM ? (nM - fm) : WGM;
        u.pm = fm + ((wgid % nig) % gsz); u.pn = (wgid % nig) / gsz; return true;
    }
};
template <class Epi, bool ALIGN_EPI, bool F8 = false>
__device__ __forceinline__ void gemm_phase(LAS unsigned char* lds, const Gemm g, const StaticOrder& S, const Epi& E, const int wid) {
    const int lane = flane(), tid = wid * 64 + lane, wr = wid >> 2, wc = wid & 3, fr = lane & 15, fq = lane >> 4;
    const int K = g.K, lda = g.lda ? g.lda : g.K; int nt = K / BK;
    if constexpr (F8) asm volatile("" : "+s"(nt));
    unsigned voffA[2], voffB[2];
#pragma unroll
    for (int i = 0; i < 2; ++i) { int R, C; stage_rc(tid * 16 + i * 8192, R, C); const int Rb = Epi::PERM ? ((R & ~31) + perm32(R & 31)) : R;
        voffA[i] = (unsigned)(R * lda + C) * 2u; voffB[i] = (unsigned)(Rb * K + C) * 2u; }
    const size_t kstep = (size_t)(BK * 2);
    const size_t hstep = (size_t)HALF * K * 2, hstepA = (size_t)HALF * lda * 2;
    const size_t tstep = 2 * hstep, tstepA = 2 * hstepA, kofA = (size_t)g.koffA * 2;
    const unsigned ldsw = (unsigned)wid * 1024u;
    const int aoff = lds_byte(wr * 64 + fr, fq * 8), boff = lds_byte(wc * 32 + fr, fq * 8);
#define PG8_SA(b, h) (((b) * 2 + (h)) * HTB)
#define PG8_SB(b, h) ((4 + (b) * 2 + (h)) * HTB)
#define PG8_STAGE(bufoff, gbase, voff) do { _Pragma("unroll") for (int _i = 0; _i < 2; ++_i) { unsigned _vo = (voff)[_i]; asm volatile("" : "+v"(_vo)); \
        __builtin_amdgcn_global_load_lds((const unsigned*)((const char*)(gbase) + _vo), (LAS unsigned*)(lds + (bufoff) + ldsw + _i * 8192), 16, 0, 0); } } while (0)
#define PG8_LDA(dst, b, h) do { _Pragma("unroll") for (int m = 0; m < 4; ++m) _Pragma("unroll") for (int k = 0; k < 2; ++k) dst[m][k] = *(const LAS f16x8*)(lds + PG8_SA(b, h) + aoff + m * 2048 + k * 1024); } while (0)
#define PG8_LDB(dst, b, h) do { _Pragma("unroll") for (int n = 0; n < 2; ++n) _Pragma("unroll") for (int k = 0; k < 2; ++k) dst[n][k] = *(const LAS f16x8*)(lds + PG8_SB(b, h) + boff + n * 2048 + k * 1024); } while (0)
#define PG8_CAT8(x, y) __builtin_shufflevector(__builtin_bit_cast(i32x4, x), __builtin_bit_cast(i32x4, y), 0, 1, 2, 3, 4, 5, 6, 7)
#define PG8_MMA(ai, bj, At, Bt) do { __builtin_amdgcn_s_setprio(1); \
        if constexpr (F8) { _Pragma("unroll") for (int m = 0; m < 4; ++m) _Pragma("unroll") for (int n = 0; n < 2; ++n) \
            acc[ai][bj][m][n] = __builtin_amdgcn_mfma_scale_f32_16x16x128_f8f6f4(PG8_CAT8(Bt[n][0], Bt[n][1]), PG8_CAT8(At[m][0], At[m][1]), acc[ai][bj][m][n], 0, 0, 0, 0, 0, 0); } \
        else { _Pragma("unroll") for (int m = 0; m < 4; ++m) _Pragma("unroll") for (int n = 0; n < 2; ++n) _Pragma("unroll") for (int k = 0; k < 2; ++k) \
            acc[ai][bj][m][n] = __builtin_amdgcn_mfma_f32_16x16x32_f16(Bt[n][k], At[m][k], acc[ai][bj][m][n], 0, 0, 0); } \
        __builtin_amdgcn_s_setprio(0); } while (0)
#define PG8_WAIT_V(n) asm volatile("s_waitcnt vmcnt(" #n ")" ::: "memory")
#define PG8_WAIT_L(n) asm volatile("s_waitcnt lgkmcnt(" #n ")" ::: "memory")
#define PG8_BAR __builtin_amdgcn_s_barrier()
#define PG8_SCHED __builtin_amdgcn_sched_barrier(0)
    Unit cur, nxt; int ui = 0;
    if (!S.next(0, cur)) return;
    f32x4 acc[2][2][4][2];
#pragma unroll
    for (int a = 0; a < 2; ++a)
#pragma unroll
        for (int b = 0; b < 2; ++b)
#pragma unroll
            for (int m = 0; m < 4; ++m)
#pragma unroll
                for (int n = 0; n < 2; ++n) acc[a][b][m][n] = (f32x4){0.f, 0.f, 0.f, 0.f};
    f16x8 At[4][2], B0[2][2], B1[2][2];
    const char* cA = (const char*)g.A + (size_t)cur.pm * tstepA + (size_t)cur.pn * kofA; const char* cB = (const char*)g.Bt + (size_t)cur.pn * tstep;
    PG8_STAGE(PG8_SB(0, 0), cB, voffB); PG8_STAGE(PG8_SB(0, 1), cB + hstep, voffB); PG8_STAGE(PG8_SA(0, 0), cA, voffA); PG8_STAGE(PG8_SA(0, 1), cA + hstepA, voffA);
    if (wr == 1) PG8_BAR;
    PG8_WAIT_V(2); PG8_BAR;
    PG8_STAGE(PG8_SB(1, 0), cB + kstep, voffB); PG8_STAGE(PG8_SA(1, 0), cA + kstep, voffA); PG8_STAGE(PG8_SB(1, 1), cB + hstep + kstep, voffB);
    PG8_WAIT_V(6); PG8_BAR;
    for (;;) {
        const bool has_next = S.next(ui + 1, nxt);
        const char* nA = has_next ? (const char*)g.A + (size_t)nxt.pm * tstepA + (size_t)nxt.pn * kofA : cA; const char* nB = has_next ? (const char*)g.Bt + (size_t)nxt.pn * tstep : cB;
        for (int t = 0; t < nt; t += 2) {
            const bool last = (t == nt - 2);
            const char* a1 = cA + (size_t)(t + 1) * kstep;
            const char* a2 = last ? nA : cA + (size_t)(t + 2) * kstep; const char* b2 = last ? nB : cB + (size_t)(t + 2) * kstep;
            const char* a3 = a2 + kstep; const char* b3 = b2 + kstep;
            PG8_LDB(B0, 0, 0); PG8_LDB(B1, 0, 1); PG8_SCHED; PG8_LDA(At, 0, 0); PG8_STAGE(PG8_SA(1, 1), a1 + hstepA, voffA);
            PG8_WAIT_V(8); PG8_WAIT_L(0); PG8_BAR; PG8_MMA(0, 0, At, B0); PG8_MMA(0, 1, At, B1); PG8_BAR; PG8_SCHED;
            PG8_LDA(At, 0, 1); PG8_STAGE(PG8_SB(0, 0), b2, voffB); PG8_STAGE(PG8_SB(0, 1), b2 + hstep, voffB); PG8_STAGE(PG8_SA(0, 0), a2, voffA);
            PG8_WAIT_V(8); PG8_WAIT_L(0); PG8_BAR; PG8_MMA(1, 0, At, B0); PG8_MMA(1, 1, At, B1); PG8_BAR; PG8_SCHED;
            PG8_LDB(B0, 1, 0); PG8_LDB(B1, 1, 1); PG8_SCHED; PG8_LDA(At, 1, 0); PG8_STAGE(PG8_SA(0, 1), a2 + hstepA, voffA);
            PG8_WAIT_V(8); PG8_WAIT_L(0); PG8_BAR; PG8_MMA(0, 0, At, B0); PG8_MMA(0, 1, At, B1); PG8_BAR; PG8_SCHED;
            PG8_LDA(At, 1, 1); PG8_STAGE(PG8_SB(1, 0), b3, voffB); PG8_STAGE(PG8_SB(1, 1), b3 + hstep, voffB); PG8_STAGE(PG8_SA(1, 0), a3, voffA);
            PG8_WAIT_V(8); PG8_WAIT_L(0); PG8_BAR; PG8_MMA(1, 0, At, B0); PG8_MMA(1, 1, At, B1); PG8_BAR; PG8_SCHED;
        }
        if constexpr (ALIGN_EPI) { if (wr == 0) PG8_BAR; }
        { const int l2 = flane(); E(acc, cur, wr, wc, l2 & 15, l2 >> 4); }
        if (!has_next) break;
#pragma unroll
        for (int a = 0; a < 2; ++a)
#pragma unroll
            for (int b = 0; b < 2; ++b)
#pragma unroll
                for (int m = 0; m < 4; ++m)
#pragma unroll
                    for (int n = 0; n < 2; ++n) acc[a][b][m][n] = (f32x4){0.f, 0.f, 0.f, 0.f};
        cur = nxt; cA = nA; cB = nB; ++ui;
        if constexpr (ALIGN_EPI) { if (wr == 1) PG8_BAR; }
    }
    PG8_WAIT_V(0);
    if constexpr (!ALIGN_EPI) { if (wr == 0) PG8_BAR; }
    PG8_BAR;
#undef PG8_SA
#undef PG8_SB
#undef PG8_STAGE
#undef PG8_LDA
#undef PG8_LDB
#undef PG8_MMA
#undef PG8_CAT8
#undef PG8_WAIT_V
#undef PG8_WAIT_L
#undef PG8_BAR
#undef PG8_SCHED
}
struct EpiF32 {
    static constexpr bool PERM = false;
    float* C; int ldc;
    __device__ __forceinline__ void operator()(const f32x4 (&acc)[2][2][4][2], const Unit& u, int wr, int wc, int fr, int fq) const {
        const int row0 = u.pm * BM + wr * 64 + fr, col0 = u.pn * BM + wc * 32 + 4 * fq;
#pragma unroll
        for (int ai = 0; ai < 2; ++ai)
#pragma unroll
            for (int m = 0; m < 4; ++m) { float* rowp = C + (size_t)(row0 + ai * HALF + m * 16) * ldc + col0;
#pragma unroll
                for (int bj = 0; bj < 2; ++bj)
#pragma unroll
                    for (int n = 0; n < 2; ++n) *(f32x4*)(rowp + bj * HALF + n * 16) = acc[ai][bj][m][n]; }
    }
};
template <bool F8>
struct EpiSwiGLU_T {
    static constexpr bool PERM = true;
    void* O;
    __device__ __forceinline__ void operator()(const f32x4 (&acc)[2][2][4][2], const Unit& u, int wr, int wc, int fr, int fq) const {
        const int row0 = u.pm * BM + wr * 64 + fr, col0 = u.pn * HALF + wc * 32 + 8 * fq;
#pragma unroll
        for (int ai = 0; ai < 2; ++ai)
#pragma unroll
            for (int m = 0; m < 4; ++m) { const size_t eo = (size_t)(row0 + ai * HALF + m * 16) * FF + col0;
                float v[8];
#pragma unroll
                for (int n = 0; n < 2; ++n)
#pragma unroll
                    for (int e = 0; e < 4; ++e) { float gg = acc[ai][0][m][n][e], uu = acc[ai][1][m][n][e]; if constexpr (F8) { gg *= F8_INV; uu *= F8_INV * F8_ACT; }
                        v[n * 4 + e] = gg * __builtin_amdgcn_rcpf(1.f + __builtin_amdgcn_exp2f(-gg * LOG2E)) * uu; }
                if constexpr (F8) { u32x2 w; w.x = pk_f8x4(v[0], v[1], v[2], v[3]); w.y = pk_f8x4(v[4], v[5], v[6], v[7]); *(u32x2*)((unsigned char*)O + eo) = w; }
                else { u32x4 w; w.x = pk_h2(v[0], v[1]); w.y = pk_h2(v[2], v[3]); w.z = pk_h2(v[4], v[5]); w.w = pk_h2(v[6], v[7]); *(u32x4*)((h16*)O + eo) = w; } }
    }
};
typedef EpiSwiGLU_T<false> EpiSwiGLU;

struct EpiIn {
    static constexpr bool PERM = false;
    h16 *ckv, *cq, *kr, *ki, *qb, *kb, *vT; float *wi, *ssq; const float* gckv; const float2* tab; LAS float* X;
    __device__ __forceinline__ void rope64(const f32x4 (&acc)[2][2][4][2], const Unit& u, int wr, int wc, int fr, int fq, h16* dst, int tl, float scale) const {
        const int tok0 = u.pm * BM + wr * 64 + fr;
        f32x4 tc[4], tn[4];
        { const f32x4* tp = (const f32x4*)(tab + (size_t)tok0 * 48 + 4 * fq); tc[0] = tp[0]; tc[1] = tp[1]; tc[2] = tp[8]; tc[3] = tp[9]; }
#pragma unroll
        for (int rr = 0; rr < 8; ++rr) { const int ai = rr >> 2, m = rr & 3, tok = tok0 + ai * HALF + m * 16;
            if (rr < 7) { const int tokn = tok0 + ((rr + 1) >> 2) * HALF + ((rr + 1) & 3) * 16; const f32x4* tp = (const f32x4*)(tab + (size_t)tokn * 48 + 4 * fq); tn[0] = tp[0]; tn[1] = tp[1]; tn[2] = tp[8]; tn[3] = tp[9]; }
#pragma unroll
            for (int n = 0; n < 2; ++n) { const int i = 16 * n + 4 * fq; const f32x4 t0 = tc[2 * n], t1 = tc[2 * n + 1];
                const f32x4 cs = {t0.x, t0.z, t1.x, t1.z}, sn = {t0.y, t0.w, t1.y, t1.w}, x1 = acc[ai][0][m][n], x2 = acc[ai][1][m][n];
                const f32x4 o1 = (x1 * cs - x2 * sn) * scale, o2 = (x2 * cs + x1 * sn) * scale;
                h16* p = dst + (size_t)tok * 768 + (4 * tl + wc) * 64 + i;
                u32x2 w1, w2; w1.x = pk_h2(o1.x, o1.y); w1.y = pk_h2(o1.z, o1.w); w2.x = pk_h2(o2.x, o2.y); w2.y = pk_h2(o2.z, o2.w);
                *(u32x2*)p = w1; *(u32x2*)(p + 32) = w2; }
#pragma unroll
            for (int k = 0; k < 4; ++k) tc[k] = tn[k];
            asm volatile("" ::: "memory"); }
    }
    __device__ __forceinline__ void operator()(const f32x4 (&acc)[2][2][4][2], const Unit& u, int wr, int wc, int fr, int fq) const {
        const int pn = u.pn;
        if (pn == 0) {
#pragma unroll
            for (int ai = 0; ai < 2; ++ai)
#pragma unroll
                for (int m = 0; m < 4; ++m) { float sq = 0.f;
#pragma unroll
                    for (int bj = 0; bj < 2; ++bj)
#pragma unroll
                        for (int n = 0; n < 2; ++n) { const f32x4 v = acc[ai][bj][m][n]; sq += (v.x * v.x + v.y * v.y) + (v.z * v.z + v.w * v.w); }
                    sq += __shfl_xor(sq, 16); sq += __shfl_xor(sq, 32);
                    if (fq == 0) X[(ai * HALF + wr * 64 + m * 16 + fr) * 4 + wc] = sq; }
            asm volatile("s_waitcnt lgkmcnt(0)" ::: "memory"); __builtin_amdgcn_s_barrier(); asm volatile("" ::: "memory");
#pragma unroll
            for (int ai = 0; ai < 2; ++ai)
#pragma unroll
                for (int m = 0; m < 4; ++m) { const int rl = ai * HALF + wr * 64 + m * 16 + fr, tok = u.pm * BM + rl; const f32x4 p = *(const LAS f32x4*)(X + rl * 4);
                    const float rstd = rsqrtf(((p.x + p.y) + (p.z + p.w)) * (1.f / KVL) + EPS);
#pragma unroll
                    for (int bj = 0; bj < 2; ++bj)
#pragma unroll
                        for (int n = 0; n < 2; ++n) { const int col = bj * HALF + wc * 32 + n * 16 + 4 * fq; const f32x4 o = acc[ai][bj][m][n] * rstd * *(const f32x4*)(gckv + col);
                            int w8 = __builtin_amdgcn_cvt_pk_fp8_f32(o.x, o.y, 0, false); w8 = __builtin_amdgcn_cvt_pk_fp8_f32(o.z, o.w, w8, true);
                            *(int*)((unsigned char*)ckv + (size_t)tok * KVL + col) = w8; }
                    asm volatile("" ::: "memory"); }
            asm volatile("s_waitcnt lgkmcnt(0)" ::: "memory"); __builtin_amdgcn_s_barrier(); asm volatile("" ::: "memory");
        } else if (pn <= 2) {
#pragma unroll
            for (int ai = 0; ai < 2; ++ai)
#pragma unroll
                for (int m = 0; m < 4; ++m) { const int tok = u.pm * BM + ai * HALF + wr * 64 + m * 16 + fr; float sq = 0.f;
#pragma unroll
                    for (int bj = 0; bj < 2; ++bj) { if (pn == 2 && bj == 1) break;
#pragma unroll
                        for (int n = 0; n < 2; ++n) { const f32x4 v = acc[ai][bj][m][n]; sq += (v.x * v.x + v.y * v.y) + (v.z * v.z + v.w * v.w);
                            const int col = (pn - 1) * 256 + bj * HALF + wc * 32 + n * 16 + 4 * fq; u32x2 w; w.x = pk_h2(v.x, v.y); w.y = pk_h2(v.z, v.w); *(u32x2*)(cq + (size_t)tok * QL + col) = w; } }
                    sq += __shfl_xor(sq, 16); sq += __shfl_xor(sq, 32);
                    if (fq == 0) ssq[tok * 8 + (pn - 1) * 4 + wc] = sq;
                    if (pn == 2) {
                        if (wc < 2) { const int i = 4 * fq; const f32x4* tp = (const f32x4*)(tab + (size_t)tok * 48 + 32 + i); const f32x4 t0 = tp[0], t1 = tp[1];
                            const f32x4 cs = {t0.x, t0.z, t1.x, t1.z}, sn = {t0.y, t0.w, t1.y, t1.w}, x1 = acc[ai][1][m][0], x2 = acc[ai][1][m][1];
                            const f32x4 o1 = x1 * cs - x2 * sn, o2 = x2 * cs + x1 * sn;
                            if (wc == 0) { unsigned char* p8 = (unsigned char*)kr + (size_t)tok * 32 + i;
                                int a8 = __builtin_amdgcn_cvt_pk_fp8_f32(o1.x, o1.y, 0, false); a8 = __builtin_amdgcn_cvt_pk_fp8_f32(o1.z, o1.w, a8, true);
                                int b8 = __builtin_amdgcn_cvt_pk_fp8_f32(o2.x, o2.y, 0, false); b8 = __builtin_amdgcn_cvt_pk_fp8_f32(o2.z, o2.w, b8, true);
                                *(int*)p8 = a8; *(int*)(p8 + 16) = b8; }
                            else { h16* p = ki + (size_t)tok * 32 + i;
                                u32x2 w1, w2; w1.x = pk_h2(o1.x, o1.y); w1.y = pk_h2(o1.z, o1.w); w2.x = pk_h2(o2.x, o2.y); w2.y = pk_h2(o2.z, o2.w);
                                *(u32x2*)p = w1; *(u32x2*)(p + 16) = w2; } }
                        else if (wc == 2 && fq < 2) { *(f32x4*)(wi + tok * 8 + 4 * fq) = acc[ai][1][m][0] * 0.35355339059327373f; }
                    }
                    asm volatile("" ::: "memory"); }
        } else if (pn <= 5) rope64(acc, u, wr, wc, fr, fq, qb, pn - 3, 0.125f * LOG2E);
        else if (pn <= 8) rope64(acc, u, wr, wc, fr, fq, kb, pn - 6, 1.0f);
        else {
#pragma unroll
            for (int ai = 0; ai < 2; ++ai)
#pragma unroll
                for (int m = 0; m < 4; ++m) { const int tok = u.pm * BM + ai * HALF + wr * 64 + m * 16 + fr;
#pragma unroll
                    for (int bj = 0; bj < 2; ++bj)
#pragma unroll
                        for (int n = 0; n < 2; ++n) { const f32x4 v = acc[ai][bj][m][n]; u32x2 w; w.x = pk_h2(v.x, v.y); w.y = pk_h2(v.z, v.w);
                            *(u32x2*)(vT + (size_t)tok * 768 + (pn - 9) * 256 + bj * HALF + wc * 32 + n * 16 + 4 * fq) = w; }
                    asm volatile("" ::: "memory"); }
        }
    }
};
struct Epi4 {
    static constexpr bool PERM = true;
    h16 *qlat, *qr, *qi; const float* rstdq; const float2* tab;
    __device__ __forceinline__ void operator()(const f32x4 (&acc)[2][2][4][2], const Unit& u, int wr, int wc, int fr, int fq) const {
        const int pn = u.pn; const float c2 = 0.10206207261596575f * LOG2E;
        const int tok0 = u.pm * BM + wr * 64 + fr;
        float rc = rstdq[tok0], rn = 0.f;
        if (pn < 8) {
#pragma unroll
            for (int rr = 0; rr < 8; ++rr) { const int ai = rr >> 2, m = rr & 3, tok = tok0 + ai * HALF + m * 16;
                if (rr < 7) rn = rstdq[tok0 + ((rr + 1) >> 2) * HALF + ((rr + 1) & 3) * 16];
#pragma unroll
                for (int bj = 0; bj < 2; ++bj) { const f32x4 o0 = acc[ai][bj][m][0] * (rc * c2), o1 = acc[ai][bj][m][1] * (rc * c2);
                    u32x4 w; w.x = pk_h2(o0.x, o0.y); w.y = pk_h2(o0.z, o0.w); w.z = pk_h2(o1.x, o1.y); w.w = pk_h2(o1.z, o1.w);
                    *(u32x4*)(qlat + (size_t)tok * 2048 + pn * 256 + bj * HALF + wc * 32 + 8 * fq) = w; }
                rc = rn; asm volatile("" ::: "memory"); }
        } else { h16* dst = (pn == 8) ? qr : qi; const float c2e = (pn == 8) ? c2 : 1.f; const int i = 4 * fq;
            f32x4 tc[2], tn[2];
            { const f32x4* tp = (const f32x4*)(tab + (size_t)tok0 * 48 + 32 + i); tc[0] = tp[0]; tc[1] = tp[1]; }
#pragma unroll
            for (int rr = 0; rr < 8; ++rr) { const int ai = rr >> 2, m = rr & 3, tok = tok0 + ai * HALF + m * 16;
                if (rr < 7) { const int tokn = tok0 + ((rr + 1) >> 2) * HALF + ((rr + 1) & 3) * 16; const f32x4* tp = (const f32x4*)(tab + (size_t)tokn * 48 + 32 + i); tn[0] = tp[0]; tn[1] = tp[1]; rn = rstdq[tokn]; }
                const f32x4 cs = {tc[0].x, tc[0].z, tc[1].x, tc[1].z}, sn = {tc[0].y, tc[0].w, tc[1].y, tc[1].w}; const float sc = rc * c2e;
#pragma unroll
                for (int bj = 0; bj < 2; ++bj) { const f32x4 x1 = acc[ai][bj][m][0], x2 = acc[ai][bj][m][1]; const f32x4 o1 = (x1 * cs - x2 * sn) * sc, o2 = (x2 * cs + x1 * sn) * sc;
                    h16* p = dst + (size_t)tok * 256 + (4 * bj + wc) * 32 + i;
                    u32x2 w1, w2; w1.x = pk_h2(o1.x, o1.y); w1.y = pk_h2(o1.z, o1.w); w2.x = pk_h2(o2.x, o2.y); w2.y = pk_h2(o2.z, o2.w);
                    *(u32x2*)p = w1; *(u32x2*)(p + 16) = w2; }
                tc[0] = tn[0]; tc[1] = tn[1]; rc = rn;
                asm volatile("" ::: "memory"); } }
    }
};
__device__ __forceinline__ u32x4 ld16_l2(const h16* p) {
    const unsigned long long a = __hip_atomic_load((const unsigned long long*)p, __ATOMIC_RELAXED, __HIP_MEMORY_SCOPE_AGENT), b = __hip_atomic_load((const unsigned long long*)p + 1, __ATOMIC_RELAXED, __HIP_MEMORY_SCOPE_AGENT);
    return (u32x4){(unsigned)a, (unsigned)(a >> 32), (unsigned)b, (unsigned)(b >> 32)};
}
typedef _Float16 h16x8 __attribute__((ext_vector_type(8)));
__device__ __forceinline__ void unpk8(const u32x4 w, float (&f)[8]) {
    const h16x8 h = __builtin_bit_cast(h16x8, w);
#pragma unroll
    for (int i = 0; i < 8; ++i) f[i] = (float)h[i];
}
template <bool SC>
struct EpiH16_T {
    static constexpr bool PERM = true;
    h16* O; int ldc = DM;
    __device__ __forceinline__ void operator()(const f32x4 (&acc)[2][2][4][2], const Unit& u, int wr, int wc, int fr, int fq) const {
        const int row0 = u.pm * BM + wr * 64 + fr, col0 = u.pn * BM + wc * 32 + 8 * fq;
#pragma unroll
        for (int ai = 0; ai < 2; ++ai)
#pragma unroll
            for (int m = 0; m < 4; ++m)
#pragma unroll
                for (int bj = 0; bj < 2; ++bj) { f32x4 v0 = acc[ai][bj][m][0], v1 = acc[ai][bj][m][1]; if constexpr (SC) { v0 *= F8_INV; v1 *= F8_INV; }
                    u32x4 w; w.x = pk_h2(v0.x, v0.y); w.y = pk_h2(v0.z, v0.w); w.z = pk_h2(v1.x, v1.y); w.w = pk_h2(v1.z, v1.w);
                    *(u32x4*)(O + (size_t)(row0 + ai * HALF + m * 16) * ldc + col0 + bj * HALF) = w; }
    }
};
typedef EpiH16_T<false> EpiH16;
struct EpiGate {
    static constexpr bool PERM = true;
    const h16* Y; h16* Z; int accum; float nls;
    __device__ __forceinline__ void operator()(const f32x4 (&acc)[2][2][4][2], const Unit& u, int wr, int wc, int fr, int fq) const {
        const int row0 = u.pm * BM + wr * 64 + fr, col0 = u.pn * BM + wc * 32 + 8 * fq;
#pragma unroll
        for (int ai = 0; ai < 2; ++ai)
#pragma unroll
            for (int m = 0; m < 4; ++m)
#pragma unroll
                for (int bj = 0; bj < 2; ++bj) { const size_t off = (size_t)(row0 + ai * HALF + m * 16) * DM + col0 + bj * HALF;
                    float y[8], zz[8]; unpk8(ld16_l2(Y + off), y);
                    if (accum) unpk8(ld16_l2(Z + off), zz); else {
#pragma unroll
                        for (int i = 0; i < 8; ++i) zz[i] = 0.f; }
                    float o[8];
#pragma unroll
                    for (int n = 0; n < 2; ++n)
#pragma unroll
                        for (int e = 0; e < 4; ++e) { const float gg = acc[ai][bj][m][n][e]; o[n * 4 + e] = zz[n * 4 + e] + y[n * 4 + e] * __builtin_amdgcn_rcpf(1.f + __builtin_amdgcn_exp2f(gg * nls)); }
                    u32x4 w; w.x = pk_h2(o[0], o[1]); w.y = pk_h2(o[2], o[3]); w.z = pk_h2(o[4], o[5]); w.w = pk_h2(o[6], o[7]);
                    *(u32x4*)(Z + off) = w; }
    }
};
}

#define XB_TMO      128
#define XB_XCNT(j)  (256  + 64 * (j))
#define XB_XSUB(j)  (1280 + 64 * (j))
#define XB_XGEN(j)  (2304 + 64 * (j))
#define XB_TOP      3328
#define XB_TOPGEN   3392
#define XCD_BAR_WORDS 3456
#define XB_SPIN_CAP (1u << 18)
__device__ __forceinline__ unsigned xb_ld(unsigned* p)              { return __hip_atomic_load(p, __ATOMIC_RELAXED, __HIP_MEMORY_SCOPE_AGENT); }
__device__ __forceinline__ unsigned xb_add(unsigned* p, unsigned v) { return __hip_atomic_fetch_add(p, v, __ATOMIC_RELAXED, __HIP_MEMORY_SCOPE_AGENT); }
__device__ __forceinline__ unsigned xb_xcc_id() { return (unsigned)__builtin_amdgcn_s_getreg((3 << 11) | 20) & 0xFu; }
#define XB_SPIN(cond, bar) do { unsigned _sp = 0; while (cond) { __builtin_amdgcn_s_sleep(1); \
    if ((++_sp & 255u) == 0u) { if (xb_ld(&(bar)[XB_TMO])) break; if (_sp > XB_SPIN_CAP) { atomicAdd(&(bar)[XB_TMO], 1u); break; } } } } while (0)
struct XcdBarrier { unsigned* bar; unsigned x; volatile LAS unsigned* st; int wave; };
__device__ __forceinline__ XcdBarrier xcd_barrier_post(unsigned* bar, volatile LAS unsigned* st, int wave) {
    XcdBarrier b; b.bar = bar; b.x = xb_xcc_id(); b.st = st; b.wave = wave;
    if (wave == 0 && flane() == 0) (void)xb_add(&bar[XB_XCNT(b.x)], 1u);
    return b;
}
__device__ __forceinline__ void xcd_barrier_complete(unsigned* bar, unsigned x, unsigned& nloc, unsigned& nx) {
    const unsigned G = gridDim.x * gridDim.y * gridDim.z;
    unsigned sum, cnt, mine, sp = 0u;
    for (;;) {
        sum = 0u; cnt = 0u; mine = 0u;
#pragma unroll
        for (unsigned j = 0; j < 16; ++j) { const unsigned c = xb_ld(&bar[XB_XCNT(j)]); sum += c; cnt += (c > 0u) ? 1u : 0u; mine = (j == x) ? c : mine; }
        if (sum == G) break;
        __builtin_amdgcn_s_sleep(1);
        if ((++sp & 255u) == 0u) { if (xb_ld(&bar[XB_TMO])) break; if (sp > XB_SPIN_CAP) { atomicAdd(&bar[XB_TMO], 1u); break; } }
    }
    nloc = mine > 0u ? mine : 1u; nx = cnt > 0u ? cnt : 1u;
}
__device__ __forceinline__ void xcd_barrier(const XcdBarrier& b) {
    asm volatile("s_waitcnt vmcnt(0)" ::: "memory");
    __syncthreads();
    if (b.wave == 0 && flane() == 0) {
        unsigned* bar = b.bar;
        __builtin_amdgcn_s_waitcnt(0);
        unsigned nloc = b.st[0], nx = b.st[1];
        if (nloc == 0u) { xcd_barrier_complete(bar, b.x, nloc, nx); b.st[0] = nloc; b.st[1] = nx; }
        const unsigned old = xb_add(&bar[XB_XSUB(b.x)], 1u);
        const unsigned gen = old / nloc;
        if (old + 1u == (gen + 1u) * nloc) {
            __builtin_amdgcn_fence(__ATOMIC_RELEASE, "agent");
            asm volatile("s_waitcnt vmcnt(0)" ::: "memory");
            const unsigned og = xb_add(&bar[XB_TOP], 1u);
            const unsigned tg = og / nx;
            if (og + 1u == (tg + 1u) * nx) xb_add(&bar[XB_TOPGEN], 1u);
            else XB_SPIN(xb_ld(&bar[XB_TOPGEN]) == tg, bar);
            __builtin_amdgcn_fence(__ATOMIC_ACQUIRE, "agent");
            xb_add(&bar[XB_XGEN(b.x)], 1u);
            asm volatile("s_waitcnt vmcnt(0)" ::: "memory");
        } else {
            XB_SPIN(xb_ld(&bar[XB_XGEN(b.x)]) == gen, bar);
            __builtin_amdgcn_fence(__ATOMIC_ACQUIRE, "agent");
            asm volatile("s_waitcnt vmcnt(0)" ::: "memory");
        }
    }
    __syncthreads();
}

constexpr int NWAVES = 8, NTHR = 512;
constexpr int RING_BYTES = 131072, LDSCTL_OFF = RING_BYTES, MISC_OFF = LDSCTL_OFF + 320, LDS_BYTES = 147456;
constexpr int XCH_OFF = RING_BYTES + 1024;
constexpr int CW_BAR = 4096;
constexpr size_t OW_GU1 = OFF_W, OW_D1 = OW_GU1 + 11 * MiB, OW_IN = OW_D1 + (size_t)DM * FF * 2, OW_GATE = OW_IN + 6 * MiB, OW_4 = OW_GATE + 4 * MiB, OW_OV = OW_4 + 2 * MiB,
                 OW_UPB = OW_OV + 4 * MiB, OW_O = OW_UPB + MiB / 2, OW_GU2 = OW_O + 2 * MiB, OW_D2 = OW_GU2 + 11 * MiB, OW_END = OW_D2 + (size_t)DM * FF * 2;
static_assert(OW_END <= OFF_H, "weights region");
constexpr int NIN3 = 3072, N4 = 2560;
constexpr size_t OW_BD = OW_OV, OW_UPA = OW_OV + MiB, OFF_OA = OFF_A + 64 * MiB;

struct Args { const float* in[27]; float* out; unsigned char* ws; int ph_lo, ph_hi; };
struct Frame {
    LAS unsigned char* lds; int tid, lane, wave, G, gw, NGW;
};
__device__ __forceinline__ float wave_sum(float v) {
#pragma unroll
    for (int o = 1; o < 64; o <<= 1) v += __shfl_xor(v, o);
    return v;
}
__device__ __forceinline__ bool map_row(int job, int n, const Args& a, const float*& W, int& ldw, int& col) {
    if (job <= 1) { const int t = n >> 8, j = n & 255; W = a.in[(job == 0 ? 6 : 23) + (j >> 7)]; ldw = FF; col = t * 128 + (j & 127); return true; }
    if (job == 2) { W = a.in[11]; ldw = DIN; const int t = n >> 8, j = n & 255;
        if (t == 0) { col = C_CKV + j; return true; }
        if (t == 1) { col = j; return true; }
        if (t == 2) { if (j < 128) { col = 256 + j; return true; } if (j < 160) { col = C_KR + (j - 128); return true; } if (j < 192) { col = C_KI + (j - 160); return true; } if (j < 200) { col = C_WI + (j - 192); return true; } col = 0; return false; }
        if (t < 9) { const int c3 = (t - 3) / 3, tl = (t - 3) % 3, hl = (j & 127) >> 5, i = j & 31; col = C_QKV + c3 * 768 + (4 * tl + hl) * 64 + (j >> 7) * 32 + i; return true; }
        col = C_QKV + 1536 + (t - 9) * 256 + j; return true; }
    { const int n2 = n - 2048, r5 = n2 & 31, nat = 16 * ((r5 >> 2) & 1) + 4 * (r5 >> 3) + (r5 & 3);
      if (n2 < 256) { W = a.in[14]; ldw = 768; col = (n2 >> 5) * 96 + 64 + nat; } else { W = a.in[17]; ldw = 256; col = ((n2 - 256) & ~31) + nat; } return true; }
}
template <typename T>
__device__ __forceinline__ void tr_item(const float* W, int ldw, int col, bool valid, const float* scale, int k0, T* WTrow0, int K, LAS float* scr, int lane) {
    const int colc = valid ? col : 0; float vv[32];
#pragma unroll
    for (int i = 0; i < 32; ++i) vv[i] = W[(size_t)(k0 + 2 * i + (lane >> 5)) * ldw + colc];
    if (scale) {
#pragma unroll
        for (int i = 0; i < 32; ++i) vv[i] *= scale[k0 + 2 * i + (lane >> 5)]; }
#pragma unroll
    for (int i = 0; i < 32; ++i) scr[(2 * i + (lane >> 5)) * 33 + (lane & 31)] = valid ? vv[i] : 0.f;
    asm volatile("s_waitcnt lgkmcnt(0)" ::: "memory");
    const int c = lane & 7;
#pragma unroll
    for (int j = 0; j < 4; ++j) { const int n = (lane >> 3) + 8 * j; const LAS float* s = scr + (8 * c) * 33 + n;
        if constexpr (sizeof(T) == 1) { u32x2 o; o.x = pk_f8x4(s[0 * 33] * F8_WGT, s[1 * 33] * F8_WGT, s[2 * 33] * F8_WGT, s[3 * 33] * F8_WGT); o.y = pk_f8x4(s[4 * 33] * F8_WGT, s[5 * 33] * F8_WGT, s[6 * 33] * F8_WGT, s[7 * 33] * F8_WGT);
            *(u32x2*)(WTrow0 + (size_t)n * K + k0 + 8 * c) = o; }
        else { u32x4 o; o.x = pk_h2(s[0 * 33], s[1 * 33]); o.y = pk_h2(s[2 * 33], s[3 * 33]); o.z = pk_h2(s[4 * 33], s[5 * 33]); o.w = pk_h2(s[6 * 33], s[7 * 33]);
            *(u32x4*)(WTrow0 + (size_t)n * K + k0 + 8 * c) = o; } }
    asm volatile("s_waitcnt lgkmcnt(0)" ::: "memory");
}
template <typename T>
__device__ __forceinline__ void tr_job_mapped(const Frame& F, const Args& a, int job, int Ndest, int n_lo, int K, T* WT, const float* scale, LAS float* scr, int phase_off) {
    const int nblk = Ndest / 32, nitems = (K / 64) * nblk;
    for (int it = (F.gw + phase_off) % F.NGW; it < nitems; it += F.NGW) {
        const int kb = it / nblk, nb = it % nblk; const float* W; int ldw, col;
        const bool valid = map_row(job, n_lo + nb * 32 + (F.lane & 31), a, W, ldw, col);
        tr_item(W, ldw, col, valid, scale, kb * 64, WT + (size_t)(n_lo + nb * 32) * K, K, scr, F.lane);
    }
}
template <typename T>
__device__ __forceinline__ void tr_job_plain(const Frame& F, const float* W, int ldw, int Ndest, int K, T* WT, LAS float* scr, int phase_off) {
    const int nblk = Ndest / 32, nitems = (K / 64) * nblk;
    for (int it = (F.gw + phase_off) % F.NGW; it < nitems; it += F.NGW) {
        const int kb = it / nblk, nb = it % nblk;
        tr_item(W, ldw, nb * 32 + (F.lane & 31), true, nullptr, kb * 64, WT + (size_t)(nb * 32) * K, K, scr, F.lane);
    }
}
__device__ __forceinline__ void row_load(const float* p, int lane, f32x4 (&v)[4]) {
#pragma unroll
    for (int j = 0; j < 4; ++j) v[j] = ((const f32x4*)p)[lane + 64 * j];
}
__device__ __forceinline__ float row_ssq(const f32x4 (&v)[4]) { float s = 0.f;
#pragma unroll
    for (int j = 0; j < 4; ++j) s += (v[j].x * v[j].x + v[j].y * v[j].y) + (v[j].z * v[j].z + v[j].w * v[j].w);
    return wave_sum(s); }
template <typename T>
__device__ __forceinline__ void row_normmod_store(const f32x4 (&v)[4], float rstd, const float* g, const float* sc, const float* sh, T* dst, int lane, unsigned char* dst8 = nullptr) {
#pragma unroll
    for (int j = 0; j < 4; ++j) { const int ci = lane + 64 * j; const f32x4 gg = ((const f32x4*)g)[ci], s1 = ((const f32x4*)sc)[ci], s0 = ((const f32x4*)sh)[ci];
        const f32x4 o = v[j] * rstd * gg * (s1 + 1.f) + s0;
        if constexpr (sizeof(T) == 1) ((unsigned*)dst)[ci] = pk_f8x4(o.x * F8_ACT, o.y * F8_ACT, o.z * F8_ACT, o.w * F8_ACT);
        else { u32x2 w; w.x = pk_h2(o.x, o.y); w.y = pk_h2(o.z, o.w); ((u32x2*)dst)[ci] = w; if (dst8) ((unsigned*)dst8)[ci] = pk_f8x4(o.x * F8_ACT, o.y * F8_ACT, o.z * F8_ACT, o.w * F8_ACT); } }
}
template <typename T>
__device__ __forceinline__ void store_nm(const f32x4 (&xv)[4], float r2, const f32x4 (&gb)[4], const f32x4 (&gc)[4], T* dst, int lane, unsigned char* dst8) {
#pragma unroll
    for (int j = 0; j < 4; ++j) { const int ci = lane + 64 * j; const f32x4 o = xv[j] * r2 * gb[j] + gc[j];
        if constexpr (sizeof(T) == 1) ((unsigned*)dst)[ci] = pk_f8x4(o.x * F8_ACT, o.y * F8_ACT, o.z * F8_ACT, o.w * F8_ACT);
        else { u32x2 w; w.x = pk_h2(o.x, o.y); w.y = pk_h2(o.z, o.w); ((u32x2*)dst)[ci] = w; if (dst8) ((unsigned*)dst8)[ci] = pk_f8x4(o.x * F8_ACT, o.y * F8_ACT, o.z * F8_ACT, o.w * F8_ACT); } }
}
template <typename T>
__device__ __forceinline__ void ph_normmod(const Frame& F, const float* x, const float* g, const float* mod, int isc, int ish, T* dst) {
    const int lane = flane();
    const int b = F.gw & 3, nsl = F.NGW >> 2; int r0 = F.gw >> 2; if (r0 >= SEQ) return;
    const float* mb = mod + b * (NMOD * DM); f32x4 gb[4], gc[4];
#pragma unroll
    for (int j = 0; j < 4; ++j) { const int ci = lane + 64 * j; gb[j] = ((const f32x4*)g)[ci] * (((const f32x4*)(mb + isc * DM))[ci] + 1.f); gc[j] = ((const f32x4*)(mb + ish * DM))[ci]; }
    const float* xb = x + (size_t)b * SEQ * DM; T* db = dst + (size_t)b * SEQ * DM;
    f32x4 v[2][4], vn[2][4];
#pragma unroll
    for (int k = 0; k < 2; ++k) { const int r = r0 + k * nsl; row_load(xb + (size_t)(r < SEQ ? r : r0) * DM, lane, v[k]); }
    for (;;) { const int rn = r0 + 2 * nsl; const bool has = rn < SEQ;
        if (has) {
#pragma unroll
            for (int k = 0; k < 2; ++k) { const int r = rn + k * nsl; row_load(xb + (size_t)(r < SEQ ? r : rn) * DM, lane, vn[k]); } }
#pragma unroll
        for (int k = 0; k < 2; ++k) { const int r = r0 + k * nsl; const float rstd = rsqrtf(row_ssq(v[k]) * (1.f / DM) + EPS);
            if (r < SEQ) store_nm(v[k], rstd, gb, gc, db + (size_t)r * DM, lane, nullptr); }
        if (!has) break;
#pragma unroll
        for (int k = 0; k < 2; ++k)
#pragma unroll
            for (int j = 0; j < 4; ++j) v[k][j] = vn[k][j];
        r0 = rn; }
}
__device__ __forceinline__ void row_load_h(const h16* p, int lane, u32x2 (&v)[4]) {
#pragma unroll
    for (int j = 0; j < 4; ++j) v[j] = ((const u32x2*)p)[lane + 64 * j];
}
typedef _Float16 h16x4 __attribute__((ext_vector_type(4)));
__device__ __forceinline__ f32x4 h4_to_f4(u32x2 w) { const h16x4 h = __builtin_bit_cast(h16x4, w); return (f32x4){(float)h[0], (float)h[1], (float)h[2], (float)h[3]}; }
template <bool XI16, bool XO16, typename T = h16>
__device__ __forceinline__ void ph_resnorm(const Frame& F, const void* xin_, const h16* f, const float* gpost, const float* mod, int igt, float coef, void* xout_,
                                           bool second, const float* gpre, int isc, int ish, T* dst, unsigned char* dst8 = nullptr) {
    const int lane = flane();
    const int b = F.gw & 3, nsl = F.NGW >> 2; int r0 = F.gw >> 2; if (r0 >= SEQ) return;
    const float* mb = mod + b * (NMOD * DM); f32x4 ga[4], gb[4], gc[4];
#pragma unroll
    for (int j = 0; j < 4; ++j) { const int ci = lane + 64 * j; ga[j] = ((const f32x4*)gpost)[ci] * ((const f32x4*)(mb + igt * DM))[ci] * coef;
        if (second) { gb[j] = ((const f32x4*)gpre)[ci] * (((const f32x4*)(mb + isc * DM))[ci] + 1.f); gc[j] = ((const f32x4*)(mb + ish * DM))[ci]; } else { gb[j] = (f32x4){0.f, 0.f, 0.f, 0.f}; gc[j] = gb[j]; } }
    const size_t bo = (size_t)b * SEQ * DM; const h16* fb = f + bo;
    u32x2 fh[2][4], fn[2][4]; f32x4 xi[2][4], xn[2][4]; u32x2 xh[2][4], xhn[2][4];
#pragma unroll
    for (int k = 0; k < 2; ++k) { const int r = r0 + k * nsl; const size_t ro = (size_t)(r < SEQ ? r : r0) * DM; row_load_h(fb + ro, lane, fh[k]);
        if constexpr (XI16) row_load_h((const h16*)xin_ + bo + ro, lane, xh[k]); else row_load((const float*)xin_ + bo + ro, lane, xi[k]); }
    for (;;) {
        const int rn = r0 + 2 * nsl; const bool has = rn < SEQ;
        if (has) {
#pragma unroll
            for (int k = 0; k < 2; ++k) { const int r = rn + k * nsl; const size_t ro = (size_t)(r < SEQ ? r : rn) * DM; row_load_h(fb + ro, lane, fn[k]);
                if constexpr (XI16) row_load_h((const h16*)xin_ + bo + ro, lane, xhn[k]); else row_load((const float*)xin_ + bo + ro, lane, xn[k]); } }
#pragma unroll
        for (int k = 0; k < 2; ++k) { const int r = r0 + k * nsl; const bool ok = r < SEQ; const size_t ro = bo + (size_t)r * DM;
            f32x4 v[4];
#pragma unroll
            for (int j = 0; j < 4; ++j) { v[j] = h4_to_f4(fh[k][j]); if constexpr (XI16) xi[k][j] = h4_to_f4(xh[k][j]); }
            const float rstd = rsqrtf(row_ssq(v) * (1.f / DM) + EPS);
#pragma unroll
            for (int j = 0; j < 4; ++j) { const int ci = lane + 64 * j;
                xi[k][j] = xi[k][j] + ga[j] * v[j] * rstd;
                if (ok) { if constexpr (XO16) { u32x2 w; w.x = pk_h2(xi[k][j].x, xi[k][j].y); w.y = pk_h2(xi[k][j].z, xi[k][j].w); ((u32x2*)((h16*)xout_ + ro))[ci] = w; }
                          else ((f32x4*)((float*)xout_ + ro))[ci] = xi[k][j]; } }
            if (second) { const float r2 = rsqrtf(row_ssq(xi[k]) * (1.f / DM) + EPS); if (ok) store_nm(xi[k], r2, gb, gc, dst + ro, lane, dst8 ? dst8 + ro : nullptr); } }
        if (!has) break;
#pragma unroll
        for (int k = 0; k < 2; ++k)
#pragma unroll
            for (int j = 0; j < 4; ++j) { fh[k][j] = fn[k][j]; if constexpr (XI16) xh[k][j] = xhn[k][j]; else xi[k][j] = xn[k][j]; }
        r0 = rn;
    }
}

__device__ __forceinline__ void ph_combine(const Frame& F, const h16* og, const float* lse2, h16* ob) {
    for (int idx = blockIdx.x * NTHR + F.tid; idx < MT * 256; idx += F.G * NTHR) {
        const int tok = idx >> 8, c = idx & 255, hh = c >> 6;
        const float l0 = lse2[tok * 12 + hh], l1 = lse2[tok * 12 + 4 + hh], l2 = lse2[tok * 12 + 8 + hh], m = fmaxf(l0, fmaxf(l1, l2));
        const float w0 = exp2f(l0 - m), w1 = exp2f(l1 - m), w2 = exp2f(l2 - m), inv = 1.f / (w0 + w1 + w2);
        ob[idx] = (h16)((w0 * (float)og[(size_t)tok * 768 + c] + w1 * (float)og[(size_t)tok * 768 + 256 + c] + w2 * (float)og[(size_t)tok * 768 + 512 + c]) * inv); }
}
typedef short v4i16_t __attribute__((ext_vector_type(4)));
typedef short s16x8 __attribute__((ext_vector_type(8)));
typedef float f32x16 __attribute__((ext_vector_type(16)));
__device__ __forceinline__ int tk_bin(float sc) { const unsigned u = __float_as_uint(sc); int e = (int)((u >> 16) & 0x7FFFu) - (122 << 7); e = e < 0 ? 0 : (e > 1023 ? 1023 : e); return (u >> 31) ? 1023 - e : 1024 + e; }
__device__ __forceinline__ void tk_scores(const f16x8 (&Af)[2], const float (&wv)[16], f16x8 b0, f16x8 b1, float& sa, float& sb) {
    f32x16 d = {0.f, 0.f, 0.f, 0.f, 0.f, 0.f, 0.f, 0.f, 0.f, 0.f, 0.f, 0.f, 0.f, 0.f, 0.f, 0.f};
    d = __builtin_amdgcn_mfma_f32_32x32x16_f16(Af[0], b0, d, 0, 0, 0); d = __builtin_amdgcn_mfma_f32_32x32x16_f16(Af[1], b1, d, 0, 0, 0);
    f32x2 acc = {0.f, 0.f};
#pragma unroll
    for (int e = 0; e < 16; e += 2) { const int i0 = __float_as_int(d[e]), i1 = __float_as_int(d[e + 1]);
        const f32x2 rl = {__int_as_float(i0 > 0 ? i0 : 0), __int_as_float(i1 > 0 ? i1 : 0)}; const f32x2 w2 = {wv[e], wv[e + 1]};
        acc = __builtin_elementwise_fma(w2, rl, acc); }
    sa = acc.x; sb = acc.y;
}
template <bool P2>
__device__ __forceinline__ void tk_tile(const f16x8 (&Af)[2], const float (&wv)[16], f16x8 b0, f16x8 b1, int tile, int r, int hi, int ta, LAS unsigned* hist, const int (&tbin)[4], int (&cs)[4], int (&cc)[4],
                                        unsigned short* sel, int tok0) {
    float sa, sb; tk_scores(Af, wv, b0, b1, sa, sb);
    const int s = 32 * tile + r;
    if constexpr (!P2) {
        if (s <= ta) { const int bn = tk_bin(sa); __hip_atomic_fetch_add(hist + (2 * hi) * 1024 + (bn >> 1), 1u << (16 * (bn & 1)), __ATOMIC_RELAXED, __HIP_MEMORY_SCOPE_WORKGROUP); }
        if (s <= ta + 1) { const int bn = tk_bin(sb); __hip_atomic_fetch_add(hist + (2 * hi + 1) * 1024 + (bn >> 1), 1u << (16 * (bn & 1)), __ATOMIC_RELAXED, __HIP_MEMORY_SCOPE_WORKGROUP); }
    } else {
        const unsigned lowmask = (1u << r) - 1u;
#pragma unroll
        for (int ab = 0; ab < 2; ++ab) { const float sc = ab ? sb : sa; const int tq = ta + ab; const int bn = tk_bin(sc);
            const int mytb = hi ? tbin[2 + ab] : tbin[ab];
            const bool valid = s <= tq, sure = valid && bn > mytb, cand = valid && bn == mytb;
            const unsigned long long ms = __ballot(sure), mc = __ballot(cand);
            const unsigned ms_h = hi ? (unsigned)(ms >> 32) : (unsigned)ms, mc_h = hi ? (unsigned)(mc >> 32) : (unsigned)mc;
            const int q = 2 * hi + ab;
            const int base_s = hi ? cs[2 + ab] : cs[ab], base_c = hi ? cc[2 + ab] : cc[ab];
            if (sure) sel[(size_t)(tok0 + q) * TOPK + base_s + __builtin_popcount(ms_h & lowmask)] = (unsigned short)s;
            if (cand) { const int pos = base_c + __builtin_popcount(mc_h & lowmask);
                if (pos < 512) ((LAS unsigned long long*)((LAS unsigned char*)hist + q * 4096))[pos] = ((unsigned long long)fkey(sc) << 16) | (unsigned long long)(0xFFFFu - (unsigned)s); }
            cs[ab] += __builtin_popcount((unsigned)ms); cs[2 + ab] += __builtin_popcount((unsigned)(ms >> 32));
            cc[ab] += __builtin_popcount((unsigned)mc); cc[2 + ab] += __builtin_popcount((unsigned)(mc >> 32)); }
    }
}
template <bool P2>
__device__ __forceinline__ void tk_pass(const f16x8 (&Af)[2], const float (&wv)[16], const h16* kbase, int ntiles, int r, int hi, int ta, LAS unsigned* hist, const int (&tbin)[4], int (&cs)[4], int (&cc)[4],
                                        unsigned short* sel, int tok0) {
    f16x8 BA[4][2], BB[4][2];
#define TK_LOAD(dst, t0_) do { _Pragma("unroll") for (int i_ = 0; i_ < 4; ++i_) { const int tt_ = ((t0_) + i_) < 127 ? ((t0_) + i_) : 127; dst[i_][0] = *(const f16x8*)(kbase + (size_t)tt_ * 1024); dst[i_][1] = *(const f16x8*)(kbase + (size_t)tt_ * 1024 + 16); } } while (0)
    TK_LOAD(BA, 0);
    for (int t0 = 0; t0 < ntiles; t0 += 8) {
        TK_LOAD(BB, t0 + 4);
#pragma unroll
        for (int i = 0; i < 4; ++i) if (t0 + i < ntiles) tk_tile<P2>(Af, wv, BA[i][0], BA[i][1], t0 + i, r, hi, ta, hist, tbin, cs, cc, sel, tok0);
        TK_LOAD(BA, t0 + 8);
#pragma unroll
        for (int i = 0; i < 4; ++i) if (t0 + 4 + i < ntiles) tk_tile<P2>(Af, wv, BB[i][0], BB[i][1], t0 + 4 + i, r, hi, ta, hist, tbin, cs, cc, sel, tok0);
    }
#undef TK_LOAD
}
__device__ __forceinline__ void tk_group(const Frame& F, const h16* qi, const h16* ki, const float* wi, unsigned short* sel, int b, int t0, LAS unsigned* hist) {
    int lane_ = F.lane; asm volatile("" : "+v"(lane_)); const int lane = lane_, r = lane & 31, hi = lane >> 5, tok0 = b * SEQ + t0;
    const int qa = 2 * ((r >> 2) & 1) + (r & 1), ha = 4 * (r >> 4) + 2 * ((r >> 3) & 1) + ((r >> 1) & 1);
    f16x8 Af[2];
#pragma unroll
    for (int s_ = 0; s_ < 2; ++s_) Af[s_] = *(const f16x8*)(qi + (size_t)(tok0 + qa) * 256 + ha * 32 + 16 * s_ + 8 * hi);
    float wv[16];
    { const f32x4 a0 = *(const f32x4*)(wi + (tok0 + 2 * hi) * 8), a1 = *(const f32x4*)(wi + (tok0 + 2 * hi) * 8 + 4), b0 = *(const f32x4*)(wi + (tok0 + 2 * hi + 1) * 8), b1 = *(const f32x4*)(wi + (tok0 + 2 * hi + 1) * 8 + 4);
      const float sa[8] = {a0.x, a0.y, a0.z, a0.w, a1.x, a1.y, a1.z, a1.w}, sb[8] = {b0.x, b0.y, b0.z, b0.w, b1.x, b1.y, b1.z, b1.w};
#pragma unroll
      for (int h = 0; h < 8; ++h) { wv[2 * h] = sa[h] * 0.17677669529663687f; wv[2 * h + 1] = sb[h] * 0.17677669529663687f; } }
    const int ntiles = (t0 + 3) / 32 + 1, ta = t0 + 2 * hi;
    const h16* kbase = ki + (size_t)(b * SEQ + r) * 32 + 8 * hi;
    int tbin[4] = {0, 0, 0, 0}, nsure[4], cs[4] = {0, 0, 0, 0}, cc[4] = {0, 0, 0, 0};
#pragma unroll
    for (int i = 0; i < 16; ++i) *(LAS u32x4*)((LAS unsigned char*)hist + i * 1024 + lane * 16) = (u32x4){0u, 0u, 0u, 0u};
    asm volatile("s_waitcnt lgkmcnt(0)" ::: "memory");
    tk_pass<false>(Af, wv, kbase, ntiles, r, hi, ta, hist, tbin, cs, cc, sel, tok0);
    asm volatile("s_waitcnt lgkmcnt(0)" ::: "memory");
#pragma unroll
    for (int q = 0; q < 4; ++q) {
        const LAS unsigned* hq = hist + q * 1024;
        unsigned sum = 0;
#pragma unroll
        for (int i = 0; i < 4; ++i) { const u32x4 v = *(const LAS u32x4*)(hq + 16 * lane + 4 * i); sum += (v.x & 0xFFFFu) + (v.x >> 16) + (v.y & 0xFFFFu) + (v.y >> 16) + (v.z & 0xFFFFu) + (v.z >> 16) + (v.w & 0xFFFFu) + (v.w >> 16); }
        unsigned incl = sum;
#pragma unroll
        for (int o = 1; o < 64; o <<= 1) { const unsigned v = __shfl_down(incl, o); if (lane + o < 64) incl += v; }
        const unsigned long long bal = __ballot(incl >= (unsigned)TOPK);
        const int L = 63 - __builtin_clzll(bal);
        unsigned cum = __shfl(incl, L) - __shfl(sum, L);
        int tbq = 32 * L, found = 0;
        for (int wd = 15; wd >= 0 && !found; --wd) { const unsigned v = hq[16 * L + wd];
            const unsigned chi = v >> 16, clo = v & 0xFFFFu;
            if (cum + chi >= (unsigned)TOPK) { tbq = 32 * L + 2 * wd + 1; found = 1; } else { cum += chi;
                if (cum + clo >= (unsigned)TOPK) { tbq = 32 * L + 2 * wd; found = 1; } else cum += clo; } }
        tbin[q] = tbq; nsure[q] = (int)cum;
    }
    asm volatile("s_waitcnt lgkmcnt(0)" ::: "memory");
    tk_pass<true>(Af, wv, kbase, ntiles, r, hi, ta, hist, tbin, cs, cc, sel, tok0);
    asm volatile("s_waitcnt lgkmcnt(0)" ::: "memory");
#pragma unroll
    for (int q = 0; q < 4; ++q) {
        const int nc = cc[q] < 512 ? cc[q] : 512, need = TOPK - cs[q];
        const LAS unsigned long long* cq = (const LAS unsigned long long*)((const LAS unsigned char*)hist + q * 4096);
        if (nc > 64) {
            unsigned long long it[8];
#pragma unroll
            for (int k = 0; k < 8; ++k) it[k] = (k * 64 + lane < nc) ? cq[k * 64 + lane] : 0ull;
            unsigned long long T = 0ull;
            for (int bit = 47; bit >= 0; --bit) { const unsigned long long cand = T | (1ull << bit); int cnt = 0;
#pragma unroll
                for (int k = 0; k < 8; ++k) cnt += __builtin_popcountll(__ballot(it[k] >= cand));
                if (cnt >= need) T = cand; }
            int basep = cs[q];
#pragma unroll
            for (int k = 0; k < 8; ++k) { const bool pick = (T != 0ull) && it[k] >= T; const unsigned long long mk = __ballot(pick);
                if (pick) sel[(size_t)(tok0 + q) * TOPK + basep + __builtin_popcountll(mk & ((1ull << lane) - 1ull))] = (unsigned short)(0xFFFFu - (unsigned)(it[k] & 0xFFFFull));
                basep += __builtin_popcountll(mk); }
        } else
        for (int base = 0; base < nc; base += 64) {
            const bool act = base + lane < nc; const unsigned long long my = act ? cq[base + lane] : 0ull; int rank = 0;
            for (int jb = 0; jb < nc; jb += 64) {
                const unsigned long long cj = (jb + lane < nc) ? cq[jb + lane] : 0ull; const unsigned clo = (unsigned)cj, chi = (unsigned)(cj >> 32);
                const int n = (nc - jb) < 64 ? (nc - jb) : 64;
                for (int j = 0; j < n; ++j) { const unsigned long long sj = ((unsigned long long)(unsigned)__builtin_amdgcn_readlane((int)chi, j) << 32) | (unsigned)__builtin_amdgcn_readlane((int)clo, j); rank += (sj > my) ? 1 : 0; } }
            if (act && rank < need) sel[(size_t)(tok0 + q) * TOPK + cs[q] + rank] = (unsigned short)(0xFFFFu - (unsigned)(my & 0xFFFFull)); }
    }
    (void)nsure;
    asm volatile("s_waitcnt lgkmcnt(0)" ::: "memory");
}
__device__ __forceinline__ void ph_topk_sparse(const Frame& F, const h16* qi, const h16* ki, const float* wi, unsigned short* sel, h16* qlat, const h16* qr, const unsigned char* ckv8, const unsigned char* kr8);
__device__ __forceinline__ void ph_topk_mfma(const Frame& F, const h16* qi, const h16* ki, const float* wi, unsigned short* sel) {
    LAS unsigned* hist = (LAS unsigned*)(F.lds + F.wave * 16384);
    for (int g = F.gw; g < 4 * 64; g += F.NGW) { const int b = g >> 6, t0 = (g & 63) * 4;
        for (int i = F.lane; i < 4 * TOPK; i += 64) { const int q = i >> 8, k = i & 255; sel[(size_t)(b * SEQ + t0 + q) * TOPK + k] = (unsigned short)(k <= t0 + q ? k : 0); } }
    for (int p = F.gw; p < 4 * 480; p += F.NGW) { const int b = p & 3, pj = p >> 2;
        tk_group(F, qi, ki, wi, sel, b, 4 * (64 + pj), hist);
        tk_group(F, qi, ki, wi, sel, b, 4 * (1023 - pj), hist);
    }
}


__device__ __forceinline__ void ph_dilated_mfma(const Frame& F, const h16* qb, const h16* kb, const h16* vb, h16* og, float* lse2) {
    const int lane = F.lane, ql = lane & 31, hi = lane >> 5;
    LAS unsigned char* VL = F.lds + F.wave * 16384;
    LAS float* linv = (LAS float*)(VL + 12288);
    constexpr int VROW = 192;
    const int trq = (lane & 15) >> 2, trp = lane & 3, trg = (lane >> 4) & 1;
    for (int u = F.gw; u < NB * 12 * 128; u += F.NGW) {
        const int b = u / 1536, rem = u % 1536, gh = rem >> 7, g = gh >> 2, wi_ = rem & 127, dil = dil_of(g), sh = g == 0 ? 0 : (g == 1 ? 2 : 4);
        const int nblk = 128 >> sh, res = wi_ / nblk, j0 = 32 * (wi_ % nblk);
        const size_t hoff = (size_t)b * SEQ * 768 + gh * 64;
        f16x8 Qf[4];
        { const h16* qp = qb + hoff + (size_t)((j0 + ql) * dil + res) * 768 + 8 * hi;
#pragma unroll
          for (int s_ = 0; s_ < 4; ++s_) Qf[s_] = *(const f16x8*)(qp + 16 * s_); }
        f32x16 S[5];
        f16x8 Kf[5][4];
#pragma unroll
        for (int kt = 0; kt < 5; ++kt) { int jk = j0 - 128 + 32 * kt + ql; jk = jk < 0 ? 0 : jk;
            const h16* kp = kb + hoff + (size_t)(jk * dil + res) * 768 + 8 * hi;
#pragma unroll
            for (int s_ = 0; s_ < 4; ++s_) Kf[kt][s_] = *(const f16x8*)(kp + 16 * s_); }
#pragma unroll
        for (int kt = 0; kt < 5; ++kt) {
            f32x16 d = {0.f, 0.f, 0.f, 0.f, 0.f, 0.f, 0.f, 0.f, 0.f, 0.f, 0.f, 0.f, 0.f, 0.f, 0.f, 0.f};
#pragma unroll
            for (int s_ = 0; s_ < 4; ++s_) d = __builtin_amdgcn_mfma_f32_32x32x16_f16(Kf[kt][s_], Qf[s_], d, 0, 0, 0);
            S[kt] = d; }
        f16x8 Vr[5][4];
#pragma unroll
        for (int kt = 0; kt < 5; ++kt) { int jk = j0 - 128 + 32 * kt + (lane >> 1); jk = jk < 0 ? 0 : jk;
            const h16* vp = vb + hoff + (size_t)(jk * dil + res) * 768 + (lane & 1) * 32;
#pragma unroll
            for (int i = 0; i < 4; ++i) Vr[kt][i] = *(const f16x8*)(vp + 8 * i); }
        float m = -INFINITY;
#pragma unroll
        for (int kt = 0; kt < 5; ++kt)
#pragma unroll
            for (int e = 0; e < 16; ++e) { const int kl = (e & 3) + 8 * (e >> 2) + 4 * hi; bool ok = (j0 - 128 + 32 * kt + kl) >= 0;
                if (kt == 0) ok = ok && (kl >= ql); if (kt == 4) ok = ok && (kl <= ql);
                if (!ok) S[kt][e] = -INFINITY; m = fmaxf(m, S[kt][e]); }
        m = fmaxf(m, __shfl_xor(m, 32));
        float l = 0.f;
#pragma unroll
        for (int kt = 0; kt < 5; ++kt)
#pragma unroll
            for (int e = 0; e < 16; ++e) { const float p = __builtin_amdgcn_exp2f(S[kt][e] - m); S[kt][e] = p; l += p; }
        l += __shfl_xor(l, 32);
        if (hi == 0) { linv[ql] = __builtin_amdgcn_rcpf(l); lse2[(size_t)(b * SEQ + (j0 + ql) * dil + res) * 12 + gh] = m + __builtin_amdgcn_logf(l); }
        f32x16 O[2];
#pragma unroll
        for (int dt = 0; dt < 2; ++dt) O[dt] = (f32x16){0.f, 0.f, 0.f, 0.f, 0.f, 0.f, 0.f, 0.f, 0.f, 0.f, 0.f, 0.f, 0.f, 0.f, 0.f, 0.f};
#pragma unroll
        for (int kt = 0; kt < 5; ++kt) {
            LAS unsigned char* vbuf = VL + (kt & 1) * 6144;
#pragma unroll
            for (int i = 0; i < 4; ++i) *(LAS f16x8*)(vbuf + (lane >> 1) * VROW + (lane & 1) * 64 + i * 16) = Vr[kt][i];
            asm volatile("s_waitcnt lgkmcnt(0)" ::: "memory");
#pragma unroll
            for (int s2 = 0; s2 < 2; ++s2) {
                u32x4 pa; pa.x = pk_h2(S[kt][8 * s2 + 0], S[kt][8 * s2 + 1]); pa.y = pk_h2(S[kt][8 * s2 + 2], S[kt][8 * s2 + 3]); pa.z = pk_h2(S[kt][8 * s2 + 4], S[kt][8 * s2 + 5]); pa.w = pk_h2(S[kt][8 * s2 + 6], S[kt][8 * s2 + 7]);
#pragma unroll
                for (int dt = 0; dt < 2; ++dt) {
                    const v4i16_t lo = __builtin_amdgcn_ds_read_tr16_b64_v4i16((LAS v4i16_t*)(vbuf + (16 * s2 + 4 * hi + trq) * VROW + (32 * dt + 16 * trg + 4 * trp) * 2));
                    const v4i16_t hh = __builtin_amdgcn_ds_read_tr16_b64_v4i16((LAS v4i16_t*)(vbuf + (16 * s2 + 8 + 4 * hi + trq) * VROW + (32 * dt + 16 * trg + 4 * trp) * 2));
                    const s16x8 bv = {lo[0], lo[1], lo[2], lo[3], hh[0], hh[1], hh[2], hh[3]};
                    O[dt] = __builtin_amdgcn_mfma_f32_32x32x16_f16(__builtin_bit_cast(f16x8, pa), __builtin_bit_cast(f16x8, bv), O[dt], 0, 0, 0); } }
            asm volatile("s_waitcnt lgkmcnt(0)" ::: "memory");
        }
#pragma unroll
        for (int e = 0; e < 16; ++e) { const int q = (e & 3) + 8 * (e >> 2) + 4 * hi; const float il = linv[q];
            h16* op = og + (size_t)(b * SEQ + (j0 + q) * dil + res) * 768 + gh * 64 + ql;
            op[0] = (h16)(O[0][e] * il); op[32] = (h16)(O[1][e] * il); }
        asm volatile("s_waitcnt lgkmcnt(0)" ::: "memory");
    }
}


__device__ __forceinline__ f16x8 fp8x8_to_f16(unsigned w0, unsigned w1) {
    const h16x2 a = __builtin_amdgcn_cvt_scalef32_pk_f16_fp8((int)w0, 1.0f, false), b = __builtin_amdgcn_cvt_scalef32_pk_f16_fp8((int)w0, 1.0f, true),
                c = __builtin_amdgcn_cvt_scalef32_pk_f16_fp8((int)w1, 1.0f, false), d = __builtin_amdgcn_cvt_scalef32_pk_f16_fp8((int)w1, 1.0f, true);
    const u32x4 r = {__builtin_bit_cast(unsigned, a), __builtin_bit_cast(unsigned, b), __builtin_bit_cast(unsigned, c), __builtin_bit_cast(unsigned, d)};
    return __builtin_bit_cast(f16x8, r);
}
template <bool FUSED>
__device__ __forceinline__ void ph_sparse_wave(const Frame& F, h16* qlat, const h16* qr, const unsigned char* ckv8, const unsigned char* kr8, const unsigned short* sel, int ta = 0, int tb = 0) {
    int lane = F.lane; asm volatile("" : "+v"(lane));
    LAS unsigned char* V = F.lds + F.wave * 16384;
    const int qp = (lane & 15) >> 2, pp = lane & 3;
    const int k0 = 4 * (lane >> 4) + qp;
    const int tr0 = k0 * 512 + (pp >> 1) * 16 + (pp & 1) * 8, x0 = k0 & 7;
    const int vw = (lane & 15) * 512, swz = lane & 7;
    const int lane0 = lane;
    const int nit = FUSED ? 8 : (MT - F.gw + F.NGW - 1) / F.NGW;
    for (int it = 0; it < nit; ++it) {
        const int tok = FUSED ? ((it < 4 ? ta : tb - 4) + it) : F.gw + it * F.NGW;
        int ll = lane0; asm volatile("" : "+v"(ll));
        const int c = ll & 15, kq = ll >> 4, hd = c & 7;
        const int b = tok / SEQ, t = tok % SEQ, cnt = (t + 1 < TOPK) ? t + 1 : TOPK, nch = (cnt + 31) >> 5;
        LAS unsigned short* sp = (LAS unsigned short*)(F.lds + XCH_OFF + F.wave * 512) + c;
        *(LAS u32x2*)(F.lds + XCH_OFF + F.wave * 512 + 8 * ll) = *(const u32x2*)(sel + (size_t)tok * TOPK + 4 * ll);
        asm volatile("s_waitcnt lgkmcnt(0)" ::: "memory");
        f16x8 Qf[9]; u32x4 Kr[2][4]; u32x2 Rr[2];
#pragma unroll
        for (int s_ = 0; s_ < 8; ++s_) Qf[s_] = *(const f16x8*)(qlat + (size_t)tok * 2048 + hd * 256 + 64 * (s_ >> 1) + 16 * kq + 8 * (s_ & 1));
        Qf[8] = *(const f16x8*)(qr + (size_t)tok * 256 + hd * 32 + 8 * kq);
        int rowi[2];
#define SW_LOADK() do { _Pragma("unroll") for (int tl = 0; tl < 2; ++tl) { _Pragma("unroll") for (int q4 = 0; q4 < 4; ++q4) Kr[tl][q4] = *(const u32x4*)(ckv8 + (size_t)rowi[tl] * 256 + 64 * q4 + 16 * kq); \
        Rr[tl] = *(const u32x2*)(kr8 + (size_t)rowi[tl] * 32 + 8 * kq); } } while (0)
        rowi[0] = b * SEQ + (int)sp[0]; rowi[1] = b * SEQ + (int)sp[16];
        SW_LOADK();
        float m = -INFINITY, l = 0.f;
        f32x4 O[16];
#pragma unroll
        for (int ft = 0; ft < 16; ++ft) O[ft] = (f32x4){0.f, 0.f, 0.f, 0.f};
        for (int ch = 0; ch < nch; ++ch) {
            const bool more = ch + 1 < nch;
            int rown0 = 0, rown1 = 0; if (more) { rown0 = (int)sp[32 * (ch + 1)]; rown1 = (int)sp[32 * (ch + 1) + 16]; }
            f16x8 Kf[2][9];
#pragma unroll
            for (int tl = 0; tl < 2; ++tl) {
#pragma unroll
                for (int q4 = 0; q4 < 4; ++q4) { Kf[tl][2 * q4] = fp8x8_to_f16(Kr[tl][q4].x, Kr[tl][q4].y); Kf[tl][2 * q4 + 1] = fp8x8_to_f16(Kr[tl][q4].z, Kr[tl][q4].w); }
                Kf[tl][8] = fp8x8_to_f16(Rr[tl].x, Rr[tl].y); }
            if (more) { rowi[0] = b * SEQ + rown0; rowi[1] = b * SEQ + rown1; SW_LOADK(); }
            f32x4 S[2];
#pragma unroll
            for (int tl = 0; tl < 2; ++tl) { S[tl] = (f32x4){0.f, 0.f, 0.f, 0.f};
#pragma unroll
                for (int s_ = 0; s_ < 9; ++s_) S[tl] = __builtin_amdgcn_mfma_f32_16x16x32_f16(Kf[tl][s_], Qf[s_], S[tl], 0, 0, 0); }
            float cm = -INFINITY;
#pragma unroll
            for (int tl = 0; tl < 2; ++tl)
#pragma unroll
                for (int e = 0; e < 4; ++e) { if (32 * ch + 16 * tl + 4 * kq + e >= cnt) S[tl][e] = -INFINITY; cm = fmaxf(cm, S[tl][e]); }
            cm = fmaxf(cm, __shfl_xor(cm, 16)); cm = fmaxf(cm, __shfl_xor(cm, 32));
            if (__any(cm > m + 8.0f)) { const float mn = fmaxf(m, cm), alpha = __builtin_amdgcn_exp2f(m - mn); m = mn; l *= alpha;
#pragma unroll
                for (int ft = 0; ft < 16; ++ft) O[ft] = O[ft] * alpha; }
            float pe[2][4]; float ps = 0.f;
#pragma unroll
            for (int tl = 0; tl < 2; ++tl)
#pragma unroll
                for (int e = 0; e < 4; ++e) { pe[tl][e] = __builtin_amdgcn_exp2f(S[tl][e] - m); ps += pe[tl][e]; }
            l += ps;
#pragma unroll
            for (int tl = 0; tl < 2; ++tl)
#pragma unroll
                for (int s_ = 0; s_ < 8; ++s_) *(LAS f16x8*)(V + vw + tl * 8192 + (((4 * (s_ >> 1) + kq) ^ swz) << 5) + (s_ & 1) * 16) = Kf[tl][s_];
            asm volatile("s_waitcnt lgkmcnt(0)" ::: "memory");
            u32x4 pk; pk.x = pk_h2(pe[0][0], pe[0][1]); pk.y = pk_h2(pe[0][2], pe[0][3]); pk.z = pk_h2(pe[1][0], pe[1][1]); pk.w = pk_h2(pe[1][2], pe[1][3]);
            const f16x8 Pf = __builtin_bit_cast(f16x8, pk);
#pragma unroll
            for (int ft = 0; ft < 16; ++ft) {
                const v4i16_t lo = __builtin_amdgcn_ds_read_tr16_b64_v4i16((LAS v4i16_t*)(V + tr0 + (((ft & 7) ^ x0) << 5) + (ft >> 3) * 256));
                const v4i16_t hi = __builtin_amdgcn_ds_read_tr16_b64_v4i16((LAS v4i16_t*)(V + tr0 + (((ft & 7) ^ x0) << 5) + (ft >> 3) * 256 + 8192));
                const s16x8 av = {lo[0], lo[1], lo[2], lo[3], hi[0], hi[1], hi[2], hi[3]};
                O[ft] = __builtin_amdgcn_mfma_f32_16x16x32_f16(__builtin_bit_cast(f16x8, av), Pf, O[ft], 0, 0, 0); }
            asm volatile("s_waitcnt lgkmcnt(0)" ::: "memory");
        }
        l += __shfl_xor(l, 16); l += __shfl_xor(l, 32);
        if (c < 8) { const float il = __builtin_amdgcn_rcpf(l);
#pragma unroll
            for (int ft = 0; ft < 16; ++ft) { const f32x4 o = O[ft] * il; u32x2 pk; pk.x = pk_h2(o.x, o.y); pk.y = pk_h2(o.z, o.w);
                *(u32x2*)(qlat + (size_t)tok * 2048 + c * 256 + 16 * ft + 4 * kq) = pk; } }
#undef SW_LOADK
    }
}


__device__ __forceinline__ void precomb_tiles(const Frame& F, const Args& args, unsigned char* ws, int t_lo, int t_hi, int wg, int nwg) {
    LAS float* As = (LAS float*)(F.lds); LAS float* Bs = (LAS float*)(F.lds + 64 * 65 * 4);
    for (int tl = t_lo + wg; tl < t_hi; tl += nwg) {
        __syncthreads();
        const bool ql = tl < 192; int hd, rb, xb;
        if (ql) { hd = tl / 24; rb = (tl % 24) / 6; xb = tl % 6; } else { const int t2 = tl - 192; hd = t2 / 64; rb = (t2 % 64) / 16; xb = t2 % 16; }
#pragma unroll
        for (int k = 0; k < 2; ++k) { const int i4 = F.tid + NTHR * k, row = i4 >> 4, c4 = (i4 & 15) * 4;
            if (ql) { const f32x4 a = *(const f32x4*)(args.in[15] + (size_t)(rb * 64 + row) * 512 + hd * 64 + c4), bq = *(const f32x4*)(args.in[14] + (size_t)(xb * 64 + row) * 768 + hd * 96 + c4);
#pragma unroll
                for (int e = 0; e < 4; ++e) { As[row * 65 + c4 + e] = a[e]; Bs[row * 65 + c4 + e] = bq[e]; } }
            else { const f32x4 a = *(const f32x4*)(args.in[18] + (size_t)(hd * 64 + row) * DM + xb * 64 + c4), bq = *(const f32x4*)(args.in[16] + (size_t)(rb * 64 + row) * 512 + hd * 64 + c4);
#pragma unroll
                for (int e = 0; e < 4; ++e) { As[(c4 + e) * 65 + row] = a[e]; Bs[row * 65 + c4 + e] = bq[e]; } } }
        __syncthreads();
        const int j = F.tid & 63, ig = F.wave;
        float acc8[8];
#pragma unroll
        for (int ii = 0; ii < 8; ++ii) acc8[ii] = 0.f;
#pragma unroll 4
        for (int v = 0; v < 64; ++v) { const float bv = Bs[j * 65 + v];
#pragma unroll
            for (int ii = 0; ii < 8; ++ii) acc8[ii] += As[(ig * 8 + ii) * 65 + v] * bv; }
        if (ql) { const float gj = args.in[12][xb * 64 + j]; h16* o = (h16*)(ws + OW_4);
#pragma unroll
            for (int ii = 0; ii < 8; ++ii) o[(size_t)(hd * 256 + rb * 64 + ig * 8 + ii) * QL + xb * 64 + j] = (h16)(acc8[ii] * gj); }
        else { h16* o = (h16*)(ws + OW_OV);
#pragma unroll
            for (int ii = 0; ii < 8; ++ii) o[(size_t)(xb * 64 + ig * 8 + ii) * 2048 + hd * 256 + rb * 64 + j] = (h16)acc8[ii]; }
    }
    __syncthreads();
}


__device__ __forceinline__ void ph_topk_sparse(const Frame& F, const h16* qi, const h16* ki, const float* wi, unsigned short* sel, h16* qlat, const h16* qr, const unsigned char* ckv8, const unsigned char* kr8) {
    LAS unsigned* hist = (LAS unsigned*)(F.lds + F.wave * 16384);
    for (int p = F.gw; p < 2048; p += F.NGW) {
        int ta, tb;
        if (p < 4 * 448) { const int b = p & 3, pj = p >> 2; ta = b * SEQ + 4 * (64 + pj); tb = b * SEQ + 4 * (959 - pj);
            tk_group(F, qi, ki, wi, sel, b, 4 * (64 + pj), hist);
            tk_group(F, qi, ki, wi, sel, b, 4 * (959 - pj), hist); }
        else { const int q_ = p - 4 * 448, b = q_ & 3, i_ = q_ >> 2, t0 = 4 * i_;
            tk_group(F, qi, ki, wi, sel, b, 4 * (960 + i_), hist);
            int l0 = F.lane; asm volatile("" : "+v"(l0));
            for (int i = l0; i < 4 * TOPK; i += 64) { const int q = i >> 8, k = i & 255; sel[(size_t)(b * SEQ + t0 + q) * TOPK + k] = (unsigned short)(k <= t0 + q ? k : 0); }
            ta = b * SEQ + 4 * (960 + i_); tb = b * SEQ + t0; }
        asm volatile("s_waitcnt vmcnt(0) lgkmcnt(0)" ::: "memory");
        ph_sparse_wave<true>(F, qlat, qr, ckv8, kr8, sel, ta, tb);
        asm volatile("s_waitcnt lgkmcnt(0)" ::: "memory");
    }
}

__global__ void __launch_bounds__(NTHR, 2) mega_fwd(Args args) {
    extern __shared__ __attribute__((aligned(16))) unsigned char lds_raw[];
    Frame F; F.lds = (LAS unsigned char*)lds_raw; F.tid = threadIdx.x; F.lane = F.tid & 63; F.wave = __builtin_amdgcn_readfirstlane(F.tid >> 6);
    F.G = gridDim.x; F.gw = blockIdx.x * NWAVES + F.wave; F.NGW = F.G * NWAVES;
    volatile LAS unsigned* MISC = (volatile LAS unsigned*)(F.lds + MISC_OFF);
    unsigned char* ws = args.ws;
    for (int u = F.tid; u < (LDS_BYTES - LDSCTL_OFF) / 4; u += NTHR) ((LAS unsigned*)(F.lds + LDSCTL_OFF))[u] = 0u;
    __syncthreads();
    XcdBarrier bar = xcd_barrier_post((unsigned*)(ws + OFF_CTL) + CW_BAR, MISC + 8, F.wave);
    const int lo = args.ph_lo, hi = args.ph_hi;
#define IN(k) (lo <= (k) && (k) < hi)
#define SEAM(k) do { if (IN(k) && IN((k) + 1)) xcd_barrier(bar); F.lane = flane(); F.tid = F.wave * 64 + F.lane; } while (0)
    float* mod = (float*)(ws + OFF_MOD); float2* tab = (float2*)(ws + OFF_ROPE);
    h16* Hb = (h16*)(ws + OFF_H); h16* Ab = (h16*)(ws + OFF_A); float* Fb = (float*)(ws + OFF_F);

    if (IN(0)) {
        LAS float* scr = (LAS float*)(F.lds + F.wave * 16384);
        for (int ch = blockIdx.x; ch < (NMOD * DM) / 36; ch += F.G) {
            LAS float* sl = (LAS float*)(F.lds);
            LAS float* part = (LAS float*)(F.lds + 16384);
            __syncthreads();
            for (int i = F.tid; i < 4 * DM; i += NTHR) sl[i] = silu_f(args.in[1][i]);
            __syncthreads();
            const int ln = F.lane < 36 ? F.lane : 35;
            const float* wm = args.in[3] + (size_t)(F.wave * 128) * (NMOD * DM) + ch * 36 + ln;
            float a0 = 0.f, a1 = 0.f, a2 = 0.f, a3 = 0.f;
#pragma unroll 16
            for (int k = 0; k < 128; ++k) { const float w = wm[(size_t)k * (NMOD * DM)]; const int kk = F.wave * 128 + k; a0 += sl[kk] * w; a1 += sl[DM + kk] * w; a2 += sl[2 * DM + kk] * w; a3 += sl[3 * DM + kk] * w; }
            part[(F.wave * 4 + 0) * 64 + F.lane] = a0; part[(F.wave * 4 + 1) * 64 + F.lane] = a1; part[(F.wave * 4 + 2) * 64 + F.lane] = a2; part[(F.wave * 4 + 3) * 64 + F.lane] = a3;
            __syncthreads();
            if (F.tid < 256 && (F.tid & 63) < 36) { const int b = F.tid >> 6, l = F.tid & 63; float sm = args.in[4][ch * 36 + l];
#pragma unroll
                for (int w = 0; w < 8; ++w) sm += part[(w * 4 + b) * 64 + l];
                mod[b * (NMOD * DM) + ch * 36 + l] = sm; }
            __syncthreads();
        }
        for (int idx = blockIdx.x * NTHR + F.tid; idx < MT * 48; idx += F.G * NTHR) { const int tok = idx / 48, i = idx % 48;
            const float inv = (i < 32) ? powf(10000.f, -(float)i / 32.f) : powf(10000.f, -(float)(i - 32) / 16.f);
            const float ang = (float)((const int*)args.in[2])[tok] * inv; tab[idx] = make_float2(cosf(ang), sinf(ang)); }
        tr_job_mapped(F, args, 0, 2 * FF, 0, DM, ws + OW_GU1, nullptr, scr, 0);
        if (F.G != 256) {
            tr_job_plain(F, args.in[8], DM, DM, FF, ws + OW_D1, scr, 768);
            tr_job_mapped(F, args, 2, NIN3, 0, DM, (h16*)(ws + OW_IN), nullptr, scr, 128);
            tr_job_plain(F, args.in[11] + C_GATE, DIN, 2048, DM, ws + OW_GATE, scr, 1664);
            tr_job_mapped(F, args, 3, 512, 2048, QL, (h16*)(ws + OW_4), args.in[12], scr, 640);
            tr_job_plain(F, args.in[19], DM, DM, 256, (h16*)(ws + OW_UPB), scr, 736);
            tr_job_plain(F, args.in[20], DM, DM, DM, (h16*)(ws + OW_O), scr, 864);
            tr_job_mapped(F, args, 1, 2 * FF, 0, DM, ws + OW_GU2, nullptr, scr, 1376);
            tr_job_plain(F, args.in[25], DM, DM, FF, ws + OW_D2, scr, 96);
            precomb_tiles(F, args, ws, 0, 192, (int)blockIdx.x, F.G);
            tr_job_plain(F, args.in[18], DM, DM, 512, (h16*)(ws + OW_UPA), scr, 256);
        }
    }
    SEAM(0);
    if (IN(1)) ph_normmod(F, args.in[0], args.in[5], mod, 1, 0, ws + OFF_H);
    SEAM(1);
    if (IN(2)) { pg8::Gemm g{Hb, (const h16*)(ws + OW_GU1), MT, 2 * FF, DM / 2}; pg8::StaticOrder S; S.init(MT, 2 * FF, F.G, (int)blockIdx.x); pg8::EpiSwiGLU_T<true> E{Ab};
        pg8::gemm_phase<pg8::EpiSwiGLU_T<true>, true, true>(F.lds, g, S, E, F.wave);
        if (F.G == 256 && blockIdx.x >= 128) {
            Frame F2 = F; F2.gw = ((int)blockIdx.x - 128) * NWAVES + F.wave; F2.NGW = 128 * NWAVES; LAS float* scr = (LAS float*)(F.lds + F.wave * 16384);
            tr_job_plain(F2, args.in[8], DM, DM, FF, ws + OW_D1, scr, 0);
            tr_job_mapped(F2, args, 2, NIN3, 0, DM, (h16*)(ws + OW_IN), nullptr, scr, 384);
            tr_job_mapped(F2, args, 3, 512, 2048, QL, (h16*)(ws + OW_4), args.in[12], scr, 896);
            tr_job_mapped(F2, args, 1, 2 * FF, 0, DM, ws + OW_GU2, nullptr, scr, 640);
            precomb_tiles(F, args, ws, 0, 192, (int)blockIdx.x - 128, 128);
            for (int i = ((int)blockIdx.x - 128) * NTHR + F.tid; i < (int)(MiB / 16); i += 128 * NTHR) ((u32x4*)(ws + OW_BD))[i] = (u32x4){0u, 0u, 0u, 0u}; } }
    SEAM(2);
    if (IN(3)) { pg8::Gemm g{Ab, (const h16*)(ws + OW_D1), MT, DM, FF / 2}; pg8::StaticOrder S; S.init(MT, DM, F.G, (int)blockIdx.x); pg8::EpiH16_T<true> E{(h16*)Fb};
        pg8::gemm_phase<pg8::EpiH16_T<true>, false, true>(F.lds, g, S, E, F.wave); }
    SEAM(3);
    if (IN(4)) ph_resnorm<false, true>(F, args.in[0], (const h16*)Fb, args.in[9], mod, 2, 0.5f, args.out, true, args.in[10], 4, 3, Hb, (unsigned char*)args.out + 32 * MiB);
    SEAM(4);
    if (IN(5)) { pg8::Gemm g{Hb, (const h16*)(ws + OW_IN), MT, NIN3, DM}; pg8::StaticOrder S; S.init(MT, NIN3, F.G, (int)blockIdx.x);
        pg8::EpiIn E{(h16*)(ws + OFF_CKV), (h16*)(ws + OFF_CQ), (h16*)(ws + OFF_KR), (h16*)(ws + OFF_KI), (h16*)(ws + OFF_QB), (h16*)(ws + OFF_KB), (h16*)(ws + OFF_VT), (float*)(ws + OFF_WI), (float*)(ws + OFF_SSQ),
                     args.in[13], tab, (LAS float*)(F.lds + XCH_OFF)};
        pg8::gemm_phase<pg8::EpiIn, true>(F.lds, g, S, E, F.wave); }
    SEAM(5);
    if (IN(6)) { for (int tk_ = blockIdx.x * NTHR + F.tid; tk_ < MT; tk_ += F.G * NTHR) { const f32x4 s0 = *(const f32x4*)((const float*)(ws + OFF_SSQ) + tk_ * 8), s1 = *(const f32x4*)((const float*)(ws + OFF_SSQ) + tk_ * 8 + 4);
            ((float*)(ws + OFF_RSTDQ))[tk_] = rsqrtf((((s0.x + s0.y) + (s0.z + s0.w)) + ((s1.x + s1.y) + (s1.z + s1.w))) * (1.f / QL) + EPS); } }
    if (IN(6)) ph_dilated_mfma(F, (const h16*)(ws + OFF_QB), (const h16*)(ws + OFF_KB), (const h16*)(ws + OFF_VT), (h16*)(ws + OFF_OG), (float*)(ws + OFF_LSE));
    SEAM(6);
    if (IN(7)) { pg8::Gemm g{(const h16*)(ws + OFF_CQ), (const h16*)(ws + OW_4), MT, N4, QL}; pg8::StaticOrder S; S.init(MT, N4, F.G, (int)blockIdx.x);
        pg8::Epi4 E{(h16*)(ws + OFF_QLAT), (h16*)(ws + OFF_QR), (h16*)(ws + OFF_QI), (const float*)(ws + OFF_RSTDQ), tab};
        pg8::gemm_phase<pg8::Epi4, true>(F.lds, g, S, E, F.wave);
        if (F.G == 256 && blockIdx.x >= 128) {
            Frame F2 = F; F2.gw = ((int)blockIdx.x - 128) * NWAVES + F.wave; F2.NGW = 128 * NWAVES; LAS float* scr = (LAS float*)(F.lds + F.wave * 16384);
            tr_job_plain(F2, args.in[11] + C_GATE, DIN, 2048, DM, ws + OW_GATE, scr, 0);
            tr_job_plain(F2, args.in[19], DM, DM, 256, (h16*)(ws + OW_UPB), scr, 512);
            tr_job_plain(F2, args.in[20], DM, DM, DM, (h16*)(ws + OW_O), scr, 640);
            tr_job_plain(F2, args.in[18], DM, DM, 512, (h16*)(ws + OW_UPA), scr, 256);
            for (int it = F2.gw; it < 4 * 16; it += F2.NGW) { const int kb = it >> 4, nb = it & 15, n0 = nb * 32, hl = (n0 >> 6) & 3;
                tr_item(args.in[16], 512, n0 + (F.lane & 31), true, nullptr, kb * 64, (h16*)(ws + OW_BD) + (size_t)n0 * 1024 + 256 * hl, 1024, scr, F.lane); } } }
    SEAM(7);
    if (IN(8)) { ph_combine(F, (const h16*)(ws + OFF_OG), (const float*)(ws + OFF_LSE), (h16*)(ws + OFF_OB));
        ph_topk_sparse(F, (const h16*)(ws + OFF_QI), (const h16*)(ws + OFF_KI), (const float*)(ws + OFF_WI), (unsigned short*)(ws + OFF_SEL),
                       (h16*)(ws + OFF_QLAT), (const h16*)(ws + OFF_QR), (const unsigned char*)(ws + OFF_CKV), (const unsigned char*)(ws + OFF_KR)); }
    SEAM(8);
    if (IN(9) && F.G == 256) { const bool first = blockIdx.x < 128;
        pg8::Gemm g{first ? (const h16*)(ws + OFF_QLAT) : (const h16*)(ws + OFF_OB), first ? (const h16*)(ws + OW_BD) : (const h16*)(ws + OW_UPB), MT, first ? 512 : DM, first ? 1024 : 256, first ? 2048 : 0, first ? 1024 : 0};
        pg8::StaticOrder S; S.init(MT, first ? 512 : DM, 128, first ? (int)blockIdx.x : (int)blockIdx.x - 128);
        pg8::EpiH16 E{first ? (h16*)(ws + OFF_OA) : (h16*)(ws + OFF_Y2), first ? 512 : DM};
        pg8::gemm_phase<pg8::EpiH16, false>(F.lds, g, S, E, F.wave); }
    SEAM(9);
    if (IN(10)) { pg8::StaticOrder S; S.init(MT, DM, F.G, (int)blockIdx.x); h16* Y1 = (h16*)(ws + OFF_Y1); h16* Y2 = (h16*)(ws + OFF_Y2);
        { pg8::Gemm g{(const h16*)(ws + OFF_OA), (const h16*)(ws + OW_UPA), MT, DM, 512}; pg8::EpiH16 E{Y1}; pg8::gemm_phase<pg8::EpiH16, false>(F.lds, g, S, E, F.wave); }
        const h16* u8 = (const h16*)((const unsigned char*)args.out + 32 * MiB);
        { pg8::Gemm g{u8, (const h16*)(ws + OW_GATE), MT, DM, DM / 2}; pg8::EpiGate E{Y1, Y1, 0, -LOG2E * F8_INV}; pg8::gemm_phase<pg8::EpiGate, false, true>(F.lds, g, S, E, F.wave); }
        { pg8::Gemm g{u8, (const h16*)(ws + OW_GATE + (size_t)DM * DM), MT, DM, DM / 2}; pg8::EpiGate E{Y2, Y1, 1, -LOG2E * F8_INV}; pg8::gemm_phase<pg8::EpiGate, false, true>(F.lds, g, S, E, F.wave); } }
    SEAM(10);
    if (IN(11)) { pg8::Gemm g{(const h16*)(ws + OFF_Y1), (const h16*)(ws + OW_O), MT, DM, DM}; pg8::StaticOrder S; S.init(MT, DM, F.G, (int)blockIdx.x); pg8::EpiH16 E{(h16*)(ws + OFF_YF)};
        pg8::gemm_phase<pg8::EpiH16, false>(F.lds, g, S, E, F.wave); }
    SEAM(11);
    if (IN(12)) ph_resnorm<true, true, unsigned char>(F, args.out, (const h16*)(ws + OFF_YF), args.in[21], mod, 5, 1.0f, ws + OFF_F, true, args.in[22], 7, 6, ws + OFF_H);
    SEAM(12);
    if (IN(13)) { pg8::Gemm g{Hb, (const h16*)(ws + OW_GU2), MT, 2 * FF, DM / 2}; pg8::StaticOrder S; S.init(MT, 2 * FF, F.G, (int)blockIdx.x); pg8::EpiSwiGLU_T<true> E{Ab};
        pg8::gemm_phase<pg8::EpiSwiGLU_T<true>, true, true>(F.lds, g, S, E, F.wave);
        if (F.G == 256 && blockIdx.x >= 128) { Frame F2 = F; F2.gw = ((int)blockIdx.x - 128) * NWAVES + F.wave; F2.NGW = 128 * NWAVES;
            tr_job_plain(F2, args.in[25], DM, DM, FF, ws + OW_D2, (LAS float*)(F.lds + F.wave * 16384), 0); } }
    SEAM(13);
    if (IN(14)) { pg8::Gemm g{Ab, (const h16*)(ws + OW_D2), MT, DM, FF / 2}; pg8::StaticOrder S; S.init(MT, DM, F.G, (int)blockIdx.x); pg8::EpiH16_T<true> E{(h16*)(ws + OFF_F + 32 * MiB)};
        pg8::gemm_phase<pg8::EpiH16_T<true>, false, true>(F.lds, g, S, E, F.wave); }
    SEAM(14);
    if (IN(15)) ph_resnorm<true, false>(F, ws + OFF_F, (const h16*)(ws + OFF_F + 32 * MiB), args.in[26], mod, 8, 0.5f, args.out, false, nullptr, 0, 0, (h16*)nullptr);
#undef IN
#undef SEAM
}


extern "C" void kernel_launch(void* const* d_in, const int* in_sizes, int n_in, void* d_out, int out_size, void* d_ws, size_t ws_size, hipStream_t stream) {
    if (n_in != 27 || ws_size < WS_END || out_size != MT * DM) { fprintf(stderr, "kernel_launch: unexpected shapes (n_in %d ws %zu out %d)\n", n_in, ws_size, out_size); return; }
    static int grid = 0;
    if (grid == 0) {
        int dev = 0, cus = 0, per_cu = 0;
        if (hipGetDevice(&dev) != hipSuccess || hipDeviceGetAttribute(&cus, hipDeviceAttributeMultiprocessorCount, dev) != hipSuccess) { grid = -1; return; }
        if (hipFuncSetAttribute((const void*)mega_fwd, hipFuncAttributeMaxDynamicSharedMemorySize, LDS_BYTES) != hipSuccess) { fprintf(stderr, "kernel_launch: hipFuncSetAttribute failed\n"); grid = -1; return; }
        if (hipOccupancyMaxActiveBlocksPerMultiprocessor(&per_cu, (const void*)mega_fwd, NTHR, LDS_BYTES) != hipSuccess || per_cu < 1) { fprintf(stderr, "kernel_launch: occupancy query says %d blocks/CU\n", per_cu); grid = -1; return; }
        grid = cus;
    }
    if (grid < 0) return;
    hipMemsetAsync((char*)d_ws + OFF_CTL, 0, 1 * MiB, stream);
    Args a{}; for (int i = 0; i < 27; ++i) a.in[i] = (const float*)d_in[i]; a.out = (float*)d_out; a.ws = (unsigned char*)d_ws; a.ph_lo = 0; a.ph_hi = 16;
    void* kargs[] = {&a};
#ifdef PH_DOUBLE
    a.ph_hi = PH_DOUBLE + 1; (void)hipLaunchCooperativeKernel((const void*)mega_fwd, dim3(grid), dim3(NTHR), kargs, LDS_BYTES, stream);
    hipMemsetAsync((char*)d_ws + OFF_CTL, 0, 1 * MiB, stream); a.ph_lo = PH_DOUBLE; a.ph_hi = 16;
#endif
    const hipError_t e = hipLaunchCooperativeKernel((const void*)mega_fwd, dim3(grid), dim3(NTHR), kargs, LDS_BYTES, stream);
    if (e != hipSuccess) fprintf(stderr, "kernel_launch: cooperative launch failed: %s (grid %d)\n", hipGetErrorString(e), grid);
    (void)in_sizes;
}
```

```cpp
#include <hip/hip_runtime.h>
#include <hip/hip_fp16.h>
#include <cstdio>
#include <cstdint>

constexpr int NB = 4, SEQ = 4096, DM = 1024, MT = NB * SEQ, FF = 2816;
constexpr int QL = 384, KVL = 256, DNOPE = 64, DROPE = 32, DVA = 64, HA = 8, HI = 8, DI = 32, TOPK = 256;
constexpr int NG = 3, HB = 4, DHB = 64, NMOD = 9, DIN = 5064;
constexpr int C_CQ = 0, C_CKV = 384, C_KR = 640, C_KI = 672, C_WI = 704, C_QKV = 712, C_GATE = 3016;
constexpr float EPS = 1e-6f, LOG2E = 1.4426950408889634f;
typedef _Float16 h16;

constexpr size_t MiB = 1u << 20;
constexpr size_t OFF_CTL = 0, OFF_MOD = 1 * MiB, OFF_ROPE = 2 * MiB, OFF_W = 8 * MiB, OFF_H = 60 * MiB, OFF_A = 92 * MiB, OFF_F = 180 * MiB, OFF_SP = 244 * MiB, WS_END = 256 * MiB;
constexpr size_t OFF_QB = OFF_A, OFF_KB = OFF_A + 24 * MiB, OFF_VT = OFF_A + 48 * MiB, OFF_CKV = OFF_A + 72 * MiB, OFF_KR = OFF_A + 80 * MiB, OFF_KI = OFF_A + 81 * MiB,
                 OFF_WI = OFF_A + 82 * MiB, OFF_SSQ = OFF_A + 82 * MiB + 512 * 1024, OFF_CQ = OFF_SP;
constexpr size_t OFF_RSTDQ = OFF_A + 83 * MiB;
constexpr size_t OFF_OG = OFF_F, OFF_LSE = OFF_F + 24 * MiB, OFF_QLAT = OFF_A, OFF_QR = OFF_A + 64 * MiB, OFF_QI = OFF_F + 25 * MiB, OFF_SEL = OFF_F + 33 * MiB, OFF_OB = OFF_SP;
constexpr size_t OFF_Y1 = OFF_F, OFF_Y2 = OFF_F + 32 * MiB, OFF_YF = OFF_A;

__device__ __forceinline__ float silu_f(float v) { return v / (1.f + __expf(-v)); }
__device__ __forceinline__ float sigm_f(float v) { return 1.f / (1.f + __expf(-v)); }
__host__ __device__ __forceinline__ int dil_of(int g) { return g == 0 ? 1 : (g == 1 ? 4 : 16); }
__device__ __forceinline__ unsigned fkey(float f) { const unsigned u = __float_as_uint(f); return (u & 0x80000000u) ? ~u : (u | 0x80000000u); }


#define LAS __attribute__((address_space(3)))
#define GAS __attribute__((address_space(1)))
typedef _Float16 f16x8 __attribute__((ext_vector_type(8)));
typedef float f32x4 __attribute__((ext_vector_type(4)));
typedef float f32x2 __attribute__((ext_vector_type(2)));
typedef unsigned u32x4 __attribute__((ext_vector_type(4)));
typedef unsigned u32x2 __attribute__((ext_vector_type(2)));
typedef _Float16 h16x2 __attribute__((ext_vector_type(2)));
__device__ __forceinline__ unsigned pk_h2(float lo, float hi) { f32x2 v = {lo, hi}; h16x2 h = __builtin_convertvector(v, h16x2); return __builtin_bit_cast(unsigned, h); }
__device__ __forceinline__ int flane() { int l; asm volatile("v_mbcnt_lo_u32_b32 %0, -1, 0\n\tv_mbcnt_hi_u32_b32 %0, -1, %0" : "=v"(l)); return l; }
__device__ __forceinline__ float sat8(float x) { return __builtin_amdgcn_fmed3f(x, -448.f, 448.f); }
__device__ __forceinline__ unsigned pk_f8x4(float a, float b, float c, float d) { int w = __builtin_amdgcn_cvt_pk_fp8_f32(sat8(a), sat8(b), 0, false); w = __builtin_amdgcn_cvt_pk_fp8_f32(sat8(c), sat8(d), w, true); return (unsigned)w; }
typedef int i32x4 __attribute__((ext_vector_type(4)));
typedef int i32x8 __attribute__((ext_vector_type(8)));
constexpr float F8_ACT = 8.f, F8_WGT = 512.f, F8_INV = 1.f / (F8_ACT * F8_WGT);

namespace pg8 {
constexpr int BM = 256, BK = 64, HALF = 128, HTB = HALF * BK * 2, STAGE_BYTES = 8 * HTB, NXCD = 8, WGM = 8;
__host__ __device__ __forceinline__ int lds_byte(int r, int c) { const int st = (r >> 4) * 2 + (c >> 5), rr = r & 15, cc = c & 31, ob = rr * 64 + cc * 2; return st * 1024 + (ob ^ (((ob >> 9) & 1) << 5)); }
__host__ __device__ __forceinline__ void stage_rc(int b, int& R, int& C) { const int st = b / 1024, sb = b % 1024, swz = sb ^ (((sb >> 9) & 1) << 5); R = (st >> 1) * 16 + swz / 64; C = (st & 1) * 32 + (swz % 64) / 2; }
__host__ __device__ __forceinline__ int perm32(int rho) { const int n = rho >> 4, i = rho & 15; return 8 * (i >> 2) + 4 * n + (i & 3); }
struct Unit { int pm, pn; };
struct Gemm { const h16* A; const h16* Bt; int M, N, K; int lda = 0, koffA = 0; };
struct StaticOrder {
    int nM, nN, nwg, G, c;
    __host__ __device__ void init(int M, int N, int G_, int c_) { nM = M / BM; nN = N / BM; nwg = nM * nN; G = G_; c = c_; }
    __host__ __device__ bool next(int i, Unit& u) const {
        const long L = (long)i * G + c; if (L >= nwg) return false;
        int wgid = (int)L; { const int q = nwg / NXCD, r = nwg % NXCD, xcd = wgid % NXCD, off = wgid / NXCD; wgid = (xcd < r ? xcd * (q + 1) : r * (q + 1) + (xcd - r) * q) + off; }
        const int nig = WGM * nN, gid = wgid / nig, fm = gid * WGM, gsz = (nM - fm) < WGM ? (nM - fm) : WGM;
        u.pm = fm + ((wgid % nig) % gsz); u.pn = (wgid % nig) / gsz; return true;
    }
};
template <class Epi, bool ALIGN_EPI, bool F8 = false>
__device__ __forceinline__ void gemm_phase(LAS unsigned char* lds, const Gemm g, const StaticOrder& S, const Epi& E, const int wid) {
    const int lane = flane(), tid = wid * 64 + lane, wr = wid >> 2, wc = wid & 3, fr = lane & 15, fq = lane >> 4;
    const int K = g.K, lda = g.lda ? g.lda : g.K; int nt = K / BK;
    if constexpr (F8) asm volatile("" : "+s"(nt));
    unsigned voffA[2], voffB[2];
#pragma unroll
    for (int i = 0; i < 2; ++i) { int R, C; stage_rc(tid * 16 + i * 8192, R, C); const int Rb = Epi::PERM ? ((R & ~31) + perm32(R & 31)) : R;
        voffA[i] = (unsigned)(R * lda + C) * 2u; voffB[i] = (unsigned)(Rb * K + C) * 2u; }
    const size_t kstep = (size_t)(BK * 2);
    const size_t hstep = (size_t)HALF * K * 2, hstepA = (size_t)HALF * lda * 2;
    const size_t tstep = 2 * hstep, tstepA = 2 * hstepA, kofA = (size_t)g.koffA * 2;
    const unsigned ldsw = (unsigned)wid * 1024u;
    const int aoff = lds_byte(wr * 64 + fr, fq * 8), boff = lds_byte(wc * 32 + fr, fq * 8);
#define PG8_SA(b, h) (((b) * 2 + (h)) * HTB)
#define PG8_SB(b, h) ((4 + (b) * 2 + (h)) * HTB)
#define PG8_STAGE(bufoff, gbase, voff) do { _Pragma("unroll") for (int _i = 0; _i < 2; ++_i) { unsigned _vo = (voff)[_i]; asm volatile("" : "+v"(_vo)); \
        __builtin_amdgcn_global_load_lds((const unsigned*)((const char*)(gbase) + _vo), (LAS unsigned*)(lds + (bufoff) + ldsw + _i * 8192), 16, 0, 0); } } while (0)
#define PG8_LDA(dst, b, h) do { _Pragma("unroll") for (int m = 0; m < 4; ++m) _Pragma("unroll") for (int k = 0; k < 2; ++k) dst[m][k] = *(const LAS f16x8*)(lds + PG8_SA(b, h) + aoff + m * 2048 + k * 1024); } while (0)
#define PG8_LDB(dst, b, h) do { _Pragma("unroll") for (int n = 0; n < 2; ++n) _Pragma("unroll") for (int k = 0; k < 2; ++k) dst[n][k] = *(const LAS f16x8*)(lds + PG8_SB(b, h) + boff + n * 2048 + k * 1024); } while (0)
#define PG8_CAT8(x, y) __builtin_shufflevector(__builtin_bit_cast(i32x4, x), __builtin_bit_cast(i32x4, y), 0, 1, 2, 3, 4, 5, 6, 7)
#define PG8_MMA(ai, bj, At, Bt) do { __builtin_amdgcn_s_setprio(1); \
        if constexpr (F8) { _Pragma("unroll") for (int m = 0; m < 4; ++m) _Pragma("unroll") for (int n = 0; n < 2; ++n) \
            acc[ai][bj][m][n] = __builtin_amdgcn_mfma_scale_f32_16x16x128_f8f6f4(PG8_CAT8(Bt[n][0], Bt[n][1]), PG8_CAT8(At[m][0], At[m][1]), acc[ai][bj][m][n], 0, 0, 0, 0, 0, 0); } \
        else { _Pragma("unroll") for (int m = 0; m < 4; ++m) _Pragma("unroll") for (int n = 0; n < 2; ++n) _Pragma("unroll") for (int k = 0; k < 2; ++k) \
            acc[ai][bj][m][n] = __builtin_amdgcn_mfma_f32_16x16x32_f16(Bt[n][k], At[m][k], acc[ai][bj][m][n], 0, 0, 0); } \
        __builtin_amdgcn_s_setprio(0); } while (0)
#define PG8_WAIT_V(n) asm volatile("s_waitcnt vmcnt(" #n ")" ::: "memory")
#define PG8_WAIT_L(n) asm volatile("s_waitcnt lgkmcnt(" #n ")" ::: "memory")
#define PG8_BAR __builtin_amdgcn_s_barrier()
#define PG8_SCHED __builtin_amdgcn_sched_barrier(0)
    Unit cur, nxt; int ui = 0;
    if (!S.next(0, cur)) return;
    f32x4 acc[2][2][4][2];
#pragma unroll
    for (int a = 0; a < 2; ++a)
#pragma unroll
        for (int b = 0; b < 2; ++b)
#pragma unroll
            for (int m = 0; m < 4; ++m)
#pragma unroll
                for (int n = 0; n < 2; ++n) acc[a][b][m][n] = (f32x4){0.f, 0.f, 0.f, 0.f};
    f16x8 At[4][2], B0[2][2], B1[2][2];
    const char* cA = (const char*)g.A + (size_t)cur.pm * tstepA + (size_t)cur.pn * kofA; const char* cB = (const char*)g.Bt + (size_t)cur.pn * tstep;
    PG8_STAGE(PG8_SB(0, 0), cB, voffB); PG8_STAGE(PG8_SB(0, 1), cB + hstep, voffB); PG8_STAGE(PG8_SA(0, 0), cA, voffA); PG8_STAGE(PG8_SA(0, 1), cA + hstepA, voffA);
    if (wr == 1) PG8_BAR;
    PG8_WAIT_V(2); PG8_BAR;
    PG8_STAGE(PG8_SB(1, 0), cB + kstep, voffB); PG8_STAGE(PG8_SA(1, 0), cA + kstep, voffA); PG8_STAGE(PG8_SB(1, 1), cB + hstep + kstep, voffB);
    PG8_WAIT_V(6); PG8_BAR;
    for (;;) {
        const bool has_next = S.next(ui + 1, nxt);
        const char* nA = has_next ? (const char*)g.A + (size_t)nxt.pm * tstepA + (size_t)nxt.pn * kofA : cA; const char* nB = has_next ? (const char*)g.Bt + (size_t)nxt.pn * tstep : cB;
        for (int t = 0; t < nt; t += 2) {
            const bool last = (t == nt - 2);
            const char* a1 = cA + (size_t)(t + 1) * kstep;
            const char* a2 = last ? nA : cA + (size_t)(t + 2) * kstep; const char* b2 = last ? nB : cB + (size_t)(t + 2) * kstep;
            const char* a3 = a2 + kstep; const char* b3 = b2 + kstep;
            PG8_LDB(B0, 0, 0); PG8_LDB(B1, 0, 1); PG8_SCHED; PG8_LDA(At, 0, 0); PG8_STAGE(PG8_SA(1, 1), a1 + hstepA, voffA);
            PG8_WAIT_V(8); PG8_WAIT_L(0); PG8_BAR; PG8_MMA(0, 0, At, B0); PG8_MMA(0, 1, At, B1); PG8_BAR; PG8_SCHED;
            PG8_LDA(At, 0, 1); PG8_STAGE(PG8_SB(0, 0), b2, voffB); PG8_STAGE(PG8_SB(0, 1), b2 + hstep, voffB); PG8_STAGE(PG8_SA(0, 0), a2, voffA);
            PG8_WAIT_V(8); PG8_WAIT_L(0); PG8_BAR; PG8_MMA(1, 0, At, B0); PG8_MMA(1, 1, At, B1); PG8_BAR; PG8_SCHED;
            PG8_LDB(B0, 1, 0); PG8_LDB(B1, 1, 1); PG8_SCHED; PG8_LDA(At, 1, 0); PG8_STAGE(PG8_SA(0, 1), a2 + hstepA, voffA);
            PG8_WAIT_V(8); PG8_WAIT_L(0); PG8_BAR; PG8_MMA(0, 0, At, B0); PG8_MMA(0, 1, At, B1); PG8_BAR; PG8_SCHED;
            PG8_LDA(At, 1, 1); PG8_STAGE(PG8_SB(1, 0), b3, voffB); PG8_STAGE(PG8_SB(1, 1), b3 + hstep, voffB); PG8_STAGE(PG8_SA(1, 0), a3, voffA);
            PG8_WAIT_V(8); PG8_WAIT_L(0); PG8_BAR; PG8_MMA(1, 0, At, B0); PG8_MMA(1, 1, At, B1); PG8_BAR; PG8_SCHED;
        }
        if constexpr (ALIGN_EPI) { if (wr == 0) PG8_BAR; }
        { const int l2 = flane(); E(acc, cur, wr, wc, l2 & 15, l2 >> 4); }
        if (!has_next) break;
#pragma unroll
        for (int a = 0; a < 2; ++a)
#pragma unroll
            for (int b = 0; b < 2; ++b)
#pragma unroll
                for (int m = 0; m < 4; ++m)
#pragma unroll
                    for (int n = 0; n < 2; ++n) acc[a][b][m][n] = (f32x4){0.f, 0.f, 0.f, 0.f};
        cur = nxt; cA = nA; cB = nB; ++ui;
        if constexpr (ALIGN_EPI) { if (wr == 1) PG8_BAR; }
    }
    PG8_WAIT_V(0);
    if constexpr (!ALIGN_EPI) { if (wr == 0) PG8_BAR; }
    PG8_BAR;
#undef PG8_SA
#undef PG8_SB
#undef PG8_STAGE
#undef PG8_LDA
#undef PG8_LDB
#undef PG8_MMA
#undef PG8_CAT8
#undef PG8_WAIT_V
#undef PG8_WAIT_L
#undef PG8_BAR
#undef PG8_SCHED
}
struct EpiF32 {
    static constexpr bool PERM = false;
    float* C; int ldc;
    __device__ __forceinline__ void operator()(const f32x4 (&acc)[2][2][4][2], const Unit& u, int wr, int wc, int fr, int fq) const {
        const int row0 = u.pm * BM + wr * 64 + fr, col0 = u.pn * BM + wc * 32 + 4 * fq;
#pragma unroll
        for (int ai = 0; ai < 2; ++ai)
#pragma unroll
            for (int m = 0; m < 4; ++m) { float* rowp = C + (size_t)(row0 + ai * HALF + m * 16) * ldc + col0;
#pragma unroll
                for (int bj = 0; bj < 2; ++bj)
#pragma unroll
                    for (int n = 0; n < 2; ++n) *(f32x4*)(rowp + bj * HALF + n * 16) = acc[ai][bj][m][n]; }
    }
};
template <bool F8>
struct EpiSwiGLU_T {
    static constexpr bool PERM = true;
    void* O;
    __device__ __forceinline__ void operator()(const f32x4 (&acc)[2][2][4][2], const Unit& u, int wr, int wc, int fr, int fq) const {
        const int row0 = u.pm * BM + wr * 64 + fr, col0 = u.pn * HALF + wc * 32 + 8 * fq;
#pragma unroll
        for (int ai = 0; ai < 2; ++ai)
#pragma unroll
            for (int m = 0; m < 4; ++m) { const size_t eo = (size_t)(row0 + ai * HALF + m * 16) * FF + col0;
                float v[8];
#pragma unroll
                for (int n = 0; n < 2; ++n)
#pragma unroll
                    for (int e = 0; e < 4; ++e) { float gg = acc[ai][0][m][n][e], uu = acc[ai][1][m][n][e]; if constexpr (F8) { gg *= F8_INV; uu *= F8_INV * F8_ACT; }
                        v[n * 4 + e] = gg * __builtin_amdgcn_rcpf(1.f + __builtin_amdgcn_exp2f(-gg * LOG2E)) * uu; }
                if constexpr (F8) { u32x2 w; w.x = pk_f8x4(v[0], v[1], v[2], v[3]); w.y = pk_f8x4(v[4], v[5], v[6], v[7]); *(u32x2*)((unsigned char*)O + eo) = w; }
                else { u32x4 w; w.x = pk_h2(v[0], v[1]); w.y = pk_h2(v[2], v[3]); w.z = pk_h2(v[4], v[5]); w.w = pk_h2(v[6], v[7]); *(u32x4*)((h16*)O + eo) = w; } }
    }
};
typedef EpiSwiGLU_T<false> EpiSwiGLU;

struct EpiIn {
    static constexpr bool PERM = false;
    h16 *ckv, *cq, *kr, *ki, *qb, *kb, *vT; float *wi, *ssq; const float* gckv; const float2* tab; LAS float* X;
    __device__ __forceinline__ void rope64(const f32x4 (&acc)[2][2][4][2], const Unit& u, int wr, int wc, int fr, int fq, h16* dst, int tl, float scale) const {
        const int tok0 = u.pm * BM + wr * 64 + fr;
        f32x4 tc[4], tn[4];
        { const f32x4* tp = (const f32x4*)(tab + (size_t)tok0 * 48 + 4 * fq); tc[0] = tp[0]; tc[1] = tp[1]; tc[2] = tp[8]; tc[3] = tp[9]; }
#pragma unroll
        for (int rr = 0; rr < 8; ++rr) { const int ai = rr >> 2, m = rr & 3, tok = tok0 + ai * HALF + m * 16;
            if (rr < 7) { const int tokn = tok0 + ((rr + 1) >> 2) * HALF + ((rr + 1) & 3) * 16; const f32x4* tp = (const f32x4*)(tab + (size_t)tokn * 48 + 4 * fq); tn[0] = tp[0]; tn[1] = tp[1]; tn[2] = tp[8]; tn[3] = tp[9]; }
#pragma unroll
            for (int n = 0; n < 2; ++n) { const int i = 16 * n + 4 * fq; const f32x4 t0 = tc[2 * n], t1 = tc[2 * n + 1];
                const f32x4 cs = {t0.x, t0.z, t1.x, t1.z}, sn = {t0.y, t0.w, t1.y, t1.w}, x1 = acc[ai][0][m][n], x2 = acc[ai][1][m][n];
                const f32x4 o1 = (x1 * cs - x2 * sn) * scale, o2 = (x2 * cs + x1 * sn) * scale;
                h16* p = dst + (size_t)tok * 768 + (4 * tl + wc) * 64 + i;
                u32x2 w1, w2; w1.x = pk_h2(o1.x, o1.y); w1.y = pk_h2(o1.z, o1.w); w2.x = pk_h2(o2.x, o2.y); w2.y = pk_h2(o2.z, o2.w);
                *(u32x2*)p = w1; *(u32x2*)(p + 32) = w2; }
#pragma unroll
            for (int k = 0; k < 4; ++k) tc[k] = tn[k];
            asm volatile("" ::: "memory"); }
    }
    __device__ __forceinline__ void operator()(const f32x4 (&acc)[2][2][4][2], const Unit& u, int wr, int wc, int fr, int fq) const {
        const int pn = u.pn;
        if (pn == 0) {
#pragma unroll
            for (int ai = 0; ai < 2; ++ai)
#pragma unroll
                for (int m = 0; m < 4; ++m) { float sq = 0.f;
#pragma unroll
                    for (int bj = 0; bj < 2; ++bj)
#pragma unroll
                        for (int n = 0; n < 2; ++n) { const f32x4 v = acc[ai][bj][m][n]; sq += (v.x * v.x + v.y * v.y) + (v.z * v.z + v.w * v.w); }
                    sq += __shfl_xor(sq, 16); sq += __shfl_xor(sq, 32);
                    if (fq == 0) X[(ai * HALF + wr * 64 + m * 16 + fr) * 4 + wc] = sq; }
            asm volatile("s_waitcnt lgkmcnt(0)" ::: "memory"); __builtin_amdgcn_s_barrier(); asm volatile("" ::: "memory");
#pragma unroll
            for (int ai = 0; ai < 2; ++ai)
#pragma unroll
                for (int m = 0; m < 4; ++m) { const int rl = ai * HALF + wr * 64 + m * 16 + fr, tok = u.pm * BM + rl; const f32x4 p = *(const LAS f32x4*)(X + rl * 4);
                    const float rstd = rsqrtf(((p.x + p.y) + (p.z + p.w)) * (1.f / KVL) + EPS);
#pragma unroll
                    for (int bj = 0; bj < 2; ++bj)
#pragma unroll
                        for (int n = 0; n < 2; ++n) { const int col = bj * HALF + wc * 32 + n * 16 + 4 * fq; const f32x4 o = acc[ai][bj][m][n] * rstd * *(const f32x4*)(gckv + col);
                            int w8 = __builtin_amdgcn_cvt_pk_fp8_f32(o.x, o.y, 0, false); w8 = __builtin_amdgcn_cvt_pk_fp8_f32(o.z, o.w, w8, true);
                            *(int*)((unsigned char*)ckv + (size_t)tok * KVL + col) = w8; }
                    asm volatile("" ::: "memory"); }
            asm volatile("s_waitcnt lgkmcnt(0)" ::: "memory"); __builtin_amdgcn_s_barrier(); asm volatile("" ::: "memory");
        } else if (pn <= 2) {
#pragma unroll
            for (int ai = 0; ai < 2; ++ai)
#pragma unroll
                for (int m = 0; m < 4; ++m) { const int tok = u.pm * BM + ai * HALF + wr * 64 + m * 16 + fr; float sq = 0.f;
#pragma unroll
                    for (int bj = 0; bj < 2; ++bj) { if (pn == 2 && bj == 1) break;
#pragma unroll
                        for (int n = 0; n < 2; ++n) { const f32x4 v = acc[ai][bj][m][n]; sq += (v.x * v.x + v.y * v.y) + (v.z * v.z + v.w * v.w);
                            const int col = (pn - 1) * 256 + bj * HALF + wc * 32 + n * 16 + 4 * fq; u32x2 w; w.x = pk_h2(v.x, v.y); w.y = pk_h2(v.z, v.w); *(u32x2*)(cq + (size_t)tok * QL + col) = w; } }
                    sq += __shfl_xor(sq, 16); sq += __shfl_xor(sq, 32);
                    if (fq == 0) ssq[tok * 8 + (pn - 1) * 4 + wc] = sq;
                    if (pn == 2) {
                        if (wc < 2) { const int i = 4 * fq; const f32x4* tp = (const f32x4*)(tab + (size_t)tok * 48 + 32 + i); const f32x4 t0 = tp[0], t1 = tp[1];
                            const f32x4 cs = {t0.x, t0.z, t1.x, t1.z}, sn = {t0.y, t0.w, t1.y, t1.w}, x1 = acc[ai][1][m][0], x2 = acc[ai][1][m][1];
                            const f32x4 o1 = x1 * cs - x2 * sn, o2 = x2 * cs + x1 * sn;
                            if (wc == 0) { unsigned char* p8 = (unsigned char*)kr + (size_t)tok * 32 + i;
                                int a8 = __builtin_amdgcn_cvt_pk_fp8_f32(o1.x, o1.y, 0, false); a8 = __builtin_amdgcn_cvt_pk_fp8_f32(o1.z, o1.w, a8, true);
                                int b8 = __builtin_amdgcn_cvt_pk_fp8_f32(o2.x, o2.y, 0, false); b8 = __builtin_amdgcn_cvt_pk_fp8_f32(o2.z, o2.w, b8, true);
                                *(int*)p8 = a8; *(int*)(p8 + 16) = b8; }
                            else { h16* p = ki + (size_t)tok * 32 + i;
                                u32x2 w1, w2; w1.x = pk_h2(o1.x, o1.y); w1.y = pk_h2(o1.z, o1.w); w2.x = pk_h2(o2.x, o2.y); w2.y = pk_h2(o2.z, o2.w);
                                *(u32x2*)p = w1; *(u32x2*)(p + 16) = w2; } }
                        else if (wc == 2 && fq < 2) { *(f32x4*)(wi + tok * 8 + 4 * fq) = acc[ai][1][m][0] * 0.35355339059327373f; }
                    }
                    asm volatile("" ::: "memory"); }
        } else if (pn <= 5) rope64(acc, u, wr, wc, fr, fq, qb, pn - 3, 0.125f * LOG2E);
        else if (pn <= 8) rope64(acc, u, wr, wc, fr, fq, kb, pn - 6, 1.0f);
        else {
#pragma unroll
            for (int ai = 0; ai < 2; ++ai)
#pragma unroll
                for (int m = 0; m < 4; ++m) { const int tok = u.pm * BM + ai * HALF + wr * 64 + m * 16 + fr;
#pragma unroll
                    for (int bj = 0; bj < 2; ++bj)
#pragma unroll
                        for (int n = 0; n < 2; ++n) { const f32x4 v = acc[ai][bj][m][n]; u32x2 w; w.x = pk_h2(v.x, v.y); w.y = pk_h2(v.z, v.w);
                            *(u32x2*)(vT + (size_t)tok * 768 + (pn - 9) * 256 + bj * HALF + wc * 32 + n * 16 + 4 * fq) = w; }
                    asm volatile("" ::: "memory"); }
        }
    }
};
struct Epi4 {
    static constexpr bool PERM = true;
    h16 *qlat, *qr, *qi; const float* rstdq; const float2* tab;
    __device__ __forceinline__ void operator()(const f32x4 (&acc)[2][2][4][2], const Unit& u, int wr, int wc, int fr, int fq) const {
        const int pn = u.pn; const float c2 = 0.10206207261596575f * LOG2E;
        const int tok0 = u.pm * BM + wr * 64 + fr;
        float rc = rstdq[tok0], rn = 0.f;
        if (pn < 8) {
#pragma unroll
            for (int rr = 0; rr < 8; ++rr) { const int ai = rr >> 2, m = rr & 3, tok = tok0 + ai * HALF + m * 16;
                if (rr < 7) rn = rstdq[tok0 + ((rr + 1) >> 2) * HALF + ((rr + 1) & 3) * 16];
#pragma unroll
                for (int bj = 0; bj < 2; ++bj) { const f32x4 o0 = acc[ai][bj][m][0] * (rc * c2), o1 = acc[ai][bj][m][1] * (rc * c2);
                    u32x4 w; w.x = pk_h2(o0.x, o0.y); w.y = pk_h2(o0.z, o0.w); w.z = pk_h2(o1.x, o1.y); w.w = pk_h2(o1.z, o1.w);
                    *(u32x4*)(qlat + (size_t)tok * 2048 + pn * 256 + bj * HALF + wc * 32 + 8 * fq) = w; }
                rc = rn; asm volatile("" ::: "memory"); }
        } else { h16* dst = (pn == 8) ? qr : qi; const float c2e = (pn == 8) ? c2 : 1.f; const int i = 4 * fq;
            f32x4 tc[2], tn[2];
            { const f32x4* tp = (const f32x4*)(tab + (size_t)tok0 * 48 + 32 + i); tc[0] = tp[0]; tc[1] = tp[1]; }
#pragma unroll
            for (int rr = 0; rr < 8; ++rr) { const int ai = rr >> 2, m = rr & 3, tok = tok0 + ai * HALF + m * 16;
                if (rr < 7) { const int tokn = tok0 + ((rr + 1) >> 2) * HALF + ((rr + 1) & 3) * 16; const f32x4* tp = (const f32x4*)(tab + (size_t)tokn * 48 + 32 + i); tn[0] = tp[0]; tn[1] = tp[1]; rn = rstdq[tokn]; }
                const f32x4 cs = {tc[0].x, tc[0].z, tc[1].x, tc[1].z}, sn = {tc[0].y, tc[0].w, tc[1].y, tc[1].w}; const float sc = rc * c2e;
#pragma unroll
                for (int bj = 0; bj < 2; ++bj) { const f32x4 x1 = acc[ai][bj][m][0], x2 = acc[ai][bj][m][1]; const f32x4 o1 = (x1 * cs - x2 * sn) * sc, o2 = (x2 * cs + x1 * sn) * sc;
                    h16* p = dst + (size_t)tok * 256 + (4 * bj + wc) * 32 + i;
                    u32x2 w1, w2; w1.x = pk_h2(o1.x, o1.y); w1.y = pk_h2(o1.z, o1.w); w2.x = pk_h2(o2.x, o2.y); w2.y = pk_h2(o2.z, o2.w);
                    *(u32x2*)p = w1; *(u32x2*)(p + 16) = w2; }
                tc[0] = tn[0]; tc[1] = tn[1]; rc = rn;
                asm volatile("" ::: "memory"); } }
    }
};
__device__ __forceinline__ u32x4 ld16_l2(const h16* p) {
    const unsigned long long a = __hip_atomic_load((const unsigned long long*)p, __ATOMIC_RELAXED, __HIP_MEMORY_SCOPE_AGENT), b = __hip_atomic_load((const unsigned long long*)p + 1, __ATOMIC_RELAXED, __HIP_MEMORY_SCOPE_AGENT);
    return (u32x4){(unsigned)a, (unsigned)(a >> 32), (unsigned)b, (unsigned)(b >> 32)};
}
typedef _Float16 h16x8 __attribute__((ext_vector_type(8)));
__device__ __forceinline__ void unpk8(const u32x4 w, float (&f)[8]) {
    const h16x8 h = __builtin_bit_cast(h16x8, w);
#pragma unroll
    for (int i = 0; i < 8; ++i) f[i] = (float)h[i];
}
template <bool SC>
struct EpiH16_T {
    static constexpr bool PERM = true;
    h16* O; int ldc = DM;
    __device__ __forceinline__ void operator()(const f32x4 (&acc)[2][2][4][2], const Unit& u, int wr, int wc, int fr, int fq) const {
        const int row0 = u.pm * BM + wr * 64 + fr, col0 = u.pn * BM + wc * 32 + 8 * fq;
#pragma unroll
        for (int ai = 0; ai < 2; ++ai)
#pragma unroll
            for (int m = 0; m < 4; ++m)
#pragma unroll
                for (int bj = 0; bj < 2; ++bj) { f32x4 v0 = acc[ai][bj][m][0], v1 = acc[ai][bj][m][1]; if constexpr (SC) { v0 *= F8_INV; v1 *= F8_INV; }
                    u32x4 w; w.x = pk_h2(v0.x, v0.y); w.y = pk_h2(v0.z, v0.w); w.z = pk_h2(v1.x, v1.y); w.w = pk_h2(v1.z, v1.w);
                    *(u32x4*)(O + (size_t)(row0 + ai * HALF + m * 16) * ldc + col0 + bj * HALF) = w; }
    }
};
typedef EpiH16_T<false> EpiH16;
struct EpiGate {
    static constexpr bool PERM = true;
    const h16* Y; h16* Z; int accum; float nls;
    __device__ __forceinline__ void operator()(const f32x4 (&acc)[2][2][4][2], const Unit& u, int wr, int wc, int fr, int fq) const {
        const int row0 = u.pm * BM + wr * 64 + fr, col0 = u.pn * BM + wc * 32 + 8 * fq;
#pragma unroll
        for (int ai = 0; ai < 2; ++ai)
#pragma unroll
            for (int m = 0; m < 4; ++m)
#pragma unroll
                for (int bj = 0; bj < 2; ++bj) { const size_t off = (size_t)(row0 + ai * HALF + m * 16) * DM + col0 + bj * HALF;
                    float y[8], zz[8]; unpk8(ld16_l2(Y + off), y);
                    if (accum) unpk8(ld16_l2(Z + off), zz); else {
#pragma unroll
                        for (int i = 0; i < 8; ++i) zz[i] = 0.f; }
                    float o[8];
#pragma unroll
                    for (int n = 0; n < 2; ++n)
#pragma unroll
                        for (int e = 0; e < 4; ++e) { const float gg = acc[ai][bj][m][n][e]; o[n * 4 + e] = zz[n * 4 + e] + y[n * 4 + e] * __builtin_amdgcn_rcpf(1.f + __builtin_amdgcn_exp2f(gg * nls)); }
                    u32x4 w; w.x = pk_h2(o[0], o[1]); w.y = pk_h2(o[2], o[3]); w.z = pk_h2(o[4], o[5]); w.w = pk_h2(o[6], o[7]);
                    *(u32x4*)(Z + off) = w; }
    }
};
}

#define XB_TMO      128
#define XB_XCNT(j)  (256  + 64 * (j))
#define XB_XSUB(j)  (1280 + 64 * (j))
#define XB_XGEN(j)  (2304 + 64 * (j))
#define XB_TOP      3328
#define XB_TOPGEN   3392
#define XCD_BAR_WORDS 3456
#define XB_SPIN_CAP (1u << 18)
__device__ __forceinline__ unsigned xb_ld(unsigned* p)              { return __hip_atomic_load(p, __ATOMIC_RELAXED, __HIP_MEMORY_SCOPE_AGENT); }
__device__ __forceinline__ unsigned xb_add(unsigned* p, unsigned v) { return __hip_atomic_fetch_add(p, v, __ATOMIC_RELAXED, __HIP_MEMORY_SCOPE_AGENT); }
__device__ __forceinline__ unsigned xb_xcc_id() { return (unsigned)__builtin_amdgcn_s_getreg((3 << 11) | 20) & 0xFu; }
#define XB_SPIN(cond, bar) do { unsigned _sp = 0; while (cond) { __builtin_amdgcn_s_sleep(1); \
    if ((++_sp & 255u) == 0u) { if (xb_ld(&(bar)[XB_TMO])) break; if (_sp > XB_SPIN_CAP) { atomicAdd(&(bar)[XB_TMO], 1u); break; } } } } while (0)
struct XcdBarrier { unsigned* bar; unsigned x; volatile LAS unsigned* st; int wave; };
__device__ __forceinline__ XcdBarrier xcd_barrier_post(unsigned* bar, volatile LAS unsigned* st, int wave) {
    XcdBarrier b; b.bar = bar; b.x = xb_xcc_id(); b.st = st; b.wave = wave;
    if (wave == 0 && flane() == 0) (void)xb_add(&bar[XB_XCNT(b.x)], 1u);
    return b;
}
__device__ __forceinline__ void xcd_barrier_complete(unsigned* bar, unsigned x, unsigned& nloc, unsigned& nx) {
    const unsigned G = gridDim.x * gridDim.y * gridDim.z;
    unsigned sum, cnt, mine, sp = 0u;
    for (;;) {
        sum = 0u; cnt = 0u; mine = 0u;
#pragma unroll
        for (unsigned j = 0; j < 16; ++j) { const unsigned c = xb_ld(&bar[XB_XCNT(j)]); sum += c; cnt += (c > 0u) ? 1u : 0u; mine = (j == x) ? c : mine; }
        if (sum == G) break;
        __builtin_amdgcn_s_sleep(1);
        if ((++sp & 255u) == 0u) { if (xb_ld(&bar[XB_TMO])) break; if (sp > XB_SPIN_CAP) { atomicAdd(&bar[XB_TMO], 1u); break; } }
    }
    nloc = mine > 0u ? mine : 1u; nx = cnt > 0u ? cnt : 1u;
}
__device__ __forceinline__ void xcd_barrier(const XcdBarrier& b) {
    asm volatile("s_waitcnt vmcnt(0)" ::: "memory");
    __syncthreads();
    if (b.wave == 0 && flane() == 0) {
        unsigned* bar = b.bar;
        __builtin_amdgcn_s_waitcnt(0);
        unsigned nloc = b.st[0], nx = b.st[1];
        if (nloc == 0u) { xcd_barrier_complete(bar, b.x, nloc, nx); b.st[0] = nloc; b.st[1] = nx; }
        const unsigned old = xb_add(&bar[XB_XSUB(b.x)], 1u);
        const unsigned gen = old / nloc;
        if (old + 1u == (gen + 1u) * nloc) {
            __builtin_amdgcn_fence(__ATOMIC_RELEASE, "agent");
            asm volatile("s_waitcnt vmcnt(0)" ::: "memory");
            const unsigned og = xb_add(&bar[XB_TOP], 1u);
            const unsigned tg = og / nx;
            if (og + 1u == (tg + 1u) * nx) xb_add(&bar[XB_TOPGEN], 1u);
            else XB_SPIN(xb_ld(&bar[XB_TOPGEN]) == tg, bar);
            __builtin_amdgcn_fence(__ATOMIC_ACQUIRE, "agent");
            xb_add(&bar[XB_XGEN(b.x)], 1u);
            asm volatile("s_waitcnt vmcnt(0)" ::: "memory");
        } else {
            XB_SPIN(xb_ld(&bar[XB_XGEN(b.x)]) == gen, bar);
            __builtin_amdgcn_fence(__ATOMIC_ACQUIRE, "agent");
            asm volatile("s_waitcnt vmcnt(0)" ::: "memory");
        }
    }
    __syncthreads();
}

constexpr int NWAVES = 8, NTHR = 512;
constexpr int RING_BYTES = 131072, LDSCTL_OFF = RING_BYTES, MISC_OFF = LDSCTL_OFF + 320, LDS_BYTES = 147456;
constexpr int XCH_OFF = RING_BYTES + 1024;
constexpr int CW_BAR = 4096;
constexpr size_t OW_GU1 = OFF_W, OW_D1 = OW_GU1 + 11 * MiB, OW_IN = OW_D1 + (size_t)DM * FF * 2, OW_GATE = OW_IN + 6 * MiB, OW_4 = OW_GATE + 4 * MiB, OW_OV = OW_4 + 2 * MiB,
                 OW_UPB = OW_OV + 4 * MiB, OW_O = OW_UPB + MiB / 2, OW_GU2 = OW_O + 2 * MiB, OW_D2 = OW_GU2 + 11 * MiB, OW_END = OW_D2 + (size_t)DM * FF * 2;
static_assert(OW_END <= OFF_H, "weights region");
constexpr int NIN3 = 3072, N4 = 2560;
constexpr size_t OW_BD = OW_OV, OW_UPA = OW_OV + MiB, OFF_OA = OFF_A + 64 * MiB;

struct Args { const float* in[27]; float* out; unsigned char* ws; int ph_lo, ph_hi; };
struct Frame {
    LAS unsigned char* lds; int tid, lane, wave, G, gw, NGW;
};
__device__ __forceinline__ float wave_sum(float v) {
#pragma unroll
    for (int o = 1; o < 64; o <<= 1) v += __shfl_xor(v, o);
    return v;
}
__device__ __forceinline__ bool map_row(int job, int n, const Args& a, const float*& W, int& ldw, int& col) {
    if (job <= 1) { const int t = n >> 8, j = n & 255; W = a.in[(job == 0 ? 6 : 23) + (j >> 7)]; ldw = FF; col = t * 128 + (j & 127); return true; }
    if (job == 2) { W = a.in[11]; ldw = DIN; const int t = n >> 8, j = n & 255;
        if (t == 0) { col = C_CKV + j; return true; }
        if (t == 1) { col = j; return true; }
        if (t == 2) { if (j < 128) { col = 256 + j; return true; } if (j < 160) { col = C_KR + (j - 128); return true; } if (j < 192) { col = C_KI + (j - 160); return true; } if (j < 200) { col = C_WI + (j - 192); return true; } col = 0; return false; }
        if (t < 9) { const int c3 = (t - 3) / 3, tl = (t - 3) % 3, hl = (j & 127) >> 5, i = j & 31; col = C_QKV + c3 * 768 + (4 * tl + hl) * 64 + (j >> 7) * 32 + i; return true; }
        col = C_QKV + 1536 + (t - 9) * 256 + j; return true; }
    { const int n2 = n - 2048, r5 = n2 & 31, nat = 16 * ((r5 >> 2) & 1) + 4 * (r5 >> 3) + (r5 & 3);
      if (n2 < 256) { W = a.in[14]; ldw = 768; col = (n2 >> 5) * 96 + 64 + nat; } else { W = a.in[17]; ldw = 256; col = ((n2 - 256) & ~31) + nat; } return true; }
}
template <typename T>
__device__ __forceinline__ void tr_item(const float* W, int ldw, int col, bool valid, const float* scale, int k0, T* WTrow0, int K, LAS float* scr, int lane) {
    const int colc = valid ? col : 0; float vv[32];
#pragma unroll
    for (int i = 0; i < 32; ++i) vv[i] = W[(size_t)(k0 + 2 * i + (lane >> 5)) * ldw + colc];
    if (scale) {
#pragma unroll
        for (int i = 0; i < 32; ++i) vv[i] *= scale[k0 + 2 * i + (lane >> 5)]; }
#pragma unroll
    for (int i = 0; i < 32; ++i) scr[(2 * i + (lane >> 5)) * 33 + (lane & 31)] = valid ? vv[i] : 0.f;
    asm volatile("s_waitcnt lgkmcnt(0)" ::: "memory");
    const int c = lane & 7;
#pragma unroll
    for (int j = 0; j < 4; ++j) { const int n = (lane >> 3) + 8 * j; const LAS float* s = scr + (8 * c) * 33 + n;
        if constexpr (sizeof(T) == 1) { u32x2 o; o.x = pk_f8x4(s[0 * 33] * F8_WGT, s[1 * 33] * F8_WGT, s[2 * 33] * F8_WGT, s[3 * 33] * F8_WGT); o.y = pk_f8x4(s[4 * 33] * F8_WGT, s[5 * 33] * F8_WGT, s[6 * 33] * F8_WGT, s[7 * 33] * F8_WGT);
            *(u32x2*)(WTrow0 + (size_t)n * K + k0 + 8 * c) = o; }
        else { u32x4 o; o.x = pk_h2(s[0 * 33], s[1 * 33]); o.y = pk_h2(s[2 * 33], s[3 * 33]); o.z = pk_h2(s[4 * 33], s[5 * 33]); o.w = pk_h2(s[6 * 33], s[7 * 33]);
            *(u32x4*)(WTrow0 + (size_t)n * K + k0 + 8 * c) = o; } }
    asm volatile("s_waitcnt lgkmcnt(0)" ::: "memory");
}
template <typename T>
__device__ __forceinline__ void tr_job_mapped(const Frame& F, const Args& a, int job, int Ndest, int n_lo, int K, T* WT, const float* scale, LAS float* scr, int phase_off) {
    const int nblk = Ndest / 32, nitems = (K / 64) * nblk;
    for (int it = (F.gw + phase_off) % F.NGW; it < nitems; it += F.NGW) {
        const int kb = it / nblk, nb = it % nblk; const float* W; int ldw, col;
        const bool valid = map_row(job, n_lo + nb * 32 + (F.lane & 31), a, W, ldw, col);
        tr_item(W, ldw, col, valid, scale, kb * 64, WT + (size_t)(n_lo + nb * 32) * K, K, scr, F.lane);
    }
}
template <typename T>
__device__ __forceinline__ void tr_job_plain(const Frame& F, const float* W, int ldw, int Ndest, int K, T* WT, LAS float* scr, int phase_off) {
    const int nblk = Ndest / 32, nitems = (K / 64) * nblk;
    for (int it = (F.gw + phase_off) % F.NGW; it < nitems; it += F.NGW) {
        const int kb = it / nblk, nb = it % nblk;
        tr_item(W, ldw, nb * 32 + (F.lane & 31), true, nullptr, kb * 64, WT + (size_t)(nb * 32) * K, K, scr, F.lane);
    }
}
__device__ __forceinline__ void row_load(const float* p, int lane, f32x4 (&v)[4]) {
#pragma unroll
    for (int j = 0; j < 4; ++j) v[j] = __builtin_nontemporal_load((const f32x4*)p + lane + 64 * j);
}
__device__ __forceinline__ float row_ssq(const f32x4 (&v)[4]) { float s = 0.f;
#pragma unroll
    for (int j = 0; j < 4; ++j) s += (v[j].x * v[j].x + v[j].y * v[j].y) + (v[j].z * v[j].z + v[j].w * v[j].w);
    return wave_sum(s); }
template <typename T>
__device__ __forceinline__ void row_normmod_store(const f32x4 (&v)[4], float rstd, const float* g, const float* sc, const float* sh, T* dst, int lane, unsigned char* dst8 = nullptr) {
#pragma unroll
    for (int j = 0; j < 4; ++j) { const int ci = lane + 64 * j; const f32x4 gg = ((const f32x4*)g)[ci], s1 = ((const f32x4*)sc)[ci], s0 = ((const f32x4*)sh)[ci];
        const f32x4 o = v[j] * rstd * gg * (s1 + 1.f) + s0;
        if constexpr (sizeof(T) == 1) ((unsigned*)dst)[ci] = pk_f8x4(o.x * F8_ACT, o.y * F8_ACT, o.z * F8_ACT, o.w * F8_ACT);
        else { u32x2 w; w.x = pk_h2(o.x, o.y); w.y = pk_h2(o.z, o.w); ((u32x2*)dst)[ci] = w; if (dst8) ((unsigned*)dst8)[ci] = pk_f8x4(o.x * F8_ACT, o.y * F8_ACT, o.z * F8_ACT, o.w * F8_ACT); } }
}
template <typename T>
__device__ __forceinline__ void store_nm(const f32x4 (&xv)[4], float r2, const f32x4 (&gb)[4], const f32x4 (&gc)[4], T* dst, int lane, unsigned char* dst8) {
#pragma unroll
    for (int j = 0; j < 4; ++j) { const int ci = lane + 64 * j; const f32x4 o = xv[j] * r2 * gb[j] + gc[j];
        if constexpr (sizeof(T) == 1) __builtin_nontemporal_store(pk_f8x4(o.x * F8_ACT, o.y * F8_ACT, o.z * F8_ACT, o.w * F8_ACT), (unsigned*)dst + ci);
        else { u32x2 w; w.x = pk_h2(o.x, o.y); w.y = pk_h2(o.z, o.w); __builtin_nontemporal_store(w, (u32x2*)dst + ci); if (dst8) __builtin_nontemporal_store(pk_f8x4(o.x * F8_ACT, o.y * F8_ACT, o.z * F8_ACT, o.w * F8_ACT), (unsigned*)dst8 + ci); } }
}
template <typename T>
__device__ __forceinline__ void ph_normmod(const Frame& F, const float* x, const float* g, const float* mod, int isc, int ish, T* dst) {
    const int lane = flane();
    const int b = F.gw & 3, nsl = F.NGW >> 2; int r0 = F.gw >> 2; if (r0 >= SEQ) return;
    const float* mb = mod + b * (NMOD * DM); f32x4 gb[4], gc[4];
#pragma unroll
    for (int j = 0; j < 4; ++j) { const int ci = lane + 64 * j; gb[j] = ((const f32x4*)g)[ci] * (((const f32x4*)(mb + isc * DM))[ci] + 1.f); gc[j] = ((const f32x4*)(mb + ish * DM))[ci]; }
    const float* xb = x + (size_t)b * SEQ * DM; T* db = dst + (size_t)b * SEQ * DM;
    f32x4 v[2][4], vn[2][4];
#pragma unroll
    for (int k = 0; k < 2; ++k) { const int r = r0 + k * nsl; row_load(xb + (size_t)(r < SEQ ? r : r0) * DM, lane, v[k]); }
    for (;;) { const int rn = r0 + 2 * nsl; const bool has = rn < SEQ;
        if (has) {
#pragma unroll
            for (int k = 0; k < 2; ++k) { const int r = rn + k * nsl; row_load(xb + (size_t)(r < SEQ ? r : rn) * DM, lane, vn[k]); } }
#pragma unroll
        for (int k = 0; k < 2; ++k) { const int r = r0 + k * nsl; const float rstd = rsqrtf(row_ssq(v[k]) * (1.f / DM) + EPS);
            if (r < SEQ) store_nm(v[k], rstd, gb, gc, db + (size_t)r * DM, lane, nullptr); }
        if (!has) break;
#pragma unroll
        for (int k = 0; k < 2; ++k)
#pragma unroll
            for (int j = 0; j < 4; ++j) v[k][j] = vn[k][j];
        r0 = rn; }
}
__device__ __forceinline__ void row_load_h(const h16* p, int lane, u32x2 (&v)[4]) {
#pragma unroll
    for (int j = 0; j < 4; ++j) v[j] = __builtin_nontemporal_load((const u32x2*)p + lane + 64 * j);
}
typedef _Float16 h16x4 __attribute__((ext_vector_type(4)));
__device__ __forceinline__ f32x4 h4_to_f4(u32x2 w) { const h16x4 h = __builtin_bit_cast(h16x4, w); return (f32x4){(float)h[0], (float)h[1], (float)h[2], (float)h[3]}; }
template <bool XI16, bool XO16, typename T = h16>
__device__ __forceinline__ void ph_resnorm(const Frame& F, const void* xin_, const h16* f, const float* gpost, const float* mod, int igt, float coef, void* xout_,
                                           bool second, const float* gpre, int isc, int ish, T* dst, unsigned char* dst8 = nullptr) {
    const int lane = flane();
    const int b = F.gw & 3, nsl = F.NGW >> 2; int r0 = F.gw >> 2; if (r0 >= SEQ) return;
    const float* mb = mod + b * (NMOD * DM); f32x4 ga[4], gb[4], gc[4];
#pragma unroll
    for (int j = 0; j < 4; ++j) { const int ci = lane + 64 * j; ga[j] = ((const f32x4*)gpost)[ci] * ((const f32x4*)(mb + igt * DM))[ci] * coef;
        if (second) { gb[j] = ((const f32x4*)gpre)[ci] * (((const f32x4*)(mb + isc * DM))[ci] + 1.f); gc[j] = ((const f32x4*)(mb + ish * DM))[ci]; } else { gb[j] = (f32x4){0.f, 0.f, 0.f, 0.f}; gc[j] = gb[j]; } }
    const size_t bo = (size_t)b * SEQ * DM; const h16* fb = f + bo;
    u32x2 fh[2][4], fn[2][4]; f32x4 xi[2][4], xn[2][4]; u32x2 xh[2][4], xhn[2][4];
#pragma unroll
    for (int k = 0; k < 2; ++k) { const int r = r0 + k * nsl; const size_t ro = (size_t)(r < SEQ ? r : r0) * DM; row_load_h(fb + ro, lane, fh[k]);
        if constexpr (XI16) row_load_h((const h16*)xin_ + bo + ro, lane, xh[k]); else row_load((const float*)xin_ + bo + ro, lane, xi[k]); }
    for (;;) {
        const int rn = r0 + 2 * nsl; const bool has = rn < SEQ;
        if (has) {
#pragma unroll
            for (int k = 0; k < 2; ++k) { const int r = rn + k * nsl; const size_t ro = (size_t)(r < SEQ ? r : rn) * DM; row_load_h(fb + ro, lane, fn[k]);
                if constexpr (XI16) row_load_h((const h16*)xin_ + bo + ro, lane, xhn[k]); else row_load((const float*)xin_ + bo + ro, lane, xn[k]); } }
#pragma unroll
        for (int k = 0; k < 2; ++k) { const int r = r0 + k * nsl; const bool ok = r < SEQ; const size_t ro = bo + (size_t)r * DM;
            f32x4 v[4];
#pragma unroll
            for (int j = 0; j < 4; ++j) { v[j] = h4_to_f4(fh[k][j]); if constexpr (XI16) xi[k][j] = h4_to_f4(xh[k][j]); }
            const float rstd = rsqrtf(row_ssq(v) * (1.f / DM) + EPS);
#pragma unroll
            for (int j = 0; j < 4; ++j) { const int ci = lane + 64 * j;
                xi[k][j] = xi[k][j] + ga[j] * v[j] * rstd;
                if (ok) { if constexpr (XO16) { u32x2 w; w.x = pk_h2(xi[k][j].x, xi[k][j].y); w.y = pk_h2(xi[k][j].z, xi[k][j].w); __builtin_nontemporal_store(w, (u32x2*)((h16*)xout_ + ro) + ci); }
                          else __builtin_nontemporal_store(xi[k][j], (f32x4*)((float*)xout_ + ro) + ci); } }
            if (second) { const float r2 = rsqrtf(row_ssq(xi[k]) * (1.f / DM) + EPS); if (ok) store_nm(xi[k], r2, gb, gc, dst + ro, lane, dst8 ? dst8 + ro : nullptr); } }
        if (!has) break;
#pragma unroll
        for (int k = 0; k < 2; ++k)
#pragma unroll
            for (int j = 0; j < 4; ++j) { fh[k][j] = fn[k][j]; if constexpr (XI16) xh[k][j] = xhn[k][j]; else xi[k][j] = xn[k][j]; }
        r0 = rn;
    }
}

__device__ __forceinline__ void ph_combine(const Frame& F, const h16* og, const float* lse2, h16* ob) {
    for (int idx = blockIdx.x * NTHR + F.tid; idx < MT * 256; idx += F.G * NTHR) {
        const int tok = idx >> 8, c = idx & 255, hh = c >> 6;
        const float l0 = lse2[tok * 12 + hh], l1 = lse2[tok * 12 + 4 + hh], l2 = lse2[tok * 12 + 8 + hh], m = fmaxf(l0, fmaxf(l1, l2));
        const float w0 = exp2f(l0 - m), w1 = exp2f(l1 - m), w2 = exp2f(l2 - m), inv = 1.f / (w0 + w1 + w2);
        ob[idx] = (h16)((w0 * (float)og[(size_t)tok * 768 + c] + w1 * (float)og[(size_t)tok * 768 + 256 + c] + w2 * (float)og[(size_t)tok * 768 + 512 + c]) * inv); }
}
typedef short v4i16_t __attribute__((ext_vector_type(4)));
typedef short s16x8 __attribute__((ext_vector_type(8)));
typedef float f32x16 __attribute__((ext_vector_type(16)));
__device__ __forceinline__ int tk_bin(float sc) { const unsigned u = __float_as_uint(sc); int e = (int)((u >> 16) & 0x7FFFu) - (122 << 7); e = e < 0 ? 0 : (e > 1023 ? 1023 : e); return (u >> 31) ? 1023 - e : 1024 + e; }
__device__ __forceinline__ void tk_scores(const f16x8 (&Af)[2], const float (&wv)[16], f16x8 b0, f16x8 b1, float& sa, float& sb) {
    f32x16 d = {0.f, 0.f, 0.f, 0.f, 0.f, 0.f, 0.f, 0.f, 0.f, 0.f, 0.f, 0.f, 0.f, 0.f, 0.f, 0.f};
    d = __builtin_amdgcn_mfma_f32_32x32x16_f16(Af[0], b0, d, 0, 0, 0); d = __builtin_amdgcn_mfma_f32_32x32x16_f16(Af[1], b1, d, 0, 0, 0);
    f32x2 acc = {0.f, 0.f};
#pragma unroll
    for (int e = 0; e < 16; e += 2) { const int i0 = __float_as_int(d[e]), i1 = __float_as_int(d[e + 1]);
        const f32x2 rl = {__int_as_float(i0 > 0 ? i0 : 0), __int_as_float(i1 > 0 ? i1 : 0)}; const f32x2 w2 = {wv[e], wv[e + 1]};
        acc = __builtin_elementwise_fma(w2, rl, acc); }
    sa = acc.x; sb = acc.y;
}
template <bool P2>
__device__ __forceinline__ void tk_tile(const f16x8 (&Af)[2], const float (&wv)[16], f16x8 b0, f16x8 b1, int tile, int r, int hi, int ta, LAS unsigned* hist, const int (&tbin)[4], int (&cs)[4], int (&cc)[4],
                                        unsigned short* sel, int tok0) {
    float sa, sb; tk_scores(Af, wv, b0, b1, sa, sb);
    const int s = 32 * tile + r;
    if constexpr (!P2) {
        if (s <= ta) { const int bn = tk_bin(sa); __hip_atomic_fetch_add(hist + (2 * hi) * 1024 + (bn >> 1), 1u << (16 * (bn & 1)), __ATOMIC_RELAXED, __HIP_MEMORY_SCOPE_WORKGROUP); }
        if (s <= ta + 1) { const int bn = tk_bin(sb); __hip_atomic_fetch_add(hist + (2 * hi + 1) * 1024 + (bn >> 1), 1u << (16 * (bn & 1)), __ATOMIC_RELAXED, __HIP_MEMORY_SCOPE_WORKGROUP); }
    } else {
        const unsigned lowmask = (1u << r) - 1u;
#pragma unroll
        for (int ab = 0; ab < 2; ++ab) { const float sc = ab ? sb : sa; const int tq = ta + ab; const int bn = tk_bin(sc);
            const int mytb = hi ? tbin[2 + ab] : tbin[ab];
            const bool valid = s <= tq, sure = valid && bn > mytb, cand = valid && bn == mytb;
            const unsigned long long ms = __ballot(sure), mc = __ballot(cand);
            const unsigned ms_h = hi ? (unsigned)(ms >> 32) : (unsigned)ms, mc_h = hi ? (unsigned)(mc >> 32) : (unsigned)mc;
            const int q = 2 * hi + ab;
            const int base_s = hi ? cs[2 + ab] : cs[ab], base_c = hi ? cc[2 + ab] : cc[ab];
            if (sure) sel[(size_t)(tok0 + q) * TOPK + base_s + __builtin_popcount(ms_h & lowmask)] = (unsigned short)s;
            if (cand) { const int pos = base_c + __builtin_popcount(mc_h & lowmask);
                if (pos < 512) ((LAS unsigned long long*)((LAS unsigned char*)hist + q * 4096))[pos] = ((unsigned long long)fkey(sc) << 16) | (unsigned long long)(0xFFFFu - (unsigned)s); }
            cs[ab] += __builtin_popcount((unsigned)ms); cs[2 + ab] += __builtin_popcount((unsigned)(ms >> 32));
            cc[ab] += __builtin_popcount((unsigned)mc); cc[2 + ab] += __builtin_popcount((unsigned)(mc >> 32)); }
    }
}
template <bool P2>
__device__ __forceinline__ void tk_pass(const f16x8 (&Af)[2], const float (&wv)[16], const h16* kbase, int ntiles, int r, int hi, int ta, LAS unsigned* hist, const int (&tbin)[4], int (&cs)[4], int (&cc)[4],
                                        unsigned short* sel, int tok0) {
    f16x8 BA[4][2], BB[4][2];
#define TK_LOAD(dst, t0_) do { _Pragma("unroll") for (int i_ = 0; i_ < 4; ++i_) { const int tt_ = ((t0_) + i_) < 127 ? ((t0_) + i_) : 127; dst[i_][0] = *(const f16x8*)(kbase + (size_t)tt_ * 1024); dst[i_][1] = *(const f16x8*)(kbase + (size_t)tt_ * 1024 + 16); } } while (0)
    TK_LOAD(BA, 0);
    for (int t0 = 0; t0 < ntiles; t0 += 8) {
        TK_LOAD(BB, t0 + 4);
#pragma unroll
        for (int i = 0; i < 4; ++i) if (t0 + i < ntiles) tk_tile<P2>(Af, wv, BA[i][0], BA[i][1], t0 + i, r, hi, ta, hist, tbin, cs, cc, sel, tok0);
        TK_LOAD(BA, t0 + 8);
#pragma unroll
        for (int i = 0; i < 4; ++i) if (t0 + 4 + i < ntiles) tk_tile<P2>(Af, wv, BB[i][0], BB[i][1], t0 + 4 + i, r, hi, ta, hist, tbin, cs, cc, sel, tok0);
    }
#undef TK_LOAD
}
__device__ __forceinline__ void tk_group(const Frame& F, const h16* qi, const h16* ki, const float* wi, unsigned short* sel, int b, int t0, LAS unsigned* hist) {
    int lane_ = F.lane; asm volatile("" : "+v"(lane_)); const int lane = lane_, r = lane & 31, hi = lane >> 5, tok0 = b * SEQ + t0;
    const int qa = 2 * ((r >> 2) & 1) + (r & 1), ha = 4 * (r >> 4) + 2 * ((r >> 3) & 1) + ((r >> 1) & 1);
    f16x8 Af[2];
#pragma unroll
    for (int s_ = 0; s_ < 2; ++s_) Af[s_] = *(const f16x8*)(qi + (size_t)(tok0 + qa) * 256 + ha * 32 + 16 * s_ + 8 * hi);
    float wv[16];
    { const f32x4 a0 = *(const f32x4*)(wi + (tok0 + 2 * hi) * 8), a1 = *(const f32x4*)(wi + (tok0 + 2 * hi) * 8 + 4), b0 = *(const f32x4*)(wi + (tok0 + 2 * hi + 1) * 8), b1 = *(const f32x4*)(wi + (tok0 + 2 * hi + 1) * 8 + 4);
      const float sa[8] = {a0.x, a0.y, a0.z, a0.w, a1.x, a1.y, a1.z, a1.w}, sb[8] = {b0.x, b0.y, b0.z, b0.w, b1.x, b1.y, b1.z, b1.w};
#pragma unroll
      for (int h = 0; h < 8; ++h) { wv[2 * h] = sa[h] * 0.17677669529663687f; wv[2 * h + 1] = sb[h] * 0.17677669529663687f; } }
    const int ntiles = (t0 + 3) / 32 + 1, ta = t0 + 2 * hi;
    const h16* kbase = ki + (size_t)(b * SEQ + r) * 32 + 8 * hi;
    int tbin[4] = {0, 0, 0, 0}, nsure[4], cs[4] = {0, 0, 0, 0}, cc[4] = {0, 0, 0, 0};
#pragma unroll
    for (int i = 0; i < 16; ++i) *(LAS u32x4*)((LAS unsigned char*)hist + i * 1024 + lane * 16) = (u32x4){0u, 0u, 0u, 0u};
    asm volatile("s_waitcnt lgkmcnt(0)" ::: "memory");
    tk_pass<false>(Af, wv, kbase, ntiles, r, hi, ta, hist, tbin, cs, cc, sel, tok0);
    asm volatile("s_waitcnt lgkmcnt(0)" ::: "memory");
#pragma unroll
    for (int q = 0; q < 4; ++q) {
        const LAS unsigned* hq = hist + q * 1024;
        unsigned sum = 0;
#pragma unroll
        for (int i = 0; i < 4; ++i) { const u32x4 v = *(const LAS u32x4*)(hq + 16 * lane + 4 * i); sum += (v.x & 0xFFFFu) + (v.x >> 16) + (v.y & 0xFFFFu) + (v.y >> 16) + (v.z & 0xFFFFu) + (v.z >> 16) + (v.w & 0xFFFFu) + (v.w >> 16); }
        unsigned incl = sum;
#pragma unroll
        for (int o = 1; o < 64; o <<= 1) { const unsigned v = __shfl_down(incl, o); if (lane + o < 64) incl += v; }
        const unsigned long long bal = __ballot(incl >= (unsigned)TOPK);
        const int L = 63 - __builtin_clzll(bal);
        unsigned cum = __shfl(incl, L) - __shfl(sum, L);
        int tbq = 32 * L, found = 0;
        for (int wd = 15; wd >= 0 && !found; --wd) { const unsigned v = hq[16 * L + wd];
            const unsigned chi = v >> 16, clo = v & 0xFFFFu;
            if (cum + chi >= (unsigned)TOPK) { tbq = 32 * L + 2 * wd + 1; found = 1; } else { cum += chi;
                if (cum + clo >= (unsigned)TOPK) { tbq = 32 * L + 2 * wd; found = 1; } else cum += clo; } }
        tbin[q] = tbq; nsure[q] = (int)cum;
    }
    asm volatile("s_waitcnt lgkmcnt(0)" ::: "memory");
    tk_pass<true>(Af, wv, kbase, ntiles, r, hi, ta, hist, tbin, cs, cc, sel, tok0);
    asm volatile("s_waitcnt lgkmcnt(0)" ::: "memory");
#pragma unroll
    for (int q = 0; q < 4; ++q) {
        const int nc = cc[q] < 512 ? cc[q] : 512, need = TOPK - cs[q];
        const LAS unsigned long long* cq = (const LAS unsigned long long*)((const LAS unsigned char*)hist + q * 4096);
        if (nc > 64) {
            unsigned long long it[8];
#pragma unroll
            for (int k = 0; k < 8; ++k) it[k] = (k * 64 + lane < nc) ? cq[k * 64 + lane] : 0ull;
            unsigned long long T = 0ull;
            for (int bit = 47; bit >= 0; --bit) { const unsigned long long cand = T | (1ull << bit); int cnt = 0;
#pragma unroll
                for (int k = 0; k < 8; ++k) cnt += __builtin_popcountll(__ballot(it[k] >= cand));
                if (cnt >= need) T = cand; }
            int basep = cs[q];
#pragma unroll
            for (int k = 0; k < 8; ++k) { const bool pick = (T != 0ull) && it[k] >= T; const unsigned long long mk = __ballot(pick);
                if (pick) sel[(size_t)(tok0 + q) * TOPK + basep + __builtin_popcountll(mk & ((1ull << lane) - 1ull))] = (unsigned short)(0xFFFFu - (unsigned)(it[k] & 0xFFFFull));
                basep += __builtin_popcountll(mk); }
        } else
        for (int base = 0; base < nc; base += 64) {
            const bool act = base + lane < nc; const unsigned long long my = act ? cq[base + lane] : 0ull; int rank = 0;
            for (int jb = 0; jb < nc; jb += 64) {
                const unsigned long long cj = (jb + lane < nc) ? cq[jb + lane] : 0ull; const unsigned clo = (unsigned)cj, chi = (unsigned)(cj >> 32);
                const int n = (nc - jb) < 64 ? (nc - jb) : 64;
                for (int j = 0; j < n; ++j) { const unsigned long long sj = ((unsigned long long)(unsigned)__builtin_amdgcn_readlane((int)chi, j) << 32) | (unsigned)__builtin_amdgcn_readlane((int)clo, j); rank += (sj > my) ? 1 : 0; } }
            if (act && rank < need) sel[(size_t)(tok0 + q) * TOPK + cs[q] + rank] = (unsigned short)(0xFFFFu - (unsigned)(my & 0xFFFFull)); }
    }
    (void)nsure;
    asm volatile("s_waitcnt lgkmcnt(0)" ::: "memory");
}
__device__ __forceinline__ void ph_topk_sparse(const Frame& F, const h16* qi, const h16* ki, const float* wi, unsigned short* sel, h16* qlat, const h16* qr, const unsigned char* ckv8, const unsigned char* kr8);
__device__ __forceinline__ void ph_topk_mfma(const Frame& F, const h16* qi, const h16* ki, const float* wi, unsigned short* sel) {
    LAS unsigned* hist = (LAS unsigned*)(F.lds + F.wave * 16384);
    for (int g = F.gw; g < 4 * 64; g += F.NGW) { const int b = g >> 6, t0 = (g & 63) * 4;
        for (int i = F.lane; i < 4 * TOPK; i += 64) { const int q = i >> 8, k = i & 255; sel[(size_t)(b * SEQ + t0 + q) * TOPK + k] = (unsigned short)(k <= t0 + q ? k : 0); } }
    for (int p = F.gw; p < 4 * 480; p += F.NGW) { const int b = p & 3, pj = p >> 2;
        tk_group(F, qi, ki, wi, sel, b, 4 * (64 + pj), hist);
        tk_group(F, qi, ki, wi, sel, b, 4 * (1023 - pj), hist);
    }
}


__device__ __forceinline__ void ph_dilated_mfma(const Frame& F, const h16* qb, const h16* kb, const h16* vb, h16* og, float* lse2) {
    const int lane = F.lane, ql = lane & 31, hi = lane >> 5;
    LAS unsigned char* VL = F.lds + F.wave * 16384;
    LAS float* linv = (LAS float*)(VL + 12288);
    constexpr int VROW = 192;
    const int trq = (lane & 15) >> 2, trp = lane & 3, trg = (lane >> 4) & 1;
    for (int u = F.gw; u < NB * 12 * 128; u += F.NGW) {
        const int b = u / 1536, rem = u % 1536, gh = rem >> 7, g = gh >> 2, wi_ = rem & 127, dil = dil_of(g), sh = g == 0 ? 0 : (g == 1 ? 2 : 4);
        const int nblk = 128 >> sh, res = wi_ / nblk, j0 = 32 * (wi_ % nblk);
        const size_t hoff = (size_t)b * SEQ * 768 + gh * 64;
        f16x8 Qf[4];
        { const h16* qp = qb + hoff + (size_t)((j0 + ql) * dil + res) * 768 + 8 * hi;
#pragma unroll
          for (int s_ = 0; s_ < 4; ++s_) Qf[s_] = *(const f16x8*)(qp + 16 * s_); }
        f32x16 S[5];
        f16x8 Kf[5][4];
#pragma unroll
        for (int kt = 0; kt < 5; ++kt) { int jk = j0 - 128 + 32 * kt + ql; jk = jk < 0 ? 0 : jk;
            const h16* kp = kb + hoff + (size_t)(jk * dil + res) * 768 + 8 * hi;
#pragma unroll
            for (int s_ = 0; s_ < 4; ++s_) Kf[kt][s_] = *(const f16x8*)(kp + 16 * s_); }
#pragma unroll
        for (int kt = 0; kt < 5; ++kt) {
            f32x16 d = {0.f, 0.f, 0.f, 0.f, 0.f, 0.f, 0.f, 0.f, 0.f, 0.f, 0.f, 0.f, 0.f, 0.f, 0.f, 0.f};
#pragma unroll
            for (int s_ = 0; s_ < 4; ++s_) d = __builtin_amdgcn_mfma_f32_32x32x16_f16(Kf[kt][s_], Qf[s_], d, 0, 0, 0);
            S[kt] = d; }
        f16x8 Vr[5][4];
#pragma unroll
        for (int kt = 0; kt < 5; ++kt) { int jk = j0 - 128 + 32 * kt + (lane >> 1); jk = jk < 0 ? 0 : jk;
            const h16* vp = vb + hoff + (size_t)(jk * dil + res) * 768 + (lane & 1) * 32;
#pragma unroll
            for (int i = 0; i < 4; ++i) Vr[kt][i] = *(const f16x8*)(vp + 8 * i); }
        float m = -INFINITY;
#pragma unroll
        for (int kt = 0; kt < 5; ++kt)
#pragma unroll
            for (int e = 0; e < 16; ++e) { const int kl = (e & 3) + 8 * (e >> 2) + 4 * hi; bool ok = (j0 - 128 + 32 * kt + kl) >= 0;
                if (kt == 0) ok = ok && (kl >= ql); if (kt == 4) ok = ok && (kl <= ql);
                if (!ok) S[kt][e] = -INFINITY; m = fmaxf(m, S[kt][e]); }
        m = fmaxf(m, __shfl_xor(m, 32));
        float l = 0.f;
#pragma unroll
        for (int kt = 0; kt < 5; ++kt)
#pragma unroll
            for (int e = 0; e < 16; ++e) { const float p = __builtin_amdgcn_exp2f(S[kt][e] - m); S[kt][e] = p; l += p; }
        l += __shfl_xor(l, 32);
        if (hi == 0) { linv[ql] = __builtin_amdgcn_rcpf(l); lse2[(size_t)(b * SEQ + (j0 + ql) * dil + res) * 12 + gh] = m + __builtin_amdgcn_logf(l); }
        f32x16 O[2];
#pragma unroll
        for (int dt = 0; dt < 2; ++dt) O[dt] = (f32x16){0.f, 0.f, 0.f, 0.f, 0.f, 0.f, 0.f, 0.f, 0.f, 0.f, 0.f, 0.f, 0.f, 0.f, 0.f, 0.f};
#pragma unroll
        for (int kt = 0; kt < 5; ++kt) {
            LAS unsigned char* vbuf = VL + (kt & 1) * 6144;
#pragma unroll
            for (int i = 0; i < 4; ++i) *(LAS f16x8*)(vbuf + (lane >> 1) * VROW + (lane & 1) * 64 + i * 16) = Vr[kt][i];
            asm volatile("s_waitcnt lgkmcnt(0)" ::: "memory");
#pragma unroll
            for (int s2 = 0; s2 < 2; ++s2) {
                u32x4 pa; pa.x = pk_h2(S[kt][8 * s2 + 0], S[kt][8 * s2 + 1]); pa.y = pk_h2(S[kt][8 * s2 + 2], S[kt][8 * s2 + 3]); pa.z = pk_h2(S[kt][8 * s2 + 4], S[kt][8 * s2 + 5]); pa.w = pk_h2(S[kt][8 * s2 + 6], S[kt][8 * s2 + 7]);
#pragma unroll
                for (int dt = 0; dt < 2; ++dt) {
                    const v4i16_t lo = __builtin_amdgcn_ds_read_tr16_b64_v4i16((LAS v4i16_t*)(vbuf + (16 * s2 + 4 * hi + trq) * VROW + (32 * dt + 16 * trg + 4 * trp) * 2));
                    const v4i16_t hh = __builtin_amdgcn_ds_read_tr16_b64_v4i16((LAS v4i16_t*)(vbuf + (16 * s2 + 8 + 4 * hi + trq) * VROW + (32 * dt + 16 * trg + 4 * trp) * 2));
                    const s16x8 bv = {lo[0], lo[1], lo[2], lo[3], hh[0], hh[1], hh[2], hh[3]};
                    O[dt] = __builtin_amdgcn_mfma_f32_32x32x16_f16(__builtin_bit_cast(f16x8, pa), __builtin_bit_cast(f16x8, bv), O[dt], 0, 0, 0); } }
            asm volatile("s_waitcnt lgkmcnt(0)" ::: "memory");
        }
#pragma unroll
        for (int e = 0; e < 16; ++e) { const int q = (e & 3) + 8 * (e >> 2) + 4 * hi; const float il = linv[q];
            h16* op = og + (size_t)(b * SEQ + (j0 + q) * dil + res) * 768 + gh * 64 + ql;
            op[0] = (h16)(O[0][e] * il); op[32] = (h16)(O[1][e] * il); }
        asm volatile("s_waitcnt lgkmcnt(0)" ::: "memory");
    }
}


__device__ __forceinline__ f16x8 fp8x8_to_f16(unsigned w0, unsigned w1) {
    const h16x2 a = __builtin_amdgcn_cvt_scalef32_pk_f16_fp8((int)w0, 1.0f, false), b = __builtin_amdgcn_cvt_scalef32_pk_f16_fp8((int)w0, 1.0f, true),
                c = __builtin_amdgcn_cvt_scalef32_pk_f16_fp8((int)w1, 1.0f, false), d = __builtin_amdgcn_cvt_scalef32_pk_f16_fp8((int)w1, 1.0f, true);
    const u32x4 r = {__builtin_bit_cast(unsigned, a), __builtin_bit_cast(unsigned, b), __builtin_bit_cast(unsigned, c), __builtin_bit_cast(unsigned, d)};
    return __builtin_bit_cast(f16x8, r);
}
template <bool FUSED>
__device__ __forceinline__ void ph_sparse_wave(const Frame& F, h16* qlat, const h16* qr, const unsigned char* ckv8, const unsigned char* kr8, const unsigned short* sel, int ta = 0, int tb = 0) {
    int lane = F.lane; asm volatile("" : "+v"(lane));
    LAS unsigned char* V = F.lds + F.wave * 16384;
    const int qp = (lane & 15) >> 2, pp = lane & 3;
    const int k0 = 4 * (lane >> 4) + qp;
    const int tr0 = k0 * 512 + (pp >> 1) * 16 + (pp & 1) * 8, x0 = k0 & 7;
    const int vw = (lane & 15) * 512, swz = lane & 7;
    const int lane0 = lane;
    const int nit = FUSED ? 8 : (MT - F.gw + F.NGW - 1) / F.NGW;
    for (int it = 0; it < nit; ++it) {
        const int tok = FUSED ? ((it < 4 ? ta : tb - 4) + it) : F.gw + it * F.NGW;
        int ll = lane0; asm volatile("" : "+v"(ll));
        const int c = ll & 15, kq = ll >> 4, hd = c & 7;
        const int b = tok / SEQ, t = tok % SEQ, cnt = (t + 1 < TOPK) ? t + 1 : TOPK, nch = (cnt + 31) >> 5;
        LAS unsigned short* sp = (LAS unsigned short*)(F.lds + XCH_OFF + F.wave * 512) + c;
        *(LAS u32x2*)(F.lds + XCH_OFF + F.wave * 512 + 8 * ll) = *(const u32x2*)(sel + (size_t)tok * TOPK + 4 * ll);
        asm volatile("s_waitcnt lgkmcnt(0)" ::: "memory");
        f16x8 Qf[9]; u32x4 Kr[2][4]; u32x2 Rr[2];
#pragma unroll
        for (int s_ = 0; s_ < 8; ++s_) Qf[s_] = *(const f16x8*)(qlat + (size_t)tok * 2048 + hd * 256 + 64 * (s_ >> 1) + 16 * kq + 8 * (s_ & 1));
        Qf[8] = *(const f16x8*)(qr + (size_t)tok * 256 + hd * 32 + 8 * kq);
        int rowi[2];
#define SW_LOADK() do { _Pragma("unroll") for (int tl = 0; tl < 2; ++tl) { _Pragma("unroll") for (int q4 = 0; q4 < 4; ++q4) Kr[tl][q4] = *(const u32x4*)(ckv8 + (size_t)rowi[tl] * 256 + 64 * q4 + 16 * kq); \
        Rr[tl] = *(const u32x2*)(kr8 + (size_t)rowi[tl] * 32 + 8 * kq); } } while (0)
        rowi[0] = b * SEQ + (int)sp[0]; rowi[1] = b * SEQ + (int)sp[16];
        SW_LOADK();
        float m = -INFINITY, l = 0.f;
        f32x4 O[16];
#pragma unroll
        for (int ft = 0; ft < 16; ++ft) O[ft] = (f32x4){0.f, 0.f, 0.f, 0.f};
        for (int ch = 0; ch < nch; ++ch) {
            const bool more = ch + 1 < nch;
            int rown0 = 0, rown1 = 0; if (more) { rown0 = (int)sp[32 * (ch + 1)]; rown1 = (int)sp[32 * (ch + 1) + 16]; }
            f16x8 Kf[2][9];
#pragma unroll
            for (int tl = 0; tl < 2; ++tl) {
#pragma unroll
                for (int q4 = 0; q4 < 4; ++q4) { Kf[tl][2 * q4] = fp8x8_to_f16(Kr[tl][q4].x, Kr[tl][q4].y); Kf[tl][2 * q4 + 1] = fp8x8_to_f16(Kr[tl][q4].z, Kr[tl][q4].w); }
                Kf[tl][8] = fp8x8_to_f16(Rr[tl].x, Rr[tl].y); }
            if (more) { rowi[0] = b * SEQ + rown0; rowi[1] = b * SEQ + rown1; SW_LOADK(); }
            f32x4 S[2];
#pragma unroll
            for (int tl = 0; tl < 2; ++tl) { S[tl] = (f32x4){0.f, 0.f, 0.f, 0.f};
#pragma unroll
                for (int s_ = 0; s_ < 9; ++s_) S[tl] = __builtin_amdgcn_mfma_f32_16x16x32_f16(Kf[tl][s_], Qf[s_], S[tl], 0, 0, 0); }
            float cm = -INFINITY;
#pragma unroll
            for (int tl = 0; tl < 2; ++tl)
#pragma unroll
                for (int e = 0; e < 4; ++e) { if (32 * ch + 16 * tl + 4 * kq + e >= cnt) S[tl][e] = -INFINITY; cm = fmaxf(cm, S[tl][e]); }
            cm = fmaxf(cm, __shfl_xor(cm, 16)); cm = fmaxf(cm, __shfl_xor(cm, 32));
            if (__any(cm > m + 8.0f)) { const float mn = fmaxf(m, cm), alpha = __builtin_amdgcn_exp2f(m - mn); m = mn; l *= alpha;
#pragma unroll
                for (int ft = 0; ft < 16; ++ft) O[ft] = O[ft] * alpha; }
            float pe[2][4]; float ps = 0.f;
#pragma unroll
            for (int tl = 0; tl < 2; ++tl)
#pragma unroll
                for (int e = 0; e < 4; ++e) { pe[tl][e] = __builtin_amdgcn_exp2f(S[tl][e] - m); ps += pe[tl][e]; }
            l += ps;
#pragma unroll
            for (int tl = 0; tl < 2; ++tl)
#pragma unroll
                for (int s_ = 0; s_ < 8; ++s_) *(LAS f16x8*)(V + vw + tl * 8192 + (((4 * (s_ >> 1) + kq) ^ swz) << 5) + (s_ & 1) * 16) = Kf[tl][s_];
            asm volatile("s_waitcnt lgkmcnt(0)" ::: "memory");
            u32x4 pk; pk.x = pk_h2(pe[0][0], pe[0][1]); pk.y = pk_h2(pe[0][2], pe[0][3]); pk.z = pk_h2(pe[1][0], pe[1][1]); pk.w = pk_h2(pe[1][2], pe[1][3]);
            const f16x8 Pf = __builtin_bit_cast(f16x8, pk);
#pragma unroll
            for (int ft = 0; ft < 16; ++ft) {
                const v4i16_t lo = __builtin_amdgcn_ds_read_tr16_b64_v4i16((LAS v4i16_t*)(V + tr0 + (((ft & 7) ^ x0) << 5) + (ft >> 3) * 256));
                const v4i16_t hi = __builtin_amdgcn_ds_read_tr16_b64_v4i16((LAS v4i16_t*)(V + tr0 + (((ft & 7) ^ x0) << 5) + (ft >> 3) * 256 + 8192));
                const s16x8 av = {lo[0], lo[1], lo[2], lo[3], hi[0], hi[1], hi[2], hi[3]};
                O[ft] = __builtin_amdgcn_mfma_f32_16x16x32_f16(__builtin_bit_cast(f16x8, av), Pf, O[ft], 0, 0, 0); }
            asm volatile("s_waitcnt lgkmcnt(0)" ::: "memory");
        }
        l += __shfl_xor(l, 16); l += __shfl_xor(l, 32);
        if (c < 8) { const float il = __builtin_amdgcn_rcpf(l);
#pragma unroll
            for (int ft = 0; ft < 16; ++ft) { const f32x4 o = O[ft] * il; u32x2 pk; pk.x = pk_h2(o.x, o.y); pk.y = pk_h2(o.z, o.w);
                *(u32x2*)(qlat + (size_t)tok * 2048 + c * 256 + 16 * ft + 4 * kq) = pk; } }
#undef SW_LOADK
    }
}


__device__ __forceinline__ void precomb_tiles(const Frame& F, const Args& args, unsigned char* ws, int t_lo, int t_hi, int wg, int nwg) {
    LAS float* As = (LAS float*)(F.lds); LAS float* Bs = (LAS float*)(F.lds + 64 * 65 * 4);
    for (int tl = t_lo + wg; tl < t_hi; tl += nwg) {
        __syncthreads();
        const bool ql = tl < 192; int hd, rb, xb;
        if (ql) { hd = tl / 24; rb = (tl % 24) / 6; xb = tl % 6; } else { const int t2 = tl - 192; hd = t2 / 64; rb = (t2 % 64) / 16; xb = t2 % 16; }
#pragma unroll
        for (int k = 0; k < 2; ++k) { const int i4 = F.tid + NTHR * k, row = i4 >> 4, c4 = (i4 & 15) * 4;
            if (ql) { const f32x4 a = *(const f32x4*)(args.in[15] + (size_t)(rb * 64 + row) * 512 + hd * 64 + c4), bq = *(const f32x4*)(args.in[14] + (size_t)(xb * 64 + row) * 768 + hd * 96 + c4);
#pragma unroll
                for (int e = 0; e < 4; ++e) { As[row * 65 + c4 + e] = a[e]; Bs[row * 65 + c4 + e] = bq[e]; } }
            else { const f32x4 a = *(const f32x4*)(args.in[18] + (size_t)(hd * 64 + row) * DM + xb * 64 + c4), bq = *(const f32x4*)(args.in[16] + (size_t)(rb * 64 + row) * 512 + hd * 64 + c4);
#pragma unroll
                for (int e = 0; e < 4; ++e) { As[(c4 + e) * 65 + row] = a[e]; Bs[row * 65 + c4 + e] = bq[e]; } } }
        __syncthreads();
        const int j = F.tid & 63, ig = F.wave;
        float acc8[8];
#pragma unroll
        for (int ii = 0; ii < 8; ++ii) acc8[ii] = 0.f;
#pragma unroll 4
        for (int v = 0; v < 64; ++v) { const float bv = Bs[j * 65 + v];
#pragma unroll
            for (int ii = 0; ii < 8; ++ii) acc8[ii] += As[(ig * 8 + ii) * 65 + v] * bv; }
        if (ql) { const float gj = args.in[12][xb * 64 + j]; h16* o = (h16*)(ws + OW_4);
#pragma unroll
            for (int ii = 0; ii < 8; ++ii) o[(size_t)(hd * 256 + rb * 64 + ig * 8 + ii) * QL + xb * 64 + j] = (h16)(acc8[ii] * gj); }
        else { h16* o = (h16*)(ws + OW_OV);
#pragma unroll
            for (int ii = 0; ii < 8; ++ii) o[(size_t)(xb * 64 + ig * 8 + ii) * 2048 + hd * 256 + rb * 64 + j] = (h16)acc8[ii]; }
    }
    __syncthreads();
}


__device__ __forceinline__ void ph_topk_sparse(const Frame& F, const h16* qi, const h16* ki, const float* wi, unsigned short* sel, h16* qlat, const h16* qr, const unsigned char* ckv8, const unsigned char* kr8) {
    LAS unsigned* hist = (LAS unsigned*)(F.lds + F.wave * 16384);
    for (int p = F.gw; p < 2048; p += F.NGW) {
        int ta, tb;
        if (p < 4 * 448) { const int b = p & 3, pj = p >> 2; ta = b * SEQ + 4 * (64 + pj); tb = b * SEQ + 4 * (959 - pj);
            tk_group(F, qi, ki, wi, sel, b, 4 * (64 + pj), hist);
            tk_group(F, qi, ki, wi, sel, b, 4 * (959 - pj), hist); }
        else { const int q_ = p - 4 * 448, b = q_ & 3, i_ = q_ >> 2, t0 = 4 * i_;
            tk_group(F, qi, ki, wi, sel, b, 4 * (960 + i_), hist);
            int l0 = F.lane; asm volatile("" : "+v"(l0));
            for (int i = l0; i < 4 * TOPK; i += 64) { const int q = i >> 8, k = i & 255; sel[(size_t)(b * SEQ + t0 + q) * TOPK + k] = (unsigned short)(k <= t0 + q ? k : 0); }
            ta = b * SEQ + 4 * (960 + i_); tb = b * SEQ + t0; }
        asm volatile("s_waitcnt vmcnt(0) lgkmcnt(0)" ::: "memory");
        ph_sparse_wave<true>(F, qlat, qr, ckv8, kr8, sel, ta, tb);
        asm volatile("s_waitcnt lgkmcnt(0)" ::: "memory");
    }
}

__global__ void __launch_bounds__(NTHR, 2) mega_fwd(Args args) {
    extern __shared__ __attribute__((aligned(16))) unsigned char lds_raw[];
    Frame F; F.lds = (LAS unsigned char*)lds_raw; F.tid = threadIdx.x; F.lane = F.tid & 63; F.wave = __builtin_amdgcn_readfirstlane(F.tid >> 6);
    F.G = gridDim.x; F.gw = blockIdx.x * NWAVES + F.wave; F.NGW = F.G * NWAVES;
    volatile LAS unsigned* MISC = (volatile LAS unsigned*)(F.lds + MISC_OFF);
    unsigned char* ws = args.ws;
    for (int u = F.tid; u < (LDS_BYTES - LDSCTL_OFF) / 4; u += NTHR) ((LAS unsigned*)(F.lds + LDSCTL_OFF))[u] = 0u;
    __syncthreads();
    XcdBarrier bar = xcd_barrier_post((unsigned*)(ws + OFF_CTL) + CW_BAR, MISC + 8, F.wave);
    const int lo = args.ph_lo, hi = args.ph_hi;
#define IN(k) (lo <= (k) && (k) < hi)
#define SEAM(k) do { if (IN(k) && IN((k) + 1)) xcd_barrier(bar); F.lane = flane(); F.tid = F.wave * 64 + F.lane; } while (0)
    float* mod = (float*)(ws + OFF_MOD); float2* tab = (float2*)(ws + OFF_ROPE);
    h16* Hb = (h16*)(ws + OFF_H); h16* Ab = (h16*)(ws + OFF_A); float* Fb = (float*)(ws + OFF_F);

    if (IN(0)) {
        LAS float* scr = (LAS float*)(F.lds + F.wave * 16384);
        for (int ch = blockIdx.x; ch < (NMOD * DM) / 36; ch += F.G) {
            LAS float* sl = (LAS float*)(F.lds);
            LAS float* part = (LAS float*)(F.lds + 16384);
            __syncthreads();
            for (int i = F.tid; i < 4 * DM; i += NTHR) sl[i] = silu_f(args.in[1][i]);
            __syncthreads();
            const int ln = F.lane < 36 ? F.lane : 35;
            const float* wm = args.in[3] + (size_t)(F.wave * 128) * (NMOD * DM) + ch * 36 + ln;
            float a0 = 0.f, a1 = 0.f, a2 = 0.f, a3 = 0.f;
#pragma unroll 16
            for (int k = 0; k < 128; ++k) { const float w = wm[(size_t)k * (NMOD * DM)]; const int kk = F.wave * 128 + k; a0 += sl[kk] * w; a1 += sl[DM + kk] * w; a2 += sl[2 * DM + kk] * w; a3 += sl[3 * DM + kk] * w; }
            part[(F.wave * 4 + 0) * 64 + F.lane] = a0; part[(F.wave * 4 + 1) * 64 + F.lane] = a1; part[(F.wave * 4 + 2) * 64 + F.lane] = a2; part[(F.wave * 4 + 3) * 64 + F.lane] = a3;
            __syncthreads();
            if (F.tid < 256 && (F.tid & 63) < 36) { const int b = F.tid >> 6, l = F.tid & 63; float sm = args.in[4][ch * 36 + l];
#pragma unroll
                for (int w = 0; w < 8; ++w) sm += part[(w * 4 + b) * 64 + l];
                mod[b * (NMOD * DM) + ch * 36 + l] = sm; }
            __syncthreads();
        }
        for (int idx = blockIdx.x * NTHR + F.tid; idx < MT * 48; idx += F.G * NTHR) { const int tok = idx / 48, i = idx % 48;
            const float inv = (i < 32) ? powf(10000.f, -(float)i / 32.f) : powf(10000.f, -(float)(i - 32) / 16.f);
            const float ang = (float)((const int*)args.in[2])[tok] * inv; tab[idx] = make_float2(cosf(ang), sinf(ang)); }
        tr_job_mapped(F, args, 0, 2 * FF, 0, DM, ws + OW_GU1, nullptr, scr, 0);
        if (F.G != 256) {
            tr_job_plain(F, args.in[8], DM, DM, FF, ws + OW_D1, scr, 768);
            tr_job_mapped(F, args, 2, NIN3, 0, DM, (h16*)(ws + OW_IN), nullptr, scr, 128);
            tr_job_plain(F, args.in[11] + C_GATE, DIN, 2048, DM, ws + OW_GATE, scr, 1664);
            tr_job_mapped(F, args, 3, 512, 2048, QL, (h16*)(ws + OW_4), args.in[12], scr, 640);
            tr_job_plain(F, args.in[19], DM, DM, 256, (h16*)(ws + OW_UPB), scr, 736);
            tr_job_plain(F, args.in[20], DM, DM, DM, (h16*)(ws + OW_O), scr, 864);
            tr_job_mapped(F, args, 1, 2 * FF, 0, DM, ws + OW_GU2, nullptr, scr, 1376);
            tr_job_plain(F, args.in[25], DM, DM, FF, ws + OW_D2, scr, 96);
            precomb_tiles(F, args, ws, 0, 192, (int)blockIdx.x, F.G);
            tr_job_plain(F, args.in[18], DM, DM, 512, (h16*)(ws + OW_UPA), scr, 256);
        }
    }
    SEAM(0);
    if (IN(1)) ph_normmod(F, args.in[0], args.in[5], mod, 1, 0, ws + OFF_H);
    SEAM(1);
    if (IN(2)) { pg8::Gemm g{Hb, (const h16*)(ws + OW_GU1), MT, 2 * FF, DM / 2}; pg8::StaticOrder S; S.init(MT, 2 * FF, F.G, (int)blockIdx.x); pg8::EpiSwiGLU_T<true> E{Ab};
        pg8::gemm_phase<pg8::EpiSwiGLU_T<true>, true, true>(F.lds, g, S, E, F.wave);
        if (F.G == 256 && blockIdx.x >= 128) {
            Frame F2 = F; F2.gw = ((int)blockIdx.x - 128) * NWAVES + F.wave; F2.NGW = 128 * NWAVES; LAS float* scr = (LAS float*)(F.lds + F.wave * 16384);
            tr_job_plain(F2, args.in[8], DM, DM, FF, ws + OW_D1, scr, 0);
            tr_job_mapped(F2, args, 2, NIN3, 0, DM, (h16*)(ws + OW_IN), nullptr, scr, 384);
            tr_job_mapped(F2, args, 3, 512, 2048, QL, (h16*)(ws + OW_4), args.in[12], scr, 896);
            tr_job_mapped(F2, args, 1, 2 * FF, 0, DM, ws + OW_GU2, nullptr, scr, 640);
            precomb_tiles(F, args, ws, 0, 192, (int)blockIdx.x - 128, 128);
            for (int i = ((int)blockIdx.x - 128) * NTHR + F.tid; i < (int)(MiB / 16); i += 128 * NTHR) ((u32x4*)(ws + OW_BD))[i] = (u32x4){0u, 0u, 0u, 0u}; } }
    SEAM(2);
    if (IN(3)) { pg8::Gemm g{Ab, (const h16*)(ws + OW_D1), MT, DM, FF / 2}; pg8::StaticOrder S; S.init(MT, DM, F.G, (int)blockIdx.x); pg8::EpiH16_T<true> E{(h16*)Fb};
        pg8::gemm_phase<pg8::EpiH16_T<true>, false, true>(F.lds, g, S, E, F.wave); }
    SEAM(3);
    if (IN(4)) ph_resnorm<false, true>(F, args.in[0], (const h16*)Fb, args.in[9], mod, 2, 0.5f, args.out, true, args.in[10], 4, 3, Hb, (unsigned char*)args.out + 32 * MiB);
    SEAM(4);
    if (IN(5)) { pg8::Gemm g{Hb, (const h16*)(ws + OW_IN), MT, NIN3, DM}; pg8::StaticOrder S; S.init(MT, NIN3, F.G, (int)blockIdx.x);
        pg8::EpiIn E{(h16*)(ws + OFF_CKV), (h16*)(ws + OFF_CQ), (h16*)(ws + OFF_KR), (h16*)(ws + OFF_KI), (h16*)(ws + OFF_QB), (h16*)(ws + OFF_KB), (h16*)(ws + OFF_VT), (float*)(ws + OFF_WI), (float*)(ws + OFF_SSQ),
                     args.in[13], tab, (LAS float*)(F.lds + XCH_OFF)};
        pg8::gemm_phase<pg8::EpiIn, true>(F.lds, g, S, E, F.wave); }
    SEAM(5);
    if (IN(6)) { for (int tk_ = blockIdx.x * NTHR + F.tid; tk_ < MT; tk_ += F.G * NTHR) { const f32x4 s0 = *(const f32x4*)((const float*)(ws + OFF_SSQ) + tk_ * 8), s1 = *(const f32x4*)((const float*)(ws + OFF_SSQ) + tk_ * 8 + 4);
            ((float*)(ws + OFF_RSTDQ))[tk_] = rsqrtf((((s0.x + s0.y) + (s0.z + s0.w)) + ((s1.x + s1.y) + (s1.z + s1.w))) * (1.f / QL) + EPS); } }
    if (IN(6)) ph_dilated_mfma(F, (const h16*)(ws + OFF_QB), (const h16*)(ws + OFF_KB), (const h16*)(ws + OFF_VT), (h16*)(ws + OFF_OG), (float*)(ws + OFF_LSE));
    SEAM(6);
    if (IN(7)) { pg8::Gemm g{(const h16*)(ws + OFF_CQ), (const h16*)(ws + OW_4), MT, N4, QL}; pg8::StaticOrder S; S.init(MT, N4, F.G, (int)blockIdx.x);
        pg8::Epi4 E{(h16*)(ws + OFF_QLAT), (h16*)(ws + OFF_QR), (h16*)(ws + OFF_QI), (const float*)(ws + OFF_RSTDQ), tab};
        pg8::gemm_phase<pg8::Epi4, true>(F.lds, g, S, E, F.wave);
        if (F.G == 256 && blockIdx.x >= 128) {
            Frame F2 = F; F2.gw = ((int)blockIdx.x - 128) * NWAVES + F.wave; F2.NGW = 128 * NWAVES; LAS float* scr = (LAS float*)(F.lds + F.wave * 16384);
            tr_job_plain(F2, args.in[11] + C_GATE, DIN, 2048, DM, ws + OW_GATE, scr, 0);
            tr_job_plain(F2, args.in[19], DM, DM, 256, (h16*)(ws + OW_UPB), scr, 512);
            tr_job_plain(F2, args.in[20], DM, DM, DM, (h16*)(ws + OW_O), scr, 640);
            tr_job_plain(F2, args.in[18], DM, DM, 512, (h16*)(ws + OW_UPA), scr, 256);
            for (int it = F2.gw; it < 4 * 16; it += F2.NGW) { const int kb = it >> 4, nb = it & 15, n0 = nb * 32, hl = (n0 >> 6) & 3;
                tr_item(args.in[16], 512, n0 + (F.lane & 31), true, nullptr, kb * 64, (h16*)(ws + OW_BD) + (size_t)n0 * 1024 + 256 * hl, 1024, scr, F.lane); } } }
    SEAM(7);
    if (IN(8)) { ph_combine(F, (const h16*)(ws + OFF_OG), (const float*)(ws + OFF_LSE), (h16*)(ws + OFF_OB));
        ph_topk_sparse(F, (const h16*)(ws + OFF_QI), (const h16*)(ws + OFF_KI), (const float*)(ws + OFF_WI), (unsigned short*)(ws + OFF_SEL),
                       (h16*)(ws + OFF_QLAT), (const h16*)(ws + OFF_QR), (const unsigned char*)(ws + OFF_CKV), (const unsigned char*)(ws + OFF_KR)); }
    SEAM(8);
    if (IN(9) && F.G == 256) { const bool first = blockIdx.x < 128;
        pg8::Gemm g{first ? (const h16*)(ws + OFF_QLAT) : (const h16*)(ws + OFF_OB), first ? (const h16*)(ws + OW_BD) : (const h16*)(ws + OW_UPB), MT, first ? 512 : DM, first ? 1024 : 256, first ? 2048 : 0, first ? 1024 : 0};
        pg8::StaticOrder S; S.init(MT, first ? 512 : DM, 128, first ? (int)blockIdx.x : (int)blockIdx.x - 128);
        pg8::EpiH16 E{first ? (h16*)(ws + OFF_OA) : (h16*)(ws + OFF_Y2), first ? 512 : DM};
        pg8::gemm_phase<pg8::EpiH16, false>(F.lds, g, S, E, F.wave); }
    SEAM(9);
    if (IN(10)) { pg8::StaticOrder S; S.init(MT, DM, F.G, (int)blockIdx.x); h16* Y1 = (h16*)(ws + OFF_Y1); h16* Y2 = (h16*)(ws + OFF_Y2);
        { pg8::Gemm g{(const h16*)(ws + OFF_OA), (const h16*)(ws + OW_UPA), MT, DM, 512}; pg8::EpiH16 E{Y1}; pg8::gemm_phase<pg8::EpiH16, false>(F.lds, g, S, E, F.wave); }
        const h16* u8 = (const h16*)((const unsigned char*)args.out + 32 * MiB);
        { pg8::Gemm g{u8, (const h16*)(ws + OW_GATE), MT, DM, DM / 2}; pg8::EpiGate E{Y1, Y1, 0, -LOG2E * F8_INV}; pg8::gemm_phase<pg8::EpiGate, false, true>(F.lds, g, S, E, F.wave); }
        { pg8::Gemm g{u8, (const h16*)(ws + OW_GATE + (size_t)DM * DM), MT, DM, DM / 2}; pg8::EpiGate E{Y2, Y1, 1, -LOG2E * F8_INV}; pg8::gemm_phase<pg8::EpiGate, false, true>(F.lds, g, S, E, F.wave); } }
    SEAM(10);
    if (IN(11)) { pg8::Gemm g{(const h16*)(ws + OFF_Y1), (const h16*)(ws + OW_O), MT, DM, DM}; pg8::StaticOrder S; S.init(MT, DM, F.G, (int)blockIdx.x); pg8::EpiH16 E{(h16*)(ws + OFF_YF)};
        pg8::gemm_phase<pg8::EpiH16, false>(F.lds, g, S, E, F.wave); }
    SEAM(11);
    if (IN(12)) ph_resnorm<true, true, unsigned char>(F, args.out, (const h16*)(ws + OFF_YF), args.in[21], mod, 5, 1.0f, ws + OFF_F, true, args.in[22], 7, 6, ws + OFF_H);
    SEAM(12);
    if (IN(13)) { pg8::Gemm g{Hb, (const h16*)(ws + OW_GU2), MT, 2 * FF, DM / 2}; pg8::StaticOrder S; S.init(MT, 2 * FF, F.G, (int)blockIdx.x); pg8::EpiSwiGLU_T<true> E{Ab};
        pg8::gemm_phase<pg8::EpiSwiGLU_T<true>, true, true>(F.lds, g, S, E, F.wave);
        if (F.G == 256 && blockIdx.x >= 128) { Frame F2 = F; F2.gw = ((int)blockIdx.x - 128) * NWAVES + F.wave; F2.NGW = 128 * NWAVES;
            tr_job_plain(F2, args.in[25], DM, DM, FF, ws + OW_D2, (LAS float*)(F.lds + F.wave * 16384), 0); } }
    SEAM(13);
    if (IN(14)) { pg8::Gemm g{Ab, (const h16*)(ws + OW_D2), MT, DM, FF / 2}; pg8::StaticOrder S; S.init(MT, DM, F.G, (int)blockIdx.x); pg8::EpiH16_T<true> E{(h16*)(ws + OFF_F + 32 * MiB)};
        pg8::gemm_phase<pg8::EpiH16_T<true>, false, true>(F.lds, g, S, E, F.wave); }
    SEAM(14);
    if (IN(15)) ph_resnorm<true, false>(F, ws + OFF_F, (const h16*)(ws + OFF_F + 32 * MiB), args.in[26], mod, 8, 0.5f, args.out, false, nullptr, 0, 0, (h16*)nullptr);
#undef IN
#undef SEAM
}


extern "C" void kernel_launch(void* const* d_in, const int* in_sizes, int n_in, void* d_out, int out_size, void* d_ws, size_t ws_size, hipStream_t stream) {
    if (n_in != 27 || ws_size < WS_END || out_size != MT * DM) { fprintf(stderr, "kernel_launch: unexpected shapes (n_in %d ws %zu out %d)\n", n_in, ws_size, out_size); return; }
    static int grid = 0;
    if (grid == 0) {
        int dev = 0, cus = 0, per_cu = 0;
        if (hipGetDevice(&dev) != hipSuccess || hipDeviceGetAttribute(&cus, hipDeviceAttributeMultiprocessorCount, dev) != hipSuccess) { grid = -1; return; }
        if (hipFuncSetAttribute((const void*)mega_fwd, hipFuncAttributeMaxDynamicSharedMemorySize, LDS_BYTES) != hipSuccess) { fprintf(stderr, "kernel_launch: hipFuncSetAttribute failed\n"); grid = -1; return; }
        if (hipOccupancyMaxActiveBlocksPerMultiprocessor(&per_cu, (const void*)mega_fwd, NTHR, LDS_BYTES) != hipSuccess || per_cu < 1) { fprintf(stderr, "kernel_launch: occupancy query says %d blocks/CU\n", per_cu); grid = -1; return; }
        grid = cus;
    }
    if (grid < 0) return;
    hipMemsetAsync((char*)d_ws + OFF_CTL, 0, 1 * MiB, stream);
    Args a{}; for (int i = 0; i < 27; ++i) a.in[i] = (const float*)d_in[i]; a.out = (float*)d_out; a.ws = (unsigned char*)d_ws; a.ph_lo = 0; a.ph_hi = 16;
    void* kargs[] = {&a};
#ifdef PH_DOUBLE
    a.ph_hi = PH_DOUBLE + 1; (void)hipLaunchCooperativeKernel((const void*)mega_fwd, dim3(grid), dim3(NTHR), kargs, LDS_BYTES, stream);
    hipMemsetAsync((char*)d_ws + OFF_CTL, 0, 1 * MiB, stream); a.ph_lo = PH_DOUBLE; a.ph_hi = 16;
#endif
    const hipError_t e = hipLaunchCooperativeKernel((const void*)mega_fwd, dim3(grid), dim3(NTHR), kargs, LDS_BYTES, stream);
    if (e != hipSuccess) fprintf(stderr, "kernel_launch: cooperative launch failed: %s (grid %d)\n", hipGetErrorString(e), grid);
    (void)in_sizes;
}
```

```cpp
#include <hip/hip_runtime.h>
#include <hip/hip_fp16.h>
#include <cstdio>
#include <cstdint>

constexpr int NB = 4, SEQ = 4096, DM = 1024, MT = NB * SEQ, FF = 2816;
constexpr int QL = 384, KVL = 256, DNOPE = 64, DROPE = 32, DVA = 64, HA = 8, HI = 8, DI = 32, TOPK = 256;
constexpr int NG = 3, HB = 4, DHB = 64, NMOD = 9, DIN = 5064;
constexpr int C_CQ = 0, C_CKV = 384, C_KR = 640, C_KI = 672, C_WI = 704, C_QKV = 712, C_GATE = 3016;
constexpr float EPS = 1e-6f, LOG2E = 1.4426950408889634f;
typedef _Float16 h16;

constexpr size_t MiB = 1u << 20;
constexpr size_t OFF_CTL = 0, OFF_MOD = 1 * MiB, OFF_ROPE = 2 * MiB, OFF_W = 8 * MiB, OFF_H = 60 * MiB, OFF_A = 92 * MiB, OFF_F = 180 * MiB, OFF_SP = 244 * MiB, WS_END = 256 * MiB;
constexpr size_t OFF_QB = OFF_A, OFF_KB = OFF_A + 24 * MiB, OFF_VT = OFF_A + 48 * MiB, OFF_CKV = OFF_A + 72 * MiB, OFF_KR = OFF_A + 80 * MiB, OFF_KI = OFF_A + 81 * MiB,
                 OFF_WI = OFF_A + 82 * MiB, OFF_SSQ = OFF_A + 82 * MiB + 512 * 1024, OFF_CQ = OFF_SP;
constexpr size_t OFF_RSTDQ = OFF_A + 83 * MiB;
constexpr size_t OFF_OG = OFF_F, OFF_LSE = OFF_F + 24 * MiB, OFF_QLAT = OFF_A, OFF_QR = OFF_A + 64 * MiB, OFF_QI = OFF_F + 25 * MiB, OFF_SEL = OFF_F + 33 * MiB, OFF_OB = OFF_SP;
constexpr size_t OFF_Y1 = OFF_F, OFF_Y2 = OFF_F + 32 * MiB, OFF_YF = OFF_A;

__device__ __forceinline__ float silu_f(float v) { return v / (1.f + __expf(-v)); }
__device__ __forceinline__ float sigm_f(float v) { return 1.f / (1.f + __expf(-v)); }
__host__ __device__ __forceinline__ int dil_of(int g) { return g == 0 ? 1 : (g == 1 ? 4 : 16); }
__device__ __forceinline__ unsigned fkey(float f) { const unsigned u = __float_as_uint(f); return (u & 0x80000000u) ? ~u : (u | 0x80000000u); }


#define LAS __attribute__((address_space(3)))
#define GAS __attribute__((address_space(1)))
typedef _Float16 f16x8 __attribute__((ext_vector_type(8)));
typedef float f32x4 __attribute__((ext_vector_type(4)));
typedef float f32x2 __attribute__((ext_vector_type(2)));
typedef unsigned u32x4 __attribute__((ext_vector_type(4)));
typedef unsigned u32x2 __attribute__((ext_vector_type(2)));
typedef _Float16 h16x2 __attribute__((ext_vector_type(2)));
__device__ __forceinline__ unsigned pk_h2(float lo, float hi) { f32x2 v = {lo, hi}; h16x2 h = __builtin_convertvector(v, h16x2); return __builtin_bit_cast(unsigned, h); }
__device__ __forceinline__ int flane() { int l; asm volatile("v_mbcnt_lo_u32_b32 %0, -1, 0\n\tv_mbcnt_hi_u32_b32 %0, -1, %0" : "=v"(l)); return l; }
__device__ __forceinline__ float sat8(float x) { return __builtin_amdgcn_fmed3f(x, -448.f, 448.f); }
__device__ __forceinline__ unsigned pk_f8x4(float a, float b, float c, float d) { int w = __builtin_amdgcn_cvt_pk_fp8_f32(sat8(a), sat8(b), 0, false); w = __builtin_amdgcn_cvt_pk_fp8_f32(sat8(c), sat8(d), w, true); return (unsigned)w; }
typedef int i32x4 __attribute__((ext_vector_type(4)));
typedef int i32x8 __attribute__((ext_vector_type(8)));
constexpr float F8_ACT = 8.f, F8_WGT = 512.f, F8_INV = 1.f / (F8_ACT * F8_WGT);

namespace pg8 {
constexpr int BM = 256, BK = 64, HALF = 128, HTB = HALF * BK * 2, STAGE_BYTES = 8 * HTB, NXCD = 8, WGM = 8;
__host__ __device__ __forceinline__ int lds_byte(int r, int c) { const int st = (r >> 4) * 2 + (c >> 5), rr = r & 15, cc = c & 31, ob = rr * 64 + cc * 2; return st * 1024 + (ob ^ (((ob >> 9) & 1) << 5)); }
__host__ __device__ __forceinline__ void stage_rc(int b, int& R, int& C) { const int st = b / 1024, sb = b % 1024, swz = sb ^ (((sb >> 9) & 1) << 5); R = (st >> 1) * 16 + swz / 64; C = (st & 1) * 32 + (swz % 64) / 2; }
__host__ __device__ __forceinline__ int perm32(int rho) { const int n = rho >> 4, i = rho & 15; return 8 * (i >> 2) + 4 * n + (i & 3); }
struct Unit { int pm, pn; };
struct Gemm { const h16* A; const h16* Bt; int M, N, K; int lda = 0, koffA = 0; };
struct StaticOrder {
    int nM, nN, nwg, G, c;
    __host__ __device__ void init(int M, int N, int G_, int c_) { nM = M / BM; nN = N / BM; nwg = nM * nN; G = G_; c = c_; }
    __host__ __device__ bool next(int i, Unit& u) const {
        const long L = (long)i * G + c; if (L >= nwg) return false;
        int wgid = (int)L; { const int q = nwg / NXCD, r = nwg % NXCD, xcd = wgid % NXCD, off = wgid / NXCD; wgid = (xcd < r ? xcd * (q + 1) : r * (q + 1) + (xcd - r) * q) + off; }
        const int nig = WGM * nN, gid = wgid / nig, fm = gid * WGM, gsz = (nM - fm) < WGM ? (nM - fm) : WGM;
        u.pm = fm + ((wgid % nig) % gsz); u.pn = (wgid % nig) / gsz; return true;
    }
};
template <class Epi, bool ALIGN_EPI, bool F8 = false>
__device__ __forceinline__ void gemm_phase(LAS unsigned char* lds, const Gemm g, const StaticOrder& S, const Epi& E, const int wid) {
    const int lane = flane(), tid = wid * 64 + lane, wr = wid >> 2, wc = wid & 3, fr = lane & 15, fq = lane >> 4;
    const int K = g.K, lda = g.lda ? g.lda : g.K; int nt = K / BK;
    if constexpr (F8) asm volatile("" : "+s"(nt));
    unsigned voffA[2], voffB[2];
#pragma unroll
    for (int i = 0; i < 2; ++i) { int R, C; stage_rc(tid * 16 + i * 8192, R, C); const int Rb = Epi::PERM ? ((R & ~31) + perm32(R & 31)) : R;
        voffA[i] = (unsigned)(R * lda + C) * 2u; voffB[i] = (unsigned)(Rb * K + C) * 2u; }
    const size_t kstep = (size_t)(BK * 2);
    const size_t hstep = (size_t)HALF * K * 2, hstepA = (size_t)HALF * lda * 2;
    const size_t tstep = 2 * hstep, tstepA = 2 * hstepA, kofA = (size_t)g.koffA * 2;
    const unsigned ldsw = (unsigned)wid * 1024u;
    const int aoff = lds_byte(wr * 64 + fr, fq * 8), boff = lds_byte(wc * 32 + fr, fq * 8);
#define PG8_SA(b, h) (((b) * 2 + (h)) * HTB)
#define PG8_SB(b, h) ((4 + (b) * 2 + (h)) * HTB)
#define PG8_STAGE(bufoff, gbase, voff) do { _Pragma("unroll") for (int _i = 0; _i < 2; ++_i) { unsigned _vo = (voff)[_i]; asm volatile("" : "+v"(_vo)); \
        __builtin_amdgcn_global_load_lds((const unsigned*)((const char*)(gbase) + _vo), (LAS unsigned*)(lds + (bufoff) + ldsw + _i * 8192), 16, 0, 0); } } while (0)
#define PG8_LDA(dst, b, h) do { _Pragma("unroll") for (int m = 0; m < 4; ++m) _Pragma("unroll") for (int k = 0; k < 2; ++k) dst[m][k] = *(const LAS f16x8*)(lds + PG8_SA(b, h) + aoff + m * 2048 + k * 1024); } while (0)
#define PG8_LDB(dst, b, h) do { _Pragma("unroll") for (int n = 0; n < 2; ++n) _Pragma("unroll") for (int k = 0; k < 2; ++k) dst[n][k] = *(const LAS f16x8*)(lds + PG8_SB(b, h) + boff + n * 2048 + k * 1024); } while (0)
#define PG8_CAT8(x, y) __builtin_shufflevector(__builtin_bit_cast(i32x4, x), __builtin_bit_cast(i32x4, y), 0, 1, 2, 3, 4, 5, 6, 7)
#define PG8_MMA(ai, bj, At, Bt) do { __builtin_amdgcn_s_setprio(1); \
        if constexpr (F8) { _Pragma("unroll") for (int m = 0; m < 4; ++m) _Pragma("unroll") for (int n = 0; n < 2; ++n) \
            acc[ai][bj][m][n] = __builtin_amdgcn_mfma_scale_f32_16x16x128_f8f6f4(PG8_CAT8(Bt[n][0], Bt[n][1]), PG8_CAT8(At[m][0], At[m][1]), acc[ai][bj][m][n], 0, 0, 0, 0, 0, 0); } \
        else { _Pragma("unroll") for (int m = 0; m < 4; ++m) _Pragma("unroll") for (int n = 0; n < 2; ++n) _Pragma("unroll") for (int k = 0; k < 2; ++k) \
            acc[ai][bj][m][n] = __builtin_amdgcn_mfma_f32_16x16x32_f16(Bt[n][k], At[m][k], acc[ai][bj][m][n], 0, 0, 0); } \
        __builtin_amdgcn_s_setprio(0); } while (0)
#define PG8_WAIT_V(n) asm volatile("s_waitcnt vmcnt(" #n ")" ::: "memory")
#define PG8_WAIT_L(n) asm volatile("s_waitcnt lgkmcnt(" #n ")" ::: "memory")
#define PG8_BAR __builtin_amdgcn_s_barrier()
#define PG8_SCHED __builtin_amdgcn_sched_barrier(0)
    Unit cur, nxt; int ui = 0;
    if (!S.next(0, cur)) return;
    f32x4 acc[2][2][4][2];
#pragma unroll
    for (int a = 0; a < 2; ++a)
#pragma unroll
        for (int b = 0; b < 2; ++b)
#pragma unroll
            for (int m = 0; m < 4; ++m)
#pragma unroll
                for (int n = 0; n < 2; ++n) acc[a][b][m][n] = (f32x4){0.f, 0.f, 0.f, 0.f};
    f16x8 At[4][2], B0[2][2], B1[2][2];
    const char* cA = (const char*)g.A + (size_t)cur.pm * tstepA + (size_t)cur.pn * kofA; const char* cB = (const char*)g.Bt + (size_t)cur.pn * tstep;
    PG8_STAGE(PG8_SB(0, 0), cB, voffB); PG8_STAGE(PG8_SB(0, 1), cB + hstep, voffB); PG8_STAGE(PG8_SA(0, 0), cA, voffA); PG8_STAGE(PG8_SA(0, 1), cA + hstepA, voffA);
    if (wr == 1) PG8_BAR;
    PG8_WAIT_V(2); PG8_BAR;
    PG8_STAGE(PG8_SB(1, 0), cB + kstep, voffB); PG8_STAGE(PG8_SA(1, 0), cA + kstep, voffA); PG8_STAGE(PG8_SB(1, 1), cB + hstep + kstep, voffB);
    PG8_WAIT_V(6); PG8_BAR;
    for (;;) {
        const bool has_next = S.next(ui + 1, nxt);
        const char* nA = has_next ? (const char*)g.A + (size_t)nxt.pm * tstepA + (size_t)nxt.pn * kofA : cA; const char* nB = has_next ? (const char*)g.Bt + (size_t)nxt.pn * tstep : cB;
        for (int t = 0; t < nt; t += 2) {
            const bool last = (t == nt - 2);
            const char* a1 = cA + (size_t)(t + 1) * kstep;
            const char* a2 = last ? nA : cA + (size_t)(t + 2) * kstep; const char* b2 = last ? nB : cB + (size_t)(t + 2) * kstep;
            const char* a3 = a2 + kstep; const char* b3 = b2 + kstep;
            PG8_LDB(B0, 0, 0); PG8_LDB(B1, 0, 1); PG8_SCHED; PG8_LDA(At, 0, 0); PG8_STAGE(PG8_SA(1, 1), a1 + hstepA, voffA);
            PG8_WAIT_V(8); PG8_WAIT_L(0); PG8_BAR; PG8_MMA(0, 0, At, B0); PG8_MMA(0, 1, At, B1); PG8_BAR; PG8_SCHED;
            PG8_LDA(At, 0, 1); PG8_STAGE(PG8_SB(0, 0), b2, voffB); PG8_STAGE(PG8_SB(0, 1), b2 + hstep, voffB); PG8_STAGE(PG8_SA(0, 0), a2, voffA);
            PG8_WAIT_V(8); PG8_WAIT_L(0); PG8_BAR; PG8_MMA(1, 0, At, B0); PG8_MMA(1, 1, At, B1); PG8_BAR; PG8_SCHED;
            PG8_LDB(B0, 1, 0); PG8_LDB(B1, 1, 1); PG8_SCHED; PG8_LDA(At, 1, 0); PG8_STAGE(PG8_SA(0, 1), a2 + hstepA, voffA);
            PG8_WAIT_V(8); PG8_WAIT_L(0); PG8_BAR; PG8_MMA(0, 0, At, B0); PG8_MMA(0, 1, At, B1); PG8_BAR; PG8_SCHED;
            PG8_LDA(At, 1, 1); PG8_STAGE(PG8_SB(1, 0), b3, voffB); PG8_STAGE(PG8_SB(1, 1), b3 + hstep, voffB); PG8_STAGE(PG8_SA(1, 0), a3, voffA);
            PG8_WAIT_V(8); PG8_WAIT_L(0); PG8_BAR; PG8_MMA(1, 0, At, B0); PG8_MMA(1, 1, At, B1); PG8_BAR; PG8_SCHED;
        }
        if constexpr (ALIGN_EPI) { if (wr == 0) PG8_BAR; }
        { const int l2 = flane(); E(acc, cur, wr, wc, l2 & 15, l2 >> 4); }
        if (!has_next) break;
#pragma unroll
        for (int a = 0; a < 2; ++a)
#pragma unroll
            for (int b = 0; b < 2; ++b)
#pragma unroll
                for (int m = 0; m < 4; ++m)
#pragma unroll
                    for (int n = 0; n < 2; ++n) acc[a][b][m][n] = (f32x4){0.f, 0.f, 0.f, 0.f};
        cur = nxt; cA = nA; cB = nB; ++ui;
        if constexpr (ALIGN_EPI) { if (wr == 1) PG8_BAR; }
    }
    PG8_WAIT_V(0);
    if constexpr (!ALIGN_EPI) { if (wr == 0) PG8_BAR; }
    PG8_BAR;
#undef PG8_SA
#undef PG8_SB
#undef PG8_STAGE
#undef PG8_LDA
#undef PG8_LDB
#undef PG8_MMA
#undef PG8_CAT8
#undef PG8_WAIT_V
#undef PG8_WAIT_L
#undef PG8_BAR
#undef PG8_SCHED
}
struct EpiF32 {
    static constexpr bool PERM = false;
    float* C; int ldc;
    __device__ __forceinline__ void operator()(const f32x4 (&acc)[2][2][4][2], const Unit& u, int wr, int wc, int fr, int fq) const {
        const int row0 = u.pm * BM + wr * 64 + fr, col0 = u.pn * BM + wc * 32 + 4 * fq;
#pragma unroll
        for (int ai = 0; ai < 2; ++ai)
#pragma unroll
            for (int m = 0; m < 4; ++m) { float* rowp = C + (size_t)(row0 + ai * HALF + m * 16) * ldc + col0;
#pragma unroll
                for (int bj = 0; bj < 2; ++bj)
#pragma unroll
                    for (int n = 0; n < 2; ++n) *(f32x4*)(rowp + bj * HALF + n * 16) = acc[ai][bj][m][n]; }
    }
};
template <bool F8>
struct EpiSwiGLU_T {
    static constexpr bool PERM = true;
    void* O;
    __device__ __forceinline__ void operator()(const f32x4 (&acc)[2][2][4][2], const Unit& u, int wr, int wc, int fr, int fq) const {
        const int row0 = u.pm * BM + wr * 64 + fr, col0 = u.pn * HALF + wc * 32 + 8 * fq;
#pragma unroll
        for (int ai = 0; ai < 2; ++ai)
#pragma unroll
            for (int m = 0; m < 4; ++m) { const size_t eo = (size_t)(row0 + ai * HALF + m * 16) * FF + col0;
                float v[8];
#pragma unroll
                for (int n = 0; n < 2; ++n)
#pragma unroll
                    for (int e = 0; e < 4; ++e) { float gg = acc[ai][0][m][n][e], uu = acc[ai][1][m][n][e]; if constexpr (F8) { gg *= F8_INV; uu *= F8_INV * F8_ACT; }
                        v[n * 4 + e] = gg * __builtin_amdgcn_rcpf(1.f + __builtin_amdgcn_exp2f(-gg * LOG2E)) * uu; }
                if constexpr (F8) { u32x2 w; w.x = pk_f8x4(v[0], v[1], v[2], v[3]); w.y = pk_f8x4(v[4], v[5], v[6], v[7]); *(u32x2*)((unsigned char*)O + eo) = w; }
                else { u32x4 w; w.x = pk_h2(v[0], v[1]); w.y = pk_h2(v[2], v[3]); w.z = pk_h2(v[4], v[5]); w.w = pk_h2(v[6], v[7]); *(u32x4*)((h16*)O + eo) = w; } }
    }
};
typedef EpiSwiGLU_T<false> EpiSwiGLU;

struct EpiIn {
    static constexpr bool PERM = false;
    h16 *ckv, *cq, *kr, *ki, *qb, *kb, *vT; float *wi, *ssq; const float* gckv; const float2* tab; LAS float* X;
    __device__ __forceinline__ void rope64(const f32x4 (&acc)[2][2][4][2], const Unit& u, int wr, int wc, int fr, int fq, h16* dst, int tl, float scale) const {
        const int tok0 = u.pm * BM + wr * 64 + fr;
        f32x4 tc[4], tn[4];
        { const f32x4* tp = (const f32x4*)(tab + (size_t)tok0 * 48 + 4 * fq); tc[0] = tp[0]; tc[1] = tp[1]; tc[2] = tp[8]; tc[3] = tp[9]; }
#pragma unroll
        for (int rr = 0; rr < 8; ++rr) { const int ai = rr >> 2, m = rr & 3, tok = tok0 + ai * HALF + m * 16;
            if (rr < 7) { const int tokn = tok0 + ((rr + 1) >> 2) * HALF + ((rr + 1) & 3) * 16; const f32x4* tp = (const f32x4*)(tab + (size_t)tokn * 48 + 4 * fq); tn[0] = tp[0]; tn[1] = tp[1]; tn[2] = tp[8]; tn[3] = tp[9]; }
#pragma unroll
            for (int n = 0; n < 2; ++n) { const int i = 16 * n + 4 * fq; const f32x4 t0 = tc[2 * n], t1 = tc[2 * n + 1];
                const f32x4 cs = {t0.x, t0.z, t1.x, t1.z}, sn = {t0.y, t0.w, t1.y, t1.w}, x1 = acc[ai][0][m][n], x2 = acc[ai][1][m][n];
                const f32x4 o1 = (x1 * cs - x2 * sn) * scale, o2 = (x2 * cs + x1 * sn) * scale;
                h16* p = dst + (size_t)tok * 768 + (4 * tl + wc) * 64 + i;
                u32x2 w1, w2; w1.x = pk_h2(o1.x, o1.y); w1.y = pk_h2(o1.z, o1.w); w2.x = pk_h2(o2.x, o2.y); w2.y = pk_h2(o2.z, o2.w);
                *(u32x2*)p = w1; *(u32x2*)(p + 32) = w2; }
#pragma unroll
            for (int k = 0; k < 4; ++k) tc[k] = tn[k];
            asm volatile("" ::: "memory"); }
    }
    __device__ __forceinline__ void operator()(const f32x4 (&acc)[2][2][4][2], const Unit& u, int wr, int wc, int fr, int fq) const {
        const int pn = u.pn;
        if (pn == 0) {
#pragma unroll
            for (int ai = 0; ai < 2; ++ai)
#pragma unroll
                for (int m = 0; m < 4; ++m) { float sq = 0.f;
#pragma unroll
                    for (int bj = 0; bj < 2; ++bj)
#pragma unroll
                        for (int n = 0; n < 2; ++n) { const f32x4 v = acc[ai][bj][m][n]; sq += (v.x * v.x + v.y * v.y) + (v.z * v.z + v.w * v.w); }
                    sq += __shfl_xor(sq, 16); sq += __shfl_xor(sq, 32);
                    if (fq == 0) X[(ai * HALF + wr * 64 + m * 16 + fr) * 4 + wc] = sq; }
            asm volatile("s_waitcnt lgkmcnt(0)" ::: "memory"); __builtin_amdgcn_s_barrier(); asm volatile("" ::: "memory");
#pragma unroll
            for (int ai = 0; ai < 2; ++ai)
#pragma unroll
                for (int m = 0; m < 4; ++m) { const int rl = ai * HALF + wr * 64 + m * 16 + fr, tok = u.pm * BM + rl; const f32x4 p = *(const LAS f32x4*)(X + rl * 4);
                    const float rstd = rsqrtf(((p.x + p.y) + (p.z + p.w)) * (1.f / KVL) + EPS);
#pragma unroll
                    for (int bj = 0; bj < 2; ++bj)
#pragma unroll
                        for (int n = 0; n < 2; ++n) { const int col = bj * HALF + wc * 32 + n * 16 + 4 * fq; const f32x4 o = acc[ai][bj][m][n] * rstd * *(const f32x4*)(gckv + col);
                            int w8 = __builtin_amdgcn_cvt_pk_fp8_f32(o.x, o.y, 0, false); w8 = __builtin_amdgcn_cvt_pk_fp8_f32(o.z, o.w, w8, true);
                            *(int*)((unsigned char*)ckv + (size_t)tok * KVL + col) = w8; }
                    asm volatile("" ::: "memory"); }
            asm volatile("s_waitcnt lgkmcnt(0)" ::: "memory"); __builtin_amdgcn_s_barrier(); asm volatile("" ::: "memory");
        } else if (pn <= 2) {
#pragma unroll
            for (int ai = 0; ai < 2; ++ai)
#pragma unroll
                for (int m = 0; m < 4; ++m) { const int tok = u.pm * BM + ai * HALF + wr * 64 + m * 16 + fr; float sq = 0.f;
#pragma unroll
                    for (int bj = 0; bj < 2; ++bj) { if (pn == 2 && bj == 1) break;
#pragma unroll
                        for (int n = 0; n < 2; ++n) { const f32x4 v = acc[ai][bj][m][n]; sq += (v.x * v.x + v.y * v.y) + (v.z * v.z + v.w * v.w);
                            const int col = (pn - 1) * 256 + bj * HALF + wc * 32 + n * 16 + 4 * fq; u32x2 w; w.x = pk_h2(v.x, v.y); w.y = pk_h2(v.z, v.w); *(u32x2*)(cq + (size_t)tok * QL + col) = w; } }
                    sq += __shfl_xor(sq, 16); sq += __shfl_xor(sq, 32);
                    if (fq == 0) ssq[tok * 8 + (pn - 1) * 4 + wc] = sq;
                    if (pn == 2) {
                        if (wc < 2) { const int i = 4 * fq; const f32x4* tp = (const f32x4*)(tab + (size_t)tok * 48 + 32 + i); const f32x4 t0 = tp[0], t1 = tp[1];
                            const f32x4 cs = {t0.x, t0.z, t1.x, t1.z}, sn = {t0.y, t0.w, t1.y, t1.w}, x1 = acc[ai][1][m][0], x2 = acc[ai][1][m][1];
                            const f32x4 o1 = x1 * cs - x2 * sn, o2 = x2 * cs + x1 * sn;
                            if (wc == 0) { unsigned char* p8 = (unsigned char*)kr + (size_t)tok * 32 + i;
                                int a8 = __builtin_amdgcn_cvt_pk_fp8_f32(o1.x, o1.y, 0, false); a8 = __builtin_amdgcn_cvt_pk_fp8_f32(o1.z, o1.w, a8, true);
                                int b8 = __builtin_amdgcn_cvt_pk_fp8_f32(o2.x, o2.y, 0, false); b8 = __builtin_amdgcn_cvt_pk_fp8_f32(o2.z, o2.w, b8, true);
                                *(int*)p8 = a8; *(int*)(p8 + 16) = b8; }
                            else { h16* p = ki + (size_t)tok * 32 + i;
                                u32x2 w1, w2; w1.x = pk_h2(o1.x, o1.y); w1.y = pk_h2(o1.z, o1.w); w2.x = pk_h2(o2.x, o2.y); w2.y = pk_h2(o2.z, o2.w);
                                *(u32x2*)p = w1; *(u32x2*)(p + 16) = w2; } }
                        else if (wc == 2 && fq < 2) { *(f32x4*)(wi + tok * 8 + 4 * fq) = acc[ai][1][m][0] * 0.35355339059327373f; }
                    }
                    asm volatile("" ::: "memory"); }
        } else if (pn <= 5) rope64(acc, u, wr, wc, fr, fq, qb, pn - 3, 0.125f * LOG2E);
        else if (pn <= 8) rope64(acc, u, wr, wc, fr, fq, kb, pn - 6, 1.0f);
        else {
#pragma unroll
            for (int ai = 0; ai < 2; ++ai)
#pragma unroll
                for (int m = 0; m < 4; ++m) { const int tok = u.pm * BM + ai * HALF + wr * 64 + m * 16 + fr;
#pragma unroll
                    for (int bj = 0; bj < 2; ++bj)
#pragma unroll
                        for (int n = 0; n < 2; ++n) { const f32x4 v = acc[ai][bj][m][n]; u32x2 w; w.x = pk_h2(v.x, v.y); w.y = pk_h2(v.z, v.w);
                            *(u32x2*)(vT + (size_t)tok * 768 + (pn - 9) * 256 + bj * HALF + wc * 32 + n * 16 + 4 * fq) = w; }
                    asm volatile("" ::: "memory"); }
        }
    }
};
struct Epi4 {
    static constexpr bool PERM = true;
    h16 *qlat, *qr, *qi; const float* rstdq; const float2* tab;
    __device__ __forceinline__ void operator()(const f32x4 (&acc)[2][2][4][2], const Unit& u, int wr, int wc, int fr, int fq) const {
        const int pn = u.pn; const float c2 = 0.10206207261596575f * LOG2E;
        const int tok0 = u.pm * BM + wr * 64 + fr;
        float rc = rstdq[tok0], rn = 0.f;
        if (pn < 8) {
#pragma unroll
            for (int rr = 0; rr < 8; ++rr) { const int ai = rr >> 2, m = rr & 3, tok = tok0 + ai * HALF + m * 16;
                if (rr < 7) rn = rstdq[tok0 + ((rr + 1) >> 2) * HALF + ((rr + 1) & 3) * 16];
#pragma unroll
                for (int bj = 0; bj < 2; ++bj) { const f32x4 o0 = acc[ai][bj][m][0] * (rc * c2), o1 = acc[ai][bj][m][1] * (rc * c2);
                    u32x4 w; w.x = pk_h2(o0.x, o0.y); w.y = pk_h2(o0.z, o0.w); w.z = pk_h2(o1.x, o1.y); w.w = pk_h2(o1.z, o1.w);
                    *(u32x4*)(qlat + (size_t)tok * 2048 + pn * 256 + bj * HALF + wc * 32 + 8 * fq) = w; }
                rc = rn; asm volatile("" ::: "memory"); }
        } else { h16* dst = (pn == 8) ? qr : qi; const float c2e = (pn == 8) ? c2 : 1.f; const int i = 4 * fq;
            f32x4 tc[2], tn[2];
            { const f32x4* tp = (const f32x4*)(tab + (size_t)tok0 * 48 + 32 + i); tc[0] = tp[0]; tc[1] = tp[1]; }
#pragma unroll
            for (int rr = 0; rr < 8; ++rr) { const int ai = rr >> 2, m = rr & 3, tok = tok0 + ai * HALF + m * 16;
                if (rr < 7) { const int tokn = tok0 + ((rr + 1) >> 2) * HALF + ((rr + 1) & 3) * 16; const f32x4* tp = (const f32x4*)(tab + (size_t)tokn * 48 + 32 + i); tn[0] = tp[0]; tn[1] = tp[1]; rn = rstdq[tokn]; }
                const f32x4 cs = {tc[0].x, tc[0].z, tc[1].x, tc[1].z}, sn = {tc[0].y, tc[0].w, tc[1].y, tc[1].w}; const float sc = rc * c2e;
#pragma unroll
                for (int bj = 0; bj < 2; ++bj) { const f32x4 x1 = acc[ai][bj][m][0], x2 = acc[ai][bj][m][1]; const f32x4 o1 = (x1 * cs - x2 * sn) * sc, o2 = (x2 * cs + x1 * sn) * sc;
                    h16* p = dst + (size_t)tok * 256 + (4 * bj + wc) * 32 + i;
                    u32x2 w1, w2; w1.x = pk_h2(o1.x, o1.y); w1.y = pk_h2(o1.z, o1.w); w2.x = pk_h2(o2.x, o2.y); w2.y = pk_h2(o2.z, o2.w);
                    *(u32x2*)p = w1; *(u32x2*)(p + 16) = w2; }
                tc[0] = tn[0]; tc[1] = tn[1]; rc = rn;
                asm volatile("" ::: "memory"); } }
    }
};
__device__ __forceinline__ u32x4 ld16_l2(const h16* p) {
    const unsigned long long a = __hip_atomic_load((const unsigned long long*)p, __ATOMIC_RELAXED, __HIP_MEMORY_SCOPE_AGENT), b = __hip_atomic_load((const unsigned long long*)p + 1, __ATOMIC_RELAXED, __HIP_MEMORY_SCOPE_AGENT);
    return (u32x4){(unsigned)a, (unsigned)(a >> 32), (unsigned)b, (unsigned)(b >> 32)};
}
typedef _Float16 h16x8 __attribute__((ext_vector_type(8)));
__device__ __forceinline__ void unpk8(const u32x4 w, float (&f)[8]) {
    const h16x8 h = __builtin_bit_cast(h16x8, w);
#pragma unroll
    for (int i = 0; i < 8; ++i) f[i] = (float)h[i];
}
template <bool SC>
struct EpiH16_T {
    static constexpr bool PERM = true;
    h16* O; int ldc = DM;
    __device__ __forceinline__ void operator()(const f32x4 (&acc)[2][2][4][2], const Unit& u, int wr, int wc, int fr, int fq) const {
        const int row0 = u.pm * BM + wr * 64 + fr, col0 = u.pn * BM + wc * 32 + 8 * fq;
#pragma unroll
        for (int ai = 0; ai < 2; ++ai)
#pragma unroll
            for (int m = 0; m < 4; ++m)
#pragma unroll
                for (int bj = 0; bj < 2; ++bj) { f32x4 v0 = acc[ai][bj][m][0], v1 = acc[ai][bj][m][1]; if constexpr (SC) { v0 *= F8_INV; v1 *= F8_INV; }
                    u32x4 w; w.x = pk_h2(v0.x, v0.y); w.y = pk_h2(v0.z, v0.w); w.z = pk_h2(v1.x, v1.y); w.w = pk_h2(v1.z, v1.w);
                    *(u32x4*)(O + (size_t)(row0 + ai * HALF + m * 16) * ldc + col0 + bj * HALF) = w; }
    }
};
typedef EpiH16_T<false> EpiH16;
struct EpiGate {
    static constexpr bool PERM = true;
    const h16* Y; h16* Z; int accum; float nls;
    __device__ __forceinline__ void operator()(const f32x4 (&acc)[2][2][4][2], const Unit& u, int wr, int wc, int fr, int fq) const {
        const int row0 = u.pm * BM + wr * 64 + fr, col0 = u.pn * BM + wc * 32 + 8 * fq;
#pragma unroll
        for (int ai = 0; ai < 2; ++ai)
#pragma unroll
            for (int m = 0; m < 4; ++m)
#pragma unroll
                for (int bj = 0; bj < 2; ++bj) { const size_t off = (size_t)(row0 + ai * HALF + m * 16) * DM + col0 + bj * HALF;
                    float y[8], zz[8]; unpk8(ld16_l2(Y + off), y);
                    if (accum) unpk8(ld16_l2(Z + off), zz); else {
#pragma unroll
                        for (int i = 0; i < 8; ++i) zz[i] = 0.f; }
                    float o[8];
#pragma unroll
                    for (int n = 0; n < 2; ++n)
#pragma unroll
                        for (int e = 0; e < 4; ++e) { const float gg = acc[ai][bj][m][n][e]; o[n * 4 + e] = zz[n * 4 + e] + y[n * 4 + e] * __builtin_amdgcn_rcpf(1.f + __builtin_amdgcn_exp2f(gg * nls)); }
                    u32x4 w; w.x = pk_h2(o[0], o[1]); w.y = pk_h2(o[2], o[3]); w.z = pk_h2(o[4], o[5]); w.w = pk_h2(o[6], o[7]);
                    *(u32x4*)(Z + off) = w; }
    }
};
}

#define XB_TMO      128
#define XB_XCNT(j)  (256  + 64 * (j))
#define XB_XSUB(j)  (1280 + 64 * (j))
#define XB_XGEN(j)  (2304 + 64 * (j))
#define XB_TOP      3328
#define XB_TOPGEN   3392
#define XCD_BAR_WORDS 3456
#define XB_SPIN_CAP (1u << 18)
__device__ __forceinline__ unsigned xb_ld(unsigned* p)              { return __hip_atomic_load(p, __ATOMIC_RELAXED, __HIP_MEMORY_SCOPE_AGENT); }
__device__ __forceinline__ unsigned xb_add(unsigned* p, unsigned v) { return __hip_atomic_fetch_add(p, v, __ATOMIC_RELAXED, __HIP_MEMORY_SCOPE_AGENT); }
__device__ __forceinline__ unsigned xb_xcc_id() { return (unsigned)__builtin_amdgcn_s_getreg((3 << 11) | 20) & 0xFu; }
#define XB_SPIN(cond, bar) do { unsigned _sp = 0; while (cond) { __builtin_amdgcn_s_sleep(1); \
    if ((++_sp & 255u) == 0u) { if (xb_ld(&(bar)[XB_TMO])) break; if (_sp > XB_SPIN_CAP) { atomicAdd(&(bar)[XB_TMO], 1u); break; } } } } while (0)
struct XcdBarrier { unsigned* bar; unsigned x; volatile LAS unsigned* st; int wave; };
__device__ __forceinline__ XcdBarrier xcd_barrier_post(unsigned* bar, volatile LAS unsigned* st, int wave) {
    XcdBarrier b; b.bar = bar; b.x = xb_xcc_id(); b.st = st; b.wave = wave;
    if (wave == 0 && flane() == 0) (void)xb_add(&bar[XB_XCNT(b.x)], 1u);
    return b;
}
__device__ __forceinline__ void xcd_barrier_complete(unsigned* bar, unsigned x, unsigned& nloc, unsigned& nx) {
    const unsigned G = gridDim.x * gridDim.y * gridDim.z;
    unsigned sum, cnt, mine, sp = 0u;
    for (;;) {
        sum = 0u; cnt = 0u; mine = 0u;
#pragma unroll
        for (unsigned j = 0; j < 16; ++j) { const unsigned c = xb_ld(&bar[XB_XCNT(j)]); sum += c; cnt += (c > 0u) ? 1u : 0u; mine = (j == x) ? c : mine; }
        if (sum == G) break;
        __builtin_amdgcn_s_sleep(1);
        if ((++sp & 255u) == 0u) { if (xb_ld(&bar[XB_TMO])) break; if (sp > XB_SPIN_CAP) { atomicAdd(&bar[XB_TMO], 1u); break; } }
    }
    nloc = mine > 0u ? mine : 1u; nx = cnt > 0u ? cnt : 1u;
}
__device__ __forceinline__ void xcd_barrier(const XcdBarrier& b) {
    asm volatile("s_waitcnt vmcnt(0)" ::: "memory");
    __syncthreads();
    if (b.wave == 0 && flane() == 0) {
        unsigned* bar = b.bar;
        __builtin_amdgcn_s_waitcnt(0);
        unsigned nloc = b.st[0], nx = b.st[1];
        if (nloc == 0u) { xcd_barrier_complete(bar, b.x, nloc, nx); b.st[0] = nloc; b.st[1] = nx; }
        const unsigned old = xb_add(&bar[XB_XSUB(b.x)], 1u);
        const unsigned gen = old / nloc;
        if (old + 1u == (gen + 1u) * nloc) {
            __builtin_amdgcn_fence(__ATOMIC_RELEASE, "agent");
            asm volatile("s_waitcnt vmcnt(0)" ::: "memory");
            const unsigned og = xb_add(&bar[XB_TOP], 1u);
            const unsigned tg = og / nx;
            if (og + 1u == (tg + 1u) * nx) xb_add(&bar[XB_TOPGEN], 1u);
            else XB_SPIN(xb_ld(&bar[XB_TOPGEN]) == tg, bar);
            __builtin_amdgcn_fence(__ATOMIC_ACQUIRE, "agent");
            xb_add(&bar[XB_XGEN(b.x)], 1u);
            asm volatile("s_waitcnt vmcnt(0)" ::: "memory");
        } else {
            XB_SPIN(xb_ld(&bar[XB_XGEN(b.x)]) == gen, bar);
            __builtin_amdgcn_fence(__ATOMIC_ACQUIRE, "agent");
            asm volatile("s_waitcnt vmcnt(0)" ::: "memory");
        }
    }
    __syncthreads();
}

constexpr int NWAVES = 8, NTHR = 512;
constexpr int RING_BYTES = 131072, LDSCTL_OFF = RING_BYTES, MISC_OFF = LDSCTL_OFF + 320, LDS_BYTES = 147456;
constexpr int XCH_OFF = RING_BYTES + 1024;
constexpr int CW_BAR = 4096;
constexpr size_t OW_GU1 = OFF_W, OW_D1 = OW_GU1 + 11 * MiB, OW_IN = OW_D1 + (size_t)DM * FF * 2, OW_GATE = OW_IN + 6 * MiB, OW_4 = OW_GATE + 4 * MiB, OW_OV = OW_4 + 2 * MiB,
                 OW_UPB = OW_OV + 4 * MiB, OW_O = OW_UPB + MiB / 2, OW_GU2 = OW_O + 2 * MiB, OW_D2 = OW_GU2 + 11 * MiB, OW_END = OW_D2 + (size_t)DM * FF * 2;
static_assert(OW_END <= OFF_H, "weights region");
constexpr int NIN3 = 3072, N4 = 2560;
constexpr size_t OW_BD = OW_OV, OW_UPA = OW_OV + MiB, OFF_OA = OFF_A + 64 * MiB;

struct Args { const float* in[27]; float* out; unsigned char* ws; int ph_lo, ph_hi; };
struct Frame {
    LAS unsigned char* lds; int tid, lane, wave, G, gw, NGW;
};
__device__ __forceinline__ float wave_sum(float v) {
#pragma unroll
    for (int o = 1; o < 64; o <<= 1) v += __shfl_xor(v, o);
    return v;
}
__device__ __forceinline__ bool map_row(int job, int n, const Args& a, const float*& W, int& ldw, int& col) {
    if (job <= 1) { const int t = n >> 8, j = n & 255; W = a.in[(job == 0 ? 6 : 23) + (j >> 7)]; ldw = FF; col = t * 128 + (j & 127); return true; }
    if (job == 2) { W = a.in[11]; ldw = DIN; const int t = n >> 8, j = n & 255;
        if (t == 0) { col = C_CKV + j; return true; }
        if (t == 1) { col = j; return true; }
        if (t == 2) { if (j < 128) { col = 256 + j; return true; } if (j < 160) { col = C_KR + (j - 128); return true; } if (j < 192) { col = C_KI + (j - 160); return true; } if (j < 200) { col = C_WI + (j - 192); return true; } col = 0; return false; }
        if (t < 9) { const int c3 = (t - 3) / 3, tl = (t - 3) % 3, hl = (j & 127) >> 5, i = j & 31; col = C_QKV + c3 * 768 + (4 * tl + hl) * 64 + (j >> 7) * 32 + i; return true; }
        col = C_QKV + 1536 + (t - 9) * 256 + j; return true; }
    { const int n2 = n - 2048, r5 = n2 & 31, nat = 16 * ((r5 >> 2) & 1) + 4 * (r5 >> 3) + (r5 & 3);
      if (n2 < 256) { W = a.in[14]; ldw = 768; col = (n2 >> 5) * 96 + 64 + nat; } else { W = a.in[17]; ldw = 256; col = ((n2 - 256) & ~31) + nat; } return true; }
}
template <typename T>
__device__ __forceinline__ void tr_item(const float* W, int ldw, int col, bool valid, const float* scale, int k0, T* WTrow0, int K, LAS float* scr, int lane) {
    const int colc = valid ? col : 0; float vv[32];
#pragma unroll
    for (int i = 0; i < 32; ++i) vv[i] = W[(size_t)(k0 + 2 * i + (lane >> 5)) * ldw + colc];
    if (scale) {
#pragma unroll
        for (int i = 0; i < 32; ++i) vv[i] *= scale[k0 + 2 * i + (lane >> 5)]; }
#pragma unroll
    for (int i = 0; i < 32; ++i) scr[(2 * i + (lane >> 5)) * 33 + (lane & 31)] = valid ? vv[i] : 0.f;
    asm volatile("s_waitcnt lgkmcnt(0)" ::: "memory");
    const int c = lane & 7;
#pragma unroll
    for (int j = 0; j < 4; ++j) { const int n = (lane >> 3) + 8 * j; const LAS float* s = scr + (8 * c) * 33 + n;
        if constexpr (sizeof(T) == 1) { u32x2 o; o.x = pk_f8x4(s[0 * 33] * F8_WGT, s[1 * 33] * F8_WGT, s[2 * 33] * F8_WGT, s[3 * 33] * F8_WGT); o.y = pk_f8x4(s[4 * 33] * F8_WGT, s[5 * 33] * F8_WGT, s[6 * 33] * F8_WGT, s[7 * 33] * F8_WGT);
            *(u32x2*)(WTrow0 + (size_t)n * K + k0 + 8 * c) = o; }
        else { u32x4 o; o.x = pk_h2(s[0 * 33], s[1 * 33]); o.y = pk_h2(s[2 * 33], s[3 * 33]); o.z = pk_h2(s[4 * 33], s[5 * 33]); o.w = pk_h2(s[6 * 33], s[7 * 33]);
            *(u32x4*)(WTrow0 + (size_t)n * K + k0 + 8 * c) = o; } }
    asm volatile("s_waitcnt lgkmcnt(0)" ::: "memory");
}
template <typename T>
__device__ __forceinline__ void tr_job_mapped(const Frame& F, const Args& a, int job, int Ndest, int n_lo, int K, T* WT, const float* scale, LAS float* scr, int phase_off) {
    const int nblk = Ndest / 32, nitems = (K / 64) * nblk;
    for (int it = (F.gw + phase_off) % F.NGW; it < nitems; it += F.NGW) {
        const int kb = it / nblk, nb = it % nblk; const float* W; int ldw, col;
        const bool valid = map_row(job, n_lo + nb * 32 + (F.lane & 31), a, W, ldw, col);
        tr_item(W, ldw, col, valid, scale, kb * 64, WT + (size_t)(n_lo + nb * 32) * K, K, scr, F.lane);
    }
}
template <typename T>
__device__ __forceinline__ void tr_job_plain(const Frame& F, const float* W, int ldw, int Ndest, int K, T* WT, LAS float* scr, int phase_off) {
    const int nblk = Ndest / 32, nitems = (K / 64) * nblk;
    for (int it = (F.gw + phase_off) % F.NGW; it < nitems; it += F.NGW) {
        const int kb = it / nblk, nb = it % nblk;
        tr_item(W, ldw, nb * 32 + (F.lane & 31), true, nullptr, kb * 64, WT + (size_t)(nb * 32) * K, K, scr, F.lane);
    }
}
__device__ __forceinline__ void row_load(const float* p, int lane, f32x4 (&v)[4]) {
#pragma unroll
    for (int j = 0; j < 4; ++j) v[j] = __builtin_nontemporal_load((const f32x4*)p + lane + 64 * j);
}
__device__ __forceinline__ float row_ssq(const f32x4 (&v)[4]) { float s = 0.f;
#pragma unroll
    for (int j = 0; j < 4; ++j) s += (v[j].x * v[j].x + v[j].y * v[j].y) + (v[j].z * v[j].z + v[j].w * v[j].w);
    return wave_sum(s); }
template <typename T>
__device__ __forceinline__ void row_normmod_store(const f32x4 (&v)[4], float rstd, const float* g, const float* sc, const float* sh, T* dst, int lane, unsigned char* dst8 = nullptr) {
#pragma unroll
    for (int j = 0; j < 4; ++j) { const int ci = lane + 64 * j; const f32x4 gg = ((const f32x4*)g)[ci], s1 = ((const f32x4*)sc)[ci], s0 = ((const f32x4*)sh)[ci];
        const f32x4 o = v[j] * rstd * gg * (s1 + 1.f) + s0;
        if constexpr (sizeof(T) == 1) ((unsigned*)dst)[ci] = pk_f8x4(o.x * F8_ACT, o.y * F8_ACT, o.z * F8_ACT, o.w * F8_ACT);
        else { u32x2 w; w.x = pk_h2(o.x, o.y); w.y = pk_h2(o.z, o.w); ((u32x2*)dst)[ci] = w; if (dst8) ((unsigned*)dst8)[ci] = pk_f8x4(o.x * F8_ACT, o.y * F8_ACT, o.z * F8_ACT, o.w * F8_ACT); } }
}
template <typename T>
__device__ __forceinline__ void store_nm(const f32x4 (&xv)[4], float r2, const f32x4 (&gb)[4], const f32x4 (&gc)[4], T* dst, int lane, unsigned char* dst8) {
#pragma unroll
    for (int j = 0; j < 4; ++j) { const int ci = lane + 64 * j; const f32x4 o = xv[j] * r2 * gb[j] + gc[j];
        if constexpr (sizeof(T) == 1) __builtin_nontemporal_store(pk_f8x4(o.x * F8_ACT, o.y * F8_ACT, o.z * F8_ACT, o.w * F8_ACT), (unsigned*)dst + ci);
        else { u32x2 w; w.x = pk_h2(o.x, o.y); w.y = pk_h2(o.z, o.w); __builtin_nontemporal_store(w, (u32x2*)dst + ci); if (dst8) __builtin_nontemporal_store(pk_f8x4(o.x * F8_ACT, o.y * F8_ACT, o.z * F8_ACT, o.w * F8_ACT), (unsigned*)dst8 + ci); } }
}
template <typename T>
__device__ __forceinline__ void ph_normmod(const Frame& F, const float* x, const float* g, const float* mod, int isc, int ish, T* dst) {
    const int lane = flane();
    const int b = F.gw & 3, nsl = F.NGW >> 2; int r0 = F.gw >> 2; if (r0 >= SEQ) return;
    const float* mb = mod + b * (NMOD * DM); f32x4 gb[4], gc[4];
#pragma unroll
    for (int j = 0; j < 4; ++j) { const int ci = lane + 64 * j; gb[j] = ((const f32x4*)g)[ci] * (((const f32x4*)(mb + isc * DM))[ci] + 1.f); gc[j] = ((const f32x4*)(mb + ish * DM))[ci]; }
    const float* xb = x + (size_t)b * SEQ * DM; T* db = dst + (size_t)b * SEQ * DM;
    f32x4 v[2][4], vn[2][4];
#pragma unroll
    for (int k = 0; k < 2; ++k) { const int r = r0 + k * nsl; row_load(xb + (size_t)(r < SEQ ? r : r0) * DM, lane, v[k]); }
    for (;;) { const int rn = r0 + 2 * nsl; const bool has = rn < SEQ;
        if (has) {
#pragma unroll
            for (int k = 0; k < 2; ++k) { const int r = rn + k * nsl; row_load(xb + (size_t)(r < SEQ ? r : rn) * DM, lane, vn[k]); } }
#pragma unroll
        for (int k = 0; k < 2; ++k) { const int r = r0 + k * nsl; const float rstd = rsqrtf(row_ssq(v[k]) * (1.f / DM) + EPS);
            if (r < SEQ) store_nm(v[k], rstd, gb, gc, db + (size_t)r * DM, lane, nullptr); }
        if (!has) break;
#pragma unroll
        for (int k = 0; k < 2; ++k)
#pragma unroll
            for (int j = 0; j < 4; ++j) v[k][j] = vn[k][j];
        r0 = rn; }
}
__device__ __forceinline__ void row_load_h(const h16* p, int lane, u32x2 (&v)[4]) {
#pragma unroll
    for (int j = 0; j < 4; ++j) v[j] = __builtin_nontemporal_load((const u32x2*)p + lane + 64 * j);
}
typedef _Float16 h16x4 __attribute__((ext_vector_type(4)));
__device__ __forceinline__ f32x4 h4_to_f4(u32x2 w) { const h16x4 h = __builtin_bit_cast(h16x4, w); return (f32x4){(float)h[0], (float)h[1], (float)h[2], (float)h[3]}; }
template <bool XI16, bool XO16, typename T = h16>
__device__ __forceinline__ void ph_resnorm(const Frame& F, const void* xin_, const h16* f, const float* gpost, const float* mod, int igt, float coef, void* xout_,
                                           bool second, const float* gpre, int isc, int ish, T* dst, unsigned char* dst8 = nullptr) {
    const int lane = flane();
    const int b = F.gw & 3, nsl = F.NGW >> 2; int r0 = F.gw >> 2; if (r0 >= SEQ) return;
    const float* mb = mod + b * (NMOD * DM); f32x4 ga[4], gb[4], gc[4];
#pragma unroll
    for (int j = 0; j < 4; ++j) { const int ci = lane + 64 * j; ga[j] = ((const f32x4*)gpost)[ci] * ((const f32x4*)(mb + igt * DM))[ci] * coef;
        if (second) { gb[j] = ((const f32x4*)gpre)[ci] * (((const f32x4*)(mb + isc * DM))[ci] + 1.f); gc[j] = ((const f32x4*)(mb + ish * DM))[ci]; } else { gb[j] = (f32x4){0.f, 0.f, 0.f, 0.f}; gc[j] = gb[j]; } }
    const size_t bo = (size_t)b * SEQ * DM; const h16* fb = f + bo;
    u32x2 fh[2][4], fn[2][4]; f32x4 xi[2][4], xn[2][4]; u32x2 xh[2][4], xhn[2][4];
#pragma unroll
    for (int k = 0; k < 2; ++k) { const int r = r0 + k * nsl; const size_t ro = (size_t)(r < SEQ ? r : r0) * DM; row_load_h(fb + ro, lane, fh[k]);
        if constexpr (XI16) row_load_h((const h16*)xin_ + bo + ro, lane, xh[k]); else row_load((const float*)xin_ + bo + ro, lane, xi[k]); }
    for (;;) {
        const int rn = r0 + 2 * nsl; const bool has = rn < SEQ;
        if (has) {
#pragma unroll
            for (int k = 0; k < 2; ++k) { const int r = rn + k * nsl; const size_t ro = (size_t)(r < SEQ ? r : rn) * DM; row_load_h(fb + ro, lane, fn[k]);
                if constexpr (XI16) row_load_h((const h16*)xin_ + bo + ro, lane, xhn[k]); else row_load((const float*)xin_ + bo + ro, lane, xn[k]); } }
#pragma unroll
        for (int k = 0; k < 2; ++k) { const int r = r0 + k * nsl; const bool ok = r < SEQ; const size_t ro = bo + (size_t)r * DM;
            f32x4 v[4];
#pragma unroll
            for (int j = 0; j < 4; ++j) { v[j] = h4_to_f4(fh[k][j]); if constexpr (XI16) xi[k][j] = h4_to_f4(xh[k][j]); }
            const float rstd = rsqrtf(row_ssq(v) * (1.f / DM) + EPS);
#pragma unroll
            for (int j = 0; j < 4; ++j) { const int ci = lane + 64 * j;
                xi[k][j] = xi[k][j] + ga[j] * v[j] * rstd;
                if (ok) { if constexpr (XO16) { u32x2 w; w.x = pk_h2(xi[k][j].x, xi[k][j].y); w.y = pk_h2(xi[k][j].z, xi[k][j].w); __builtin_nontemporal_store(w, (u32x2*)((h16*)xout_ + ro) + ci); }
                          else __builtin_nontemporal_store(xi[k][j], (f32x4*)((float*)xout_ + ro) + ci); } }
            if (second) { const float r2 = rsqrtf(row_ssq(xi[k]) * (1.f / DM) + EPS); if (ok) store_nm(xi[k], r2, gb, gc, dst + ro, lane, dst8 ? dst8 + ro : nullptr); } }
        if (!has) break;
#pragma unroll
        for (int k = 0; k < 2; ++k)
#pragma unroll
            for (int j = 0; j < 4; ++j) { fh[k][j] = fn[k][j]; if constexpr (XI16) xh[k][j] = xhn[k][j]; else xi[k][j] = xn[k][j]; }
        r0 = rn;
    }
}

__device__ __forceinline__ void ph_combine(const Frame& F, const h16* og, const float* lse2, h16* ob) {
    for (int idx = blockIdx.x * NTHR + F.tid; idx < MT * 256; idx += F.G * NTHR) {
        const int tok = idx >> 8, c = idx & 255, hh = c >> 6;
        const float l0 = lse2[tok * 12 + hh], l1 = lse2[tok * 12 + 4 + hh], l2 = lse2[tok * 12 + 8 + hh], m = fmaxf(l0, fmaxf(l1, l2));
        const float w0 = exp2f(l0 - m), w1 = exp2f(l1 - m), w2 = exp2f(l2 - m), inv = 1.f / (w0 + w1 + w2);
        ob[idx] = (h16)((w0 * (float)og[(size_t)tok * 768 + c] + w1 * (float)og[(size_t)tok * 768 + 256 + c] + w2 * (float)og[(size_t)tok * 768 + 512 + c]) * inv); }
}
typedef short v4i16_t __attribute__((ext_vector_type(4)));
typedef short s16x8 __attribute__((ext_vector_type(8)));
typedef float f32x16 __attribute__((ext_vector_type(16)));
__device__ __forceinline__ int tk_bin(float sc) { const unsigned u = __float_as_uint(sc); int e = (int)((u >> 16) & 0x7FFFu) - (122 << 7); e = e < 0 ? 0 : (e > 1023 ? 1023 : e); return (u >> 31) ? 1023 - e : 1024 + e; }
__device__ __forceinline__ void tk_scores(const f16x8 (&Af)[2], const float (&wv)[16], f16x8 b0, f16x8 b1, float& sa, float& sb) {
    f32x16 d = {0.f, 0.f, 0.f, 0.f, 0.f, 0.f, 0.f, 0.f, 0.f, 0.f, 0.f, 0.f, 0.f, 0.f, 0.f, 0.f};
    d = __builtin_amdgcn_mfma_f32_32x32x16_f16(Af[0], b0, d, 0, 0, 0); d = __builtin_amdgcn_mfma_f32_32x32x16_f16(Af[1], b1, d, 0, 0, 0);
    f32x2 acc = {0.f, 0.f};
#pragma unroll
    for (int e = 0; e < 16; e += 2) { const int i0 = __float_as_int(d[e]), i1 = __float_as_int(d[e + 1]);
        const f32x2 rl = {__int_as_float(i0 > 0 ? i0 : 0), __int_as_float(i1 > 0 ? i1 : 0)}; const f32x2 w2 = {wv[e], wv[e + 1]};
        acc = __builtin_elementwise_fma(w2, rl, acc); }
    sa = acc.x; sb = acc.y;
}
template <bool P2>
__device__ __forceinline__ void tk_tile(const f16x8 (&Af)[2], const float (&wv)[16], f16x8 b0, f16x8 b1, int tile, int r, int hi, int ta, LAS unsigned* hist, const int (&tbin)[4], int (&cs)[4], int (&cc)[4],
                                        unsigned short* sel, int tok0) {
    float sa, sb; tk_scores(Af, wv, b0, b1, sa, sb);
    const int s = 32 * tile + r;
    if constexpr (!P2) {
        if (s <= ta) { const int bn = tk_bin(sa); __hip_atomic_fetch_add(hist + (2 * hi) * 1024 + (bn >> 1), 1u << (16 * (bn & 1)), __ATOMIC_RELAXED, __HIP_MEMORY_SCOPE_WORKGROUP); }
        if (s <= ta + 1) { const int bn = tk_bin(sb); __hip_atomic_fetch_add(hist + (2 * hi + 1) * 1024 + (bn >> 1), 1u << (16 * (bn & 1)), __ATOMIC_RELAXED, __HIP_MEMORY_SCOPE_WORKGROUP); }
    } else {
        const unsigned lowmask = (1u << r) - 1u;
#pragma unroll
        for (int ab = 0; ab < 2; ++ab) { const float sc = ab ? sb : sa; const int tq = ta + ab; const int bn = tk_bin(sc);
            const int mytb = hi ? tbin[2 + ab] : tbin[ab];
            const bool valid = s <= tq, sure = valid && bn > mytb, cand = valid && bn == mytb;
            const unsigned long long ms = __ballot(sure), mc = __ballot(cand);
            const unsigned ms_h = hi ? (unsigned)(ms >> 32) : (unsigned)ms, mc_h = hi ? (unsigned)(mc >> 32) : (unsigned)mc;
            const int q = 2 * hi + ab;
            const int base_s = hi ? cs[2 + ab] : cs[ab], base_c = hi ? cc[2 + ab] : cc[ab];
            if (sure) sel[(size_t)(tok0 + q) * TOPK + base_s + __builtin_popcount(ms_h & lowmask)] = (unsigned short)s;
            if (cand) { const int pos = base_c + __builtin_popcount(mc_h & lowmask);
                if (pos < 512) ((LAS unsigned long long*)((LAS unsigned char*)hist + q * 4096))[pos] = ((unsigned long long)fkey(sc) << 16) | (unsigned long long)(0xFFFFu - (unsigned)s); }
            cs[ab] += __builtin_popcount((unsigned)ms); cs[2 + ab] += __builtin_popcount((unsigned)(ms >> 32));
            cc[ab] += __builtin_popcount((unsigned)mc); cc[2 + ab] += __builtin_popcount((unsigned)(mc >> 32)); }
    }
}
template <bool P2>
__device__ __forceinline__ void tk_pass(const f16x8 (&Af)[2], const float (&wv)[16], const h16* kbase, int ntiles, int r, int hi, int ta, LAS unsigned* hist, const int (&tbin)[4], int (&cs)[4], int (&cc)[4],
                                        unsigned short* sel, int tok0) {
    f16x8 BA[4][2], BB[4][2];
#define TK_LOAD(dst, t0_) do { _Pragma("unroll") for (int i_ = 0; i_ < 4; ++i_) { const int tt_ = ((t0_) + i_) < 127 ? ((t0_) + i_) : 127; dst[i_][0] = *(const f16x8*)(kbase + (size_t)tt_ * 1024); dst[i_][1] = *(const f16x8*)(kbase + (size_t)tt_ * 1024 + 16); } } while (0)
    TK_LOAD(BA, 0);
    for (int t0 = 0; t0 < ntiles; t0 += 8) {
        TK_LOAD(BB, t0 + 4);
#pragma unroll
        for (int i = 0; i < 4; ++i) if (t0 + i < ntiles) tk_tile<P2>(Af, wv, BA[i][0], BA[i][1], t0 + i, r, hi, ta, hist, tbin, cs, cc, sel, tok0);
        TK_LOAD(BA, t0 + 8);
#pragma unroll
        for (int i = 0; i < 4; ++i) if (t0 + 4 + i < ntiles) tk_tile<P2>(Af, wv, BB[i][0], BB[i][1], t0 + 4 + i, r, hi, ta, hist, tbin, cs, cc, sel, tok0);
    }
#undef TK_LOAD
}
__device__ __forceinline__ void tk_group(const Frame& F, const h16* qi, const h16* ki, const float* wi, unsigned short* sel, int b, int t0, LAS unsigned* hist) {
    int lane_ = F.lane; asm volatile("" : "+v"(lane_)); const int lane = lane_, r = lane & 31, hi = lane >> 5, tok0 = b * SEQ + t0;
    const int qa = 2 * ((r >> 2) & 1) + (r & 1), ha = 4 * (r >> 4) + 2 * ((r >> 3) & 1) + ((r >> 1) & 1);
    f16x8 Af[2];
#pragma unroll
    for (int s_ = 0; s_ < 2; ++s_) Af[s_] = *(const f16x8*)(qi + (size_t)(tok0 + qa) * 256 + ha * 32 + 16 * s_ + 8 * hi);
    float wv[16];
    { const f32x4 a0 = *(const f32x4*)(wi + (tok0 + 2 * hi) * 8), a1 = *(const f32x4*)(wi + (tok0 + 2 * hi) * 8 + 4), b0 = *(const f32x4*)(wi + (tok0 + 2 * hi + 1) * 8), b1 = *(const f32x4*)(wi + (tok0 + 2 * hi + 1) * 8 + 4);
      const float sa[8] = {a0.x, a0.y, a0.z, a0.w, a1.x, a1.y, a1.z, a1.w}, sb[8] = {b0.x, b0.y, b0.z, b0.w, b1.x, b1.y, b1.z, b1.w};
#pragma unroll
      for (int h = 0; h < 8; ++h) { wv[2 * h] = sa[h] * 0.17677669529663687f; wv[2 * h + 1] = sb[h] * 0.17677669529663687f; } }
    const int ntiles = (t0 + 3) / 32 + 1, ta = t0 + 2 * hi;
    const h16* kbase = ki + (size_t)(b * SEQ + r) * 32 + 8 * hi;
    int tbin[4] = {0, 0, 0, 0}, nsure[4], cs[4] = {0, 0, 0, 0}, cc[4] = {0, 0, 0, 0};
#pragma unroll
    for (int i = 0; i < 16; ++i) *(LAS u32x4*)((LAS unsigned char*)hist + i * 1024 + lane * 16) = (u32x4){0u, 0u, 0u, 0u};
    asm volatile("s_waitcnt lgkmcnt(0)" ::: "memory");
    tk_pass<false>(Af, wv, kbase, ntiles, r, hi, ta, hist, tbin, cs, cc, sel, tok0);
    asm volatile("s_waitcnt lgkmcnt(0)" ::: "memory");
#pragma unroll
    for (int q = 0; q < 4; ++q) {
        const LAS unsigned* hq = hist + q * 1024;
        unsigned sum = 0;
#pragma unroll
        for (int i = 0; i < 4; ++i) { const u32x4 v = *(const LAS u32x4*)(hq + 16 * lane + 4 * i); sum += (v.x & 0xFFFFu) + (v.x >> 16) + (v.y & 0xFFFFu) + (v.y >> 16) + (v.z & 0xFFFFu) + (v.z >> 16) + (v.w & 0xFFFFu) + (v.w >> 16); }
        unsigned incl = sum;
#pragma unroll
        for (int o = 1; o < 64; o <<= 1) { const unsigned v = __shfl_down(incl, o); if (lane + o < 64) incl += v; }
        const unsigned long long bal = __ballot(incl >= (unsigned)TOPK);
        const int L = 63 - __builtin_clzll(bal);
        unsigned cum = __shfl(incl, L) - __shfl(sum, L);
        int tbq = 32 * L, found = 0;
        for (int wd = 15; wd >= 0 && !found; --wd) { const unsigned v = hq[16 * L + wd];
            const unsigned chi = v >> 16, clo = v & 0xFFFFu;
            if (cum + chi >= (unsigned)TOPK) { tbq = 32 * L + 2 * wd + 1; found = 1; } else { cum += chi;
                if (cum + clo >= (unsigned)TOPK) { tbq = 32 * L + 2 * wd; found = 1; } else cum += clo; } }
        tbin[q] = tbq; nsure[q] = (int)cum;
    }
    asm volatile("s_waitcnt lgkmcnt(0)" ::: "memory");
    tk_pass<true>(Af, wv, kbase, ntiles, r, hi, ta, hist, tbin, cs, cc, sel, tok0);
    asm volatile("s_waitcnt lgkmcnt(0)" ::: "memory");
#pragma unroll
    for (int q = 0; q < 4; ++q) {
        const int nc = cc[q] < 512 ? cc[q] : 512, need = TOPK - cs[q];
        const LAS unsigned long long* cq = (const LAS unsigned long long*)((const LAS unsigned char*)hist + q * 4096);
        if (nc > 64) {
            unsigned long long it[8];
#pragma unroll
            for (int k = 0; k < 8; ++k) it[k] = (k * 64 + lane < nc) ? cq[k * 64 + lane] : 0ull;
            unsigned long long T = 0ull;
            for (int bit = 47; bit >= 0; --bit) { const unsigned long long cand = T | (1ull << bit); int cnt = 0;
#pragma unroll
                for (int k = 0; k < 8; ++k) cnt += __builtin_popcountll(__ballot(it[k] >= cand));
                if (cnt >= need) T = cand; }
            int basep = cs[q];
#pragma unroll
            for (int k = 0; k < 8; ++k) { const bool pick = (T != 0ull) && it[k] >= T; const unsigned long long mk = __ballot(pick);
                if (pick) sel[(size_t)(tok0 + q) * TOPK + basep + __builtin_popcountll(mk & ((1ull << lane) - 1ull))] = (unsigned short)(0xFFFFu - (unsigned)(it[k] & 0xFFFFull));
                basep += __builtin_popcountll(mk); }
        } else
        for (int base = 0; base < nc; base += 64) {
            const bool act = base + lane < nc; const unsigned long long my = act ? cq[base + lane] : 0ull; int rank = 0;
            for (int jb = 0; jb < nc; jb += 64) {
                const unsigned long long cj = (jb + lane < nc) ? cq[jb + lane] : 0ull; const unsigned clo = (unsigned)cj, chi = (unsigned)(cj >> 32);
                const int n = (nc - jb) < 64 ? (nc - jb) : 64;
                for (int j = 0; j < n; ++j) { const unsigned long long sj = ((unsigned long long)(unsigned)__builtin_amdgcn_readlane((int)chi, j) << 32) | (unsigned)__builtin_amdgcn_readlane((int)clo, j); rank += (sj > my) ? 1 : 0; } }
            if (act && rank < need) sel[(size_t)(tok0 + q) * TOPK + cs[q] + rank] = (unsigned short)(0xFFFFu - (unsigned)(my & 0xFFFFull)); }
    }
    (void)nsure;
    asm volatile("s_waitcnt lgkmcnt(0)" ::: "memory");
}
__device__ __forceinline__ void ph_topk_sparse(const Frame& F, const h16* qi, const h16* ki, const float* wi, unsigned short* sel, h16* qlat, const h16* qr, const unsigned char* ckv8, const unsigned char* kr8);
__device__ __forceinline__ void ph_topk_mfma(const Frame& F, const h16* qi, const h16* ki, const float* wi, unsigned short* sel) {
    LAS unsigned* hist = (LAS unsigned*)(F.lds + F.wave * 16384);
    for (int g = F.gw; g < 4 * 64; g += F.NGW) { const int b = g >> 6, t0 = (g & 63) * 4;
        for (int i = F.lane; i < 4 * TOPK; i += 64) { const int q = i >> 8, k = i & 255; sel[(size_t)(b * SEQ + t0 + q) * TOPK + k] = (unsigned short)(k <= t0 + q ? k : 0); } }
    for (int p = F.gw; p < 4 * 480; p += F.NGW) { const int b = p & 3, pj = p >> 2;
        tk_group(F, qi, ki, wi, sel, b, 4 * (64 + pj), hist);
        tk_group(F, qi, ki, wi, sel, b, 4 * (1023 - pj), hist);
    }
}


__device__ __forceinline__ void ph_dilated_mfma(const Frame& F, const h16* qb, const h16* kb, const h16* vb, h16* og, float* lse2) {
    const int lane = F.lane, ql = lane & 31, hi = lane >> 5;
    LAS unsigned char* VL = F.lds + F.wave * 16384;
    LAS float* linv = (LAS float*)(VL + 12288);
    constexpr int VROW = 192;
    const int trq = (lane & 15) >> 2, trp = lane & 3, trg = (lane >> 4) & 1;
    for (int u = F.gw; u < NB * 12 * 128; u += F.NGW) {
        const int b = u / 1536, rem = u % 1536, gh = rem >> 7, g = gh >> 2, wi_ = rem & 127, dil = dil_of(g), sh = g == 0 ? 0 : (g == 1 ? 2 : 4);
        const int nblk = 128 >> sh, res = wi_ / nblk, j0 = 32 * (wi_ % nblk);
        const size_t hoff = (size_t)b * SEQ * 768 + gh * 64;
        f16x8 Qf[4];
        { const h16* qp = qb + hoff + (size_t)((j0 + ql) * dil + res) * 768 + 8 * hi;
#pragma unroll
          for (int s_ = 0; s_ < 4; ++s_) Qf[s_] = *(const f16x8*)(qp + 16 * s_); }
        f32x16 S[5];
        f16x8 Kf[5][4];
#pragma unroll
        for (int kt = 0; kt < 5; ++kt) { int jk = j0 - 128 + 32 * kt + ql; jk = jk < 0 ? 0 : jk;
            const h16* kp = kb + hoff + (size_t)(jk * dil + res) * 768 + 8 * hi;
#pragma unroll
            for (int s_ = 0; s_ < 4; ++s_) Kf[kt][s_] = *(const f16x8*)(kp + 16 * s_); }
#pragma unroll
        for (int kt = 0; kt < 5; ++kt) {
            f32x16 d = {0.f, 0.f, 0.f, 0.f, 0.f, 0.f, 0.f, 0.f, 0.f, 0.f, 0.f, 0.f, 0.f, 0.f, 0.f, 0.f};
#pragma unroll
            for (int s_ = 0; s_ < 4; ++s_) d = __builtin_amdgcn_mfma_f32_32x32x16_f16(Kf[kt][s_], Qf[s_], d, 0, 0, 0);
            S[kt] = d; }
        f16x8 Vr[5][4];
#pragma unroll
        for (int kt = 0; kt < 5; ++kt) { int jk = j0 - 128 + 32 * kt + (lane >> 1); jk = jk < 0 ? 0 : jk;
            const h16* vp = vb + hoff + (size_t)(jk * dil + res) * 768 + (lane & 1) * 32;
#pragma unroll
            for (int i = 0; i < 4; ++i) Vr[kt][i] = *(const f16x8*)(vp + 8 * i); }
        float m = -INFINITY;
#pragma unroll
        for (int kt = 0; kt < 5; ++kt)
#pragma unroll
            for (int e = 0; e < 16; ++e) { const int kl = (e & 3) + 8 * (e >> 2) + 4 * hi; bool ok = (j0 - 128 + 32 * kt + kl) >= 0;
                if (kt == 0) ok = ok && (kl >= ql); if (kt == 4) ok = ok && (kl <= ql);
                if (!ok) S[kt][e] = -INFINITY; m = fmaxf(m, S[kt][e]); }
        m = fmaxf(m, __shfl_xor(m, 32));
        float l = 0.f;
#pragma unroll
        for (int kt = 0; kt < 5; ++kt)
#pragma unroll
            for (int e = 0; e < 16; ++e) { const float p = __builtin_amdgcn_exp2f(S[kt][e] - m); S[kt][e] = p; l += p; }
        l += __shfl_xor(l, 32);
        if (hi == 0) { linv[ql] = __builtin_amdgcn_rcpf(l); lse2[(size_t)(b * SEQ + (j0 + ql) * dil + res) * 12 + gh] = m + __builtin_amdgcn_logf(l); }
        f32x16 O[2];
#pragma unroll
        for (int dt = 0; dt < 2; ++dt) O[dt] = (f32x16){0.f, 0.f, 0.f, 0.f, 0.f, 0.f, 0.f, 0.f, 0.f, 0.f, 0.f, 0.f, 0.f, 0.f, 0.f, 0.f};
#pragma unroll
        for (int kt = 0; kt < 5; ++kt) {
            LAS unsigned char* vbuf = VL + (kt & 1) * 6144;
#pragma unroll
            for (int i = 0; i < 4; ++i) *(LAS f16x8*)(vbuf + (lane >> 1) * VROW + (lane & 1) * 64 + i * 16) = Vr[kt][i];
            asm volatile("s_waitcnt lgkmcnt(0)" ::: "memory");
#pragma unroll
            for (int s2 = 0; s2 < 2; ++s2) {
                u32x4 pa; pa.x = pk_h2(S[kt][8 * s2 + 0], S[kt][8 * s2 + 1]); pa.y = pk_h2(S[kt][8 * s2 + 2], S[kt][8 * s2 + 3]); pa.z = pk_h2(S[kt][8 * s2 + 4], S[kt][8 * s2 + 5]); pa.w = pk_h2(S[kt][8 * s2 + 6], S[kt][8 * s2 + 7]);
#pragma unroll
                for (int dt = 0; dt < 2; ++dt) {
                    const v4i16_t lo = __builtin_amdgcn_ds_read_tr16_b64_v4i16((LAS v4i16_t*)(vbuf + (16 * s2 + 4 * hi + trq) * VROW + (32 * dt + 16 * trg + 4 * trp) * 2));
                    const v4i16_t hh = __builtin_amdgcn_ds_read_tr16_b64_v4i16((LAS v4i16_t*)(vbuf + (16 * s2 + 8 + 4 * hi + trq) * VROW + (32 * dt + 16 * trg + 4 * trp) * 2));
                    const s16x8 bv = {lo[0], lo[1], lo[2], lo[3], hh[0], hh[1], hh[2], hh[3]};
                    O[dt] = __builtin_amdgcn_mfma_f32_32x32x16_f16(__builtin_bit_cast(f16x8, pa), __builtin_bit_cast(f16x8, bv), O[dt], 0, 0, 0); } }
            asm volatile("s_waitcnt lgkmcnt(0)" ::: "memory");
        }
#pragma unroll
        for (int e = 0; e < 16; ++e) { const int q = (e & 3) + 8 * (e >> 2) + 4 * hi; const float il = linv[q];
            h16* op = og + (size_t)(b * SEQ + (j0 + q) * dil + res) * 768 + gh * 64 + ql;
            op[0] = (h16)(O[0][e] * il); op[32] = (h16)(O[1][e] * il); }
        asm volatile("s_waitcnt lgkmcnt(0)" ::: "memory");
    }
}


__device__ __forceinline__ f16x8 fp8x8_to_f16(unsigned w0, unsigned w1) {
    const h16x2 a = __builtin_amdgcn_cvt_scalef32_pk_f16_fp8((int)w0, 1.0f, false), b = __builtin_amdgcn_cvt_scalef32_pk_f16_fp8((int)w0, 1.0f, true),
                c = __builtin_amdgcn_cvt_scalef32_pk_f16_fp8((int)w1, 1.0f, false), d = __builtin_amdgcn_cvt_scalef32_pk_f16_fp8((int)w1, 1.0f, true);
    const u32x4 r = {__builtin_bit_cast(unsigned, a), __builtin_bit_cast(unsigned, b), __builtin_bit_cast(unsigned, c), __builtin_bit_cast(unsigned, d)};
    return __builtin_bit_cast(f16x8, r);
}
template <bool FUSED>
__device__ __forceinline__ void ph_sparse_wave(const Frame& F, h16* qlat, const h16* qr, const unsigned char* ckv8, const unsigned char* kr8, const unsigned short* sel, int ta = 0, int tb = 0) {
    int lane = F.lane; asm volatile("" : "+v"(lane));
    LAS unsigned char* V = F.lds + F.wave * 16384;
    const int qp = (lane & 15) >> 2, pp = lane & 3;
    const int k0 = 4 * (lane >> 4) + qp;
    const int tr0 = k0 * 512 + (pp >> 1) * 16 + (pp & 1) * 8, x0 = k0 & 7;
    const int vw = (lane & 15) * 512, swz = lane & 7;
    const int lane0 = lane;
    const int nit = FUSED ? 8 : (MT - F.gw + F.NGW - 1) / F.NGW;
    for (int it = 0; it < nit; ++it) {
        const int tok = FUSED ? ((it < 4 ? ta : tb - 4) + it) : F.gw + it * F.NGW;
        int ll = lane0; asm volatile("" : "+v"(ll));
        const int c = ll & 15, kq = ll >> 4, hd = c & 7;
        const int b = tok / SEQ, t = tok % SEQ, cnt = (t + 1 < TOPK) ? t + 1 : TOPK, nch = (cnt + 31) >> 5;
        LAS unsigned short* sp = (LAS unsigned short*)(F.lds + XCH_OFF + F.wave * 512) + c;
        *(LAS u32x2*)(F.lds + XCH_OFF + F.wave * 512 + 8 * ll) = *(const u32x2*)(sel + (size_t)tok * TOPK + 4 * ll);
        asm volatile("s_waitcnt lgkmcnt(0)" ::: "memory");
        f16x8 Qf[9]; u32x4 Kr[2][4]; u32x2 Rr[2];
#pragma unroll
        for (int s_ = 0; s_ < 8; ++s_) Qf[s_] = *(const f16x8*)(qlat + (size_t)tok * 2048 + hd * 256 + 64 * (s_ >> 1) + 16 * kq + 8 * (s_ & 1));
        Qf[8] = *(const f16x8*)(qr + (size_t)tok * 256 + hd * 32 + 8 * kq);
        int rowi[2];
#define SW_LOADK() do { _Pragma("unroll") for (int tl = 0; tl < 2; ++tl) { _Pragma("unroll") for (int q4 = 0; q4 < 4; ++q4) Kr[tl][q4] = *(const u32x4*)(ckv8 + (size_t)rowi[tl] * 256 + 64 * q4 + 16 * kq); \
        Rr[tl] = *(const u32x2*)(kr8 + (size_t)rowi[tl] * 32 + 8 * kq); } } while (0)
        rowi[0] = b * SEQ + (int)sp[0]; rowi[1] = b * SEQ + (int)sp[16];
        SW_LOADK();
        float m = -INFINITY, l = 0.f;
        f32x4 O[16];
#pragma unroll
        for (int ft = 0; ft < 16; ++ft) O[ft] = (f32x4){0.f, 0.f, 0.f, 0.f};
        for (int ch = 0; ch < nch; ++ch) {
            const bool more = ch + 1 < nch;
            int rown0 = 0, rown1 = 0; if (more) { rown0 = (int)sp[32 * (ch + 1)]; rown1 = (int)sp[32 * (ch + 1) + 16]; }
            f16x8 Kf[2][9];
#pragma unroll
            for (int tl = 0; tl < 2; ++tl) {
#pragma unroll
                for (int q4 = 0; q4 < 4; ++q4) { Kf[tl][2 * q4] = fp8x8_to_f16(Kr[tl][q4].x, Kr[tl][q4].y); Kf[tl][2 * q4 + 1] = fp8x8_to_f16(Kr[tl][q4].z, Kr[tl][q4].w); }
                Kf[tl][8] = fp8x8_to_f16(Rr[tl].x, Rr[tl].y); }
            if (more) { rowi[0] = b * SEQ + rown0; rowi[1] = b * SEQ + rown1; SW_LOADK(); }
            f32x4 S[2];
#pragma unroll
            for (int tl = 0; tl < 2; ++tl) { S[tl] = (f32x4){0.f, 0.f, 0.f, 0.f};
#pragma unroll
                for (int s_ = 0; s_ < 9; ++s_) S[tl] = __builtin_amdgcn_mfma_f32_16x16x32_f16(Kf[tl][s_], Qf[s_], S[tl], 0, 0, 0); }
            float cm = -INFINITY;
#pragma unroll
            for (int tl = 0; tl < 2; ++tl)
#pragma unroll
                for (int e = 0; e < 4; ++e) { if (32 * ch + 16 * tl + 4 * kq + e >= cnt) S[tl][e] = -INFINITY; cm = fmaxf(cm, S[tl][e]); }
            cm = fmaxf(cm, __shfl_xor(cm, 16)); cm = fmaxf(cm, __shfl_xor(cm, 32));
            if (__any(cm > m + 8.0f)) { const float mn = fmaxf(m, cm), alpha = __builtin_amdgcn_exp2f(m - mn); m = mn; l *= alpha;
#pragma unroll
                for (int ft = 0; ft < 16; ++ft) O[ft] = O[ft] * alpha; }
            float pe[2][4]; float ps = 0.f;
#pragma unroll
            for (int tl = 0; tl < 2; ++tl)
#pragma unroll
                for (int e = 0; e < 4; ++e) { pe[tl][e] = __builtin_amdgcn_exp2f(S[tl][e] - m); ps += pe[tl][e]; }
            l += ps;
#pragma unroll
            for (int tl = 0; tl < 2; ++tl)
#pragma unroll
                for (int s_ = 0; s_ < 8; ++s_) *(LAS f16x8*)(V + vw + tl * 8192 + (((4 * (s_ >> 1) + kq) ^ swz) << 5) + (s_ & 1) * 16) = Kf[tl][s_];
            asm volatile("s_waitcnt lgkmcnt(0)" ::: "memory");
            u32x4 pk; pk.x = pk_h2(pe[0][0], pe[0][1]); pk.y = pk_h2(pe[0][2], pe[0][3]); pk.z = pk_h2(pe[1][0], pe[1][1]); pk.w = pk_h2(pe[1][2], pe[1][3]);
            const f16x8 Pf = __builtin_bit_cast(f16x8, pk);
#pragma unroll
            for (int ft = 0; ft < 16; ++ft) {
                const v4i16_t lo = __builtin_amdgcn_ds_read_tr16_b64_v4i16((LAS v4i16_t*)(V + tr0 + (((ft & 7) ^ x0) << 5) + (ft >> 3) * 256));
                const v4i16_t hi = __builtin_amdgcn_ds_read_tr16_b64_v4i16((LAS v4i16_t*)(V + tr0 + (((ft & 7) ^ x0) << 5) + (ft >> 3) * 256 + 8192));
                const s16x8 av = {lo[0], lo[1], lo[2], lo[3], hi[0], hi[1], hi[2], hi[3]};
                O[ft] = __builtin_amdgcn_mfma_f32_16x16x32_f16(__builtin_bit_cast(f16x8, av), Pf, O[ft], 0, 0, 0); }
            asm volatile("s_waitcnt lgkmcnt(0)" ::: "memory");
        }
        l += __shfl_xor(l, 16); l += __shfl_xor(l, 32);
        if (c < 8) { const float il = __builtin_amdgcn_rcpf(l);
#pragma unroll
            for (int ft = 0; ft < 16; ++ft) { const f32x4 o = O[ft] * il; u32x2 pk; pk.x = pk_h2(o.x, o.y); pk.y = pk_h2(o.z, o.w);
                *(u32x2*)(qlat + (size_t)tok * 2048 + c * 256 + 16 * ft + 4 * kq) = pk; } }
#undef SW_LOADK
    }
}


__device__ __forceinline__ void precomb_tiles(const Frame& F, const Args& args, unsigned char* ws, int t_lo, int t_hi, int wg, int nwg) {
    LAS float* As = (LAS float*)(F.lds); LAS float* Bs = (LAS float*)(F.lds + 64 * 65 * 4);
    for (int tl = t_lo + wg; tl < t_hi; tl += nwg) {
        __syncthreads();
        const bool ql = tl < 192; int hd, rb, xb;
        if (ql) { hd = tl / 24; rb = (tl % 24) / 6; xb = tl % 6; } else { const int t2 = tl - 192; hd = t2 / 64; rb = (t2 % 64) / 16; xb = t2 % 16; }
#pragma unroll
        for (int k = 0; k < 2; ++k) { const int i4 = F.tid + NTHR * k, row = i4 >> 4, c4 = (i4 & 15) * 4;
            if (ql) { const f32x4 a = *(const f32x4*)(args.in[15] + (size_t)(rb * 64 + row) * 512 + hd * 64 + c4), bq = *(const f32x4*)(args.in[14] + (size_t)(xb * 64 + row) * 768 + hd * 96 + c4);
#pragma unroll
                for (int e = 0; e < 4; ++e) { As[row * 65 + c4 + e] = a[e]; Bs[row * 65 + c4 + e] = bq[e]; } }
            else { const f32x4 a = *(const f32x4*)(args.in[18] + (size_t)(hd * 64 + row) * DM + xb * 64 + c4), bq = *(const f32x4*)(args.in[16] + (size_t)(rb * 64 + row) * 512 + hd * 64 + c4);
#pragma unroll
                for (int e = 0; e < 4; ++e) { As[(c4 + e) * 65 + row] = a[e]; Bs[row * 65 + c4 + e] = bq[e]; } } }
        __syncthreads();
        const int j = F.tid & 63, ig = F.wave;
        float acc8[8];
#pragma unroll
        for (int ii = 0; ii < 8; ++ii) acc8[ii] = 0.f;
#pragma unroll 4
        for (int v = 0; v < 64; ++v) { const float bv = Bs[j * 65 + v];
#pragma unroll
            for (int ii = 0; ii < 8; ++ii) acc8[ii] += As[(ig * 8 + ii) * 65 + v] * bv; }
        if (ql) { const float gj = args.in[12][xb * 64 + j]; h16* o = (h16*)(ws + OW_4);
#pragma unroll
            for (int ii = 0; ii < 8; ++ii) o[(size_t)(hd * 256 + rb * 64 + ig * 8 + ii) * QL + xb * 64 + j] = (h16)(acc8[ii] * gj); }
        else { h16* o = (h16*)(ws + OW_OV);
#pragma unroll
            for (int ii = 0; ii < 8; ++ii) o[(size_t)(xb * 64 + ig * 8 + ii) * 2048 + hd * 256 + rb * 64 + j] = (h16)acc8[ii]; }
    }
    __syncthreads();
}


__device__ __forceinline__ void ph_topk_sparse(const Frame& F, const h16* qi, const h16* ki, const float* wi, unsigned short* sel, h16* qlat, const h16* qr, const unsigned char* ckv8, const unsigned char* kr8) {
    LAS unsigned* hist = (LAS unsigned*)(F.lds + F.wave * 16384);
    for (int p = F.gw; p < 2048; p += F.NGW) {
        int ta, tb;
        if (p < 4 * 448) { const int b = p & 3, pj = p >> 2; ta = b * SEQ + 4 * (64 + pj); tb = b * SEQ + 4 * (959 - pj);
            tk_group(F, qi, ki, wi, sel, b, 4 * (64 + pj), hist);
            tk_group(F, qi, ki, wi, sel, b, 4 * (959 - pj), hist); }
        else { const int q_ = p - 4 * 448, b = q_ & 3, i_ = q_ >> 2, t0 = 4 * i_;
            tk_group(F, qi, ki, wi, sel, b, 4 * (960 + i_), hist);
            int l0 = F.lane; asm volatile("" : "+v"(l0));
            for (int i = l0; i < 4 * TOPK; i += 64) { const int q = i >> 8, k = i & 255; sel[(size_t)(b * SEQ + t0 + q) * TOPK + k] = (unsigned short)(k <= t0 + q ? k : 0); }
            ta = b * SEQ + 4 * (960 + i_); tb = b * SEQ + t0; }
        asm volatile("s_waitcnt vmcnt(0) lgkmcnt(0)" ::: "memory");
        ph_sparse_wave<true>(F, qlat, qr, ckv8, kr8, sel, ta, tb);
        asm volatile("s_waitcnt lgkmcnt(0)" ::: "memory");
    }
}

__global__ void __launch_bounds__(NTHR, 2) mega_fwd(Args args) {
    extern __shared__ __attribute__((aligned(16))) unsigned char lds_raw[];
    Frame F; F.lds = (LAS unsigned char*)lds_raw; F.tid = threadIdx.x; F.lane = F.tid & 63; F.wave = __builtin_amdgcn_readfirstlane(F.tid >> 6);
    F.G = gridDim.x; F.gw = blockIdx.x * NWAVES + F.wave; F.NGW = F.G * NWAVES;
    volatile LAS unsigned* MISC = (volatile LAS unsigned*)(F.lds + MISC_OFF);
    unsigned char* ws = args.ws;
    for (int u = F.tid; u < (LDS_BYTES - LDSCTL_OFF) / 4; u += NTHR) ((LAS unsigned*)(F.lds + LDSCTL_OFF))[u] = 0u;
    __syncthreads();
    XcdBarrier bar = xcd_barrier_post((unsigned*)(ws + OFF_CTL) + CW_BAR, MISC + 8, F.wave);
    const int lo = args.ph_lo, hi = args.ph_hi;
#define IN(k) (lo <= (k) && (k) < hi)
#define SEAM(k) do { if (IN(k) && IN((k) + 1)) xcd_barrier(bar); F.lane = flane(); F.tid = F.wave * 64 + F.lane; } while (0)
    float* mod = (float*)(ws + OFF_MOD); float2* tab = (float2*)(ws + OFF_ROPE);
    h16* Hb = (h16*)(ws + OFF_H); h16* Ab = (h16*)(ws + OFF_A); float* Fb = (float*)(ws + OFF_F);

    if (IN(0)) {
        LAS float* scr = (LAS float*)(F.lds + F.wave * 16384);
        for (int ch = blockIdx.x; ch < (NMOD * DM) / 36; ch += F.G) {
            LAS float* sl = (LAS float*)(F.lds);
            LAS f32x4* part = (LAS f32x4*)(F.lds + 16384);
            __syncthreads();
            for (int i = F.tid; i < 4 * DM; i += NTHR) sl[i] = silu_f(args.in[1][i]);
            __syncthreads();
            const int r7 = F.lane / 9, c4 = F.lane - 9 * r7; const bool act = F.lane < 63;
            const float* wm = args.in[3] + (size_t)(F.wave * 128 + r7) * (NMOD * DM) + ch * 36 + 4 * c4;
            f32x4 wv[19];
#pragma unroll
            for (int i = 0; i < 19; ++i) { const bool ok = act && (7 * i + r7 < 128); wv[i] = *(const f32x4*)(wm + (size_t)(ok ? 7 * i : 0) * (NMOD * DM)); }
            f32x4 a0 = {0.f, 0.f, 0.f, 0.f}, a1 = a0, a2 = a0, a3 = a0;
#pragma unroll
            for (int i = 0; i < 19; ++i) { const bool ok = act && (7 * i + r7 < 128); const int kk = F.wave * 128 + (ok ? 7 * i + r7 : 0); const f32x4 w = ok ? wv[i] : (f32x4){0.f, 0.f, 0.f, 0.f};
                a0 += w * sl[kk]; a1 += w * sl[DM + kk]; a2 += w * sl[2 * DM + kk]; a3 += w * sl[3 * DM + kk]; }
            if (act) { LAS f32x4* pp = part + ((F.wave * 7 + r7) * 4) * 9 + c4; pp[0] = a0; pp[9] = a1; pp[18] = a2; pp[27] = a3; }
            __syncthreads();
            if (F.tid < 144) { const int b = F.tid / 36, l = F.tid - 36 * b; float sm = args.in[4][ch * 36 + l]; const LAS float* pf = (const LAS float*)part + (b * 9) * 4 + l;
#pragma unroll 8
                for (int w = 0; w < 56; ++w) sm += pf[w * 144];
                mod[b * (NMOD * DM) + ch * 36 + l] = sm; }
            __syncthreads();
        }
        for (int idx = blockIdx.x * NTHR + F.tid; idx < MT * 48; idx += F.G * NTHR) { const int tok = idx / 48, i = idx % 48;
            const float inv = (i < 32) ? powf(10000.f, -(float)i / 32.f) : powf(10000.f, -(float)(i - 32) / 16.f);
            const float ang = (float)((const int*)args.in[2])[tok] * inv; float sn, cs; sincosf(ang, &sn, &cs); tab[idx] = make_float2(cs, sn); }
        tr_job_mapped(F, args, 0, 2 * FF, 0, DM, ws + OW_GU1, nullptr, scr, 0);
        if (F.G != 256) {
            tr_job_plain(F, args.in[8], DM, DM, FF, ws + OW_D1, scr, 768);
            tr_job_mapped(F, args, 2, NIN3, 0, DM, (h16*)(ws + OW_IN), nullptr, scr, 128);
            tr_job_plain(F, args.in[11] + C_GATE, DIN, 2048, DM, ws + OW_GATE, scr, 1664);
            tr_job_mapped(F, args, 3, 512, 2048, QL, (h16*)(ws + OW_4), args.in[12], scr, 640);
            tr_job_plain(F, args.in[19], DM, DM, 256, (h16*)(ws + OW_UPB), scr, 736);
            tr_job_plain(F, args.in[20], DM, DM, DM, (h16*)(ws + OW_O), scr, 864);
            tr_job_mapped(F, args, 1, 2 * FF, 0, DM, ws + OW_GU2, nullptr, scr, 1376);
            tr_job_plain(F, args.in[25], DM, DM, FF, ws + OW_D2, scr, 96);
            precomb_tiles(F, args, ws, 0, 192, (int)blockIdx.x, F.G);
            tr_job_plain(F, args.in[18], DM, DM, 512, (h16*)(ws + OW_UPA), scr, 256);
        }
    }
    SEAM(0);
    if (IN(1)) ph_normmod(F, args.in[0], args.in[5], mod, 1, 0, ws + OFF_H);
    SEAM(1);
    if (IN(2)) { pg8::Gemm g{Hb, (const h16*)(ws + OW_GU1), MT, 2 * FF, DM / 2}; pg8::StaticOrder S; S.init(MT, 2 * FF, F.G, (int)blockIdx.x); pg8::EpiSwiGLU_T<true> E{Ab};
        pg8::gemm_phase<pg8::EpiSwiGLU_T<true>, true, true>(F.lds, g, S, E, F.wave);
        if (F.G == 256 && blockIdx.x >= 128) {
            Frame F2 = F; F2.gw = ((int)blockIdx.x - 128) * NWAVES + F.wave; F2.NGW = 128 * NWAVES; LAS float* scr = (LAS float*)(F.lds + F.wave * 16384);
            tr_job_plain(F2, args.in[8], DM, DM, FF, ws + OW_D1, scr, 0);
            tr_job_mapped(F2, args, 2, NIN3, 0, DM, (h16*)(ws + OW_IN), nullptr, scr, 384);
            tr_job_mapped(F2, args, 3, 512, 2048, QL, (h16*)(ws + OW_4), args.in[12], scr, 896);
            tr_job_mapped(F2, args, 1, 2 * FF, 0, DM, ws + OW_GU2, nullptr, scr, 640);
            precomb_tiles(F, args, ws, 0, 192, (int)blockIdx.x - 128, 128);
            for (int i = ((int)blockIdx.x - 128) * NTHR + F.tid; i < (int)(MiB / 16); i += 128 * NTHR) ((u32x4*)(ws + OW_BD))[i] = (u32x4){0u, 0u, 0u, 0u}; } }
    SEAM(2);
    if (IN(3)) { pg8::Gemm g{Ab, (const h16*)(ws + OW_D1), MT, DM, FF / 2}; pg8::StaticOrder S; S.init(MT, DM, F.G, (int)blockIdx.x); pg8::EpiH16_T<true> E{(h16*)Fb};
        pg8::gemm_phase<pg8::EpiH16_T<true>, false, true>(F.lds, g, S, E, F.wave); }
    SEAM(3);
    if (IN(4)) ph_resnorm<false, true>(F, args.in[0], (const h16*)Fb, args.in[9], mod, 2, 0.5f, args.out, true, args.in[10], 4, 3, Hb, (unsigned char*)args.out + 32 * MiB);
    SEAM(4);
    if (IN(5)) { pg8::Gemm g{Hb, (const h16*)(ws + OW_IN), MT, NIN3, DM}; pg8::StaticOrder S; S.init(MT, NIN3, F.G, (int)blockIdx.x);
        pg8::EpiIn E{(h16*)(ws + OFF_CKV), (h16*)(ws + OFF_CQ), (h16*)(ws + OFF_KR), (h16*)(ws + OFF_KI), (h16*)(ws + OFF_QB), (h16*)(ws + OFF_KB), (h16*)(ws + OFF_VT), (float*)(ws + OFF_WI), (float*)(ws + OFF_SSQ),
                     args.in[13], tab, (LAS float*)(F.lds + XCH_OFF)};
        pg8::gemm_phase<pg8::EpiIn, true>(F.lds, g, S, E, F.wave); }
    SEAM(5);
    if (IN(6)) { for (int tk_ = blockIdx.x * NTHR + F.tid; tk_ < MT; tk_ += F.G * NTHR) { const f32x4 s0 = *(const f32x4*)((const float*)(ws + OFF_SSQ) + tk_ * 8), s1 = *(const f32x4*)((const float*)(ws + OFF_SSQ) + tk_ * 8 + 4);
            ((float*)(ws + OFF_RSTDQ))[tk_] = rsqrtf((((s0.x + s0.y) + (s0.z + s0.w)) + ((s1.x + s1.y) + (s1.z + s1.w))) * (1.f / QL) + EPS); } }
    if (IN(6)) ph_dilated_mfma(F, (const h16*)(ws + OFF_QB), (const h16*)(ws + OFF_KB), (const h16*)(ws + OFF_VT), (h16*)(ws + OFF_OG), (float*)(ws + OFF_LSE));
    SEAM(6);
    if (IN(7)) { pg8::Gemm g{(const h16*)(ws + OFF_CQ), (const h16*)(ws + OW_4), MT, N4, QL}; pg8::StaticOrder S; S.init(MT, N4, F.G, (int)blockIdx.x);
        pg8::Epi4 E{(h16*)(ws + OFF_QLAT), (h16*)(ws + OFF_QR), (h16*)(ws + OFF_QI), (const float*)(ws + OFF_RSTDQ), tab};
        pg8::gemm_phase<pg8::Epi4, true>(F.lds, g, S, E, F.wave);
        if (F.G == 256 && blockIdx.x >= 128) {
            Frame F2 = F; F2.gw = ((int)blockIdx.x - 128) * NWAVES + F.wave; F2.NGW = 128 * NWAVES; LAS float* scr = (LAS float*)(F.lds + F.wave * 16384);
            tr_job_plain(F2, args.in[11] + C_GATE, DIN, 2048, DM, ws + OW_GATE, scr, 0);
            tr_job_plain(F2, args.in[19], DM, DM, 256, (h16*)(ws + OW_UPB), scr, 512);
            tr_job_plain(F2, args.in[20], DM, DM, DM, (h16*)(ws + OW_O), scr, 640);
            tr_job_plain(F2, args.in[18], DM, DM, 512, (h16*)(ws + OW_UPA), scr, 256);
            for (int it = F2.gw; it < 4 * 16; it += F2.NGW) { const int kb = it >> 4, nb = it & 15, n0 = nb * 32, hl = (n0 >> 6) & 3;
                tr_item(args.in[16], 512, n0 + (F.lane & 31), true, nullptr, kb * 64, (h16*)(ws + OW_BD) + (size_t)n0 * 1024 + 256 * hl, 1024, scr, F.lane); } } }
    SEAM(7);
    if (IN(8)) { ph_combine(F, (const h16*)(ws + OFF_OG), (const float*)(ws + OFF_LSE), (h16*)(ws + OFF_OB));
        ph_topk_sparse(F, (const h16*)(ws + OFF_QI), (const h16*)(ws + OFF_KI), (const float*)(ws + OFF_WI), (unsigned short*)(ws + OFF_SEL),
                       (h16*)(ws + OFF_QLAT), (const h16*)(ws + OFF_QR), (const unsigned char*)(ws + OFF_CKV), (const unsigned char*)(ws + OFF_KR)); }
    SEAM(8);
    if (IN(9) && F.G == 256) { const bool first = blockIdx.x < 128;
        pg8::Gemm g{first ? (const h16*)(ws + OFF_QLAT) : (const h16*)(ws + OFF_OB), first ? (const h16*)(ws + OW_BD) : (const h16*)(ws + OW_UPB), MT, first ? 512 : DM, first ? 1024 : 256, first ? 2048 : 0, first ? 1024 : 0};
        pg8::StaticOrder S; S.init(MT, first ? 512 : DM, 128, first ? (int)blockIdx.x : (int)blockIdx.x - 128);
        pg8::EpiH16 E{first ? (h16*)(ws + OFF_OA) : (h16*)(ws + OFF_Y2), first ? 512 : DM};
        pg8::gemm_phase<pg8::EpiH16, false>(F.lds, g, S, E, F.wave); }
    SEAM(9);
    if (IN(10)) { pg8::StaticOrder S; S.init(MT, DM, F.G, (int)blockIdx.x); h16* Y1 = (h16*)(ws + OFF_Y1); h16* Y2 = (h16*)(ws + OFF_Y2);
        { pg8::Gemm g{(const h16*)(ws + OFF_OA), (const h16*)(ws + OW_UPA), MT, DM, 512}; pg8::EpiH16 E{Y1}; pg8::gemm_phase<pg8::EpiH16, false>(F.lds, g, S, E, F.wave); }
        const h16* u8 = (const h16*)((const unsigned char*)args.out + 32 * MiB);
        { pg8::Gemm g{u8, (const h16*)(ws + OW_GATE), MT, DM, DM / 2}; pg8::EpiGate E{Y1, Y1, 0, -LOG2E * F8_INV}; pg8::gemm_phase<pg8::EpiGate, false, true>(F.lds, g, S, E, F.wave); }
        { pg8::Gemm g{u8, (const h16*)(ws + OW_GATE + (size_t)DM * DM), MT, DM, DM / 2}; pg8::EpiGate E{Y2, Y1, 1, -LOG2E * F8_INV}; pg8::gemm_phase<pg8::EpiGate, false, true>(F.lds, g, S, E, F.wave); } }
    SEAM(10);
    if (IN(11)) { pg8::Gemm g{(const h16*)(ws + OFF_Y1), (const h16*)(ws + OW_O), MT, DM, DM}; pg8::StaticOrder S; S.init(MT, DM, F.G, (int)blockIdx.x); pg8::EpiH16 E{(h16*)(ws + OFF_YF)};
        pg8::gemm_phase<pg8::EpiH16, false>(F.lds, g, S, E, F.wave); }
    SEAM(11);
    if (IN(12)) ph_resnorm<true, true, unsigned char>(F, args.out, (const h16*)(ws + OFF_YF), args.in[21], mod, 5, 1.0f, ws + OFF_F, true, args.in[22], 7, 6, ws + OFF_H);
    SEAM(12);
    if (IN(13)) { pg8::Gemm g{Hb, (const h16*)(ws + OW_GU2), MT, 2 * FF, DM / 2}; pg8::StaticOrder S; S.init(MT, 2 * FF, F.G, (int)blockIdx.x); pg8::EpiSwiGLU_T<true> E{Ab};
        pg8::gemm_phase<pg8::EpiSwiGLU_T<true>, true, true>(F.lds, g, S, E, F.wave);
        if (F.G == 256 && blockIdx.x >= 128) { Frame F2 = F; F2.gw = ((int)blockIdx.x - 128) * NWAVES + F.wave; F2.NGW = 128 * NWAVES;
            tr_job_plain(F2, args.in[25], DM, DM, FF, ws + OW_D2, (LAS float*)(F.lds + F.wave * 16384), 0); } }
    SEAM(13);
    if (IN(14)) { pg8::Gemm g{Ab, (const h16*)(ws + OW_D2), MT, DM, FF / 2}; pg8::StaticOrder S; S.init(MT, DM, F.G, (int)blockIdx.x); pg8::EpiH16_T<true> E{(h16*)(ws + OFF_F + 32 * MiB)};
        pg8::gemm_phase<pg8::EpiH16_T<true>, false, true>(F.lds, g, S, E, F.wave); }
    SEAM(14);
    if (IN(15)) ph_resnorm<true, false>(F, ws + OFF_F, (const h16*)(ws + OFF_F + 32 * MiB), args.in[26], mod, 8, 0.5f, args.out, false, nullptr, 0, 0, (h16*)nullptr);
#undef IN
#undef SEAM
}


extern "C" void kernel_launch(void* const* d_in, const int* in_sizes, int n_in, void* d_out, int out_size, void* d_ws, size_t ws_size, hipStream_t stream) {
    if (n_in != 27 || ws_size < WS_END || out_size != MT * DM) { fprintf(stderr, "kernel_launch: unexpected shapes (n_in %d ws %zu out %d)\n", n_in, ws_size, out_size); return; }
    static int grid = 0;
    if (grid == 0) {
        int dev = 0, cus = 0, per_cu = 0;
        if (hipGetDevice(&dev) != hipSuccess || hipDeviceGetAttribute(&cus, hipDeviceAttributeMultiprocessorCount, dev) != hipSuccess) { grid = -1; return; }
        if (hipFuncSetAttribute((const void*)mega_fwd, hipFuncAttributeMaxDynamicSharedMemorySize, LDS_BYTES) != hipSuccess) { fprintf(stderr, "kernel_launch: hipFuncSetAttribute failed\n"); grid = -1; return; }
        if (hipOccupancyMaxActiveBlocksPerMultiprocessor(&per_cu, (const void*)mega_fwd, NTHR, LDS_BYTES) != hipSuccess || per_cu < 1) { fprintf(stderr, "kernel_launch: occupancy query says %d blocks/CU\n", per_cu); grid = -1; return; }
        grid = cus;
    }
    if (grid < 0) return;
    hipMemsetAsync((char*)d_ws + OFF_CTL, 0, 1 * MiB, stream);
    Args a{}; for (int i = 0; i < 27; ++i) a.in[i] = (const float*)d_in[i]; a.out = (float*)d_out; a.ws = (unsigned char*)d_ws; a.ph_lo = 0; a.ph_hi = 16;
    void* kargs[] = {&a};
#ifdef PH_DOUBLE
    a.ph_hi = PH_DOUBLE + 1; (void)hipLaunchCooperativeKernel((const void*)mega_fwd, dim3(grid), dim3(NTHR), kargs, LDS_BYTES, stream);
    hipMemsetAsync((char*)d_ws + OFF_CTL, 0, 1 * MiB, stream); a.ph_lo = PH_DOUBLE; a.ph_hi = 16;
#endif
    const hipError_t e = hipLaunchCooperativeKernel((const void*)mega_fwd, dim3(grid), dim3(NTHR), kargs, LDS_BYTES, stream);
    if (e != hipSuccess) fprintf(stderr, "kernel_launch: cooperative launch failed: %s (grid %d)\n", hipGetErrorString(e), grid);
    (void)in_sizes;
}
```

```cpp
#include <hip/hip_runtime.h>
#include <hip/hip_fp16.h>
#include <cstdio>
#include <cstdint>

constexpr int NB = 4, SEQ = 4096, DM = 1024, MT = NB * SEQ, FF = 2816;
constexpr int QL = 384, KVL = 256, DNOPE = 64, DROPE = 32, DVA = 64, HA = 8, HI = 8, DI = 32, TOPK = 256;
constexpr int NG = 3, HB = 4, DHB = 64, NMOD = 9, DIN = 5064;
constexpr int C_CQ = 0, C_CKV = 384, C_KR = 640, C_KI = 672, C_WI = 704, C_QKV = 712, C_GATE = 3016;
constexpr float EPS = 1e-6f, LOG2E = 1.4426950408889634f;
typedef _Float16 h16;

constexpr size_t MiB = 1u << 20;
constexpr size_t OFF_CTL = 0, OFF_MOD = 1 * MiB, OFF_ROPE = 2 * MiB, OFF_W = 8 * MiB, OFF_H = 60 * MiB, OFF_A = 92 * MiB, OFF_F = 180 * MiB, OFF_SP = 244 * MiB, WS_END = 256 * MiB;
constexpr size_t OFF_QB = OFF_A, OFF_KB = OFF_A + 24 * MiB, OFF_VT = OFF_A + 48 * MiB, OFF_CKV = OFF_A + 72 * MiB, OFF_KR = OFF_A + 80 * MiB, OFF_KI = OFF_A + 81 * MiB,
                 OFF_WI = OFF_A + 82 * MiB, OFF_SSQ = OFF_A + 82 * MiB + 512 * 1024, OFF_CQ = OFF_SP;
constexpr size_t OFF_RSTDQ = OFF_A + 83 * MiB;
constexpr size_t OFF_OG = OFF_F, OFF_LSE = OFF_F + 24 * MiB, OFF_QLAT = OFF_A, OFF_QR = OFF_A + 64 * MiB, OFF_QI = OFF_F + 25 * MiB, OFF_SEL = OFF_F + 33 * MiB, OFF_OB = OFF_SP;
constexpr size_t OFF_Y1 = OFF_F, OFF_Y2 = OFF_F + 32 * MiB, OFF_YF = OFF_A;

__device__ __forceinline__ float silu_f(float v) { return v / (1.f + __expf(-v)); }
__device__ __forceinline__ float sigm_f(float v) { return 1.f / (1.f + __expf(-v)); }
__host__ __device__ __forceinline__ int dil_of(int g) { return g == 0 ? 1 : (g == 1 ? 4 : 16); }
__device__ __forceinline__ unsigned fkey(float f) { const unsigned u = __float_as_uint(f); return (u & 0x80000000u) ? ~u : (u | 0x80000000u); }


#define LAS __attribute__((address_space(3)))
#define GAS __attribute__((address_space(1)))
typedef _Float16 f16x8 __attribute__((ext_vector_type(8)));
typedef float f32x4 __attribute__((ext_vector_type(4)));
typedef float f32x2 __attribute__((ext_vector_type(2)));
typedef unsigned u32x4 __attribute__((ext_vector_type(4)));
typedef unsigned u32x2 __attribute__((ext_vector_type(2)));
typedef _Float16 h16x2 __attribute__((ext_vector_type(2)));
__device__ __forceinline__ unsigned pk_h2(float lo, float hi) { f32x2 v = {lo, hi}; h16x2 h = __builtin_convertvector(v, h16x2); return __builtin_bit_cast(unsigned, h); }
__device__ __forceinline__ int flane() { int l; asm volatile("v_mbcnt_lo_u32_b32 %0, -1, 0\n\tv_mbcnt_hi_u32_b32 %0, -1, %0" : "=v"(l)); return l; }
__device__ __forceinline__ float sat8(float x) { return __builtin_amdgcn_fmed3f(x, -448.f, 448.f); }
__device__ __forceinline__ unsigned pk_f8x4(float a, float b, float c, float d) { int w = __builtin_amdgcn_cvt_pk_fp8_f32(sat8(a), sat8(b), 0, false); w = __builtin_amdgcn_cvt_pk_fp8_f32(sat8(c), sat8(d), w, true); return (unsigned)w; }
typedef int i32x4 __attribute__((ext_vector_type(4)));
typedef int i32x8 __attribute__((ext_vector_type(8)));
constexpr float F8_ACT = 8.f, F8_WGT = 512.f, F8_INV = 1.f / (F8_ACT * F8_WGT);

namespace pg8 {
constexpr int BM = 256, BK = 64, HALF = 128, HTB = HALF * BK * 2, STAGE_BYTES = 8 * HTB, NXCD = 8, WGM = 8;
__host__ __device__ __forceinline__ int lds_byte(int r, int c) { const int st = (r >> 4) * 2 + (c >> 5), rr = r & 15, cc = c & 31, ob = rr * 64 + cc * 2; return st * 1024 + (ob ^ (((ob >> 9) & 1) << 5)); }
__host__ __device__ __forceinline__ void stage_rc(int b, int& R, int& C) { const int st = b / 1024, sb = b % 1024, swz = sb ^ (((sb >> 9) & 1) << 5); R = (st >> 1) * 16 + swz / 64; C = (st & 1) * 32 + (swz % 64) / 2; }
__host__ __device__ __forceinline__ int perm32(int rho) { const int n = rho >> 4, i = rho & 15; return 8 * (i >> 2) + 4 * n + (i & 3); }
struct Unit { int pm, pn; };
struct Gemm { const h16* A; const h16* Bt; int M, N, K; int lda = 0, koffA = 0; };
struct StaticOrder {
    int nM, nN, nwg, G, c;
    __host__ __device__ void init(int M, int N, int G_, int c_) { nM = M / BM; nN = N / BM; nwg = nM * nN; G = G_; c = c_; }
    __host__ __device__ bool next(int i, Unit& u) const {
        const long L = (long)i * G + c; if (L >= nwg) return false;
        int wgid = (int)L; { const int q = nwg / NXCD, r = nwg % NXCD, xcd = wgid % NXCD, off = wgid / NXCD; wgid = (xcd < r ? xcd * (q + 1) : r * (q + 1) + (xcd - r) * q) + off; }
        const int nig = WGM * nN, gid = wgid / nig, fm = gid * WGM, gsz = (nM - fm) < WGM ? (nM - fm) : WGM;
        u.pm = fm + ((wgid % nig) % gsz); u.pn = (wgid % nig) / gsz; return true;
    }
};
template <class Epi, bool ALIGN_EPI, bool F8 = false>
__device__ __forceinline__ void gemm_phase(LAS unsigned char* lds, const Gemm g, const StaticOrder& S, const Epi& E, const int wid) {
    const int lane = flane(), tid = wid * 64 + lane, wr = wid >> 2, wc = wid & 3, fr = lane & 15, fq = lane >> 4;
    const int K = g.K, lda = g.lda ? g.lda : g.K; int nt = K / BK;
    if constexpr (F8) asm volatile("" : "+s"(nt));
    unsigned voffA[2], voffB[2];
#pragma unroll
    for (int i = 0; i < 2; ++i) { int R, C; stage_rc(tid * 16 + i * 8192, R, C); const int Rb = Epi::PERM ? ((R & ~31) + perm32(R & 31)) : R;
        voffA[i] = (unsigned)(R * lda + C) * 2u; voffB[i] = (unsigned)(Rb * K + C) * 2u; }
    const size_t kstep = (size_t)(BK * 2);
    const size_t hstep = (size_t)HALF * K * 2, hstepA = (size_t)HALF * lda * 2;
    const size_t tstep = 2 * hstep, tstepA = 2 * hstepA, kofA = (size_t)g.koffA * 2;
    const unsigned ldsw = (unsigned)wid * 1024u;
    const int aoff = lds_byte(wr * 64 + fr, fq * 8), boff = lds_byte(wc * 32 + fr, fq * 8);
#define PG8_SA(b, h) (((b) * 2 + (h)) * HTB)
#define PG8_SB(b, h) ((4 + (b) * 2 + (h)) * HTB)
#define PG8_STAGE(bufoff, gbase, voff) do { _Pragma("unroll") for (int _i = 0; _i < 2; ++_i) { unsigned _vo = (voff)[_i]; asm volatile("" : "+v"(_vo)); \
        __builtin_amdgcn_global_load_lds((const unsigned*)((const char*)(gbase) + _vo), (LAS unsigned*)(lds + (bufoff) + ldsw + _i * 8192), 16, 0, 0); } } while (0)
#define PG8_LDA(dst, b, h) do { _Pragma("unroll") for (int m = 0; m < 4; ++m) _Pragma("unroll") for (int k = 0; k < 2; ++k) dst[m][k] = *(const LAS f16x8*)(lds + PG8_SA(b, h) + aoff + m * 2048 + k * 1024); } while (0)
#define PG8_LDB(dst, b, h) do { _Pragma("unroll") for (int n = 0; n < 2; ++n) _Pragma("unroll") for (int k = 0; k < 2; ++k) dst[n][k] = *(const LAS f16x8*)(lds + PG8_SB(b, h) + boff + n * 2048 + k * 1024); } while (0)
#define PG8_CAT8(x, y) __builtin_shufflevector(__builtin_bit_cast(i32x4, x), __builtin_bit_cast(i32x4, y), 0, 1, 2, 3, 4, 5, 6, 7)
#define PG8_MMA(ai, bj, At, Bt) do { __builtin_amdgcn_s_setprio(1); \
        if constexpr (F8) { _Pragma("unroll") for (int m = 0; m < 4; ++m) _Pragma("unroll") for (int n = 0; n < 2; ++n) \
            acc[ai][bj][m][n] = __builtin_amdgcn_mfma_scale_f32_16x16x128_f8f6f4(PG8_CAT8(Bt[n][0], Bt[n][1]), PG8_CAT8(At[m][0], At[m][1]), acc[ai][bj][m][n], 0, 0, 0, 0, 0, 0); } \
        else { _Pragma("unroll") for (int m = 0; m < 4; ++m) _Pragma("unroll") for (int n = 0; n < 2; ++n) _Pragma("unroll") for (int k = 0; k < 2; ++k) \
            acc[ai][bj][m][n] = __builtin_amdgcn_mfma_f32_16x16x32_f16(Bt[n][k], At[m][k], acc[ai][bj][m][n], 0, 0, 0); } \
        __builtin_amdgcn_s_setprio(0); } while (0)
#define PG8_WAIT_V(n) asm volatile("s_waitcnt vmcnt(" #n ")" ::: "memory")
#define PG8_WAIT_L(n) asm volatile("s_waitcnt lgkmcnt(" #n ")" ::: "memory")
#define PG8_BAR __builtin_amdgcn_s_barrier()
#define PG8_SCHED __builtin_amdgcn_sched_barrier(0)
    Unit cur, nxt; int ui = 0;
    if (!S.next(0, cur)) return;
    f32x4 acc[2][2][4][2];
#pragma unroll
    for (int a = 0; a < 2; ++a)
#pragma unroll
        for (int b = 0; b < 2; ++b)
#pragma unroll
            for (int m = 0; m < 4; ++m)
#pragma unroll
                for (int n = 0; n < 2; ++n) acc[a][b][m][n] = (f32x4){0.f, 0.f, 0.f, 0.f};
    f16x8 At[4][2], B0[2][2], B1[2][2];
    const char* cA = (const char*)g.A + (size_t)cur.pm * tstepA + (size_t)cur.pn * kofA; const char* cB = (const char*)g.Bt + (size_t)cur.pn * tstep;
    PG8_STAGE(PG8_SB(0, 0), cB, voffB); PG8_STAGE(PG8_SB(0, 1), cB + hstep, voffB); PG8_STAGE(PG8_SA(0, 0), cA, voffA); PG8_STAGE(PG8_SA(0, 1), cA + hstepA, voffA);
    if (wr == 1) PG8_BAR;
    PG8_WAIT_V(2); PG8_BAR;
    PG8_STAGE(PG8_SB(1, 0), cB + kstep, voffB); PG8_STAGE(PG8_SA(1, 0), cA + kstep, voffA); PG8_STAGE(PG8_SB(1, 1), cB + hstep + kstep, voffB);
    PG8_WAIT_V(6); PG8_BAR;
    for (;;) {
        const bool has_next = S.next(ui + 1, nxt);
        const char* nA = has_next ? (const char*)g.A + (size_t)nxt.pm * tstepA + (size_t)nxt.pn * kofA : cA; const char* nB = has_next ? (const char*)g.Bt + (size_t)nxt.pn * tstep : cB;
        for (int t = 0; t < nt; t += 2) {
            const bool last = (t == nt - 2);
            const char* a1 = cA + (size_t)(t + 1) * kstep;
            const char* a2 = last ? nA : cA + (size_t)(t + 2) * kstep; const char* b2 = last ? nB : cB + (size_t)(t + 2) * kstep;
            const char* a3 = a2 + kstep; const char* b3 = b2 + kstep;
            PG8_LDB(B0, 0, 0); PG8_LDB(B1, 0, 1); PG8_SCHED; PG8_LDA(At, 0, 0); PG8_STAGE(PG8_SA(1, 1), a1 + hstepA, voffA);
            PG8_WAIT_V(8); PG8_WAIT_L(0); PG8_BAR; PG8_MMA(0, 0, At, B0); PG8_MMA(0, 1, At, B1); PG8_BAR; PG8_SCHED;
            PG8_LDA(At, 0, 1); PG8_STAGE(PG8_SB(0, 0), b2, voffB); PG8_STAGE(PG8_SB(0, 1), b2 + hstep, voffB); PG8_STAGE(PG8_SA(0, 0), a2, voffA);
            PG8_WAIT_V(8); PG8_WAIT_L(0); PG8_BAR; PG8_MMA(1, 0, At, B0); PG8_MMA(1, 1, At, B1); PG8_BAR; PG8_SCHED;
            PG8_LDB(B0, 1, 0); PG8_LDB(B1, 1, 1); PG8_SCHED; PG8_LDA(At, 1, 0); PG8_STAGE(PG8_SA(0, 1), a2 + hstepA, voffA);
            PG8_WAIT_V(8); PG8_WAIT_L(0); PG8_BAR; PG8_MMA(0, 0, At, B0); PG8_MMA(0, 1, At, B1); PG8_BAR; PG8_SCHED;
            PG8_LDA(At, 1, 1); PG8_STAGE(PG8_SB(1, 0), b3, voffB); PG8_STAGE(PG8_SB(1, 1), b3 + hstep, voffB); PG8_STAGE(PG8_SA(1, 0), a3, voffA);
            PG8_WAIT_V(8); PG8_WAIT_L(0); PG8_BAR; PG8_MMA(1, 0, At, B0); PG8_MMA(1, 1, At, B1); PG8_BAR; PG8_SCHED;
        }
        if constexpr (ALIGN_EPI) { if (wr == 0) PG8_BAR; }
        { const int l2 = flane(); E(acc, cur, wr, wc, l2 & 15, l2 >> 4); }
        if (!has_next) break;
#pragma unroll
        for (int a = 0; a < 2; ++a)
#pragma unroll
            for (int b = 0; b < 2; ++b)
#pragma unroll
                for (int m = 0; m < 4; ++m)
#pragma unroll
                    for (int n = 0; n < 2; ++n) acc[a][b][m][n] = (f32x4){0.f, 0.f, 0.f, 0.f};
        cur = nxt; cA = nA; cB = nB; ++ui;
        if constexpr (ALIGN_EPI) { if (wr == 1) PG8_BAR; }
    }
    PG8_WAIT_V(0);
    if constexpr (!ALIGN_EPI) { if (wr == 0) PG8_BAR; }
    PG8_BAR;
#undef PG8_SA
#undef PG8_SB
#undef PG8_STAGE
#undef PG8_LDA
#undef PG8_LDB
#undef PG8_MMA
#undef PG8_CAT8
#undef PG8_WAIT_V
#undef PG8_WAIT_L
#undef PG8_BAR
#undef PG8_SCHED
}
struct EpiF32 {
    static constexpr bool PERM = false;
    float* C; int ldc;
    __device__ __forceinline__ void operator()(const f32x4 (&acc)[2][2][4][2], const Unit& u, int wr, int wc, int fr, int fq) const {
        const int row0 = u.pm * BM + wr * 64 + fr, col0 = u.pn * BM + wc * 32 + 4 * fq;
#pragma unroll
        for (int ai = 0; ai < 2; ++ai)
#pragma unroll
            for (int m = 0; m < 4; ++m) { float* rowp = C + (size_t)(row0 + ai * HALF + m * 16) * ldc + col0;
#pragma unroll
                for (int bj = 0; bj < 2; ++bj)
#pragma unroll
                    for (int n = 0; n < 2; ++n) *(f32x4*)(rowp + bj * HALF + n * 16) = acc[ai][bj][m][n]; }
    }
};
template <bool F8>
struct EpiSwiGLU_T {
    static constexpr bool PERM = true;
    void* O;
    __device__ __forceinline__ void operator()(const f32x4 (&acc)[2][2][4][2], const Unit& u, int wr, int wc, int fr, int fq) const {
        const int row0 = u.pm * BM + wr * 64 + fr, col0 = u.pn * HALF + wc * 32 + 8 * fq;
#pragma unroll
        for (int ai = 0; ai < 2; ++ai)
#pragma unroll
            for (int m = 0; m < 4; ++m) { const size_t eo = (size_t)(row0 + ai * HALF + m * 16) * FF + col0;
                float v[8];
#pragma unroll
                for (int n = 0; n < 2; ++n)
#pragma unroll
                    for (int e = 0; e < 4; ++e) { float gg = acc[ai][0][m][n][e], uu = acc[ai][1][m][n][e]; if constexpr (F8) { gg *= F8_INV; uu *= F8_INV * F8_ACT; }
                        v[n * 4 + e] = gg * __builtin_amdgcn_rcpf(1.f + __builtin_amdgcn_exp2f(-gg * LOG2E)) * uu; }
                if constexpr (F8) { u32x2 w; w.x = pk_f8x4(v[0], v[1], v[2], v[3]); w.y = pk_f8x4(v[4], v[5], v[6], v[7]); *(u32x2*)((unsigned char*)O + eo) = w; }
                else { u32x4 w; w.x = pk_h2(v[0], v[1]); w.y = pk_h2(v[2], v[3]); w.z = pk_h2(v[4], v[5]); w.w = pk_h2(v[6], v[7]); *(u32x4*)((h16*)O + eo) = w; } }
    }
};
typedef EpiSwiGLU_T<false> EpiSwiGLU;

struct EpiIn {
    static constexpr bool PERM = false;
    h16 *ckv, *cq, *kr, *ki, *qb, *kb, *vT; float *wi, *ssq; const float* gckv; const float2* tab; LAS float* X;
    __device__ __forceinline__ void rope64(const f32x4 (&acc)[2][2][4][2], const Unit& u, int wr, int wc, int fr, int fq, h16* dst, int tl, float scale) const {
        const int tok0 = u.pm * BM + wr * 64 + fr;
        f32x4 tc[4], tn[4];
        { const f32x4* tp = (const f32x4*)(tab + (size_t)tok0 * 48 + 4 * fq); tc[0] = tp[0]; tc[1] = tp[1]; tc[2] = tp[8]; tc[3] = tp[9]; }
#pragma unroll
        for (int rr = 0; rr < 8; ++rr) { const int ai = rr >> 2, m = rr & 3, tok = tok0 + ai * HALF + m * 16;
            if (rr < 7) { const int tokn = tok0 + ((rr + 1) >> 2) * HALF + ((rr + 1) & 3) * 16; const f32x4* tp = (const f32x4*)(tab + (size_t)tokn * 48 + 4 * fq); tn[0] = tp[0]; tn[1] = tp[1]; tn[2] = tp[8]; tn[3] = tp[9]; }
#pragma unroll
            for (int n = 0; n < 2; ++n) { const int i = 16 * n + 4 * fq; const f32x4 t0 = tc[2 * n], t1 = tc[2 * n + 1];
                const f32x4 cs = {t0.x, t0.z, t1.x, t1.z}, sn = {t0.y, t0.w, t1.y, t1.w}, x1 = acc[ai][0][m][n], x2 = acc[ai][1][m][n];
                const f32x4 o1 = (x1 * cs - x2 * sn) * scale, o2 = (x2 * cs + x1 * sn) * scale;
                h16* p = dst + (size_t)tok * 768 + (4 * tl + wc) * 64 + i;
                u32x2 w1, w2; w1.x = pk_h2(o1.x, o1.y); w1.y = pk_h2(o1.z, o1.w); w2.x = pk_h2(o2.x, o2.y); w2.y = pk_h2(o2.z, o2.w);
                *(u32x2*)p = w1; *(u32x2*)(p + 32) = w2; }
#pragma unroll
            for (int k = 0; k < 4; ++k) tc[k] = tn[k];
            asm volatile("" ::: "memory"); }
    }
    __device__ __forceinline__ void operator()(const f32x4 (&acc)[2][2][4][2], const Unit& u, int wr, int wc, int fr, int fq) const {
        const int pn = u.pn;
        if (pn == 0) {
#pragma unroll
            for (int ai = 0; ai < 2; ++ai)
#pragma unroll
                for (int m = 0; m < 4; ++m) { float sq = 0.f;
#pragma unroll
                    for (int bj = 0; bj < 2; ++bj)
#pragma unroll
                        for (int n = 0; n < 2; ++n) { const f32x4 v = acc[ai][bj][m][n]; sq += (v.x * v.x + v.y * v.y) + (v.z * v.z + v.w * v.w); }
                    sq += __shfl_xor(sq, 16); sq += __shfl_xor(sq, 32);
                    if (fq == 0) X[(ai * HALF + wr * 64 + m * 16 + fr) * 4 + wc] = sq; }
            asm volatile("s_waitcnt lgkmcnt(0)" ::: "memory"); __builtin_amdgcn_s_barrier(); asm volatile("" ::: "memory");
#pragma unroll
            for (int ai = 0; ai < 2; ++ai)
#pragma unroll
                for (int m = 0; m < 4; ++m) { const int rl = ai * HALF + wr * 64 + m * 16 + fr, tok = u.pm * BM + rl; const f32x4 p = *(const LAS f32x4*)(X + rl * 4);
                    const float rstd = rsqrtf(((p.x + p.y) + (p.z + p.w)) * (1.f / KVL) + EPS);
#pragma unroll
                    for (int bj = 0; bj < 2; ++bj)
#pragma unroll
                        for (int n = 0; n < 2; ++n) { const int col = bj * HALF + wc * 32 + n * 16 + 4 * fq; const f32x4 o = acc[ai][bj][m][n] * rstd * *(const f32x4*)(gckv + col);
                            int w8 = __builtin_amdgcn_cvt_pk_fp8_f32(o.x, o.y, 0, false); w8 = __builtin_amdgcn_cvt_pk_fp8_f32(o.z, o.w, w8, true);
                            *(int*)((unsigned char*)ckv + (size_t)tok * KVL + col) = w8; }
                    asm volatile("" ::: "memory"); }
            asm volatile("s_waitcnt lgkmcnt(0)" ::: "memory"); __builtin_amdgcn_s_barrier(); asm volatile("" ::: "memory");
        } else if (pn <= 2) {
#pragma unroll
            for (int ai = 0; ai < 2; ++ai)
#pragma unroll
                for (int m = 0; m < 4; ++m) { const int tok = u.pm * BM + ai * HALF + wr * 64 + m * 16 + fr; float sq = 0.f;
#pragma unroll
                    for (int bj = 0; bj < 2; ++bj) { if (pn == 2 && bj == 1) break;
#pragma unroll
                        for (int n = 0; n < 2; ++n) { const f32x4 v = acc[ai][bj][m][n]; sq += (v.x * v.x + v.y * v.y) + (v.z * v.z + v.w * v.w);
                            const int col = (pn - 1) * 256 + bj * HALF + wc * 32 + n * 16 + 4 * fq; u32x2 w; w.x = pk_h2(v.x, v.y); w.y = pk_h2(v.z, v.w); *(u32x2*)(cq + (size_t)tok * QL + col) = w; } }
                    sq += __shfl_xor(sq, 16); sq += __shfl_xor(sq, 32);
                    if (fq == 0) ssq[tok * 8 + (pn - 1) * 4 + wc] = sq;
                    if (pn == 2) {
                        if (wc < 2) { const int i = 4 * fq; const f32x4* tp = (const f32x4*)(tab + (size_t)tok * 48 + 32 + i); const f32x4 t0 = tp[0], t1 = tp[1];
                            const f32x4 cs = {t0.x, t0.z, t1.x, t1.z}, sn = {t0.y, t0.w, t1.y, t1.w}, x1 = acc[ai][1][m][0], x2 = acc[ai][1][m][1];
                            const f32x4 o1 = x1 * cs - x2 * sn, o2 = x2 * cs + x1 * sn;
                            if (wc == 0) { unsigned char* p8 = (unsigned char*)kr + (size_t)tok * 32 + i;
                                int a8 = __builtin_amdgcn_cvt_pk_fp8_f32(o1.x, o1.y, 0, false); a8 = __builtin_amdgcn_cvt_pk_fp8_f32(o1.z, o1.w, a8, true);
                                int b8 = __builtin_amdgcn_cvt_pk_fp8_f32(o2.x, o2.y, 0, false); b8 = __builtin_amdgcn_cvt_pk_fp8_f32(o2.z, o2.w, b8, true);
                                *(int*)p8 = a8; *(int*)(p8 + 16) = b8; }
                            else { h16* p = ki + (size_t)tok * 32 + i;
                                u32x2 w1, w2; w1.x = pk_h2(o1.x, o1.y); w1.y = pk_h2(o1.z, o1.w); w2.x = pk_h2(o2.x, o2.y); w2.y = pk_h2(o2.z, o2.w);
                                *(u32x2*)p = w1; *(u32x2*)(p + 16) = w2; } }
                        else if (wc == 2 && fq < 2) { *(f32x4*)(wi + tok * 8 + 4 * fq) = acc[ai][1][m][0] * 0.35355339059327373f; }
                    }
                    asm volatile("" ::: "memory"); }
        } else if (pn <= 5) rope64(acc, u, wr, wc, fr, fq, qb, pn - 3, 0.125f * LOG2E);
        else if (pn <= 8) rope64(acc, u, wr, wc, fr, fq, kb, pn - 6, 1.0f);
        else {
#pragma unroll
            for (int ai = 0; ai < 2; ++ai)
#pragma unroll
                for (int m = 0; m < 4; ++m) { const int tok = u.pm * BM + ai * HALF + wr * 64 + m * 16 + fr;
#pragma unroll
                    for (int bj = 0; bj < 2; ++bj)
#pragma unroll
                        for (int n = 0; n < 2; ++n) { const f32x4 v = acc[ai][bj][m][n]; u32x2 w; w.x = pk_h2(v.x, v.y); w.y = pk_h2(v.z, v.w);
                            *(u32x2*)(vT + (size_t)tok * 768 + (pn - 9) * 256 + bj * HALF + wc * 32 + n * 16 + 4 * fq) = w; }
                    asm volatile("" ::: "memory"); }
        }
    }
};
struct Epi4 {
    static constexpr bool PERM = true;
    h16 *qlat, *qr, *qi; const float* rstdq; const float2* tab;
    __device__ __forceinline__ void operator()(const f32x4 (&acc)[2][2][4][2], const Unit& u, int wr, int wc, int fr, int fq) const {
        const int pn = u.pn; const float c2 = 0.10206207261596575f * LOG2E;
        const int tok0 = u.pm * BM + wr * 64 + fr;
        float rc = rstdq[tok0], rn = 0.f;
        if (pn < 8) {
#pragma unroll
            for (int rr = 0; rr < 8; ++rr) { const int ai = rr >> 2, m = rr & 3, tok = tok0 + ai * HALF + m * 16;
                if (rr < 7) rn = rstdq[tok0 + ((rr + 1) >> 2) * HALF + ((rr + 1) & 3) * 16];
#pragma unroll
                for (int bj = 0; bj < 2; ++bj) { const f32x4 o0 = acc[ai][bj][m][0] * (rc * c2), o1 = acc[ai][bj][m][1] * (rc * c2);
                    u32x4 w; w.x = pk_h2(o0.x, o0.y); w.y = pk_h2(o0.z, o0.w); w.z = pk_h2(o1.x, o1.y); w.w = pk_h2(o1.z, o1.w);
                    *(u32x4*)(qlat + (size_t)tok * 2048 + pn * 256 + bj * HALF + wc * 32 + 8 * fq) = w; }
                rc = rn; asm volatile("" ::: "memory"); }
        } else { h16* dst = (pn == 8) ? qr : qi; const float c2e = (pn == 8) ? c2 : 1.f; const int i = 4 * fq;
            f32x4 tc[2], tn[2];
            { const f32x4* tp = (const f32x4*)(tab + (size_t)tok0 * 48 + 32 + i); tc[0] = tp[0]; tc[1] = tp[1]; }
#pragma unroll
            for (int rr = 0; rr < 8; ++rr) { const int ai = rr >> 2, m = rr & 3, tok = tok0 + ai * HALF + m * 16;
                if (rr < 7) { const int tokn = tok0 + ((rr + 1) >> 2) * HALF + ((rr + 1) & 3) * 16; const f32x4* tp = (const f32x4*)(tab + (size_t)tokn * 48 + 32 + i); tn[0] = tp[0]; tn[1] = tp[1]; rn = rstdq[tokn]; }
                const f32x4 cs = {tc[0].x, tc[0].z, tc[1].x, tc[1].z}, sn = {tc[0].y, tc[0].w, tc[1].y, tc[1].w}; const float sc = rc * c2e;
#pragma unroll
                for (int bj = 0; bj < 2; ++bj) { const f32x4 x1 = acc[ai][bj][m][0], x2 = acc[ai][bj][m][1]; const f32x4 o1 = (x1 * cs - x2 * sn) * sc, o2 = (x2 * cs + x1 * sn) * sc;
                    h16* p = dst + (size_t)tok * 256 + (4 * bj + wc) * 32 + i;
                    u32x2 w1, w2; w1.x = pk_h2(o1.x, o1.y); w1.y = pk_h2(o1.z, o1.w); w2.x = pk_h2(o2.x, o2.y); w2.y = pk_h2(o2.z, o2.w);
                    *(u32x2*)p = w1; *(u32x2*)(p + 16) = w2; }
                tc[0] = tn[0]; tc[1] = tn[1]; rc = rn;
                asm volatile("" ::: "memory"); } }
    }
};
__device__ __forceinline__ u32x4 ld16_l2(const h16* p) {
    const unsigned long long a = __hip_atomic_load((const unsigned long long*)p, __ATOMIC_RELAXED, __HIP_MEMORY_SCOPE_AGENT), b = __hip_atomic_load((const unsigned long long*)p + 1, __ATOMIC_RELAXED, __HIP_MEMORY_SCOPE_AGENT);
    return (u32x4){(unsigned)a, (unsigned)(a >> 32), (unsigned)b, (unsigned)(b >> 32)};
}
typedef _Float16 h16x8 __attribute__((ext_vector_type(8)));
__device__ __forceinline__ void unpk8(const u32x4 w, float (&f)[8]) {
    const h16x8 h = __builtin_bit_cast(h16x8, w);
#pragma unroll
    for (int i = 0; i < 8; ++i) f[i] = (float)h[i];
}
template <bool SC>
struct EpiH16_T {
    static constexpr bool PERM = true;
    h16* O; int ldc = DM;
    __device__ __forceinline__ void operator()(const f32x4 (&acc)[2][2][4][2], const Unit& u, int wr, int wc, int fr, int fq) const {
        const int row0 = u.pm * BM + wr * 64 + fr, col0 = u.pn * BM + wc * 32 + 8 * fq;
#pragma unroll
        for (int ai = 0; ai < 2; ++ai)
#pragma unroll
            for (int m = 0; m < 4; ++m)
#pragma unroll
                for (int bj = 0; bj < 2; ++bj) { f32x4 v0 = acc[ai][bj][m][0], v1 = acc[ai][bj][m][1]; if constexpr (SC) { v0 *= F8_INV; v1 *= F8_INV; }
                    u32x4 w; w.x = pk_h2(v0.x, v0.y); w.y = pk_h2(v0.z, v0.w); w.z = pk_h2(v1.x, v1.y); w.w = pk_h2(v1.z, v1.w);
                    *(u32x4*)(O + (size_t)(row0 + ai * HALF + m * 16) * ldc + col0 + bj * HALF) = w; }
    }
};
typedef EpiH16_T<false> EpiH16;
struct EpiGate {
    static constexpr bool PERM = true;
    const h16* Y; h16* Z; int accum; float nls;
    __device__ __forceinline__ void operator()(const f32x4 (&acc)[2][2][4][2], const Unit& u, int wr, int wc, int fr, int fq) const {
        const int row0 = u.pm * BM + wr * 64 + fr, col0 = u.pn * BM + wc * 32 + 8 * fq;
#pragma unroll
        for (int ai = 0; ai < 2; ++ai)
#pragma unroll
            for (int m = 0; m < 4; ++m)
#pragma unroll
                for (int bj = 0; bj < 2; ++bj) { const size_t off = (size_t)(row0 + ai * HALF + m * 16) * DM + col0 + bj * HALF;
                    float y[8], zz[8]; unpk8(ld16_l2(Y + off), y);
                    if (accum) unpk8(ld16_l2(Z + off), zz); else {
#pragma unroll
                        for (int i = 0; i < 8; ++i) zz[i] = 0.f; }
                    float o[8];
#pragma unroll
                    for (int n = 0; n < 2; ++n)
#pragma unroll
                        for (int e = 0; e < 4; ++e) { const float gg = acc[ai][bj][m][n][e]; o[n * 4 + e] = zz[n * 4 + e] + y[n * 4 + e] * __builtin_amdgcn_rcpf(1.f + __builtin_amdgcn_exp2f(gg * nls)); }
                    u32x4 w; w.x = pk_h2(o[0], o[1]); w.y = pk_h2(o[2], o[3]); w.z = pk_h2(o[4], o[5]); w.w = pk_h2(o[6], o[7]);
                    *(u32x4*)(Z + off) = w; }
    }
};
}

#define XB_TMO      128
#define XB_XCNT(j)  (256  + 64 * (j))
#define XB_XSUB(j)  (1280 + 64 * (j))
#define XB_XGEN(j)  (2304 + 64 * (j))
#define XB_TOP      3328
#define XB_TOPGEN   3392
#define XCD_BAR_WORDS 3456
#define XB_SPIN_CAP (1u << 18)
__device__ __forceinline__ unsigned xb_ld(unsigned* p)              { return __hip_atomic_load(p, __ATOMIC_RELAXED, __HIP_MEMORY_SCOPE_AGENT); }
__device__ __forceinline__ unsigned xb_add(unsigned* p, unsigned v) { return __hip_atomic_fetch_add(p, v, __ATOMIC_RELAXED, __HIP_MEMORY_SCOPE_AGENT); }
__device__ __forceinline__ unsigned xb_xcc_id() { return (unsigned)__builtin_amdgcn_s_getreg((3 << 11) | 20) & 0xFu; }
#define XB_SPIN(cond, bar) do { unsigned _sp = 0; while (cond) { __builtin_amdgcn_s_sleep(1); \
    if ((++_sp & 255u) == 0u) { if (xb_ld(&(bar)[XB_TMO])) break; if (_sp > XB_SPIN_CAP) { atomicAdd(&(bar)[XB_TMO], 1u); break; } } } } while (0)
struct XcdBarrier { unsigned* bar; unsigned x; volatile LAS unsigned* st; int wave; };
__device__ __forceinline__ XcdBarrier xcd_barrier_post(unsigned* bar, volatile LAS unsigned* st, int wave) {
    XcdBarrier b; b.bar = bar; b.x = xb_xcc_id(); b.st = st; b.wave = wave;
    if (wave == 0 && flane() == 0) (void)xb_add(&bar[XB_XCNT(b.x)], 1u);
    return b;
}
__device__ __forceinline__ void xcd_barrier_complete(unsigned* bar, unsigned x, unsigned& nloc, unsigned& nx) {
    const unsigned G = gridDim.x * gridDim.y * gridDim.z;
    unsigned sum, cnt, mine, sp = 0u;
    for (;;) {
        sum = 0u; cnt = 0u; mine = 0u;
#pragma unroll
        for (unsigned j = 0; j < 16; ++j) { const unsigned c = xb_ld(&bar[XB_XCNT(j)]); sum += c; cnt += (c > 0u) ? 1u : 0u; mine = (j == x) ? c : mine; }
        if (sum == G) break;
        __builtin_amdgcn_s_sleep(1);
        if ((++sp & 255u) == 0u) { if (xb_ld(&bar[XB_TMO])) break; if (sp > XB_SPIN_CAP) { atomicAdd(&bar[XB_TMO], 1u); break; } }
    }
    nloc = mine > 0u ? mine : 1u; nx = cnt > 0u ? cnt : 1u;
}
__device__ __forceinline__ void xcd_barrier(const XcdBarrier& b) {
    asm volatile("s_waitcnt vmcnt(0)" ::: "memory");
    __syncthreads();
    if (b.wave == 0 && flane() == 0) {
        unsigned* bar = b.bar;
        __builtin_amdgcn_s_waitcnt(0);
        unsigned nloc = b.st[0], nx = b.st[1];
        if (nloc == 0u) { xcd_barrier_complete(bar, b.x, nloc, nx); b.st[0] = nloc; b.st[1] = nx; }
        const unsigned old = xb_add(&bar[XB_XSUB(b.x)], 1u);
        const unsigned gen = old / nloc;
        if (old + 1u == (gen + 1u) * nloc) {
            __builtin_amdgcn_fence(__ATOMIC_RELEASE, "agent");
            asm volatile("s_waitcnt vmcnt(0)" ::: "memory");
            const unsigned og = xb_add(&bar[XB_TOP], 1u);
            const unsigned tg = og / nx;
            if (og + 1u == (tg + 1u) * nx) xb_add(&bar[XB_TOPGEN], 1u);
            else XB_SPIN(xb_ld(&bar[XB_TOPGEN]) == tg, bar);
            __builtin_amdgcn_fence(__ATOMIC_ACQUIRE, "agent");
            xb_add(&bar[XB_XGEN(b.x)], 1u);
            asm volatile("s_waitcnt vmcnt(0)" ::: "memory");
        } else {
            XB_SPIN(xb_ld(&bar[XB_XGEN(b.x)]) == gen, bar);
            __builtin_amdgcn_fence(__ATOMIC_ACQUIRE, "agent");
            asm volatile("s_waitcnt vmcnt(0)" ::: "memory");
        }
    }
    __syncthreads();
}

constexpr int NWAVES = 8, NTHR = 512;
constexpr int RING_BYTES = 131072, LDSCTL_OFF = RING_BYTES, MISC_OFF = LDSCTL_OFF + 320, LDS_BYTES = 147456;
constexpr int XCH_OFF = RING_BYTES + 1024;
constexpr int CW_BAR = 4096;
constexpr size_t OW_GU1 = OFF_W, OW_D1 = OW_GU1 + 11 * MiB, OW_IN = OW_D1 + (size_t)DM * FF * 2, OW_GATE = OW_IN + 6 * MiB, OW_4 = OW_GATE + 4 * MiB, OW_OV = OW_4 + 2 * MiB,
                 OW_UPB = OW_OV + 4 * MiB, OW_O = OW_UPB + MiB / 2, OW_GU2 = OW_O + 2 * MiB, OW_D2 = OW_GU2 + 11 * MiB, OW_END = OW_D2 + (size_t)DM * FF * 2;
static_assert(OW_END <= OFF_H, "weights region");
constexpr int NIN3 = 3072, N4 = 2560;
constexpr size_t OW_BD = OW_OV, OW_UPA = OW_OV + MiB, OFF_OA = OFF_A + 64 * MiB;

struct Args { const float* in[27]; float* out; unsigned char* ws; int ph_lo, ph_hi; };
struct Frame {
    LAS unsigned char* lds; int tid, lane, wave, G, gw, NGW;
};
__device__ __forceinline__ float wave_sum(float v) {
#pragma unroll
    for (int o = 1; o < 64; o <<= 1) v += __shfl_xor(v, o);
    return v;
}
__device__ __forceinline__ bool map_row(int job, int n, const Args& a, const float*& W, int& ldw, int& col) {
    if (job <= 1) { const int t = n >> 8, j = n & 255; W = a.in[(job == 0 ? 6 : 23) + (j >> 7)]; ldw = FF; col = t * 128 + (j & 127); return true; }
    if (job == 2) { W = a.in[11]; ldw = DIN; const int t = n >> 8, j = n & 255;
        if (t == 0) { col = C_CKV + j; return true; }
        if (t == 1) { col = j; return true; }
        if (t == 2) { if (j < 128) { col = 256 + j; return true; } if (j < 160) { col = C_KR + (j - 128); return true; } if (j < 192) { col = C_KI + (j - 160); return true; } if (j < 200) { col = C_WI + (j - 192); return true; } col = 0; return false; }
        if (t < 9) { const int c3 = (t - 3) / 3, tl = (t - 3) % 3, hl = (j & 127) >> 5, i = j & 31; col = C_QKV + c3 * 768 + (4 * tl + hl) * 64 + (j >> 7) * 32 + i; return true; }
        col = C_QKV + 1536 + (t - 9) * 256 + j; return true; }
    { const int n2 = n - 2048, r5 = n2 & 31, nat = 16 * ((r5 >> 2) & 1) + 4 * (r5 >> 3) + (r5 & 3);
      if (n2 < 256) { W = a.in[14]; ldw = 768; col = (n2 >> 5) * 96 + 64 + nat; } else { W = a.in[17]; ldw = 256; col = ((n2 - 256) & ~31) + nat; } return true; }
}
template <typename T>
__device__ __forceinline__ void tr_item(const float* W, int ldw, int col, bool valid, const float* scale, int k0, T* WTrow0, int K, LAS float* scr, int lane) {
    const int colc = valid ? col : 0; float vv[32];
#pragma unroll
    for (int i = 0; i < 32; ++i) vv[i] = W[(size_t)(k0 + 2 * i + (lane >> 5)) * ldw + colc];
    if (scale) {
#pragma unroll
        for (int i = 0; i < 32; ++i) vv[i] *= scale[k0 + 2 * i + (lane >> 5)]; }
#pragma unroll
    for (int i = 0; i < 32; ++i) scr[(2 * i + (lane >> 5)) * 33 + (lane & 31)] = valid ? vv[i] : 0.f;
    asm volatile("s_waitcnt lgkmcnt(0)" ::: "memory");
    const int c = lane & 7;
#pragma unroll
    for (int j = 0; j < 4; ++j) { const int n = (lane >> 3) + 8 * j; const LAS float* s = scr + (8 * c) * 33 + n;
        if constexpr (sizeof(T) == 1) { u32x2 o; o.x = pk_f8x4(s[0 * 33] * F8_WGT, s[1 * 33] * F8_WGT, s[2 * 33] * F8_WGT, s[3 * 33] * F8_WGT); o.y = pk_f8x4(s[4 * 33] * F8_WGT, s[5 * 33] * F8_WGT, s[6 * 33] * F8_WGT, s[7 * 33] * F8_WGT);
            *(u32x2*)(WTrow0 + (size_t)n * K + k0 + 8 * c) = o; }
        else { u32x4 o; o.x = pk_h2(s[0 * 33], s[1 * 33]); o.y = pk_h2(s[2 * 33], s[3 * 33]); o.z = pk_h2(s[4 * 33], s[5 * 33]); o.w = pk_h2(s[6 * 33], s[7 * 33]);
            *(u32x4*)(WTrow0 + (size_t)n * K + k0 + 8 * c) = o; } }
    asm volatile("s_waitcnt lgkmcnt(0)" ::: "memory");
}
template <typename T>
__device__ __forceinline__ void tr_job_mapped(const Frame& F, const Args& a, int job, int Ndest, int n_lo, int K, T* WT, const float* scale, LAS float* scr, int phase_off) {
    const int nblk = Ndest / 32, nitems = (K / 64) * nblk;
    for (int it = (F.gw + phase_off) % F.NGW; it < nitems; it += F.NGW) {
        const int kb = it / nblk, nb = it % nblk; const float* W; int ldw, col;
        const bool valid = map_row(job, n_lo + nb * 32 + (F.lane & 31), a, W, ldw, col);
        tr_item(W, ldw, col, valid, scale, kb * 64, WT + (size_t)(n_lo + nb * 32) * K, K, scr, F.lane);
    }
}
template <typename T>
__device__ __forceinline__ void tr_job_plain(const Frame& F, const float* W, int ldw, int Ndest, int K, T* WT, LAS float* scr, int phase_off) {
    const int nblk = Ndest / 32, nitems = (K / 64) * nblk;
    for (int it = (F.gw + phase_off) % F.NGW; it < nitems; it += F.NGW) {
        const int kb = it / nblk, nb = it % nblk;
        tr_item(W, ldw, nb * 32 + (F.lane & 31), true, nullptr, kb * 64, WT + (size_t)(nb * 32) * K, K, scr, F.lane);
    }
}
__device__ __forceinline__ void row_load(const float* p, int lane, f32x4 (&v)[4]) {
#pragma unroll
    for (int j = 0; j < 4; ++j) v[j] = __builtin_nontemporal_load((const f32x4*)p + lane + 64 * j);
}
__device__ __forceinline__ float row_ssq(const f32x4 (&v)[4]) { float s = 0.f;
#pragma unroll
    for (int j = 0; j < 4; ++j) s += (v[j].x * v[j].x + v[j].y * v[j].y) + (v[j].z * v[j].z + v[j].w * v[j].w);
    return wave_sum(s); }
template <typename T>
__device__ __forceinline__ void row_normmod_store(const f32x4 (&v)[4], float rstd, const float* g, const float* sc, const float* sh, T* dst, int lane, unsigned char* dst8 = nullptr) {
#pragma unroll
    for (int j = 0; j < 4; ++j) { const int ci = lane + 64 * j; const f32x4 gg = ((const f32x4*)g)[ci], s1 = ((const f32x4*)sc)[ci], s0 = ((const f32x4*)sh)[ci];
        const f32x4 o = v[j] * rstd * gg * (s1 + 1.f) + s0;
        if constexpr (sizeof(T) == 1) ((unsigned*)dst)[ci] = pk_f8x4(o.x * F8_ACT, o.y * F8_ACT, o.z * F8_ACT, o.w * F8_ACT);
        else { u32x2 w; w.x = pk_h2(o.x, o.y); w.y = pk_h2(o.z, o.w); ((u32x2*)dst)[ci] = w; if (dst8) ((unsigned*)dst8)[ci] = pk_f8x4(o.x * F8_ACT, o.y * F8_ACT, o.z * F8_ACT, o.w * F8_ACT); } }
}
template <typename T>
__device__ __forceinline__ void store_nm(const f32x4 (&xv)[4], float r2, const f32x4 (&gb)[4], const f32x4 (&gc)[4], T* dst, int lane, unsigned char* dst8) {
#pragma unroll
    for (int j = 0; j < 4; ++j) { const int ci = lane + 64 * j; const f32x4 o = xv[j] * r2 * gb[j] + gc[j];
        if constexpr (sizeof(T) == 1) __builtin_nontemporal_store(pk_f8x4(o.x * F8_ACT, o.y * F8_ACT, o.z * F8_ACT, o.w * F8_ACT), (unsigned*)dst + ci);
        else { u32x2 w; w.x = pk_h2(o.x, o.y); w.y = pk_h2(o.z, o.w); __builtin_nontemporal_store(w, (u32x2*)dst + ci); if (dst8) __builtin_nontemporal_store(pk_f8x4(o.x * F8_ACT, o.y * F8_ACT, o.z * F8_ACT, o.w * F8_ACT), (unsigned*)dst8 + ci); } }
}
template <typename T>
__device__ __forceinline__ void ph_normmod(const Frame& F, const float* x, const float* g, const float* mod, int isc, int ish, T* dst) {
    const int lane = flane();
    const int b = F.gw & 3, nsl = F.NGW >> 2; int r0 = F.gw >> 2; if (r0 >= SEQ) return;
    const float* mb = mod + b * (NMOD * DM); f32x4 gb[4], gc[4];
#pragma unroll
    for (int j = 0; j < 4; ++j) { const int ci = lane + 64 * j; gb[j] = ((const f32x4*)g)[ci] * (((const f32x4*)(mb + isc * DM))[ci] + 1.f); gc[j] = ((const f32x4*)(mb + ish * DM))[ci]; }
    const float* xb = x + (size_t)b * SEQ * DM; T* db = dst + (size_t)b * SEQ * DM;
    f32x4 v[2][4], vn[2][4];
#pragma unroll
    for (int k = 0; k < 2; ++k) { const int r = r0 + k * nsl; row_load(xb + (size_t)(r < SEQ ? r : r0) * DM, lane, v[k]); }
    for (;;) { const int rn = r0 + 2 * nsl; const bool has = rn < SEQ;
        if (has) {
#pragma unroll
            for (int k = 0; k < 2; ++k) { const int r = rn + k * nsl; row_load(xb + (size_t)(r < SEQ ? r : rn) * DM, lane, vn[k]); } }
#pragma unroll
        for (int k = 0; k < 2; ++k) { const int r = r0 + k * nsl; const float rstd = rsqrtf(row_ssq(v[k]) * (1.f / DM) + EPS);
            if (r < SEQ) store_nm(v[k], rstd, gb, gc, db + (size_t)r * DM, lane, nullptr); }
        if (!has) break;
#pragma unroll
        for (int k = 0; k < 2; ++k)
#pragma unroll
            for (int j = 0; j < 4; ++j) v[k][j] = vn[k][j];
        r0 = rn; }
}
__device__ __forceinline__ void row_load_h(const h16* p, int lane, u32x2 (&v)[4]) {
#pragma unroll
    for (int j = 0; j < 4; ++j) v[j] = __builtin_nontemporal_load((const u32x2*)p + lane + 64 * j);
}
typedef _Float16 h16x4 __attribute__((ext_vector_type(4)));
__device__ __forceinline__ f32x4 h4_to_f4(u32x2 w) { const h16x4 h = __builtin_bit_cast(h16x4, w); return (f32x4){(float)h[0], (float)h[1], (float)h[2], (float)h[3]}; }
template <bool XI16, bool XO16, typename T = h16>
__device__ __forceinline__ void ph_resnorm(const Frame& F, const void* xin_, const h16* f, const float* gpost, const float* mod, int igt, float coef, void* xout_,
                                           bool second, const float* gpre, int isc, int ish, T* dst, unsigned char* dst8 = nullptr) {
    const int lane = flane();
    const int b = F.gw & 3, nsl = F.NGW >> 2; int r0 = F.gw >> 2; if (r0 >= SEQ) return;
    const float* mb = mod + b * (NMOD * DM); f32x4 ga[4], gb[4], gc[4];
#pragma unroll
    for (int j = 0; j < 4; ++j) { const int ci = lane + 64 * j; ga[j] = ((const f32x4*)gpost)[ci] * ((const f32x4*)(mb + igt * DM))[ci] * coef;
        if (second) { gb[j] = ((const f32x4*)gpre)[ci] * (((const f32x4*)(mb + isc * DM))[ci] + 1.f); gc[j] = ((const f32x4*)(mb + ish * DM))[ci]; } else { gb[j] = (f32x4){0.f, 0.f, 0.f, 0.f}; gc[j] = gb[j]; } }
    const size_t bo = (size_t)b * SEQ * DM; const h16* fb = f + bo;
    u32x2 fh[2][4], fn[2][4]; f32x4 xi[2][4], xn[2][4]; u32x2 xh[2][4], xhn[2][4];
#pragma unroll
    for (int k = 0; k < 2; ++k) { const int r = r0 + k * nsl; const size_t ro = (size_t)(r < SEQ ? r : r0) * DM; row_load_h(fb + ro, lane, fh[k]);
        if constexpr (XI16) row_load_h((const h16*)xin_ + bo + ro, lane, xh[k]); else row_load((const float*)xin_ + bo + ro, lane, xi[k]); }
    for (;;) {
        const int rn = r0 + 2 * nsl; const bool has = rn < SEQ;
        if (has) {
#pragma unroll
            for (int k = 0; k < 2; ++k) { const int r = rn + k * nsl; const size_t ro = (size_t)(r < SEQ ? r : rn) * DM; row_load_h(fb + ro, lane, fn[k]);
                if constexpr (XI16) row_load_h((const h16*)xin_ + bo + ro, lane, xhn[k]); else row_load((const float*)xin_ + bo + ro, lane, xn[k]); } }
#pragma unroll
        for (int k = 0; k < 2; ++k) { const int r = r0 + k * nsl; const bool ok = r < SEQ; const size_t ro = bo + (size_t)r * DM;
            f32x4 v[4];
#pragma unroll
            for (int j = 0; j < 4; ++j) { v[j] = h4_to_f4(fh[k][j]); if constexpr (XI16) xi[k][j] = h4_to_f4(xh[k][j]); }
            const float rstd = rsqrtf(row_ssq(v) * (1.f / DM) + EPS);
#pragma unroll
            for (int j = 0; j < 4; ++j) { const int ci = lane + 64 * j;
                xi[k][j] = xi[k][j] + ga[j] * v[j] * rstd;
                if (ok) { if constexpr (XO16) { u32x2 w; w.x = pk_h2(xi[k][j].x, xi[k][j].y); w.y = pk_h2(xi[k][j].z, xi[k][j].w); __builtin_nontemporal_store(w, (u32x2*)((h16*)xout_ + ro) + ci); }
                          else __builtin_nontemporal_store(xi[k][j], (f32x4*)((float*)xout_ + ro) + ci); } }
            if (second) { const float r2 = rsqrtf(row_ssq(xi[k]) * (1.f / DM) + EPS); if (ok) store_nm(xi[k], r2, gb, gc, dst + ro, lane, dst8 ? dst8 + ro : nullptr); } }
        if (!has) break;
#pragma unroll
        for (int k = 0; k < 2; ++k)
#pragma unroll
            for (int j = 0; j < 4; ++j) { fh[k][j] = fn[k][j]; if constexpr (XI16) xh[k][j] = xhn[k][j]; else xi[k][j] = xn[k][j]; }
        r0 = rn;
    }
}

__device__ __forceinline__ void ph_combine(const Frame& F, const h16* og, const float* lse2, h16* ob) {
    for (int idx = blockIdx.x * NTHR + F.tid; idx < MT * 32; idx += F.G * NTHR) {
        const int tok = idx >> 5, c = (idx & 31) * 8, hh = c >> 6;
        const float l0 = lse2[tok * 12 + hh], l1 = lse2[tok * 12 + 4 + hh], l2 = lse2[tok * 12 + 8 + hh], m = fmaxf(l0, fmaxf(l1, l2));
        const float w0 = exp2f(l0 - m), w1 = exp2f(l1 - m), w2 = exp2f(l2 - m), inv = 1.f / (w0 + w1 + w2);
        const u32x4 a = *(const u32x4*)(og + (size_t)tok * 768 + c), b = *(const u32x4*)(og + (size_t)tok * 768 + 256 + c), d = *(const u32x4*)(og + (size_t)tok * 768 + 512 + c);
        const f16x8 ha = __builtin_bit_cast(f16x8, a), hb = __builtin_bit_cast(f16x8, b), hd = __builtin_bit_cast(f16x8, d);
        float o[8];
#pragma unroll
        for (int i = 0; i < 8; ++i) o[i] = (w0 * (float)ha[i] + w1 * (float)hb[i] + w2 * (float)hd[i]) * inv;
        u32x4 w; w.x = pk_h2(o[0], o[1]); w.y = pk_h2(o[2], o[3]); w.z = pk_h2(o[4], o[5]); w.w = pk_h2(o[6], o[7]);
        *(u32x4*)(ob + (size_t)tok * 256 + c) = w; }
}
typedef short v4i16_t __attribute__((ext_vector_type(4)));
typedef short s16x8 __attribute__((ext_vector_type(8)));
typedef float f32x16 __attribute__((ext_vector_type(16)));
__device__ __forceinline__ int tk_bin(float sc) { const unsigned u = __float_as_uint(sc); int e = (int)((u >> 16) & 0x7FFFu) - (122 << 7); e = e < 0 ? 0 : (e > 1023 ? 1023 : e); return (u >> 31) ? 1023 - e : 1024 + e; }
__device__ __forceinline__ void tk_scores(const f16x8 (&Af)[2], const float (&wv)[16], f16x8 b0, f16x8 b1, float& sa, float& sb) {
    f32x16 d = {0.f, 0.f, 0.f, 0.f, 0.f, 0.f, 0.f, 0.f, 0.f, 0.f, 0.f, 0.f, 0.f, 0.f, 0.f, 0.f};
    d = __builtin_amdgcn_mfma_f32_32x32x16_f16(Af[0], b0, d, 0, 0, 0); d = __builtin_amdgcn_mfma_f32_32x32x16_f16(Af[1], b1, d, 0, 0, 0);
    f32x2 acc = {0.f, 0.f};
#pragma unroll
    for (int e = 0; e < 16; e += 2) { const int i0 = __float_as_int(d[e]), i1 = __float_as_int(d[e + 1]);
        const f32x2 rl = {__int_as_float(i0 > 0 ? i0 : 0), __int_as_float(i1 > 0 ? i1 : 0)}; const f32x2 w2 = {wv[e], wv[e + 1]};
        acc = __builtin_elementwise_fma(w2, rl, acc); }
    sa = acc.x; sb = acc.y;
}
template <bool P2>
__device__ __forceinline__ void tk_tile(const f16x8 (&Af)[2], const float (&wv)[16], f16x8 b0, f16x8 b1, int tile, int r, int hi, int ta, LAS unsigned* hist, const int (&tbin)[4], int (&cs)[4], int (&cc)[4],
                                        unsigned short* sel, int tok0) {
    float sa, sb; tk_scores(Af, wv, b0, b1, sa, sb);
    const int s = 32 * tile + r;
    if constexpr (!P2) {
        if (s <= ta) { const int bn = tk_bin(sa); __hip_atomic_fetch_add(hist + (2 * hi) * 1024 + (bn >> 1), 1u << (16 * (bn & 1)), __ATOMIC_RELAXED, __HIP_MEMORY_SCOPE_WORKGROUP); }
        if (s <= ta + 1) { const int bn = tk_bin(sb); __hip_atomic_fetch_add(hist + (2 * hi + 1) * 1024 + (bn >> 1), 1u << (16 * (bn & 1)), __ATOMIC_RELAXED, __HIP_MEMORY_SCOPE_WORKGROUP); }
    } else {
        const unsigned lowmask = (1u << r) - 1u;
#pragma unroll
        for (int ab = 0; ab < 2; ++ab) { const float sc = ab ? sb : sa; const int tq = ta + ab; const int bn = tk_bin(sc);
            const int mytb = hi ? tbin[2 + ab] : tbin[ab];
            const bool valid = s <= tq, sure = valid && bn > mytb, cand = valid && bn == mytb;
            const unsigned long long ms = __ballot(sure), mc = __ballot(cand);
            const unsigned ms_h = hi ? (unsigned)(ms >> 32) : (unsigned)ms, mc_h = hi ? (unsigned)(mc >> 32) : (unsigned)mc;
            const int q = 2 * hi + ab;
            const int base_s = hi ? cs[2 + ab] : cs[ab], base_c = hi ? cc[2 + ab] : cc[ab];
            if (sure) sel[(size_t)(tok0 + q) * TOPK + base_s + __builtin_popcount(ms_h & lowmask)] = (unsigned short)s;
            if (cand) { const int pos = base_c + __builtin_popcount(mc_h & lowmask);
                if (pos < 512) ((LAS unsigned long long*)((LAS unsigned char*)hist + q * 4096))[pos] = ((unsigned long long)fkey(sc) << 16) | (unsigned long long)(0xFFFFu - (unsigned)s); }
            cs[ab] += __builtin_popcount((unsigned)ms); cs[2 + ab] += __builtin_popcount((unsigned)(ms >> 32));
            cc[ab] += __builtin_popcount((unsigned)mc); cc[2 + ab] += __builtin_popcount((unsigned)(mc >> 32)); }
    }
}
template <bool P2>
__device__ __forceinline__ void tk_pass(const f16x8 (&Af)[2], const float (&wv)[16], const h16* kbase, int ntiles, int r, int hi, int ta, LAS unsigned* hist, const int (&tbin)[4], int (&cs)[4], int (&cc)[4],
                                        unsigned short* sel, int tok0) {
    f16x8 BA[4][2], BB[4][2];
#define TK_LOAD(dst, t0_) do { _Pragma("unroll") for (int i_ = 0; i_ < 4; ++i_) { const int tt_ = ((t0_) + i_) < 127 ? ((t0_) + i_) : 127; dst[i_][0] = *(const f16x8*)(kbase + (size_t)tt_ * 1024); dst[i_][1] = *(const f16x8*)(kbase + (size_t)tt_ * 1024 + 16); } } while (0)
    TK_LOAD(BA, 0);
    for (int t0 = 0; t0 < ntiles; t0 += 8) {
        TK_LOAD(BB, t0 + 4);
#pragma unroll
        for (int i = 0; i < 4; ++i) if (t0 + i < ntiles) tk_tile<P2>(Af, wv, BA[i][0], BA[i][1], t0 + i, r, hi, ta, hist, tbin, cs, cc, sel, tok0);
        TK_LOAD(BA, t0 + 8);
#pragma unroll
        for (int i = 0; i < 4; ++i) if (t0 + 4 + i < ntiles) tk_tile<P2>(Af, wv, BB[i][0], BB[i][1], t0 + 4 + i, r, hi, ta, hist, tbin, cs, cc, sel, tok0);
    }
#undef TK_LOAD
}
__device__ __forceinline__ void tk_group(const Frame& F, const h16* qi, const h16* ki, const float* wi, unsigned short* sel, int b, int t0, LAS unsigned* hist) {
    int lane_ = F.lane; asm volatile("" : "+v"(lane_)); const int lane = lane_, r = lane & 31, hi = lane >> 5, tok0 = b * SEQ + t0;
    const int qa = 2 * ((r >> 2) & 1) + (r & 1), ha = 4 * (r >> 4) + 2 * ((r >> 3) & 1) + ((r >> 1) & 1);
    f16x8 Af[2];
#pragma unroll
    for (int s_ = 0; s_ < 2; ++s_) Af[s_] = *(const f16x8*)(qi + (size_t)(tok0 + qa) * 256 + ha * 32 + 16 * s_ + 8 * hi);
    float wv[16];
    { const f32x4 a0 = *(const f32x4*)(wi + (tok0 + 2 * hi) * 8), a1 = *(const f32x4*)(wi + (tok0 + 2 * hi) * 8 + 4), b0 = *(const f32x4*)(wi + (tok0 + 2 * hi + 1) * 8), b1 = *(const f32x4*)(wi + (tok0 + 2 * hi + 1) * 8 + 4);
      const float sa[8] = {a0.x, a0.y, a0.z, a0.w, a1.x, a1.y, a1.z, a1.w}, sb[8] = {b0.x, b0.y, b0.z, b0.w, b1.x, b1.y, b1.z, b1.w};
#pragma unroll
      for (int h = 0; h < 8; ++h) { wv[2 * h] = sa[h] * 0.17677669529663687f; wv[2 * h + 1] = sb[h] * 0.17677669529663687f; } }
    const int ntiles = (t0 + 3) / 32 + 1, ta = t0 + 2 * hi;
    const h16* kbase = ki + (size_t)(b * SEQ + r) * 32 + 8 * hi;
    int tbin[4] = {0, 0, 0, 0}, nsure[4], cs[4] = {0, 0, 0, 0}, cc[4] = {0, 0, 0, 0};
#pragma unroll
    for (int i = 0; i < 16; ++i) *(LAS u32x4*)((LAS unsigned char*)hist + i * 1024 + lane * 16) = (u32x4){0u, 0u, 0u, 0u};
    asm volatile("s_waitcnt lgkmcnt(0)" ::: "memory");
    tk_pass<false>(Af, wv, kbase, ntiles, r, hi, ta, hist, tbin, cs, cc, sel, tok0);
    asm volatile("s_waitcnt lgkmcnt(0)" ::: "memory");
#pragma unroll
    for (int q = 0; q < 4; ++q) {
        const LAS unsigned* hq = hist + q * 1024;
        unsigned sum = 0;
#pragma unroll
        for (int i = 0; i < 4; ++i) { const u32x4 v = *(const LAS u32x4*)(hq + 16 * lane + 4 * i); sum += (v.x & 0xFFFFu) + (v.x >> 16) + (v.y & 0xFFFFu) + (v.y >> 16) + (v.z & 0xFFFFu) + (v.z >> 16) + (v.w & 0xFFFFu) + (v.w >> 16); }
        unsigned incl = sum;
#pragma unroll
        for (int o = 1; o < 64; o <<= 1) { const unsigned v = __shfl_down(incl, o); if (lane + o < 64) incl += v; }
        const unsigned long long bal = __ballot(incl >= (unsigned)TOPK);
        const int L = 63 - __builtin_clzll(bal);
        unsigned cum = __shfl(incl, L) - __shfl(sum, L);
        int tbq = 32 * L, found = 0;
        for (int wd = 15; wd >= 0 && !found; --wd) { const unsigned v = hq[16 * L + wd];
            const unsigned chi = v >> 16, clo = v & 0xFFFFu;
            if (cum + chi >= (unsigned)TOPK) { tbq = 32 * L + 2 * wd + 1; found = 1; } else { cum += chi;
                if (cum + clo >= (unsigned)TOPK) { tbq = 32 * L + 2 * wd; found = 1; } else cum += clo; } }
        tbin[q] = tbq; nsure[q] = (int)cum;
    }
    asm volatile("s_waitcnt lgkmcnt(0)" ::: "memory");
    tk_pass<true>(Af, wv, kbase, ntiles, r, hi, ta, hist, tbin, cs, cc, sel, tok0);
    asm volatile("s_waitcnt lgkmcnt(0)" ::: "memory");
#pragma unroll
    for (int q = 0; q < 4; ++q) {
        const int nc = cc[q] < 512 ? cc[q] : 512, need = TOPK - cs[q];
        const LAS unsigned long long* cq = (const LAS unsigned long long*)((const LAS unsigned char*)hist + q * 4096);
        if (nc > 64) {
            unsigned long long it[8];
#pragma unroll
            for (int k = 0; k < 8; ++k) it[k] = (k * 64 + lane < nc) ? cq[k * 64 + lane] : 0ull;
            unsigned long long T = 0ull;
            for (int bit = 47; bit >= 0; --bit) { const unsigned long long cand = T | (1ull << bit); int cnt = 0;
#pragma unroll
                for (int k = 0; k < 8; ++k) cnt += __builtin_popcountll(__ballot(it[k] >= cand));
                if (cnt >= need) T = cand; }
            int basep = cs[q];
#pragma unroll
            for (int k = 0; k < 8; ++k) { const bool pick = (T != 0ull) && it[k] >= T; const unsigned long long mk = __ballot(pick);
                if (pick) sel[(size_t)(tok0 + q) * TOPK + basep + __builtin_popcountll(mk & ((1ull << lane) - 1ull))] = (unsigned short)(0xFFFFu - (unsigned)(it[k] & 0xFFFFull));
                basep += __builtin_popcountll(mk); }
        } else
        for (int base = 0; base < nc; base += 64) {
            const bool act = base + lane < nc; const unsigned long long my = act ? cq[base + lane] : 0ull; int rank = 0;
            for (int jb = 0; jb < nc; jb += 64) {
                const unsigned long long cj = (jb + lane < nc) ? cq[jb + lane] : 0ull; const unsigned clo = (unsigned)cj, chi = (unsigned)(cj >> 32);
                const int n = (nc - jb) < 64 ? (nc - jb) : 64;
                for (int j = 0; j < n; ++j) { const unsigned long long sj = ((unsigned long long)(unsigned)__builtin_amdgcn_readlane((int)chi, j) << 32) | (unsigned)__builtin_amdgcn_readlane((int)clo, j); rank += (sj > my) ? 1 : 0; } }
            if (act && rank < need) sel[(size_t)(tok0 + q) * TOPK + cs[q] + rank] = (unsigned short)(0xFFFFu - (unsigned)(my & 0xFFFFull)); }
    }
    (void)nsure;
    asm volatile("s_waitcnt lgkmcnt(0)" ::: "memory");
}
__device__ __forceinline__ void ph_topk_sparse(const Frame& F, const h16* qi, const h16* ki, const float* wi, unsigned short* sel, h16* qlat, const h16* qr, const unsigned char* ckv8, const unsigned char* kr8);
__device__ __forceinline__ void ph_topk_mfma(const Frame& F, const h16* qi, const h16* ki, const float* wi, unsigned short* sel) {
    LAS unsigned* hist = (LAS unsigned*)(F.lds + F.wave * 16384);
    for (int g = F.gw; g < 4 * 64; g += F.NGW) { const int b = g >> 6, t0 = (g & 63) * 4;
        for (int i = F.lane; i < 4 * TOPK; i += 64) { const int q = i >> 8, k = i & 255; sel[(size_t)(b * SEQ + t0 + q) * TOPK + k] = (unsigned short)(k <= t0 + q ? k : 0); } }
    for (int p = F.gw; p < 4 * 480; p += F.NGW) { const int b = p & 3, pj = p >> 2;
        tk_group(F, qi, ki, wi, sel, b, 4 * (64 + pj), hist);
        tk_group(F, qi, ki, wi, sel, b, 4 * (1023 - pj), hist);
    }
}


__device__ __forceinline__ void ph_dilated_mfma(const Frame& F, const h16* qb, const h16* kb, const h16* vb, h16* og, float* lse2) {
    const int lane = F.lane, ql = lane & 31, hi = lane >> 5;
    LAS unsigned char* VL = F.lds + F.wave * 16384;
    LAS float* linv = (LAS float*)(VL + 12288);
    constexpr int VROW = 192;
    const int trq = (lane & 15) >> 2, trp = lane & 3, trg = (lane >> 4) & 1;
    for (int u = F.gw; u < NB * 12 * 128; u += F.NGW) {
        const int b = u / 1536, rem = u % 1536, gh = rem >> 7, g = gh >> 2, wi_ = rem & 127, dil = dil_of(g), sh = g == 0 ? 0 : (g == 1 ? 2 : 4);
        const int nblk = 128 >> sh, res = wi_ / nblk, j0 = 32 * (wi_ % nblk);
        const size_t hoff = (size_t)b * SEQ * 768 + gh * 64;
        f16x8 Qf[4];
        { const h16* qp = qb + hoff + (size_t)((j0 + ql) * dil + res) * 768 + 8 * hi;
#pragma unroll
          for (int s_ = 0; s_ < 4; ++s_) Qf[s_] = *(const f16x8*)(qp + 16 * s_); }
        f32x16 S[5];
        f16x8 Kf[5][4];
#pragma unroll
        for (int kt = 0; kt < 5; ++kt) { int jk = j0 - 128 + 32 * kt + ql; jk = jk < 0 ? 0 : jk;
            const h16* kp = kb + hoff + (size_t)(jk * dil + res) * 768 + 8 * hi;
#pragma unroll
            for (int s_ = 0; s_ < 4; ++s_) Kf[kt][s_] = *(const f16x8*)(kp + 16 * s_); }
#pragma unroll
        for (int kt = 0; kt < 5; ++kt) {
            f32x16 d = {0.f, 0.f, 0.f, 0.f, 0.f, 0.f, 0.f, 0.f, 0.f, 0.f, 0.f, 0.f, 0.f, 0.f, 0.f, 0.f};
#pragma unroll
            for (int s_ = 0; s_ < 4; ++s_) d = __builtin_amdgcn_mfma_f32_32x32x16_f16(Kf[kt][s_], Qf[s_], d, 0, 0, 0);
            S[kt] = d; }
        f16x8 Vr[5][4];
#pragma unroll
        for (int kt = 0; kt < 5; ++kt) { int jk = j0 - 128 + 32 * kt + (lane >> 1); jk = jk < 0 ? 0 : jk;
            const h16* vp = vb + hoff + (size_t)(jk * dil + res) * 768 + (lane & 1) * 32;
#pragma unroll
            for (int i = 0; i < 4; ++i) Vr[kt][i] = *(const f16x8*)(vp + 8 * i); }
        float m = -INFINITY;
#pragma unroll
        for (int kt = 0; kt < 5; ++kt)
#pragma unroll
            for (int e = 0; e < 16; ++e) { const int kl = (e & 3) + 8 * (e >> 2) + 4 * hi; bool ok = (j0 - 128 + 32 * kt + kl) >= 0;
                if (kt == 0) ok = ok && (kl >= ql); if (kt == 4) ok = ok && (kl <= ql);
                if (!ok) S[kt][e] = -INFINITY; m = fmaxf(m, S[kt][e]); }
        m = fmaxf(m, __shfl_xor(m, 32));
        float l = 0.f;
#pragma unroll
        for (int kt = 0; kt < 5; ++kt)
#pragma unroll
            for (int e = 0; e < 16; ++e) { const float p = __builtin_amdgcn_exp2f(S[kt][e] - m); S[kt][e] = p; l += p; }
        l += __shfl_xor(l, 32);
        if (hi == 0) { linv[ql] = __builtin_amdgcn_rcpf(l); lse2[(size_t)(b * SEQ + (j0 + ql) * dil + res) * 12 + gh] = m + __builtin_amdgcn_logf(l); }
        f32x16 O[2];
#pragma unroll
        for (int dt = 0; dt < 2; ++dt) O[dt] = (f32x16){0.f, 0.f, 0.f, 0.f, 0.f, 0.f, 0.f, 0.f, 0.f, 0.f, 0.f, 0.f, 0.f, 0.f, 0.f, 0.f};
#pragma unroll
        for (int kt = 0; kt < 5; ++kt) {
            LAS unsigned char* vbuf = VL + (kt & 1) * 6144;
#pragma unroll
            for (int i = 0; i < 4; ++i) *(LAS f16x8*)(vbuf + (lane >> 1) * VROW + (lane & 1) * 64 + i * 16) = Vr[kt][i];
            asm volatile("s_waitcnt lgkmcnt(0)" ::: "memory");
#pragma unroll
            for (int s2 = 0; s2 < 2; ++s2) {
                u32x4 pa; pa.x = pk_h2(S[kt][8 * s2 + 0], S[kt][8 * s2 + 1]); pa.y = pk_h2(S[kt][8 * s2 + 2], S[kt][8 * s2 + 3]); pa.z = pk_h2(S[kt][8 * s2 + 4], S[kt][8 * s2 + 5]); pa.w = pk_h2(S[kt][8 * s2 + 6], S[kt][8 * s2 + 7]);
#pragma unroll
                for (int dt = 0; dt < 2; ++dt) {
                    const v4i16_t lo = __builtin_amdgcn_ds_read_tr16_b64_v4i16((LAS v4i16_t*)(vbuf + (16 * s2 + 4 * hi + trq) * VROW + (32 * dt + 16 * trg + 4 * trp) * 2));
                    const v4i16_t hh = __builtin_amdgcn_ds_read_tr16_b64_v4i16((LAS v4i16_t*)(vbuf + (16 * s2 + 8 + 4 * hi + trq) * VROW + (32 * dt + 16 * trg + 4 * trp) * 2));
                    const s16x8 bv = {lo[0], lo[1], lo[2], lo[3], hh[0], hh[1], hh[2], hh[3]};
                    O[dt] = __builtin_amdgcn_mfma_f32_32x32x16_f16(__builtin_bit_cast(f16x8, pa), __builtin_bit_cast(f16x8, bv), O[dt], 0, 0, 0); } }
            asm volatile("s_waitcnt lgkmcnt(0)" ::: "memory");
        }
#pragma unroll
        for (int e = 0; e < 16; ++e) { const int q = (e & 3) + 8 * (e >> 2) + 4 * hi; const float il = linv[q];
            h16* op = og + (size_t)(b * SEQ + (j0 + q) * dil + res) * 768 + gh * 64 + ql;
            op[0] = (h16)(O[0][e] * il); op[32] = (h16)(O[1][e] * il); }
        asm volatile("s_waitcnt lgkmcnt(0)" ::: "memory");
    }
}


__device__ __forceinline__ f16x8 fp8x8_to_f16(unsigned w0, unsigned w1) {
    const h16x2 a = __builtin_amdgcn_cvt_scalef32_pk_f16_fp8((int)w0, 1.0f, false), b = __builtin_amdgcn_cvt_scalef32_pk_f16_fp8((int)w0, 1.0f, true),
                c = __builtin_amdgcn_cvt_scalef32_pk_f16_fp8((int)w1, 1.0f, false), d = __builtin_amdgcn_cvt_scalef32_pk_f16_fp8((int)w1, 1.0f, true);
    const u32x4 r = {__builtin_bit_cast(unsigned, a), __builtin_bit_cast(unsigned, b), __builtin_bit_cast(unsigned, c), __builtin_bit_cast(unsigned, d)};
    return __builtin_bit_cast(f16x8, r);
}
template <bool FUSED>
__device__ __forceinline__ void ph_sparse_wave(const Frame& F, h16* qlat, const h16* qr, const unsigned char* ckv8, const unsigned char* kr8, const unsigned short* sel, int ta = 0, int tb = 0) {
    int lane = F.lane; asm volatile("" : "+v"(lane));
    LAS unsigned char* V = F.lds + F.wave * 16384;
    const int qp = (lane & 15) >> 2, pp = lane & 3;
    const int k0 = 4 * (lane >> 4) + qp;
    const int tr0 = k0 * 512 + (pp >> 1) * 16 + (pp & 1) * 8, x0 = k0 & 7;
    const int vw = (lane & 15) * 512, swz = lane & 7;
    const int lane0 = lane;
    const int nit = FUSED ? 8 : (MT - F.gw + F.NGW - 1) / F.NGW;
    for (int it = 0; it < nit; ++it) {
        const int tok = FUSED ? ((it < 4 ? ta : tb - 4) + it) : F.gw + it * F.NGW;
        int ll = lane0; asm volatile("" : "+v"(ll));
        const int c = ll & 15, kq = ll >> 4, hd = c & 7;
        const int b = tok / SEQ, t = tok % SEQ, cnt = (t + 1 < TOPK) ? t + 1 : TOPK, nch = (cnt + 31) >> 5;
        LAS unsigned short* sp = (LAS unsigned short*)(F.lds + XCH_OFF + F.wave * 512) + c;
        *(LAS u32x2*)(F.lds + XCH_OFF + F.wave * 512 + 8 * ll) = *(const u32x2*)(sel + (size_t)tok * TOPK + 4 * ll);
        asm volatile("s_waitcnt lgkmcnt(0)" ::: "memory");
        f16x8 Qf[9]; u32x4 Kr[2][4]; u32x2 Rr[2];
#pragma unroll
        for (int s_ = 0; s_ < 8; ++s_) Qf[s_] = *(const f16x8*)(qlat + (size_t)tok * 2048 + hd * 256 + 64 * (s_ >> 1) + 16 * kq + 8 * (s_ & 1));
        Qf[8] = *(const f16x8*)(qr + (size_t)tok * 256 + hd * 32 + 8 * kq);
        int rowi[2];
#define SW_LOADK() do { _Pragma("unroll") for (int tl = 0; tl < 2; ++tl) { _Pragma("unroll") for (int q4 = 0; q4 < 4; ++q4) Kr[tl][q4] = *(const u32x4*)(ckv8 + (size_t)rowi[tl] * 256 + 64 * q4 + 16 * kq); \
        Rr[tl] = *(const u32x2*)(kr8 + (size_t)rowi[tl] * 32 + 8 * kq); } } while (0)
        rowi[0] = b * SEQ + (int)sp[0]; rowi[1] = b * SEQ + (int)sp[16];
        SW_LOADK();
        float m = -INFINITY, l = 0.f;
        f32x4 O[16];
#pragma unroll
        for (int ft = 0; ft < 16; ++ft) O[ft] = (f32x4){0.f, 0.f, 0.f, 0.f};
        for (int ch = 0; ch < nch; ++ch) {
            const bool more = ch + 1 < nch;
            int rown0 = 0, rown1 = 0; if (more) { rown0 = (int)sp[32 * (ch + 1)]; rown1 = (int)sp[32 * (ch + 1) + 16]; }
            f16x8 Kf[2][9];
#pragma unroll
            for (int tl = 0; tl < 2; ++tl) {
#pragma unroll
                for (int q4 = 0; q4 < 4; ++q4) { Kf[tl][2 * q4] = fp8x8_to_f16(Kr[tl][q4].x, Kr[tl][q4].y); Kf[tl][2 * q4 + 1] = fp8x8_to_f16(Kr[tl][q4].z, Kr[tl][q4].w); }
                Kf[tl][8] = fp8x8_to_f16(Rr[tl].x, Rr[tl].y); }
            if (more) { rowi[0] = b * SEQ + rown0; rowi[1] = b * SEQ + rown1; SW_LOADK(); }
            f32x4 S[2];
#pragma unroll
            for (int tl = 0; tl < 2; ++tl) { S[tl] = (f32x4){0.f, 0.f, 0.f, 0.f};
#pragma unroll
                for (int s_ = 0; s_ < 9; ++s_) S[tl] = __builtin_amdgcn_mfma_f32_16x16x32_f16(Kf[tl][s_], Qf[s_], S[tl], 0, 0, 0); }
            float cm = -INFINITY;
#pragma unroll
            for (int tl = 0; tl < 2; ++tl)
#pragma unroll
                for (int e = 0; e < 4; ++e) { if (32 * ch + 16 * tl + 4 * kq + e >= cnt) S[tl][e] = -INFINITY; cm = fmaxf(cm, S[tl][e]); }
            cm = fmaxf(cm, __shfl_xor(cm, 16)); cm = fmaxf(cm, __shfl_xor(cm, 32));
            if (__any(cm > m + 8.0f)) { const float mn = fmaxf(m, cm), alpha = __builtin_amdgcn_exp2f(m - mn); m = mn; l *= alpha;
#pragma unroll
                for (int ft = 0; ft < 16; ++ft) O[ft] = O[ft] * alpha; }
            float pe[2][4]; float ps = 0.f;
#pragma unroll
            for (int tl = 0; tl < 2; ++tl)
#pragma unroll
                for (int e = 0; e < 4; ++e) { pe[tl][e] = __builtin_amdgcn_exp2f(S[tl][e] - m); ps += pe[tl][e]; }
            l += ps;
#pragma unroll
            for (int tl = 0; tl < 2; ++tl)
#pragma unroll
                for (int s_ = 0; s_ < 8; ++s_) *(LAS f16x8*)(V + vw + tl * 8192 + (((4 * (s_ >> 1) + kq) ^ swz) << 5) + (s_ & 1) * 16) = Kf[tl][s_];
            asm volatile("s_waitcnt lgkmcnt(0)" ::: "memory");
            u32x4 pk; pk.x = pk_h2(pe[0][0], pe[0][1]); pk.y = pk_h2(pe[0][2], pe[0][3]); pk.z = pk_h2(pe[1][0], pe[1][1]); pk.w = pk_h2(pe[1][2], pe[1][3]);
            const f16x8 Pf = __builtin_bit_cast(f16x8, pk);
#pragma unroll
            for (int ft = 0; ft < 16; ++ft) {
                const v4i16_t lo = __builtin_amdgcn_ds_read_tr16_b64_v4i16((LAS v4i16_t*)(V + tr0 + (((ft & 7) ^ x0) << 5) + (ft >> 3) * 256));
                const v4i16_t hi = __builtin_amdgcn_ds_read_tr16_b64_v4i16((LAS v4i16_t*)(V + tr0 + (((ft & 7) ^ x0) << 5) + (ft >> 3) * 256 + 8192));
                const s16x8 av = {lo[0], lo[1], lo[2], lo[3], hi[0], hi[1], hi[2], hi[3]};
                O[ft] = __builtin_amdgcn_mfma_f32_16x16x32_f16(__builtin_bit_cast(f16x8, av), Pf, O[ft], 0, 0, 0); }
            asm volatile("s_waitcnt lgkmcnt(0)" ::: "memory");
        }
        l += __shfl_xor(l, 16); l += __shfl_xor(l, 32);
        if (c < 8) { const float il = __builtin_amdgcn_rcpf(l);
#pragma unroll
            for (int ft = 0; ft < 16; ++ft) { const f32x4 o = O[ft] * il; u32x2 pk; pk.x = pk_h2(o.x, o.y); pk.y = pk_h2(o.z, o.w);
                *(u32x2*)(qlat + (size_t)tok * 2048 + c * 256 + 16 * ft + 4 * kq) = pk; } }
#undef SW_LOADK
    }
}


__device__ __forceinline__ void precomb_tiles(const Frame& F, const Args& args, unsigned char* ws, int t_lo, int t_hi, int wg, int nwg) {
    LAS float* As = (LAS float*)(F.lds); LAS float* Bs = (LAS float*)(F.lds + 64 * 65 * 4);
    for (int tl = t_lo + wg; tl < t_hi; tl += nwg) {
        __syncthreads();
        const bool ql = tl < 192; int hd, rb, xb;
        if (ql) { hd = tl / 24; rb = (tl % 24) / 6; xb = tl % 6; } else { const int t2 = tl - 192; hd = t2 / 64; rb = (t2 % 64) / 16; xb = t2 % 16; }
#pragma unroll
        for (int k = 0; k < 2; ++k) { const int i4 = F.tid + NTHR * k, row = i4 >> 4, c4 = (i4 & 15) * 4;
            if (ql) { const f32x4 a = *(const f32x4*)(args.in[15] + (size_t)(rb * 64 + row) * 512 + hd * 64 + c4), bq = *(const f32x4*)(args.in[14] + (size_t)(xb * 64 + row) * 768 + hd * 96 + c4);
#pragma unroll
                for (int e = 0; e < 4; ++e) { As[row * 65 + c4 + e] = a[e]; Bs[row * 65 + c4 + e] = bq[e]; } }
            else { const f32x4 a = *(const f32x4*)(args.in[18] + (size_t)(hd * 64 + row) * DM + xb * 64 + c4), bq = *(const f32x4*)(args.in[16] + (size_t)(rb * 64 + row) * 512 + hd * 64 + c4);
#pragma unroll
                for (int e = 0; e < 4; ++e) { As[(c4 + e) * 65 + row] = a[e]; Bs[row * 65 + c4 + e] = bq[e]; } } }
        __syncthreads();
        const int j = F.tid & 63, ig = F.wave;
        float acc8[8];
#pragma unroll
        for (int ii = 0; ii < 8; ++ii) acc8[ii] = 0.f;
#pragma unroll 4
        for (int v = 0; v < 64; ++v) { const float bv = Bs[j * 65 + v];
#pragma unroll
            for (int ii = 0; ii < 8; ++ii) acc8[ii] += As[(ig * 8 + ii) * 65 + v] * bv; }
        if (ql) { const float gj = args.in[12][xb * 64 + j]; h16* o = (h16*)(ws + OW_4);
#pragma unroll
            for (int ii = 0; ii < 8; ++ii) o[(size_t)(hd * 256 + rb * 64 + ig * 8 + ii) * QL + xb * 64 + j] = (h16)(acc8[ii] * gj); }
        else { h16* o = (h16*)(ws + OW_OV);
#pragma unroll
            for (int ii = 0; ii < 8; ++ii) o[(size_t)(xb * 64 + ig * 8 + ii) * 2048 + hd * 256 + rb * 64 + j] = (h16)acc8[ii]; }
    }
    __syncthreads();
}


__device__ __forceinline__ void ph_topk_sparse(const Frame& F, const h16* qi, const h16* ki, const float* wi, unsigned short* sel, h16* qlat, const h16* qr, const unsigned char* ckv8, const unsigned char* kr8) {
    LAS unsigned* hist = (LAS unsigned*)(F.lds + F.wave * 16384);
    for (int p = F.gw; p < 2048; p += F.NGW) {
        int ta, tb;
        if (p < 4 * 448) { const int b = p & 3, pj = p >> 2; ta = b * SEQ + 4 * (64 + pj); tb = b * SEQ + 4 * (959 - pj);
            tk_group(F, qi, ki, wi, sel, b, 4 * (64 + pj), hist);
            tk_group(F, qi, ki, wi, sel, b, 4 * (959 - pj), hist); }
        else { const int q_ = p - 4 * 448, b = q_ & 3, i_ = q_ >> 2, t0 = 4 * i_;
            tk_group(F, qi, ki, wi, sel, b, 4 * (960 + i_), hist);
            int l0 = F.lane; asm volatile("" : "+v"(l0));
            for (int i = l0; i < 4 * TOPK; i += 64) { const int q = i >> 8, k = i & 255; sel[(size_t)(b * SEQ + t0 + q) * TOPK + k] = (unsigned short)(k <= t0 + q ? k : 0); }
            ta = b * SEQ + 4 * (960 + i_); tb = b * SEQ + t0; }
        asm volatile("s_waitcnt vmcnt(0) lgkmcnt(0)" ::: "memory");
        ph_sparse_wave<true>(F, qlat, qr, ckv8, kr8, sel, ta, tb);
        asm volatile("s_waitcnt lgkmcnt(0)" ::: "memory");
    }
}

__global__ void __launch_bounds__(NTHR, 2) mega_fwd(Args args) {
    extern __shared__ __attribute__((aligned(16))) unsigned char lds_raw[];
    Frame F; F.lds = (LAS unsigned char*)lds_raw; F.tid = threadIdx.x; F.lane = F.tid & 63; F.wave = __builtin_amdgcn_readfirstlane(F.tid >> 6);
    F.G = gridDim.x; F.gw = blockIdx.x * NWAVES + F.wave; F.NGW = F.G * NWAVES;
    volatile LAS unsigned* MISC = (volatile LAS unsigned*)(F.lds + MISC_OFF);
    unsigned char* ws = args.ws;
    for (int u = F.tid; u < (LDS_BYTES - LDSCTL_OFF) / 4; u += NTHR) ((LAS unsigned*)(F.lds + LDSCTL_OFF))[u] = 0u;
    __syncthreads();
    XcdBarrier bar = xcd_barrier_post((unsigned*)(ws + OFF_CTL) + CW_BAR, MISC + 8, F.wave);
    const int lo = args.ph_lo, hi = args.ph_hi;
#define IN(k) (lo <= (k) && (k) < hi)
#define SEAM(k) do { if (IN(k) && IN((k) + 1)) xcd_barrier(bar); F.lane = flane(); F.tid = F.wave * 64 + F.lane; } while (0)
    float* mod = (float*)(ws + OFF_MOD); float2* tab = (float2*)(ws + OFF_ROPE);
    h16* Hb = (h16*)(ws + OFF_H); h16* Ab = (h16*)(ws + OFF_A); float* Fb = (float*)(ws + OFF_F);

    if (IN(0)) {
        LAS float* scr = (LAS float*)(F.lds + F.wave * 16384);
        for (int ch = blockIdx.x; ch < (NMOD * DM) / 36; ch += F.G) {
            LAS float* sl = (LAS float*)(F.lds);
            LAS f32x4* part = (LAS f32x4*)(F.lds + 16384);
            __syncthreads();
            for (int i = F.tid; i < 4 * DM; i += NTHR) sl[i] = silu_f(args.in[1][i]);
            __syncthreads();
            const int r7 = F.lane / 9, c4 = F.lane - 9 * r7; const bool act = F.lane < 63;
            const float* wm = args.in[3] + (size_t)(F.wave * 128 + r7) * (NMOD * DM) + ch * 36 + 4 * c4;
            f32x4 wv[19];
#pragma unroll
            for (int i = 0; i < 19; ++i) { const bool ok = act && (7 * i + r7 < 128); wv[i] = *(const f32x4*)(wm + (size_t)(ok ? 7 * i : 0) * (NMOD * DM)); }
            f32x4 a0 = {0.f, 0.f, 0.f, 0.f}, a1 = a0, a2 = a0, a3 = a0;
#pragma unroll
            for (int i = 0; i < 19; ++i) { const bool ok = act && (7 * i + r7 < 128); const int kk = F.wave * 128 + (ok ? 7 * i + r7 : 0); const f32x4 w = ok ? wv[i] : (f32x4){0.f, 0.f, 0.f, 0.f};
                a0 += w * sl[kk]; a1 += w * sl[DM + kk]; a2 += w * sl[2 * DM + kk]; a3 += w * sl[3 * DM + kk]; }
            if (act) { LAS f32x4* pp = part + ((F.wave * 7 + r7) * 4) * 9 + c4; pp[0] = a0; pp[9] = a1; pp[18] = a2; pp[27] = a3; }
            __syncthreads();
            if (F.tid < 144) { const int b = F.tid / 36, l = F.tid - 36 * b; float sm = args.in[4][ch * 36 + l]; const LAS float* pf = (const LAS float*)part + (b * 9) * 4 + l;
#pragma unroll 8
                for (int w = 0; w < 56; ++w) sm += pf[w * 144];
                mod[b * (NMOD * DM) + ch * 36 + l] = sm; }
            __syncthreads();
        }
        for (int idx = blockIdx.x * NTHR + F.tid; idx < MT * 48; idx += F.G * NTHR) { const int tok = idx / 48, i = idx % 48;
            const float inv = (i < 32) ? powf(10000.f, -(float)i / 32.f) : powf(10000.f, -(float)(i - 32) / 16.f);
            const float ang = (float)((const int*)args.in[2])[tok] * inv; float sn, cs; sincosf(ang, &sn, &cs); tab[idx] = make_float2(cs, sn); }
        tr_job_mapped(F, args, 0, 2 * FF, 0, DM, ws + OW_GU1, nullptr, scr, 0);
        if (F.G != 256) {
            tr_job_plain(F, args.in[8], DM, DM, FF, ws + OW_D1, scr, 768);
            tr_job_mapped(F, args, 2, NIN3, 0, DM, (h16*)(ws + OW_IN), nullptr, scr, 128);
            tr_job_plain(F, args.in[11] + C_GATE, DIN, 2048, DM, ws + OW_GATE, scr, 1664);
            tr_job_mapped(F, args, 3, 512, 2048, QL, (h16*)(ws + OW_4), args.in[12], scr, 640);
            tr_job_plain(F, args.in[19], DM, DM, 256, (h16*)(ws + OW_UPB), scr, 736);
            tr_job_plain(F, args.in[20], DM, DM, DM, (h16*)(ws + OW_O), scr, 864);
            tr_job_mapped(F, args, 1, 2 * FF, 0, DM, ws + OW_GU2, nullptr, scr, 1376);
            tr_job_plain(F, args.in[25], DM, DM, FF, ws + OW_D2, scr, 96);
            precomb_tiles(F, args, ws, 0, 192, (int)blockIdx.x, F.G);
            tr_job_plain(F, args.in[18], DM, DM, 512, (h16*)(ws + OW_UPA), scr, 256);
        }
    }
    SEAM(0);
    if (IN(1)) ph_normmod(F, args.in[0], args.in[5], mod, 1, 0, ws + OFF_H);
    SEAM(1);
    if (IN(2)) { pg8::Gemm g{Hb, (const h16*)(ws + OW_GU1), MT, 2 * FF, DM / 2}; pg8::StaticOrder S; S.init(MT, 2 * FF, F.G, (int)blockIdx.x); pg8::EpiSwiGLU_T<true> E{Ab};
        pg8::gemm_phase<pg8::EpiSwiGLU_T<true>, true, true>(F.lds, g, S, E, F.wave);
        if (F.G == 256 && blockIdx.x >= 128) {
            Frame F2 = F; F2.gw = ((int)blockIdx.x - 128) * NWAVES + F.wave; F2.NGW = 128 * NWAVES; LAS float* scr = (LAS float*)(F.lds + F.wave * 16384);
            tr_job_plain(F2, args.in[8], DM, DM, FF, ws + OW_D1, scr, 0);
            tr_job_mapped(F2, args, 2, NIN3, 0, DM, (h16*)(ws + OW_IN), nullptr, scr, 384);
            tr_job_mapped(F2, args, 3, 512, 2048, QL, (h16*)(ws + OW_4), args.in[12], scr, 896);
            tr_job_mapped(F2, args, 1, 2 * FF, 0, DM, ws + OW_GU2, nullptr, scr, 640);
            precomb_tiles(F, args, ws, 0, 192, (int)blockIdx.x - 128, 128);
            for (int i = ((int)blockIdx.x - 128) * NTHR + F.tid; i < (int)(MiB / 16); i += 128 * NTHR) ((u32x4*)(ws + OW_BD))[i] = (u32x4){0u, 0u, 0u, 0u}; } }
    SEAM(2);
    if (IN(3)) { pg8::Gemm g{Ab, (const h16*)(ws + OW_D1), MT, DM, FF / 2}; pg8::StaticOrder S; S.init(MT, DM, F.G, (int)blockIdx.x); pg8::EpiH16_T<true> E{(h16*)Fb};
        pg8::gemm_phase<pg8::EpiH16_T<true>, false, true>(F.lds, g, S, E, F.wave); }
    SEAM(3);
    if (IN(4)) ph_resnorm<false, true>(F, args.in[0], (const h16*)Fb, args.in[9], mod, 2, 0.5f, args.out, true, args.in[10], 4, 3, Hb, (unsigned char*)args.out + 32 * MiB);
    SEAM(4);
    if (IN(5)) { pg8::Gemm g{Hb, (const h16*)(ws + OW_IN), MT, NIN3, DM}; pg8::StaticOrder S; S.init(MT, NIN3, F.G, (int)blockIdx.x);
        pg8::EpiIn E{(h16*)(ws + OFF_CKV), (h16*)(ws + OFF_CQ), (h16*)(ws + OFF_KR), (h16*)(ws + OFF_KI), (h16*)(ws + OFF_QB), (h16*)(ws + OFF_KB), (h16*)(ws + OFF_VT), (float*)(ws + OFF_WI), (float*)(ws + OFF_SSQ),
                     args.in[13], tab, (LAS float*)(F.lds + XCH_OFF)};
        pg8::gemm_phase<pg8::EpiIn, true>(F.lds, g, S, E, F.wave); }
    SEAM(5);
    if (IN(6)) { for (int tk_ = blockIdx.x * NTHR + F.tid; tk_ < MT; tk_ += F.G * NTHR) { const f32x4 s0 = *(const f32x4*)((const float*)(ws + OFF_SSQ) + tk_ * 8), s1 = *(const f32x4*)((const float*)(ws + OFF_SSQ) + tk_ * 8 + 4);
            ((float*)(ws + OFF_RSTDQ))[tk_] = rsqrtf((((s0.x + s0.y) + (s0.z + s0.w)) + ((s1.x + s1.y) + (s1.z + s1.w))) * (1.f / QL) + EPS); } }
    if (IN(6)) ph_dilated_mfma(F, (const h16*)(ws + OFF_QB), (const h16*)(ws + OFF_KB), (const h16*)(ws + OFF_VT), (h16*)(ws + OFF_OG), (float*)(ws + OFF_LSE));
    SEAM(6);
    if (IN(7)) { pg8::Gemm g{(const h16*)(ws + OFF_CQ), (const h16*)(ws + OW_4), MT, N4, QL}; pg8::StaticOrder S; S.init(MT, N4, F.G, (int)blockIdx.x);
        pg8::Epi4 E{(h16*)(ws + OFF_QLAT), (h16*)(ws + OFF_QR), (h16*)(ws + OFF_QI), (const float*)(ws + OFF_RSTDQ), tab};
        pg8::gemm_phase<pg8::Epi4, true>(F.lds, g, S, E, F.wave);
        if (F.G == 256 && blockIdx.x >= 128) {
            Frame F2 = F; F2.gw = ((int)blockIdx.x - 128) * NWAVES + F.wave; F2.NGW = 128 * NWAVES; LAS float* scr = (LAS float*)(F.lds + F.wave * 16384);
            tr_job_plain(F2, args.in[11] + C_GATE, DIN, 2048, DM, ws + OW_GATE, scr, 0);
            tr_job_plain(F2, args.in[19], DM, DM, 256, (h16*)(ws + OW_UPB), scr, 512);
            tr_job_plain(F2, args.in[20], DM, DM, DM, (h16*)(ws + OW_O), scr, 640);
            tr_job_plain(F2, args.in[18], DM, DM, 512, (h16*)(ws + OW_UPA), scr, 256);
            for (int it = F2.gw; it < 4 * 16; it += F2.NGW) { const int kb = it >> 4, nb = it & 15, n0 = nb * 32, hl = (n0 >> 6) & 3;
                tr_item(args.in[16], 512, n0 + (F.lane & 31), true, nullptr, kb * 64, (h16*)(ws + OW_BD) + (size_t)n0 * 1024 + 256 * hl, 1024, scr, F.lane); } } }
    SEAM(7);
    if (IN(8)) { ph_combine(F, (const h16*)(ws + OFF_OG), (const float*)(ws + OFF_LSE), (h16*)(ws + OFF_OB));
        ph_topk_sparse(F, (const h16*)(ws + OFF_QI), (const h16*)(ws + OFF_KI), (const float*)(ws + OFF_WI), (unsigned short*)(ws + OFF_SEL),
                       (h16*)(ws + OFF_QLAT), (const h16*)(ws + OFF_QR), (const unsigned char*)(ws + OFF_CKV), (const unsigned char*)(ws + OFF_KR)); }
    SEAM(8);
    if (IN(9) && F.G == 256) { const bool first = blockIdx.x < 128;
        pg8::Gemm g{first ? (const h16*)(ws + OFF_QLAT) : (const h16*)(ws + OFF_OB), first ? (const h16*)(ws + OW_BD) : (const h16*)(ws + OW_UPB), MT, first ? 512 : DM, first ? 1024 : 256, first ? 2048 : 0, first ? 1024 : 0};
        pg8::StaticOrder S; S.init(MT, first ? 512 : DM, 128, first ? (int)blockIdx.x : (int)blockIdx.x - 128);
        pg8::EpiH16 E{first ? (h16*)(ws + OFF_OA) : (h16*)(ws + OFF_Y2), first ? 512 : DM};
        pg8::gemm_phase<pg8::EpiH16, false>(F.lds, g, S, E, F.wave); }
    SEAM(9);
    if (IN(10)) { pg8::StaticOrder S; S.init(MT, DM, F.G, (int)blockIdx.x); h16* Y1 = (h16*)(ws + OFF_Y1); h16* Y2 = (h16*)(ws + OFF_Y2);
        { pg8::Gemm g{(const h16*)(ws + OFF_OA), (const h16*)(ws + OW_UPA), MT, DM, 512}; pg8::EpiH16 E{Y1}; pg8::gemm_phase<pg8::EpiH16, false>(F.lds, g, S, E, F.wave); }
        const h16* u8 = (const h16*)((const unsigned char*)args.out + 32 * MiB);
        { pg8::Gemm g{u8, (const h16*)(ws + OW_GATE), MT, DM, DM / 2}; pg8::EpiGate E{Y1, Y1, 0, -LOG2E * F8_INV}; pg8::gemm_phase<pg8::EpiGate, false, true>(F.lds, g, S, E, F.wave); }
        { pg8::Gemm g{u8, (const h16*)(ws + OW_GATE + (size_t)DM * DM), MT, DM, DM / 2}; pg8::EpiGate E{Y2, Y1, 1, -LOG2E * F8_INV}; pg8::gemm_phase<pg8::EpiGate, false, true>(F.lds, g, S, E, F.wave); } }
    SEAM(10);
    if (IN(11)) { pg8::Gemm g{(const h16*)(ws + OFF_Y1), (const h16*)(ws + OW_O), MT, DM, DM}; pg8::StaticOrder S; S.init(MT, DM, F.G, (int)blockIdx.x); pg8::EpiH16 E{(h16*)(ws + OFF_YF)};
        pg8::gemm_phase<pg8::EpiH16, false>(F.lds, g, S, E, F.wave); }
    SEAM(11);
    if (IN(12)) ph_resnorm<true, true, unsigned char>(F, args.out, (const h16*)(ws + OFF_YF), args.in[21], mod, 5, 1.0f, ws + OFF_F, true, args.in[22], 7, 6, ws + OFF_H);
    SEAM(12);
    if (IN(13)) { pg8::Gemm g{Hb, (const h16*)(ws + OW_GU2), MT, 2 * FF, DM / 2}; pg8::StaticOrder S; S.init(MT, 2 * FF, F.G, (int)blockIdx.x); pg8::EpiSwiGLU_T<true> E{Ab};
        pg8::gemm_phase<pg8::EpiSwiGLU_T<true>, true, true>(F.lds, g, S, E, F.wave);
        if (F.G == 256 && blockIdx.x >= 128) { Frame F2 = F; F2.gw = ((int)blockIdx.x - 128) * NWAVES + F.wave; F2.NGW = 128 * NWAVES;
            tr_job_plain(F2, args.in[25], DM, DM, FF, ws + OW_D2, (LAS float*)(F.lds + F.wave * 16384), 0); } }
    SEAM(13);
    if (IN(14)) { pg8::Gemm g{Ab, (const h16*)(ws + OW_D2), MT, DM, FF / 2}; pg8::StaticOrder S; S.init(MT, DM, F.G, (int)blockIdx.x); pg8::EpiH16_T<true> E{(h16*)(ws + OFF_F + 32 * MiB)};
        pg8::gemm_phase<pg8::EpiH16_T<true>, false, true>(F.lds, g, S, E, F.wave); }
    SEAM(14);
    if (IN(15)) ph_resnorm<true, false>(F, ws + OFF_F, (const h16*)(ws + OFF_F + 32 * MiB), args.in[26], mod, 8, 0.5f, args.out, false, nullptr, 0, 0, (h16*)nullptr);
#undef IN
#undef SEAM
}


extern "C" void kernel_launch(void* const* d_in, const int* in_sizes, int n_in, void* d_out, int out_size, void* d_ws, size_t ws_size, hipStream_t stream) {
    if (n_in != 27 || ws_size < WS_END || out_size != MT * DM) { fprintf(stderr, "kernel_launch: unexpected shapes (n_in %d ws %zu out %d)\n", n_in, ws_size, out_size); return; }
    static int grid = 0;
    if (grid == 0) {
        int dev = 0, cus = 0, per_cu = 0;
        if (hipGetDevice(&dev) != hipSuccess || hipDeviceGetAttribute(&cus, hipDeviceAttributeMultiprocessorCount, dev) != hipSuccess) { grid = -1; return; }
        if (hipFuncSetAttribute((const void*)mega_fwd, hipFuncAttributeMaxDynamicSharedMemorySize, LDS_BYTES) != hipSuccess) { fprintf(stderr, "kernel_launch: hipFuncSetAttribute failed\n"); grid = -1; return; }
        if (hipOccupancyMaxActiveBlocksPerMultiprocessor(&per_cu, (const void*)mega_fwd, NTHR, LDS_BYTES) != hipSuccess || per_cu < 1) { fprintf(stderr, "kernel_launch: occupancy query says %d blocks/CU\n", per_cu); grid = -1; return; }
        grid = cus;
    }
    if (grid < 0) return;
    hipMemsetAsync((char*)d_ws + OFF_CTL, 0, 1 * MiB, stream);
    Args a{}; for (int i = 0; i < 27; ++i) a.in[i] = (const float*)d_in[i]; a.out = (float*)d_out; a.ws = (unsigned char*)d_ws; a.ph_lo = 0; a.ph_hi = 16;
    void* kargs[] = {&a};
#ifdef PH_DOUBLE
    a.ph_hi = PH_DOUBLE + 1; (void)hipLaunchCooperativeKernel((const void*)mega_fwd, dim3(grid), dim3(NTHR), kargs, LDS_BYTES, stream);
    hipMemsetAsync((char*)d_ws + OFF_CTL, 0, 1 * MiB, stream); a.ph_lo = PH_DOUBLE; a.ph_hi = 16;
#endif
    const hipError_t e = hipLaunchCooperativeKernel((const void*)mega_fwd, dim3(grid), dim3(NTHR), kargs, LDS_BYTES, stream);
    if (e != hipSuccess) fprintf(stderr, "kernel_launch: cooperative launch failed: %s (grid %d)\n", hipGetErrorString(e), grid);
    (void)in_sizes;
}
```

```cpp
#include <hip/hip_runtime.h>
#include <hip/hip_fp16.h>
#include <cstdio>
#include <cstdint>

constexpr int NB = 4, SEQ = 4096, DM = 1024, MT = NB * SEQ, FF = 2816;
constexpr int QL = 384, KVL = 256, DNOPE = 64, DROPE = 32, DVA = 64, HA = 8, HI = 8, DI = 32, TOPK = 256;
constexpr int NG = 3, HB = 4, DHB = 64, NMOD = 9, DIN = 5064;
constexpr int C_CQ = 0, C_CKV = 384, C_KR = 640, C_KI = 672, C_WI = 704, C_QKV = 712, C_GATE = 3016;
constexpr float EPS = 1e-6f, LOG2E = 1.4426950408889634f;
typedef _Float16 h16;

constexpr size_t MiB = 1u << 20;
constexpr size_t OFF_CTL = 0, OFF_MOD = 1 * MiB, OFF_ROPE = 2 * MiB, OFF_W = 8 * MiB, OFF_H = 60 * MiB, OFF_A = 92 * MiB, OFF_F = 180 * MiB, OFF_SP = 244 * MiB, WS_END = 256 * MiB;
constexpr size_t OFF_QB = OFF_A, OFF_KB = OFF_A + 24 * MiB, OFF_VT = OFF_A + 48 * MiB, OFF_CKV = OFF_A + 72 * MiB, OFF_KR = OFF_A + 80 * MiB, OFF_KI = OFF_A + 81 * MiB,
                 OFF_WI = OFF_A + 82 * MiB, OFF_SSQ = OFF_A + 82 * MiB + 512 * 1024, OFF_CQ = OFF_SP;
constexpr size_t OFF_RSTDQ = OFF_A + 83 * MiB;
constexpr size_t OFF_OG = OFF_F, OFF_LSE = OFF_F + 24 * MiB, OFF_QLAT = OFF_A, OFF_QR = OFF_A + 64 * MiB, OFF_QI = OFF_F + 25 * MiB, OFF_SEL = OFF_F + 33 * MiB, OFF_OB = OFF_SP;
constexpr size_t OFF_Y1 = OFF_F, OFF_Y2 = OFF_F + 32 * MiB, OFF_YF = OFF_A;

__device__ __forceinline__ float silu_f(float v) { return v / (1.f + __expf(-v)); }
__device__ __forceinline__ float sigm_f(float v) { return 1.f / (1.f + __expf(-v)); }
__host__ __device__ __forceinline__ int dil_of(int g) { return g == 0 ? 1 : (g == 1 ? 4 : 16); }
__device__ __forceinline__ unsigned fkey(float f) { const unsigned u = __float_as_uint(f); return (u & 0x80000000u) ? ~u : (u | 0x80000000u); }


#define LAS __attribute__((address_space(3)))
#define GAS __attribute__((address_space(1)))
typedef _Float16 f16x8 __attribute__((ext_vector_type(8)));
typedef float f32x4 __attribute__((ext_vector_type(4)));
typedef float f32x2 __attribute__((ext_vector_type(2)));
typedef unsigned u32x4 __attribute__((ext_vector_type(4)));
typedef unsigned u32x2 __attribute__((ext_vector_type(2)));
typedef _Float16 h16x2 __attribute__((ext_vector_type(2)));
__device__ __forceinline__ unsigned pk_h2(float lo, float hi) { f32x2 v = {lo, hi}; h16x2 h = __builtin_convertvector(v, h16x2); return __builtin_bit_cast(unsigned, h); }
__device__ __forceinline__ int flane() { int l; asm volatile("v_mbcnt_lo_u32_b32 %0, -1, 0\n\tv_mbcnt_hi_u32_b32 %0, -1, %0" : "=v"(l)); return l; }
__device__ __forceinline__ float sat8(float x) { return __builtin_amdgcn_fmed3f(x, -448.f, 448.f); }
__device__ __forceinline__ unsigned pk_f8x4(float a, float b, float c, float d) { int w = __builtin_amdgcn_cvt_pk_fp8_f32(sat8(a), sat8(b), 0, false); w = __builtin_amdgcn_cvt_pk_fp8_f32(sat8(c), sat8(d), w, true); return (unsigned)w; }
typedef int i32x4 __attribute__((ext_vector_type(4)));
typedef int i32x8 __attribute__((ext_vector_type(8)));
constexpr float F8_ACT = 8.f, F8_WGT = 512.f, F8_INV = 1.f / (F8_ACT * F8_WGT);

namespace pg8 {
constexpr int BM = 256, BK = 64, HALF = 128, HTB = HALF * BK * 2, STAGE_BYTES = 8 * HTB, NXCD = 8, WGM = 8;
__host__ __device__ __forceinline__ int lds_byte(int r, int c) { const int st = (r >> 4) * 2 + (c >> 5), rr = r & 15, cc = c & 31, ob = rr * 64 + cc * 2; return st * 1024 + (ob ^ (((ob >> 9) & 1) << 5)); }
__host__ __device__ __forceinline__ void stage_rc(int b, int& R, int& C) { const int st = b / 1024, sb = b % 1024, swz = sb ^ (((sb >> 9) & 1) << 5); R = (st >> 1) * 16 + swz / 64; C = (st & 1) * 32 + (swz % 64) / 2; }
__host__ __device__ __forceinline__ int perm32(int rho) { const int n = rho >> 4, i = rho & 15; return 8 * (i >> 2) + 4 * n + (i & 3); }
struct Unit { int pm, pn; };
struct Gemm { const h16* A; const h16* Bt; int M, N, K; int lda = 0, koffA = 0; };
struct StaticOrder {
    int nM, nN, nwg, G, c;
    __host__ __device__ void init(int M, int N, int G_, int c_) { nM = M / BM; nN = N / BM; nwg = nM * nN; G = G_; c = c_; }
    __host__ __device__ bool next(int i, Unit& u) const {
        const long L = (long)i * G + c; if (L >= nwg) return false;
        int wgid = (int)L; { const int q = nwg / NXCD, r = nwg % NXCD, xcd = wgid % NXCD, off = wgid / NXCD; wgid = (xcd < r ? xcd * (q + 1) : r * (q + 1) + (xcd - r) * q) + off; }
        const int nig = WGM * nN, gid = wgid / nig, fm = gid * WGM, gsz = (nM - fm) < WGM ? (nM - fm) : WGM;
        u.pm = fm + ((wgid % nig) % gsz); u.pn = (wgid % nig) / gsz; return true;
    }
};
template <class Epi, bool ALIGN_EPI, bool F8 = false>
__device__ __forceinline__ void gemm_phase(LAS unsigned char* lds, const Gemm g, const StaticOrder& S, const Epi& E, const int wid) {
    const int lane = flane(), tid = wid * 64 + lane, wr = wid >> 2, wc = wid & 3, fr = lane & 15, fq = lane >> 4;
    const int K = g.K, lda = g.lda ? g.lda : g.K; int nt = K / BK;
    if constexpr (F8) asm volatile("" : "+s"(nt));
    unsigned voffA[2], voffB[2];
#pragma unroll
    for (int i = 0; i < 2; ++i) { int R, C; stage_rc(tid * 16 + i * 8192, R, C); const int Rb = Epi::PERM ? ((R & ~31) + perm32(R & 31)) : R;
        voffA[i] = (unsigned)(R * lda + C) * 2u; voffB[i] = (unsigned)(Rb * K + C) * 2u; }
    const size_t kstep = (size_t)(BK * 2);
    const size_t hstep = (size_t)HALF * K * 2, hstepA = (size_t)HALF * lda * 2;
    const size_t tstep = 2 * hstep, tstepA = 2 * hstepA, kofA = (size_t)g.koffA * 2;
    const unsigned ldsw = (unsigned)wid * 1024u;
    const int aoff = lds_byte(wr * 64 + fr, fq * 8), boff = lds_byte(wc * 32 + fr, fq * 8);
#define PG8_SA(b, h) (((b) * 2 + (h)) * HTB)
#define PG8_SB(b, h) ((4 + (b) * 2 + (h)) * HTB)
#define PG8_STAGE(bufoff, gbase, voff) do { _Pragma("unroll") for (int _i = 0; _i < 2; ++_i) { unsigned _vo = (voff)[_i]; asm volatile("" : "+v"(_vo)); \
        __builtin_amdgcn_global_load_lds((const unsigned*)((const char*)(gbase) + _vo), (LAS unsigned*)(lds + (bufoff) + ldsw + _i * 8192), 16, 0, 0); } } while (0)
#define PG8_LDA(dst, b, h) do { _Pragma("unroll") for (int m = 0; m < 4; ++m) _Pragma("unroll") for (int k = 0; k < 2; ++k) dst[m][k] = *(const LAS f16x8*)(lds + PG8_SA(b, h) + aoff + m * 2048 + k * 1024); } while (0)
#define PG8_LDB(dst, b, h) do { _Pragma("unroll") for (int n = 0; n < 2; ++n) _Pragma("unroll") for (int k = 0; k < 2; ++k) dst[n][k] = *(const LAS f16x8*)(lds + PG8_SB(b, h) + boff + n * 2048 + k * 1024); } while (0)
#define PG8_CAT8(x, y) __builtin_shufflevector(__builtin_bit_cast(i32x4, x), __builtin_bit_cast(i32x4, y), 0, 1, 2, 3, 4, 5, 6, 7)
#define PG8_MMA(ai, bj, At, Bt) do { __builtin_amdgcn_s_setprio(1); \
        if constexpr (F8) { _Pragma("unroll") for (int m = 0; m < 4; ++m) _Pragma("unroll") for (int n = 0; n < 2; ++n) \
            acc[ai][bj][m][n] = __builtin_amdgcn_mfma_scale_f32_16x16x128_f8f6f4(PG8_CAT8(Bt[n][0], Bt[n][1]), PG8_CAT8(At[m][0], At[m][1]), acc[ai][bj][m][n], 0, 0, 0, 0, 0, 0); } \
        else { _Pragma("unroll") for (int m = 0; m < 4; ++m) _Pragma("unroll") for (int n = 0; n < 2; ++n) _Pragma("unroll") for (int k = 0; k < 2; ++k) \
            acc[ai][bj][m][n] = __builtin_amdgcn_mfma_f32_16x16x32_f16(Bt[n][k], At[m][k], acc[ai][bj][m][n], 0, 0, 0); } \
        __builtin_amdgcn_s_setprio(0); } while (0)
#define PG8_WAIT_V(n) asm volatile("s_waitcnt vmcnt(" #n ")" ::: "memory")
#define PG8_WAIT_L(n) asm volatile("s_waitcnt lgkmcnt(" #n ")" ::: "memory")
#define PG8_BAR __builtin_amdgcn_s_barrier()
#define PG8_SCHED __builtin_amdgcn_sched_barrier(0)
    Unit cur, nxt; int ui = 0;
    if (!S.next(0, cur)) return;
    f32x4 acc[2][2][4][2];
#pragma unroll
    for (int a = 0; a < 2; ++a)
#pragma unroll
        for (int b = 0; b < 2; ++b)
#pragma unroll
            for (int m = 0; m < 4; ++m)
#pragma unroll
                for (int n = 0; n < 2; ++n) acc[a][b][m][n] = (f32x4){0.f, 0.f, 0.f, 0.f};
    f16x8 At[4][2], B0[2][2], B1[2][2];
    const char* cA = (const char*)g.A + (size_t)cur.pm * tstepA + (size_t)cur.pn * kofA; const char* cB = (const char*)g.Bt + (size_t)cur.pn * tstep;
    PG8_STAGE(PG8_SB(0, 0), cB, voffB); PG8_STAGE(PG8_SB(0, 1), cB + hstep, voffB); PG8_STAGE(PG8_SA(0, 0), cA, voffA); PG8_STAGE(PG8_SA(0, 1), cA + hstepA, voffA);
    if (wr == 1) PG8_BAR;
    PG8_WAIT_V(2); PG8_BAR;
    PG8_STAGE(PG8_SB(1, 0), cB + kstep, voffB); PG8_STAGE(PG8_SA(1, 0), cA + kstep, voffA); PG8_STAGE(PG8_SB(1, 1), cB + hstep + kstep, voffB);
    PG8_WAIT_V(6); PG8_BAR;
    for (;;) {
        const bool has_next = S.next(ui + 1, nxt);
        const char* nA = has_next ? (const char*)g.A + (size_t)nxt.pm * tstepA + (size_t)nxt.pn * kofA : cA; const char* nB = has_next ? (const char*)g.Bt + (size_t)nxt.pn * tstep : cB;
        for (int t = 0; t < nt; t += 2) {
            const bool last = (t == nt - 2);
            const char* a1 = cA + (size_t)(t + 1) * kstep;
            const char* a2 = last ? nA : cA + (size_t)(t + 2) * kstep; const char* b2 = last ? nB : cB + (size_t)(t + 2) * kstep;
            const char* a3 = a2 + kstep; const char* b3 = b2 + kstep;
            PG8_LDB(B0, 0, 0); PG8_LDB(B1, 0, 1); PG8_SCHED; PG8_LDA(At, 0, 0); PG8_STAGE(PG8_SA(1, 1), a1 + hstepA, voffA);
            PG8_WAIT_V(8); PG8_WAIT_L(0); PG8_BAR; PG8_MMA(0, 0, At, B0); PG8_MMA(0, 1, At, B1); PG8_BAR; PG8_SCHED;
            PG8_LDA(At, 0, 1); PG8_STAGE(PG8_SB(0, 0), b2, voffB); PG8_STAGE(PG8_SB(0, 1), b2 + hstep, voffB); PG8_STAGE(PG8_SA(0, 0), a2, voffA);
            PG8_WAIT_V(8); PG8_WAIT_L(0); PG8_BAR; PG8_MMA(1, 0, At, B0); PG8_MMA(1, 1, At, B1); PG8_BAR; PG8_SCHED;
            PG8_LDB(B0, 1, 0); PG8_LDB(B1, 1, 1); PG8_SCHED; PG8_LDA(At, 1, 0); PG8_STAGE(PG8_SA(0, 1), a2 + hstepA, voffA);
            PG8_WAIT_V(8); PG8_WAIT_L(0); PG8_BAR; PG8_MMA(0, 0, At, B0); PG8_MMA(0, 1, At, B1); PG8_BAR; PG8_SCHED;
            PG8_LDA(At, 1, 1); PG8_STAGE(PG8_SB(1, 0), b3, voffB); PG8_STAGE(PG8_SB(1, 1), b3 + hstep, voffB); PG8_STAGE(PG8_SA(1, 0), a3, voffA);
            PG8_WAIT_V(8); PG8_WAIT_L(0); PG8_BAR; PG8_MMA(1, 0, At, B0); PG8_MMA(1, 1, At, B1); PG8_BAR; PG8_SCHED;
        }
        if constexpr (ALIGN_EPI) { if (wr == 0) PG8_BAR; }
        { const int l2 = flane(); E(acc, cur, wr, wc, l2 & 15, l2 >> 4); }
        if (!has_next) break;
#pragma unroll
        for (int a = 0; a < 2; ++a)
#pragma unroll
            for (int b = 0; b < 2; ++b)
#pragma unroll
                for (int m = 0; m < 4; ++m)
#pragma unroll
                    for (int n = 0; n < 2; ++n) acc[a][b][m][n] = (f32x4){0.f, 0.f, 0.f, 0.f};
        cur = nxt; cA = nA; cB = nB; ++ui;
        if constexpr (ALIGN_EPI) { if (wr == 1) PG8_BAR; }
    }
    PG8_WAIT_V(0);
    if constexpr (!ALIGN_EPI) { if (wr == 0) PG8_BAR; }
    PG8_BAR;
#undef PG8_SA
#undef PG8_SB
#undef PG8_STAGE
#undef PG8_LDA
#undef PG8_LDB
#undef PG8_MMA
#undef PG8_CAT8
#undef PG8_WAIT_V
#undef PG8_WAIT_L
#undef PG8_BAR
#undef PG8_SCHED
}
struct EpiF32 {
    static constexpr bool PERM = false;
    float* C; int ldc;
    __device__ __forceinline__ void operator()(const f32x4 (&acc)[2][2][4][2], const Unit& u, int wr, int wc, int fr, int fq) const {
        const int row0 = u.pm * BM + wr * 64 + fr, col0 = u.pn * BM + wc * 32 + 4 * fq;
#pragma unroll
        for (int ai = 0; ai < 2; ++ai)
#pragma unroll
            for (int m = 0; m < 4; ++m) { float* rowp = C + (size_t)(row0 + ai * HALF + m * 16) * ldc + col0;
#pragma unroll
                for (int bj = 0; bj < 2; ++bj)
#pragma unroll
                    for (int n = 0; n < 2; ++n) *(f32x4*)(rowp + bj * HALF + n * 16) = acc[ai][bj][m][n]; }
    }
};
template <bool F8>
struct EpiSwiGLU_T {
    static constexpr bool PERM = true;
    void* O;
    __device__ __forceinline__ void operator()(const f32x4 (&acc)[2][2][4][2], const Unit& u, int wr, int wc, int fr, int fq) const {
        const int row0 = u.pm * BM + wr * 64 + fr, col0 = u.pn * HALF + wc * 32 + 8 * fq;
#pragma unroll
        for (int ai = 0; ai < 2; ++ai)
#pragma unroll
            for (int m = 0; m < 4; ++m) { const size_t eo = (size_t)(row0 + ai * HALF + m * 16) * FF + col0;
                float v[8];
#pragma unroll
                for (int n = 0; n < 2; ++n)
#pragma unroll
                    for (int e = 0; e < 4; ++e) { float gg = acc[ai][0][m][n][e], uu = acc[ai][1][m][n][e]; if constexpr (F8) { gg *= F8_INV; uu *= F8_INV * F8_ACT; }
                        v[n * 4 + e] = gg * __builtin_amdgcn_rcpf(1.f + __builtin_amdgcn_exp2f(-gg * LOG2E)) * uu; }
                if constexpr (F8) { u32x2 w; w.x = pk_f8x4(v[0], v[1], v[2], v[3]); w.y = pk_f8x4(v[4], v[5], v[6], v[7]); *(u32x2*)((unsigned char*)O + eo) = w; }
                else { u32x4 w; w.x = pk_h2(v[0], v[1]); w.y = pk_h2(v[2], v[3]); w.z = pk_h2(v[4], v[5]); w.w = pk_h2(v[6], v[7]); *(u32x4*)((h16*)O + eo) = w; } }
    }
};
typedef EpiSwiGLU_T<false> EpiSwiGLU;

struct EpiIn {
    static constexpr bool PERM = false;
    h16 *ckv, *cq, *kr, *ki, *qb, *kb, *vT; float *wi, *ssq; const float* gckv; const float2* tab; LAS float* X;
    __device__ __forceinline__ void rope64(const f32x4 (&acc)[2][2][4][2], const Unit& u, int wr, int wc, int fr, int fq, h16* dst, int tl, float scale) const {
        const int tok0 = u.pm * BM + wr * 64 + fr;
        f32x4 tc[4], tn[4];
        { const f32x4* tp = (const f32x4*)(tab + (size_t)tok0 * 48 + 4 * fq); tc[0] = tp[0]; tc[1] = tp[1]; tc[2] = tp[8]; tc[3] = tp[9]; }
#pragma unroll
        for (int rr = 0; rr < 8; ++rr) { const int ai = rr >> 2, m = rr & 3, tok = tok0 + ai * HALF + m * 16;
            if (rr < 7) { const int tokn = tok0 + ((rr + 1) >> 2) * HALF + ((rr + 1) & 3) * 16; const f32x4* tp = (const f32x4*)(tab + (size_t)tokn * 48 + 4 * fq); tn[0] = tp[0]; tn[1] = tp[1]; tn[2] = tp[8]; tn[3] = tp[9]; }
#pragma unroll
            for (int n = 0; n < 2; ++n) { const int i = 16 * n + 4 * fq; const f32x4 t0 = tc[2 * n], t1 = tc[2 * n + 1];
                const f32x4 cs = {t0.x, t0.z, t1.x, t1.z}, sn = {t0.y, t0.w, t1.y, t1.w}, x1 = acc[ai][0][m][n], x2 = acc[ai][1][m][n];
                const f32x4 o1 = (x1 * cs - x2 * sn) * scale, o2 = (x2 * cs + x1 * sn) * scale;
                h16* p = dst + (size_t)tok * 768 + (4 * tl + wc) * 64 + i;
                u32x2 w1, w2; w1.x = pk_h2(o1.x, o1.y); w1.y = pk_h2(o1.z, o1.w); w2.x = pk_h2(o2.x, o2.y); w2.y = pk_h2(o2.z, o2.w);
                *(u32x2*)p = w1; *(u32x2*)(p + 32) = w2; }
#pragma unroll
            for (int k = 0; k < 4; ++k) tc[k] = tn[k];
            asm volatile("" ::: "memory"); }
    }
    __device__ __forceinline__ void operator()(const f32x4 (&acc)[2][2][4][2], const Unit& u, int wr, int wc, int fr, int fq) const {
        const int pn = u.pn;
        if (pn == 0) {
#pragma unroll
            for (int ai = 0; ai < 2; ++ai)
#pragma unroll
                for (int m = 0; m < 4; ++m) { float sq = 0.f;
#pragma unroll
                    for (int bj = 0; bj < 2; ++bj)
#pragma unroll
                        for (int n = 0; n < 2; ++n) { const f32x4 v = acc[ai][bj][m][n]; sq += (v.x * v.x + v.y * v.y) + (v.z * v.z + v.w * v.w); }
                    sq += __shfl_xor(sq, 16); sq += __shfl_xor(sq, 32);
                    if (fq == 0) X[(ai * HALF + wr * 64 + m * 16 + fr) * 4 + wc] = sq; }
            asm volatile("s_waitcnt lgkmcnt(0)" ::: "memory"); __builtin_amdgcn_s_barrier(); asm volatile("" ::: "memory");
#pragma unroll
            for (int ai = 0; ai < 2; ++ai)
#pragma unroll
                for (int m = 0; m < 4; ++m) { const int rl = ai * HALF + wr * 64 + m * 16 + fr, tok = u.pm * BM + rl; const f32x4 p = *(const LAS f32x4*)(X + rl * 4);
                    const float rstd = rsqrtf(((p.x + p.y) + (p.z + p.w)) * (1.f / KVL) + EPS);
#pragma unroll
                    for (int bj = 0; bj < 2; ++bj)
#pragma unroll
                        for (int n = 0; n < 2; ++n) { const int col = bj * HALF + wc * 32 + n * 16 + 4 * fq; const f32x4 o = acc[ai][bj][m][n] * rstd * *(const f32x4*)(gckv + col);
                            int w8 = __builtin_amdgcn_cvt_pk_fp8_f32(o.x, o.y, 0, false); w8 = __builtin_amdgcn_cvt_pk_fp8_f32(o.z, o.w, w8, true);
                            *(int*)((unsigned char*)ckv + (size_t)tok * KVL + col) = w8; }
                    asm volatile("" ::: "memory"); }
            asm volatile("s_waitcnt lgkmcnt(0)" ::: "memory"); __builtin_amdgcn_s_barrier(); asm volatile("" ::: "memory");
        } else if (pn <= 2) {
#pragma unroll
            for (int ai = 0; ai < 2; ++ai)
#pragma unroll
                for (int m = 0; m < 4; ++m) { const int tok = u.pm * BM + ai * HALF + wr * 64 + m * 16 + fr; float sq = 0.f;
#pragma unroll
                    for (int bj = 0; bj < 2; ++bj) { if (pn == 2 && bj == 1) break;
#pragma unroll
                        for (int n = 0; n < 2; ++n) { const f32x4 v = acc[ai][bj][m][n]; sq += (v.x * v.x + v.y * v.y) + (v.z * v.z + v.w * v.w);
                            const int col = (pn - 1) * 256 + bj * HALF + wc * 32 + n * 16 + 4 * fq; u32x2 w; w.x = pk_h2(v.x, v.y); w.y = pk_h2(v.z, v.w); *(u32x2*)(cq + (size_t)tok * QL + col) = w; } }
                    sq += __shfl_xor(sq, 16); sq += __shfl_xor(sq, 32);
                    if (fq == 0) ssq[tok * 8 + (pn - 1) * 4 + wc] = sq;
                    if (pn == 2) {
                        if (wc < 2) { const int i = 4 * fq; const f32x4* tp = (const f32x4*)(tab + (size_t)tok * 48 + 32 + i); const f32x4 t0 = tp[0], t1 = tp[1];
                            const f32x4 cs = {t0.x, t0.z, t1.x, t1.z}, sn = {t0.y, t0.w, t1.y, t1.w}, x1 = acc[ai][1][m][0], x2 = acc[ai][1][m][1];
                            const f32x4 o1 = x1 * cs - x2 * sn, o2 = x2 * cs + x1 * sn;
                            if (wc == 0) { unsigned char* p8 = (unsigned char*)kr + (size_t)tok * 32 + i;
                                int a8 = __builtin_amdgcn_cvt_pk_fp8_f32(o1.x, o1.y, 0, false); a8 = __builtin_amdgcn_cvt_pk_fp8_f32(o1.z, o1.w, a8, true);
                                int b8 = __builtin_amdgcn_cvt_pk_fp8_f32(o2.x, o2.y, 0, false); b8 = __builtin_amdgcn_cvt_pk_fp8_f32(o2.z, o2.w, b8, true);
                                *(int*)p8 = a8; *(int*)(p8 + 16) = b8; }
                            else { h16* p = ki + (size_t)tok * 32 + i;
                                u32x2 w1, w2; w1.x = pk_h2(o1.x, o1.y); w1.y = pk_h2(o1.z, o1.w); w2.x = pk_h2(o2.x, o2.y); w2.y = pk_h2(o2.z, o2.w);
                                *(u32x2*)p = w1; *(u32x2*)(p + 16) = w2; } }
                        else if (wc == 2 && fq < 2) { *(f32x4*)(wi + tok * 8 + 4 * fq) = acc[ai][1][m][0] * 0.35355339059327373f; }
                    }
                    asm volatile("" ::: "memory"); }
        } else if (pn <= 5) rope64(acc, u, wr, wc, fr, fq, qb, pn - 3, 0.125f * LOG2E);
        else if (pn <= 8) rope64(acc, u, wr, wc, fr, fq, kb, pn - 6, 1.0f);
        else {
#pragma unroll
            for (int ai = 0; ai < 2; ++ai)
#pragma unroll
                for (int m = 0; m < 4; ++m) { const int tok = u.pm * BM + ai * HALF + wr * 64 + m * 16 + fr;
#pragma unroll
                    for (int bj = 0; bj < 2; ++bj)
#pragma unroll
                        for (int n = 0; n < 2; ++n) { const f32x4 v = acc[ai][bj][m][n]; u32x2 w; w.x = pk_h2(v.x, v.y); w.y = pk_h2(v.z, v.w);
                            *(u32x2*)(vT + (size_t)tok * 768 + (pn - 9) * 256 + bj * HALF + wc * 32 + n * 16 + 4 * fq) = w; }
                    asm volatile("" ::: "memory"); }
        }
    }
};
struct Epi4 {
    static constexpr bool PERM = true;
    h16 *qlat, *qr, *qi; const float* rstdq; const float2* tab;
    __device__ __forceinline__ void operator()(const f32x4 (&acc)[2][2][4][2], const Unit& u, int wr, int wc, int fr, int fq) const {
        const int pn = u.pn; const float c2 = 0.10206207261596575f * LOG2E;
        const int tok0 = u.pm * BM + wr * 64 + fr;
        float rc = rstdq[tok0], rn = 0.f;
        if (pn < 8) {
#pragma unroll
            for (int rr = 0; rr < 8; ++rr) { const int ai = rr >> 2, m = rr & 3, tok = tok0 + ai * HALF + m * 16;
                if (rr < 7) rn = rstdq[tok0 + ((rr + 1) >> 2) * HALF + ((rr + 1) & 3) * 16];
#pragma unroll
                for (int bj = 0; bj < 2; ++bj) { const f32x4 o0 = acc[ai][bj][m][0] * (rc * c2), o1 = acc[ai][bj][m][1] * (rc * c2);
                    u32x4 w; w.x = pk_h2(o0.x, o0.y); w.y = pk_h2(o0.z, o0.w); w.z = pk_h2(o1.x, o1.y); w.w = pk_h2(o1.z, o1.w);
                    *(u32x4*)(qlat + (size_t)tok * 2048 + pn * 256 + bj * HALF + wc * 32 + 8 * fq) = w; }
                rc = rn; asm volatile("" ::: "memory"); }
        } else { h16* dst = (pn == 8) ? qr : qi; const float c2e = (pn == 8) ? c2 : 1.f; const int i = 4 * fq;
            f32x4 tc[2], tn[2];
            { const f32x4* tp = (const f32x4*)(tab + (size_t)tok0 * 48 + 32 + i); tc[0] = tp[0]; tc[1] = tp[1]; }
#pragma unroll
            for (int rr = 0; rr < 8; ++rr) { const int ai = rr >> 2, m = rr & 3, tok = tok0 + ai * HALF + m * 16;
                if (rr < 7) { const int tokn = tok0 + ((rr + 1) >> 2) * HALF + ((rr + 1) & 3) * 16; const f32x4* tp = (const f32x4*)(tab + (size_t)tokn * 48 + 32 + i); tn[0] = tp[0]; tn[1] = tp[1]; rn = rstdq[tokn]; }
                const f32x4 cs = {tc[0].x, tc[0].z, tc[1].x, tc[1].z}, sn = {tc[0].y, tc[0].w, tc[1].y, tc[1].w}; const float sc = rc * c2e;
#pragma unroll
                for (int bj = 0; bj < 2; ++bj) { const f32x4 x1 = acc[ai][bj][m][0], x2 = acc[ai][bj][m][1]; const f32x4 o1 = (x1 * cs - x2 * sn) * sc, o2 = (x2 * cs + x1 * sn) * sc;
                    h16* p = dst + (size_t)tok * 256 + (4 * bj + wc) * 32 + i;
                    u32x2 w1, w2; w1.x = pk_h2(o1.x, o1.y); w1.y = pk_h2(o1.z, o1.w); w2.x = pk_h2(o2.x, o2.y); w2.y = pk_h2(o2.z, o2.w);
                    *(u32x2*)p = w1; *(u32x2*)(p + 16) = w2; }
                tc[0] = tn[0]; tc[1] = tn[1]; rc = rn;
                asm volatile("" ::: "memory"); } }
    }
};
__device__ __forceinline__ u32x4 ld16_l2(const h16* p) {
    const unsigned long long a = __hip_atomic_load((const unsigned long long*)p, __ATOMIC_RELAXED, __HIP_MEMORY_SCOPE_AGENT), b = __hip_atomic_load((const unsigned long long*)p + 1, __ATOMIC_RELAXED, __HIP_MEMORY_SCOPE_AGENT);
    return (u32x4){(unsigned)a, (unsigned)(a >> 32), (unsigned)b, (unsigned)(b >> 32)};
}
typedef _Float16 h16x8 __attribute__((ext_vector_type(8)));
__device__ __forceinline__ void unpk8(const u32x4 w, float (&f)[8]) {
    const h16x8 h = __builtin_bit_cast(h16x8, w);
#pragma unroll
    for (int i = 0; i < 8; ++i) f[i] = (float)h[i];
}
template <bool SC>
struct EpiH16_T {
    static constexpr bool PERM = true;
    h16* O; int ldc = DM;
    __device__ __forceinline__ void operator()(const f32x4 (&acc)[2][2][4][2], const Unit& u, int wr, int wc, int fr, int fq) const {
        const int row0 = u.pm * BM + wr * 64 + fr, col0 = u.pn * BM + wc * 32 + 8 * fq;
#pragma unroll
        for (int ai = 0; ai < 2; ++ai)
#pragma unroll
            for (int m = 0; m < 4; ++m)
#pragma unroll
                for (int bj = 0; bj < 2; ++bj) { f32x4 v0 = acc[ai][bj][m][0], v1 = acc[ai][bj][m][1]; if constexpr (SC) { v0 *= F8_INV; v1 *= F8_INV; }
                    u32x4 w; w.x = pk_h2(v0.x, v0.y); w.y = pk_h2(v0.z, v0.w); w.z = pk_h2(v1.x, v1.y); w.w = pk_h2(v1.z, v1.w);
                    *(u32x4*)(O + (size_t)(row0 + ai * HALF + m * 16) * ldc + col0 + bj * HALF) = w; }
    }
};
typedef EpiH16_T<false> EpiH16;
struct EpiGate {
    static constexpr bool PERM = true;
    const h16* Y; h16* Z; int accum; float nls;
    __device__ __forceinline__ void operator()(const f32x4 (&acc)[2][2][4][2], const Unit& u, int wr, int wc, int fr, int fq) const {
        const int row0 = u.pm * BM + wr * 64 + fr, col0 = u.pn * BM + wc * 32 + 8 * fq;
#pragma unroll
        for (int ai = 0; ai < 2; ++ai)
#pragma unroll
            for (int m = 0; m < 4; ++m)
#pragma unroll
                for (int bj = 0; bj < 2; ++bj) { const size_t off = (size_t)(row0 + ai * HALF + m * 16) * DM + col0 + bj * HALF;
                    float y[8], zz[8]; unpk8(ld16_l2(Y + off), y);
                    if (accum) unpk8(ld16_l2(Z + off), zz); else {
#pragma unroll
                        for (int i = 0; i < 8; ++i) zz[i] = 0.f; }
                    float o[8];
#pragma unroll
                    for (int n = 0; n < 2; ++n)
#pragma unroll
                        for (int e = 0; e < 4; ++e) { const float gg = acc[ai][bj][m][n][e]; o[n * 4 + e] = zz[n * 4 + e] + y[n * 4 + e] * __builtin_amdgcn_rcpf(1.f + __builtin_amdgcn_exp2f(gg * nls)); }
                    u32x4 w; w.x = pk_h2(o[0], o[1]); w.y = pk_h2(o[2], o[3]); w.z = pk_h2(o[4], o[5]); w.w = pk_h2(o[6], o[7]);
                    *(u32x4*)(Z + off) = w; }
    }
};
}

#define XB_TMO      128
#define XB_XCNT(j)  (256  + 64 * (j))
#define XB_XSUB(j)  (1280 + 64 * (j))
#define XB_XGEN(j)  (2304 + 64 * (j))
#define XB_TOP      3328
#define XB_TOPGEN   3392
#define XCD_BAR_WORDS 3456
#define XB_SPIN_CAP (1u << 18)
__device__ __forceinline__ unsigned xb_ld(unsigned* p)              { return __hip_atomic_load(p, __ATOMIC_RELAXED, __HIP_MEMORY_SCOPE_AGENT); }
__device__ __forceinline__ unsigned xb_add(unsigned* p, unsigned v) { return __hip_atomic_fetch_add(p, v, __ATOMIC_RELAXED, __HIP_MEMORY_SCOPE_AGENT); }
__device__ __forceinline__ unsigned xb_xcc_id() { return (unsigned)__builtin_amdgcn_s_getreg((3 << 11) | 20) & 0xFu; }
#define XB_SPIN(cond, bar) do { unsigned _sp = 0; while (cond) { __builtin_amdgcn_s_sleep(1); \
    if ((++_sp & 255u) == 0u) { if (xb_ld(&(bar)[XB_TMO])) break; if (_sp > XB_SPIN_CAP) { atomicAdd(&(bar)[XB_TMO], 1u); break; } } } } while (0)
struct XcdBarrier { unsigned* bar; unsigned x; volatile LAS unsigned* st; int wave; };
__device__ __forceinline__ XcdBarrier xcd_barrier_post(unsigned* bar, volatile LAS unsigned* st, int wave) {
    XcdBarrier b; b.bar = bar; b.x = xb_xcc_id(); b.st = st; b.wave = wave;
    if (wave == 0 && flane() == 0) (void)xb_add(&bar[XB_XCNT(b.x)], 1u);
    return b;
}
__device__ __forceinline__ void xcd_barrier_complete(unsigned* bar, unsigned x, unsigned& nloc, unsigned& nx) {
    const unsigned G = gridDim.x * gridDim.y * gridDim.z;
    unsigned sum, cnt, mine, sp = 0u;
    for (;;) {
        sum = 0u; cnt = 0u; mine = 0u;
#pragma unroll
        for (unsigned j = 0; j < 16; ++j) { const unsigned c = xb_ld(&bar[XB_XCNT(j)]); sum += c; cnt += (c > 0u) ? 1u : 0u; mine = (j == x) ? c : mine; }
        if (sum == G) break;
        __builtin_amdgcn_s_sleep(1);
        if ((++sp & 255u) == 0u) { if (xb_ld(&bar[XB_TMO])) break; if (sp > XB_SPIN_CAP) { atomicAdd(&bar[XB_TMO], 1u); break; } }
    }
    nloc = mine > 0u ? mine : 1u; nx = cnt > 0u ? cnt : 1u;
}
__device__ __forceinline__ void xcd_barrier(const XcdBarrier& b) {
    asm volatile("s_waitcnt vmcnt(0)" ::: "memory");
    __syncthreads();
    if (b.wave == 0 && flane() == 0) {
        unsigned* bar = b.bar;
        __builtin_amdgcn_s_waitcnt(0);
        unsigned nloc = b.st[0], nx = b.st[1];
        if (nloc == 0u) { xcd_barrier_complete(bar, b.x, nloc, nx); b.st[0] = nloc; b.st[1] = nx; }
        const unsigned old = xb_add(&bar[XB_XSUB(b.x)], 1u);
        const unsigned gen = old / nloc;
        if (old + 1u == (gen + 1u) * nloc) {
            __builtin_amdgcn_fence(__ATOMIC_RELEASE, "agent");
            asm volatile("s_waitcnt vmcnt(0)" ::: "memory");
            const unsigned og = xb_add(&bar[XB_TOP], 1u);
            const unsigned tg = og / nx;
            if (og + 1u == (tg + 1u) * nx) xb_add(&bar[XB_TOPGEN], 1u);
            else XB_SPIN(xb_ld(&bar[XB_TOPGEN]) == tg, bar);
            __builtin_amdgcn_fence(__ATOMIC_ACQUIRE, "agent");
            xb_add(&bar[XB_XGEN(b.x)], 1u);
            asm volatile("s_waitcnt vmcnt(0)" ::: "memory");
        } else {
            XB_SPIN(xb_ld(&bar[XB_XGEN(b.x)]) == gen, bar);
            __builtin_amdgcn_fence(__ATOMIC_ACQUIRE, "agent");
            asm volatile("s_waitcnt vmcnt(0)" ::: "memory");
        }
    }
    __syncthreads();
}

constexpr int NWAVES = 8, NTHR = 512;
constexpr int RING_BYTES = 131072, LDSCTL_OFF = RING_BYTES, MISC_OFF = LDSCTL_OFF + 320, LDS_BYTES = 147456;
constexpr int XCH_OFF = RING_BYTES + 1024;
constexpr int CW_BAR = 4096;
constexpr size_t OW_GU1 = OFF_W, OW_D1 = OW_GU1 + 11 * MiB, OW_IN = OW_D1 + (size_t)DM * FF * 2, OW_GATE = OW_IN + 6 * MiB, OW_4 = OW_GATE + 4 * MiB, OW_OV = OW_4 + 2 * MiB,
                 OW_UPB = OW_OV + 4 * MiB, OW_O = OW_UPB + MiB / 2, OW_GU2 = OW_O + 2 * MiB, OW_D2 = OW_GU2 + 11 * MiB, OW_END = OW_D2 + (size_t)DM * FF * 2;
static_assert(OW_END <= OFF_H, "weights region");
constexpr int NIN3 = 3072, N4 = 2560;
constexpr size_t OW_BD = OW_OV, OW_UPA = OW_OV + MiB, OFF_OA = OFF_A + 64 * MiB;

struct Args { const float* in[27]; float* out; unsigned char* ws; int ph_lo, ph_hi; };
struct Frame {
    LAS unsigned char* lds; int tid, lane, wave, G, gw, NGW;
};
__device__ __forceinline__ float wave_sum(float v) {
#pragma unroll
    for (int o = 1; o < 64; o <<= 1) v += __shfl_xor(v, o);
    return v;
}
__device__ __forceinline__ bool map_row(int job, int n, const Args& a, const float*& W, int& ldw, int& col) {
    if (job <= 1) { const int t = n >> 8, j = n & 255; W = a.in[(job == 0 ? 6 : 23) + (j >> 7)]; ldw = FF; col = t * 128 + (j & 127); return true; }
    if (job == 2) { W = a.in[11]; ldw = DIN; const int t = n >> 8, j = n & 255;
        if (t == 0) { col = C_CKV + j; return true; }
        if (t == 1) { col = j; return true; }
        if (t == 2) { if (j < 128) { col = 256 + j; return true; } if (j < 160) { col = C_KR + (j - 128); return true; } if (j < 192) { col = C_KI + (j - 160); return true; } if (j < 200) { col = C_WI + (j - 192); return true; } col = 0; return false; }
        if (t < 9) { const int c3 = (t - 3) / 3, tl = (t - 3) % 3, hl = (j & 127) >> 5, i = j & 31; col = C_QKV + c3 * 768 + (4 * tl + hl) * 64 + (j >> 7) * 32 + i; return true; }
        col = C_QKV + 1536 + (t - 9) * 256 + j; return true; }
    { const int n2 = n - 2048, r5 = n2 & 31, nat = 16 * ((r5 >> 2) & 1) + 4 * (r5 >> 3) + (r5 & 3);
      if (n2 < 256) { W = a.in[14]; ldw = 768; col = (n2 >> 5) * 96 + 64 + nat; } else { W = a.in[17]; ldw = 256; col = ((n2 - 256) & ~31) + nat; } return true; }
}
template <typename T>
__device__ __forceinline__ void tr_item(const float* W, int ldw, int col, bool valid, const float* scale, int k0, T* WTrow0, int K, LAS float* scr, int lane) {
    const int colc = valid ? col : 0; float vv[32];
#pragma unroll
    for (int i = 0; i < 32; ++i) vv[i] = W[(size_t)(k0 + 2 * i + (lane >> 5)) * ldw + colc];
    if (scale) {
#pragma unroll
        for (int i = 0; i < 32; ++i) vv[i] *= scale[k0 + 2 * i + (lane >> 5)]; }
#pragma unroll
    for (int i = 0; i < 32; ++i) scr[(2 * i + (lane >> 5)) * 33 + (lane & 31)] = valid ? vv[i] : 0.f;
    asm volatile("s_waitcnt lgkmcnt(0)" ::: "memory");
    const int c = lane & 7;
#pragma unroll
    for (int j = 0; j < 4; ++j) { const int n = (lane >> 3) + 8 * j; const LAS float* s = scr + (8 * c) * 33 + n;
        if constexpr (sizeof(T) == 1) { u32x2 o; o.x = pk_f8x4(s[0 * 33] * F8_WGT, s[1 * 33] * F8_WGT, s[2 * 33] * F8_WGT, s[3 * 33] * F8_WGT); o.y = pk_f8x4(s[4 * 33] * F8_WGT, s[5 * 33] * F8_WGT, s[6 * 33] * F8_WGT, s[7 * 33] * F8_WGT);
            *(u32x2*)(WTrow0 + (size_t)n * K + k0 + 8 * c) = o; }
        else { u32x4 o; o.x = pk_h2(s[0 * 33], s[1 * 33]); o.y = pk_h2(s[2 * 33], s[3 * 33]); o.z = pk_h2(s[4 * 33], s[5 * 33]); o.w = pk_h2(s[6 * 33], s[7 * 33]);
            *(u32x4*)(WTrow0 + (size_t)n * K + k0 + 8 * c) = o; } }
    asm volatile("s_waitcnt lgkmcnt(0)" ::: "memory");
}
template <typename T>
__device__ __forceinline__ void tr_job_mapped(const Frame& F, const Args& a, int job, int Ndest, int n_lo, int K, T* WT, const float* scale, LAS float* scr, int phase_off) {
    const int nblk = Ndest / 32, nitems = (K / 64) * nblk;
    for (int it = (F.gw + phase_off) % F.NGW; it < nitems; it += F.NGW) {
        const int kb = it / nblk, nb = it % nblk; const float* W; int ldw, col;
        const bool valid = map_row(job, n_lo + nb * 32 + (F.lane & 31), a, W, ldw, col);
        tr_item(W, ldw, col, valid, scale, kb * 64, WT + (size_t)(n_lo + nb * 32) * K, K, scr, F.lane);
    }
}
template <typename T>
__device__ __forceinline__ void tr_job_plain(const Frame& F, const float* W, int ldw, int Ndest, int K, T* WT, LAS float* scr, int phase_off) {
    const int nblk = Ndest / 32, nitems = (K / 64) * nblk;
    for (int it = (F.gw + phase_off) % F.NGW; it < nitems; it += F.NGW) {
        const int kb = it / nblk, nb = it % nblk;
        tr_item(W, ldw, nb * 32 + (F.lane & 31), true, nullptr, kb * 64, WT + (size_t)(nb * 32) * K, K, scr, F.lane);
    }
}
__device__ __forceinline__ void row_load(const float* p, int lane, f32x4 (&v)[4]) {
#pragma unroll
    for (int j = 0; j < 4; ++j) v[j] = __builtin_nontemporal_load((const f32x4*)p + lane + 64 * j);
}
__device__ __forceinline__ float row_ssq(const f32x4 (&v)[4]) { float s = 0.f;
#pragma unroll
    for (int j = 0; j < 4; ++j) s += (v[j].x * v[j].x + v[j].y * v[j].y) + (v[j].z * v[j].z + v[j].w * v[j].w);
    return wave_sum(s); }
template <typename T>
__device__ __forceinline__ void row_normmod_store(const f32x4 (&v)[4], float rstd, const float* g, const float* sc, const float* sh, T* dst, int lane, unsigned char* dst8 = nullptr) {
#pragma unroll
    for (int j = 0; j < 4; ++j) { const int ci = lane + 64 * j; const f32x4 gg = ((const f32x4*)g)[ci], s1 = ((const f32x4*)sc)[ci], s0 = ((const f32x4*)sh)[ci];
        const f32x4 o = v[j] * rstd * gg * (s1 + 1.f) + s0;
        if constexpr (sizeof(T) == 1) ((unsigned*)dst)[ci] = pk_f8x4(o.x * F8_ACT, o.y * F8_ACT, o.z * F8_ACT, o.w * F8_ACT);
        else { u32x2 w; w.x = pk_h2(o.x, o.y); w.y = pk_h2(o.z, o.w); ((u32x2*)dst)[ci] = w; if (dst8) ((unsigned*)dst8)[ci] = pk_f8x4(o.x * F8_ACT, o.y * F8_ACT, o.z * F8_ACT, o.w * F8_ACT); } }
}
template <typename T>
__device__ __forceinline__ void store_nm(const f32x4 (&xv)[4], float r2, const f32x4 (&gb)[4], const f32x4 (&gc)[4], T* dst, int lane, unsigned char* dst8) {
#pragma unroll
    for (int j = 0; j < 4; ++j) { const int ci = lane + 64 * j; const f32x4 o = xv[j] * r2 * gb[j] + gc[j];
        if constexpr (sizeof(T) == 1) __builtin_nontemporal_store(pk_f8x4(o.x * F8_ACT, o.y * F8_ACT, o.z * F8_ACT, o.w * F8_ACT), (unsigned*)dst + ci);
        else { u32x2 w; w.x = pk_h2(o.x, o.y); w.y = pk_h2(o.z, o.w); __builtin_nontemporal_store(w, (u32x2*)dst + ci); if (dst8) __builtin_nontemporal_store(pk_f8x4(o.x * F8_ACT, o.y * F8_ACT, o.z * F8_ACT, o.w * F8_ACT), (unsigned*)dst8 + ci); } }
}
template <typename T>
__device__ __forceinline__ void ph_normmod(const Frame& F, const float* x, const float* g, const float* mod, int isc, int ish, T* dst) {
    const int lane = flane();
    const int b = F.gw & 3, nsl = F.NGW >> 2; int r0 = F.gw >> 2; if (r0 >= SEQ) return;
    const float* mb = mod + b * (NMOD * DM); f32x4 gb[4], gc[4];
#pragma unroll
    for (int j = 0; j < 4; ++j) { const int ci = lane + 64 * j; gb[j] = ((const f32x4*)g)[ci] * (((const f32x4*)(mb + isc * DM))[ci] + 1.f); gc[j] = ((const f32x4*)(mb + ish * DM))[ci]; }
    const float* xb = x + (size_t)b * SEQ * DM; T* db = dst + (size_t)b * SEQ * DM;
    f32x4 v[2][4], vn[2][4];
#pragma unroll
    for (int k = 0; k < 2; ++k) { const int r = r0 + k * nsl; row_load(xb + (size_t)(r < SEQ ? r : r0) * DM, lane, v[k]); }
    for (;;) { const int rn = r0 + 2 * nsl; const bool has = rn < SEQ;
        if (has) {
#pragma unroll
            for (int k = 0; k < 2; ++k) { const int r = rn + k * nsl; row_load(xb + (size_t)(r < SEQ ? r : rn) * DM, lane, vn[k]); } }
#pragma unroll
        for (int k = 0; k < 2; ++k) { const int r = r0 + k * nsl; const float rstd = rsqrtf(row_ssq(v[k]) * (1.f / DM) + EPS);
            if (r < SEQ) store_nm(v[k], rstd, gb, gc, db + (size_t)r * DM, lane, nullptr); }
        if (!has) break;
#pragma unroll
        for (int k = 0; k < 2; ++k)
#pragma unroll
            for (int j = 0; j < 4; ++j) v[k][j] = vn[k][j];
        r0 = rn; }
}
__device__ __forceinline__ void row_load_h(const h16* p, int lane, u32x2 (&v)[4]) {
#pragma unroll
    for (int j = 0; j < 4; ++j) v[j] = __builtin_nontemporal_load((const u32x2*)p + lane + 64 * j);
}
typedef _Float16 h16x4 __attribute__((ext_vector_type(4)));
__device__ __forceinline__ f32x4 h4_to_f4(u32x2 w) { const h16x4 h = __builtin_bit_cast(h16x4, w); return (f32x4){(float)h[0], (float)h[1], (float)h[2], (float)h[3]}; }
template <bool XI16, bool XO16, typename T = h16>
__device__ __forceinline__ void ph_resnorm(const Frame& F, const void* xin_, const h16* f, const float* gpost, const float* mod, int igt, float coef, void* xout_,
                                           bool second, const float* gpre, int isc, int ish, T* dst, unsigned char* dst8 = nullptr) {
    const int lane = flane();
    const int b = F.gw & 3, nsl = F.NGW >> 2; int r0 = F.gw >> 2; if (r0 >= SEQ) return;
    const float* mb = mod + b * (NMOD * DM); f32x4 ga[4], gb[4], gc[4];
#pragma unroll
    for (int j = 0; j < 4; ++j) { const int ci = lane + 64 * j; ga[j] = ((const f32x4*)gpost)[ci] * ((const f32x4*)(mb + igt * DM))[ci] * coef;
        if (second) { gb[j] = ((const f32x4*)gpre)[ci] * (((const f32x4*)(mb + isc * DM))[ci] + 1.f); gc[j] = ((const f32x4*)(mb + ish * DM))[ci]; } else { gb[j] = (f32x4){0.f, 0.f, 0.f, 0.f}; gc[j] = gb[j]; } }
    const size_t bo = (size_t)b * SEQ * DM; const h16* fb = f + bo;
    u32x2 fh[2][4], fn[2][4]; f32x4 xi[2][4], xn[2][4]; u32x2 xh[2][4], xhn[2][4];
#pragma unroll
    for (int k = 0; k < 2; ++k) { const int r = r0 + k * nsl; const size_t ro = (size_t)(r < SEQ ? r : r0) * DM; row_load_h(fb + ro, lane, fh[k]);
        if constexpr (XI16) row_load_h((const h16*)xin_ + bo + ro, lane, xh[k]); else row_load((const float*)xin_ + bo + ro, lane, xi[k]); }
    for (;;) {
        const int rn = r0 + 2 * nsl; const bool has = rn < SEQ;
        if (has) {
#pragma unroll
            for (int k = 0; k < 2; ++k) { const int r = rn + k * nsl; const size_t ro = (size_t)(r < SEQ ? r : rn) * DM; row_load_h(fb + ro, lane, fn[k]);
                if constexpr (XI16) row_load_h((const h16*)xin_ + bo + ro, lane, xhn[k]); else row_load((const float*)xin_ + bo + ro, lane, xn[k]); } }
#pragma unroll
        for (int k = 0; k < 2; ++k) { const int r = r0 + k * nsl; const bool ok = r < SEQ; const size_t ro = bo + (size_t)r * DM;
            f32x4 v[4];
#pragma unroll
            for (int j = 0; j < 4; ++j) { v[j] = h4_to_f4(fh[k][j]); if constexpr (XI16) xi[k][j] = h4_to_f4(xh[k][j]); }
            const float rstd = rsqrtf(row_ssq(v) * (1.f / DM) + EPS);
#pragma unroll
            for (int j = 0; j < 4; ++j) { const int ci = lane + 64 * j;
                xi[k][j] = xi[k][j] + ga[j] * v[j] * rstd;
                if (ok) { if constexpr (XO16) { u32x2 w; w.x = pk_h2(xi[k][j].x, xi[k][j].y); w.y = pk_h2(xi[k][j].z, xi[k][j].w); __builtin_nontemporal_store(w, (u32x2*)((h16*)xout_ + ro) + ci); }
                          else __builtin_nontemporal_store(xi[k][j], (f32x4*)((float*)xout_ + ro) + ci); } }
            if (second) { const float r2 = rsqrtf(row_ssq(xi[k]) * (1.f / DM) + EPS); if (ok) store_nm(xi[k], r2, gb, gc, dst + ro, lane, dst8 ? dst8 + ro : nullptr); } }
        if (!has) break;
#pragma unroll
        for (int k = 0; k < 2; ++k)
#pragma unroll
            for (int j = 0; j < 4; ++j) { fh[k][j] = fn[k][j]; if constexpr (XI16) xh[k][j] = xhn[k][j]; else xi[k][j] = xn[k][j]; }
        r0 = rn;
    }
}

__device__ __forceinline__ void ph_combine(const Frame& F, const h16* og, const float* lse2, h16* ob) {
    for (int idx = blockIdx.x * NTHR + F.tid; idx < MT * 32; idx += F.G * NTHR) {
        const int tok = idx >> 5, c = (idx & 31) * 8, hh = c >> 6;
        const float l0 = lse2[tok * 12 + hh], l1 = lse2[tok * 12 + 4 + hh], l2 = lse2[tok * 12 + 8 + hh], m = fmaxf(l0, fmaxf(l1, l2));
        const float w0 = exp2f(l0 - m), w1 = exp2f(l1 - m), w2 = exp2f(l2 - m), inv = 1.f / (w0 + w1 + w2);
        const u32x4 a = *(const u32x4*)(og + (size_t)tok * 768 + c), b = *(const u32x4*)(og + (size_t)tok * 768 + 256 + c), d = *(const u32x4*)(og + (size_t)tok * 768 + 512 + c);
        const f16x8 ha = __builtin_bit_cast(f16x8, a), hb = __builtin_bit_cast(f16x8, b), hd = __builtin_bit_cast(f16x8, d);
        float o[8];
#pragma unroll
        for (int i = 0; i < 8; ++i) o[i] = (w0 * (float)ha[i] + w1 * (float)hb[i] + w2 * (float)hd[i]) * inv;
        u32x4 w; w.x = pk_h2(o[0], o[1]); w.y = pk_h2(o[2], o[3]); w.z = pk_h2(o[4], o[5]); w.w = pk_h2(o[6], o[7]);
        *(u32x4*)(ob + (size_t)tok * 256 + c) = w; }
}
typedef short v4i16_t __attribute__((ext_vector_type(4)));
typedef short s16x8 __attribute__((ext_vector_type(8)));
typedef float f32x16 __attribute__((ext_vector_type(16)));
__device__ __forceinline__ int tk_bin(float sc) { const unsigned u = __float_as_uint(sc); int e = (int)((u >> 16) & 0x7FFFu) - (122 << 7); e = e < 0 ? 0 : (e > 1023 ? 1023 : e); return (u >> 31) ? 1023 - e : 1024 + e; }
__device__ __forceinline__ void tk_scores(const f16x8 (&Af)[2], const float (&wv)[16], f16x8 b0, f16x8 b1, float& sa, float& sb) {
    f32x16 d = {0.f, 0.f, 0.f, 0.f, 0.f, 0.f, 0.f, 0.f, 0.f, 0.f, 0.f, 0.f, 0.f, 0.f, 0.f, 0.f};
    d = __builtin_amdgcn_mfma_f32_32x32x16_f16(Af[0], b0, d, 0, 0, 0); d = __builtin_amdgcn_mfma_f32_32x32x16_f16(Af[1], b1, d, 0, 0, 0);
    f32x2 acc = {0.f, 0.f};
#pragma unroll
    for (int e = 0; e < 16; e += 2) { const int i0 = __float_as_int(d[e]), i1 = __float_as_int(d[e + 1]);
        const f32x2 rl = {__int_as_float(i0 > 0 ? i0 : 0), __int_as_float(i1 > 0 ? i1 : 0)}; const f32x2 w2 = {wv[e], wv[e + 1]};
        acc = __builtin_elementwise_fma(w2, rl, acc); }
    sa = acc.x; sb = acc.y;
}
template <bool P2>
__device__ __forceinline__ void tk_tile(const f16x8 (&Af)[2], const float (&wv)[16], f16x8 b0, f16x8 b1, int tile, int r, int hi, int ta, LAS unsigned* hist, const int (&tbin)[4], int (&cs)[4], int (&cc)[4],
                                        unsigned short* sel, int tok0) {
    float sa, sb; tk_scores(Af, wv, b0, b1, sa, sb);
    const int s = 32 * tile + r;
    if constexpr (!P2) {
        if (s <= ta) { const int bn = tk_bin(sa); __hip_atomic_fetch_add(hist + (2 * hi) * 1024 + (bn >> 1), 1u << (16 * (bn & 1)), __ATOMIC_RELAXED, __HIP_MEMORY_SCOPE_WORKGROUP); }
        if (s <= ta + 1) { const int bn = tk_bin(sb); __hip_atomic_fetch_add(hist + (2 * hi + 1) * 1024 + (bn >> 1), 1u << (16 * (bn & 1)), __ATOMIC_RELAXED, __HIP_MEMORY_SCOPE_WORKGROUP); }
    } else {
        const unsigned lowmask = (1u << r) - 1u;
#pragma unroll
        for (int ab = 0; ab < 2; ++ab) { const float sc = ab ? sb : sa; const int tq = ta + ab; const int bn = tk_bin(sc);
            const int mytb = hi ? tbin[2 + ab] : tbin[ab];
            const bool valid = s <= tq, sure = valid && bn > mytb, cand = valid && bn == mytb;
            const unsigned long long ms = __ballot(sure), mc = __ballot(cand);
            const unsigned ms_h = hi ? (unsigned)(ms >> 32) : (unsigned)ms, mc_h = hi ? (unsigned)(mc >> 32) : (unsigned)mc;
            const int q = 2 * hi + ab;
            const int base_s = hi ? cs[2 + ab] : cs[ab], base_c = hi ? cc[2 + ab] : cc[ab];
            if (sure) sel[(size_t)(tok0 + q) * TOPK + base_s + __builtin_popcount(ms_h & lowmask)] = (unsigned short)s;
            if (cand) { const int pos = base_c + __builtin_popcount(mc_h & lowmask);
                if (pos < 512) ((LAS unsigned long long*)((LAS unsigned char*)hist + q * 4096))[pos] = ((unsigned long long)fkey(sc) << 16) | (unsigned long long)(0xFFFFu - (unsigned)s); }
            cs[ab] += __builtin_popcount((unsigned)ms); cs[2 + ab] += __builtin_popcount((unsigned)(ms >> 32));
            cc[ab] += __builtin_popcount((unsigned)mc); cc[2 + ab] += __builtin_popcount((unsigned)(mc >> 32)); }
    }
}
template <bool P2>
__device__ __forceinline__ void tk_pass(const f16x8 (&Af)[2], const float (&wv)[16], const h16* kbase, int ntiles, int r, int hi, int ta, LAS unsigned* hist, const int (&tbin)[4], int (&cs)[4], int (&cc)[4],
                                        unsigned short* sel, int tok0) {
    f16x8 BA[4][2], BB[4][2];
#define TK_LOAD(dst, t0_) do { _Pragma("unroll") for (int i_ = 0; i_ < 4; ++i_) { const int tt_ = ((t0_) + i_) < 127 ? ((t0_) + i_) : 127; dst[i_][0] = *(const f16x8*)(kbase + (size_t)tt_ * 1024); dst[i_][1] = *(const f16x8*)(kbase + (size_t)tt_ * 1024 + 16); } } while (0)
    TK_LOAD(BA, 0);
    for (int t0 = 0; t0 < ntiles; t0 += 8) {
        TK_LOAD(BB, t0 + 4);
#pragma unroll
        for (int i = 0; i < 4; ++i) if (t0 + i < ntiles) tk_tile<P2>(Af, wv, BA[i][0], BA[i][1], t0 + i, r, hi, ta, hist, tbin, cs, cc, sel, tok0);
        TK_LOAD(BA, t0 + 8);
#pragma unroll
        for (int i = 0; i < 4; ++i) if (t0 + 4 + i < ntiles) tk_tile<P2>(Af, wv, BB[i][0], BB[i][1], t0 + 4 + i, r, hi, ta, hist, tbin, cs, cc, sel, tok0);
    }
#undef TK_LOAD
}
__device__ __forceinline__ void tk_group(const Frame& F, const h16* qi, const h16* ki, const float* wi, unsigned short* sel, int b, int t0, LAS unsigned* hist) {
    int lane_ = F.lane; asm volatile("" : "+v"(lane_)); const int lane = lane_, r = lane & 31, hi = lane >> 5, tok0 = b * SEQ + t0;
    const int qa = 2 * ((r >> 2) & 1) + (r & 1), ha = 4 * (r >> 4) + 2 * ((r >> 3) & 1) + ((r >> 1) & 1);
    f16x8 Af[2];
#pragma unroll
    for (int s_ = 0; s_ < 2; ++s_) Af[s_] = *(const f16x8*)(qi + (size_t)(tok0 + qa) * 256 + ha * 32 + 16 * s_ + 8 * hi);
    float wv[16];
    { const f32x4 a0 = *(const f32x4*)(wi + (tok0 + 2 * hi) * 8), a1 = *(const f32x4*)(wi + (tok0 + 2 * hi) * 8 + 4), b0 = *(const f32x4*)(wi + (tok0 + 2 * hi + 1) * 8), b1 = *(const f32x4*)(wi + (tok0 + 2 * hi + 1) * 8 + 4);
      const float sa[8] = {a0.x, a0.y, a0.z, a0.w, a1.x, a1.y, a1.z, a1.w}, sb[8] = {b0.x, b0.y, b0.z, b0.w, b1.x, b1.y, b1.z, b1.w};
#pragma unroll
      for (int h = 0; h < 8; ++h) { wv[2 * h] = sa[h] * 0.17677669529663687f; wv[2 * h + 1] = sb[h] * 0.17677669529663687f; } }
    const int ntiles = (t0 + 3) / 32 + 1, ta = t0 + 2 * hi;
    const h16* kbase = ki + (size_t)(b * SEQ + r) * 32 + 8 * hi;
    int tbin[4] = {0, 0, 0, 0}, nsure[4], cs[4] = {0, 0, 0, 0}, cc[4] = {0, 0, 0, 0};
#pragma unroll
    for (int i = 0; i < 16; ++i) *(LAS u32x4*)((LAS unsigned char*)hist + i * 1024 + lane * 16) = (u32x4){0u, 0u, 0u, 0u};
    asm volatile("s_waitcnt lgkmcnt(0)" ::: "memory");
    tk_pass<false>(Af, wv, kbase, ntiles, r, hi, ta, hist, tbin, cs, cc, sel, tok0);
    asm volatile("s_waitcnt lgkmcnt(0)" ::: "memory");
#pragma unroll
    for (int q = 0; q < 4; ++q) {
        const LAS unsigned* hq = hist + q * 1024;
        unsigned sum = 0;
#pragma unroll
        for (int i = 0; i < 4; ++i) { const u32x4 v = *(const LAS u32x4*)(hq + 16 * lane + 4 * i); sum += (v.x & 0xFFFFu) + (v.x >> 16) + (v.y & 0xFFFFu) + (v.y >> 16) + (v.z & 0xFFFFu) + (v.z >> 16) + (v.w & 0xFFFFu) + (v.w >> 16); }
        unsigned incl = sum;
#pragma unroll
        for (int o = 1; o < 64; o <<= 1) { const unsigned v = __shfl_down(incl, o); if (lane + o < 64) incl += v; }
        const unsigned long long bal = __ballot(incl >= (unsigned)TOPK);
        const int L = 63 - __builtin_clzll(bal);
        unsigned cum = __shfl(incl, L) - __shfl(sum, L);
        int tbq = 32 * L, found = 0;
        for (int wd = 15; wd >= 0 && !found; --wd) { const unsigned v = hq[16 * L + wd];
            const unsigned chi = v >> 16, clo = v & 0xFFFFu;
            if (cum + chi >= (unsigned)TOPK) { tbq = 32 * L + 2 * wd + 1; found = 1; } else { cum += chi;
                if (cum + clo >= (unsigned)TOPK) { tbq = 32 * L + 2 * wd; found = 1; } else cum += clo; } }
        tbin[q] = tbq; nsure[q] = (int)cum;
    }
    asm volatile("s_waitcnt lgkmcnt(0)" ::: "memory");
    tk_pass<true>(Af, wv, kbase, ntiles, r, hi, ta, hist, tbin, cs, cc, sel, tok0);
    asm volatile("s_waitcnt lgkmcnt(0)" ::: "memory");
#pragma unroll
    for (int q = 0; q < 4; ++q) {
        const int nc = cc[q] < 512 ? cc[q] : 512, need = TOPK - cs[q];
        const LAS unsigned long long* cq = (const LAS unsigned long long*)((const LAS unsigned char*)hist + q * 4096);
        if (nc > 64) {
            unsigned long long it[8];
#pragma unroll
            for (int k = 0; k < 8; ++k) it[k] = (k * 64 + lane < nc) ? cq[k * 64 + lane] : 0ull;
            unsigned long long T = 0ull;
            for (int bit = 47; bit >= 0; --bit) { const unsigned long long cand = T | (1ull << bit); int cnt = 0;
#pragma unroll
                for (int k = 0; k < 8; ++k) cnt += __builtin_popcountll(__ballot(it[k] >= cand));
                if (cnt >= need) T = cand; }
            int basep = cs[q];
#pragma unroll
            for (int k = 0; k < 8; ++k) { const bool pick = (T != 0ull) && it[k] >= T; const unsigned long long mk = __ballot(pick);
                if (pick) sel[(size_t)(tok0 + q) * TOPK + basep + __builtin_popcountll(mk & ((1ull << lane) - 1ull))] = (unsigned short)(0xFFFFu - (unsigned)(it[k] & 0xFFFFull));
                basep += __builtin_popcountll(mk); }
        } else
        for (int base = 0; base < nc; base += 64) {
            const bool act = base + lane < nc; const unsigned long long my = act ? cq[base + lane] : 0ull; int rank = 0;
            for (int jb = 0; jb < nc; jb += 64) {
                const unsigned long long cj = (jb + lane < nc) ? cq[jb + lane] : 0ull; const unsigned clo = (unsigned)cj, chi = (unsigned)(cj >> 32);
                const int n = (nc - jb) < 64 ? (nc - jb) : 64;
                for (int j = 0; j < n; ++j) { const unsigned long long sj = ((unsigned long long)(unsigned)__builtin_amdgcn_readlane((int)chi, j) << 32) | (unsigned)__builtin_amdgcn_readlane((int)clo, j); rank += (sj > my) ? 1 : 0; } }
            if (act && rank < need) sel[(size_t)(tok0 + q) * TOPK + cs[q] + rank] = (unsigned short)(0xFFFFu - (unsigned)(my & 0xFFFFull)); }
    }
    (void)nsure;
    asm volatile("s_waitcnt lgkmcnt(0)" ::: "memory");
}
__device__ __forceinline__ void ph_topk_sparse(const Frame& F, const h16* qi, const h16* ki, const float* wi, unsigned short* sel, h16* qlat, const h16* qr, const unsigned char* ckv8, const unsigned char* kr8);
__device__ __forceinline__ void ph_topk_mfma(const Frame& F, const h16* qi, const h16* ki, const float* wi, unsigned short* sel) {
    LAS unsigned* hist = (LAS unsigned*)(F.lds + F.wave * 16384);
    for (int g = F.gw; g < 4 * 64; g += F.NGW) { const int b = g >> 6, t0 = (g & 63) * 4;
        for (int i = F.lane; i < 4 * TOPK; i += 64) { const int q = i >> 8, k = i & 255; sel[(size_t)(b * SEQ + t0 + q) * TOPK + k] = (unsigned short)(k <= t0 + q ? k : 0); } }
    for (int p = F.gw; p < 4 * 480; p += F.NGW) { const int b = p & 3, pj = p >> 2;
        tk_group(F, qi, ki, wi, sel, b, 4 * (64 + pj), hist);
        tk_group(F, qi, ki, wi, sel, b, 4 * (1023 - pj), hist);
    }
}


__device__ __forceinline__ void ph_dilated_mfma(const Frame& F, const h16* qb, const h16* kb, const h16* vb, h16* og, float* lse2) {
    const int lane = F.lane, ql = lane & 31, hi = lane >> 5;
    LAS unsigned char* VL = F.lds + F.wave * 16384;
    LAS float* linv = (LAS float*)(VL + 12288);
    constexpr int VROW = 192;
    const int trq = (lane & 15) >> 2, trp = lane & 3, trg = (lane >> 4) & 1;
    for (int u = F.gw; u < NB * 12 * 128; u += F.NGW) {
        const int b = u / 1536, rem = u % 1536, gh = rem >> 7, g = gh >> 2, wi_ = rem & 127, dil = dil_of(g), sh = g == 0 ? 0 : (g == 1 ? 2 : 4);
        const int nblk = 128 >> sh, res = wi_ / nblk, j0 = 32 * (wi_ % nblk);
        const size_t hoff = (size_t)b * SEQ * 768 + gh * 64;
        f16x8 Qf[4];
        { const h16* qp = qb + hoff + (size_t)((j0 + ql) * dil + res) * 768 + 8 * hi;
#pragma unroll
          for (int s_ = 0; s_ < 4; ++s_) Qf[s_] = *(const f16x8*)(qp + 16 * s_); }
        f32x16 S[5];
        f16x8 Kf[5][4];
#pragma unroll
        for (int kt = 0; kt < 5; ++kt) { int jk = j0 - 128 + 32 * kt + ql; jk = jk < 0 ? 0 : jk;
            const h16* kp = kb + hoff + (size_t)(jk * dil + res) * 768 + 8 * hi;
#pragma unroll
            for (int s_ = 0; s_ < 4; ++s_) Kf[kt][s_] = *(const f16x8*)(kp + 16 * s_); }
#pragma unroll
        for (int kt = 0; kt < 5; ++kt) {
            f32x16 d = {0.f, 0.f, 0.f, 0.f, 0.f, 0.f, 0.f, 0.f, 0.f, 0.f, 0.f, 0.f, 0.f, 0.f, 0.f, 0.f};
#pragma unroll
            for (int s_ = 0; s_ < 4; ++s_) d = __builtin_amdgcn_mfma_f32_32x32x16_f16(Kf[kt][s_], Qf[s_], d, 0, 0, 0);
            S[kt] = d; }
        f16x8 Vr[5][4];
#pragma unroll
        for (int kt = 0; kt < 5; ++kt) { int jk = j0 - 128 + 32 * kt + (lane >> 1); jk = jk < 0 ? 0 : jk;
            const h16* vp = vb + hoff + (size_t)(jk * dil + res) * 768 + (lane & 1) * 32;
#pragma unroll
            for (int i = 0; i < 4; ++i) Vr[kt][i] = *(const f16x8*)(vp + 8 * i); }
        float m = -INFINITY;
#pragma unroll
        for (int kt = 0; kt < 5; ++kt)
#pragma unroll
            for (int e = 0; e < 16; ++e) { const int kl = (e & 3) + 8 * (e >> 2) + 4 * hi; bool ok = (j0 - 128 + 32 * kt + kl) >= 0;
                if (kt == 0) ok = ok && (kl >= ql); if (kt == 4) ok = ok && (kl <= ql);
                if (!ok) S[kt][e] = -INFINITY; m = fmaxf(m, S[kt][e]); }
        m = fmaxf(m, __shfl_xor(m, 32));
        float l = 0.f;
#pragma unroll
        for (int kt = 0; kt < 5; ++kt)
#pragma unroll
            for (int e = 0; e < 16; ++e) { const float p = __builtin_amdgcn_exp2f(S[kt][e] - m); S[kt][e] = p; l += p; }
        l += __shfl_xor(l, 32);
        if (hi == 0) { linv[ql] = __builtin_amdgcn_rcpf(l); lse2[(size_t)(b * SEQ + (j0 + ql) * dil + res) * 12 + gh] = m + __builtin_amdgcn_logf(l); }
        f32x16 O[2];
#pragma unroll
        for (int dt = 0; dt < 2; ++dt) O[dt] = (f32x16){0.f, 0.f, 0.f, 0.f, 0.f, 0.f, 0.f, 0.f, 0.f, 0.f, 0.f, 0.f, 0.f, 0.f, 0.f, 0.f};
#pragma unroll
        for (int kt = 0; kt < 5; ++kt) {
            LAS unsigned char* vbuf = VL + (kt & 1) * 6144;
#pragma unroll
            for (int i = 0; i < 4; ++i) *(LAS f16x8*)(vbuf + (lane >> 1) * VROW + (lane & 1) * 64 + i * 16) = Vr[kt][i];
            asm volatile("s_waitcnt lgkmcnt(0)" ::: "memory");
#pragma unroll
            for (int s2 = 0; s2 < 2; ++s2) {
                u32x4 pa; pa.x = pk_h2(S[kt][8 * s2 + 0], S[kt][8 * s2 + 1]); pa.y = pk_h2(S[kt][8 * s2 + 2], S[kt][8 * s2 + 3]); pa.z = pk_h2(S[kt][8 * s2 + 4], S[kt][8 * s2 + 5]); pa.w = pk_h2(S[kt][8 * s2 + 6], S[kt][8 * s2 + 7]);
#pragma unroll
                for (int dt = 0; dt < 2; ++dt) {
                    const v4i16_t lo = __builtin_amdgcn_ds_read_tr16_b64_v4i16((LAS v4i16_t*)(vbuf + (16 * s2 + 4 * hi + trq) * VROW + (32 * dt + 16 * trg + 4 * trp) * 2));
                    const v4i16_t hh = __builtin_amdgcn_ds_read_tr16_b64_v4i16((LAS v4i16_t*)(vbuf + (16 * s2 + 8 + 4 * hi + trq) * VROW + (32 * dt + 16 * trg + 4 * trp) * 2));
                    const s16x8 bv = {lo[0], lo[1], lo[2], lo[3], hh[0], hh[1], hh[2], hh[3]};
                    O[dt] = __builtin_amdgcn_mfma_f32_32x32x16_f16(__builtin_bit_cast(f16x8, pa), __builtin_bit_cast(f16x8, bv), O[dt], 0, 0, 0); } }
            asm volatile("s_waitcnt lgkmcnt(0)" ::: "memory");
        }
#pragma unroll
        for (int e = 0; e < 16; ++e) { const int q = (e & 3) + 8 * (e >> 2) + 4 * hi; const float il = linv[q];
            h16* op = og + (size_t)(b * SEQ + (j0 + q) * dil + res) * 768 + gh * 64 + ql;
            op[0] = (h16)(O[0][e] * il); op[32] = (h16)(O[1][e] * il); }
        asm volatile("s_waitcnt lgkmcnt(0)" ::: "memory");
    }
}


__device__ __forceinline__ f16x8 fp8x8_to_f16(unsigned w0, unsigned w1) {
    const h16x2 a = __builtin_amdgcn_cvt_scalef32_pk_f16_fp8((int)w0, 1.0f, false), b = __builtin_amdgcn_cvt_scalef32_pk_f16_fp8((int)w0, 1.0f, true),
                c = __builtin_amdgcn_cvt_scalef32_pk_f16_fp8((int)w1, 1.0f, false), d = __builtin_amdgcn_cvt_scalef32_pk_f16_fp8((int)w1, 1.0f, true);
    const u32x4 r = {__builtin_bit_cast(unsigned, a), __builtin_bit_cast(unsigned, b), __builtin_bit_cast(unsigned, c), __builtin_bit_cast(unsigned, d)};
    return __builtin_bit_cast(f16x8, r);
}
template <bool FUSED>
__device__ __forceinline__ void ph_sparse_wave(const Frame& F, h16* qlat, const h16* qr, const unsigned char* ckv8, const unsigned char* kr8, const unsigned short* sel, int ta = 0, int tb = 0) {
    int lane = F.lane; asm volatile("" : "+v"(lane));
    LAS unsigned char* V = F.lds + F.wave * 16384;
    const int qp = (lane & 15) >> 2, pp = lane & 3;
    const int k0 = 4 * (lane >> 4) + qp;
    const int tr0 = k0 * 512 + (pp >> 1) * 16 + (pp & 1) * 8, x0 = k0 & 7;
    const int vw = (lane & 15) * 512, swz = lane & 7;
    const int lane0 = lane;
    const int nit = FUSED ? 8 : (MT - F.gw + F.NGW - 1) / F.NGW;
    for (int it = 0; it < nit; ++it) {
        const int tok = FUSED ? ((it < 4 ? ta : tb - 4) + it) : F.gw + it * F.NGW;
        int ll = lane0; asm volatile("" : "+v"(ll));
        const int c = ll & 15, kq = ll >> 4, hd = c & 7;
        const int b = tok / SEQ, t = tok % SEQ, cnt = (t + 1 < TOPK) ? t + 1 : TOPK, nch = (cnt + 31) >> 5;
        LAS unsigned short* sp = (LAS unsigned short*)(F.lds + XCH_OFF + F.wave * 512) + c;
        *(LAS u32x2*)(F.lds + XCH_OFF + F.wave * 512 + 8 * ll) = *(const u32x2*)(sel + (size_t)tok * TOPK + 4 * ll);
        asm volatile("s_waitcnt lgkmcnt(0)" ::: "memory");
        f16x8 Qf[9]; u32x4 Kr[2][4]; u32x2 Rr[2];
#pragma unroll
        for (int s_ = 0; s_ < 8; ++s_) Qf[s_] = *(const f16x8*)(qlat + (size_t)tok * 2048 + hd * 256 + 64 * (s_ >> 1) + 16 * kq + 8 * (s_ & 1));
        Qf[8] = *(const f16x8*)(qr + (size_t)tok * 256 + hd * 32 + 8 * kq);
        int rowi[2];
#define SW_LOADK() do { _Pragma("unroll") for (int tl = 0; tl < 2; ++tl) { _Pragma("unroll") for (int q4 = 0; q4 < 4; ++q4) Kr[tl][q4] = *(const u32x4*)(ckv8 + (size_t)rowi[tl] * 256 + 64 * q4 + 16 * kq); \
        Rr[tl] = *(const u32x2*)(kr8 + (size_t)rowi[tl] * 32 + 8 * kq); } } while (0)
        rowi[0] = b * SEQ + (int)sp[0]; rowi[1] = b * SEQ + (int)sp[16];
        SW_LOADK();
        float m = -INFINITY, l = 0.f;
        f32x4 O[16];
#pragma unroll
        for (int ft = 0; ft < 16; ++ft) O[ft] = (f32x4){0.f, 0.f, 0.f, 0.f};
        for (int ch = 0; ch < nch; ++ch) {
            const bool more = ch + 1 < nch;
            int rown0 = 0, rown1 = 0; if (more) { rown0 = (int)sp[32 * (ch + 1)]; rown1 = (int)sp[32 * (ch + 1) + 16]; }
            f16x8 Kf[2][9];
#pragma unroll
            for (int tl = 0; tl < 2; ++tl) {
#pragma unroll
                for (int q4 = 0; q4 < 4; ++q4) { Kf[tl][2 * q4] = fp8x8_to_f16(Kr[tl][q4].x, Kr[tl][q4].y); Kf[tl][2 * q4 + 1] = fp8x8_to_f16(Kr[tl][q4].z, Kr[tl][q4].w); }
                Kf[tl][8] = fp8x8_to_f16(Rr[tl].x, Rr[tl].y); }
            if (more) { rowi[0] = b * SEQ + rown0; rowi[1] = b * SEQ + rown1; SW_LOADK(); }
            f32x4 S[2];
#pragma unroll
            for (int tl = 0; tl < 2; ++tl) { S[tl] = (f32x4){0.f, 0.f, 0.f, 0.f};
#pragma unroll
                for (int s_ = 0; s_ < 9; ++s_) S[tl] = __builtin_amdgcn_mfma_f32_16x16x32_f16(Kf[tl][s_], Qf[s_], S[tl], 0, 0, 0); }
            float cm = -INFINITY;
#pragma unroll
            for (int tl = 0; tl < 2; ++tl)
#pragma unroll
                for (int e = 0; e < 4; ++e) { if (32 * ch + 16 * tl + 4 * kq + e >= cnt) S[tl][e] = -INFINITY; cm = fmaxf(cm, S[tl][e]); }
            cm = fmaxf(cm, __shfl_xor(cm, 16)); cm = fmaxf(cm, __shfl_xor(cm, 32));
            if (__any(cm > m + 8.0f)) { const float mn = fmaxf(m, cm), alpha = __builtin_amdgcn_exp2f(m - mn); m = mn; l *= alpha;
#pragma unroll
                for (int ft = 0; ft < 16; ++ft) O[ft] = O[ft] * alpha; }
            float pe[2][4]; float ps = 0.f;
#pragma unroll
            for (int tl = 0; tl < 2; ++tl)
#pragma unroll
                for (int e = 0; e < 4; ++e) { pe[tl][e] = __builtin_amdgcn_exp2f(S[tl][e] - m); ps += pe[tl][e]; }
            l += ps;
#pragma unroll
            for (int tl = 0; tl < 2; ++tl)
#pragma unroll
                for (int s_ = 0; s_ < 8; ++s_) *(LAS f16x8*)(V + vw + tl * 8192 + (((4 * (s_ >> 1) + kq) ^ swz) << 5) + (s_ & 1) * 16) = Kf[tl][s_];
            asm volatile("s_waitcnt lgkmcnt(0)" ::: "memory");
            u32x4 pk; pk.x = pk_h2(pe[0][0], pe[0][1]); pk.y = pk_h2(pe[0][2], pe[0][3]); pk.z = pk_h2(pe[1][0], pe[1][1]); pk.w = pk_h2(pe[1][2], pe[1][3]);
            const f16x8 Pf = __builtin_bit_cast(f16x8, pk);
#pragma unroll
            for (int ft = 0; ft < 16; ++ft) {
                const v4i16_t lo = __builtin_amdgcn_ds_read_tr16_b64_v4i16((LAS v4i16_t*)(V + tr0 + (((ft & 7) ^ x0) << 5) + (ft >> 3) * 256));
                const v4i16_t hi = __builtin_amdgcn_ds_read_tr16_b64_v4i16((LAS v4i16_t*)(V + tr0 + (((ft & 7) ^ x0) << 5) + (ft >> 3) * 256 + 8192));
                const s16x8 av = {lo[0], lo[1], lo[2], lo[3], hi[0], hi[1], hi[2], hi[3]};
                O[ft] = __builtin_amdgcn_mfma_f32_16x16x32_f16(__builtin_bit_cast(f16x8, av), Pf, O[ft], 0, 0, 0); }
            asm volatile("s_waitcnt lgkmcnt(0)" ::: "memory");
        }
        l += __shfl_xor(l, 16); l += __shfl_xor(l, 32);
        if (c < 8) { const float il = __builtin_amdgcn_rcpf(l);
#pragma unroll
            for (int ft = 0; ft < 16; ++ft) { const f32x4 o = O[ft] * il; u32x2 pk; pk.x = pk_h2(o.x, o.y); pk.y = pk_h2(o.z, o.w);
                *(u32x2*)(qlat + (size_t)tok * 2048 + c * 256 + 16 * ft + 4 * kq) = pk; } }
#undef SW_LOADK
    }
}


__device__ __forceinline__ void precomb_tiles(const Frame& F, const Args& args, unsigned char* ws, int t_lo, int t_hi, int wg, int nwg) {
    LAS float* As = (LAS float*)(F.lds); LAS float* Bs = (LAS float*)(F.lds + 64 * 65 * 4);
    for (int tl = t_lo + wg; tl < t_hi; tl += nwg) {
        __syncthreads();
        const bool ql = tl < 192; int hd, rb, xb;
        if (ql) { hd = tl / 24; rb = (tl % 24) / 6; xb = tl % 6; } else { const int t2 = tl - 192; hd = t2 / 64; rb = (t2 % 64) / 16; xb = t2 % 16; }
#pragma unroll
        for (int k = 0; k < 2; ++k) { const int i4 = F.tid + NTHR * k, row = i4 >> 4, c4 = (i4 & 15) * 4;
            if (ql) { const f32x4 a = *(const f32x4*)(args.in[15] + (size_t)(rb * 64 + row) * 512 + hd * 64 + c4), bq = *(const f32x4*)(args.in[14] + (size_t)(xb * 64 + row) * 768 + hd * 96 + c4);
#pragma unroll
                for (int e = 0; e < 4; ++e) { As[row * 65 + c4 + e] = a[e]; Bs[row * 65 + c4 + e] = bq[e]; } }
            else { const f32x4 a = *(const f32x4*)(args.in[18] + (size_t)(hd * 64 + row) * DM + xb * 64 + c4), bq = *(const f32x4*)(args.in[16] + (size_t)(rb * 64 + row) * 512 + hd * 64 + c4);
#pragma unroll
                for (int e = 0; e < 4; ++e) { As[(c4 + e) * 65 + row] = a[e]; Bs[row * 65 + c4 + e] = bq[e]; } } }
        __syncthreads();
        const int j = F.tid & 63, ig = F.wave;
        float acc8[8];
#pragma unroll
        for (int ii = 0; ii < 8; ++ii) acc8[ii] = 0.f;
#pragma unroll 4
        for (int v = 0; v < 64; ++v) { const float bv = Bs[j * 65 + v];
#pragma unroll
            for (int ii = 0; ii < 8; ++ii) acc8[ii] += As[(ig * 8 + ii) * 65 + v] * bv; }
        if (ql) { const float gj = args.in[12][xb * 64 + j]; h16* o = (h16*)(ws + OW_4);
#pragma unroll
            for (int ii = 0; ii < 8; ++ii) o[(size_t)(hd * 256 + rb * 64 + ig * 8 + ii) * QL + xb * 64 + j] = (h16)(acc8[ii] * gj); }
        else { h16* o = (h16*)(ws + OW_OV);
#pragma unroll
            for (int ii = 0; ii < 8; ++ii) o[(size_t)(xb * 64 + ig * 8 + ii) * 2048 + hd * 256 + rb * 64 + j] = (h16)acc8[ii]; }
    }
    __syncthreads();
}


__device__ __forceinline__ void ph_topk_sparse(const Frame& F, const h16* qi, const h16* ki, const float* wi, unsigned short* sel, h16* qlat, const h16* qr, const unsigned char* ckv8, const unsigned char* kr8) {
    LAS unsigned* hist = (LAS unsigned*)(F.lds + F.wave * 16384);
    for (int p = F.gw; p < 2048; p += F.NGW) {
        int ta, tb;
        if (p < 4 * 448) { const int b = p & 3, pj = p >> 2; ta = b * SEQ + 4 * (64 + pj); tb = b * SEQ + 4 * (959 - pj);
            tk_group(F, qi, ki, wi, sel, b, 4 * (64 + pj), hist);
            tk_group(F, qi, ki, wi, sel, b, 4 * (959 - pj), hist); }
        else { const int q_ = p - 4 * 448, b = q_ & 3, i_ = q_ >> 2, t0 = 4 * i_;
            tk_group(F, qi, ki, wi, sel, b, 4 * (960 + i_), hist);
            int l0 = F.lane; asm volatile("" : "+v"(l0));
            for (int i = l0; i < 4 * TOPK; i += 64) { const int q = i >> 8, k = i & 255; sel[(size_t)(b * SEQ + t0 + q) * TOPK + k] = (unsigned short)(k <= t0 + q ? k : 0); }
            ta = b * SEQ + 4 * (960 + i_); tb = b * SEQ + t0; }
        asm volatile("s_waitcnt vmcnt(0) lgkmcnt(0)" ::: "memory");
        ph_sparse_wave<true>(F, qlat, qr, ckv8, kr8, sel, ta, tb);
        asm volatile("s_waitcnt lgkmcnt(0)" ::: "memory");
    }
}

__global__ void __launch_bounds__(NTHR, 2) mega_fwd(Args args) {
    extern __shared__ __attribute__((aligned(16))) unsigned char lds_raw[];
    Frame F; F.lds = (LAS unsigned char*)lds_raw; F.tid = threadIdx.x; F.lane = F.tid & 63; F.wave = __builtin_amdgcn_readfirstlane(F.tid >> 6);
    F.G = gridDim.x; F.gw = blockIdx.x * NWAVES + F.wave; F.NGW = F.G * NWAVES;
    volatile LAS unsigned* MISC = (volatile LAS unsigned*)(F.lds + MISC_OFF);
    unsigned char* ws = args.ws;
    for (int u = F.tid; u < (LDS_BYTES - LDSCTL_OFF) / 4; u += NTHR) ((LAS unsigned*)(F.lds + LDSCTL_OFF))[u] = 0u;
    __syncthreads();
    XcdBarrier bar = xcd_barrier_post((unsigned*)(ws + OFF_CTL) + CW_BAR, MISC + 8, F.wave);
    const int lo = args.ph_lo, hi = args.ph_hi;
#define IN(k) (lo <= (k) && (k) < hi)
#define SEAM(k) do { if (IN(k) && IN((k) + 1)) xcd_barrier(bar); F.lane = flane(); F.tid = F.wave * 64 + F.lane; } while (0)
    float* mod = (float*)(ws + OFF_MOD); float2* tab = (float2*)(ws + OFF_ROPE);
    h16* Hb = (h16*)(ws + OFF_H); h16* Ab = (h16*)(ws + OFF_A); float* Fb = (float*)(ws + OFF_F);

    if (IN(0)) {
        LAS float* scr = (LAS float*)(F.lds + F.wave * 16384);
        for (int ch = blockIdx.x; ch < (NMOD * DM) / 36; ch += F.G) {
            LAS float* sl = (LAS float*)(F.lds);
            LAS f32x4* part = (LAS f32x4*)(F.lds + 16384);
            __syncthreads();
            for (int i = F.tid; i < 4 * DM; i += NTHR) sl[i] = silu_f(args.in[1][i]);
            __syncthreads();
            const int r7 = F.lane / 9, c4 = F.lane - 9 * r7; const bool act = F.lane < 63;
            const float* wm = args.in[3] + (size_t)(F.wave * 128 + r7) * (NMOD * DM) + ch * 36 + 4 * c4;
            f32x4 wv[19];
#pragma unroll
            for (int i = 0; i < 19; ++i) { const bool ok = act && (7 * i + r7 < 128); wv[i] = *(const f32x4*)(wm + (size_t)(ok ? 7 * i : 0) * (NMOD * DM)); }
            f32x4 a0 = {0.f, 0.f, 0.f, 0.f}, a1 = a0, a2 = a0, a3 = a0;
#pragma unroll
            for (int i = 0; i < 19; ++i) { const bool ok = act && (7 * i + r7 < 128); const int kk = F.wave * 128 + (ok ? 7 * i + r7 : 0); const f32x4 w = ok ? wv[i] : (f32x4){0.f, 0.f, 0.f, 0.f};
                a0 += w * sl[kk]; a1 += w * sl[DM + kk]; a2 += w * sl[2 * DM + kk]; a3 += w * sl[3 * DM + kk]; }
            if (act) { LAS f32x4* pp = part + ((F.wave * 7 + r7) * 4) * 9 + c4; pp[0] = a0; pp[9] = a1; pp[18] = a2; pp[27] = a3; }
            __syncthreads();
            if (F.tid < 144) { const int b = F.tid / 36, l = F.tid - 36 * b; float sm = args.in[4][ch * 36 + l]; const LAS float* pf = (const LAS float*)part + (b * 9) * 4 + l;
#pragma unroll 8
                for (int w = 0; w < 56; ++w) sm += pf[w * 144];
                mod[b * (NMOD * DM) + ch * 36 + l] = sm; }
            __syncthreads();
        }
        for (int idx = blockIdx.x * NTHR + F.tid; idx < MT * 48; idx += F.G * NTHR) { const int tok = idx / 48, i = idx % 48;
            const float inv = (i < 32) ? powf(10000.f, -(float)i / 32.f) : powf(10000.f, -(float)(i - 32) / 16.f);
            const float ang = (float)((const int*)args.in[2])[tok] * inv; float sn, cs; sincosf(ang, &sn, &cs); tab[idx] = make_float2(cs, sn); }
        tr_job_mapped(F, args, 0, 2 * FF, 0, DM, ws + OW_GU1, nullptr, scr, 0);
        if (F.G != 256) {
            tr_job_plain(F, args.in[8], DM, DM, FF, ws + OW_D1, scr, 768);
            tr_job_mapped(F, args, 2, NIN3, 0, DM, (h16*)(ws + OW_IN), nullptr, scr, 128);
            tr_job_plain(F, args.in[11] + C_GATE, DIN, 2048, DM, ws + OW_GATE, scr, 1664);
            tr_job_mapped(F, args, 3, 512, 2048, QL, (h16*)(ws + OW_4), args.in[12], scr, 640);
            tr_job_plain(F, args.in[19], DM, DM, 256, (h16*)(ws + OW_UPB), scr, 736);
            tr_job_plain(F, args.in[20], DM, DM, DM, (h16*)(ws + OW_O), scr, 864);
            tr_job_mapped(F, args, 1, 2 * FF, 0, DM, ws + OW_GU2, nullptr, scr, 1376);
            tr_job_plain(F, args.in[25], DM, DM, FF, ws + OW_D2, scr, 96);
            precomb_tiles(F, args, ws, 0, 192, (int)blockIdx.x, F.G);
            tr_job_plain(F, args.in[18], DM, DM, 512, (h16*)(ws + OW_UPA), scr, 256);
        }
    }
    SEAM(0);
    if (IN(1)) ph_normmod(F, args.in[0], args.in[5], mod, 1, 0, ws + OFF_H);
    SEAM(1);
    if (IN(2)) { pg8::Gemm g{Hb, (const h16*)(ws + OW_GU1), MT, 2 * FF, DM / 2}; pg8::StaticOrder S; S.init(MT, 2 * FF, F.G, (int)blockIdx.x); pg8::EpiSwiGLU_T<true> E{Ab};
        pg8::gemm_phase<pg8::EpiSwiGLU_T<true>, true, true>(F.lds, g, S, E, F.wave);
        if (F.G == 256 && blockIdx.x >= 128) {
            Frame F2 = F; F2.gw = ((int)blockIdx.x - 128) * NWAVES + F.wave; F2.NGW = 128 * NWAVES; LAS float* scr = (LAS float*)(F.lds + F.wave * 16384);
            tr_job_plain(F2, args.in[8], DM, DM, FF, ws + OW_D1, scr, 0);
            tr_job_mapped(F2, args, 2, NIN3, 0, DM, (h16*)(ws + OW_IN), nullptr, scr, 384);
            tr_job_mapped(F2, args, 3, 512, 2048, QL, (h16*)(ws + OW_4), args.in[12], scr, 896);
            precomb_tiles(F, args, ws, 0, 192, (int)blockIdx.x - 128, 128);
            for (int i = ((int)blockIdx.x - 128) * NTHR + F.tid; i < (int)(MiB / 16); i += 128 * NTHR) ((u32x4*)(ws + OW_BD))[i] = (u32x4){0u, 0u, 0u, 0u}; } }
    SEAM(2);
    if (IN(3)) { pg8::Gemm g{Ab, (const h16*)(ws + OW_D1), MT, DM, FF / 2}; pg8::StaticOrder S; S.init(MT, DM, F.G, (int)blockIdx.x); pg8::EpiH16_T<true> E{(h16*)Fb};
        pg8::gemm_phase<pg8::EpiH16_T<true>, false, true>(F.lds, g, S, E, F.wave); }
    SEAM(3);
    if (IN(4)) ph_resnorm<false, true>(F, args.in[0], (const h16*)Fb, args.in[9], mod, 2, 0.5f, args.out, true, args.in[10], 4, 3, Hb, (unsigned char*)args.out + 32 * MiB);
    SEAM(4);
    if (IN(5)) { pg8::Gemm g{Hb, (const h16*)(ws + OW_IN), MT, NIN3, DM}; pg8::StaticOrder S; S.init(MT, NIN3, F.G, (int)blockIdx.x);
        pg8::EpiIn E{(h16*)(ws + OFF_CKV), (h16*)(ws + OFF_CQ), (h16*)(ws + OFF_KR), (h16*)(ws + OFF_KI), (h16*)(ws + OFF_QB), (h16*)(ws + OFF_KB), (h16*)(ws + OFF_VT), (float*)(ws + OFF_WI), (float*)(ws + OFF_SSQ),
                     args.in[13], tab, (LAS float*)(F.lds + XCH_OFF)};
        pg8::gemm_phase<pg8::EpiIn, true>(F.lds, g, S, E, F.wave); }
    SEAM(5);
    if (IN(6)) { for (int tk_ = blockIdx.x * NTHR + F.tid; tk_ < MT; tk_ += F.G * NTHR) { const f32x4 s0 = *(const f32x4*)((const float*)(ws + OFF_SSQ) + tk_ * 8), s1 = *(const f32x4*)((const float*)(ws + OFF_SSQ) + tk_ * 8 + 4);
            ((float*)(ws + OFF_RSTDQ))[tk_] = rsqrtf((((s0.x + s0.y) + (s0.z + s0.w)) + ((s1.x + s1.y) + (s1.z + s1.w))) * (1.f / QL) + EPS); } }
    if (IN(6)) ph_dilated_mfma(F, (const h16*)(ws + OFF_QB), (const h16*)(ws + OFF_KB), (const h16*)(ws + OFF_VT), (h16*)(ws + OFF_OG), (float*)(ws + OFF_LSE));
    SEAM(6);
    if (IN(7)) { pg8::Gemm g{(const h16*)(ws + OFF_CQ), (const h16*)(ws + OW_4), MT, N4, QL}; pg8::StaticOrder S; S.init(MT, N4, F.G, (int)blockIdx.x);
        pg8::Epi4 E{(h16*)(ws + OFF_QLAT), (h16*)(ws + OFF_QR), (h16*)(ws + OFF_QI), (const float*)(ws + OFF_RSTDQ), tab};
        pg8::gemm_phase<pg8::Epi4, true>(F.lds, g, S, E, F.wave);
        if (F.G == 256 && blockIdx.x >= 128) {
            Frame F2 = F; F2.gw = ((int)blockIdx.x - 128) * NWAVES + F.wave; F2.NGW = 128 * NWAVES; LAS float* scr = (LAS float*)(F.lds + F.wave * 16384);
            tr_job_plain(F2, args.in[11] + C_GATE, DIN, 2048, DM, ws + OW_GATE, scr, 0);
            tr_job_mapped(F2, args, 1, 2 * FF, 0, DM, ws + OW_GU2, nullptr, scr, 640);
            tr_job_plain(F2, args.in[19], DM, DM, 256, (h16*)(ws + OW_UPB), scr, 512);
            tr_job_plain(F2, args.in[20], DM, DM, DM, (h16*)(ws + OW_O), scr, 640);
            tr_job_plain(F2, args.in[18], DM, DM, 512, (h16*)(ws + OW_UPA), scr, 256);
            for (int it = F2.gw; it < 4 * 16; it += F2.NGW) { const int kb = it >> 4, nb = it & 15, n0 = nb * 32, hl = (n0 >> 6) & 3;
                tr_item(args.in[16], 512, n0 + (F.lane & 31), true, nullptr, kb * 64, (h16*)(ws + OW_BD) + (size_t)n0 * 1024 + 256 * hl, 1024, scr, F.lane); } } }
    SEAM(7);
    if (IN(8)) { ph_combine(F, (const h16*)(ws + OFF_OG), (const float*)(ws + OFF_LSE), (h16*)(ws + OFF_OB));
        ph_topk_sparse(F, (const h16*)(ws + OFF_QI), (const h16*)(ws + OFF_KI), (const float*)(ws + OFF_WI), (unsigned short*)(ws + OFF_SEL),
                       (h16*)(ws + OFF_QLAT), (const h16*)(ws + OFF_QR), (const unsigned char*)(ws + OFF_CKV), (const unsigned char*)(ws + OFF_KR)); }
    SEAM(8);
    if (IN(9) && F.G == 256) { const bool first = blockIdx.x < 128;
        pg8::Gemm g{first ? (const h16*)(ws + OFF_QLAT) : (const h16*)(ws + OFF_OB), first ? (const h16*)(ws + OW_BD) : (const h16*)(ws + OW_UPB), MT, first ? 512 : DM, first ? 1024 : 256, first ? 2048 : 0, first ? 1024 : 0};
        pg8::StaticOrder S; S.init(MT, first ? 512 : DM, 128, first ? (int)blockIdx.x : (int)blockIdx.x - 128);
        pg8::EpiH16 E{first ? (h16*)(ws + OFF_OA) : (h16*)(ws + OFF_Y2), first ? 512 : DM};
        pg8::gemm_phase<pg8::EpiH16, false>(F.lds, g, S, E, F.wave); }
    SEAM(9);
    if (IN(10)) { pg8::StaticOrder S; S.init(MT, DM, F.G, (int)blockIdx.x); h16* Y1 = (h16*)(ws + OFF_Y1); h16* Y2 = (h16*)(ws + OFF_Y2);
        { pg8::Gemm g{(const h16*)(ws + OFF_OA), (const h16*)(ws + OW_UPA), MT, DM, 512}; pg8::EpiH16 E{Y1}; pg8::gemm_phase<pg8::EpiH16, false>(F.lds, g, S, E, F.wave); }
        const h16* u8 = (const h16*)((const unsigned char*)args.out + 32 * MiB);
        { pg8::Gemm g{u8, (const h16*)(ws + OW_GATE), MT, DM, DM / 2}; pg8::EpiGate E{Y1, Y1, 0, -LOG2E * F8_INV}; pg8::gemm_phase<pg8::EpiGate, false, true>(F.lds, g, S, E, F.wave); }
        { pg8::Gemm g{u8, (const h16*)(ws + OW_GATE + (size_t)DM * DM), MT, DM, DM / 2}; pg8::EpiGate E{Y2, Y1, 1, -LOG2E * F8_INV}; pg8::gemm_phase<pg8::EpiGate, false, true>(F.lds, g, S, E, F.wave); } }
    SEAM(10);
    if (IN(11)) { pg8::Gemm g{(const h16*)(ws + OFF_Y1), (const h16*)(ws + OW_O), MT, DM, DM}; pg8::StaticOrder S; S.init(MT, DM, F.G, (int)blockIdx.x); pg8::EpiH16 E{(h16*)(ws + OFF_YF)};
        pg8::gemm_phase<pg8::EpiH16, false>(F.lds, g, S, E, F.wave); }
    SEAM(11);
    if (IN(12)) ph_resnorm<true, true, unsigned char>(F, args.out, (const h16*)(ws + OFF_YF), args.in[21], mod, 5, 1.0f, ws + OFF_F, true, args.in[22], 7, 6, ws + OFF_H);
    SEAM(12);
    if (IN(13)) { pg8::Gemm g{Hb, (const h16*)(ws + OW_GU2), MT, 2 * FF, DM / 2}; pg8::StaticOrder S; S.init(MT, 2 * FF, F.G, (int)blockIdx.x); pg8::EpiSwiGLU_T<true> E{Ab};
        pg8::gemm_phase<pg8::EpiSwiGLU_T<true>, true, true>(F.lds, g, S, E, F.wave);
        if (F.G == 256 && blockIdx.x >= 128) { Frame F2 = F; F2.gw = ((int)blockIdx.x - 128) * NWAVES + F.wave; F2.NGW = 128 * NWAVES;
            tr_job_plain(F2, args.in[25], DM, DM, FF, ws + OW_D2, (LAS float*)(F.lds + F.wave * 16384), 0); } }
    SEAM(13);
    if (IN(14)) { pg8::Gemm g{Ab, (const h16*)(ws + OW_D2), MT, DM, FF / 2}; pg8::StaticOrder S; S.init(MT, DM, F.G, (int)blockIdx.x); pg8::EpiH16_T<true> E{(h16*)(ws + OFF_F + 32 * MiB)};
        pg8::gemm_phase<pg8::EpiH16_T<true>, false, true>(F.lds, g, S, E, F.wave); }
    SEAM(14);
    if (IN(15)) ph_resnorm<true, false>(F, ws + OFF_F, (const h16*)(ws + OFF_F + 32 * MiB), args.in[26], mod, 8, 0.5f, args.out, false, nullptr, 0, 0, (h16*)nullptr);
#undef IN
#undef SEAM
}


extern "C" void kernel_launch(void* const* d_in, const int* in_sizes, int n_in, void* d_out, int out_size, void* d_ws, size_t ws_size, hipStream_t stream) {
    if (n_in != 27 || ws_size < WS_END || out_size != MT * DM) { fprintf(stderr, "kernel_launch: unexpected shapes (n_in %d ws %zu out %d)\n", n_in, ws_size, out_size); return; }
    static int grid = 0;
    if (grid == 0) {
        int dev = 0, cus = 0, per_cu = 0;
        if (hipGetDevice(&dev) != hipSuccess || hipDeviceGetAttribute(&cus, hipDeviceAttributeMultiprocessorCount, dev) != hipSuccess) { grid = -1; return; }
        if (hipFuncSetAttribute((const void*)mega_fwd, hipFuncAttributeMaxDynamicSharedMemorySize, LDS_BYTES) != hipSuccess) { fprintf(stderr, "kernel_launch: hipFuncSetAttribute failed\n"); grid = -1; return; }
        if (hipOccupancyMaxActiveBlocksPerMultiprocessor(&per_cu, (const void*)mega_fwd, NTHR, LDS_BYTES) != hipSuccess || per_cu < 1) { fprintf(stderr, "kernel_launch: occupancy query says %d blocks/CU\n", per_cu); grid = -1; return; }
        grid = cus;
    }
    if (grid < 0) return;
    hipMemsetAsync((char*)d_ws + OFF_CTL, 0, 1 * MiB, stream);
    Args a{}; for (int i = 0; i < 27; ++i) a.in[i] = (const float*)d_in[i]; a.out = (float*)d_out; a.ws = (unsigned char*)d_ws; a.ph_lo = 0; a.ph_hi = 16;
    void* kargs[] = {&a};
#ifdef PH_DOUBLE
    a.ph_hi = PH_DOUBLE + 1; (void)hipLaunchCooperativeKernel((const void*)mega_fwd, dim3(grid), dim3(NTHR), kargs, LDS_BYTES, stream);
    hipMemsetAsync((char*)d_ws + OFF_CTL, 0, 1 * MiB, stream); a.ph_lo = PH_DOUBLE; a.ph_hi = 16;
#endif
    const hipError_t e = hipLaunchCooperativeKernel((const void*)mega_fwd, dim3(grid), dim3(NTHR), kargs, LDS_BYTES, stream);
    if (e != hipSuccess) fprintf(stderr, "kernel_launch: cooperative launch failed: %s (grid %d)\n", hipGetErrorString(e), grid);
    (void)in_sizes;
}
```

```cpp
#include <hip/hip_runtime.h>
#include <hip/hip_fp16.h>
#include <cstdio>
#include <cstdint>

constexpr int NB = 4, SEQ = 4096, DM = 1024, MT = NB * SEQ, FF = 2816;
constexpr int QL = 384, KVL = 256, DNOPE = 64, DROPE = 32, DVA = 64, HA = 8, HI = 8, DI = 32, TOPK = 256;
constexpr int NG = 3, HB = 4, DHB = 64, NMOD = 9, DIN = 5064;
constexpr int C_CQ = 0, C_CKV = 384, C_KR = 640, C_KI = 672, C_WI = 704, C_QKV = 712, C_GATE = 3016;
constexpr float EPS = 1e-6f, LOG2E = 1.4426950408889634f;
typedef _Float16 h16;

constexpr size_t MiB = 1u << 20;
constexpr size_t OFF_CTL = 0, OFF_MOD = 1 * MiB, OFF_ROPE = 2 * MiB, OFF_W = 8 * MiB, OFF_H = 60 * MiB, OFF_A = 92 * MiB, OFF_F = 180 * MiB, OFF_SP = 244 * MiB, WS_END = 256 * MiB;
constexpr size_t OFF_QB = OFF_A, OFF_KB = OFF_A + 24 * MiB, OFF_VT = OFF_A + 48 * MiB, OFF_CKV = OFF_A + 72 * MiB, OFF_KR = OFF_A + 80 * MiB, OFF_KI = OFF_A + 81 * MiB,
                 OFF_WI = OFF_A + 82 * MiB, OFF_SSQ = OFF_A + 82 * MiB + 512 * 1024, OFF_CQ = OFF_SP;
constexpr size_t OFF_RSTDQ = OFF_A + 83 * MiB;
constexpr size_t OFF_OG = OFF_F, OFF_LSE = OFF_F + 24 * MiB, OFF_QLAT = OFF_A, OFF_QR = OFF_A + 64 * MiB, OFF_QI = OFF_F + 25 * MiB, OFF_SEL = OFF_F + 33 * MiB, OFF_OB = OFF_SP;
constexpr size_t OFF_Y1 = OFF_F, OFF_Y2 = OFF_F + 32 * MiB, OFF_YF = OFF_A;

__device__ __forceinline__ float silu_f(float v) { return v / (1.f + __expf(-v)); }
__device__ __forceinline__ float sigm_f(float v) { return 1.f / (1.f + __expf(-v)); }
__host__ __device__ __forceinline__ int dil_of(int g) { return g == 0 ? 1 : (g == 1 ? 4 : 16); }
__device__ __forceinline__ unsigned fkey(float f) { const unsigned u = __float_as_uint(f); return (u & 0x80000000u) ? ~u : (u | 0x80000000u); }


#define LAS __attribute__((address_space(3)))
#define GAS __attribute__((address_space(1)))
typedef _Float16 f16x8 __attribute__((ext_vector_type(8)));
typedef float f32x4 __attribute__((ext_vector_type(4)));
typedef float f32x2 __attribute__((ext_vector_type(2)));
typedef unsigned u32x4 __attribute__((ext_vector_type(4)));
typedef unsigned u32x2 __attribute__((ext_vector_type(2)));
typedef _Float16 h16x2 __attribute__((ext_vector_type(2)));
__device__ __forceinline__ unsigned pk_h2(float lo, float hi) { f32x2 v = {lo, hi}; h16x2 h = __builtin_convertvector(v, h16x2); return __builtin_bit_cast(unsigned, h); }
__device__ __forceinline__ int flane() { int l; asm volatile("v_mbcnt_lo_u32_b32 %0, -1, 0\n\tv_mbcnt_hi_u32_b32 %0, -1, %0" : "=v"(l)); return l; }
typedef unsigned u32x2s __attribute__((ext_vector_type(2)));
__device__ __forceinline__ float sum_x16(float v) { const unsigned u = __float_as_uint(v); const u32x2s r = __builtin_amdgcn_permlane16_swap(u, u, false, false); return __uint_as_float(r.x) + __uint_as_float(r.y); }
__device__ __forceinline__ float sum_x32(float v) { const unsigned u = __float_as_uint(v); const u32x2s r = __builtin_amdgcn_permlane32_swap(u, u, false, false); return __uint_as_float(r.x) + __uint_as_float(r.y); }
__device__ __forceinline__ float max_x16(float v) { const unsigned u = __float_as_uint(v); const u32x2s r = __builtin_amdgcn_permlane16_swap(u, u, false, false); return fmaxf(__uint_as_float(r.x), __uint_as_float(r.y)); }
__device__ __forceinline__ float max_x32(float v) { const unsigned u = __float_as_uint(v); const u32x2s r = __builtin_amdgcn_permlane32_swap(u, u, false, false); return fmaxf(__uint_as_float(r.x), __uint_as_float(r.y)); }
template <int CTRL> __device__ __forceinline__ float dpp_f(float v) { return __int_as_float(__builtin_amdgcn_update_dpp(0, __float_as_int(v), CTRL, 0xF, 0xF, true)); }
__device__ __forceinline__ float sat8(float x) { return __builtin_amdgcn_fmed3f(x, -448.f, 448.f); }
__device__ __forceinline__ unsigned pk_f8x4(float a, float b, float c, float d) { int w = __builtin_amdgcn_cvt_pk_fp8_f32(sat8(a), sat8(b), 0, false); w = __builtin_amdgcn_cvt_pk_fp8_f32(sat8(c), sat8(d), w, true); return (unsigned)w; }
typedef int i32x4 __attribute__((ext_vector_type(4)));
typedef int i32x8 __attribute__((ext_vector_type(8)));
constexpr float F8_ACT = 8.f, F8_WGT = 512.f, F8_INV = 1.f / (F8_ACT * F8_WGT);

namespace pg8 {
constexpr int BM = 256, BK = 64, HALF = 128, HTB = HALF * BK * 2, STAGE_BYTES = 8 * HTB, NXCD = 8, WGM = 8;
__host__ __device__ __forceinline__ int lds_byte(int r, int c) { const int st = (r >> 4) * 2 + (c >> 5), rr = r & 15, cc = c & 31, ob = rr * 64 + cc * 2; return st * 1024 + (ob ^ (((ob >> 9) & 1) << 5)); }
__host__ __device__ __forceinline__ void stage_rc(int b, int& R, int& C) { const int st = b / 1024, sb = b % 1024, swz = sb ^ (((sb >> 9) & 1) << 5); R = (st >> 1) * 16 + swz / 64; C = (st & 1) * 32 + (swz % 64) / 2; }
__host__ __device__ __forceinline__ int perm32(int rho) { const int n = rho >> 4, i = rho & 15; return 8 * (i >> 2) + 4 * n + (i & 3); }
struct Unit { int pm, pn; };
struct Gemm { const h16* A; const h16* Bt; int M, N, K; int lda = 0, koffA = 0; };
struct StaticOrder {
    int nM, nN, nwg, G, c;
    __host__ __device__ void init(int M, int N, int G_, int c_) { nM = M / BM; nN = N / BM; nwg = nM * nN; G = G_; c = c_; }
    __host__ __device__ bool next(int i, Unit& u) const {
        const long L = (long)i * G + c; if (L >= nwg) return false;
        int wgid = (int)L; { const int q = nwg / NXCD, r = nwg % NXCD, xcd = wgid % NXCD, off = wgid / NXCD; wgid = (xcd < r ? xcd * (q + 1) : r * (q + 1) + (xcd - r) * q) + off; }
        const int nig = WGM * nN, gid = wgid / nig, fm = gid * WGM, gsz = (nM - fm) < WGM ? (nM - fm) : WGM;
        u.pm = fm + ((wgid % nig) % gsz); u.pn = (wgid % nig) / gsz; return true;
    }
};
struct PairOrder { StaticOrder S;
    __host__ __device__ bool next(int i, Unit& u) const { if (i >= 2 || !S.next(0, u)) return false; u.pn += 4 * i; return true; } };
template <class Epi, bool ALIGN_EPI, bool F8 = false, class Order = StaticOrder>
__device__ __forceinline__ void gemm_phase(LAS unsigned char* lds, const Gemm g, const Order& S, const Epi& E, const int wid) {
    const int lane = flane(), tid = wid * 64 + lane, wr = wid >> 2, wc = wid & 3, fr = lane & 15, fq = lane >> 4;
    const int K = g.K, lda = g.lda ? g.lda : g.K; int nt = K / BK;
    if constexpr (F8) asm volatile("" : "+s"(nt));
    unsigned voffA[2], voffB[2];
#pragma unroll
    for (int i = 0; i < 2; ++i) { int R, C; stage_rc(tid * 16 + i * 8192, R, C); const int Rb = Epi::PERM ? ((R & ~31) + perm32(R & 31)) : R;
        voffA[i] = (unsigned)(R * lda + C) * 2u; voffB[i] = (unsigned)(Rb * K + C) * 2u; }
    const size_t kstep = (size_t)(BK * 2);
    const size_t hstep = (size_t)HALF * K * 2, hstepA = (size_t)HALF * lda * 2;
    const size_t tstep = 2 * hstep, tstepA = 2 * hstepA, kofA = (size_t)g.koffA * 2;
    const unsigned ldsw = (unsigned)wid * 1024u;
    const int aoff = lds_byte(wr * 64 + fr, fq * 8), boff = lds_byte(wc * 32 + fr, fq * 8);
#define PG8_SA(b, h) (((b) * 2 + (h)) * HTB)
#define PG8_SB(b, h) ((4 + (b) * 2 + (h)) * HTB)
#define PG8_STAGE(bufoff, gbase, voff) do { _Pragma("unroll") for (int _i = 0; _i < 2; ++_i) { unsigned _vo = (voff)[_i]; asm volatile("" : "+v"(_vo)); \
        __builtin_amdgcn_global_load_lds((const unsigned*)((const char*)(gbase) + _vo), (LAS unsigned*)(lds + (bufoff) + ldsw + _i * 8192), 16, 0, 0); } } while (0)
#define PG8_LDA(dst, b, h) do { _Pragma("unroll") for (int m = 0; m < 4; ++m) _Pragma("unroll") for (int k = 0; k < 2; ++k) dst[m][k] = *(const LAS f16x8*)(lds + PG8_SA(b, h) + aoff + m * 2048 + k * 1024); } while (0)
#define PG8_LDB(dst, b, h) do { _Pragma("unroll") for (int n = 0; n < 2; ++n) _Pragma("unroll") for (int k = 0; k < 2; ++k) dst[n][k] = *(const LAS f16x8*)(lds + PG8_SB(b, h) + boff + n * 2048 + k * 1024); } while (0)
#define PG8_CAT8(x, y) __builtin_shufflevector(__builtin_bit_cast(i32x4, x), __builtin_bit_cast(i32x4, y), 0, 1, 2, 3, 4, 5, 6, 7)
#define PG8_MMA(ai, bj, At, Bt) do { __builtin_amdgcn_s_setprio(1); \
        if constexpr (F8) { _Pragma("unroll") for (int m = 0; m < 4; ++m) _Pragma("unroll") for (int n = 0; n < 2; ++n) \
            acc[ai][bj][m][n] = __builtin_amdgcn_mfma_scale_f32_16x16x128_f8f6f4(PG8_CAT8(Bt[n][0], Bt[n][1]), PG8_CAT8(At[m][0], At[m][1]), acc[ai][bj][m][n], 0, 0, 0, 0, 0, 0); } \
        else { _Pragma("unroll") for (int m = 0; m < 4; ++m) _Pragma("unroll") for (int n = 0; n < 2; ++n) _Pragma("unroll") for (int k = 0; k < 2; ++k) \
            acc[ai][bj][m][n] = __builtin_amdgcn_mfma_f32_16x16x32_f16(Bt[n][k], At[m][k], acc[ai][bj][m][n], 0, 0, 0); } \
        __builtin_amdgcn_s_setprio(0); } while (0)
#define PG8_WAIT_V(n) asm volatile("s_waitcnt vmcnt(" #n ")" ::: "memory")
#define PG8_WAIT_L(n) asm volatile("s_waitcnt lgkmcnt(" #n ")" ::: "memory")
#define PG8_BAR __builtin_amdgcn_s_barrier()
#define PG8_SCHED __builtin_amdgcn_sched_barrier(0)
    Unit cur, nxt; int ui = 0;
    if (!S.next(0, cur)) return;
    f32x4 acc[2][2][4][2];
#pragma unroll
    for (int a = 0; a < 2; ++a)
#pragma unroll
        for (int b = 0; b < 2; ++b)
#pragma unroll
            for (int m = 0; m < 4; ++m)
#pragma unroll
                for (int n = 0; n < 2; ++n) acc[a][b][m][n] = (f32x4){0.f, 0.f, 0.f, 0.f};
    f16x8 At[4][2], B0[2][2], B1[2][2];
    const char* cA = (const char*)g.A + (size_t)cur.pm * tstepA + (size_t)cur.pn * kofA; const char* cB = (const char*)g.Bt + (size_t)cur.pn * tstep;
    PG8_STAGE(PG8_SB(0, 0), cB, voffB); PG8_STAGE(PG8_SB(0, 1), cB + hstep, voffB); PG8_STAGE(PG8_SA(0, 0), cA, voffA); PG8_STAGE(PG8_SA(0, 1), cA + hstepA, voffA);
    if (wr == 1) PG8_BAR;
    PG8_WAIT_V(2); PG8_BAR;
    PG8_STAGE(PG8_SB(1, 0), cB + kstep, voffB); PG8_STAGE(PG8_SA(1, 0), cA + kstep, voffA); PG8_STAGE(PG8_SB(1, 1), cB + hstep + kstep, voffB);
    PG8_WAIT_V(6); PG8_BAR;
    for (;;) {
        const bool has_next = S.next(ui + 1, nxt);
        const char* nA = has_next ? (const char*)g.A + (size_t)nxt.pm * tstepA + (size_t)nxt.pn * kofA : cA; const char* nB = has_next ? (const char*)g.Bt + (size_t)nxt.pn * tstep : cB;
        for (int t = 0; t < nt; t += 2) {
            const bool last = (t == nt - 2);
            const char* a1 = cA + (size_t)(t + 1) * kstep;
            const char* a2 = last ? nA : cA + (size_t)(t + 2) * kstep; const char* b2 = last ? nB : cB + (size_t)(t + 2) * kstep;
            const char* a3 = a2 + kstep; const char* b3 = b2 + kstep;
            PG8_LDB(B0, 0, 0); PG8_LDB(B1, 0, 1); PG8_SCHED; PG8_LDA(At, 0, 0); PG8_STAGE(PG8_SA(1, 1), a1 + hstepA, voffA);
            PG8_WAIT_V(8); PG8_WAIT_L(0); PG8_BAR; PG8_MMA(0, 0, At, B0); PG8_MMA(0, 1, At, B1); PG8_BAR; PG8_SCHED;
            PG8_LDA(At, 0, 1); PG8_STAGE(PG8_SB(0, 0), b2, voffB); PG8_STAGE(PG8_SB(0, 1), b2 + hstep, voffB); PG8_STAGE(PG8_SA(0, 0), a2, voffA);
            PG8_WAIT_V(8); PG8_WAIT_L(0); PG8_BAR; PG8_MMA(1, 0, At, B0); PG8_MMA(1, 1, At, B1); PG8_BAR; PG8_SCHED;
            PG8_LDB(B0, 1, 0); PG8_LDB(B1, 1, 1); PG8_SCHED; PG8_LDA(At, 1, 0); PG8_STAGE(PG8_SA(0, 1), a2 + hstepA, voffA);
            PG8_WAIT_V(8); PG8_WAIT_L(0); PG8_BAR; PG8_MMA(0, 0, At, B0); PG8_MMA(0, 1, At, B1); PG8_BAR; PG8_SCHED;
            PG8_LDA(At, 1, 1); PG8_STAGE(PG8_SB(1, 0), b3, voffB); PG8_STAGE(PG8_SB(1, 1), b3 + hstep, voffB); PG8_STAGE(PG8_SA(1, 0), a3, voffA);
            PG8_WAIT_V(8); PG8_WAIT_L(0); PG8_BAR; PG8_MMA(1, 0, At, B0); PG8_MMA(1, 1, At, B1); PG8_BAR; PG8_SCHED;
        }
        if constexpr (ALIGN_EPI) { if (wr == 0) PG8_BAR; }
        { const int l2 = flane(); E(acc, cur, wr, wc, l2 & 15, l2 >> 4); }
        if (!has_next) break;
#pragma unroll
        for (int a = 0; a < 2; ++a)
#pragma unroll
            for (int b = 0; b < 2; ++b)
#pragma unroll
                for (int m = 0; m < 4; ++m)
#pragma unroll
                    for (int n = 0; n < 2; ++n) acc[a][b][m][n] = (f32x4){0.f, 0.f, 0.f, 0.f};
        cur = nxt; cA = nA; cB = nB; ++ui;
        if constexpr (ALIGN_EPI) { if (wr == 1) PG8_BAR; }
    }
    PG8_WAIT_V(0);
    if constexpr (!ALIGN_EPI) { if (wr == 0) PG8_BAR; }
    PG8_BAR;
#undef PG8_SA
#undef PG8_SB
#undef PG8_STAGE
#undef PG8_LDA
#undef PG8_LDB
#undef PG8_MMA
#undef PG8_CAT8
#undef PG8_WAIT_V
#undef PG8_WAIT_L
#undef PG8_BAR
#undef PG8_SCHED
}
struct EpiF32 {
    static constexpr bool PERM = false;
    float* C; int ldc;
    __device__ __forceinline__ void operator()(const f32x4 (&acc)[2][2][4][2], const Unit& u, int wr, int wc, int fr, int fq) const {
        const int row0 = u.pm * BM + wr * 64 + fr, col0 = u.pn * BM + wc * 32 + 4 * fq;
#pragma unroll
        for (int ai = 0; ai < 2; ++ai)
#pragma unroll
            for (int m = 0; m < 4; ++m) { float* rowp = C + (size_t)(row0 + ai * HALF + m * 16) * ldc + col0;
#pragma unroll
                for (int bj = 0; bj < 2; ++bj)
#pragma unroll
                    for (int n = 0; n < 2; ++n) *(f32x4*)(rowp + bj * HALF + n * 16) = acc[ai][bj][m][n]; }
    }
};
template <bool F8, bool O8 = F8>
struct EpiSwiGLU_T {
    static constexpr bool PERM = true;
    void* O;
    __device__ __forceinline__ void operator()(const f32x4 (&acc)[2][2][4][2], const Unit& u, int wr, int wc, int fr, int fq) const {
        const int row0 = u.pm * BM + wr * 64 + fr, col0 = u.pn * HALF + wc * 32 + 8 * fq;
#pragma unroll
        for (int ai = 0; ai < 2; ++ai)
#pragma unroll
            for (int m = 0; m < 4; ++m) { const size_t eo = (size_t)(row0 + ai * HALF + m * 16) * FF + col0;
                float v[8];
#pragma unroll
                for (int n = 0; n < 2; ++n)
#pragma unroll
                    for (int e = 0; e < 4; ++e) { float gg = acc[ai][0][m][n][e], uu = acc[ai][1][m][n][e]; if constexpr (F8) { gg *= F8_INV; uu *= O8 ? F8_INV * F8_ACT : F8_INV; }
                        v[n * 4 + e] = gg * __builtin_amdgcn_rcpf(1.f + __builtin_amdgcn_exp2f(-gg * LOG2E)) * uu; }
                if constexpr (O8) { u32x2 w; w.x = pk_f8x4(v[0], v[1], v[2], v[3]); w.y = pk_f8x4(v[4], v[5], v[6], v[7]); *(u32x2*)((unsigned char*)O + eo) = w; }
                else { u32x4 w; w.x = pk_h2(v[0], v[1]); w.y = pk_h2(v[2], v[3]); w.z = pk_h2(v[4], v[5]); w.w = pk_h2(v[6], v[7]); *(u32x4*)((h16*)O + eo) = w; } }
    }
};
typedef EpiSwiGLU_T<false> EpiSwiGLU;

struct EpiIn {
    static constexpr bool PERM = false;
    h16 *ckv, *cq, *kr, *ki, *qb, *kb, *vT; float *wi, *ssq; const float* gckv; const float2* tab; LAS float* X;
    __device__ __forceinline__ void rope64(const f32x4 (&acc)[2][2][4][2], const Unit& u, int wr, int wc, int fr, int fq, h16* dst, int tl, float scale) const {
        const int tok0 = u.pm * BM + wr * 64 + fr;
        f32x4 tc[4], tn[4];
        { const f32x4* tp = (const f32x4*)(tab + (size_t)tok0 * 48 + 4 * fq); tc[0] = tp[0]; tc[1] = tp[1]; tc[2] = tp[8]; tc[3] = tp[9]; }
#pragma unroll
        for (int rr = 0; rr < 8; ++rr) { const int ai = rr >> 2, m = rr & 3, tok = tok0 + ai * HALF + m * 16;
            if (rr < 7) { const int tokn = tok0 + ((rr + 1) >> 2) * HALF + ((rr + 1) & 3) * 16; const f32x4* tp = (const f32x4*)(tab + (size_t)tokn * 48 + 4 * fq); tn[0] = tp[0]; tn[1] = tp[1]; tn[2] = tp[8]; tn[3] = tp[9]; }
#pragma unroll
            for (int n = 0; n < 2; ++n) { const int i = 16 * n + 4 * fq; const f32x4 t0 = tc[2 * n], t1 = tc[2 * n + 1];
                const f32x4 cs = {t0.x, t0.z, t1.x, t1.z}, sn = {t0.y, t0.w, t1.y, t1.w}, x1 = acc[ai][0][m][n], x2 = acc[ai][1][m][n];
                const f32x4 o1 = (x1 * cs - x2 * sn) * scale, o2 = (x2 * cs + x1 * sn) * scale;
                h16* p = dst + (size_t)tok * 768 + (4 * tl + wc) * 64 + i;
                u32x2 w1, w2; w1.x = pk_h2(o1.x, o1.y); w1.y = pk_h2(o1.z, o1.w); w2.x = pk_h2(o2.x, o2.y); w2.y = pk_h2(o2.z, o2.w);
                *(u32x2*)p = w1; *(u32x2*)(p + 32) = w2; }
#pragma unroll
            for (int k = 0; k < 4; ++k) tc[k] = tn[k];
            asm volatile("" ::: "memory"); }
    }
    __device__ __forceinline__ void operator()(const f32x4 (&acc)[2][2][4][2], const Unit& u, int wr, int wc, int fr, int fq) const {
        const int pn = u.pn;
        if (pn == 0) {
#pragma unroll
            for (int ai = 0; ai < 2; ++ai)
#pragma unroll
                for (int m = 0; m < 4; ++m) { float sq = 0.f;
#pragma unroll
                    for (int bj = 0; bj < 2; ++bj)
#pragma unroll
                        for (int n = 0; n < 2; ++n) { const f32x4 v = acc[ai][bj][m][n]; sq += (v.x * v.x + v.y * v.y) + (v.z * v.z + v.w * v.w); }
                    sq = sum_x16(sq); sq = sum_x32(sq);
                    if (fq == 0) X[(ai * HALF + wr * 64 + m * 16 + fr) * 4 + wc] = sq; }
            asm volatile("s_waitcnt lgkmcnt(0)" ::: "memory"); __builtin_amdgcn_s_barrier(); asm volatile("" ::: "memory");
#pragma unroll
            for (int ai = 0; ai < 2; ++ai)
#pragma unroll
                for (int m = 0; m < 4; ++m) { const int rl = ai * HALF + wr * 64 + m * 16 + fr, tok = u.pm * BM + rl; const f32x4 p = *(const LAS f32x4*)(X + rl * 4);
                    const float rstd = rsqrtf(((p.x + p.y) + (p.z + p.w)) * (1.f / KVL) + EPS);
#pragma unroll
                    for (int bj = 0; bj < 2; ++bj)
#pragma unroll
                        for (int n = 0; n < 2; ++n) { const int col = bj * HALF + wc * 32 + n * 16 + 4 * fq; const f32x4 o = acc[ai][bj][m][n] * rstd * *(const f32x4*)(gckv + col);
                            int w8 = __builtin_amdgcn_cvt_pk_fp8_f32(o.x, o.y, 0, false); w8 = __builtin_amdgcn_cvt_pk_fp8_f32(o.z, o.w, w8, true);
                            *(int*)((unsigned char*)ckv + (size_t)tok * KVL + col) = w8; }
                    asm volatile("" ::: "memory"); }
            asm volatile("s_waitcnt lgkmcnt(0)" ::: "memory"); __builtin_amdgcn_s_barrier(); asm volatile("" ::: "memory");
        } else if (pn <= 2) {
#pragma unroll
            for (int ai = 0; ai < 2; ++ai)
#pragma unroll
                for (int m = 0; m < 4; ++m) { const int tok = u.pm * BM + ai * HALF + wr * 64 + m * 16 + fr; float sq = 0.f;
#pragma unroll
                    for (int bj = 0; bj < 2; ++bj) { if (pn == 2 && bj == 1) break;
#pragma unroll
                        for (int n = 0; n < 2; ++n) { const f32x4 v = acc[ai][bj][m][n]; sq += (v.x * v.x + v.y * v.y) + (v.z * v.z + v.w * v.w);
                            const int col = (pn - 1) * 256 + bj * HALF + wc * 32 + n * 16 + 4 * fq; u32x2 w; w.x = pk_h2(v.x, v.y); w.y = pk_h2(v.z, v.w); *(u32x2*)(cq + (size_t)tok * QL + col) = w; } }
                    sq = sum_x16(sq); sq = sum_x32(sq);
                    if (fq == 0) ssq[tok * 8 + (pn - 1) * 4 + wc] = sq;
                    if (pn == 2) {
                        if (wc < 2) { const int i = 4 * fq; const f32x4* tp = (const f32x4*)(tab + (size_t)tok * 48 + 32 + i); const f32x4 t0 = tp[0], t1 = tp[1];
                            const f32x4 cs = {t0.x, t0.z, t1.x, t1.z}, sn = {t0.y, t0.w, t1.y, t1.w}, x1 = acc[ai][1][m][0], x2 = acc[ai][1][m][1];
                            const f32x4 o1 = x1 * cs - x2 * sn, o2 = x2 * cs + x1 * sn;
                            if (wc == 0) { unsigned char* p8 = (unsigned char*)kr + (size_t)tok * 32 + i;
                                int a8 = __builtin_amdgcn_cvt_pk_fp8_f32(o1.x, o1.y, 0, false); a8 = __builtin_amdgcn_cvt_pk_fp8_f32(o1.z, o1.w, a8, true);
                                int b8 = __builtin_amdgcn_cvt_pk_fp8_f32(o2.x, o2.y, 0, false); b8 = __builtin_amdgcn_cvt_pk_fp8_f32(o2.z, o2.w, b8, true);
                                *(int*)p8 = a8; *(int*)(p8 + 16) = b8; }
                            else { h16* p = ki + (size_t)tok * 32 + i;
                                u32x2 w1, w2; w1.x = pk_h2(o1.x, o1.y); w1.y = pk_h2(o1.z, o1.w); w2.x = pk_h2(o2.x, o2.y); w2.y = pk_h2(o2.z, o2.w);
                                *(u32x2*)p = w1; *(u32x2*)(p + 16) = w2; } }
                        else if (wc == 2 && fq < 2) { *(f32x4*)(wi + tok * 8 + 4 * fq) = acc[ai][1][m][0] * 0.35355339059327373f; }
                    }
                    asm volatile("" ::: "memory"); }
        } else if (pn <= 5) rope64(acc, u, wr, wc, fr, fq, qb, pn - 3, 0.125f * LOG2E);
        else if (pn <= 8) rope64(acc, u, wr, wc, fr, fq, kb, pn - 6, 1.0f);
        else {
#pragma unroll
            for (int ai = 0; ai < 2; ++ai)
#pragma unroll
                for (int m = 0; m < 4; ++m) { const int tok = u.pm * BM + ai * HALF + wr * 64 + m * 16 + fr;
#pragma unroll
                    for (int bj = 0; bj < 2; ++bj)
#pragma unroll
                        for (int n = 0; n < 2; ++n) { const f32x4 v = acc[ai][bj][m][n]; u32x2 w; w.x = pk_h2(v.x, v.y); w.y = pk_h2(v.z, v.w);
                            *(u32x2*)(vT + (size_t)tok * 768 + (pn - 9) * 256 + bj * HALF + wc * 32 + n * 16 + 4 * fq) = w; }
                    asm volatile("" ::: "memory"); }
        }
    }
};
struct Epi4 {
    static constexpr bool PERM = true;
    h16 *qlat, *qr, *qi; const float* rstdq; const float2* tab;
    __device__ __forceinline__ void operator()(const f32x4 (&acc)[2][2][4][2], const Unit& u, int wr, int wc, int fr, int fq) const {
        const int pn = u.pn; const float c2 = 0.10206207261596575f * LOG2E;
        const int tok0 = u.pm * BM + wr * 64 + fr;
        float rc, rn = 0.f;
        if (pn < 8) {
            float rs[8];
#pragma unroll
            for (int rr = 0; rr < 8; ++rr) rs[rr] = rstdq[tok0 + (rr >> 2) * HALF + (rr & 3) * 16];
#pragma unroll
            for (int rr = 0; rr < 8; ++rr) { const int ai = rr >> 2, m = rr & 3, tok = tok0 + ai * HALF + m * 16; rc = rs[rr];
#pragma unroll
                for (int bj = 0; bj < 2; ++bj) { const f32x4 o0 = acc[ai][bj][m][0] * (rc * c2), o1 = acc[ai][bj][m][1] * (rc * c2);
                    u32x4 w; w.x = pk_h2(o0.x, o0.y); w.y = pk_h2(o0.z, o0.w); w.z = pk_h2(o1.x, o1.y); w.w = pk_h2(o1.z, o1.w);
                    *(u32x4*)(qlat + (size_t)tok * 2048 + pn * 256 + bj * HALF + wc * 32 + 8 * fq) = w; }
                asm volatile("" ::: "memory"); }
        } else { rc = rstdq[tok0]; h16* dst = (pn == 8) ? qr : qi; const float c2e = (pn == 8) ? c2 : 1.f; const int i = 4 * fq;
            f32x4 tc[2], tn[2];
            { const f32x4* tp = (const f32x4*)(tab + (size_t)tok0 * 48 + 32 + i); tc[0] = tp[0]; tc[1] = tp[1]; }
#pragma unroll
            for (int rr = 0; rr < 8; ++rr) { const int ai = rr >> 2, m = rr & 3, tok = tok0 + ai * HALF + m * 16;
                if (rr < 7) { const int tokn = tok0 + ((rr + 1) >> 2) * HALF + ((rr + 1) & 3) * 16; const f32x4* tp = (const f32x4*)(tab + (size_t)tokn * 48 + 32 + i); tn[0] = tp[0]; tn[1] = tp[1]; rn = rstdq[tokn]; }
                const f32x4 cs = {tc[0].x, tc[0].z, tc[1].x, tc[1].z}, sn = {tc[0].y, tc[0].w, tc[1].y, tc[1].w}; const float sc = rc * c2e;
#pragma unroll
                for (int bj = 0; bj < 2; ++bj) { const f32x4 x1 = acc[ai][bj][m][0], x2 = acc[ai][bj][m][1]; const f32x4 o1 = (x1 * cs - x2 * sn) * sc, o2 = (x2 * cs + x1 * sn) * sc;
                    h16* p = dst + (size_t)tok * 256 + (4 * bj + wc) * 32 + i;
                    u32x2 w1, w2; w1.x = pk_h2(o1.x, o1.y); w1.y = pk_h2(o1.z, o1.w); w2.x = pk_h2(o2.x, o2.y); w2.y = pk_h2(o2.z, o2.w);
                    *(u32x2*)p = w1; *(u32x2*)(p + 16) = w2; }
                tc[0] = tn[0]; tc[1] = tn[1]; rc = rn;
                asm volatile("" ::: "memory"); } }
    }
};
__device__ __forceinline__ u32x4 ld16_l2(const h16* p) {
    const unsigned long long a = __hip_atomic_load((const unsigned long long*)p, __ATOMIC_RELAXED, __HIP_MEMORY_SCOPE_AGENT), b = __hip_atomic_load((const unsigned long long*)p + 1, __ATOMIC_RELAXED, __HIP_MEMORY_SCOPE_AGENT);
    return (u32x4){(unsigned)a, (unsigned)(a >> 32), (unsigned)b, (unsigned)(b >> 32)};
}
typedef _Float16 h16x8 __attribute__((ext_vector_type(8)));
__device__ __forceinline__ void unpk8(const u32x4 w, float (&f)[8]) {
    const h16x8 h = __builtin_bit_cast(h16x8, w);
#pragma unroll
    for (int i = 0; i < 8; ++i) f[i] = (float)h[i];
}
template <bool SC>
struct EpiH16_T {
    static constexpr bool PERM = true;
    h16* O; int ldc = DM;
    __device__ __forceinline__ void operator()(const f32x4 (&acc)[2][2][4][2], const Unit& u, int wr, int wc, int fr, int fq) const {
        const int row0 = u.pm * BM + wr * 64 + fr, col0 = u.pn * BM + wc * 32 + 8 * fq;
#pragma unroll
        for (int ai = 0; ai < 2; ++ai)
#pragma unroll
            for (int m = 0; m < 4; ++m)
#pragma unroll
                for (int bj = 0; bj < 2; ++bj) { f32x4 v0 = acc[ai][bj][m][0], v1 = acc[ai][bj][m][1]; if constexpr (SC) { v0 *= F8_INV; v1 *= F8_INV; }
                    u32x4 w; w.x = pk_h2(v0.x, v0.y); w.y = pk_h2(v0.z, v0.w); w.z = pk_h2(v1.x, v1.y); w.w = pk_h2(v1.z, v1.w);
                    *(u32x4*)(O + (size_t)(row0 + ai * HALF + m * 16) * ldc + col0 + bj * HALF) = w; }
    }
};
typedef EpiH16_T<false> EpiH16;
struct EpiGate {
    static constexpr bool PERM = true;
    const h16* Y; h16* Z; int accum; float nls; const h16* Yb = nullptr;
    __device__ __forceinline__ void operator()(const f32x4 (&acc)[2][2][4][2], const Unit& u, int wr, int wc, int fr, int fq) const {
        const int row0 = u.pm * BM + wr * 64 + fr, col0 = (u.pn & 3) * BM + wc * 32 + 8 * fq; const bool accum = Yb ? (u.pn >= 4) : (this->accum != 0); const h16* Y = (Yb && u.pn >= 4) ? Yb : this->Y;
#pragma unroll
        for (int ai = 0; ai < 2; ++ai)
#pragma unroll
            for (int m = 0; m < 4; ++m)
#pragma unroll
                for (int bj = 0; bj < 2; ++bj) { const size_t off = (size_t)(row0 + ai * HALF + m * 16) * DM + col0 + bj * HALF;
                    float y[8], zz[8]; unpk8(ld16_l2(Y + off), y);
                    if (accum) unpk8(ld16_l2(Z + off), zz); else {
#pragma unroll
                        for (int i = 0; i < 8; ++i) zz[i] = 0.f; }
                    float o[8];
#pragma unroll
                    for (int n = 0; n < 2; ++n)
#pragma unroll
                        for (int e = 0; e < 4; ++e) { const float gg = acc[ai][bj][m][n][e]; o[n * 4 + e] = zz[n * 4 + e] + y[n * 4 + e] * __builtin_amdgcn_rcpf(1.f + __builtin_amdgcn_exp2f(gg * nls)); }
                    u32x4 w; w.x = pk_h2(o[0], o[1]); w.y = pk_h2(o[2], o[3]); w.z = pk_h2(o[4], o[5]); w.w = pk_h2(o[6], o[7]);
                    *(u32x4*)(Z + off) = w; }
    }
};
}

#define XB_TMO      128
#define XB_XCNT(j)  (256  + 64 * (j))
#define XB_XSUB(j)  (1280 + 64 * (j))
#define XB_XGEN(j)  (2304 + 64 * (j))
#define XB_TOP      3328
#define XB_TOPGEN   3392
#define XCD_BAR_WORDS 3456
#define XB_SPIN_CAP (1u << 18)
__device__ __forceinline__ unsigned xb_ld(unsigned* p)              { return __hip_atomic_load(p, __ATOMIC_RELAXED, __HIP_MEMORY_SCOPE_AGENT); }
__device__ __forceinline__ unsigned xb_add(unsigned* p, unsigned v) { return __hip_atomic_fetch_add(p, v, __ATOMIC_RELAXED, __HIP_MEMORY_SCOPE_AGENT); }
__device__ __forceinline__ unsigned xb_xcc_id() { return (unsigned)__builtin_amdgcn_s_getreg((3 << 11) | 20) & 0xFu; }
#define XB_SPIN(cond, bar) do { unsigned _sp = 0; while (cond) { __builtin_amdgcn_s_sleep(1); \
    if ((++_sp & 255u) == 0u) { if (xb_ld(&(bar)[XB_TMO])) break; if (_sp > XB_SPIN_CAP) { atomicAdd(&(bar)[XB_TMO], 1u); break; } } } } while (0)
struct XcdBarrier { unsigned* bar; unsigned x; volatile LAS unsigned* st; int wave; };
__device__ __forceinline__ XcdBarrier xcd_barrier_post(unsigned* bar, volatile LAS unsigned* st, int wave) {
    XcdBarrier b; b.bar = bar; b.x = xb_xcc_id(); b.st = st; b.wave = wave;
    if (wave == 0 && flane() == 0) (void)xb_add(&bar[XB_XCNT(b.x)], 1u);
    return b;
}
__device__ __forceinline__ void xcd_barrier_complete(unsigned* bar, unsigned x, unsigned& nloc, unsigned& nx) {
    const unsigned G = gridDim.x * gridDim.y * gridDim.z;
    unsigned sum, cnt, mine, sp = 0u;
    for (;;) {
        sum = 0u; cnt = 0u; mine = 0u;
#pragma unroll
        for (unsigned j = 0; j < 16; ++j) { const unsigned c = xb_ld(&bar[XB_XCNT(j)]); sum += c; cnt += (c > 0u) ? 1u : 0u; mine = (j == x) ? c : mine; }
        if (sum == G) break;
        __builtin_amdgcn_s_sleep(1);
        if ((++sp & 255u) == 0u) { if (xb_ld(&bar[XB_TMO])) break; if (sp > XB_SPIN_CAP) { atomicAdd(&bar[XB_TMO], 1u); break; } }
    }
    nloc = mine > 0u ? mine : 1u; nx = cnt > 0u ? cnt : 1u;
}
__device__ __forceinline__ void xcd_barrier(const XcdBarrier& b) {
    asm volatile("s_waitcnt vmcnt(0)" ::: "memory");
    __syncthreads();
    if (b.wave == 0 && flane() == 0) {
        unsigned* bar = b.bar;
        __builtin_amdgcn_s_waitcnt(0);
        unsigned nloc = b.st[0], nx = b.st[1];
        if (nloc == 0u) { xcd_barrier_complete(bar, b.x, nloc, nx); b.st[0] = nloc; b.st[1] = nx; }
        const unsigned old = xb_add(&bar[XB_XSUB(b.x)], 1u);
        const unsigned gen = old / nloc;
        if (old + 1u == (gen + 1u) * nloc) {
            __builtin_amdgcn_fence(__ATOMIC_RELEASE, "agent");
            asm volatile("s_waitcnt vmcnt(0)" ::: "memory");
            const unsigned og = xb_add(&bar[XB_TOP], 1u);
            const unsigned tg = og / nx;
            if (og + 1u == (tg + 1u) * nx) xb_add(&bar[XB_TOPGEN], 1u);
            else XB_SPIN(xb_ld(&bar[XB_TOPGEN]) == tg, bar);
            __builtin_amdgcn_fence(__ATOMIC_ACQUIRE, "agent");
            xb_add(&bar[XB_XGEN(b.x)], 1u);
            asm volatile("s_waitcnt vmcnt(0)" ::: "memory");
        } else {
            XB_SPIN(xb_ld(&bar[XB_XGEN(b.x)]) == gen, bar);
            __builtin_amdgcn_fence(__ATOMIC_ACQUIRE, "agent");
            asm volatile("s_waitcnt vmcnt(0)" ::: "memory");
        }
    }
    __syncthreads();
}

constexpr int NWAVES = 8, NTHR = 512;
constexpr int RING_BYTES = 131072, LDSCTL_OFF = RING_BYTES, MISC_OFF = LDSCTL_OFF + 320, LDS_BYTES = 149504;
constexpr int XCH_OFF = RING_BYTES + 1024;
constexpr int SELL_OFF = XCH_OFF;
static_assert(SELL_OFF + 8 * 2048 <= LDS_BYTES, "LDS layout");
constexpr int CW_BAR = 4096;
constexpr size_t OW_GU1 = OFF_W, OW_D1 = OW_GU1 + 11 * MiB, OW_IN = OW_D1 + (size_t)DM * FF * 2, OW_GATE = OW_IN + 6 * MiB, OW_4 = OW_GATE + 4 * MiB, OW_OV = OW_4 + 2 * MiB,
                 OW_UPB = OW_OV + 4 * MiB, OW_O = OW_UPB + MiB / 2, OW_GU2 = OW_O + 2 * MiB, OW_D2 = OW_GU2 + 11 * MiB, OW_END = OW_D2 + (size_t)DM * FF * 2;
static_assert(OW_END <= OFF_H, "weights region");
constexpr int NIN3 = 3072, N4 = 2560;
constexpr size_t OW_BD = OW_OV, OW_UPA = OW_OV + MiB, OFF_OA = OFF_A + 64 * MiB;

struct Args { const float* in[27]; float* out; unsigned char* ws; int ph_lo, ph_hi; };
struct Frame {
    LAS unsigned char* lds; int tid, lane, wave, G, gw, NGW;
};
__device__ __forceinline__ float wave_sum(float v) {
    v += dpp_f<0xB1>(v); v += dpp_f<0x4E>(v); v += dpp_f<0x141>(v); v += dpp_f<0x140>(v);
    v = sum_x16(v); v = sum_x32(v);
    return v;
}
__device__ __forceinline__ bool map_row(int job, int n, const Args& a, const float*& W, int& ldw, int& col) {
    if (job <= 1) { const int t = n >> 8, j = n & 255; W = a.in[(job == 0 ? 6 : 23) + (j >> 7)]; ldw = FF; col = t * 128 + (j & 127); return true; }
    if (job == 2) { W = a.in[11]; ldw = DIN; const int t = n >> 8, j = n & 255;
        if (t == 0) { col = C_CKV + j; return true; }
        if (t == 1) { col = j; return true; }
        if (t == 2) { if (j < 128) { col = 256 + j; return true; } if (j < 160) { col = C_KR + (j - 128); return true; } if (j < 192) { col = C_KI + (j - 160); return true; } if (j < 200) { col = C_WI + (j - 192); return true; } col = 0; return false; }
        if (t < 9) { const int c3 = (t - 3) / 3, tl = (t - 3) % 3, hl = (j & 127) >> 5, i = j & 31; col = C_QKV + c3 * 768 + (4 * tl + hl) * 64 + (j >> 7) * 32 + i; return true; }
        col = C_QKV + 1536 + (t - 9) * 256 + j; return true; }
    { const int n2 = n - 2048, r5 = n2 & 31, nat = 16 * ((r5 >> 2) & 1) + 4 * (r5 >> 3) + (r5 & 3);
      if (n2 < 256) { W = a.in[14]; ldw = 768; col = (n2 >> 5) * 96 + 64 + nat; } else { W = a.in[17]; ldw = 256; col = ((n2 - 256) & ~31) + nat; } return true; }
}
template <typename T>
__device__ __forceinline__ void tr_item(const float* W, int ldw, int col, bool valid, const float* scale, int k0, T* WTrow0, int K, LAS float* scr, int lane) {
    const int colc = valid ? col : 0; float vv[32];
#pragma unroll
    for (int i = 0; i < 32; ++i) vv[i] = W[(size_t)(k0 + 2 * i + (lane >> 5)) * ldw + colc];
    if (scale) {
#pragma unroll
        for (int i = 0; i < 32; ++i) vv[i] *= scale[k0 + 2 * i + (lane >> 5)]; }
#pragma unroll
    for (int i = 0; i < 32; ++i) scr[(2 * i + (lane >> 5)) * 33 + (lane & 31)] = valid ? vv[i] : 0.f;
    asm volatile("s_waitcnt lgkmcnt(0)" ::: "memory");
    const int c = lane & 7;
#pragma unroll
    for (int j = 0; j < 4; ++j) { const int n = (lane >> 3) + 8 * j; const LAS float* s = scr + (8 * c) * 33 + n;
        if constexpr (sizeof(T) == 1) { u32x2 o; o.x = pk_f8x4(s[0 * 33] * F8_WGT, s[1 * 33] * F8_WGT, s[2 * 33] * F8_WGT, s[3 * 33] * F8_WGT); o.y = pk_f8x4(s[4 * 33] * F8_WGT, s[5 * 33] * F8_WGT, s[6 * 33] * F8_WGT, s[7 * 33] * F8_WGT);
            *(u32x2*)(WTrow0 + (size_t)n * K + k0 + 8 * c) = o; }
        else { u32x4 o; o.x = pk_h2(s[0 * 33], s[1 * 33]); o.y = pk_h2(s[2 * 33], s[3 * 33]); o.z = pk_h2(s[4 * 33], s[5 * 33]); o.w = pk_h2(s[6 * 33], s[7 * 33]);
            *(u32x4*)(WTrow0 + (size_t)n * K + k0 + 8 * c) = o; } }
    asm volatile("s_waitcnt lgkmcnt(0)" ::: "memory");
}
template <typename T>
__device__ __forceinline__ void tr_job_mapped(const Frame& F, const Args& a, int job, int Ndest, int n_lo, int K, T* WT, const float* scale, LAS float* scr, int phase_off) {
    const int nblk = Ndest / 32, nitems = (K / 64) * nblk;
    for (int it = (F.gw + phase_off) % F.NGW; it < nitems; it += F.NGW) {
        const int kb = it / nblk, nb = it % nblk; const float* W; int ldw, col;
        const bool valid = map_row(job, n_lo + nb * 32 + (F.lane & 31), a, W, ldw, col);
        tr_item(W, ldw, col, valid, scale, kb * 64, WT + (size_t)(n_lo + nb * 32) * K, K, scr, F.lane);
    }
}
template <typename T>
__device__ __forceinline__ void tr_job_plain(const Frame& F, const float* W, int ldw, int Ndest, int K, T* WT, LAS float* scr, int phase_off) {
    const int nblk = Ndest / 32, nitems = (K / 64) * nblk;
    for (int it = (F.gw + phase_off) % F.NGW; it < nitems; it += F.NGW) {
        const int kb = it / nblk, nb = it % nblk;
        tr_item(W, ldw, nb * 32 + (F.lane & 31), true, nullptr, kb * 64, WT + (size_t)(nb * 32) * K, K, scr, F.lane);
    }
}
__device__ __forceinline__ void row_load(const float* p, int lane, f32x4 (&v)[4]) {
#pragma unroll
    for (int j = 0; j < 4; ++j) v[j] = __builtin_nontemporal_load((const f32x4*)p + lane + 64 * j);
}
__device__ __forceinline__ float row_ssq(const f32x4 (&v)[4]) { float s = 0.f;
#pragma unroll
    for (int j = 0; j < 4; ++j) s += (v[j].x * v[j].x + v[j].y * v[j].y) + (v[j].z * v[j].z + v[j].w * v[j].w);
    return wave_sum(s); }
template <typename T>
__device__ __forceinline__ void store_nm(const f32x4 (&xv)[4], float r2, const f32x4 (&gb)[4], const f32x4 (&gc)[4], T* dst, int lane, unsigned char* dst8) {
#pragma unroll
    for (int j = 0; j < 4; ++j) { const int ci = lane + 64 * j; const f32x4 o = xv[j] * r2 * gb[j] + gc[j];
        if constexpr (sizeof(T) == 1) __builtin_nontemporal_store(pk_f8x4(o.x * F8_ACT, o.y * F8_ACT, o.z * F8_ACT, o.w * F8_ACT), (unsigned*)dst + ci);
        else { u32x2 w; w.x = pk_h2(o.x, o.y); w.y = pk_h2(o.z, o.w); __builtin_nontemporal_store(w, (u32x2*)dst + ci); if (dst8) __builtin_nontemporal_store(pk_f8x4(o.x * F8_ACT, o.y * F8_ACT, o.z * F8_ACT, o.w * F8_ACT), (unsigned*)dst8 + ci); } }
}
template <typename T>
__device__ __forceinline__ void ph_normmod(const Frame& F, const float* x, const float* g, const float* mod, int isc, int ish, T* dst) {
    const int lane = flane();
    const int b = F.gw & 3, nsl = F.NGW >> 2; int r0 = F.gw >> 2; if (r0 >= SEQ) return;
    const float* mb = mod + b * (NMOD * DM); f32x4 gb[4], gc[4];
#pragma unroll
    for (int j = 0; j < 4; ++j) { const int ci = lane + 64 * j; gb[j] = ((const f32x4*)g)[ci] * (((const f32x4*)(mb + isc * DM))[ci] + 1.f); gc[j] = ((const f32x4*)(mb + ish * DM))[ci]; }
    const float* xb = x + (size_t)b * SEQ * DM; T* db = dst + (size_t)b * SEQ * DM;
    f32x4 v[2][4], vn[2][4];
#pragma unroll
    for (int k = 0; k < 2; ++k) { const int r = r0 + k * nsl; row_load(xb + (size_t)(r < SEQ ? r : r0) * DM, lane, v[k]); }
    for (;;) { const int rn = r0 + 2 * nsl; const bool has = rn < SEQ;
        if (has) {
#pragma unroll
            for (int k = 0; k < 2; ++k) { const int r = rn + k * nsl; row_load(xb + (size_t)(r < SEQ ? r : rn) * DM, lane, vn[k]); } }
#pragma unroll
        for (int k = 0; k < 2; ++k) { const int r = r0 + k * nsl; const float rstd = rsqrtf(row_ssq(v[k]) * (1.f / DM) + EPS);
            if (r < SEQ) store_nm(v[k], rstd, gb, gc, db + (size_t)r * DM, lane, nullptr); }
        if (!has) break;
#pragma unroll
        for (int k = 0; k < 2; ++k)
#pragma unroll
            for (int j = 0; j < 4; ++j) v[k][j] = vn[k][j];
        r0 = rn; }
}
__device__ __forceinline__ void row_load_h(const h16* p, int lane, u32x2 (&v)[4]) {
#pragma unroll
    for (int j = 0; j < 4; ++j) v[j] = __builtin_nontemporal_load((const u32x2*)p + lane + 64 * j);
}
typedef _Float16 h16x4 __attribute__((ext_vector_type(4)));
__device__ __forceinline__ f32x4 h4_to_f4(u32x2 w) { const h16x4 h = __builtin_bit_cast(h16x4, w); return (f32x4){(float)h[0], (float)h[1], (float)h[2], (float)h[3]}; }
template <bool XI16, bool XO16, typename T = h16>
__device__ __forceinline__ void ph_resnorm(const Frame& F, const void* xin_, const h16* f, const float* gpost, const float* mod, int igt, float coef, void* xout_,
                                           bool second, const float* gpre, int isc, int ish, T* dst, unsigned char* dst8 = nullptr) {
    const int lane = flane();
    const int b = F.gw & 3, nsl = F.NGW >> 2; int r0 = F.gw >> 2; if (r0 >= SEQ) return;
    const float* mb = mod + b * (NMOD * DM); f32x4 ga[4], gb[4], gc[4];
#pragma unroll
    for (int j = 0; j < 4; ++j) { const int ci = lane + 64 * j; ga[j] = ((const f32x4*)gpost)[ci] * ((const f32x4*)(mb + igt * DM))[ci] * coef;
        if (second) { gb[j] = ((const f32x4*)gpre)[ci] * (((const f32x4*)(mb + isc * DM))[ci] + 1.f); gc[j] = ((const f32x4*)(mb + ish * DM))[ci]; } else { gb[j] = (f32x4){0.f, 0.f, 0.f, 0.f}; gc[j] = gb[j]; } }
    const size_t bo = (size_t)b * SEQ * DM; const h16* fb = f + bo;
    u32x2 fh[2][4], fn[2][4]; f32x4 xi[2][4], xn[2][4]; u32x2 xh[2][4], xhn[2][4];
#pragma unroll
    for (int k = 0; k < 2; ++k) { const int r = r0 + k * nsl; const size_t ro = (size_t)(r < SEQ ? r : r0) * DM; row_load_h(fb + ro, lane, fh[k]);
        if constexpr (XI16) row_load_h((const h16*)xin_ + bo + ro, lane, xh[k]); else row_load((const float*)xin_ + bo + ro, lane, xi[k]); }
    for (;;) {
        const int rn = r0 + 2 * nsl; const bool has = rn < SEQ;
        if (has) {
#pragma unroll
            for (int k = 0; k < 2; ++k) { const int r = rn + k * nsl; const size_t ro = (size_t)(r < SEQ ? r : rn) * DM; row_load_h(fb + ro, lane, fn[k]);
                if constexpr (XI16) row_load_h((const h16*)xin_ + bo + ro, lane, xhn[k]); else row_load((const float*)xin_ + bo + ro, lane, xn[k]); } }
#pragma unroll
        for (int k = 0; k < 2; ++k) { const int r = r0 + k * nsl; const bool ok = r < SEQ; const size_t ro = bo + (size_t)r * DM;
            f32x4 v[4];
#pragma unroll
            for (int j = 0; j < 4; ++j) { v[j] = h4_to_f4(fh[k][j]); if constexpr (XI16) xi[k][j] = h4_to_f4(xh[k][j]); }
            const float rstd = rsqrtf(row_ssq(v) * (1.f / DM) + EPS);
#pragma unroll
            for (int j = 0; j < 4; ++j) { const int ci = lane + 64 * j;
                xi[k][j] = xi[k][j] + ga[j] * v[j] * rstd;
                if (ok) { if constexpr (XO16) { u32x2 w; w.x = pk_h2(xi[k][j].x, xi[k][j].y); w.y = pk_h2(xi[k][j].z, xi[k][j].w); __builtin_nontemporal_store(w, (u32x2*)((h16*)xout_ + ro) + ci); }
                          else __builtin_nontemporal_store(xi[k][j], (f32x4*)((float*)xout_ + ro) + ci); } }
            if (second) { const float r2 = rsqrtf(row_ssq(xi[k]) * (1.f / DM) + EPS); if (ok) store_nm(xi[k], r2, gb, gc, dst + ro, lane, dst8 ? dst8 + ro : nullptr); } }
        if (!has) break;
#pragma unroll
        for (int k = 0; k < 2; ++k)
#pragma unroll
            for (int j = 0; j < 4; ++j) { fh[k][j] = fn[k][j]; if constexpr (XI16) xh[k][j] = xhn[k][j]; else xi[k][j] = xn[k][j]; }
        r0 = rn;
    }
}

__device__ __forceinline__ void ph_combine(const Frame& F, const h16* og, const float* lse2, h16* ob) {
    for (int idx = blockIdx.x * NTHR + F.tid; idx < MT * 32; idx += F.G * NTHR) {
        const int tok = idx >> 5, c = (idx & 31) * 8, hh = c >> 6;
        const float l0 = lse2[tok * 12 + hh], l1 = lse2[tok * 12 + 4 + hh], l2 = lse2[tok * 12 + 8 + hh], m = fmaxf(l0, fmaxf(l1, l2));
        const float w0 = exp2f(l0 - m), w1 = exp2f(l1 - m), w2 = exp2f(l2 - m), inv = 1.f / (w0 + w1 + w2);
        const u32x4 a = *(const u32x4*)(og + (size_t)tok * 768 + c), b = *(const u32x4*)(og + (size_t)tok * 768 + 256 + c), d = *(const u32x4*)(og + (size_t)tok * 768 + 512 + c);
        const f16x8 ha = __builtin_bit_cast(f16x8, a), hb = __builtin_bit_cast(f16x8, b), hd = __builtin_bit_cast(f16x8, d);
        float o[8];
#pragma unroll
        for (int i = 0; i < 8; ++i) o[i] = (w0 * (float)ha[i] + w1 * (float)hb[i] + w2 * (float)hd[i]) * inv;
        u32x4 w; w.x = pk_h2(o[0], o[1]); w.y = pk_h2(o[2], o[3]); w.z = pk_h2(o[4], o[5]); w.w = pk_h2(o[6], o[7]);
        *(u32x4*)(ob + (size_t)tok * 256 + c) = w; }
}
typedef short v4i16_t __attribute__((ext_vector_type(4)));
typedef short s16x8 __attribute__((ext_vector_type(8)));
typedef float f32x16 __attribute__((ext_vector_type(16)));
__device__ __forceinline__ int tk_bin(float sc) { const unsigned u = __float_as_uint(sc); int e = (int)((u >> 16) & 0x7FFFu) - (122 << 7); e = e < 0 ? 0 : (e > 1023 ? 1023 : e); return (u >> 31) ? 1023 - e : 1024 + e; }
__device__ __forceinline__ void tk_scores(const f16x8 (&Af)[2], const float (&wv)[16], f16x8 b0, f16x8 b1, float& sa, float& sb) {
    f32x16 d = {0.f, 0.f, 0.f, 0.f, 0.f, 0.f, 0.f, 0.f, 0.f, 0.f, 0.f, 0.f, 0.f, 0.f, 0.f, 0.f};
    d = __builtin_amdgcn_mfma_f32_32x32x16_f16(Af[0], b0, d, 0, 0, 0); d = __builtin_amdgcn_mfma_f32_32x32x16_f16(Af[1], b1, d, 0, 0, 0);
    f32x2 acc = {0.f, 0.f};
#pragma unroll
    for (int e = 0; e < 16; e += 2) { const int i0 = __float_as_int(d[e]), i1 = __float_as_int(d[e + 1]);
        const f32x2 rl = {__int_as_float(i0 > 0 ? i0 : 0), __int_as_float(i1 > 0 ? i1 : 0)}; const f32x2 w2 = {wv[e], wv[e + 1]};
        acc = __builtin_elementwise_fma(w2, rl, acc); }
    sa = acc.x; sb = acc.y;
}
template <bool P2>
__device__ __forceinline__ void tk_tile(const f16x8 (&Af)[2], const float (&wv)[16], f16x8 b0, f16x8 b1, int tile, int r, int hi, int ta, LAS unsigned* hist, const int (&tbin)[4], int (&cs)[4], int (&cc)[4],
                                        LAS unsigned short* sel, int tok0, unsigned* sscr, unsigned sload = 0u) {
    float sa, sb;
    if constexpr (!P2) { tk_scores(Af, wv, b0, b1, sa, sb); const h16x2 hp = {(h16)sa, (h16)sb}; sa = (float)hp[0]; sb = (float)hp[1]; sscr[tile * 64 + 2 * r + hi] = __builtin_bit_cast(unsigned, hp); }
    else { const h16x2 hp = __builtin_bit_cast(h16x2, sload); sa = (float)hp[0]; sb = (float)hp[1]; }
    const int s = 32 * tile + r;
    if constexpr (!P2) {
        if (s <= ta) { const int bn = tk_bin(sa); __hip_atomic_fetch_add(hist + (2 * hi) * 1024 + (bn >> 1), 1u << (16 * (bn & 1)), __ATOMIC_RELAXED, __HIP_MEMORY_SCOPE_WORKGROUP); }
        if (s <= ta + 1) { const int bn = tk_bin(sb); __hip_atomic_fetch_add(hist + (2 * hi + 1) * 1024 + (bn >> 1), 1u << (16 * (bn & 1)), __ATOMIC_RELAXED, __HIP_MEMORY_SCOPE_WORKGROUP); }
    } else {
        const unsigned lowmask = (1u << r) - 1u;
#pragma unroll
        for (int ab = 0; ab < 2; ++ab) { const float sc = ab ? sb : sa; const int tq = ta + ab; const int bn = tk_bin(sc);
            const int mytb = hi ? tbin[2 + ab] : tbin[ab];
            const bool valid = s <= tq, sure = valid && bn > mytb, cand = valid && bn == mytb;
            const unsigned long long ms = __ballot(sure), mc = __ballot(cand);
            const unsigned ms_h = hi ? (unsigned)(ms >> 32) : (unsigned)ms, mc_h = hi ? (unsigned)(mc >> 32) : (unsigned)mc;
            const int q = 2 * hi + ab;
            const int base_s = hi ? cs[2 + ab] : cs[ab], base_c = hi ? cc[2 + ab] : cc[ab];
            if (sure) sel[q * TOPK + base_s + __builtin_popcount(ms_h & lowmask)] = (unsigned short)s;
            if (cand) { const int pos = base_c + __builtin_popcount(mc_h & lowmask);
                if (pos < 512) ((LAS unsigned long long*)((LAS unsigned char*)hist + q * 4096))[pos] = ((unsigned long long)fkey(sc) << 16) | (unsigned long long)(0xFFFFu - (unsigned)s); }
            cs[ab] += __builtin_popcount((unsigned)ms); cs[2 + ab] += __builtin_popcount((unsigned)(ms >> 32));
            cc[ab] += __builtin_popcount((unsigned)mc); cc[2 + ab] += __builtin_popcount((unsigned)(mc >> 32)); }
    }
}
template <bool P2>
__device__ __forceinline__ void tk_pass(const f16x8 (&Af)[2], const float (&wv)[16], const h16* kbase, int ntiles, int r, int hi, int ta, LAS unsigned* hist, const int (&tbin)[4], int (&cs)[4], int (&cc)[4],
                                        LAS unsigned short* sel, int tok0, unsigned* sscr) {
    if constexpr (P2) {
        const unsigned* sp_ = sscr + 2 * r + hi; unsigned SA[8], SB[8]; const f16x8 z8 = {0, 0, 0, 0, 0, 0, 0, 0};
#define TK_LOADS(dst, t0_) do { _Pragma("unroll") for (int i_ = 0; i_ < 8; ++i_) { const int tt_ = ((t0_) + i_) < 127 ? ((t0_) + i_) : 127; dst[i_] = __builtin_nontemporal_load(sp_ + tt_ * 64); } } while (0)
        TK_LOADS(SA, 0);
        for (int t0 = 0; t0 < ntiles; t0 += 16) {
            TK_LOADS(SB, t0 + 8);
#pragma unroll
            for (int i = 0; i < 8; ++i) if (t0 + i < ntiles) tk_tile<true>(Af, wv, z8, z8, t0 + i, r, hi, ta, hist, tbin, cs, cc, sel, tok0, sscr, SA[i]);
            TK_LOADS(SA, t0 + 16);
#pragma unroll
            for (int i = 0; i < 8; ++i) if (t0 + 8 + i < ntiles) tk_tile<true>(Af, wv, z8, z8, t0 + 8 + i, r, hi, ta, hist, tbin, cs, cc, sel, tok0, sscr, SB[i]);
        }
#undef TK_LOADS
        return; }
    f16x8 BA[4][2], BB[4][2];
#define TK_LOAD(dst, t0_) do { _Pragma("unroll") for (int i_ = 0; i_ < 4; ++i_) { const int tt_ = ((t0_) + i_) < 127 ? ((t0_) + i_) : 127; dst[i_][0] = *(const f16x8*)(kbase + (size_t)tt_ * 1024); dst[i_][1] = *(const f16x8*)(kbase + (size_t)tt_ * 1024 + 16); } } while (0)
    TK_LOAD(BA, 0);
    for (int t0 = 0; t0 < ntiles; t0 += 8) {
        TK_LOAD(BB, t0 + 4);
#pragma unroll
        for (int i = 0; i < 4; ++i) if (t0 + i < ntiles) tk_tile<P2>(Af, wv, BA[i][0], BA[i][1], t0 + i, r, hi, ta, hist, tbin, cs, cc, sel, tok0, sscr);
        TK_LOAD(BA, t0 + 8);
#pragma unroll
        for (int i = 0; i < 4; ++i) if (t0 + 4 + i < ntiles) tk_tile<P2>(Af, wv, BB[i][0], BB[i][1], t0 + 4 + i, r, hi, ta, hist, tbin, cs, cc, sel, tok0, sscr);
    }
#undef TK_LOAD
}
__device__ __forceinline__ void tk_group(const Frame& F, const h16* qi, const h16* ki, const float* wi, LAS unsigned short* sel, int b, int t0, LAS unsigned* hist, unsigned* sscr) {
    int lane_ = F.lane; asm volatile("" : "+v"(lane_)); const int lane = lane_, r = lane & 31, hi = lane >> 5, tok0 = b * SEQ + t0;
    const int qa = 2 * ((r >> 2) & 1) + (r & 1), ha = 4 * (r >> 4) + 2 * ((r >> 3) & 1) + ((r >> 1) & 1);
    f16x8 Af[2];
#pragma unroll
    for (int s_ = 0; s_ < 2; ++s_) Af[s_] = *(const f16x8*)(qi + (size_t)(tok0 + qa) * 256 + ha * 32 + 16 * s_ + 8 * hi);
    float wv[16];
    { const f32x4 a0 = *(const f32x4*)(wi + (tok0 + 2 * hi) * 8), a1 = *(const f32x4*)(wi + (tok0 + 2 * hi) * 8 + 4), b0 = *(const f32x4*)(wi + (tok0 + 2 * hi + 1) * 8), b1 = *(const f32x4*)(wi + (tok0 + 2 * hi + 1) * 8 + 4);
      const float sa[8] = {a0.x, a0.y, a0.z, a0.w, a1.x, a1.y, a1.z, a1.w}, sb[8] = {b0.x, b0.y, b0.z, b0.w, b1.x, b1.y, b1.z, b1.w};
#pragma unroll
      for (int h = 0; h < 8; ++h) { wv[2 * h] = sa[h] * 0.17677669529663687f; wv[2 * h + 1] = sb[h] * 0.17677669529663687f; } }
    const int ntiles = (t0 + 3) / 32 + 1, ta = t0 + 2 * hi;
    const h16* kbase = ki + (size_t)(b * SEQ + r) * 32 + 8 * hi;
    int tbin[4] = {0, 0, 0, 0}, nsure[4], cs[4] = {0, 0, 0, 0}, cc[4] = {0, 0, 0, 0};
#pragma unroll
    for (int i = 0; i < 16; ++i) *(LAS u32x4*)((LAS unsigned char*)hist + i * 1024 + lane * 16) = (u32x4){0u, 0u, 0u, 0u};
    asm volatile("s_waitcnt lgkmcnt(0)" ::: "memory");
    tk_pass<false>(Af, wv, kbase, ntiles, r, hi, ta, hist, tbin, cs, cc, sel, tok0, sscr);
    asm volatile("s_waitcnt vmcnt(0)" ::: "memory");
    asm volatile("s_waitcnt lgkmcnt(0)" ::: "memory");
#pragma unroll
    for (int q = 0; q < 4; ++q) {
        const LAS unsigned* hq = hist + q * 1024;
        unsigned sum = 0;
#pragma unroll
        for (int i = 0; i < 4; ++i) { const u32x4 v = *(const LAS u32x4*)(hq + 16 * lane + 4 * i); sum += (v.x & 0xFFFFu) + (v.x >> 16) + (v.y & 0xFFFFu) + (v.y >> 16) + (v.z & 0xFFFFu) + (v.z >> 16) + (v.w & 0xFFFFu) + (v.w >> 16); }
        unsigned incl = sum;
#pragma unroll
        for (int o = 1; o < 64; o <<= 1) { const unsigned v = __shfl_down(incl, o); if (lane + o < 64) incl += v; }
        const unsigned long long bal = __ballot(incl >= (unsigned)TOPK);
        const int L = 63 - __builtin_clzll(bal);
        unsigned cum = __shfl(incl, L) - __shfl(sum, L);
        int tbq = 32 * L, found = 0;
        for (int wd = 15; wd >= 0 && !found; --wd) { const unsigned v = hq[16 * L + wd];
            const unsigned chi = v >> 16, clo = v & 0xFFFFu;
            if (cum + chi >= (unsigned)TOPK) { tbq = 32 * L + 2 * wd + 1; found = 1; } else { cum += chi;
                if (cum + clo >= (unsigned)TOPK) { tbq = 32 * L + 2 * wd; found = 1; } else cum += clo; } }
        tbin[q] = tbq; nsure[q] = (int)cum;
    }
    asm volatile("s_waitcnt lgkmcnt(0)" ::: "memory");
    tk_pass<true>(Af, wv, kbase, ntiles, r, hi, ta, hist, tbin, cs, cc, sel, tok0, sscr);
    asm volatile("s_waitcnt lgkmcnt(0)" ::: "memory");
#pragma unroll
    for (int q = 0; q < 4; ++q) {
        const int nc = cc[q] < 512 ? cc[q] : 512, need = TOPK - cs[q];
        const LAS unsigned long long* cq = (const LAS unsigned long long*)((const LAS unsigned char*)hist + q * 4096);
        if (nc > 64) {
            unsigned long long it[8];
#pragma unroll
            for (int k = 0; k < 8; ++k) it[k] = (k * 64 + lane < nc) ? cq[k * 64 + lane] : 0ull;
            unsigned long long T = 0ull;
            for (int bit = 47; bit >= 0; --bit) { const unsigned long long cand = T | (1ull << bit); int cnt = 0;
#pragma unroll
                for (int k = 0; k < 8; ++k) cnt += __builtin_popcountll(__ballot(it[k] >= cand));
                if (cnt >= need) T = cand; }
            int basep = cs[q];
#pragma unroll
            for (int k = 0; k < 8; ++k) { const bool pick = (T != 0ull) && it[k] >= T; const unsigned long long mk = __ballot(pick);
                if (pick) sel[q * TOPK + basep + __builtin_popcountll(mk & ((1ull << lane) - 1ull))] = (unsigned short)(0xFFFFu - (unsigned)(it[k] & 0xFFFFull));
                basep += __builtin_popcountll(mk); }
        } else
        for (int base = 0; base < nc; base += 64) {
            const bool act = base + lane < nc; const unsigned long long my = act ? cq[base + lane] : 0ull; int rank = 0;
            for (int jb = 0; jb < nc; jb += 64) {
                const unsigned long long cj = (jb + lane < nc) ? cq[jb + lane] : 0ull; const unsigned clo = (unsigned)cj, chi = (unsigned)(cj >> 32);
                const int n = (nc - jb) < 64 ? (nc - jb) : 64;
                for (int j = 0; j < n; ++j) { const unsigned long long sj = ((unsigned long long)(unsigned)__builtin_amdgcn_readlane((int)chi, j) << 32) | (unsigned)__builtin_amdgcn_readlane((int)clo, j); rank += (sj > my) ? 1 : 0; } }
            if (act && rank < need) sel[q * TOPK + cs[q] + rank] = (unsigned short)(0xFFFFu - (unsigned)(my & 0xFFFFull)); }
    }
    (void)nsure;
    asm volatile("s_waitcnt lgkmcnt(0)" ::: "memory");
}

__device__ __forceinline__ void ph_dilated_mfma(const Frame& F, const h16* qb, const h16* kb, const h16* vb, h16* og, float* lse2) {
    const int lane0 = F.lane;
    LAS unsigned char* VL = F.lds + F.wave * 16384;
    LAS float* linv = (LAS float*)(VL + 12288);
    constexpr int VROW = 192;
    for (int u = F.gw; u < NB * 12 * 128; u += F.NGW) {
        int lane = lane0; asm volatile("" : "+v"(lane));
        const int ql = lane & 31, hi = lane >> 5, trq = (lane & 15) >> 2, trp = lane & 3, trg = (lane >> 4) & 1;
        const int b = u / 1536, rem = u % 1536, gh = rem >> 7, g = gh >> 2, wi_ = rem & 127, dil = dil_of(g), sh = g == 0 ? 0 : (g == 1 ? 2 : 4);
        const int nblk = 128 >> sh, res = wi_ / nblk, j0 = 32 * (wi_ % nblk);
        const size_t hoff = (size_t)b * SEQ * 768 + gh * 64;
        f16x8 Qf[4];
        { const h16* qp = qb + hoff + (size_t)((j0 + ql) * dil + res) * 768 + 8 * hi;
#pragma unroll
          for (int s_ = 0; s_ < 4; ++s_) Qf[s_] = *(const f16x8*)(qp + 16 * s_); }
        f32x16 S[5];
        f16x8 Kf[5][4];
#pragma unroll
        for (int kt = 0; kt < 5; ++kt) { int jk = j0 - 128 + 32 * kt + ql; jk = jk < 0 ? 0 : jk;
            const h16* kp = kb + hoff + (size_t)(jk * dil + res) * 768 + 8 * hi;
#pragma unroll
            for (int s_ = 0; s_ < 4; ++s_) Kf[kt][s_] = *(const f16x8*)(kp + 16 * s_); }
#pragma unroll
        for (int kt = 0; kt < 5; ++kt) {
            f32x16 d = {0.f, 0.f, 0.f, 0.f, 0.f, 0.f, 0.f, 0.f, 0.f, 0.f, 0.f, 0.f, 0.f, 0.f, 0.f, 0.f};
#pragma unroll
            for (int s_ = 0; s_ < 4; ++s_) d = __builtin_amdgcn_mfma_f32_32x32x16_f16(Kf[kt][s_], Qf[s_], d, 0, 0, 0);
            S[kt] = d; }
        f16x8 Vr[5][4];
#pragma unroll
        for (int kt = 0; kt < 5; ++kt) { int jk = j0 - 128 + 32 * kt + (lane >> 1); jk = jk < 0 ? 0 : jk;
            const h16* vp = vb + hoff + (size_t)(jk * dil + res) * 768 + (lane & 1) * 32;
#pragma unroll
            for (int i = 0; i < 4; ++i) Vr[kt][i] = *(const f16x8*)(vp + 8 * i); }
        float m = -INFINITY;
#pragma unroll
        for (int kt = 0; kt < 5; ++kt)
#pragma unroll
            for (int e = 0; e < 16; ++e) { const int kl = (e & 3) + 8 * (e >> 2) + 4 * hi; bool ok = (j0 - 128 + 32 * kt + kl) >= 0;
                if (kt == 0) ok = ok && (kl >= ql); if (kt == 4) ok = ok && (kl <= ql);
                if (!ok) S[kt][e] = -INFINITY; m = fmaxf(m, S[kt][e]); }
        m = max_x32(m);
        float l = 0.f;
#pragma unroll
        for (int kt = 0; kt < 5; ++kt)
#pragma unroll
            for (int e = 0; e < 16; ++e) { const float p = __builtin_amdgcn_exp2f(S[kt][e] - m); S[kt][e] = p; l += p; }
        l = sum_x32(l);
        if (hi == 0) { linv[ql] = __builtin_amdgcn_rcpf(l); lse2[(size_t)(b * SEQ + (j0 + ql) * dil + res) * 12 + gh] = m + __builtin_amdgcn_logf(l); }
        f32x16 O[2];
#pragma unroll
        for (int dt = 0; dt < 2; ++dt) O[dt] = (f32x16){0.f, 0.f, 0.f, 0.f, 0.f, 0.f, 0.f, 0.f, 0.f, 0.f, 0.f, 0.f, 0.f, 0.f, 0.f, 0.f};
#pragma unroll
        for (int kt = 0; kt < 5; ++kt) {
            LAS unsigned char* vbuf = VL + (kt & 1) * 6144;
#pragma unroll
            for (int i = 0; i < 4; ++i) *(LAS f16x8*)(vbuf + (lane >> 1) * VROW + (lane & 1) * 64 + i * 16) = Vr[kt][i];
            asm volatile("s_waitcnt lgkmcnt(0)" ::: "memory");
#pragma unroll
            for (int s2 = 0; s2 < 2; ++s2) {
                u32x4 pa; pa.x = pk_h2(S[kt][8 * s2 + 0], S[kt][8 * s2 + 1]); pa.y = pk_h2(S[kt][8 * s2 + 2], S[kt][8 * s2 + 3]); pa.z = pk_h2(S[kt][8 * s2 + 4], S[kt][8 * s2 + 5]); pa.w = pk_h2(S[kt][8 * s2 + 6], S[kt][8 * s2 + 7]);
#pragma unroll
                for (int dt = 0; dt < 2; ++dt) {
                    const v4i16_t lo = __builtin_amdgcn_ds_read_tr16_b64_v4i16((LAS v4i16_t*)(vbuf + (16 * s2 + 4 * hi + trq) * VROW + (32 * dt + 16 * trg + 4 * trp) * 2));
                    const v4i16_t hh = __builtin_amdgcn_ds_read_tr16_b64_v4i16((LAS v4i16_t*)(vbuf + (16 * s2 + 8 + 4 * hi + trq) * VROW + (32 * dt + 16 * trg + 4 * trp) * 2));
                    const s16x8 bv = {lo[0], lo[1], lo[2], lo[3], hh[0], hh[1], hh[2], hh[3]};
                    O[dt] = __builtin_amdgcn_mfma_f32_32x32x16_f16(__builtin_bit_cast(f16x8, pa), __builtin_bit_cast(f16x8, bv), O[dt], 0, 0, 0); } }
            asm volatile("s_waitcnt lgkmcnt(0)" ::: "memory");
        }
#pragma unroll
        for (int e = 0; e < 16; ++e) { const int q = (e & 3) + 8 * (e >> 2) + 4 * hi; const float il = linv[q];
            *(LAS h16*)(VL + q * 144 + ql * 2) = (h16)(O[0][e] * il); *(LAS h16*)(VL + q * 144 + 64 + ql * 2) = (h16)(O[1][e] * il); }
        asm volatile("s_waitcnt lgkmcnt(0)" ::: "memory");
#pragma unroll
        for (int r_ = 0; r_ < 4; ++r_) { int l2 = ql + 32 * hi; asm volatile("" : "+v"(l2)); const int P = r_ * 64 + l2, q = P >> 3, p8 = P & 7; const u32x4 v = *(const LAS u32x4*)(VL + q * 144 + p8 * 16);
            *(u32x4*)(og + (size_t)(b * SEQ + (j0 + q) * dil + res) * 768 + gh * 64 + p8 * 8) = v; asm volatile("" ::: "memory"); }
        asm volatile("s_waitcnt lgkmcnt(0)" ::: "memory");
    }
}


__device__ __forceinline__ f16x8 fp8x8_to_f16(unsigned w0, unsigned w1) {
    const h16x2 a = __builtin_amdgcn_cvt_scalef32_pk_f16_fp8((int)w0, 1.0f, false), b = __builtin_amdgcn_cvt_scalef32_pk_f16_fp8((int)w0, 1.0f, true),
                c = __builtin_amdgcn_cvt_scalef32_pk_f16_fp8((int)w1, 1.0f, false), d = __builtin_amdgcn_cvt_scalef32_pk_f16_fp8((int)w1, 1.0f, true);
    const u32x4 r = {__builtin_bit_cast(unsigned, a), __builtin_bit_cast(unsigned, b), __builtin_bit_cast(unsigned, c), __builtin_bit_cast(unsigned, d)};
    return __builtin_bit_cast(f16x8, r);
}
typedef int i32x2_t __attribute__((ext_vector_type(2)));
template <bool FUSED>
__device__ __forceinline__ void ph_sparse_wave(const Frame& F, h16* qlat, const h16* qr, const unsigned char* ckv8, const unsigned char* kr8, const LAS unsigned short* selL, int ta = 0) {
    int lane = F.lane; asm volatile("" : "+v"(lane));
    LAS unsigned char* V = F.lds + F.wave * 16384;
    const int tr_r = (lane & 15) >> 1, tr_c = lane & 1, tr_key = (tr_r < 4) ? (4 * (lane >> 4) + tr_r) : (16 + 4 * (lane >> 4) + tr_r - 4);
    const int tr0 = tr_key * 256 + 8 * tr_c, x0 = (tr_key & 15) ^ ((tr_key >> 4) << 3);
    const int lane0 = lane;
    const int nit = 4;
    for (int it = 0; it < nit; ++it) {
        const int tok = ta + it;
        int ll = lane0; asm volatile("" : "+v"(ll));
        const int c = ll & 15, kq = ll >> 4, hd = c & 7;
        const int b = tok / SEQ, t = tok % SEQ, cnt = (t + 1 < TOPK) ? t + 1 : TOPK, nch = (cnt + 31) >> 5;
        const LAS unsigned short* sp = selL + it * TOPK + c;
        u32x4 Q8[4]; f16x8 Qr;
#pragma unroll
        for (int q4 = 0; q4 < 4; ++q4) { const f16x8 lo = *(const f16x8*)(qlat + (size_t)tok * 2048 + hd * 256 + 64 * q4 + 16 * kq), hi = *(const f16x8*)(qlat + (size_t)tok * 2048 + hd * 256 + 64 * q4 + 16 * kq + 8);
            Q8[q4].x = pk_f8x4((float)lo[0] * 64.f, (float)lo[1] * 64.f, (float)lo[2] * 64.f, (float)lo[3] * 64.f); Q8[q4].y = pk_f8x4((float)lo[4] * 64.f, (float)lo[5] * 64.f, (float)lo[6] * 64.f, (float)lo[7] * 64.f);
            Q8[q4].z = pk_f8x4((float)hi[0] * 64.f, (float)hi[1] * 64.f, (float)hi[2] * 64.f, (float)hi[3] * 64.f); Q8[q4].w = pk_f8x4((float)hi[4] * 64.f, (float)hi[5] * 64.f, (float)hi[6] * 64.f, (float)hi[7] * 64.f); }
        { const f16x8 q0 = *(const f16x8*)(qr + (size_t)tok * 256 + hd * 32 + 8 * kq);
#pragma unroll
          for (int i = 0; i < 8; ++i) Qr[i] = q0[i] * (h16)64.f; }
        const i32x8 Qa = __builtin_shufflevector(__builtin_bit_cast(i32x4, Q8[0]), __builtin_bit_cast(i32x4, Q8[1]), 0, 1, 2, 3, 4, 5, 6, 7), Qb = __builtin_shufflevector(__builtin_bit_cast(i32x4, Q8[2]), __builtin_bit_cast(i32x4, Q8[3]), 0, 1, 2, 3, 4, 5, 6, 7);
        u32x4 KrA[2][4], KrB[2][4]; u32x2 RrA[2], RrB[2];
#define SW_LOADK(KR, RR, CH) do { const int r0_ = b * SEQ + (int)sp[32 * (CH)], r1_ = b * SEQ + (int)sp[32 * (CH) + 16]; \
        const unsigned char* p0_ = ckv8 + (size_t)r0_ * 256 + 16 * kq; const unsigned char* p1_ = ckv8 + (size_t)r1_ * 256 + 16 * kq; const unsigned char* p2_ = kr8 + (size_t)r0_ * 32 + 8 * kq; const unsigned char* p3_ = kr8 + (size_t)r1_ * 32 + 8 * kq; \
        asm volatile("global_load_dwordx4 %0, %8, off\n\tglobal_load_dwordx4 %1, %8, off offset:64\n\tglobal_load_dwordx4 %2, %8, off offset:128\n\tglobal_load_dwordx4 %3, %8, off offset:192\n\t" \
                     "global_load_dwordx4 %4, %9, off\n\tglobal_load_dwordx4 %5, %9, off offset:64\n\tglobal_load_dwordx4 %6, %9, off offset:128\n\tglobal_load_dwordx4 %7, %9, off offset:192" \
                     : "=&v"(KR[0][0]), "=&v"(KR[0][1]), "=&v"(KR[0][2]), "=&v"(KR[0][3]), "=&v"(KR[1][0]), "=&v"(KR[1][1]), "=&v"(KR[1][2]), "=&v"(KR[1][3]) : "v"(p0_), "v"(p1_) : "memory"); \
        asm volatile("global_load_dwordx2 %0, %2, off\n\tglobal_load_dwordx2 %1, %3, off" : "=&v"(RR[0]), "=&v"(RR[1]) : "v"(p2_), "v"(p3_) : "memory"); } while (0)
#define SW_WAITK(KR, RR, N) asm volatile("s_waitcnt vmcnt(" #N ")" : "+v"(KR[0][0]), "+v"(KR[0][1]), "+v"(KR[0][2]), "+v"(KR[0][3]), "+v"(KR[1][0]), "+v"(KR[1][1]), "+v"(KR[1][2]), "+v"(KR[1][3]), "+v"(RR[0]), "+v"(RR[1]) :: "memory")
        asm volatile("s_waitcnt vmcnt(0)" ::: "memory");
        SW_LOADK(KrA, RrA, 0);
        SW_LOADK(KrB, RrB, 1);
        float m = -INFINITY, l = 0.f;
        f32x4 O[16];
#pragma unroll
        for (int ft = 0; ft < 16; ++ft) O[ft] = (f32x4){0.f, 0.f, 0.f, 0.f};
#define SW_CHUNK(KR, RR, CH, NWAIT, LOADNEXT) do { \
            LAS unsigned char* Vb = V + ((CH) & 1) * 8192; \
            SW_WAITK(KR, RR, NWAIT); \
            _Pragma("unroll") for (int tl = 0; tl < 2; ++tl) _Pragma("unroll") for (int q4 = 0; q4 < 4; ++q4) *(LAS u32x4*)(Vb + (16 * tl + c) * 256 + (((4 * q4 + kq) ^ (c ^ (8 * tl))) << 4)) = KR[tl][q4]; \
            f32x4 S[2]; \
            _Pragma("unroll") for (int tl = 0; tl < 2; ++tl) { \
                const i32x8 Ka = __builtin_shufflevector(__builtin_bit_cast(i32x4, KR[tl][0]), __builtin_bit_cast(i32x4, KR[tl][1]), 0, 1, 2, 3, 4, 5, 6, 7), Kb = __builtin_shufflevector(__builtin_bit_cast(i32x4, KR[tl][2]), __builtin_bit_cast(i32x4, KR[tl][3]), 0, 1, 2, 3, 4, 5, 6, 7); \
                S[tl] = __builtin_amdgcn_mfma_scale_f32_16x16x128_f8f6f4(Ka, Qa, (f32x4){0.f, 0.f, 0.f, 0.f}, 0, 0, 0, 0, 0, 0); \
                S[tl] = __builtin_amdgcn_mfma_scale_f32_16x16x128_f8f6f4(Kb, Qb, S[tl], 0, 0, 0, 0, 0, 0); \
                S[tl] = __builtin_amdgcn_mfma_f32_16x16x32_f16(fp8x8_to_f16(RR[tl].x, RR[tl].y), Qr, S[tl], 0, 0, 0); } \
            asm volatile("" : "+v"(S[0]), "+v"(S[1]));                        \
            asm volatile("s_waitcnt lgkmcnt(0)" ::: "memory");               \
            if (LOADNEXT) SW_LOADK(KR, RR, (CH) + 2); \
            float cm = -INFINITY; \
            _Pragma("unroll") for (int tl = 0; tl < 2; ++tl) _Pragma("unroll") for (int e = 0; e < 4; ++e) { S[tl][e] = (32 * (CH) + 16 * tl + 4 * kq + e >= cnt) ? -INFINITY : S[tl][e] * (1.f / 64.f); cm = fmaxf(cm, S[tl][e]); } \
            cm = max_x16(cm); cm = max_x32(cm); \
              \
            if (__any(cm > m + 4.0f)) { const float mn = fmaxf(m, cm), alpha = __builtin_amdgcn_exp2f(m - mn); m = mn; l *= alpha; \
                _Pragma("unroll") for (int ft = 0; ft < 16; ++ft) O[ft] = O[ft] * alpha; } \
            float pe[2][4]; float ps = 0.f; \
            _Pragma("unroll") for (int tl = 0; tl < 2; ++tl) _Pragma("unroll") for (int e = 0; e < 4; ++e) { pe[tl][e] = __builtin_amdgcn_exp2f(S[tl][e] - m); ps += pe[tl][e]; } \
            l += ps; \
            u32x2 pk; pk.x = pk_f8x4(pe[0][0] * 16.f, pe[0][1] * 16.f, pe[0][2] * 16.f, pe[0][3] * 16.f); pk.y = pk_f8x4(pe[1][0] * 16.f, pe[1][1] * 16.f, pe[1][2] * 16.f, pe[1][3] * 16.f); \
            const long Pf = __builtin_bit_cast(long, pk); \
            _Pragma("unroll") for (int ft = 0; ft < 16; ++ft) { \
                const i32x2_t av = __builtin_amdgcn_ds_read_tr8_b64_v2i32((LAS i32x2_t*)(Vb + tr0 + ((ft ^ x0) << 4))); \
                O[ft] = __builtin_amdgcn_mfma_f32_16x16x32_fp8_fp8(__builtin_bit_cast(long, av), Pf, O[ft], 0, 0, 0); } } while (0)
        for (int ch = 0; ch < 6; ch += 2) {
            SW_CHUNK(KrA, RrA, ch, 10, true);
            SW_CHUNK(KrB, RrB, ch + 1, 10, true);
        }
        SW_CHUNK(KrA, RrA, 6, 10, false);
        SW_CHUNK(KrB, RrB, 7, 0, false);
#undef SW_CHUNK
#undef SW_WAITK
        asm volatile("s_waitcnt lgkmcnt(0)" ::: "memory");
        l = sum_x16(l); l = sum_x32(l);
        if (c < 8) { const float il = __builtin_amdgcn_rcpf(l) * (1.f / 16.f);
#pragma unroll
            for (int ft = 0; ft < 16; ++ft) { const f32x4 o = O[ft] * il; u32x2 pk; pk.x = pk_h2(o.x, o.y); pk.y = pk_h2(o.z, o.w);
                *(LAS u32x2*)(V + c * 512 + ((4 * (ft ^ c) + kq) << 3)) = pk; } }
        asm volatile("s_waitcnt lgkmcnt(0)" ::: "memory");
        { u32x4 ov[4];
#pragma unroll
          for (int r_ = 0; r_ < 4; ++r_) { const int P = r_ * 64 + ll, h = P >> 5, p = P & 31; ov[r_] = *(const LAS u32x4*)(V + h * 512 + ((p ^ (2 * h)) << 4)); }
#pragma unroll
          for (int r_ = 0; r_ < 4; ++r_) *(u32x4*)(qlat + (size_t)tok * 2048 + (r_ * 64 + ll) * 8) = ov[r_]; }
        asm volatile("s_waitcnt lgkmcnt(0)" ::: "memory");
#undef SW_LOADK
    }
}


__device__ __forceinline__ void precomb_tiles(const Frame& F, const Args& args, unsigned char* ws, int t_lo, int t_hi, int wg, int nwg) {
    LAS float* As = (LAS float*)(F.lds); LAS float* Bs = (LAS float*)(F.lds + 64 * 65 * 4);
    for (int tl = t_lo + wg; tl < t_hi; tl += nwg) {
        __syncthreads();
        const bool ql = tl < 192; int hd, rb, xb;
        if (ql) { hd = tl / 24; rb = (tl % 24) / 6; xb = tl % 6; } else { const int t2 = tl - 192; hd = t2 / 64; rb = (t2 % 64) / 16; xb = t2 % 16; }
#pragma unroll
        for (int k = 0; k < 2; ++k) { const int i4 = F.tid + NTHR * k, row = i4 >> 4, c4 = (i4 & 15) * 4;
            if (ql) { const f32x4 a = *(const f32x4*)(args.in[15] + (size_t)(rb * 64 + row) * 512 + hd * 64 + c4), bq = *(const f32x4*)(args.in[14] + (size_t)(xb * 64 + row) * 768 + hd * 96 + c4);
#pragma unroll
                for (int e = 0; e < 4; ++e) { As[row * 65 + c4 + e] = a[e]; Bs[row * 65 + c4 + e] = bq[e]; } }
            else { const f32x4 a = *(const f32x4*)(args.in[18] + (size_t)(hd * 64 + row) * DM + xb * 64 + c4), bq = *(const f32x4*)(args.in[16] + (size_t)(rb * 64 + row) * 512 + hd * 64 + c4);
#pragma unroll
                for (int e = 0; e < 4; ++e) { As[(c4 + e) * 65 + row] = a[e]; Bs[row * 65 + c4 + e] = bq[e]; } } }
        __syncthreads();
        const int j = F.tid & 63, ig = F.wave;
        float acc8[8];
#pragma unroll
        for (int ii = 0; ii < 8; ++ii) acc8[ii] = 0.f;
#pragma unroll 4
        for (int v = 0; v < 64; ++v) { const float bv = Bs[j * 65 + v];
#pragma unroll
            for (int ii = 0; ii < 8; ++ii) acc8[ii] += As[(ig * 8 + ii) * 65 + v] * bv; }
        if (ql) { const float gj = args.in[12][xb * 64 + j]; h16* o = (h16*)(ws + OW_4);
#pragma unroll
            for (int ii = 0; ii < 8; ++ii) o[(size_t)(hd * 256 + rb * 64 + ig * 8 + ii) * QL + xb * 64 + j] = (h16)(acc8[ii] * gj); }
        else { h16* o = (h16*)(ws + OW_OV);
#pragma unroll
            for (int ii = 0; ii < 8; ++ii) o[(size_t)(xb * 64 + ig * 8 + ii) * 2048 + hd * 256 + rb * 64 + j] = (h16)acc8[ii]; }
    }
    __syncthreads();
}


__device__ __forceinline__ void ph_topk_sparse(const Frame& F, const h16* qi, const h16* ki, const float* wi, h16* qlat, const h16* qr, const unsigned char* ckv8, const unsigned char* kr8, unsigned char* ws, unsigned char* dout) {
    LAS unsigned* hist = (LAS unsigned*)(F.lds + F.wave * 16384);
    LAS unsigned short* selL = (LAS unsigned short*)(F.lds + SELL_OFF + F.wave * 2048);
    unsigned* sscr = (unsigned*)(F.gw < 1024 ? ws + OFF_H + (size_t)F.gw * 32768 : (F.gw < 1760 ? ws + OFF_F + 41 * MiB + (size_t)(F.gw - 1024) * 32768 : dout + 48 * MiB + (size_t)(F.gw - 1760) * 32768));
    for (int p = F.gw; p < 2048; p += F.NGW) {
        int b, ga, gb;
        if (p < 4 * 448) { b = p & 3; const int pj = p >> 2; ga = 64 + pj; gb = 959 - pj; }
        else { const int q_ = p - 4 * 448; b = q_ & 3; ga = 960 + (q_ >> 2); gb = q_ >> 2; }
        tk_group(F, qi, ki, wi, selL, b, 4 * ga, hist, sscr);
        asm volatile("s_waitcnt lgkmcnt(0)" ::: "memory");
        ph_sparse_wave<true>(F, qlat, qr, ckv8, kr8, selL, b * SEQ + 4 * ga);
        asm volatile("s_waitcnt lgkmcnt(0)" ::: "memory");
        if (gb >= 64) tk_group(F, qi, ki, wi, selL, b, 4 * gb, hist, sscr);
        else { int l0 = F.lane; asm volatile("" : "+v"(l0));
            for (int i = l0; i < 4 * TOPK; i += 64) { const int q = i >> 8, k = i & 255; selL[i] = (unsigned short)(k <= 4 * gb + q ? k : 0); } }
        asm volatile("s_waitcnt lgkmcnt(0)" ::: "memory");
        ph_sparse_wave<true>(F, qlat, qr, ckv8, kr8, selL, b * SEQ + 4 * gb);
        asm volatile("s_waitcnt lgkmcnt(0)" ::: "memory");
    }
}

__global__ void __launch_bounds__(NTHR, 2) mega_fwd(Args args) {
    extern __shared__ __attribute__((aligned(16))) unsigned char lds_raw[];
    Frame F; F.lds = (LAS unsigned char*)lds_raw; F.tid = threadIdx.x; F.lane = F.tid & 63; F.wave = __builtin_amdgcn_readfirstlane(F.tid >> 6);
    F.G = gridDim.x; F.gw = blockIdx.x * NWAVES + F.wave; F.NGW = F.G * NWAVES;
    volatile LAS unsigned* MISC = (volatile LAS unsigned*)(F.lds + MISC_OFF);
    unsigned char* ws = args.ws;
    for (int u = F.tid; u < (LDS_BYTES - LDSCTL_OFF) / 4; u += NTHR) ((LAS unsigned*)(F.lds + LDSCTL_OFF))[u] = 0u;
    __syncthreads();
    XcdBarrier bar = xcd_barrier_post((unsigned*)(ws + OFF_CTL) + CW_BAR, MISC + 8, F.wave);
    const int lo = args.ph_lo, hi = args.ph_hi;
#define IN(k) (lo <= (k) && (k) < hi)
#define SEAM(k) do { if (IN(k) && IN((k) + 1)) xcd_barrier(bar); F.lane = flane(); F.tid = F.wave * 64 + F.lane; } while (0)
    float* mod = (float*)(ws + OFF_MOD); float2* tab = (float2*)(ws + OFF_ROPE);
    h16* Hb = (h16*)(ws + OFF_H); h16* Ab = (h16*)(ws + OFF_A); float* Fb = (float*)(ws + OFF_F);

    if (IN(0)) {
        LAS float* scr = (LAS float*)(F.lds + F.wave * 16384);
        for (int ch = blockIdx.x; ch < (NMOD * DM) / 36; ch += F.G) {
            LAS float* sl = (LAS float*)(F.lds);
            LAS f32x4* part = (LAS f32x4*)(F.lds + 16384);
            __syncthreads();
            for (int i = F.tid; i < 4 * DM; i += NTHR) sl[i] = silu_f(args.in[1][i]);
            __syncthreads();
            const int r7 = F.lane / 9, c4 = F.lane - 9 * r7; const bool act = F.lane < 63;
            const float* wm = args.in[3] + (size_t)(F.wave * 128 + r7) * (NMOD * DM) + ch * 36 + 4 * c4;
            f32x4 wv[19];
#pragma unroll
            for (int i = 0; i < 19; ++i) { const bool ok = act && (7 * i + r7 < 128); wv[i] = *(const f32x4*)(wm + (size_t)(ok ? 7 * i : 0) * (NMOD * DM)); }
            f32x4 a0 = {0.f, 0.f, 0.f, 0.f}, a1 = a0, a2 = a0, a3 = a0;
#pragma unroll
            for (int i = 0; i < 19; ++i) { const bool ok = act && (7 * i + r7 < 128); const int kk = F.wave * 128 + (ok ? 7 * i + r7 : 0); const f32x4 w = ok ? wv[i] : (f32x4){0.f, 0.f, 0.f, 0.f};
                a0 += w * sl[kk]; a1 += w * sl[DM + kk]; a2 += w * sl[2 * DM + kk]; a3 += w * sl[3 * DM + kk]; }
            if (act) { LAS f32x4* pp = part + ((F.wave * 7 + r7) * 4) * 9 + c4; pp[0] = a0; pp[9] = a1; pp[18] = a2; pp[27] = a3; }
            __syncthreads();
            if (F.tid < 144) { const int b = F.tid / 36, l = F.tid - 36 * b; float sm = args.in[4][ch * 36 + l]; const LAS float* pf = (const LAS float*)part + (b * 9) * 4 + l;
#pragma unroll 8
                for (int w = 0; w < 56; ++w) sm += pf[w * 144];
                mod[b * (NMOD * DM) + ch * 36 + l] = sm; }
            __syncthreads();
        }
        for (int idx = blockIdx.x * NTHR + F.tid; idx < MT * 48; idx += F.G * NTHR) { const int tok = idx / 48, i = idx % 48;
            const float inv = (i < 32) ? powf(10000.f, -(float)i / 32.f) : powf(10000.f, -(float)(i - 32) / 16.f);
            const float ang = (float)((const int*)args.in[2])[tok] * inv; float sn, cs; sincosf(ang, &sn, &cs); tab[idx] = make_float2(cs, sn); }
        tr_job_mapped(F, args, 0, 2 * FF, 0, DM, ws + OW_GU1, nullptr, scr, 0);
        if (F.G != 256) {
            tr_job_plain(F, args.in[8], DM, DM, FF, ws + OW_D1, scr, 768);
            tr_job_mapped(F, args, 2, NIN3, 0, DM, (h16*)(ws + OW_IN), nullptr, scr, 128);
            tr_job_plain(F, args.in[11] + C_GATE, DIN, 2048, DM, ws + OW_GATE, scr, 1664);
            tr_job_mapped(F, args, 3, 512, 2048, QL, (h16*)(ws + OW_4), args.in[12], scr, 640);
            tr_job_plain(F, args.in[19], DM, DM, 256, (h16*)(ws + OW_UPB), scr, 736);
            tr_job_plain(F, args.in[20], DM, DM, DM, (h16*)(ws + OW_O), scr, 864);
            tr_job_mapped(F, args, 1, 2 * FF, 0, DM, ws + OW_GU2, nullptr, scr, 1376);
            tr_job_plain(F, args.in[25], DM, DM, FF, ws + OW_D2, scr, 96);
            precomb_tiles(F, args, ws, 0, 192, (int)blockIdx.x, F.G);
            tr_job_plain(F, args.in[18], DM, DM, 512, (h16*)(ws + OW_UPA), scr, 256);
        }
    }
    SEAM(0);
    if (IN(1)) ph_normmod(F, args.in[0], args.in[5], mod, 1, 0, ws + OFF_H);
    SEAM(1);
    if (IN(2)) { pg8::Gemm g{Hb, (const h16*)(ws + OW_GU1), MT, 2 * FF, DM / 2}; pg8::StaticOrder S; S.init(MT, 2 * FF, F.G, (int)blockIdx.x); pg8::EpiSwiGLU_T<true> E{Ab};
        pg8::gemm_phase<pg8::EpiSwiGLU_T<true>, true, true>(F.lds, g, S, E, F.wave);
        if (F.G == 256 && blockIdx.x >= 128) {
            Frame F2 = F; F2.gw = ((int)blockIdx.x - 128) * NWAVES + F.wave; F2.NGW = 128 * NWAVES; LAS float* scr = (LAS float*)(F.lds + F.wave * 16384);
            tr_job_plain(F2, args.in[8], DM, DM, FF, ws + OW_D1, scr, 0);
            tr_job_mapped(F2, args, 2, NIN3, 0, DM, (h16*)(ws + OW_IN), nullptr, scr, 384);
            tr_job_mapped(F2, args, 3, 512, 2048, QL, (h16*)(ws + OW_4), args.in[12], scr, 896);
            precomb_tiles(F, args, ws, 0, 192, (int)blockIdx.x - 128, 128);
            for (int i = ((int)blockIdx.x - 128) * NTHR + F.tid; i < (int)(MiB / 16); i += 128 * NTHR) ((u32x4*)(ws + OW_BD))[i] = (u32x4){0u, 0u, 0u, 0u}; } }
    SEAM(2);
    if (IN(3)) { pg8::Gemm g{Ab, (const h16*)(ws + OW_D1), MT, DM, FF / 2}; pg8::StaticOrder S; S.init(MT, DM, F.G, (int)blockIdx.x); pg8::EpiH16_T<true> E{(h16*)Fb};
        pg8::gemm_phase<pg8::EpiH16_T<true>, false, true>(F.lds, g, S, E, F.wave); }
    SEAM(3);
    if (IN(4)) ph_resnorm<false, true>(F, args.in[0], (const h16*)Fb, args.in[9], mod, 2, 0.5f, args.out, true, args.in[10], 4, 3, Hb, (unsigned char*)args.out + 32 * MiB);
    SEAM(4);
    if (IN(5)) { pg8::Gemm g{Hb, (const h16*)(ws + OW_IN), MT, NIN3, DM}; pg8::StaticOrder S; S.init(MT, NIN3, F.G, (int)blockIdx.x);
        pg8::EpiIn E{(h16*)(ws + OFF_CKV), (h16*)(ws + OFF_CQ), (h16*)(ws + OFF_KR), (h16*)(ws + OFF_KI), (h16*)(ws + OFF_QB), (h16*)(ws + OFF_KB), (h16*)(ws + OFF_VT), (float*)(ws + OFF_WI), (float*)(ws + OFF_SSQ),
                     args.in[13], tab, (LAS float*)(F.lds + XCH_OFF)};
        pg8::gemm_phase<pg8::EpiIn, true>(F.lds, g, S, E, F.wave); }
    SEAM(5);
    if (IN(6)) { for (int tk_ = blockIdx.x * NTHR + F.tid; tk_ < MT; tk_ += F.G * NTHR) { const f32x4 s0 = *(const f32x4*)((const float*)(ws + OFF_SSQ) + tk_ * 8), s1 = *(const f32x4*)((const float*)(ws + OFF_SSQ) + tk_ * 8 + 4);
            ((float*)(ws + OFF_RSTDQ))[tk_] = rsqrtf((((s0.x + s0.y) + (s0.z + s0.w)) + ((s1.x + s1.y) + (s1.z + s1.w))) * (1.f / QL) + EPS); } }
    if (IN(6)) ph_dilated_mfma(F, (const h16*)(ws + OFF_QB), (const h16*)(ws + OFF_KB), (const h16*)(ws + OFF_VT), (h16*)(ws + OFF_OG), (float*)(ws + OFF_LSE));
    SEAM(6);
    if (IN(7)) { pg8::Gemm g{(const h16*)(ws + OFF_CQ), (const h16*)(ws + OW_4), MT, N4, QL}; pg8::StaticOrder S; S.init(MT, N4, F.G, (int)blockIdx.x);
        pg8::Epi4 E{(h16*)(ws + OFF_QLAT), (h16*)(ws + OFF_QR), (h16*)(ws + OFF_QI), (const float*)(ws + OFF_RSTDQ), tab};
        pg8::gemm_phase<pg8::Epi4, true>(F.lds, g, S, E, F.wave);
        if (F.G == 256 && blockIdx.x >= 128) {
            Frame F2 = F; F2.gw = ((int)blockIdx.x - 128) * NWAVES + F.wave; F2.NGW = 128 * NWAVES; LAS float* scr = (LAS float*)(F.lds + F.wave * 16384);
            tr_job_plain(F2, args.in[11] + C_GATE, DIN, 2048, DM, ws + OW_GATE, scr, 0);
            tr_job_mapped(F2, args, 1, 2 * FF, 0, DM, ws + OW_GU2, nullptr, scr, 640);
            tr_job_plain(F2, args.in[19], DM, DM, 256, (h16*)(ws + OW_UPB), scr, 512);
            tr_job_plain(F2, args.in[20], DM, DM, DM, (h16*)(ws + OW_O), scr, 640);
            tr_job_plain(F2, args.in[18], DM, DM, 512, (h16*)(ws + OW_UPA), scr, 256);
            for (int it = F2.gw; it < 4 * 16; it += F2.NGW) { const int kb = it >> 4, nb = it & 15, n0 = nb * 32, hl = (n0 >> 6) & 3;
                tr_item(args.in[16], 512, n0 + (F.lane & 31), true, nullptr, kb * 64, (h16*)(ws + OW_BD) + (size_t)n0 * 1024 + 256 * hl, 1024, scr, F.lane); } } }
    SEAM(7);
    if (IN(8)) { ph_combine(F, (const h16*)(ws + OFF_OG), (const float*)(ws + OFF_LSE), (h16*)(ws + OFF_OB));
        ph_topk_sparse(F, (const h16*)(ws + OFF_QI), (const h16*)(ws + OFF_KI), (const float*)(ws + OFF_WI),
                       (h16*)(ws + OFF_QLAT), (const h16*)(ws + OFF_QR), (const unsigned char*)(ws + OFF_CKV), (const unsigned char*)(ws + OFF_KR), ws, (unsigned char*)args.out); }
    SEAM(8);
    if (IN(9) && F.G == 256) { const bool first = blockIdx.x < 128;
        pg8::Gemm g{first ? (const h16*)(ws + OFF_QLAT) : (const h16*)(ws + OFF_OB), first ? (const h16*)(ws + OW_BD) : (const h16*)(ws + OW_UPB), MT, first ? 512 : DM, first ? 1024 : 256, first ? 2048 : 0, first ? 1024 : 0};
        pg8::StaticOrder S; S.init(MT, first ? 512 : DM, 128, first ? (int)blockIdx.x : (int)blockIdx.x - 128);
        pg8::EpiH16 E{first ? (h16*)(ws + OFF_OA) : (h16*)(ws + OFF_Y2), first ? 512 : DM};
        pg8::gemm_phase<pg8::EpiH16, false>(F.lds, g, S, E, F.wave); }
    SEAM(9);
    if (IN(10)) { pg8::StaticOrder S; S.init(MT, DM, F.G, (int)blockIdx.x); h16* Y1 = (h16*)(ws + OFF_Y1); h16* Y2 = (h16*)(ws + OFF_Y2);
        { pg8::Gemm g{(const h16*)(ws + OFF_OA), (const h16*)(ws + OW_UPA), MT, DM, 512}; pg8::EpiH16 E{Y1}; pg8::gemm_phase<pg8::EpiH16, false>(F.lds, g, S, E, F.wave); }
        const h16* u8 = (const h16*)((const unsigned char*)args.out + 32 * MiB);
        { pg8::Gemm g{u8, (const h16*)(ws + OW_GATE), MT, 2 * DM, DM / 2}; pg8::EpiGate E{Y1, Y1, 0, -LOG2E * F8_INV, Y2}; pg8::PairOrder P{S};
          pg8::gemm_phase<pg8::EpiGate, false, true, pg8::PairOrder>(F.lds, g, P, E, F.wave); } }
    SEAM(10);
    if (IN(11)) { pg8::Gemm g{(const h16*)(ws + OFF_Y1), (const h16*)(ws + OW_O), MT, DM, DM}; pg8::StaticOrder S; S.init(MT, DM, F.G, (int)blockIdx.x); pg8::EpiH16 E{(h16*)(ws + OFF_YF)};
        pg8::gemm_phase<pg8::EpiH16, false>(F.lds, g, S, E, F.wave); }
    SEAM(11);
    if (IN(12)) ph_resnorm<true, true, unsigned char>(F, args.out, (const h16*)(ws + OFF_YF), args.in[21], mod, 5, 1.0f, ws + OFF_F, true, args.in[22], 7, 6, ws + OFF_H);
    SEAM(12);
    if (IN(13)) { pg8::Gemm g{Hb, (const h16*)(ws + OW_GU2), MT, 2 * FF, DM / 2}; pg8::StaticOrder S; S.init(MT, 2 * FF, F.G, (int)blockIdx.x); pg8::EpiSwiGLU_T<true> E{Ab};
        pg8::gemm_phase<pg8::EpiSwiGLU_T<true>, true, true>(F.lds, g, S, E, F.wave);
        if (F.G == 256 && blockIdx.x >= 128) { Frame F2 = F; F2.gw = ((int)blockIdx.x - 128) * NWAVES + F.wave; F2.NGW = 128 * NWAVES;
            tr_job_plain(F2, args.in[25], DM, DM, FF, ws + OW_D2, (LAS float*)(F.lds + F.wave * 16384), 0); } }
    SEAM(13);
    if (IN(14)) { pg8::Gemm g{Ab, (const h16*)(ws + OW_D2), MT, DM, FF / 2}; pg8::StaticOrder S; S.init(MT, DM, F.G, (int)blockIdx.x); pg8::EpiH16_T<true> E{(h16*)(ws + OFF_F + 32 * MiB)};
        pg8::gemm_phase<pg8::EpiH16_T<true>, false, true>(F.lds, g, S, E, F.wave); }
    SEAM(14);
    if (IN(15)) ph_resnorm<true, false>(F, ws + OFF_F, (const h16*)(ws + OFF_F + 32 * MiB), args.in[26], mod, 8, 0.5f, args.out, false, nullptr, 0, 0, (h16*)nullptr);
#undef IN
#undef SEAM
}


extern "C" void kernel_launch(void* const* d_in, const int* in_sizes, int n_in, void* d_out, int out_size, void* d_ws, size_t ws_size, hipStream_t stream) {
    if (n_in != 27 || ws_size < WS_END || out_size != MT * DM) { fprintf(stderr, "kernel_launch: unexpected shapes (n_in %d ws %zu out %d)\n", n_in, ws_size, out_size); return; }
    static int grid = 0;
    if (grid == 0) {
        int dev = 0, cus = 0, per_cu = 0;
        if (hipGetDevice(&dev) != hipSuccess || hipDeviceGetAttribute(&cus, hipDeviceAttributeMultiprocessorCount, dev) != hipSuccess) { grid = -1; return; }
        if (hipFuncSetAttribute((const void*)mega_fwd, hipFuncAttributeMaxDynamicSharedMemorySize, LDS_BYTES) != hipSuccess) { fprintf(stderr, "kernel_launch: hipFuncSetAttribute failed\n"); grid = -1; return; }
        if (hipOccupancyMaxActiveBlocksPerMultiprocessor(&per_cu, (const void*)mega_fwd, NTHR, LDS_BYTES) != hipSuccess || per_cu < 1) { fprintf(stderr, "kernel_launch: occupancy query says %d blocks/CU\n", per_cu); grid = -1; return; }
        grid = cus;
    }
    if (grid < 0) return;
    hipMemsetAsync((char*)d_ws + OFF_CTL, 0, 1 * MiB, stream);
    Args a{}; for (int i = 0; i < 27; ++i) a.in[i] = (const float*)d_in[i]; a.out = (float*)d_out; a.ws = (unsigned char*)d_ws; a.ph_lo = 0; a.ph_hi = 16;
    void* kargs[] = {&a};
#ifdef PH_DOUBLE
    a.ph_hi = PH_DOUBLE + 1; (void)hipLaunchCooperativeKernel((const void*)mega_fwd, dim3(grid), dim3(NTHR), kargs, LDS_BYTES, stream);
    hipMemsetAsync((char*)d_ws + OFF_CTL, 0, 1 * MiB, stream); a.ph_lo = PH_DOUBLE; a.ph_hi = 16;
#endif
    const hipError_t e = hipLaunchCooperativeKernel((const void*)mega_fwd, dim3(grid), dim3(NTHR), kargs, LDS_BYTES, stream);
    if (e != hipSuccess) fprintf(stderr, "kernel_launch: cooperative launch failed: %s (grid %d)\n", hipGetErrorString(e), grid);
    (void)in_sizes;
}
```

```cpp
#include <hip/hip_runtime.h>
#include <hip/hip_fp16.h>
#include <cstdio>
#include <cstdint>

constexpr int NB = 4, SEQ = 4096, DM = 1024, MT = NB * SEQ, FF = 2816;
constexpr int QL = 384, KVL = 256, DNOPE = 64, DROPE = 32, DVA = 64, HA = 8, HI = 8, DI = 32, TOPK = 256;
constexpr int NG = 3, HB = 4, DHB = 64, NMOD = 9, DIN = 5064;
constexpr int C_CQ = 0, C_CKV = 384, C_KR = 640, C_KI = 672, C_WI = 704, C_QKV = 712, C_GATE = 3016;
constexpr float EPS = 1e-6f, LOG2E = 1.4426950408889634f;
typedef _Float16 h16;

constexpr size_t MiB = 1u << 20;
constexpr size_t OFF_CTL = 0, OFF_MOD = 1 * MiB, OFF_ROPE = 2 * MiB, OFF_W = 8 * MiB, OFF_H = 60 * MiB, OFF_A = 92 * MiB, OFF_F = 180 * MiB, OFF_SP = 244 * MiB, WS_END = 256 * MiB;
constexpr size_t OFF_QB = OFF_A, OFF_KB = OFF_A + 24 * MiB, OFF_VT = OFF_A + 48 * MiB, OFF_CKV = OFF_A + 72 * MiB, OFF_KR = OFF_A + 80 * MiB, OFF_KI = OFF_A + 81 * MiB,
                 OFF_WI = OFF_A + 82 * MiB, OFF_SSQ = OFF_A + 82 * MiB + 512 * 1024, OFF_CQ = OFF_SP;
constexpr size_t OFF_RSTDQ = OFF_A + 83 * MiB;
constexpr size_t OFF_OG = OFF_F, OFF_LSE = OFF_F + 24 * MiB, OFF_QLAT = OFF_A, OFF_QR = OFF_A + 64 * MiB, OFF_QI = OFF_F + 25 * MiB, OFF_SEL = OFF_F + 33 * MiB, OFF_OB = OFF_SP;
constexpr size_t OFF_Y1 = OFF_F, OFF_Y2 = OFF_F + 32 * MiB, OFF_YF = OFF_A;

__device__ __forceinline__ float silu_f(float v) { return v / (1.f + __expf(-v)); }
__device__ __forceinline__ float sigm_f(float v) { return 1.f / (1.f + __expf(-v)); }
__host__ __device__ __forceinline__ int dil_of(int g) { return g == 0 ? 1 : (g == 1 ? 4 : 16); }
__device__ __forceinline__ unsigned fkey(float f) { const unsigned u = __float_as_uint(f); return (u & 0x80000000u) ? ~u : (u | 0x80000000u); }


#define LAS __attribute__((address_space(3)))
#define GAS __attribute__((address_space(1)))
typedef _Float16 f16x8 __attribute__((ext_vector_type(8)));
typedef float f32x4 __attribute__((ext_vector_type(4)));
typedef float f32x2 __attribute__((ext_vector_type(2)));
typedef unsigned u32x4 __attribute__((ext_vector_type(4)));
typedef unsigned u32x2 __attribute__((ext_vector_type(2)));
typedef _Float16 h16x2 __attribute__((ext_vector_type(2)));
__device__ __forceinline__ unsigned pk_h2(float lo, float hi) { f32x2 v = {lo, hi}; h16x2 h = __builtin_convertvector(v, h16x2); return __builtin_bit_cast(unsigned, h); }
__device__ __forceinline__ int flane() { int l; asm volatile("v_mbcnt_lo_u32_b32 %0, -1, 0\n\tv_mbcnt_hi_u32_b32 %0, -1, %0" : "=v"(l)); return l; }
typedef unsigned u32x2s __attribute__((ext_vector_type(2)));
__device__ __forceinline__ float sum_x16(float v) { const unsigned u = __float_as_uint(v); const u32x2s r = __builtin_amdgcn_permlane16_swap(u, u, false, false); return __uint_as_float(r.x) + __uint_as_float(r.y); }
__device__ __forceinline__ float sum_x32(float v) { const unsigned u = __float_as_uint(v); const u32x2s r = __builtin_amdgcn_permlane32_swap(u, u, false, false); return __uint_as_float(r.x) + __uint_as_float(r.y); }
__device__ __forceinline__ float max_x16(float v) { const unsigned u = __float_as_uint(v); const u32x2s r = __builtin_amdgcn_permlane16_swap(u, u, false, false); return fmaxf(__uint_as_float(r.x), __uint_as_float(r.y)); }
__device__ __forceinline__ float max_x32(float v) { const unsigned u = __float_as_uint(v); const u32x2s r = __builtin_amdgcn_permlane32_swap(u, u, false, false); return fmaxf(__uint_as_float(r.x), __uint_as_float(r.y)); }
template <int CTRL> __device__ __forceinline__ float dpp_f(float v) { return __int_as_float(__builtin_amdgcn_update_dpp(0, __float_as_int(v), CTRL, 0xF, 0xF, true)); }
__device__ __forceinline__ float sat8(float x) { return __builtin_amdgcn_fmed3f(x, -448.f, 448.f); }
__device__ __forceinline__ unsigned pk_f8x4(float a, float b, float c, float d) { int w = __builtin_amdgcn_cvt_pk_fp8_f32(sat8(a), sat8(b), 0, false); w = __builtin_amdgcn_cvt_pk_fp8_f32(sat8(c), sat8(d), w, true); return (unsigned)w; }
typedef int i32x4 __attribute__((ext_vector_type(4)));
typedef int i32x8 __attribute__((ext_vector_type(8)));
constexpr float F8_ACT = 8.f, F8_WGT = 512.f, F8_INV = 1.f / (F8_ACT * F8_WGT);

namespace pg8 {
constexpr int BM = 256, BK = 64, HALF = 128, HTB = HALF * BK * 2, STAGE_BYTES = 8 * HTB, NXCD = 8, WGM = 8;
__host__ __device__ __forceinline__ int lds_byte(int r, int c) { const int st = (r >> 4) * 2 + (c >> 5), rr = r & 15, cc = c & 31, ob = rr * 64 + cc * 2; return st * 1024 + (ob ^ (((ob >> 9) & 1) << 5)); }
__host__ __device__ __forceinline__ void stage_rc(int b, int& R, int& C) { const int st = b / 1024, sb = b % 1024, swz = sb ^ (((sb >> 9) & 1) << 5); R = (st >> 1) * 16 + swz / 64; C = (st & 1) * 32 + (swz % 64) / 2; }
__host__ __device__ __forceinline__ int perm32(int rho) { const int n = rho >> 4, i = rho & 15; return 8 * (i >> 2) + 4 * n + (i & 3); }
struct Unit { int pm, pn; };
struct Gemm { const h16* A; const h16* Bt; int M, N, K; int lda = 0, koffA = 0; };
struct StaticOrder {
    int nM, nN, nwg, G, c;
    __host__ __device__ void init(int M, int N, int G_, int c_) { nM = M / BM; nN = N / BM; nwg = nM * nN; G = G_; c = c_; }
    __host__ __device__ bool next(int i, Unit& u) const {
        const long L = (long)i * G + c; if (L >= nwg) return false;
        int wgid = (int)L; { const int q = nwg / NXCD, r = nwg % NXCD, xcd = wgid % NXCD, off = wgid / NXCD; wgid = (xcd < r ? xcd * (q + 1) : r * (q + 1) + (xcd - r) * q) + off; }
        const int nig = WGM * nN, gid = wgid / nig, fm = gid * WGM, gsz = (nM - fm) < WGM ? (nM - fm) : WGM;
        u.pm = fm + ((wgid % nig) % gsz); u.pn = (wgid % nig) / gsz; return true;
    }
};
struct PairOrder { StaticOrder S;
    __host__ __device__ bool next(int i, Unit& u) const { if (i >= 2 || !S.next(0, u)) return false; u.pn += 4 * i; return true; } };
template <class Epi, bool ALIGN_EPI, bool F8 = false, class Order = StaticOrder>
__device__ __forceinline__ void gemm_phase(LAS unsigned char* lds, const Gemm g, const Order& S, const Epi& E, const int wid) {
    const int lane = flane(), tid = wid * 64 + lane, wr = wid >> 2, wc = wid & 3, fr = lane & 15, fq = lane >> 4;
    const int K = g.K, lda = g.lda ? g.lda : g.K; int nt = K / BK;
    if constexpr (F8) asm volatile("" : "+s"(nt));
    unsigned voffA[2], voffB[2];
#pragma unroll
    for (int i = 0; i < 2; ++i) { int R, C; stage_rc(tid * 16 + i * 8192, R, C); const int Rb = Epi::PERM ? ((R & ~31) + perm32(R & 31)) : R;
        voffA[i] = (unsigned)(R * lda + C) * 2u; voffB[i] = (unsigned)(Rb * K + C) * 2u; }
    const size_t kstep = (size_t)(BK * 2);
    const size_t hstep = (size_t)HALF * K * 2, hstepA = (size_t)HALF * lda * 2;
    const size_t tstep = 2 * hstep, tstepA = 2 * hstepA, kofA = (size_t)g.koffA * 2;
    const unsigned ldsw = (unsigned)wid * 1024u;
    const int aoff = lds_byte(wr * 64 + fr, fq * 8), boff = lds_byte(wc * 32 + fr, fq * 8);
#define PG8_SA(b, h) (((b) * 2 + (h)) * HTB)
#define PG8_SB(b, h) ((4 + (b) * 2 + (h)) * HTB)
#define PG8_STAGE(bufoff, gbase, voff) do { _Pragma("unroll") for (int _i = 0; _i < 2; ++_i) { unsigned _vo = (voff)[_i]; asm volatile("" : "+v"(_vo)); \
        __builtin_amdgcn_global_load_lds((const unsigned*)((const char*)(gbase) + _vo), (LAS unsigned*)(lds + (bufoff) + ldsw + _i * 8192), 16, 0, 0); } } while (0)
#define PG8_LDA(dst, b, h) do { _Pragma("unroll") for (int m = 0; m < 4; ++m) _Pragma("unroll") for (int k = 0; k < 2; ++k) dst[m][k] = *(const LAS f16x8*)(lds + PG8_SA(b, h) + aoff + m * 2048 + k * 1024); } while (0)
#define PG8_LDB(dst, b, h) do { _Pragma("unroll") for (int n = 0; n < 2; ++n) _Pragma("unroll") for (int k = 0; k < 2; ++k) dst[n][k] = *(const LAS f16x8*)(lds + PG8_SB(b, h) + boff + n * 2048 + k * 1024); } while (0)
#define PG8_CAT8(x, y) __builtin_shufflevector(__builtin_bit_cast(i32x4, x), __builtin_bit_cast(i32x4, y), 0, 1, 2, 3, 4, 5, 6, 7)
#define PG8_MMA(ai, bj, At, Bt) do { __builtin_amdgcn_s_setprio(1); \
        if constexpr (F8) { _Pragma("unroll") for (int m = 0; m < 4; ++m) _Pragma("unroll") for (int n = 0; n < 2; ++n) \
            acc[ai][bj][m][n] = __builtin_amdgcn_mfma_scale_f32_16x16x128_f8f6f4(PG8_CAT8(Bt[n][0], Bt[n][1]), PG8_CAT8(At[m][0], At[m][1]), acc[ai][bj][m][n], 0, 0, 0, 0, 0, 0); } \
        else { _Pragma("unroll") for (int m = 0; m < 4; ++m) _Pragma("unroll") for (int n = 0; n < 2; ++n) _Pragma("unroll") for (int k = 0; k < 2; ++k) \
            acc[ai][bj][m][n] = __builtin_amdgcn_mfma_f32_16x16x32_f16(Bt[n][k], At[m][k], acc[ai][bj][m][n], 0, 0, 0); } \
        __builtin_amdgcn_s_setprio(0); } while (0)
#define PG8_WAIT_V(n) asm volatile("s_waitcnt vmcnt(" #n ")" ::: "memory")
#define PG8_WAIT_L(n) asm volatile("s_waitcnt lgkmcnt(" #n ")" ::: "memory")
#define PG8_BAR __builtin_amdgcn_s_barrier()
#define PG8_SCHED __builtin_amdgcn_sched_barrier(0)
    Unit cur, nxt; int ui = 0;
    if (!S.next(0, cur)) return;
    f32x4 acc[2][2][4][2];
#pragma unroll
    for (int a = 0; a < 2; ++a)
#pragma unroll
        for (int b = 0; b < 2; ++b)
#pragma unroll
            for (int m = 0; m < 4; ++m)
#pragma unroll
                for (int n = 0; n < 2; ++n) acc[a][b][m][n] = (f32x4){0.f, 0.f, 0.f, 0.f};
    f16x8 At[4][2], B0[2][2], B1[2][2];
    const char* cA = (const char*)g.A + (size_t)cur.pm * tstepA + (size_t)cur.pn * kofA; const char* cB = (const char*)g.Bt + (size_t)cur.pn * tstep;
    PG8_STAGE(PG8_SB(0, 0), cB, voffB); PG8_STAGE(PG8_SB(0, 1), cB + hstep, voffB); PG8_STAGE(PG8_SA(0, 0), cA, voffA); PG8_STAGE(PG8_SA(0, 1), cA + hstepA, voffA);
    if (wr == 1) PG8_BAR;
    PG8_WAIT_V(2); PG8_BAR;
    PG8_STAGE(PG8_SB(1, 0), cB + kstep, voffB); PG8_STAGE(PG8_SA(1, 0), cA + kstep, voffA); PG8_STAGE(PG8_SB(1, 1), cB + hstep + kstep, voffB);
    PG8_WAIT_V(6); PG8_BAR;
    for (;;) {
        const bool has_next = S.next(ui + 1, nxt);
        const char* nA = has_next ? (const char*)g.A + (size_t)nxt.pm * tstepA + (size_t)nxt.pn * kofA : cA; const char* nB = has_next ? (const char*)g.Bt + (size_t)nxt.pn * tstep : cB;
        for (int t = 0; t < nt; t += 2) {
            const bool last = (t == nt - 2);
            const char* a1 = cA + (size_t)(t + 1) * kstep;
            const char* a2 = last ? nA : cA + (size_t)(t + 2) * kstep; const char* b2 = last ? nB : cB + (size_t)(t + 2) * kstep;
            const char* a3 = a2 + kstep; const char* b3 = b2 + kstep;
            PG8_LDB(B0, 0, 0); PG8_LDB(B1, 0, 1); PG8_SCHED; PG8_LDA(At, 0, 0); PG8_STAGE(PG8_SA(1, 1), a1 + hstepA, voffA);
            PG8_WAIT_V(8); PG8_WAIT_L(0); PG8_BAR; PG8_MMA(0, 0, At, B0); PG8_MMA(0, 1, At, B1); PG8_BAR; PG8_SCHED;
            PG8_LDA(At, 0, 1); PG8_STAGE(PG8_SB(0, 0), b2, voffB); PG8_STAGE(PG8_SB(0, 1), b2 + hstep, voffB); PG8_STAGE(PG8_SA(0, 0), a2, voffA);
            PG8_WAIT_V(8); PG8_WAIT_L(0); PG8_BAR; PG8_MMA(1, 0, At, B0); PG8_MMA(1, 1, At, B1); PG8_BAR; PG8_SCHED;
            PG8_LDB(B0, 1, 0); PG8_LDB(B1, 1, 1); PG8_SCHED; PG8_LDA(At, 1, 0); PG8_STAGE(PG8_SA(0, 1), a2 + hstepA, voffA);
            PG8_WAIT_V(8); PG8_WAIT_L(0); PG8_BAR; PG8_MMA(0, 0, At, B0); PG8_MMA(0, 1, At, B1); PG8_BAR; PG8_SCHED;
            PG8_LDA(At, 1, 1); PG8_STAGE(PG8_SB(1, 0), b3, voffB); PG8_STAGE(PG8_SB(1, 1), b3 + hstep, voffB); PG8_STAGE(PG8_SA(1, 0), a3, voffA);
            PG8_WAIT_V(8); PG8_WAIT_L(0); PG8_BAR; PG8_MMA(1, 0, At, B0); PG8_MMA(1, 1, At, B1); PG8_BAR; PG8_SCHED;
        }
        if constexpr (ALIGN_EPI) { if (wr == 0) PG8_BAR; }
        { const int l2 = flane(); E(acc, cur, wr, wc, l2 & 15, l2 >> 4); }
        if (!has_next) break;
#pragma unroll
        for (int a = 0; a < 2; ++a)
#pragma unroll
            for (int b = 0; b < 2; ++b)
#pragma unroll
                for (int m = 0; m < 4; ++m)
#pragma unroll
                    for (int n = 0; n < 2; ++n) acc[a][b][m][n] = (f32x4){0.f, 0.f, 0.f, 0.f};
        cur = nxt; cA = nA; cB = nB; ++ui;
        if constexpr (ALIGN_EPI) { if (wr == 1) PG8_BAR; }
    }
    PG8_WAIT_V(0);
    if constexpr (!ALIGN_EPI) { if (wr == 0) PG8_BAR; }
    PG8_BAR;
#undef PG8_SA
#undef PG8_SB
#undef PG8_STAGE
#undef PG8_LDA
#undef PG8_LDB
#undef PG8_MMA
#undef PG8_CAT8
#undef PG8_WAIT_V
#undef PG8_WAIT_L
#undef PG8_BAR
#undef PG8_SCHED
}
struct EpiF32 {
    static constexpr bool PERM = false;
    float* C; int ldc;
    __device__ __forceinline__ void operator()(const f32x4 (&acc)[2][2][4][2], const Unit& u, int wr, int wc, int fr, int fq) const {
        const int row0 = u.pm * BM + wr * 64 + fr, col0 = u.pn * BM + wc * 32 + 4 * fq;
#pragma unroll
        for (int ai = 0; ai < 2; ++ai)
#pragma unroll
            for (int m = 0; m < 4; ++m) { float* rowp = C + (size_t)(row0 + ai * HALF + m * 16) * ldc + col0;
#pragma unroll
                for (int bj = 0; bj < 2; ++bj)
#pragma unroll
                    for (int n = 0; n < 2; ++n) *(f32x4*)(rowp + bj * HALF + n * 16) = acc[ai][bj][m][n]; }
    }
};
template <bool F8, bool O8 = F8>
struct EpiSwiGLU_T {
    static constexpr bool PERM = true;
    void* O;
    __device__ __forceinline__ void operator()(const f32x4 (&acc)[2][2][4][2], const Unit& u, int wr, int wc, int fr, int fq) const {
        const int row0 = u.pm * BM + wr * 64 + fr, col0 = u.pn * HALF + wc * 32 + 8 * fq;
#pragma unroll
        for (int ai = 0; ai < 2; ++ai)
#pragma unroll
            for (int m = 0; m < 4; ++m) { const size_t eo = (size_t)(row0 + ai * HALF + m * 16) * FF + col0;
                float v[8];
#pragma unroll
                for (int n = 0; n < 2; ++n)
#pragma unroll
                    for (int e = 0; e < 4; ++e) { float gg = acc[ai][0][m][n][e], uu = acc[ai][1][m][n][e]; if constexpr (F8) { gg *= F8_INV; uu *= O8 ? F8_INV * F8_ACT : F8_INV; }
                        v[n * 4 + e] = gg * __builtin_amdgcn_rcpf(1.f + __builtin_amdgcn_exp2f(-gg * LOG2E)) * uu; }
                if constexpr (O8) { u32x2 w; w.x = pk_f8x4(v[0], v[1], v[2], v[3]); w.y = pk_f8x4(v[4], v[5], v[6], v[7]); *(u32x2*)((unsigned char*)O + eo) = w; }
                else { u32x4 w; w.x = pk_h2(v[0], v[1]); w.y = pk_h2(v[2], v[3]); w.z = pk_h2(v[4], v[5]); w.w = pk_h2(v[6], v[7]); *(u32x4*)((h16*)O + eo) = w; } }
    }
};
typedef EpiSwiGLU_T<false> EpiSwiGLU;

struct EpiIn {
    static constexpr bool PERM = false;
    h16 *ckv, *cq, *kr, *ki, *qb, *kb, *vT; float *wi, *ssq; const float* gckv; const float2* tab; LAS float* X;
    __device__ __forceinline__ void rope64(const f32x4 (&acc)[2][2][4][2], const Unit& u, int wr, int wc, int fr, int fq, h16* dst, int tl, float scale) const {
        const int tok0 = u.pm * BM + wr * 64 + fr;
        f32x4 tc[4], tn[4];
        { const f32x4* tp = (const f32x4*)(tab + (size_t)tok0 * 48 + 4 * fq); tc[0] = tp[0]; tc[1] = tp[1]; tc[2] = tp[8]; tc[3] = tp[9]; }
#pragma unroll
        for (int rr = 0; rr < 8; ++rr) { const int ai = rr >> 2, m = rr & 3, tok = tok0 + ai * HALF + m * 16;
            if (rr < 7) { const int tokn = tok0 + ((rr + 1) >> 2) * HALF + ((rr + 1) & 3) * 16; const f32x4* tp = (const f32x4*)(tab + (size_t)tokn * 48 + 4 * fq); tn[0] = tp[0]; tn[1] = tp[1]; tn[2] = tp[8]; tn[3] = tp[9]; }
#pragma unroll
            for (int n = 0; n < 2; ++n) { const int i = 16 * n + 4 * fq; const f32x4 t0 = tc[2 * n], t1 = tc[2 * n + 1];
                const f32x4 cs = {t0.x, t0.z, t1.x, t1.z}, sn = {t0.y, t0.w, t1.y, t1.w}, x1 = acc[ai][0][m][n], x2 = acc[ai][1][m][n];
                const f32x4 o1 = (x1 * cs - x2 * sn) * scale, o2 = (x2 * cs + x1 * sn) * scale;
                h16* p = dst + (size_t)tok * 768 + (4 * tl + wc) * 64 + i;
                u32x2 w1, w2; w1.x = pk_h2(o1.x, o1.y); w1.y = pk_h2(o1.z, o1.w); w2.x = pk_h2(o2.x, o2.y); w2.y = pk_h2(o2.z, o2.w);
                *(u32x2*)p = w1; *(u32x2*)(p + 32) = w2; }
#pragma unroll
            for (int k = 0; k < 4; ++k) tc[k] = tn[k];
            asm volatile("" ::: "memory"); }
    }
    __device__ __forceinline__ void operator()(const f32x4 (&acc)[2][2][4][2], const Unit& u, int wr, int wc, int fr, int fq) const {
        const int pn = u.pn;
        if (pn == 0) {
#pragma unroll
            for (int ai = 0; ai < 2; ++ai)
#pragma unroll
                for (int m = 0; m < 4; ++m) { float sq = 0.f;
#pragma unroll
                    for (int bj = 0; bj < 2; ++bj)
#pragma unroll
                        for (int n = 0; n < 2; ++n) { const f32x4 v = acc[ai][bj][m][n]; sq += (v.x * v.x + v.y * v.y) + (v.z * v.z + v.w * v.w); }
                    sq = sum_x16(sq); sq = sum_x32(sq);
                    if (fq == 0) X[(ai * HALF + wr * 64 + m * 16 + fr) * 4 + wc] = sq; }
            asm volatile("s_waitcnt lgkmcnt(0)" ::: "memory"); __builtin_amdgcn_s_barrier(); asm volatile("" ::: "memory");
#pragma unroll
            for (int ai = 0; ai < 2; ++ai)
#pragma unroll
                for (int m = 0; m < 4; ++m) { const int rl = ai * HALF + wr * 64 + m * 16 + fr, tok = u.pm * BM + rl; const f32x4 p = *(const LAS f32x4*)(X + rl * 4);
                    const float rstd = rsqrtf(((p.x + p.y) + (p.z + p.w)) * (1.f / KVL) + EPS);
#pragma unroll
                    for (int bj = 0; bj < 2; ++bj)
#pragma unroll
                        for (int n = 0; n < 2; ++n) { const int col = bj * HALF + wc * 32 + n * 16 + 4 * fq; const f32x4 o = acc[ai][bj][m][n] * rstd * *(const f32x4*)(gckv + col);
                            int w8 = __builtin_amdgcn_cvt_pk_fp8_f32(o.x, o.y, 0, false); w8 = __builtin_amdgcn_cvt_pk_fp8_f32(o.z, o.w, w8, true);
                            *(int*)((unsigned char*)ckv + (size_t)tok * KVL + col) = w8; }
                    asm volatile("" ::: "memory"); }
            asm volatile("s_waitcnt lgkmcnt(0)" ::: "memory"); __builtin_amdgcn_s_barrier(); asm volatile("" ::: "memory");
        } else if (pn <= 2) {
#pragma unroll
            for (int ai = 0; ai < 2; ++ai)
#pragma unroll
                for (int m = 0; m < 4; ++m) { const int tok = u.pm * BM + ai * HALF + wr * 64 + m * 16 + fr; float sq = 0.f;
#pragma unroll
                    for (int bj = 0; bj < 2; ++bj) { if (pn == 2 && bj == 1) break;
#pragma unroll
                        for (int n = 0; n < 2; ++n) { const f32x4 v = acc[ai][bj][m][n]; sq += (v.x * v.x + v.y * v.y) + (v.z * v.z + v.w * v.w);
                            const int col = (pn - 1) * 256 + bj * HALF + wc * 32 + n * 16 + 4 * fq; u32x2 w; w.x = pk_h2(v.x, v.y); w.y = pk_h2(v.z, v.w); *(u32x2*)(cq + (size_t)tok * QL + col) = w; } }
                    sq = sum_x16(sq); sq = sum_x32(sq);
                    if (fq == 0) ssq[tok * 8 + (pn - 1) * 4 + wc] = sq;
                    if (pn == 2) {
                        if (wc < 2) { const int i = 4 * fq; const f32x4* tp = (const f32x4*)(tab + (size_t)tok * 48 + 32 + i); const f32x4 t0 = tp[0], t1 = tp[1];
                            const f32x4 cs = {t0.x, t0.z, t1.x, t1.z}, sn = {t0.y, t0.w, t1.y, t1.w}, x1 = acc[ai][1][m][0], x2 = acc[ai][1][m][1];
                            const f32x4 o1 = x1 * cs - x2 * sn, o2 = x2 * cs + x1 * sn;
                            if (wc == 0) { unsigned char* p8 = (unsigned char*)kr + (size_t)tok * 32 + i;
                                int a8 = __builtin_amdgcn_cvt_pk_fp8_f32(o1.x, o1.y, 0, false); a8 = __builtin_amdgcn_cvt_pk_fp8_f32(o1.z, o1.w, a8, true);
                                int b8 = __builtin_amdgcn_cvt_pk_fp8_f32(o2.x, o2.y, 0, false); b8 = __builtin_amdgcn_cvt_pk_fp8_f32(o2.z, o2.w, b8, true);
                                *(int*)p8 = a8; *(int*)(p8 + 16) = b8; }
                            else { h16* p = ki + (size_t)tok * 32 + i;
                                u32x2 w1, w2; w1.x = pk_h2(o1.x, o1.y); w1.y = pk_h2(o1.z, o1.w); w2.x = pk_h2(o2.x, o2.y); w2.y = pk_h2(o2.z, o2.w);
                                *(u32x2*)p = w1; *(u32x2*)(p + 16) = w2; } }
                        else if (wc == 2 && fq < 2) { *(f32x4*)(wi + tok * 8 + 4 * fq) = acc[ai][1][m][0] * 0.35355339059327373f; }
                    }
                    asm volatile("" ::: "memory"); }
        } else if (pn <= 5) rope64(acc, u, wr, wc, fr, fq, qb, pn - 3, 0.125f * LOG2E);
        else if (pn <= 8) rope64(acc, u, wr, wc, fr, fq, kb, pn - 6, 1.0f);
        else {
#pragma unroll
            for (int ai = 0; ai < 2; ++ai)
#pragma unroll
                for (int m = 0; m < 4; ++m) { const int tok = u.pm * BM + ai * HALF + wr * 64 + m * 16 + fr;
#pragma unroll
                    for (int bj = 0; bj < 2; ++bj)
#pragma unroll
                        for (int n = 0; n < 2; ++n) { const f32x4 v = acc[ai][bj][m][n]; u32x2 w; w.x = pk_h2(v.x, v.y); w.y = pk_h2(v.z, v.w);
                            *(u32x2*)(vT + (size_t)tok * 768 + (pn - 9) * 256 + bj * HALF + wc * 32 + n * 16 + 4 * fq) = w; }
                    asm volatile("" ::: "memory"); }
        }
    }
};
struct Epi4 {
    static constexpr bool PERM = true;
    h16 *qlat, *qr, *qi; const float* rstdq; const float2* tab;
    __device__ __forceinline__ void operator()(const f32x4 (&acc)[2][2][4][2], const Unit& u, int wr, int wc, int fr, int fq) const {
        const int pn = u.pn; const float c2 = 0.10206207261596575f * LOG2E;
        const int tok0 = u.pm * BM + wr * 64 + fr;
        float rc, rn = 0.f;
        if (pn < 8) {
            float rs[8];
#pragma unroll
            for (int rr = 0; rr < 8; ++rr) rs[rr] = rstdq[tok0 + (rr >> 2) * HALF + (rr & 3) * 16];
#pragma unroll
            for (int rr = 0; rr < 8; ++rr) { const int ai = rr >> 2, m = rr & 3, tok = tok0 + ai * HALF + m * 16; rc = rs[rr];
#pragma unroll
                for (int bj = 0; bj < 2; ++bj) { const f32x4 o0 = acc[ai][bj][m][0] * (rc * c2 * 64.f), o1 = acc[ai][bj][m][1] * (rc * c2 * 64.f);
                    u32x2 w; w.x = pk_f8x4(o0.x, o0.y, o0.z, o0.w); w.y = pk_f8x4(o1.x, o1.y, o1.z, o1.w);
                    *(u32x2*)((unsigned char*)qlat + (size_t)tok * 4096 + pn * 256 + bj * HALF + wc * 32 + 8 * fq) = w; }
                asm volatile("" ::: "memory"); }
        } else { rc = rstdq[tok0]; h16* dst = (pn == 8) ? qr : qi; const float c2e = (pn == 8) ? c2 : 1.f; const int i = 4 * fq;
            f32x4 tc[2], tn[2];
            { const f32x4* tp = (const f32x4*)(tab + (size_t)tok0 * 48 + 32 + i); tc[0] = tp[0]; tc[1] = tp[1]; }
#pragma unroll
            for (int rr = 0; rr < 8; ++rr) { const int ai = rr >> 2, m = rr & 3, tok = tok0 + ai * HALF + m * 16;
                if (rr < 7) { const int tokn = tok0 + ((rr + 1) >> 2) * HALF + ((rr + 1) & 3) * 16; const f32x4* tp = (const f32x4*)(tab + (size_t)tokn * 48 + 32 + i); tn[0] = tp[0]; tn[1] = tp[1]; rn = rstdq[tokn]; }
                const f32x4 cs = {tc[0].x, tc[0].z, tc[1].x, tc[1].z}, sn = {tc[0].y, tc[0].w, tc[1].y, tc[1].w}; const float sc = rc * c2e;
#pragma unroll
                for (int bj = 0; bj < 2; ++bj) { const f32x4 x1 = acc[ai][bj][m][0], x2 = acc[ai][bj][m][1]; const f32x4 o1 = (x1 * cs - x2 * sn) * sc, o2 = (x2 * cs + x1 * sn) * sc;
                    h16* p = dst + (size_t)tok * 256 + (4 * bj + wc) * 32 + i;
                    u32x2 w1, w2; w1.x = pk_h2(o1.x, o1.y); w1.y = pk_h2(o1.z, o1.w); w2.x = pk_h2(o2.x, o2.y); w2.y = pk_h2(o2.z, o2.w);
                    *(u32x2*)p = w1; *(u32x2*)(p + 16) = w2; }
                tc[0] = tn[0]; tc[1] = tn[1]; rc = rn;
                asm volatile("" ::: "memory"); } }
    }
};
__device__ __forceinline__ u32x4 ld16_l2(const h16* p) {
    const unsigned long long a = __hip_atomic_load((const unsigned long long*)p, __ATOMIC_RELAXED, __HIP_MEMORY_SCOPE_AGENT), b = __hip_atomic_load((const unsigned long long*)p + 1, __ATOMIC_RELAXED, __HIP_MEMORY_SCOPE_AGENT);
    return (u32x4){(unsigned)a, (unsigned)(a >> 32), (unsigned)b, (unsigned)(b >> 32)};
}
typedef _Float16 h16x8 __attribute__((ext_vector_type(8)));
__device__ __forceinline__ void unpk8(const u32x4 w, float (&f)[8]) {
    const h16x8 h = __builtin_bit_cast(h16x8, w);
#pragma unroll
    for (int i = 0; i < 8; ++i) f[i] = (float)h[i];
}
template <bool SC>
struct EpiH16_T {
    static constexpr bool PERM = true;
    h16* O; int ldc = DM;
    __device__ __forceinline__ void operator()(const f32x4 (&acc)[2][2][4][2], const Unit& u, int wr, int wc, int fr, int fq) const {
        const int row0 = u.pm * BM + wr * 64 + fr, col0 = u.pn * BM + wc * 32 + 8 * fq;
#pragma unroll
        for (int ai = 0; ai < 2; ++ai)
#pragma unroll
            for (int m = 0; m < 4; ++m)
#pragma unroll
                for (int bj = 0; bj < 2; ++bj) { f32x4 v0 = acc[ai][bj][m][0], v1 = acc[ai][bj][m][1]; if constexpr (SC) { v0 *= F8_INV; v1 *= F8_INV; }
                    u32x4 w; w.x = pk_h2(v0.x, v0.y); w.y = pk_h2(v0.z, v0.w); w.z = pk_h2(v1.x, v1.y); w.w = pk_h2(v1.z, v1.w);
                    *(u32x4*)(O + (size_t)(row0 + ai * HALF + m * 16) * ldc + col0 + bj * HALF) = w; }
    }
};
typedef EpiH16_T<false> EpiH16;
struct EpiGate {
    static constexpr bool PERM = true;
    const h16* Y; h16* Z; int accum; float nls; const h16* Yb = nullptr;
    __device__ __forceinline__ void operator()(const f32x4 (&acc)[2][2][4][2], const Unit& u, int wr, int wc, int fr, int fq) const {
        const int row0 = u.pm * BM + wr * 64 + fr, col0 = (u.pn & 3) * BM + wc * 32 + 8 * fq; const bool accum = Yb ? (u.pn >= 4) : (this->accum != 0); const h16* Y = (Yb && u.pn >= 4) ? Yb : this->Y;
#pragma unroll
        for (int ai = 0; ai < 2; ++ai)
#pragma unroll
            for (int m = 0; m < 4; ++m)
#pragma unroll
                for (int bj = 0; bj < 2; ++bj) { const size_t off = (size_t)(row0 + ai * HALF + m * 16) * DM + col0 + bj * HALF;
                    float y[8], zz[8]; unpk8(ld16_l2(Y + off), y);
                    if (accum) unpk8(ld16_l2(Z + off), zz); else {
#pragma unroll
                        for (int i = 0; i < 8; ++i) zz[i] = 0.f; }
                    float o[8];
#pragma unroll
                    for (int n = 0; n < 2; ++n)
#pragma unroll
                        for (int e = 0; e < 4; ++e) { const float gg = acc[ai][bj][m][n][e]; o[n * 4 + e] = zz[n * 4 + e] + y[n * 4 + e] * __builtin_amdgcn_rcpf(1.f + __builtin_amdgcn_exp2f(gg * nls)); }
                    u32x4 w; w.x = pk_h2(o[0], o[1]); w.y = pk_h2(o[2], o[3]); w.z = pk_h2(o[4], o[5]); w.w = pk_h2(o[6], o[7]);
                    *(u32x4*)(Z + off) = w; }
    }
};
}

#define XB_TMO      128
#define XB_XCNT(j)  (256  + 64 * (j))
#define XB_XSUB(j)  (1280 + 64 * (j))
#define XB_XGEN(j)  (2304 + 64 * (j))
#define XB_TOP      3328
#define XB_TOPGEN   3392
#define XCD_BAR_WORDS 3456
#define XB_SPIN_CAP (1u << 18)
__device__ __forceinline__ unsigned xb_ld(unsigned* p)              { return __hip_atomic_load(p, __ATOMIC_RELAXED, __HIP_MEMORY_SCOPE_AGENT); }
__device__ __forceinline__ unsigned xb_add(unsigned* p, unsigned v) { return __hip_atomic_fetch_add(p, v, __ATOMIC_RELAXED, __HIP_MEMORY_SCOPE_AGENT); }
__device__ __forceinline__ unsigned xb_xcc_id() { return (unsigned)__builtin_amdgcn_s_getreg((3 << 11) | 20) & 0xFu; }
#define XB_SPIN(cond, bar) do { unsigned _sp = 0; while (cond) { __builtin_amdgcn_s_sleep(1); \
    if ((++_sp & 255u) == 0u) { if (xb_ld(&(bar)[XB_TMO])) break; if (_sp > XB_SPIN_CAP) { atomicAdd(&(bar)[XB_TMO], 1u); break; } } } } while (0)
struct XcdBarrier { unsigned* bar; unsigned x; volatile LAS unsigned* st; int wave; };
__device__ __forceinline__ XcdBarrier xcd_barrier_post(unsigned* bar, volatile LAS unsigned* st, int wave) {
    XcdBarrier b; b.bar = bar; b.x = xb_xcc_id(); b.st = st; b.wave = wave;
    if (wave == 0 && flane() == 0) (void)xb_add(&bar[XB_XCNT(b.x)], 1u);
    return b;
}
__device__ __forceinline__ void xcd_barrier_complete(unsigned* bar, unsigned x, unsigned& nloc, unsigned& nx) {
    const unsigned G = gridDim.x * gridDim.y * gridDim.z;
    unsigned sum, cnt, mine, sp = 0u;
    for (;;) {
        sum = 0u; cnt = 0u; mine = 0u;
#pragma unroll
        for (unsigned j = 0; j < 16; ++j) { const unsigned c = xb_ld(&bar[XB_XCNT(j)]); sum += c; cnt += (c > 0u) ? 1u : 0u; mine = (j == x) ? c : mine; }
        if (sum == G) break;
        __builtin_amdgcn_s_sleep(1);
        if ((++sp & 255u) == 0u) { if (xb_ld(&bar[XB_TMO])) break; if (sp > XB_SPIN_CAP) { atomicAdd(&bar[XB_TMO], 1u); break; } }
    }
    nloc = mine > 0u ? mine : 1u; nx = cnt > 0u ? cnt : 1u;
}
__device__ __forceinline__ void xcd_barrier(const XcdBarrier& b) {
    asm volatile("s_waitcnt vmcnt(0)" ::: "memory");
    __syncthreads();
    if (b.wave == 0 && flane() == 0) {
        unsigned* bar = b.bar;
        __builtin_amdgcn_s_waitcnt(0);
        unsigned nloc = b.st[0], nx = b.st[1];
        if (nloc == 0u) { xcd_barrier_complete(bar, b.x, nloc, nx); b.st[0] = nloc; b.st[1] = nx; }
        const unsigned old = xb_add(&bar[XB_XSUB(b.x)], 1u);
        const unsigned gen = old / nloc;
        if (old + 1u == (gen + 1u) * nloc) {
            __builtin_amdgcn_fence(__ATOMIC_RELEASE, "agent");
            asm volatile("s_waitcnt vmcnt(0)" ::: "memory");
            const unsigned og = xb_add(&bar[XB_TOP], 1u);
            const unsigned tg = og / nx;
            if (og + 1u == (tg + 1u) * nx) xb_add(&bar[XB_TOPGEN], 1u);
            else XB_SPIN(xb_ld(&bar[XB_TOPGEN]) == tg, bar);
            __builtin_amdgcn_fence(__ATOMIC_ACQUIRE, "agent");
            xb_add(&bar[XB_XGEN(b.x)], 1u);
            asm volatile("s_waitcnt vmcnt(0)" ::: "memory");
        } else {
            XB_SPIN(xb_ld(&bar[XB_XGEN(b.x)]) == gen, bar);
            __builtin_amdgcn_fence(__ATOMIC_ACQUIRE, "agent");
            asm volatile("s_waitcnt vmcnt(0)" ::: "memory");
        }
    }
    __syncthreads();
}

constexpr int NWAVES = 8, NTHR = 512;
constexpr int RING_BYTES = 131072, LDSCTL_OFF = RING_BYTES, MISC_OFF = LDSCTL_OFF + 320, LDS_BYTES = 149504;
constexpr int XCH_OFF = RING_BYTES + 1024;
constexpr int SELL_OFF = XCH_OFF;
static_assert(SELL_OFF + 8 * 2048 <= LDS_BYTES, "LDS layout");
constexpr int CW_BAR = 4096;
constexpr size_t OW_GU1 = OFF_W, OW_D1 = OW_GU1 + 11 * MiB, OW_IN = OW_D1 + (size_t)DM * FF * 2, OW_GATE = OW_IN + 6 * MiB, OW_4 = OW_GATE + 4 * MiB, OW_OV = OW_4 + 2 * MiB,
                 OW_UPB = OW_OV + 4 * MiB, OW_O = OW_UPB + MiB / 2, OW_GU2 = OW_O + 2 * MiB, OW_D2 = OW_GU2 + 11 * MiB, OW_END = OW_D2 + (size_t)DM * FF * 2;
static_assert(OW_END <= OFF_H, "weights region");
constexpr int NIN3 = 3072, N4 = 2560;
constexpr size_t OW_BD = OW_OV, OW_UPA = OW_OV + MiB, OFF_OA = OFF_A + 64 * MiB;

struct Args { const float* in[27]; float* out; unsigned char* ws; int ph_lo, ph_hi; };
struct Frame {
    LAS unsigned char* lds; int tid, lane, wave, G, gw, NGW;
};
__device__ __forceinline__ float wave_sum(float v) {
    v += dpp_f<0xB1>(v); v += dpp_f<0x4E>(v); v += dpp_f<0x141>(v); v += dpp_f<0x140>(v);
    v = sum_x16(v); v = sum_x32(v);
    return v;
}
__device__ __forceinline__ bool map_row(int job, int n, const Args& a, const float*& W, int& ldw, int& col) {
    if (job <= 1) { const int t = n >> 8, j = n & 255; W = a.in[(job == 0 ? 6 : 23) + (j >> 7)]; ldw = FF; col = t * 128 + (j & 127); return true; }
    if (job == 2) { W = a.in[11]; ldw = DIN; const int t = n >> 8, j = n & 255;
        if (t == 0) { col = C_CKV + j; return true; }
        if (t == 1) { col = j; return true; }
        if (t == 2) { if (j < 128) { col = 256 + j; return true; } if (j < 160) { col = C_KR + (j - 128); return true; } if (j < 192) { col = C_KI + (j - 160); return true; } if (j < 200) { col = C_WI + (j - 192); return true; } col = 0; return false; }
        if (t < 9) { const int c3 = (t - 3) / 3, tl = (t - 3) % 3, hl = (j & 127) >> 5, i = j & 31; col = C_QKV + c3 * 768 + (4 * tl + hl) * 64 + (j >> 7) * 32 + i; return true; }
        col = C_QKV + 1536 + (t - 9) * 256 + j; return true; }
    { const int n2 = n - 2048, r5 = n2 & 31, nat = 16 * ((r5 >> 2) & 1) + 4 * (r5 >> 3) + (r5 & 3);
      if (n2 < 256) { W = a.in[14]; ldw = 768; col = (n2 >> 5) * 96 + 64 + nat; } else { W = a.in[17]; ldw = 256; col = ((n2 - 256) & ~31) + nat; } return true; }
}
template <typename T>
__device__ __forceinline__ void tr_item(const float* W, int ldw, int col, bool valid, const float* scale, int k0, T* WTrow0, int K, LAS float* scr, int lane) {
    const int colc = valid ? col : 0; float vv[32];
#pragma unroll
    for (int i = 0; i < 32; ++i) vv[i] = W[(size_t)(k0 + 2 * i + (lane >> 5)) * ldw + colc];
    if (scale) {
#pragma unroll
        for (int i = 0; i < 32; ++i) vv[i] *= scale[k0 + 2 * i + (lane >> 5)]; }
#pragma unroll
    for (int i = 0; i < 32; ++i) scr[(2 * i + (lane >> 5)) * 33 + (lane & 31)] = valid ? vv[i] : 0.f;
    asm volatile("s_waitcnt lgkmcnt(0)" ::: "memory");
    const int c = lane & 7;
#pragma unroll
    for (int j = 0; j < 4; ++j) { const int n = (lane >> 3) + 8 * j; const LAS float* s = scr + (8 * c) * 33 + n;
        if constexpr (sizeof(T) == 1) { u32x2 o; o.x = pk_f8x4(s[0 * 33] * F8_WGT, s[1 * 33] * F8_WGT, s[2 * 33] * F8_WGT, s[3 * 33] * F8_WGT); o.y = pk_f8x4(s[4 * 33] * F8_WGT, s[5 * 33] * F8_WGT, s[6 * 33] * F8_WGT, s[7 * 33] * F8_WGT);
            *(u32x2*)(WTrow0 + (size_t)n * K + k0 + 8 * c) = o; }
        else { u32x4 o; o.x = pk_h2(s[0 * 33], s[1 * 33]); o.y = pk_h2(s[2 * 33], s[3 * 33]); o.z = pk_h2(s[4 * 33], s[5 * 33]); o.w = pk_h2(s[6 * 33], s[7 * 33]);
            *(u32x4*)(WTrow0 + (size_t)n * K + k0 + 8 * c) = o; } }
    asm volatile("s_waitcnt lgkmcnt(0)" ::: "memory");
}
template <typename T>
__device__ __forceinline__ void tr_job_mapped(const Frame& F, const Args& a, int job, int Ndest, int n_lo, int K, T* WT, const float* scale, LAS float* scr, int phase_off) {
    const int nblk = Ndest / 32, nitems = (K / 64) * nblk;
    for (int it = (F.gw + phase_off) % F.NGW; it < nitems; it += F.NGW) {
        const int kb = it / nblk, nb = it % nblk; const float* W; int ldw, col;
        const bool valid = map_row(job, n_lo + nb * 32 + (F.lane & 31), a, W, ldw, col);
        tr_item(W, ldw, col, valid, scale, kb * 64, WT + (size_t)(n_lo + nb * 32) * K, K, scr, F.lane);
    }
}
template <typename T>
__device__ __forceinline__ void tr_job_plain(const Frame& F, const float* W, int ldw, int Ndest, int K, T* WT, LAS float* scr, int phase_off) {
    const int nblk = Ndest / 32, nitems = (K / 64) * nblk;
    for (int it = (F.gw + phase_off) % F.NGW; it < nitems; it += F.NGW) {
        const int kb = it / nblk, nb = it % nblk;
        tr_item(W, ldw, nb * 32 + (F.lane & 31), true, nullptr, kb * 64, WT + (size_t)(nb * 32) * K, K, scr, F.lane);
    }
}
__device__ __forceinline__ void row_load(const float* p, int lane, f32x4 (&v)[4]) {
#pragma unroll
    for (int j = 0; j < 4; ++j) v[j] = __builtin_nontemporal_load((const f32x4*)p + lane + 64 * j);
}
__device__ __forceinline__ float row_ssq(const f32x4 (&v)[4]) { float s = 0.f;
#pragma unroll
    for (int j = 0; j < 4; ++j) s += (v[j].x * v[j].x + v[j].y * v[j].y) + (v[j].z * v[j].z + v[j].w * v[j].w);
    return wave_sum(s); }
template <typename T>
__device__ __forceinline__ void store_nm(const f32x4 (&xv)[4], float r2, const f32x4 (&gb)[4], const f32x4 (&gc)[4], T* dst, int lane, unsigned char* dst8) {
#pragma unroll
    for (int j = 0; j < 4; ++j) { const int ci = lane + 64 * j; const f32x4 o = xv[j] * r2 * gb[j] + gc[j];
        if constexpr (sizeof(T) == 1) __builtin_nontemporal_store(pk_f8x4(o.x * F8_ACT, o.y * F8_ACT, o.z * F8_ACT, o.w * F8_ACT), (unsigned*)dst + ci);
        else { u32x2 w; w.x = pk_h2(o.x, o.y); w.y = pk_h2(o.z, o.w); __builtin_nontemporal_store(w, (u32x2*)dst + ci); if (dst8) __builtin_nontemporal_store(pk_f8x4(o.x * F8_ACT, o.y * F8_ACT, o.z * F8_ACT, o.w * F8_ACT), (unsigned*)dst8 + ci); } }
}
template <typename T>
__device__ __forceinline__ void ph_normmod(const Frame& F, const float* x, const float* g, const float* mod, int isc, int ish, T* dst) {
    const int lane = flane();
    const int b = F.gw & 3, nsl = F.NGW >> 2; int r0 = F.gw >> 2; if (r0 >= SEQ) return;
    const float* mb = mod + b * (NMOD * DM); f32x4 gb[4], gc[4];
#pragma unroll
    for (int j = 0; j < 4; ++j) { const int ci = lane + 64 * j; gb[j] = ((const f32x4*)g)[ci] * (((const f32x4*)(mb + isc * DM))[ci] + 1.f); gc[j] = ((const f32x4*)(mb + ish * DM))[ci]; }
    const float* xb = x + (size_t)b * SEQ * DM; T* db = dst + (size_t)b * SEQ * DM;
    f32x4 v[2][4], vn[2][4];
#pragma unroll
    for (int k = 0; k < 2; ++k) { const int r = r0 + k * nsl; row_load(xb + (size_t)(r < SEQ ? r : r0) * DM, lane, v[k]); }
    for (;;) { const int rn = r0 + 2 * nsl; const bool has = rn < SEQ;
        if (has) {
#pragma unroll
            for (int k = 0; k < 2; ++k) { const int r = rn + k * nsl; row_load(xb + (size_t)(r < SEQ ? r : rn) * DM, lane, vn[k]); } }
#pragma unroll
        for (int k = 0; k < 2; ++k) { const int r = r0 + k * nsl; const float rstd = rsqrtf(row_ssq(v[k]) * (1.f / DM) + EPS);
            if (r < SEQ) store_nm(v[k], rstd, gb, gc, db + (size_t)r * DM, lane, nullptr); }
        if (!has) break;
#pragma unroll
        for (int k = 0; k < 2; ++k)
#pragma unroll
            for (int j = 0; j < 4; ++j) v[k][j] = vn[k][j];
        r0 = rn; }
}
__device__ __forceinline__ void row_load_h(const h16* p, int lane, u32x2 (&v)[4]) {
#pragma unroll
    for (int j = 0; j < 4; ++j) v[j] = __builtin_nontemporal_load((const u32x2*)p + lane + 64 * j);
}
typedef _Float16 h16x4 __attribute__((ext_vector_type(4)));
__device__ __forceinline__ f32x4 h4_to_f4(u32x2 w) { const h16x4 h = __builtin_bit_cast(h16x4, w); return (f32x4){(float)h[0], (float)h[1], (float)h[2], (float)h[3]}; }
template <bool XI16, bool XO16, typename T = h16>
__device__ __forceinline__ void ph_resnorm(const Frame& F, const void* xin_, const h16* f, const float* gpost, const float* mod, int igt, float coef, void* xout_,
                                           bool second, const float* gpre, int isc, int ish, T* dst, unsigned char* dst8 = nullptr) {
    const int lane = flane();
    const int b = F.gw & 3, nsl = F.NGW >> 2; int r0 = F.gw >> 2; if (r0 >= SEQ) return;
    const float* mb = mod + b * (NMOD * DM); f32x4 ga[4], gb[4], gc[4];
#pragma unroll
    for (int j = 0; j < 4; ++j) { const int ci = lane + 64 * j; ga[j] = ((const f32x4*)gpost)[ci] * ((const f32x4*)(mb + igt * DM))[ci] * coef;
        if (second) { gb[j] = ((const f32x4*)gpre)[ci] * (((const f32x4*)(mb + isc * DM))[ci] + 1.f); gc[j] = ((const f32x4*)(mb + ish * DM))[ci]; } else { gb[j] = (f32x4){0.f, 0.f, 0.f, 0.f}; gc[j] = gb[j]; } }
    const size_t bo = (size_t)b * SEQ * DM; const h16* fb = f + bo;
    u32x2 fh[2][4], fn[2][4]; f32x4 xi[2][4], xn[2][4]; u32x2 xh[2][4], xhn[2][4];
#pragma unroll
    for (int k = 0; k < 2; ++k) { const int r = r0 + k * nsl; const size_t ro = (size_t)(r < SEQ ? r : r0) * DM; row_load_h(fb + ro, lane, fh[k]);
        if constexpr (XI16) row_load_h((const h16*)xin_ + bo + ro, lane, xh[k]); else row_load((const float*)xin_ + bo + ro, lane, xi[k]); }
    for (;;) {
        const int rn = r0 + 2 * nsl; const bool has = rn < SEQ;
        if (has) {
#pragma unroll
            for (int k = 0; k < 2; ++k) { const int r = rn + k * nsl; const size_t ro = (size_t)(r < SEQ ? r : rn) * DM; row_load_h(fb + ro, lane, fn[k]);
                if constexpr (XI16) row_load_h((const h16*)xin_ + bo + ro, lane, xhn[k]); else row_load((const float*)xin_ + bo + ro, lane, xn[k]); } }
#pragma unroll
        for (int k = 0; k < 2; ++k) { const int r = r0 + k * nsl; const bool ok = r < SEQ; const size_t ro = bo + (size_t)r * DM;
            f32x4 v[4];
#pragma unroll
            for (int j = 0; j < 4; ++j) { v[j] = h4_to_f4(fh[k][j]); if constexpr (XI16) xi[k][j] = h4_to_f4(xh[k][j]); }
            const float rstd = rsqrtf(row_ssq(v) * (1.f / DM) + EPS);
#pragma unroll
            for (int j = 0; j < 4; ++j) { const int ci = lane + 64 * j;
                xi[k][j] = xi[k][j] + ga[j] * v[j] * rstd;
                if (ok) { if constexpr (XO16) { u32x2 w; w.x = pk_h2(xi[k][j].x, xi[k][j].y); w.y = pk_h2(xi[k][j].z, xi[k][j].w); __builtin_nontemporal_store(w, (u32x2*)((h16*)xout_ + ro) + ci); }
                          else __builtin_nontemporal_store(xi[k][j], (f32x4*)((float*)xout_ + ro) + ci); } }
            if (second) { const float r2 = rsqrtf(row_ssq(xi[k]) * (1.f / DM) + EPS); if (ok) store_nm(xi[k], r2, gb, gc, dst + ro, lane, dst8 ? dst8 + ro : nullptr); } }
        if (!has) break;
#pragma unroll
        for (int k = 0; k < 2; ++k)
#pragma unroll
            for (int j = 0; j < 4; ++j) { fh[k][j] = fn[k][j]; if constexpr (XI16) xh[k][j] = xhn[k][j]; else xi[k][j] = xn[k][j]; }
        r0 = rn;
    }
}

__device__ __forceinline__ void ph_combine(const Frame& F, const h16* og, const float* lse2, h16* ob) {
    for (int idx = blockIdx.x * NTHR + F.tid; idx < MT * 32; idx += F.G * NTHR) {
        const int tok = idx >> 5, c = (idx & 31) * 8, hh = c >> 6;
        const float l0 = lse2[tok * 12 + hh], l1 = lse2[tok * 12 + 4 + hh], l2 = lse2[tok * 12 + 8 + hh], m = fmaxf(l0, fmaxf(l1, l2));
        const float w0 = exp2f(l0 - m), w1 = exp2f(l1 - m), w2 = exp2f(l2 - m), inv = 1.f / (w0 + w1 + w2);
        const u32x4 a = *(const u32x4*)(og + (size_t)tok * 768 + c), b = *(const u32x4*)(og + (size_t)tok * 768 + 256 + c), d = *(const u32x4*)(og + (size_t)tok * 768 + 512 + c);
        const f16x8 ha = __builtin_bit_cast(f16x8, a), hb = __builtin_bit_cast(f16x8, b), hd = __builtin_bit_cast(f16x8, d);
        float o[8];
#pragma unroll
        for (int i = 0; i < 8; ++i) o[i] = (w0 * (float)ha[i] + w1 * (float)hb[i] + w2 * (float)hd[i]) * inv;
        u32x4 w; w.x = pk_h2(o[0], o[1]); w.y = pk_h2(o[2], o[3]); w.z = pk_h2(o[4], o[5]); w.w = pk_h2(o[6], o[7]);
        *(u32x4*)(ob + (size_t)tok * 256 + c) = w; }
}
typedef short v4i16_t __attribute__((ext_vector_type(4)));
typedef short s16x8 __attribute__((ext_vector_type(8)));
typedef float f32x16 __attribute__((ext_vector_type(16)));
__device__ __forceinline__ int tk_bin(float sc) { const unsigned u = __float_as_uint(sc); int e = (int)((u >> 16) & 0x7FFFu) - (122 << 7); e = e < 0 ? 0 : (e > 1023 ? 1023 : e); return (u >> 31) ? 1023 - e : 1024 + e; }
__device__ __forceinline__ void tk_scores(const f16x8 (&Af)[2], const float (&wv)[16], f16x8 b0, f16x8 b1, float& sa, float& sb) {
    f32x16 d = {0.f, 0.f, 0.f, 0.f, 0.f, 0.f, 0.f, 0.f, 0.f, 0.f, 0.f, 0.f, 0.f, 0.f, 0.f, 0.f};
    d = __builtin_amdgcn_mfma_f32_32x32x16_f16(Af[0], b0, d, 0, 0, 0); d = __builtin_amdgcn_mfma_f32_32x32x16_f16(Af[1], b1, d, 0, 0, 0);
    f32x2 acc = {0.f, 0.f};
#pragma unroll
    for (int e = 0; e < 16; e += 2) { const int i0 = __float_as_int(d[e]), i1 = __float_as_int(d[e + 1]);
        const f32x2 rl = {__int_as_float(i0 > 0 ? i0 : 0), __int_as_float(i1 > 0 ? i1 : 0)}; const f32x2 w2 = {wv[e], wv[e + 1]};
        acc = __builtin_elementwise_fma(w2, rl, acc); }
    sa = acc.x; sb = acc.y;
}
template <bool P2>
__device__ __forceinline__ void tk_tile(const f16x8 (&Af)[2], const float (&wv)[16], f16x8 b0, f16x8 b1, int tile, int r, int hi, int ta, LAS unsigned* hist, const int (&tbin)[4], int (&cs)[4], int (&cc)[4],
                                        LAS unsigned short* sel, int tok0, unsigned* sscr, unsigned sload = 0u) {
    float sa, sb;
    if constexpr (!P2) { tk_scores(Af, wv, b0, b1, sa, sb); const h16x2 hp = {(h16)sa, (h16)sb}; sa = (float)hp[0]; sb = (float)hp[1]; sscr[tile * 64 + 2 * r + hi] = __builtin_bit_cast(unsigned, hp); }
    else { const h16x2 hp = __builtin_bit_cast(h16x2, sload); sa = (float)hp[0]; sb = (float)hp[1]; }
    const int s = 32 * tile + r;
    if constexpr (!P2) {
        if (s <= ta) { const int bn = tk_bin(sa); __hip_atomic_fetch_add(hist + (2 * hi) * 1024 + (bn >> 1), 1u << (16 * (bn & 1)), __ATOMIC_RELAXED, __HIP_MEMORY_SCOPE_WORKGROUP); }
        if (s <= ta + 1) { const int bn = tk_bin(sb); __hip_atomic_fetch_add(hist + (2 * hi + 1) * 1024 + (bn >> 1), 1u << (16 * (bn & 1)), __ATOMIC_RELAXED, __HIP_MEMORY_SCOPE_WORKGROUP); }
    } else {
        const unsigned lowmask = (1u << r) - 1u;
#pragma unroll
        for (int ab = 0; ab < 2; ++ab) { const float sc = ab ? sb : sa; const int tq = ta + ab; const int bn = tk_bin(sc);
            const int mytb = hi ? tbin[2 + ab] : tbin[ab];
            const bool valid = s <= tq, sure = valid && bn > mytb, cand = valid && bn == mytb;
            const unsigned long long ms = __ballot(sure), mc = __ballot(cand);
            const unsigned ms_h = hi ? (unsigned)(ms >> 32) : (unsigned)ms, mc_h = hi ? (unsigned)(mc >> 32) : (unsigned)mc;
            const int q = 2 * hi + ab;
            const int base_s = hi ? cs[2 + ab] : cs[ab], base_c = hi ? cc[2 + ab] : cc[ab];
            if (sure) sel[q * TOPK + base_s + __builtin_popcount(ms_h & lowmask)] = (unsigned short)s;
            if (cand) { const int pos = base_c + __builtin_popcount(mc_h & lowmask);
                if (pos < 512) ((LAS unsigned long long*)((LAS unsigned char*)hist + q * 4096))[pos] = ((unsigned long long)fkey(sc) << 16) | (unsigned long long)(0xFFFFu - (unsigned)s); }
            cs[ab] += __builtin_popcount((unsigned)ms); cs[2 + ab] += __builtin_popcount((unsigned)(ms >> 32));
            cc[ab] += __builtin_popcount((unsigned)mc); cc[2 + ab] += __builtin_popcount((unsigned)(mc >> 32)); }
    }
}
template <bool P2>
__device__ __forceinline__ void tk_pass(const f16x8 (&Af)[2], const float (&wv)[16], const h16* kbase, int ntiles, int r, int hi, int ta, LAS unsigned* hist, const int (&tbin)[4], int (&cs)[4], int (&cc)[4],
                                        LAS unsigned short* sel, int tok0, unsigned* sscr) {
    if constexpr (P2) {
        const unsigned* sp_ = sscr + 2 * r + hi; unsigned SA[8], SB[8]; const f16x8 z8 = {0, 0, 0, 0, 0, 0, 0, 0};
#define TK_LOADS(dst, t0_) do { _Pragma("unroll") for (int i_ = 0; i_ < 8; ++i_) { const int tt_ = ((t0_) + i_) < 127 ? ((t0_) + i_) : 127; dst[i_] = __builtin_nontemporal_load(sp_ + tt_ * 64); } } while (0)
        TK_LOADS(SA, 0);
        for (int t0 = 0; t0 < ntiles; t0 += 16) {
            TK_LOADS(SB, t0 + 8);
#pragma unroll
            for (int i = 0; i < 8; ++i) if (t0 + i < ntiles) tk_tile<true>(Af, wv, z8, z8, t0 + i, r, hi, ta, hist, tbin, cs, cc, sel, tok0, sscr, SA[i]);
            TK_LOADS(SA, t0 + 16);
#pragma unroll
            for (int i = 0; i < 8; ++i) if (t0 + 8 + i < ntiles) tk_tile<true>(Af, wv, z8, z8, t0 + 8 + i, r, hi, ta, hist, tbin, cs, cc, sel, tok0, sscr, SB[i]);
        }
#undef TK_LOADS
        return; }
    f16x8 BA[4][2], BB[4][2];
#define TK_LOAD(dst, t0_) do { _Pragma("unroll") for (int i_ = 0; i_ < 4; ++i_) { const int tt_ = ((t0_) + i_) < 127 ? ((t0_) + i_) : 127; dst[i_][0] = *(const f16x8*)(kbase + (size_t)tt_ * 1024); dst[i_][1] = *(const f16x8*)(kbase + (size_t)tt_ * 1024 + 16); } } while (0)
    TK_LOAD(BA, 0);
    for (int t0 = 0; t0 < ntiles; t0 += 8) {
        TK_LOAD(BB, t0 + 4);
#pragma unroll
        for (int i = 0; i < 4; ++i) if (t0 + i < ntiles) tk_tile<P2>(Af, wv, BA[i][0], BA[i][1], t0 + i, r, hi, ta, hist, tbin, cs, cc, sel, tok0, sscr);
        TK_LOAD(BA, t0 + 8);
#pragma unroll
        for (int i = 0; i < 4; ++i) if (t0 + 4 + i < ntiles) tk_tile<P2>(Af, wv, BB[i][0], BB[i][1], t0 + 4 + i, r, hi, ta, hist, tbin, cs, cc, sel, tok0, sscr);
    }
#undef TK_LOAD
}
__device__ __forceinline__ void tk_group(const Frame& F, const h16* qi, const h16* ki, const float* wi, LAS unsigned short* sel, int b, int t0, LAS unsigned* hist, unsigned* sscr) {
    int lane_ = F.lane; asm volatile("" : "+v"(lane_)); const int lane = lane_, r = lane & 31, hi = lane >> 5, tok0 = b * SEQ + t0;
    const int qa = 2 * ((r >> 2) & 1) + (r & 1), ha = 4 * (r >> 4) + 2 * ((r >> 3) & 1) + ((r >> 1) & 1);
    f16x8 Af[2];
#pragma unroll
    for (int s_ = 0; s_ < 2; ++s_) Af[s_] = *(const f16x8*)(qi + (size_t)(tok0 + qa) * 256 + ha * 32 + 16 * s_ + 8 * hi);
    float wv[16];
    { const f32x4 a0 = *(const f32x4*)(wi + (tok0 + 2 * hi) * 8), a1 = *(const f32x4*)(wi + (tok0 + 2 * hi) * 8 + 4), b0 = *(const f32x4*)(wi + (tok0 + 2 * hi + 1) * 8), b1 = *(const f32x4*)(wi + (tok0 + 2 * hi + 1) * 8 + 4);
      const float sa[8] = {a0.x, a0.y, a0.z, a0.w, a1.x, a1.y, a1.z, a1.w}, sb[8] = {b0.x, b0.y, b0.z, b0.w, b1.x, b1.y, b1.z, b1.w};
#pragma unroll
      for (int h = 0; h < 8; ++h) { wv[2 * h] = sa[h] * 0.17677669529663687f; wv[2 * h + 1] = sb[h] * 0.17677669529663687f; } }
    const int ntiles = (t0 + 3) / 32 + 1, ta = t0 + 2 * hi;
    const h16* kbase = ki + (size_t)(b * SEQ + r) * 32 + 8 * hi;
    int tbin[4] = {0, 0, 0, 0}, nsure[4], cs[4] = {0, 0, 0, 0}, cc[4] = {0, 0, 0, 0};
#pragma unroll
    for (int i = 0; i < 16; ++i) *(LAS u32x4*)((LAS unsigned char*)hist + i * 1024 + lane * 16) = (u32x4){0u, 0u, 0u, 0u};
    asm volatile("s_waitcnt lgkmcnt(0)" ::: "memory");
    tk_pass<false>(Af, wv, kbase, ntiles, r, hi, ta, hist, tbin, cs, cc, sel, tok0, sscr);
    asm volatile("s_waitcnt vmcnt(0)" ::: "memory");
    asm volatile("s_waitcnt lgkmcnt(0)" ::: "memory");
#pragma unroll
    for (int q = 0; q < 4; ++q) {
        const LAS unsigned* hq = hist + q * 1024;
        unsigned sum = 0;
#pragma unroll
        for (int i = 0; i < 4; ++i) { const u32x4 v = *(const LAS u32x4*)(hq + 16 * lane + 4 * i); sum += (v.x & 0xFFFFu) + (v.x >> 16) + (v.y & 0xFFFFu) + (v.y >> 16) + (v.z & 0xFFFFu) + (v.z >> 16) + (v.w & 0xFFFFu) + (v.w >> 16); }
        unsigned incl = sum;
#pragma unroll
        for (int o = 1; o < 64; o <<= 1) { const unsigned v = __shfl_down(incl, o); if (lane + o < 64) incl += v; }
        const unsigned long long bal = __ballot(incl >= (unsigned)TOPK);
        const int L = 63 - __builtin_clzll(bal);
        unsigned cum = __shfl(incl, L) - __shfl(sum, L);
        int tbq = 32 * L, found = 0;
        for (int wd = 15; wd >= 0 && !found; --wd) { const unsigned v = hq[16 * L + wd];
            const unsigned chi = v >> 16, clo = v & 0xFFFFu;
            if (cum + chi >= (unsigned)TOPK) { tbq = 32 * L + 2 * wd + 1; found = 1; } else { cum += chi;
                if (cum + clo >= (unsigned)TOPK) { tbq = 32 * L + 2 * wd; found = 1; } else cum += clo; } }
        tbin[q] = tbq; nsure[q] = (int)cum;
    }
    asm volatile("s_waitcnt lgkmcnt(0)" ::: "memory");
    tk_pass<true>(Af, wv, kbase, ntiles, r, hi, ta, hist, tbin, cs, cc, sel, tok0, sscr);
    asm volatile("s_waitcnt lgkmcnt(0)" ::: "memory");
#pragma unroll
    for (int q = 0; q < 4; ++q) {
        const int nc = cc[q] < 512 ? cc[q] : 512, need = TOPK - cs[q];
        const LAS unsigned long long* cq = (const LAS unsigned long long*)((const LAS unsigned char*)hist + q * 4096);
        if (nc > 64) {
            unsigned long long it[8];
#pragma unroll
            for (int k = 0; k < 8; ++k) it[k] = (k * 64 + lane < nc) ? cq[k * 64 + lane] : 0ull;
            unsigned long long T = 0ull;
            for (int bit = 47; bit >= 0; --bit) { const unsigned long long cand = T | (1ull << bit); int cnt = 0;
#pragma unroll
                for (int k = 0; k < 8; ++k) cnt += __builtin_popcountll(__ballot(it[k] >= cand));
                if (cnt >= need) T = cand; }
            int basep = cs[q];
#pragma unroll
            for (int k = 0; k < 8; ++k) { const bool pick = (T != 0ull) && it[k] >= T; const unsigned long long mk = __ballot(pick);
                if (pick) sel[q * TOPK + basep + __builtin_popcountll(mk & ((1ull << lane) - 1ull))] = (unsigned short)(0xFFFFu - (unsigned)(it[k] & 0xFFFFull));
                basep += __builtin_popcountll(mk); }
        } else
        for (int base = 0; base < nc; base += 64) {
            const bool act = base + lane < nc; const unsigned long long my = act ? cq[base + lane] : 0ull; int rank = 0;
            for (int jb = 0; jb < nc; jb += 64) {
                const unsigned long long cj = (jb + lane < nc) ? cq[jb + lane] : 0ull; const unsigned clo = (unsigned)cj, chi = (unsigned)(cj >> 32);
                const int n = (nc - jb) < 64 ? (nc - jb) : 64;
                for (int j = 0; j < n; ++j) { const unsigned long long sj = ((unsigned long long)(unsigned)__builtin_amdgcn_readlane((int)chi, j) << 32) | (unsigned)__builtin_amdgcn_readlane((int)clo, j); rank += (sj > my) ? 1 : 0; } }
            if (act && rank < need) sel[q * TOPK + cs[q] + rank] = (unsigned short)(0xFFFFu - (unsigned)(my & 0xFFFFull)); }
    }
    (void)nsure;
    asm volatile("s_waitcnt lgkmcnt(0)" ::: "memory");
}

__device__ __forceinline__ void ph_dilated_mfma(const Frame& F, const h16* qb, const h16* kb, const h16* vb, h16* og, float* lse2) {
    const int lane = F.lane, ql = lane & 31, hi = lane >> 5;
    LAS unsigned char* VL = F.lds + F.wave * 16384;
    LAS float* linv = (LAS float*)(VL + 12288);
    constexpr int VROW = 192;
    const int trq = (lane & 15) >> 2, trp = lane & 3, trg = (lane >> 4) & 1;
    for (int u = F.gw; u < NB * 12 * 128; u += F.NGW) {
        const int b = u / 1536, rem = u % 1536, gh = rem >> 7, g = gh >> 2, wi_ = rem & 127, dil = dil_of(g), sh = g == 0 ? 0 : (g == 1 ? 2 : 4);
        const int nblk = 128 >> sh, res = wi_ / nblk, j0 = 32 * (wi_ % nblk);
        const size_t hoff = (size_t)b * SEQ * 768 + gh * 64;
        f16x8 Qf[4];
        { const h16* qp = qb + hoff + (size_t)((j0 + ql) * dil + res) * 768 + 8 * hi;
#pragma unroll
          for (int s_ = 0; s_ < 4; ++s_) Qf[s_] = *(const f16x8*)(qp + 16 * s_); }
        f32x16 S[5];
        f16x8 Kf[5][4];
#pragma unroll
        for (int kt = 0; kt < 5; ++kt) { int jk = j0 - 128 + 32 * kt + ql; jk = jk < 0 ? 0 : jk;
            const h16* kp = kb + hoff + (size_t)(jk * dil + res) * 768 + 8 * hi;
#pragma unroll
            for (int s_ = 0; s_ < 4; ++s_) Kf[kt][s_] = *(const f16x8*)(kp + 16 * s_); }
#pragma unroll
        for (int kt = 0; kt < 5; ++kt) {
            f32x16 d = {0.f, 0.f, 0.f, 0.f, 0.f, 0.f, 0.f, 0.f, 0.f, 0.f, 0.f, 0.f, 0.f, 0.f, 0.f, 0.f};
#pragma unroll
            for (int s_ = 0; s_ < 4; ++s_) d = __builtin_amdgcn_mfma_f32_32x32x16_f16(Kf[kt][s_], Qf[s_], d, 0, 0, 0);
            S[kt] = d; }
        f16x8 Vr[5][4];
#pragma unroll
        for (int kt = 0; kt < 5; ++kt) { int jk = j0 - 128 + 32 * kt + (lane >> 1); jk = jk < 0 ? 0 : jk;
            const h16* vp = vb + hoff + (size_t)(jk * dil + res) * 768 + (lane & 1) * 32;
#pragma unroll
            for (int i = 0; i < 4; ++i) Vr[kt][i] = *(const f16x8*)(vp + 8 * i); }
        float m = -INFINITY;
#pragma unroll
        for (int kt = 0; kt < 5; ++kt)
#pragma unroll
            for (int e = 0; e < 16; ++e) { const int kl = (e & 3) + 8 * (e >> 2) + 4 * hi; bool ok = (j0 - 128 + 32 * kt + kl) >= 0;
                if (kt == 0) ok = ok && (kl >= ql); if (kt == 4) ok = ok && (kl <= ql);
                if (!ok) S[kt][e] = -INFINITY; m = fmaxf(m, S[kt][e]); }
        m = max_x32(m);
        float l = 0.f;
#pragma unroll
        for (int kt = 0; kt < 5; ++kt)
#pragma unroll
            for (int e = 0; e < 16; ++e) { const float p = __builtin_amdgcn_exp2f(S[kt][e] - m); S[kt][e] = p; l += p; }
        l = sum_x32(l);
        if (hi == 0) { linv[ql] = __builtin_amdgcn_rcpf(l); lse2[(size_t)(b * SEQ + (j0 + ql) * dil + res) * 12 + gh] = m + __builtin_amdgcn_logf(l); }
        f32x16 O[2];
#pragma unroll
        for (int dt = 0; dt < 2; ++dt) O[dt] = (f32x16){0.f, 0.f, 0.f, 0.f, 0.f, 0.f, 0.f, 0.f, 0.f, 0.f, 0.f, 0.f, 0.f, 0.f, 0.f, 0.f};
#pragma unroll
        for (int kt = 0; kt < 5; ++kt) {
            LAS unsigned char* vbuf = VL + (kt & 1) * 6144;
#pragma unroll
            for (int i = 0; i < 4; ++i) *(LAS f16x8*)(vbuf + (lane >> 1) * VROW + (lane & 1) * 64 + i * 16) = Vr[kt][i];
            asm volatile("s_waitcnt lgkmcnt(0)" ::: "memory");
#pragma unroll
            for (int s2 = 0; s2 < 2; ++s2) {
                u32x4 pa; pa.x = pk_h2(S[kt][8 * s2 + 0], S[kt][8 * s2 + 1]); pa.y = pk_h2(S[kt][8 * s2 + 2], S[kt][8 * s2 + 3]); pa.z = pk_h2(S[kt][8 * s2 + 4], S[kt][8 * s2 + 5]); pa.w = pk_h2(S[kt][8 * s2 + 6], S[kt][8 * s2 + 7]);
#pragma unroll
                for (int dt = 0; dt < 2; ++dt) {
                    const v4i16_t lo = __builtin_amdgcn_ds_read_tr16_b64_v4i16((LAS v4i16_t*)(vbuf + (16 * s2 + 4 * hi + trq) * VROW + (32 * dt + 16 * trg + 4 * trp) * 2));
                    const v4i16_t hh = __builtin_amdgcn_ds_read_tr16_b64_v4i16((LAS v4i16_t*)(vbuf + (16 * s2 + 8 + 4 * hi + trq) * VROW + (32 * dt + 16 * trg + 4 * trp) * 2));
                    const s16x8 bv = {lo[0], lo[1], lo[2], lo[3], hh[0], hh[1], hh[2], hh[3]};
                    O[dt] = __builtin_amdgcn_mfma_f32_32x32x16_f16(__builtin_bit_cast(f16x8, pa), __builtin_bit_cast(f16x8, bv), O[dt], 0, 0, 0); } }
            asm volatile("s_waitcnt lgkmcnt(0)" ::: "memory");
        }
#pragma unroll
        for (int e = 0; e < 16; ++e) { const int q = (e & 3) + 8 * (e >> 2) + 4 * hi; const float il = linv[q];
            h16* op = og + (size_t)(b * SEQ + (j0 + q) * dil + res) * 768 + gh * 64 + ql;
            op[0] = (h16)(O[0][e] * il); op[32] = (h16)(O[1][e] * il); }
        asm volatile("s_waitcnt lgkmcnt(0)" ::: "memory");
    }
}


__device__ __forceinline__ f16x8 fp8x8_to_f16(unsigned w0, unsigned w1) {
    const h16x2 a = __builtin_amdgcn_cvt_scalef32_pk_f16_fp8((int)w0, 1.0f, false), b = __builtin_amdgcn_cvt_scalef32_pk_f16_fp8((int)w0, 1.0f, true),
                c = __builtin_amdgcn_cvt_scalef32_pk_f16_fp8((int)w1, 1.0f, false), d = __builtin_amdgcn_cvt_scalef32_pk_f16_fp8((int)w1, 1.0f, true);
    const u32x4 r = {__builtin_bit_cast(unsigned, a), __builtin_bit_cast(unsigned, b), __builtin_bit_cast(unsigned, c), __builtin_bit_cast(unsigned, d)};
    return __builtin_bit_cast(f16x8, r);
}
typedef int i32x2_t __attribute__((ext_vector_type(2)));
template <bool FUSED>
__device__ __forceinline__ void ph_sparse_wave(const Frame& F, h16* qlat, const h16* qr, const unsigned char* ckv8, const unsigned char* kr8, const LAS unsigned short* selL, int ta = 0) {
    int lane = F.lane; asm volatile("" : "+v"(lane));
    LAS unsigned char* V = F.lds + F.wave * 16384;
    const int tr_r = (lane & 15) >> 1, tr_c = lane & 1, tr_key = (tr_r < 4) ? (4 * (lane >> 4) + tr_r) : (16 + 4 * (lane >> 4) + tr_r - 4);
    const int tr0 = tr_key * 256 + 8 * tr_c, x0 = (tr_key & 15) ^ ((tr_key >> 4) << 3);
    const int lane0 = lane;
    const int nit = 4;
    for (int it = 0; it < nit; ++it) {
        const int tok = ta + it;
        int ll = lane0; asm volatile("" : "+v"(ll));
        const int c = ll & 15, kq = ll >> 4, hd = c & 7;
        const int b = tok / SEQ, t = tok % SEQ, cnt = (t + 1 < TOPK) ? t + 1 : TOPK, nch = (cnt + 31) >> 5;
        const LAS unsigned short* sp = selL + it * TOPK + c;
        u32x4 Q8[4]; f16x8 Qr;
#pragma unroll
        for (int q4 = 0; q4 < 4; ++q4) Q8[q4] = *(const u32x4*)((const unsigned char*)qlat + (size_t)tok * 4096 + hd * 256 + 64 * q4 + 16 * kq);
        { const f16x8 q0 = *(const f16x8*)(qr + (size_t)tok * 256 + hd * 32 + 8 * kq);
#pragma unroll
          for (int i = 0; i < 8; ++i) Qr[i] = q0[i] * (h16)64.f; }
        const i32x8 Qa = __builtin_shufflevector(__builtin_bit_cast(i32x4, Q8[0]), __builtin_bit_cast(i32x4, Q8[1]), 0, 1, 2, 3, 4, 5, 6, 7), Qb = __builtin_shufflevector(__builtin_bit_cast(i32x4, Q8[2]), __builtin_bit_cast(i32x4, Q8[3]), 0, 1, 2, 3, 4, 5, 6, 7);
        u32x4 KrA[2][4], KrB[2][4]; u32x2 RrA[2], RrB[2];
#define SW_LOADK(KR, RR, CH) do { const int r0_ = b * SEQ + (int)sp[32 * (CH)], r1_ = b * SEQ + (int)sp[32 * (CH) + 16]; \
        const unsigned char* p0_ = ckv8 + (size_t)r0_ * 256 + 16 * kq; const unsigned char* p1_ = ckv8 + (size_t)r1_ * 256 + 16 * kq; const unsigned char* p2_ = kr8 + (size_t)r0_ * 32 + 8 * kq; const unsigned char* p3_ = kr8 + (size_t)r1_ * 32 + 8 * kq; \
        asm volatile("global_load_dwordx4 %0, %8, off\n\tglobal_load_dwordx4 %1, %8, off offset:64\n\tglobal_load_dwordx4 %2, %8, off offset:128\n\tglobal_load_dwordx4 %3, %8, off offset:192\n\t" \
                     "global_load_dwordx4 %4, %9, off\n\tglobal_load_dwordx4 %5, %9, off offset:64\n\tglobal_load_dwordx4 %6, %9, off offset:128\n\tglobal_load_dwordx4 %7, %9, off offset:192" \
                     : "=&v"(KR[0][0]), "=&v"(KR[0][1]), "=&v"(KR[0][2]), "=&v"(KR[0][3]), "=&v"(KR[1][0]), "=&v"(KR[1][1]), "=&v"(KR[1][2]), "=&v"(KR[1][3]) : "v"(p0_), "v"(p1_) : "memory"); \
        asm volatile("global_load_dwordx2 %0, %2, off\n\tglobal_load_dwordx2 %1, %3, off" : "=&v"(RR[0]), "=&v"(RR[1]) : "v"(p2_), "v"(p3_) : "memory"); } while (0)
#define SW_WAITK(KR, RR, N) asm volatile("s_waitcnt vmcnt(" #N ")" : "+v"(KR[0][0]), "+v"(KR[0][1]), "+v"(KR[0][2]), "+v"(KR[0][3]), "+v"(KR[1][0]), "+v"(KR[1][1]), "+v"(KR[1][2]), "+v"(KR[1][3]), "+v"(RR[0]), "+v"(RR[1]) :: "memory")
        asm volatile("s_waitcnt vmcnt(0)" ::: "memory");
        SW_LOADK(KrA, RrA, 0);
        SW_LOADK(KrB, RrB, 1);
        float m = -INFINITY, l = 0.f;
        f32x4 O[16];
#pragma unroll
        for (int ft = 0; ft < 16; ++ft) O[ft] = (f32x4){0.f, 0.f, 0.f, 0.f};
#define SW_CHUNK(KR, RR, CH, NWAIT, LOADNEXT) do { \
            LAS unsigned char* Vb = V + ((CH) & 1) * 8192; \
            SW_WAITK(KR, RR, NWAIT); \
            _Pragma("unroll") for (int tl = 0; tl < 2; ++tl) _Pragma("unroll") for (int q4 = 0; q4 < 4; ++q4) *(LAS u32x4*)(Vb + (16 * tl + c) * 256 + (((4 * q4 + kq) ^ (c ^ (8 * tl))) << 4)) = KR[tl][q4]; \
            f32x4 S[2]; \
            _Pragma("unroll") for (int tl = 0; tl < 2; ++tl) { \
                const i32x8 Ka = __builtin_shufflevector(__builtin_bit_cast(i32x4, KR[tl][0]), __builtin_bit_cast(i32x4, KR[tl][1]), 0, 1, 2, 3, 4, 5, 6, 7), Kb = __builtin_shufflevector(__builtin_bit_cast(i32x4, KR[tl][2]), __builtin_bit_cast(i32x4, KR[tl][3]), 0, 1, 2, 3, 4, 5, 6, 7); \
                S[tl] = __builtin_amdgcn_mfma_scale_f32_16x16x128_f8f6f4(Ka, Qa, (f32x4){0.f, 0.f, 0.f, 0.f}, 0, 0, 0, 0, 0, 0); \
                S[tl] = __builtin_amdgcn_mfma_scale_f32_16x16x128_f8f6f4(Kb, Qb, S[tl], 0, 0, 0, 0, 0, 0); \
                S[tl] = __builtin_amdgcn_mfma_f32_16x16x32_f16(fp8x8_to_f16(RR[tl].x, RR[tl].y), Qr, S[tl], 0, 0, 0); } \
            asm volatile("" : "+v"(S[0]), "+v"(S[1]));                        \
            asm volatile("s_waitcnt lgkmcnt(0)" ::: "memory");               \
            if (LOADNEXT) SW_LOADK(KR, RR, (CH) + 2); \
            float cm = -INFINITY; \
            _Pragma("unroll") for (int tl = 0; tl < 2; ++tl) _Pragma("unroll") for (int e = 0; e < 4; ++e) { S[tl][e] = (32 * (CH) + 16 * tl + 4 * kq + e >= cnt) ? -INFINITY : S[tl][e] * (1.f / 64.f); cm = fmaxf(cm, S[tl][e]); } \
            cm = max_x16(cm); cm = max_x32(cm); \
              \
            if (__any(cm > m + 4.0f)) { const float mn = fmaxf(m, cm), alpha = __builtin_amdgcn_exp2f(m - mn); m = mn; l *= alpha; \
                _Pragma("unroll") for (int ft = 0; ft < 16; ++ft) O[ft] = O[ft] * alpha; } \
            float pe[2][4]; float ps = 0.f; \
            _Pragma("unroll") for (int tl = 0; tl < 2; ++tl) _Pragma("unroll") for (int e = 0; e < 4; ++e) { pe[tl][e] = __builtin_amdgcn_exp2f(S[tl][e] - m); ps += pe[tl][e]; } \
            l += ps; \
            u32x2 pk; pk.x = pk_f8x4(pe[0][0] * 16.f, pe[0][1] * 16.f, pe[0][2] * 16.f, pe[0][3] * 16.f); pk.y = pk_f8x4(pe[1][0] * 16.f, pe[1][1] * 16.f, pe[1][2] * 16.f, pe[1][3] * 16.f); \
            const long Pf = __builtin_bit_cast(long, pk); \
            _Pragma("unroll") for (int ft = 0; ft < 16; ++ft) { \
                const i32x2_t av = __builtin_amdgcn_ds_read_tr8_b64_v2i32((LAS i32x2_t*)(Vb + tr0 + ((ft ^ x0) << 4))); \
                O[ft] = __builtin_amdgcn_mfma_f32_16x16x32_fp8_fp8(__builtin_bit_cast(long, av), Pf, O[ft], 0, 0, 0); } } while (0)
        for (int ch = 0; ch < 6; ch += 2) {
            SW_CHUNK(KrA, RrA, ch, 10, true);
            SW_CHUNK(KrB, RrB, ch + 1, 10, true);
        }
        SW_CHUNK(KrA, RrA, 6, 10, false);
        SW_CHUNK(KrB, RrB, 7, 0, false);
#undef SW_CHUNK
#undef SW_WAITK
        asm volatile("s_waitcnt lgkmcnt(0)" ::: "memory");
        l = sum_x16(l); l = sum_x32(l);
        if (c < 8) { const float il = __builtin_amdgcn_rcpf(l) * (1.f / 16.f);
#pragma unroll
            for (int ft = 0; ft < 16; ++ft) { const f32x4 o = O[ft] * il; u32x2 pk; pk.x = pk_h2(o.x, o.y); pk.y = pk_h2(o.z, o.w);
                *(LAS u32x2*)(V + c * 512 + ((4 * (ft ^ c) + kq) << 3)) = pk; } }
        asm volatile("s_waitcnt lgkmcnt(0)" ::: "memory");
        { u32x4 ov[4];
#pragma unroll
          for (int r_ = 0; r_ < 4; ++r_) { const int P = r_ * 64 + ll, h = P >> 5, p = P & 31; ov[r_] = *(const LAS u32x4*)(V + h * 512 + ((p ^ (2 * h)) << 4)); }
#pragma unroll
          for (int r_ = 0; r_ < 4; ++r_) *(u32x4*)(qlat + (size_t)tok * 2048 + (r_ * 64 + ll) * 8) = ov[r_]; }
        asm volatile("s_waitcnt lgkmcnt(0)" ::: "memory");
#undef SW_LOADK
    }
}


__device__ __forceinline__ void precomb_tiles(const Frame& F, const Args& args, unsigned char* ws, int t_lo, int t_hi, int wg, int nwg) {
    LAS float* As = (LAS float*)(F.lds); LAS float* Bs = (LAS float*)(F.lds + 64 * 65 * 4);
    for (int tl = t_lo + wg; tl < t_hi; tl += nwg) {
        __syncthreads();
        const bool ql = tl < 192; int hd, rb, xb;
        if (ql) { hd = tl / 24; rb = (tl % 24) / 6; xb = tl % 6; } else { const int t2 = tl - 192; hd = t2 / 64; rb = (t2 % 64) / 16; xb = t2 % 16; }
#pragma unroll
        for (int k = 0; k < 2; ++k) { const int i4 = F.tid + NTHR * k, row = i4 >> 4, c4 = (i4 & 15) * 4;
            if (ql) { const f32x4 a = *(const f32x4*)(args.in[15] + (size_t)(rb * 64 + row) * 512 + hd * 64 + c4), bq = *(const f32x4*)(args.in[14] + (size_t)(xb * 64 + row) * 768 + hd * 96 + c4);
#pragma unroll
                for (int e = 0; e < 4; ++e) { As[row * 65 + c4 + e] = a[e]; Bs[row * 65 + c4 + e] = bq[e]; } }
            else { const f32x4 a = *(const f32x4*)(args.in[18] + (size_t)(hd * 64 + row) * DM + xb * 64 + c4), bq = *(const f32x4*)(args.in[16] + (size_t)(rb * 64 + row) * 512 + hd * 64 + c4);
#pragma unroll
                for (int e = 0; e < 4; ++e) { As[(c4 + e) * 65 + row] = a[e]; Bs[row * 65 + c4 + e] = bq[e]; } } }
        __syncthreads();
        const int j = F.tid & 63, ig = F.wave;
        float acc8[8];
#pragma unroll
        for (int ii = 0; ii < 8; ++ii) acc8[ii] = 0.f;
#pragma unroll 4
        for (int v = 0; v < 64; ++v) { const float bv = Bs[j * 65 + v];
#pragma unroll
            for (int ii = 0; ii < 8; ++ii) acc8[ii] += As[(ig * 8 + ii) * 65 + v] * bv; }
        if (ql) { const float gj = args.in[12][xb * 64 + j]; h16* o = (h16*)(ws + OW_4);
#pragma unroll
            for (int ii = 0; ii < 8; ++ii) o[(size_t)(hd * 256 + rb * 64 + ig * 8 + ii) * QL + xb * 64 + j] = (h16)(acc8[ii] * gj); }
        else { h16* o = (h16*)(ws + OW_OV);
#pragma unroll
            for (int ii = 0; ii < 8; ++ii) o[(size_t)(xb * 64 + ig * 8 + ii) * 2048 + hd * 256 + rb * 64 + j] = (h16)acc8[ii]; }
    }
    __syncthreads();
}


__device__ __forceinline__ void ph_topk_sparse(const Frame& F, const h16* qi, const h16* ki, const float* wi, h16* qlat, const h16* qr, const unsigned char* ckv8, const unsigned char* kr8, unsigned char* ws, unsigned char* dout) {
    LAS unsigned* hist = (LAS unsigned*)(F.lds + F.wave * 16384);
    LAS unsigned short* selL = (LAS unsigned short*)(F.lds + SELL_OFF + F.wave * 2048);
    unsigned* sscr = (unsigned*)(F.gw < 1024 ? ws + OFF_H + (size_t)F.gw * 32768 : (F.gw < 1760 ? ws + OFF_F + 41 * MiB + (size_t)(F.gw - 1024) * 32768 : dout + 48 * MiB + (size_t)(F.gw - 1760) * 32768));
    for (int p = F.gw; p < 2048; p += F.NGW) {
        int b, ga, gb;
        if (p < 4 * 448) { b = p & 3; const int pj = p >> 2; ga = 64 + pj; gb = 959 - pj; }
        else { const int q_ = p - 4 * 448; b = q_ & 3; ga = 960 + (q_ >> 2); gb = q_ >> 2; }
        tk_group(F, qi, ki, wi, selL, b, 4 * ga, hist, sscr);
        asm volatile("s_waitcnt lgkmcnt(0)" ::: "memory");
        ph_sparse_wave<true>(F, qlat, qr, ckv8, kr8, selL, b * SEQ + 4 * ga);
        asm volatile("s_waitcnt lgkmcnt(0)" ::: "memory");
        if (gb >= 64) tk_group(F, qi, ki, wi, selL, b, 4 * gb, hist, sscr);
        else { int l0 = F.lane; asm volatile("" : "+v"(l0));
            for (int i = l0; i < 4 * TOPK; i += 64) { const int q = i >> 8, k = i & 255; selL[i] = (unsigned short)(k <= 4 * gb + q ? k : 0); } }
        asm volatile("s_waitcnt lgkmcnt(0)" ::: "memory");
        ph_sparse_wave<true>(F, qlat, qr, ckv8, kr8, selL, b * SEQ + 4 * gb);
        asm volatile("s_waitcnt lgkmcnt(0)" ::: "memory");
    }
}

__global__ void __launch_bounds__(NTHR, 2) mega_fwd(Args args) {
    extern __shared__ __attribute__((aligned(16))) unsigned char lds_raw[];
    Frame F; F.lds = (LAS unsigned char*)lds_raw; F.tid = threadIdx.x; F.lane = F.tid & 63; F.wave = __builtin_amdgcn_readfirstlane(F.tid >> 6);
    F.G = gridDim.x; F.gw = blockIdx.x * NWAVES + F.wave; F.NGW = F.G * NWAVES;
    volatile LAS unsigned* MISC = (volatile LAS unsigned*)(F.lds + MISC_OFF);
    unsigned char* ws = args.ws;
    for (int u = F.tid; u < (LDS_BYTES - LDSCTL_OFF) / 4; u += NTHR) ((LAS unsigned*)(F.lds + LDSCTL_OFF))[u] = 0u;
    __syncthreads();
    XcdBarrier bar = xcd_barrier_post((unsigned*)(ws + OFF_CTL) + CW_BAR, MISC + 8, F.wave);
    const int lo = args.ph_lo, hi = args.ph_hi;
#define IN(k) (lo <= (k) && (k) < hi)
#define SEAM(k) do { if (IN(k) && IN((k) + 1)) xcd_barrier(bar); F.lane = flane(); F.tid = F.wave * 64 + F.lane; } while (0)
    float* mod = (float*)(ws + OFF_MOD); float2* tab = (float2*)(ws + OFF_ROPE);
    h16* Hb = (h16*)(ws + OFF_H); h16* Ab = (h16*)(ws + OFF_A); float* Fb = (float*)(ws + OFF_F);

    if (IN(0)) {
        LAS float* scr = (LAS float*)(F.lds + F.wave * 16384);
        for (int ch = blockIdx.x; ch < (NMOD * DM) / 36; ch += F.G) {
            LAS float* sl = (LAS float*)(F.lds);
            LAS f32x4* part = (LAS f32x4*)(F.lds + 16384);
            __syncthreads();
            for (int i = F.tid; i < 4 * DM; i += NTHR) sl[i] = silu_f(args.in[1][i]);
            __syncthreads();
            const int r7 = F.lane / 9, c4 = F.lane - 9 * r7; const bool act = F.lane < 63;
            const float* wm = args.in[3] + (size_t)(F.wave * 128 + r7) * (NMOD * DM) + ch * 36 + 4 * c4;
            f32x4 wv[19];
#pragma unroll
            for (int i = 0; i < 19; ++i) { const bool ok = act && (7 * i + r7 < 128); wv[i] = *(const f32x4*)(wm + (size_t)(ok ? 7 * i : 0) * (NMOD * DM)); }
            f32x4 a0 = {0.f, 0.f, 0.f, 0.f}, a1 = a0, a2 = a0, a3 = a0;
#pragma unroll
            for (int i = 0; i < 19; ++i) { const bool ok = act && (7 * i + r7 < 128); const int kk = F.wave * 128 + (ok ? 7 * i + r7 : 0); const f32x4 w = ok ? wv[i] : (f32x4){0.f, 0.f, 0.f, 0.f};
                a0 += w * sl[kk]; a1 += w * sl[DM + kk]; a2 += w * sl[2 * DM + kk]; a3 += w * sl[3 * DM + kk]; }
            if (act) { LAS f32x4* pp = part + ((F.wave * 7 + r7) * 4) * 9 + c4; pp[0] = a0; pp[9] = a1; pp[18] = a2; pp[27] = a3; }
            __syncthreads();
            if (F.tid < 144) { const int b = F.tid / 36, l = F.tid - 36 * b; float sm = args.in[4][ch * 36 + l]; const LAS float* pf = (const LAS float*)part + (b * 9) * 4 + l;
#pragma unroll 8
                for (int w = 0; w < 56; ++w) sm += pf[w * 144];
                mod[b * (NMOD * DM) + ch * 36 + l] = sm; }
            __syncthreads();
        }
        for (int idx = blockIdx.x * NTHR + F.tid; idx < MT * 48; idx += F.G * NTHR) { const int tok = idx / 48, i = idx % 48;
            const float inv = (i < 32) ? powf(10000.f, -(float)i / 32.f) : powf(10000.f, -(float)(i - 32) / 16.f);
            const float ang = (float)((const int*)args.in[2])[tok] * inv; float sn, cs; sincosf(ang, &sn, &cs); tab[idx] = make_float2(cs, sn); }
        tr_job_mapped(F, args, 0, 2 * FF, 0, DM, ws + OW_GU1, nullptr, scr, 0);
        if (F.G != 256) {
            tr_job_plain(F, args.in[8], DM, DM, FF, ws + OW_D1, scr, 768);
            tr_job_mapped(F, args, 2, NIN3, 0, DM, (h16*)(ws + OW_IN), nullptr, scr, 128);
            tr_job_plain(F, args.in[11] + C_GATE, DIN, 2048, DM, ws + OW_GATE, scr, 1664);
            tr_job_mapped(F, args, 3, 512, 2048, QL, (h16*)(ws + OW_4), args.in[12], scr, 640);
            tr_job_plain(F, args.in[19], DM, DM, 256, (h16*)(ws + OW_UPB), scr, 736);
            tr_job_plain(F, args.in[20], DM, DM, DM, (h16*)(ws + OW_O), scr, 864);
            tr_job_mapped(F, args, 1, 2 * FF, 0, DM, ws + OW_GU2, nullptr, scr, 1376);
            tr_job_plain(F, args.in[25], DM, DM, FF, ws + OW_D2, scr, 96);
            precomb_tiles(F, args, ws, 0, 192, (int)blockIdx.x, F.G);
            tr_job_plain(F, args.in[18], DM, DM, 512, (h16*)(ws + OW_UPA), scr, 256);
        }
    }
    SEAM(0);
    if (IN(1)) ph_normmod(F, args.in[0], args.in[5], mod, 1, 0, ws + OFF_H);
    SEAM(1);
    if (IN(2)) { pg8::Gemm g{Hb, (const h16*)(ws + OW_GU1), MT, 2 * FF, DM / 2}; pg8::StaticOrder S; S.init(MT, 2 * FF, F.G, (int)blockIdx.x); pg8::EpiSwiGLU_T<true> E{Ab};
        pg8::gemm_phase<pg8::EpiSwiGLU_T<true>, true, true>(F.lds, g, S, E, F.wave);
        if (F.G == 256 && blockIdx.x >= 128) {
            Frame F2 = F; F2.gw = ((int)blockIdx.x - 128) * NWAVES + F.wave; F2.NGW = 128 * NWAVES; LAS float* scr = (LAS float*)(F.lds + F.wave * 16384);
            tr_job_plain(F2, args.in[8], DM, DM, FF, ws + OW_D1, scr, 0);
            tr_job_mapped(F2, args, 2, NIN3, 0, DM, (h16*)(ws + OW_IN), nullptr, scr, 384);
            tr_job_mapped(F2, args, 3, 512, 2048, QL, (h16*)(ws + OW_4), args.in[12], scr, 896);
            precomb_tiles(F, args, ws, 0, 192, (int)blockIdx.x - 128, 128);
            for (int i = ((int)blockIdx.x - 128) * NTHR + F.tid; i < (int)(MiB / 16); i += 128 * NTHR) ((u32x4*)(ws + OW_BD))[i] = (u32x4){0u, 0u, 0u, 0u}; } }
    SEAM(2);
    if (IN(3)) { pg8::Gemm g{Ab, (const h16*)(ws + OW_D1), MT, DM, FF / 2}; pg8::StaticOrder S; S.init(MT, DM, F.G, (int)blockIdx.x); pg8::EpiH16_T<true> E{(h16*)Fb};
        pg8::gemm_phase<pg8::EpiH16_T<true>, false, true>(F.lds, g, S, E, F.wave); }
    SEAM(3);
    if (IN(4)) ph_resnorm<false, true>(F, args.in[0], (const h16*)Fb, args.in[9], mod, 2, 0.5f, args.out, true, args.in[10], 4, 3, Hb, (unsigned char*)args.out + 32 * MiB);
    SEAM(4);
    if (IN(5)) { pg8::Gemm g{Hb, (const h16*)(ws + OW_IN), MT, NIN3, DM}; pg8::StaticOrder S; S.init(MT, NIN3, F.G, (int)blockIdx.x);
        pg8::EpiIn E{(h16*)(ws + OFF_CKV), (h16*)(ws + OFF_CQ), (h16*)(ws + OFF_KR), (h16*)(ws + OFF_KI), (h16*)(ws + OFF_QB), (h16*)(ws + OFF_KB), (h16*)(ws + OFF_VT), (float*)(ws + OFF_WI), (float*)(ws + OFF_SSQ),
                     args.in[13], tab, (LAS float*)(F.lds + XCH_OFF)};
        pg8::gemm_phase<pg8::EpiIn, true>(F.lds, g, S, E, F.wave); }
    SEAM(5);
    if (IN(6)) { for (int tk_ = blockIdx.x * NTHR + F.tid; tk_ < MT; tk_ += F.G * NTHR) { const f32x4 s0 = *(const f32x4*)((const float*)(ws + OFF_SSQ) + tk_ * 8), s1 = *(const f32x4*)((const float*)(ws + OFF_SSQ) + tk_ * 8 + 4);
            ((float*)(ws + OFF_RSTDQ))[tk_] = rsqrtf((((s0.x + s0.y) + (s0.z + s0.w)) + ((s1.x + s1.y) + (s1.z + s1.w))) * (1.f / QL) + EPS); } }
    if (IN(6)) ph_dilated_mfma(F, (const h16*)(ws + OFF_QB), (const h16*)(ws + OFF_KB), (const h16*)(ws + OFF_VT), (h16*)(ws + OFF_OG), (float*)(ws + OFF_LSE));
    SEAM(6);
    if (IN(7)) { pg8::Gemm g{(const h16*)(ws + OFF_CQ), (const h16*)(ws + OW_4), MT, N4, QL}; pg8::StaticOrder S; S.init(MT, N4, F.G, (int)blockIdx.x);
        pg8::Epi4 E{(h16*)(ws + OFF_QLAT), (h16*)(ws + OFF_QR), (h16*)(ws + OFF_QI), (const float*)(ws + OFF_RSTDQ), tab};
        pg8::gemm_phase<pg8::Epi4, true>(F.lds, g, S, E, F.wave);
        if (F.G == 256 && blockIdx.x >= 128) {
            Frame F2 = F; F2.gw = ((int)blockIdx.x - 128) * NWAVES + F.wave; F2.NGW = 128 * NWAVES; LAS float* scr = (LAS float*)(F.lds + F.wave * 16384);
            tr_job_plain(F2, args.in[11] + C_GATE, DIN, 2048, DM, ws + OW_GATE, scr, 0);
            tr_job_mapped(F2, args, 1, 2 * FF, 0, DM, ws + OW_GU2, nullptr, scr, 640);
            tr_job_plain(F2, args.in[19], DM, DM, 256, (h16*)(ws + OW_UPB), scr, 512);
            tr_job_plain(F2, args.in[20], DM, DM, DM, (h16*)(ws + OW_O), scr, 640);
            tr_job_plain(F2, args.in[18], DM, DM, 512, (h16*)(ws + OW_UPA), scr, 256);
            for (int it = F2.gw; it < 4 * 16; it += F2.NGW) { const int kb = it >> 4, nb = it & 15, n0 = nb * 32, hl = (n0 >> 6) & 3;
                tr_item(args.in[16], 512, n0 + (F.lane & 31), true, nullptr, kb * 64, (h16*)(ws + OW_BD) + (size_t)n0 * 1024 + 256 * hl, 1024, scr, F.lane); } } }
    SEAM(7);
    if (IN(8)) { ph_combine(F, (const h16*)(ws + OFF_OG), (const float*)(ws + OFF_LSE), (h16*)(ws + OFF_OB));
        ph_topk_sparse(F, (const h16*)(ws + OFF_QI), (const h16*)(ws + OFF_KI), (const float*)(ws + OFF_WI),
                       (h16*)(ws + OFF_QLAT), (const h16*)(ws + OFF_QR), (const unsigned char*)(ws + OFF_CKV), (const unsigned char*)(ws + OFF_KR), ws, (unsigned char*)args.out); }
    SEAM(8);
    if (IN(9) && F.G == 256) { const bool first = blockIdx.x < 128;
        pg8::Gemm g{first ? (const h16*)(ws + OFF_QLAT) : (const h16*)(ws + OFF_OB), first ? (const h16*)(ws + OW_BD) : (const h16*)(ws + OW_UPB), MT, first ? 512 : DM, first ? 1024 : 256, first ? 2048 : 0, first ? 1024 : 0};
        pg8::StaticOrder S; S.init(MT, first ? 512 : DM, 128, first ? (int)blockIdx.x : (int)blockIdx.x - 128);
        pg8::EpiH16 E{first ? (h16*)(ws + OFF_OA) : (h16*)(ws + OFF_Y2), first ? 512 : DM};
        pg8::gemm_phase<pg8::EpiH16, false>(F.lds, g, S, E, F.wave); }
    SEAM(9);
    if (IN(10)) { pg8::StaticOrder S; S.init(MT, DM, F.G, (int)blockIdx.x); h16* Y1 = (h16*)(ws + OFF_Y1); h16* Y2 = (h16*)(ws + OFF_Y2);
        { pg8::Gemm g{(const h16*)(ws + OFF_OA), (const h16*)(ws + OW_UPA), MT, DM, 512}; pg8::EpiH16 E{Y1}; pg8::gemm_phase<pg8::EpiH16, false>(F.lds, g, S, E, F.wave); }
        const h16* u8 = (const h16*)((const unsigned char*)args.out + 32 * MiB);
        { pg8::Gemm g{u8, (const h16*)(ws + OW_GATE), MT, 2 * DM, DM / 2}; pg8::EpiGate E{Y1, Y1, 0, -LOG2E * F8_INV, Y2}; pg8::PairOrder P{S};
          pg8::gemm_phase<pg8::EpiGate, false, true, pg8::PairOrder>(F.lds, g, P, E, F.wave); } }
    SEAM(10);
    if (IN(11)) { pg8::Gemm g{(const h16*)(ws + OFF_Y1), (const h16*)(ws + OW_O), MT, DM, DM}; pg8::StaticOrder S; S.init(MT, DM, F.G, (int)blockIdx.x); pg8::EpiH16 E{(h16*)(ws + OFF_YF)};
        pg8::gemm_phase<pg8::EpiH16, false>(F.lds, g, S, E, F.wave); }
    SEAM(11);
    if (IN(12)) ph_resnorm<true, true, unsigned char>(F, args.out, (const h16*)(ws + OFF_YF), args.in[21], mod, 5, 1.0f, ws + OFF_F, true, args.in[22], 7, 6, ws + OFF_H);
    SEAM(12);
    if (IN(13)) { pg8::Gemm g{Hb, (const h16*)(ws + OW_GU2), MT, 2 * FF, DM / 2}; pg8::StaticOrder S; S.init(MT, 2 * FF, F.G, (int)blockIdx.x); pg8::EpiSwiGLU_T<true> E{Ab};
        pg8::gemm_phase<pg8::EpiSwiGLU_T<true>, true, true>(F.lds, g, S, E, F.wave);
        if (F.G == 256 && blockIdx.x >= 128) { Frame F2 = F; F2.gw = ((int)blockIdx.x - 128) * NWAVES + F.wave; F2.NGW = 128 * NWAVES;
            tr_job_plain(F2, args.in[25], DM, DM, FF, ws + OW_D2, (LAS float*)(F.lds + F.wave * 16384), 0); } }
    SEAM(13);
    if (IN(14)) { pg8::Gemm g{Ab, (const h16*)(ws + OW_D2), MT, DM, FF / 2}; pg8::StaticOrder S; S.init(MT, DM, F.G, (int)blockIdx.x); pg8::EpiH16_T<true> E{(h16*)(ws + OFF_F + 32 * MiB)};
        pg8::gemm_phase<pg8::EpiH16_T<true>, false, true>(F.lds, g, S, E, F.wave); }
    SEAM(14);
    if (IN(15)) ph_resnorm<true, false>(F, ws + OFF_F, (const h16*)(ws + OFF_F + 32 * MiB), args.in[26], mod, 8, 0.5f, args.out, false, nullptr, 0, 0, (h16*)nullptr);
#undef IN
#undef SEAM
}


extern "C" void kernel_launch(void* const* d_in, const int* in_sizes, int n_in, void* d_out, int out_size, void* d_ws, size_t ws_size, hipStream_t stream) {
    if (n_in != 27 || ws_size < WS_END || out_size != MT * DM) { fprintf(stderr, "kernel_launch: unexpected shapes (n_in %d ws %zu out %d)\n", n_in, ws_size, out_size); return; }
    static int grid = 0;
    if (grid == 0) {
        int dev = 0, cus = 0, per_cu = 0;
        if (hipGetDevice(&dev) != hipSuccess || hipDeviceGetAttribute(&cus, hipDeviceAttributeMultiprocessorCount, dev) != hipSuccess) { grid = -1; return; }
        if (hipFuncSetAttribute((const void*)mega_fwd, hipFuncAttributeMaxDynamicSharedMemorySize, LDS_BYTES) != hipSuccess) { fprintf(stderr, "kernel_launch: hipFuncSetAttribute failed\n"); grid = -1; return; }
        if (hipOccupancyMaxActiveBlocksPerMultiprocessor(&per_cu, (const void*)mega_fwd, NTHR, LDS_BYTES) != hipSuccess || per_cu < 1) { fprintf(stderr, "kernel_launch: occupancy query says %d blocks/CU\n", per_cu); grid = -1; return; }
        grid = cus;
    }
    if (grid < 0) return;
    hipMemsetAsync((char*)d_ws + OFF_CTL, 0, 1 * MiB, stream);
    Args a{}; for (int i = 0; i < 27; ++i) a.in[i] = (const float*)d_in[i]; a.out = (float*)d_out; a.ws = (unsigned char*)d_ws; a.ph_lo = 0; a.ph_hi = 16;
    void* kargs[] = {&a};
#ifdef PH_DOUBLE
    a.ph_hi = PH_DOUBLE + 1; (void)hipLaunchCooperativeKernel((const void*)mega_fwd, dim3(grid), dim3(NTHR), kargs, LDS_BYTES, stream);
    hipMemsetAsync((char*)d_ws + OFF_CTL, 0, 1 * MiB, stream); a.ph_lo = PH_DOUBLE; a.ph_hi = 16;
#endif
    const hipError_t e = hipLaunchCooperativeKernel((const void*)mega_fwd, dim3(grid), dim3(NTHR), kargs, LDS_BYTES, stream);
    if (e != hipSuccess) fprintf(stderr, "kernel_launch: cooperative launch failed: %s (grid %d)\n", hipGetErrorString(e), grid);
    (void)in_sizes;
}
```

```cpp
#include <hip/hip_runtime.h>
#include <hip/hip_fp16.h>
#include <cstdio>
#include <cstdint>

constexpr int NB = 4, SEQ = 4096, DM = 1024, MT = NB * SEQ, FF = 2816;
constexpr int QL = 384, KVL = 256, DNOPE = 64, DROPE = 32, DVA = 64, HA = 8, HI = 8, DI = 32, TOPK = 256;
constexpr int NG = 3, HB = 4, DHB = 64, NMOD = 9, DIN = 5064;
constexpr int C_CQ = 0, C_CKV = 384, C_KR = 640, C_KI = 672, C_WI = 704, C_QKV = 712, C_GATE = 3016;
constexpr float EPS = 1e-6f, LOG2E = 1.4426950408889634f;
typedef _Float16 h16;

constexpr size_t MiB = 1u << 20;
constexpr size_t OFF_CTL = 0, OFF_MOD = 1 * MiB, OFF_ROPE = 2 * MiB, OFF_W = 8 * MiB, OFF_H = 60 * MiB, OFF_A = 92 * MiB, OFF_F = 180 * MiB, OFF_SP = 244 * MiB, WS_END = 256 * MiB;
constexpr size_t OFF_QB = OFF_A, OFF_KB = OFF_A + 24 * MiB, OFF_VT = OFF_A + 48 * MiB, OFF_CKV = OFF_A + 72 * MiB, OFF_KR = OFF_A + 80 * MiB, OFF_KI = OFF_A + 81 * MiB,
                 OFF_WI = OFF_A + 82 * MiB, OFF_SSQ = OFF_A + 82 * MiB + 512 * 1024, OFF_CQ = OFF_SP;
constexpr size_t OFF_RSTDQ = OFF_A + 83 * MiB;
constexpr size_t OFF_OG = OFF_F, OFF_LSE = OFF_F + 24 * MiB, OFF_QLAT = OFF_A, OFF_QR = OFF_A + 64 * MiB, OFF_QI = OFF_F + 25 * MiB, OFF_SEL = OFF_F + 33 * MiB, OFF_OB = OFF_SP;
constexpr size_t OFF_Y1 = OFF_F, OFF_Y2 = OFF_F + 32 * MiB, OFF_YF = OFF_A;

__device__ __forceinline__ float silu_f(float v) { return v / (1.f + __expf(-v)); }
__device__ __forceinline__ float sigm_f(float v) { return 1.f / (1.f + __expf(-v)); }
__host__ __device__ __forceinline__ int dil_of(int g) { return g == 0 ? 1 : (g == 1 ? 4 : 16); }
__device__ __forceinline__ unsigned fkey(float f) { const unsigned u = __float_as_uint(f); return (u & 0x80000000u) ? ~u : (u | 0x80000000u); }


#define LAS __attribute__((address_space(3)))
#define GAS __attribute__((address_space(1)))
typedef _Float16 f16x8 __attribute__((ext_vector_type(8)));
typedef float f32x4 __attribute__((ext_vector_type(4)));
typedef float f32x2 __attribute__((ext_vector_type(2)));
typedef unsigned u32x4 __attribute__((ext_vector_type(4)));
typedef unsigned u32x2 __attribute__((ext_vector_type(2)));
typedef _Float16 h16x2 __attribute__((ext_vector_type(2)));
__device__ __forceinline__ unsigned pk_h2(float lo, float hi) { f32x2 v = {lo, hi}; h16x2 h = __builtin_convertvector(v, h16x2); return __builtin_bit_cast(unsigned, h); }
__device__ __forceinline__ int flane() { int l; asm volatile("v_mbcnt_lo_u32_b32 %0, -1, 0\n\tv_mbcnt_hi_u32_b32 %0, -1, %0" : "=v"(l)); return l; }
typedef unsigned u32x2s __attribute__((ext_vector_type(2)));
__device__ __forceinline__ float sum_x16(float v) { const unsigned u = __float_as_uint(v); const u32x2s r = __builtin_amdgcn_permlane16_swap(u, u, false, false); return __uint_as_float(r.x) + __uint_as_float(r.y); }
__device__ __forceinline__ float sum_x32(float v) { const unsigned u = __float_as_uint(v); const u32x2s r = __builtin_amdgcn_permlane32_swap(u, u, false, false); return __uint_as_float(r.x) + __uint_as_float(r.y); }
__device__ __forceinline__ float max_x16(float v) { const unsigned u = __float_as_uint(v); const u32x2s r = __builtin_amdgcn_permlane16_swap(u, u, false, false); return fmaxf(__uint_as_float(r.x), __uint_as_float(r.y)); }
__device__ __forceinline__ float max_x32(float v) { const unsigned u = __float_as_uint(v); const u32x2s r = __builtin_amdgcn_permlane32_swap(u, u, false, false); return fmaxf(__uint_as_float(r.x), __uint_as_float(r.y)); }
template <int CTRL> __device__ __forceinline__ float dpp_f(float v) { return __int_as_float(__builtin_amdgcn_update_dpp(0, __float_as_int(v), CTRL, 0xF, 0xF, true)); }
__device__ __forceinline__ float sat8(float x) { return __builtin_amdgcn_fmed3f(x, -448.f, 448.f); }
__device__ __forceinline__ unsigned pk_f8x4(float a, float b, float c, float d) { int w = __builtin_amdgcn_cvt_pk_fp8_f32(sat8(a), sat8(b), 0, false); w = __builtin_amdgcn_cvt_pk_fp8_f32(sat8(c), sat8(d), w, true); return (unsigned)w; }
typedef int i32x4 __attribute__((ext_vector_type(4)));
typedef int i32x8 __attribute__((ext_vector_type(8)));
constexpr float F8_ACT = 8.f, F8_WGT = 512.f, F8_INV = 1.f / (F8_ACT * F8_WGT);

namespace pg8 {
constexpr int BM = 256, BK = 64, HALF = 128, HTB = HALF * BK * 2, STAGE_BYTES = 8 * HTB, NXCD = 8, WGM = 8;
__host__ __device__ __forceinline__ int lds_byte(int r, int c) { const int st = (r >> 4) * 2 + (c >> 5), rr = r & 15, cc = c & 31, ob = rr * 64 + cc * 2; return st * 1024 + (ob ^ (((ob >> 9) & 1) << 5)); }
__host__ __device__ __forceinline__ void stage_rc(int b, int& R, int& C) { const int st = b / 1024, sb = b % 1024, swz = sb ^ (((sb >> 9) & 1) << 5); R = (st >> 1) * 16 + swz / 64; C = (st & 1) * 32 + (swz % 64) / 2; }
__host__ __device__ __forceinline__ int perm32(int rho) { const int n = rho >> 4, i = rho & 15; return 8 * (i >> 2) + 4 * n + (i & 3); }
struct Unit { int pm, pn; };
struct Gemm { const h16* A; const h16* Bt; int M, N, K; int lda = 0, koffA = 0; };
struct StaticOrder {
    int nM, nN, nwg, G, c;
    __host__ __device__ void init(int M, int N, int G_, int c_) { nM = M / BM; nN = N / BM; nwg = nM * nN; G = G_; c = c_; }
    __host__ __device__ bool next(int i, Unit& u) const {
        const long L = (long)i * G + c; if (L >= nwg) return false;
        int wgid = (int)L; { const int q = nwg / NXCD, r = nwg % NXCD, xcd = wgid % NXCD, off = wgid / NXCD; wgid = (xcd < r ? xcd * (q + 1) : r * (q + 1) + (xcd - r) * q) + off; }
        const int nig = WGM * nN, gid = wgid / nig, fm = gid * WGM, gsz = (nM - fm) < WGM ? (nM - fm) : WGM;
        u.pm = fm + ((wgid % nig) % gsz); u.pn = (wgid % nig) / gsz; return true;
    }
};
struct PairOrder { StaticOrder S;
    __host__ __device__ bool next(int i, Unit& u) const { if (i >= 2 || !S.next(0, u)) return false; u.pn += 4 * i; return true; } };
template <class Epi, bool ALIGN_EPI, bool F8 = false, class Order = StaticOrder>
__device__ __forceinline__ void gemm_phase(LAS unsigned char* lds, const Gemm g, const Order& S, const Epi& E, const int wid) {
    const int lane = flane(), tid = wid * 64 + lane, wr = wid >> 2, wc = wid & 3, fr = lane & 15, fq = lane >> 4;
    const int K = g.K, lda = g.lda ? g.lda : g.K; int nt = K / BK;
    if constexpr (F8) asm volatile("" : "+s"(nt));
    unsigned voffA[2], voffB[2];
#pragma unroll
    for (int i = 0; i < 2; ++i) { int R, C; stage_rc(tid * 16 + i * 8192, R, C); const int Rb = Epi::PERM ? ((R & ~31) + perm32(R & 31)) : R;
        voffA[i] = (unsigned)(R * lda + C) * 2u; voffB[i] = (unsigned)(Rb * K + C) * 2u; }
    const size_t kstep = (size_t)(BK * 2);
    const size_t hstep = (size_t)HALF * K * 2, hstepA = (size_t)HALF * lda * 2;
    const size_t tstep = 2 * hstep, tstepA = 2 * hstepA, kofA = (size_t)g.koffA * 2;
    const unsigned ldsw = (unsigned)wid * 1024u;
    const int aoff = lds_byte(wr * 64 + fr, fq * 8), boff = lds_byte(wc * 32 + fr, fq * 8);
#define PG8_SA(b, h) (((b) * 2 + (h)) * HTB)
#define PG8_SB(b, h) ((4 + (b) * 2 + (h)) * HTB)
#define PG8_STAGE(bufoff, gbase, voff) do { _Pragma("unroll") for (int _i = 0; _i < 2; ++_i) { unsigned _vo = (voff)[_i]; asm volatile("" : "+v"(_vo)); \
        __builtin_amdgcn_global_load_lds((const unsigned*)((const char*)(gbase) + _vo), (LAS unsigned*)(lds + (bufoff) + ldsw + _i * 8192), 16, 0, 0); } } while (0)
#define PG8_LDA(dst, b, h) do { _Pragma("unroll") for (int m = 0; m < 4; ++m) _Pragma("unroll") for (int k = 0; k < 2; ++k) dst[m][k] = *(const LAS f16x8*)(lds + PG8_SA(b, h) + aoff + m * 2048 + k * 1024); } while (0)
#define PG8_LDB(dst, b, h) do { _Pragma("unroll") for (int n = 0; n < 2; ++n) _Pragma("unroll") for (int k = 0; k < 2; ++k) dst[n][k] = *(const LAS f16x8*)(lds + PG8_SB(b, h) + boff + n * 2048 + k * 1024); } while (0)
#define PG8_CAT8(x, y) __builtin_shufflevector(__builtin_bit_cast(i32x4, x), __builtin_bit_cast(i32x4, y), 0, 1, 2, 3, 4, 5, 6, 7)
#define PG8_MMA(ai, bj, At, Bt) do { __builtin_amdgcn_s_setprio(1); \
        if constexpr (F8) { _Pragma("unroll") for (int m = 0; m < 4; ++m) _Pragma("unroll") for (int n = 0; n < 2; ++n) \
            acc[ai][bj][m][n] = __builtin_amdgcn_mfma_scale_f32_16x16x128_f8f6f4(PG8_CAT8(Bt[n][0], Bt[n][1]), PG8_CAT8(At[m][0], At[m][1]), acc[ai][bj][m][n], 0, 0, 0, 0, 0, 0); } \
        else { _Pragma("unroll") for (int m = 0; m < 4; ++m) _Pragma("unroll") for (int n = 0; n < 2; ++n) _Pragma("unroll") for (int k = 0; k < 2; ++k) \
            acc[ai][bj][m][n] = __builtin_amdgcn_mfma_f32_16x16x32_f16(Bt[n][k], At[m][k], acc[ai][bj][m][n], 0, 0, 0); } \
        __builtin_amdgcn_s_setprio(0); } while (0)
#define PG8_WAIT_V(n) asm volatile("s_waitcnt vmcnt(" #n ")" ::: "memory")
#define PG8_WAIT_L(n) asm volatile("s_waitcnt lgkmcnt(" #n ")" ::: "memory")
#define PG8_BAR __builtin_amdgcn_s_barrier()
#define PG8_SCHED __builtin_amdgcn_sched_barrier(0)
    Unit cur, nxt; int ui = 0;
    if (!S.next(0, cur)) return;
    f32x4 acc[2][2][4][2];
#pragma unroll
    for (int a = 0; a < 2; ++a)
#pragma unroll
        for (int b = 0; b < 2; ++b)
#pragma unroll
            for (int m = 0; m < 4; ++m)
#pragma unroll
                for (int n = 0; n < 2; ++n) acc[a][b][m][n] = (f32x4){0.f, 0.f, 0.f, 0.f};
    f16x8 At[4][2], B0[2][2], B1[2][2];
    const char* cA = (const char*)g.A + (size_t)cur.pm * tstepA + (size_t)cur.pn * kofA; const char* cB = (const char*)g.Bt + (size_t)cur.pn * tstep;
    PG8_STAGE(PG8_SB(0, 0), cB, voffB); PG8_STAGE(PG8_SB(0, 1), cB + hstep, voffB); PG8_STAGE(PG8_SA(0, 0), cA, voffA); PG8_STAGE(PG8_SA(0, 1), cA + hstepA, voffA);
    if (wr == 1) PG8_BAR;
    PG8_WAIT_V(2); PG8_BAR;
    PG8_STAGE(PG8_SB(1, 0), cB + kstep, voffB); PG8_STAGE(PG8_SA(1, 0), cA + kstep, voffA); PG8_STAGE(PG8_SB(1, 1), cB + hstep + kstep, voffB);
    PG8_WAIT_V(6); PG8_BAR;
    for (;;) {
        const bool has_next = S.next(ui + 1, nxt);
        const char* nA = has_next ? (const char*)g.A + (size_t)nxt.pm * tstepA + (size_t)nxt.pn * kofA : cA; const char* nB = has_next ? (const char*)g.Bt + (size_t)nxt.pn * tstep : cB;
        for (int t = 0; t < nt; t += 2) {
            const bool last = (t == nt - 2);
            const char* a1 = cA + (size_t)(t + 1) * kstep;
            const char* a2 = last ? nA : cA + (size_t)(t + 2) * kstep; const char* b2 = last ? nB : cB + (size_t)(t + 2) * kstep;
            const char* a3 = a2 + kstep; const char* b3 = b2 + kstep;
            PG8_LDB(B0, 0, 0); PG8_LDB(B1, 0, 1); PG8_SCHED; PG8_LDA(At, 0, 0); PG8_STAGE(PG8_SA(1, 1), a1 + hstepA, voffA);
            PG8_WAIT_V(8); PG8_WAIT_L(0); PG8_BAR; PG8_MMA(0, 0, At, B0); PG8_MMA(0, 1, At, B1); PG8_BAR; PG8_SCHED;
            PG8_LDA(At, 0, 1); PG8_STAGE(PG8_SB(0, 0), b2, voffB); PG8_STAGE(PG8_SB(0, 1), b2 + hstep, voffB); PG8_STAGE(PG8_SA(0, 0), a2, voffA);
            PG8_WAIT_V(8); PG8_WAIT_L(0); PG8_BAR; PG8_MMA(1, 0, At, B0); PG8_MMA(1, 1, At, B1); PG8_BAR; PG8_SCHED;
            PG8_LDB(B0, 1, 0); PG8_LDB(B1, 1, 1); PG8_SCHED; PG8_LDA(At, 1, 0); PG8_STAGE(PG8_SA(0, 1), a2 + hstepA, voffA);
            PG8_WAIT_V(8); PG8_WAIT_L(0); PG8_BAR; PG8_MMA(0, 0, At, B0); PG8_MMA(0, 1, At, B1); PG8_BAR; PG8_SCHED;
            PG8_LDA(At, 1, 1); PG8_STAGE(PG8_SB(1, 0), b3, voffB); PG8_STAGE(PG8_SB(1, 1), b3 + hstep, voffB); PG8_STAGE(PG8_SA(1, 0), a3, voffA);
            PG8_WAIT_V(8); PG8_WAIT_L(0); PG8_BAR; PG8_MMA(1, 0, At, B0); PG8_MMA(1, 1, At, B1); PG8_BAR; PG8_SCHED;
        }
        if constexpr (ALIGN_EPI) { if (wr == 0) PG8_BAR; }
        { const int l2 = flane(); E(acc, cur, wr, wc, l2 & 15, l2 >> 4); }
        if (!has_next) break;
#pragma unroll
        for (int a = 0; a < 2; ++a)
#pragma unroll
            for (int b = 0; b < 2; ++b)
#pragma unroll
                for (int m = 0; m < 4; ++m)
#pragma unroll
                    for (int n = 0; n < 2; ++n) acc[a][b][m][n] = (f32x4){0.f, 0.f, 0.f, 0.f};
        cur = nxt; cA = nA; cB = nB; ++ui;
        if constexpr (ALIGN_EPI) { if (wr == 1) PG8_BAR; }
    }
    PG8_WAIT_V(0);
    if constexpr (!ALIGN_EPI) { if (wr == 0) PG8_BAR; }
    PG8_BAR;
#undef PG8_SA
#undef PG8_SB
#undef PG8_STAGE
#undef PG8_LDA
#undef PG8_LDB
#undef PG8_MMA
#undef PG8_CAT8
#undef PG8_WAIT_V
#undef PG8_WAIT_L
#undef PG8_BAR
#undef PG8_SCHED
}
struct EpiF32 {
    static constexpr bool PERM = false;
    float* C; int ldc;
    __device__ __forceinline__ void operator()(const f32x4 (&acc)[2][2][4][2], const Unit& u, int wr, int wc, int fr, int fq) const {
        const int row0 = u.pm * BM + wr * 64 + fr, col0 = u.pn * BM + wc * 32 + 4 * fq;
#pragma unroll
        for (int ai = 0; ai < 2; ++ai)
#pragma unroll
            for (int m = 0; m < 4; ++m) { float* rowp = C + (size_t)(row0 + ai * HALF + m * 16) * ldc + col0;
#pragma unroll
                for (int bj = 0; bj < 2; ++bj)
#pragma unroll
                    for (int n = 0; n < 2; ++n) *(f32x4*)(rowp + bj * HALF + n * 16) = acc[ai][bj][m][n]; }
    }
};
template <bool F8, bool O8 = F8>
struct EpiSwiGLU_T {
    static constexpr bool PERM = true;
    void* O;
    __device__ __forceinline__ void operator()(const f32x4 (&acc)[2][2][4][2], const Unit& u, int wr, int wc, int fr, int fq) const {
        const int row0 = u.pm * BM + wr * 64 + fr, col0 = u.pn * HALF + wc * 32 + 8 * fq;
#pragma unroll
        for (int ai = 0; ai < 2; ++ai)
#pragma unroll
            for (int m = 0; m < 4; ++m) { const size_t eo = (size_t)(row0 + ai * HALF + m * 16) * FF + col0;
                float v[8];
#pragma unroll
                for (int n = 0; n < 2; ++n)
#pragma unroll
                    for (int e = 0; e < 4; ++e) { float gg = acc[ai][0][m][n][e], uu = acc[ai][1][m][n][e]; if constexpr (F8) { gg *= F8_INV; uu *= O8 ? F8_INV * F8_ACT : F8_INV; }
                        v[n * 4 + e] = gg * __builtin_amdgcn_rcpf(1.f + __builtin_amdgcn_exp2f(-gg * LOG2E)) * uu; }
                if constexpr (O8) { u32x2 w; w.x = pk_f8x4(v[0], v[1], v[2], v[3]); w.y = pk_f8x4(v[4], v[5], v[6], v[7]); *(u32x2*)((unsigned char*)O + eo) = w; }
                else { u32x4 w; w.x = pk_h2(v[0], v[1]); w.y = pk_h2(v[2], v[3]); w.z = pk_h2(v[4], v[5]); w.w = pk_h2(v[6], v[7]); *(u32x4*)((h16*)O + eo) = w; } }
    }
};
typedef EpiSwiGLU_T<false> EpiSwiGLU;

struct EpiIn {
    static constexpr bool PERM = false;
    h16 *ckv, *cq, *kr, *ki, *qb, *kb, *vT; float *wi, *ssq; const float* gckv; const float2* tab; LAS float* X;
    __device__ __forceinline__ void rope64(const f32x4 (&acc)[2][2][4][2], const Unit& u, int wr, int wc, int fr, int fq, h16* dst, int tl, float scale) const {
        const int tok0 = u.pm * BM + wr * 64 + fr;
        f32x4 tc[4], tn[4];
        { const f32x4* tp = (const f32x4*)(tab + (size_t)tok0 * 48 + 4 * fq); tc[0] = tp[0]; tc[1] = tp[1]; tc[2] = tp[8]; tc[3] = tp[9]; }
#pragma unroll
        for (int rr = 0; rr < 8; ++rr) { const int ai = rr >> 2, m = rr & 3, tok = tok0 + ai * HALF + m * 16;
            if (rr < 7) { const int tokn = tok0 + ((rr + 1) >> 2) * HALF + ((rr + 1) & 3) * 16; const f32x4* tp = (const f32x4*)(tab + (size_t)tokn * 48 + 4 * fq); tn[0] = tp[0]; tn[1] = tp[1]; tn[2] = tp[8]; tn[3] = tp[9]; }
#pragma unroll
            for (int n = 0; n < 2; ++n) { const int i = 16 * n + 4 * fq; const f32x4 t0 = tc[2 * n], t1 = tc[2 * n + 1];
                const f32x4 cs = {t0.x, t0.z, t1.x, t1.z}, sn = {t0.y, t0.w, t1.y, t1.w}, x1 = acc[ai][0][m][n], x2 = acc[ai][1][m][n];
                const f32x4 o1 = (x1 * cs - x2 * sn) * scale, o2 = (x2 * cs + x1 * sn) * scale;
                h16* p = dst + (size_t)tok * 768 + (4 * tl + wc) * 64 + i;
                u32x2 w1, w2; w1.x = pk_h2(o1.x, o1.y); w1.y = pk_h2(o1.z, o1.w); w2.x = pk_h2(o2.x, o2.y); w2.y = pk_h2(o2.z, o2.w);
                *(u32x2*)p = w1; *(u32x2*)(p + 32) = w2; }
#pragma unroll
            for (int k = 0; k < 4; ++k) tc[k] = tn[k];
            asm volatile("" ::: "memory"); }
    }
    __device__ __forceinline__ void operator()(const f32x4 (&acc)[2][2][4][2], const Unit& u, int wr, int wc, int fr, int fq) const {
        const int pn = u.pn;
        if (pn == 0) {
#pragma unroll
            for (int ai = 0; ai < 2; ++ai)
#pragma unroll
                for (int m = 0; m < 4; ++m) { float sq = 0.f;
#pragma unroll
                    for (int bj = 0; bj < 2; ++bj)
#pragma unroll
                        for (int n = 0; n < 2; ++n) { const f32x4 v = acc[ai][bj][m][n]; sq += (v.x * v.x + v.y * v.y) + (v.z * v.z + v.w * v.w); }
                    sq = sum_x16(sq); sq = sum_x32(sq);
                    if (fq == 0) X[(ai * HALF + wr * 64 + m * 16 + fr) * 4 + wc] = sq; }
            asm volatile("s_waitcnt lgkmcnt(0)" ::: "memory"); __builtin_amdgcn_s_barrier(); asm volatile("" ::: "memory");
#pragma unroll
            for (int ai = 0; ai < 2; ++ai)
#pragma unroll
                for (int m = 0; m < 4; ++m) { const int rl = ai * HALF + wr * 64 + m * 16 + fr, tok = u.pm * BM + rl; const f32x4 p = *(const LAS f32x4*)(X + rl * 4);
                    const float rstd = rsqrtf(((p.x + p.y) + (p.z + p.w)) * (1.f / KVL) + EPS);
#pragma unroll
                    for (int bj = 0; bj < 2; ++bj)
#pragma unroll
                        for (int n = 0; n < 2; ++n) { const int col = bj * HALF + wc * 32 + n * 16 + 4 * fq; const f32x4 o = acc[ai][bj][m][n] * rstd * *(const f32x4*)(gckv + col);
                            int w8 = __builtin_amdgcn_cvt_pk_fp8_f32(o.x, o.y, 0, false); w8 = __builtin_amdgcn_cvt_pk_fp8_f32(o.z, o.w, w8, true);
                            *(int*)((unsigned char*)ckv + (size_t)tok * KVL + col) = w8; }
                    asm volatile("" ::: "memory"); }
            asm volatile("s_waitcnt lgkmcnt(0)" ::: "memory"); __builtin_amdgcn_s_barrier(); asm volatile("" ::: "memory");
        } else if (pn <= 2) {
#pragma unroll
            for (int ai = 0; ai < 2; ++ai)
#pragma unroll
                for (int m = 0; m < 4; ++m) { const int tok = u.pm * BM + ai * HALF + wr * 64 + m * 16 + fr; float sq = 0.f;
#pragma unroll
                    for (int bj = 0; bj < 2; ++bj) { if (pn == 2 && bj == 1) break;
#pragma unroll
                        for (int n = 0; n < 2; ++n) { const f32x4 v = acc[ai][bj][m][n]; sq += (v.x * v.x + v.y * v.y) + (v.z * v.z + v.w * v.w);
                            const int col = (pn - 1) * 256 + bj * HALF + wc * 32 + n * 16 + 4 * fq; u32x2 w; w.x = pk_h2(v.x, v.y); w.y = pk_h2(v.z, v.w); *(u32x2*)(cq + (size_t)tok * QL + col) = w; } }
                    sq = sum_x16(sq); sq = sum_x32(sq);
                    if (fq == 0) ssq[tok * 8 + (pn - 1) * 4 + wc] = sq;
                    if (pn == 2) {
                        if (wc < 2) { const int i = 4 * fq; const f32x4* tp = (const f32x4*)(tab + (size_t)tok * 48 + 32 + i); const f32x4 t0 = tp[0], t1 = tp[1];
                            const f32x4 cs = {t0.x, t0.z, t1.x, t1.z}, sn = {t0.y, t0.w, t1.y, t1.w}, x1 = acc[ai][1][m][0], x2 = acc[ai][1][m][1];
                            const f32x4 o1 = x1 * cs - x2 * sn, o2 = x2 * cs + x1 * sn;
                            if (wc == 0) { unsigned char* p8 = (unsigned char*)kr + (size_t)tok * 32 + i;
                                int a8 = __builtin_amdgcn_cvt_pk_fp8_f32(o1.x, o1.y, 0, false); a8 = __builtin_amdgcn_cvt_pk_fp8_f32(o1.z, o1.w, a8, true);
                                int b8 = __builtin_amdgcn_cvt_pk_fp8_f32(o2.x, o2.y, 0, false); b8 = __builtin_amdgcn_cvt_pk_fp8_f32(o2.z, o2.w, b8, true);
                                *(int*)p8 = a8; *(int*)(p8 + 16) = b8; }
                            else { h16* p = ki + (size_t)tok * 32 + i;
                                u32x2 w1, w2; w1.x = pk_h2(o1.x, o1.y); w1.y = pk_h2(o1.z, o1.w); w2.x = pk_h2(o2.x, o2.y); w2.y = pk_h2(o2.z, o2.w);
                                *(u32x2*)p = w1; *(u32x2*)(p + 16) = w2; } }
                        else if (wc == 2 && fq < 2) { *(f32x4*)(wi + tok * 8 + 4 * fq) = acc[ai][1][m][0] * 0.35355339059327373f; }
                    }
                    asm volatile("" ::: "memory"); }
        } else if (pn <= 5) rope64(acc, u, wr, wc, fr, fq, qb, pn - 3, 0.125f * LOG2E);
        else if (pn <= 8) rope64(acc, u, wr, wc, fr, fq, kb, pn - 6, 1.0f);
        else {
#pragma unroll
            for (int ai = 0; ai < 2; ++ai)
#pragma unroll
                for (int m = 0; m < 4; ++m) { const int tok = u.pm * BM + ai * HALF + wr * 64 + m * 16 + fr;
#pragma unroll
                    for (int bj = 0; bj < 2; ++bj)
#pragma unroll
                        for (int n = 0; n < 2; ++n) { const f32x4 v = acc[ai][bj][m][n]; u32x2 w; w.x = pk_h2(v.x, v.y); w.y = pk_h2(v.z, v.w);
                            *(u32x2*)(vT + (size_t)tok * 768 + (pn - 9) * 256 + bj * HALF + wc * 32 + n * 16 + 4 * fq) = w; }
                    asm volatile("" ::: "memory"); }
        }
    }
};
struct Epi4 {
    static constexpr bool PERM = true;
    h16 *qlat, *qr, *qi; const float* rstdq; const float2* tab;
    __device__ __forceinline__ void operator()(const f32x4 (&acc)[2][2][4][2], const Unit& u, int wr, int wc, int fr, int fq) const {
        const int pn = u.pn; const float c2 = 0.10206207261596575f * LOG2E;
        const int tok0 = u.pm * BM + wr * 64 + fr;
        float rc, rn = 0.f;
        if (pn < 8) {
            float rs[8];
#pragma unroll
            for (int rr = 0; rr < 8; ++rr) rs[rr] = rstdq[tok0 + (rr >> 2) * HALF + (rr & 3) * 16];
#pragma unroll
            for (int rr = 0; rr < 8; ++rr) { const int ai = rr >> 2, m = rr & 3, tok = tok0 + ai * HALF + m * 16; rc = rs[rr];
#pragma unroll
                for (int bj = 0; bj < 2; ++bj) { const f32x4 o0 = acc[ai][bj][m][0] * (rc * c2 * 64.f), o1 = acc[ai][bj][m][1] * (rc * c2 * 64.f);
                    u32x2 w; w.x = pk_f8x4(o0.x, o0.y, o0.z, o0.w); w.y = pk_f8x4(o1.x, o1.y, o1.z, o1.w);
                    *(u32x2*)((unsigned char*)qlat + (size_t)tok * 4096 + pn * 256 + bj * HALF + wc * 32 + 8 * fq) = w; }
                asm volatile("" ::: "memory"); }
        } else { rc = rstdq[tok0]; h16* dst = (pn == 8) ? qr : qi; const float c2e = (pn == 8) ? c2 : 1.f; const int i = 4 * fq;
            f32x4 tc[2], tn[2];
            { const f32x4* tp = (const f32x4*)(tab + (size_t)tok0 * 48 + 32 + i); tc[0] = tp[0]; tc[1] = tp[1]; }
#pragma unroll
            for (int rr = 0; rr < 8; ++rr) { const int ai = rr >> 2, m = rr & 3, tok = tok0 + ai * HALF + m * 16;
                if (rr < 7) { const int tokn = tok0 + ((rr + 1) >> 2) * HALF + ((rr + 1) & 3) * 16; const f32x4* tp = (const f32x4*)(tab + (size_t)tokn * 48 + 32 + i); tn[0] = tp[0]; tn[1] = tp[1]; rn = rstdq[tokn]; }
                const f32x4 cs = {tc[0].x, tc[0].z, tc[1].x, tc[1].z}, sn = {tc[0].y, tc[0].w, tc[1].y, tc[1].w}; const float sc = rc * c2e;
#pragma unroll
                for (int bj = 0; bj < 2; ++bj) { const f32x4 x1 = acc[ai][bj][m][0], x2 = acc[ai][bj][m][1]; const f32x4 o1 = (x1 * cs - x2 * sn) * sc, o2 = (x2 * cs + x1 * sn) * sc;
                    h16* p = dst + (size_t)tok * 256 + (4 * bj + wc) * 32 + i;
                    u32x2 w1, w2; w1.x = pk_h2(o1.x, o1.y); w1.y = pk_h2(o1.z, o1.w); w2.x = pk_h2(o2.x, o2.y); w2.y = pk_h2(o2.z, o2.w);
                    *(u32x2*)p = w1; *(u32x2*)(p + 16) = w2; }
                tc[0] = tn[0]; tc[1] = tn[1]; rc = rn;
                asm volatile("" ::: "memory"); } }
    }
};
__device__ __forceinline__ u32x4 ld16_l2(const h16* p) {
    const unsigned long long a = __hip_atomic_load((const unsigned long long*)p, __ATOMIC_RELAXED, __HIP_MEMORY_SCOPE_AGENT), b = __hip_atomic_load((const unsigned long long*)p + 1, __ATOMIC_RELAXED, __HIP_MEMORY_SCOPE_AGENT);
    return (u32x4){(unsigned)a, (unsigned)(a >> 32), (unsigned)b, (unsigned)(b >> 32)};
}
typedef _Float16 h16x8 __attribute__((ext_vector_type(8)));
__device__ __forceinline__ void unpk8(const u32x4 w, float (&f)[8]) {
    const h16x8 h = __builtin_bit_cast(h16x8, w);
#pragma unroll
    for (int i = 0; i < 8; ++i) f[i] = (float)h[i];
}
template <bool SC>
struct EpiH16_T {
    static constexpr bool PERM = true;
    h16* O; int ldc = DM;
    __device__ __forceinline__ void operator()(const f32x4 (&acc)[2][2][4][2], const Unit& u, int wr, int wc, int fr, int fq) const {
        const int row0 = u.pm * BM + wr * 64 + fr, col0 = u.pn * BM + wc * 32 + 8 * fq;
#pragma unroll
        for (int ai = 0; ai < 2; ++ai)
#pragma unroll
            for (int m = 0; m < 4; ++m)
#pragma unroll
                for (int bj = 0; bj < 2; ++bj) { f32x4 v0 = acc[ai][bj][m][0], v1 = acc[ai][bj][m][1]; if constexpr (SC) { v0 *= F8_INV; v1 *= F8_INV; }
                    u32x4 w; w.x = pk_h2(v0.x, v0.y); w.y = pk_h2(v0.z, v0.w); w.z = pk_h2(v1.x, v1.y); w.w = pk_h2(v1.z, v1.w);
                    *(u32x4*)(O + (size_t)(row0 + ai * HALF + m * 16) * ldc + col0 + bj * HALF) = w; }
    }
};
typedef EpiH16_T<false> EpiH16;
struct EpiGate {
    static constexpr bool PERM = true;
    const h16* Y; h16* Z; int accum; float nls; const h16* Yb = nullptr;
    __device__ __forceinline__ void operator()(const f32x4 (&acc)[2][2][4][2], const Unit& u, int wr, int wc, int fr, int fq) const {
        const int row0 = u.pm * BM + wr * 64 + fr, col0 = (u.pn & 3) * BM + wc * 32 + 8 * fq; const bool accum = Yb ? (u.pn >= 4) : (this->accum != 0); const h16* Y = (Yb && u.pn >= 4) ? Yb : this->Y;
#pragma unroll
        for (int ai = 0; ai < 2; ++ai)
#pragma unroll
            for (int m = 0; m < 4; ++m)
#pragma unroll
                for (int bj = 0; bj < 2; ++bj) { const size_t off = (size_t)(row0 + ai * HALF + m * 16) * DM + col0 + bj * HALF;
                    float y[8], zz[8]; unpk8(ld16_l2(Y + off), y);
                    if (accum) unpk8(ld16_l2(Z + off), zz); else {
#pragma unroll
                        for (int i = 0; i < 8; ++i) zz[i] = 0.f; }
                    float o[8];
#pragma unroll
                    for (int n = 0; n < 2; ++n)
#pragma unroll
                        for (int e = 0; e < 4; ++e) { const float gg = acc[ai][bj][m][n][e]; o[n * 4 + e] = zz[n * 4 + e] + y[n * 4 + e] * __builtin_amdgcn_rcpf(1.f + __builtin_amdgcn_exp2f(gg * nls)); }
                    u32x4 w; w.x = pk_h2(o[0], o[1]); w.y = pk_h2(o[2], o[3]); w.z = pk_h2(o[4], o[5]); w.w = pk_h2(o[6], o[7]);
                    *(u32x4*)(Z + off) = w; }
    }
};
}

#define XB_TMO      128
#define XB_XCNT(j)  (256  + 64 * (j))
#define XB_XSUB(j)  (1280 + 64 * (j))
#define XB_XGEN(j)  (2304 + 64 * (j))
#define XB_TOP      3328
#define XB_TOPGEN   3392
#define XCD_BAR_WORDS 3456
#define XB_SPIN_CAP (1u << 18)
__device__ __forceinline__ unsigned xb_ld(unsigned* p)              { return __hip_atomic_load(p, __ATOMIC_RELAXED, __HIP_MEMORY_SCOPE_AGENT); }
__device__ __forceinline__ unsigned xb_add(unsigned* p, unsigned v) { return __hip_atomic_fetch_add(p, v, __ATOMIC_RELAXED, __HIP_MEMORY_SCOPE_AGENT); }
__device__ __forceinline__ unsigned xb_xcc_id() { return (unsigned)__builtin_amdgcn_s_getreg((3 << 11) | 20) & 0xFu; }
#define XB_SPIN(cond, bar) do { unsigned _sp = 0; while (cond) { __builtin_amdgcn_s_sleep(1); \
    if ((++_sp & 255u) == 0u) { if (xb_ld(&(bar)[XB_TMO])) break; if (_sp > XB_SPIN_CAP) { atomicAdd(&(bar)[XB_TMO], 1u); break; } } } } while (0)
struct XcdBarrier { unsigned* bar; unsigned x; volatile LAS unsigned* st; int wave; };
__device__ __forceinline__ XcdBarrier xcd_barrier_post(unsigned* bar, volatile LAS unsigned* st, int wave) {
    XcdBarrier b; b.bar = bar; b.x = xb_xcc_id(); b.st = st; b.wave = wave;
    if (wave == 0 && flane() == 0) (void)xb_add(&bar[XB_XCNT(b.x)], 1u);
    return b;
}
__device__ __forceinline__ void xcd_barrier_complete(unsigned* bar, unsigned x, unsigned& nloc, unsigned& nx) {
    const unsigned G = gridDim.x * gridDim.y * gridDim.z;
    unsigned sum, cnt, mine, sp = 0u;
    for (;;) {
        sum = 0u; cnt = 0u; mine = 0u;
#pragma unroll
        for (unsigned j = 0; j < 16; ++j) { const unsigned c = xb_ld(&bar[XB_XCNT(j)]); sum += c; cnt += (c > 0u) ? 1u : 0u; mine = (j == x) ? c : mine; }
        if (sum == G) break;
        __builtin_amdgcn_s_sleep(1);
        if ((++sp & 255u) == 0u) { if (xb_ld(&bar[XB_TMO])) break; if (sp > XB_SPIN_CAP) { atomicAdd(&bar[XB_TMO], 1u); break; } }
    }
    nloc = mine > 0u ? mine : 1u; nx = cnt > 0u ? cnt : 1u;
}
__device__ __forceinline__ void xcd_barrier(const XcdBarrier& b) {
    asm volatile("s_waitcnt vmcnt(0)" ::: "memory");
    __syncthreads();
    if (b.wave == 0 && flane() == 0) {
        unsigned* bar = b.bar;
        __builtin_amdgcn_s_waitcnt(0);
        unsigned nloc = b.st[0], nx = b.st[1];
        if (nloc == 0u) { xcd_barrier_complete(bar, b.x, nloc, nx); b.st[0] = nloc; b.st[1] = nx; }
        const unsigned old = xb_add(&bar[XB_XSUB(b.x)], 1u);
        const unsigned gen = old / nloc;
        if (old + 1u == (gen + 1u) * nloc) {
            __builtin_amdgcn_fence(__ATOMIC_RELEASE, "agent");
            asm volatile("s_waitcnt vmcnt(0)" ::: "memory");
            const unsigned og = xb_add(&bar[XB_TOP], 1u);
            const unsigned tg = og / nx;
            if (og + 1u == (tg + 1u) * nx) xb_add(&bar[XB_TOPGEN], 1u);
            else XB_SPIN(xb_ld(&bar[XB_TOPGEN]) == tg, bar);
            __builtin_amdgcn_fence(__ATOMIC_ACQUIRE, "agent");
            xb_add(&bar[XB_XGEN(b.x)], 1u);
            asm volatile("s_waitcnt vmcnt(0)" ::: "memory");
        } else {
            XB_SPIN(xb_ld(&bar[XB_XGEN(b.x)]) == gen, bar);
            __builtin_amdgcn_fence(__ATOMIC_ACQUIRE, "agent");
            asm volatile("s_waitcnt vmcnt(0)" ::: "memory");
        }
    }
    __syncthreads();
}

constexpr int NWAVES = 8, NTHR = 512;
constexpr int RING_BYTES = 131072, LDSCTL_OFF = RING_BYTES, MISC_OFF = LDSCTL_OFF + 320, LDS_BYTES = 149504;
constexpr int XCH_OFF = RING_BYTES + 1024;
constexpr int SELL_OFF = XCH_OFF;
static_assert(SELL_OFF + 8 * 2048 <= LDS_BYTES, "LDS layout");
constexpr int CW_BAR = 4096;
constexpr size_t OW_GU1 = OFF_W, OW_D1 = OW_GU1 + 11 * MiB, OW_IN = OW_D1 + (size_t)DM * FF * 2, OW_GATE = OW_IN + 6 * MiB, OW_4 = OW_GATE + 4 * MiB, OW_OV = OW_4 + 2 * MiB,
                 OW_UPB = OW_OV + 4 * MiB, OW_O = OW_UPB + MiB / 2, OW_GU2 = OW_O + 2 * MiB, OW_D2 = OW_GU2 + 11 * MiB, OW_END = OW_D2 + (size_t)DM * FF * 2;
static_assert(OW_END <= OFF_H, "weights region");
constexpr int NIN3 = 3072, N4 = 2560;
constexpr size_t OW_BD = OW_OV, OW_UPA = OW_OV + MiB, OFF_OA = OFF_A + 64 * MiB;

struct Args { const float* in[27]; float* out; unsigned char* ws; int ph_lo, ph_hi; };
struct Frame {
    LAS unsigned char* lds; int tid, lane, wave, G, gw, NGW;
};
__device__ __forceinline__ float wave_sum(float v) {
    v += dpp_f<0xB1>(v); v += dpp_f<0x4E>(v); v += dpp_f<0x141>(v); v += dpp_f<0x140>(v);
    v = sum_x16(v); v = sum_x32(v);
    return v;
}
__device__ __forceinline__ bool map_row(int job, int n, const Args& a, const float*& W, int& ldw, int& col) {
    if (job <= 1) { const int t = n >> 8, j = n & 255; W = a.in[(job == 0 ? 6 : 23) + (j >> 7)]; ldw = FF; col = t * 128 + (j & 127); return true; }
    if (job == 2) { W = a.in[11]; ldw = DIN; const int t = n >> 8, j = n & 255;
        if (t == 0) { col = C_CKV + j; return true; }
        if (t == 1) { col = j; return true; }
        if (t == 2) { if (j < 128) { col = 256 + j; return true; } if (j < 160) { col = C_KR + (j - 128); return true; } if (j < 192) { col = C_KI + (j - 160); return true; } if (j < 200) { col = C_WI + (j - 192); return true; } col = 0; return false; }
        if (t < 9) { const int c3 = (t - 3) / 3, tl = (t - 3) % 3, hl = (j & 127) >> 5, i = j & 31; col = C_QKV + c3 * 768 + (4 * tl + hl) * 64 + (j >> 7) * 32 + i; return true; }
        col = C_QKV + 1536 + (t - 9) * 256 + j; return true; }
    { const int n2 = n - 2048, r5 = n2 & 31, nat = 16 * ((r5 >> 2) & 1) + 4 * (r5 >> 3) + (r5 & 3);
      if (n2 < 256) { W = a.in[14]; ldw = 768; col = (n2 >> 5) * 96 + 64 + nat; } else { W = a.in[17]; ldw = 256; col = ((n2 - 256) & ~31) + nat; } return true; }
}
template <typename T>
__device__ __forceinline__ void tr_item(const float* W, int ldw, int col, bool valid, const float* scale, int k0, T* WTrow0, int K, LAS float* scr, int lane) {
    const int colc = valid ? col : 0; float vv[32];
#pragma unroll
    for (int i = 0; i < 32; ++i) vv[i] = W[(size_t)(k0 + 2 * i + (lane >> 5)) * ldw + colc];
    if (scale) {
#pragma unroll
        for (int i = 0; i < 32; ++i) vv[i] *= scale[k0 + 2 * i + (lane >> 5)]; }
#pragma unroll
    for (int i = 0; i < 32; ++i) scr[(2 * i + (lane >> 5)) * 33 + (lane & 31)] = valid ? vv[i] : 0.f;
    asm volatile("s_waitcnt lgkmcnt(0)" ::: "memory");
    const int c = lane & 7;
#pragma unroll
    for (int j = 0; j < 4; ++j) { const int n = (lane >> 3) + 8 * j; const LAS float* s = scr + (8 * c) * 33 + n;
        if constexpr (sizeof(T) == 1) { u32x2 o; o.x = pk_f8x4(s[0 * 33] * F8_WGT, s[1 * 33] * F8_WGT, s[2 * 33] * F8_WGT, s[3 * 33] * F8_WGT); o.y = pk_f8x4(s[4 * 33] * F8_WGT, s[5 * 33] * F8_WGT, s[6 * 33] * F8_WGT, s[7 * 33] * F8_WGT);
            *(u32x2*)(WTrow0 + (size_t)n * K + k0 + 8 * c) = o; }
        else { u32x4 o; o.x = pk_h2(s[0 * 33], s[1 * 33]); o.y = pk_h2(s[2 * 33], s[3 * 33]); o.z = pk_h2(s[4 * 33], s[5 * 33]); o.w = pk_h2(s[6 * 33], s[7 * 33]);
            *(u32x4*)(WTrow0 + (size_t)n * K + k0 + 8 * c) = o; } }
    asm volatile("s_waitcnt lgkmcnt(0)" ::: "memory");
}
template <typename T>
__device__ __forceinline__ void tr_job_mapped(const Frame& F, const Args& a, int job, int Ndest, int n_lo, int K, T* WT, const float* scale, LAS float* scr, int phase_off) {
    const int nblk = Ndest / 32, nitems = (K / 64) * nblk;
    for (int it = (F.gw + phase_off) % F.NGW; it < nitems; it += F.NGW) {
        const int kb = it / nblk, nb = it % nblk; const float* W; int ldw, col;
        const bool valid = map_row(job, n_lo + nb * 32 + (F.lane & 31), a, W, ldw, col);
        tr_item(W, ldw, col, valid, scale, kb * 64, WT + (size_t)(n_lo + nb * 32) * K, K, scr, F.lane);
    }
}
template <typename T>
__device__ __forceinline__ void tr_job_plain(const Frame& F, const float* W, int ldw, int Ndest, int K, T* WT, LAS float* scr, int phase_off) {
    const int nblk = Ndest / 32, nitems = (K / 64) * nblk;
    for (int it = (F.gw + phase_off) % F.NGW; it < nitems; it += F.NGW) {
        const int kb = it / nblk, nb = it % nblk;
        tr_item(W, ldw, nb * 32 + (F.lane & 31), true, nullptr, kb * 64, WT + (size_t)(nb * 32) * K, K, scr, F.lane);
    }
}
__device__ __forceinline__ void row_load(const float* p, int lane, f32x4 (&v)[4]) {
#pragma unroll
    for (int j = 0; j < 4; ++j) v[j] = __builtin_nontemporal_load((const f32x4*)p + lane + 64 * j);
}
__device__ __forceinline__ float row_ssq(const f32x4 (&v)[4]) { float s = 0.f;
#pragma unroll
    for (int j = 0; j < 4; ++j) s += (v[j].x * v[j].x + v[j].y * v[j].y) + (v[j].z * v[j].z + v[j].w * v[j].w);
    return wave_sum(s); }
template <typename T>
__device__ __forceinline__ void store_nm(const f32x4 (&xv)[4], float r2, const f32x4 (&gb)[4], const f32x4 (&gc)[4], T* dst, int lane, unsigned char* dst8) {
#pragma unroll
    for (int j = 0; j < 4; ++j) { const int ci = lane + 64 * j; const f32x4 o = xv[j] * r2 * gb[j] + gc[j];
        if constexpr (sizeof(T) == 1) __builtin_nontemporal_store(pk_f8x4(o.x * F8_ACT, o.y * F8_ACT, o.z * F8_ACT, o.w * F8_ACT), (unsigned*)dst + ci);
        else { u32x2 w; w.x = pk_h2(o.x, o.y); w.y = pk_h2(o.z, o.w); __builtin_nontemporal_store(w, (u32x2*)dst + ci); if (dst8) __builtin_nontemporal_store(pk_f8x4(o.x * F8_ACT, o.y * F8_ACT, o.z * F8_ACT, o.w * F8_ACT), (unsigned*)dst8 + ci); } }
}
template <typename T>
__device__ __forceinline__ void ph_normmod(const Frame& F, const float* x, const float* g, const float* mod, int isc, int ish, T* dst) {
    const int lane = flane();
    const int b = F.gw & 3, nsl = F.NGW >> 2; int r0 = F.gw >> 2; if (r0 >= SEQ) return;
    const float* mb = mod + b * (NMOD * DM); f32x4 gb[4], gc[4];
#pragma unroll
    for (int j = 0; j < 4; ++j) { const int ci = lane + 64 * j; gb[j] = ((const f32x4*)g)[ci] * (((const f32x4*)(mb + isc * DM))[ci] + 1.f); gc[j] = ((const f32x4*)(mb + ish * DM))[ci]; }
    const float* xb = x + (size_t)b * SEQ * DM; T* db = dst + (size_t)b * SEQ * DM;
    f32x4 v[2][4], vn[2][4];
#pragma unroll
    for (int k = 0; k < 2; ++k) { const int r = r0 + k * nsl; row_load(xb + (size_t)(r < SEQ ? r : r0) * DM, lane, v[k]); }
    for (;;) { const int rn = r0 + 2 * nsl; const bool has = rn < SEQ;
        if (has) {
#pragma unroll
            for (int k = 0; k < 2; ++k) { const int r = rn + k * nsl; row_load(xb + (size_t)(r < SEQ ? r : rn) * DM, lane, vn[k]); } }
#pragma unroll
        for (int k = 0; k < 2; ++k) { const int r = r0 + k * nsl; const float rstd = rsqrtf(row_ssq(v[k]) * (1.f / DM) + EPS);
            if (r < SEQ) store_nm(v[k], rstd, gb, gc, db + (size_t)r * DM, lane, nullptr); }
        if (!has) break;
#pragma unroll
        for (int k = 0; k < 2; ++k)
#pragma unroll
            for (int j = 0; j < 4; ++j) v[k][j] = vn[k][j];
        r0 = rn; }
}
__device__ __forceinline__ void row_load_h(const h16* p, int lane, u32x2 (&v)[4]) {
#pragma unroll
    for (int j = 0; j < 4; ++j) v[j] = __builtin_nontemporal_load((const u32x2*)p + lane + 64 * j);
}
typedef _Float16 h16x4 __attribute__((ext_vector_type(4)));
__device__ __forceinline__ f32x4 h4_to_f4(u32x2 w) { const h16x4 h = __builtin_bit_cast(h16x4, w); return (f32x4){(float)h[0], (float)h[1], (float)h[2], (float)h[3]}; }
template <bool XI16, bool XO16, typename T = h16>
__device__ __forceinline__ void ph_resnorm(const Frame& F, const void* xin_, const h16* f, const float* gpost, const float* mod, int igt, float coef, void* xout_,
                                           bool second, const float* gpre, int isc, int ish, T* dst, unsigned char* dst8 = nullptr) {
    const int lane = flane();
    const int b = F.gw & 3, nsl = F.NGW >> 2; int r0 = F.gw >> 2; if (r0 >= SEQ) return;
    const float* mb = mod + b * (NMOD * DM); f32x4 ga[4], gb[4], gc[4];
#pragma unroll
    for (int j = 0; j < 4; ++j) { const int ci = lane + 64 * j; ga[j] = ((const f32x4*)gpost)[ci] * ((const f32x4*)(mb + igt * DM))[ci] * coef;
        if (second) { gb[j] = ((const f32x4*)gpre)[ci] * (((const f32x4*)(mb + isc * DM))[ci] + 1.f); gc[j] = ((const f32x4*)(mb + ish * DM))[ci]; } else { gb[j] = (f32x4){0.f, 0.f, 0.f, 0.f}; gc[j] = gb[j]; } }
    const size_t bo = (size_t)b * SEQ * DM; const h16* fb = f + bo;
    u32x2 fh[2][4], fn[2][4]; f32x4 xi[2][4], xn[2][4]; u32x2 xh[2][4], xhn[2][4];
#pragma unroll
    for (int k = 0; k < 2; ++k) { const int r = r0 + k * nsl; const size_t ro = (size_t)(r < SEQ ? r : r0) * DM; row_load_h(fb + ro, lane, fh[k]);
        if constexpr (XI16) row_load_h((const h16*)xin_ + bo + ro, lane, xh[k]); else row_load((const float*)xin_ + bo + ro, lane, xi[k]); }
    for (;;) {
        const int rn = r0 + 2 * nsl; const bool has = rn < SEQ;
        if (has) {
#pragma unroll
            for (int k = 0; k < 2; ++k) { const int r = rn + k * nsl; const size_t ro = (size_t)(r < SEQ ? r : rn) * DM; row_load_h(fb + ro, lane, fn[k]);
                if constexpr (XI16) row_load_h((const h16*)xin_ + bo + ro, lane, xhn[k]); else row_load((const float*)xin_ + bo + ro, lane, xn[k]); } }
#pragma unroll
        for (int k = 0; k < 2; ++k) { const int r = r0 + k * nsl; const bool ok = r < SEQ; const size_t ro = bo + (size_t)r * DM;
            f32x4 v[4];
#pragma unroll
            for (int j = 0; j < 4; ++j) { v[j] = h4_to_f4(fh[k][j]); if constexpr (XI16) xi[k][j] = h4_to_f4(xh[k][j]); }
            const float rstd = rsqrtf(row_ssq(v) * (1.f / DM) + EPS);
#pragma unroll
            for (int j = 0; j < 4; ++j) { const int ci = lane + 64 * j;
                xi[k][j] = xi[k][j] + ga[j] * v[j] * rstd;
                if (ok) { if constexpr (XO16) { u32x2 w; w.x = pk_h2(xi[k][j].x, xi[k][j].y); w.y = pk_h2(xi[k][j].z, xi[k][j].w); __builtin_nontemporal_store(w, (u32x2*)((h16*)xout_ + ro) + ci); }
                          else __builtin_nontemporal_store(xi[k][j], (f32x4*)((float*)xout_ + ro) + ci); } }
            if (second) { const float r2 = rsqrtf(row_ssq(xi[k]) * (1.f / DM) + EPS); if (ok) store_nm(xi[k], r2, gb, gc, dst + ro, lane, dst8 ? dst8 + ro : nullptr); } }
        if (!has) break;
#pragma unroll
        for (int k = 0; k < 2; ++k)
#pragma unroll
            for (int j = 0; j < 4; ++j) { fh[k][j] = fn[k][j]; if constexpr (XI16) xh[k][j] = xhn[k][j]; else xi[k][j] = xn[k][j]; }
        r0 = rn;
    }
}

__device__ __forceinline__ void ph_combine(const Frame& F, const h16* og, const float* lse2, h16* ob) {
    for (int idx = blockIdx.x * NTHR + F.tid; idx < MT * 32; idx += F.G * NTHR) {
        const int tok = idx >> 5, c = (idx & 31) * 8, hh = c >> 6;
        const float l0 = lse2[tok * 12 + hh], l1 = lse2[tok * 12 + 4 + hh], l2 = lse2[tok * 12 + 8 + hh], m = fmaxf(l0, fmaxf(l1, l2));
        const float w0 = exp2f(l0 - m), w1 = exp2f(l1 - m), w2 = exp2f(l2 - m), inv = 1.f / (w0 + w1 + w2);
        const u32x4 a = *(const u32x4*)(og + (size_t)tok * 768 + c), b = *(const u32x4*)(og + (size_t)tok * 768 + 256 + c), d = *(const u32x4*)(og + (size_t)tok * 768 + 512 + c);
        const f16x8 ha = __builtin_bit_cast(f16x8, a), hb = __builtin_bit_cast(f16x8, b), hd = __builtin_bit_cast(f16x8, d);
        float o[8];
#pragma unroll
        for (int i = 0; i < 8; ++i) o[i] = (w0 * (float)ha[i] + w1 * (float)hb[i] + w2 * (float)hd[i]) * inv;
        u32x4 w; w.x = pk_h2(o[0], o[1]); w.y = pk_h2(o[2], o[3]); w.z = pk_h2(o[4], o[5]); w.w = pk_h2(o[6], o[7]);
        *(u32x4*)(ob + (size_t)tok * 256 + c) = w; }
}
typedef short v4i16_t __attribute__((ext_vector_type(4)));
typedef short s16x8 __attribute__((ext_vector_type(8)));
typedef float f32x16 __attribute__((ext_vector_type(16)));
__device__ __forceinline__ int tk_bin(float sc) { const unsigned u = __float_as_uint(sc); int e = (int)((u >> 16) & 0x7FFFu) - (122 << 7); e = e < 0 ? 0 : (e > 1023 ? 1023 : e); return (u >> 31) ? 1023 - e : 1024 + e; }
__device__ __forceinline__ void tk_scores(const f16x8 (&Af)[2], const float (&wv)[16], f16x8 b0, f16x8 b1, float& sa, float& sb) {
    f32x16 d = {0.f, 0.f, 0.f, 0.f, 0.f, 0.f, 0.f, 0.f, 0.f, 0.f, 0.f, 0.f, 0.f, 0.f, 0.f, 0.f};
    d = __builtin_amdgcn_mfma_f32_32x32x16_f16(Af[0], b0, d, 0, 0, 0); d = __builtin_amdgcn_mfma_f32_32x32x16_f16(Af[1], b1, d, 0, 0, 0);
    f32x2 acc = {0.f, 0.f};
#pragma unroll
    for (int e = 0; e < 16; e += 2) { const int i0 = __float_as_int(d[e]), i1 = __float_as_int(d[e + 1]);
        const f32x2 rl = {__int_as_float(i0 > 0 ? i0 : 0), __int_as_float(i1 > 0 ? i1 : 0)}; const f32x2 w2 = {wv[e], wv[e + 1]};
        acc = __builtin_elementwise_fma(w2, rl, acc); }
    sa = acc.x; sb = acc.y;
}
template <bool P2>
__device__ __forceinline__ void tk_tile(const f16x8 (&Af)[2], const float (&wv)[16], f16x8 b0, f16x8 b1, int tile, int r, int hi, int ta, LAS unsigned* hist, const int (&tbin)[4], int (&cs)[4], int (&cc)[4],
                                        LAS unsigned short* sel, int tok0, unsigned* sscr, unsigned sload = 0u) {
    float sa, sb;
    if constexpr (!P2) { tk_scores(Af, wv, b0, b1, sa, sb); const h16x2 hp = {(h16)sa, (h16)sb}; sa = (float)hp[0]; sb = (float)hp[1]; sscr[tile * 64 + 2 * r + hi] = __builtin_bit_cast(unsigned, hp); }
    else { const h16x2 hp = __builtin_bit_cast(h16x2, sload); sa = (float)hp[0]; sb = (float)hp[1]; }
    const int s = 32 * tile + r;
    if constexpr (!P2) {
        if (s <= ta) { const int bn = tk_bin(sa); __hip_atomic_fetch_add(hist + (2 * hi) * 1024 + (bn >> 1), 1u << (16 * (bn & 1)), __ATOMIC_RELAXED, __HIP_MEMORY_SCOPE_WORKGROUP); }
        if (s <= ta + 1) { const int bn = tk_bin(sb); __hip_atomic_fetch_add(hist + (2 * hi + 1) * 1024 + (bn >> 1), 1u << (16 * (bn & 1)), __ATOMIC_RELAXED, __HIP_MEMORY_SCOPE_WORKGROUP); }
    } else {
        const unsigned lowmask = (1u << r) - 1u;
#pragma unroll
        for (int ab = 0; ab < 2; ++ab) { const float sc = ab ? sb : sa; const int tq = ta + ab; const int bn = tk_bin(sc);
            const int mytb = hi ? tbin[2 + ab] : tbin[ab];
            const bool valid = s <= tq, sure = valid && bn > mytb, cand = valid && bn == mytb;
            const unsigned long long ms = __ballot(sure), mc = __ballot(cand);
            const unsigned ms_h = hi ? (unsigned)(ms >> 32) : (unsigned)ms, mc_h = hi ? (unsigned)(mc >> 32) : (unsigned)mc;
            const int q = 2 * hi + ab;
            const int base_s = hi ? cs[2 + ab] : cs[ab], base_c = hi ? cc[2 + ab] : cc[ab];
            if (sure) sel[q * TOPK + base_s + __builtin_popcount(ms_h & lowmask)] = (unsigned short)s;
            if (cand) { const int pos = base_c + __builtin_popcount(mc_h & lowmask);
                if (pos < 512) ((LAS unsigned long long*)((LAS unsigned char*)hist + q * 4096))[pos] = ((unsigned long long)fkey(sc) << 16) | (unsigned long long)(0xFFFFu - (unsigned)s); }
            cs[ab] += __builtin_popcount((unsigned)ms); cs[2 + ab] += __builtin_popcount((unsigned)(ms >> 32));
            cc[ab] += __builtin_popcount((unsigned)mc); cc[2 + ab] += __builtin_popcount((unsigned)(mc >> 32)); }
    }
}
template <bool P2>
__device__ __forceinline__ void tk_pass(const f16x8 (&Af)[2], const float (&wv)[16], const h16* kbase, int ntiles, int r, int hi, int ta, LAS unsigned* hist, const int (&tbin)[4], int (&cs)[4], int (&cc)[4],
                                        LAS unsigned short* sel, int tok0, unsigned* sscr) {
    if constexpr (P2) {
        const unsigned* sp_ = sscr + 2 * r + hi; unsigned SA[8], SB[8]; const f16x8 z8 = {0, 0, 0, 0, 0, 0, 0, 0};
#define TK_LOADS(dst, t0_) do { _Pragma("unroll") for (int i_ = 0; i_ < 8; ++i_) { const int tt_ = ((t0_) + i_) < 127 ? ((t0_) + i_) : 127; dst[i_] = __builtin_nontemporal_load(sp_ + tt_ * 64); } } while (0)
        TK_LOADS(SA, 0);
        for (int t0 = 0; t0 < ntiles; t0 += 16) {
            TK_LOADS(SB, t0 + 8);
#pragma unroll
            for (int i = 0; i < 8; ++i) if (t0 + i < ntiles) tk_tile<true>(Af, wv, z8, z8, t0 + i, r, hi, ta, hist, tbin, cs, cc, sel, tok0, sscr, SA[i]);
            TK_LOADS(SA, t0 + 16);
#pragma unroll
            for (int i = 0; i < 8; ++i) if (t0 + 8 + i < ntiles) tk_tile<true>(Af, wv, z8, z8, t0 + 8 + i, r, hi, ta, hist, tbin, cs, cc, sel, tok0, sscr, SB[i]);
        }
#undef TK_LOADS
        return; }
    f16x8 BA[4][2], BB[4][2];
#define TK_LOAD(dst, t0_) do { _Pragma("unroll") for (int i_ = 0; i_ < 4; ++i_) { const int tt_ = ((t0_) + i_) < 127 ? ((t0_) + i_) : 127; dst[i_][0] = *(const f16x8*)(kbase + (size_t)tt_ * 1024); dst[i_][1] = *(const f16x8*)(kbase + (size_t)tt_ * 1024 + 16); } } while (0)
    TK_LOAD(BA, 0);
    for (int t0 = 0; t0 < ntiles; t0 += 8) {
        TK_LOAD(BB, t0 + 4);
#pragma unroll
        for (int i = 0; i < 4; ++i) if (t0 + i < ntiles) tk_tile<P2>(Af, wv, BA[i][0], BA[i][1], t0 + i, r, hi, ta, hist, tbin, cs, cc, sel, tok0, sscr);
        TK_LOAD(BA, t0 + 8);
#pragma unroll
        for (int i = 0; i < 4; ++i) if (t0 + 4 + i < ntiles) tk_tile<P2>(Af, wv, BB[i][0], BB[i][1], t0 + 4 + i, r, hi, ta, hist, tbin, cs, cc, sel, tok0, sscr);
    }
#undef TK_LOAD
}
__device__ __forceinline__ void tk_group(const Frame& F, const h16* qi, const h16* ki, const float* wi, LAS unsigned short* sel, int b, int t0, LAS unsigned* hist, unsigned* sscr) {
    int lane_ = F.lane; asm volatile("" : "+v"(lane_)); const int lane = lane_, r = lane & 31, hi = lane >> 5, tok0 = b * SEQ + t0;
    const int qa = 2 * ((r >> 2) & 1) + (r & 1), ha = 4 * (r >> 4) + 2 * ((r >> 3) & 1) + ((r >> 1) & 1);
    f16x8 Af[2];
#pragma unroll
    for (int s_ = 0; s_ < 2; ++s_) Af[s_] = *(const f16x8*)(qi + (size_t)(tok0 + qa) * 256 + ha * 32 + 16 * s_ + 8 * hi);
    float wv[16];
    { const f32x4 a0 = *(const f32x4*)(wi + (tok0 + 2 * hi) * 8), a1 = *(const f32x4*)(wi + (tok0 + 2 * hi) * 8 + 4), b0 = *(const f32x4*)(wi + (tok0 + 2 * hi + 1) * 8), b1 = *(const f32x4*)(wi + (tok0 + 2 * hi + 1) * 8 + 4);
      const float sa[8] = {a0.x, a0.y, a0.z, a0.w, a1.x, a1.y, a1.z, a1.w}, sb[8] = {b0.x, b0.y, b0.z, b0.w, b1.x, b1.y, b1.z, b1.w};
#pragma unroll
      for (int h = 0; h < 8; ++h) { wv[2 * h] = sa[h] * 0.17677669529663687f; wv[2 * h + 1] = sb[h] * 0.17677669529663687f; } }
    const int ntiles = (t0 + 3) / 32 + 1, ta = t0 + 2 * hi;
    const h16* kbase = ki + (size_t)(b * SEQ + r) * 32 + 8 * hi;
    int tbin[4] = {0, 0, 0, 0}, nsure[4], cs[4] = {0, 0, 0, 0}, cc[4] = {0, 0, 0, 0};
#pragma unroll
    for (int i = 0; i < 16; ++i) *(LAS u32x4*)((LAS unsigned char*)hist + i * 1024 + lane * 16) = (u32x4){0u, 0u, 0u, 0u};
    asm volatile("s_waitcnt lgkmcnt(0)" ::: "memory");
    tk_pass<false>(Af, wv, kbase, ntiles, r, hi, ta, hist, tbin, cs, cc, sel, tok0, sscr);
    asm volatile("s_waitcnt vmcnt(0)" ::: "memory");
    asm volatile("s_waitcnt lgkmcnt(0)" ::: "memory");
#pragma unroll
    for (int q = 0; q < 4; ++q) {
        const LAS unsigned* hq = hist + q * 1024;
        unsigned sum = 0;
#pragma unroll
        for (int i = 0; i < 4; ++i) { const u32x4 v = *(const LAS u32x4*)(hq + 16 * lane + 4 * i); sum += (v.x & 0xFFFFu) + (v.x >> 16) + (v.y & 0xFFFFu) + (v.y >> 16) + (v.z & 0xFFFFu) + (v.z >> 16) + (v.w & 0xFFFFu) + (v.w >> 16); }
        unsigned incl = sum;
#pragma unroll
        for (int o = 1; o < 64; o <<= 1) { const unsigned v = __shfl_down(incl, o); if (lane + o < 64) incl += v; }
        const unsigned long long bal = __ballot(incl >= (unsigned)TOPK);
        const int L = 63 - __builtin_clzll(bal);
        unsigned cum = __shfl(incl, L) - __shfl(sum, L);
        int tbq = 32 * L, found = 0;
        for (int wd = 15; wd >= 0 && !found; --wd) { const unsigned v = hq[16 * L + wd];
            const unsigned chi = v >> 16, clo = v & 0xFFFFu;
            if (cum + chi >= (unsigned)TOPK) { tbq = 32 * L + 2 * wd + 1; found = 1; } else { cum += chi;
                if (cum + clo >= (unsigned)TOPK) { tbq = 32 * L + 2 * wd; found = 1; } else cum += clo; } }
        tbin[q] = tbq; nsure[q] = (int)cum;
    }
    asm volatile("s_waitcnt lgkmcnt(0)" ::: "memory");
    {   unsigned klo[4], khi[4];
#pragma unroll
        for (int q = 0; q < 4; ++q) { const int tb = tbin[q];
            if (tb >= 1024) { const int e = tb - 1024; klo[q] = 0x80000000u | (e == 0 ? 0u : (unsigned)(e + 15616) << 16); khi[q] = (e == 1023) ? 0xFFFFFFFFu : (0x80000000u | ((unsigned)(e + 15617) << 16)); }
            else { const int e = 1023 - tb; const unsigned mlo = e == 0 ? 0u : (unsigned)(e + 15616) << 16, mhi = (e == 1023) ? 0x80000000u : (unsigned)(e + 15617) << 16; klo[q] = 0x80000000u - mhi; khi[q] = 0x80000000u - mlo; } }
        const int nkb = (t0 + 3) / 64 + 1;
        const u32x2* sp2 = (const u32x2*)sscr + lane;
        u32x2 wc_ = __builtin_nontemporal_load(sp2), wn_ = wc_;
        for (int j = 0; j < nkb; ++j) {
            if (j + 1 < nkb) wn_ = __builtin_nontemporal_load(sp2 + 64 * (j + 1));
            const int s_ = 64 * j + lane;
#pragma unroll
            for (int q = 0; q < 4; ++q) { const unsigned w_ = q < 2 ? wc_.x : wc_.y; const h16x2 hp = __builtin_bit_cast(h16x2, w_); const float sc = (float)hp[q & 1];
                const unsigned kk = fkey(sc); const bool valid = s_ <= t0 + q, sure = valid && kk >= khi[q] && khi[q] != 0xFFFFFFFFu, cand = valid && kk >= klo[q] && !(kk >= khi[q] && khi[q] != 0xFFFFFFFFu);
                const unsigned long long ms = __ballot(sure), mc = __ballot(cand);
                if (sure) sel[q * TOPK + cs[q] + (int)__builtin_amdgcn_mbcnt_hi((unsigned)(ms >> 32), __builtin_amdgcn_mbcnt_lo((unsigned)ms, 0u))] = (unsigned short)s_;
                if (cand) { const int pos = cc[q] + (int)__builtin_amdgcn_mbcnt_hi((unsigned)(mc >> 32), __builtin_amdgcn_mbcnt_lo((unsigned)mc, 0u));
                    if (pos < 512) ((LAS unsigned long long*)((LAS unsigned char*)hist + q * 4096))[pos] = ((unsigned long long)kk << 16) | (unsigned long long)(0xFFFFu - (unsigned)s_); }
                cs[q] += __builtin_popcountll(ms); cc[q] += __builtin_popcountll(mc); }
            wc_ = wn_; } }
    asm volatile("s_waitcnt lgkmcnt(0)" ::: "memory");
#pragma unroll
    for (int q = 0; q < 4; ++q) {
        const int nc = cc[q] < 512 ? cc[q] : 512, need = TOPK - cs[q];
        const LAS unsigned long long* cq = (const LAS unsigned long long*)((const LAS unsigned char*)hist + q * 4096);
        if (nc > 64) {
            unsigned long long it[8];
#pragma unroll
            for (int k = 0; k < 8; ++k) it[k] = (k * 64 + lane < nc) ? cq[k * 64 + lane] : 0ull;
            unsigned long long T = 0ull;
            for (int bit = 47; bit >= 0; --bit) { const unsigned long long cand = T | (1ull << bit); int cnt = 0;
#pragma unroll
                for (int k = 0; k < 8; ++k) cnt += __builtin_popcountll(__ballot(it[k] >= cand));
                if (cnt >= need) T = cand; }
            int basep = cs[q];
#pragma unroll
            for (int k = 0; k < 8; ++k) { const bool pick = (T != 0ull) && it[k] >= T; const unsigned long long mk = __ballot(pick);
                if (pick) sel[q * TOPK + basep + __builtin_popcountll(mk & ((1ull << lane) - 1ull))] = (unsigned short)(0xFFFFu - (unsigned)(it[k] & 0xFFFFull));
                basep += __builtin_popcountll(mk); }
        } else
        for (int base = 0; base < nc; base += 64) {
            const bool act = base + lane < nc; const unsigned long long my = act ? cq[base + lane] : 0ull; int rank = 0;
            for (int jb = 0; jb < nc; jb += 64) {
                const unsigned long long cj = (jb + lane < nc) ? cq[jb + lane] : 0ull; const unsigned clo = (unsigned)cj, chi = (unsigned)(cj >> 32);
                const int n = (nc - jb) < 64 ? (nc - jb) : 64;
                for (int j = 0; j < n; ++j) { const unsigned long long sj = ((unsigned long long)(unsigned)__builtin_amdgcn_readlane((int)chi, j) << 32) | (unsigned)__builtin_amdgcn_readlane((int)clo, j); rank += (sj > my) ? 1 : 0; } }
            if (act && rank < need) sel[q * TOPK + cs[q] + rank] = (unsigned short)(0xFFFFu - (unsigned)(my & 0xFFFFull)); }
    }
    (void)nsure;
    asm volatile("s_waitcnt lgkmcnt(0)" ::: "memory");
}

__device__ __forceinline__ void ph_dilated_mfma(const Frame& F, const h16* qb, const h16* kb, const h16* vb, h16* og, float* lse2) {
    const int lane = F.lane, ql = lane & 31, hi = lane >> 5;
    LAS unsigned char* VL = F.lds + F.wave * 16384;
    LAS float* linv = (LAS float*)(VL + 12288);
    constexpr int VROW = 192;
    const int trq = (lane & 15) >> 2, trp = lane & 3, trg = (lane >> 4) & 1;
    for (int u = F.gw; u < NB * 12 * 128; u += F.NGW) {
        const int b = u / 1536, rem = u % 1536, gh = rem >> 7, g = gh >> 2, wi_ = rem & 127, dil = dil_of(g), sh = g == 0 ? 0 : (g == 1 ? 2 : 4);
        const int nblk = 128 >> sh, res = wi_ / nblk, j0 = 32 * (wi_ % nblk);
        const size_t hoff = (size_t)b * SEQ * 768 + gh * 64;
        f16x8 Qf[4];
        { const h16* qp = qb + hoff + (size_t)((j0 + ql) * dil + res) * 768 + 8 * hi;
#pragma unroll
          for (int s_ = 0; s_ < 4; ++s_) Qf[s_] = *(const f16x8*)(qp + 16 * s_); }
        f32x16 S[5];
        f16x8 Kf[5][4];
#pragma unroll
        for (int kt = 0; kt < 5; ++kt) { int jk = j0 - 128 + 32 * kt + ql; jk = jk < 0 ? 0 : jk;
            const h16* kp = kb + hoff + (size_t)(jk * dil + res) * 768 + 8 * hi;
#pragma unroll
            for (int s_ = 0; s_ < 4; ++s_) Kf[kt][s_] = *(const f16x8*)(kp + 16 * s_); }
#pragma unroll
        for (int kt = 0; kt < 5; ++kt) {
            f32x16 d = {0.f, 0.f, 0.f, 0.f, 0.f, 0.f, 0.f, 0.f, 0.f, 0.f, 0.f, 0.f, 0.f, 0.f, 0.f, 0.f};
#pragma unroll
            for (int s_ = 0; s_ < 4; ++s_) d = __builtin_amdgcn_mfma_f32_32x32x16_f16(Kf[kt][s_], Qf[s_], d, 0, 0, 0);
            S[kt] = d; }
        f16x8 Vr[5][4];
#pragma unroll
        for (int kt = 0; kt < 5; ++kt) { int jk = j0 - 128 + 32 * kt + (lane >> 1); jk = jk < 0 ? 0 : jk;
            const h16* vp = vb + hoff + (size_t)(jk * dil + res) * 768 + (lane & 1) * 32;
#pragma unroll
            for (int i = 0; i < 4; ++i) Vr[kt][i] = *(const f16x8*)(vp + 8 * i); }
        float m = -INFINITY;
#pragma unroll
        for (int kt = 0; kt < 5; ++kt)
#pragma unroll
            for (int e = 0; e < 16; ++e) { const int kl = (e & 3) + 8 * (e >> 2) + 4 * hi; bool ok = (j0 - 128 + 32 * kt + kl) >= 0;
                if (kt == 0) ok = ok && (kl >= ql); if (kt == 4) ok = ok && (kl <= ql);
                if (!ok) S[kt][e] = -INFINITY; m = fmaxf(m, S[kt][e]); }
        m = max_x32(m);
        float l = 0.f;
#pragma unroll
        for (int kt = 0; kt < 5; ++kt)
#pragma unroll
            for (int e = 0; e < 16; ++e) { const float p = __builtin_amdgcn_exp2f(S[kt][e] - m); S[kt][e] = p; l += p; }
        l = sum_x32(l);
        if (hi == 0) { linv[ql] = __builtin_amdgcn_rcpf(l); lse2[(size_t)(b * SEQ + (j0 + ql) * dil + res) * 12 + gh] = m + __builtin_amdgcn_logf(l); }
        f32x16 O[2];
#pragma unroll
        for (int dt = 0; dt < 2; ++dt) O[dt] = (f32x16){0.f, 0.f, 0.f, 0.f, 0.f, 0.f, 0.f, 0.f, 0.f, 0.f, 0.f, 0.f, 0.f, 0.f, 0.f, 0.f};
#pragma unroll
        for (int kt = 0; kt < 5; ++kt) {
            LAS unsigned char* vbuf = VL + (kt & 1) * 6144;
#pragma unroll
            for (int i = 0; i < 4; ++i) *(LAS f16x8*)(vbuf + (lane >> 1) * VROW + (lane & 1) * 64 + i * 16) = Vr[kt][i];
            asm volatile("s_waitcnt lgkmcnt(0)" ::: "memory");
#pragma unroll
            for (int s2 = 0; s2 < 2; ++s2) {
                u32x4 pa; pa.x = pk_h2(S[kt][8 * s2 + 0], S[kt][8 * s2 + 1]); pa.y = pk_h2(S[kt][8 * s2 + 2], S[kt][8 * s2 + 3]); pa.z = pk_h2(S[kt][8 * s2 + 4], S[kt][8 * s2 + 5]); pa.w = pk_h2(S[kt][8 * s2 + 6], S[kt][8 * s2 + 7]);
#pragma unroll
                for (int dt = 0; dt < 2; ++dt) {
                    const v4i16_t lo = __builtin_amdgcn_ds_read_tr16_b64_v4i16((LAS v4i16_t*)(vbuf + (16 * s2 + 4 * hi + trq) * VROW + (32 * dt + 16 * trg + 4 * trp) * 2));
                    const v4i16_t hh = __builtin_amdgcn_ds_read_tr16_b64_v4i16((LAS v4i16_t*)(vbuf + (16 * s2 + 8 + 4 * hi + trq) * VROW + (32 * dt + 16 * trg + 4 * trp) * 2));
                    const s16x8 bv = {lo[0], lo[1], lo[2], lo[3], hh[0], hh[1], hh[2], hh[3]};
                    O[dt] = __builtin_amdgcn_mfma_f32_32x32x16_f16(__builtin_bit_cast(f16x8, pa), __builtin_bit_cast(f16x8, bv), O[dt], 0, 0, 0); } }
            asm volatile("s_waitcnt lgkmcnt(0)" ::: "memory");
        }
#pragma unroll
        for (int e = 0; e < 16; ++e) { const int q = (e & 3) + 8 * (e >> 2) + 4 * hi; const float il = linv[q];
            h16* op = og + (size_t)(b * SEQ + (j0 + q) * dil + res) * 768 + gh * 64 + ql;
            op[0] = (h16)(O[0][e] * il); op[32] = (h16)(O[1][e] * il); }
        asm volatile("s_waitcnt lgkmcnt(0)" ::: "memory");
    }
}


__device__ __forceinline__ f16x8 fp8x8_to_f16(unsigned w0, unsigned w1) {
    const h16x2 a = __builtin_amdgcn_cvt_scalef32_pk_f16_fp8((int)w0, 1.0f, false), b = __builtin_amdgcn_cvt_scalef32_pk_f16_fp8((int)w0, 1.0f, true),
                c = __builtin_amdgcn_cvt_scalef32_pk_f16_fp8((int)w1, 1.0f, false), d = __builtin_amdgcn_cvt_scalef32_pk_f16_fp8((int)w1, 1.0f, true);
    const u32x4 r = {__builtin_bit_cast(unsigned, a), __builtin_bit_cast(unsigned, b), __builtin_bit_cast(unsigned, c), __builtin_bit_cast(unsigned, d)};
    return __builtin_bit_cast(f16x8, r);
}
typedef int i32x2_t __attribute__((ext_vector_type(2)));
template <bool FUSED>
__device__ __forceinline__ void ph_sparse_wave(const Frame& F, h16* qlat, const h16* qr, const unsigned char* ckv8, const unsigned char* kr8, const LAS unsigned short* selL, int ta = 0) {
    int lane = F.lane; asm volatile("" : "+v"(lane));
    LAS unsigned char* V = F.lds + F.wave * 16384;
    const int tr_r = (lane & 15) >> 1, tr_c = lane & 1, tr_key = (tr_r < 4) ? (4 * (lane >> 4) + tr_r) : (16 + 4 * (lane >> 4) + tr_r - 4);
    const int tr0 = tr_key * 256 + 8 * tr_c, x0 = (tr_key & 15) ^ ((tr_key >> 4) << 3);
    const int lane0 = lane;
    const int nit = 4;
    for (int it = 0; it < nit; ++it) {
        const int tok = ta + it;
        int ll = lane0; asm volatile("" : "+v"(ll));
        const int c = ll & 15, kq = ll >> 4, hd = c & 7;
        const int b = tok / SEQ, t = tok % SEQ, cnt = (t + 1 < TOPK) ? t + 1 : TOPK, nch = (cnt + 31) >> 5;
        const LAS unsigned short* sp = selL + it * TOPK + c;
        u32x4 Q8[4]; f16x8 Qr;
#pragma unroll
        for (int q4 = 0; q4 < 4; ++q4) Q8[q4] = *(const u32x4*)((const unsigned char*)qlat + (size_t)tok * 4096 + hd * 256 + 64 * q4 + 16 * kq);
        { const f16x8 q0 = *(const f16x8*)(qr + (size_t)tok * 256 + hd * 32 + 8 * kq);
#pragma unroll
          for (int i = 0; i < 8; ++i) Qr[i] = q0[i] * (h16)64.f; }
        const i32x8 Qa = __builtin_shufflevector(__builtin_bit_cast(i32x4, Q8[0]), __builtin_bit_cast(i32x4, Q8[1]), 0, 1, 2, 3, 4, 5, 6, 7), Qb = __builtin_shufflevector(__builtin_bit_cast(i32x4, Q8[2]), __builtin_bit_cast(i32x4, Q8[3]), 0, 1, 2, 3, 4, 5, 6, 7);
        u32x4 KrA[2][4], KrB[2][4]; u32x2 RrA[2], RrB[2];
#define SW_LOADK(KR, RR, CH) do { const int r0_ = b * SEQ + (int)sp[32 * (CH)], r1_ = b * SEQ + (int)sp[32 * (CH) + 16]; \
        const unsigned char* p0_ = ckv8 + (size_t)r0_ * 256 + 16 * kq; const unsigned char* p1_ = ckv8 + (size_t)r1_ * 256 + 16 * kq; const unsigned char* p2_ = kr8 + (size_t)r0_ * 32 + 8 * kq; const unsigned char* p3_ = kr8 + (size_t)r1_ * 32 + 8 * kq; \
        asm volatile("global_load_dwordx4 %0, %8, off\n\tglobal_load_dwordx4 %1, %8, off offset:64\n\tglobal_load_dwordx4 %2, %8, off offset:128\n\tglobal_load_dwordx4 %3, %8, off offset:192\n\t" \
                     "global_load_dwordx4 %4, %9, off\n\tglobal_load_dwordx4 %5, %9, off offset:64\n\tglobal_load_dwordx4 %6, %9, off offset:128\n\tglobal_load_dwordx4 %7, %9, off offset:192" \
                     : "=&v"(KR[0][0]), "=&v"(KR[0][1]), "=&v"(KR[0][2]), "=&v"(KR[0][3]), "=&v"(KR[1][0]), "=&v"(KR[1][1]), "=&v"(KR[1][2]), "=&v"(KR[1][3]) : "v"(p0_), "v"(p1_) : "memory"); \
        asm volatile("global_load_dwordx2 %0, %2, off\n\tglobal_load_dwordx2 %1, %3, off" : "=&v"(RR[0]), "=&v"(RR[1]) : "v"(p2_), "v"(p3_) : "memory"); } while (0)
#define SW_WAITK(KR, RR, N) asm volatile("s_waitcnt vmcnt(" #N ")" : "+v"(KR[0][0]), "+v"(KR[0][1]), "+v"(KR[0][2]), "+v"(KR[0][3]), "+v"(KR[1][0]), "+v"(KR[1][1]), "+v"(KR[1][2]), "+v"(KR[1][3]), "+v"(RR[0]), "+v"(RR[1]) :: "memory")
        asm volatile("s_waitcnt vmcnt(0)" ::: "memory");
        SW_LOADK(KrA, RrA, 0);
        SW_LOADK(KrB, RrB, 1);
        float m = -INFINITY, l = 0.f;
        f32x4 O[16];
#pragma unroll
        for (int ft = 0; ft < 16; ++ft) O[ft] = (f32x4){0.f, 0.f, 0.f, 0.f};
#define SW_CHUNK(KR, RR, CH, NWAIT, LOADNEXT) do { \
            LAS unsigned char* Vb = V + ((CH) & 1) * 8192; \
            SW_WAITK(KR, RR, NWAIT); \
            _Pragma("unroll") for (int tl = 0; tl < 2; ++tl) _Pragma("unroll") for (int q4 = 0; q4 < 4; ++q4) *(LAS u32x4*)(Vb + (16 * tl + c) * 256 + (((4 * q4 + kq) ^ (c ^ (8 * tl))) << 4)) = KR[tl][q4]; \
            f32x4 S[2]; \
            _Pragma("unroll") for (int tl = 0; tl < 2; ++tl) { \
                const i32x8 Ka = __builtin_shufflevector(__builtin_bit_cast(i32x4, KR[tl][0]), __builtin_bit_cast(i32x4, KR[tl][1]), 0, 1, 2, 3, 4, 5, 6, 7), Kb = __builtin_shufflevector(__builtin_bit_cast(i32x4, KR[tl][2]), __builtin_bit_cast(i32x4, KR[tl][3]), 0, 1, 2, 3, 4, 5, 6, 7); \
                S[tl] = __builtin_amdgcn_mfma_scale_f32_16x16x128_f8f6f4(Ka, Qa, (f32x4){0.f, 0.f, 0.f, 0.f}, 0, 0, 0, 0, 0, 0); \
                S[tl] = __builtin_amdgcn_mfma_scale_f32_16x16x128_f8f6f4(Kb, Qb, S[tl], 0, 0, 0, 0, 0, 0); \
                S[tl] = __builtin_amdgcn_mfma_f32_16x16x32_f16(fp8x8_to_f16(RR[tl].x, RR[tl].y), Qr, S[tl], 0, 0, 0); } \
            asm volatile("" : "+v"(S[0]), "+v"(S[1]));                        \
            asm volatile("s_waitcnt lgkmcnt(0)" ::: "memory");               \
            if (LOADNEXT) SW_LOADK(KR, RR, (CH) + 2); \
            float cm = -INFINITY; \
            _Pragma("unroll") for (int tl = 0; tl < 2; ++tl) _Pragma("unroll") for (int e = 0; e < 4; ++e) { S[tl][e] = (32 * (CH) + 16 * tl + 4 * kq + e >= cnt) ? -INFINITY : S[tl][e] * (1.f / 64.f); cm = fmaxf(cm, S[tl][e]); } \
            cm = max_x16(cm); cm = max_x32(cm); \
              \
            if (__any(cm > m + 4.0f)) { const float mn = fmaxf(m, cm), alpha = __builtin_amdgcn_exp2f(m - mn); m = mn; l *= alpha; \
                _Pragma("unroll") for (int ft = 0; ft < 16; ++ft) O[ft] = O[ft] * alpha; } \
            float pe[2][4]; float ps = 0.f; \
            _Pragma("unroll") for (int tl = 0; tl < 2; ++tl) _Pragma("unroll") for (int e = 0; e < 4; ++e) { pe[tl][e] = __builtin_amdgcn_exp2f(S[tl][e] - m); ps += pe[tl][e]; } \
            l += ps; \
            u32x2 pk; pk.x = pk_f8x4(pe[0][0] * 16.f, pe[0][1] * 16.f, pe[0][2] * 16.f, pe[0][3] * 16.f); pk.y = pk_f8x4(pe[1][0] * 16.f, pe[1][1] * 16.f, pe[1][2] * 16.f, pe[1][3] * 16.f); \
            const long Pf = __builtin_bit_cast(long, pk); \
            _Pragma("unroll") for (int ft = 0; ft < 16; ++ft) { \
                const i32x2_t av = __builtin_amdgcn_ds_read_tr8_b64_v2i32((LAS i32x2_t*)(Vb + tr0 + ((ft ^ x0) << 4))); \
                O[ft] = __builtin_amdgcn_mfma_f32_16x16x32_fp8_fp8(__builtin_bit_cast(long, av), Pf, O[ft], 0, 0, 0); } } while (0)
        for (int ch = 0; ch < 6; ch += 2) {
            SW_CHUNK(KrA, RrA, ch, 10, true);
            SW_CHUNK(KrB, RrB, ch + 1, 10, true);
        }
        SW_CHUNK(KrA, RrA, 6, 10, false);
        SW_CHUNK(KrB, RrB, 7, 0, false);
#undef SW_CHUNK
#undef SW_WAITK
        asm volatile("s_waitcnt lgkmcnt(0)" ::: "memory");
        l = sum_x16(l); l = sum_x32(l);
        if (c < 8) { const float il = __builtin_amdgcn_rcpf(l) * (1.f / 16.f);
#pragma unroll
            for (int ft = 0; ft < 16; ++ft) { const f32x4 o = O[ft] * il; u32x2 pk; pk.x = pk_h2(o.x, o.y); pk.y = pk_h2(o.z, o.w);
                *(LAS u32x2*)(V + c * 512 + ((4 * (ft ^ c) + kq) << 3)) = pk; } }
        asm volatile("s_waitcnt lgkmcnt(0)" ::: "memory");
        { u32x4 ov[4];
#pragma unroll
          for (int r_ = 0; r_ < 4; ++r_) { const int P = r_ * 64 + ll, h = P >> 5, p = P & 31; ov[r_] = *(const LAS u32x4*)(V + h * 512 + ((p ^ (2 * h)) << 4)); }
#pragma unroll
          for (int r_ = 0; r_ < 4; ++r_) *(u32x4*)(qlat + (size_t)tok * 2048 + (r_ * 64 + ll) * 8) = ov[r_]; }
        asm volatile("s_waitcnt lgkmcnt(0)" ::: "memory");
#undef SW_LOADK
    }
}


__device__ __forceinline__ void precomb_tiles(const Frame& F, const Args& args, unsigned char* ws, int t_lo, int t_hi, int wg, int nwg) {
    LAS float* As = (LAS float*)(F.lds); LAS float* Bs = (LAS float*)(F.lds + 64 * 65 * 4);
    for (int tl = t_lo + wg; tl < t_hi; tl += nwg) {
        __syncthreads();
        const bool ql = tl < 192; int hd, rb, xb;
        if (ql) { hd = tl / 24; rb = (tl % 24) / 6; xb = tl % 6; } else { const int t2 = tl - 192; hd = t2 / 64; rb = (t2 % 64) / 16; xb = t2 % 16; }
#pragma unroll
        for (int k = 0; k < 2; ++k) { const int i4 = F.tid + NTHR * k, row = i4 >> 4, c4 = (i4 & 15) * 4;
            if (ql) { const f32x4 a = *(const f32x4*)(args.in[15] + (size_t)(rb * 64 + row) * 512 + hd * 64 + c4), bq = *(const f32x4*)(args.in[14] + (size_t)(xb * 64 + row) * 768 + hd * 96 + c4);
#pragma unroll
                for (int e = 0; e < 4; ++e) { As[row * 65 + c4 + e] = a[e]; Bs[row * 65 + c4 + e] = bq[e]; } }
            else { const f32x4 a = *(const f32x4*)(args.in[18] + (size_t)(hd * 64 + row) * DM + xb * 64 + c4), bq = *(const f32x4*)(args.in[16] + (size_t)(rb * 64 + row) * 512 + hd * 64 + c4);
#pragma unroll
                for (int e = 0; e < 4; ++e) { As[(c4 + e) * 65 + row] = a[e]; Bs[row * 65 + c4 + e] = bq[e]; } } }
        __syncthreads();
        const int j = F.tid & 63, ig = F.wave;
        float acc8[8];
#pragma unroll
        for (int ii = 0; ii < 8; ++ii) acc8[ii] = 0.f;
#pragma unroll 4
        for (int v = 0; v < 64; ++v) { const float bv = Bs[j * 65 + v];
#pragma unroll
            for (int ii = 0; ii < 8; ++ii) acc8[ii] += As[(ig * 8 + ii) * 65 + v] * bv; }
        if (ql) { const float gj = args.in[12][xb * 64 + j]; h16* o = (h16*)(ws + OW_4);
#pragma unroll
            for (int ii = 0; ii < 8; ++ii) o[(size_t)(hd * 256 + rb * 64 + ig * 8 + ii) * QL + xb * 64 + j] = (h16)(acc8[ii] * gj); }
        else { h16* o = (h16*)(ws + OW_OV);
#pragma unroll
            for (int ii = 0; ii < 8; ++ii) o[(size_t)(xb * 64 + ig * 8 + ii) * 2048 + hd * 256 + rb * 64 + j] = (h16)acc8[ii]; }
    }
    __syncthreads();
}


__device__ __forceinline__ void ph_topk_sparse(const Frame& F, const h16* qi, const h16* ki, const float* wi, h16* qlat, const h16* qr, const unsigned char* ckv8, const unsigned char* kr8, unsigned char* ws, unsigned char* dout) {
    LAS unsigned* hist = (LAS unsigned*)(F.lds + F.wave * 16384);
    LAS unsigned short* selL = (LAS unsigned short*)(F.lds + SELL_OFF + F.wave * 2048);
    unsigned* sscr = (unsigned*)(F.gw < 1024 ? ws + OFF_H + (size_t)F.gw * 32768 : (F.gw < 1760 ? ws + OFF_F + 41 * MiB + (size_t)(F.gw - 1024) * 32768 : dout + 48 * MiB + (size_t)(F.gw - 1760) * 32768));
    for (int p = F.gw; p < 2048; p += F.NGW) {
        int b, ga, gb;
        if (p < 4 * 448) { b = p & 3; const int pj = p >> 2; ga = 64 + pj; gb = 959 - pj; }
        else { const int q_ = p - 4 * 448; b = q_ & 3; ga = 960 + (q_ >> 2); gb = q_ >> 2; }
        tk_group(F, qi, ki, wi, selL, b, 4 * ga, hist, sscr);
        asm volatile("s_waitcnt lgkmcnt(0)" ::: "memory");
        ph_sparse_wave<true>(F, qlat, qr, ckv8, kr8, selL, b * SEQ + 4 * ga);
        asm volatile("s_waitcnt lgkmcnt(0)" ::: "memory");
        if (gb >= 64) tk_group(F, qi, ki, wi, selL, b, 4 * gb, hist, sscr);
        else { int l0 = F.lane; asm volatile("" : "+v"(l0));
            for (int i = l0; i < 4 * TOPK; i += 64) { const int q = i >> 8, k = i & 255; selL[i] = (unsigned short)(k <= 4 * gb + q ? k : 0); } }
        asm volatile("s_waitcnt lgkmcnt(0)" ::: "memory");
        ph_sparse_wave<true>(F, qlat, qr, ckv8, kr8, selL, b * SEQ + 4 * gb);
        asm volatile("s_waitcnt lgkmcnt(0)" ::: "memory");
    }
}

__global__ void __launch_bounds__(NTHR, 2) mega_fwd(Args args) {
    extern __shared__ __attribute__((aligned(16))) unsigned char lds_raw[];
    Frame F; F.lds = (LAS unsigned char*)lds_raw; F.tid = threadIdx.x; F.lane = F.tid & 63; F.wave = __builtin_amdgcn_readfirstlane(F.tid >> 6);
    F.G = gridDim.x; F.gw = blockIdx.x * NWAVES + F.wave; F.NGW = F.G * NWAVES;
    volatile LAS unsigned* MISC = (volatile LAS unsigned*)(F.lds + MISC_OFF);
    unsigned char* ws = args.ws;
    for (int u = F.tid; u < (LDS_BYTES - LDSCTL_OFF) / 4; u += NTHR) ((LAS unsigned*)(F.lds + LDSCTL_OFF))[u] = 0u;
    __syncthreads();
    XcdBarrier bar = xcd_barrier_post((unsigned*)(ws + OFF_CTL) + CW_BAR, MISC + 8, F.wave);
    const int lo = args.ph_lo, hi = args.ph_hi;
#define IN(k) (lo <= (k) && (k) < hi)
#define SEAM(k) do { if (IN(k) && IN((k) + 1)) xcd_barrier(bar); F.lane = flane(); F.tid = F.wave * 64 + F.lane; } while (0)
    float* mod = (float*)(ws + OFF_MOD); float2* tab = (float2*)(ws + OFF_ROPE);
    h16* Hb = (h16*)(ws + OFF_H); h16* Ab = (h16*)(ws + OFF_A); float* Fb = (float*)(ws + OFF_F);

    if (IN(0)) {
        LAS float* scr = (LAS float*)(F.lds + F.wave * 16384);
        for (int ch = blockIdx.x; ch < (NMOD * DM) / 36; ch += F.G) {
            LAS float* sl = (LAS float*)(F.lds);
            LAS f32x4* part = (LAS f32x4*)(F.lds + 16384);
            __syncthreads();
            for (int i = F.tid; i < 4 * DM; i += NTHR) sl[i] = silu_f(args.in[1][i]);
            __syncthreads();
            const int r7 = F.lane / 9, c4 = F.lane - 9 * r7; const bool act = F.lane < 63;
            const float* wm = args.in[3] + (size_t)(F.wave * 128 + r7) * (NMOD * DM) + ch * 36 + 4 * c4;
            f32x4 wv[19];
#pragma unroll
            for (int i = 0; i < 19; ++i) { const bool ok = act && (7 * i + r7 < 128); wv[i] = *(const f32x4*)(wm + (size_t)(ok ? 7 * i : 0) * (NMOD * DM)); }
            f32x4 a0 = {0.f, 0.f, 0.f, 0.f}, a1 = a0, a2 = a0, a3 = a0;
#pragma unroll
            for (int i = 0; i < 19; ++i) { const bool ok = act && (7 * i + r7 < 128); const int kk = F.wave * 128 + (ok ? 7 * i + r7 : 0); const f32x4 w = ok ? wv[i] : (f32x4){0.f, 0.f, 0.f, 0.f};
                a0 += w * sl[kk]; a1 += w * sl[DM + kk]; a2 += w * sl[2 * DM + kk]; a3 += w * sl[3 * DM + kk]; }
            if (act) { LAS f32x4* pp = part + ((F.wave * 7 + r7) * 4) * 9 + c4; pp[0] = a0; pp[9] = a1; pp[18] = a2; pp[27] = a3; }
            __syncthreads();
            if (F.tid < 144) { const int b = F.tid / 36, l = F.tid - 36 * b; float sm = args.in[4][ch * 36 + l]; const LAS float* pf = (const LAS float*)part + (b * 9) * 4 + l;
#pragma unroll 8
                for (int w = 0; w < 56; ++w) sm += pf[w * 144];
                mod[b * (NMOD * DM) + ch * 36 + l] = sm; }
            __syncthreads();
        }
        for (int idx = blockIdx.x * NTHR + F.tid; idx < MT * 48; idx += F.G * NTHR) { const int tok = idx / 48, i = idx % 48;
            const float inv = (i < 32) ? powf(10000.f, -(float)i / 32.f) : powf(10000.f, -(float)(i - 32) / 16.f);
            const float ang = (float)((const int*)args.in[2])[tok] * inv; float sn, cs; sincosf(ang, &sn, &cs); tab[idx] = make_float2(cs, sn); }
        tr_job_mapped(F, args, 0, 2 * FF, 0, DM, ws + OW_GU1, nullptr, scr, 0);
        if (F.G != 256) {
            tr_job_plain(F, args.in[8], DM, DM, FF, ws + OW_D1, scr, 768);
            tr_job_mapped(F, args, 2, NIN3, 0, DM, (h16*)(ws + OW_IN), nullptr, scr, 128);
            tr_job_plain(F, args.in[11] + C_GATE, DIN, 2048, DM, ws + OW_GATE, scr, 1664);
            tr_job_mapped(F, args, 3, 512, 2048, QL, (h16*)(ws + OW_4), args.in[12], scr, 640);
            tr_job_plain(F, args.in[19], DM, DM, 256, (h16*)(ws + OW_UPB), scr, 736);
            tr_job_plain(F, args.in[20], DM, DM, DM, (h16*)(ws + OW_O), scr, 864);
            tr_job_mapped(F, args, 1, 2 * FF, 0, DM, ws + OW_GU2, nullptr, scr, 1376);
            tr_job_plain(F, args.in[25], DM, DM, FF, ws + OW_D2, scr, 96);
            precomb_tiles(F, args, ws, 0, 192, (int)blockIdx.x, F.G);
            tr_job_plain(F, args.in[18], DM, DM, 512, (h16*)(ws + OW_UPA), scr, 256);
        }
    }
    SEAM(0);
    if (IN(1)) ph_normmod(F, args.in[0], args.in[5], mod, 1, 0, ws + OFF_H);
    SEAM(1);
    if (IN(2)) { pg8::Gemm g{Hb, (const h16*)(ws + OW_GU1), MT, 2 * FF, DM / 2}; pg8::StaticOrder S; S.init(MT, 2 * FF, F.G, (int)blockIdx.x); pg8::EpiSwiGLU_T<true> E{Ab};
        pg8::gemm_phase<pg8::EpiSwiGLU_T<true>, true, true>(F.lds, g, S, E, F.wave);
        if (F.G == 256 && blockIdx.x >= 128) {
            Frame F2 = F; F2.gw = ((int)blockIdx.x - 128) * NWAVES + F.wave; F2.NGW = 128 * NWAVES; LAS float* scr = (LAS float*)(F.lds + F.wave * 16384);
            tr_job_plain(F2, args.in[8], DM, DM, FF, ws + OW_D1, scr, 0);
            tr_job_mapped(F2, args, 2, NIN3, 0, DM, (h16*)(ws + OW_IN), nullptr, scr, 384);
            tr_job_mapped(F2, args, 3, 512, 2048, QL, (h16*)(ws + OW_4), args.in[12], scr, 896);
            precomb_tiles(F, args, ws, 0, 192, (int)blockIdx.x - 128, 128);
            for (int i = ((int)blockIdx.x - 128) * NTHR + F.tid; i < (int)(MiB / 16); i += 128 * NTHR) ((u32x4*)(ws + OW_BD))[i] = (u32x4){0u, 0u, 0u, 0u}; } }
    SEAM(2);
    if (IN(3)) { pg8::Gemm g{Ab, (const h16*)(ws + OW_D1), MT, DM, FF / 2}; pg8::StaticOrder S; S.init(MT, DM, F.G, (int)blockIdx.x); pg8::EpiH16_T<true> E{(h16*)Fb};
        pg8::gemm_phase<pg8::EpiH16_T<true>, false, true>(F.lds, g, S, E, F.wave); }
    SEAM(3);
    if (IN(4)) ph_resnorm<false, true>(F, args.in[0], (const h16*)Fb, args.in[9], mod, 2, 0.5f, args.out, true, args.in[10], 4, 3, Hb, (unsigned char*)args.out + 32 * MiB);
    SEAM(4);
    if (IN(5)) { pg8::Gemm g{Hb, (const h16*)(ws + OW_IN), MT, NIN3, DM}; pg8::StaticOrder S; S.init(MT, NIN3, F.G, (int)blockIdx.x);
        pg8::EpiIn E{(h16*)(ws + OFF_CKV), (h16*)(ws + OFF_CQ), (h16*)(ws + OFF_KR), (h16*)(ws + OFF_KI), (h16*)(ws + OFF_QB), (h16*)(ws + OFF_KB), (h16*)(ws + OFF_VT), (float*)(ws + OFF_WI), (float*)(ws + OFF_SSQ),
                     args.in[13], tab, (LAS float*)(F.lds + XCH_OFF)};
        pg8::gemm_phase<pg8::EpiIn, true>(F.lds, g, S, E, F.wave); }
    SEAM(5);
    if (IN(6)) { for (int tk_ = blockIdx.x * NTHR + F.tid; tk_ < MT; tk_ += F.G * NTHR) { const f32x4 s0 = *(const f32x4*)((const float*)(ws + OFF_SSQ) + tk_ * 8), s1 = *(const f32x4*)((const float*)(ws + OFF_SSQ) + tk_ * 8 + 4);
            ((float*)(ws + OFF_RSTDQ))[tk_] = rsqrtf((((s0.x + s0.y) + (s0.z + s0.w)) + ((s1.x + s1.y) + (s1.z + s1.w))) * (1.f / QL) + EPS); } }
    if (IN(6)) ph_dilated_mfma(F, (const h16*)(ws + OFF_QB), (const h16*)(ws + OFF_KB), (const h16*)(ws + OFF_VT), (h16*)(ws + OFF_OG), (float*)(ws + OFF_LSE));
    SEAM(6);
    if (IN(7)) { pg8::Gemm g{(const h16*)(ws + OFF_CQ), (const h16*)(ws + OW_4), MT, N4, QL}; pg8::StaticOrder S; S.init(MT, N4, F.G, (int)blockIdx.x);
        pg8::Epi4 E{(h16*)(ws + OFF_QLAT), (h16*)(ws + OFF_QR), (h16*)(ws + OFF_QI), (const float*)(ws + OFF_RSTDQ), tab};
        pg8::gemm_phase<pg8::Epi4, true>(F.lds, g, S, E, F.wave);
        if (F.G == 256 && blockIdx.x >= 128) {
            Frame F2 = F; F2.gw = ((int)blockIdx.x - 128) * NWAVES + F.wave; F2.NGW = 128 * NWAVES; LAS float* scr = (LAS float*)(F.lds + F.wave * 16384);
            tr_job_plain(F2, args.in[11] + C_GATE, DIN, 2048, DM, ws + OW_GATE, scr, 0);
            tr_job_mapped(F2, args, 1, 2 * FF, 0, DM, ws + OW_GU2, nullptr, scr, 640);
            tr_job_plain(F2, args.in[19], DM, DM, 256, (h16*)(ws + OW_UPB), scr, 512);
            tr_job_plain(F2, args.in[20], DM, DM, DM, (h16*)(ws + OW_O), scr, 640);
            tr_job_plain(F2, args.in[18], DM, DM, 512, (h16*)(ws + OW_UPA), scr, 256);
            for (int it = F2.gw; it < 4 * 16; it += F2.NGW) { const int kb = it >> 4, nb = it & 15, n0 = nb * 32, hl = (n0 >> 6) & 3;
                tr_item(args.in[16], 512, n0 + (F.lane & 31), true, nullptr, kb * 64, (h16*)(ws + OW_BD) + (size_t)n0 * 1024 + 256 * hl, 1024, scr, F.lane); } } }
    SEAM(7);
    if (IN(8)) { ph_combine(F, (const h16*)(ws + OFF_OG), (const float*)(ws + OFF_LSE), (h16*)(ws + OFF_OB));
        ph_topk_sparse(F, (const h16*)(ws + OFF_QI), (const h16*)(ws + OFF_KI), (const float*)(ws + OFF_WI),
                       (h16*)(ws + OFF_QLAT), (const h16*)(ws + OFF_QR), (const unsigned char*)(ws + OFF_CKV), (const unsigned char*)(ws + OFF_KR), ws, (unsigned char*)args.out); }
    SEAM(8);
    if (IN(9) && F.G == 256) { const bool first = blockIdx.x < 128;
        pg8::Gemm g{first ? (const h16*)(ws + OFF_QLAT) : (const h16*)(ws + OFF_OB), first ? (const h16*)(ws + OW_BD) : (const h16*)(ws + OW_UPB), MT, first ? 512 : DM, first ? 1024 : 256, first ? 2048 : 0, first ? 1024 : 0};
        pg8::StaticOrder S; S.init(MT, first ? 512 : DM, 128, first ? (int)blockIdx.x : (int)blockIdx.x - 128);
        pg8::EpiH16 E{first ? (h16*)(ws + OFF_OA) : (h16*)(ws + OFF_Y2), first ? 512 : DM};
        pg8::gemm_phase<pg8::EpiH16, false>(F.lds, g, S, E, F.wave); }
    SEAM(9);
    if (IN(10)) { pg8::StaticOrder S; S.init(MT, DM, F.G, (int)blockIdx.x); h16* Y1 = (h16*)(ws + OFF_Y1); h16* Y2 = (h16*)(ws + OFF_Y2);
        { pg8::Gemm g{(const h16*)(ws + OFF_OA), (const h16*)(ws + OW_UPA), MT, DM, 512}; pg8::EpiH16 E{Y1}; pg8::gemm_phase<pg8::EpiH16, false>(F.lds, g, S, E, F.wave); }
        const h16* u8 = (const h16*)((const unsigned char*)args.out + 32 * MiB);
        { pg8::Gemm g{u8, (const h16*)(ws + OW_GATE), MT, 2 * DM, DM / 2}; pg8::EpiGate E{Y1, Y1, 0, -LOG2E * F8_INV, Y2}; pg8::PairOrder P{S};
          pg8::gemm_phase<pg8::EpiGate, false, true, pg8::PairOrder>(F.lds, g, P, E, F.wave); } }
    SEAM(10);
    if (IN(11)) { pg8::Gemm g{(const h16*)(ws + OFF_Y1), (const h16*)(ws + OW_O), MT, DM, DM}; pg8::StaticOrder S; S.init(MT, DM, F.G, (int)blockIdx.x); pg8::EpiH16 E{(h16*)(ws + OFF_YF)};
        pg8::gemm_phase<pg8::EpiH16, false>(F.lds, g, S, E, F.wave); }
    SEAM(11);
    if (IN(12)) ph_resnorm<true, true, unsigned char>(F, args.out, (const h16*)(ws + OFF_YF), args.in[21], mod, 5, 1.0f, ws + OFF_F, true, args.in[22], 7, 6, ws + OFF_H);
    SEAM(12);
    if (IN(13)) { pg8::Gemm g{Hb, (const h16*)(ws + OW_GU2), MT, 2 * FF, DM / 2}; pg8::StaticOrder S; S.init(MT, 2 * FF, F.G, (int)blockIdx.x); pg8::EpiSwiGLU_T<true> E{Ab};
        pg8::gemm_phase<pg8::EpiSwiGLU_T<true>, true, true>(F.lds, g, S, E, F.wave);
        if (F.G == 256 && blockIdx.x >= 128) { Frame F2 = F; F2.gw = ((int)blockIdx.x - 128) * NWAVES + F.wave; F2.NGW = 128 * NWAVES;
            tr_job_plain(F2, args.in[25], DM, DM, FF, ws + OW_D2, (LAS float*)(F.lds + F.wave * 16384), 0); } }
    SEAM(13);
    if (IN(14)) { pg8::Gemm g{Ab, (const h16*)(ws + OW_D2), MT, DM, FF / 2}; pg8::StaticOrder S; S.init(MT, DM, F.G, (int)blockIdx.x); pg8::EpiH16_T<true> E{(h16*)(ws + OFF_F + 32 * MiB)};
        pg8::gemm_phase<pg8::EpiH16_T<true>, false, true>(F.lds, g, S, E, F.wave); }
    SEAM(14);
    if (IN(15)) ph_resnorm<true, false>(F, ws + OFF_F, (const h16*)(ws + OFF_F + 32 * MiB), args.in[26], mod, 8, 0.5f, args.out, false, nullptr, 0, 0, (h16*)nullptr);
#undef IN
#undef SEAM
}


extern "C" void kernel_launch(void* const* d_in, const int* in_sizes, int n_in, void* d_out, int out_size, void* d_ws, size_t ws_size, hipStream_t stream) {
    if (n_in != 27 || ws_size < WS_END || out_size != MT * DM) { fprintf(stderr, "kernel_launch: unexpected shapes (n_in %d ws %zu out %d)\n", n_in, ws_size, out_size); return; }
    static int grid = 0;
    if (grid == 0) {
        int dev = 0, cus = 0, per_cu = 0;
        if (hipGetDevice(&dev) != hipSuccess || hipDeviceGetAttribute(&cus, hipDeviceAttributeMultiprocessorCount, dev) != hipSuccess) { grid = -1; return; }
        if (hipFuncSetAttribute((const void*)mega_fwd, hipFuncAttributeMaxDynamicSharedMemorySize, LDS_BYTES) != hipSuccess) { fprintf(stderr, "kernel_launch: hipFuncSetAttribute failed\n"); grid = -1; return; }
        if (hipOccupancyMaxActiveBlocksPerMultiprocessor(&per_cu, (const void*)mega_fwd, NTHR, LDS_BYTES) != hipSuccess || per_cu < 1) { fprintf(stderr, "kernel_launch: occupancy query says %d blocks/CU\n", per_cu); grid = -1; return; }
        grid = cus;
    }
    if (grid < 0) return;
    hipMemsetAsync((char*)d_ws + OFF_CTL, 0, 1 * MiB, stream);
    Args a{}; for (int i = 0; i < 27; ++i) a.in[i] = (const float*)d_in[i]; a.out = (float*)d_out; a.ws = (unsigned char*)d_ws; a.ph_lo = 0; a.ph_hi = 16;
    void* kargs[] = {&a};
#ifdef PH_DOUBLE
    a.ph_hi = PH_DOUBLE + 1; (void)hipLaunchCooperativeKernel((const void*)mega_fwd, dim3(grid), dim3(NTHR), kargs, LDS_BYTES, stream);
    hipMemsetAsync((char*)d_ws + OFF_CTL, 0, 1 * MiB, stream); a.ph_lo = PH_DOUBLE; a.ph_hi = 16;
#endif
    const hipError_t e = hipLaunchCooperativeKernel((const void*)mega_fwd, dim3(grid), dim3(NTHR), kargs, LDS_BYTES, stream);
    if (e != hipSuccess) fprintf(stderr, "kernel_launch: cooperative launch failed: %s (grid %d)\n", hipGetErrorString(e), grid);
    (void)in_sizes;
}
```

```cpp
#include <hip/hip_runtime.h>
#include <hip/hip_fp16.h>
#include <cstdio>
#include <cstdint>

constexpr int NB = 4, SEQ = 4096, DM = 1024, MT = NB * SEQ, FF = 2816;
constexpr int QL = 384, KVL = 256, DNOPE = 64, DROPE = 32, DVA = 64, HA = 8, HI = 8, DI = 32, TOPK = 256;
constexpr int NG = 3, HB = 4, DHB = 64, NMOD = 9, DIN = 5064;
constexpr int C_CQ = 0, C_CKV = 384, C_KR = 640, C_KI = 672, C_WI = 704, C_QKV = 712, C_GATE = 3016;
constexpr float EPS = 1e-6f, LOG2E = 1.4426950408889634f;
typedef _Float16 h16;

constexpr size_t MiB = 1u << 20;
constexpr size_t OFF_CTL = 0, OFF_MOD = 1 * MiB, OFF_ROPE = 2 * MiB, OFF_W = 8 * MiB, OFF_H = 60 * MiB, OFF_A = 92 * MiB, OFF_F = 180 * MiB, OFF_SP = 244 * MiB, WS_END = 256 * MiB;
constexpr size_t OFF_QB = OFF_A, OFF_KB = OFF_A + 24 * MiB, OFF_VT = OFF_A + 48 * MiB, OFF_CKV = OFF_A + 72 * MiB, OFF_KR = OFF_A + 80 * MiB, OFF_KI = OFF_A + 81 * MiB,
                 OFF_WI = OFF_A + 82 * MiB, OFF_SSQ = OFF_A + 82 * MiB + 512 * 1024, OFF_CQ = OFF_SP;
constexpr size_t OFF_RSTDQ = OFF_A + 83 * MiB;
constexpr size_t OFF_OG = OFF_F, OFF_LSE = OFF_F + 24 * MiB, OFF_QLAT = OFF_A, OFF_QR = OFF_A + 64 * MiB, OFF_QI = OFF_F + 25 * MiB, OFF_OB = OFF_SP;
constexpr size_t OFF_Y1 = OFF_F, OFF_Y2 = OFF_F + 32 * MiB, OFF_YF = OFF_A;

__device__ __forceinline__ float silu_f(float v) { return v / (1.f + __expf(-v)); }
__device__ __forceinline__ float sigm_f(float v) { return 1.f / (1.f + __expf(-v)); }
__host__ __device__ __forceinline__ int dil_of(int g) { return g == 0 ? 1 : (g == 1 ? 4 : 16); }
__device__ __forceinline__ unsigned fkey(float f) { const unsigned u = __float_as_uint(f); return (u & 0x80000000u) ? ~u : (u | 0x80000000u); }


#define LAS __attribute__((address_space(3)))
#define GAS __attribute__((address_space(1)))
typedef _Float16 f16x8 __attribute__((ext_vector_type(8)));
typedef float f32x4 __attribute__((ext_vector_type(4)));
typedef float f32x2 __attribute__((ext_vector_type(2)));
typedef unsigned u32x4 __attribute__((ext_vector_type(4)));
typedef unsigned u32x2 __attribute__((ext_vector_type(2)));
typedef _Float16 h16x2 __attribute__((ext_vector_type(2)));
__device__ __forceinline__ unsigned pk_h2(float lo, float hi) { f32x2 v = {lo, hi}; h16x2 h = __builtin_convertvector(v, h16x2); return __builtin_bit_cast(unsigned, h); }
__device__ __forceinline__ int flane() { int l; asm volatile("v_mbcnt_lo_u32_b32 %0, -1, 0\n\tv_mbcnt_hi_u32_b32 %0, -1, %0" : "=v"(l)); return l; }
typedef unsigned u32x2s __attribute__((ext_vector_type(2)));
__device__ __forceinline__ float sum_x16(float v) { const unsigned u = __float_as_uint(v); const u32x2s r = __builtin_amdgcn_permlane16_swap(u, u, false, false); return __uint_as_float(r.x) + __uint_as_float(r.y); }
__device__ __forceinline__ float sum_x32(float v) { const unsigned u = __float_as_uint(v); const u32x2s r = __builtin_amdgcn_permlane32_swap(u, u, false, false); return __uint_as_float(r.x) + __uint_as_float(r.y); }
__device__ __forceinline__ float max_x16(float v) { const unsigned u = __float_as_uint(v); const u32x2s r = __builtin_amdgcn_permlane16_swap(u, u, false, false); return fmaxf(__uint_as_float(r.x), __uint_as_float(r.y)); }
__device__ __forceinline__ float max_x32(float v) { const unsigned u = __float_as_uint(v); const u32x2s r = __builtin_amdgcn_permlane32_swap(u, u, false, false); return fmaxf(__uint_as_float(r.x), __uint_as_float(r.y)); }
template <int CTRL> __device__ __forceinline__ float dpp_f(float v) { return __int_as_float(__builtin_amdgcn_update_dpp(0, __float_as_int(v), CTRL, 0xF, 0xF, true)); }
__device__ __forceinline__ float sat8(float x) { return __builtin_amdgcn_fmed3f(x, -448.f, 448.f); }
__device__ __forceinline__ unsigned pk_f8x4(float a, float b, float c, float d) { int w = __builtin_amdgcn_cvt_pk_fp8_f32(sat8(a), sat8(b), 0, false); w = __builtin_amdgcn_cvt_pk_fp8_f32(sat8(c), sat8(d), w, true); return (unsigned)w; }
typedef int i32x4 __attribute__((ext_vector_type(4)));
typedef int i32x8 __attribute__((ext_vector_type(8)));
constexpr float F8_ACT = 8.f, F8_WGT = 512.f, F8_INV = 1.f / (F8_ACT * F8_WGT);

namespace pg8 {
constexpr int BM = 256, BK = 64, HALF = 128, HTB = HALF * BK * 2, STAGE_BYTES = 8 * HTB, NXCD = 8, WGM = 8;
__host__ __device__ __forceinline__ int lds_byte(int r, int c) { const int st = (r >> 4) * 2 + (c >> 5), rr = r & 15, cc = c & 31, ob = rr * 64 + cc * 2; return st * 1024 + (ob ^ (((ob >> 9) & 1) << 5)); }
__host__ __device__ __forceinline__ void stage_rc(int b, int& R, int& C) { const int st = b / 1024, sb = b % 1024, swz = sb ^ (((sb >> 9) & 1) << 5); R = (st >> 1) * 16 + swz / 64; C = (st & 1) * 32 + (swz % 64) / 2; }
__host__ __device__ __forceinline__ int perm32(int rho) { const int n = rho >> 4, i = rho & 15; return 8 * (i >> 2) + 4 * n + (i & 3); }
struct Unit { int pm, pn; };
struct Gemm { const h16* A; const h16* Bt; int M, N, K; int lda = 0, koffA = 0; };
struct StaticOrder {
    int nM, nN, nwg, G, c;
    __host__ __device__ void init(int M, int N, int G_, int c_) { nM = M / BM; nN = N / BM; nwg = nM * nN; G = G_; c = c_; }
    __host__ __device__ bool next(int i, Unit& u) const {
        const long L = (long)i * G + c; if (L >= nwg) return false;
        int wgid = (int)L; { const int q = nwg / NXCD, r = nwg % NXCD, xcd = wgid % NXCD, off = wgid / NXCD; wgid = (xcd < r ? xcd * (q + 1) : r * (q + 1) + (xcd - r) * q) + off; }
        const int nig = WGM * nN, gid = wgid / nig, fm = gid * WGM, gsz = (nM - fm) < WGM ? (nM - fm) : WGM;
        u.pm = fm + ((wgid % nig) % gsz); u.pn = (wgid % nig) / gsz; return true;
    }
};
struct PairOrder { StaticOrder S;
    __host__ __device__ bool next(int i, Unit& u) const { if (i >= 2 || !S.next(0, u)) return false; u.pn += 4 * i; return true; } };
template <class Epi, bool ALIGN_EPI, bool F8 = false, class Order = StaticOrder>
__device__ __forceinline__ void gemm_phase(LAS unsigned char* lds, const Gemm g, const Order& S, const Epi& E, const int wid) {
    const int lane = flane(), tid = wid * 64 + lane, wr = wid >> 2, wc = wid & 3, fr = lane & 15, fq = lane >> 4;
    const int K = g.K, lda = g.lda ? g.lda : g.K; int nt = K / BK;
    if constexpr (F8) asm volatile("" : "+s"(nt));
    unsigned voffA[2], voffB[2];
#pragma unroll
    for (int i = 0; i < 2; ++i) { int R, C; stage_rc(tid * 16 + i * 8192, R, C); const int Rb = Epi::PERM ? ((R & ~31) + perm32(R & 31)) : R;
        voffA[i] = (unsigned)(R * lda + C) * 2u; voffB[i] = (unsigned)(Rb * K + C) * 2u; }
    const size_t kstep = (size_t)(BK * 2);
    const size_t hstep = (size_t)HALF * K * 2, hstepA = (size_t)HALF * lda * 2;
    const size_t tstep = 2 * hstep, tstepA = 2 * hstepA, kofA = (size_t)g.koffA * 2;
    const unsigned ldsw = (unsigned)wid * 1024u;
    const int aoff = lds_byte(wr * 64 + fr, fq * 8), boff = lds_byte(wc * 32 + fr, fq * 8);
#define PG8_SA(b, h) (((b) * 2 + (h)) * HTB)
#define PG8_SB(b, h) ((4 + (b) * 2 + (h)) * HTB)
#define PG8_STAGE(bufoff, gbase, voff) do { _Pragma("unroll") for (int _i = 0; _i < 2; ++_i) { unsigned _vo = (voff)[_i]; asm volatile("" : "+v"(_vo)); \
        __builtin_amdgcn_global_load_lds((const unsigned*)((const char*)(gbase) + _vo), (LAS unsigned*)(lds + (bufoff) + ldsw + _i * 8192), 16, 0, 0); } } while (0)
#define PG8_LDA(dst, b, h) do { _Pragma("unroll") for (int m = 0; m < 4; ++m) _Pragma("unroll") for (int k = 0; k < 2; ++k) dst[m][k] = *(const LAS f16x8*)(lds + PG8_SA(b, h) + aoff + m * 2048 + k * 1024); } while (0)
#define PG8_LDB(dst, b, h) do { _Pragma("unroll") for (int n = 0; n < 2; ++n) _Pragma("unroll") for (int k = 0; k < 2; ++k) dst[n][k] = *(const LAS f16x8*)(lds + PG8_SB(b, h) + boff + n * 2048 + k * 1024); } while (0)
#define PG8_CAT8(x, y) __builtin_shufflevector(__builtin_bit_cast(i32x4, x), __builtin_bit_cast(i32x4, y), 0, 1, 2, 3, 4, 5, 6, 7)
#define PG8_MMA(ai, bj, At, Bt) do { __builtin_amdgcn_s_setprio(1); \
        if constexpr (F8) { _Pragma("unroll") for (int m = 0; m < 4; ++m) _Pragma("unroll") for (int n = 0; n < 2; ++n) \
            acc[ai][bj][m][n] = __builtin_amdgcn_mfma_scale_f32_16x16x128_f8f6f4(PG8_CAT8(Bt[n][0], Bt[n][1]), PG8_CAT8(At[m][0], At[m][1]), acc[ai][bj][m][n], 0, 0, 0, 0, 0, 0); } \
        else { _Pragma("unroll") for (int m = 0; m < 4; ++m) _Pragma("unroll") for (int n = 0; n < 2; ++n) _Pragma("unroll") for (int k = 0; k < 2; ++k) \
            acc[ai][bj][m][n] = __builtin_amdgcn_mfma_f32_16x16x32_f16(Bt[n][k], At[m][k], acc[ai][bj][m][n], 0, 0, 0); } \
        __builtin_amdgcn_s_setprio(0); } while (0)
#define PG8_WAIT_V(n) asm volatile("s_waitcnt vmcnt(" #n ")" ::: "memory")
#define PG8_WAIT_L(n) asm volatile("s_waitcnt lgkmcnt(" #n ")" ::: "memory")
#define PG8_BAR __builtin_amdgcn_s_barrier()
#define PG8_SCHED __builtin_amdgcn_sched_barrier(0)
    Unit cur, nxt; int ui = 0;
    if (!S.next(0, cur)) return;
    f32x4 acc[2][2][4][2];
#pragma unroll
    for (int a = 0; a < 2; ++a)
#pragma unroll
        for (int b = 0; b < 2; ++b)
#pragma unroll
            for (int m = 0; m < 4; ++m)
#pragma unroll
                for (int n = 0; n < 2; ++n) acc[a][b][m][n] = (f32x4){0.f, 0.f, 0.f, 0.f};
    f16x8 At[4][2], B0[2][2], B1[2][2];
    const char* cA = (const char*)g.A + (size_t)cur.pm * tstepA + (size_t)cur.pn * kofA; const char* cB = (const char*)g.Bt + (size_t)cur.pn * tstep;
    PG8_STAGE(PG8_SB(0, 0), cB, voffB); PG8_STAGE(PG8_SB(0, 1), cB + hstep, voffB); PG8_STAGE(PG8_SA(0, 0), cA, voffA); PG8_STAGE(PG8_SA(0, 1), cA + hstepA, voffA);
    if (wr == 1) PG8_BAR;
    PG8_WAIT_V(2); PG8_BAR;
    PG8_STAGE(PG8_SB(1, 0), cB + kstep, voffB); PG8_STAGE(PG8_SA(1, 0), cA + kstep, voffA); PG8_STAGE(PG8_SB(1, 1), cB + hstep + kstep, voffB);
    PG8_WAIT_V(6); PG8_BAR;
    for (;;) {
        const bool has_next = S.next(ui + 1, nxt);
        const char* nA = has_next ? (const char*)g.A + (size_t)nxt.pm * tstepA + (size_t)nxt.pn * kofA : cA; const char* nB = has_next ? (const char*)g.Bt + (size_t)nxt.pn * tstep : cB;
        for (int t = 0; t < nt; t += 2) {
            const bool last = (t == nt - 2);
            const char* a1 = cA + (size_t)(t + 1) * kstep;
            const char* a2 = last ? nA : cA + (size_t)(t + 2) * kstep; const char* b2 = last ? nB : cB + (size_t)(t + 2) * kstep;
            const char* a3 = a2 + kstep; const char* b3 = b2 + kstep;
            PG8_LDB(B0, 0, 0); PG8_LDB(B1, 0, 1); PG8_SCHED; PG8_LDA(At, 0, 0); PG8_STAGE(PG8_SA(1, 1), a1 + hstepA, voffA);
            PG8_WAIT_V(8); PG8_WAIT_L(0); PG8_BAR; PG8_MMA(0, 0, At, B0); PG8_MMA(0, 1, At, B1); PG8_BAR; PG8_SCHED;
            PG8_LDA(At, 0, 1); PG8_STAGE(PG8_SB(0, 0), b2, voffB); PG8_STAGE(PG8_SB(0, 1), b2 + hstep, voffB); PG8_STAGE(PG8_SA(0, 0), a2, voffA);
            PG8_WAIT_V(8); PG8_WAIT_L(0); PG8_BAR; PG8_MMA(1, 0, At, B0); PG8_MMA(1, 1, At, B1); PG8_BAR; PG8_SCHED;
            PG8_LDB(B0, 1, 0); PG8_LDB(B1, 1, 1); PG8_SCHED; PG8_LDA(At, 1, 0); PG8_STAGE(PG8_SA(0, 1), a2 + hstepA, voffA);
            PG8_WAIT_V(8); PG8_WAIT_L(0); PG8_BAR; PG8_MMA(0, 0, At, B0); PG8_MMA(0, 1, At, B1); PG8_BAR; PG8_SCHED;
            PG8_LDA(At, 1, 1); PG8_STAGE(PG8_SB(1, 0), b3, voffB); PG8_STAGE(PG8_SB(1, 1), b3 + hstep, voffB); PG8_STAGE(PG8_SA(1, 0), a3, voffA);
            PG8_WAIT_V(8); PG8_WAIT_L(0); PG8_BAR; PG8_MMA(1, 0, At, B0); PG8_MMA(1, 1, At, B1); PG8_BAR; PG8_SCHED;
        }
        if constexpr (ALIGN_EPI) { if (wr == 0) PG8_BAR; }
        { const int l2 = flane(); E(acc, cur, wr, wc, l2 & 15, l2 >> 4); }
        if (!has_next) break;
#pragma unroll
        for (int a = 0; a < 2; ++a)
#pragma unroll
            for (int b = 0; b < 2; ++b)
#pragma unroll
                for (int m = 0; m < 4; ++m)
#pragma unroll
                    for (int n = 0; n < 2; ++n) acc[a][b][m][n] = (f32x4){0.f, 0.f, 0.f, 0.f};
        cur = nxt; cA = nA; cB = nB; ++ui;
        if constexpr (ALIGN_EPI) { if (wr == 1) PG8_BAR; }
    }
    PG8_WAIT_V(0);
    if constexpr (!ALIGN_EPI) { if (wr == 0) PG8_BAR; }
    PG8_BAR;
#undef PG8_SA
#undef PG8_SB
#undef PG8_STAGE
#undef PG8_LDA
#undef PG8_LDB
#undef PG8_MMA
#undef PG8_CAT8
#undef PG8_WAIT_V
#undef PG8_WAIT_L
#undef PG8_BAR
#undef PG8_SCHED
}
template <bool F8, bool O8 = F8>
struct EpiSwiGLU_T {
    static constexpr bool PERM = true;
    void* O;
    __device__ __forceinline__ void operator()(const f32x4 (&acc)[2][2][4][2], const Unit& u, int wr, int wc, int fr, int fq) const {
        const int row0 = u.pm * BM + wr * 64 + fr, col0 = u.pn * HALF + wc * 32 + 8 * fq;
#pragma unroll
        for (int ai = 0; ai < 2; ++ai)
#pragma unroll
            for (int m = 0; m < 4; ++m) { const size_t eo = (size_t)(row0 + ai * HALF + m * 16) * FF + col0;
                float v[8];
#pragma unroll
                for (int n = 0; n < 2; ++n)
#pragma unroll
                    for (int e = 0; e < 4; ++e) { float gg = acc[ai][0][m][n][e], uu = acc[ai][1][m][n][e]; if constexpr (F8) { gg *= F8_INV; uu *= O8 ? F8_INV * F8_ACT : F8_INV; }
                        v[n * 4 + e] = gg * __builtin_amdgcn_rcpf(1.f + __builtin_amdgcn_exp2f(-gg * LOG2E)) * uu; }
                if constexpr (O8) { u32x2 w; w.x = pk_f8x4(v[0], v[1], v[2], v[3]); w.y = pk_f8x4(v[4], v[5], v[6], v[7]); *(u32x2*)((unsigned char*)O + eo) = w; }
                else { u32x4 w; w.x = pk_h2(v[0], v[1]); w.y = pk_h2(v[2], v[3]); w.z = pk_h2(v[4], v[5]); w.w = pk_h2(v[6], v[7]); *(u32x4*)((h16*)O + eo) = w; } }
    }
};
typedef EpiSwiGLU_T<false> EpiSwiGLU;

struct EpiIn {
    static constexpr bool PERM = false;
    h16 *ckv, *cq, *kr, *ki, *qb, *kb, *vT; float *wi, *ssq; const float* gckv; const float2* tab; LAS float* X;
    __device__ __forceinline__ void rope64(const f32x4 (&acc)[2][2][4][2], const Unit& u, int wr, int wc, int fr, int fq, h16* dst, int tl, float scale) const {
        const int tok0 = u.pm * BM + wr * 64 + fr;
        f32x4 tc[4], tn[4];
        { const f32x4* tp = (const f32x4*)(tab + (size_t)tok0 * 48 + 4 * fq); tc[0] = tp[0]; tc[1] = tp[1]; tc[2] = tp[8]; tc[3] = tp[9]; }
#pragma unroll
        for (int rr = 0; rr < 8; ++rr) { const int ai = rr >> 2, m = rr & 3, tok = tok0 + ai * HALF + m * 16;
            if (rr < 7) { const int tokn = tok0 + ((rr + 1) >> 2) * HALF + ((rr + 1) & 3) * 16; const f32x4* tp = (const f32x4*)(tab + (size_t)tokn * 48 + 4 * fq); tn[0] = tp[0]; tn[1] = tp[1]; tn[2] = tp[8]; tn[3] = tp[9]; }
#pragma unroll
            for (int n = 0; n < 2; ++n) { const int i = 16 * n + 4 * fq; const f32x4 t0 = tc[2 * n], t1 = tc[2 * n + 1];
                const f32x4 cs = {t0.x, t0.z, t1.x, t1.z}, sn = {t0.y, t0.w, t1.y, t1.w}, x1 = acc[ai][0][m][n], x2 = acc[ai][1][m][n];
                const f32x4 o1 = (x1 * cs - x2 * sn) * scale, o2 = (x2 * cs + x1 * sn) * scale;
                h16* p = dst + (size_t)tok * 768 + (4 * tl + wc) * 64 + i;
                u32x2 w1, w2; w1.x = pk_h2(o1.x, o1.y); w1.y = pk_h2(o1.z, o1.w); w2.x = pk_h2(o2.x, o2.y); w2.y = pk_h2(o2.z, o2.w);
                *(u32x2*)p = w1; *(u32x2*)(p + 32) = w2; }
#pragma unroll
            for (int k = 0; k < 4; ++k) tc[k] = tn[k];
            asm volatile("" ::: "memory"); }
    }
    __device__ __forceinline__ void operator()(const f32x4 (&acc)[2][2][4][2], const Unit& u, int wr, int wc, int fr, int fq) const {
        const int pn = u.pn;
        if (pn == 0) {
#pragma unroll
            for (int ai = 0; ai < 2; ++ai)
#pragma unroll
                for (int m = 0; m < 4; ++m) { float sq = 0.f;
#pragma unroll
                    for (int bj = 0; bj < 2; ++bj)
#pragma unroll
                        for (int n = 0; n < 2; ++n) { const f32x4 v = acc[ai][bj][m][n]; sq += (v.x * v.x + v.y * v.y) + (v.z * v.z + v.w * v.w); }
                    sq = sum_x16(sq); sq = sum_x32(sq);
                    if (fq == 0) X[(ai * HALF + wr * 64 + m * 16 + fr) * 4 + wc] = sq; }
            asm volatile("s_waitcnt lgkmcnt(0)" ::: "memory"); __builtin_amdgcn_s_barrier(); asm volatile("" ::: "memory");
#pragma unroll
            for (int ai = 0; ai < 2; ++ai)
#pragma unroll
                for (int m = 0; m < 4; ++m) { const int rl = ai * HALF + wr * 64 + m * 16 + fr, tok = u.pm * BM + rl; const f32x4 p = *(const LAS f32x4*)(X + rl * 4);
                    const float rstd = rsqrtf(((p.x + p.y) + (p.z + p.w)) * (1.f / KVL) + EPS);
#pragma unroll
                    for (int bj = 0; bj < 2; ++bj)
#pragma unroll
                        for (int n = 0; n < 2; ++n) { const int col = bj * HALF + wc * 32 + n * 16 + 4 * fq; const f32x4 o = acc[ai][bj][m][n] * rstd * *(const f32x4*)(gckv + col);
                            int w8 = __builtin_amdgcn_cvt_pk_fp8_f32(o.x, o.y, 0, false); w8 = __builtin_amdgcn_cvt_pk_fp8_f32(o.z, o.w, w8, true);
                            *(int*)((unsigned char*)ckv + (size_t)tok * KVL + col) = w8; }
                    asm volatile("" ::: "memory"); }
            asm volatile("s_waitcnt lgkmcnt(0)" ::: "memory"); __builtin_amdgcn_s_barrier(); asm volatile("" ::: "memory");
        } else if (pn <= 2) {
#pragma unroll
            for (int ai = 0; ai < 2; ++ai)
#pragma unroll
                for (int m = 0; m < 4; ++m) { const int tok = u.pm * BM + ai * HALF + wr * 64 + m * 16 + fr; float sq = 0.f;
#pragma unroll
                    for (int bj = 0; bj < 2; ++bj) { if (pn == 2 && bj == 1) break;
#pragma unroll
                        for (int n = 0; n < 2; ++n) { const f32x4 v = acc[ai][bj][m][n]; sq += (v.x * v.x + v.y * v.y) + (v.z * v.z + v.w * v.w);
                            const int col = (pn - 1) * 256 + bj * HALF + wc * 32 + n * 16 + 4 * fq; u32x2 w; w.x = pk_h2(v.x, v.y); w.y = pk_h2(v.z, v.w); *(u32x2*)(cq + (size_t)tok * QL + col) = w; } }
                    sq = sum_x16(sq); sq = sum_x32(sq);
                    if (fq == 0) ssq[tok * 8 + (pn - 1) * 4 + wc] = sq;
                    if (pn == 2) {
                        if (wc < 2) { const int i = 4 * fq; const f32x4* tp = (const f32x4*)(tab + (size_t)tok * 48 + 32 + i); const f32x4 t0 = tp[0], t1 = tp[1];
                            const f32x4 cs = {t0.x, t0.z, t1.x, t1.z}, sn = {t0.y, t0.w, t1.y, t1.w}, x1 = acc[ai][1][m][0], x2 = acc[ai][1][m][1];
                            const f32x4 o1 = x1 * cs - x2 * sn, o2 = x2 * cs + x1 * sn;
                            if (wc == 0) { unsigned char* p8 = (unsigned char*)kr + (size_t)tok * 32 + i;
                                int a8 = __builtin_amdgcn_cvt_pk_fp8_f32(o1.x, o1.y, 0, false); a8 = __builtin_amdgcn_cvt_pk_fp8_f32(o1.z, o1.w, a8, true);
                                int b8 = __builtin_amdgcn_cvt_pk_fp8_f32(o2.x, o2.y, 0, false); b8 = __builtin_amdgcn_cvt_pk_fp8_f32(o2.z, o2.w, b8, true);
                                *(int*)p8 = a8; *(int*)(p8 + 16) = b8; }
                            else { h16* p = ki + (size_t)(tok >> 5) * 1024 + (i >> 3) * 256 + (tok & 31) * 8 + (i & 7);
                                u32x2 w1, w2; w1.x = pk_h2(o1.x, o1.y); w1.y = pk_h2(o1.z, o1.w); w2.x = pk_h2(o2.x, o2.y); w2.y = pk_h2(o2.z, o2.w);
                                *(u32x2*)p = w1; *(u32x2*)(p + 512) = w2; } }
                        else if (wc == 2 && fq < 2) { *(f32x4*)(wi + tok * 8 + 4 * fq) = acc[ai][1][m][0] * 0.35355339059327373f; }
                    }
                    asm volatile("" ::: "memory"); }
        } else if (pn <= 5) rope64(acc, u, wr, wc, fr, fq, qb, pn - 3, 0.125f * LOG2E);
        else if (pn <= 8) rope64(acc, u, wr, wc, fr, fq, kb, pn - 6, 1.0f);
        else {
#pragma unroll
            for (int ai = 0; ai < 2; ++ai)
#pragma unroll
                for (int m = 0; m < 4; ++m) { const int tok = u.pm * BM + ai * HALF + wr * 64 + m * 16 + fr;
#pragma unroll
                    for (int bj = 0; bj < 2; ++bj)
#pragma unroll
                        for (int n = 0; n < 2; ++n) { const f32x4 v = acc[ai][bj][m][n]; u32x2 w; w.x = pk_h2(v.x, v.y); w.y = pk_h2(v.z, v.w);
                            *(u32x2*)(vT + (size_t)tok * 768 + (pn - 9) * 256 + bj * HALF + wc * 32 + n * 16 + 4 * fq) = w; }
                    asm volatile("" ::: "memory"); }
        }
    }
};
struct Epi4 {
    static constexpr bool PERM = true;
    h16 *qlat, *qr, *qi; const float* rstdq; const float2* tab;
    __device__ __forceinline__ void operator()(const f32x4 (&acc)[2][2][4][2], const Unit& u, int wr, int wc, int fr, int fq) const {
        const int pn = u.pn; const float c2 = 0.10206207261596575f * LOG2E;
        const int tok0 = u.pm * BM + wr * 64 + fr;
        float rc, rn = 0.f;
        if (pn < 8) {
            float rs[8];
#pragma unroll
            for (int rr = 0; rr < 8; ++rr) rs[rr] = rstdq[tok0 + (rr >> 2) * HALF + (rr & 3) * 16];
#pragma unroll
            for (int rr = 0; rr < 8; ++rr) { const int ai = rr >> 2, m = rr & 3, tok = tok0 + ai * HALF + m * 16; rc = rs[rr];
#pragma unroll
                for (int bj = 0; bj < 2; ++bj) { const f32x4 o0 = acc[ai][bj][m][0] * (rc * c2 * 64.f), o1 = acc[ai][bj][m][1] * (rc * c2 * 64.f);
                    u32x2 w; w.x = pk_f8x4(o0.x, o0.y, o0.z, o0.w); w.y = pk_f8x4(o1.x, o1.y, o1.z, o1.w);
                    *(u32x2*)((unsigned char*)qlat + (size_t)tok * 4096 + pn * 256 + bj * HALF + wc * 32 + 8 * fq) = w; }
                asm volatile("" ::: "memory"); }
        } else { rc = rstdq[tok0]; h16* dst = (pn == 8) ? qr : qi; const float c2e = (pn == 8) ? c2 : 1.f; const int i = 4 * fq;
            f32x4 tc[2], tn[2];
            { const f32x4* tp = (const f32x4*)(tab + (size_t)tok0 * 48 + 32 + i); tc[0] = tp[0]; tc[1] = tp[1]; }
#pragma unroll
            for (int rr = 0; rr < 8; ++rr) { const int ai = rr >> 2, m = rr & 3, tok = tok0 + ai * HALF + m * 16;
                if (rr < 7) { const int tokn = tok0 + ((rr + 1) >> 2) * HALF + ((rr + 1) & 3) * 16; const f32x4* tp = (const f32x4*)(tab + (size_t)tokn * 48 + 32 + i); tn[0] = tp[0]; tn[1] = tp[1]; rn = rstdq[tokn]; }
                const f32x4 cs = {tc[0].x, tc[0].z, tc[1].x, tc[1].z}, sn = {tc[0].y, tc[0].w, tc[1].y, tc[1].w}; const float sc = rc * c2e;
#pragma unroll
                for (int bj = 0; bj < 2; ++bj) { const f32x4 x1 = acc[ai][bj][m][0], x2 = acc[ai][bj][m][1]; const f32x4 o1 = (x1 * cs - x2 * sn) * sc, o2 = (x2 * cs + x1 * sn) * sc;
                    h16* p = dst + (size_t)tok * 256 + (4 * bj + wc) * 32 + i;
                    u32x2 w1, w2; w1.x = pk_h2(o1.x, o1.y); w1.y = pk_h2(o1.z, o1.w); w2.x = pk_h2(o2.x, o2.y); w2.y = pk_h2(o2.z, o2.w);
                    *(u32x2*)p = w1; *(u32x2*)(p + 16) = w2; }
                tc[0] = tn[0]; tc[1] = tn[1]; rc = rn;
                asm volatile("" ::: "memory"); } }
    }
};
__device__ __forceinline__ u32x4 ld16_l2(const h16* p) {
    const unsigned long long a = __hip_atomic_load((const unsigned long long*)p, __ATOMIC_RELAXED, __HIP_MEMORY_SCOPE_AGENT), b = __hip_atomic_load((const unsigned long long*)p + 1, __ATOMIC_RELAXED, __HIP_MEMORY_SCOPE_AGENT);
    return (u32x4){(unsigned)a, (unsigned)(a >> 32), (unsigned)b, (unsigned)(b >> 32)};
}
typedef _Float16 h16x8 __attribute__((ext_vector_type(8)));
__device__ __forceinline__ void unpk8(const u32x4 w, float (&f)[8]) {
    const h16x8 h = __builtin_bit_cast(h16x8, w);
#pragma unroll
    for (int i = 0; i < 8; ++i) f[i] = (float)h[i];
}
template <bool SC>
struct EpiH16_T {
    static constexpr bool PERM = true;
    h16* O; int ldc = DM;
    __device__ __forceinline__ void operator()(const f32x4 (&acc)[2][2][4][2], const Unit& u, int wr, int wc, int fr, int fq) const {
        const int row0 = u.pm * BM + wr * 64 + fr, col0 = u.pn * BM + wc * 32 + 8 * fq;
#pragma unroll
        for (int ai = 0; ai < 2; ++ai)
#pragma unroll
            for (int m = 0; m < 4; ++m)
#pragma unroll
                for (int bj = 0; bj < 2; ++bj) { f32x4 v0 = acc[ai][bj][m][0], v1 = acc[ai][bj][m][1]; if constexpr (SC) { v0 *= F8_INV; v1 *= F8_INV; }
                    u32x4 w; w.x = pk_h2(v0.x, v0.y); w.y = pk_h2(v0.z, v0.w); w.z = pk_h2(v1.x, v1.y); w.w = pk_h2(v1.z, v1.w);
                    *(u32x4*)(O + (size_t)(row0 + ai * HALF + m * 16) * ldc + col0 + bj * HALF) = w; }
    }
};
typedef EpiH16_T<false> EpiH16;
struct EpiGate {
    static constexpr bool PERM = true;
    const h16* Y; h16* Z; int accum; float nls; const h16* Yb = nullptr;
    __device__ __forceinline__ void operator()(const f32x4 (&acc)[2][2][4][2], const Unit& u, int wr, int wc, int fr, int fq) const {
        const int row0 = u.pm * BM + wr * 64 + fr, col0 = (u.pn & 3) * BM + wc * 32 + 8 * fq; const bool accum = Yb ? (u.pn >= 4) : (this->accum != 0); const h16* Y = (Yb && u.pn >= 4) ? Yb : this->Y;
#pragma unroll
        for (int ai = 0; ai < 2; ++ai)
#pragma unroll
            for (int m = 0; m < 4; ++m)
#pragma unroll
                for (int bj = 0; bj < 2; ++bj) { const size_t off = (size_t)(row0 + ai * HALF + m * 16) * DM + col0 + bj * HALF;
                    float y[8], zz[8]; unpk8(ld16_l2(Y + off), y);
                    if (accum) unpk8(ld16_l2(Z + off), zz); else {
#pragma unroll
                        for (int i = 0; i < 8; ++i) zz[i] = 0.f; }
                    float o[8];
#pragma unroll
                    for (int n = 0; n < 2; ++n)
#pragma unroll
                        for (int e = 0; e < 4; ++e) { const float gg = acc[ai][bj][m][n][e]; o[n * 4 + e] = zz[n * 4 + e] + y[n * 4 + e] * __builtin_amdgcn_rcpf(1.f + __builtin_amdgcn_exp2f(gg * nls)); }
                    u32x4 w; w.x = pk_h2(o[0], o[1]); w.y = pk_h2(o[2], o[3]); w.z = pk_h2(o[4], o[5]); w.w = pk_h2(o[6], o[7]);
                    *(u32x4*)(Z + off) = w; }
    }
};
}

#define XB_TMO      128
#define XB_XCNT(j)  (256  + 64 * (j))
#define XB_XSUB(j)  (1280 + 64 * (j))
#define XB_XGEN(j)  (2304 + 64 * (j))
#define XB_TOP      3328
#define XB_TOPGEN   3392
#define XCD_BAR_WORDS 3456
#define XB_SPIN_CAP (1u << 18)
__device__ __forceinline__ unsigned xb_ld(unsigned* p)              { return __hip_atomic_load(p, __ATOMIC_RELAXED, __HIP_MEMORY_SCOPE_AGENT); }
__device__ __forceinline__ unsigned xb_add(unsigned* p, unsigned v) { return __hip_atomic_fetch_add(p, v, __ATOMIC_RELAXED, __HIP_MEMORY_SCOPE_AGENT); }
__device__ __forceinline__ unsigned xb_xcc_id() { return (unsigned)__builtin_amdgcn_s_getreg((3 << 11) | 20) & 0xFu; }
#define XB_SPIN(cond, bar) do { unsigned _sp = 0; while (cond) { __builtin_amdgcn_s_sleep(1); \
    if ((++_sp & 255u) == 0u) { if (xb_ld(&(bar)[XB_TMO])) break; if (_sp > XB_SPIN_CAP) { atomicAdd(&(bar)[XB_TMO], 1u); break; } } } } while (0)
struct XcdBarrier { unsigned* bar; unsigned x; volatile LAS unsigned* st; int wave; };
__device__ __forceinline__ XcdBarrier xcd_barrier_post(unsigned* bar, volatile LAS unsigned* st, int wave) {
    XcdBarrier b; b.bar = bar; b.x = xb_xcc_id(); b.st = st; b.wave = wave;
    if (wave == 0 && flane() == 0) (void)xb_add(&bar[XB_XCNT(b.x)], 1u);
    return b;
}
__device__ __forceinline__ void xcd_barrier_complete(unsigned* bar, unsigned x, unsigned& nloc, unsigned& nx) {
    const unsigned G = gridDim.x * gridDim.y * gridDim.z;
    unsigned sum, cnt, mine, sp = 0u;
    for (;;) {
        sum = 0u; cnt = 0u; mine = 0u;
#pragma unroll
        for (unsigned j = 0; j < 16; ++j) { const unsigned c = xb_ld(&bar[XB_XCNT(j)]); sum += c; cnt += (c > 0u) ? 1u : 0u; mine = (j == x) ? c : mine; }
        if (sum == G) break;
        __builtin_amdgcn_s_sleep(1);
        if ((++sp & 255u) == 0u) { if (xb_ld(&bar[XB_TMO])) break; if (sp > XB_SPIN_CAP) { atomicAdd(&bar[XB_TMO], 1u); break; } }
    }
    nloc = mine > 0u ? mine : 1u; nx = cnt > 0u ? cnt : 1u;
}
__device__ __forceinline__ void xcd_barrier(const XcdBarrier& b) {
    asm volatile("s_waitcnt vmcnt(0)" ::: "memory");
    __syncthreads();
    if (b.wave == 0 && flane() == 0) {
        unsigned* bar = b.bar;
        __builtin_amdgcn_s_waitcnt(0);
        unsigned nloc = b.st[0], nx = b.st[1];
        if (nloc == 0u) { xcd_barrier_complete(bar, b.x, nloc, nx); b.st[0] = nloc; b.st[1] = nx; }
        const unsigned old = xb_add(&bar[XB_XSUB(b.x)], 1u);
        const unsigned gen = old / nloc;
        if (old + 1u == (gen + 1u) * nloc) {
            __builtin_amdgcn_fence(__ATOMIC_RELEASE, "agent");
            asm volatile("s_waitcnt vmcnt(0)" ::: "memory");
            asm volatile("buffer_inv sc1" ::: "memory");
            const unsigned og = xb_add(&bar[XB_TOP], 1u);
            const unsigned tg = og / nx;
            if (og + 1u != (tg + 1u) * nx) XB_SPIN(xb_ld(&bar[XB_TOP]) < (tg + 1u) * nx, bar);
            asm volatile("s_waitcnt vmcnt(0)" ::: "memory");
        } else {
            asm volatile("buffer_inv sc1" ::: "memory");
            XB_SPIN(xb_ld(&bar[XB_TOP]) < (gen + 1u) * nx, bar);
            asm volatile("s_waitcnt vmcnt(0)" ::: "memory");
        }
    }
    __syncthreads();
}

constexpr int NWAVES = 8, NTHR = 512;
constexpr int RING_BYTES = 131072, LDSCTL_OFF = RING_BYTES, MISC_OFF = LDSCTL_OFF + 320, LDS_BYTES = 157696;
constexpr int XCH_OFF = RING_BYTES + 1024;
constexpr int SELL_OFF = XCH_OFF;
constexpr int KRL_OFF = SELL_OFF + 8 * 2048;
static_assert(KRL_OFF + 8 * 1024 <= LDS_BYTES, "LDS layout");
constexpr int CW_BAR = 4096;
constexpr size_t OW_GU1 = OFF_W, OW_D1 = OW_GU1 + 11 * MiB, OW_IN = OW_D1 + (size_t)DM * FF * 2, OW_GATE = OW_IN + 6 * MiB, OW_4 = OW_GATE + 4 * MiB, OW_OV = OW_4 + 2 * MiB,
                 OW_UPB = OW_OV + 4 * MiB, OW_O = OW_UPB + MiB / 2, OW_GU2 = OW_O + 2 * MiB, OW_D2 = OW_GU2 + 11 * MiB, OW_END = OW_D2 + (size_t)DM * FF * 2;
static_assert(OW_END <= OFF_H, "weights region");
constexpr int NIN3 = 3072, N4 = 2560;
constexpr size_t OW_BD = OW_OV, OW_UPA = OW_OV + MiB, OFF_OA = OFF_A + 64 * MiB;

struct Args { const float* in[27]; float* out; unsigned char* ws; int ph_lo, ph_hi; };
struct Frame {
    LAS unsigned char* lds; int tid, lane, wave, G, gw, NGW;
};
__device__ __forceinline__ float wave_sum(float v) {
    v += dpp_f<0xB1>(v); v += dpp_f<0x4E>(v); v += dpp_f<0x141>(v); v += dpp_f<0x140>(v);
    v = sum_x16(v); v = sum_x32(v);
    return v;
}
__device__ __forceinline__ bool map_row(int job, int n, const Args& a, const float*& W, int& ldw, int& col) {
    if (job <= 1) { const int t = n >> 8, j = n & 255; W = a.in[(job == 0 ? 6 : 23) + (j >> 7)]; ldw = FF; col = t * 128 + (j & 127); return true; }
    if (job == 2) { W = a.in[11]; ldw = DIN; const int t = n >> 8, j = n & 255;
        if (t == 0) { col = C_CKV + j; return true; }
        if (t == 1) { col = j; return true; }
        if (t == 2) { if (j < 128) { col = 256 + j; return true; } if (j < 160) { col = C_KR + (j - 128); return true; } if (j < 192) { col = C_KI + (j - 160); return true; } if (j < 200) { col = C_WI + (j - 192); return true; } col = 0; return false; }
        if (t < 9) { const int c3 = (t - 3) / 3, tl = (t - 3) % 3, hl = (j & 127) >> 5, i = j & 31; col = C_QKV + c3 * 768 + (4 * tl + hl) * 64 + (j >> 7) * 32 + i; return true; }
        col = C_QKV + 1536 + (t - 9) * 256 + j; return true; }
    { const int n2 = n - 2048, r5 = n2 & 31, nat = 16 * ((r5 >> 2) & 1) + 4 * (r5 >> 3) + (r5 & 3);
      if (n2 < 256) { W = a.in[14]; ldw = 768; col = (n2 >> 5) * 96 + 64 + nat; } else { W = a.in[17]; ldw = 256; col = ((n2 - 256) & ~31) + nat; } return true; }
}
template <typename T>
__device__ __forceinline__ void tr_item(const float* W, int ldw, int col, bool valid, const float* scale, int k0, T* WTrow0, int K, LAS float* scr, int lane) {
    const int colc = valid ? col : 0; float vv[32];
#pragma unroll
    for (int i = 0; i < 32; ++i) vv[i] = W[(size_t)(k0 + 2 * i + (lane >> 5)) * ldw + colc];
    if (scale) {
#pragma unroll
        for (int i = 0; i < 32; ++i) vv[i] *= scale[k0 + 2 * i + (lane >> 5)]; }
#pragma unroll
    for (int i = 0; i < 32; ++i) scr[(2 * i + (lane >> 5)) * 33 + (lane & 31)] = valid ? vv[i] : 0.f;
    asm volatile("s_waitcnt lgkmcnt(0)" ::: "memory");
    const int c = lane & 7;
#pragma unroll
    for (int j = 0; j < 4; ++j) { const int n = (lane >> 3) + 8 * j; const LAS float* s = scr + (8 * c) * 33 + n;
        if constexpr (sizeof(T) == 1) { u32x2 o; o.x = pk_f8x4(s[0 * 33] * F8_WGT, s[1 * 33] * F8_WGT, s[2 * 33] * F8_WGT, s[3 * 33] * F8_WGT); o.y = pk_f8x4(s[4 * 33] * F8_WGT, s[5 * 33] * F8_WGT, s[6 * 33] * F8_WGT, s[7 * 33] * F8_WGT);
            *(u32x2*)(WTrow0 + (size_t)n * K + k0 + 8 * c) = o; }
        else { u32x4 o; o.x = pk_h2(s[0 * 33], s[1 * 33]); o.y = pk_h2(s[2 * 33], s[3 * 33]); o.z = pk_h2(s[4 * 33], s[5 * 33]); o.w = pk_h2(s[6 * 33], s[7 * 33]);
            *(u32x4*)(WTrow0 + (size_t)n * K + k0 + 8 * c) = o; } }
    asm volatile("s_waitcnt lgkmcnt(0)" ::: "memory");
}
template <typename T>
__device__ __forceinline__ void tr_job_mapped(const Frame& F, const Args& a, int job, int Ndest, int n_lo, int K, T* WT, const float* scale, LAS float* scr, int phase_off) {
    const int nblk = Ndest / 32, nitems = (K / 64) * nblk;
    for (int it = (F.gw + phase_off) % F.NGW; it < nitems; it += F.NGW) {
        const int kb = it / nblk, nb = it % nblk; const float* W; int ldw, col;
        const bool valid = map_row(job, n_lo + nb * 32 + (F.lane & 31), a, W, ldw, col);
        tr_item(W, ldw, col, valid, scale, kb * 64, WT + (size_t)(n_lo + nb * 32) * K, K, scr, F.lane);
    }
}
template <typename T>
__device__ __forceinline__ void tr_job_plain(const Frame& F, const float* W, int ldw, int Ndest, int K, T* WT, LAS float* scr, int phase_off) {
    const int nblk = Ndest / 32, nitems = (K / 64) * nblk;
    for (int it = (F.gw + phase_off) % F.NGW; it < nitems; it += F.NGW) {
        const int kb = it / nblk, nb = it % nblk;
        tr_item(W, ldw, nb * 32 + (F.lane & 31), true, nullptr, kb * 64, WT + (size_t)(nb * 32) * K, K, scr, F.lane);
    }
}
__device__ __forceinline__ void row_load(const float* p, int lane, f32x4 (&v)[4]) {
#pragma unroll
    for (int j = 0; j < 4; ++j) v[j] = __builtin_nontemporal_load((const f32x4*)p + lane + 64 * j);
}
__device__ __forceinline__ float row_ssq(const f32x4 (&v)[4]) { float s = 0.f;
#pragma unroll
    for (int j = 0; j < 4; ++j) s += (v[j].x * v[j].x + v[j].y * v[j].y) + (v[j].z * v[j].z + v[j].w * v[j].w);
    return wave_sum(s); }
template <typename T>
__device__ __forceinline__ void store_nm(const f32x4 (&xv)[4], float r2, const f32x4 (&gb)[4], const f32x4 (&gc)[4], T* dst, int lane, unsigned char* dst8) {
#pragma unroll
    for (int j = 0; j < 4; ++j) { const int ci = lane + 64 * j; const f32x4 o = xv[j] * r2 * gb[j] + gc[j];
        if constexpr (sizeof(T) == 1) __builtin_nontemporal_store(pk_f8x4(o.x * F8_ACT, o.y * F8_ACT, o.z * F8_ACT, o.w * F8_ACT), (unsigned*)dst + ci);
        else { u32x2 w; w.x = pk_h2(o.x, o.y); w.y = pk_h2(o.z, o.w); __builtin_nontemporal_store(w, (u32x2*)dst + ci); if (dst8) __builtin_nontemporal_store(pk_f8x4(o.x * F8_ACT, o.y * F8_ACT, o.z * F8_ACT, o.w * F8_ACT), (unsigned*)dst8 + ci); } }
}
template <typename T>
__device__ __forceinline__ void ph_normmod(const Frame& F, const float* x, const float* g, const float* mod, int isc, int ish, T* dst) {
    const int lane = flane();
    const int b = F.gw & 3, nsl = F.NGW >> 2; int r0 = F.gw >> 2; if (r0 >= SEQ) return;
    const float* mb = mod + b * (NMOD * DM); f32x4 gb[4], gc[4];
#pragma unroll
    for (int j = 0; j < 4; ++j) { const int ci = lane + 64 * j; gb[j] = ((const f32x4*)g)[ci] * (((const f32x4*)(mb + isc * DM))[ci] + 1.f); gc[j] = ((const f32x4*)(mb + ish * DM))[ci]; }
    const float* xb = x + (size_t)b * SEQ * DM; T* db = dst + (size_t)b * SEQ * DM;
    f32x4 v[2][4], vn[2][4];
#pragma unroll
    for (int k = 0; k < 2; ++k) { const int r = r0 + k * nsl; row_load(xb + (size_t)(r < SEQ ? r : r0) * DM, lane, v[k]); }
    for (;;) { const int rn = r0 + 2 * nsl; const bool has = rn < SEQ;
        if (has) {
#pragma unroll
            for (int k = 0; k < 2; ++k) { const int r = rn + k * nsl; row_load(xb + (size_t)(r < SEQ ? r : rn) * DM, lane, vn[k]); } }
#pragma unroll
        for (int k = 0; k < 2; ++k) { const int r = r0 + k * nsl; const float rstd = rsqrtf(row_ssq(v[k]) * (1.f / DM) + EPS);
            if (r < SEQ) store_nm(v[k], rstd, gb, gc, db + (size_t)r * DM, lane, nullptr); }
        if (!has) break;
#pragma unroll
        for (int k = 0; k < 2; ++k)
#pragma unroll
            for (int j = 0; j < 4; ++j) v[k][j] = vn[k][j];
        r0 = rn; }
}
__device__ __forceinline__ void row_load_h(const h16* p, int lane, u32x2 (&v)[4]) {
#pragma unroll
    for (int j = 0; j < 4; ++j) v[j] = __builtin_nontemporal_load((const u32x2*)p + lane + 64 * j);
}
typedef _Float16 h16x4 __attribute__((ext_vector_type(4)));
__device__ __forceinline__ f32x4 h4_to_f4(u32x2 w) { const h16x4 h = __builtin_bit_cast(h16x4, w); return (f32x4){(float)h[0], (float)h[1], (float)h[2], (float)h[3]}; }
template <bool XI16, bool XO16, typename T = h16>
__device__ __forceinline__ void ph_resnorm(const Frame& F, const void* xin_, const h16* f, const float* gpost, const float* mod, int igt, float coef, void* xout_,
                                           bool second, const float* gpre, int isc, int ish, T* dst, unsigned char* dst8 = nullptr) {
    const int lane = flane();
    const int b = F.gw & 3, nsl = F.NGW >> 2; int r0 = F.gw >> 2; if (r0 >= SEQ) return;
    const float* mb = mod + b * (NMOD * DM); f32x4 ga[4], gb[4], gc[4];
#pragma unroll
    for (int j = 0; j < 4; ++j) { const int ci = lane + 64 * j; ga[j] = ((const f32x4*)gpost)[ci] * ((const f32x4*)(mb + igt * DM))[ci] * coef;
        if (second) { gb[j] = ((const f32x4*)gpre)[ci] * (((const f32x4*)(mb + isc * DM))[ci] + 1.f); gc[j] = ((const f32x4*)(mb + ish * DM))[ci]; } else { gb[j] = (f32x4){0.f, 0.f, 0.f, 0.f}; gc[j] = gb[j]; } }
    const size_t bo = (size_t)b * SEQ * DM; const h16* fb = f + bo;
    u32x2 fh[2][4], fn[2][4]; f32x4 xi[2][4], xn[2][4]; u32x2 xh[2][4], xhn[2][4];
#pragma unroll
    for (int k = 0; k < 2; ++k) { const int r = r0 + k * nsl; const size_t ro = (size_t)(r < SEQ ? r : r0) * DM; row_load_h(fb + ro, lane, fh[k]);
        if constexpr (XI16) row_load_h((const h16*)xin_ + bo + ro, lane, xh[k]); else row_load((const float*)xin_ + bo + ro, lane, xi[k]); }
    for (;;) {
        const int rn = r0 + 2 * nsl; const bool has = rn < SEQ;
        if (has) {
#pragma unroll
            for (int k = 0; k < 2; ++k) { const int r = rn + k * nsl; const size_t ro = (size_t)(r < SEQ ? r : rn) * DM; row_load_h(fb + ro, lane, fn[k]);
                if constexpr (XI16) row_load_h((const h16*)xin_ + bo + ro, lane, xhn[k]); else row_load((const float*)xin_ + bo + ro, lane, xn[k]); } }
#pragma unroll
        for (int k = 0; k < 2; ++k) { const int r = r0 + k * nsl; const bool ok = r < SEQ; const size_t ro = bo + (size_t)r * DM;
            f32x4 v[4];
#pragma unroll
            for (int j = 0; j < 4; ++j) { v[j] = h4_to_f4(fh[k][j]); if constexpr (XI16) xi[k][j] = h4_to_f4(xh[k][j]); }
            const float rstd = rsqrtf(row_ssq(v) * (1.f / DM) + EPS);
#pragma unroll
            for (int j = 0; j < 4; ++j) { const int ci = lane + 64 * j;
                xi[k][j] = xi[k][j] + ga[j] * v[j] * rstd;
                if (ok) { if constexpr (XO16) { u32x2 w; w.x = pk_h2(xi[k][j].x, xi[k][j].y); w.y = pk_h2(xi[k][j].z, xi[k][j].w); __builtin_nontemporal_store(w, (u32x2*)((h16*)xout_ + ro) + ci); }
                          else __builtin_nontemporal_store(xi[k][j], (f32x4*)((float*)xout_ + ro) + ci); } }
            if (second) { const float r2 = rsqrtf(row_ssq(xi[k]) * (1.f / DM) + EPS); if (ok) store_nm(xi[k], r2, gb, gc, dst + ro, lane, dst8 ? dst8 + ro : nullptr); } }
        if (!has) break;
#pragma unroll
        for (int k = 0; k < 2; ++k)
#pragma unroll
            for (int j = 0; j < 4; ++j) { fh[k][j] = fn[k][j]; if constexpr (XI16) xh[k][j] = xhn[k][j]; else xi[k][j] = xn[k][j]; }
        r0 = rn;
    }
}

__device__ __forceinline__ void ph_combine(const Frame& F, const h16* og, const float* lse2, h16* ob) {
    const int stride = F.G * NTHR;
    for (int base = blockIdx.x * NTHR + F.tid; base < MT * 32; base += 4 * stride) {
        u32x4 a[4], b[4], d[4]; float l0[4], l1[4], l2[4];
#pragma unroll
        for (int k = 0; k < 4; ++k) { const int idx0 = base + k * stride, idx = idx0 < MT * 32 ? idx0 : base; const int tok = idx >> 5, c = (idx & 31) * 8, hh = c >> 6;
            l0[k] = lse2[tok * 12 + hh]; l1[k] = lse2[tok * 12 + 4 + hh]; l2[k] = lse2[tok * 12 + 8 + hh];
            a[k] = *(const u32x4*)(og + (size_t)tok * 768 + c); b[k] = *(const u32x4*)(og + (size_t)tok * 768 + 256 + c); d[k] = *(const u32x4*)(og + (size_t)tok * 768 + 512 + c); }
#pragma unroll
        for (int k = 0; k < 4; ++k) { const int idx = base + k * stride; if (idx >= MT * 32) break; const int tok = idx >> 5, c = (idx & 31) * 8;
            const float m = fmaxf(l0[k], fmaxf(l1[k], l2[k])); const float w0 = exp2f(l0[k] - m), w1 = exp2f(l1[k] - m), w2 = exp2f(l2[k] - m), inv = 1.f / (w0 + w1 + w2);
            const f16x8 ha = __builtin_bit_cast(f16x8, a[k]), hb = __builtin_bit_cast(f16x8, b[k]), hd = __builtin_bit_cast(f16x8, d[k]);
            float o[8];
#pragma unroll
            for (int i = 0; i < 8; ++i) o[i] = (w0 * (float)ha[i] + w1 * (float)hb[i] + w2 * (float)hd[i]) * inv;
            u32x4 w; w.x = pk_h2(o[0], o[1]); w.y = pk_h2(o[2], o[3]); w.z = pk_h2(o[4], o[5]); w.w = pk_h2(o[6], o[7]);
            *(u32x4*)(ob + (size_t)tok * 256 + c) = w; } }
}
typedef short v4i16_t __attribute__((ext_vector_type(4)));
typedef short s16x8 __attribute__((ext_vector_type(8)));
typedef float f32x16 __attribute__((ext_vector_type(16)));
__device__ __forceinline__ int tk_bin(float sc) { const unsigned u = __float_as_uint(sc); int e = (int)((u >> 16) & 0x7FFFu) - (122 << 7); e = e < 0 ? 0 : (e > 1023 ? 1023 : e); return (u >> 31) ? 1023 - e : 1024 + e; }
__device__ __forceinline__ void tk_scores(const f16x8 (&Af)[2], const float (&wv)[16], f16x8 b0, f16x8 b1, float& sa, float& sb) {
    f32x16 d = {0.f, 0.f, 0.f, 0.f, 0.f, 0.f, 0.f, 0.f, 0.f, 0.f, 0.f, 0.f, 0.f, 0.f, 0.f, 0.f};
    d = __builtin_amdgcn_mfma_f32_32x32x16_f16(Af[0], b0, d, 0, 0, 0); d = __builtin_amdgcn_mfma_f32_32x32x16_f16(Af[1], b1, d, 0, 0, 0);
    f32x2 acc = {0.f, 0.f};
#pragma unroll
    for (int e = 0; e < 16; e += 2) { const int i0 = __float_as_int(d[e]), i1 = __float_as_int(d[e + 1]);
        const f32x2 rl = {__int_as_float(i0 > 0 ? i0 : 0), __int_as_float(i1 > 0 ? i1 : 0)}; const f32x2 w2 = {wv[e], wv[e + 1]};
        acc = __builtin_elementwise_fma(w2, rl, acc); }
    sa = acc.x; sb = acc.y;
}
__device__ __forceinline__ void tk_tile1(const f16x8 (&Af)[2], const float (&wv)[16], f16x8 b0, f16x8 b1, int tile, int r, int hi, int ta, LAS unsigned* hist, unsigned* sscr) {
    float sa, sb; tk_scores(Af, wv, b0, b1, sa, sb);
    const h16x2 hp = {(h16)sa, (h16)sb}; sa = (float)hp[0]; sb = (float)hp[1]; sscr[tile * 64 + 2 * r + hi] = __builtin_bit_cast(unsigned, hp);
    const int s = 32 * tile + r;
    { const int bn = tk_bin(sa); __hip_atomic_fetch_add(hist + (2 * hi) * 1024 + (bn >> 1), (s <= ta ? 1u : 0u) << (16 * (bn & 1)), __ATOMIC_RELAXED, __HIP_MEMORY_SCOPE_WORKGROUP); }
    { const int bn = tk_bin(sb); __hip_atomic_fetch_add(hist + (2 * hi + 1) * 1024 + (bn >> 1), (s <= ta + 1 ? 1u : 0u) << (16 * (bn & 1)), __ATOMIC_RELAXED, __HIP_MEMORY_SCOPE_WORKGROUP); }
}
__device__ __forceinline__ void tk_pass1(const f16x8 (&Af)[2], const float (&wv)[16], const h16* kbase, int ntiles, int r, int hi, int ta, LAS unsigned* hist, unsigned* sscr) {
    f16x8 BA[4][2], BB[4][2];
#define TK_LOAD(dst, t0_) do { _Pragma("unroll") for (int i_ = 0; i_ < 4; ++i_) { const int tt_ = ((t0_) + i_) < 127 ? ((t0_) + i_) : 127; dst[i_][0] = *(const f16x8*)(kbase + (size_t)tt_ * 1024); dst[i_][1] = *(const f16x8*)(kbase + (size_t)tt_ * 1024 + 512); } } while (0)
    TK_LOAD(BA, 0);
    for (int t0 = 0; t0 < ntiles; t0 += 8) {
        TK_LOAD(BB, t0 + 4);
#pragma unroll
        for (int i = 0; i < 4; ++i) if (t0 + i < ntiles) tk_tile1(Af, wv, BA[i][0], BA[i][1], t0 + i, r, hi, ta, hist, sscr);
        TK_LOAD(BA, t0 + 8);
#pragma unroll
        for (int i = 0; i < 4; ++i) if (t0 + 4 + i < ntiles) tk_tile1(Af, wv, BB[i][0], BB[i][1], t0 + 4 + i, r, hi, ta, hist, sscr);
    }
#undef TK_LOAD
}
__device__ __forceinline__ void tk_group(const Frame& F, const h16* qi, const h16* ki, const float* wi, LAS unsigned short* sel, int b, int t0, LAS unsigned* hist, unsigned* sscr) {
    int lane_ = F.lane; asm volatile("" : "+v"(lane_)); const int lane = lane_, r = lane & 31, hi = lane >> 5, tok0 = b * SEQ + t0;
    const int qa = 2 * ((r >> 2) & 1) + (r & 1), ha = 4 * (r >> 4) + 2 * ((r >> 3) & 1) + ((r >> 1) & 1);
    f16x8 Af[2];
#pragma unroll
    for (int s_ = 0; s_ < 2; ++s_) Af[s_] = *(const f16x8*)(qi + (size_t)(tok0 + qa) * 256 + ha * 32 + 16 * s_ + 8 * hi);
    float wv[16];
    { const f32x4 a0 = *(const f32x4*)(wi + (tok0 + 2 * hi) * 8), a1 = *(const f32x4*)(wi + (tok0 + 2 * hi) * 8 + 4), b0 = *(const f32x4*)(wi + (tok0 + 2 * hi + 1) * 8), b1 = *(const f32x4*)(wi + (tok0 + 2 * hi + 1) * 8 + 4);
      const float sa[8] = {a0.x, a0.y, a0.z, a0.w, a1.x, a1.y, a1.z, a1.w}, sb[8] = {b0.x, b0.y, b0.z, b0.w, b1.x, b1.y, b1.z, b1.w};
#pragma unroll
      for (int h = 0; h < 8; ++h) { wv[2 * h] = sa[h] * 0.17677669529663687f; wv[2 * h + 1] = sb[h] * 0.17677669529663687f; } }
    const int ntiles = (t0 + 3) / 32 + 1, ta = t0 + 2 * hi;
    const h16* kbase = ki + (size_t)(b * SEQ) * 32 + hi * 256 + r * 8;
    int tbin[4] = {0, 0, 0, 0}, cs[4] = {0, 0, 0, 0}, cc[4] = {0, 0, 0, 0};
#pragma unroll
    for (int i = 0; i < 16; ++i) *(LAS u32x4*)((LAS unsigned char*)hist + i * 1024 + lane * 16) = (u32x4){0u, 0u, 0u, 0u};
    asm volatile("s_waitcnt lgkmcnt(0)" ::: "memory");
    tk_pass1(Af, wv, kbase, ntiles, r, hi, ta, hist, sscr);
    asm volatile("s_waitcnt lgkmcnt(0)" ::: "memory");
#pragma unroll
    for (int q = 0; q < 4; ++q) {
        const LAS unsigned* hq = hist + q * 1024;
        unsigned sum = 0;
#pragma unroll
        for (int i = 0; i < 4; ++i) { const u32x4 v = *(const LAS u32x4*)(hq + 16 * lane + 4 * i); sum += (v.x & 0xFFFFu) + (v.x >> 16) + (v.y & 0xFFFFu) + (v.y >> 16) + (v.z & 0xFFFFu) + (v.z >> 16) + (v.w & 0xFFFFu) + (v.w >> 16); }
#define TK_DPPU(x, ctrl) ((unsigned)__builtin_amdgcn_update_dpp(0, (int)(x), ctrl, 0xF, 0xF, true))
        unsigned rsum = sum; rsum += TK_DPPU(rsum, 0x101); rsum += TK_DPPU(rsum, 0x102); rsum += TK_DPPU(rsum, 0x104); rsum += TK_DPPU(rsum, 0x108);
        const unsigned T1 = (unsigned)__builtin_amdgcn_readlane((int)rsum, 16), T2 = (unsigned)__builtin_amdgcn_readlane((int)rsum, 32), T3 = (unsigned)__builtin_amdgcn_readlane((int)rsum, 48);
        const unsigned incl = rsum + (lane < 16 ? T1 + T2 + T3 : (lane < 32 ? T2 + T3 : (lane < 48 ? T3 : 0u)));
        const unsigned long long bal = __ballot(incl >= (unsigned)TOPK);
        const int L = 63 - __builtin_clzll(bal);
        unsigned cum = (unsigned)__builtin_amdgcn_readlane((int)incl, L) - (unsigned)__builtin_amdgcn_readlane((int)sum, L);
        const unsigned wv_ = hq[16 * L + 15 - (lane & 15)]; const unsigned chi_ = wv_ >> 16, clo_ = wv_ & 0xFFFFu, tw_ = chi_ + clo_;
        unsigned pf_ = tw_; pf_ += TK_DPPU(pf_, 0x111); pf_ += TK_DPPU(pf_, 0x112); pf_ += TK_DPPU(pf_, 0x114); pf_ += TK_DPPU(pf_, 0x118);
#undef TK_DPPU
        const unsigned hm_ = (unsigned)__ballot(cum + pf_ >= (unsigned)TOPK) & 0xFFFFu;
        const int is_ = hm_ ? __builtin_ctz(hm_) : 15, wd = 15 - is_;
        cum += (unsigned)__builtin_amdgcn_readlane((int)pf_, is_) - (unsigned)__builtin_amdgcn_readlane((int)tw_, is_);
        const unsigned chs_ = (unsigned)__builtin_amdgcn_readlane((int)chi_, is_);
        int tbq;
        if (cum + chs_ >= (unsigned)TOPK) tbq = 32 * L + 2 * wd + 1; else { cum += chs_; tbq = 32 * L + 2 * wd; }
        tbin[q] = tbq;
    }
    asm volatile("s_waitcnt lgkmcnt(0)" ::: "memory");
    {   unsigned klo[4], khi[4];
#pragma unroll
        for (int q = 0; q < 4; ++q) { const int tb = tbin[q];
            if (tb >= 1024) { const int e = tb - 1024; klo[q] = 0x80000000u | (e == 0 ? 0u : (unsigned)(e + 15616) << 16); khi[q] = (e == 1023) ? 0xFFFFFFFFu : (0x80000000u | ((unsigned)(e + 15617) << 16)); }
            else { const int e = 1023 - tb; const unsigned mlo = e == 0 ? 0u : (unsigned)(e + 15616) << 16, mhi = (e == 1023) ? 0x80000000u : (unsigned)(e + 15617) << 16; klo[q] = 0x80000000u - mhi; khi[q] = 0x80000000u - mlo; } }
        const int nkb = (t0 + 3) / 64 + 1;
        const u32x2* sp2 = (const u32x2*)sscr + lane;
        asm volatile("s_waitcnt vmcnt(0)" ::: "memory");
        u32x2 wq_[4];
#pragma unroll
        for (int i = 0; i < 4; ++i) wq_[i] = __builtin_nontemporal_load(sp2 + 64 * (i < nkb ? i : nkb - 1));
        for (int j0 = 0; j0 < nkb; j0 += 4) {
#pragma unroll
            for (int jj = 0; jj < 4; ++jj) { const int j = j0 + jj; if (j >= nkb) break;
                const u32x2 wc_ = wq_[jj]; { const int jn = j + 4 < nkb ? j + 4 : nkb - 1; wq_[jj] = __builtin_nontemporal_load(sp2 + 64 * jn); }
                const int s_ = 64 * j + lane;
#pragma unroll
                for (int q = 0; q < 4; ++q) { const unsigned w_ = q < 2 ? wc_.x : wc_.y; const h16x2 hp = __builtin_bit_cast(h16x2, w_); const float sc = (float)hp[q & 1];
                    const unsigned kk = fkey(sc); const bool valid = s_ <= t0 + q, sure = valid && kk >= khi[q], cand = valid && kk >= klo[q] && kk < khi[q];
                    const unsigned long long ms = __builtin_amdgcn_ballot_w64(sure), mc = __builtin_amdgcn_ballot_w64(cand);
                    if (sure) sel[q * TOPK + cs[q] + (int)__builtin_amdgcn_mbcnt_hi((unsigned)(ms >> 32), __builtin_amdgcn_mbcnt_lo((unsigned)ms, 0u))] = (unsigned short)s_;
                    if (cand) { const int pos = cc[q] + (int)__builtin_amdgcn_mbcnt_hi((unsigned)(mc >> 32), __builtin_amdgcn_mbcnt_lo((unsigned)mc, 0u));
                        if (pos < 512) ((LAS unsigned long long*)((LAS unsigned char*)hist + q * 4096))[pos] = ((unsigned long long)kk << 16) | (unsigned long long)(0xFFFFu - (unsigned)s_); }
                    cs[q] += __builtin_popcountll(ms); cc[q] += __builtin_popcountll(mc); } } } }
    asm volatile("s_waitcnt lgkmcnt(0)" ::: "memory");
#pragma unroll
    for (int q = 0; q < 4; ++q) {
        const int nc = cc[q] < 512 ? cc[q] : 512, need = TOPK - cs[q];
        const LAS unsigned long long* cq = (const LAS unsigned long long*)((const LAS unsigned char*)hist + q * 4096);
        if (nc > 64) {
            unsigned long long it[8];
#pragma unroll
            for (int k = 0; k < 8; ++k) it[k] = (k * 64 + lane < nc) ? cq[k * 64 + lane] : 0ull;
            unsigned long long T = 0ull;
            for (int bit = 47; bit >= 0; --bit) { const unsigned long long cand = T | (1ull << bit); int cnt = 0;
#pragma unroll
                for (int k = 0; k < 8; ++k) cnt += __builtin_popcountll(__ballot(it[k] >= cand));
                if (cnt >= need) T = cand; }
            int basep = cs[q];
#pragma unroll
            for (int k = 0; k < 8; ++k) { const bool pick = (T != 0ull) && it[k] >= T; const unsigned long long mk = __ballot(pick);
                if (pick) sel[q * TOPK + basep + __builtin_popcountll(mk & ((1ull << lane) - 1ull))] = (unsigned short)(0xFFFFu - (unsigned)(it[k] & 0xFFFFull));
                basep += __builtin_popcountll(mk); }
        } else
        for (int base = 0; base < nc; base += 64) {
            const bool act = base + lane < nc; const unsigned long long my = act ? cq[base + lane] : 0ull; int rank = 0;
            for (int jb = 0; jb < nc; jb += 64) {
                const unsigned long long cj = (jb + lane < nc) ? cq[jb + lane] : 0ull; const unsigned clo = (unsigned)cj, chi = (unsigned)(cj >> 32);
                const int n = (nc - jb) < 64 ? (nc - jb) : 64;
                for (int j = 0; j < n; ++j) { const unsigned long long sj = ((unsigned long long)(unsigned)__builtin_amdgcn_readlane((int)chi, j) << 32) | (unsigned)__builtin_amdgcn_readlane((int)clo, j); rank += (sj > my) ? 1 : 0; } }
            if (act && rank < need) sel[q * TOPK + cs[q] + rank] = (unsigned short)(0xFFFFu - (unsigned)(my & 0xFFFFull)); }
    }
    asm volatile("s_waitcnt lgkmcnt(0)" ::: "memory");
}

__device__ __forceinline__ void ph_dilated_mfma(const Frame& F, const h16* qb, const h16* kb, const h16* vb, h16* og, float* lse2) {
    const int lane0 = F.lane;
    LAS unsigned char* KL = F.lds + F.wave * 16384;
    LAS unsigned char* VL = KL + 4608;
    LAS float* linv = (LAS float*)(KL + 13824);
    constexpr int VROW = 144, VBUF = 4608;
    for (int u = F.gw; u < NB * 12 * 128; u += F.NGW) {
        int lane = lane0; asm volatile("" : "+v"(lane));
        const int ql = lane & 31, hi = lane >> 5, trq = (lane & 15) >> 2, trp = lane & 3, trg = (lane >> 4) & 1;
        const int b = u / 1536, rem = u % 1536, gh = rem >> 7, g = gh >> 2, wi_ = rem & 127, dil = dil_of(g), sh = g == 0 ? 0 : (g == 1 ? 2 : 4);
        const int nblk = 128 >> sh, res = wi_ / nblk, j0 = 32 * (wi_ % nblk);
        const size_t hoff = (size_t)b * SEQ * 768 + gh * 64;
        f16x8 Qf[4];
        { const h16* qp = qb + hoff + (size_t)((j0 + ql) * dil + res) * 768 + 8 * hi;
#pragma unroll
          for (int s_ = 0; s_ < 4; ++s_) Qf[s_] = *(const f16x8*)(qp + 16 * s_); }
        f32x16 S[5];
        f16x8 KG[5][4];
#pragma unroll
        for (int kt = 0; kt < 5; ++kt)
#pragma unroll
            for (int i = 0; i < 4; ++i) { int jk = j0 - 128 + 32 * kt + 8 * i + (lane >> 3); jk = jk < 0 ? 0 : jk;
                KG[kt][i] = *(const f16x8*)(kb + hoff + (size_t)(jk * dil + res) * 768 + (lane & 7) * 8); }
        f16x8 Vr[5][4];
#pragma unroll
        for (int kt = 0; kt < 5; ++kt)
#pragma unroll
            for (int i = 0; i < 4; ++i) { int jk = j0 - 128 + 32 * kt + 8 * i + (lane >> 3); jk = jk < 0 ? 0 : jk;
                Vr[kt][i] = *(const f16x8*)(vb + hoff + (size_t)(jk * dil + res) * 768 + (lane & 7) * 8); }
#pragma unroll
        for (int kt = 0; kt < 5; ++kt) {
#pragma unroll
            for (int i = 0; i < 4; ++i) *(LAS f16x8*)(KL + (8 * i + (lane >> 3)) * 144 + (lane & 7) * 16) = KG[kt][i];
            f16x8 Kf[4];
#pragma unroll
            for (int s_ = 0; s_ < 4; ++s_) Kf[s_] = *(const LAS f16x8*)(KL + ql * 144 + (2 * s_ + hi) * 16);
            f32x16 d = {0.f, 0.f, 0.f, 0.f, 0.f, 0.f, 0.f, 0.f, 0.f, 0.f, 0.f, 0.f, 0.f, 0.f, 0.f, 0.f};
#pragma unroll
            for (int s_ = 0; s_ < 4; ++s_) d = __builtin_amdgcn_mfma_f32_32x32x16_f16(Kf[s_], Qf[s_], d, 0, 0, 0);
            S[kt] = d; }
        float m = -INFINITY;
#pragma unroll
        for (int kt = 0; kt < 5; ++kt)
#pragma unroll
            for (int e = 0; e < 16; ++e) { const int kl = (e & 3) + 8 * (e >> 2) + 4 * hi; bool ok = (j0 - 128 + 32 * kt + kl) >= 0;
                if (kt == 0) ok = ok && (kl >= ql); if (kt == 4) ok = ok && (kl <= ql);
                if (!ok) S[kt][e] = -INFINITY; m = fmaxf(m, S[kt][e]); }
        m = max_x32(m);
        float l = 0.f;
#pragma unroll
        for (int kt = 0; kt < 5; ++kt)
#pragma unroll
            for (int e = 0; e < 16; ++e) { const float p = __builtin_amdgcn_exp2f(S[kt][e] - m); S[kt][e] = p; l += p; }
        l = sum_x32(l);
        if (hi == 0) { linv[ql] = __builtin_amdgcn_rcpf(l); lse2[(size_t)(b * SEQ + (j0 + ql) * dil + res) * 12 + gh] = m + __builtin_amdgcn_logf(l); }
        f32x16 O[2];
#pragma unroll
        for (int dt = 0; dt < 2; ++dt) O[dt] = (f32x16){0.f, 0.f, 0.f, 0.f, 0.f, 0.f, 0.f, 0.f, 0.f, 0.f, 0.f, 0.f, 0.f, 0.f, 0.f, 0.f};
#pragma unroll
        for (int kt = 0; kt < 5; ++kt) {
            LAS unsigned char* vbuf = VL + (kt & 1) * VBUF;
#pragma unroll
            for (int i = 0; i < 4; ++i) *(LAS f16x8*)(vbuf + (8 * i + (lane >> 3)) * VROW + (lane & 7) * 16) = Vr[kt][i];
            asm volatile("" ::: "memory");
#pragma unroll
            for (int s2 = 0; s2 < 2; ++s2) {
                u32x4 pa; pa.x = pk_h2(S[kt][8 * s2 + 0], S[kt][8 * s2 + 1]); pa.y = pk_h2(S[kt][8 * s2 + 2], S[kt][8 * s2 + 3]); pa.z = pk_h2(S[kt][8 * s2 + 4], S[kt][8 * s2 + 5]); pa.w = pk_h2(S[kt][8 * s2 + 6], S[kt][8 * s2 + 7]);
#pragma unroll
                for (int dt = 0; dt < 2; ++dt) {
                    const v4i16_t lo = __builtin_amdgcn_ds_read_tr16_b64_v4i16((LAS v4i16_t*)(vbuf + (16 * s2 + 4 * hi + trq) * VROW + (32 * dt + 16 * trg + 4 * trp) * 2));
                    const v4i16_t hh = __builtin_amdgcn_ds_read_tr16_b64_v4i16((LAS v4i16_t*)(vbuf + (16 * s2 + 8 + 4 * hi + trq) * VROW + (32 * dt + 16 * trg + 4 * trp) * 2));
                    const s16x8 bv = {lo[0], lo[1], lo[2], lo[3], hh[0], hh[1], hh[2], hh[3]};
                    O[dt] = __builtin_amdgcn_mfma_f32_32x32x16_f16(__builtin_bit_cast(f16x8, pa), __builtin_bit_cast(f16x8, bv), O[dt], 0, 0, 0); } }
            asm volatile("" ::: "memory");
        }
#pragma unroll
        for (int e = 0; e < 16; ++e) { const int q = (e & 3) + 8 * (e >> 2) + 4 * hi; const float il = linv[q];
            *(LAS h16*)(KL + q * 144 + ql * 2) = (h16)(O[0][e] * il); *(LAS h16*)(KL + q * 144 + 64 + ql * 2) = (h16)(O[1][e] * il); }
#pragma unroll
        for (int r_ = 0; r_ < 4; ++r_) { const int q = 8 * r_ + (lane >> 3), p8 = lane & 7; const u32x4 v = *(const LAS u32x4*)(KL + q * 144 + p8 * 16);
            *(u32x4*)(og + (size_t)(b * SEQ + (j0 + q) * dil + res) * 768 + gh * 64 + p8 * 8) = v; }
        asm volatile("s_waitcnt lgkmcnt(0)" ::: "memory");
    }
}


__device__ __forceinline__ f16x8 fp8x8_to_f16(unsigned w0, unsigned w1) {
    const h16x2 a = __builtin_amdgcn_cvt_scalef32_pk_f16_fp8((int)w0, 1.0f, false), b = __builtin_amdgcn_cvt_scalef32_pk_f16_fp8((int)w0, 1.0f, true),
                c = __builtin_amdgcn_cvt_scalef32_pk_f16_fp8((int)w1, 1.0f, false), d = __builtin_amdgcn_cvt_scalef32_pk_f16_fp8((int)w1, 1.0f, true);
    const u32x4 r = {__builtin_bit_cast(unsigned, a), __builtin_bit_cast(unsigned, b), __builtin_bit_cast(unsigned, c), __builtin_bit_cast(unsigned, d)};
    return __builtin_bit_cast(f16x8, r);
}
typedef int i32x2_t __attribute__((ext_vector_type(2)));
template <bool FUSED>
__device__ __forceinline__ void ph_sparse_wave(const Frame& F, h16* qlat, const h16* qr, const unsigned char* ckv8, const unsigned char* kr8, const LAS unsigned short* selL, int ta = 0) {
    int lane = F.lane; asm volatile("" : "+v"(lane));
    LAS unsigned char* V = F.lds + F.wave * 16384;
    const int tr_r = (lane & 15) >> 1, tr_c = lane & 1, tr_key = (tr_r < 4) ? (4 * (lane >> 4) + tr_r) : (16 + 4 * (lane >> 4) + tr_r - 4);
    const int tr0 = tr_key * 256 + 8 * tr_c, x0 = (tr_key & 15) ^ ((tr_key >> 4) << 3);
    const int lane0 = lane;
    const int nit = 4;
    u32x4 GA[8], RA;
    for (int it = 0; it < nit; ++it) {
        const int tok = ta + it;
        int ll = lane0; asm volatile("" : "+v"(ll));
        const int c = ll & 15, kq = ll >> 4, hd = c & 7;
        const int b = tok / SEQ, t = tok % SEQ, cnt = (t + 1 < TOPK) ? t + 1 : TOPK, nch = (cnt + 31) >> 5;
        u32x4 Q8[4]; f16x8 Qr;
#pragma unroll
        for (int q4 = 0; q4 < 4; ++q4) Q8[q4] = *(const u32x4*)((const unsigned char*)qlat + (size_t)tok * 4096 + hd * 256 + 64 * q4 + 16 * kq);
        { const f16x8 q0 = *(const f16x8*)(qr + (size_t)tok * 256 + hd * 32 + 8 * kq);
#pragma unroll
          for (int i = 0; i < 8; ++i) Qr[i] = q0[i] * (h16)64.f; }
        const i32x8 Qa = __builtin_shufflevector(__builtin_bit_cast(i32x4, Q8[0]), __builtin_bit_cast(i32x4, Q8[1]), 0, 1, 2, 3, 4, 5, 6, 7), Qb = __builtin_shufflevector(__builtin_bit_cast(i32x4, Q8[2]), __builtin_bit_cast(i32x4, Q8[3]), 0, 1, 2, 3, 4, 5, 6, 7);
        const LAS unsigned short* selq = selL + it * TOPK;
        LAS unsigned char* KRB = F.lds + KRL_OFF + F.wave * 1024;
        const int cq = c ^ kq, wbase = kq * 256;
#define SW_LOADK(G, RR, SELP, CH) do { const LAS unsigned short* sq_ = (SELP) + 32 * (CH); const unsigned char* p_[8]; \
        _Pragma("unroll") for (int i = 0; i < 8; ++i) p_[i] = ckv8 + (size_t)(b * SEQ + (int)sq_[4 * i + kq]) * 256 + 16 * c; \
        const unsigned char* pk_ = kr8 + (size_t)(b * SEQ + (int)sq_[ll >> 1]) * 32 + 16 * (ll & 1); \
        _Pragma("unroll") for (int i = 0; i < 8; ++i) G[i] = *(const u32x4*)p_[i]; \
        RR = *(const u32x4*)pk_; } while (0)
#define SW_WRITE(G, RR, BUF) do { LAS unsigned char* Wb = V + (BUF) * 8192; \
        _Pragma("unroll") for (int i = 0; i < 8; ++i) *(LAS u32x4*)(Wb + i * 1024 + wbase + ((cq ^ ((4 * (i & 3)) ^ (8 * (i >> 2)))) << 4)) = G[i]; \
        *(LAS u32x4*)(KRB + ll * 16) = RR; } while (0)
        if (it == 0) { SW_LOADK(GA, RA, selq, 0); SW_WRITE(GA, RA, 0); SW_LOADK(GA, RA, selq, 1); }
        float m = -INFINITY, l = 0.f;
        f32x4 O[16];
#pragma unroll
        for (int ft = 0; ft < 16; ++ft) O[ft] = (f32x4){0.f, 0.f, 0.f, 0.f};
#define SW_CHUNK(G, RR, CH, NWAIT, LOADNEXT) do { \
            LAS unsigned char* Vb = V + ((CH) & 1) * 8192; \
            asm volatile("s_waitcnt lgkmcnt(0)" ::: "memory");               \
            f32x4 S[2]; u32x4 Ko[2][4]; u32x2 Ro[2]; \
            _Pragma("unroll") for (int tl = 0; tl < 2; ++tl) { \
                _Pragma("unroll") for (int q4 = 0; q4 < 4; ++q4) Ko[tl][q4] = *(const LAS u32x4*)(Vb + (16 * tl + c) * 256 + (((4 * q4 + kq) ^ (c ^ (8 * tl))) << 4)); \
                Ro[tl] = *(const LAS u32x2*)(KRB + (16 * tl + c) * 32 + 8 * kq); } \
            _Pragma("unroll") for (int tl = 0; tl < 2; ++tl) { \
                const i32x8 Ka = __builtin_shufflevector(__builtin_bit_cast(i32x4, Ko[tl][0]), __builtin_bit_cast(i32x4, Ko[tl][1]), 0, 1, 2, 3, 4, 5, 6, 7), Kb = __builtin_shufflevector(__builtin_bit_cast(i32x4, Ko[tl][2]), __builtin_bit_cast(i32x4, Ko[tl][3]), 0, 1, 2, 3, 4, 5, 6, 7); \
                S[tl] = __builtin_amdgcn_mfma_scale_f32_16x16x128_f8f6f4(Ka, Qa, (f32x4){0.f, 0.f, 0.f, 0.f}, 0, 0, 0, 0, 0, 0); \
                S[tl] = __builtin_amdgcn_mfma_scale_f32_16x16x128_f8f6f4(Kb, Qb, S[tl], 0, 0, 0, 0, 0, 0); \
                S[tl] = __builtin_amdgcn_mfma_f32_16x16x32_f16(fp8x8_to_f16(Ro[tl].x, Ro[tl].y), Qr, S[tl], 0, 0, 0); } \
            float cm = -INFINITY; \
            _Pragma("unroll") for (int tl = 0; tl < 2; ++tl) _Pragma("unroll") for (int e = 0; e < 4; ++e) { S[tl][e] = (32 * (CH) + 16 * tl + 4 * kq + e >= cnt) ? -INFINITY : S[tl][e] * (1.f / 64.f); cm = fmaxf(cm, S[tl][e]); } \
            cm = max_x16(cm); cm = max_x32(cm); \
              \
            if (__any(cm > m + 4.0f)) { const float mn = fmaxf(m, cm), alpha = __builtin_amdgcn_exp2f(m - mn); m = mn; l *= alpha; \
                _Pragma("unroll") for (int ft = 0; ft < 16; ++ft) O[ft] = O[ft] * alpha; } \
            float pe[2][4]; float ps = 0.f; \
            _Pragma("unroll") for (int tl = 0; tl < 2; ++tl) _Pragma("unroll") for (int e = 0; e < 4; ++e) { pe[tl][e] = __builtin_amdgcn_exp2f(S[tl][e] - m); ps += pe[tl][e]; } \
            l += ps; \
            u32x2 pk; pk.x = pk_f8x4(pe[0][0] * 16.f, pe[0][1] * 16.f, pe[0][2] * 16.f, pe[0][3] * 16.f); pk.y = pk_f8x4(pe[1][0] * 16.f, pe[1][1] * 16.f, pe[1][2] * 16.f, pe[1][3] * 16.f); \
            const long Pf = __builtin_bit_cast(long, pk); \
            _Pragma("unroll") for (int ft = 0; ft < 16; ++ft) { \
                const i32x2_t av = __builtin_amdgcn_ds_read_tr8_b64_v2i32((LAS i32x2_t*)(Vb + tr0 + ((ft ^ x0) << 4))); \
                O[ft] = __builtin_amdgcn_mfma_f32_16x16x32_fp8_fp8(__builtin_bit_cast(long, av), Pf, O[ft], 0, 0, 0); } \
            { const int n1_ = it * 8 + (CH) + 1, n2_ = n1_ + 1;              \
              if (n1_ < 32) { SW_WRITE(G, RR, n1_ & 1); if (n2_ < 32) SW_LOADK(G, RR, selL + (n2_ >> 3) * TOPK, n2_ & 7); } } } while (0)
#pragma unroll 1
        for (int ch = 0; ch < 8; ++ch) SW_CHUNK(GA, RA, ch, 0, true);
#undef SW_CHUNK
        asm volatile("s_waitcnt lgkmcnt(0)" ::: "memory");
        l = sum_x16(l); l = sum_x32(l);
        if (c < 8) { const float il = __builtin_amdgcn_rcpf(l) * (1.f / 16.f);
#pragma unroll
            for (int ft = 0; ft < 16; ++ft) { const f32x4 o = O[ft] * il; u32x2 pk; pk.x = pk_h2(o.x, o.y); pk.y = pk_h2(o.z, o.w);
                *(LAS u32x2*)(V + 8192 + c * 512 + ((4 * (ft ^ c) + kq) << 3)) = pk; } }
        asm volatile("s_waitcnt lgkmcnt(0)" ::: "memory");
        { u32x4 ov[4];
#pragma unroll
          for (int r_ = 0; r_ < 4; ++r_) { const int P = r_ * 64 + ll, h = P >> 5, p = P & 31; ov[r_] = *(const LAS u32x4*)(V + 8192 + h * 512 + ((p ^ (2 * h)) << 4)); }
#pragma unroll
          for (int r_ = 0; r_ < 4; ++r_) *(u32x4*)(qlat + (size_t)tok * 2048 + (r_ * 64 + ll) * 8) = ov[r_]; }
        asm volatile("s_waitcnt lgkmcnt(0)" ::: "memory");
#undef SW_LOADK
#undef SW_WRITE
    }
}


__device__ __forceinline__ void precomb_tiles(const Frame& F, const Args& args, unsigned char* ws, int t_lo, int t_hi, int wg, int nwg) {
    LAS float* As = (LAS float*)(F.lds); LAS float* Bs = (LAS float*)(F.lds + 64 * 65 * 4);
    for (int tl = t_lo + wg; tl < t_hi; tl += nwg) {
        __syncthreads();
        const bool ql = tl < 192; int hd, rb, xb;
        if (ql) { hd = tl / 24; rb = (tl % 24) / 6; xb = tl % 6; } else { const int t2 = tl - 192; hd = t2 / 64; rb = (t2 % 64) / 16; xb = t2 % 16; }
#pragma unroll
        for (int k = 0; k < 2; ++k) { const int i4 = F.tid + NTHR * k, row = i4 >> 4, c4 = (i4 & 15) * 4;
            if (ql) { const f32x4 a = *(const f32x4*)(args.in[15] + (size_t)(rb * 64 + row) * 512 + hd * 64 + c4), bq = *(const f32x4*)(args.in[14] + (size_t)(xb * 64 + row) * 768 + hd * 96 + c4);
#pragma unroll
                for (int e = 0; e < 4; ++e) { As[row * 65 + c4 + e] = a[e]; Bs[row * 65 + c4 + e] = bq[e]; } }
            else { const f32x4 a = *(const f32x4*)(args.in[18] + (size_t)(hd * 64 + row) * DM + xb * 64 + c4), bq = *(const f32x4*)(args.in[16] + (size_t)(rb * 64 + row) * 512 + hd * 64 + c4);
#pragma unroll
                for (int e = 0; e < 4; ++e) { As[(c4 + e) * 65 + row] = a[e]; Bs[row * 65 + c4 + e] = bq[e]; } } }
        __syncthreads();
        const int j = F.tid & 63, ig = F.wave;
        float acc8[8];
#pragma unroll
        for (int ii = 0; ii < 8; ++ii) acc8[ii] = 0.f;
#pragma unroll 4
        for (int v = 0; v < 64; ++v) { const float bv = Bs[j * 65 + v];
#pragma unroll
            for (int ii = 0; ii < 8; ++ii) acc8[ii] += As[(ig * 8 + ii) * 65 + v] * bv; }
        if (ql) { const float gj = args.in[12][xb * 64 + j]; h16* o = (h16*)(ws + OW_4);
#pragma unroll
            for (int ii = 0; ii < 8; ++ii) o[(size_t)(hd * 256 + rb * 64 + ig * 8 + ii) * QL + xb * 64 + j] = (h16)(acc8[ii] * gj); }
        else { h16* o = (h16*)(ws + OW_OV);
#pragma unroll
            for (int ii = 0; ii < 8; ++ii) o[(size_t)(xb * 64 + ig * 8 + ii) * 2048 + hd * 256 + rb * 64 + j] = (h16)acc8[ii]; }
    }
    __syncthreads();
}


__device__ __forceinline__ void ph_topk_sparse(const Frame& F, const h16* qi, const h16* ki, const float* wi, h16* qlat, const h16* qr, const unsigned char* ckv8, const unsigned char* kr8, unsigned char* ws, unsigned char* dout) {
    LAS unsigned* hist = (LAS unsigned*)(F.lds + F.wave * 16384);
    LAS unsigned short* selL = (LAS unsigned short*)(F.lds + SELL_OFF + F.wave * 2048);
    unsigned* sscr = (unsigned*)(F.gw < 1024 ? ws + OFF_H + (size_t)F.gw * 32768 : (F.gw < 1760 ? ws + OFF_F + 41 * MiB + (size_t)(F.gw - 1024) * 32768 : dout + 48 * MiB + (size_t)(F.gw - 1760) * 32768));
    for (int p = F.gw; p < 2048; p += F.NGW) {
        int b, ga, gb;
        if (p < 4 * 448) { b = p & 3; const int pj = p >> 2; ga = 64 + pj; gb = 959 - pj; }
        else { const int q_ = p - 4 * 448; b = q_ & 3; ga = 960 + (q_ >> 2); gb = q_ >> 2; }
        tk_group(F, qi, ki, wi, selL, b, 4 * ga, hist, sscr);
        asm volatile("s_waitcnt lgkmcnt(0)" ::: "memory");
        ph_sparse_wave<true>(F, qlat, qr, ckv8, kr8, selL, b * SEQ + 4 * ga);
        asm volatile("s_waitcnt lgkmcnt(0)" ::: "memory");
        if (gb >= 64) tk_group(F, qi, ki, wi, selL, b, 4 * gb, hist, sscr);
        else { int l0 = F.lane; asm volatile("" : "+v"(l0));
            for (int i = l0; i < 4 * TOPK; i += 64) { const int q = i >> 8, k = i & 255; selL[i] = (unsigned short)(k <= 4 * gb + q ? k : 0); } }
        asm volatile("s_waitcnt lgkmcnt(0)" ::: "memory");
        ph_sparse_wave<true>(F, qlat, qr, ckv8, kr8, selL, b * SEQ + 4 * gb);
        asm volatile("s_waitcnt lgkmcnt(0)" ::: "memory");
    }
}

__global__ void __launch_bounds__(NTHR, 2) mega_fwd(Args args) {
    extern __shared__ __attribute__((aligned(16))) unsigned char lds_raw[];
    Frame F; F.lds = (LAS unsigned char*)lds_raw; F.tid = threadIdx.x; F.lane = F.tid & 63; F.wave = __builtin_amdgcn_readfirstlane(F.tid >> 6);
    F.G = gridDim.x; F.gw = blockIdx.x * NWAVES + F.wave; F.NGW = F.G * NWAVES;
    volatile LAS unsigned* MISC = (volatile LAS unsigned*)(F.lds + MISC_OFF);
    unsigned char* ws = args.ws;
    for (int u = F.tid; u < (LDS_BYTES - LDSCTL_OFF) / 4; u += NTHR) ((LAS unsigned*)(F.lds + LDSCTL_OFF))[u] = 0u;
    __syncthreads();
    XcdBarrier bar = xcd_barrier_post((unsigned*)(ws + OFF_CTL) + CW_BAR, MISC + 8, F.wave);
    const int lo = args.ph_lo, hi = args.ph_hi;
#define IN(k) (lo <= (k) && (k) < hi)
#define SEAM(k) do { if (IN(k) && IN((k) + 1)) xcd_barrier(bar); F.lane = flane(); F.tid = F.wave * 64 + F.lane; } while (0)
    float* mod = (float*)(ws + OFF_MOD); float2* tab = (float2*)(ws + OFF_ROPE);
    h16* Hb = (h16*)(ws + OFF_H); h16* Ab = (h16*)(ws + OFF_A); float* Fb = (float*)(ws + OFF_F);

    if (IN(0)) {
        LAS float* scr = (LAS float*)(F.lds + F.wave * 16384);
        for (int ch = blockIdx.x; ch < (NMOD * DM) / 36; ch += F.G) {
            LAS float* sl = (LAS float*)(F.lds);
            LAS f32x4* part = (LAS f32x4*)(F.lds + 16384);
            __syncthreads();
            for (int i = F.tid; i < 4 * DM; i += NTHR) sl[i] = silu_f(args.in[1][i]);
            __syncthreads();
            const int r7 = F.lane / 9, c4 = F.lane - 9 * r7; const bool act = F.lane < 63;
            const float* wm = args.in[3] + (size_t)(F.wave * 128 + r7) * (NMOD * DM) + ch * 36 + 4 * c4;
            f32x4 wv[19];
#pragma unroll
            for (int i = 0; i < 19; ++i) { const bool ok = act && (7 * i + r7 < 128); wv[i] = *(const f32x4*)(wm + (size_t)(ok ? 7 * i : 0) * (NMOD * DM)); }
            f32x4 a0 = {0.f, 0.f, 0.f, 0.f}, a1 = a0, a2 = a0, a3 = a0;
#pragma unroll
            for (int i = 0; i < 19; ++i) { const bool ok = act && (7 * i + r7 < 128); const int kk = F.wave * 128 + (ok ? 7 * i + r7 : 0); const f32x4 w = ok ? wv[i] : (f32x4){0.f, 0.f, 0.f, 0.f};
                a0 += w * sl[kk]; a1 += w * sl[DM + kk]; a2 += w * sl[2 * DM + kk]; a3 += w * sl[3 * DM + kk]; }
            if (act) { LAS f32x4* pp = part + ((F.wave * 7 + r7) * 4) * 9 + c4; pp[0] = a0; pp[9] = a1; pp[18] = a2; pp[27] = a3; }
            __syncthreads();
            if (F.tid < 144) { const int b = F.tid / 36, l = F.tid - 36 * b; float sm = args.in[4][ch * 36 + l]; const LAS float* pf = (const LAS float*)part + (b * 9) * 4 + l;
#pragma unroll 8
                for (int w = 0; w < 56; ++w) sm += pf[w * 144];
                mod[b * (NMOD * DM) + ch * 36 + l] = sm; }
            __syncthreads();
        }
        for (int base = blockIdx.x * NTHR + F.tid; base < MT * 48; base += 6 * F.G * NTHR) {
            int ps[6];
#pragma unroll
            for (int k = 0; k < 6; ++k) { const int idx = base + k * F.G * NTHR; ps[k] = ((const int*)args.in[2])[(idx < MT * 48 ? idx : base) / 48]; }
#pragma unroll
            for (int k = 0; k < 6; ++k) { const int idx = base + k * F.G * NTHR; if (idx < MT * 48) { const int i = idx % 48;
                const float inv = (i < 32) ? powf(10000.f, -(float)i / 32.f) : powf(10000.f, -(float)(i - 32) / 16.f);
                const float ang = (float)ps[k] * inv; float sn, cs; sincosf(ang, &sn, &cs); tab[idx] = make_float2(cs, sn); } } }
        tr_job_mapped(F, args, 0, 2 * FF, 0, DM, ws + OW_GU1, nullptr, scr, 0);
        if (F.G != 256) {
            tr_job_plain(F, args.in[8], DM, DM, FF, ws + OW_D1, scr, 768);
            tr_job_mapped(F, args, 2, NIN3, 0, DM, (h16*)(ws + OW_IN), nullptr, scr, 128);
            tr_job_plain(F, args.in[11] + C_GATE, DIN, 2048, DM, ws + OW_GATE, scr, 1664);
            tr_job_mapped(F, args, 3, 512, 2048, QL, (h16*)(ws + OW_4), args.in[12], scr, 640);
            tr_job_plain(F, args.in[19], DM, DM, 256, (h16*)(ws + OW_UPB), scr, 736);
            tr_job_plain(F, args.in[20], DM, DM, DM, (h16*)(ws + OW_O), scr, 864);
            tr_job_mapped(F, args, 1, 2 * FF, 0, DM, ws + OW_GU2, nullptr, scr, 1376);
            tr_job_plain(F, args.in[25], DM, DM, FF, ws + OW_D2, scr, 96);
            precomb_tiles(F, args, ws, 0, 192, (int)blockIdx.x, F.G);
            tr_job_plain(F, args.in[18], DM, DM, 512, (h16*)(ws + OW_UPA), scr, 256);
        }
    }
    SEAM(0);
    if (IN(1)) ph_normmod(F, args.in[0], args.in[5], mod, 1, 0, ws + OFF_H);
    SEAM(1);
    if (IN(2)) { pg8::Gemm g{Hb, (const h16*)(ws + OW_GU1), MT, 2 * FF, DM / 2}; pg8::StaticOrder S; S.init(MT, 2 * FF, F.G, (int)blockIdx.x); pg8::EpiSwiGLU_T<true> E{Ab};
        pg8::gemm_phase<pg8::EpiSwiGLU_T<true>, true, true>(F.lds, g, S, E, F.wave);
        if (F.G == 256 && blockIdx.x >= 128) {
            Frame F2 = F; F2.gw = ((int)blockIdx.x - 128) * NWAVES + F.wave; F2.NGW = 128 * NWAVES; LAS float* scr = (LAS float*)(F.lds + F.wave * 16384);
            tr_job_plain(F2, args.in[8], DM, DM, FF, ws + OW_D1, scr, 0);
            tr_job_mapped(F2, args, 2, NIN3, 0, DM, (h16*)(ws + OW_IN), nullptr, scr, 384);
            tr_job_mapped(F2, args, 3, 512, 2048, QL, (h16*)(ws + OW_4), args.in[12], scr, 896);
            precomb_tiles(F, args, ws, 0, 192, (int)blockIdx.x - 128, 128);
            for (int i = ((int)blockIdx.x - 128) * NTHR + F.tid; i < (int)(MiB / 16); i += 128 * NTHR) ((u32x4*)(ws + OW_BD))[i] = (u32x4){0u, 0u, 0u, 0u}; } }
    SEAM(2);
    if (IN(3)) { pg8::Gemm g{Ab, (const h16*)(ws + OW_D1), MT, DM, FF / 2}; pg8::StaticOrder S; S.init(MT, DM, F.G, (int)blockIdx.x); pg8::EpiH16_T<true> E{(h16*)Fb};
        pg8::gemm_phase<pg8::EpiH16_T<true>, false, true>(F.lds, g, S, E, F.wave); }
    SEAM(3);
    if (IN(4)) ph_resnorm<false, true>(F, args.in[0], (const h16*)Fb, args.in[9], mod, 2, 0.5f, args.out, true, args.in[10], 4, 3, Hb, (unsigned char*)args.out + 32 * MiB);
    SEAM(4);
    if (IN(5)) { pg8::Gemm g{Hb, (const h16*)(ws + OW_IN), MT, NIN3, DM}; pg8::StaticOrder S; S.init(MT, NIN3, F.G, (int)blockIdx.x);
        pg8::EpiIn E{(h16*)(ws + OFF_CKV), (h16*)(ws + OFF_CQ), (h16*)(ws + OFF_KR), (h16*)(ws + OFF_KI), (h16*)(ws + OFF_QB), (h16*)(ws + OFF_KB), (h16*)(ws + OFF_VT), (float*)(ws + OFF_WI), (float*)(ws + OFF_SSQ),
                     args.in[13], tab, (LAS float*)(F.lds + XCH_OFF)};
        pg8::gemm_phase<pg8::EpiIn, true>(F.lds, g, S, E, F.wave); }
    SEAM(5);
    if (IN(6)) { for (int tk_ = blockIdx.x * NTHR + F.tid; tk_ < MT; tk_ += F.G * NTHR) { const f32x4 s0 = *(const f32x4*)((const float*)(ws + OFF_SSQ) + tk_ * 8), s1 = *(const f32x4*)((const float*)(ws + OFF_SSQ) + tk_ * 8 + 4);
            ((float*)(ws + OFF_RSTDQ))[tk_] = rsqrtf((((s0.x + s0.y) + (s0.z + s0.w)) + ((s1.x + s1.y) + (s1.z + s1.w))) * (1.f / QL) + EPS); } }
    if (IN(6)) ph_dilated_mfma(F, (const h16*)(ws + OFF_QB), (const h16*)(ws + OFF_KB), (const h16*)(ws + OFF_VT), (h16*)(ws + OFF_OG), (float*)(ws + OFF_LSE));
    SEAM(6);
    if (IN(7)) { pg8::Gemm g{(const h16*)(ws + OFF_CQ), (const h16*)(ws + OW_4), MT, N4, QL}; pg8::StaticOrder S; S.init(MT, N4, F.G, (int)blockIdx.x);
        pg8::Epi4 E{(h16*)(ws + OFF_QLAT), (h16*)(ws + OFF_QR), (h16*)(ws + OFF_QI), (const float*)(ws + OFF_RSTDQ), tab};
        pg8::gemm_phase<pg8::Epi4, true>(F.lds, g, S, E, F.wave);
        if (F.G == 256 && blockIdx.x >= 128) {
            Frame F2 = F; F2.gw = ((int)blockIdx.x - 128) * NWAVES + F.wave; F2.NGW = 128 * NWAVES; LAS float* scr = (LAS float*)(F.lds + F.wave * 16384);
            tr_job_plain(F2, args.in[11] + C_GATE, DIN, 2048, DM, ws + OW_GATE, scr, 0);
            tr_job_mapped(F2, args, 1, 2 * FF, 0, DM, ws + OW_GU2, nullptr, scr, 640);
            tr_job_plain(F2, args.in[19], DM, DM, 256, (h16*)(ws + OW_UPB), scr, 512);
            tr_job_plain(F2, args.in[20], DM, DM, DM, (h16*)(ws + OW_O), scr, 640);
            tr_job_plain(F2, args.in[18], DM, DM, 512, (h16*)(ws + OW_UPA), scr, 256);
            for (int it = F2.gw; it < 4 * 16; it += F2.NGW) { const int kb = it >> 4, nb = it & 15, n0 = nb * 32, hl = (n0 >> 6) & 3;
                tr_item(args.in[16], 512, n0 + (F.lane & 31), true, nullptr, kb * 64, (h16*)(ws + OW_BD) + (size_t)n0 * 1024 + 256 * hl, 1024, scr, F.lane); } } }
    SEAM(7);
    if (IN(8)) { ph_combine(F, (const h16*)(ws + OFF_OG), (const float*)(ws + OFF_LSE), (h16*)(ws + OFF_OB));
        ph_topk_sparse(F, (const h16*)(ws + OFF_QI), (const h16*)(ws + OFF_KI), (const float*)(ws + OFF_WI),
                       (h16*)(ws + OFF_QLAT), (const h16*)(ws + OFF_QR), (const unsigned char*)(ws + OFF_CKV), (const unsigned char*)(ws + OFF_KR), ws, (unsigned char*)args.out); }
    SEAM(8);
    if (IN(9) && F.G == 256) { const bool first = blockIdx.x < 128;
        pg8::Gemm g{first ? (const h16*)(ws + OFF_QLAT) : (const h16*)(ws + OFF_OB), first ? (const h16*)(ws + OW_BD) : (const h16*)(ws + OW_UPB), MT, first ? 512 : DM, first ? 1024 : 256, first ? 2048 : 0, first ? 1024 : 0};
        pg8::StaticOrder S; S.init(MT, first ? 512 : DM, 128, first ? (int)blockIdx.x : (int)blockIdx.x - 128);
        pg8::EpiH16 E{first ? (h16*)(ws + OFF_OA) : (h16*)(ws + OFF_Y2), first ? 512 : DM};
        pg8::gemm_phase<pg8::EpiH16, false>(F.lds, g, S, E, F.wave); }
    SEAM(9);
    if (IN(10)) { pg8::StaticOrder S; S.init(MT, DM, F.G, (int)blockIdx.x); h16* Y1 = (h16*)(ws + OFF_Y1); h16* Y2 = (h16*)(ws + OFF_Y2);
        { pg8::Gemm g{(const h16*)(ws + OFF_OA), (const h16*)(ws + OW_UPA), MT, DM, 512}; pg8::EpiH16 E{Y1}; pg8::gemm_phase<pg8::EpiH16, false>(F.lds, g, S, E, F.wave); }
        const h16* u8 = (const h16*)((const unsigned char*)args.out + 32 * MiB);
        { pg8::Gemm g{u8, (const h16*)(ws + OW_GATE), MT, 2 * DM, DM / 2}; pg8::EpiGate E{Y1, Y1, 0, -LOG2E * F8_INV, Y2}; pg8::PairOrder P{S};
          pg8::gemm_phase<pg8::EpiGate, false, true, pg8::PairOrder>(F.lds, g, P, E, F.wave); } }
    SEAM(10);
    if (IN(11)) { pg8::Gemm g{(const h16*)(ws + OFF_Y1), (const h16*)(ws + OW_O), MT, DM, DM}; pg8::StaticOrder S; S.init(MT, DM, F.G, (int)blockIdx.x); pg8::EpiH16 E{(h16*)(ws + OFF_YF)};
        pg8::gemm_phase<pg8::EpiH16, false>(F.lds, g, S, E, F.wave); }
    SEAM(11);
    if (IN(12)) ph_resnorm<true, true, unsigned char>(F, args.out, (const h16*)(ws + OFF_YF), args.in[21], mod, 5, 1.0f, ws + OFF_F, true, args.in[22], 7, 6, ws + OFF_H);
    SEAM(12);
    if (IN(13)) { pg8::Gemm g{Hb, (const h16*)(ws + OW_GU2), MT, 2 * FF, DM / 2}; pg8::StaticOrder S; S.init(MT, 2 * FF, F.G, (int)blockIdx.x); pg8::EpiSwiGLU_T<true> E{Ab};
        pg8::gemm_phase<pg8::EpiSwiGLU_T<true>, true, true>(F.lds, g, S, E, F.wave);
        if (F.G == 256 && blockIdx.x >= 128) { Frame F2 = F; F2.gw = ((int)blockIdx.x - 128) * NWAVES + F.wave; F2.NGW = 128 * NWAVES;
            tr_job_plain(F2, args.in[25], DM, DM, FF, ws + OW_D2, (LAS float*)(F.lds + F.wave * 16384), 0); } }
    SEAM(13);
    if (IN(14)) { pg8::Gemm g{Ab, (const h16*)(ws + OW_D2), MT, DM, FF / 2}; pg8::StaticOrder S; S.init(MT, DM, F.G, (int)blockIdx.x); pg8::EpiH16_T<true> E{(h16*)(ws + OFF_F + 32 * MiB)};
        pg8::gemm_phase<pg8::EpiH16_T<true>, false, true>(F.lds, g, S, E, F.wave); }
    SEAM(14);
    if (IN(15)) ph_resnorm<true, false>(F, ws + OFF_F, (const h16*)(ws + OFF_F + 32 * MiB), args.in[26], mod, 8, 0.5f, args.out, false, nullptr, 0, 0, (h16*)nullptr);
#undef IN
#undef SEAM
}


extern "C" void kernel_launch(void* const* d_in, const int* in_sizes, int n_in, void* d_out, int out_size, void* d_ws, size_t ws_size, hipStream_t stream) {
    if (n_in != 27 || ws_size < WS_END || out_size != MT * DM) { fprintf(stderr, "kernel_launch: unexpected shapes (n_in %d ws %zu out %d)\n", n_in, ws_size, out_size); return; }
    static int grid = 0;
    if (grid == 0) {
        int dev = 0, cus = 0, per_cu = 0;
        if (hipGetDevice(&dev) != hipSuccess || hipDeviceGetAttribute(&cus, hipDeviceAttributeMultiprocessorCount, dev) != hipSuccess) { grid = -1; return; }
        if (hipFuncSetAttribute((const void*)mega_fwd, hipFuncAttributeMaxDynamicSharedMemorySize, LDS_BYTES) != hipSuccess) { fprintf(stderr, "kernel_launch: hipFuncSetAttribute failed\n"); grid = -1; return; }
        if (hipOccupancyMaxActiveBlocksPerMultiprocessor(&per_cu, (const void*)mega_fwd, NTHR, LDS_BYTES) != hipSuccess || per_cu < 1) { fprintf(stderr, "kernel_launch: occupancy query says %d blocks/CU\n", per_cu); grid = -1; return; }
        grid = cus;
    }
    if (grid < 0) return;
    (void)hipMemsetAsync((char*)d_ws + OFF_CTL + CW_BAR * 4, 0, 16384, stream);
    Args a{}; for (int i = 0; i < 27; ++i) a.in[i] = (const float*)d_in[i]; a.out = (float*)d_out; a.ws = (unsigned char*)d_ws; a.ph_lo = 0; a.ph_hi = 16;
    void* kargs[] = {&a};
#ifdef PH_DOUBLE
    a.ph_hi = PH_DOUBLE + 1; (void)hipLaunchCooperativeKernel((const void*)mega_fwd, dim3(grid), dim3(NTHR), kargs, LDS_BYTES, stream);
    (void)hipMemsetAsync((char*)d_ws + OFF_CTL + CW_BAR * 4, 0, 16384, stream); a.ph_lo = PH_DOUBLE; a.ph_hi = 16;
#endif
    const hipError_t e = hipLaunchCooperativeKernel((const void*)mega_fwd, dim3(grid), dim3(NTHR), kargs, LDS_BYTES, stream);
    if (e != hipSuccess) fprintf(stderr, "kernel_launch: cooperative launch failed: %s (grid %d)\n", hipGetErrorString(e), grid);
    (void)in_sizes;
}
```
